# Optimizing an MI355X kernel written in HIP

```python
import jax
import jax.numpy as jnp
from jax import lax
import numpy as np

D_MODEL = 2048
BATCH = 8
SEQ = 2048
DEPTH = 1

D_MIX = D_MODEL
D_LRU = D_MIX // 2
D_RWKV = D_MIX - D_LRU
LRU_HEADS = 8
LRU_HEAD_DIM = D_LRU // LRU_HEADS
CONV_WIDTH = 4
LRU_C = 8.0
RWKV_HEAD_DIM = 64
RWKV_HEADS = D_RWKV // RWKV_HEAD_DIM
DECAY_LORA = 64
AAA_LORA = 64
GATE_LORA = 160
RWKV_COLS = 3 * D_RWKV + DECAY_LORA + AAA_LORA + GATE_LORA
IN_COLS = 2 * D_LRU + RWKV_COLS
PEER_HEADS = 8
PEER_NKEYS = 128
PEER_EXPERTS = PEER_NKEYS * PEER_NKEYS
PEER_DQ = 256
PEER_DHALF = PEER_DQ // 2
PEER_TOPK = 16
PEER_BLOCK = 128
NORM_EPS = 1e-6
GN_EPS = 64e-5

kernel_name = "hybrid_rglru_rwkv7_peer"


def rms_norm(x, g):
    xf = x.astype(jnp.float32)
    y = xf * lax.rsqrt(jnp.mean(xf * xf, axis=-1, keepdims=True) + NORM_EPS)
    return (y * g.astype(jnp.float32)).astype(x.dtype)


def rg_lru_group(xb, gate, conv_w, conv_b, wa, ba, wi, bi, lam):
    B, S, C = xb.shape
    xc = lax.conv_general_dilated(
        xb, conv_w.astype(xb.dtype)[:, None, :], window_strides=(1,),
        padding=((CONV_WIDTH - 1, 0),), dimension_numbers=("NWC", "WIO", "NWC"),
        feature_group_count=C) + conv_b
    xh = xc.reshape(B, S, LRU_HEADS, LRU_HEAD_DIM)
    r = jax.nn.sigmoid(jnp.einsum("bshi,hij->bshj", xh, wa).reshape(B, S, C) + ba)
    i = jax.nn.sigmoid(jnp.einsum("bshi,hij->bshj", xh, wi).reshape(B, S, C) + bi)
    log_a = -LRU_C * r.astype(jnp.float32) * jax.nn.softplus(-lam.astype(jnp.float32))
    a = jnp.exp(log_a)
    bx = jnp.sqrt(-jnp.expm1(2.0 * log_a)) * (i * xc).astype(jnp.float32)

    def combine(c1, c2):
        a1, b1 = c1
        a2, b2 = c2
        return a1 * a2, a2 * b1 + b2

    _, h = lax.associative_scan(combine, (a, bx), axis=1)
    return (h * jax.nn.gelu(gate.astype(jnp.float32))).astype(xb.dtype)


def rwkv7_group(p, mu, w0, w2, a0, a2, g2, k_k, k_a, r_k, lnx_w, lnx_b):
    B, S, _ = p.shape
    H, N = RWKV_HEADS, RWKV_HEAD_DIM
    prev = jnp.pad(p, ((0, 0), (1, 0), (0, 0)))[:, :-1]
    ps = (p + (prev - p) * mu).astype(jnp.float32)
    r, k, v, wd, ad, gd = jnp.split(
        ps, [D_RWKV, 2 * D_RWKV, 3 * D_RWKV, 3 * D_RWKV + DECAY_LORA,
             3 * D_RWKV + DECAY_LORA + AAA_LORA], axis=-1)
    w_log = -jax.nn.softplus(-(w0 + jnp.tanh(wd) @ w2)) - 0.5
    decay = jnp.exp(-jnp.exp(w_log))
    a = jax.nn.sigmoid(a0 + ad @ a2)
    g = jax.nn.sigmoid(gd) @ g2
    kk = (k * k_k).reshape(B, S, H, N)
    kk = kk / jnp.maximum(jnp.sqrt(jnp.sum(kk * kk, axis=-1, keepdims=True)), 1e-12)
    k = k * (1.0 + (a - 1.0) * k_a)
    heads = lambda t: t.reshape(B, S, H, N)
    r_h, k_h, v_h, w_h, a_h = heads(r), heads(k), heads(v), heads(decay), heads(a)
    b_h = kk * a_h

    def step(state, inp):
        r_t, w_t, k_t, v_t, na_t, b_t = inp
        sa = jnp.einsum("bhij,bhj->bhi", state, na_t)
        state = (state * w_t[:, :, None, :] + sa[..., None] * b_t[:, :, None, :]
                 + v_t[..., None] * k_t[:, :, None, :])
        return state, jnp.einsum("bhij,bhj->bhi", state, r_t)

    seq_first = lambda t: jnp.moveaxis(t, 1, 0)
    state0 = jnp.zeros((B, H, N, N), jnp.float32)
    _, y = lax.scan(step, state0, (seq_first(r_h), seq_first(w_h), seq_first(k_h),
                                   seq_first(v_h), seq_first(-kk), seq_first(b_h)))
    y = jnp.moveaxis(y, 0, 1)
    mean = jnp.mean(y, axis=-1, keepdims=True)
    var = jnp.mean(jnp.square(y - mean), axis=-1, keepdims=True)
    y = ((y - mean) * lax.rsqrt(var + GN_EPS)).reshape(B, S, D_RWKV) * lnx_w + lnx_b
    bonus = jnp.sum(r_h * k_h * r_k, axis=-1, keepdims=True) * v_h
    y = (y + bonus.reshape(B, S, D_RWKV)) * g
    return y.astype(p.dtype)


def peer_ffn(h, wq, keys, u_tab, v_tab):
    B, S, D = h.shape
    q = (h @ wq).astype(jnp.float32).reshape(B, S, PEER_HEADS, 2, PEER_DHALF)
    sub = jnp.einsum("bshpd,hpnd->bshpn", q, keys.astype(jnp.float32))
    sv, si = lax.top_k(sub, PEER_TOPK)
    cand = (sv[..., 0, :, None] + sv[..., 1, None, :]).reshape(
        B, S, PEER_HEADS, PEER_TOPK * PEER_TOPK)
    cid = (si[..., 0, :, None] * PEER_NKEYS + si[..., 1, None, :]).reshape(
        B, S, PEER_HEADS, PEER_TOPK * PEER_TOPK)
    best, pos = lax.top_k(cand, PEER_TOPK)
    experts = jnp.take_along_axis(cid, pos, axis=-1)
    gates = jax.nn.softmax(best, axis=-1)
    n_blk = (B * S) // PEER_BLOCK
    E = PEER_HEADS * PEER_TOPK
    xs = h.reshape(n_blk, PEER_BLOCK, D)
    es = experts.reshape(n_blk, PEER_BLOCK, E)
    gs = gates.reshape(n_blk, PEER_BLOCK, E).astype(h.dtype)

    def block(args):
        xb, eb, gb = args
        u = jnp.take(u_tab, eb, axis=0)
        act = jax.nn.gelu(jnp.einsum("cd,ced->ce", xb, u))
        vv = jnp.take(v_tab, eb, axis=0)
        return jnp.einsum("ce,ced->cd", gb * act, vv)

    return lax.map(block, (xs, es, gs)).reshape(B, S, D)


def hybrid_layer(x, norm1_g, w_in, conv_w, conv_b, lru_wa, lru_ba, lru_wi, lru_bi,
                 lru_lambda, rwkv_mu, rwkv_w0, rwkv_w2, rwkv_a0, rwkv_a2, rwkv_g2,
                 rwkv_k_k, rwkv_k_a, rwkv_r_k, rwkv_lnx_w, rwkv_lnx_b, w_out,
                 norm2_g, peer_wq, peer_keys, peer_u, peer_v):
    h = rms_norm(x, norm1_g)
    proj = h @ w_in
    y_lru = rg_lru_group(proj[..., :D_LRU], proj[..., D_LRU:2 * D_LRU], conv_w, conv_b,
                         lru_wa, lru_ba, lru_wi, lru_bi, lru_lambda)
    y_rwkv = rwkv7_group(proj[..., 2 * D_LRU:], rwkv_mu, rwkv_w0, rwkv_w2, rwkv_a0,
                         rwkv_a2, rwkv_g2, rwkv_k_k, rwkv_k_a, rwkv_r_k,
                         rwkv_lnx_w, rwkv_lnx_b)
    x = x + jnp.concatenate([y_lru, y_rwkv], axis=-1) @ w_out
    x = x + peer_ffn(rms_norm(x, norm2_g), peer_wq, peer_keys, peer_u, peer_v)
    return x


def setup_inputs(seed: int = 0) -> dict:
    key = jax.random.key(seed)
    ks = jax.random.split(key, 28)
    f32 = jnp.float32
    L = DEPTH

    def nrm(k, shape, std):
        return jax.random.normal(k, shape, f32) * std

    lam_u = jax.random.uniform(ks[10], (L, D_LRU), f32, 0.9, 0.999)
    lam_s = lam_u ** (1.0 / LRU_C)
    lru_lambda = jnp.log(lam_s) - jnp.log1p(-lam_s)
    ramp = jnp.linspace(0.0, 1.0, D_RWKV, dtype=f32)
    rwkv_w0 = -6.5 + 5.0 * ramp ** 0.85 + nrm(ks[12], (L, D_RWKV), 0.1)
    return {
        "x": nrm(ks[0], (BATCH, SEQ, D_MODEL), 1.0),
        "norm1_g": 1.0 + nrm(ks[1], (L, D_MODEL), 0.02),
        "w_in": nrm(ks[2], (L, D_MODEL, IN_COLS), D_MODEL ** -0.5),
        "conv_w": nrm(ks[3], (L, CONV_WIDTH, D_LRU), CONV_WIDTH ** -0.5),
        "conv_b": nrm(ks[4], (L, D_LRU), 0.02),
        "lru_wa": nrm(ks[5], (L, LRU_HEADS, LRU_HEAD_DIM, LRU_HEAD_DIM), LRU_HEAD_DIM ** -0.5),
        "lru_ba": nrm(ks[6], (L, D_LRU), 0.02),
        "lru_wi": nrm(ks[7], (L, LRU_HEADS, LRU_HEAD_DIM, LRU_HEAD_DIM), LRU_HEAD_DIM ** -0.5),
        "lru_bi": nrm(ks[8], (L, D_LRU), 0.02),
        "lru_lambda": lru_lambda,
        "rwkv_mu": jax.random.uniform(ks[11], (L, RWKV_COLS), f32),
        "rwkv_w0": rwkv_w0,
        "rwkv_w2": nrm(ks[13], (L, DECAY_LORA, D_RWKV), 0.1 * DECAY_LORA ** -0.5),
        "rwkv_a0": nrm(ks[14], (L, D_RWKV), 0.1),
        "rwkv_a2": nrm(ks[15], (L, AAA_LORA, D_RWKV), AAA_LORA ** -0.5),
        "rwkv_g2": nrm(ks[16], (L, GATE_LORA, D_RWKV), GATE_LORA ** -0.5),
        "rwkv_k_k": 0.85 + nrm(ks[17], (L, D_RWKV), 0.02),
        "rwkv_k_a": 1.0 + nrm(ks[18], (L, D_RWKV), 0.02),
        "rwkv_r_k": nrm(ks[19], (L, RWKV_HEADS, RWKV_HEAD_DIM), 0.1),
        "rwkv_lnx_w": 1.0 + nrm(ks[20], (L, D_RWKV), 0.02),
        "rwkv_lnx_b": nrm(ks[21], (L, D_RWKV), 0.02),
        "w_out": nrm(ks[22], (L, D_MIX, D_MODEL), D_MIX ** -0.5),
        "norm2_g": 1.0 + nrm(ks[23], (L, D_MODEL), 0.02),
        "peer_wq": nrm(ks[24], (L, D_MODEL, PEER_HEADS * PEER_DQ), D_MODEL ** -0.5),
        "peer_keys": nrm(ks[25], (L, PEER_HEADS, 2, PEER_NKEYS, PEER_DHALF), PEER_DHALF ** -0.5),
        "peer_u": nrm(ks[26], (L, PEER_EXPERTS, D_MODEL), D_MODEL ** -0.5),
        "peer_v": nrm(ks[27], (L, PEER_EXPERTS, D_MODEL), 0.5),
        "normf_g": 1.0 + nrm(ks[9], (D_MODEL,), 0.02),
    }


def reference(x, norm1_g, w_in, conv_w, conv_b, lru_wa, lru_ba, lru_wi, lru_bi,
              lru_lambda, rwkv_mu, rwkv_w0, rwkv_w2, rwkv_a0, rwkv_a2, rwkv_g2,
              rwkv_k_k, rwkv_k_a, rwkv_r_k, rwkv_lnx_w, rwkv_lnx_b, w_out, norm2_g,
              peer_wq, peer_keys, peer_u, peer_v, normf_g):
    for l in range(DEPTH):
        x = hybrid_layer(x, norm1_g[l], w_in[l], conv_w[l], conv_b[l], lru_wa[l],
                         lru_ba[l], lru_wi[l], lru_bi[l], lru_lambda[l], rwkv_mu[l],
                         rwkv_w0[l], rwkv_w2[l], rwkv_a0[l], rwkv_a2[l], rwkv_g2[l],
                         rwkv_k_k[l], rwkv_k_a[l], rwkv_r_k[l], rwkv_lnx_w[l],
                         rwkv_lnx_b[l], w_out[l], norm2_g[l], peer_wq[l],
                         peer_keys[l], peer_u[l], peer_v[l])
    return rms_norm(x, normf_g)
```

```cpp
#include <hip/hip_runtime.h>
#include <cstdio>
#include <cstdint>
#define MK_N_LAUNCHES 7
namespace pg8 {
#define PG8_LAS __attribute__((address_space(3)))
typedef unsigned short bf16_t;
typedef short bf16x8 __attribute__((ext_vector_type(8)));
typedef float f32x4 __attribute__((ext_vector_type(4)));
typedef unsigned u32x4 __attribute__((ext_vector_type(4)));
constexpr int BM = 256, BK = 64, HALF = 128, HTB = HALF * BK * 2  , STAGE_BYTES = 8 * HTB, NXCD = 8, WGM = 8;

__host__ __device__ __forceinline__ int lds_byte(int r, int c) { const int st = (r >> 4) * 2 + (c >> 5), rr = r & 15, cc = c & 31, ob = rr * 64 + cc * 2; return st * 1024 + (ob ^ (((ob >> 9) & 1) << 5)); }
__host__ __device__ __forceinline__ void stage_rc(int b, int& R, int& C) { const int st = b / 1024, sb = b % 1024, swz = sb ^ (((sb >> 9) & 1) << 5); R = (st >> 1) * 16 + swz / 64; C = (st & 1) * 32 + (swz % 64) / 2; }
__host__ __device__ __forceinline__ int perm32(int rho) { const int n = rho >> 4, i = rho & 15; return 8 * (i >> 2) + 4 * n + (i & 3); }

struct Unit { int pm, pn; };
struct Gemm { const bf16_t* A; const bf16_t* Bt; int M, N, K; };

struct StaticOrder {
    int nM, nN, nwg, G, c;
    __host__ __device__ void init(int M, int N, int G_, int c_) { nM = M / BM; nN = N / BM; nwg = nM * nN; G = G_; c = c_; }
    __host__ __device__ bool next(int i, Unit& u) const {
        const long L = (long)i * G + c; if (L >= nwg) return false;
        int wgid = (int)L; { const int q = nwg / NXCD, r = nwg % NXCD, xcd = wgid % NXCD, off = wgid / NXCD; wgid = (xcd < r ? xcd * (q + 1) : r * (q + 1) + (xcd - r) * q) + off; }
        const int nig = WGM * nN, gid = wgid / nig, fm = gid * WGM, gsz = (nM - fm) < WGM ? (nM - fm) : WGM;
        u.pm = fm + ((wgid % nig) % gsz); u.pn = (wgid % nig) / gsz; return true;
    }
    __device__ __forceinline__ void a_ready(const Unit&) const {}
    __device__ __forceinline__ void done(const Unit&) const {}
};

__device__ __forceinline__ unsigned cvt_pk_bf16(float lo, float hi) { unsigned r; asm volatile("v_cvt_pk_bf16_f32 %0, %1, %2" : "=v"(r) : "v"(lo), "v"(hi)); return r; }
typedef float f32x2 __attribute__((ext_vector_type(2)));
typedef unsigned u32x2 __attribute__((ext_vector_type(2)));
template <int MODE> struct EpiRowScaleBf16 {
    static constexpr bool PERM = true, AFTER_DRAIN = false;
    bf16_t* O; int ldc; const float* rs; float eps;
    __device__ __forceinline__ void operator()(const f32x4 (&acc)[2][2][4][2], const Unit& u, int wr, int wc, int fr, int fq) const {
        const int row0 = u.pm * BM + wr * 64 + fr, col0 = u.pn * BM + wc * 32 + 8 * fq;
#pragma unroll
        for (int ai = 0; ai < 2; ++ai)
#pragma unroll
            for (int m = 0; m < 4; ++m) { const int r = row0 + ai * HALF + m * 16; float s = rs[r]; if (MODE == 1) s = 1.0f / sqrtf(s * (1.0f / 2048.0f) + eps);
                bf16_t* rowp = O + (size_t)r * ldc + col0;
#pragma unroll
                for (int bj = 0; bj < 2; ++bj) { const f32x4 v0 = acc[ai][bj][m][0] * s, v1 = acc[ai][bj][m][1] * s;
                    u32x4 w; w.x = cvt_pk_bf16(v0[0], v0[1]); w.y = cvt_pk_bf16(v0[2], v0[3]); w.z = cvt_pk_bf16(v1[0], v1[1]); w.w = cvt_pk_bf16(v1[2], v1[3]);
                    *(u32x4*)(rowp + bj * HALF) = w; } }
    }
};
struct EpiResidual {
    static constexpr bool PERM = false, AFTER_DRAIN = false;
    const float* base; float* out; bf16_t* outb; float* ssq; int ldc;
    __device__ __forceinline__ void operator()(const f32x4 (&acc)[2][2][4][2], const Unit& u, int wr, int wc, int fr, int fq) const {
        const int row0 = u.pm * BM + wr * 64 + fr, col0 = u.pn * BM + wc * 32 + 4 * fq;
#pragma unroll
        for (int ai = 0; ai < 2; ++ai)
#pragma unroll
            for (int m = 0; m < 4; ++m) { const int r = row0 + ai * HALF + m * 16; const size_t off = (size_t)r * ldc + col0; float q = 0.f;
#pragma unroll
                for (int bj = 0; bj < 2; ++bj)
#pragma unroll
                    for (int n = 0; n < 2; ++n) { const f32x4 bs = *(const f32x4*)(base + off + bj * HALF + n * 16); const f32x4 o = bs + acc[ai][bj][m][n];
                        *(f32x4*)(out + off + bj * HALF + n * 16) = o; q += (o[0] * o[0] + o[1] * o[1]) + (o[2] * o[2] + o[3] * o[3]);
                        u32x2 w; w.x = cvt_pk_bf16(o[0], o[1]); w.y = cvt_pk_bf16(o[2], o[3]); *(u32x2*)(outb + off + bj * HALF + n * 16) = w; }
                q += __shfl_xor(q, 16); q += __shfl_xor(q, 32);
                if (fq == 0) atomicAdd(ssq + r, q);
                asm volatile("" ::: "memory"); }
    }
};
template <class Epi, class Sched, bool ALIGN_EPI = false, bool SP2 = false>
__device__ __forceinline__ void gemm_phase(PG8_LAS unsigned char* lds, const Gemm g, const Sched& S, const Epi& E) {
    const int tid = threadIdx.x, wid = __builtin_amdgcn_readfirstlane(tid >> 6), lane = tid & 63, wr = wid >> 2, wc = wid & 3, fr = lane & 15, fq = lane >> 4;
    const int K = g.K, nt = K / BK;
    unsigned voffA[2], voffB[2];
#pragma unroll
    for (int i = 0; i < 2; ++i) { int R, C; stage_rc(tid * 16 + i * 8192, R, C); const int Rb = Epi::PERM ? ((R & ~31) + perm32(R & 31)) : R;
        voffA[i] = (unsigned)(R * K + C) * 2u; voffB[i] = (unsigned)(Rb * K + C) * 2u; }
    const size_t kstep = (size_t)(BK * 2);
    const size_t hstep = (size_t)HALF * K * 2;
    const size_t tstep = 2 * hstep;
    const unsigned ldsw = (unsigned)wid * 1024u;
    const int aoff = lds_byte(wr * 64 + fr, fq * 8), boff = lds_byte(wc * 32 + fr, fq * 8);
#define PG8_SA(b, h) (((b) * 2 + (h)) * HTB)
#define PG8_SB(b, h) ((4 + (b) * 2 + (h)) * HTB)
#define PG8_STAGE(bufoff, gbase, voff) do { _Pragma("unroll") for (int _i = 0; _i < 2; ++_i) \
        __builtin_amdgcn_global_load_lds((const unsigned*)((const char*)(gbase) + (voff)[_i]), (PG8_LAS unsigned*)(lds + (bufoff) + ldsw + _i * 8192), 16, 0, 0); } while (0)
#define PG8_LDA(dst, b, h) do { _Pragma("unroll") for (int m = 0; m < 4; ++m) _Pragma("unroll") for (int k = 0; k < 2; ++k) dst[m][k] = *(const PG8_LAS bf16x8*)(lds + PG8_SA(b, h) + aoff + m * 2048 + k * 1024); } while (0)
#define PG8_LDB(dst, b, h) do { _Pragma("unroll") for (int n = 0; n < 2; ++n) _Pragma("unroll") for (int k = 0; k < 2; ++k) dst[n][k] = *(const PG8_LAS bf16x8*)(lds + PG8_SB(b, h) + boff + n * 2048 + k * 1024); } while (0)
#define PG8_MMA(ai, bj, At, Bt) do { __builtin_amdgcn_s_setprio(1); _Pragma("unroll") for (int m = 0; m < 4; ++m) _Pragma("unroll") for (int n = 0; n < 2; ++n) _Pragma("unroll") for (int k = 0; k < 2; ++k) \
        acc[ai][bj][m][n] = __builtin_amdgcn_mfma_f32_16x16x32_bf16(Bt[n][k], At[m][k], acc[ai][bj][m][n], 0, 0, 0); __builtin_amdgcn_s_setprio(0); } while (0)
#define PG8_WAIT_V(n) asm volatile("s_waitcnt vmcnt(" #n ")" ::: "memory")
#define PG8_WAIT_L(n) asm volatile("s_waitcnt lgkmcnt(" #n ")" ::: "memory")
#define PG8_BAR __builtin_amdgcn_s_barrier()
#define PG8_SCHED __builtin_amdgcn_sched_barrier(0)
    Unit cur, nxt; int ui = 0;
    if (!S.next(0, cur)) return;
    f32x4 acc[2][2][4][2];
#pragma unroll
    for (int a = 0; a < 2; ++a)
#pragma unroll
        for (int b = 0; b < 2; ++b)
#pragma unroll
            for (int m = 0; m < 4; ++m)
#pragma unroll
                for (int n = 0; n < 2; ++n) acc[a][b][m][n] = (f32x4){0.f, 0.f, 0.f, 0.f};
    bf16x8 At[4][2], B0[2][2], B1[2][2];
    const char* cA = (const char*)g.A + (size_t)cur.pm * tstep; const char* cB = (const char*)g.Bt + (size_t)cur.pn * tstep;
    S.a_ready(cur);
    if constexpr (SP2) {
        PG8_STAGE(PG8_SB(0, 0), cB, voffB); PG8_STAGE(PG8_SB(0, 1), cB + hstep, voffB); PG8_STAGE(PG8_SA(0, 0), cA, voffA); PG8_STAGE(PG8_SA(0, 1), cA + hstep, voffA);
        if (wr == 1) PG8_BAR;
        PG8_WAIT_V(2); PG8_BAR;
        PG8_STAGE(PG8_SB(1, 0), cB + kstep, voffB); PG8_STAGE(PG8_SA(1, 0), cA + kstep, voffA); PG8_STAGE(PG8_SB(1, 1), cB + hstep + kstep, voffB);
        PG8_WAIT_V(6); PG8_BAR;
    } else {
        PG8_STAGE(PG8_SB(0, 0), cB, voffB); PG8_STAGE(PG8_SA(0, 0), cA, voffA); PG8_STAGE(PG8_SB(0, 1), cB + hstep, voffB); PG8_STAGE(PG8_SA(0, 1), cA + hstep, voffA);
        if (wr == 1) PG8_BAR;
        PG8_WAIT_V(4); PG8_BAR;
        PG8_STAGE(PG8_SB(1, 0), cB + kstep, voffB); PG8_STAGE(PG8_SA(1, 0), cA + kstep, voffA); PG8_STAGE(PG8_SB(1, 1), cB + hstep + kstep, voffB);
        PG8_WAIT_V(6); PG8_BAR;
    }
    for (;;) {
        const bool has_next = S.next(ui + 1, nxt);
        const char* nA = has_next ? (const char*)g.A + (size_t)nxt.pm * tstep : cA; const char* nB = has_next ? (const char*)g.Bt + (size_t)nxt.pn * tstep : cB;
        for (int t = 0; t < nt; t += 2) {
            const bool last = (t == nt - 2);
            const char* a1 = cA + (size_t)(t + 1) * kstep;
            const char* a2 = last ? nA : cA + (size_t)(t + 2) * kstep; const char* b2 = last ? nB : cB + (size_t)(t + 2) * kstep;
            const char* a3 = a2 + kstep; const char* b3 = b2 + kstep;
            if (last && has_next) S.a_ready(nxt);
            if constexpr (SP2) {
            PG8_LDB(B0, 0, 0); PG8_LDB(B1, 0, 1); PG8_SCHED; PG8_LDA(At, 0, 0); PG8_STAGE(PG8_SA(1, 1), a1 + hstep, voffA);
            PG8_WAIT_V(8); PG8_WAIT_L(0); PG8_BAR; PG8_MMA(0, 0, At, B0); PG8_MMA(0, 1, At, B1); PG8_BAR; PG8_SCHED;
            PG8_LDA(At, 0, 1); PG8_STAGE(PG8_SB(0, 0), b2, voffB); PG8_STAGE(PG8_SB(0, 1), b2 + hstep, voffB); PG8_STAGE(PG8_SA(0, 0), a2, voffA);
            PG8_WAIT_V(8); PG8_WAIT_L(0); PG8_BAR; PG8_MMA(1, 0, At, B0); PG8_MMA(1, 1, At, B1); PG8_BAR; PG8_SCHED;
            PG8_LDB(B0, 1, 0); PG8_LDB(B1, 1, 1); PG8_SCHED; PG8_LDA(At, 1, 0); PG8_STAGE(PG8_SA(0, 1), a2 + hstep, voffA);
            PG8_WAIT_V(8); PG8_WAIT_L(0); PG8_BAR; PG8_MMA(0, 0, At, B0); PG8_MMA(0, 1, At, B1); PG8_BAR; PG8_SCHED;
            PG8_LDA(At, 1, 1); PG8_STAGE(PG8_SB(1, 0), b3, voffB); PG8_STAGE(PG8_SB(1, 1), b3 + hstep, voffB); PG8_STAGE(PG8_SA(1, 0), a3, voffA);
            PG8_WAIT_V(8); PG8_WAIT_L(0); PG8_BAR; PG8_MMA(1, 0, At, B0); PG8_MMA(1, 1, At, B1); PG8_BAR; PG8_SCHED;
            } else {
            PG8_LDB(B0, 0, 0); PG8_SCHED; PG8_LDA(At, 0, 0); PG8_STAGE(PG8_SA(1, 1), a1 + hstep, voffA);
            PG8_WAIT_L(8); PG8_BAR; PG8_WAIT_L(0); PG8_MMA(0, 0, At, B0); PG8_BAR; PG8_SCHED;
            PG8_LDB(B1, 0, 1); PG8_STAGE(PG8_SB(0, 0), b2, voffB);
            PG8_BAR; PG8_WAIT_L(0); PG8_MMA(0, 1, At, B1); PG8_BAR;
            PG8_LDA(At, 0, 1); PG8_STAGE(PG8_SA(0, 0), a2, voffA);
            PG8_BAR; PG8_WAIT_L(0); PG8_MMA(1, 0, At, B0); PG8_BAR; PG8_SCHED;
            PG8_STAGE(PG8_SB(0, 1), b2 + hstep, voffB);
            PG8_WAIT_V(6); PG8_BAR; PG8_MMA(1, 1, At, B1); PG8_BAR;
            PG8_LDB(B0, 1, 0); PG8_SCHED; PG8_LDA(At, 1, 0); PG8_STAGE(PG8_SA(0, 1), a2 + hstep, voffA);
            PG8_WAIT_L(8); PG8_BAR; PG8_WAIT_L(0); PG8_MMA(0, 0, At, B0); PG8_BAR; PG8_SCHED;
            PG8_LDB(B1, 1, 1); PG8_STAGE(PG8_SB(1, 0), b3, voffB);
            PG8_BAR; PG8_WAIT_L(0); PG8_MMA(0, 1, At, B1); PG8_BAR;
            PG8_LDA(At, 1, 1); PG8_STAGE(PG8_SA(1, 0), a3, voffA);
            PG8_BAR; PG8_WAIT_L(0); PG8_MMA(1, 0, At, B0); PG8_BAR; PG8_SCHED;
            PG8_STAGE(PG8_SB(1, 1), b3 + hstep, voffB);
            PG8_WAIT_V(6); PG8_BAR; PG8_MMA(1, 1, At, B1); PG8_BAR;
            }
        }
        if constexpr (ALIGN_EPI) { if (wr == 0) PG8_BAR; }
        if constexpr (!Epi::AFTER_DRAIN) { E(acc, cur, wr, wc, fr, fq); S.done(cur); }
        if (!has_next) break;
#pragma unroll
        for (int a = 0; a < 2; ++a)
#pragma unroll
            for (int b = 0; b < 2; ++b)
#pragma unroll
                for (int m = 0; m < 4; ++m)
#pragma unroll
                    for (int n = 0; n < 2; ++n) acc[a][b][m][n] = (f32x4){0.f, 0.f, 0.f, 0.f};
        cur = nxt; cA = nA; cB = nB; ++ui;
        if constexpr (ALIGN_EPI) { if (wr == 1) PG8_BAR; }
    }
    PG8_WAIT_V(0);
    if constexpr (!ALIGN_EPI) { if (wr == 0) PG8_BAR; }
    PG8_BAR;
    if constexpr (Epi::AFTER_DRAIN) { E.fused(acc, cur, wr, wc, fr, fq, lds, wid, lane); S.done(cur); }
#undef PG8_SA
#undef PG8_SB
#undef PG8_STAGE
#undef PG8_LDA
#undef PG8_LDB
#undef PG8_MMA
#undef PG8_WAIT_V
#undef PG8_WAIT_L
#undef PG8_BAR
#undef PG8_SCHED
}
}

constexpr int NWAVES = 8, NTHR = NWAVES * 64;
#ifndef MK_N_LAUNCHES
#define MK_N_LAUNCHES 1
#endif
constexpr int N_PHASES = 7;
constexpr int N_LAUNCHES = MK_N_LAUNCHES;
static_assert(N_LAUNCHES == 1 || N_LAUNCHES == N_PHASES, "MK_N_LAUNCHES is 1 or 7");

constexpr int BATCH = 8, SEQ = 2048, T = BATCH * SEQ, D = 2048;
constexpr int NIN = 5408, NINP = 5632;
constexpr int PC_GATE = 1024, PC_R = 2048, PC_K = 3072, PC_V = 4096, PC_WD = 5120, PC_AD = 5184, PC_GD = 5248;
constexpr int RWKV_C0 = 2048;
constexpr int NEXP = 16384, NSEL = 128;
constexpr float NORM_EPS = 1e-6f, GN_EPS = 64e-5f;

constexpr size_t MiB = 1u << 20;
constexpr size_t WS_CTL = 0, CTL_ZERO_BYTES = 1 * MiB;
constexpr size_t WS_SSQ2 = 512 * 1024;
constexpr size_t WS_RSTD1 = 1 * MiB;
constexpr size_t WS_WIN = 2 * MiB;
constexpr size_t WS_WOUT = 24 * MiB;
constexpr size_t WS_WQ = 32 * MiB;
constexpr size_t WS_KEYS = 40 * MiB;
constexpr size_t WS_W2T = WS_KEYS + 512 * 1024;
constexpr size_t WS_A2T = WS_W2T + 128 * 1024;
constexpr size_t WS_G2T = WS_A2T + 128 * 1024;
constexpr size_t WS_WAT = WS_G2T + 320 * 1024;
constexpr size_t WS_WIT = WS_WAT + 256 * 1024;
constexpr size_t WS_EXP = 42 * MiB;
constexpr size_t WS_GATE = 50 * MiB;
constexpr size_t WS_XB = 64 * MiB;
constexpr size_t WS_PROJ = 128 * MiB;
constexpr size_t WS_Q = WS_PROJ;
constexpr size_t WS_Y = 304 * MiB;
constexpr size_t WS_UT = 368 * MiB;
constexpr size_t WS_VT = 432 * MiB;
constexpr size_t WS_END = 496 * MiB;
static_assert(WS_WIT + 256 * 1024 <= WS_EXP && WS_PROJ + (size_t)T * NINP * 2 <= WS_Y && WS_WIN + (size_t)NINP * D * 2 <= WS_WOUT, "d_ws map");
constexpr int CW_BAR = 4096;

constexpr int RING_BYTES = 131072;
constexpr int LDSCTL_OFF = RING_BYTES, MISC_OFF = LDSCTL_OFF + 320;
constexpr int LDS_BYTES = 147456;

#define GAS __attribute__((address_space(1)))
#define LAS __attribute__((address_space(3)))
typedef unsigned short bf16;
typedef unsigned v4u __attribute__((ext_vector_type(4)));
typedef unsigned v2u __attribute__((ext_vector_type(2)));
typedef float f32x4 __attribute__((ext_vector_type(4)));
typedef float f32x16 __attribute__((ext_vector_type(16)));
typedef short bf16x8 __attribute__((ext_vector_type(8)));
typedef __bf16 bf16x2_t __attribute__((ext_vector_type(2)));
typedef GAS unsigned gu32;
#define RLX_AGENT __ATOMIC_RELAXED, __HIP_MEMORY_SCOPE_AGENT
__device__ __forceinline__ unsigned f2bf(float f) { unsigned u = __builtin_bit_cast(unsigned, f); return (u + 0x7fffu + ((u >> 16) & 1u)) >> 16; }
__device__ __forceinline__ unsigned pk2(float lo, float hi) { return f2bf(lo) | (f2bf(hi) << 16); }
__device__ __forceinline__ float bf_lo(unsigned w) { return __uint_as_float(w << 16); }
__device__ __forceinline__ float bf_hi(unsigned w) { return __uint_as_float(w & 0xffff0000u); }
__device__ __forceinline__ void unpack8(const v4u& w, float (&o)[8]) { o[0] = bf_lo(w.x); o[1] = bf_hi(w.x); o[2] = bf_lo(w.y); o[3] = bf_hi(w.y); o[4] = bf_lo(w.z); o[5] = bf_hi(w.z); o[6] = bf_lo(w.w); o[7] = bf_hi(w.w); }
__device__ __forceinline__ v4u pack8(const float (&o)[8]) { v4u w; w.x = pk2(o[0], o[1]); w.y = pk2(o[2], o[3]); w.z = pk2(o[4], o[5]); w.w = pk2(o[6], o[7]); return w; }
__device__ __forceinline__ float sigmoidf_(float x) { return 1.0f / (1.0f + __expf(-x)); }
__device__ __forceinline__ float softplusf_(float z) { return fmaxf(z, 0.f) + log1pf(__expf(-fabsf(z))); }
__device__ __forceinline__ float gelu_tanh(float x) { const float u = 0.7978845608028654f * (x + 0.044715f * x * x * x); return 0.5f * x * (1.0f + tanhf(u)); }
template <int CTRL> __device__ __forceinline__ float dppf(float x) { return __builtin_bit_cast(float, __builtin_amdgcn_mov_dpp(__builtin_bit_cast(int, x), CTRL, 0xf, 0xf, true)); }
__device__ __forceinline__ float red8(float v) { v += dppf<0xB1>(v); v += dppf<0x4E>(v); v += dppf<0x141>(v); return v; }
__device__ __forceinline__ float red16(float v) { v = red8(v); v += dppf<0x140>(v); return v; }
__device__ __forceinline__ float wave_sum(float v) {
#pragma unroll
    for (int o = 1; o < 64; o <<= 1) v += __shfl_xor(v, o);
    return v;
}
__device__ __forceinline__ float dot2bf(unsigned a, unsigned b, float acc) { return __builtin_amdgcn_fdot2_f32_bf16(__builtin_bit_cast(bf16x2_t, a), __builtin_bit_cast(bf16x2_t, b), acc, false); }
#define MFMA16(a, b, c) __builtin_amdgcn_mfma_f32_16x16x32_bf16((a), (b), (c), 0, 0, 0)
#define MFMA32(a, b, c) __builtin_amdgcn_mfma_f32_32x32x16_bf16((a), (b), (c), 0, 0, 0)

#define XB_TMO      128
#define XB_XCNT(j)  (256  + 64 * (j))
#define XB_XSUB(j)  (1280 + 64 * (j))
#define XB_XGEN(j)  (2304 + 64 * (j))
#define XB_TOP      3328
#define XB_TOPGEN   3392
#define XCD_BAR_WORDS 3456
#define XB_SPIN_CAP (1u << 22)
__device__ __forceinline__ unsigned xb_ld(unsigned* p)              { return __hip_atomic_load(p, __ATOMIC_RELAXED, __HIP_MEMORY_SCOPE_AGENT); }
__device__ __forceinline__ unsigned xb_add(unsigned* p, unsigned v) { return __hip_atomic_fetch_add(p, v, __ATOMIC_RELAXED, __HIP_MEMORY_SCOPE_AGENT); }
__device__ __forceinline__ unsigned xb_xcc_id() { return (unsigned)__builtin_amdgcn_s_getreg((3 << 11) | 20) & 0xFu; }
#define XB_SPIN(cond, bar) do { unsigned _sp = 0; while (cond) { __builtin_amdgcn_s_sleep(1); \
    if ((++_sp & 255u) == 0u) { if (xb_ld(&(bar)[XB_TMO])) break; if (_sp > XB_SPIN_CAP) { atomicAdd(&(bar)[XB_TMO], 1u); break; } } } } while (0)
struct XcdBarrier { unsigned* bar; unsigned x; volatile LAS unsigned* st; };
__device__ __forceinline__ XcdBarrier xcd_barrier_post(unsigned* bar, volatile LAS unsigned* st) {
    XcdBarrier b; b.bar = bar; b.x = xb_xcc_id(); b.st = st;
    if (threadIdx.x == 0) (void)xb_add(&bar[XB_XCNT(b.x)], 1u);
    return b;
}
__device__ __forceinline__ void xcd_barrier_complete(unsigned* bar, unsigned x, unsigned& nloc, unsigned& nx) {
    const unsigned G = gridDim.x * gridDim.y * gridDim.z;
    unsigned sum, cnt, mine, sp = 0u;
    for (;;) {
        sum = 0u; cnt = 0u; mine = 0u;
#pragma unroll
        for (unsigned j = 0; j < 16; ++j) { const unsigned c = xb_ld(&bar[XB_XCNT(j)]); sum += c; cnt += (c > 0u) ? 1u : 0u; mine = (j == x) ? c : mine; }
        if (sum == G) break;
        __builtin_amdgcn_s_sleep(1);
        if ((++sp & 255u) == 0u) { if (xb_ld(&bar[XB_TMO])) break; if (sp > XB_SPIN_CAP) { atomicAdd(&bar[XB_TMO], 1u); break; } }
    }
    nloc = mine > 0u ? mine : 1u; nx = cnt > 0u ? cnt : 1u;
}
__device__ __forceinline__ void xcd_barrier(const XcdBarrier& b) {
    asm volatile("s_waitcnt vmcnt(0)" ::: "memory");
    __syncthreads();
    if (threadIdx.x == 0) {
        unsigned* bar = b.bar;
        __builtin_amdgcn_s_waitcnt(0);
        unsigned nloc = b.st[0], nx = b.st[1];
        if (nloc == 0u) { xcd_barrier_complete(bar, b.x, nloc, nx); b.st[0] = nloc; b.st[1] = nx; }
        const unsigned old = xb_add(&bar[XB_XSUB(b.x)], 1u);
        const unsigned gen = old / nloc;
        if (old + 1u == (gen + 1u) * nloc) {
            __builtin_amdgcn_fence(__ATOMIC_RELEASE, "agent");
            asm volatile("s_waitcnt vmcnt(0)" ::: "memory");
            const unsigned og = xb_add(&bar[XB_TOP], 1u);
            const unsigned tg = og / nx;
            if (og + 1u == (tg + 1u) * nx) xb_add(&bar[XB_TOPGEN], 1u);
            else XB_SPIN(xb_ld(&bar[XB_TOPGEN]) == tg, bar);
            __builtin_amdgcn_fence(__ATOMIC_ACQUIRE, "agent");
            xb_add(&bar[XB_XGEN(b.x)], 1u);
            asm volatile("s_waitcnt vmcnt(0)" ::: "memory");
        } else {
            XB_SPIN(xb_ld(&bar[XB_XGEN(b.x)]) == gen, bar);
            __builtin_amdgcn_fence(__ATOMIC_ACQUIRE, "agent");
            asm volatile("s_waitcnt vmcnt(0)" ::: "memory");
        }
    }
    __syncthreads();
}

struct Frame {
    LAS unsigned char* lds;
    int tid, lane, wave, G, bid;
    const float* in[28];
    float* out;
    unsigned char* ws;
};
#define WSP(type, off) ((type*)(F.ws + (off)))
enum { I_X = 0, I_G1, I_WIN, I_CONVW, I_CONVB, I_WA, I_BA, I_WI, I_BI, I_LAM, I_MU, I_W0, I_W2, I_A0, I_A2, I_G2, I_KK, I_KA, I_RK, I_LNW, I_LNB, I_WOUT, I_G2N, I_WQ, I_KEYS, I_U, I_V, I_GF };

__device__ __forceinline__ void p0_transpose_item(const float* W, int K, int N, bf16* WT, const float* ksc, LAS float* scr, int item, int lane) {
    const int nblk = N / 32, kb = item / nblk, nb = item % nblk, k0 = 64 * kb, n0 = 32 * nb;
#pragma unroll 8
    for (int i = 0; i < 32; ++i) { const int kk = 2 * i + (lane >> 5); float v = W[(size_t)(k0 + kk) * N + n0 + (lane & 31)]; if (ksc) v *= ksc[k0 + kk]; scr[kk * 33 + (lane & 31)] = v; }
    asm volatile("s_waitcnt lgkmcnt(0)" ::: "memory");
    const int c = lane & 7;
#pragma unroll
    for (int j = 0; j < 4; ++j) { const int n = (lane >> 3) + 8 * j; const LAS float* s = scr + (8 * c) * 33 + n;
        v4u o; o.x = pk2(s[0 * 33], s[1 * 33]); o.y = pk2(s[2 * 33], s[3 * 33]); o.z = pk2(s[4 * 33], s[5 * 33]); o.w = pk2(s[6 * 33], s[7 * 33]);
        *(v4u*)(WT + (size_t)(n0 + n) * K + k0 + 8 * c) = o; }
    asm volatile("s_waitcnt lgkmcnt(0)" ::: "memory");
}
__device__ __forceinline__ void p0_small_transpose(const float* src, bf16* dst, int nb, int K, int N, int gt, int NGT) {
    const int tot = nb * K * N;
    for (int i = gt; i < tot; i += NGT) { const int bb = i / (K * N), r = i - bb * K * N, n = r / K, k = r - n * K; dst[i] = (bf16)f2bf(src[(size_t)bb * K * N + (size_t)k * N + n]); }
}
__device__ __forceinline__ void p0_prologue(const Frame& F) {
    LAS float* scr = (LAS float*)(F.lds + F.wave * 8448);
    const int gw = F.bid * NWAVES + F.wave, NGW = F.G * NWAVES, gt = gw * 64 + F.lane, NGT = NGW * 64;
    constexpr int I1 = (D / 64) * (NIN / 32), I2 = (D / 64) * (D / 32), NITEMS = I1 + 2 * I2;
    for (int it = gw; it < NITEMS; it += NGW) {
        int r = it;
        if (r < I1) { p0_transpose_item(F.in[I_WIN], D, NIN, WSP(bf16, WS_WIN), F.in[I_G1], scr, r, F.lane); continue; } r -= I1;
        if (r < I2) { p0_transpose_item(F.in[I_WOUT], D, D, WSP(bf16, WS_WOUT), nullptr, scr, r, F.lane); continue; } r -= I2;
        p0_transpose_item(F.in[I_WQ], D, D, WSP(bf16, WS_WQ), F.in[I_G2N], scr, r, F.lane);
    }
    { v4u* z = (v4u*)(WSP(bf16, WS_WIN) + (size_t)NIN * D); const int nz = (NINP - NIN) * D * 2 / 16; for (int i = gt; i < nz; i += NGT) z[i] = (v4u){0u, 0u, 0u, 0u}; }
    p0_small_transpose(F.in[I_W2], WSP(bf16, WS_W2T), 1, 64, 1024, gt, NGT);
    p0_small_transpose(F.in[I_A2], WSP(bf16, WS_A2T), 1, 64, 1024, gt, NGT);
    p0_small_transpose(F.in[I_G2], WSP(bf16, WS_G2T), 1, 160, 1024, gt, NGT);
    p0_small_transpose(F.in[I_WA], WSP(bf16, WS_WAT), 8, 128, 128, gt, NGT);
    p0_small_transpose(F.in[I_WI], WSP(bf16, WS_WIT), 8, 128, 128, gt, NGT);
    { const float* s = F.in[I_KEYS]; bf16* d = WSP(bf16, WS_KEYS); for (int i = gt; i < 8 * 2 * 128 * 128 / 8; i += NGT) { const f32x4 a = *(const f32x4*)(s + (size_t)i * 8), b = *(const f32x4*)(s + (size_t)i * 8 + 4);
        v4u o; o.x = pk2(a[0], a[1]); o.y = pk2(a[2], a[3]); o.z = pk2(b[0], b[1]); o.w = pk2(b[2], b[3]); *(v4u*)(d + (size_t)i * 8) = o; } }
    { const float* su = F.in[I_U]; const float* sv = F.in[I_V]; const float* g2 = F.in[I_G2N]; bf16* du = WSP(bf16, WS_UT); bf16* dv = WSP(bf16, WS_VT);
      constexpr int NCH = NEXP * D / 8;
      for (int i = gt; i < NCH; i += NGT) { const int c8 = (i & 255) * 8; const f32x4 ga = *(const f32x4*)(g2 + c8), gb = *(const f32x4*)(g2 + c8 + 4);
          const f32x4 a = *(const f32x4*)(su + (size_t)i * 8) * ga, b = *(const f32x4*)(su + (size_t)i * 8 + 4) * gb;
          v4u o; o.x = pk2(a[0], a[1]); o.y = pk2(a[2], a[3]); o.z = pk2(b[0], b[1]); o.w = pk2(b[2], b[3]); *(v4u*)(du + (size_t)i * 8) = o;
          const f32x4 c = *(const f32x4*)(sv + (size_t)i * 8), d = *(const f32x4*)(sv + (size_t)i * 8 + 4);
          v4u p; p.x = pk2(c[0], c[1]); p.y = pk2(c[2], c[3]); p.z = pk2(d[0], d[1]); p.w = pk2(d[2], d[3]); *(v4u*)(dv + (size_t)i * 8) = p; } }
    { const float* x = F.in[I_X]; bf16* xb = WSP(bf16, WS_XB); float* rstd = WSP(float, WS_RSTD1);
      for (int m = gw; m < T; m += NGW) { const f32x4* xr = (const f32x4*)(x + (size_t)m * D) + F.lane; f32x4 v[8]; float s = 0.f;
#pragma unroll
          for (int j = 0; j < 8; ++j) { v[j] = xr[64 * j]; s += (v[j][0] * v[j][0] + v[j][1] * v[j][1]) + (v[j][2] * v[j][2] + v[j][3] * v[j][3]); }
          s = wave_sum(s);
          if (F.lane == 0) rstd[m] = 1.0f / sqrtf(s * (1.0f / D) + NORM_EPS);
          v2u* o = (v2u*)(xb + (size_t)m * D) + F.lane;
#pragma unroll
          for (int j = 0; j < 8; ++j) { v2u w; w.x = pk2(v[j][0], v[j][1]); w.y = pk2(v[j][2], v[j][3]); o[64 * j] = w; } } }
}

__device__ __forceinline__ void rwkv_item(const Frame& F, int item) {
    const int b = item >> 4, h = item & 15, tid = F.tid, lane = F.lane, wave = F.wave;
    LAS unsigned char* L = F.lds;
    LAS float* SC = (LAS float*)(L + 0);
    LAS float* VS = (LAS float*)(L + 40960);
    LAS float* RS = (LAS float*)(L + 49152);
    LAS float* KS = (LAS float*)(L + 57344);
    LAS float* WP = (LAS float*)(L + 65536);
    LAS float* AP = (LAS float*)(L + 73728);
    LAS float* GG = (LAS float*)(L + 81920);
    LAS float* BON = (LAS float*)(L + 90112);
    LAS float* YB = (LAS float*)(L + 90240);
    LAS bf16* LAW = (LAS bf16*)(L + 98432);
    LAS bf16* LAA = (LAS bf16*)(L + 103040);
    LAS bf16* LAG = (LAS bf16*)(L + 107648);
    const bf16* PROJ = WSP(bf16, WS_PROJ); bf16* Y = WSP(bf16, WS_Y);
    const float* mu = F.in[I_MU];
    const int mt = wave >> 2, nt = wave & 3, fr = lane & 15, fq = lane >> 4;
    bf16x8 bw[2], ba[2], bg[5];
    { const int n = h * 64 + nt * 16 + fr; const bf16* w2t = WSP(bf16, WS_W2T); const bf16* a2t = WSP(bf16, WS_A2T); const bf16* g2t = WSP(bf16, WS_G2T);
#pragma unroll
      for (int ks = 0; ks < 2; ++ks) { bw[ks] = *(const bf16x8*)(w2t + n * 64 + ks * 32 + 8 * fq); ba[ks] = *(const bf16x8*)(a2t + n * 64 + ks * 32 + 8 * fq); }
#pragma unroll
      for (int ks = 0; ks < 5; ++ks) bg[ks] = *(const bf16x8*)(g2t + n * 160 + ks * 32 + 8 * fq); }
    const int tt = tid >> 4, j0 = (tid & 15) * 4, hc = h * 64 + j0;
    const f32x4 pw0 = *(const f32x4*)(F.in[I_W0] + hc), pa0 = *(const f32x4*)(F.in[I_A0] + hc), pkk = *(const f32x4*)(F.in[I_KK] + hc), pka = *(const f32x4*)(F.in[I_KA] + hc),
                prk = *(const f32x4*)(F.in[I_RK] + hc), plw = *(const f32x4*)(F.in[I_LNW] + hc), plb = *(const f32x4*)(F.in[I_LNB] + hc);
    const int irow = wave * 8 + (lane >> 3), js = lane & 7;
    float s[8];
#pragma unroll
    for (int e = 0; e < 8; ++e) s[e] = 0.f;
    for (int tl = 0; tl < SEQ / 32; ++tl) {
        const int t0 = tl * 32; const size_t tokbase = (size_t)b * SEQ + t0;
        for (int ch = tid; ch < 32 * 60; ch += NTHR) {
            const int t = ch / 60, cc = ch - t * 60;
            const int pcol = cc < 24 ? (PC_R + (cc >> 3) * 1024 + h * 64 + (cc & 7) * 8) : (PC_WD + (cc - 24) * 8);
            const bf16* pr = PROJ + (tokbase + t) * NINP + pcol;
            const v4u cur = *(const v4u*)pr; v4u prv = (v4u){0u, 0u, 0u, 0u}; if (t0 + t > 0) prv = *(const v4u*)(pr - NINP);
            const f32x4 m0 = *(const f32x4*)(mu + pcol - RWKV_C0), m1 = *(const f32x4*)(mu + pcol - RWKV_C0 + 4);
            float c[8], p[8], ps[8]; unpack8(cur, c); unpack8(prv, p);
#pragma unroll
            for (int e = 0; e < 8; ++e) ps[e] = c[e] + (p[e] - c[e]) * (e < 4 ? m0[e] : m1[e - 4]);
            if (cc < 24) { LAS float* dst = (cc < 8 ? RS : (cc < 16 ? KS : VS)) + t * 64 + (cc & 7) * 8;
                *(LAS f32x4*)dst = (f32x4){ps[0], ps[1], ps[2], ps[3]}; *(LAS f32x4*)(dst + 4) = (f32x4){ps[4], ps[5], ps[6], ps[7]}; }
            else { const int m = (cc - 24) * 8; float o[8];
                if (m < 64) {
#pragma unroll
                    for (int e = 0; e < 8; ++e) o[e] = tanhf(ps[e]);
                    *(LAS v4u*)(LAW + t * 72 + m) = pack8(o); }
                else if (m < 128) { *(LAS v4u*)(LAA + t * 72 + (m - 64)) = pack8(ps); }
                else {
#pragma unroll
                    for (int e = 0; e < 8; ++e) o[e] = sigmoidf_(ps[e]);
                    *(LAS v4u*)(LAG + t * 168 + (m - 128)) = pack8(o); } }
        }
        __syncthreads();
        { f32x4 cw = (f32x4){0.f, 0.f, 0.f, 0.f}, ca = cw, cg = cw;
#pragma unroll
          for (int ks = 0; ks < 2; ++ks) { const bf16x8 aw = *(const LAS bf16x8*)(LAW + (mt * 16 + fr) * 72 + ks * 32 + 8 * fq); cw = MFMA16(aw, bw[ks], cw);
                                           const bf16x8 aa = *(const LAS bf16x8*)(LAA + (mt * 16 + fr) * 72 + ks * 32 + 8 * fq); ca = MFMA16(aa, ba[ks], ca); }
#pragma unroll
          for (int ks = 0; ks < 5; ++ks) { const bf16x8 ag = *(const LAS bf16x8*)(LAG + (mt * 16 + fr) * 168 + ks * 32 + 8 * fq); cg = MFMA16(ag, bg[ks], cg); }
#pragma unroll
          for (int r = 0; r < 4; ++r) { const int o = (mt * 16 + fq * 4 + r) * 64 + nt * 16 + fr; WP[o] = cw[r]; AP[o] = ca[r]; GG[o] = cg[r]; } }
        __syncthreads();
        { const f32x4 r4 = *(const LAS f32x4*)(RS + tt * 64 + j0), k4 = *(const LAS f32x4*)(KS + tt * 64 + j0), wp = *(const LAS f32x4*)(WP + tt * 64 + j0), ap = *(const LAS f32x4*)(AP + tt * 64 + j0);
          f32x4 dec, av, kk, km, bb; float ss = 0.f, bon = 0.f;
#pragma unroll
          for (int e = 0; e < 4; ++e) { const float wl = -softplusf_(-(pw0[e] + wp[e])) - 0.5f; dec[e] = __expf(-__expf(wl)); av[e] = sigmoidf_(pa0[e] + ap[e]); kk[e] = k4[e] * pkk[e]; ss += kk[e] * kk[e]; }
          ss = red16(ss); const float inv = 1.0f / fmaxf(sqrtf(ss), 1e-12f);
#pragma unroll
          for (int e = 0; e < 4; ++e) { kk[e] *= inv; km[e] = k4[e] * (1.0f + (av[e] - 1.0f) * pka[e]); bb[e] = kk[e] * av[e]; bon += r4[e] * km[e] * prk[e]; }
          bon = red16(bon);
          LAS float* sc = SC + tt * 320 + j0;
          *(LAS f32x4*)(sc) = dec; *(LAS f32x4*)(sc + 64) = km; *(LAS f32x4*)(sc + 128) = bb; *(LAS f32x4*)(sc + 192) = -kk; *(LAS f32x4*)(sc + 256) = r4;
          if ((tid & 15) == 0) BON[tt] = bon; }
        __syncthreads();
#pragma unroll 2
        for (int t = 0; t < 32; ++t) {
            const LAS float* sc = SC + t * 320 + js * 8;
            const f32x4 w0 = *(const LAS f32x4*)(sc), w1 = *(const LAS f32x4*)(sc + 4), k0 = *(const LAS f32x4*)(sc + 64), k1 = *(const LAS f32x4*)(sc + 68),
                        b0 = *(const LAS f32x4*)(sc + 128), b1 = *(const LAS f32x4*)(sc + 132), n0 = *(const LAS f32x4*)(sc + 192), n1 = *(const LAS f32x4*)(sc + 196),
                        r0 = *(const LAS f32x4*)(sc + 256), r1 = *(const LAS f32x4*)(sc + 260);
            const float vv = VS[t * 64 + irow];
            float sa = (s[0] * n0[0] + s[1] * n0[1]) + (s[2] * n0[2] + s[3] * n0[3]) + (s[4] * n1[0] + s[5] * n1[1]) + (s[6] * n1[2] + s[7] * n1[3]);
            sa = red8(sa);
#pragma unroll
            for (int e = 0; e < 4; ++e) { s[e] = s[e] * w0[e] + (sa * b0[e] + vv * k0[e]); s[e + 4] = s[e + 4] * w1[e] + (sa * b1[e] + vv * k1[e]); }
            float y = (s[0] * r0[0] + s[1] * r0[1]) + (s[2] * r0[2] + s[3] * r0[3]) + (s[4] * r1[0] + s[5] * r1[1]) + (s[6] * r1[2] + s[7] * r1[3]);
            y = red8(y);
            if (js == 0) YB[t * 64 + irow] = y;
        }
        __syncthreads();
        { const f32x4 y4 = *(const LAS f32x4*)(YB + tt * 64 + j0), v4 = *(const LAS f32x4*)(VS + tt * 64 + j0), g4 = *(const LAS f32x4*)(GG + tt * 64 + j0);
          float sm = (y4[0] + y4[1]) + (y4[2] + y4[3]); sm = red16(sm); const float mean = sm * (1.0f / 64.0f);
          const f32x4 d4 = y4 - mean; float sv = (d4[0] * d4[0] + d4[1] * d4[1]) + (d4[2] * d4[2] + d4[3] * d4[3]); sv = red16(sv);
          const float rstd = 1.0f / sqrtf(sv * (1.0f / 64.0f) + GN_EPS), bon = BON[tt];
          f32x4 o;
#pragma unroll
          for (int e = 0; e < 4; ++e) o[e] = (d4[e] * rstd * plw[e] + plb[e] + bon * v4[e]) * g4[e];
          v2u w; w.x = pk2(o[0], o[1]); w.y = pk2(o[2], o[3]);
          *(v2u*)(Y + (tokbase + tt) * D + 1024 + hc) = w; }
        __syncthreads();
    }
}
__device__ __forceinline__ void lru_item(const Frame& F, int item) {
    const int b = item >> 5, h = (item >> 2) & 7, cs = item & 3, tid = F.tid, lane = F.lane, wave = F.wave;
    LAS unsigned char* L = F.lds;
    LAS bf16* XA = (LAS bf16*)(L + 0);
    LAS float* XC = (LAS float*)(L + 17408);
    LAS float* RI = (LAS float*)(L + 25600);
    LAS float* SEG = (LAS float*)(L + 41984);
    LAS float* CARRY = (LAS float*)(L + 46080);
    const bf16* PROJ = WSP(bf16, WS_PROJ); bf16* Y = WSP(bf16, WS_Y);
    const float* convw = F.in[I_CONVW]; const float* convb = F.in[I_CONVB];
    const int gsel = wave & 1, nt = (wave >> 1) & 1, mp = wave >> 2, fr = lane & 15, fq = lane >> 4;
    bf16x8 bfr[4];
    { const bf16* WTp = (gsel ? WSP(bf16, WS_WIT) : WSP(bf16, WS_WAT)) + (size_t)h * 128 * 128; const int n = cs * 32 + nt * 16 + fr;
#pragma unroll
      for (int ks = 0; ks < 4; ++ks) bfr[ks] = *(const bf16x8*)(WTp + n * 128 + ks * 32 + 8 * fq); }
    const int c = tid & 31, seg = tid >> 5, chg = h * 128 + cs * 32 + c;
    const float ba_c = F.in[I_BA][chg], bi_c = F.in[I_BI][chg], sp8 = 8.0f * softplusf_(-F.in[I_LAM][chg]);
    if (tid < 32) CARRY[tid] = 0.f;
    __syncthreads();
    for (int tl = 0; tl < SEQ / 64; ++tl) {
        const int t0 = tl * 64; const size_t tokbase = (size_t)b * SEQ + t0;
#pragma unroll
        for (int u = 0; u < 2; ++u) { const int chn = tid + NTHR * u, t = chn >> 4, c8 = (chn & 15) * 8, gch = h * 128 + c8;
            float acc[8]; { const f32x4 b0 = *(const f32x4*)(convb + gch), b1 = *(const f32x4*)(convb + gch + 4);
#pragma unroll
                for (int e = 0; e < 4; ++e) { acc[e] = b0[e]; acc[e + 4] = b1[e]; } }
#pragma unroll
            for (int w = 0; w < 4; ++w) { const int ts = t0 + t - 3 + w; if (ts >= 0) { const v4u xv = *(const v4u*)(PROJ + ((size_t)b * SEQ + ts) * NINP + gch); float xf[8]; unpack8(xv, xf);
                    const f32x4 w0 = *(const f32x4*)(convw + w * 1024 + gch), w1 = *(const f32x4*)(convw + w * 1024 + gch + 4);
#pragma unroll
                    for (int e = 0; e < 4; ++e) { acc[e] += w0[e] * xf[e]; acc[e + 4] += w1[e] * xf[e + 4]; } } }
            *(LAS v4u*)(XA + t * 136 + c8) = pack8(acc);
            if ((c8 >> 5) == cs) { LAS float* d = XC + t * 32 + (c8 & 31); *(LAS f32x4*)d = (f32x4){acc[0], acc[1], acc[2], acc[3]}; *(LAS f32x4*)(d + 4) = (f32x4){acc[4], acc[5], acc[6], acc[7]}; } }
        __syncthreads();
#pragma unroll
        for (int ml = 0; ml < 2; ++ml) { const int mt = mp * 2 + ml; f32x4 a4 = (f32x4){0.f, 0.f, 0.f, 0.f};
#pragma unroll
            for (int ks = 0; ks < 4; ++ks) { const bf16x8 af = *(const LAS bf16x8*)(XA + (mt * 16 + fr) * 136 + ks * 32 + 8 * fq); a4 = MFMA16(af, bfr[ks], a4); }
#pragma unroll
            for (int r = 0; r < 4; ++r) RI[gsel * 2048 + (mt * 16 + fq * 4 + r) * 32 + nt * 16 + fr] = a4[r]; }
        __syncthreads();
        float av[4], bx[4]; float A = 1.f, B = 0.f;
#pragma unroll
        for (int e = 0; e < 4; ++e) { const int t = seg * 4 + e; const float r = sigmoidf_(RI[t * 32 + c] + ba_c), ig = sigmoidf_(RI[2048 + t * 32 + c] + bi_c), xc = XC[t * 32 + c];
            const float la = -sp8 * r; av[e] = __expf(la); bx[e] = sqrtf(fmaxf(-expm1f(2.0f * la), 0.f)) * (ig * xc); A *= av[e]; B = av[e] * B + bx[e]; }
        SEG[(seg * 32 + c) * 2] = A; SEG[(seg * 32 + c) * 2 + 1] = B;
        __syncthreads();
        float hst = CARRY[c];
        for (int s2 = 0; s2 < seg; ++s2) hst = SEG[(s2 * 32 + c) * 2] * hst + SEG[(s2 * 32 + c) * 2 + 1];
#pragma unroll
        for (int e = 0; e < 4; ++e) { hst = av[e] * hst + bx[e]; const size_t tok = tokbase + seg * 4 + e;
            const float g = __uint_as_float((unsigned)PROJ[tok * NINP + PC_GATE + chg] << 16);
            Y[tok * D + chg] = (bf16)f2bf(hst * gelu_tanh(g)); }
        __syncthreads();
        if (seg == 15) CARRY[c] = hst;
    }
    __syncthreads();
}

__device__ __forceinline__ unsigned f2ord(float f) { const unsigned u = __builtin_bit_cast(unsigned, f); return (u & 0x80000000u) ? ~u : (u | 0x80000000u); }
__device__ __forceinline__ float ord2f(unsigned o) { const unsigned u = (o & 0x80000000u) ? (o & 0x7fffffffu) : ~o; return __builtin_bit_cast(float, u); }
#define CMPX(hi_, lo_) do { const unsigned _a = (hi_), _b = (lo_); (hi_) = _a > _b ? _a : _b; (lo_) = _a > _b ? _b : _a; } while (0)
__device__ __forceinline__ void ins16(unsigned (&Lk)[16], unsigned x) {
#pragma unroll
    for (int i = 0; i < 16; ++i) { const unsigned a = Lk[i]; Lk[i] = a > x ? a : x; x = a > x ? x : a; }
}
__device__ __forceinline__ void merge_partner(unsigned (&Lk)[16]) {
    unsigned P[16];
#pragma unroll
    for (int i = 0; i < 16; ++i) P[i] = (unsigned)__shfl_xor((int)Lk[i], 32);
#pragma unroll
    for (int i = 0; i < 16; ++i) { const unsigned q = P[15 - i]; Lk[i] = Lk[i] > q ? Lk[i] : q; }
#pragma unroll
    for (int d = 8; d >= 1; d >>= 1)
#pragma unroll
        for (int i = 0; i < 16; ++i) if ((i & d) == 0) CMPX(Lk[i], Lk[i + d]);
}
__device__ __forceinline__ void route_item(const Frame& F, int item, int lane) {
    const int tok0 = (item >> 3) * 32, h = item & 7, c = lane & 31, hi = lane >> 5;
    const bf16* Q = WSP(bf16, WS_Q); const bf16* KB = WSP(bf16, WS_KEYS);
    LAS unsigned* WL = (LAS unsigned*)(F.lds + F.wave * 8192);
    unsigned LST[2][16];
#pragma unroll
    for (int p = 0; p < 2; ++p) {
        bf16x8 qf[8];
#pragma unroll
        for (int ks = 0; ks < 8; ++ks) qf[ks] = *(const bf16x8*)(Q + (size_t)(tok0 + c) * D + h * 256 + p * 128 + ks * 16 + 8 * hi);
        unsigned Lk[16];
#pragma unroll
        for (int i = 0; i < 16; ++i) Lk[i] = 0u;
#pragma unroll 1
        for (int m = 0; m < 4; ++m) {
            f32x16 acc;
#pragma unroll
            for (int r = 0; r < 16; ++r) acc[r] = 0.f;
            const bf16* kp = KB + (size_t)((h * 2 + p) * 128 + m * 32 + c) * 128 + 8 * hi;
#pragma unroll
            for (int ks = 0; ks < 8; ++ks) { const bf16x8 kf = *(const bf16x8*)(kp + ks * 16); acc = MFMA32(kf, qf[ks], acc); }
#pragma unroll
            for (int r = 0; r < 16; ++r) { const unsigned idx = (unsigned)(m * 32 + (r & 3) + 8 * (r >> 2)) | ((unsigned)hi << 2); ins16(Lk, (f2ord(acc[r]) & ~0x7Fu) | idx); }
        }
        merge_partner(Lk);
#pragma unroll
        for (int i = 0; i < 16; ++i) { LST[p][i] = Lk[i]; WL[(p * 16 + i) * 64 + lane] = Lk[i] & 0x7Fu; }
    }
    float va[4], vb[16];
#pragma unroll
    for (int i = 0; i < 4; ++i) va[i] = ord2f((hi ? LST[1][i] : LST[0][i]) & ~0x7Fu);
#pragma unroll
    for (int j = 0; j < 16; ++j) vb[j] = ord2f((hi ? LST[0][j] : LST[1][j]) & ~0x7Fu);
    unsigned Ck[16];
#pragma unroll
    for (int i = 0; i < 16; ++i) Ck[i] = 0u;
#pragma unroll
    for (int i = 0; i < 4; ++i) { const unsigned key = (f2ord(va[i] + vb[i]) & ~0xFFu) | (unsigned)(i * 17); ins16(Ck, hi ? 0u : key); }
#pragma unroll
    for (int i = 0; i < 3; ++i)
#pragma unroll
        for (int j = i + 1; j < 16; ++j) if ((i + 1) * (j + 1) <= 16) { const unsigned code = hi ? (unsigned)(j * 16 + i) : (unsigned)(i * 16 + j); ins16(Ck, (f2ord(va[i] + vb[j]) & ~0xFFu) | code); }
    merge_partner(Ck);
    const float mx = ord2f(Ck[0] & ~0xFFu); float den = 0.f;
#pragma unroll
    for (int k = 0; k < 16; ++k) den += __expf(ord2f(Ck[k] & ~0xFFu) - mx);
    const float rden = 1.0f / den;
    int eo[8]; float go[8];
#pragma unroll
    for (int k = 0; k < 8; ++k) { const unsigned fm = hi ? Ck[k + 8] : Ck[k]; const unsigned code = fm & 0xFFu;
        const unsigned k0 = WL[(code >> 4) * 64 + lane], k1 = WL[(16 + (code & 15u)) * 64 + lane];
        eo[k] = (int)(k0 * 128u + k1); go[k] = __expf(ord2f(fm & ~0xFFu) - mx) * rden; }
    int* ep = WSP(int, WS_EXP) + (size_t)(tok0 + c) * NSEL + h * 16 + hi * 8; float* gp = WSP(float, WS_GATE) + (size_t)(tok0 + c) * NSEL + h * 16 + hi * 8;
    *(int4*)ep = make_int4(eo[0], eo[1], eo[2], eo[3]); *(int4*)(ep + 4) = make_int4(eo[4], eo[5], eo[6], eo[7]);
    *(f32x4*)gp = (f32x4){go[0], go[1], go[2], go[3]}; *(f32x4*)(gp + 4) = (f32x4){go[4], go[5], go[6], go[7]};
}

__device__ __forceinline__ void peer_token(const Frame& F, int tok, int lane) {
    const bf16* UT = WSP(bf16, WS_UT); const bf16* VT = WSP(bf16, WS_VT);
    const bf16* xr = WSP(bf16, WS_XB) + (size_t)tok * D + lane * 8;
    v4u xb[4];
#pragma unroll
    for (int j = 0; j < 4; ++j) xb[j] = *(const v4u*)(xr + j * 512);
    const int* ep = WSP(int, WS_EXP) + (size_t)tok * NSEL; const float* gp = WSP(float, WS_GATE) + (size_t)tok * NSEL;
    int ex[2]; float ga[2], cf[2];
    ex[0] = ep[lane]; ex[1] = ep[64 + lane]; ga[0] = gp[lane]; ga[1] = gp[64 + lane];
    const float rstd = 1.0f / sqrtf(WSP(float, WS_SSQ2)[tok] * (1.0f / D) + NORM_EPS);
#pragma unroll
    for (int hf = 0; hf < 2; ++hf) {
        float sc = 0.f;
        for (int e = 0; e < 64; e += 4) {
            v4u w[4][4];
#pragma unroll
            for (int q = 0; q < 4; ++q) { const int eid = __builtin_amdgcn_readlane(ex[hf], e + q); const bf16* ur = UT + (size_t)eid * D + lane * 8;
#pragma unroll
                for (int j = 0; j < 4; ++j) w[q][j] = *(const v4u*)(ur + j * 512); }
#pragma unroll
            for (int q = 0; q < 4; ++q) { float d0 = 0.f, d1 = 0.f, d2 = 0.f, d3 = 0.f;
#pragma unroll
                for (int j = 0; j < 4; ++j) { d0 = dot2bf(w[q][j].x, xb[j].x, d0); d1 = dot2bf(w[q][j].y, xb[j].y, d1); d2 = dot2bf(w[q][j].z, xb[j].z, d2); d3 = dot2bf(w[q][j].w, xb[j].w, d3); }
                const float d = wave_sum((d0 + d1) + (d2 + d3));
                sc = (lane == e + q) ? d : sc; }
        }
        cf[hf] = ga[hf] * gelu_tanh(sc * rstd);
    }
    float o[32];
#pragma unroll
    for (int i = 0; i < 32; ++i) o[i] = 0.f;
#pragma unroll
    for (int hf = 0; hf < 2; ++hf) {
        for (int e = 0; e < 64; e += 4) {
            v4u w[4][4]; float cq[4];
#pragma unroll
            for (int q = 0; q < 4; ++q) { const int eid = __builtin_amdgcn_readlane(ex[hf], e + q); cq[q] = __builtin_bit_cast(float, __builtin_amdgcn_readlane(__builtin_bit_cast(int, cf[hf]), e + q));
                const bf16* vr = VT + (size_t)eid * D + lane * 8;
#pragma unroll
                for (int j = 0; j < 4; ++j) w[q][j] = *(const v4u*)(vr + j * 512); }
#pragma unroll
            for (int q = 0; q < 4; ++q)
#pragma unroll
                for (int j = 0; j < 4; ++j) { float vf[8]; unpack8(w[q][j], vf);
#pragma unroll
                    for (int t = 0; t < 8; ++t) o[j * 8 + t] += cq[q] * vf[t]; }
        }
    }
    float* xo = F.out + (size_t)tok * D + lane * 8; const float* gf = F.in[I_GF] + lane * 8;
    float ss = 0.f;
#pragma unroll
    for (int j = 0; j < 4; ++j) { const f32x4 a = *(const f32x4*)(xo + j * 512), b = *(const f32x4*)(xo + j * 512 + 4);
#pragma unroll
        for (int t = 0; t < 4; ++t) { o[j * 8 + t] += a[t]; o[j * 8 + 4 + t] += b[t]; ss += o[j * 8 + t] * o[j * 8 + t] + o[j * 8 + 4 + t] * o[j * 8 + 4 + t]; } }
    ss = wave_sum(ss);
    const float rs = 1.0f / sqrtf(ss * (1.0f / D) + NORM_EPS);
#pragma unroll
    for (int j = 0; j < 4; ++j) { const f32x4 ga4 = *(const f32x4*)(gf + j * 512), gb4 = *(const f32x4*)(gf + j * 512 + 4); f32x4 a, b;
#pragma unroll
        for (int t = 0; t < 4; ++t) { a[t] = o[j * 8 + t] * rs * ga4[t]; b[t] = o[j * 8 + 4 + t] * rs * gb4[t]; }
        *(f32x4*)(xo + j * 512) = a; *(f32x4*)(xo + j * 512 + 4) = b; }
}

struct Args { const float* in[28]; float* out; unsigned char* ws; int ph_lo, ph_hi, li, pad; };
__global__ void __launch_bounds__(NTHR, 2) hybrid_fwd(Args args) {
    extern __shared__ __attribute__((aligned(16))) unsigned char lds[];
    Frame F;
    F.lds = (LAS unsigned char*)lds;
    F.tid = threadIdx.x; F.lane = F.tid & 63; F.wave = __builtin_amdgcn_readfirstlane(F.tid >> 6);
    F.G = gridDim.x; F.bid = blockIdx.x;
#pragma unroll
    for (int i = 0; i < 28; ++i) F.in[i] = args.in[i];
    F.out = args.out; F.ws = args.ws;
    volatile LAS unsigned* MISC = (volatile LAS unsigned*)(F.lds + MISC_OFF);
    for (int u = F.tid; u < (LDS_BYTES - LDSCTL_OFF) / 4; u += NTHR) ((LAS unsigned*)(F.lds + LDSCTL_OFF))[u] = 0u;
    __syncthreads();
    unsigned* barw = (unsigned*)(F.ws + WS_CTL) + CW_BAR;
    XcdBarrier bar; bar.bar = barw; bar.x = 0; bar.st = nullptr;
    if (N_LAUNCHES == 1) bar = xcd_barrier_post(barw, MISC + 8);
    const int lo = args.ph_lo, hi = args.ph_hi;
#define IN(k) (lo <= (k) && (k) < hi)
#define SEAM(k) do { if (IN(k) && IN((k) + 1)) xcd_barrier(bar); } while (0)

    if (IN(0)) { p0_prologue(F); __syncthreads(); }
    SEAM(0);
    if (IN(1)) {
        pg8::Gemm g{WSP(const bf16, WS_XB), WSP(const bf16, WS_WIN), T, NINP, D}; pg8::StaticOrder S; S.init(T, NINP, F.G, F.bid);
        pg8::EpiRowScaleBf16<0> E{WSP(bf16, WS_PROJ), NINP, WSP(const float, WS_RSTD1), NORM_EPS};
        pg8::gemm_phase<pg8::EpiRowScaleBf16<0>, pg8::StaticOrder, true, true>(F.lds, g, S, E);
    }
    SEAM(1);
    if (IN(2)) {
        if (F.G >= 256) { if (F.bid < 128) rwkv_item(F, F.bid); else for (int it = F.bid - 128; it < 256; it += F.G - 128) lru_item(F, it); }
        else for (int it = F.bid; it < 384; it += F.G) { if (it < 128) rwkv_item(F, it); else lru_item(F, it - 128); }
    }
    SEAM(2);
    if (IN(3)) {
        pg8::Gemm g{WSP(const bf16, WS_Y), WSP(const bf16, WS_WOUT), T, D, D}; pg8::StaticOrder S; S.init(T, D, F.G, F.bid);
        pg8::EpiResidual E{F.in[I_X], F.out, WSP(bf16, WS_XB), WSP(float, WS_SSQ2), D};
        pg8::gemm_phase<pg8::EpiResidual, pg8::StaticOrder, true, true>(F.lds, g, S, E);
    }
    SEAM(3);
    if (IN(4)) {
        pg8::Gemm g{WSP(const bf16, WS_XB), WSP(const bf16, WS_WQ), T, D, D}; pg8::StaticOrder S; S.init(T, D, F.G, F.bid);
        pg8::EpiRowScaleBf16<1> E{WSP(bf16, WS_Q), D, WSP(const float, WS_SSQ2), NORM_EPS};
        pg8::gemm_phase<pg8::EpiRowScaleBf16<1>, pg8::StaticOrder, true, true>(F.lds, g, S, E);
    }
    SEAM(4);
    if (IN(5)) { const int gw = F.bid * NWAVES + F.wave, NGW = F.G * NWAVES; for (int it = gw; it < (T / 32) * 8; it += NGW) route_item(F, it, F.lane); }
    SEAM(5);
    if (IN(6)) { const int gw = F.bid * NWAVES + F.wave, NGW = F.G * NWAVES; for (int tok = gw; tok < T; tok += NGW) peer_token(F, tok, F.lane); }
#undef IN
#undef SEAM
}

extern "C" void kernel_launch(void* const* d_in, const int* in_sizes, int n_in, void* d_out, int out_size, void* d_ws, size_t ws_size, hipStream_t stream) {
    static int grid = 0;
    if (grid == 0) {
        if (n_in != 28 || in_sizes[0] != T * D || out_size != T * D || ws_size < WS_END) { fprintf(stderr, "kernel_launch: shape/workspace mismatch: n_in %d in0 %d out %d ws %zu (need %zu)\n", n_in, n_in > 0 ? in_sizes[0] : -1, out_size, ws_size, (size_t)WS_END); grid = -1; return; }
        int dev = 0, cus = 0, per_cu = 0;
        if (hipGetDevice(&dev) != hipSuccess || hipDeviceGetAttribute(&cus, hipDeviceAttributeMultiprocessorCount, dev) != hipSuccess) { fprintf(stderr, "kernel_launch: device query failed\n"); grid = -1; return; }
        if (hipFuncSetAttribute((const void*)hybrid_fwd, hipFuncAttributeMaxDynamicSharedMemorySize, LDS_BYTES) != hipSuccess) { fprintf(stderr, "kernel_launch: hipFuncSetAttribute failed\n"); grid = -1; return; }
        if (hipOccupancyMaxActiveBlocksPerMultiprocessor(&per_cu, (const void*)hybrid_fwd, NTHR, LDS_BYTES) != hipSuccess || per_cu < 1) { fprintf(stderr, "kernel_launch: occupancy query says %d blocks per CU\n", per_cu); per_cu = 1; }
        (void)hipGetLastError();
        grid = cus;
    }
    if (grid < 0) return;
    if (hipMemsetAsync((char*)d_ws + WS_CTL, 0, CTL_ZERO_BYTES, stream) != hipSuccess) { fprintf(stderr, "kernel_launch: hipMemsetAsync failed\n"); return; }
    Args a{};
    for (int i = 0; i < 28; ++i) a.in[i] = (const float*)d_in[i];
    a.out = (float*)d_out; a.ws = (unsigned char*)d_ws;
    for (int li = 0; li < N_LAUNCHES; ++li) {
        a.ph_lo = (N_LAUNCHES == 1) ? 0 : li; a.ph_hi = (N_LAUNCHES == 1) ? N_PHASES : li + 1; a.li = li;
        hipLaunchKernelGGL(hybrid_fwd, dim3(grid), dim3(NTHR), LDS_BYTES, stream, a);
        const hipError_t le = hipPeekAtLastError();
        if (le != hipSuccess) { fprintf(stderr, "kernel_launch: launch %d failed: %s\n", li, hipGetErrorName(le)); break; }
    }
}
```

```cpp
#include <hip/hip_runtime.h>
#include <cstdio>
#include <cstdint>
namespace pg8 {
#define PG8_LAS __attribute__((address_space(3)))
typedef unsigned short bf16_t;
typedef short bf16x8 __attribute__((ext_vector_type(8)));
typedef float f32x4 __attribute__((ext_vector_type(4)));
typedef unsigned u32x4 __attribute__((ext_vector_type(4)));
constexpr int BM = 256, BK = 64, HALF = 128, HTB = HALF * BK * 2  , STAGE_BYTES = 8 * HTB, NXCD = 8, WGM = 8;

__host__ __device__ __forceinline__ int lds_byte(int r, int c) { const int st = (r >> 4) * 2 + (c >> 5), rr = r & 15, cc = c & 31, ob = rr * 64 + cc * 2; return st * 1024 + (ob ^ (((ob >> 9) & 1) << 5)); }
__host__ __device__ __forceinline__ void stage_rc(int b, int& R, int& C) { const int st = b / 1024, sb = b % 1024, swz = sb ^ (((sb >> 9) & 1) << 5); R = (st >> 1) * 16 + swz / 64; C = (st & 1) * 32 + (swz % 64) / 2; }
__host__ __device__ __forceinline__ int perm32(int rho) { const int n = rho >> 4, i = rho & 15; return 8 * (i >> 2) + 4 * n + (i & 3); }

struct Unit { int pm, pn; };
struct Gemm { const bf16_t* A; const bf16_t* Bt; int M, N, K; };

struct StaticOrder {
    int nM, nN, nwg, G, c;
    __host__ __device__ void init(int M, int N, int G_, int c_) { nM = M / BM; nN = N / BM; nwg = nM * nN; G = G_; c = c_; }
    __host__ __device__ bool next(int i, Unit& u) const {
        const long L = (long)i * G + c; if (L >= nwg) return false;
        int wgid = (int)L; { const int q = nwg / NXCD, r = nwg % NXCD, xcd = wgid % NXCD, off = wgid / NXCD; wgid = (xcd < r ? xcd * (q + 1) : r * (q + 1) + (xcd - r) * q) + off; }
        const int nig = WGM * nN, gid = wgid / nig, fm = gid * WGM, gsz = (nM - fm) < WGM ? (nM - fm) : WGM;
        u.pm = fm + ((wgid % nig) % gsz); u.pn = (wgid % nig) / gsz; return true;
    }
    __device__ __forceinline__ void a_ready(const Unit&) const {}
    __device__ __forceinline__ void done(const Unit&) const {}
};

__device__ __forceinline__ unsigned cvt_pk_bf16(float lo, float hi) { unsigned r; asm volatile("v_cvt_pk_bf16_f32 %0, %1, %2" : "=v"(r) : "v"(lo), "v"(hi)); return r; }
typedef float f32x2 __attribute__((ext_vector_type(2)));
typedef unsigned u32x2 __attribute__((ext_vector_type(2)));
template <int MODE> struct EpiRowScaleBf16 {
    static constexpr bool PERM = true, AFTER_DRAIN = false;
    bf16_t* O; int ldc; const float* rs; float eps;
    __device__ __forceinline__ void operator()(const f32x4 (&acc)[2][2][4][2], const Unit& u, int wr, int wc, int fr, int fq) const {
        const int row0 = u.pm * BM + wr * 64 + fr, col0 = u.pn * BM + wc * 32 + 8 * fq;
#pragma unroll
        for (int ai = 0; ai < 2; ++ai)
#pragma unroll
            for (int m = 0; m < 4; ++m) { const int r = row0 + ai * HALF + m * 16; float s = rs[r]; if (MODE == 1) s = 1.0f / sqrtf(s * (1.0f / 2048.0f) + eps);
                bf16_t* rowp = O + (size_t)r * ldc + col0;
#pragma unroll
                for (int bj = 0; bj < 2; ++bj) { const f32x4 v0 = acc[ai][bj][m][0] * s, v1 = acc[ai][bj][m][1] * s;
                    u32x4 w; w.x = cvt_pk_bf16(v0[0], v0[1]); w.y = cvt_pk_bf16(v0[2], v0[3]); w.z = cvt_pk_bf16(v1[0], v1[1]); w.w = cvt_pk_bf16(v1[2], v1[3]);
                    *(u32x4*)(rowp + bj * HALF) = w; } }
    }
};
struct EpiResidual {
    static constexpr bool PERM = false, AFTER_DRAIN = false;
    const float* base; float* out; bf16_t* outb; float* ssq; int ldc;
    __device__ __forceinline__ void operator()(const f32x4 (&acc)[2][2][4][2], const Unit& u, int wr, int wc, int fr, int fq) const {
        const int row0 = u.pm * BM + wr * 64 + fr, col0 = u.pn * BM + wc * 32 + 4 * fq;
#pragma unroll
        for (int ai = 0; ai < 2; ++ai)
#pragma unroll
            for (int m = 0; m < 4; ++m) { const int r = row0 + ai * HALF + m * 16; const size_t off = (size_t)r * ldc + col0; float q = 0.f;
#pragma unroll
                for (int bj = 0; bj < 2; ++bj)
#pragma unroll
                    for (int n = 0; n < 2; ++n) { const f32x4 bs = *(const f32x4*)(base + off + bj * HALF + n * 16); const f32x4 o = bs + acc[ai][bj][m][n];
                        *(f32x4*)(out + off + bj * HALF + n * 16) = o; q += (o[0] * o[0] + o[1] * o[1]) + (o[2] * o[2] + o[3] * o[3]);
                        u32x2 w; w.x = cvt_pk_bf16(o[0], o[1]); w.y = cvt_pk_bf16(o[2], o[3]); *(u32x2*)(outb + off + bj * HALF + n * 16) = w; }
                q += __shfl_xor(q, 16); q += __shfl_xor(q, 32);
                if (fq == 0) atomicAdd(ssq + r, q);
                asm volatile("" ::: "memory"); }
    }
};
template <class Epi, class Sched, bool ALIGN_EPI = false, bool SP2 = false>
__device__ __forceinline__ void gemm_phase(PG8_LAS unsigned char* lds, const Gemm g, const Sched& S, const Epi& E) {
    const int tid = threadIdx.x, wid = __builtin_amdgcn_readfirstlane(tid >> 6), lane = tid & 63, wr = wid >> 2, wc = wid & 3, fr = lane & 15, fq = lane >> 4;
    const int K = g.K, nt = K / BK;
    unsigned voffA[2], voffB[2];
#pragma unroll
    for (int i = 0; i < 2; ++i) { int R, C; stage_rc(tid * 16 + i * 8192, R, C); const int Rb = Epi::PERM ? ((R & ~31) + perm32(R & 31)) : R;
        voffA[i] = (unsigned)(R * K + C) * 2u; voffB[i] = (unsigned)(Rb * K + C) * 2u; }
    const size_t kstep = (size_t)(BK * 2);
    const size_t hstep = (size_t)HALF * K * 2;
    const size_t tstep = 2 * hstep;
    const unsigned ldsw = (unsigned)wid * 1024u;
    const int aoff = lds_byte(wr * 64 + fr, fq * 8), boff = lds_byte(wc * 32 + fr, fq * 8);
#define PG8_SA(b, h) (((b) * 2 + (h)) * HTB)
#define PG8_SB(b, h) ((4 + (b) * 2 + (h)) * HTB)
#define PG8_STAGE(bufoff, gbase, voff) do { _Pragma("unroll") for (int _i = 0; _i < 2; ++_i) \
        __builtin_amdgcn_global_load_lds((const unsigned*)((const char*)(gbase) + (voff)[_i]), (PG8_LAS unsigned*)(lds + (bufoff) + ldsw + _i * 8192), 16, 0, 0); } while (0)
#define PG8_LDA(dst, b, h) do { _Pragma("unroll") for (int m = 0; m < 4; ++m) _Pragma("unroll") for (int k = 0; k < 2; ++k) dst[m][k] = *(const PG8_LAS bf16x8*)(lds + PG8_SA(b, h) + aoff + m * 2048 + k * 1024); } while (0)
#define PG8_LDB(dst, b, h) do { _Pragma("unroll") for (int n = 0; n < 2; ++n) _Pragma("unroll") for (int k = 0; k < 2; ++k) dst[n][k] = *(const PG8_LAS bf16x8*)(lds + PG8_SB(b, h) + boff + n * 2048 + k * 1024); } while (0)
#define PG8_MMA(ai, bj, At, Bt) do { __builtin_amdgcn_s_setprio(1); _Pragma("unroll") for (int m = 0; m < 4; ++m) _Pragma("unroll") for (int n = 0; n < 2; ++n) _Pragma("unroll") for (int k = 0; k < 2; ++k) \
        acc[ai][bj][m][n] = __builtin_amdgcn_mfma_f32_16x16x32_bf16(Bt[n][k], At[m][k], acc[ai][bj][m][n], 0, 0, 0); __builtin_amdgcn_s_setprio(0); } while (0)
#define PG8_WAIT_V(n) asm volatile("s_waitcnt vmcnt(" #n ")" ::: "memory")
#define PG8_WAIT_L(n) asm volatile("s_waitcnt lgkmcnt(" #n ")" ::: "memory")
#define PG8_BAR __builtin_amdgcn_s_barrier()
#define PG8_SCHED __builtin_amdgcn_sched_barrier(0)
    Unit cur, nxt; int ui = 0;
    if (!S.next(0, cur)) return;
    f32x4 acc[2][2][4][2];
#pragma unroll
    for (int a = 0; a < 2; ++a)
#pragma unroll
        for (int b = 0; b < 2; ++b)
#pragma unroll
            for (int m = 0; m < 4; ++m)
#pragma unroll
                for (int n = 0; n < 2; ++n) acc[a][b][m][n] = (f32x4){0.f, 0.f, 0.f, 0.f};
    bf16x8 At[4][2], B0[2][2], B1[2][2];
    const char* cA = (const char*)g.A + (size_t)cur.pm * tstep; const char* cB = (const char*)g.Bt + (size_t)cur.pn * tstep;
    S.a_ready(cur);
    if constexpr (SP2) {
        PG8_STAGE(PG8_SB(0, 0), cB, voffB); PG8_STAGE(PG8_SB(0, 1), cB + hstep, voffB); PG8_STAGE(PG8_SA(0, 0), cA, voffA); PG8_STAGE(PG8_SA(0, 1), cA + hstep, voffA);
        if (wr == 1) PG8_BAR;
        PG8_WAIT_V(2); PG8_BAR;
        PG8_STAGE(PG8_SB(1, 0), cB + kstep, voffB); PG8_STAGE(PG8_SA(1, 0), cA + kstep, voffA); PG8_STAGE(PG8_SB(1, 1), cB + hstep + kstep, voffB);
        PG8_WAIT_V(6); PG8_BAR;
    } else {
        PG8_STAGE(PG8_SB(0, 0), cB, voffB); PG8_STAGE(PG8_SA(0, 0), cA, voffA); PG8_STAGE(PG8_SB(0, 1), cB + hstep, voffB); PG8_STAGE(PG8_SA(0, 1), cA + hstep, voffA);
        if (wr == 1) PG8_BAR;
        PG8_WAIT_V(4); PG8_BAR;
        PG8_STAGE(PG8_SB(1, 0), cB + kstep, voffB); PG8_STAGE(PG8_SA(1, 0), cA + kstep, voffA); PG8_STAGE(PG8_SB(1, 1), cB + hstep + kstep, voffB);
        PG8_WAIT_V(6); PG8_BAR;
    }
    for (;;) {
        const bool has_next = S.next(ui + 1, nxt);
        const char* nA = has_next ? (const char*)g.A + (size_t)nxt.pm * tstep : cA; const char* nB = has_next ? (const char*)g.Bt + (size_t)nxt.pn * tstep : cB;
        for (int t = 0; t < nt; t += 2) {
            const bool last = (t == nt - 2);
            const char* a1 = cA + (size_t)(t + 1) * kstep;
            const char* a2 = last ? nA : cA + (size_t)(t + 2) * kstep; const char* b2 = last ? nB : cB + (size_t)(t + 2) * kstep;
            const char* a3 = a2 + kstep; const char* b3 = b2 + kstep;
            if (last && has_next) S.a_ready(nxt);
            if constexpr (SP2) {
            PG8_LDB(B0, 0, 0); PG8_LDB(B1, 0, 1); PG8_SCHED; PG8_LDA(At, 0, 0); PG8_STAGE(PG8_SA(1, 1), a1 + hstep, voffA);
            PG8_WAIT_V(8); PG8_WAIT_L(0); PG8_BAR; PG8_MMA(0, 0, At, B0); PG8_MMA(0, 1, At, B1); PG8_BAR; PG8_SCHED;
            PG8_LDA(At, 0, 1); PG8_STAGE(PG8_SB(0, 0), b2, voffB); PG8_STAGE(PG8_SB(0, 1), b2 + hstep, voffB); PG8_STAGE(PG8_SA(0, 0), a2, voffA);
            PG8_WAIT_V(8); PG8_WAIT_L(0); PG8_BAR; PG8_MMA(1, 0, At, B0); PG8_MMA(1, 1, At, B1); PG8_BAR; PG8_SCHED;
            PG8_LDB(B0, 1, 0); PG8_LDB(B1, 1, 1); PG8_SCHED; PG8_LDA(At, 1, 0); PG8_STAGE(PG8_SA(0, 1), a2 + hstep, voffA);
            PG8_WAIT_V(8); PG8_WAIT_L(0); PG8_BAR; PG8_MMA(0, 0, At, B0); PG8_MMA(0, 1, At, B1); PG8_BAR; PG8_SCHED;
            PG8_LDA(At, 1, 1); PG8_STAGE(PG8_SB(1, 0), b3, voffB); PG8_STAGE(PG8_SB(1, 1), b3 + hstep, voffB); PG8_STAGE(PG8_SA(1, 0), a3, voffA);
            PG8_WAIT_V(8); PG8_WAIT_L(0); PG8_BAR; PG8_MMA(1, 0, At, B0); PG8_MMA(1, 1, At, B1); PG8_BAR; PG8_SCHED;
            } else {
            PG8_LDB(B0, 0, 0); PG8_SCHED; PG8_LDA(At, 0, 0); PG8_STAGE(PG8_SA(1, 1), a1 + hstep, voffA);
            PG8_WAIT_L(8); PG8_BAR; PG8_WAIT_L(0); PG8_MMA(0, 0, At, B0); PG8_BAR; PG8_SCHED;
            PG8_LDB(B1, 0, 1); PG8_STAGE(PG8_SB(0, 0), b2, voffB);
            PG8_BAR; PG8_WAIT_L(0); PG8_MMA(0, 1, At, B1); PG8_BAR;
            PG8_LDA(At, 0, 1); PG8_STAGE(PG8_SA(0, 0), a2, voffA);
            PG8_BAR; PG8_WAIT_L(0); PG8_MMA(1, 0, At, B0); PG8_BAR; PG8_SCHED;
            PG8_STAGE(PG8_SB(0, 1), b2 + hstep, voffB);
            PG8_WAIT_V(6); PG8_BAR; PG8_MMA(1, 1, At, B1); PG8_BAR;
            PG8_LDB(B0, 1, 0); PG8_SCHED; PG8_LDA(At, 1, 0); PG8_STAGE(PG8_SA(0, 1), a2 + hstep, voffA);
            PG8_WAIT_L(8); PG8_BAR; PG8_WAIT_L(0); PG8_MMA(0, 0, At, B0); PG8_BAR; PG8_SCHED;
            PG8_LDB(B1, 1, 1); PG8_STAGE(PG8_SB(1, 0), b3, voffB);
            PG8_BAR; PG8_WAIT_L(0); PG8_MMA(0, 1, At, B1); PG8_BAR;
            PG8_LDA(At, 1, 1); PG8_STAGE(PG8_SA(1, 0), a3, voffA);
            PG8_BAR; PG8_WAIT_L(0); PG8_MMA(1, 0, At, B0); PG8_BAR; PG8_SCHED;
            PG8_STAGE(PG8_SB(1, 1), b3 + hstep, voffB);
            PG8_WAIT_V(6); PG8_BAR; PG8_MMA(1, 1, At, B1); PG8_BAR;
            }
        }
        if constexpr (ALIGN_EPI) { if (wr == 0) PG8_BAR; }
        if constexpr (!Epi::AFTER_DRAIN) { E(acc, cur, wr, wc, fr, fq); S.done(cur); }
        if (!has_next) break;
#pragma unroll
        for (int a = 0; a < 2; ++a)
#pragma unroll
            for (int b = 0; b < 2; ++b)
#pragma unroll
                for (int m = 0; m < 4; ++m)
#pragma unroll
                    for (int n = 0; n < 2; ++n) acc[a][b][m][n] = (f32x4){0.f, 0.f, 0.f, 0.f};
        cur = nxt; cA = nA; cB = nB; ++ui;
        if constexpr (ALIGN_EPI) { if (wr == 1) PG8_BAR; }
    }
    PG8_WAIT_V(0);
    if constexpr (!ALIGN_EPI) { if (wr == 0) PG8_BAR; }
    PG8_BAR;
    if constexpr (Epi::AFTER_DRAIN) { E.fused(acc, cur, wr, wc, fr, fq, lds, wid, lane); S.done(cur); }
#undef PG8_SA
#undef PG8_SB
#undef PG8_STAGE
#undef PG8_LDA
#undef PG8_LDB
#undef PG8_MMA
#undef PG8_WAIT_V
#undef PG8_WAIT_L
#undef PG8_BAR
#undef PG8_SCHED
}
}

#ifndef PROBE_DUP
#define PROBE_DUP -1
#endif
constexpr int NWAVES = 8, NTHR = NWAVES * 64;
#ifndef MK_N_LAUNCHES
#define MK_N_LAUNCHES 1
#endif
constexpr int N_PHASES = 10;
constexpr int N_LAUNCHES = MK_N_LAUNCHES;
static_assert(N_LAUNCHES == 1 || N_LAUNCHES == N_PHASES, "MK_N_LAUNCHES is 1 or N_PHASES");

constexpr int BATCH = 8, SEQ = 2048, T = BATCH * SEQ, D = 2048;
constexpr int NIN = 5408, NINP = 5632;
constexpr int PC_GATE = 1024, PC_R = 2048, PC_K = 3072, PC_V = 4096, PC_WD = 5120, PC_AD = 5184, PC_GD = 5248;
constexpr int RWKV_C0 = 2048;
constexpr int NEXP = 16384, NSEL = 128;
constexpr float NORM_EPS = 1e-6f, GN_EPS = 64e-5f;

constexpr size_t MiB = 1u << 20;
constexpr size_t WS_CTL = 0, CTL_ZERO_BYTES = 1 * MiB;
constexpr size_t WS_SSQ3 = 576 * 1024;
constexpr size_t WS_SSQ2 = 512 * 1024;
constexpr size_t WS_RSTD1 = 1 * MiB;
constexpr size_t WS_USC = 1 * MiB + 64 * 1024, WS_VSC = 1 * MiB + 128 * 1024;
constexpr size_t WS_SX = 1 * MiB + 192 * 1024;
constexpr size_t WS_WIN = 2 * MiB;
constexpr size_t WS_WOUT = 24 * MiB;
constexpr size_t WS_WQ = 32 * MiB;
constexpr size_t WS_KEYS = 40 * MiB;
constexpr size_t WS_W2T = WS_KEYS + 512 * 1024;
constexpr size_t WS_A2T = WS_W2T + 128 * 1024;
constexpr size_t WS_G2T = WS_A2T + 128 * 1024;
constexpr size_t WS_WAT = WS_G2T + 320 * 1024;
constexpr size_t WS_WIT = WS_WAT + 256 * 1024;
constexpr size_t WS_EXP = 42 * MiB;
constexpr size_t WS_GATE = 50 * MiB;
constexpr size_t WS_LA = 64 * MiB;
constexpr size_t WS_SUMM = 58 * MiB;
constexpr size_t WS_XB = 64 * MiB;
constexpr size_t WS_PROJ = 128 * MiB;
constexpr size_t WS_Q = WS_PROJ;
constexpr size_t WS_PART = 192 * MiB;
constexpr size_t WS_XQ = 320 * MiB;
constexpr size_t WS_COEF = 352 * MiB;
constexpr size_t WS_CSC = 356 * MiB;
constexpr size_t WS_Y = 304 * MiB;
constexpr size_t WS_UT = 368 * MiB;
constexpr size_t WS_VT = 432 * MiB;
constexpr size_t WS_END = 496 * MiB;
static_assert(WS_WIT + 256 * 1024 <= WS_EXP && WS_PROJ + (size_t)T * NINP * 2 <= WS_Y && WS_WIN + (size_t)NINP * D * 2 <= WS_WOUT, "d_ws map");
constexpr int CW_PREBAR = 2112;
constexpr int CW_LRUBAR = 2048;
constexpr int CW_BAR = 4096;

constexpr int RING_BYTES = 131072;
constexpr int LDSCTL_OFF = 143360, MISC_OFF = LDSCTL_OFF + 320;
constexpr int LDS_BYTES = 147456;

#define GAS __attribute__((address_space(1)))
#define LAS __attribute__((address_space(3)))
typedef unsigned short bf16;
typedef unsigned v4u __attribute__((ext_vector_type(4)));
typedef unsigned v2u __attribute__((ext_vector_type(2)));
typedef float f32x4 __attribute__((ext_vector_type(4)));
typedef float f32x16 __attribute__((ext_vector_type(16)));
typedef short bf16x8 __attribute__((ext_vector_type(8)));
typedef __bf16 bf16x2_t __attribute__((ext_vector_type(2)));
typedef GAS unsigned gu32;
#define RLX_AGENT __ATOMIC_RELAXED, __HIP_MEMORY_SCOPE_AGENT
__device__ __forceinline__ unsigned f2bf(float f) { unsigned u = __builtin_bit_cast(unsigned, f); return (u + 0x7fffu + ((u >> 16) & 1u)) >> 16; }
__device__ __forceinline__ unsigned pk2(float lo, float hi) { return f2bf(lo) | (f2bf(hi) << 16); }
__device__ __forceinline__ float bf_lo(unsigned w) { return __uint_as_float(w << 16); }
__device__ __forceinline__ float bf_hi(unsigned w) { return __uint_as_float(w & 0xffff0000u); }
__device__ __forceinline__ void unpack8(const v4u& w, float (&o)[8]) { o[0] = bf_lo(w.x); o[1] = bf_hi(w.x); o[2] = bf_lo(w.y); o[3] = bf_hi(w.y); o[4] = bf_lo(w.z); o[5] = bf_hi(w.z); o[6] = bf_lo(w.w); o[7] = bf_hi(w.w); }
__device__ __forceinline__ v4u pack8(const float (&o)[8]) { v4u w; w.x = pk2(o[0], o[1]); w.y = pk2(o[2], o[3]); w.z = pk2(o[4], o[5]); w.w = pk2(o[6], o[7]); return w; }
__device__ __forceinline__ float sigmoidf_(float x) { return 1.0f / (1.0f + __expf(-x)); }
__device__ __forceinline__ float softplusf_(float z) { return fmaxf(z, 0.f) + log1pf(__expf(-fabsf(z))); }
__device__ __forceinline__ float gelu_tanh(float x) { const float u = 0.7978845608028654f * (x + 0.044715f * x * x * x); return 0.5f * x * (1.0f + tanhf(u)); }
template <int CTRL> __device__ __forceinline__ float dppf(float x) { return __builtin_bit_cast(float, __builtin_amdgcn_mov_dpp(__builtin_bit_cast(int, x), CTRL, 0xf, 0xf, true)); }
__device__ __forceinline__ float red8(float v) { v += dppf<0xB1>(v); v += dppf<0x4E>(v); v += dppf<0x141>(v); return v; }
__device__ __forceinline__ float red16(float v) { v = red8(v); v += dppf<0x140>(v); return v; }
__device__ __forceinline__ float wave_sum(float v) {
#pragma unroll
    for (int o = 1; o < 64; o <<= 1) v += __shfl_xor(v, o);
    return v;
}
__device__ __forceinline__ float dot2bf(unsigned a, unsigned b, float acc) { return __builtin_amdgcn_fdot2_f32_bf16(__builtin_bit_cast(bf16x2_t, a), __builtin_bit_cast(bf16x2_t, b), acc, false); }
#define MFMA16(a, b, c) __builtin_amdgcn_mfma_f32_16x16x32_bf16((a), (b), (c), 0, 0, 0)
#define MFMA32(a, b, c) __builtin_amdgcn_mfma_f32_32x32x16_bf16((a), (b), (c), 0, 0, 0)

#define XB_TMO      128
#define XB_XCNT(j)  (256  + 64 * (j))
#define XB_XSUB(j)  (1280 + 64 * (j))
#define XB_XGEN(j)  (2304 + 64 * (j))
#define XB_TOP      3328
#define XB_TOPGEN   3392
#define XCD_BAR_WORDS 3456
#define XB_SPIN_CAP (1u << 22)
__device__ __forceinline__ unsigned xb_ld(unsigned* p)              { return __hip_atomic_load(p, __ATOMIC_RELAXED, __HIP_MEMORY_SCOPE_AGENT); }
__device__ __forceinline__ unsigned xb_add(unsigned* p, unsigned v) { return __hip_atomic_fetch_add(p, v, __ATOMIC_RELAXED, __HIP_MEMORY_SCOPE_AGENT); }
__device__ __forceinline__ unsigned xb_xcc_id() { return (unsigned)__builtin_amdgcn_s_getreg((3 << 11) | 20) & 0xFu; }
#define XB_SPIN(cond, bar) do { unsigned _sp = 0; while (cond) { __builtin_amdgcn_s_sleep(1); \
    if ((++_sp & 255u) == 0u) { if (xb_ld(&(bar)[XB_TMO])) break; if (_sp > XB_SPIN_CAP) { atomicAdd(&(bar)[XB_TMO], 1u); break; } } } } while (0)
struct XcdBarrier { unsigned* bar; unsigned x; volatile LAS unsigned* st; };
__device__ __forceinline__ XcdBarrier xcd_barrier_post(unsigned* bar, volatile LAS unsigned* st) {
    XcdBarrier b; b.bar = bar; b.x = xb_xcc_id(); b.st = st;
    if (threadIdx.x == 0) (void)xb_add(&bar[XB_XCNT(b.x)], 1u);
    return b;
}
__device__ __forceinline__ void xcd_barrier_complete(unsigned* bar, unsigned x, unsigned& nloc, unsigned& nx) {
    const unsigned G = gridDim.x * gridDim.y * gridDim.z;
    unsigned sum, cnt, mine, sp = 0u;
    for (;;) {
        sum = 0u; cnt = 0u; mine = 0u;
#pragma unroll
        for (unsigned j = 0; j < 16; ++j) { const unsigned c = xb_ld(&bar[XB_XCNT(j)]); sum += c; cnt += (c > 0u) ? 1u : 0u; mine = (j == x) ? c : mine; }
        if (sum == G) break;
        __builtin_amdgcn_s_sleep(1);
        if ((++sp & 255u) == 0u) { if (xb_ld(&bar[XB_TMO])) break; if (sp > XB_SPIN_CAP) { atomicAdd(&bar[XB_TMO], 1u); break; } }
    }
    nloc = mine > 0u ? mine : 1u; nx = cnt > 0u ? cnt : 1u;
}
__device__ __forceinline__ void xcd_barrier(const XcdBarrier& b) {
    asm volatile("s_waitcnt vmcnt(0)" ::: "memory");
    __syncthreads();
    if (threadIdx.x == 0) {
        unsigned* bar = b.bar;
        __builtin_amdgcn_s_waitcnt(0);
        unsigned nloc = b.st[0], nx = b.st[1];
        if (nloc == 0u) { xcd_barrier_complete(bar, b.x, nloc, nx); b.st[0] = nloc; b.st[1] = nx; }
        const unsigned old = xb_add(&bar[XB_XSUB(b.x)], 1u);
        const unsigned gen = old / nloc;
        if (old + 1u == (gen + 1u) * nloc) {
            __builtin_amdgcn_fence(__ATOMIC_RELEASE, "agent");
            asm volatile("s_waitcnt vmcnt(0)" ::: "memory");
            const unsigned og = xb_add(&bar[XB_TOP], 1u);
            const unsigned tg = og / nx;
            if (og + 1u == (tg + 1u) * nx) xb_add(&bar[XB_TOPGEN], 1u);
            else XB_SPIN(xb_ld(&bar[XB_TOPGEN]) == tg, bar);
            __builtin_amdgcn_fence(__ATOMIC_ACQUIRE, "agent");
            xb_add(&bar[XB_XGEN(b.x)], 1u);
            asm volatile("s_waitcnt vmcnt(0)" ::: "memory");
        } else {
            XB_SPIN(xb_ld(&bar[XB_XGEN(b.x)]) == gen, bar);
            __builtin_amdgcn_fence(__ATOMIC_ACQUIRE, "agent");
            asm volatile("s_waitcnt vmcnt(0)" ::: "memory");
        }
    }
    __syncthreads();
}

struct Frame {
    LAS unsigned char* lds;
    int tid, lane, wave, G, bid;
    const float* in[28];
    float* out;
    unsigned char* ws;
};
#define WSP(type, off) ((type*)(F.ws + (off)))
enum { I_X = 0, I_G1, I_WIN, I_CONVW, I_CONVB, I_WA, I_BA, I_WI, I_BI, I_LAM, I_MU, I_W0, I_W2, I_A0, I_A2, I_G2, I_KK, I_KA, I_RK, I_LNW, I_LNB, I_WOUT, I_G2N, I_WQ, I_KEYS, I_U, I_V, I_GF };

__device__ __forceinline__ void p0_transpose_item(const float* W, int K, int N, bf16* WT, const float* ksc, LAS float* scr, int item, int lane) {
    const int nblk = N / 32, kb = item / nblk, nb = item % nblk, k0 = 64 * kb, n0 = 32 * nb;
    const int lr = lane >> 3, c4 = (lane & 7) * 4;
    f32x4 v[8];
#pragma unroll
    for (int i = 0; i < 8; ++i) v[i] = *(const f32x4*)(W + (size_t)(k0 + 8 * i + lr) * N + n0 + c4);
#pragma unroll
    for (int i = 0; i < 8; ++i) { const int kk = 8 * i + lr; const float sc = ksc ? ksc[k0 + kk] : 1.0f; LAS float* d = scr + kk * 33 + c4; d[0] = v[i][0] * sc; d[1] = v[i][1] * sc; d[2] = v[i][2] * sc; d[3] = v[i][3] * sc; }
    asm volatile("s_waitcnt lgkmcnt(0)" ::: "memory");
    const int c = lane & 7;
#pragma unroll
    for (int j = 0; j < 4; ++j) { const int n = (lane >> 3) + 8 * j; const LAS float* s = scr + (8 * c) * 33 + n;
        v4u o; o.x = pk2(s[0 * 33], s[1 * 33]); o.y = pk2(s[2 * 33], s[3 * 33]); o.z = pk2(s[4 * 33], s[5 * 33]); o.w = pk2(s[6 * 33], s[7 * 33]);
        *(v4u*)(WT + (size_t)(n0 + n) * K + k0 + 8 * c) = o; }
    asm volatile("s_waitcnt lgkmcnt(0)" ::: "memory");
}
__device__ __forceinline__ void p0_small_transpose(const float* src, bf16* dst, int nb, int K, int N, int gt, int NGT) {
    const int tot = nb * K * N;
    for (int i = gt; i < tot; i += NGT) { const int bb = i / (K * N), r = i - bb * K * N, n = r / K, k = r - n * K; dst[i] = (bf16)f2bf(src[(size_t)bb * K * N + (size_t)k * N + n]); }
}
template <int PART> __device__ __forceinline__ void p0_prologue(const Frame& F, int vb, int VG) {
    LAS float* scr = (LAS float*)(F.lds + F.wave * 8448);
    const int gw = vb * NWAVES + F.wave, NGW = VG * NWAVES, gt = gw * 64 + F.lane, NGT = NGW * 64;
    constexpr int I1 = (D / 64) * (NIN / 32), I2 = (D / 64) * (D / 32);
    if (PART == 0) { for (int it = gw; it < I1; it += NGW) p0_transpose_item(F.in[I_WIN], D, NIN, WSP(bf16, WS_WIN), F.in[I_G1], scr, it, F.lane); }
    else { for (int it = gw; it < 2 * I2; it += NGW) { if (it < I2) p0_transpose_item(F.in[I_WOUT], D, D, WSP(bf16, WS_WOUT), nullptr, scr, it, F.lane); else p0_transpose_item(F.in[I_WQ], D, D, WSP(bf16, WS_WQ), F.in[I_G2N], scr, it - I2, F.lane); } }
    if (PART == 0) {
    { v4u* z = (v4u*)(WSP(bf16, WS_WIN) + (size_t)NIN * D); const int nz = (NINP - NIN) * D * 2 / 16; for (int i = gt; i < nz; i += NGT) z[i] = (v4u){0u, 0u, 0u, 0u}; }
    p0_small_transpose(F.in[I_W2], WSP(bf16, WS_W2T), 1, 64, 1024, gt, NGT);
    p0_small_transpose(F.in[I_A2], WSP(bf16, WS_A2T), 1, 64, 1024, gt, NGT);
    p0_small_transpose(F.in[I_G2], WSP(bf16, WS_G2T), 1, 160, 1024, gt, NGT);
    p0_small_transpose(F.in[I_WA], WSP(bf16, WS_WAT), 8, 128, 128, gt, NGT);
    p0_small_transpose(F.in[I_WI], WSP(bf16, WS_WIT), 8, 128, 128, gt, NGT);
    { const float* s = F.in[I_KEYS]; bf16* d = WSP(bf16, WS_KEYS); for (int i = gt; i < 8 * 2 * 128 * 128 / 8; i += NGT) { const f32x4 a = *(const f32x4*)(s + (size_t)i * 8), b = *(const f32x4*)(s + (size_t)i * 8 + 4);
        v4u o; o.x = pk2(a[0], a[1]); o.y = pk2(a[2], a[3]); o.z = pk2(b[0], b[1]); o.w = pk2(b[2], b[3]); *(v4u*)(d + (size_t)i * 8) = o; } }
    }
    if (PART == 1) {
    { const float* su = F.in[I_U]; const float* sv = F.in[I_V]; const float* g2 = F.in[I_G2N]; unsigned char* du = WSP(unsigned char, WS_UT); unsigned char* dv = WSP(unsigned char, WS_VT);
      float* usc = WSP(float, WS_USC); float* vsc = WSP(float, WS_VSC);
      f32x4 gg[2][4];
#pragma unroll
      for (int hh = 0; hh < 2; ++hh)
#pragma unroll
          for (int q = 0; q < 4; ++q) gg[hh][q] = *(const f32x4*)(g2 + hh * 1024 + F.lane * 16 + q * 4);
      for (int row = gw; row < NEXP; row += NGW) {
          f32x4 uu[2][4], vv[2][4]; float am = 0.f, vm = 0.f;
#pragma unroll
          for (int hh = 0; hh < 2; ++hh)
#pragma unroll
              for (int q = 0; q < 4; ++q) { uu[hh][q] = *(const f32x4*)(su + (size_t)row * D + hh * 1024 + F.lane * 16 + q * 4) * gg[hh][q]; vv[hh][q] = *(const f32x4*)(sv + (size_t)row * D + hh * 1024 + F.lane * 16 + q * 4);
#pragma unroll
                  for (int e = 0; e < 4; ++e) { am = fmaxf(am, fabsf(uu[hh][q][e])); vm = fmaxf(vm, fabsf(vv[hh][q][e])); } }
#pragma unroll
          for (int o = 1; o < 64; o <<= 1) { am = fmaxf(am, __shfl_xor(am, o)); vm = fmaxf(vm, __shfl_xor(vm, o)); }
          const float uq = am > 0.f ? 127.0f / am : 0.f, vq = vm > 0.f ? 127.0f / vm : 0.f;
          if (F.lane == 0) { usc[row] = am * (1.0f / 127.0f); vsc[row] = vm * (1.0f / 127.0f); }
#pragma unroll
          for (int hh = 0; hh < 2; ++hh) { v4u ou, ov;
#pragma unroll
              for (int q = 0; q < 4; ++q) { unsigned w = 0u, wv = 0u;
#pragma unroll
                  for (int e = 0; e < 4; ++e) { const int qi = (int)rintf(uu[hh][q][e] * uq); w |= ((unsigned)qi & 0xFFu) << (8 * e); const int qv = (int)rintf(vv[hh][q][e] * vq); wv |= ((unsigned)qv & 0xFFu) << (8 * e); }
                  ou[q] = w; ov[q] = wv; }
              *(v4u*)(du + (size_t)row * D + hh * 1024 + F.lane * 16) = ou; *(v4u*)(dv + (size_t)row * D + hh * 1024 + F.lane * 16) = ov; }
      } }
    }
    if (PART == 0) {
    { const float* x = F.in[I_X]; bf16* xb = WSP(bf16, WS_XB); float* rstd = WSP(float, WS_RSTD1);
      for (int m = gw; m < T; m += NGW) { const f32x4* xr = (const f32x4*)(x + (size_t)m * D) + F.lane; f32x4 v[8]; float s = 0.f;
#pragma unroll
          for (int j = 0; j < 8; ++j) { v[j] = xr[64 * j]; s += (v[j][0] * v[j][0] + v[j][1] * v[j][1]) + (v[j][2] * v[j][2] + v[j][3] * v[j][3]); }
          s = wave_sum(s);
          if (F.lane == 0) rstd[m] = 1.0f / sqrtf(s * (1.0f / D) + NORM_EPS);
          v2u* o = (v2u*)(xb + (size_t)m * D) + F.lane;
#pragma unroll
          for (int j = 0; j < 8; ++j) { v2u w; w.x = pk2(v[j][0], v[j][1]); w.y = pk2(v[j][2], v[j][3]); o[64 * j] = w; } } }
    }
}

typedef float f32x2c __attribute__((ext_vector_type(2)));
__device__ __forceinline__ unsigned cvtpk(float lo, float hi) { const f32x2c v = {lo, hi}; const bf16x2_t b = __builtin_convertvector(v, bf16x2_t); return __builtin_bit_cast(unsigned, b); }
__device__ __forceinline__ float rcpf_(float x) { return __builtin_amdgcn_rcpf(x); }
__device__ __forceinline__ float sigmoid_fast(float x) { return rcpf_(1.0f + __expf(-x)); }
__device__ __forceinline__ float tanh_fast(float x) { return 1.0f - 2.0f * rcpf_(1.0f + __expf(2.0f * x)); }
__device__ __forceinline__ float softplus_fast(float z) { return fmaxf(z, 0.f) + __logf(1.0f + __expf(-fabsf(z))); }
__device__ __forceinline__ float gelu_fast(float x) { const float u = 0.7978845608028654f * (x + 0.044715f * x * x * x); return x * rcpf_(1.0f + __expf(-2.0f * u)); }
__device__ __forceinline__ void rwkv_item(const Frame& F, int item) {
    const int b = item >> 4, h = item & 15, wave = F.wave; int tid = F.tid; asm volatile("" : "+v"(tid)); const int lane = tid & 63;
    LAS unsigned char* L = F.lds;
    constexpr int LD64 = 72, LD32 = 40, E0 = 70784;
    LAS bf16* AT = (LAS bf16*)(L + 0);  LAS bf16* BT_ = (LAS bf16*)(L + 4608); LAS bf16* KT_ = (LAS bf16*)(L + 9216); LAS bf16* RT = (LAS bf16*)(L + 13824);
    LAS bf16* BTT = (LAS bf16*)(L + 18432); LAS bf16* KTT = (LAS bf16*)(L + 23552); LAS bf16* VT = (LAS bf16*)(L + 28672);
    LAS bf16* S0B = (LAS bf16*)(L + 33792);
    LAS float* GG = (LAS float*)(L + 52224);
    LAS float* YB = (LAS float*)(L + 60416);
    LAS float* BON = (LAS float*)(L + 69120);
    LAS float* PC = (LAS float*)(L + 69248);
    LAS float* CST = (LAS float*)(L + 69504);
    LAS float* TOT = (LAS float*)(L + E0 + 66048);
    LAS float* RS = (LAS float*)(L + E0);
    LAS float* KS = (LAS float*)(L + E0 + 8192);
    LAS float* LW = (LAS float*)(L + E0 + 16384);
    LAS float* NAU = (LAS float*)(L + E0 + 24576);
    LAS float* BBU = (LAS float*)(L + E0 + 32768);
    LAS bf16* VSB = (LAS bf16*)(L + E0 + 40960);
    LAS float* SSP = (LAS float*)(L + E0 + 45056);
    LAS float* BNP = (LAS float*)(L + E0 + 45568);
    LAS bf16* LAW = (LAS bf16*)(L + E0 + 46080);
    LAS bf16* LAA = (LAS bf16*)(L + E0 + 50688);
    LAS bf16* LAG = (LAS bf16*)(L + E0 + 55296);
    LAS bf16* AAK = (LAS bf16*)(L + E0); LAS bf16* ARB = (LAS bf16*)(L + E0 + 2560); LAS bf16* ARK = (LAS bf16*)(L + E0 + 5120);
    LAS bf16* XB_ = (LAS bf16*)(L + E0 + 7680);
    LAS bf16* XTB = (LAS bf16*)(L + E0 + 12800);
    LAS bf16* PMB = (LAS bf16*)(L + E0 + 17920);
    LAS bf16* RHS = (LAS bf16*)(L + E0 + 23040);
    LAS bf16* SAB = (LAS bf16*)(L + E0 + 28160);
    static_assert(E0 + 66048 + 512 <= LDSCTL_OFF, "rwkv LDS map");
    const bf16* PROJ = WSP(bf16, WS_PROJ); bf16* Y = WSP(bf16, WS_Y);
    const int fr0 = lane & 15, fq0 = lane >> 4;
#define FRAG(base, row0, ld, ks) (*(const LAS bf16x8*)((base) + ((row0) + fr) * (ld) + (ks) * 32 + 8 * fq))
    const int mt = wave >> 2, nt = wave & 3, jc = nt * 16 + fr0;
    const bf16* w2p = WSP(bf16, WS_W2T) + (h * 64 + jc) * 64 + 8 * fq0; const bf16* a2p = WSP(bf16, WS_A2T) + (h * 64 + jc) * 64 + 8 * fq0; const bf16* g2p = WSP(bf16, WS_G2T) + (h * 64 + jc) * 160 + 8 * fq0;
    if (tid < 320) { const int q = tid >> 6, jj = tid & 63; const float* src = q == 0 ? F.in[I_W0] : (q == 1 ? F.in[I_A0] : (q == 2 ? F.in[I_KK] : (q == 3 ? F.in[I_KA] : F.in[I_RK]))); CST[q * 64 + jj] = src[h * 64 + jj]; }
    const int tt = tid >> 4, j0 = (tid & 15) * 4, hc = h * 64 + j0;
    const f32x4 plw = *(const f32x4*)(F.in[I_LNW] + hc), plb = *(const f32x4*)(F.in[I_LNB] + hc);
    const int lcc = tid % 60, ltg = tid / 60; const bool ldr = tid < 480, lrkv = lcc < 24;
    const int pcol = PC_R + (lcc >> 3) * 1024 + h * 64 + (lcc & 7) * 8;
    f32x4 mu0 = (f32x4){0.f, 0.f, 0.f, 0.f}, mu1 = mu0;
    if (ldr && lrkv) { mu0 = *(const f32x4*)(F.in[I_MU] + pcol - RWKV_C0); mu1 = *(const f32x4*)(F.in[I_MU] + pcol - RWKV_C0 + 4); }
    const bf16* LA = WSP(bf16, WS_LA);
    v4u pf[5];
#define RWKV_PREFETCH(tl_) do { if (ldr) { const int t0_ = (tl_) * 32 + 4 * ltg; \
        if (lrkv) { const bf16* pr_ = PROJ + ((size_t)b * SEQ + t0_) * NINP + pcol; \
            pf[0] = (v4u){0u, 0u, 0u, 0u}; if (t0_ > 0) pf[0] = *(const v4u*)(pr_ - NINP); \
            _Pragma("unroll") for (int e_ = 0; e_ < 4; ++e_) pf[1 + e_] = *(const v4u*)(pr_ + (size_t)e_ * NINP); } \
        else { const bf16* pr_ = LA + ((size_t)b * SEQ + t0_) * 288 + (lcc - 24) * 8; \
            _Pragma("unroll") for (int e_ = 0; e_ < 4; ++e_) pf[1 + e_] = *(const v4u*)(pr_ + (size_t)e_ * 288); } } } while (0)
    const int ib = wave >> 1, tb = wave & 1, i0 = ib * 16, t0m = tb * 16;
    f32x4 sacc[2], pmacc, yacc;
    sacc[0] = (f32x4){0.f, 0.f, 0.f, 0.f}; sacc[1] = sacc[0]; pmacc = sacc[0]; yacc = sacc[0];
    for (int u = tid; u < 2 * 64 * LD64 / 2; u += NTHR) ((LAS unsigned*)S0B)[u] = 0u;
    RWKV_PREFETCH(0);
    __syncthreads();
    for (int tl = 0; tl <= SEQ / 32; ++tl) {
        const int cur = tl & 1;
        int lane_c = lane; asm volatile("" : "+v"(lane_c)); const int fr = lane_c & 15, fq = lane_c >> 4;
        if (tl > 0) { const size_t tokb = (size_t)b * SEQ + (tl - 1) * 32;
          const f32x4 y4 = *(const LAS f32x4*)(YB + tt * 68 + j0), g4 = *(const LAS f32x4*)(GG + tt * 64 + j0);
          f32x4 v4;
#pragma unroll
          for (int e = 0; e < 4; ++e) v4[e] = __uint_as_float((unsigned)VT[(j0 + e) * LD32 + tt] << 16);
          float sm = (y4[0] + y4[1]) + (y4[2] + y4[3]); sm = red16(sm); const float mean = sm * (1.0f / 64.0f);
          const f32x4 d4 = y4 - mean; float sv = (d4[0] * d4[0] + d4[1] * d4[1]) + (d4[2] * d4[2] + d4[3] * d4[3]); sv = red16(sv);
          const float rstd = __builtin_amdgcn_rsqf(sv * (1.0f / 64.0f) + GN_EPS), bon = BON[tt];
          f32x4 o;
#pragma unroll
          for (int e = 0; e < 4; ++e) o[e] = (d4[e] * rstd * plw[e] + plb[e] + bon * v4[e]) * g4[e];
          v2u w; w.x = cvtpk(o[0], o[1]); w.y = cvtpk(o[2], o[3]);
          *(v2u*)(Y + (tokb + tt) * D + 1024 + hc) = w; }
        if (tl == SEQ / 32) break;
        const LAS bf16* S0c = S0B + cur * 64 * LD64; LAS bf16* S0n = S0B + (cur ^ 1) * 64 * LD64;
        if (ldr) {
            if (lrkv) { float p[8]; unpack8(pf[0], p);
#pragma unroll
                for (int e4 = 0; e4 < 4; ++e4) { const int t = 4 * ltg + e4; float c[8], ps[8]; unpack8(pf[1 + e4], c);
#pragma unroll
                    for (int e = 0; e < 8; ++e) { ps[e] = c[e] + (p[e] - c[e]) * (e < 4 ? mu0[e] : mu1[e - 4]); p[e] = c[e]; }
                    if (lcc < 16) { LAS float* dst = (lcc < 8 ? RS : KS) + t * 64 + (lcc & 7) * 8;
                        *(LAS f32x4*)dst = (f32x4){ps[0], ps[1], ps[2], ps[3]}; *(LAS f32x4*)(dst + 4) = (f32x4){ps[4], ps[5], ps[6], ps[7]}; }
                    else { v4u w; w.x = cvtpk(ps[0], ps[1]); w.y = cvtpk(ps[2], ps[3]); w.z = cvtpk(ps[4], ps[5]); w.w = cvtpk(ps[6], ps[7]); *(LAS v4u*)(VSB + t * 64 + (lcc & 7) * 8) = w; } } }
            else { const int m = (lcc - 24) * 8; LAS bf16* dst = (m < 64) ? (LAW + m) : ((m < 128) ? (LAA + (m - 64)) : (LAG + (m - 128))); const int ld = (m < 128) ? 72 : 168;
#pragma unroll
                for (int e4 = 0; e4 < 4; ++e4) *(LAS v4u*)(dst + (4 * ltg + e4) * ld) = pf[1 + e4]; }
        }
        if (tl + 1 < SEQ / 32) RWKV_PREFETCH(tl + 1);
        bf16x8 bw[2], ba[2], bg[5];
#pragma unroll
        for (int ks = 0; ks < 2; ++ks) { bw[ks] = *(const bf16x8*)(w2p + ks * 32); ba[ks] = *(const bf16x8*)(a2p + ks * 32); }
#pragma unroll
        for (int ks = 0; ks < 5; ++ks) bg[ks] = *(const bf16x8*)(g2p + ks * 32);
        __syncthreads();
        { f32x4 cw = (f32x4){0.f, 0.f, 0.f, 0.f}, ca = cw, cg = cw;
#pragma unroll
          for (int ks = 0; ks < 2; ++ks) { cw = MFMA16(bw[ks], FRAG(LAW, mt * 16, 72, ks), cw); ca = MFMA16(ba[ks], FRAG(LAA, mt * 16, 72, ks), ca); }
#pragma unroll
          for (int ks = 0; ks < 5; ++ks) cg = MFMA16(bg[ks], FRAG(LAG, mt * 16, 168, ks), cg);
          const int t = mt * 16 + fr, j4 = nt * 16 + fq * 4, o = t * 64 + j4;
          const f32x4 rr = *(const LAS f32x4*)(RS + o), kv = *(const LAS f32x4*)(KS + o);
          const f32x4 c_w0 = *(const LAS f32x4*)(CST + j4), c_a0 = *(const LAS f32x4*)(CST + 64 + j4), c_kk = *(const LAS f32x4*)(CST + 128 + j4), c_ka = *(const LAS f32x4*)(CST + 192 + j4), c_rk = *(const LAS f32x4*)(CST + 256 + j4);
          f32x4 lw, nau, bbu, km; float s2 = 0.f, bn = 0.f;
#pragma unroll
          for (int r = 0; r < 4; ++r) { const float av = sigmoid_fast(c_a0[r] + ca[r]), ku = kv[r] * c_kk[r]; km[r] = kv[r] * (1.0f + (av - 1.0f) * c_ka[r]);
              lw[r] = -0.6065306597126334f * sigmoid_fast(c_w0[r] + cw[r]);
              nau[r] = -ku; bbu[r] = ku * av; s2 += ku * ku; bn += rr[r] * km[r] * c_rk[r]; }
#pragma unroll
          for (int r = 0; r < 4; ++r) { float v = lw[r];
              v += __builtin_bit_cast(float, __builtin_amdgcn_update_dpp(0, __builtin_bit_cast(int, v), 0x111, 0xf, 0xf, true));
              v += __builtin_bit_cast(float, __builtin_amdgcn_update_dpp(0, __builtin_bit_cast(int, v), 0x112, 0xf, 0xf, true));
              v += __builtin_bit_cast(float, __builtin_amdgcn_update_dpp(0, __builtin_bit_cast(int, v), 0x114, 0xf, 0xf, true));
              v += __builtin_bit_cast(float, __builtin_amdgcn_update_dpp(0, __builtin_bit_cast(int, v), 0x118, 0xf, 0xf, true));
              lw[r] = v; }
          *(LAS f32x4*)(LW + o) = lw; *(LAS f32x4*)(NAU + o) = nau; *(LAS f32x4*)(BBU + o) = bbu; *(LAS f32x4*)(KS + o) = km; *(LAS f32x4*)(GG + o) = cg;
          if (fr == 15) *(LAS f32x4*)(TOT + mt * 64 + j4) = lw;
          { auto x = __builtin_amdgcn_permlane16_swap(__float_as_uint(s2), __float_as_uint(s2), false, false); s2 = __uint_as_float(x[0]) + __uint_as_float(x[1]); }
          { auto x = __builtin_amdgcn_permlane32_swap(__float_as_uint(s2), __float_as_uint(s2), false, false); s2 = __uint_as_float(x[0]) + __uint_as_float(x[1]); }
          { auto x = __builtin_amdgcn_permlane16_swap(__float_as_uint(bn), __float_as_uint(bn), false, false); bn = __uint_as_float(x[0]) + __uint_as_float(x[1]); }
          { auto x = __builtin_amdgcn_permlane32_swap(__float_as_uint(bn), __float_as_uint(bn), false, false); bn = __uint_as_float(x[0]) + __uint_as_float(x[1]); }
          if (fq == 0) { SSP[t * 4 + nt] = s2; BNP[t * 4 + nt] = bn; } }
        __syncthreads();
        for (int rp_ = 0; rp_ < ((PROBE_DUP) == 40 ? 2 : 1); ++rp_)
        { const int j = tid & 63, part = wave;
          const float addt = (part >= 4) ? TOT[j] : 0.f;
          float run = addt + (((part & 3) != 0) ? LW[(4 * part - 1) * 64 + j] : 0.f);
          float bt4[4], kt4[4];
          float epp = __expf(run);
#pragma unroll
          for (int e = 0; e < 4; ++e) { const int t = 4 * part + e; run = addt + LW[t * 64 + j];
              const f32x4 sp = *(const LAS f32x4*)(SSP + t * 4); const float inv = __builtin_amdgcn_rsqf(fmaxf((sp[0] + sp[1]) + (sp[2] + sp[3]), 1e-24f));
              const float ep = __expf(run), em = rcpf_(ep), eprev = epp; epp = ep;
              AT[t * LD64 + j] = (bf16)(cvtpk(NAU[t * 64 + j] * inv * eprev, 0.f) & 0xffffu); RT[t * LD64 + j] = (bf16)(cvtpk(RS[t * 64 + j] * ep, 0.f) & 0xffffu);
              bt4[e] = BBU[t * 64 + j] * inv * em; kt4[e] = KS[t * 64 + j] * em;
              BT_[t * LD64 + j] = (bf16)(cvtpk(bt4[e], 0.f) & 0xffffu); KT_[t * LD64 + j] = (bf16)(cvtpk(kt4[e], 0.f) & 0xffffu);
              if (j == 0) { const f32x4 bp = *(const LAS f32x4*)(BNP + t * 4); BON[t] = (bp[0] + bp[1]) + (bp[2] + bp[3]); } }
          v2u w; w.x = cvtpk(bt4[0], bt4[1]); w.y = cvtpk(bt4[2], bt4[3]); *(LAS v2u*)(BTT + j * LD32 + 4 * part) = w;
          w.x = cvtpk(kt4[0], kt4[1]); w.y = cvtpk(kt4[2], kt4[3]); *(LAS v2u*)(KTT + j * LD32 + 4 * part) = w;
          w.x = (unsigned)VSB[(4 * part) * 64 + j] | ((unsigned)VSB[(4 * part + 1) * 64 + j] << 16); w.y = (unsigned)VSB[(4 * part + 2) * 64 + j] | ((unsigned)VSB[(4 * part + 3) * 64 + j] << 16);
          *(LAS v2u*)(VT + j * LD32 + 4 * part) = w;
          if (part == 7) PC[j] = epp; }
        __syncthreads();
        for (int rp_ = 0; rp_ < ((PROBE_DUP) == 41 ? 2 : 1); ++rp_)
        if (wave < 4) { const int tq = (wave >> 1) * 16, sq = (wave & 1) * 16;
#pragma unroll
            for (int mtx = 0; mtx < 3; ++mtx) { const LAS bf16* Xs = (mtx == 1) ? BT_ : KT_; const LAS bf16* Yt = (mtx == 0) ? AT : RT; LAS bf16* O = (mtx == 0) ? AAK : (mtx == 1 ? ARB : ARK);
                f32x4 a4 = (f32x4){0.f, 0.f, 0.f, 0.f};
#pragma unroll
                for (int ks = 0; ks < 2; ++ks) a4 = MFMA16(FRAG(Xs, sq, LD64, ks), FRAG(Yt, tq, LD64, ks), a4);
                const int t = tq + fr, s = sq + fq * 4;
#pragma unroll
                for (int r = 0; r < 4; ++r) { const bool keep = (mtx == 0) ? (s + r < t) : (s + r <= t); a4[r] = keep ? a4[r] : 0.f; }
                v2u w; w.x = cvtpk(a4[0], a4[1]); w.y = cvtpk(a4[2], a4[3]); *(LAS v2u*)(O + t * LD32 + s) = w; } }
        else { const int q = wave - 4, tq = (q >> 1) * 16, sq = (q & 1) * 16;
            f32x4 a4 = (f32x4){0.f, 0.f, 0.f, 0.f};
#pragma unroll
            for (int ks = 0; ks < 2; ++ks) a4 = MFMA16(FRAG(BT_, sq, LD64, ks), FRAG(AT, tq, LD64, ks), a4);
            const int t = tq + fr, s = sq + fq * 4;
#pragma unroll
            for (int r = 0; r < 4; ++r) { a4[r] = (s + r < t) ? a4[r] : 0.f; XTB[(s + r) * LD32 + t] = (bf16)(cvtpk(a4[r], 0.f) & 0xffffu); }
            v2u w; w.x = cvtpk(a4[0], a4[1]); w.y = cvtpk(a4[2], a4[3]); *(LAS v2u*)(XB_ + t * LD32 + s) = w;
#pragma unroll
            for (int r = 0; r < 4; ++r) pmacc[r] = a4[r] + ((s + r == t) ? 1.0f : 0.f);
            w.x = cvtpk(pmacc[0], pmacc[1]); w.y = cvtpk(pmacc[2], pmacc[3]); *(LAS v2u*)(PMB + t * LD32 + s) = w; }
        __syncthreads();
#pragma unroll
        for (int ns = 0; ns < 5; ++ns) { const int cb = ns & 1, nb = cb ^ 1;
            const LAS bf16* Xc = XB_ + cb * 32 * LD32; const LAS bf16* XTc = XTB + cb * 32 * LD32; const LAS bf16* Pc = PMB + cb * 32 * LD32;
            LAS bf16* Xn = XB_ + nb * 32 * LD32; LAS bf16* XTn = XTB + nb * 32 * LD32; LAS bf16* Pn = PMB + nb * 32 * LD32;
            if (wave < 4) { if (ns < 4) { const int tq = (wave >> 1) * 16, sq = (wave & 1) * 16;
                    f32x4 a4 = (f32x4){0.f, 0.f, 0.f, 0.f}; a4 = MFMA16(FRAG(XTc, sq, LD32, 0), FRAG(Xc, tq, LD32, 0), a4);
                    const int t = tq + fr, s = sq + fq * 4;
#pragma unroll
                    for (int r = 0; r < 4; ++r) XTn[(s + r) * LD32 + t] = (bf16)(cvtpk(a4[r], 0.f) & 0xffffu);
                    v2u w; w.x = cvtpk(a4[0], a4[1]); w.y = cvtpk(a4[2], a4[3]); *(LAS v2u*)(Xn + t * LD32 + s) = w; } }
            else { const int q = wave - 4, tq = (q >> 1) * 16, sq = (q & 1) * 16;
                if (ns > 0) pmacc = MFMA16(FRAG(XTc, sq, LD32, 0), FRAG(Pc, tq, LD32, 0), pmacc);
                const int t = tq + fr, s = sq + fq * 4;
                v2u w; w.x = cvtpk(pmacc[0], pmacc[1]); w.y = cvtpk(pmacc[2], pmacc[3]); *(LAS v2u*)(Pn + t * LD32 + s) = w; }
            if (ns == 1) {
                f32x4 a4 = (f32x4){0.f, 0.f, 0.f, 0.f};
#pragma unroll
                for (int ks = 0; ks < 2; ++ks) a4 = MFMA16(FRAG(AT, t0m, LD64, ks), FRAG(S0c, i0, LD64, ks), a4);
                a4 = MFMA16(FRAG(AAK, t0m, LD32, 0), FRAG(VT, i0, LD32, 0), a4);
                v2u w; w.x = cvtpk(a4[0], a4[1]); w.y = cvtpk(a4[2], a4[3]); *(LAS v2u*)(RHS + (i0 + fr) * LD32 + t0m + fq * 4) = w; }
            if (ns == 2) {
                yacc = (f32x4){0.f, 0.f, 0.f, 0.f};
#pragma unroll
                for (int ks = 0; ks < 2; ++ks) yacc = MFMA16(FRAG(S0c, i0, LD64, ks), FRAG(RT, t0m, LD64, ks), yacc);
                yacc = MFMA16(FRAG(VT, i0, LD32, 0), FRAG(ARK, t0m, LD32, 0), yacc); }
            if (ns == 3) {
#pragma unroll
                for (int u = 0; u < 2; ++u) { const int tile = wave * 2 + u, si0 = (tile >> 2) * 16, sj0 = (tile & 3) * 16; sacc[u] = MFMA16(FRAG(KTT, sj0, LD32, 0), FRAG(VT, si0, LD32, 0), sacc[u]); } }
            __syncthreads();
        }
        const LAS bf16* MINV = PMB + 1 * 32 * LD32;
        { f32x4 a4 = (f32x4){0.f, 0.f, 0.f, 0.f}; a4 = MFMA16(FRAG(MINV, t0m, LD32, 0), FRAG(RHS, i0, LD32, 0), a4);
          v2u w; w.x = cvtpk(a4[0], a4[1]); w.y = cvtpk(a4[2], a4[3]); *(LAS v2u*)(SAB + (i0 + fr) * LD32 + t0m + fq * 4) = w; }
        __syncthreads();
        { yacc = MFMA16(FRAG(SAB, i0, LD32, 0), FRAG(ARB, t0m, LD32, 0), yacc);
          *(LAS f32x4*)(YB + (t0m + fr) * 68 + i0 + fq * 4) = yacc;
#pragma unroll
          for (int u = 0; u < 2; ++u) { const int tile = wave * 2 + u, si0 = (tile >> 2) * 16, sj0 = (tile & 3) * 16;
              sacc[u] = MFMA16(FRAG(BTT, sj0, LD32, 0), FRAG(SAB, si0, LD32, 0), sacc[u]);
              const f32x4 pc = *(const LAS f32x4*)(PC + sj0 + fq * 4); sacc[u] = sacc[u] * pc;
              v2u w; w.x = cvtpk(sacc[u][0], sacc[u][1]); w.y = cvtpk(sacc[u][2], sacc[u][3]); *(LAS v2u*)(S0n + (si0 + fr) * LD64 + sj0 + fq * 4) = w; } }
        __syncthreads();
    }
    __syncthreads();
#undef FRAG
#undef RWKV_PREFETCH
}
__device__ __forceinline__ void lora_prepass(const Frame& F) {
    const bf16* PROJ = WSP(bf16, WS_PROJ); bf16* LA = WSP(bf16, WS_LA); const float* mu = F.in[I_MU] + (PC_WD - RWKV_C0);
    const int gt = (F.bid * NWAVES + F.wave) * 64 + F.lane, NGT = F.G * NTHR;
    for (int i = gt; i < T * 36; i += NGT) { const int tok = i / 36, cc = i - tok * 36, m = cc * 8;
        const bf16* pr = PROJ + (size_t)tok * NINP + PC_WD + m;
        const v4u curv = *(const v4u*)pr; v4u prv = (v4u){0u, 0u, 0u, 0u}; if ((tok & (SEQ - 1)) != 0) prv = *(const v4u*)(pr - NINP);
        const f32x4 m0 = *(const f32x4*)(mu + m), m1 = *(const f32x4*)(mu + m + 4);
        float c[8], p[8], o[8]; unpack8(curv, c); unpack8(prv, p);
#pragma unroll
        for (int e = 0; e < 8; ++e) { const float ps = c[e] + (p[e] - c[e]) * (e < 4 ? m0[e] : m1[e - 4]); o[e] = (m < 64) ? tanh_fast(ps) : ((m < 128) ? ps : sigmoid_fast(ps)); }
        v4u w; w.x = cvtpk(o[0], o[1]); w.y = cvtpk(o[2], o[3]); w.z = cvtpk(o[4], o[5]); w.w = cvtpk(o[6], o[7]);
        *(v4u*)(LA + (size_t)tok * 288 + m) = w; }
}
__device__ __forceinline__ void lru_seq(const Frame& F, int bh) {
    const int b = bh >> 3, h = bh & 7, wave = F.wave; int tid = F.tid; asm volatile("" : "+v"(tid)); const int lane = tid & 63;
    LAS unsigned char* L = F.lds;
    LAS bf16* XA = (LAS bf16*)(L + 0);
    LAS float* XC = (LAS float*)(L + 17408);
    LAS float* RI = (LAS float*)(L + 50176);
    LAS float* SEG = (LAS float*)(L + 115712);
    LAS float* CARRY = (LAS float*)(L + 119808);
    LAS float* CW = (LAS float*)(L + 120320);
    const bf16* PROJ = WSP(bf16, WS_PROJ); bf16* Y = WSP(bf16, WS_Y);
    const int fr0 = lane & 15, fq0 = lane >> 4;
    for (int i = tid; i < 640; i += NTHR) { const int w = i >> 7, cch = i & 127; CW[i] = (w < 4) ? F.in[I_CONVW][w * 1024 + h * 128 + cch] : F.in[I_CONVB][h * 128 + cch]; }
    if (tid < 128) CARRY[tid] = 0.f;
    const int gsel = wave & 1, nt0 = (wave >> 1) * 2;
    bf16x8 wf[2][4];
    { const bf16* WTp = (gsel ? WSP(bf16, WS_WIT) : WSP(bf16, WS_WAT)) + (size_t)h * 128 * 128;
#pragma unroll
      for (int n = 0; n < 2; ++n)
#pragma unroll
          for (int ks = 0; ks < 4; ++ks) wf[n][ks] = *(const bf16x8*)(WTp + ((nt0 + n) * 16 + fr0) * 128 + ks * 32 + 8 * fq0); }
    const int c = tid & 127, sg = tid >> 7, chg = h * 128 + c;
    const float ba_c = F.in[I_BA][chg], bi_c = F.in[I_BI][chg], sp8 = 8.0f * softplus_fast(-F.in[I_LAM][chg]);
    v4u pf[2][4];
#define LRU_PREFETCH(k_) do { _Pragma("unroll") for (int u_ = 0; u_ < 2; ++u_) { const int chn_ = tid + NTHR * u_, t_ = chn_ >> 4, c8_ = (chn_ & 15) * 8; \
        _Pragma("unroll") for (int w_ = 0; w_ < 4; ++w_) { const int ts_ = (k_) * 64 + t_ - 3 + w_; pf[u_][w_] = (v4u){0u, 0u, 0u, 0u}; \
            if (ts_ >= 0) pf[u_][w_] = *(const v4u*)(PROJ + ((size_t)b * SEQ + ts_) * NINP + h * 128 + c8_); } } } while (0)
    LRU_PREFETCH(0);
    __syncthreads();
    for (int k = 0; k < SEQ / 64; ++k) {
        const size_t tokbase = (size_t)b * SEQ + k * 64;
        int lane_c = lane; asm volatile("" : "+v"(lane_c)); const int fr = lane_c & 15, fq = lane_c >> 4;
#pragma unroll
        for (int u = 0; u < 2; ++u) { const int chn = tid + NTHR * u, t = chn >> 4, c8 = (chn & 15) * 8;
            float acc[8]; { const f32x4 b0 = *(const LAS f32x4*)(CW + 512 + c8), b1 = *(const LAS f32x4*)(CW + 512 + c8 + 4);
#pragma unroll
                for (int e = 0; e < 4; ++e) { acc[e] = b0[e]; acc[e + 4] = b1[e]; } }
#pragma unroll
            for (int w = 0; w < 4; ++w) { float xf[8]; unpack8(pf[u][w], xf);
                const f32x4 w0 = *(const LAS f32x4*)(CW + w * 128 + c8), w1 = *(const LAS f32x4*)(CW + w * 128 + c8 + 4);
#pragma unroll
                for (int e = 0; e < 4; ++e) { acc[e] += w0[e] * xf[e]; acc[e + 4] += w1[e] * xf[e + 4]; } }
            v4u pk; pk.x = cvtpk(acc[0], acc[1]); pk.y = cvtpk(acc[2], acc[3]); pk.z = cvtpk(acc[4], acc[5]); pk.w = cvtpk(acc[6], acc[7]);
            *(LAS v4u*)(XA + t * 136 + c8) = pk;
            LAS float* d = XC + t * 128 + c8; *(LAS f32x4*)d = (f32x4){acc[0], acc[1], acc[2], acc[3]}; *(LAS f32x4*)(d + 4) = (f32x4){acc[4], acc[5], acc[6], acc[7]}; }
        if (k + 1 < SEQ / 64) LRU_PREFETCH(k + 1);
        unsigned short gt[16];
#pragma unroll
        for (int e = 0; e < 16; ++e) gt[e] = PROJ[(tokbase + sg * 16 + e) * NINP + PC_GATE + chg];
        __syncthreads();
#pragma unroll
        for (int mt = 0; mt < 4; ++mt) {
            bf16x8 af[4];
#pragma unroll
            for (int ks = 0; ks < 4; ++ks) af[ks] = *(const LAS bf16x8*)(XA + (mt * 16 + fr) * 136 + ks * 32 + 8 * fq);
#pragma unroll
            for (int n = 0; n < 2; ++n) { f32x4 a4 = (f32x4){0.f, 0.f, 0.f, 0.f};
#pragma unroll
                for (int ks = 0; ks < 4; ++ks) a4 = MFMA16(wf[n][ks], af[ks], a4);
                *(LAS f32x4*)(RI + gsel * 8192 + (mt * 16 + fr) * 128 + (nt0 + n) * 16 + fq * 4) = a4; } }
        __syncthreads();
        float av[16], bx[16]; float A = 1.f, B = 0.f;
#pragma unroll
        for (int e = 0; e < 16; ++e) { const int t = sg * 16 + e; const float r = sigmoid_fast(RI[t * 128 + c] + ba_c), ig = sigmoid_fast(RI[8192 + t * 128 + c] + bi_c), xc = XC[t * 128 + c];
            const float la = -sp8 * r; av[e] = __expf(la); bx[e] = sqrtf(fmaxf(1.0f - av[e] * av[e], 0.f)) * (ig * xc); A *= av[e]; B = av[e] * B + bx[e]; }
        SEG[(sg * 128 + c) * 2] = A; SEG[(sg * 128 + c) * 2 + 1] = B;
        __syncthreads();
        float hst = CARRY[c];
        for (int s2 = 0; s2 < sg; ++s2) hst = SEG[(s2 * 128 + c) * 2] * hst + SEG[(s2 * 128 + c) * 2 + 1];
#pragma unroll
        for (int e = 0; e < 16; ++e) { hst = av[e] * hst + bx[e];
            const float g = __uint_as_float((unsigned)gt[e] << 16);
            Y[(tokbase + sg * 16 + e) * D + chg] = (bf16)(cvtpk(hst * gelu_fast(g), 0.f) & 0xffffu); }
        __syncthreads();
        if (sg == 3) CARRY[c] = hst;
    }
    __syncthreads();
#undef LRU_PREFETCH
}
__device__ __forceinline__ void group_barrier(unsigned* cnt, unsigned n) {
    asm volatile("s_waitcnt vmcnt(0)" ::: "memory");
    __syncthreads();
    if (threadIdx.x == 0) {
        __builtin_amdgcn_fence(__ATOMIC_RELEASE, "agent");
        asm volatile("s_waitcnt vmcnt(0)" ::: "memory");
        xb_add(cnt, 1u);
        unsigned sp = 0; while (xb_ld(cnt) < n) { __builtin_amdgcn_s_sleep(2); if (++sp > (1u << 24)) break; }
        __builtin_amdgcn_fence(__ATOMIC_ACQUIRE, "agent");
        asm volatile("s_waitcnt vmcnt(0)" ::: "memory");
    }
    __syncthreads();
}

__device__ __forceinline__ unsigned f2ord(float f) { const unsigned u = __builtin_bit_cast(unsigned, f); return (u & 0x80000000u) ? ~u : (u | 0x80000000u); }
__device__ __forceinline__ float ord2f(unsigned o) { const unsigned u = (o & 0x80000000u) ? (o & 0x7fffffffu) : ~o; return __builtin_bit_cast(float, u); }
#define CMPX(hi_, lo_) do { const unsigned _a = (hi_), _b = (lo_); (hi_) = _a > _b ? _a : _b; (lo_) = _a > _b ? _b : _a; } while (0)
template <int N> __device__ __forceinline__ void sort_desc(unsigned (&a)[N]) {
#pragma unroll
    for (int k = 2; k <= N; k <<= 1)
#pragma unroll
        for (int j = k >> 1; j > 0; j >>= 1)
#pragma unroll
            for (int i = 0; i < N; ++i) { const int l = i ^ j; if (l > i) { if ((i & k) == 0) CMPX(a[i], a[l]); else CMPX(a[l], a[i]); } }
}
__device__ __forceinline__ void merge16(unsigned (&A)[16], const unsigned (&B)[16]) {
#pragma unroll
    for (int i = 0; i < 16; ++i) { const unsigned q = B[15 - i]; A[i] = A[i] > q ? A[i] : q; }
#pragma unroll
    for (int d = 8; d >= 1; d >>= 1)
#pragma unroll
        for (int i = 0; i < 16; ++i) if ((i & d) == 0) CMPX(A[i], A[i + d]);
}
__device__ __forceinline__ void merge_partner(unsigned (&Lk)[16]) {
    unsigned P[16];
#pragma unroll
    for (int i = 0; i < 16; ++i) P[i] = (unsigned)__shfl_xor((int)Lk[i], 32);
#pragma unroll
    for (int i = 0; i < 16; ++i) { const unsigned q = P[15 - i]; Lk[i] = Lk[i] > q ? Lk[i] : q; }
#pragma unroll
    for (int d = 8; d >= 1; d >>= 1)
#pragma unroll
        for (int i = 0; i < 16; ++i) if ((i & d) == 0) CMPX(Lk[i], Lk[i + d]);
}
__device__ __forceinline__ void route_item(const Frame& F, int item, int lane) {
    const int tok0 = (item >> 3) * 32, h = item & 7, c = lane & 31, hi = lane >> 5;
    const bf16* Q = WSP(bf16, WS_Q); const bf16* KB = WSP(bf16, WS_KEYS);
    LAS unsigned* WL = (LAS unsigned*)(F.lds + F.wave * 8192);
    unsigned LST[2][16];
#pragma unroll
    for (int p = 0; p < 2; ++p) {
        bf16x8 qf[8];
#pragma unroll
        for (int ks = 0; ks < 8; ++ks) qf[ks] = *(const bf16x8*)(Q + (size_t)(tok0 + c) * D + h * 256 + p * 128 + ks * 16 + 8 * hi);
        unsigned Lk[16];
#pragma unroll 1
        for (int m = 0; m < 4; ++m) {
            f32x16 acc;
#pragma unroll
            for (int r = 0; r < 16; ++r) acc[r] = 0.f;
            const bf16* kp = KB + (size_t)((h * 2 + p) * 128 + m * 32 + c) * 128 + 8 * hi;
#pragma unroll
            for (int ks = 0; ks < 8; ++ks) { const bf16x8 kf = *(const bf16x8*)(kp + ks * 16); acc = MFMA32(kf, qf[ks], acc); }
            unsigned G16[16];
#pragma unroll
            for (int r = 0; r < 16; ++r) { const unsigned idx = (unsigned)(m * 32 + (r & 3) + 8 * (r >> 2)) | ((unsigned)hi << 2); G16[r] = (f2ord(acc[r]) & ~0x7Fu) | idx; }
            sort_desc<16>(G16);
            if (m == 0) {
#pragma unroll
                for (int i = 0; i < 16; ++i) Lk[i] = G16[i]; }
            else merge16(Lk, G16);
        }
        merge_partner(Lk);
#pragma unroll
        for (int i = 0; i < 16; ++i) { LST[p][i] = Lk[i]; WL[(p * 16 + i) * 64 + lane] = Lk[i] & 0x7Fu; }
    }
    float va[4], vb[16];
#pragma unroll
    for (int i = 0; i < 4; ++i) va[i] = ord2f((hi ? LST[1][i] : LST[0][i]) & ~0x7Fu);
#pragma unroll
    for (int j = 0; j < 16; ++j) vb[j] = ord2f((hi ? LST[0][j] : LST[1][j]) & ~0x7Fu);
    unsigned C32[32];
#pragma unroll
    for (int i = 0; i < 32; ++i) C32[i] = 0u;
#pragma unroll
    for (int i = 0; i < 4; ++i) { const unsigned key = (f2ord(va[i] + vb[i]) & ~0xFFu) | (unsigned)(i * 17); C32[i] = hi ? 0u : key; }
    { int cn = 4;
#pragma unroll
      for (int i = 0; i < 3; ++i)
#pragma unroll
          for (int j = i + 1; j < 16; ++j) if ((i + 1) * (j + 1) <= 16) { const unsigned code = hi ? (unsigned)(j * 16 + i) : (unsigned)(i * 16 + j); C32[cn] = (f2ord(va[i] + vb[j]) & ~0xFFu) | code; ++cn; } }
    sort_desc<32>(C32);
    unsigned Ck[16];
#pragma unroll
    for (int i = 0; i < 16; ++i) Ck[i] = C32[i];
    merge_partner(Ck);
    const float mx = ord2f(Ck[0] & ~0xFFu); float den = 0.f;
#pragma unroll
    for (int k = 0; k < 16; ++k) den += __expf(ord2f(Ck[k] & ~0xFFu) - mx);
    const float rden = 1.0f / den;
    int eo[8]; float go[8];
#pragma unroll
    for (int k = 0; k < 8; ++k) { const unsigned fm = hi ? Ck[k + 8] : Ck[k]; const unsigned code = fm & 0xFFu;
        const unsigned k0 = WL[(code >> 4) * 64 + lane], k1 = WL[(16 + (code & 15u)) * 64 + lane];
        eo[k] = (int)(k0 * 128u + k1); go[k] = __expf(ord2f(fm & ~0xFFu) - mx) * rden; }
    int* ep = WSP(int, WS_EXP) + (size_t)(tok0 + c) * NSEL + h * 16 + hi * 8; float* gp = WSP(float, WS_GATE) + (size_t)(tok0 + c) * NSEL + h * 16 + hi * 8;
    *(int4*)ep = make_int4(eo[0], eo[1], eo[2], eo[3]); *(int4*)(ep + 4) = make_int4(eo[4], eo[5], eo[6], eo[7]);
    *(f32x4*)gp = (f32x4){go[0], go[1], go[2], go[3]}; *(f32x4*)(gp + 4) = (f32x4){go[4], go[5], go[6], go[7]};
}

typedef float f32x2 __attribute__((ext_vector_type(2)));
__device__ __forceinline__ int dot4i(unsigned a, unsigned b, int c) { return __builtin_amdgcn_sdot4((int)a, (int)b, c, false); }
template <int CTRL> __device__ __forceinline__ int dppi(int x) { return __builtin_amdgcn_mov_dpp(x, CTRL, 0xf, 0xf, true); }
struct PeerGeom { int ngrp, g, rank, nrank; };
__device__ __forceinline__ PeerGeom peer_geom(const Frame& F) { PeerGeom p; p.ngrp = (F.G % 8 == 0) ? 8 : 1; p.g = F.bid % p.ngrp; p.rank = F.bid / p.ngrp; p.nrank = F.G / p.ngrp; return p; }
__device__ __forceinline__ void xquant_token(const Frame& F, int tok, int lane) {
    const bf16* xr = WSP(bf16, WS_XB) + (size_t)tok * D + lane * 16; float xf[32]; float am = 0.f;
#pragma unroll
    for (int hh = 0; hh < 2; ++hh)
#pragma unroll
        for (int q = 0; q < 2; ++q) { const v4u w = *(const v4u*)(xr + hh * 1024 + q * 8); float t8[8]; unpack8(w, t8);
#pragma unroll
            for (int e = 0; e < 8; ++e) { xf[hh * 16 + q * 8 + e] = t8[e]; am = fmaxf(am, fabsf(t8[e])); } }
#pragma unroll
    for (int o = 1; o < 64; o <<= 1) am = fmaxf(am, __shfl_xor(am, o));
    const float qs = am > 0.f ? 127.0f / am : 0.f;
    if (lane == 0) WSP(float, WS_SX)[tok] = am * (1.0f / 127.0f);
#pragma unroll
    for (int hh = 0; hh < 2; ++hh) { v4u o;
#pragma unroll
        for (int d = 0; d < 4; ++d) { unsigned w = 0u;
#pragma unroll
            for (int e = 0; e < 4; ++e) { const int qi = (int)rintf(xf[hh * 16 + d * 4 + e] * qs); w |= ((unsigned)qi & 0xFFu) << (8 * e); }
            o[d] = w; }
        *(v4u*)(WSP(unsigned char, WS_XQ) + (size_t)tok * D + hh * 1024 + lane * 16) = o; }
}
__device__ __forceinline__ void peer_score_slice(const Frame& F, int tok, int slice, int lane, LAS int* wl) {
    const int e8 = lane >> 3, c16 = lane & 7;
    const int* ep = WSP(int, WS_EXP) + (size_t)tok * NSEL;
    wl[lane] = ep[lane]; wl[64 + lane] = ep[64 + lane];
    const v4u xs = *(const v4u*)(WSP(unsigned char, WS_XQ) + (size_t)tok * D + slice * 128 + c16 * 16);
    const unsigned char* ub = WSP(unsigned char, WS_UT); const unsigned lo = (unsigned)(slice * 128 + c16 * 16);
    int p[16];
#pragma unroll
    for (int ld = 0; ld < 16; ++ld) { const unsigned eid = (unsigned)wl[e8 * 16 + ld]; const v4u w = *(const v4u*)(ub + (eid * 2048u + lo));
        int a = dot4i(w.x, xs.x, 0); a = dot4i(w.y, xs.y, a); a = dot4i(w.z, xs.z, a); p[ld] = dot4i(w.w, xs.w, a); }
    { const bool up = (lane & 4) != 0;
#pragma unroll
      for (int k = 0; k < 8; ++k) { const int keep = up ? p[k + 8] : p[k], send = up ? p[k] : p[k + 8]; p[k] = keep + dppi<0x141>(send); } }
    { const bool up = (lane & 2) != 0;
#pragma unroll
      for (int k = 0; k < 4; ++k) { const int keep = up ? p[k + 4] : p[k], send = up ? p[k] : p[k + 4]; p[k] = keep + dppi<0x4E>(send); } }
    { const bool up = (lane & 1) != 0;
#pragma unroll
      for (int k = 0; k < 2; ++k) { const int keep = up ? p[k + 2] : p[k], send = up ? p[k] : p[k + 2]; p[k] = keep + dppi<0xB1>(send); } }
    int* dst = WSP(int, WS_PART) + ((size_t)slice * T + tok) * NSEL + lane * 2;
    *(int2*)dst = make_int2(p[0], p[1]);
}
__device__ __forceinline__ void peer_coef_token(const Frame& F, int tok, int lane) {
    int s0 = 0, s1 = 0;
#pragma unroll
    for (int s = 0; s < 16; ++s) { const int2 v = *(const int2*)(WSP(int, WS_PART) + ((size_t)s * T + tok) * NSEL + lane * 2); s0 += v.x; s1 += v.y; }
    const int2 ex = *(const int2*)(WSP(int, WS_EXP) + (size_t)tok * NSEL + lane * 2); const f32x2 ga = *(const f32x2*)(WSP(float, WS_GATE) + (size_t)tok * NSEL + lane * 2);
    const float rs = WSP(float, WS_SX)[tok] * (1.0f / sqrtf(WSP(float, WS_SSQ2)[tok] * (1.0f / D) + NORM_EPS));
    const float sc0 = (float)s0 * WSP(float, WS_USC)[ex.x] * rs, sc1 = (float)s1 * WSP(float, WS_USC)[ex.y] * rs;
    f32x2 c; c.x = ga.x * gelu_fast(sc0) * WSP(float, WS_VSC)[ex.x]; c.y = ga.y * gelu_fast(sc1) * WSP(float, WS_VSC)[ex.y];
    float cm = fmaxf(fabsf(c.x), fabsf(c.y));
#pragma unroll
    for (int o = 1; o < 64; o <<= 1) cm = fmaxf(cm, __shfl_xor(cm, o));
    const float qs = cm > 0.f ? 127.0f / cm : 0.f;
    const int q0 = (int)rintf(c.x * qs), q1 = (int)rintf(c.y * qs);
    ((unsigned short*)(F.ws + WS_COEF))[(size_t)tok * 64 + lane] = (unsigned short)(((unsigned)q0 & 0xFFu) | (((unsigned)q1 & 0xFFu) << 8));
    if (lane == 0) WSP(float, WS_CSC)[tok] = cm * (1.0f / 127.0f);
}
struct PeerOutBuf { v4u w[16]; v4u cq; f32x2 x; float cs; };
__device__ __forceinline__ void peer_out_issue(const Frame& F, int tok, int slice, int lane, LAS int* wl, PeerOutBuf& B) {
    const int e8 = lane >> 3, c16 = lane & 7;
    const int* ep = WSP(int, WS_EXP) + (size_t)tok * NSEL;
    wl[lane] = ep[lane]; wl[64 + lane] = ep[64 + lane];
    B.cq = *(const v4u*)(F.ws + WS_COEF + (size_t)tok * 128 + e8 * 16);
    B.cs = WSP(float, WS_CSC)[tok];
    const unsigned char* vb = WSP(unsigned char, WS_VT); const unsigned lofs = (unsigned)(slice * 128 + c16 * 16);
#pragma unroll
    for (int ld = 0; ld < 16; ++ld) { const unsigned eid = (unsigned)wl[e8 * 16 + ld]; B.w[ld] = *(const v4u*)(vb + (eid * 2048u + lofs)); }
    B.x = *(const f32x2*)(F.out + (size_t)tok * D + slice * 128 + c16 * 16 + e8 * 2);
}
__device__ __forceinline__ void peer_out_consume(const Frame& F, int tok, int slice, int lane, LAS int* wl, const PeerOutBuf& B) {
    const int e8 = lane >> 3, c16 = lane & 7;
    int o[16];
#pragma unroll
    for (int i = 0; i < 16; ++i) o[i] = 0;
#pragma unroll
    for (int g = 0; g < 4; ++g) { const unsigned cq = B.cq[g];
#pragma unroll
        for (int d = 0; d < 4; ++d) { const unsigned w0 = B.w[4 * g][d], w1 = B.w[4 * g + 1][d], w2 = B.w[4 * g + 2][d], w3 = B.w[4 * g + 3][d];
            const unsigned lo01 = __builtin_amdgcn_perm(w1, w0, 0x05010400u), hi01 = __builtin_amdgcn_perm(w1, w0, 0x07030602u);
            const unsigned lo23 = __builtin_amdgcn_perm(w3, w2, 0x05010400u), hi23 = __builtin_amdgcn_perm(w3, w2, 0x07030602u);
            const unsigned t0 = __builtin_amdgcn_perm(lo23, lo01, 0x05040100u), t1 = __builtin_amdgcn_perm(lo23, lo01, 0x07060302u);
            const unsigned t2 = __builtin_amdgcn_perm(hi23, hi01, 0x05040100u), t3 = __builtin_amdgcn_perm(hi23, hi01, 0x07060302u);
            o[d * 4 + 0] = dot4i(t0, cq, o[d * 4 + 0]); o[d * 4 + 1] = dot4i(t1, cq, o[d * 4 + 1]); o[d * 4 + 2] = dot4i(t2, cq, o[d * 4 + 2]); o[d * 4 + 3] = dot4i(t3, cq, o[d * 4 + 3]); } }
#pragma unroll
    for (int k = 0; k < 8; ++k) { auto s = __builtin_amdgcn_permlane32_swap((unsigned)o[k], (unsigned)o[k + 8], false, false); o[k] = (int)(s[0] + s[1]); }
#pragma unroll
    for (int k = 0; k < 4; ++k) { auto s = __builtin_amdgcn_permlane16_swap((unsigned)o[k], (unsigned)o[k + 4], false, false); o[k] = (int)(s[0] + s[1]); }
    { const bool up = (lane & 8) != 0;
#pragma unroll
      for (int k = 0; k < 2; ++k) { const int keep = up ? o[k + 2] : o[k], send = up ? o[k] : o[k + 2]; o[k] = keep + dppi<0x128>(send); } }
    f32x2 x = B.x; x.x += (float)o[0] * B.cs; x.y += (float)o[1] * B.cs;
    *(f32x2*)(F.out + (size_t)tok * D + slice * 128 + c16 * 16 + e8 * 2) = x;
    float ss = x.x * x.x + x.y * x.y;
    ss += dppf<0xB1>(ss); ss += dppf<0x4E>(ss); ss += dppf<0x141>(ss); ss += dppf<0x140>(ss);
    { auto s = __builtin_amdgcn_permlane16_swap(__float_as_uint(ss), __float_as_uint(ss), false, false); ss = __uint_as_float(s[0]) + __uint_as_float(s[1]); }
    { auto s = __builtin_amdgcn_permlane32_swap(__float_as_uint(ss), __float_as_uint(ss), false, false); ss = __uint_as_float(s[0]) + __uint_as_float(s[1]); }
    if (lane == 0) atomicAdd(WSP(float, WS_SSQ3) + tok, ss);
}
__device__ __forceinline__ void peer_out_phase(const Frame& F, const PeerGeom& pg, LAS int* wl2) {
    const int lane = F.lane, first = pg.rank * NWAVES + F.wave, step = pg.nrank * NWAVES;
    LAS int* wlA = wl2; LAS int* wlB = wl2 + 256;
    for (int r = 0; r < 16 / pg.ngrp; ++r) { const int slice = r * pg.ngrp + pg.g;
        PeerOutBuf A, B;
        int tok = first;
        if (tok < T) peer_out_issue(F, tok, slice, lane, wlA, A);
        while (tok < T) {
            const int t1 = tok + step, t2 = tok + 2 * step;
            if (t1 < T) peer_out_issue(F, t1, slice, lane, wlB, B);
            peer_out_consume(F, tok, slice, lane, wlA, A);
            if (t1 >= T) break;
            if (t2 < T) peer_out_issue(F, t2, slice, lane, wlA, A);
            peer_out_consume(F, t1, slice, lane, wlB, B);
            tok = t2;
        }
    }
}
__device__ __forceinline__ void final_norm_token(const Frame& F, int tok, int lane) {
    f32x4* xo = (f32x4*)(F.out + (size_t)tok * D) + lane; const f32x4* gf = (const f32x4*)F.in[I_GF] + lane;
    const float rs = 1.0f / sqrtf(WSP(float, WS_SSQ3)[tok] * (1.0f / D) + NORM_EPS);
    f32x4 v[8];
#pragma unroll
    for (int j = 0; j < 8; ++j) v[j] = xo[64 * j];
#pragma unroll
    for (int j = 0; j < 8; ++j) xo[64 * j] = v[j] * rs * gf[64 * j];
}

struct Args { const float* in[28]; float* out; unsigned char* ws; int ph_lo, ph_hi, li, pad; };
__global__ void __launch_bounds__(NTHR, 2) hybrid_fwd(Args args) {
    extern __shared__ __attribute__((aligned(16))) unsigned char lds[];
    Frame F;
    F.lds = (LAS unsigned char*)lds;
    F.tid = threadIdx.x; F.lane = F.tid & 63; F.wave = __builtin_amdgcn_readfirstlane(F.tid >> 6);
    F.G = gridDim.x; F.bid = blockIdx.x;
#pragma unroll
    for (int i = 0; i < 28; ++i) F.in[i] = args.in[i];
    F.out = args.out; F.ws = args.ws;
    volatile LAS unsigned* MISC = (volatile LAS unsigned*)(F.lds + MISC_OFF);
    for (int u = F.tid; u < (LDS_BYTES - LDSCTL_OFF) / 4; u += NTHR) ((LAS unsigned*)(F.lds + LDSCTL_OFF))[u] = 0u;
    __syncthreads();
    unsigned* barw = (unsigned*)(F.ws + WS_CTL) + CW_BAR;
    XcdBarrier bar; bar.bar = barw; bar.x = 0; bar.st = nullptr;
    if (N_LAUNCHES == 1) bar = xcd_barrier_post(barw, MISC + 8);
    const int lo = args.ph_lo, hi = args.ph_hi;
#define IN(k) (lo <= (k) && (k) < hi)
#define SEAM(k) do { if (IN(k) && IN((k) + 1)) xcd_barrier(bar); } while (0)

#ifndef PROBE_DUP
#define PROBE_DUP -1
#endif
#define REPS(k) for (int rep_ = 0; rep_ < ((PROBE_DUP) == (k) ? 2 : 1); ++rep_)
    if (IN(0)) REPS(0) { p0_prologue<0>(F, F.bid, F.G); __syncthreads(); }
    SEAM(0);
    if (IN(1)) REPS(1) {
        pg8::Gemm g{WSP(const bf16, WS_XB), WSP(const bf16, WS_WIN), T, NINP, D}; pg8::StaticOrder S; S.init(T, NINP, F.G, F.bid);
        pg8::EpiRowScaleBf16<0> E{WSP(bf16, WS_PROJ), NINP, WSP(const float, WS_RSTD1), NORM_EPS};
        pg8::gemm_phase<pg8::EpiRowScaleBf16<0>, pg8::StaticOrder, true, true>(F.lds, g, S, E);
    }
    SEAM(1);
    if (IN(2)) REPS(2) {
        lora_prepass(F);
        group_barrier((unsigned*)(F.ws + WS_CTL) + CW_PREBAR, (unsigned)F.G);
        const int R1 = F.G >= 256 ? 128 : F.G, L0 = F.G >= 256 ? 128 : 0, NL = F.G - L0;
        if (F.bid < R1) for (int it = F.bid; it < 128; it += R1) rwkv_item(F, it);
        if (F.bid >= L0) {
            for (int it = F.bid - L0; it < 64; it += NL) lru_seq(F, it);
            for (int r3 = 0; r3 < ((PROBE_DUP) == 30 ? 2 : 1); ++r3) { p0_prologue<1>(F, F.bid - L0, NL); __syncthreads(); }
        }
    }
    SEAM(2);
    if (IN(3)) {
        pg8::Gemm g{WSP(const bf16, WS_Y), WSP(const bf16, WS_WOUT), T, D, D}; pg8::StaticOrder S; S.init(T, D, F.G, F.bid);
        pg8::EpiResidual E{F.in[I_X], F.out, WSP(bf16, WS_XB), WSP(float, WS_SSQ2), D};
        pg8::gemm_phase<pg8::EpiResidual, pg8::StaticOrder, true, true>(F.lds, g, S, E);
    }
    SEAM(3);
    if (IN(4)) REPS(4) {
        pg8::Gemm g{WSP(const bf16, WS_XB), WSP(const bf16, WS_WQ), T, D, D}; pg8::StaticOrder S; S.init(T, D, F.G, F.bid);
        pg8::EpiRowScaleBf16<1> E{WSP(bf16, WS_Q), D, WSP(const float, WS_SSQ2), NORM_EPS};
        pg8::gemm_phase<pg8::EpiRowScaleBf16<1>, pg8::StaticOrder, true, true>(F.lds, g, S, E);
    }
    if (IN(4)) { __syncthreads();
        pg8::StaticOrder S; S.init(T, D, F.G, F.bid); pg8::Unit u;
        for (int i = 0; S.next(i, u); ++i) route_item(F, ((u.pm * 8 + F.wave) << 3) | u.pn, F.lane);
        const int gw = F.bid * NWAVES + F.wave, NGW = F.G * NWAVES;
        for (int tok = gw; tok < T; tok += NGW) xquant_token(F, tok, F.lane); }
    if (IN(4) && IN(6)) xcd_barrier(bar);
    { const PeerGeom pg = peer_geom(F); LAS int* wl = (LAS int*)(F.lds + F.wave * 1024);
      if (IN(6)) REPS(6) { for (int r = 0; r < 16 / pg.ngrp; ++r) { const int slice = r * pg.ngrp + pg.g; for (int tok = pg.rank * NWAVES + F.wave; tok < T; tok += pg.nrank * NWAVES) peer_score_slice(F, tok, slice, F.lane, wl); } }
      SEAM(6);
      if (IN(7)) REPS(7) { const int gw = F.bid * NWAVES + F.wave, NGW = F.G * NWAVES; for (int tok = gw; tok < T; tok += NGW) peer_coef_token(F, tok, F.lane); }
      SEAM(7);
      if (IN(8)) peer_out_phase(F, pg, (LAS int*)(F.lds + 16384 + F.wave * 2048));
      SEAM(8);
      if (IN(9)) { const int gw = F.bid * NWAVES + F.wave, NGW = F.G * NWAVES; for (int tok = gw; tok < T; tok += NGW) final_norm_token(F, tok, F.lane); } }
#undef IN
#undef SEAM
}

extern "C" void kernel_launch(void* const* d_in, const int* in_sizes, int n_in, void* d_out, int out_size, void* d_ws, size_t ws_size, hipStream_t stream) {
    static int grid = 0;
    if (grid == 0) {
        if (n_in != 28 || in_sizes[0] != T * D || out_size != T * D || ws_size < WS_END) { fprintf(stderr, "kernel_launch: shape/workspace mismatch: n_in %d in0 %d out %d ws %zu (need %zu)\n", n_in, n_in > 0 ? in_sizes[0] : -1, out_size, ws_size, (size_t)WS_END); grid = -1; return; }
        int dev = 0, cus = 0, per_cu = 0;
        if (hipGetDevice(&dev) != hipSuccess || hipDeviceGetAttribute(&cus, hipDeviceAttributeMultiprocessorCount, dev) != hipSuccess) { fprintf(stderr, "kernel_launch: device query failed\n"); grid = -1; return; }
        if (hipFuncSetAttribute((const void*)hybrid_fwd, hipFuncAttributeMaxDynamicSharedMemorySize, LDS_BYTES) != hipSuccess) { fprintf(stderr, "kernel_launch: hipFuncSetAttribute failed\n"); grid = -1; return; }
        if (hipOccupancyMaxActiveBlocksPerMultiprocessor(&per_cu, (const void*)hybrid_fwd, NTHR, LDS_BYTES) != hipSuccess || per_cu < 1) { fprintf(stderr, "kernel_launch: occupancy query says %d blocks per CU\n", per_cu); per_cu = 1; }
        (void)hipGetLastError();
        grid = cus;
    }
    if (grid < 0) return;
    if (hipMemsetAsync((char*)d_ws + WS_CTL, 0, CTL_ZERO_BYTES, stream) != hipSuccess) { fprintf(stderr, "kernel_launch: hipMemsetAsync failed\n"); return; }
    Args a{};
    for (int i = 0; i < 28; ++i) a.in[i] = (const float*)d_in[i];
    a.out = (float*)d_out; a.ws = (unsigned char*)d_ws;
    for (int li = 0; li < N_LAUNCHES; ++li) {
        a.ph_lo = (N_LAUNCHES == 1) ? 0 : li; a.ph_hi = (N_LAUNCHES == 1) ? N_PHASES : li + 1; a.li = li;
        hipLaunchKernelGGL(hybrid_fwd, dim3(grid), dim3(NTHR), LDS_BYTES, stream, a);
        const hipError_t le = hipPeekAtLastError();
        if (le != hipSuccess) { fprintf(stderr, "kernel_launch: launch %d failed: %s\n", li, hipGetErrorName(le)); break; }
    }
}
```

```cpp
#include <hip/hip_runtime.h>
#include <cstdio>
#include <cstdint>
namespace pg8 {
#define PG8_LAS __attribute__((address_space(3)))
typedef unsigned short bf16_t;
typedef short bf16x8 __attribute__((ext_vector_type(8)));
typedef float f32x4 __attribute__((ext_vector_type(4)));
typedef unsigned u32x4 __attribute__((ext_vector_type(4)));
constexpr int BM = 256, BK = 64, HALF = 128, HTB = HALF * BK * 2  , STAGE_BYTES = 8 * HTB, NXCD = 8, WGM = 8;

__host__ __device__ __forceinline__ int lds_byte(int r, int c) { const int st = (r >> 4) * 2 + (c >> 5), rr = r & 15, cc = c & 31, ob = rr * 64 + cc * 2; return st * 1024 + (ob ^ (((ob >> 9) & 1) << 5)); }
__host__ __device__ __forceinline__ void stage_rc(int b, int& R, int& C) { const int st = b / 1024, sb = b % 1024, swz = sb ^ (((sb >> 9) & 1) << 5); R = (st >> 1) * 16 + swz / 64; C = (st & 1) * 32 + (swz % 64) / 2; }
__host__ __device__ __forceinline__ int perm32(int rho) { const int n = rho >> 4, i = rho & 15; return 8 * (i >> 2) + 4 * n + (i & 3); }

struct Unit { int pm, pn; };
struct Gemm { const bf16_t* A; const bf16_t* Bt; int M, N, K; };

struct StaticOrder {
    int nM, nN, nwg, G, c;
    __host__ __device__ void init(int M, int N, int G_, int c_) { nM = M / BM; nN = N / BM; nwg = nM * nN; G = G_; c = c_; }
    __host__ __device__ bool next(int i, Unit& u) const {
        const long L = (long)i * G + c; if (L >= nwg) return false;
        int wgid = (int)L; { const int q = nwg / NXCD, r = nwg % NXCD, xcd = wgid % NXCD, off = wgid / NXCD; wgid = (xcd < r ? xcd * (q + 1) : r * (q + 1) + (xcd - r) * q) + off; }
        const int nig = WGM * nN, gid = wgid / nig, fm = gid * WGM, gsz = (nM - fm) < WGM ? (nM - fm) : WGM;
        u.pm = fm + ((wgid % nig) % gsz); u.pn = (wgid % nig) / gsz; return true;
    }
    __device__ __forceinline__ void a_ready(const Unit&) const {}
    __device__ __forceinline__ void done(const Unit&) const {}
};

__device__ __forceinline__ unsigned cvt_pk_bf16(float lo, float hi) { unsigned r; asm volatile("v_cvt_pk_bf16_f32 %0, %1, %2" : "=v"(r) : "v"(lo), "v"(hi)); return r; }
typedef float f32x2 __attribute__((ext_vector_type(2)));
typedef unsigned u32x2 __attribute__((ext_vector_type(2)));
template <int MODE> struct EpiRowScaleBf16 {
    static constexpr bool PERM = true, AFTER_DRAIN = false;
    bf16_t* O; int ldc; const float* rs; float eps;
    __device__ __forceinline__ void operator()(const f32x4 (&acc)[2][2][4][2], const Unit& u, int wr, int wc, int fr, int fq) const {
        const int row0 = u.pm * BM + wr * 64 + fr, col0 = u.pn * BM + wc * 32 + 8 * fq;
#pragma unroll
        for (int ai = 0; ai < 2; ++ai)
#pragma unroll
            for (int m = 0; m < 4; ++m) { const int r = row0 + ai * HALF + m * 16; float s = rs[r]; if (MODE == 1) s = 1.0f / sqrtf(s * (1.0f / 2048.0f) + eps);
                bf16_t* rowp = O + (size_t)r * ldc + col0;
#pragma unroll
                for (int bj = 0; bj < 2; ++bj) { const f32x4 v0 = acc[ai][bj][m][0] * s, v1 = acc[ai][bj][m][1] * s;
                    u32x4 w; w.x = cvt_pk_bf16(v0[0], v0[1]); w.y = cvt_pk_bf16(v0[2], v0[3]); w.z = cvt_pk_bf16(v1[0], v1[1]); w.w = cvt_pk_bf16(v1[2], v1[3]);
                    *(u32x4*)(rowp + bj * HALF) = w; } }
    }
};
struct EpiResidual {
    static constexpr bool PERM = false, AFTER_DRAIN = false;
    const float* base; float* out; bf16_t* outb; float* ssq; int ldc;
    __device__ __forceinline__ void operator()(const f32x4 (&acc)[2][2][4][2], const Unit& u, int wr, int wc, int fr, int fq) const {
        const int row0 = u.pm * BM + wr * 64 + fr, col0 = u.pn * BM + wc * 32 + 4 * fq;
#pragma unroll
        for (int ai = 0; ai < 2; ++ai)
#pragma unroll
            for (int m = 0; m < 4; ++m) { const int r = row0 + ai * HALF + m * 16; const size_t off = (size_t)r * ldc + col0; float q = 0.f;
#pragma unroll
                for (int bj = 0; bj < 2; ++bj)
#pragma unroll
                    for (int n = 0; n < 2; ++n) { const f32x4 bs = *(const f32x4*)(base + off + bj * HALF + n * 16); const f32x4 o = bs + acc[ai][bj][m][n];
                        *(f32x4*)(out + off + bj * HALF + n * 16) = o; q += (o[0] * o[0] + o[1] * o[1]) + (o[2] * o[2] + o[3] * o[3]);
                        u32x2 w; w.x = cvt_pk_bf16(o[0], o[1]); w.y = cvt_pk_bf16(o[2], o[3]); *(u32x2*)(outb + off + bj * HALF + n * 16) = w; }
                q += __shfl_xor(q, 16); q += __shfl_xor(q, 32);
                if (fq == 0) atomicAdd(ssq + r, q);
                asm volatile("" ::: "memory"); }
    }
};
template <class Epi, class Sched, bool ALIGN_EPI = false, bool SP2 = false>
__device__ __forceinline__ void gemm_phase(PG8_LAS unsigned char* lds, const Gemm g, const Sched& S, const Epi& E) {
    const int tid = threadIdx.x, wid = __builtin_amdgcn_readfirstlane(tid >> 6), lane = tid & 63, wr = wid >> 2, wc = wid & 3, fr = lane & 15, fq = lane >> 4;
    const int K = g.K, nt = K / BK;
    unsigned voffA[2], voffB[2];
#pragma unroll
    for (int i = 0; i < 2; ++i) { int R, C; stage_rc(tid * 16 + i * 8192, R, C); const int Rb = Epi::PERM ? ((R & ~31) + perm32(R & 31)) : R;
        voffA[i] = (unsigned)(R * K + C) * 2u; voffB[i] = (unsigned)(Rb * K + C) * 2u; }
    const size_t kstep = (size_t)(BK * 2);
    const size_t hstep = (size_t)HALF * K * 2;
    const size_t tstep = 2 * hstep;
    const unsigned ldsw = (unsigned)wid * 1024u;
    const int aoff = lds_byte(wr * 64 + fr, fq * 8), boff = lds_byte(wc * 32 + fr, fq * 8);
#define PG8_SA(b, h) (((b) * 2 + (h)) * HTB)
#define PG8_SB(b, h) ((4 + (b) * 2 + (h)) * HTB)
#define PG8_STAGE(bufoff, gbase, voff) do { _Pragma("unroll") for (int _i = 0; _i < 2; ++_i) \
        __builtin_amdgcn_global_load_lds((const unsigned*)((const char*)(gbase) + (voff)[_i]), (PG8_LAS unsigned*)(lds + (bufoff) + ldsw + _i * 8192), 16, 0, 0); } while (0)
#define PG8_LDA(dst, b, h) do { _Pragma("unroll") for (int m = 0; m < 4; ++m) _Pragma("unroll") for (int k = 0; k < 2; ++k) dst[m][k] = *(const PG8_LAS bf16x8*)(lds + PG8_SA(b, h) + aoff + m * 2048 + k * 1024); } while (0)
#define PG8_LDB(dst, b, h) do { _Pragma("unroll") for (int n = 0; n < 2; ++n) _Pragma("unroll") for (int k = 0; k < 2; ++k) dst[n][k] = *(const PG8_LAS bf16x8*)(lds + PG8_SB(b, h) + boff + n * 2048 + k * 1024); } while (0)
#define PG8_MMA(ai, bj, At, Bt) do { __builtin_amdgcn_s_setprio(1); _Pragma("unroll") for (int m = 0; m < 4; ++m) _Pragma("unroll") for (int n = 0; n < 2; ++n) _Pragma("unroll") for (int k = 0; k < 2; ++k) \
        acc[ai][bj][m][n] = __builtin_amdgcn_mfma_f32_16x16x32_bf16(Bt[n][k], At[m][k], acc[ai][bj][m][n], 0, 0, 0); __builtin_amdgcn_s_setprio(0); } while (0)
#define PG8_WAIT_V(n) asm volatile("s_waitcnt vmcnt(" #n ")" ::: "memory")
#define PG8_WAIT_L(n) asm volatile("s_waitcnt lgkmcnt(" #n ")" ::: "memory")
#define PG8_BAR __builtin_amdgcn_s_barrier()
#define PG8_SCHED __builtin_amdgcn_sched_barrier(0)
    Unit cur, nxt; int ui = 0;
    if (!S.next(0, cur)) return;
    f32x4 acc[2][2][4][2];
#pragma unroll
    for (int a = 0; a < 2; ++a)
#pragma unroll
        for (int b = 0; b < 2; ++b)
#pragma unroll
            for (int m = 0; m < 4; ++m)
#pragma unroll
                for (int n = 0; n < 2; ++n) acc[a][b][m][n] = (f32x4){0.f, 0.f, 0.f, 0.f};
    bf16x8 At[4][2], B0[2][2], B1[2][2];
    const char* cA = (const char*)g.A + (size_t)cur.pm * tstep; const char* cB = (const char*)g.Bt + (size_t)cur.pn * tstep;
    S.a_ready(cur);
    if constexpr (SP2) {
        PG8_STAGE(PG8_SB(0, 0), cB, voffB); PG8_STAGE(PG8_SB(0, 1), cB + hstep, voffB); PG8_STAGE(PG8_SA(0, 0), cA, voffA); PG8_STAGE(PG8_SA(0, 1), cA + hstep, voffA);
        if (wr == 1) PG8_BAR;
        PG8_WAIT_V(2); PG8_BAR;
        PG8_STAGE(PG8_SB(1, 0), cB + kstep, voffB); PG8_STAGE(PG8_SA(1, 0), cA + kstep, voffA); PG8_STAGE(PG8_SB(1, 1), cB + hstep + kstep, voffB);
        PG8_WAIT_V(6); PG8_BAR;
    } else {
        PG8_STAGE(PG8_SB(0, 0), cB, voffB); PG8_STAGE(PG8_SA(0, 0), cA, voffA); PG8_STAGE(PG8_SB(0, 1), cB + hstep, voffB); PG8_STAGE(PG8_SA(0, 1), cA + hstep, voffA);
        if (wr == 1) PG8_BAR;
        PG8_WAIT_V(4); PG8_BAR;
        PG8_STAGE(PG8_SB(1, 0), cB + kstep, voffB); PG8_STAGE(PG8_SA(1, 0), cA + kstep, voffA); PG8_STAGE(PG8_SB(1, 1), cB + hstep + kstep, voffB);
        PG8_WAIT_V(6); PG8_BAR;
    }
    for (;;) {
        const bool has_next = S.next(ui + 1, nxt);
        const char* nA = has_next ? (const char*)g.A + (size_t)nxt.pm * tstep : cA; const char* nB = has_next ? (const char*)g.Bt + (size_t)nxt.pn * tstep : cB;
        for (int t = 0; t < nt; t += 2) {
            const bool last = (t == nt - 2);
            const char* a1 = cA + (size_t)(t + 1) * kstep;
            const char* a2 = last ? nA : cA + (size_t)(t + 2) * kstep; const char* b2 = last ? nB : cB + (size_t)(t + 2) * kstep;
            const char* a3 = a2 + kstep; const char* b3 = b2 + kstep;
            if (last && has_next) S.a_ready(nxt);
            if constexpr (SP2) {
            PG8_LDB(B0, 0, 0); PG8_LDB(B1, 0, 1); PG8_SCHED; PG8_LDA(At, 0, 0); PG8_STAGE(PG8_SA(1, 1), a1 + hstep, voffA);
            PG8_WAIT_V(8); PG8_WAIT_L(0); PG8_BAR; PG8_MMA(0, 0, At, B0); PG8_MMA(0, 1, At, B1); PG8_BAR; PG8_SCHED;
            PG8_LDA(At, 0, 1); PG8_STAGE(PG8_SB(0, 0), b2, voffB); PG8_STAGE(PG8_SB(0, 1), b2 + hstep, voffB); PG8_STAGE(PG8_SA(0, 0), a2, voffA);
            PG8_WAIT_V(8); PG8_WAIT_L(0); PG8_BAR; PG8_MMA(1, 0, At, B0); PG8_MMA(1, 1, At, B1); PG8_BAR; PG8_SCHED;
            PG8_LDB(B0, 1, 0); PG8_LDB(B1, 1, 1); PG8_SCHED; PG8_LDA(At, 1, 0); PG8_STAGE(PG8_SA(0, 1), a2 + hstep, voffA);
            PG8_WAIT_V(8); PG8_WAIT_L(0); PG8_BAR; PG8_MMA(0, 0, At, B0); PG8_MMA(0, 1, At, B1); PG8_BAR; PG8_SCHED;
            PG8_LDA(At, 1, 1); PG8_STAGE(PG8_SB(1, 0), b3, voffB); PG8_STAGE(PG8_SB(1, 1), b3 + hstep, voffB); PG8_STAGE(PG8_SA(1, 0), a3, voffA);
            PG8_WAIT_V(8); PG8_WAIT_L(0); PG8_BAR; PG8_MMA(1, 0, At, B0); PG8_MMA(1, 1, At, B1); PG8_BAR; PG8_SCHED;
            } else {
            PG8_LDB(B0, 0, 0); PG8_SCHED; PG8_LDA(At, 0, 0); PG8_STAGE(PG8_SA(1, 1), a1 + hstep, voffA);
            PG8_WAIT_L(8); PG8_BAR; PG8_WAIT_L(0); PG8_MMA(0, 0, At, B0); PG8_BAR; PG8_SCHED;
            PG8_LDB(B1, 0, 1); PG8_STAGE(PG8_SB(0, 0), b2, voffB);
            PG8_BAR; PG8_WAIT_L(0); PG8_MMA(0, 1, At, B1); PG8_BAR;
            PG8_LDA(At, 0, 1); PG8_STAGE(PG8_SA(0, 0), a2, voffA);
            PG8_BAR; PG8_WAIT_L(0); PG8_MMA(1, 0, At, B0); PG8_BAR; PG8_SCHED;
            PG8_STAGE(PG8_SB(0, 1), b2 + hstep, voffB);
            PG8_WAIT_V(6); PG8_BAR; PG8_MMA(1, 1, At, B1); PG8_BAR;
            PG8_LDB(B0, 1, 0); PG8_SCHED; PG8_LDA(At, 1, 0); PG8_STAGE(PG8_SA(0, 1), a2 + hstep, voffA);
            PG8_WAIT_L(8); PG8_BAR; PG8_WAIT_L(0); PG8_MMA(0, 0, At, B0); PG8_BAR; PG8_SCHED;
            PG8_LDB(B1, 1, 1); PG8_STAGE(PG8_SB(1, 0), b3, voffB);
            PG8_BAR; PG8_WAIT_L(0); PG8_MMA(0, 1, At, B1); PG8_BAR;
            PG8_LDA(At, 1, 1); PG8_STAGE(PG8_SA(1, 0), a3, voffA);
            PG8_BAR; PG8_WAIT_L(0); PG8_MMA(1, 0, At, B0); PG8_BAR; PG8_SCHED;
            PG8_STAGE(PG8_SB(1, 1), b3 + hstep, voffB);
            PG8_WAIT_V(6); PG8_BAR; PG8_MMA(1, 1, At, B1); PG8_BAR;
            }
        }
        if constexpr (ALIGN_EPI) { if (wr == 0) PG8_BAR; }
        if constexpr (!Epi::AFTER_DRAIN) { E(acc, cur, wr, wc, fr, fq); S.done(cur); }
        if (!has_next) break;
#pragma unroll
        for (int a = 0; a < 2; ++a)
#pragma unroll
            for (int b = 0; b < 2; ++b)
#pragma unroll
                for (int m = 0; m < 4; ++m)
#pragma unroll
                    for (int n = 0; n < 2; ++n) acc[a][b][m][n] = (f32x4){0.f, 0.f, 0.f, 0.f};
        cur = nxt; cA = nA; cB = nB; ++ui;
        if constexpr (ALIGN_EPI) { if (wr == 1) PG8_BAR; }
    }
    PG8_WAIT_V(0);
    if constexpr (!ALIGN_EPI) { if (wr == 0) PG8_BAR; }
    PG8_BAR;
    if constexpr (Epi::AFTER_DRAIN) { E.fused(acc, cur, wr, wc, fr, fq, lds, wid, lane); S.done(cur); }
#undef PG8_SA
#undef PG8_SB
#undef PG8_STAGE
#undef PG8_LDA
#undef PG8_LDB
#undef PG8_MMA
#undef PG8_WAIT_V
#undef PG8_WAIT_L
#undef PG8_BAR
#undef PG8_SCHED
}
}

#ifndef PROBE_DUP
#define PROBE_DUP -1
#endif
constexpr int NWAVES = 8, NTHR = NWAVES * 64;
#ifndef MK_N_LAUNCHES
#define MK_N_LAUNCHES 1
#endif
constexpr int N_PHASES = 10;
constexpr int N_LAUNCHES = MK_N_LAUNCHES;
static_assert(N_LAUNCHES == 1 || N_LAUNCHES == N_PHASES, "MK_N_LAUNCHES is 1 or N_PHASES");

constexpr int BATCH = 8, SEQ = 2048, T = BATCH * SEQ, D = 2048;
constexpr int NIN = 5408, NINP = 5632;
constexpr int PC_GATE = 1024, PC_R = 2048, PC_K = 3072, PC_V = 4096, PC_WD = 5120, PC_AD = 5184, PC_GD = 5248;
constexpr int RWKV_C0 = 2048;
constexpr int NEXP = 16384, NSEL = 128;
constexpr float NORM_EPS = 1e-6f, GN_EPS = 64e-5f;

constexpr size_t MiB = 1u << 20;
constexpr size_t WS_CTL = 0, CTL_ZERO_BYTES = 1 * MiB;
constexpr size_t WS_SSQ3 = 576 * 1024;
constexpr size_t WS_SSQ2 = 512 * 1024;
constexpr size_t WS_RSTD1 = 1 * MiB;
constexpr size_t WS_USC = 1 * MiB + 64 * 1024, WS_VSC = 1 * MiB + 128 * 1024;
constexpr size_t WS_SX = 1 * MiB + 192 * 1024;
constexpr size_t WS_WIN = 2 * MiB;
constexpr size_t WS_WOUT = 24 * MiB;
constexpr size_t WS_WQ = 32 * MiB;
constexpr size_t WS_KEYS = 40 * MiB;
constexpr size_t WS_W2T = WS_KEYS + 512 * 1024;
constexpr size_t WS_A2T = WS_W2T + 128 * 1024;
constexpr size_t WS_G2T = WS_A2T + 128 * 1024;
constexpr size_t WS_WAT = WS_G2T + 320 * 1024;
constexpr size_t WS_WIT = WS_WAT + 256 * 1024;
constexpr size_t WS_EXP = 42 * MiB;
constexpr size_t WS_GATE = 50 * MiB;
constexpr size_t WS_LA = 64 * MiB;
constexpr size_t WS_SUMM = 58 * MiB;
constexpr size_t WS_XB = 64 * MiB;
constexpr size_t WS_PROJ = 128 * MiB;
constexpr size_t WS_Q = WS_PROJ;
constexpr size_t WS_PART = 192 * MiB;
constexpr size_t WS_XQ = 320 * MiB;
constexpr size_t WS_COEF = 352 * MiB;
constexpr size_t WS_CSC = 356 * MiB;
constexpr size_t WS_Y = 304 * MiB;
constexpr size_t WS_UT = 368 * MiB;
constexpr size_t WS_VT = 432 * MiB;
constexpr size_t WS_END = 496 * MiB;
static_assert(WS_WIT + 256 * 1024 <= WS_EXP && WS_PROJ + (size_t)T * NINP * 2 <= WS_Y && WS_WIN + (size_t)NINP * D * 2 <= WS_WOUT, "d_ws map");
constexpr int CW_PREBAR = 2112;
constexpr int CW_LRUBAR = 2048;
constexpr int CW_BAR = 4096;

constexpr int RING_BYTES = 131072;
constexpr int LDSCTL_OFF = 143360, MISC_OFF = LDSCTL_OFF + 320;
constexpr int LDS_BYTES = 147456;

#define GAS __attribute__((address_space(1)))
#define LAS __attribute__((address_space(3)))
typedef unsigned short bf16;
typedef unsigned v4u __attribute__((ext_vector_type(4)));
typedef unsigned v2u __attribute__((ext_vector_type(2)));
typedef float f32x4 __attribute__((ext_vector_type(4)));
typedef float f32x16 __attribute__((ext_vector_type(16)));
typedef short bf16x8 __attribute__((ext_vector_type(8)));
typedef __bf16 bf16x2_t __attribute__((ext_vector_type(2)));
typedef GAS unsigned gu32;
#define RLX_AGENT __ATOMIC_RELAXED, __HIP_MEMORY_SCOPE_AGENT
__device__ __forceinline__ unsigned f2bf(float f) { unsigned u = __builtin_bit_cast(unsigned, f); return (u + 0x7fffu + ((u >> 16) & 1u)) >> 16; }
__device__ __forceinline__ unsigned pk2(float lo, float hi) { return f2bf(lo) | (f2bf(hi) << 16); }
__device__ __forceinline__ float bf_lo(unsigned w) { return __uint_as_float(w << 16); }
__device__ __forceinline__ float bf_hi(unsigned w) { return __uint_as_float(w & 0xffff0000u); }
__device__ __forceinline__ void unpack8(const v4u& w, float (&o)[8]) { o[0] = bf_lo(w.x); o[1] = bf_hi(w.x); o[2] = bf_lo(w.y); o[3] = bf_hi(w.y); o[4] = bf_lo(w.z); o[5] = bf_hi(w.z); o[6] = bf_lo(w.w); o[7] = bf_hi(w.w); }
__device__ __forceinline__ v4u pack8(const float (&o)[8]) { v4u w; w.x = pk2(o[0], o[1]); w.y = pk2(o[2], o[3]); w.z = pk2(o[4], o[5]); w.w = pk2(o[6], o[7]); return w; }
__device__ __forceinline__ float sigmoidf_(float x) { return 1.0f / (1.0f + __expf(-x)); }
__device__ __forceinline__ float softplusf_(float z) { return fmaxf(z, 0.f) + log1pf(__expf(-fabsf(z))); }
__device__ __forceinline__ float gelu_tanh(float x) { const float u = 0.7978845608028654f * (x + 0.044715f * x * x * x); return 0.5f * x * (1.0f + tanhf(u)); }
template <int CTRL> __device__ __forceinline__ float dppf(float x) { return __builtin_bit_cast(float, __builtin_amdgcn_mov_dpp(__builtin_bit_cast(int, x), CTRL, 0xf, 0xf, true)); }
__device__ __forceinline__ float red8(float v) { v += dppf<0xB1>(v); v += dppf<0x4E>(v); v += dppf<0x141>(v); return v; }
__device__ __forceinline__ float red16(float v) { v = red8(v); v += dppf<0x140>(v); return v; }
__device__ __forceinline__ float wave_sum(float v) {
#pragma unroll
    for (int o = 1; o < 64; o <<= 1) v += __shfl_xor(v, o);
    return v;
}
__device__ __forceinline__ float dot2bf(unsigned a, unsigned b, float acc) { return __builtin_amdgcn_fdot2_f32_bf16(__builtin_bit_cast(bf16x2_t, a), __builtin_bit_cast(bf16x2_t, b), acc, false); }
#define MFMA16(a, b, c) __builtin_amdgcn_mfma_f32_16x16x32_bf16((a), (b), (c), 0, 0, 0)
#define MFMA32(a, b, c) __builtin_amdgcn_mfma_f32_32x32x16_bf16((a), (b), (c), 0, 0, 0)

#define XB_TMO      128
#define XB_XCNT(j)  (256  + 64 * (j))
#define XB_XSUB(j)  (1280 + 64 * (j))
#define XB_XGEN(j)  (2304 + 64 * (j))
#define XB_TOP      3328
#define XB_TOPGEN   3392
#define XCD_BAR_WORDS 3456
#define XB_SPIN_CAP (1u << 22)
__device__ __forceinline__ unsigned xb_ld(unsigned* p)              { return __hip_atomic_load(p, __ATOMIC_RELAXED, __HIP_MEMORY_SCOPE_AGENT); }
__device__ __forceinline__ unsigned xb_add(unsigned* p, unsigned v) { return __hip_atomic_fetch_add(p, v, __ATOMIC_RELAXED, __HIP_MEMORY_SCOPE_AGENT); }
__device__ __forceinline__ unsigned xb_xcc_id() { return (unsigned)__builtin_amdgcn_s_getreg((3 << 11) | 20) & 0xFu; }
#define XB_SPIN(cond, bar) do { unsigned _sp = 0; while (cond) { __builtin_amdgcn_s_sleep(1); \
    if ((++_sp & 255u) == 0u) { if (xb_ld(&(bar)[XB_TMO])) break; if (_sp > XB_SPIN_CAP) { atomicAdd(&(bar)[XB_TMO], 1u); break; } } } } while (0)
struct XcdBarrier { unsigned* bar; unsigned x; volatile LAS unsigned* st; };
__device__ __forceinline__ XcdBarrier xcd_barrier_post(unsigned* bar, volatile LAS unsigned* st) {
    XcdBarrier b; b.bar = bar; b.x = xb_xcc_id(); b.st = st;
    if (threadIdx.x == 0) (void)xb_add(&bar[XB_XCNT(b.x)], 1u);
    return b;
}
__device__ __forceinline__ void xcd_barrier_complete(unsigned* bar, unsigned x, unsigned& nloc, unsigned& nx) {
    const unsigned G = gridDim.x * gridDim.y * gridDim.z;
    unsigned sum, cnt, mine, sp = 0u;
    for (;;) {
        sum = 0u; cnt = 0u; mine = 0u;
#pragma unroll
        for (unsigned j = 0; j < 16; ++j) { const unsigned c = xb_ld(&bar[XB_XCNT(j)]); sum += c; cnt += (c > 0u) ? 1u : 0u; mine = (j == x) ? c : mine; }
        if (sum == G) break;
        __builtin_amdgcn_s_sleep(1);
        if ((++sp & 255u) == 0u) { if (xb_ld(&bar[XB_TMO])) break; if (sp > XB_SPIN_CAP) { atomicAdd(&bar[XB_TMO], 1u); break; } }
    }
    nloc = mine > 0u ? mine : 1u; nx = cnt > 0u ? cnt : 1u;
}
__device__ __forceinline__ void xcd_barrier(const XcdBarrier& b) {
    asm volatile("s_waitcnt vmcnt(0)" ::: "memory");
    __syncthreads();
    if (threadIdx.x == 0) {
        unsigned* bar = b.bar;
        __builtin_amdgcn_s_waitcnt(0);
        unsigned nloc = b.st[0], nx = b.st[1];
        if (nloc == 0u) { xcd_barrier_complete(bar, b.x, nloc, nx); b.st[0] = nloc; b.st[1] = nx; }
        const unsigned old = xb_add(&bar[XB_XSUB(b.x)], 1u);
        const unsigned gen = old / nloc;
        if (old + 1u == (gen + 1u) * nloc) {
            __builtin_amdgcn_fence(__ATOMIC_RELEASE, "agent");
            asm volatile("s_waitcnt vmcnt(0)" ::: "memory");
            const unsigned og = xb_add(&bar[XB_TOP], 1u);
            const unsigned tg = og / nx;
            if (og + 1u == (tg + 1u) * nx) xb_add(&bar[XB_TOPGEN], 1u);
            else XB_SPIN(xb_ld(&bar[XB_TOPGEN]) == tg, bar);
            __builtin_amdgcn_fence(__ATOMIC_ACQUIRE, "agent");
            xb_add(&bar[XB_XGEN(b.x)], 1u);
            asm volatile("s_waitcnt vmcnt(0)" ::: "memory");
        } else {
            XB_SPIN(xb_ld(&bar[XB_XGEN(b.x)]) == gen, bar);
            __builtin_amdgcn_fence(__ATOMIC_ACQUIRE, "agent");
            asm volatile("s_waitcnt vmcnt(0)" ::: "memory");
        }
    }
    __syncthreads();
}

struct Frame {
    LAS unsigned char* lds;
    int tid, lane, wave, G, bid;
    const float* in[28];
    float* out;
    unsigned char* ws;
};
#define WSP(type, off) ((type*)(F.ws + (off)))
enum { I_X = 0, I_G1, I_WIN, I_CONVW, I_CONVB, I_WA, I_BA, I_WI, I_BI, I_LAM, I_MU, I_W0, I_W2, I_A0, I_A2, I_G2, I_KK, I_KA, I_RK, I_LNW, I_LNB, I_WOUT, I_G2N, I_WQ, I_KEYS, I_U, I_V, I_GF };

__device__ __forceinline__ void p0_transpose_item(const float* W, int K, int N, bf16* WT, const float* ksc, LAS float* scr, int item, int lane) {
    const int nblk = N / 32, kb = item / nblk, nb = item % nblk, k0 = 64 * kb, n0 = 32 * nb;
    const int lr = lane >> 3, c4 = (lane & 7) * 4;
    f32x4 v[8];
#pragma unroll
    for (int i = 0; i < 8; ++i) v[i] = *(const f32x4*)(W + (size_t)(k0 + 8 * i + lr) * N + n0 + c4);
#pragma unroll
    for (int i = 0; i < 8; ++i) { const int kk = 8 * i + lr; const float sc = ksc ? ksc[k0 + kk] : 1.0f; LAS float* d = scr + kk * 33 + c4; d[0] = v[i][0] * sc; d[1] = v[i][1] * sc; d[2] = v[i][2] * sc; d[3] = v[i][3] * sc; }
    asm volatile("s_waitcnt lgkmcnt(0)" ::: "memory");
    const int c = lane & 7;
#pragma unroll
    for (int j = 0; j < 4; ++j) { const int n = (lane >> 3) + 8 * j; const LAS float* s = scr + (8 * c) * 33 + n;
        v4u o; o.x = pk2(s[0 * 33], s[1 * 33]); o.y = pk2(s[2 * 33], s[3 * 33]); o.z = pk2(s[4 * 33], s[5 * 33]); o.w = pk2(s[6 * 33], s[7 * 33]);
        *(v4u*)(WT + (size_t)(n0 + n) * K + k0 + 8 * c) = o; }
    asm volatile("s_waitcnt lgkmcnt(0)" ::: "memory");
}
__device__ __forceinline__ void p0_small_transpose(const float* src, bf16* dst, int nb, int K, int N, int gt, int NGT) {
    const int tot = nb * K * N;
    for (int i = gt; i < tot; i += NGT) { const int bb = i / (K * N), r = i - bb * K * N, n = r / K, k = r - n * K; dst[i] = (bf16)f2bf(src[(size_t)bb * K * N + (size_t)k * N + n]); }
}
template <int PART> __device__ __forceinline__ void p0_prologue(const Frame& F, int vb, int VG) {
    LAS float* scr = (LAS float*)(F.lds + F.wave * 8448);
    const int gw = vb * NWAVES + F.wave, NGW = VG * NWAVES, gt = gw * 64 + F.lane, NGT = NGW * 64;
    constexpr int I1 = (D / 64) * (NIN / 32), I2 = (D / 64) * (D / 32);
    if (PART == 0) { for (int it = gw; it < I1; it += NGW) p0_transpose_item(F.in[I_WIN], D, NIN, WSP(bf16, WS_WIN), F.in[I_G1], scr, it, F.lane); }
    else { for (int it = gw; it < 2 * I2; it += NGW) { if (it < I2) p0_transpose_item(F.in[I_WOUT], D, D, WSP(bf16, WS_WOUT), nullptr, scr, it, F.lane); else p0_transpose_item(F.in[I_WQ], D, D, WSP(bf16, WS_WQ), F.in[I_G2N], scr, it - I2, F.lane); } }
    if (PART == 0) {
    { v4u* z = (v4u*)(WSP(bf16, WS_WIN) + (size_t)NIN * D); const int nz = (NINP - NIN) * D * 2 / 16; for (int i = gt; i < nz; i += NGT) z[i] = (v4u){0u, 0u, 0u, 0u}; }
    p0_small_transpose(F.in[I_W2], WSP(bf16, WS_W2T), 1, 64, 1024, gt, NGT);
    p0_small_transpose(F.in[I_A2], WSP(bf16, WS_A2T), 1, 64, 1024, gt, NGT);
    p0_small_transpose(F.in[I_G2], WSP(bf16, WS_G2T), 1, 160, 1024, gt, NGT);
    p0_small_transpose(F.in[I_WA], WSP(bf16, WS_WAT), 8, 128, 128, gt, NGT);
    p0_small_transpose(F.in[I_WI], WSP(bf16, WS_WIT), 8, 128, 128, gt, NGT);
    { const float* s = F.in[I_KEYS]; bf16* d = WSP(bf16, WS_KEYS); for (int i = gt; i < 8 * 2 * 128 * 128 / 8; i += NGT) { const f32x4 a = *(const f32x4*)(s + (size_t)i * 8), b = *(const f32x4*)(s + (size_t)i * 8 + 4);
        v4u o; o.x = pk2(a[0], a[1]); o.y = pk2(a[2], a[3]); o.z = pk2(b[0], b[1]); o.w = pk2(b[2], b[3]); *(v4u*)(d + (size_t)i * 8) = o; } }
    }
    if (PART == 1) {
    { const float* su = F.in[I_U]; const float* sv = F.in[I_V]; const float* g2 = F.in[I_G2N]; unsigned char* du = WSP(unsigned char, WS_UT); unsigned char* dv = WSP(unsigned char, WS_VT);
      float* usc = WSP(float, WS_USC); float* vsc = WSP(float, WS_VSC);
      f32x4 gg[2][4];
#pragma unroll
      for (int hh = 0; hh < 2; ++hh)
#pragma unroll
          for (int q = 0; q < 4; ++q) gg[hh][q] = *(const f32x4*)(g2 + hh * 1024 + F.lane * 16 + q * 4);
      for (int row = gw; row < NEXP; row += NGW) {
          f32x4 uu[2][4], vv[2][4]; float am = 0.f, vm = 0.f;
#pragma unroll
          for (int hh = 0; hh < 2; ++hh)
#pragma unroll
              for (int q = 0; q < 4; ++q) { uu[hh][q] = *(const f32x4*)(su + (size_t)row * D + hh * 1024 + F.lane * 16 + q * 4) * gg[hh][q]; vv[hh][q] = *(const f32x4*)(sv + (size_t)row * D + hh * 1024 + F.lane * 16 + q * 4);
#pragma unroll
                  for (int e = 0; e < 4; ++e) { am = fmaxf(am, fabsf(uu[hh][q][e])); vm = fmaxf(vm, fabsf(vv[hh][q][e])); } }
#pragma unroll
          for (int o = 1; o < 64; o <<= 1) { am = fmaxf(am, __shfl_xor(am, o)); vm = fmaxf(vm, __shfl_xor(vm, o)); }
          const float uq = am > 0.f ? 127.0f / am : 0.f, vq = vm > 0.f ? 127.0f / vm : 0.f;
          if (F.lane == 0) { usc[row] = am * (1.0f / 127.0f); vsc[row] = vm * (1.0f / 127.0f); }
#pragma unroll
          for (int hh = 0; hh < 2; ++hh) { v4u ou, ov;
#pragma unroll
              for (int q = 0; q < 4; ++q) { unsigned w = 0u, wv = 0u;
#pragma unroll
                  for (int e = 0; e < 4; ++e) { const int qi = (int)rintf(uu[hh][q][e] * uq); w |= ((unsigned)qi & 0xFFu) << (8 * e); const int qv = (int)rintf(vv[hh][q][e] * vq); wv |= ((unsigned)qv & 0xFFu) << (8 * e); }
                  ou[q] = w; ov[q] = wv; }
              *(v4u*)(du + (size_t)row * D + hh * 1024 + F.lane * 16) = ou; *(v4u*)(dv + (size_t)row * D + hh * 1024 + F.lane * 16) = ov; }
      } }
    }
    if (PART == 0) {
    { const float* x = F.in[I_X]; bf16* xb = WSP(bf16, WS_XB); float* rstd = WSP(float, WS_RSTD1);
      for (int m = gw; m < T; m += NGW) { const f32x4* xr = (const f32x4*)(x + (size_t)m * D) + F.lane; f32x4 v[8]; float s = 0.f;
#pragma unroll
          for (int j = 0; j < 8; ++j) { v[j] = xr[64 * j]; s += (v[j][0] * v[j][0] + v[j][1] * v[j][1]) + (v[j][2] * v[j][2] + v[j][3] * v[j][3]); }
          s = wave_sum(s);
          if (F.lane == 0) rstd[m] = 1.0f / sqrtf(s * (1.0f / D) + NORM_EPS);
          v2u* o = (v2u*)(xb + (size_t)m * D) + F.lane;
#pragma unroll
          for (int j = 0; j < 8; ++j) { v2u w; w.x = pk2(v[j][0], v[j][1]); w.y = pk2(v[j][2], v[j][3]); o[64 * j] = w; } } }
    }
}

typedef float f32x2c __attribute__((ext_vector_type(2)));
__device__ __forceinline__ unsigned cvtpk(float lo, float hi) { const f32x2c v = {lo, hi}; const bf16x2_t b = __builtin_convertvector(v, bf16x2_t); return __builtin_bit_cast(unsigned, b); }
__device__ __forceinline__ float rcpf_(float x) { return __builtin_amdgcn_rcpf(x); }
__device__ __forceinline__ float sigmoid_fast(float x) { return rcpf_(1.0f + __expf(-x)); }
__device__ __forceinline__ float tanh_fast(float x) { return 1.0f - 2.0f * rcpf_(1.0f + __expf(2.0f * x)); }
__device__ __forceinline__ float softplus_fast(float z) { return fmaxf(z, 0.f) + __logf(1.0f + __expf(-fabsf(z))); }
__device__ __forceinline__ float gelu_fast(float x) { const float u = 0.7978845608028654f * (x + 0.044715f * x * x * x); return x * rcpf_(1.0f + __expf(-2.0f * u)); }
__device__ __forceinline__ void rwkv_item(const Frame& F, int item) {
    const int b = item >> 4, h = item & 15, wave = F.wave; int tid = F.tid; asm volatile("" : "+v"(tid)); const int lane = tid & 63;
    LAS unsigned char* L = F.lds;
    constexpr int LD64 = 72, LD32 = 40, E0 = 93056;
    LAS bf16* AT = (LAS bf16*)(L + 0);  LAS bf16* BT_ = (LAS bf16*)(L + 4608); LAS bf16* KT_ = (LAS bf16*)(L + 9216); LAS bf16* RT = (LAS bf16*)(L + 13824);
    LAS bf16* BTT = (LAS bf16*)(L + 18432); LAS bf16* KTT = (LAS bf16*)(L + 23552); LAS bf16* VT = (LAS bf16*)(L + 28672);
    LAS bf16* S0B = (LAS bf16*)(L + 33792);
    LAS float* GG = (LAS float*)(L + 52224);
    LAS float* YB = (LAS float*)(L + 60416);
    LAS float* BON = (LAS float*)(L + 69120);
    LAS float* PC = (LAS float*)(L + 69248);
    LAS float* CST = (LAS float*)(L + 69504);
    LAS float* SSP = (LAS float*)(L + 71552);
    LAS float* BNP = (LAS float*)(L + 72064);
    LAS float* TOT = (LAS float*)(L + 72576);
    LAS bf16* LAW = (LAS bf16*)(L + 73088);
    LAS bf16* LAA = (LAS bf16*)(L + 77696);
    LAS bf16* LAG = (LAS bf16*)(L + 82304);
    LAS bf16* AAK = (LAS bf16*)(L + E0); LAS bf16* ARB = (LAS bf16*)(L + E0 + 2560); LAS bf16* ARK = (LAS bf16*)(L + E0 + 5120);
    LAS bf16* XB_ = (LAS bf16*)(L + E0 + 7680);
    LAS bf16* XTB = (LAS bf16*)(L + E0 + 12800);
    LAS bf16* PMB = (LAS bf16*)(L + E0 + 17920);
    LAS bf16* RHS = (LAS bf16*)(L + E0 + 23040);
    LAS bf16* SAB = (LAS bf16*)(L + E0 + 28160);
    static_assert(E0 + 33280 <= LDSCTL_OFF, "rwkv LDS map");
    const bf16* PROJ = WSP(bf16, WS_PROJ); bf16* Y = WSP(bf16, WS_Y);
    const int fr0 = lane & 15, fq0 = lane >> 4;
#define FRAG(base, row0, ld, ks) (*(const LAS bf16x8*)((base) + ((row0) + fr) * (ld) + (ks) * 32 + 8 * fq))
    const int mt = wave >> 2, nt = wave & 3, jc = nt * 16 + fr0;
    const bf16* w2p = WSP(bf16, WS_W2T) + (h * 64 + jc) * 64 + 8 * fq0; const bf16* a2p = WSP(bf16, WS_A2T) + (h * 64 + jc) * 64 + 8 * fq0; const bf16* g2p = WSP(bf16, WS_G2T) + (h * 64 + jc) * 160 + 8 * fq0;
    { const int q = tid >> 6, jj = tid & 63;
      const float* src = q == 0 ? F.in[I_W0] : (q == 1 ? F.in[I_A0] : (q == 2 ? F.in[I_KK] : (q == 3 ? F.in[I_KA] : (q == 4 ? F.in[I_RK] : F.in[I_MU] + (q - 5) * 1024))));
      CST[q * 64 + jj] = src[h * 64 + jj]; }
    const int tt = tid >> 4, j0 = (tid & 15) * 4, hc = h * 64 + j0;
    const f32x4 plw = *(const f32x4*)(F.in[I_LNW] + hc), plb = *(const f32x4*)(F.in[I_LNB] + hc);
    const bf16* LA = WSP(bf16, WS_LA);
    const bf16* prkv = PROJ + ((size_t)b * SEQ + mt * 16 + fr0) * NINP + PC_R + h * 64 + nt * 16 + fq0 * 4;
    v2u pc_[3], pp_[3]; v4u pl_[3];
#define RWKV_PREFETCH(tl_) do { const bf16* p_ = prkv + (size_t)(tl_) * 32 * NINP; const bool hasp_ = ((tl_) * 32 + mt * 16 + fr0) > 0; const int po_ = hasp_ ? NINP : 0;   \
        _Pragma("unroll") for (int q_ = 0; q_ < 3; ++q_) { pc_[q_] = *(const v2u*)(p_ + q_ * 1024); const v2u t_ = *(const v2u*)(p_ + q_ * 1024 - po_); pp_[q_].x = hasp_ ? t_.x : 0u; pp_[q_].y = hasp_ ? t_.y : 0u; } \
        _Pragma("unroll") for (int q_ = 0; q_ < 3; ++q_) { int pi_ = tid + q_ * NTHR; pi_ = pi_ < 1152 ? pi_ : 1151; const int row_ = pi_ / 36, c_ = pi_ - row_ * 36; \
            pl_[q_] = *(const v4u*)(LA + ((size_t)b * SEQ + (tl_) * 32 + row_) * 288 + c_ * 8); } } while (0)
#define RWKV_UNPK4(w_) ((f32x4){bf_lo((w_).x), bf_hi((w_).x), bf_lo((w_).y), bf_hi((w_).y)})
    const int ib = wave >> 1, tb = wave & 1, i0 = ib * 16, t0m = tb * 16;
    f32x4 sacc[2], pmacc, yacc;
    sacc[0] = (f32x4){0.f, 0.f, 0.f, 0.f}; sacc[1] = sacc[0]; pmacc = sacc[0]; yacc = sacc[0];
    for (int u = tid; u < 2 * 64 * LD64 / 2; u += NTHR) ((LAS unsigned*)S0B)[u] = 0u;
    RWKV_PREFETCH(0);
    __syncthreads();
    for (int tl = 0; tl <= SEQ / 32; ++tl) {
        const int cur = tl & 1;
        int lane_c = lane; asm volatile("" : "+v"(lane_c)); const int fr = lane_c & 15, fq = lane_c >> 4;
        bf16x8 bw[2], ba[2], bg[5];
#pragma unroll
        for (int ks = 0; ks < 2; ++ks) { bw[ks] = *(const bf16x8*)(w2p + ks * 32); ba[ks] = *(const bf16x8*)(a2p + ks * 32); }
#pragma unroll
        for (int ks = 0; ks < 5; ++ks) bg[ks] = *(const bf16x8*)(g2p + ks * 32);
        for (int rp_ = 0; rp_ < ((PROBE_DUP) == 64 ? 2 : 1); ++rp_)
        if (tl > 0) { const size_t tokb = (size_t)b * SEQ + (tl - 1) * 32;
          const f32x4 y4 = *(const LAS f32x4*)(YB + tt * 68 + j0), g4 = *(const LAS f32x4*)(GG + tt * 64 + j0);
          f32x4 v4;
#pragma unroll
          for (int e = 0; e < 4; ++e) v4[e] = __uint_as_float((unsigned)VT[(j0 + e) * LD32 + tt] << 16);
          float sm = (y4[0] + y4[1]) + (y4[2] + y4[3]); sm = red16(sm); const float mean = sm * (1.0f / 64.0f);
          const f32x4 d4 = y4 - mean; float sv = (d4[0] * d4[0] + d4[1] * d4[1]) + (d4[2] * d4[2] + d4[3] * d4[3]); sv = red16(sv);
          const float rstd = __builtin_amdgcn_rsqf(sv * (1.0f / 64.0f) + GN_EPS), bon = BON[tt];
          f32x4 o;
#pragma unroll
          for (int e = 0; e < 4; ++e) o[e] = (d4[e] * rstd * plw[e] + plb[e] + bon * v4[e]) * g4[e];
          v2u w; w.x = cvtpk(o[0], o[1]); w.y = cvtpk(o[2], o[3]);
          *(v2u*)(Y + (tokb + tt) * D + 1024 + hc) = w; }
        if (tl == SEQ / 32) break;
        const LAS bf16* S0c = S0B + cur * 64 * LD64; LAS bf16* S0n = S0B + (cur ^ 1) * 64 * LD64;
#pragma unroll
        for (int q = 0; q < 3; ++q) { int pi = tid + q * NTHR; pi = pi < 1152 ? pi : 1151; const int row = pi / 36, c = pi - row * 36;
                LAS bf16* dst = (c < 8) ? (LAW + row * 72 + c * 8) : ((c < 16) ? (LAA + row * 72 + (c - 8) * 8) : (LAG + row * 168 + (c - 16) * 8));
                *(LAS v4u*)dst = pl_[q]; }
        const f32x4 rc = RWKV_UNPK4(pc_[0]), kc = RWKV_UNPK4(pc_[1]), vc = RWKV_UNPK4(pc_[2]), rp = RWKV_UNPK4(pp_[0]), kp = RWKV_UNPK4(pp_[1]), vp = RWKV_UNPK4(pp_[2]);
        { const int tn_ = tl + 1 < SEQ / 32 ? tl + 1 : SEQ / 32 - 1; RWKV_PREFETCH(tn_); }
        __syncthreads();
        const int t = mt * 16 + fr, j4 = nt * 16 + fq * 4;
        f32x4 nau, bbu, km, rr, vv, cum;
        for (int rp_ = 0; rp_ < ((PROBE_DUP) == 60 ? 2 : 1); ++rp_)
        { f32x4 cw = (f32x4){0.f, 0.f, 0.f, 0.f}, ca = cw, cg = cw;
#pragma unroll
          for (int ks = 0; ks < 2; ++ks) { cw = MFMA16(bw[ks], FRAG(LAW, mt * 16, 72, ks), cw); ca = MFMA16(ba[ks], FRAG(LAA, mt * 16, 72, ks), ca); }
#pragma unroll
          for (int ks = 0; ks < 5; ++ks) cg = MFMA16(bg[ks], FRAG(LAG, mt * 16, 168, ks), cg);
          const f32x4 c_w0 = *(const LAS f32x4*)(CST + j4), c_a0 = *(const LAS f32x4*)(CST + 64 + j4), c_kk = *(const LAS f32x4*)(CST + 128 + j4), c_ka = *(const LAS f32x4*)(CST + 192 + j4), c_rk = *(const LAS f32x4*)(CST + 256 + j4);
          const f32x4 m_r = *(const LAS f32x4*)(CST + 320 + j4), m_k = *(const LAS f32x4*)(CST + 384 + j4), m_v = *(const LAS f32x4*)(CST + 448 + j4);
          rr = rc + (rp - rc) * m_r; const f32x4 kv = kc + (kp - kc) * m_k; vv = vc + (vp - vc) * m_v;
          float s2 = 0.f, bn = 0.f;
#pragma unroll
          for (int r = 0; r < 4; ++r) { const float av = sigmoid_fast(c_a0[r] + ca[r]), ku = kv[r] * c_kk[r]; km[r] = kv[r] * (1.0f + (av - 1.0f) * c_ka[r]);
              cum[r] = -0.6065306597126334f * sigmoid_fast(c_w0[r] + cw[r]);
              nau[r] = -ku; bbu[r] = ku * av; s2 += ku * ku; bn += rr[r] * km[r] * c_rk[r]; }
#pragma unroll
          for (int r = 0; r < 4; ++r) { float v = cum[r];
              v += __builtin_bit_cast(float, __builtin_amdgcn_update_dpp(0, __builtin_bit_cast(int, v), 0x111, 0xf, 0xf, true));
              v += __builtin_bit_cast(float, __builtin_amdgcn_update_dpp(0, __builtin_bit_cast(int, v), 0x112, 0xf, 0xf, true));
              v += __builtin_bit_cast(float, __builtin_amdgcn_update_dpp(0, __builtin_bit_cast(int, v), 0x114, 0xf, 0xf, true));
              v += __builtin_bit_cast(float, __builtin_amdgcn_update_dpp(0, __builtin_bit_cast(int, v), 0x118, 0xf, 0xf, true));
              cum[r] = v; }
          *(LAS f32x4*)(GG + t * 64 + j4) = cg;
          if (fr == 15) *(LAS f32x4*)(TOT + mt * 64 + j4) = cum;
          { auto x = __builtin_amdgcn_permlane16_swap(__float_as_uint(s2), __float_as_uint(s2), false, false); s2 = __uint_as_float(x[0]) + __uint_as_float(x[1]); }
          { auto x = __builtin_amdgcn_permlane32_swap(__float_as_uint(s2), __float_as_uint(s2), false, false); s2 = __uint_as_float(x[0]) + __uint_as_float(x[1]); }
          { auto x = __builtin_amdgcn_permlane16_swap(__float_as_uint(bn), __float_as_uint(bn), false, false); bn = __uint_as_float(x[0]) + __uint_as_float(x[1]); }
          { auto x = __builtin_amdgcn_permlane32_swap(__float_as_uint(bn), __float_as_uint(bn), false, false); bn = __uint_as_float(x[0]) + __uint_as_float(x[1]); }
          if (fq == 0) { SSP[t * 4 + nt] = s2; BNP[t * 4 + nt] = bn; } }
        __syncthreads();
        for (int rp_ = 0; rp_ < ((PROBE_DUP) == 61 ? 2 : 1); ++rp_)
        { const f32x4 sp = *(const LAS f32x4*)(SSP + t * 4); const float inv = __builtin_amdgcn_rsqf(fmaxf((sp[0] + sp[1]) + (sp[2] + sp[3]), 1e-24f));
          f32x4 addt = (f32x4){0.f, 0.f, 0.f, 0.f}; if (mt) addt = *(const LAS f32x4*)(TOT + j4);
          f32x4 at4, rt4, bt4, kt4;
#pragma unroll
          for (int r = 0; r < 4; ++r) { const float run = cum[r] + addt[r], ep = __expf(run), em = rcpf_(ep);
              float eprev = __builtin_bit_cast(float, __builtin_amdgcn_update_dpp(0, __builtin_bit_cast(int, ep), 0x111, 0xf, 0xf, true));
              if (fr == 0) eprev = mt ? __expf(addt[r]) : 1.0f;
              at4[r] = nau[r] * inv * eprev; rt4[r] = rr[r] * ep; bt4[r] = bbu[r] * inv * em; kt4[r] = km[r] * em;
              if (t == 31) PC[j4 + r] = ep; }
          v2u w; w.x = cvtpk(at4[0], at4[1]); w.y = cvtpk(at4[2], at4[3]); *(LAS v2u*)(AT + t * LD64 + j4) = w;
          w.x = cvtpk(rt4[0], rt4[1]); w.y = cvtpk(rt4[2], rt4[3]); *(LAS v2u*)(RT + t * LD64 + j4) = w;
          const unsigned b01 = cvtpk(bt4[0], bt4[1]), b23 = cvtpk(bt4[2], bt4[3]), k01 = cvtpk(kt4[0], kt4[1]), k23 = cvtpk(kt4[2], kt4[3]), v01 = cvtpk(vv[0], vv[1]), v23 = cvtpk(vv[2], vv[3]);
          w.x = b01; w.y = b23; *(LAS v2u*)(BT_ + t * LD64 + j4) = w; w.x = k01; w.y = k23; *(LAS v2u*)(KT_ + t * LD64 + j4) = w;
          BTT[(j4 + 0) * LD32 + t] = (bf16)(b01 & 0xffffu); BTT[(j4 + 1) * LD32 + t] = (bf16)(b01 >> 16); BTT[(j4 + 2) * LD32 + t] = (bf16)(b23 & 0xffffu); BTT[(j4 + 3) * LD32 + t] = (bf16)(b23 >> 16);
          KTT[(j4 + 0) * LD32 + t] = (bf16)(k01 & 0xffffu); KTT[(j4 + 1) * LD32 + t] = (bf16)(k01 >> 16); KTT[(j4 + 2) * LD32 + t] = (bf16)(k23 & 0xffffu); KTT[(j4 + 3) * LD32 + t] = (bf16)(k23 >> 16);
          VT[(j4 + 0) * LD32 + t] = (bf16)(v01 & 0xffffu); VT[(j4 + 1) * LD32 + t] = (bf16)(v01 >> 16); VT[(j4 + 2) * LD32 + t] = (bf16)(v23 & 0xffffu); VT[(j4 + 3) * LD32 + t] = (bf16)(v23 >> 16);
          if (nt == 0 && fq == 0) { const f32x4 bp = *(const LAS f32x4*)(BNP + t * 4); BON[t] = (bp[0] + bp[1]) + (bp[2] + bp[3]); } }
        __syncthreads();
        for (int rq_ = 0; rq_ < ((PROBE_DUP) == 62 ? 2 : 1); ++rq_) {
        if ((PROBE_DUP) == 50) { __syncthreads(); __syncthreads(); __syncthreads(); __syncthreads(); }
        for (int rp_ = 0; rp_ < ((PROBE_DUP) == 41 ? 2 : 1); ++rp_)
        { const int q = wave & 3, tq = (q >> 1) * 16, sq = (q & 1) * 16; const bool zt = sq > tq;
#pragma unroll
            for (int mi = 0; mi < 2; ++mi) { const int mtx = (wave < 4) ? mi : 2; if (wave >= 4 && mi == 1) break;
                const LAS bf16* Xs = (mtx == 1) ? BT_ : KT_; const LAS bf16* Yt = (mtx == 0) ? AT : RT; LAS bf16* O = (mtx == 0) ? AAK : (mtx == 1 ? ARB : ARK);
                f32x4 a4 = (f32x4){0.f, 0.f, 0.f, 0.f};
                if (!zt) {
#pragma unroll
                    for (int ks = 0; ks < 2; ++ks) a4 = MFMA16(FRAG(Xs, sq, LD64, ks), FRAG(Yt, tq, LD64, ks), a4); }
                const int t = tq + fr, s = sq + fq * 4;
#pragma unroll
                for (int r = 0; r < 4; ++r) { const bool keep = (mtx == 0) ? (s + r < t) : (s + r <= t); a4[r] = keep ? a4[r] : 0.f; }
                v2u w; w.x = cvtpk(a4[0], a4[1]); w.y = cvtpk(a4[2], a4[3]); *(LAS v2u*)(O + t * LD32 + s) = w; } }
        if (wave >= 4) { const int q = wave - 4, tq = (q >> 1) * 16, sq = (q & 1) * 16;
            f32x4 a4 = (f32x4){0.f, 0.f, 0.f, 0.f};
            if (sq <= tq) {
#pragma unroll
            for (int ks = 0; ks < 2; ++ks) a4 = MFMA16(FRAG(BT_, sq, LD64, ks), FRAG(AT, tq, LD64, ks), a4); }
            const int t = tq + fr, s = sq + fq * 4;
#pragma unroll
            for (int r = 0; r < 4; ++r) { a4[r] = (s + r < t) ? a4[r] : 0.f; XTB[(s + r) * LD32 + t] = (bf16)(cvtpk(a4[r], 0.f) & 0xffffu); }
            v2u w; w.x = cvtpk(a4[0], a4[1]); w.y = cvtpk(a4[2], a4[3]); *(LAS v2u*)(XB_ + t * LD32 + s) = w;
#pragma unroll
            for (int r = 0; r < 4; ++r) pmacc[r] = a4[r] + ((s + r == t) ? 1.0f : 0.f);
            w.x = cvtpk(pmacc[0], pmacc[1]); w.y = cvtpk(pmacc[2], pmacc[3]); *(LAS v2u*)(PMB + t * LD32 + s) = w; }
        __syncthreads();
#pragma unroll
        for (int ns = 0; ns < 5; ++ns) { const int cb = ns & 1, nb = cb ^ 1;
            const LAS bf16* Xc = XB_ + cb * 32 * LD32; const LAS bf16* XTc = XTB + cb * 32 * LD32; const LAS bf16* Pc = PMB + cb * 32 * LD32;
            LAS bf16* Xn = XB_ + nb * 32 * LD32; LAS bf16* XTn = XTB + nb * 32 * LD32; LAS bf16* Pn = PMB + nb * 32 * LD32;
            if (wave < 4) { if (ns < 4) { const int tq = (wave >> 1) * 16, sq = (wave & 1) * 16;
                    f32x4 a4 = (f32x4){0.f, 0.f, 0.f, 0.f}; a4 = MFMA16(FRAG(XTc, sq, LD32, 0), FRAG(Xc, tq, LD32, 0), a4);
                    const int t = tq + fr, s = sq + fq * 4;
#pragma unroll
                    for (int r = 0; r < 4; ++r) XTn[(s + r) * LD32 + t] = (bf16)(cvtpk(a4[r], 0.f) & 0xffffu);
                    v2u w; w.x = cvtpk(a4[0], a4[1]); w.y = cvtpk(a4[2], a4[3]); *(LAS v2u*)(Xn + t * LD32 + s) = w; } }
            else { const int q = wave - 4, tq = (q >> 1) * 16, sq = (q & 1) * 16;
                if (ns > 0) pmacc = MFMA16(FRAG(XTc, sq, LD32, 0), FRAG(Pc, tq, LD32, 0), pmacc);
                const int t = tq + fr, s = sq + fq * 4;
                v2u w; w.x = cvtpk(pmacc[0], pmacc[1]); w.y = cvtpk(pmacc[2], pmacc[3]); *(LAS v2u*)(Pn + t * LD32 + s) = w; }
            if (ns == 1 && rq_ == 0) {
                f32x4 a4 = (f32x4){0.f, 0.f, 0.f, 0.f};
#pragma unroll
                for (int ks = 0; ks < 2; ++ks) a4 = MFMA16(FRAG(AT, t0m, LD64, ks), FRAG(S0c, i0, LD64, ks), a4);
                a4 = MFMA16(FRAG(AAK, t0m, LD32, 0), FRAG(VT, i0, LD32, 0), a4);
                v2u w; w.x = cvtpk(a4[0], a4[1]); w.y = cvtpk(a4[2], a4[3]); *(LAS v2u*)(RHS + (i0 + fr) * LD32 + t0m + fq * 4) = w; }
            if (ns == 2 && rq_ == 0) {
                yacc = (f32x4){0.f, 0.f, 0.f, 0.f};
#pragma unroll
                for (int ks = 0; ks < 2; ++ks) yacc = MFMA16(FRAG(S0c, i0, LD64, ks), FRAG(RT, t0m, LD64, ks), yacc);
                yacc = MFMA16(FRAG(VT, i0, LD32, 0), FRAG(ARK, t0m, LD32, 0), yacc); }
            if (ns == 3 && rq_ == 0) {
#pragma unroll
                for (int u = 0; u < 2; ++u) { const int tile = wave * 2 + u, si0 = (tile >> 2) * 16, sj0 = (tile & 3) * 16; sacc[u] = MFMA16(FRAG(KTT, sj0, LD32, 0), FRAG(VT, si0, LD32, 0), sacc[u]); } }
            __syncthreads();
        }
        }
        const LAS bf16* MINV = PMB + 1 * 32 * LD32;
        for (int rp_ = 0; rp_ < ((PROBE_DUP) == 63 ? 2 : 1); ++rp_)
        { f32x4 a4 = (f32x4){0.f, 0.f, 0.f, 0.f}; a4 = MFMA16(FRAG(MINV, t0m, LD32, 0), FRAG(RHS, i0, LD32, 0), a4);
          v2u w; w.x = cvtpk(a4[0], a4[1]); w.y = cvtpk(a4[2], a4[3]); *(LAS v2u*)(SAB + (i0 + fr) * LD32 + t0m + fq * 4) = w; }
        __syncthreads();
        { yacc = MFMA16(FRAG(SAB, i0, LD32, 0), FRAG(ARB, t0m, LD32, 0), yacc);
          *(LAS f32x4*)(YB + (t0m + fr) * 68 + i0 + fq * 4) = yacc;
#pragma unroll
          for (int u = 0; u < 2; ++u) { const int tile = wave * 2 + u, si0 = (tile >> 2) * 16, sj0 = (tile & 3) * 16;
              sacc[u] = MFMA16(FRAG(BTT, sj0, LD32, 0), FRAG(SAB, si0, LD32, 0), sacc[u]);
              const f32x4 pc = *(const LAS f32x4*)(PC + sj0 + fq * 4); sacc[u] = sacc[u] * pc;
              v2u w; w.x = cvtpk(sacc[u][0], sacc[u][1]); w.y = cvtpk(sacc[u][2], sacc[u][3]); *(LAS v2u*)(S0n + (si0 + fr) * LD64 + sj0 + fq * 4) = w; } }
        __syncthreads();
    }
    __syncthreads();
#undef FRAG
#undef RWKV_PREFETCH
#undef RWKV_UNPK4
}
__device__ __forceinline__ void lora_prepass(const Frame& F) {
    const bf16* PROJ = WSP(bf16, WS_PROJ); bf16* LA = WSP(bf16, WS_LA); const float* mu = F.in[I_MU] + (PC_WD - RWKV_C0);
    const int gt = (F.bid * NWAVES + F.wave) * 64 + F.lane, NGT = F.G * NTHR;
    for (int i = gt; i < T * 36; i += NGT) { const int tok = i / 36, cc = i - tok * 36, m = cc * 8;
        const bf16* pr = PROJ + (size_t)tok * NINP + PC_WD + m;
        const v4u curv = *(const v4u*)pr; v4u prv = (v4u){0u, 0u, 0u, 0u}; if ((tok & (SEQ - 1)) != 0) prv = *(const v4u*)(pr - NINP);
        const f32x4 m0 = *(const f32x4*)(mu + m), m1 = *(const f32x4*)(mu + m + 4);
        float c[8], p[8], o[8]; unpack8(curv, c); unpack8(prv, p);
#pragma unroll
        for (int e = 0; e < 8; ++e) { const float ps = c[e] + (p[e] - c[e]) * (e < 4 ? m0[e] : m1[e - 4]); o[e] = (m < 64) ? tanh_fast(ps) : ((m < 128) ? ps : sigmoid_fast(ps)); }
        v4u w; w.x = cvtpk(o[0], o[1]); w.y = cvtpk(o[2], o[3]); w.z = cvtpk(o[4], o[5]); w.w = cvtpk(o[6], o[7]);
        *(v4u*)(LA + (size_t)tok * 288 + m) = w; }
}
__device__ __forceinline__ void lru_seq(const Frame& F, int bh) {
    const int b = bh >> 3, h = bh & 7, wave = F.wave; int tid = F.tid; asm volatile("" : "+v"(tid)); const int lane = tid & 63;
    LAS unsigned char* L = F.lds;
    LAS bf16* XA = (LAS bf16*)(L + 0);
    LAS float* XC = (LAS float*)(L + 17408);
    LAS float* RI = (LAS float*)(L + 50176);
    LAS float* SEG = (LAS float*)(L + 115712);
    LAS float* CARRY = (LAS float*)(L + 119808);
    LAS float* CW = (LAS float*)(L + 120320);
    const bf16* PROJ = WSP(bf16, WS_PROJ); bf16* Y = WSP(bf16, WS_Y);
    const int fr0 = lane & 15, fq0 = lane >> 4;
    for (int i = tid; i < 640; i += NTHR) { const int w = i >> 7, cch = i & 127; CW[i] = (w < 4) ? F.in[I_CONVW][w * 1024 + h * 128 + cch] : F.in[I_CONVB][h * 128 + cch]; }
    if (tid < 128) CARRY[tid] = 0.f;
    const int gsel = wave & 1, nt0 = (wave >> 1) * 2;
    bf16x8 wf[2][4];
    { const bf16* WTp = (gsel ? WSP(bf16, WS_WIT) : WSP(bf16, WS_WAT)) + (size_t)h * 128 * 128;
#pragma unroll
      for (int n = 0; n < 2; ++n)
#pragma unroll
          for (int ks = 0; ks < 4; ++ks) wf[n][ks] = *(const bf16x8*)(WTp + ((nt0 + n) * 16 + fr0) * 128 + ks * 32 + 8 * fq0); }
    const int c = tid & 127, sg = tid >> 7, chg = h * 128 + c;
    const float ba_c = F.in[I_BA][chg], bi_c = F.in[I_BI][chg], sp8 = 8.0f * softplus_fast(-F.in[I_LAM][chg]);
    v4u pf[2][4];
#define LRU_PREFETCH(k_) do { _Pragma("unroll") for (int u_ = 0; u_ < 2; ++u_) { const int chn_ = tid + NTHR * u_, t_ = chn_ >> 4, c8_ = (chn_ & 15) * 8; \
        _Pragma("unroll") for (int w_ = 0; w_ < 4; ++w_) { const int ts_ = (k_) * 64 + t_ - 3 + w_; const int tc_ = ts_ >= 0 ? ts_ : 0;   \
            const v4u x_ = *(const v4u*)(PROJ + ((size_t)b * SEQ + tc_) * NINP + h * 128 + c8_); const unsigned m_ = ts_ >= 0 ? 0xffffffffu : 0u; \
            pf[u_][w_] = (v4u){x_.x & m_, x_.y & m_, x_.z & m_, x_.w & m_}; } } } while (0)
    LRU_PREFETCH(0);
    __syncthreads();
    for (int k = 0; k < SEQ / 64; ++k) {
        const size_t tokbase = (size_t)b * SEQ + k * 64;
        int lane_c = lane; asm volatile("" : "+v"(lane_c)); const int fr = lane_c & 15, fq = lane_c >> 4;
#pragma unroll
        for (int u = 0; u < 2; ++u) { const int chn = tid + NTHR * u, t = chn >> 4, c8 = (chn & 15) * 8;
            float acc[8]; { const f32x4 b0 = *(const LAS f32x4*)(CW + 512 + c8), b1 = *(const LAS f32x4*)(CW + 512 + c8 + 4);
#pragma unroll
                for (int e = 0; e < 4; ++e) { acc[e] = b0[e]; acc[e + 4] = b1[e]; } }
#pragma unroll
            for (int w = 0; w < 4; ++w) { float xf[8]; unpack8(pf[u][w], xf);
                const f32x4 w0 = *(const LAS f32x4*)(CW + w * 128 + c8), w1 = *(const LAS f32x4*)(CW + w * 128 + c8 + 4);
#pragma unroll
                for (int e = 0; e < 4; ++e) { acc[e] += w0[e] * xf[e]; acc[e + 4] += w1[e] * xf[e + 4]; } }
            v4u pk; pk.x = cvtpk(acc[0], acc[1]); pk.y = cvtpk(acc[2], acc[3]); pk.z = cvtpk(acc[4], acc[5]); pk.w = cvtpk(acc[6], acc[7]);
            *(LAS v4u*)(XA + t * 136 + c8) = pk;
            LAS float* d = XC + t * 128 + c8; *(LAS f32x4*)d = (f32x4){acc[0], acc[1], acc[2], acc[3]}; *(LAS f32x4*)(d + 4) = (f32x4){acc[4], acc[5], acc[6], acc[7]}; }
        { const int kn_ = k + 1 < SEQ / 64 ? k + 1 : SEQ / 64 - 1; LRU_PREFETCH(kn_); }
        unsigned short gt[16];
#pragma unroll
        for (int e = 0; e < 16; ++e) gt[e] = PROJ[(tokbase + sg * 16 + e) * NINP + PC_GATE + chg];
        __syncthreads();
#pragma unroll
        for (int mt = 0; mt < 4; ++mt) {
            bf16x8 af[4];
#pragma unroll
            for (int ks = 0; ks < 4; ++ks) af[ks] = *(const LAS bf16x8*)(XA + (mt * 16 + fr) * 136 + ks * 32 + 8 * fq);
#pragma unroll
            for (int n = 0; n < 2; ++n) { f32x4 a4 = (f32x4){0.f, 0.f, 0.f, 0.f};
#pragma unroll
                for (int ks = 0; ks < 4; ++ks) a4 = MFMA16(wf[n][ks], af[ks], a4);
                *(LAS f32x4*)(RI + gsel * 8192 + (mt * 16 + fr) * 128 + (nt0 + n) * 16 + fq * 4) = a4; } }
        __syncthreads();
        float av[16], bx[16]; float A = 1.f, B = 0.f;
#pragma unroll
        for (int e = 0; e < 16; ++e) { const int t = sg * 16 + e; const float r = sigmoid_fast(RI[t * 128 + c] + ba_c), ig = sigmoid_fast(RI[8192 + t * 128 + c] + bi_c), xc = XC[t * 128 + c];
            const float la = -sp8 * r; av[e] = __expf(la); bx[e] = sqrtf(fmaxf(1.0f - av[e] * av[e], 0.f)) * (ig * xc); A *= av[e]; B = av[e] * B + bx[e]; }
        SEG[(sg * 128 + c) * 2] = A; SEG[(sg * 128 + c) * 2 + 1] = B;
        __syncthreads();
        float hst = CARRY[c];
        for (int s2 = 0; s2 < sg; ++s2) hst = SEG[(s2 * 128 + c) * 2] * hst + SEG[(s2 * 128 + c) * 2 + 1];
#pragma unroll
        for (int e = 0; e < 16; ++e) { hst = av[e] * hst + bx[e];
            const float g = __uint_as_float((unsigned)gt[e] << 16);
            Y[(tokbase + sg * 16 + e) * D + chg] = (bf16)(cvtpk(hst * gelu_fast(g), 0.f) & 0xffffu); }
        __syncthreads();
        if (sg == 3) CARRY[c] = hst;
    }
    __syncthreads();
#undef LRU_PREFETCH
}
__device__ __forceinline__ void group_barrier(unsigned* cnt, unsigned n) {
    asm volatile("s_waitcnt vmcnt(0)" ::: "memory");
    __syncthreads();
    if (threadIdx.x == 0) {
        __builtin_amdgcn_fence(__ATOMIC_RELEASE, "agent");
        asm volatile("s_waitcnt vmcnt(0)" ::: "memory");
        xb_add(cnt, 1u);
        unsigned sp = 0; while (xb_ld(cnt) < n) { __builtin_amdgcn_s_sleep(2); if (++sp > (1u << 24)) break; }
        __builtin_amdgcn_fence(__ATOMIC_ACQUIRE, "agent");
        asm volatile("s_waitcnt vmcnt(0)" ::: "memory");
    }
    __syncthreads();
}

__device__ __forceinline__ unsigned f2ord(float f) { const unsigned u = __builtin_bit_cast(unsigned, f); return (u & 0x80000000u) ? ~u : (u | 0x80000000u); }
__device__ __forceinline__ float ord2f(unsigned o) { const unsigned u = (o & 0x80000000u) ? (o & 0x7fffffffu) : ~o; return __builtin_bit_cast(float, u); }
#define CMPX(hi_, lo_) do { const unsigned _a = (hi_), _b = (lo_); (hi_) = _a > _b ? _a : _b; (lo_) = _a > _b ? _b : _a; } while (0)
template <int N> __device__ __forceinline__ void sort_desc(unsigned (&a)[N]) {
#pragma unroll
    for (int k = 2; k <= N; k <<= 1)
#pragma unroll
        for (int j = k >> 1; j > 0; j >>= 1)
#pragma unroll
            for (int i = 0; i < N; ++i) { const int l = i ^ j; if (l > i) { if ((i & k) == 0) CMPX(a[i], a[l]); else CMPX(a[l], a[i]); } }
}
__device__ __forceinline__ void merge16(unsigned (&A)[16], const unsigned (&B)[16]) {
#pragma unroll
    for (int i = 0; i < 16; ++i) { const unsigned q = B[15 - i]; A[i] = A[i] > q ? A[i] : q; }
#pragma unroll
    for (int d = 8; d >= 1; d >>= 1)
#pragma unroll
        for (int i = 0; i < 16; ++i) if ((i & d) == 0) CMPX(A[i], A[i + d]);
}
__device__ __forceinline__ void merge_partner(unsigned (&Lk)[16]) {
    unsigned P[16];
#pragma unroll
    for (int i = 0; i < 16; ++i) P[i] = (unsigned)__shfl_xor((int)Lk[i], 32);
#pragma unroll
    for (int i = 0; i < 16; ++i) { const unsigned q = P[15 - i]; Lk[i] = Lk[i] > q ? Lk[i] : q; }
#pragma unroll
    for (int d = 8; d >= 1; d >>= 1)
#pragma unroll
        for (int i = 0; i < 16; ++i) if ((i & d) == 0) CMPX(Lk[i], Lk[i + d]);
}
__device__ __forceinline__ void route_item(const Frame& F, int item, int lane) {
    const int tok0 = (item >> 3) * 32, h = item & 7, c = lane & 31, hi = lane >> 5;
    const bf16* Q = WSP(bf16, WS_Q); const bf16* KB = WSP(bf16, WS_KEYS);
    LAS unsigned* WL = (LAS unsigned*)(F.lds + F.wave * 8192);
    unsigned LST[2][16];
    bf16x8 qf[8], qn[8], kf[8], kn[8];
#pragma unroll
    for (int ks = 0; ks < 8; ++ks) { qf[ks] = *(const bf16x8*)(Q + (size_t)(tok0 + c) * D + h * 256 + ks * 16 + 8 * hi); qn[ks] = *(const bf16x8*)(Q + (size_t)(tok0 + c) * D + h * 256 + 128 + ks * 16 + 8 * hi);
        kf[ks] = *(const bf16x8*)(KB + (size_t)((h * 2) * 128 + c) * 128 + 8 * hi + ks * 16); }
    unsigned Lk[16];
#pragma unroll
    for (int st = 0; st < 8; ++st) { const int p = st >> 2, m = st & 3;
        if (st < 7) { const int p2 = (st + 1) >> 2, m2 = (st + 1) & 3; const bf16* kp = KB + (size_t)((h * 2 + p2) * 128 + m2 * 32 + c) * 128 + 8 * hi;
#pragma unroll
            for (int ks = 0; ks < 8; ++ks) kn[ks] = *(const bf16x8*)(kp + ks * 16); }
        f32x16 acc;
#pragma unroll
        for (int r = 0; r < 16; ++r) acc[r] = 0.f;
#pragma unroll
        for (int ks = 0; ks < 8; ++ks) acc = MFMA32(kf[ks], p ? qn[ks] : qf[ks], acc);
        unsigned G16[16];
#pragma unroll
        for (int r = 0; r < 16; ++r) { const unsigned idx = (unsigned)(m * 32 + (r & 3) + 8 * (r >> 2)) | ((unsigned)hi << 2); G16[r] = (f2ord(acc[r]) & ~0x7Fu) | idx; }
        sort_desc<16>(G16);
        if (m == 0) {
#pragma unroll
            for (int i = 0; i < 16; ++i) Lk[i] = G16[i]; }
        else merge16(Lk, G16);
        if (m == 3) { merge_partner(Lk);
#pragma unroll
            for (int i = 0; i < 16; ++i) { LST[p][i] = Lk[i]; WL[(p * 16 + i) * 64 + lane] = Lk[i] & 0x7Fu; } }
#pragma unroll
        for (int ks = 0; ks < 8; ++ks) kf[ks] = kn[ks];
    }
    float va[4], vb[16];
#pragma unroll
    for (int i = 0; i < 4; ++i) va[i] = ord2f((hi ? LST[1][i] : LST[0][i]) & ~0x7Fu);
#pragma unroll
    for (int j = 0; j < 16; ++j) vb[j] = ord2f((hi ? LST[0][j] : LST[1][j]) & ~0x7Fu);
    unsigned C32[32];
#pragma unroll
    for (int i = 0; i < 32; ++i) C32[i] = 0u;
#pragma unroll
    for (int i = 0; i < 4; ++i) { const unsigned key = (f2ord(va[i] + vb[i]) & ~0xFFu) | (unsigned)(i * 17); C32[i] = hi ? 0u : key; }
    { int cn = 4;
#pragma unroll
      for (int i = 0; i < 3; ++i)
#pragma unroll
          for (int j = i + 1; j < 16; ++j) if ((i + 1) * (j + 1) <= 16) { const unsigned code = hi ? (unsigned)(j * 16 + i) : (unsigned)(i * 16 + j); C32[cn] = (f2ord(va[i] + vb[j]) & ~0xFFu) | code; ++cn; } }
    sort_desc<32>(C32);
    unsigned Ck[16];
#pragma unroll
    for (int i = 0; i < 16; ++i) Ck[i] = C32[i];
    merge_partner(Ck);
    const float mx = ord2f(Ck[0] & ~0xFFu); float den = 0.f;
#pragma unroll
    for (int k = 0; k < 16; ++k) den += __expf(ord2f(Ck[k] & ~0xFFu) - mx);
    const float rden = 1.0f / den;
    int eo[8]; float go[8];
#pragma unroll
    for (int k = 0; k < 8; ++k) { const unsigned fm = hi ? Ck[k + 8] : Ck[k]; const unsigned code = fm & 0xFFu;
        const unsigned k0 = WL[(code >> 4) * 64 + lane], k1 = WL[(16 + (code & 15u)) * 64 + lane];
        eo[k] = (int)(k0 * 128u + k1); go[k] = __expf(ord2f(fm & ~0xFFu) - mx) * rden; }
    int* ep = WSP(int, WS_EXP) + (size_t)(tok0 + c) * NSEL + h * 16 + hi * 8; float* gp = WSP(float, WS_GATE) + (size_t)(tok0 + c) * NSEL + h * 16 + hi * 8;
    *(int4*)ep = make_int4(eo[0], eo[1], eo[2], eo[3]); *(int4*)(ep + 4) = make_int4(eo[4], eo[5], eo[6], eo[7]);
    *(f32x4*)gp = (f32x4){go[0], go[1], go[2], go[3]}; *(f32x4*)(gp + 4) = (f32x4){go[4], go[5], go[6], go[7]};
}

typedef float f32x2 __attribute__((ext_vector_type(2)));
__device__ __forceinline__ int dot4i(unsigned a, unsigned b, int c) { return __builtin_amdgcn_sdot4((int)a, (int)b, c, false); }
template <int CTRL> __device__ __forceinline__ int dppi(int x) { return __builtin_amdgcn_mov_dpp(x, CTRL, 0xf, 0xf, true); }
struct PeerGeom { int ngrp, g, rank, nrank; };
__device__ __forceinline__ PeerGeom peer_geom(const Frame& F) { PeerGeom p; p.ngrp = (F.G % 8 == 0) ? 8 : 1; p.g = F.bid % p.ngrp; p.rank = F.bid / p.ngrp; p.nrank = F.G / p.ngrp; return p; }
__device__ __forceinline__ void xquant_token(const Frame& F, int tok, int lane) {
    const bf16* xr = WSP(bf16, WS_XB) + (size_t)tok * D + lane * 16; float xf[32]; float am = 0.f;
#pragma unroll
    for (int hh = 0; hh < 2; ++hh)
#pragma unroll
        for (int q = 0; q < 2; ++q) { const v4u w = *(const v4u*)(xr + hh * 1024 + q * 8); float t8[8]; unpack8(w, t8);
#pragma unroll
            for (int e = 0; e < 8; ++e) { xf[hh * 16 + q * 8 + e] = t8[e]; am = fmaxf(am, fabsf(t8[e])); } }
#pragma unroll
    for (int o = 1; o < 64; o <<= 1) am = fmaxf(am, __shfl_xor(am, o));
    const float qs = am > 0.f ? 127.0f / am : 0.f;
    if (lane == 0) WSP(float, WS_SX)[tok] = am * (1.0f / 127.0f);
#pragma unroll
    for (int hh = 0; hh < 2; ++hh) { v4u o;
#pragma unroll
        for (int d = 0; d < 4; ++d) { unsigned w = 0u;
#pragma unroll
            for (int e = 0; e < 4; ++e) { const int qi = (int)rintf(xf[hh * 16 + d * 4 + e] * qs); w |= ((unsigned)qi & 0xFFu) << (8 * e); }
            o[d] = w; }
        *(v4u*)(WSP(unsigned char, WS_XQ) + (size_t)tok * D + hh * 1024 + lane * 16) = o; }
}
__device__ __forceinline__ void peer_score_slice(const Frame& F, int tok, int slice, int lane, LAS int* wl) {
    const int e8 = lane >> 3, c16 = lane & 7;
    const int* ep = WSP(int, WS_EXP) + (size_t)tok * NSEL;
    wl[lane] = ep[lane]; wl[64 + lane] = ep[64 + lane];
    const v4u xs = *(const v4u*)(WSP(unsigned char, WS_XQ) + (size_t)tok * D + slice * 128 + c16 * 16);
    const unsigned char* ub = WSP(unsigned char, WS_UT); const unsigned lo = (unsigned)(slice * 128 + c16 * 16);
    int p[16];
#pragma unroll
    for (int ld = 0; ld < 16; ++ld) { const unsigned eid = (unsigned)wl[e8 * 16 + ld]; const v4u w = *(const v4u*)(ub + (eid * 2048u + lo));
        int a = dot4i(w.x, xs.x, 0); a = dot4i(w.y, xs.y, a); a = dot4i(w.z, xs.z, a); p[ld] = dot4i(w.w, xs.w, a); }
    { const bool up = (lane & 4) != 0;
#pragma unroll
      for (int k = 0; k < 8; ++k) { const int keep = up ? p[k + 8] : p[k], send = up ? p[k] : p[k + 8]; p[k] = keep + dppi<0x141>(send); } }
    { const bool up = (lane & 2) != 0;
#pragma unroll
      for (int k = 0; k < 4; ++k) { const int keep = up ? p[k + 4] : p[k], send = up ? p[k] : p[k + 4]; p[k] = keep + dppi<0x4E>(send); } }
    { const bool up = (lane & 1) != 0;
#pragma unroll
      for (int k = 0; k < 2; ++k) { const int keep = up ? p[k + 2] : p[k], send = up ? p[k] : p[k + 2]; p[k] = keep + dppi<0xB1>(send); } }
    int* dst = WSP(int, WS_PART) + ((size_t)slice * T + tok) * NSEL + lane * 2;
    *(int2*)dst = make_int2(p[0], p[1]);
}
__device__ __forceinline__ void peer_coef_token(const Frame& F, int tok, int lane) {
    int s0 = 0, s1 = 0;
#pragma unroll
    for (int s = 0; s < 16; ++s) { const int2 v = *(const int2*)(WSP(int, WS_PART) + ((size_t)s * T + tok) * NSEL + lane * 2); s0 += v.x; s1 += v.y; }
    const int2 ex = *(const int2*)(WSP(int, WS_EXP) + (size_t)tok * NSEL + lane * 2); const f32x2 ga = *(const f32x2*)(WSP(float, WS_GATE) + (size_t)tok * NSEL + lane * 2);
    const float rs = WSP(float, WS_SX)[tok] * (1.0f / sqrtf(WSP(float, WS_SSQ2)[tok] * (1.0f / D) + NORM_EPS));
    const float sc0 = (float)s0 * WSP(float, WS_USC)[ex.x] * rs, sc1 = (float)s1 * WSP(float, WS_USC)[ex.y] * rs;
    f32x2 c; c.x = ga.x * gelu_fast(sc0) * WSP(float, WS_VSC)[ex.x]; c.y = ga.y * gelu_fast(sc1) * WSP(float, WS_VSC)[ex.y];
    float cm = fmaxf(fabsf(c.x), fabsf(c.y));
#pragma unroll
    for (int o = 1; o < 64; o <<= 1) cm = fmaxf(cm, __shfl_xor(cm, o));
    const float qs = cm > 0.f ? 127.0f / cm : 0.f;
    const int q0 = (int)rintf(c.x * qs), q1 = (int)rintf(c.y * qs);
    ((unsigned short*)(F.ws + WS_COEF))[(size_t)tok * 64 + lane] = (unsigned short)(((unsigned)q0 & 0xFFu) | (((unsigned)q1 & 0xFFu) << 8));
    if (lane == 0) WSP(float, WS_CSC)[tok] = cm * (1.0f / 127.0f);
}
struct PeerOutBuf { v4u w[16]; v4u cq; f32x2 x; float cs; };
__device__ __forceinline__ void peer_out_issue(const Frame& F, int tok, int slice, int lane, LAS int* wl, PeerOutBuf& B) {
    const int e8 = lane >> 3, c16 = lane & 7;
    const int* ep = WSP(int, WS_EXP) + (size_t)tok * NSEL;
    wl[lane] = ep[lane]; wl[64 + lane] = ep[64 + lane];
    B.cq = *(const v4u*)(F.ws + WS_COEF + (size_t)tok * 128 + e8 * 16);
    B.cs = WSP(float, WS_CSC)[tok];
    const unsigned char* vb = WSP(unsigned char, WS_VT); const unsigned lofs = (unsigned)(slice * 128 + c16 * 16);
#pragma unroll
    for (int ld = 0; ld < 16; ++ld) { const unsigned eid = (unsigned)wl[e8 * 16 + ld]; B.w[ld] = *(const v4u*)(vb + (eid * 2048u + lofs)); }
    B.x = *(const f32x2*)(F.out + (size_t)tok * D + slice * 128 + c16 * 16 + e8 * 2);
}
__device__ __forceinline__ void peer_out_consume(const Frame& F, int tok, int slice, int lane, LAS int* wl, const PeerOutBuf& B) {
    const int e8 = lane >> 3, c16 = lane & 7;
    int o[16];
#pragma unroll
    for (int i = 0; i < 16; ++i) o[i] = 0;
#pragma unroll
    for (int g = 0; g < 4; ++g) { const unsigned cq = B.cq[g];
#pragma unroll
        for (int d = 0; d < 4; ++d) { const unsigned w0 = B.w[4 * g][d], w1 = B.w[4 * g + 1][d], w2 = B.w[4 * g + 2][d], w3 = B.w[4 * g + 3][d];
            const unsigned lo01 = __builtin_amdgcn_perm(w1, w0, 0x05010400u), hi01 = __builtin_amdgcn_perm(w1, w0, 0x07030602u);
            const unsigned lo23 = __builtin_amdgcn_perm(w3, w2, 0x05010400u), hi23 = __builtin_amdgcn_perm(w3, w2, 0x07030602u);
            const unsigned t0 = __builtin_amdgcn_perm(lo23, lo01, 0x05040100u), t1 = __builtin_amdgcn_perm(lo23, lo01, 0x07060302u);
            const unsigned t2 = __builtin_amdgcn_perm(hi23, hi01, 0x05040100u), t3 = __builtin_amdgcn_perm(hi23, hi01, 0x07060302u);
            o[d * 4 + 0] = dot4i(t0, cq, o[d * 4 + 0]); o[d * 4 + 1] = dot4i(t1, cq, o[d * 4 + 1]); o[d * 4 + 2] = dot4i(t2, cq, o[d * 4 + 2]); o[d * 4 + 3] = dot4i(t3, cq, o[d * 4 + 3]); } }
#pragma unroll
    for (int k = 0; k < 8; ++k) { auto s = __builtin_amdgcn_permlane32_swap((unsigned)o[k], (unsigned)o[k + 8], false, false); o[k] = (int)(s[0] + s[1]); }
#pragma unroll
    for (int k = 0; k < 4; ++k) { auto s = __builtin_amdgcn_permlane16_swap((unsigned)o[k], (unsigned)o[k + 4], false, false); o[k] = (int)(s[0] + s[1]); }
    { const bool up = (lane & 8) != 0;
#pragma unroll
      for (int k = 0; k < 2; ++k) { const int keep = up ? o[k + 2] : o[k], send = up ? o[k] : o[k + 2]; o[k] = keep + dppi<0x128>(send); } }
    f32x2 x = B.x; x.x += (float)o[0] * B.cs; x.y += (float)o[1] * B.cs;
    *(f32x2*)(F.out + (size_t)tok * D + slice * 128 + c16 * 16 + e8 * 2) = x;
    float ss = x.x * x.x + x.y * x.y;
    ss += dppf<0xB1>(ss); ss += dppf<0x4E>(ss); ss += dppf<0x141>(ss); ss += dppf<0x140>(ss);
    { auto s = __builtin_amdgcn_permlane16_swap(__float_as_uint(ss), __float_as_uint(ss), false, false); ss = __uint_as_float(s[0]) + __uint_as_float(s[1]); }
    { auto s = __builtin_amdgcn_permlane32_swap(__float_as_uint(ss), __float_as_uint(ss), false, false); ss = __uint_as_float(s[0]) + __uint_as_float(s[1]); }
    if (lane == 0) atomicAdd(WSP(float, WS_SSQ3) + tok, ss);
}
__device__ __forceinline__ void peer_out_phase(const Frame& F, const PeerGeom& pg, LAS int* wl2) {
    const int lane = F.lane, first = pg.rank * NWAVES + F.wave, step = pg.nrank * NWAVES;
    LAS int* wlA = wl2; LAS int* wlB = wl2 + 256;
    for (int r = 0; r < 16 / pg.ngrp; ++r) { const int slice = r * pg.ngrp + pg.g;
        PeerOutBuf A, B;
        int tok = first;
        if (tok < T) peer_out_issue(F, tok, slice, lane, wlA, A);
        while (tok < T) {
            const int t1 = tok + step, t2 = tok + 2 * step;
            if (t1 < T) peer_out_issue(F, t1, slice, lane, wlB, B);
            peer_out_consume(F, tok, slice, lane, wlA, A);
            if (t1 >= T) break;
            if (t2 < T) peer_out_issue(F, t2, slice, lane, wlA, A);
            peer_out_consume(F, t1, slice, lane, wlB, B);
            tok = t2;
        }
    }
}
__device__ __forceinline__ void final_norm_phase(const Frame& F) {
    const int lane = F.lane, gw = F.bid * NWAVES + F.wave, NGW = F.G * NWAVES;
    const f32x4* gf = (const f32x4*)F.in[I_GF] + lane;
    f32x4 g[8];
#pragma unroll
    for (int j = 0; j < 8; ++j) g[j] = gf[64 * j];
    if (gw >= T) return;
    f32x4 va[8], vb[8]; float sa, sb;
#define FN_LOAD(v_, s_, tok_) do { const int tc_ = (tok_) < T ? (tok_) : T - 1; const f32x4* xi_ = (const f32x4*)(F.out + (size_t)tc_ * D) + lane; s_ = WSP(float, WS_SSQ3)[tc_]; \
        _Pragma("unroll") for (int j_ = 0; j_ < 8; ++j_) v_[j_] = xi_[64 * j_]; } while (0)
#define FN_STORE(v_, s_, tok_) do { f32x4* xo_ = (f32x4*)(F.out + (size_t)(tok_) * D) + lane; const float rs_ = 1.0f / sqrtf(s_ * (1.0f / D) + NORM_EPS); \
        _Pragma("unroll") for (int j_ = 0; j_ < 8; ++j_) xo_[64 * j_] = v_[j_] * rs_ * g[j_]; } while (0)
    FN_LOAD(va, sa, gw);
    for (int tok = gw; tok < T; tok += 2 * NGW) {
        FN_LOAD(vb, sb, tok + NGW);
        FN_STORE(va, sa, tok);
        FN_LOAD(va, sa, tok + 2 * NGW);
        if (tok + NGW < T) FN_STORE(vb, sb, tok + NGW);
    }
#undef FN_LOAD
#undef FN_STORE
}

struct Args { const float* in[28]; float* out; unsigned char* ws; int ph_lo, ph_hi, li, pad; };
__global__ void __launch_bounds__(NTHR, 2) hybrid_fwd(Args args) {
    extern __shared__ __attribute__((aligned(16))) unsigned char lds[];
    Frame F;
    F.lds = (LAS unsigned char*)lds;
    F.tid = threadIdx.x; F.lane = F.tid & 63; F.wave = __builtin_amdgcn_readfirstlane(F.tid >> 6);
    F.G = gridDim.x; F.bid = blockIdx.x;
#pragma unroll
    for (int i = 0; i < 28; ++i) F.in[i] = args.in[i];
    F.out = args.out; F.ws = args.ws;
    volatile LAS unsigned* MISC = (volatile LAS unsigned*)(F.lds + MISC_OFF);
    for (int u = F.tid; u < (LDS_BYTES - LDSCTL_OFF) / 4; u += NTHR) ((LAS unsigned*)(F.lds + LDSCTL_OFF))[u] = 0u;
    __syncthreads();
    unsigned* barw = (unsigned*)(F.ws + WS_CTL) + CW_BAR;
    XcdBarrier bar; bar.bar = barw; bar.x = 0; bar.st = nullptr;
    if (N_LAUNCHES == 1) bar = xcd_barrier_post(barw, MISC + 8);
    const int lo = args.ph_lo, hi = args.ph_hi;
#define IN(k) (lo <= (k) && (k) < hi)
#define SEAM(k) do { if (IN(k) && IN((k) + 1)) xcd_barrier(bar); } while (0)

#ifndef PROBE_DUP
#define PROBE_DUP -1
#endif
#define REPS(k) for (int rep_ = 0; rep_ < ((PROBE_DUP) == (k) ? 2 : 1); ++rep_)
    if (IN(0)) REPS(0) { p0_prologue<0>(F, F.bid, F.G); __syncthreads(); }
    SEAM(0);
    if (IN(1)) REPS(1) {
        pg8::Gemm g{WSP(const bf16, WS_XB), WSP(const bf16, WS_WIN), T, NINP, D}; pg8::StaticOrder S; S.init(T, NINP, F.G, F.bid);
        pg8::EpiRowScaleBf16<0> E{WSP(bf16, WS_PROJ), NINP, WSP(const float, WS_RSTD1), NORM_EPS};
        pg8::gemm_phase<pg8::EpiRowScaleBf16<0>, pg8::StaticOrder, true, true>(F.lds, g, S, E);
    }
    SEAM(1);
    if (IN(2)) REPS(2) {
        lora_prepass(F);
        group_barrier((unsigned*)(F.ws + WS_CTL) + CW_PREBAR, (unsigned)F.G);
        const int R1 = F.G >= 256 ? 128 : F.G, L0 = F.G >= 256 ? 128 : 0, NL = F.G - L0;
        if (F.bid < R1) for (int it = F.bid; it < 128; it += R1) rwkv_item(F, it);
        if (F.bid >= L0) {
            for (int it = F.bid - L0; it < 64; it += NL) lru_seq(F, it);
            for (int r3 = 0; r3 < ((PROBE_DUP) == 30 ? 2 : 1); ++r3) { p0_prologue<1>(F, F.bid - L0, NL); __syncthreads(); }
        }
    }
    SEAM(2);
    if (IN(3)) {
        pg8::Gemm g{WSP(const bf16, WS_Y), WSP(const bf16, WS_WOUT), T, D, D}; pg8::StaticOrder S; S.init(T, D, F.G, F.bid);
        pg8::EpiResidual E{F.in[I_X], F.out, WSP(bf16, WS_XB), WSP(float, WS_SSQ2), D};
        pg8::gemm_phase<pg8::EpiResidual, pg8::StaticOrder, true, true>(F.lds, g, S, E);
    }
    SEAM(3);
    if (IN(4)) REPS(4) {
        pg8::Gemm g{WSP(const bf16, WS_XB), WSP(const bf16, WS_WQ), T, D, D}; pg8::StaticOrder S; S.init(T, D, F.G, F.bid);
        pg8::EpiRowScaleBf16<1> E{WSP(bf16, WS_Q), D, WSP(const float, WS_SSQ2), NORM_EPS};
        pg8::gemm_phase<pg8::EpiRowScaleBf16<1>, pg8::StaticOrder, true, true>(F.lds, g, S, E);
    }
    if (IN(4)) { __syncthreads();
        pg8::StaticOrder S; S.init(T, D, F.G, F.bid); pg8::Unit u;
        for (int i = 0; S.next(i, u); ++i) route_item(F, ((u.pm * 8 + F.wave) << 3) | u.pn, F.lane);
        const int gw = F.bid * NWAVES + F.wave, NGW = F.G * NWAVES;
        for (int tok = gw; tok < T; tok += NGW) xquant_token(F, tok, F.lane); }
    if (IN(4) && IN(6)) xcd_barrier(bar);
    { const PeerGeom pg = peer_geom(F); LAS int* wl = (LAS int*)(F.lds + F.wave * 1024);
      if (IN(6)) REPS(6) { for (int r = 0; r < 16 / pg.ngrp; ++r) { const int slice = r * pg.ngrp + pg.g; for (int tok = pg.rank * NWAVES + F.wave; tok < T; tok += pg.nrank * NWAVES) peer_score_slice(F, tok, slice, F.lane, wl); } }
      SEAM(6);
      if (IN(7)) REPS(7) { const int gw = F.bid * NWAVES + F.wave, NGW = F.G * NWAVES; for (int tok = gw; tok < T; tok += NGW) peer_coef_token(F, tok, F.lane); }
      SEAM(7);
      if (IN(8)) peer_out_phase(F, pg, (LAS int*)(F.lds + 16384 + F.wave * 2048));
      SEAM(8);
      if (IN(9)) final_norm_phase(F); }
#undef IN
#undef SEAM
}

extern "C" void kernel_launch(void* const* d_in, const int* in_sizes, int n_in, void* d_out, int out_size, void* d_ws, size_t ws_size, hipStream_t stream) {
    static int grid = 0;
    if (grid == 0) {
        if (n_in != 28 || in_sizes[0] != T * D || out_size != T * D || ws_size < WS_END) { fprintf(stderr, "kernel_launch: shape/workspace mismatch: n_in %d in0 %d out %d ws %zu (need %zu)\n", n_in, n_in > 0 ? in_sizes[0] : -1, out_size, ws_size, (size_t)WS_END); grid = -1; return; }
        int dev = 0, cus = 0, per_cu = 0;
        if (hipGetDevice(&dev) != hipSuccess || hipDeviceGetAttribute(&cus, hipDeviceAttributeMultiprocessorCount, dev) != hipSuccess) { fprintf(stderr, "kernel_launch: device query failed\n"); grid = -1; return; }
        if (hipFuncSetAttribute((const void*)hybrid_fwd, hipFuncAttributeMaxDynamicSharedMemorySize, LDS_BYTES) != hipSuccess) { fprintf(stderr, "kernel_launch: hipFuncSetAttribute failed\n"); grid = -1; return; }
        if (hipOccupancyMaxActiveBlocksPerMultiprocessor(&per_cu, (const void*)hybrid_fwd, NTHR, LDS_BYTES) != hipSuccess || per_cu < 1) { fprintf(stderr, "kernel_launch: occupancy query says %d blocks per CU\n", per_cu); per_cu = 1; }
        (void)hipGetLastError();
        grid = cus;
    }
    if (grid < 0) return;
    if (hipMemsetAsync((char*)d_ws + WS_CTL, 0, CTL_ZERO_BYTES, stream) != hipSuccess) { fprintf(stderr, "kernel_launch: hipMemsetAsync failed\n"); return; }
    Args a{};
    for (int i = 0; i < 28; ++i) a.in[i] = (const float*)d_in[i];
    a.out = (float*)d_out; a.ws = (unsigned char*)d_ws;
    for (int li = 0; li < N_LAUNCHES; ++li) {
        a.ph_lo = (N_LAUNCHES == 1) ? 0 : li; a.ph_hi = (N_LAUNCHES == 1) ? N_PHASES : li + 1; a.li = li;
        hipLaunchKernelGGL(hybrid_fwd, dim3(grid), dim3(NTHR), LDS_BYTES, stream, a);
        const hipError_t le = hipPeekAtLastError();
        if (le != hipSuccess) { fprintf(stderr, "kernel_launch: launch %d failed: %s\n", li, hipGetErrorName(le)); break; }
    }
}
```

```cpp
#include <hip/hip_runtime.h>
#include <cstdio>
#include <cstdint>
namespace pg8 {
#define PG8_LAS __attribute__((address_space(3)))
typedef unsigned short bf16_t;
typedef short bf16x8 __attribute__((ext_vector_type(8)));
typedef float f32x4 __attribute__((ext_vector_type(4)));
typedef unsigned u32x4 __attribute__((ext_vector_type(4)));
constexpr int BM = 256, BK = 64, HALF = 128, HTB = HALF * BK * 2  , STAGE_BYTES = 8 * HTB, NXCD = 8, WGM = 8;

__host__ __device__ __forceinline__ int lds_byte(int r, int c) { const int st = (r >> 4) * 2 + (c >> 5), rr = r & 15, cc = c & 31, ob = rr * 64 + cc * 2; return st * 1024 + (ob ^ (((ob >> 9) & 1) << 5)); }
__host__ __device__ __forceinline__ void stage_rc(int b, int& R, int& C) { const int st = b / 1024, sb = b % 1024, swz = sb ^ (((sb >> 9) & 1) << 5); R = (st >> 1) * 16 + swz / 64; C = (st & 1) * 32 + (swz % 64) / 2; }
__host__ __device__ __forceinline__ int perm32(int rho) { const int n = rho >> 4, i = rho & 15; return 8 * (i >> 2) + 4 * n + (i & 3); }

struct Unit { int pm, pn; };
struct Gemm { const bf16_t* A; const bf16_t* Bt; int M, N, K; };

struct StaticOrder {
    int nM, nN, nwg, G, c;
    __host__ __device__ void init(int M, int N, int G_, int c_) { nM = M / BM; nN = N / BM; nwg = nM * nN; G = G_; c = c_; }
    __host__ __device__ bool next(int i, Unit& u) const {
        const long L = (long)i * G + c; if (L >= nwg) return false;
        int wgid = (int)L; { const int q = nwg / NXCD, r = nwg % NXCD, xcd = wgid % NXCD, off = wgid / NXCD; wgid = (xcd < r ? xcd * (q + 1) : r * (q + 1) + (xcd - r) * q) + off; }
        const int nig = WGM * nN, gid = wgid / nig, fm = gid * WGM, gsz = (nM - fm) < WGM ? (nM - fm) : WGM;
        u.pm = fm + ((wgid % nig) % gsz); u.pn = (wgid % nig) / gsz; return true;
    }
    __device__ __forceinline__ void a_ready(const Unit&) const {}
    __device__ __forceinline__ void done(const Unit&) const {}
};

__device__ __forceinline__ unsigned cvt_pk_bf16(float lo, float hi) { unsigned r; asm volatile("v_cvt_pk_bf16_f32 %0, %1, %2" : "=v"(r) : "v"(lo), "v"(hi)); return r; }
typedef float f32x2 __attribute__((ext_vector_type(2)));
typedef unsigned u32x2 __attribute__((ext_vector_type(2)));
template <int MODE> struct EpiRowScaleBf16 {
    static constexpr bool PERM = true, AFTER_DRAIN = false;
    bf16_t* O; int ldc; const float* rs; float eps;
    __device__ __forceinline__ void operator()(const f32x4 (&acc)[2][2][4][2], const Unit& u, int wr, int wc, int fr, int fq) const {
        const int row0 = u.pm * BM + wr * 64 + fr, col0 = u.pn * BM + wc * 32 + 8 * fq;
#pragma unroll
        for (int ai = 0; ai < 2; ++ai)
#pragma unroll
            for (int m = 0; m < 4; ++m) { const int r = row0 + ai * HALF + m * 16; float s = rs[r]; if (MODE == 1) s = 1.0f / sqrtf(s * (1.0f / 2048.0f) + eps);
                bf16_t* rowp = O + (size_t)r * ldc + col0;
#pragma unroll
                for (int bj = 0; bj < 2; ++bj) { const f32x4 v0 = acc[ai][bj][m][0] * s, v1 = acc[ai][bj][m][1] * s;
                    u32x4 w; w.x = cvt_pk_bf16(v0[0], v0[1]); w.y = cvt_pk_bf16(v0[2], v0[3]); w.z = cvt_pk_bf16(v1[0], v1[1]); w.w = cvt_pk_bf16(v1[2], v1[3]);
                    *(u32x4*)(rowp + bj * HALF) = w; } }
    }
};
struct EpiResidual {
    static constexpr bool PERM = false, AFTER_DRAIN = false;
    const float* base; float* out; bf16_t* outb; float* ssq; int ldc;
    __device__ __forceinline__ void operator()(const f32x4 (&acc)[2][2][4][2], const Unit& u, int wr, int wc, int fr, int fq) const {
        const int row0 = u.pm * BM + wr * 64 + fr, col0 = u.pn * BM + wc * 32 + 4 * fq;
#pragma unroll
        for (int ai = 0; ai < 2; ++ai)
#pragma unroll
            for (int m = 0; m < 4; ++m) { const int r = row0 + ai * HALF + m * 16; const size_t off = (size_t)r * ldc + col0; float q = 0.f;
#pragma unroll
                for (int bj = 0; bj < 2; ++bj)
#pragma unroll
                    for (int n = 0; n < 2; ++n) { const f32x4 bs = *(const f32x4*)(base + off + bj * HALF + n * 16); const f32x4 o = bs + acc[ai][bj][m][n];
                        *(f32x4*)(out + off + bj * HALF + n * 16) = o; q += (o[0] * o[0] + o[1] * o[1]) + (o[2] * o[2] + o[3] * o[3]);
                        u32x2 w; w.x = cvt_pk_bf16(o[0], o[1]); w.y = cvt_pk_bf16(o[2], o[3]); *(u32x2*)(outb + off + bj * HALF + n * 16) = w; }
                q += __shfl_xor(q, 16); q += __shfl_xor(q, 32);
                if (fq == 0) atomicAdd(ssq + r, q);
                asm volatile("" ::: "memory"); }
    }
};
template <class Epi, class Sched, bool ALIGN_EPI = false, bool SP2 = false>
__device__ __forceinline__ void gemm_phase(PG8_LAS unsigned char* lds, const Gemm g, const Sched& S, const Epi& E) {
    const int tid = threadIdx.x, wid = __builtin_amdgcn_readfirstlane(tid >> 6), lane = tid & 63, wr = wid >> 2, wc = wid & 3, fr = lane & 15, fq = lane >> 4;
    const int K = g.K, nt = K / BK;
    unsigned voffA[2], voffB[2];
#pragma unroll
    for (int i = 0; i < 2; ++i) { int R, C; stage_rc(tid * 16 + i * 8192, R, C); const int Rb = Epi::PERM ? ((R & ~31) + perm32(R & 31)) : R;
        voffA[i] = (unsigned)(R * K + C) * 2u; voffB[i] = (unsigned)(Rb * K + C) * 2u; }
    const size_t kstep = (size_t)(BK * 2);
    const size_t hstep = (size_t)HALF * K * 2;
    const size_t tstep = 2 * hstep;
    const unsigned ldsw = (unsigned)wid * 1024u;
    const int aoff = lds_byte(wr * 64 + fr, fq * 8), boff = lds_byte(wc * 32 + fr, fq * 8);
#define PG8_SA(b, h) (((b) * 2 + (h)) * HTB)
#define PG8_SB(b, h) ((4 + (b) * 2 + (h)) * HTB)
#define PG8_STAGE(bufoff, gbase, voff) do { _Pragma("unroll") for (int _i = 0; _i < 2; ++_i) \
        __builtin_amdgcn_global_load_lds((const unsigned*)((const char*)(gbase) + (voff)[_i]), (PG8_LAS unsigned*)(lds + (bufoff) + ldsw + _i * 8192), 16, 0, 0); } while (0)
#define PG8_LDA(dst, b, h) do { _Pragma("unroll") for (int m = 0; m < 4; ++m) _Pragma("unroll") for (int k = 0; k < 2; ++k) dst[m][k] = *(const PG8_LAS bf16x8*)(lds + PG8_SA(b, h) + aoff + m * 2048 + k * 1024); } while (0)
#define PG8_LDB(dst, b, h) do { _Pragma("unroll") for (int n = 0; n < 2; ++n) _Pragma("unroll") for (int k = 0; k < 2; ++k) dst[n][k] = *(const PG8_LAS bf16x8*)(lds + PG8_SB(b, h) + boff + n * 2048 + k * 1024); } while (0)
#define PG8_MMA(ai, bj, At, Bt) do { __builtin_amdgcn_s_setprio(1); _Pragma("unroll") for (int m = 0; m < 4; ++m) _Pragma("unroll") for (int n = 0; n < 2; ++n) _Pragma("unroll") for (int k = 0; k < 2; ++k) \
        acc[ai][bj][m][n] = __builtin_amdgcn_mfma_f32_16x16x32_bf16(Bt[n][k], At[m][k], acc[ai][bj][m][n], 0, 0, 0); __builtin_amdgcn_s_setprio(0); } while (0)
#define PG8_WAIT_V(n) asm volatile("s_waitcnt vmcnt(" #n ")" ::: "memory")
#define PG8_WAIT_L(n) asm volatile("s_waitcnt lgkmcnt(" #n ")" ::: "memory")
#define PG8_BAR __builtin_amdgcn_s_barrier()
#define PG8_SCHED __builtin_amdgcn_sched_barrier(0)
    Unit cur, nxt; int ui = 0;
    if (!S.next(0, cur)) return;
    f32x4 acc[2][2][4][2];
#pragma unroll
    for (int a = 0; a < 2; ++a)
#pragma unroll
        for (int b = 0; b < 2; ++b)
#pragma unroll
            for (int m = 0; m < 4; ++m)
#pragma unroll
                for (int n = 0; n < 2; ++n) acc[a][b][m][n] = (f32x4){0.f, 0.f, 0.f, 0.f};
    bf16x8 At[4][2], B0[2][2], B1[2][2];
    const char* cA = (const char*)g.A + (size_t)cur.pm * tstep; const char* cB = (const char*)g.Bt + (size_t)cur.pn * tstep;
    S.a_ready(cur);
    if constexpr (SP2) {
        PG8_STAGE(PG8_SB(0, 0), cB, voffB); PG8_STAGE(PG8_SB(0, 1), cB + hstep, voffB); PG8_STAGE(PG8_SA(0, 0), cA, voffA); PG8_STAGE(PG8_SA(0, 1), cA + hstep, voffA);
        if (wr == 1) PG8_BAR;
        PG8_WAIT_V(2); PG8_BAR;
        PG8_STAGE(PG8_SB(1, 0), cB + kstep, voffB); PG8_STAGE(PG8_SA(1, 0), cA + kstep, voffA); PG8_STAGE(PG8_SB(1, 1), cB + hstep + kstep, voffB);
        PG8_WAIT_V(6); PG8_BAR;
    } else {
        PG8_STAGE(PG8_SB(0, 0), cB, voffB); PG8_STAGE(PG8_SA(0, 0), cA, voffA); PG8_STAGE(PG8_SB(0, 1), cB + hstep, voffB); PG8_STAGE(PG8_SA(0, 1), cA + hstep, voffA);
        if (wr == 1) PG8_BAR;
        PG8_WAIT_V(4); PG8_BAR;
        PG8_STAGE(PG8_SB(1, 0), cB + kstep, voffB); PG8_STAGE(PG8_SA(1, 0), cA + kstep, voffA); PG8_STAGE(PG8_SB(1, 1), cB + hstep + kstep, voffB);
        PG8_WAIT_V(6); PG8_BAR;
    }
    for (;;) {
        const bool has_next = S.next(ui + 1, nxt);
        const char* nA = has_next ? (const char*)g.A + (size_t)nxt.pm * tstep : cA; const char* nB = has_next ? (const char*)g.Bt + (size_t)nxt.pn * tstep : cB;
        for (int t = 0; t < nt; t += 2) {
            const bool last = (t == nt - 2);
            const char* a1 = cA + (size_t)(t + 1) * kstep;
            const char* a2 = last ? nA : cA + (size_t)(t + 2) * kstep; const char* b2 = last ? nB : cB + (size_t)(t + 2) * kstep;
            const char* a3 = a2 + kstep; const char* b3 = b2 + kstep;
            if (last && has_next) S.a_ready(nxt);
            if constexpr (SP2) {
            PG8_LDB(B0, 0, 0); PG8_LDB(B1, 0, 1); PG8_SCHED; PG8_LDA(At, 0, 0); PG8_STAGE(PG8_SA(1, 1), a1 + hstep, voffA);
            PG8_WAIT_V(8); PG8_WAIT_L(0); PG8_BAR; PG8_MMA(0, 0, At, B0); PG8_MMA(0, 1, At, B1); PG8_BAR; PG8_SCHED;
            PG8_LDA(At, 0, 1); PG8_STAGE(PG8_SB(0, 0), b2, voffB); PG8_STAGE(PG8_SB(0, 1), b2 + hstep, voffB); PG8_STAGE(PG8_SA(0, 0), a2, voffA);
            PG8_WAIT_V(8); PG8_WAIT_L(0); PG8_BAR; PG8_MMA(1, 0, At, B0); PG8_MMA(1, 1, At, B1); PG8_BAR; PG8_SCHED;
            PG8_LDB(B0, 1, 0); PG8_LDB(B1, 1, 1); PG8_SCHED; PG8_LDA(At, 1, 0); PG8_STAGE(PG8_SA(0, 1), a2 + hstep, voffA);
            PG8_WAIT_V(8); PG8_WAIT_L(0); PG8_BAR; PG8_MMA(0, 0, At, B0); PG8_MMA(0, 1, At, B1); PG8_BAR; PG8_SCHED;
            PG8_LDA(At, 1, 1); PG8_STAGE(PG8_SB(1, 0), b3, voffB); PG8_STAGE(PG8_SB(1, 1), b3 + hstep, voffB); PG8_STAGE(PG8_SA(1, 0), a3, voffA);
            PG8_WAIT_V(8); PG8_WAIT_L(0); PG8_BAR; PG8_MMA(1, 0, At, B0); PG8_MMA(1, 1, At, B1); PG8_BAR; PG8_SCHED;
            } else {
            PG8_LDB(B0, 0, 0); PG8_SCHED; PG8_LDA(At, 0, 0); PG8_STAGE(PG8_SA(1, 1), a1 + hstep, voffA);
            PG8_WAIT_L(8); PG8_BAR; PG8_WAIT_L(0); PG8_MMA(0, 0, At, B0); PG8_BAR; PG8_SCHED;
            PG8_LDB(B1, 0, 1); PG8_STAGE(PG8_SB(0, 0), b2, voffB);
            PG8_BAR; PG8_WAIT_L(0); PG8_MMA(0, 1, At, B1); PG8_BAR;
            PG8_LDA(At, 0, 1); PG8_STAGE(PG8_SA(0, 0), a2, voffA);
            PG8_BAR; PG8_WAIT_L(0); PG8_MMA(1, 0, At, B0); PG8_BAR; PG8_SCHED;
            PG8_STAGE(PG8_SB(0, 1), b2 + hstep, voffB);
            PG8_WAIT_V(6); PG8_BAR; PG8_MMA(1, 1, At, B1); PG8_BAR;
            PG8_LDB(B0, 1, 0); PG8_SCHED; PG8_LDA(At, 1, 0); PG8_STAGE(PG8_SA(0, 1), a2 + hstep, voffA);
            PG8_WAIT_L(8); PG8_BAR; PG8_WAIT_L(0); PG8_MMA(0, 0, At, B0); PG8_BAR; PG8_SCHED;
            PG8_LDB(B1, 1, 1); PG8_STAGE(PG8_SB(1, 0), b3, voffB);
            PG8_BAR; PG8_WAIT_L(0); PG8_MMA(0, 1, At, B1); PG8_BAR;
            PG8_LDA(At, 1, 1); PG8_STAGE(PG8_SA(1, 0), a3, voffA);
            PG8_BAR; PG8_WAIT_L(0); PG8_MMA(1, 0, At, B0); PG8_BAR; PG8_SCHED;
            PG8_STAGE(PG8_SB(1, 1), b3 + hstep, voffB);
            PG8_WAIT_V(6); PG8_BAR; PG8_MMA(1, 1, At, B1); PG8_BAR;
            }
        }
        if constexpr (ALIGN_EPI) { if (wr == 0) PG8_BAR; }
        if constexpr (!Epi::AFTER_DRAIN) { E(acc, cur, wr, wc, fr, fq); S.done(cur); }
        if (!has_next) break;
#pragma unroll
        for (int a = 0; a < 2; ++a)
#pragma unroll
            for (int b = 0; b < 2; ++b)
#pragma unroll
                for (int m = 0; m < 4; ++m)
#pragma unroll
                    for (int n = 0; n < 2; ++n) acc[a][b][m][n] = (f32x4){0.f, 0.f, 0.f, 0.f};
        cur = nxt; cA = nA; cB = nB; ++ui;
        if constexpr (ALIGN_EPI) { if (wr == 1) PG8_BAR; }
    }
    PG8_WAIT_V(0);
    if constexpr (!ALIGN_EPI) { if (wr == 0) PG8_BAR; }
    PG8_BAR;
    if constexpr (Epi::AFTER_DRAIN) { E.fused(acc, cur, wr, wc, fr, fq, lds, wid, lane); S.done(cur); }
#undef PG8_SA
#undef PG8_SB
#undef PG8_STAGE
#undef PG8_LDA
#undef PG8_LDB
#undef PG8_MMA
#undef PG8_WAIT_V
#undef PG8_WAIT_L
#undef PG8_BAR
#undef PG8_SCHED
}
}

#ifndef PROBE_DUP
#define PROBE_DUP -1
#endif
constexpr int NWAVES = 8, NTHR = NWAVES * 64;
#ifndef MK_N_LAUNCHES
#define MK_N_LAUNCHES 1
#endif
constexpr int N_PHASES = 10;
constexpr int N_LAUNCHES = MK_N_LAUNCHES;
static_assert(N_LAUNCHES == 1 || N_LAUNCHES == N_PHASES, "MK_N_LAUNCHES is 1 or N_PHASES");

constexpr int BATCH = 8, SEQ = 2048, T = BATCH * SEQ, D = 2048;
constexpr int NIN = 5408, NINP = 5632;
constexpr int PC_GATE = 1024, PC_R = 2048, PC_K = 3072, PC_V = 4096, PC_WD = 5120, PC_AD = 5184, PC_GD = 5248;
constexpr int RWKV_C0 = 2048;
constexpr int NEXP = 16384, NSEL = 128;
constexpr float NORM_EPS = 1e-6f, GN_EPS = 64e-5f;

constexpr size_t MiB = 1u << 20;
constexpr size_t WS_CTL = 0, CTL_ZERO_BYTES = 1 * MiB;
constexpr size_t WS_SSQ3 = 576 * 1024;
constexpr size_t WS_SSQ2 = 512 * 1024;
constexpr size_t WS_RSTD1 = 1 * MiB;
constexpr size_t WS_USC = 1 * MiB + 64 * 1024, WS_VSC = 1 * MiB + 128 * 1024;
constexpr size_t WS_SX = 1 * MiB + 192 * 1024;
constexpr size_t WS_WIN = 2 * MiB;
constexpr size_t WS_WOUT = 24 * MiB;
constexpr size_t WS_WQ = 32 * MiB;
constexpr size_t WS_KEYS = 40 * MiB;
constexpr size_t WS_W2T = WS_KEYS + 512 * 1024;
constexpr size_t WS_A2T = WS_W2T + 128 * 1024;
constexpr size_t WS_G2T = WS_A2T + 128 * 1024;
constexpr size_t WS_WAT = WS_G2T + 320 * 1024;
constexpr size_t WS_WIT = WS_WAT + 256 * 1024;
constexpr size_t WS_EXP = 42 * MiB;
constexpr size_t WS_GATE = 50 * MiB;
constexpr size_t WS_LA = 42 * MiB;
constexpr size_t WS_SUMM = 58 * MiB;
constexpr size_t WS_TA = 64 * MiB, WS_TB = 96 * MiB, WS_TK = 400 * MiB, WS_TR = 464 * MiB;
constexpr size_t OUT_TV = 0, OUT_TG = 32 * MiB, OUT_PC = 64 * MiB, OUT_BON = 66 * MiB;
constexpr size_t WS_XB = 64 * MiB;
constexpr size_t WS_PROJ = 128 * MiB;
constexpr size_t WS_Q = WS_PROJ;
constexpr size_t WS_PART = 192 * MiB;
constexpr size_t WS_XQ = 320 * MiB;
constexpr size_t WS_COEF = 352 * MiB;
constexpr size_t WS_CSC = 356 * MiB;
constexpr size_t WS_Y = 304 * MiB;
constexpr size_t WS_UT = 368 * MiB;
constexpr size_t WS_VT = 432 * MiB;
constexpr size_t WS_END = 496 * MiB;
static_assert(WS_WIT + 256 * 1024 <= WS_EXP && WS_PROJ + (size_t)T * NINP * 2 <= WS_Y && WS_WIN + (size_t)NINP * D * 2 <= WS_WOUT, "d_ws map");
constexpr int CW_DEFQ = 2240;
constexpr int CW_PREPBAR = 2176;
constexpr int CW_PREBAR = 2112;
constexpr int CW_LRUBAR = 2048;
constexpr int CW_BAR = 4096;

constexpr int RING_BYTES = 131072;
constexpr int LDSCTL_OFF = 143360, MISC_OFF = LDSCTL_OFF + 320;
constexpr int LDS_BYTES = 147456;

#define GAS __attribute__((address_space(1)))
#define LAS __attribute__((address_space(3)))
typedef unsigned short bf16;
typedef unsigned v4u __attribute__((ext_vector_type(4)));
typedef unsigned v2u __attribute__((ext_vector_type(2)));
typedef float f32x4 __attribute__((ext_vector_type(4)));
typedef float f32x16 __attribute__((ext_vector_type(16)));
typedef short bf16x8 __attribute__((ext_vector_type(8)));
typedef __bf16 bf16x2_t __attribute__((ext_vector_type(2)));
typedef GAS unsigned gu32;
#define RLX_AGENT __ATOMIC_RELAXED, __HIP_MEMORY_SCOPE_AGENT
__device__ __forceinline__ unsigned f2bf(float f) { unsigned u = __builtin_bit_cast(unsigned, f); return (u + 0x7fffu + ((u >> 16) & 1u)) >> 16; }
__device__ __forceinline__ unsigned pk2(float lo, float hi) { return f2bf(lo) | (f2bf(hi) << 16); }
__device__ __forceinline__ float bf_lo(unsigned w) { return __uint_as_float(w << 16); }
__device__ __forceinline__ float bf_hi(unsigned w) { return __uint_as_float(w & 0xffff0000u); }
__device__ __forceinline__ void unpack8(const v4u& w, float (&o)[8]) { o[0] = bf_lo(w.x); o[1] = bf_hi(w.x); o[2] = bf_lo(w.y); o[3] = bf_hi(w.y); o[4] = bf_lo(w.z); o[5] = bf_hi(w.z); o[6] = bf_lo(w.w); o[7] = bf_hi(w.w); }
__device__ __forceinline__ v4u pack8(const float (&o)[8]) { v4u w; w.x = pk2(o[0], o[1]); w.y = pk2(o[2], o[3]); w.z = pk2(o[4], o[5]); w.w = pk2(o[6], o[7]); return w; }
__device__ __forceinline__ float sigmoidf_(float x) { return 1.0f / (1.0f + __expf(-x)); }
__device__ __forceinline__ float softplusf_(float z) { return fmaxf(z, 0.f) + log1pf(__expf(-fabsf(z))); }
__device__ __forceinline__ float gelu_tanh(float x) { const float u = 0.7978845608028654f * (x + 0.044715f * x * x * x); return 0.5f * x * (1.0f + tanhf(u)); }
template <int CTRL> __device__ __forceinline__ float dppf(float x) { return __builtin_bit_cast(float, __builtin_amdgcn_mov_dpp(__builtin_bit_cast(int, x), CTRL, 0xf, 0xf, true)); }
__device__ __forceinline__ float red8(float v) { v += dppf<0xB1>(v); v += dppf<0x4E>(v); v += dppf<0x141>(v); return v; }
__device__ __forceinline__ float red16(float v) { v = red8(v); v += dppf<0x140>(v); return v; }
__device__ __forceinline__ float wave_sum(float v) {
#pragma unroll
    for (int o = 1; o < 64; o <<= 1) v += __shfl_xor(v, o);
    return v;
}
__device__ __forceinline__ float dot2bf(unsigned a, unsigned b, float acc) { return __builtin_amdgcn_fdot2_f32_bf16(__builtin_bit_cast(bf16x2_t, a), __builtin_bit_cast(bf16x2_t, b), acc, false); }
#define MFMA16(a, b, c) __builtin_amdgcn_mfma_f32_16x16x32_bf16((a), (b), (c), 0, 0, 0)
#define MFMA32(a, b, c) __builtin_amdgcn_mfma_f32_32x32x16_bf16((a), (b), (c), 0, 0, 0)

#define XB_TMO      128
#define XB_XCNT(j)  (256  + 64 * (j))
#define XB_XSUB(j)  (1280 + 64 * (j))
#define XB_XGEN(j)  (2304 + 64 * (j))
#define XB_TOP      3328
#define XB_TOPGEN   3392
#define XCD_BAR_WORDS 3456
#define XB_SPIN_CAP (1u << 22)
__device__ __forceinline__ unsigned xb_ld(unsigned* p)              { return __hip_atomic_load(p, __ATOMIC_RELAXED, __HIP_MEMORY_SCOPE_AGENT); }
__device__ __forceinline__ unsigned xb_add(unsigned* p, unsigned v) { return __hip_atomic_fetch_add(p, v, __ATOMIC_RELAXED, __HIP_MEMORY_SCOPE_AGENT); }
__device__ __forceinline__ unsigned xb_xcc_id() { return (unsigned)__builtin_amdgcn_s_getreg((3 << 11) | 20) & 0xFu; }
#define XB_SPIN(cond, bar) do { unsigned _sp = 0; while (cond) { __builtin_amdgcn_s_sleep(1); \
    if ((++_sp & 255u) == 0u) { if (xb_ld(&(bar)[XB_TMO])) break; if (_sp > XB_SPIN_CAP) { atomicAdd(&(bar)[XB_TMO], 1u); break; } } } } while (0)
struct XcdBarrier { unsigned* bar; unsigned x; volatile LAS unsigned* st; };
__device__ __forceinline__ XcdBarrier xcd_barrier_post(unsigned* bar, volatile LAS unsigned* st) {
    XcdBarrier b; b.bar = bar; b.x = xb_xcc_id(); b.st = st;
    if (threadIdx.x == 0) (void)xb_add(&bar[XB_XCNT(b.x)], 1u);
    return b;
}
__device__ __forceinline__ void xcd_barrier_complete(unsigned* bar, unsigned x, unsigned& nloc, unsigned& nx) {
    const unsigned G = gridDim.x * gridDim.y * gridDim.z;
    unsigned sum, cnt, mine, sp = 0u;
    for (;;) {
        sum = 0u; cnt = 0u; mine = 0u;
#pragma unroll
        for (unsigned j = 0; j < 16; ++j) { const unsigned c = xb_ld(&bar[XB_XCNT(j)]); sum += c; cnt += (c > 0u) ? 1u : 0u; mine = (j == x) ? c : mine; }
        if (sum == G) break;
        __builtin_amdgcn_s_sleep(1);
        if ((++sp & 255u) == 0u) { if (xb_ld(&bar[XB_TMO])) break; if (sp > XB_SPIN_CAP) { atomicAdd(&bar[XB_TMO], 1u); break; } }
    }
    nloc = mine > 0u ? mine : 1u; nx = cnt > 0u ? cnt : 1u;
}
__device__ __forceinline__ void xcd_barrier(const XcdBarrier& b) {
    asm volatile("s_waitcnt vmcnt(0)" ::: "memory");
    __syncthreads();
    if (threadIdx.x == 0) {
        unsigned* bar = b.bar;
        __builtin_amdgcn_s_waitcnt(0);
        unsigned nloc = b.st[0], nx = b.st[1];
        if (nloc == 0u) { xcd_barrier_complete(bar, b.x, nloc, nx); b.st[0] = nloc; b.st[1] = nx; }
        const unsigned old = xb_add(&bar[XB_XSUB(b.x)], 1u);
        const unsigned gen = old / nloc;
        if (old + 1u == (gen + 1u) * nloc) {
            __builtin_amdgcn_fence(__ATOMIC_RELEASE, "agent");
            asm volatile("s_waitcnt vmcnt(0)" ::: "memory");
            const unsigned og = xb_add(&bar[XB_TOP], 1u);
            const unsigned tg = og / nx;
            if (og + 1u == (tg + 1u) * nx) xb_add(&bar[XB_TOPGEN], 1u);
            else XB_SPIN(xb_ld(&bar[XB_TOPGEN]) == tg, bar);
            __builtin_amdgcn_fence(__ATOMIC_ACQUIRE, "agent");
            xb_add(&bar[XB_XGEN(b.x)], 1u);
            asm volatile("s_waitcnt vmcnt(0)" ::: "memory");
        } else {
            XB_SPIN(xb_ld(&bar[XB_XGEN(b.x)]) == gen, bar);
            __builtin_amdgcn_fence(__ATOMIC_ACQUIRE, "agent");
            asm volatile("s_waitcnt vmcnt(0)" ::: "memory");
        }
    }
    __syncthreads();
}

struct Frame {
    LAS unsigned char* lds;
    int tid, lane, wave, G, bid;
    const float* in[28];
    float* out;
    unsigned char* ws;
};
#define WSP(type, off) ((type*)(F.ws + (off)))
enum { I_X = 0, I_G1, I_WIN, I_CONVW, I_CONVB, I_WA, I_BA, I_WI, I_BI, I_LAM, I_MU, I_W0, I_W2, I_A0, I_A2, I_G2, I_KK, I_KA, I_RK, I_LNW, I_LNB, I_WOUT, I_G2N, I_WQ, I_KEYS, I_U, I_V, I_GF };

__device__ __forceinline__ void p0_transpose_item(const float* W, int K, int N, bf16* WT, const float* ksc, LAS float* scr, int item, int lane) {
    const int nblk = N / 32, kb = item / nblk, nb = item % nblk, k0 = 64 * kb, n0 = 32 * nb;
    const int lr = lane >> 3, c4 = (lane & 7) * 4;
    f32x4 v[8];
#pragma unroll
    for (int i = 0; i < 8; ++i) v[i] = *(const f32x4*)(W + (size_t)(k0 + 8 * i + lr) * N + n0 + c4);
#pragma unroll
    for (int i = 0; i < 8; ++i) { const int kk = 8 * i + lr; const float sc = ksc ? ksc[k0 + kk] : 1.0f; LAS float* d = scr + kk * 33 + c4; d[0] = v[i][0] * sc; d[1] = v[i][1] * sc; d[2] = v[i][2] * sc; d[3] = v[i][3] * sc; }
    asm volatile("s_waitcnt lgkmcnt(0)" ::: "memory");
    const int c = lane & 7;
#pragma unroll
    for (int j = 0; j < 4; ++j) { const int n = (lane >> 3) + 8 * j; const LAS float* s = scr + (8 * c) * 33 + n;
        v4u o; o.x = pk2(s[0 * 33], s[1 * 33]); o.y = pk2(s[2 * 33], s[3 * 33]); o.z = pk2(s[4 * 33], s[5 * 33]); o.w = pk2(s[6 * 33], s[7 * 33]);
        *(v4u*)(WT + (size_t)(n0 + n) * K + k0 + 8 * c) = o; }
    asm volatile("s_waitcnt lgkmcnt(0)" ::: "memory");
}
__device__ __forceinline__ void p0_small_transpose(const float* src, bf16* dst, int nb, int K, int N, int gt, int NGT) {
    const int tot = nb * K * N;
    for (int i = gt; i < tot; i += NGT) { const int bb = i / (K * N), r = i - bb * K * N, n = r / K, k = r - n * K; dst[i] = (bf16)f2bf(src[(size_t)bb * K * N + (size_t)k * N + n]); }
}
template <int PART> __device__ __forceinline__ void p0_prologue(const Frame& F, int vb, int VG) {
    LAS float* scr = (LAS float*)(F.lds + F.wave * 8448);
    const int gw = vb * NWAVES + F.wave, NGW = VG * NWAVES, gt = gw * 64 + F.lane, NGT = NGW * 64;
    constexpr int I1 = (D / 64) * (NIN / 32), I2 = (D / 64) * (D / 32);
    if (PART == 0) { for (int it = gw; it < I1; it += NGW) p0_transpose_item(F.in[I_WIN], D, NIN, WSP(bf16, WS_WIN), F.in[I_G1], scr, it, F.lane); }
    else { for (int it = gw; it < 2 * I2; it += NGW) { if (it < I2) p0_transpose_item(F.in[I_WOUT], D, D, WSP(bf16, WS_WOUT), nullptr, scr, it, F.lane); else p0_transpose_item(F.in[I_WQ], D, D, WSP(bf16, WS_WQ), F.in[I_G2N], scr, it - I2, F.lane); } }
    if (PART == 0) {
    { v4u* z = (v4u*)(WSP(bf16, WS_WIN) + (size_t)NIN * D); const int nz = (NINP - NIN) * D * 2 / 16; for (int i = gt; i < nz; i += NGT) z[i] = (v4u){0u, 0u, 0u, 0u}; }
    p0_small_transpose(F.in[I_W2], WSP(bf16, WS_W2T), 1, 64, 1024, gt, NGT);
    p0_small_transpose(F.in[I_A2], WSP(bf16, WS_A2T), 1, 64, 1024, gt, NGT);
    p0_small_transpose(F.in[I_G2], WSP(bf16, WS_G2T), 1, 160, 1024, gt, NGT);
    p0_small_transpose(F.in[I_WA], WSP(bf16, WS_WAT), 8, 128, 128, gt, NGT);
    p0_small_transpose(F.in[I_WI], WSP(bf16, WS_WIT), 8, 128, 128, gt, NGT);
    { const float* s = F.in[I_KEYS]; bf16* d = WSP(bf16, WS_KEYS); for (int i = gt; i < 8 * 2 * 128 * 128 / 8; i += NGT) { const f32x4 a = *(const f32x4*)(s + (size_t)i * 8), b = *(const f32x4*)(s + (size_t)i * 8 + 4);
        v4u o; o.x = pk2(a[0], a[1]); o.y = pk2(a[2], a[3]); o.z = pk2(b[0], b[1]); o.w = pk2(b[2], b[3]); *(v4u*)(d + (size_t)i * 8) = o; } }
    }
    if (PART == 1) {
    { const float* su = F.in[I_U]; const float* sv = F.in[I_V]; const float* g2 = F.in[I_G2N]; unsigned char* du = WSP(unsigned char, WS_UT); unsigned char* dv = WSP(unsigned char, WS_VT);
      float* usc = WSP(float, WS_USC); float* vsc = WSP(float, WS_VSC);
      f32x4 gg[2][4];
#pragma unroll
      for (int hh = 0; hh < 2; ++hh)
#pragma unroll
          for (int q = 0; q < 4; ++q) gg[hh][q] = *(const f32x4*)(g2 + hh * 1024 + F.lane * 16 + q * 4);
      for (int row = gw; row < NEXP; row += NGW) {
          f32x4 uu[2][4], vv[2][4]; float am = 0.f, vm = 0.f;
#pragma unroll
          for (int hh = 0; hh < 2; ++hh)
#pragma unroll
              for (int q = 0; q < 4; ++q) { uu[hh][q] = *(const f32x4*)(su + (size_t)row * D + hh * 1024 + F.lane * 16 + q * 4) * gg[hh][q]; vv[hh][q] = *(const f32x4*)(sv + (size_t)row * D + hh * 1024 + F.lane * 16 + q * 4);
#pragma unroll
                  for (int e = 0; e < 4; ++e) { am = fmaxf(am, fabsf(uu[hh][q][e])); vm = fmaxf(vm, fabsf(vv[hh][q][e])); } }
#pragma unroll
          for (int o = 1; o < 64; o <<= 1) { am = fmaxf(am, __shfl_xor(am, o)); vm = fmaxf(vm, __shfl_xor(vm, o)); }
          const float uq = am > 0.f ? 127.0f / am : 0.f, vq = vm > 0.f ? 127.0f / vm : 0.f;
          if (F.lane == 0) { usc[row] = am * (1.0f / 127.0f); vsc[row] = vm * (1.0f / 127.0f); }
#pragma unroll
          for (int hh = 0; hh < 2; ++hh) { v4u ou, ov;
#pragma unroll
              for (int q = 0; q < 4; ++q) { unsigned w = 0u, wv = 0u;
#pragma unroll
                  for (int e = 0; e < 4; ++e) { const int qi = (int)rintf(uu[hh][q][e] * uq); w |= ((unsigned)qi & 0xFFu) << (8 * e); const int qv = (int)rintf(vv[hh][q][e] * vq); wv |= ((unsigned)qv & 0xFFu) << (8 * e); }
                  ou[q] = w; ov[q] = wv; }
              *(v4u*)(du + (size_t)row * D + hh * 1024 + F.lane * 16) = ou; *(v4u*)(dv + (size_t)row * D + hh * 1024 + F.lane * 16) = ov; }
      } }
    }
    if (PART == 0) {
    { const float* x = F.in[I_X]; bf16* xb = WSP(bf16, WS_XB); float* rstd = WSP(float, WS_RSTD1);
      for (int m = gw; m < T; m += NGW) { const f32x4* xr = (const f32x4*)(x + (size_t)m * D) + F.lane; f32x4 v[8]; float s = 0.f;
#pragma unroll
          for (int j = 0; j < 8; ++j) { v[j] = xr[64 * j]; s += (v[j][0] * v[j][0] + v[j][1] * v[j][1]) + (v[j][2] * v[j][2] + v[j][3] * v[j][3]); }
          s = wave_sum(s);
          if (F.lane == 0) rstd[m] = 1.0f / sqrtf(s * (1.0f / D) + NORM_EPS);
          v2u* o = (v2u*)(xb + (size_t)m * D) + F.lane;
#pragma unroll
          for (int j = 0; j < 8; ++j) { v2u w; w.x = pk2(v[j][0], v[j][1]); w.y = pk2(v[j][2], v[j][3]); o[64 * j] = w; } } }
    }
}

typedef float f32x2c __attribute__((ext_vector_type(2)));
__device__ __forceinline__ unsigned cvtpk(float lo, float hi) { const f32x2c v = {lo, hi}; const bf16x2_t b = __builtin_convertvector(v, bf16x2_t); return __builtin_bit_cast(unsigned, b); }
__device__ __forceinline__ float rcpf_(float x) { return __builtin_amdgcn_rcpf(x); }
__device__ __forceinline__ float sigmoid_fast(float x) { return rcpf_(1.0f + __expf(-x)); }
__device__ __forceinline__ float tanh_fast(float x) { return 1.0f - 2.0f * rcpf_(1.0f + __expf(2.0f * x)); }
__device__ __forceinline__ float softplus_fast(float z) { return fmaxf(z, 0.f) + __logf(1.0f + __expf(-fabsf(z))); }
__device__ __forceinline__ float gelu_fast(float x) { const float u = 0.7978845608028654f * (x + 0.044715f * x * x * x); return x * rcpf_(1.0f + __expf(-2.0f * u)); }
__device__ __forceinline__ void rwkv_prep_unit(const Frame& F, int chunk, int h, int lane, const LAS bf16* WL2, const LAS bf16* AL2, const LAS bf16* GL2, const LAS float* CW) {
    const int fr = lane & 15, fq = lane >> 4;
    const bf16* PROJ = WSP(bf16, WS_PROJ); const bf16* LA = WSP(bf16, WS_LA);
    bf16* TA = WSP(bf16, WS_TA); bf16* TB = WSP(bf16, WS_TB); bf16* TK = WSP(bf16, WS_TK); bf16* TR = WSP(bf16, WS_TR);
    bf16* TV = (bf16*)F.out + OUT_TV / 2; bf16* TG = (bf16*)F.out + OUT_TG / 2; float* PCG = F.out + OUT_PC / 4; float* BONG = F.out + OUT_BON / 4;
#define PU4(w_) ((f32x4){bf_lo((w_).x), bf_hi((w_).x), bf_lo((w_).y), bf_hi((w_).y)})
    size_t tokm[2]; int pom[2]; unsigned pmm[2];
#pragma unroll
    for (int mt = 0; mt < 2; ++mt) { tokm[mt] = (size_t)chunk * 32 + mt * 16 + fr; const bool hasp = ((chunk & 63) * 32 + mt * 16 + fr) > 0; pom[mt] = hasp ? NINP : 0; pmm[mt] = hasp ? 0xffffffffu : 0u; }
    bf16x8 la[2][9];
#pragma unroll
    for (int mt = 0; mt < 2; ++mt)
#pragma unroll
        for (int ks = 0; ks < 9; ++ks) la[mt][ks] = *(const bf16x8*)(LA + tokm[mt] * 288 + ks * 32 + 8 * fq);
    float inv[2], bn[2];
#pragma unroll
    for (int mt = 0; mt < 2; ++mt) { float s2 = 0.f;
#pragma unroll
        for (int nt = 0; nt < 4; ++nt) { const int j4 = nt * 16 + fq * 4; const bf16* pr = PROJ + tokm[mt] * NINP + PC_K + h * 64 + j4;
            const v2u kc = *(const v2u*)pr; v2u kp = *(const v2u*)(pr - pom[mt]); kp.x &= pmm[mt]; kp.y &= pmm[mt];
            const f32x4 c_kk = *(const LAS f32x4*)(CW + 128 + j4), m_k = *(const LAS f32x4*)(CW + 384 + j4);
            const f32x4 kcf = PU4(kc); const f32x4 ku = (kcf + (PU4(kp) - kcf) * m_k) * c_kk; s2 += (ku[0] * ku[0] + ku[1] * ku[1]) + (ku[2] * ku[2] + ku[3] * ku[3]); }
        { auto x = __builtin_amdgcn_permlane16_swap(__float_as_uint(s2), __float_as_uint(s2), false, false); s2 = __uint_as_float(x[0]) + __uint_as_float(x[1]); }
        { auto x = __builtin_amdgcn_permlane32_swap(__float_as_uint(s2), __float_as_uint(s2), false, false); s2 = __uint_as_float(x[0]) + __uint_as_float(x[1]); }
        inv[mt] = __builtin_amdgcn_rsqf(fmaxf(s2, 1e-24f)); bn[mt] = 0.f; }
    v2u cur_[3], prv_[3], ncur_[3], nprv_[3];
#define PREP_LOAD_RKV(C_, P_, st_) do { const int mt_ = (st_) >> 2, nt_ = (st_) & 3; const bf16* pr_ = PROJ + tokm[mt_] * NINP + PC_R + h * 64 + nt_ * 16 + fq * 4; \
        _Pragma("unroll") for (int q_ = 0; q_ < 3; ++q_) { C_[q_] = *(const v2u*)(pr_ + q_ * 1024); P_[q_] = *(const v2u*)(pr_ + q_ * 1024 - pom[mt_]); } } while (0)
    PREP_LOAD_RKV(cur_, prv_, 0);
    f32x4 tot0[4];
#pragma unroll
    for (int n = 0; n < 4; ++n) tot0[n] = (f32x4){0.f, 0.f, 0.f, 0.f};
#pragma unroll
    for (int st = 0; st < 8; ++st) { const int mt = st >> 2, nt = st & 3; const int j4 = nt * 16 + fq * 4; const size_t col = (size_t)h * 64 + j4;
        if (st < 7) PREP_LOAD_RKV(ncur_, nprv_, st + 1);
        f32x4 cw = (f32x4){0.f, 0.f, 0.f, 0.f}, ca = cw, cg = cw;
#pragma unroll
        for (int ks = 0; ks < 2; ++ks) { cw = MFMA16(*(const LAS bf16x8*)(WL2 + (nt * 16 + fr) * 72 + ks * 32 + 8 * fq), la[mt][ks], cw); ca = MFMA16(*(const LAS bf16x8*)(AL2 + (nt * 16 + fr) * 72 + ks * 32 + 8 * fq), la[mt][2 + ks], ca); }
#pragma unroll
        for (int ks = 0; ks < 5; ++ks) cg = MFMA16(*(const LAS bf16x8*)(GL2 + (nt * 16 + fr) * 168 + ks * 32 + 8 * fq), la[mt][4 + ks], cg);
        const f32x4 c_w0 = *(const LAS f32x4*)(CW + j4), c_a0 = *(const LAS f32x4*)(CW + 64 + j4), c_kk = *(const LAS f32x4*)(CW + 128 + j4), c_ka = *(const LAS f32x4*)(CW + 192 + j4), c_rk = *(const LAS f32x4*)(CW + 256 + j4);
        const f32x4 m_r = *(const LAS f32x4*)(CW + 320 + j4), m_k = *(const LAS f32x4*)(CW + 384 + j4), m_v = *(const LAS f32x4*)(CW + 448 + j4);
        v2u rp = prv_[0], kp = prv_[1], vp = prv_[2]; const unsigned pm = pmm[mt];
        rp.x &= pm; rp.y &= pm; kp.x &= pm; kp.y &= pm; vp.x &= pm; vp.y &= pm;
        const f32x4 rcf = PU4(cur_[0]), kcf = PU4(cur_[1]), vcf = PU4(cur_[2]);
        const f32x4 rr = rcf + (PU4(rp) - rcf) * m_r, kv = kcf + (PU4(kp) - kcf) * m_k, vv = vcf + (PU4(vp) - vcf) * m_v;
        f32x4 nau, bbu, km, cum;
#pragma unroll
        for (int r = 0; r < 4; ++r) { const float av = sigmoid_fast(c_a0[r] + ca[r]), ku = kv[r] * c_kk[r]; km[r] = kv[r] * (1.0f + (av - 1.0f) * c_ka[r]);
            cum[r] = -0.6065306597126334f * sigmoid_fast(c_w0[r] + cw[r]);
            nau[r] = -ku; bbu[r] = ku * av; bn[mt] += rr[r] * km[r] * c_rk[r]; }
        f32x4 at4, rt4, bt4, kt4, ep4;
#pragma unroll
        for (int r = 0; r < 4; ++r) { float v = cum[r];
            v += __builtin_bit_cast(float, __builtin_amdgcn_update_dpp(0, __builtin_bit_cast(int, v), 0x111, 0xf, 0xf, true));
            v += __builtin_bit_cast(float, __builtin_amdgcn_update_dpp(0, __builtin_bit_cast(int, v), 0x112, 0xf, 0xf, true));
            v += __builtin_bit_cast(float, __builtin_amdgcn_update_dpp(0, __builtin_bit_cast(int, v), 0x114, 0xf, 0xf, true));
            v += __builtin_bit_cast(float, __builtin_amdgcn_update_dpp(0, __builtin_bit_cast(int, v), 0x118, 0xf, 0xf, true));
            if (mt == 0) tot0[nt][r] = __shfl(v, (lane & 48) | 15); else v += tot0[nt][r];
            const float ep = __expf(v), em = rcpf_(ep);
            float eprev = __builtin_bit_cast(float, __builtin_amdgcn_update_dpp(0, __builtin_bit_cast(int, ep), 0x111, 0xf, 0xf, true));
            if (fr == 0) eprev = mt ? __expf(tot0[nt][r]) : 1.0f;
            at4[r] = nau[r] * inv[mt] * eprev; rt4[r] = rr[r] * ep; bt4[r] = bbu[r] * inv[mt] * em; kt4[r] = km[r] * em; ep4[r] = ep; }
        const size_t o = tokm[mt] * 1024 + col; v2u w;
        w.x = cvtpk(at4[0], at4[1]); w.y = cvtpk(at4[2], at4[3]); *(v2u*)(TA + o) = w;
        w.x = cvtpk(rt4[0], rt4[1]); w.y = cvtpk(rt4[2], rt4[3]); *(v2u*)(TR + o) = w;
        w.x = cvtpk(bt4[0], bt4[1]); w.y = cvtpk(bt4[2], bt4[3]); *(v2u*)(TB + o) = w;
        w.x = cvtpk(kt4[0], kt4[1]); w.y = cvtpk(kt4[2], kt4[3]); *(v2u*)(TK + o) = w;
        w.x = cvtpk(vv[0], vv[1]); w.y = cvtpk(vv[2], vv[3]); *(v2u*)(TV + o) = w;
        w.x = cvtpk(cg[0], cg[1]); w.y = cvtpk(cg[2], cg[3]); *(v2u*)(TG + o) = w;
        if (mt == 1 && fr == 15) *(f32x4*)(PCG + (size_t)chunk * 1024 + col) = ep4;
#pragma unroll
        for (int q = 0; q < 3; ++q) { cur_[q] = ncur_[q]; prv_[q] = nprv_[q]; }
    }
#undef PREP_LOAD_RKV
#undef PU4
#pragma unroll
    for (int mt = 0; mt < 2; ++mt) { float b2 = bn[mt];
        { auto x = __builtin_amdgcn_permlane16_swap(__float_as_uint(b2), __float_as_uint(b2), false, false); b2 = __uint_as_float(x[0]) + __uint_as_float(x[1]); }
        { auto x = __builtin_amdgcn_permlane32_swap(__float_as_uint(b2), __float_as_uint(b2), false, false); b2 = __uint_as_float(x[0]) + __uint_as_float(x[1]); }
        if (fq == 0) BONG[tokm[mt] * 16 + h] = b2; }
}
__device__ __forceinline__ void rwkv_prep_phase(const Frame& F) {
    LAS bf16* WL2 = (LAS bf16*)(F.lds + 0); LAS bf16* AL2 = (LAS bf16*)(F.lds + 9216); LAS bf16* GL2 = (LAS bf16*)(F.lds + 18432); LAS float* CW = (LAS float*)(F.lds + 39936);
    int hcur = -1;
    for (int u = F.bid; u < 1024; u += F.G) { const int h = u & 15, cg = u >> 4;
        if (h != hcur) { hcur = h; __syncthreads();
            const bf16* w2t = WSP(bf16, WS_W2T) + (size_t)h * 64 * 64; const bf16* a2t = WSP(bf16, WS_A2T) + (size_t)h * 64 * 64; const bf16* g2t = WSP(bf16, WS_G2T) + (size_t)h * 64 * 160;
            { const int r = F.tid >> 3, c = (F.tid & 7) * 8; *(LAS v4u*)(WL2 + r * 72 + c) = *(const v4u*)(w2t + r * 64 + c); *(LAS v4u*)(AL2 + r * 72 + c) = *(const v4u*)(a2t + r * 64 + c); }
            for (int i = F.tid; i < 64 * 20; i += NTHR) { const int r = i / 20, c = (i - r * 20) * 8; *(LAS v4u*)(GL2 + r * 168 + c) = *(const v4u*)(g2t + r * 160 + c); }
            { const int q = F.tid >> 6, jj = F.tid & 63; const float* src = q == 0 ? F.in[I_W0] : (q == 1 ? F.in[I_A0] : (q == 2 ? F.in[I_KK] : (q == 3 ? F.in[I_KA] : (q == 4 ? F.in[I_RK] : F.in[I_MU] + (q - 5) * 1024)))); CW[q * 64 + jj] = src[h * 64 + jj]; }
            __syncthreads(); }
        rwkv_prep_unit(F, cg * 8 + F.wave, h, F.lane, WL2, AL2, GL2, CW); }
    __syncthreads();
}
typedef short v4i16_t __attribute__((ext_vector_type(4)));
__device__ __forceinline__ bf16x8 frag_tr16(const LAS bf16* p, int ld) {
    const v4i16_t a = __builtin_amdgcn_ds_read_tr16_b64_v4i16((LAS v4i16_t*)p), b = __builtin_amdgcn_ds_read_tr16_b64_v4i16((LAS v4i16_t*)(p + 4 * ld));
    return (bf16x8){a[0], a[1], a[2], a[3], b[0], b[1], b[2], b[3]};
}
__device__ __forceinline__ void rwkv_item(const Frame& F, int item) {
    const int b = item >> 4, h = item & 15, wave = F.wave; int tid = F.tid; asm volatile("" : "+v"(tid)); const int lane = tid & 63;
    LAS unsigned char* L = F.lds;
    constexpr int LD64 = 72, LD32 = 40, E0 = 69632;
    LAS bf16* AT = (LAS bf16*)(L + 0);  LAS bf16* BT_ = (LAS bf16*)(L + 4608); LAS bf16* KT_ = (LAS bf16*)(L + 9216); LAS bf16* RT = (LAS bf16*)(L + 13824);
    LAS bf16* VS = (LAS bf16*)(L + 18432);
    LAS bf16* S0B = (LAS bf16*)(L + 33792);
    LAS bf16* GGB = (LAS bf16*)(L + 52224);
    LAS float* YB = (LAS float*)(L + 56832);
    LAS float* BON = (LAS float*)(L + 65536);
    LAS float* PC = (LAS float*)(L + 65664);
    LAS bf16* AAK = (LAS bf16*)(L + E0); LAS bf16* ARB = (LAS bf16*)(L + E0 + 2560); LAS bf16* ARK = (LAS bf16*)(L + E0 + 5120);
    LAS bf16* XB_ = (LAS bf16*)(L + E0 + 7680);
    LAS bf16* XTB = (LAS bf16*)(L + E0 + 12800);
    LAS bf16* PMB = (LAS bf16*)(L + E0 + 17920);
    LAS bf16* RHS = (LAS bf16*)(L + E0 + 23040);
    LAS bf16* SAB = (LAS bf16*)(L + E0 + 28160);
    static_assert(E0 + 33280 <= LDSCTL_OFF, "rwkv LDS map");
    bf16* Y = WSP(bf16, WS_Y);
#define FRAG(base, row0, ld, ks) (*(const LAS bf16x8*)((base) + ((row0) + fr) * (ld) + (ks) * 32 + 8 * fq))
#define FRAGT(base, col0, ld) frag_tr16((base) + (8 * fq + (fr >> 2)) * (ld) + (col0) + 4 * (fr & 3), (ld))
    const int tt = tid >> 4, j0 = (tid & 15) * 4, hc = h * 64 + j0;
    const f32x4 plw = *(const f32x4*)(F.in[I_LNW] + hc), plb = *(const f32x4*)(F.in[I_LNB] + hc);
    const int lr = (tid & 255) >> 3, lc8 = tid & 7; const bool hi2 = tid >= 256;
    const bf16* srcA[3] = { (hi2 ? WSP(bf16, WS_TR) : WSP(bf16, WS_TA)), (hi2 ? WSP(bf16, WS_TK) : WSP(bf16, WS_TB)), (hi2 ? (const bf16*)F.out + OUT_TG / 2 : (const bf16*)F.out + OUT_TV / 2) };
    const size_t poff = ((size_t)b * SEQ + lr) * 1024 + h * 64 + lc8 * 8;
    const float* PCG = F.out + OUT_PC / 4 + (size_t)(b * 64) * 1024 + h * 64; const float* BONG = F.out + OUT_BON / 4 + (size_t)b * SEQ * 16 + h;
    v4u pl_[3]; float ppc = 0.f, pbn = 0.f;
#define RWKV_PREFETCH(tl_) do { _Pragma("unroll") for (int q_ = 0; q_ < 3; ++q_) pl_[q_] = *(const v4u*)(srcA[q_] + poff + (size_t)(tl_) * 32 * 1024); \
        ppc = PCG[(size_t)(tl_) * 1024 + (tid & 63)]; pbn = BONG[((size_t)(tl_) * 32 + (tid & 31)) * 16]; } while (0)
    const int ib = wave >> 1, tb = wave & 1, i0 = ib * 16, t0m = tb * 16;
    f32x4 sacc[2], pmacc, yacc;
    sacc[0] = (f32x4){0.f, 0.f, 0.f, 0.f}; sacc[1] = sacc[0]; pmacc = sacc[0]; yacc = sacc[0];
    for (int u = tid; u < 2 * 64 * LD64 / 2; u += NTHR) ((LAS unsigned*)S0B)[u] = 0u;
    RWKV_PREFETCH(0);
    __syncthreads();
    for (int tl = 0; tl <= SEQ / 32; ++tl) {
        const int cur = tl & 1;
        int lane_c = lane; asm volatile("" : "+v"(lane_c)); const int fr = lane_c & 15, fq = lane_c >> 4;
        if (tl > 0) { const size_t tokb = (size_t)b * SEQ + (tl - 1) * 32;
          const f32x4 y4 = *(const LAS f32x4*)(YB + tt * 68 + j0); const v2u gw_ = *(const LAS v2u*)(GGB + tt * LD64 + j0);
          const f32x4 g4 = (f32x4){bf_lo(gw_.x), bf_hi(gw_.x), bf_lo(gw_.y), bf_hi(gw_.y)};
          const v2u vw_ = *(const LAS v2u*)(VS + tt * LD64 + j0); const f32x4 v4 = (f32x4){bf_lo(vw_.x), bf_hi(vw_.x), bf_lo(vw_.y), bf_hi(vw_.y)};
          float sm = (y4[0] + y4[1]) + (y4[2] + y4[3]); sm = red16(sm); const float mean = sm * (1.0f / 64.0f);
          const f32x4 d4 = y4 - mean; float sv = (d4[0] * d4[0] + d4[1] * d4[1]) + (d4[2] * d4[2] + d4[3] * d4[3]); sv = red16(sv);
          const float rstd = __builtin_amdgcn_rsqf(sv * (1.0f / 64.0f) + GN_EPS), bon = BON[tt];
          f32x4 o;
#pragma unroll
          for (int e = 0; e < 4; ++e) o[e] = (d4[e] * rstd * plw[e] + plb[e] + bon * v4[e]) * g4[e];
          v2u w; w.x = cvtpk(o[0], o[1]); w.y = cvtpk(o[2], o[3]);
          *(v2u*)(Y + (tokb + tt) * D + 1024 + hc) = w; }
        if (tl == SEQ / 32) break;
        const LAS bf16* S0c = S0B + cur * 64 * LD64; LAS bf16* S0n = S0B + (cur ^ 1) * 64 * LD64;
        __syncthreads();
        { const v4u p0 = pl_[0], p1 = pl_[1], p2 = pl_[2];
          *(LAS v4u*)((hi2 ? RT : AT) + lr * LD64 + lc8 * 8) = p0;
          *(LAS v4u*)((hi2 ? KT_ : BT_) + lr * LD64 + lc8 * 8) = p1;
          *(LAS v4u*)((hi2 ? GGB : VS) + lr * LD64 + lc8 * 8) = p2;
          if (tid < 64) PC[tid] = ppc;
          if (tid >= 64 && tid < 96) BON[tid - 64] = pbn; }
        { const int tn_ = tl + 1 < SEQ / 32 ? tl + 1 : SEQ / 32 - 1; RWKV_PREFETCH(tn_); }
        __syncthreads();
        { const int q = wave & 3, tq = (q >> 1) * 16, sq = (q & 1) * 16; const bool zt = sq > tq;
#pragma unroll
            for (int mi = 0; mi < 2; ++mi) { const int mtx = (wave < 4) ? mi : 2; if (wave >= 4 && mi == 1) break;
                const LAS bf16* Xs = (mtx == 1) ? BT_ : KT_; const LAS bf16* Yt = (mtx == 0) ? AT : RT; LAS bf16* O = (mtx == 0) ? AAK : (mtx == 1 ? ARB : ARK);
                f32x4 a4 = (f32x4){0.f, 0.f, 0.f, 0.f};
                if (!zt) {
#pragma unroll
                    for (int ks = 0; ks < 2; ++ks) a4 = MFMA16(FRAG(Xs, sq, LD64, ks), FRAG(Yt, tq, LD64, ks), a4); }
                const int t = tq + fr, s = sq + fq * 4;
#pragma unroll
                for (int r = 0; r < 4; ++r) { const bool keep = (mtx == 0) ? (s + r < t) : (s + r <= t); a4[r] = keep ? a4[r] : 0.f; }
                v2u w; w.x = cvtpk(a4[0], a4[1]); w.y = cvtpk(a4[2], a4[3]); *(LAS v2u*)(O + t * LD32 + s) = w; } }
        if (wave >= 4) { const int q = wave - 4, tq = (q >> 1) * 16, sq = (q & 1) * 16;
            f32x4 a4 = (f32x4){0.f, 0.f, 0.f, 0.f};
            if (sq <= tq) {
#pragma unroll
            for (int ks = 0; ks < 2; ++ks) a4 = MFMA16(FRAG(BT_, sq, LD64, ks), FRAG(AT, tq, LD64, ks), a4); }
            const int t = tq + fr, s = sq + fq * 4;
#pragma unroll
            for (int r = 0; r < 4; ++r) { a4[r] = (s + r < t) ? a4[r] : 0.f; XTB[(s + r) * LD32 + t] = (bf16)(cvtpk(a4[r], 0.f) & 0xffffu); }
            v2u w; w.x = cvtpk(a4[0], a4[1]); w.y = cvtpk(a4[2], a4[3]); *(LAS v2u*)(XB_ + t * LD32 + s) = w;
#pragma unroll
            for (int r = 0; r < 4; ++r) pmacc[r] = a4[r] + ((s + r == t) ? 1.0f : 0.f);
            w.x = cvtpk(pmacc[0], pmacc[1]); w.y = cvtpk(pmacc[2], pmacc[3]); *(LAS v2u*)(PMB + t * LD32 + s) = w; }
        __syncthreads();
#pragma unroll
        for (int ns = 0; ns < 5; ++ns) { const int cb = ns & 1, nb = cb ^ 1;
            const LAS bf16* Xc = XB_ + cb * 32 * LD32; const LAS bf16* XTc = XTB + cb * 32 * LD32; const LAS bf16* Pc = PMB + cb * 32 * LD32;
            LAS bf16* Xn = XB_ + nb * 32 * LD32; LAS bf16* XTn = XTB + nb * 32 * LD32; LAS bf16* Pn = PMB + nb * 32 * LD32;
            if (wave < 4) { if (ns < 4) { const int tq = (wave >> 1) * 16, sq = (wave & 1) * 16;
                    f32x4 a4 = (f32x4){0.f, 0.f, 0.f, 0.f}; a4 = MFMA16(FRAG(XTc, sq, LD32, 0), FRAG(Xc, tq, LD32, 0), a4);
                    const int t = tq + fr, s = sq + fq * 4;
#pragma unroll
                    for (int r = 0; r < 4; ++r) XTn[(s + r) * LD32 + t] = (bf16)(cvtpk(a4[r], 0.f) & 0xffffu);
                    v2u w; w.x = cvtpk(a4[0], a4[1]); w.y = cvtpk(a4[2], a4[3]); *(LAS v2u*)(Xn + t * LD32 + s) = w; } }
            else { const int q = wave - 4, tq = (q >> 1) * 16, sq = (q & 1) * 16;
                if (ns > 0) pmacc = MFMA16(FRAG(XTc, sq, LD32, 0), FRAG(Pc, tq, LD32, 0), pmacc);
                const int t = tq + fr, s = sq + fq * 4;
                v2u w; w.x = cvtpk(pmacc[0], pmacc[1]); w.y = cvtpk(pmacc[2], pmacc[3]); *(LAS v2u*)(Pn + t * LD32 + s) = w; }
            if (ns == 1) {
                f32x4 a4 = (f32x4){0.f, 0.f, 0.f, 0.f};
#pragma unroll
                for (int ks = 0; ks < 2; ++ks) a4 = MFMA16(FRAG(AT, t0m, LD64, ks), FRAG(S0c, i0, LD64, ks), a4);
                a4 = MFMA16(FRAG(AAK, t0m, LD32, 0), FRAGT(VS, i0, LD64), a4);
                v2u w; w.x = cvtpk(a4[0], a4[1]); w.y = cvtpk(a4[2], a4[3]); *(LAS v2u*)(RHS + (i0 + fr) * LD32 + t0m + fq * 4) = w; }
            if (ns == 2) {
                yacc = (f32x4){0.f, 0.f, 0.f, 0.f};
#pragma unroll
                for (int ks = 0; ks < 2; ++ks) yacc = MFMA16(FRAG(S0c, i0, LD64, ks), FRAG(RT, t0m, LD64, ks), yacc);
                yacc = MFMA16(FRAGT(VS, i0, LD64), FRAG(ARK, t0m, LD32, 0), yacc); }
            if (ns == 3) {
#pragma unroll
                for (int u = 0; u < 2; ++u) { const int tile = wave * 2 + u, si0 = (tile >> 2) * 16, sj0 = (tile & 3) * 16; sacc[u] = MFMA16(FRAGT(KT_, sj0, LD64), FRAGT(VS, si0, LD64), sacc[u]); } }
            __syncthreads();
        }
        const LAS bf16* MINV = PMB + 1 * 32 * LD32;
        { f32x4 a4 = (f32x4){0.f, 0.f, 0.f, 0.f}; a4 = MFMA16(FRAG(MINV, t0m, LD32, 0), FRAG(RHS, i0, LD32, 0), a4);
          v2u w; w.x = cvtpk(a4[0], a4[1]); w.y = cvtpk(a4[2], a4[3]); *(LAS v2u*)(SAB + (i0 + fr) * LD32 + t0m + fq * 4) = w; }
        __syncthreads();
        { yacc = MFMA16(FRAG(SAB, i0, LD32, 0), FRAG(ARB, t0m, LD32, 0), yacc);
          *(LAS f32x4*)(YB + (t0m + fr) * 68 + i0 + fq * 4) = yacc;
#pragma unroll
          for (int u = 0; u < 2; ++u) { const int tile = wave * 2 + u, si0 = (tile >> 2) * 16, sj0 = (tile & 3) * 16;
              sacc[u] = MFMA16(FRAGT(BT_, sj0, LD64), FRAG(SAB, si0, LD32, 0), sacc[u]);
              const f32x4 pc = *(const LAS f32x4*)(PC + sj0 + fq * 4); sacc[u] = sacc[u] * pc;
              v2u w; w.x = cvtpk(sacc[u][0], sacc[u][1]); w.y = cvtpk(sacc[u][2], sacc[u][3]); *(LAS v2u*)(S0n + (si0 + fr) * LD64 + sj0 + fq * 4) = w; } }
        __syncthreads();
    }
    __syncthreads();
#undef FRAG
#undef FRAGT
#undef RWKV_PREFETCH
}
__device__ __forceinline__ void lora_prepass(const Frame& F) {
    const bf16* PROJ = WSP(bf16, WS_PROJ); bf16* LA = WSP(bf16, WS_LA); const float* mu = F.in[I_MU] + (PC_WD - RWKV_C0);
    const int gt = (F.bid * NWAVES + F.wave) * 64 + F.lane, NGT = F.G * NTHR;
    for (int i = gt; i < T * 36; i += NGT) { const int tok = i / 36, cc = i - tok * 36, m = cc * 8;
        const bf16* pr = PROJ + (size_t)tok * NINP + PC_WD + m;
        const v4u curv = *(const v4u*)pr; v4u prv = (v4u){0u, 0u, 0u, 0u}; if ((tok & (SEQ - 1)) != 0) prv = *(const v4u*)(pr - NINP);
        const f32x4 m0 = *(const f32x4*)(mu + m), m1 = *(const f32x4*)(mu + m + 4);
        float c[8], p[8], o[8]; unpack8(curv, c); unpack8(prv, p);
#pragma unroll
        for (int e = 0; e < 8; ++e) { const float ps = c[e] + (p[e] - c[e]) * (e < 4 ? m0[e] : m1[e - 4]); o[e] = (m < 64) ? tanh_fast(ps) : ((m < 128) ? ps : sigmoid_fast(ps)); }
        v4u w; w.x = cvtpk(o[0], o[1]); w.y = cvtpk(o[2], o[3]); w.z = cvtpk(o[4], o[5]); w.w = cvtpk(o[6], o[7]);
        *(v4u*)(LA + (size_t)tok * 288 + m) = w; }
}
__device__ __forceinline__ void lru_seq(const Frame& F, int bh) {
    const int b = bh >> 3, h = bh & 7, wave = F.wave; int tid = F.tid; asm volatile("" : "+v"(tid)); const int lane = tid & 63;
    LAS unsigned char* L = F.lds;
    LAS bf16* XA = (LAS bf16*)(L + 0);
    LAS float* XC = (LAS float*)(L + 17408);
    LAS float* RI = (LAS float*)(L + 50176);
    LAS float* SEG = (LAS float*)(L + 115712);
    LAS float* CARRY = (LAS float*)(L + 119808);
    LAS float* CW = (LAS float*)(L + 120320);
    const bf16* PROJ = WSP(bf16, WS_PROJ); bf16* Y = WSP(bf16, WS_Y);
    const int fr0 = lane & 15, fq0 = lane >> 4;
    for (int i = tid; i < 640; i += NTHR) { const int w = i >> 7, cch = i & 127; CW[i] = (w < 4) ? F.in[I_CONVW][w * 1024 + h * 128 + cch] : F.in[I_CONVB][h * 128 + cch]; }
    if (tid < 128) CARRY[tid] = 0.f;
    const int gsel = wave & 1, nt0 = (wave >> 1) * 2;
    bf16x8 wf[2][4];
    { const bf16* WTp = (gsel ? WSP(bf16, WS_WIT) : WSP(bf16, WS_WAT)) + (size_t)h * 128 * 128;
#pragma unroll
      for (int n = 0; n < 2; ++n)
#pragma unroll
          for (int ks = 0; ks < 4; ++ks) wf[n][ks] = *(const bf16x8*)(WTp + ((nt0 + n) * 16 + fr0) * 128 + ks * 32 + 8 * fq0); }
    const int c = tid & 127, sg = tid >> 7, chg = h * 128 + c;
    const float ba_c = F.in[I_BA][chg], bi_c = F.in[I_BI][chg], sp8 = 8.0f * softplus_fast(-F.in[I_LAM][chg]);
    v4u pf[2][4];
#define LRU_PREFETCH(k_) do { _Pragma("unroll") for (int u_ = 0; u_ < 2; ++u_) { const int chn_ = tid + NTHR * u_, t_ = chn_ >> 4, c8_ = (chn_ & 15) * 8; \
        _Pragma("unroll") for (int w_ = 0; w_ < 4; ++w_) { const int ts_ = (k_) * 64 + t_ - 3 + w_; const int tc_ = ts_ >= 0 ? ts_ : 0;   \
            const v4u x_ = *(const v4u*)(PROJ + ((size_t)b * SEQ + tc_) * NINP + h * 128 + c8_); const unsigned m_ = ts_ >= 0 ? 0xffffffffu : 0u; \
            pf[u_][w_] = (v4u){x_.x & m_, x_.y & m_, x_.z & m_, x_.w & m_}; } } } while (0)
    LRU_PREFETCH(0);
    __syncthreads();
    for (int k = 0; k < SEQ / 64; ++k) {
        const size_t tokbase = (size_t)b * SEQ + k * 64;
        int lane_c = lane; asm volatile("" : "+v"(lane_c)); const int fr = lane_c & 15, fq = lane_c >> 4;
#pragma unroll
        for (int u = 0; u < 2; ++u) { const int chn = tid + NTHR * u, t = chn >> 4, c8 = (chn & 15) * 8;
            float acc[8]; { const f32x4 b0 = *(const LAS f32x4*)(CW + 512 + c8), b1 = *(const LAS f32x4*)(CW + 512 + c8 + 4);
#pragma unroll
                for (int e = 0; e < 4; ++e) { acc[e] = b0[e]; acc[e + 4] = b1[e]; } }
#pragma unroll
            for (int w = 0; w < 4; ++w) { float xf[8]; unpack8(pf[u][w], xf);
                const f32x4 w0 = *(const LAS f32x4*)(CW + w * 128 + c8), w1 = *(const LAS f32x4*)(CW + w * 128 + c8 + 4);
#pragma unroll
                for (int e = 0; e < 4; ++e) { acc[e] += w0[e] * xf[e]; acc[e + 4] += w1[e] * xf[e + 4]; } }
            v4u pk; pk.x = cvtpk(acc[0], acc[1]); pk.y = cvtpk(acc[2], acc[3]); pk.z = cvtpk(acc[4], acc[5]); pk.w = cvtpk(acc[6], acc[7]);
            *(LAS v4u*)(XA + t * 136 + c8) = pk;
            LAS float* d = XC + t * 128 + c8; *(LAS f32x4*)d = (f32x4){acc[0], acc[1], acc[2], acc[3]}; *(LAS f32x4*)(d + 4) = (f32x4){acc[4], acc[5], acc[6], acc[7]}; }
        { const int kn_ = k + 1 < SEQ / 64 ? k + 1 : SEQ / 64 - 1; LRU_PREFETCH(kn_); }
        unsigned short gt[16];
#pragma unroll
        for (int e = 0; e < 16; ++e) gt[e] = PROJ[(tokbase + sg * 16 + e) * NINP + PC_GATE + chg];
        __syncthreads();
#pragma unroll
        for (int mt = 0; mt < 4; ++mt) {
            bf16x8 af[4];
#pragma unroll
            for (int ks = 0; ks < 4; ++ks) af[ks] = *(const LAS bf16x8*)(XA + (mt * 16 + fr) * 136 + ks * 32 + 8 * fq);
#pragma unroll
            for (int n = 0; n < 2; ++n) { f32x4 a4 = (f32x4){0.f, 0.f, 0.f, 0.f};
#pragma unroll
                for (int ks = 0; ks < 4; ++ks) a4 = MFMA16(wf[n][ks], af[ks], a4);
                *(LAS f32x4*)(RI + gsel * 8192 + (mt * 16 + fr) * 128 + (nt0 + n) * 16 + fq * 4) = a4; } }
        __syncthreads();
        float av[16], bx[16]; float A = 1.f, B = 0.f;
#pragma unroll
        for (int e = 0; e < 16; ++e) { const int t = sg * 16 + e; const float r = sigmoid_fast(RI[t * 128 + c] + ba_c), ig = sigmoid_fast(RI[8192 + t * 128 + c] + bi_c), xc = XC[t * 128 + c];
            const float la = -sp8 * r; av[e] = __expf(la); bx[e] = sqrtf(fmaxf(1.0f - av[e] * av[e], 0.f)) * (ig * xc); A *= av[e]; B = av[e] * B + bx[e]; }
        SEG[(sg * 128 + c) * 2] = A; SEG[(sg * 128 + c) * 2 + 1] = B;
        __syncthreads();
        float hst = CARRY[c];
        for (int s2 = 0; s2 < sg; ++s2) hst = SEG[(s2 * 128 + c) * 2] * hst + SEG[(s2 * 128 + c) * 2 + 1];
#pragma unroll
        for (int e = 0; e < 16; ++e) { hst = av[e] * hst + bx[e];
            const float g = __uint_as_float((unsigned)gt[e] << 16);
            Y[(tokbase + sg * 16 + e) * D + chg] = (bf16)(cvtpk(hst * gelu_fast(g), 0.f) & 0xffffu); }
        __syncthreads();
        if (sg == 3) CARRY[c] = hst;
    }
    __syncthreads();
#undef LRU_PREFETCH
}
__device__ __forceinline__ void group_barrier(unsigned* cnt, unsigned n) {
    asm volatile("s_waitcnt vmcnt(0)" ::: "memory");
    __syncthreads();
    if (threadIdx.x == 0) {
        __builtin_amdgcn_fence(__ATOMIC_RELEASE, "agent");
        asm volatile("s_waitcnt vmcnt(0)" ::: "memory");
        xb_add(cnt, 1u);
        unsigned sp = 0; while (xb_ld(cnt) < n) { __builtin_amdgcn_s_sleep(2); if (++sp > (1u << 24)) break; }
        __builtin_amdgcn_fence(__ATOMIC_ACQUIRE, "agent");
        asm volatile("s_waitcnt vmcnt(0)" ::: "memory");
    }
    __syncthreads();
}

__device__ __forceinline__ unsigned f2ord(float f) { const unsigned u = __builtin_bit_cast(unsigned, f); return (u & 0x80000000u) ? ~u : (u | 0x80000000u); }
__device__ __forceinline__ float ord2f(unsigned o) { const unsigned u = (o & 0x80000000u) ? (o & 0x7fffffffu) : ~o; return __builtin_bit_cast(float, u); }
#define CMPX(hi_, lo_) do { const unsigned _a = (hi_), _b = (lo_); (hi_) = _a > _b ? _a : _b; (lo_) = _a > _b ? _b : _a; } while (0)
template <int N> __device__ __forceinline__ void sort_desc(unsigned (&a)[N]) {
#pragma unroll
    for (int k = 2; k <= N; k <<= 1)
#pragma unroll
        for (int j = k >> 1; j > 0; j >>= 1)
#pragma unroll
            for (int i = 0; i < N; ++i) { const int l = i ^ j; if (l > i) { if ((i & k) == 0) CMPX(a[i], a[l]); else CMPX(a[l], a[i]); } }
}
__device__ __forceinline__ void merge16(unsigned (&A)[16], const unsigned (&B)[16]) {
#pragma unroll
    for (int i = 0; i < 16; ++i) { const unsigned q = B[15 - i]; A[i] = A[i] > q ? A[i] : q; }
#pragma unroll
    for (int d = 8; d >= 1; d >>= 1)
#pragma unroll
        for (int i = 0; i < 16; ++i) if ((i & d) == 0) CMPX(A[i], A[i + d]);
}
__device__ __forceinline__ void merge_partner(unsigned (&Lk)[16]) {
    unsigned P[16];
#pragma unroll
    for (int i = 0; i < 16; ++i) P[i] = (unsigned)__shfl_xor((int)Lk[i], 32);
#pragma unroll
    for (int i = 0; i < 16; ++i) { const unsigned q = P[15 - i]; Lk[i] = Lk[i] > q ? Lk[i] : q; }
#pragma unroll
    for (int d = 8; d >= 1; d >>= 1)
#pragma unroll
        for (int i = 0; i < 16; ++i) if ((i & d) == 0) CMPX(Lk[i], Lk[i + d]);
}
__device__ __forceinline__ void route_item(const Frame& F, int item, int lane) {
    const int tok0 = (item >> 3) * 32, h = item & 7, c = lane & 31, hi = lane >> 5;
    const bf16* Q = WSP(bf16, WS_Q); const bf16* KB = WSP(bf16, WS_KEYS);
    LAS unsigned* WL = (LAS unsigned*)(F.lds + F.wave * 8192);
    unsigned LST[2][16];
    bf16x8 qf[8], qn[8], kf[8], kn[8];
#pragma unroll
    for (int ks = 0; ks < 8; ++ks) { qf[ks] = *(const bf16x8*)(Q + (size_t)(tok0 + c) * D + h * 256 + ks * 16 + 8 * hi); qn[ks] = *(const bf16x8*)(Q + (size_t)(tok0 + c) * D + h * 256 + 128 + ks * 16 + 8 * hi);
        kf[ks] = *(const bf16x8*)(KB + (size_t)((h * 2) * 128 + c) * 128 + 8 * hi + ks * 16); }
    unsigned Lk[16];
#pragma unroll
    for (int st = 0; st < 8; ++st) { const int p = st >> 2, m = st & 3;
        if (st < 7) { const int p2 = (st + 1) >> 2, m2 = (st + 1) & 3; const bf16* kp = KB + (size_t)((h * 2 + p2) * 128 + m2 * 32 + c) * 128 + 8 * hi;
#pragma unroll
            for (int ks = 0; ks < 8; ++ks) kn[ks] = *(const bf16x8*)(kp + ks * 16); }
        f32x16 acc;
#pragma unroll
        for (int r = 0; r < 16; ++r) acc[r] = 0.f;
#pragma unroll
        for (int ks = 0; ks < 8; ++ks) acc = MFMA32(kf[ks], p ? qn[ks] : qf[ks], acc);
        unsigned G16[16];
#pragma unroll
        for (int r = 0; r < 16; ++r) { const unsigned idx = (unsigned)(m * 32 + (r & 3) + 8 * (r >> 2)) | ((unsigned)hi << 2); G16[r] = (f2ord(acc[r]) & ~0x7Fu) | idx; }
        sort_desc<16>(G16);
        if (m == 0) {
#pragma unroll
            for (int i = 0; i < 16; ++i) Lk[i] = G16[i]; }
        else merge16(Lk, G16);
        if (m == 3) { merge_partner(Lk);
#pragma unroll
            for (int i = 0; i < 16; ++i) { LST[p][i] = Lk[i]; WL[(p * 16 + i) * 64 + lane] = Lk[i] & 0x7Fu; } }
#pragma unroll
        for (int ks = 0; ks < 8; ++ks) kf[ks] = kn[ks];
    }
    float va[4], vb[16];
#pragma unroll
    for (int i = 0; i < 4; ++i) va[i] = ord2f((hi ? LST[1][i] : LST[0][i]) & ~0x7Fu);
#pragma unroll
    for (int j = 0; j < 16; ++j) vb[j] = ord2f((hi ? LST[0][j] : LST[1][j]) & ~0x7Fu);
    unsigned C32[32];
#pragma unroll
    for (int i = 0; i < 32; ++i) C32[i] = 0u;
#pragma unroll
    for (int i = 0; i < 4; ++i) { const unsigned key = (f2ord(va[i] + vb[i]) & ~0xFFu) | (unsigned)(i * 17); C32[i] = hi ? 0u : key; }
    { int cn = 4;
#pragma unroll
      for (int i = 0; i < 3; ++i)
#pragma unroll
          for (int j = i + 1; j < 16; ++j) if ((i + 1) * (j + 1) <= 16) { const unsigned code = hi ? (unsigned)(j * 16 + i) : (unsigned)(i * 16 + j); C32[cn] = (f2ord(va[i] + vb[j]) & ~0xFFu) | code; ++cn; } }
    sort_desc<32>(C32);
    unsigned Ck[16];
#pragma unroll
    for (int i = 0; i < 16; ++i) Ck[i] = C32[i];
    merge_partner(Ck);
    const float mx = ord2f(Ck[0] & ~0xFFu); float den = 0.f;
#pragma unroll
    for (int k = 0; k < 16; ++k) den += __expf(ord2f(Ck[k] & ~0xFFu) - mx);
    const float rden = 1.0f / den;
    int eo[8]; float go[8];
#pragma unroll
    for (int k = 0; k < 8; ++k) { const unsigned fm = hi ? Ck[k + 8] : Ck[k]; const unsigned code = fm & 0xFFu;
        const unsigned k0 = WL[(code >> 4) * 64 + lane], k1 = WL[(16 + (code & 15u)) * 64 + lane];
        eo[k] = (int)(k0 * 128u + k1); go[k] = __expf(ord2f(fm & ~0xFFu) - mx) * rden; }
    int* ep = WSP(int, WS_EXP) + (size_t)(tok0 + c) * NSEL + h * 16 + hi * 8; float* gp = WSP(float, WS_GATE) + (size_t)(tok0 + c) * NSEL + h * 16 + hi * 8;
    *(int4*)ep = make_int4(eo[0], eo[1], eo[2], eo[3]); *(int4*)(ep + 4) = make_int4(eo[4], eo[5], eo[6], eo[7]);
    *(f32x4*)gp = (f32x4){go[0], go[1], go[2], go[3]}; *(f32x4*)(gp + 4) = (f32x4){go[4], go[5], go[6], go[7]};
}

typedef float f32x2 __attribute__((ext_vector_type(2)));
__device__ __forceinline__ int dot4i(unsigned a, unsigned b, int c) { return __builtin_amdgcn_sdot4((int)a, (int)b, c, false); }
template <int CTRL> __device__ __forceinline__ int dppi(int x) { return __builtin_amdgcn_mov_dpp(x, CTRL, 0xf, 0xf, true); }
struct PeerGeom { int ngrp, g, rank, nrank; };
__device__ __forceinline__ PeerGeom peer_geom(const Frame& F) { PeerGeom p; p.ngrp = (F.G % 8 == 0) ? 8 : 1; p.g = F.bid % p.ngrp; p.rank = F.bid / p.ngrp; p.nrank = F.G / p.ngrp; return p; }
__device__ __forceinline__ void xquant_token(const Frame& F, int tok, int lane) {
    const bf16* xr = WSP(bf16, WS_XB) + (size_t)tok * D + lane * 16; float xf[32]; float am = 0.f;
#pragma unroll
    for (int hh = 0; hh < 2; ++hh)
#pragma unroll
        for (int q = 0; q < 2; ++q) { const v4u w = *(const v4u*)(xr + hh * 1024 + q * 8); float t8[8]; unpack8(w, t8);
#pragma unroll
            for (int e = 0; e < 8; ++e) { xf[hh * 16 + q * 8 + e] = t8[e]; am = fmaxf(am, fabsf(t8[e])); } }
#pragma unroll
    for (int o = 1; o < 64; o <<= 1) am = fmaxf(am, __shfl_xor(am, o));
    const float qs = am > 0.f ? 127.0f / am : 0.f;
    if (lane == 0) WSP(float, WS_SX)[tok] = am * (1.0f / 127.0f);
#pragma unroll
    for (int hh = 0; hh < 2; ++hh) { v4u o;
#pragma unroll
        for (int d = 0; d < 4; ++d) { unsigned w = 0u;
#pragma unroll
            for (int e = 0; e < 4; ++e) { const int qi = (int)rintf(xf[hh * 16 + d * 4 + e] * qs); w |= ((unsigned)qi & 0xFFu) << (8 * e); }
            o[d] = w; }
        *(v4u*)(WSP(unsigned char, WS_XQ) + (size_t)tok * D + hh * 1024 + lane * 16) = o; }
}
__device__ __forceinline__ void peer_score_slice(const Frame& F, int tok, int slice, int lane, LAS int* wl) {
    const int e8 = lane >> 3, c16 = lane & 7;
    const int* ep = WSP(int, WS_EXP) + (size_t)tok * NSEL;
    wl[lane] = ep[lane]; wl[64 + lane] = ep[64 + lane];
    const v4u xs = *(const v4u*)(WSP(unsigned char, WS_XQ) + (size_t)tok * D + slice * 128 + c16 * 16);
    const unsigned char* ub = WSP(unsigned char, WS_UT); const unsigned lo = (unsigned)(slice * 128 + c16 * 16);
    int p[16];
#pragma unroll
    for (int ld = 0; ld < 16; ++ld) { const unsigned eid = (unsigned)wl[e8 * 16 + ld]; const v4u w = *(const v4u*)(ub + (eid * 2048u + lo));
        int a = dot4i(w.x, xs.x, 0); a = dot4i(w.y, xs.y, a); a = dot4i(w.z, xs.z, a); p[ld] = dot4i(w.w, xs.w, a); }
    { const bool up = (lane & 4) != 0;
#pragma unroll
      for (int k = 0; k < 8; ++k) { const int keep = up ? p[k + 8] : p[k], send = up ? p[k] : p[k + 8]; p[k] = keep + dppi<0x141>(send); } }
    { const bool up = (lane & 2) != 0;
#pragma unroll
      for (int k = 0; k < 4; ++k) { const int keep = up ? p[k + 4] : p[k], send = up ? p[k] : p[k + 4]; p[k] = keep + dppi<0x4E>(send); } }
    { const bool up = (lane & 1) != 0;
#pragma unroll
      for (int k = 0; k < 2; ++k) { const int keep = up ? p[k + 2] : p[k], send = up ? p[k] : p[k + 2]; p[k] = keep + dppi<0xB1>(send); } }
    int* dst = WSP(int, WS_PART) + ((size_t)slice * T + tok) * NSEL + lane * 2;
    *(int2*)dst = make_int2(p[0], p[1]);
}
__device__ __forceinline__ void peer_coef_token(const Frame& F, int tok, int lane) {
    int s0 = 0, s1 = 0;
#pragma unroll
    for (int s = 0; s < 16; ++s) { const int2 v = *(const int2*)(WSP(int, WS_PART) + ((size_t)s * T + tok) * NSEL + lane * 2); s0 += v.x; s1 += v.y; }
    const int2 ex = *(const int2*)(WSP(int, WS_EXP) + (size_t)tok * NSEL + lane * 2); const f32x2 ga = *(const f32x2*)(WSP(float, WS_GATE) + (size_t)tok * NSEL + lane * 2);
    const float rs = WSP(float, WS_SX)[tok] * (1.0f / sqrtf(WSP(float, WS_SSQ2)[tok] * (1.0f / D) + NORM_EPS));
    const float sc0 = (float)s0 * WSP(float, WS_USC)[ex.x] * rs, sc1 = (float)s1 * WSP(float, WS_USC)[ex.y] * rs;
    f32x2 c; c.x = ga.x * gelu_fast(sc0) * WSP(float, WS_VSC)[ex.x]; c.y = ga.y * gelu_fast(sc1) * WSP(float, WS_VSC)[ex.y];
    float cm = fmaxf(fabsf(c.x), fabsf(c.y));
#pragma unroll
    for (int o = 1; o < 64; o <<= 1) cm = fmaxf(cm, __shfl_xor(cm, o));
    const float qs = cm > 0.f ? 127.0f / cm : 0.f;
    const int q0 = (int)rintf(c.x * qs), q1 = (int)rintf(c.y * qs);
    ((unsigned short*)(F.ws + WS_COEF))[(size_t)tok * 64 + lane] = (unsigned short)(((unsigned)q0 & 0xFFu) | (((unsigned)q1 & 0xFFu) << 8));
    if (lane == 0) WSP(float, WS_CSC)[tok] = cm * (1.0f / 127.0f);
}
struct PeerOutBuf { v4u w[16]; v4u cq; f32x2 x; float cs; };
__device__ __forceinline__ void peer_out_issue(const Frame& F, int tok, int slice, int lane, LAS int* wl, PeerOutBuf& B) {
    const int e8 = lane >> 3, c16 = lane & 7;
    const int* ep = WSP(int, WS_EXP) + (size_t)tok * NSEL;
    wl[lane] = ep[lane]; wl[64 + lane] = ep[64 + lane];
    B.cq = *(const v4u*)(F.ws + WS_COEF + (size_t)tok * 128 + e8 * 16);
    B.cs = WSP(float, WS_CSC)[tok];
    const unsigned char* vb = WSP(unsigned char, WS_VT); const unsigned lofs = (unsigned)(slice * 128 + c16 * 16);
#pragma unroll
    for (int ld = 0; ld < 16; ++ld) { const unsigned eid = (unsigned)wl[e8 * 16 + ld]; B.w[ld] = *(const v4u*)(vb + (eid * 2048u + lofs)); }
    B.x = *(const f32x2*)(F.out + (size_t)tok * D + slice * 128 + c16 * 16 + e8 * 2);
}
__device__ __forceinline__ void peer_out_consume(const Frame& F, int tok, int slice, int lane, LAS int* wl, const PeerOutBuf& B) {
    const int e8 = lane >> 3, c16 = lane & 7;
    int o[16];
#pragma unroll
    for (int i = 0; i < 16; ++i) o[i] = 0;
#pragma unroll
    for (int g = 0; g < 4; ++g) { const unsigned cq = B.cq[g];
#pragma unroll
        for (int d = 0; d < 4; ++d) { const unsigned w0 = B.w[4 * g][d], w1 = B.w[4 * g + 1][d], w2 = B.w[4 * g + 2][d], w3 = B.w[4 * g + 3][d];
            const unsigned lo01 = __builtin_amdgcn_perm(w1, w0, 0x05010400u), hi01 = __builtin_amdgcn_perm(w1, w0, 0x07030602u);
            const unsigned lo23 = __builtin_amdgcn_perm(w3, w2, 0x05010400u), hi23 = __builtin_amdgcn_perm(w3, w2, 0x07030602u);
            const unsigned t0 = __builtin_amdgcn_perm(lo23, lo01, 0x05040100u), t1 = __builtin_amdgcn_perm(lo23, lo01, 0x07060302u);
            const unsigned t2 = __builtin_amdgcn_perm(hi23, hi01, 0x05040100u), t3 = __builtin_amdgcn_perm(hi23, hi01, 0x07060302u);
            o[d * 4 + 0] = dot4i(t0, cq, o[d * 4 + 0]); o[d * 4 + 1] = dot4i(t1, cq, o[d * 4 + 1]); o[d * 4 + 2] = dot4i(t2, cq, o[d * 4 + 2]); o[d * 4 + 3] = dot4i(t3, cq, o[d * 4 + 3]); } }
#pragma unroll
    for (int k = 0; k < 8; ++k) { auto s = __builtin_amdgcn_permlane32_swap((unsigned)o[k], (unsigned)o[k + 8], false, false); o[k] = (int)(s[0] + s[1]); }
#pragma unroll
    for (int k = 0; k < 4; ++k) { auto s = __builtin_amdgcn_permlane16_swap((unsigned)o[k], (unsigned)o[k + 4], false, false); o[k] = (int)(s[0] + s[1]); }
    { const bool up = (lane & 8) != 0;
#pragma unroll
      for (int k = 0; k < 2; ++k) { const int keep = up ? o[k + 2] : o[k], send = up ? o[k] : o[k + 2]; o[k] = keep + dppi<0x128>(send); } }
    f32x2 x = B.x; x.x += (float)o[0] * B.cs; x.y += (float)o[1] * B.cs;
    *(f32x2*)(F.out + (size_t)tok * D + slice * 128 + c16 * 16 + e8 * 2) = x;
    float ss = x.x * x.x + x.y * x.y;
    ss += dppf<0xB1>(ss); ss += dppf<0x4E>(ss); ss += dppf<0x141>(ss); ss += dppf<0x140>(ss);
    { auto s = __builtin_amdgcn_permlane16_swap(__float_as_uint(ss), __float_as_uint(ss), false, false); ss = __uint_as_float(s[0]) + __uint_as_float(s[1]); }
    { auto s = __builtin_amdgcn_permlane32_swap(__float_as_uint(ss), __float_as_uint(ss), false, false); ss = __uint_as_float(s[0]) + __uint_as_float(s[1]); }
    if (lane == 0) atomicAdd(WSP(float, WS_SSQ3) + tok, ss);
}
__device__ __forceinline__ void peer_out_phase(const Frame& F, const PeerGeom& pg, LAS int* wl2) {
    const int lane = F.lane, first = pg.rank * NWAVES + F.wave, step = pg.nrank * NWAVES;
    LAS int* wlA = wl2; LAS int* wlB = wl2 + 256;
    for (int r = 0; r < 16 / pg.ngrp; ++r) { const int slice = r * pg.ngrp + pg.g;
        PeerOutBuf A, B;
        int tok = first;
        if (tok < T) peer_out_issue(F, tok, slice, lane, wlA, A);
        while (tok < T) {
            const int t1 = tok + step, t2 = tok + 2 * step;
            if (t1 < T) peer_out_issue(F, t1, slice, lane, wlB, B);
            peer_out_consume(F, tok, slice, lane, wlA, A);
            if (t1 >= T) break;
            if (t2 < T) peer_out_issue(F, t2, slice, lane, wlA, A);
            peer_out_consume(F, t1, slice, lane, wlB, B);
            tok = t2;
        }
    }
}
__device__ __forceinline__ void final_norm_phase(const Frame& F) {
    const int lane = F.lane, gw = F.bid * NWAVES + F.wave, NGW = F.G * NWAVES;
    const f32x4* gf = (const f32x4*)F.in[I_GF] + lane;
    f32x4 g[8];
#pragma unroll
    for (int j = 0; j < 8; ++j) g[j] = gf[64 * j];
    if (gw >= T) return;
    f32x4 va[8], vb[8]; float sa, sb;
#define FN_LOAD(v_, s_, tok_) do { const int tc_ = (tok_) < T ? (tok_) : T - 1; const f32x4* xi_ = (const f32x4*)(F.out + (size_t)tc_ * D) + lane; s_ = WSP(float, WS_SSQ3)[tc_]; \
        _Pragma("unroll") for (int j_ = 0; j_ < 8; ++j_) v_[j_] = xi_[64 * j_]; } while (0)
#define FN_STORE(v_, s_, tok_) do { f32x4* xo_ = (f32x4*)(F.out + (size_t)(tok_) * D) + lane; const float rs_ = 1.0f / sqrtf(s_ * (1.0f / D) + NORM_EPS); \
        _Pragma("unroll") for (int j_ = 0; j_ < 8; ++j_) xo_[64 * j_] = v_[j_] * rs_ * g[j_]; } while (0)
    FN_LOAD(va, sa, gw);
    for (int tok = gw; tok < T; tok += 2 * NGW) {
        FN_LOAD(vb, sb, tok + NGW);
        FN_STORE(va, sa, tok);
        FN_LOAD(va, sa, tok + 2 * NGW);
        if (tok + NGW < T) FN_STORE(vb, sb, tok + NGW);
    }
#undef FN_LOAD
#undef FN_STORE
}

struct Args { const float* in[28]; float* out; unsigned char* ws; int ph_lo, ph_hi, li, pad; };
__global__ void __launch_bounds__(NTHR, 2) hybrid_fwd(Args args) {
    extern __shared__ __attribute__((aligned(16))) unsigned char lds[];
    Frame F;
    F.lds = (LAS unsigned char*)lds;
    F.tid = threadIdx.x; F.lane = F.tid & 63; F.wave = __builtin_amdgcn_readfirstlane(F.tid >> 6);
    F.G = gridDim.x; F.bid = blockIdx.x;
#pragma unroll
    for (int i = 0; i < 28; ++i) F.in[i] = args.in[i];
    F.out = args.out; F.ws = args.ws;
    volatile LAS unsigned* MISC = (volatile LAS unsigned*)(F.lds + MISC_OFF);
    for (int u = F.tid; u < (LDS_BYTES - LDSCTL_OFF) / 4; u += NTHR) ((LAS unsigned*)(F.lds + LDSCTL_OFF))[u] = 0u;
    __syncthreads();
    unsigned* barw = (unsigned*)(F.ws + WS_CTL) + CW_BAR;
    XcdBarrier bar; bar.bar = barw; bar.x = 0; bar.st = nullptr;
    if (N_LAUNCHES == 1) bar = xcd_barrier_post(barw, MISC + 8);
    const int lo = args.ph_lo, hi = args.ph_hi;
#define IN(k) (lo <= (k) && (k) < hi)
#define SEAM(k) do { if (IN(k) && IN((k) + 1)) xcd_barrier(bar); } while (0)

#ifndef PROBE_DUP
#define PROBE_DUP -1
#endif
#define REPS(k) for (int rep_ = 0; rep_ < ((PROBE_DUP) == (k) ? 2 : 1); ++rep_)
    if (IN(0)) REPS(0) { p0_prologue<0>(F, F.bid, F.G); __syncthreads(); }
    SEAM(0);
    if (IN(1)) REPS(1) {
        pg8::Gemm g{WSP(const bf16, WS_XB), WSP(const bf16, WS_WIN), T, NINP, D}; pg8::StaticOrder S; S.init(T, NINP, F.G, F.bid);
        pg8::EpiRowScaleBf16<0> E{WSP(bf16, WS_PROJ), NINP, WSP(const float, WS_RSTD1), NORM_EPS};
        pg8::gemm_phase<pg8::EpiRowScaleBf16<0>, pg8::StaticOrder, true, true>(F.lds, g, S, E);
    }
    SEAM(1);
    if (IN(2)) REPS(2) {
        lora_prepass(F);
        group_barrier((unsigned*)(F.ws + WS_CTL) + CW_PREBAR, (unsigned)F.G);
        for (int r4 = 0; r4 < ((PROBE_DUP) == 70 ? 2 : 1); ++r4) rwkv_prep_phase(F);
        group_barrier((unsigned*)(F.ws + WS_CTL) + CW_PREPBAR, (unsigned)F.G);
        const int R1 = F.G >= 256 ? 128 : F.G, L0 = F.G >= 256 ? 128 : 0, NL = F.G - L0;
        if (F.bid < R1) for (int it = F.bid; it < 128; it += R1) rwkv_item(F, it);
        if (F.bid >= L0) for (int it = F.bid - L0; it < 64; it += NL) lru_seq(F, it);
        { volatile LAS int* qslot = (volatile LAS int*)(F.lds + LDSCTL_OFF + 1024);
          for (;;) { __syncthreads(); if (F.tid == 0) *qslot = (int)xb_add((unsigned*)(F.ws + WS_CTL) + CW_DEFQ, 1u); __syncthreads();
              const int vb = *qslot; if (vb >= 1024) break; p0_prologue<1>(F, vb, 1024); } }
    }
    SEAM(2);
    if (IN(3)) {
        pg8::Gemm g{WSP(const bf16, WS_Y), WSP(const bf16, WS_WOUT), T, D, D}; pg8::StaticOrder S; S.init(T, D, F.G, F.bid);
        pg8::EpiResidual E{F.in[I_X], F.out, WSP(bf16, WS_XB), WSP(float, WS_SSQ2), D};
        pg8::gemm_phase<pg8::EpiResidual, pg8::StaticOrder, true, true>(F.lds, g, S, E);
    }
    SEAM(3);
    if (IN(4)) REPS(4) {
        pg8::Gemm g{WSP(const bf16, WS_XB), WSP(const bf16, WS_WQ), T, D, D}; pg8::StaticOrder S; S.init(T, D, F.G, F.bid);
        pg8::EpiRowScaleBf16<1> E{WSP(bf16, WS_Q), D, WSP(const float, WS_SSQ2), NORM_EPS};
        pg8::gemm_phase<pg8::EpiRowScaleBf16<1>, pg8::StaticOrder, true, true>(F.lds, g, S, E);
    }
    if (IN(4)) { __syncthreads();
        pg8::StaticOrder S; S.init(T, D, F.G, F.bid); pg8::Unit u;
        for (int i = 0; S.next(i, u); ++i) route_item(F, ((u.pm * 8 + F.wave) << 3) | u.pn, F.lane);
        const int gw = F.bid * NWAVES + F.wave, NGW = F.G * NWAVES;
        for (int tok = gw; tok < T; tok += NGW) xquant_token(F, tok, F.lane); }
    if (IN(4) && IN(6)) xcd_barrier(bar);
    { const PeerGeom pg = peer_geom(F); LAS int* wl = (LAS int*)(F.lds + F.wave * 1024);
      if (IN(6)) REPS(6) { for (int r = 0; r < 16 / pg.ngrp; ++r) { const int slice = r * pg.ngrp + pg.g; for (int tok = pg.rank * NWAVES + F.wave; tok < T; tok += pg.nrank * NWAVES) peer_score_slice(F, tok, slice, F.lane, wl); } }
      SEAM(6);
      if (IN(7)) REPS(7) { const int gw = F.bid * NWAVES + F.wave, NGW = F.G * NWAVES; for (int tok = gw; tok < T; tok += NGW) peer_coef_token(F, tok, F.lane); }
      SEAM(7);
      if (IN(8)) peer_out_phase(F, pg, (LAS int*)(F.lds + 16384 + F.wave * 2048));
      SEAM(8);
      if (IN(9)) final_norm_phase(F); }
#undef IN
#undef SEAM
}

extern "C" void kernel_launch(void* const* d_in, const int* in_sizes, int n_in, void* d_out, int out_size, void* d_ws, size_t ws_size, hipStream_t stream) {
    static int grid = 0;
    if (grid == 0) {
        if (n_in != 28 || in_sizes[0] != T * D || out_size != T * D || ws_size < WS_END) { fprintf(stderr, "kernel_launch: shape/workspace mismatch: n_in %d in0 %d out %d ws %zu (need %zu)\n", n_in, n_in > 0 ? in_sizes[0] : -1, out_size, ws_size, (size_t)WS_END); grid = -1; return; }
        int dev = 0, cus = 0, per_cu = 0;
        if (hipGetDevice(&dev) != hipSuccess || hipDeviceGetAttribute(&cus, hipDeviceAttributeMultiprocessorCount, dev) != hipSuccess) { fprintf(stderr, "kernel_launch: device query failed\n"); grid = -1; return; }
        if (hipFuncSetAttribute((const void*)hybrid_fwd, hipFuncAttributeMaxDynamicSharedMemorySize, LDS_BYTES) != hipSuccess) { fprintf(stderr, "kernel_launch: hipFuncSetAttribute failed\n"); grid = -1; return; }
        if (hipOccupancyMaxActiveBlocksPerMultiprocessor(&per_cu, (const void*)hybrid_fwd, NTHR, LDS_BYTES) != hipSuccess || per_cu < 1) { fprintf(stderr, "kernel_launch: occupancy query says %d blocks per CU\n", per_cu); per_cu = 1; }
        (void)hipGetLastError();
        grid = cus;
    }
    if (grid < 0) return;
    if (hipMemsetAsync((char*)d_ws + WS_CTL, 0, CTL_ZERO_BYTES, stream) != hipSuccess) { fprintf(stderr, "kernel_launch: hipMemsetAsync failed\n"); return; }
    Args a{};
    for (int i = 0; i < 28; ++i) a.in[i] = (const float*)d_in[i];
    a.out = (float*)d_out; a.ws = (unsigned char*)d_ws;
    for (int li = 0; li < N_LAUNCHES; ++li) {
        a.ph_lo = (N_LAUNCHES == 1) ? 0 : li; a.ph_hi = (N_LAUNCHES == 1) ? N_PHASES : li + 1; a.li = li;
        hipLaunchKernelGGL(hybrid_fwd, dim3(grid), dim3(NTHR), LDS_BYTES, stream, a);
        const hipError_t le = hipPeekAtLastError();
        if (le != hipSuccess) { fprintf(stderr, "kernel_launch: launch %d failed: %s\n", li, hipGetErrorName(le)); break; }
    }
}
```

```cpp
#include <hip/hip_runtime.h>
#include <cstdio>
#include <cstdint>
namespace pg8 {
#define PG8_LAS __attribute__((address_space(3)))
typedef unsigned short bf16_t;
typedef short bf16x8 __attribute__((ext_vector_type(8)));
typedef float f32x4 __attribute__((ext_vector_type(4)));
typedef unsigned u32x4 __attribute__((ext_vector_type(4)));
constexpr int BM = 256, BK = 64, HALF = 128, HTB = HALF * BK * 2  , STAGE_BYTES = 8 * HTB, NXCD = 8, WGM = 8;

__host__ __device__ __forceinline__ int lds_byte(int r, int c) { const int st = (r >> 4) * 2 + (c >> 5), rr = r & 15, cc = c & 31, ob = rr * 64 + cc * 2; return st * 1024 + (ob ^ (((ob >> 9) & 1) << 5)); }
__host__ __device__ __forceinline__ void stage_rc(int b, int& R, int& C) { const int st = b / 1024, sb = b % 1024, swz = sb ^ (((sb >> 9) & 1) << 5); R = (st >> 1) * 16 + swz / 64; C = (st & 1) * 32 + (swz % 64) / 2; }
__host__ __device__ __forceinline__ int perm32(int rho) { const int n = rho >> 4, i = rho & 15; return 8 * (i >> 2) + 4 * n + (i & 3); }

struct Unit { int pm, pn; };
struct Gemm { const bf16_t* A; const bf16_t* Bt; int M, N, K; };

struct StaticOrder {
    int nM, nN, nwg, G, c;
    __host__ __device__ void init(int M, int N, int G_, int c_) { nM = M / BM; nN = N / BM; nwg = nM * nN; G = G_; c = c_; }
    __host__ __device__ bool next(int i, Unit& u) const {
        const long L = (long)i * G + c; if (L >= nwg) return false;
        int wgid = (int)L; { const int q = nwg / NXCD, r = nwg % NXCD, xcd = wgid % NXCD, off = wgid / NXCD; wgid = (xcd < r ? xcd * (q + 1) : r * (q + 1) + (xcd - r) * q) + off; }
        const int nig = WGM * nN, gid = wgid / nig, fm = gid * WGM, gsz = (nM - fm) < WGM ? (nM - fm) : WGM;
        u.pm = fm + ((wgid % nig) % gsz); u.pn = (wgid % nig) / gsz; return true;
    }
    __device__ __forceinline__ void a_ready(const Unit&) const {}
    __device__ __forceinline__ void done(const Unit&) const {}
};

__device__ __forceinline__ unsigned cvt_pk_bf16(float lo, float hi) { unsigned r; asm volatile("v_cvt_pk_bf16_f32 %0, %1, %2" : "=v"(r) : "v"(lo), "v"(hi)); return r; }
typedef float f32x2 __attribute__((ext_vector_type(2)));
typedef unsigned u32x2 __attribute__((ext_vector_type(2)));
template <int MODE> struct EpiRowScaleBf16 {
    static constexpr bool PERM = true, AFTER_DRAIN = false;
    bf16_t* O; int ldc; const float* rs; float eps;
    __device__ __forceinline__ void operator()(const f32x4 (&acc)[2][2][4][2], const Unit& u, int wr, int wc, int fr, int fq) const {
        const int row0 = u.pm * BM + wr * 64 + fr, col0 = u.pn * BM + wc * 32 + 8 * fq;
#pragma unroll
        for (int ai = 0; ai < 2; ++ai)
#pragma unroll
            for (int m = 0; m < 4; ++m) { const int r = row0 + ai * HALF + m * 16; float s = rs[r]; if (MODE == 1) s = 1.0f / sqrtf(s * (1.0f / 2048.0f) + eps);
                bf16_t* rowp = O + (size_t)r * ldc + col0;
#pragma unroll
                for (int bj = 0; bj < 2; ++bj) { const f32x4 v0 = acc[ai][bj][m][0] * s, v1 = acc[ai][bj][m][1] * s;
                    u32x4 w; w.x = cvt_pk_bf16(v0[0], v0[1]); w.y = cvt_pk_bf16(v0[2], v0[3]); w.z = cvt_pk_bf16(v1[0], v1[1]); w.w = cvt_pk_bf16(v1[2], v1[3]);
                    *(u32x4*)(rowp + bj * HALF) = w; } }
    }
};
struct EpiResidual {
    static constexpr bool PERM = false, AFTER_DRAIN = false;
    const float* base; float* out; bf16_t* outb; float* ssq; int ldc;
    __device__ __forceinline__ void operator()(const f32x4 (&acc)[2][2][4][2], const Unit& u, int wr, int wc, int fr, int fq) const {
        const int row0 = u.pm * BM + wr * 64 + fr, col0 = u.pn * BM + wc * 32 + 4 * fq;
#pragma unroll
        for (int ai = 0; ai < 2; ++ai)
#pragma unroll
            for (int m = 0; m < 4; ++m) { const int r = row0 + ai * HALF + m * 16; const size_t off = (size_t)r * ldc + col0; float q = 0.f;
#pragma unroll
                for (int bj = 0; bj < 2; ++bj)
#pragma unroll
                    for (int n = 0; n < 2; ++n) { const f32x4 bs = *(const f32x4*)(base + off + bj * HALF + n * 16); const f32x4 o = bs + acc[ai][bj][m][n];
                        *(f32x4*)(out + off + bj * HALF + n * 16) = o; q += (o[0] * o[0] + o[1] * o[1]) + (o[2] * o[2] + o[3] * o[3]);
                        u32x2 w; w.x = cvt_pk_bf16(o[0], o[1]); w.y = cvt_pk_bf16(o[2], o[3]); *(u32x2*)(outb + off + bj * HALF + n * 16) = w; }
                q += __shfl_xor(q, 16); q += __shfl_xor(q, 32);
                if (fq == 0) atomicAdd(ssq + r, q);
                asm volatile("" ::: "memory"); }
    }
};
template <class Epi, class Sched, bool ALIGN_EPI = false, bool SP2 = false>
__device__ __forceinline__ void gemm_phase(PG8_LAS unsigned char* lds, const Gemm g, const Sched& S, const Epi& E) {
    const int tid = threadIdx.x, wid = __builtin_amdgcn_readfirstlane(tid >> 6), lane = tid & 63, wr = wid >> 2, wc = wid & 3, fr = lane & 15, fq = lane >> 4;
    const int K = g.K, nt = K / BK;
    unsigned voffA[2], voffB[2];
#pragma unroll
    for (int i = 0; i < 2; ++i) { int R, C; stage_rc(tid * 16 + i * 8192, R, C); const int Rb = Epi::PERM ? ((R & ~31) + perm32(R & 31)) : R;
        voffA[i] = (unsigned)(R * K + C) * 2u; voffB[i] = (unsigned)(Rb * K + C) * 2u; }
    const size_t kstep = (size_t)(BK * 2);
    const size_t hstep = (size_t)HALF * K * 2;
    const size_t tstep = 2 * hstep;
    const unsigned ldsw = (unsigned)wid * 1024u;
    const int aoff = lds_byte(wr * 64 + fr, fq * 8), boff = lds_byte(wc * 32 + fr, fq * 8);
#define PG8_SA(b, h) (((b) * 2 + (h)) * HTB)
#define PG8_SB(b, h) ((4 + (b) * 2 + (h)) * HTB)
#define PG8_STAGE(bufoff, gbase, voff) do { _Pragma("unroll") for (int _i = 0; _i < 2; ++_i) \
        __builtin_amdgcn_global_load_lds((const unsigned*)((const char*)(gbase) + (voff)[_i]), (PG8_LAS unsigned*)(lds + (bufoff) + ldsw + _i * 8192), 16, 0, 0); } while (0)
#define PG8_LDA(dst, b, h) do { _Pragma("unroll") for (int m = 0; m < 4; ++m) _Pragma("unroll") for (int k = 0; k < 2; ++k) dst[m][k] = *(const PG8_LAS bf16x8*)(lds + PG8_SA(b, h) + aoff + m * 2048 + k * 1024); } while (0)
#define PG8_LDB(dst, b, h) do { _Pragma("unroll") for (int n = 0; n < 2; ++n) _Pragma("unroll") for (int k = 0; k < 2; ++k) dst[n][k] = *(const PG8_LAS bf16x8*)(lds + PG8_SB(b, h) + boff + n * 2048 + k * 1024); } while (0)
#define PG8_MMA(ai, bj, At, Bt) do { __builtin_amdgcn_s_setprio(1); _Pragma("unroll") for (int m = 0; m < 4; ++m) _Pragma("unroll") for (int n = 0; n < 2; ++n) _Pragma("unroll") for (int k = 0; k < 2; ++k) \
        acc[ai][bj][m][n] = __builtin_amdgcn_mfma_f32_16x16x32_bf16(Bt[n][k], At[m][k], acc[ai][bj][m][n], 0, 0, 0); __builtin_amdgcn_s_setprio(0); } while (0)
#define PG8_WAIT_V(n) asm volatile("s_waitcnt vmcnt(" #n ")" ::: "memory")
#define PG8_WAIT_L(n) asm volatile("s_waitcnt lgkmcnt(" #n ")" ::: "memory")
#define PG8_BAR __builtin_amdgcn_s_barrier()
#define PG8_SCHED __builtin_amdgcn_sched_barrier(0)
    Unit cur, nxt; int ui = 0;
    if (!S.next(0, cur)) return;
    f32x4 acc[2][2][4][2];
#pragma unroll
    for (int a = 0; a < 2; ++a)
#pragma unroll
        for (int b = 0; b < 2; ++b)
#pragma unroll
            for (int m = 0; m < 4; ++m)
#pragma unroll
                for (int n = 0; n < 2; ++n) acc[a][b][m][n] = (f32x4){0.f, 0.f, 0.f, 0.f};
    bf16x8 At[4][2], B0[2][2], B1[2][2];
    const char* cA = (const char*)g.A + (size_t)cur.pm * tstep; const char* cB = (const char*)g.Bt + (size_t)cur.pn * tstep;
    S.a_ready(cur);
    if constexpr (SP2) {
        PG8_STAGE(PG8_SB(0, 0), cB, voffB); PG8_STAGE(PG8_SB(0, 1), cB + hstep, voffB); PG8_STAGE(PG8_SA(0, 0), cA, voffA); PG8_STAGE(PG8_SA(0, 1), cA + hstep, voffA);
        if (wr == 1) PG8_BAR;
        PG8_WAIT_V(2); PG8_BAR;
        PG8_STAGE(PG8_SB(1, 0), cB + kstep, voffB); PG8_STAGE(PG8_SA(1, 0), cA + kstep, voffA); PG8_STAGE(PG8_SB(1, 1), cB + hstep + kstep, voffB);
        PG8_WAIT_V(6); PG8_BAR;
    } else {
        PG8_STAGE(PG8_SB(0, 0), cB, voffB); PG8_STAGE(PG8_SA(0, 0), cA, voffA); PG8_STAGE(PG8_SB(0, 1), cB + hstep, voffB); PG8_STAGE(PG8_SA(0, 1), cA + hstep, voffA);
        if (wr == 1) PG8_BAR;
        PG8_WAIT_V(4); PG8_BAR;
        PG8_STAGE(PG8_SB(1, 0), cB + kstep, voffB); PG8_STAGE(PG8_SA(1, 0), cA + kstep, voffA); PG8_STAGE(PG8_SB(1, 1), cB + hstep + kstep, voffB);
        PG8_WAIT_V(6); PG8_BAR;
    }
    for (;;) {
        const bool has_next = S.next(ui + 1, nxt);
        const char* nA = has_next ? (const char*)g.A + (size_t)nxt.pm * tstep : cA; const char* nB = has_next ? (const char*)g.Bt + (size_t)nxt.pn * tstep : cB;
        for (int t = 0; t < nt; t += 2) {
            const bool last = (t == nt - 2);
            const char* a1 = cA + (size_t)(t + 1) * kstep;
            const char* a2 = last ? nA : cA + (size_t)(t + 2) * kstep; const char* b2 = last ? nB : cB + (size_t)(t + 2) * kstep;
            const char* a3 = a2 + kstep; const char* b3 = b2 + kstep;
            if (last && has_next) S.a_ready(nxt);
            if constexpr (SP2) {
            PG8_LDB(B0, 0, 0); PG8_LDB(B1, 0, 1); PG8_SCHED; PG8_LDA(At, 0, 0); PG8_STAGE(PG8_SA(1, 1), a1 + hstep, voffA);
            PG8_WAIT_V(8); PG8_WAIT_L(0); PG8_BAR; PG8_MMA(0, 0, At, B0); PG8_MMA(0, 1, At, B1); PG8_BAR; PG8_SCHED;
            PG8_LDA(At, 0, 1); PG8_STAGE(PG8_SB(0, 0), b2, voffB); PG8_STAGE(PG8_SB(0, 1), b2 + hstep, voffB); PG8_STAGE(PG8_SA(0, 0), a2, voffA);
            PG8_WAIT_V(8); PG8_WAIT_L(0); PG8_BAR; PG8_MMA(1, 0, At, B0); PG8_MMA(1, 1, At, B1); PG8_BAR; PG8_SCHED;
            PG8_LDB(B0, 1, 0); PG8_LDB(B1, 1, 1); PG8_SCHED; PG8_LDA(At, 1, 0); PG8_STAGE(PG8_SA(0, 1), a2 + hstep, voffA);
            PG8_WAIT_V(8); PG8_WAIT_L(0); PG8_BAR; PG8_MMA(0, 0, At, B0); PG8_MMA(0, 1, At, B1); PG8_BAR; PG8_SCHED;
            PG8_LDA(At, 1, 1); PG8_STAGE(PG8_SB(1, 0), b3, voffB); PG8_STAGE(PG8_SB(1, 1), b3 + hstep, voffB); PG8_STAGE(PG8_SA(1, 0), a3, voffA);
            PG8_WAIT_V(8); PG8_WAIT_L(0); PG8_BAR; PG8_MMA(1, 0, At, B0); PG8_MMA(1, 1, At, B1); PG8_BAR; PG8_SCHED;
            } else {
            PG8_LDB(B0, 0, 0); PG8_SCHED; PG8_LDA(At, 0, 0); PG8_STAGE(PG8_SA(1, 1), a1 + hstep, voffA);
            PG8_WAIT_L(8); PG8_BAR; PG8_WAIT_L(0); PG8_MMA(0, 0, At, B0); PG8_BAR; PG8_SCHED;
            PG8_LDB(B1, 0, 1); PG8_STAGE(PG8_SB(0, 0), b2, voffB);
            PG8_BAR; PG8_WAIT_L(0); PG8_MMA(0, 1, At, B1); PG8_BAR;
            PG8_LDA(At, 0, 1); PG8_STAGE(PG8_SA(0, 0), a2, voffA);
            PG8_BAR; PG8_WAIT_L(0); PG8_MMA(1, 0, At, B0); PG8_BAR; PG8_SCHED;
            PG8_STAGE(PG8_SB(0, 1), b2 + hstep, voffB);
            PG8_WAIT_V(6); PG8_BAR; PG8_MMA(1, 1, At, B1); PG8_BAR;
            PG8_LDB(B0, 1, 0); PG8_SCHED; PG8_LDA(At, 1, 0); PG8_STAGE(PG8_SA(0, 1), a2 + hstep, voffA);
            PG8_WAIT_L(8); PG8_BAR; PG8_WAIT_L(0); PG8_MMA(0, 0, At, B0); PG8_BAR; PG8_SCHED;
            PG8_LDB(B1, 1, 1); PG8_STAGE(PG8_SB(1, 0), b3, voffB);
            PG8_BAR; PG8_WAIT_L(0); PG8_MMA(0, 1, At, B1); PG8_BAR;
            PG8_LDA(At, 1, 1); PG8_STAGE(PG8_SA(1, 0), a3, voffA);
            PG8_BAR; PG8_WAIT_L(0); PG8_MMA(1, 0, At, B0); PG8_BAR; PG8_SCHED;
            PG8_STAGE(PG8_SB(1, 1), b3 + hstep, voffB);
            PG8_WAIT_V(6); PG8_BAR; PG8_MMA(1, 1, At, B1); PG8_BAR;
            }
        }
        if constexpr (ALIGN_EPI) { if (wr == 0) PG8_BAR; }
        if constexpr (!Epi::AFTER_DRAIN) { E(acc, cur, wr, wc, fr, fq); S.done(cur); }
        if (!has_next) break;
#pragma unroll
        for (int a = 0; a < 2; ++a)
#pragma unroll
            for (int b = 0; b < 2; ++b)
#pragma unroll
                for (int m = 0; m < 4; ++m)
#pragma unroll
                    for (int n = 0; n < 2; ++n) acc[a][b][m][n] = (f32x4){0.f, 0.f, 0.f, 0.f};
        cur = nxt; cA = nA; cB = nB; ++ui;
        if constexpr (ALIGN_EPI) { if (wr == 1) PG8_BAR; }
    }
    PG8_WAIT_V(0);
    if constexpr (!ALIGN_EPI) { if (wr == 0) PG8_BAR; }
    PG8_BAR;
    if constexpr (Epi::AFTER_DRAIN) { E.fused(acc, cur, wr, wc, fr, fq, lds, wid, lane); S.done(cur); }
#undef PG8_SA
#undef PG8_SB
#undef PG8_STAGE
#undef PG8_LDA
#undef PG8_LDB
#undef PG8_MMA
#undef PG8_WAIT_V
#undef PG8_WAIT_L
#undef PG8_BAR
#undef PG8_SCHED
}
}

#ifndef PROBE_DUP
#define PROBE_DUP -1
#endif
constexpr int NWAVES = 8, NTHR = NWAVES * 64;
#ifndef MK_N_LAUNCHES
#define MK_N_LAUNCHES 1
#endif
constexpr int N_PHASES = 10;
constexpr int N_LAUNCHES = MK_N_LAUNCHES;
static_assert(N_LAUNCHES == 1 || N_LAUNCHES == N_PHASES, "MK_N_LAUNCHES is 1 or N_PHASES");

constexpr int BATCH = 8, SEQ = 2048, T = BATCH * SEQ, D = 2048;
constexpr int NIN = 5408, NINP = 5632;
constexpr int PC_GATE = 1024, PC_R = 2048, PC_K = 3072, PC_V = 4096, PC_WD = 5120, PC_AD = 5184, PC_GD = 5248;
constexpr int RWKV_C0 = 2048;
constexpr int NEXP = 16384, NSEL = 128;
constexpr float NORM_EPS = 1e-6f, GN_EPS = 64e-5f;

constexpr size_t MiB = 1u << 20;
constexpr size_t WS_CTL = 0, CTL_ZERO_BYTES = 1 * MiB;
constexpr size_t WS_SSQ3 = 576 * 1024;
constexpr size_t WS_SSQ2 = 512 * 1024;
constexpr size_t WS_RSTD1 = 1 * MiB;
constexpr size_t WS_USC = 1 * MiB + 64 * 1024, WS_VSC = 1 * MiB + 128 * 1024;
constexpr size_t WS_SX = 1 * MiB + 192 * 1024;
constexpr size_t WS_WIN = 2 * MiB;
constexpr size_t WS_WOUT = 24 * MiB;
constexpr size_t WS_WQ = 32 * MiB;
constexpr size_t WS_KEYS = 40 * MiB;
constexpr size_t WS_W2T = WS_KEYS + 512 * 1024;
constexpr size_t WS_A2T = WS_W2T + 128 * 1024;
constexpr size_t WS_G2T = WS_A2T + 128 * 1024;
constexpr size_t WS_WAT = WS_G2T + 320 * 1024;
constexpr size_t WS_WIT = WS_WAT + 256 * 1024;
constexpr size_t WS_EXP = 42 * MiB;
constexpr size_t WS_GATE = 50 * MiB;
constexpr size_t WS_LA = 42 * MiB;
constexpr size_t WS_SUMM = 58 * MiB;
constexpr size_t WS_TA = 64 * MiB, WS_TB = 96 * MiB, WS_TK = 400 * MiB, WS_TR = 464 * MiB;
constexpr size_t OUT_TV = 0, OUT_TG = 32 * MiB, OUT_PC = 64 * MiB, OUT_BON = 66 * MiB;
constexpr size_t WS_XB = 64 * MiB;
constexpr size_t WS_PROJ = 128 * MiB;
constexpr size_t WS_Q = WS_PROJ;
constexpr size_t WS_PART = 192 * MiB;
constexpr size_t WS_XQ = 320 * MiB;
constexpr size_t WS_COEF = 352 * MiB;
constexpr size_t WS_CSC = 356 * MiB;
constexpr size_t WS_Y = 304 * MiB;
constexpr size_t WS_UT = 368 * MiB;
constexpr size_t WS_VT = 432 * MiB;
constexpr size_t WS_END = 496 * MiB;
static_assert(WS_WIT + 256 * 1024 <= WS_EXP && WS_PROJ + (size_t)T * NINP * 2 <= WS_Y && WS_WIN + (size_t)NINP * D * 2 <= WS_WOUT, "d_ws map");
constexpr int CW_DEFQ = 2240;
constexpr int CW_PREPBAR = 2176;
constexpr int CW_PREBAR = 2112;
constexpr int CW_LRUBAR = 2048;
constexpr int CW_BAR = 4096;

constexpr int RING_BYTES = 131072;
constexpr int LDSCTL_OFF = 143360, MISC_OFF = LDSCTL_OFF + 320;
constexpr int LDS_BYTES = 147456;

#define GAS __attribute__((address_space(1)))
#define LAS __attribute__((address_space(3)))
typedef unsigned short bf16;
typedef unsigned v4u __attribute__((ext_vector_type(4)));
typedef unsigned v2u __attribute__((ext_vector_type(2)));
typedef float f32x4 __attribute__((ext_vector_type(4)));
typedef float f32x16 __attribute__((ext_vector_type(16)));
typedef short bf16x8 __attribute__((ext_vector_type(8)));
typedef __bf16 bf16x2_t __attribute__((ext_vector_type(2)));
typedef GAS unsigned gu32;
#define RLX_AGENT __ATOMIC_RELAXED, __HIP_MEMORY_SCOPE_AGENT
__device__ __forceinline__ unsigned f2bf(float f) { unsigned u = __builtin_bit_cast(unsigned, f); return (u + 0x7fffu + ((u >> 16) & 1u)) >> 16; }
__device__ __forceinline__ unsigned pk2(float lo, float hi) { return f2bf(lo) | (f2bf(hi) << 16); }
__device__ __forceinline__ float bf_lo(unsigned w) { return __uint_as_float(w << 16); }
__device__ __forceinline__ float bf_hi(unsigned w) { return __uint_as_float(w & 0xffff0000u); }
__device__ __forceinline__ void unpack8(const v4u& w, float (&o)[8]) { o[0] = bf_lo(w.x); o[1] = bf_hi(w.x); o[2] = bf_lo(w.y); o[3] = bf_hi(w.y); o[4] = bf_lo(w.z); o[5] = bf_hi(w.z); o[6] = bf_lo(w.w); o[7] = bf_hi(w.w); }
__device__ __forceinline__ v4u pack8(const float (&o)[8]) { v4u w; w.x = pk2(o[0], o[1]); w.y = pk2(o[2], o[3]); w.z = pk2(o[4], o[5]); w.w = pk2(o[6], o[7]); return w; }
__device__ __forceinline__ float sigmoidf_(float x) { return 1.0f / (1.0f + __expf(-x)); }
__device__ __forceinline__ float softplusf_(float z) { return fmaxf(z, 0.f) + log1pf(__expf(-fabsf(z))); }
__device__ __forceinline__ float gelu_tanh(float x) { const float u = 0.7978845608028654f * (x + 0.044715f * x * x * x); return 0.5f * x * (1.0f + tanhf(u)); }
template <int CTRL> __device__ __forceinline__ float dppf(float x) { return __builtin_bit_cast(float, __builtin_amdgcn_mov_dpp(__builtin_bit_cast(int, x), CTRL, 0xf, 0xf, true)); }
__device__ __forceinline__ float red8(float v) { v += dppf<0xB1>(v); v += dppf<0x4E>(v); v += dppf<0x141>(v); return v; }
__device__ __forceinline__ float red16(float v) { v = red8(v); v += dppf<0x140>(v); return v; }
__device__ __forceinline__ float wave_sum(float v) {
#pragma unroll
    for (int o = 1; o < 64; o <<= 1) v += __shfl_xor(v, o);
    return v;
}
__device__ __forceinline__ float dot2bf(unsigned a, unsigned b, float acc) { return __builtin_amdgcn_fdot2_f32_bf16(__builtin_bit_cast(bf16x2_t, a), __builtin_bit_cast(bf16x2_t, b), acc, false); }
#define MFMA16(a, b, c) __builtin_amdgcn_mfma_f32_16x16x32_bf16((a), (b), (c), 0, 0, 0)
#define MFMA32(a, b, c) __builtin_amdgcn_mfma_f32_32x32x16_bf16((a), (b), (c), 0, 0, 0)

#define XB_TMO      128
#define XB_XCNT(j)  (256  + 64 * (j))
#define XB_XSUB(j)  (1280 + 64 * (j))
#define XB_XGEN(j)  (2304 + 64 * (j))
#define XB_TOP      3328
#define XB_TOPGEN   3392
#define XCD_BAR_WORDS 3456
#define XB_SPIN_CAP (1u << 22)
__device__ __forceinline__ unsigned xb_ld(unsigned* p)              { return __hip_atomic_load(p, __ATOMIC_RELAXED, __HIP_MEMORY_SCOPE_AGENT); }
__device__ __forceinline__ unsigned xb_add(unsigned* p, unsigned v) { return __hip_atomic_fetch_add(p, v, __ATOMIC_RELAXED, __HIP_MEMORY_SCOPE_AGENT); }
__device__ __forceinline__ unsigned xb_xcc_id() { return (unsigned)__builtin_amdgcn_s_getreg((3 << 11) | 20) & 0xFu; }
#define XB_SPIN(cond, bar) do { unsigned _sp = 0; while (cond) { __builtin_amdgcn_s_sleep(1); \
    if ((++_sp & 255u) == 0u) { if (xb_ld(&(bar)[XB_TMO])) break; if (_sp > XB_SPIN_CAP) { atomicAdd(&(bar)[XB_TMO], 1u); break; } } } } while (0)
struct XcdBarrier { unsigned* bar; unsigned x; volatile LAS unsigned* st; };
__device__ __forceinline__ XcdBarrier xcd_barrier_post(unsigned* bar, volatile LAS unsigned* st) {
    XcdBarrier b; b.bar = bar; b.x = xb_xcc_id(); b.st = st;
    if (threadIdx.x == 0) (void)xb_add(&bar[XB_XCNT(b.x)], 1u);
    return b;
}
__device__ __forceinline__ void xcd_barrier_complete(unsigned* bar, unsigned x, unsigned& nloc, unsigned& nx) {
    const unsigned G = gridDim.x * gridDim.y * gridDim.z;
    unsigned sum, cnt, mine, sp = 0u;
    for (;;) {
        sum = 0u; cnt = 0u; mine = 0u;
#pragma unroll
        for (unsigned j = 0; j < 16; ++j) { const unsigned c = xb_ld(&bar[XB_XCNT(j)]); sum += c; cnt += (c > 0u) ? 1u : 0u; mine = (j == x) ? c : mine; }
        if (sum == G) break;
        __builtin_amdgcn_s_sleep(1);
        if ((++sp & 255u) == 0u) { if (xb_ld(&bar[XB_TMO])) break; if (sp > XB_SPIN_CAP) { atomicAdd(&bar[XB_TMO], 1u); break; } }
    }
    nloc = mine > 0u ? mine : 1u; nx = cnt > 0u ? cnt : 1u;
}
__device__ __forceinline__ void xcd_barrier(const XcdBarrier& b) {
    asm volatile("s_waitcnt vmcnt(0)" ::: "memory");
    __syncthreads();
    if (threadIdx.x == 0) {
        unsigned* bar = b.bar;
        __builtin_amdgcn_s_waitcnt(0);
        unsigned nloc = b.st[0], nx = b.st[1];
        if (nloc == 0u) { xcd_barrier_complete(bar, b.x, nloc, nx); b.st[0] = nloc; b.st[1] = nx; }
        const unsigned old = xb_add(&bar[XB_XSUB(b.x)], 1u);
        const unsigned gen = old / nloc;
        if (old + 1u == (gen + 1u) * nloc) {
            __builtin_amdgcn_fence(__ATOMIC_RELEASE, "agent");
            asm volatile("s_waitcnt vmcnt(0)" ::: "memory");
            const unsigned og = xb_add(&bar[XB_TOP], 1u);
            const unsigned tg = og / nx;
            if (og + 1u == (tg + 1u) * nx) xb_add(&bar[XB_TOPGEN], 1u);
            else XB_SPIN(xb_ld(&bar[XB_TOPGEN]) == tg, bar);
            __builtin_amdgcn_fence(__ATOMIC_ACQUIRE, "agent");
            xb_add(&bar[XB_XGEN(b.x)], 1u);
            asm volatile("s_waitcnt vmcnt(0)" ::: "memory");
        } else {
            XB_SPIN(xb_ld(&bar[XB_XGEN(b.x)]) == gen, bar);
            __builtin_amdgcn_fence(__ATOMIC_ACQUIRE, "agent");
            asm volatile("s_waitcnt vmcnt(0)" ::: "memory");
        }
    }
    __syncthreads();
}

struct Frame {
    LAS unsigned char* lds;
    int tid, lane, wave, G, bid;
    const float* in[28];
    float* out;
    unsigned char* ws;
};
#define WSP(type, off) ((type*)(F.ws + (off)))
enum { I_X = 0, I_G1, I_WIN, I_CONVW, I_CONVB, I_WA, I_BA, I_WI, I_BI, I_LAM, I_MU, I_W0, I_W2, I_A0, I_A2, I_G2, I_KK, I_KA, I_RK, I_LNW, I_LNB, I_WOUT, I_G2N, I_WQ, I_KEYS, I_U, I_V, I_GF };

__device__ __forceinline__ void p0_transpose_item(const float* W, int K, int N, bf16* WT, const float* ksc, LAS float* scr, int item, int lane) {
    const int nblk = N / 32, kb = item / nblk, nb = item % nblk, k0 = 64 * kb, n0 = 32 * nb;
    const int lr = lane >> 3, c4 = (lane & 7) * 4;
    f32x4 v[8];
#pragma unroll
    for (int i = 0; i < 8; ++i) v[i] = *(const f32x4*)(W + (size_t)(k0 + 8 * i + lr) * N + n0 + c4);
#pragma unroll
    for (int i = 0; i < 8; ++i) { const int kk = 8 * i + lr; const float sc = ksc ? ksc[k0 + kk] : 1.0f; LAS float* d = scr + kk * 33 + c4; d[0] = v[i][0] * sc; d[1] = v[i][1] * sc; d[2] = v[i][2] * sc; d[3] = v[i][3] * sc; }
    asm volatile("s_waitcnt lgkmcnt(0)" ::: "memory");
    const int c = lane & 7;
#pragma unroll
    for (int j = 0; j < 4; ++j) { const int n = (lane >> 3) + 8 * j; const LAS float* s = scr + (8 * c) * 33 + n;
        v4u o; o.x = pk2(s[0 * 33], s[1 * 33]); o.y = pk2(s[2 * 33], s[3 * 33]); o.z = pk2(s[4 * 33], s[5 * 33]); o.w = pk2(s[6 * 33], s[7 * 33]);
        *(v4u*)(WT + (size_t)(n0 + n) * K + k0 + 8 * c) = o; }
    asm volatile("s_waitcnt lgkmcnt(0)" ::: "memory");
}
__device__ __forceinline__ void p0_small_transpose(const float* src, bf16* dst, int nb, int K, int N, int gt, int NGT) {
    const int tot = nb * K * N;
    for (int i = gt; i < tot; i += NGT) { const int bb = i / (K * N), r = i - bb * K * N, n = r / K, k = r - n * K; dst[i] = (bf16)f2bf(src[(size_t)bb * K * N + (size_t)k * N + n]); }
}
template <int PART> __device__ __forceinline__ void p0_prologue(const Frame& F, int vb, int VG) {
    LAS float* scr = (LAS float*)(F.lds + F.wave * 8448);
    const int gw = vb * NWAVES + F.wave, NGW = VG * NWAVES, gt = gw * 64 + F.lane, NGT = NGW * 64;
    constexpr int I1 = (D / 64) * (NIN / 32), I2 = (D / 64) * (D / 32);
    if (PART == 0) { for (int it = gw; it < I1; it += NGW) p0_transpose_item(F.in[I_WIN], D, NIN, WSP(bf16, WS_WIN), F.in[I_G1], scr, it, F.lane); }
    else { for (int it = gw; it < 2 * I2; it += NGW) { if (it < I2) p0_transpose_item(F.in[I_WOUT], D, D, WSP(bf16, WS_WOUT), nullptr, scr, it, F.lane); else p0_transpose_item(F.in[I_WQ], D, D, WSP(bf16, WS_WQ), F.in[I_G2N], scr, it - I2, F.lane); } }
    if (PART == 0) {
    { v4u* z = (v4u*)(WSP(bf16, WS_WIN) + (size_t)NIN * D); const int nz = (NINP - NIN) * D * 2 / 16; for (int i = gt; i < nz; i += NGT) z[i] = (v4u){0u, 0u, 0u, 0u}; }
    p0_small_transpose(F.in[I_W2], WSP(bf16, WS_W2T), 1, 64, 1024, gt, NGT);
    p0_small_transpose(F.in[I_A2], WSP(bf16, WS_A2T), 1, 64, 1024, gt, NGT);
    p0_small_transpose(F.in[I_G2], WSP(bf16, WS_G2T), 1, 160, 1024, gt, NGT);
    p0_small_transpose(F.in[I_WA], WSP(bf16, WS_WAT), 8, 128, 128, gt, NGT);
    p0_small_transpose(F.in[I_WI], WSP(bf16, WS_WIT), 8, 128, 128, gt, NGT);
    { const float* s = F.in[I_KEYS]; bf16* d = WSP(bf16, WS_KEYS); for (int i = gt; i < 8 * 2 * 128 * 128 / 8; i += NGT) { const f32x4 a = *(const f32x4*)(s + (size_t)i * 8), b = *(const f32x4*)(s + (size_t)i * 8 + 4);
        v4u o; o.x = pk2(a[0], a[1]); o.y = pk2(a[2], a[3]); o.z = pk2(b[0], b[1]); o.w = pk2(b[2], b[3]); *(v4u*)(d + (size_t)i * 8) = o; } }
    }
    if (PART == 1) {
    { const float* su = F.in[I_U]; const float* sv = F.in[I_V]; const float* g2 = F.in[I_G2N]; unsigned char* du = WSP(unsigned char, WS_UT); unsigned char* dv = WSP(unsigned char, WS_VT);
      float* usc = WSP(float, WS_USC); float* vsc = WSP(float, WS_VSC);
      f32x4 gg[2][4];
#pragma unroll
      for (int hh = 0; hh < 2; ++hh)
#pragma unroll
          for (int q = 0; q < 4; ++q) gg[hh][q] = *(const f32x4*)(g2 + hh * 1024 + F.lane * 16 + q * 4);
      for (int row = gw; row < NEXP; row += NGW) {
          f32x4 uu[2][4], vv[2][4]; float am = 0.f, vm = 0.f;
#pragma unroll
          for (int hh = 0; hh < 2; ++hh)
#pragma unroll
              for (int q = 0; q < 4; ++q) { uu[hh][q] = *(const f32x4*)(su + (size_t)row * D + hh * 1024 + F.lane * 16 + q * 4) * gg[hh][q]; vv[hh][q] = *(const f32x4*)(sv + (size_t)row * D + hh * 1024 + F.lane * 16 + q * 4);
#pragma unroll
                  for (int e = 0; e < 4; ++e) { am = fmaxf(am, fabsf(uu[hh][q][e])); vm = fmaxf(vm, fabsf(vv[hh][q][e])); } }
#pragma unroll
          for (int o = 1; o < 64; o <<= 1) { am = fmaxf(am, __shfl_xor(am, o)); vm = fmaxf(vm, __shfl_xor(vm, o)); }
          const float uq = am > 0.f ? 127.0f / am : 0.f, vq = vm > 0.f ? 127.0f / vm : 0.f;
          if (F.lane == 0) { usc[row] = am * (1.0f / 127.0f); vsc[row] = vm * (1.0f / 127.0f); }
#pragma unroll
          for (int hh = 0; hh < 2; ++hh) { v4u ou, ov;
#pragma unroll
              for (int q = 0; q < 4; ++q) { unsigned w = 0u, wv = 0u;
#pragma unroll
                  for (int e = 0; e < 4; ++e) { const int qi = (int)rintf(uu[hh][q][e] * uq); w |= ((unsigned)qi & 0xFFu) << (8 * e); const int qv = (int)rintf(vv[hh][q][e] * vq); wv |= ((unsigned)qv & 0xFFu) << (8 * e); }
                  ou[q] = w; ov[q] = wv; }
              *(v4u*)(du + (size_t)row * D + hh * 1024 + F.lane * 16) = ou; *(v4u*)(dv + (size_t)row * D + hh * 1024 + F.lane * 16) = ov; }
      } }
    }
    if (PART == 0) {
    { const float* x = F.in[I_X]; bf16* xb = WSP(bf16, WS_XB); float* rstd = WSP(float, WS_RSTD1);
      for (int m = gw; m < T; m += NGW) { const f32x4* xr = (const f32x4*)(x + (size_t)m * D) + F.lane; f32x4 v[8]; float s = 0.f;
#pragma unroll
          for (int j = 0; j < 8; ++j) { v[j] = xr[64 * j]; s += (v[j][0] * v[j][0] + v[j][1] * v[j][1]) + (v[j][2] * v[j][2] + v[j][3] * v[j][3]); }
          s = wave_sum(s);
          if (F.lane == 0) rstd[m] = 1.0f / sqrtf(s * (1.0f / D) + NORM_EPS);
          v2u* o = (v2u*)(xb + (size_t)m * D) + F.lane;
#pragma unroll
          for (int j = 0; j < 8; ++j) { v2u w; w.x = pk2(v[j][0], v[j][1]); w.y = pk2(v[j][2], v[j][3]); o[64 * j] = w; } } }
    }
}

typedef float f32x2c __attribute__((ext_vector_type(2)));
__device__ __forceinline__ unsigned cvtpk(float lo, float hi) { const f32x2c v = {lo, hi}; const bf16x2_t b = __builtin_convertvector(v, bf16x2_t); return __builtin_bit_cast(unsigned, b); }
__device__ __forceinline__ float rcpf_(float x) { return __builtin_amdgcn_rcpf(x); }
__device__ __forceinline__ float sigmoid_fast(float x) { return rcpf_(1.0f + __expf(-x)); }
__device__ __forceinline__ float tanh_fast(float x) { return 1.0f - 2.0f * rcpf_(1.0f + __expf(2.0f * x)); }
__device__ __forceinline__ float softplus_fast(float z) { return fmaxf(z, 0.f) + __logf(1.0f + __expf(-fabsf(z))); }
__device__ __forceinline__ float gelu_fast(float x) { const float u = 0.7978845608028654f * (x + 0.044715f * x * x * x); return x * rcpf_(1.0f + __expf(-2.0f * u)); }
__device__ __forceinline__ void rwkv_prep_unit(const Frame& F, int chunk, int h, int lane, const LAS bf16* WL2, const LAS bf16* AL2, const LAS bf16* GL2, const LAS float* CW, LAS bf16* ST) {
    asm volatile("" : "+v"(lane));
    const int fr = lane & 15, fq = lane >> 4;
    const bf16* PROJ = WSP(bf16, WS_PROJ); const bf16* LA = WSP(bf16, WS_LA);
    bf16* TA = WSP(bf16, WS_TA); bf16* TB = WSP(bf16, WS_TB); bf16* TK = WSP(bf16, WS_TK); bf16* TR = WSP(bf16, WS_TR);
    bf16* TV = (bf16*)F.out + OUT_TV / 2; bf16* TG = (bf16*)F.out + OUT_TG / 2; float* PCG = F.out + OUT_PC / 4; float* BONG = F.out + OUT_BON / 4;
#define PU4(w_) ((f32x4){bf_lo((w_).x), bf_hi((w_).x), bf_lo((w_).y), bf_hi((w_).y)})
    size_t tokm[2]; int pom[2]; unsigned pmm[2];
#pragma unroll
    for (int mt = 0; mt < 2; ++mt) { tokm[mt] = (size_t)chunk * 32 + mt * 16 + fr; const bool hasp = ((chunk & 63) * 32 + mt * 16 + fr) > 0; pom[mt] = hasp ? NINP : 0; pmm[mt] = hasp ? 0xffffffffu : 0u; }
    float inv[2], bn[2];
#pragma unroll
    for (int mt = 0; mt < 2; ++mt) { float s2 = 0.f;
#pragma unroll
        for (int nt = 0; nt < 4; ++nt) { const int j4 = nt * 16 + fq * 4; const bf16* pr = PROJ + tokm[mt] * NINP + PC_K + h * 64 + j4;
            const v2u kc = *(const v2u*)pr; v2u kp = *(const v2u*)(pr - pom[mt]); kp.x &= pmm[mt]; kp.y &= pmm[mt];
            const f32x4 c_kk = *(const LAS f32x4*)(CW + 128 + j4), m_k = *(const LAS f32x4*)(CW + 384 + j4);
            const f32x4 kcf = PU4(kc); const f32x4 ku = (kcf + (PU4(kp) - kcf) * m_k) * c_kk; s2 += (ku[0] * ku[0] + ku[1] * ku[1]) + (ku[2] * ku[2] + ku[3] * ku[3]); }
        { auto x = __builtin_amdgcn_permlane16_swap(__float_as_uint(s2), __float_as_uint(s2), false, false); s2 = __uint_as_float(x[0]) + __uint_as_float(x[1]); }
        { auto x = __builtin_amdgcn_permlane32_swap(__float_as_uint(s2), __float_as_uint(s2), false, false); s2 = __uint_as_float(x[0]) + __uint_as_float(x[1]); }
        inv[mt] = __builtin_amdgcn_rsqf(fmaxf(s2, 1e-24f)); bn[mt] = 0.f; }
    v2u cur_[3], prv_[3], ncur_[3], nprv_[3];
#define PREP_LOAD_RKV(C_, P_, st_) do { const int mt_ = (st_) >> 2, nt_ = (st_) & 3; const bf16* pr_ = PROJ + tokm[mt_] * NINP + PC_R + h * 64 + nt_ * 16 + fq * 4; \
        _Pragma("unroll") for (int q_ = 0; q_ < 3; ++q_) { C_[q_] = *(const v2u*)(pr_ + q_ * 1024); P_[q_] = *(const v2u*)(pr_ + q_ * 1024 - pom[mt_]); } } while (0)
    PREP_LOAD_RKV(cur_, prv_, 0);
    f32x4 tot0[4];
#pragma unroll
    for (int n = 0; n < 4; ++n) tot0[n] = (f32x4){0.f, 0.f, 0.f, 0.f};
    bf16x8 la[9];
#pragma unroll
    for (int st = 0; st < 8; ++st) { const int mt = st >> 2, nt = st & 3; const int j4 = nt * 16 + fq * 4; const size_t col = (size_t)h * 64 + j4;
        if (nt == 0) {
#pragma unroll
            for (int ks = 0; ks < 9; ++ks) la[ks] = *(const bf16x8*)(LA + tokm[mt] * 288 + ks * 32 + 8 * fq); }
        if (st < 7) PREP_LOAD_RKV(ncur_, nprv_, st + 1);
        f32x4 cw = (f32x4){0.f, 0.f, 0.f, 0.f}, ca = cw, cg = cw;
#pragma unroll
        for (int ks = 0; ks < 2; ++ks) { cw = MFMA16(*(const LAS bf16x8*)(WL2 + (nt * 16 + fr) * 72 + ks * 32 + 8 * fq), la[ks], cw); ca = MFMA16(*(const LAS bf16x8*)(AL2 + (nt * 16 + fr) * 72 + ks * 32 + 8 * fq), la[2 + ks], ca); }
#pragma unroll
        for (int ks = 0; ks < 5; ++ks) cg = MFMA16(*(const LAS bf16x8*)(GL2 + (nt * 16 + fr) * 168 + ks * 32 + 8 * fq), la[4 + ks], cg);
        const f32x4 c_w0 = *(const LAS f32x4*)(CW + j4), c_a0 = *(const LAS f32x4*)(CW + 64 + j4), c_kk = *(const LAS f32x4*)(CW + 128 + j4), c_ka = *(const LAS f32x4*)(CW + 192 + j4), c_rk = *(const LAS f32x4*)(CW + 256 + j4);
        const f32x4 m_r = *(const LAS f32x4*)(CW + 320 + j4), m_k = *(const LAS f32x4*)(CW + 384 + j4), m_v = *(const LAS f32x4*)(CW + 448 + j4);
        v2u rp = prv_[0], kp = prv_[1], vp = prv_[2]; const unsigned pm = pmm[mt];
        rp.x &= pm; rp.y &= pm; kp.x &= pm; kp.y &= pm; vp.x &= pm; vp.y &= pm;
        const f32x4 rcf = PU4(cur_[0]), kcf = PU4(cur_[1]), vcf = PU4(cur_[2]);
        const f32x4 rr = rcf + (PU4(rp) - rcf) * m_r, kv = kcf + (PU4(kp) - kcf) * m_k, vv = vcf + (PU4(vp) - vcf) * m_v;
        f32x4 nau, bbu, km, cum;
#pragma unroll
        for (int r = 0; r < 4; ++r) { const float av = sigmoid_fast(c_a0[r] + ca[r]), ku = kv[r] * c_kk[r]; km[r] = kv[r] * (1.0f + (av - 1.0f) * c_ka[r]);
            cum[r] = -0.6065306597126334f * sigmoid_fast(c_w0[r] + cw[r]);
            nau[r] = -ku; bbu[r] = ku * av; bn[mt] += rr[r] * km[r] * c_rk[r]; }
        f32x4 at4, rt4, bt4, kt4, ep4;
#pragma unroll
        for (int r = 0; r < 4; ++r) { float v = cum[r];
            v += __builtin_bit_cast(float, __builtin_amdgcn_update_dpp(0, __builtin_bit_cast(int, v), 0x111, 0xf, 0xf, true));
            v += __builtin_bit_cast(float, __builtin_amdgcn_update_dpp(0, __builtin_bit_cast(int, v), 0x112, 0xf, 0xf, true));
            v += __builtin_bit_cast(float, __builtin_amdgcn_update_dpp(0, __builtin_bit_cast(int, v), 0x114, 0xf, 0xf, true));
            v += __builtin_bit_cast(float, __builtin_amdgcn_update_dpp(0, __builtin_bit_cast(int, v), 0x118, 0xf, 0xf, true));
            if (mt == 0) tot0[nt][r] = __shfl(v, (lane & 48) | 15); else v += tot0[nt][r];
            const float ep = __expf(v), em = rcpf_(ep);
            float eprev = __builtin_bit_cast(float, __builtin_amdgcn_update_dpp(0, __builtin_bit_cast(int, ep), 0x111, 0xf, 0xf, true));
            if (fr == 0) eprev = mt ? __expf(tot0[nt][r]) : 1.0f;
            at4[r] = nau[r] * inv[mt] * eprev; rt4[r] = rr[r] * ep; bt4[r] = bbu[r] * inv[mt] * em; kt4[r] = km[r] * em; ep4[r] = ep; }
        { LAS bf16* sp = ST + fr * 64 + j4; v2u w;
          w.x = cvtpk(at4[0], at4[1]); w.y = cvtpk(at4[2], at4[3]); *(LAS v2u*)(sp) = w;
          w.x = cvtpk(rt4[0], rt4[1]); w.y = cvtpk(rt4[2], rt4[3]); *(LAS v2u*)(sp + 1024) = w;
          w.x = cvtpk(bt4[0], bt4[1]); w.y = cvtpk(bt4[2], bt4[3]); *(LAS v2u*)(sp + 2048) = w;
          w.x = cvtpk(kt4[0], kt4[1]); w.y = cvtpk(kt4[2], kt4[3]); *(LAS v2u*)(sp + 3072) = w;
          w.x = cvtpk(vv[0], vv[1]); w.y = cvtpk(vv[2], vv[3]); *(LAS v2u*)(sp + 4096) = w;
          w.x = cvtpk(cg[0], cg[1]); w.y = cvtpk(cg[2], cg[3]); *(LAS v2u*)(sp + 5120) = w; }
        if (nt == 3) {
            bf16* const dstp[6] = {TA, TR, TB, TK, TV, TG};
#pragma unroll
            for (int a6 = 0; a6 < 6; ++a6)
#pragma unroll
                for (int hrow = 0; hrow < 2; ++hrow) { const int row = hrow * 8 + (lane >> 3), c8 = (lane & 7) * 8;
                    const v4u pv = *(const LAS v4u*)(ST + a6 * 1024 + row * 64 + c8);
                    *(v4u*)(dstp[a6] + ((size_t)chunk * 32 + mt * 16 + row) * 1024 + (size_t)h * 64 + c8) = pv; } }
        if (mt == 1 && fr == 15) *(f32x4*)(PCG + (size_t)chunk * 1024 + col) = ep4;
#pragma unroll
        for (int q = 0; q < 3; ++q) { cur_[q] = ncur_[q]; prv_[q] = nprv_[q]; }
    }
#undef PREP_LOAD_RKV
#undef PU4
#pragma unroll
    for (int mt = 0; mt < 2; ++mt) { float b2 = bn[mt];
        { auto x = __builtin_amdgcn_permlane16_swap(__float_as_uint(b2), __float_as_uint(b2), false, false); b2 = __uint_as_float(x[0]) + __uint_as_float(x[1]); }
        { auto x = __builtin_amdgcn_permlane32_swap(__float_as_uint(b2), __float_as_uint(b2), false, false); b2 = __uint_as_float(x[0]) + __uint_as_float(x[1]); }
        if (fq == 0) BONG[tokm[mt] * 16 + h] = b2; }
}
__device__ __forceinline__ void rwkv_prep_phase(const Frame& F) {
    LAS bf16* WL2 = (LAS bf16*)(F.lds + 0); LAS bf16* AL2 = (LAS bf16*)(F.lds + 9216); LAS bf16* GL2 = (LAS bf16*)(F.lds + 18432); LAS float* CW = (LAS float*)(F.lds + 39936);
    int hcur = -1;
    for (int u = F.bid; u < 1024; u += F.G) { const int h = u & 15, cg = u >> 4;
        if (h != hcur) { hcur = h; __syncthreads();
            int tid_ = F.tid; asm volatile("" : "+v"(tid_));
            const bf16* w2t = WSP(bf16, WS_W2T) + (size_t)h * 64 * 64; const bf16* a2t = WSP(bf16, WS_A2T) + (size_t)h * 64 * 64; const bf16* g2t = WSP(bf16, WS_G2T) + (size_t)h * 64 * 160;
            { const int r = tid_ >> 3, c = (tid_ & 7) * 8; *(LAS v4u*)(WL2 + r * 72 + c) = *(const v4u*)(w2t + r * 64 + c); *(LAS v4u*)(AL2 + r * 72 + c) = *(const v4u*)(a2t + r * 64 + c); }
            for (int i = tid_; i < 64 * 20; i += NTHR) { const int r = i / 20, c = (i - r * 20) * 8; *(LAS v4u*)(GL2 + r * 168 + c) = *(const v4u*)(g2t + r * 160 + c); }
            { const int q = tid_ >> 6, jj = tid_ & 63; const float* src = q == 0 ? F.in[I_W0] : (q == 1 ? F.in[I_A0] : (q == 2 ? F.in[I_KK] : (q == 3 ? F.in[I_KA] : (q == 4 ? F.in[I_RK] : F.in[I_MU] + (q - 5) * 1024)))); CW[q * 64 + jj] = src[h * 64 + jj]; }
            __syncthreads(); }
        rwkv_prep_unit(F, cg * 8 + F.wave, h, F.lane, WL2, AL2, GL2, CW, (LAS bf16*)(F.lds + 43008 + F.wave * 12288)); }
    __syncthreads();
}
typedef short v4i16_t __attribute__((ext_vector_type(4)));
__device__ __forceinline__ bf16x8 frag_tr16(const LAS bf16* p, int ld) {
    const v4i16_t a = __builtin_amdgcn_ds_read_tr16_b64_v4i16((LAS v4i16_t*)p), b = __builtin_amdgcn_ds_read_tr16_b64_v4i16((LAS v4i16_t*)(p + 4 * ld));
    return (bf16x8){a[0], a[1], a[2], a[3], b[0], b[1], b[2], b[3]};
}
__device__ __forceinline__ void rwkv_item(const Frame& F, int item) {
    const int b = item >> 4, h = item & 15, wave = F.wave; int tid = F.tid; asm volatile("" : "+v"(tid)); const int lane = tid & 63;
    LAS unsigned char* L = F.lds;
    constexpr int LD64 = 72, LD32 = 40, E0 = 69632;
    LAS bf16* AT = (LAS bf16*)(L + 0);  LAS bf16* BT_ = (LAS bf16*)(L + 4608); LAS bf16* KT_ = (LAS bf16*)(L + 9216); LAS bf16* RT = (LAS bf16*)(L + 13824);
    LAS bf16* VS = (LAS bf16*)(L + 18432);
    LAS bf16* S0B = (LAS bf16*)(L + 33792);
    LAS bf16* GGB = (LAS bf16*)(L + 52224);
    LAS float* YB = (LAS float*)(L + 56832);
    LAS float* BON = (LAS float*)(L + 65536);
    LAS float* PC = (LAS float*)(L + 65664);
    LAS bf16* AAK = (LAS bf16*)(L + E0); LAS bf16* ARB = (LAS bf16*)(L + E0 + 2560); LAS bf16* ARK = (LAS bf16*)(L + E0 + 5120);
    LAS bf16* XB_ = (LAS bf16*)(L + E0 + 7680);
    LAS bf16* XTB = (LAS bf16*)(L + E0 + 12800);
    LAS bf16* PMB = (LAS bf16*)(L + E0 + 17920);
    LAS bf16* RHS = (LAS bf16*)(L + E0 + 23040);
    LAS bf16* SAB = (LAS bf16*)(L + E0 + 28160);
    static_assert(E0 + 33280 <= LDSCTL_OFF, "rwkv LDS map");
    bf16* Y = WSP(bf16, WS_Y);
#define FRAG(base, row0, ld, ks) (*(const LAS bf16x8*)((base) + ((row0) + fr) * (ld) + (ks) * 32 + 8 * fq))
#define FRAGT(base, col0, ld) frag_tr16((base) + (8 * fq + (fr >> 2)) * (ld) + (col0) + 4 * (fr & 3), (ld))
    const int tt = tid >> 4, j0 = (tid & 15) * 4, hc = h * 64 + j0;
    const f32x4 plw = *(const f32x4*)(F.in[I_LNW] + hc), plb = *(const f32x4*)(F.in[I_LNB] + hc);
    const int lr = (tid & 255) >> 3, lc8 = tid & 7; const bool hi2 = tid >= 256;
    const bf16* srcA[3] = { (hi2 ? WSP(bf16, WS_TR) : WSP(bf16, WS_TA)), (hi2 ? WSP(bf16, WS_TK) : WSP(bf16, WS_TB)), (hi2 ? (const bf16*)F.out + OUT_TG / 2 : (const bf16*)F.out + OUT_TV / 2) };
    const size_t poff = ((size_t)b * SEQ + lr) * 1024 + h * 64 + lc8 * 8;
    const float* PCG = F.out + OUT_PC / 4 + (size_t)(b * 64) * 1024 + h * 64; const float* BONG = F.out + OUT_BON / 4 + (size_t)b * SEQ * 16 + h;
    v4u pl_[3]; float ppc = 0.f, pbn = 0.f;
#define RWKV_PREFETCH(tl_) do { _Pragma("unroll") for (int q_ = 0; q_ < 3; ++q_) pl_[q_] = *(const v4u*)(srcA[q_] + poff + (size_t)(tl_) * 32 * 1024); \
        ppc = PCG[(size_t)(tl_) * 1024 + (tid & 63)]; pbn = BONG[((size_t)(tl_) * 32 + (tid & 31)) * 16]; } while (0)
    const int ib = wave >> 1, tb = wave & 1, i0 = ib * 16, t0m = tb * 16;
    f32x4 sacc[2], pmacc, yacc;
    sacc[0] = (f32x4){0.f, 0.f, 0.f, 0.f}; sacc[1] = sacc[0]; pmacc = sacc[0]; yacc = sacc[0];
    for (int u = tid; u < 2 * 64 * LD64 / 2; u += NTHR) ((LAS unsigned*)S0B)[u] = 0u;
    RWKV_PREFETCH(0);
    __syncthreads();
    for (int tl = 0; tl <= SEQ / 32; ++tl) {
        const int cur = tl & 1;
        int lane_c = lane; asm volatile("" : "+v"(lane_c)); const int fr = lane_c & 15, fq = lane_c >> 4;
        if (tl > 0) { const size_t tokb = (size_t)b * SEQ + (tl - 1) * 32;
          const f32x4 y4 = *(const LAS f32x4*)(YB + tt * 68 + j0); const v2u gw_ = *(const LAS v2u*)(GGB + tt * LD64 + j0);
          const f32x4 g4 = (f32x4){bf_lo(gw_.x), bf_hi(gw_.x), bf_lo(gw_.y), bf_hi(gw_.y)};
          const v2u vw_ = *(const LAS v2u*)(VS + tt * LD64 + j0); const f32x4 v4 = (f32x4){bf_lo(vw_.x), bf_hi(vw_.x), bf_lo(vw_.y), bf_hi(vw_.y)};
          float sm = (y4[0] + y4[1]) + (y4[2] + y4[3]); sm = red16(sm); const float mean = sm * (1.0f / 64.0f);
          const f32x4 d4 = y4 - mean; float sv = (d4[0] * d4[0] + d4[1] * d4[1]) + (d4[2] * d4[2] + d4[3] * d4[3]); sv = red16(sv);
          const float rstd = __builtin_amdgcn_rsqf(sv * (1.0f / 64.0f) + GN_EPS), bon = BON[tt];
          f32x4 o;
#pragma unroll
          for (int e = 0; e < 4; ++e) o[e] = (d4[e] * rstd * plw[e] + plb[e] + bon * v4[e]) * g4[e];
          v2u w; w.x = cvtpk(o[0], o[1]); w.y = cvtpk(o[2], o[3]);
          *(v2u*)(Y + (tokb + tt) * D + 1024 + hc) = w; }
        if (tl == SEQ / 32) break;
        const LAS bf16* S0c = S0B + cur * 64 * LD64; LAS bf16* S0n = S0B + (cur ^ 1) * 64 * LD64;
        __syncthreads();
        { const v4u p0 = pl_[0], p1 = pl_[1], p2 = pl_[2];
          *(LAS v4u*)((hi2 ? RT : AT) + lr * LD64 + lc8 * 8) = p0;
          *(LAS v4u*)((hi2 ? KT_ : BT_) + lr * LD64 + lc8 * 8) = p1;
          *(LAS v4u*)((hi2 ? GGB : VS) + lr * LD64 + lc8 * 8) = p2;
          if (tid < 64) PC[tid] = ppc;
          if (tid >= 64 && tid < 96) BON[tid - 64] = pbn; }
        { const int tn_ = tl + 1 < SEQ / 32 ? tl + 1 : SEQ / 32 - 1; RWKV_PREFETCH(tn_); }
        __syncthreads();
        { const int q = wave & 3, tq = (q >> 1) * 16, sq = (q & 1) * 16; const bool zt = sq > tq;
#pragma unroll
            for (int mi = 0; mi < 2; ++mi) { const int mtx = (wave < 4) ? mi : 2; if (wave >= 4 && mi == 1) break;
                const LAS bf16* Xs = (mtx == 1) ? BT_ : KT_; const LAS bf16* Yt = (mtx == 0) ? AT : RT; LAS bf16* O = (mtx == 0) ? AAK : (mtx == 1 ? ARB : ARK);
                f32x4 a4 = (f32x4){0.f, 0.f, 0.f, 0.f};
                if (!zt) {
#pragma unroll
                    for (int ks = 0; ks < 2; ++ks) a4 = MFMA16(FRAG(Xs, sq, LD64, ks), FRAG(Yt, tq, LD64, ks), a4); }
                const int t = tq + fr, s = sq + fq * 4;
#pragma unroll
                for (int r = 0; r < 4; ++r) { const bool keep = (mtx == 0) ? (s + r < t) : (s + r <= t); a4[r] = keep ? a4[r] : 0.f; }
                v2u w; w.x = cvtpk(a4[0], a4[1]); w.y = cvtpk(a4[2], a4[3]); *(LAS v2u*)(O + t * LD32 + s) = w; } }
        if (wave >= 4) { const int q = wave - 4, tq = (q >> 1) * 16, sq = (q & 1) * 16;
            f32x4 a4 = (f32x4){0.f, 0.f, 0.f, 0.f};
            if (sq <= tq) {
#pragma unroll
            for (int ks = 0; ks < 2; ++ks) a4 = MFMA16(FRAG(BT_, sq, LD64, ks), FRAG(AT, tq, LD64, ks), a4); }
            const int t = tq + fr, s = sq + fq * 4;
#pragma unroll
            for (int r = 0; r < 4; ++r) { a4[r] = (s + r < t) ? a4[r] : 0.f; XTB[(s + r) * LD32 + t] = (bf16)(cvtpk(a4[r], 0.f) & 0xffffu); }
            v2u w; w.x = cvtpk(a4[0], a4[1]); w.y = cvtpk(a4[2], a4[3]); *(LAS v2u*)(XB_ + t * LD32 + s) = w;
#pragma unroll
            for (int r = 0; r < 4; ++r) pmacc[r] = a4[r] + ((s + r == t) ? 1.0f : 0.f);
            w.x = cvtpk(pmacc[0], pmacc[1]); w.y = cvtpk(pmacc[2], pmacc[3]); *(LAS v2u*)(PMB + t * LD32 + s) = w; }
        __syncthreads();
#pragma unroll
        for (int ns = 0; ns < 5; ++ns) { const int cb = ns & 1, nb = cb ^ 1;
            const LAS bf16* Xc = XB_ + cb * 32 * LD32; const LAS bf16* XTc = XTB + cb * 32 * LD32; const LAS bf16* Pc = PMB + cb * 32 * LD32;
            LAS bf16* Xn = XB_ + nb * 32 * LD32; LAS bf16* XTn = XTB + nb * 32 * LD32; LAS bf16* Pn = PMB + nb * 32 * LD32;
            if (wave < 4) { if (ns < 4) { const int tq = (wave >> 1) * 16, sq = (wave & 1) * 16;
                    f32x4 a4 = (f32x4){0.f, 0.f, 0.f, 0.f}; a4 = MFMA16(FRAG(XTc, sq, LD32, 0), FRAG(Xc, tq, LD32, 0), a4);
                    const int t = tq + fr, s = sq + fq * 4;
#pragma unroll
                    for (int r = 0; r < 4; ++r) XTn[(s + r) * LD32 + t] = (bf16)(cvtpk(a4[r], 0.f) & 0xffffu);
                    v2u w; w.x = cvtpk(a4[0], a4[1]); w.y = cvtpk(a4[2], a4[3]); *(LAS v2u*)(Xn + t * LD32 + s) = w; } }
            else { const int q = wave - 4, tq = (q >> 1) * 16, sq = (q & 1) * 16;
                if (ns > 0) pmacc = MFMA16(FRAG(XTc, sq, LD32, 0), FRAG(Pc, tq, LD32, 0), pmacc);
                const int t = tq + fr, s = sq + fq * 4;
                v2u w; w.x = cvtpk(pmacc[0], pmacc[1]); w.y = cvtpk(pmacc[2], pmacc[3]); *(LAS v2u*)(Pn + t * LD32 + s) = w; }
            if (ns == 1) {
                f32x4 a4 = (f32x4){0.f, 0.f, 0.f, 0.f};
#pragma unroll
                for (int ks = 0; ks < 2; ++ks) a4 = MFMA16(FRAG(AT, t0m, LD64, ks), FRAG(S0c, i0, LD64, ks), a4);
                a4 = MFMA16(FRAG(AAK, t0m, LD32, 0), FRAGT(VS, i0, LD64), a4);
                v2u w; w.x = cvtpk(a4[0], a4[1]); w.y = cvtpk(a4[2], a4[3]); *(LAS v2u*)(RHS + (i0 + fr) * LD32 + t0m + fq * 4) = w; }
            if (ns == 2) {
                yacc = (f32x4){0.f, 0.f, 0.f, 0.f};
#pragma unroll
                for (int ks = 0; ks < 2; ++ks) yacc = MFMA16(FRAG(S0c, i0, LD64, ks), FRAG(RT, t0m, LD64, ks), yacc);
                yacc = MFMA16(FRAGT(VS, i0, LD64), FRAG(ARK, t0m, LD32, 0), yacc); }
            if (ns == 3) {
#pragma unroll
                for (int u = 0; u < 2; ++u) { const int tile = wave * 2 + u, si0 = (tile >> 2) * 16, sj0 = (tile & 3) * 16; sacc[u] = MFMA16(FRAGT(KT_, sj0, LD64), FRAGT(VS, si0, LD64), sacc[u]); } }
            __syncthreads();
        }
        const LAS bf16* MINV = PMB + 1 * 32 * LD32;
        { f32x4 a4 = (f32x4){0.f, 0.f, 0.f, 0.f}; a4 = MFMA16(FRAG(MINV, t0m, LD32, 0), FRAG(RHS, i0, LD32, 0), a4);
          v2u w; w.x = cvtpk(a4[0], a4[1]); w.y = cvtpk(a4[2], a4[3]); *(LAS v2u*)(SAB + (i0 + fr) * LD32 + t0m + fq * 4) = w; }
        __syncthreads();
        { yacc = MFMA16(FRAG(SAB, i0, LD32, 0), FRAG(ARB, t0m, LD32, 0), yacc);
          *(LAS f32x4*)(YB + (t0m + fr) * 68 + i0 + fq * 4) = yacc;
#pragma unroll
          for (int u = 0; u < 2; ++u) { const int tile = wave * 2 + u, si0 = (tile >> 2) * 16, sj0 = (tile & 3) * 16;
              sacc[u] = MFMA16(FRAGT(BT_, sj0, LD64), FRAG(SAB, si0, LD32, 0), sacc[u]);
              const f32x4 pc = *(const LAS f32x4*)(PC + sj0 + fq * 4); sacc[u] = sacc[u] * pc;
              v2u w; w.x = cvtpk(sacc[u][0], sacc[u][1]); w.y = cvtpk(sacc[u][2], sacc[u][3]); *(LAS v2u*)(S0n + (si0 + fr) * LD64 + sj0 + fq * 4) = w; } }
        __syncthreads();
    }
    __syncthreads();
#undef FRAG
#undef FRAGT
#undef RWKV_PREFETCH
}
__device__ __forceinline__ void lora_prepass(const Frame& F) {
    const bf16* PROJ = WSP(bf16, WS_PROJ); bf16* LA = WSP(bf16, WS_LA); const float* mu = F.in[I_MU] + (PC_WD - RWKV_C0);
    const int gt = (F.bid * NWAVES + F.wave) * 64 + F.lane, NGT = F.G * NTHR;
    for (int i = gt; i < T * 36; i += NGT) { const int tok = i / 36, cc = i - tok * 36, m = cc * 8;
        const bf16* pr = PROJ + (size_t)tok * NINP + PC_WD + m;
        const v4u curv = *(const v4u*)pr; v4u prv = (v4u){0u, 0u, 0u, 0u}; if ((tok & (SEQ - 1)) != 0) prv = *(const v4u*)(pr - NINP);
        const f32x4 m0 = *(const f32x4*)(mu + m), m1 = *(const f32x4*)(mu + m + 4);
        float c[8], p[8], o[8]; unpack8(curv, c); unpack8(prv, p);
#pragma unroll
        for (int e = 0; e < 8; ++e) { const float ps = c[e] + (p[e] - c[e]) * (e < 4 ? m0[e] : m1[e - 4]); o[e] = (m < 64) ? tanh_fast(ps) : ((m < 128) ? ps : sigmoid_fast(ps)); }
        v4u w; w.x = cvtpk(o[0], o[1]); w.y = cvtpk(o[2], o[3]); w.z = cvtpk(o[4], o[5]); w.w = cvtpk(o[6], o[7]);
        *(v4u*)(LA + (size_t)tok * 288 + m) = w; }
}
__device__ __forceinline__ void lru_seq(const Frame& F, int bh) {
    const int b = bh >> 3, h = bh & 7, wave = F.wave; int tid = F.tid; asm volatile("" : "+v"(tid)); const int lane = tid & 63;
    LAS unsigned char* L = F.lds;
    LAS bf16* XA = (LAS bf16*)(L + 0);
    LAS float* XC = (LAS float*)(L + 17408);
    LAS float* RI = (LAS float*)(L + 50176);
    LAS float* SEG = (LAS float*)(L + 115712);
    LAS float* CARRY = (LAS float*)(L + 119808);
    LAS float* CW = (LAS float*)(L + 120320);
    const bf16* PROJ = WSP(bf16, WS_PROJ); bf16* Y = WSP(bf16, WS_Y);
    const int fr0 = lane & 15, fq0 = lane >> 4;
    for (int i = tid; i < 640; i += NTHR) { const int w = i >> 7, cch = i & 127; CW[i] = (w < 4) ? F.in[I_CONVW][w * 1024 + h * 128 + cch] : F.in[I_CONVB][h * 128 + cch]; }
    if (tid < 128) CARRY[tid] = 0.f;
    const int gsel = wave & 1, nt0 = (wave >> 1) * 2;
    bf16x8 wf[2][4];
    { const bf16* WTp = (gsel ? WSP(bf16, WS_WIT) : WSP(bf16, WS_WAT)) + (size_t)h * 128 * 128;
#pragma unroll
      for (int n = 0; n < 2; ++n)
#pragma unroll
          for (int ks = 0; ks < 4; ++ks) wf[n][ks] = *(const bf16x8*)(WTp + ((nt0 + n) * 16 + fr0) * 128 + ks * 32 + 8 * fq0); }
    const int c = tid & 127, sg = tid >> 7, chg = h * 128 + c;
    const float ba_c = F.in[I_BA][chg], bi_c = F.in[I_BI][chg], sp8 = 8.0f * softplus_fast(-F.in[I_LAM][chg]);
    v4u pf[2][4];
#define LRU_PREFETCH(k_) do { _Pragma("unroll") for (int u_ = 0; u_ < 2; ++u_) { const int chn_ = tid + NTHR * u_, t_ = chn_ >> 4, c8_ = (chn_ & 15) * 8; \
        _Pragma("unroll") for (int w_ = 0; w_ < 4; ++w_) { const int ts_ = (k_) * 64 + t_ - 3 + w_; const int tc_ = ts_ >= 0 ? ts_ : 0;   \
            const v4u x_ = *(const v4u*)(PROJ + ((size_t)b * SEQ + tc_) * NINP + h * 128 + c8_); const unsigned m_ = ts_ >= 0 ? 0xffffffffu : 0u; \
            pf[u_][w_] = (v4u){x_.x & m_, x_.y & m_, x_.z & m_, x_.w & m_}; } } } while (0)
    LRU_PREFETCH(0);
    __syncthreads();
    for (int k = 0; k < SEQ / 64; ++k) {
        const size_t tokbase = (size_t)b * SEQ + k * 64;
        int lane_c = lane; asm volatile("" : "+v"(lane_c)); const int fr = lane_c & 15, fq = lane_c >> 4;
#pragma unroll
        for (int u = 0; u < 2; ++u) { const int chn = tid + NTHR * u, t = chn >> 4, c8 = (chn & 15) * 8;
            float acc[8]; { const f32x4 b0 = *(const LAS f32x4*)(CW + 512 + c8), b1 = *(const LAS f32x4*)(CW + 512 + c8 + 4);
#pragma unroll
                for (int e = 0; e < 4; ++e) { acc[e] = b0[e]; acc[e + 4] = b1[e]; } }
#pragma unroll
            for (int w = 0; w < 4; ++w) { float xf[8]; unpack8(pf[u][w], xf);
                const f32x4 w0 = *(const LAS f32x4*)(CW + w * 128 + c8), w1 = *(const LAS f32x4*)(CW + w * 128 + c8 + 4);
#pragma unroll
                for (int e = 0; e < 4; ++e) { acc[e] += w0[e] * xf[e]; acc[e + 4] += w1[e] * xf[e + 4]; } }
            v4u pk; pk.x = cvtpk(acc[0], acc[1]); pk.y = cvtpk(acc[2], acc[3]); pk.z = cvtpk(acc[4], acc[5]); pk.w = cvtpk(acc[6], acc[7]);
            *(LAS v4u*)(XA + t * 136 + c8) = pk;
            LAS float* d = XC + t * 128 + c8; *(LAS f32x4*)d = (f32x4){acc[0], acc[1], acc[2], acc[3]}; *(LAS f32x4*)(d + 4) = (f32x4){acc[4], acc[5], acc[6], acc[7]}; }
        { const int kn_ = k + 1 < SEQ / 64 ? k + 1 : SEQ / 64 - 1; LRU_PREFETCH(kn_); }
        unsigned short gt[16];
#pragma unroll
        for (int e = 0; e < 16; ++e) gt[e] = PROJ[(tokbase + sg * 16 + e) * NINP + PC_GATE + chg];
        __syncthreads();
#pragma unroll
        for (int mt = 0; mt < 4; ++mt) {
            bf16x8 af[4];
#pragma unroll
            for (int ks = 0; ks < 4; ++ks) af[ks] = *(const LAS bf16x8*)(XA + (mt * 16 + fr) * 136 + ks * 32 + 8 * fq);
#pragma unroll
            for (int n = 0; n < 2; ++n) { f32x4 a4 = (f32x4){0.f, 0.f, 0.f, 0.f};
#pragma unroll
                for (int ks = 0; ks < 4; ++ks) a4 = MFMA16(wf[n][ks], af[ks], a4);
                *(LAS f32x4*)(RI + gsel * 8192 + (mt * 16 + fr) * 128 + (nt0 + n) * 16 + fq * 4) = a4; } }
        __syncthreads();
        float av[16], bx[16]; float A = 1.f, B = 0.f;
#pragma unroll
        for (int e = 0; e < 16; ++e) { const int t = sg * 16 + e; const float r = sigmoid_fast(RI[t * 128 + c] + ba_c), ig = sigmoid_fast(RI[8192 + t * 128 + c] + bi_c), xc = XC[t * 128 + c];
            const float la = -sp8 * r; av[e] = __expf(la); bx[e] = sqrtf(fmaxf(1.0f - av[e] * av[e], 0.f)) * (ig * xc); A *= av[e]; B = av[e] * B + bx[e]; }
        SEG[(sg * 128 + c) * 2] = A; SEG[(sg * 128 + c) * 2 + 1] = B;
        __syncthreads();
        float hst = CARRY[c];
        for (int s2 = 0; s2 < sg; ++s2) hst = SEG[(s2 * 128 + c) * 2] * hst + SEG[(s2 * 128 + c) * 2 + 1];
#pragma unroll
        for (int e = 0; e < 16; ++e) { hst = av[e] * hst + bx[e];
            const float g = __uint_as_float((unsigned)gt[e] << 16);
            Y[(tokbase + sg * 16 + e) * D + chg] = (bf16)(cvtpk(hst * gelu_fast(g), 0.f) & 0xffffu); }
        __syncthreads();
        if (sg == 3) CARRY[c] = hst;
    }
    __syncthreads();
#undef LRU_PREFETCH
}
__device__ __forceinline__ void group_barrier(unsigned* cnt, unsigned n) {
    asm volatile("s_waitcnt vmcnt(0)" ::: "memory");
    __syncthreads();
    if (threadIdx.x == 0) {
        __builtin_amdgcn_fence(__ATOMIC_RELEASE, "agent");
        asm volatile("s_waitcnt vmcnt(0)" ::: "memory");
        xb_add(cnt, 1u);
        unsigned sp = 0; while (xb_ld(cnt) < n) { __builtin_amdgcn_s_sleep(2); if (++sp > (1u << 24)) break; }
        __builtin_amdgcn_fence(__ATOMIC_ACQUIRE, "agent");
        asm volatile("s_waitcnt vmcnt(0)" ::: "memory");
    }
    __syncthreads();
}

__device__ __forceinline__ unsigned f2ord(float f) { const unsigned u = __builtin_bit_cast(unsigned, f); return (u & 0x80000000u) ? ~u : (u | 0x80000000u); }
__device__ __forceinline__ float ord2f(unsigned o) { const unsigned u = (o & 0x80000000u) ? (o & 0x7fffffffu) : ~o; return __builtin_bit_cast(float, u); }
#define CMPX(hi_, lo_) do { const unsigned _a = (hi_), _b = (lo_); (hi_) = _a > _b ? _a : _b; (lo_) = _a > _b ? _b : _a; } while (0)
template <int N> __device__ __forceinline__ void sort_desc(unsigned (&a)[N]) {
#pragma unroll
    for (int k = 2; k <= N; k <<= 1)
#pragma unroll
        for (int j = k >> 1; j > 0; j >>= 1)
#pragma unroll
            for (int i = 0; i < N; ++i) { const int l = i ^ j; if (l > i) { if ((i & k) == 0) CMPX(a[i], a[l]); else CMPX(a[l], a[i]); } }
}
__device__ __forceinline__ void merge16(unsigned (&A)[16], const unsigned (&B)[16]) {
#pragma unroll
    for (int i = 0; i < 16; ++i) { const unsigned q = B[15 - i]; A[i] = A[i] > q ? A[i] : q; }
#pragma unroll
    for (int d = 8; d >= 1; d >>= 1)
#pragma unroll
        for (int i = 0; i < 16; ++i) if ((i & d) == 0) CMPX(A[i], A[i + d]);
}
__device__ __forceinline__ void merge_partner(unsigned (&Lk)[16]) {
    unsigned P[16];
#pragma unroll
    for (int i = 0; i < 16; ++i) P[i] = (unsigned)__shfl_xor((int)Lk[i], 32);
#pragma unroll
    for (int i = 0; i < 16; ++i) { const unsigned q = P[15 - i]; Lk[i] = Lk[i] > q ? Lk[i] : q; }
#pragma unroll
    for (int d = 8; d >= 1; d >>= 1)
#pragma unroll
        for (int i = 0; i < 16; ++i) if ((i & d) == 0) CMPX(Lk[i], Lk[i + d]);
}
__device__ __forceinline__ void route_item(const Frame& F, int item, int lane) {
    const int tok0 = (item >> 3) * 32, h = item & 7, c = lane & 31, hi = lane >> 5;
    const bf16* Q = WSP(bf16, WS_Q); const bf16* KB = WSP(bf16, WS_KEYS);
    LAS unsigned* WL = (LAS unsigned*)(F.lds + F.wave * 8192);
    unsigned LST[2][16];
    bf16x8 qf[8], qn[8], kf[8], kn[8];
#pragma unroll
    for (int ks = 0; ks < 8; ++ks) { qf[ks] = *(const bf16x8*)(Q + (size_t)(tok0 + c) * D + h * 256 + ks * 16 + 8 * hi); qn[ks] = *(const bf16x8*)(Q + (size_t)(tok0 + c) * D + h * 256 + 128 + ks * 16 + 8 * hi);
        kf[ks] = *(const bf16x8*)(KB + (size_t)((h * 2) * 128 + c) * 128 + 8 * hi + ks * 16); }
    unsigned Lk[16];
#pragma unroll
    for (int st = 0; st < 8; ++st) { const int p = st >> 2, m = st & 3;
        if (st < 7) { const int p2 = (st + 1) >> 2, m2 = (st + 1) & 3; const bf16* kp = KB + (size_t)((h * 2 + p2) * 128 + m2 * 32 + c) * 128 + 8 * hi;
#pragma unroll
            for (int ks = 0; ks < 8; ++ks) kn[ks] = *(const bf16x8*)(kp + ks * 16); }
        f32x16 acc;
#pragma unroll
        for (int r = 0; r < 16; ++r) acc[r] = 0.f;
#pragma unroll
        for (int ks = 0; ks < 8; ++ks) acc = MFMA32(kf[ks], p ? qn[ks] : qf[ks], acc);
        unsigned G16[16];
#pragma unroll
        for (int r = 0; r < 16; ++r) { const unsigned idx = (unsigned)(m * 32 + (r & 3) + 8 * (r >> 2)) | ((unsigned)hi << 2); G16[r] = (f2ord(acc[r]) & ~0x7Fu) | idx; }
        sort_desc<16>(G16);
        if (m == 0) {
#pragma unroll
            for (int i = 0; i < 16; ++i) Lk[i] = G16[i]; }
        else merge16(Lk, G16);
        if (m == 3) { merge_partner(Lk);
#pragma unroll
            for (int i = 0; i < 16; ++i) { LST[p][i] = Lk[i]; WL[(p * 16 + i) * 64 + lane] = Lk[i] & 0x7Fu; } }
#pragma unroll
        for (int ks = 0; ks < 8; ++ks) kf[ks] = kn[ks];
    }
    float va[4], vb[16];
#pragma unroll
    for (int i = 0; i < 4; ++i) va[i] = ord2f((hi ? LST[1][i] : LST[0][i]) & ~0x7Fu);
#pragma unroll
    for (int j = 0; j < 16; ++j) vb[j] = ord2f((hi ? LST[0][j] : LST[1][j]) & ~0x7Fu);
    unsigned C32[32];
#pragma unroll
    for (int i = 0; i < 32; ++i) C32[i] = 0u;
#pragma unroll
    for (int i = 0; i < 4; ++i) { const unsigned key = (f2ord(va[i] + vb[i]) & ~0xFFu) | (unsigned)(i * 17); C32[i] = hi ? 0u : key; }
    { int cn = 4;
#pragma unroll
      for (int i = 0; i < 3; ++i)
#pragma unroll
          for (int j = i + 1; j < 16; ++j) if ((i + 1) * (j + 1) <= 16) { const unsigned code = hi ? (unsigned)(j * 16 + i) : (unsigned)(i * 16 + j); C32[cn] = (f2ord(va[i] + vb[j]) & ~0xFFu) | code; ++cn; } }
    sort_desc<32>(C32);
    unsigned Ck[16];
#pragma unroll
    for (int i = 0; i < 16; ++i) Ck[i] = C32[i];
    merge_partner(Ck);
    const float mx = ord2f(Ck[0] & ~0xFFu); float den = 0.f;
#pragma unroll
    for (int k = 0; k < 16; ++k) den += __expf(ord2f(Ck[k] & ~0xFFu) - mx);
    const float rden = 1.0f / den;
    int eo[8]; float go[8];
#pragma unroll
    for (int k = 0; k < 8; ++k) { const unsigned fm = hi ? Ck[k + 8] : Ck[k]; const unsigned code = fm & 0xFFu;
        const unsigned k0 = WL[(code >> 4) * 64 + lane], k1 = WL[(16 + (code & 15u)) * 64 + lane];
        eo[k] = (int)(k0 * 128u + k1); go[k] = __expf(ord2f(fm & ~0xFFu) - mx) * rden; }
    int* ep = WSP(int, WS_EXP) + (size_t)(tok0 + c) * NSEL + h * 16 + hi * 8; float* gp = WSP(float, WS_GATE) + (size_t)(tok0 + c) * NSEL + h * 16 + hi * 8;
    *(int4*)ep = make_int4(eo[0], eo[1], eo[2], eo[3]); *(int4*)(ep + 4) = make_int4(eo[4], eo[5], eo[6], eo[7]);
    *(f32x4*)gp = (f32x4){go[0], go[1], go[2], go[3]}; *(f32x4*)(gp + 4) = (f32x4){go[4], go[5], go[6], go[7]};
}

typedef float f32x2 __attribute__((ext_vector_type(2)));
__device__ __forceinline__ int dot4i(unsigned a, unsigned b, int c) { return __builtin_amdgcn_sdot4((int)a, (int)b, c, false); }
template <int CTRL> __device__ __forceinline__ int dppi(int x) { return __builtin_amdgcn_mov_dpp(x, CTRL, 0xf, 0xf, true); }
struct PeerGeom { int ngrp, g, rank, nrank; };
__device__ __forceinline__ PeerGeom peer_geom(const Frame& F) { PeerGeom p; p.ngrp = (F.G % 8 == 0) ? 8 : 1; p.g = F.bid % p.ngrp; p.rank = F.bid / p.ngrp; p.nrank = F.G / p.ngrp; return p; }
__device__ __forceinline__ void xquant_token(const Frame& F, int tok, int lane) {
    const bf16* xr = WSP(bf16, WS_XB) + (size_t)tok * D + lane * 16; float xf[32]; float am = 0.f;
#pragma unroll
    for (int hh = 0; hh < 2; ++hh)
#pragma unroll
        for (int q = 0; q < 2; ++q) { const v4u w = *(const v4u*)(xr + hh * 1024 + q * 8); float t8[8]; unpack8(w, t8);
#pragma unroll
            for (int e = 0; e < 8; ++e) { xf[hh * 16 + q * 8 + e] = t8[e]; am = fmaxf(am, fabsf(t8[e])); } }
#pragma unroll
    for (int o = 1; o < 64; o <<= 1) am = fmaxf(am, __shfl_xor(am, o));
    const float qs = am > 0.f ? 127.0f / am : 0.f;
    if (lane == 0) WSP(float, WS_SX)[tok] = am * (1.0f / 127.0f);
#pragma unroll
    for (int hh = 0; hh < 2; ++hh) { v4u o;
#pragma unroll
        for (int d = 0; d < 4; ++d) { unsigned w = 0u;
#pragma unroll
            for (int e = 0; e < 4; ++e) { const int qi = (int)rintf(xf[hh * 16 + d * 4 + e] * qs); w |= ((unsigned)qi & 0xFFu) << (8 * e); }
            o[d] = w; }
        *(v4u*)(WSP(unsigned char, WS_XQ) + (size_t)tok * D + hh * 1024 + lane * 16) = o; }
}
__device__ __forceinline__ void peer_score_slice(const Frame& F, int tok, int slice, int lane, LAS int* wl) {
    const int e8 = lane >> 3, c16 = lane & 7;
    const int* ep = WSP(int, WS_EXP) + (size_t)tok * NSEL;
    wl[lane] = ep[lane]; wl[64 + lane] = ep[64 + lane];
    const v4u xs = *(const v4u*)(WSP(unsigned char, WS_XQ) + (size_t)tok * D + slice * 128 + c16 * 16);
    const unsigned char* ub = WSP(unsigned char, WS_UT); const unsigned lo = (unsigned)(slice * 128 + c16 * 16);
    int p[16];
#pragma unroll
    for (int ld = 0; ld < 16; ++ld) { const unsigned eid = (unsigned)wl[e8 * 16 + ld]; const v4u w = *(const v4u*)(ub + (eid * 2048u + lo));
        int a = dot4i(w.x, xs.x, 0); a = dot4i(w.y, xs.y, a); a = dot4i(w.z, xs.z, a); p[ld] = dot4i(w.w, xs.w, a); }
    { const bool up = (lane & 4) != 0;
#pragma unroll
      for (int k = 0; k < 8; ++k) { const int keep = up ? p[k + 8] : p[k], send = up ? p[k] : p[k + 8]; p[k] = keep + dppi<0x141>(send); } }
    { const bool up = (lane & 2) != 0;
#pragma unroll
      for (int k = 0; k < 4; ++k) { const int keep = up ? p[k + 4] : p[k], send = up ? p[k] : p[k + 4]; p[k] = keep + dppi<0x4E>(send); } }
    { const bool up = (lane & 1) != 0;
#pragma unroll
      for (int k = 0; k < 2; ++k) { const int keep = up ? p[k + 2] : p[k], send = up ? p[k] : p[k + 2]; p[k] = keep + dppi<0xB1>(send); } }
    int* dst = WSP(int, WS_PART) + ((size_t)slice * T + tok) * NSEL + lane * 2;
    *(int2*)dst = make_int2(p[0], p[1]);
}
__device__ __forceinline__ void peer_coef_token(const Frame& F, int tok, int lane) {
    int s0 = 0, s1 = 0;
#pragma unroll
    for (int s = 0; s < 16; ++s) { const int2 v = *(const int2*)(WSP(int, WS_PART) + ((size_t)s * T + tok) * NSEL + lane * 2); s0 += v.x; s1 += v.y; }
    const int2 ex = *(const int2*)(WSP(int, WS_EXP) + (size_t)tok * NSEL + lane * 2); const f32x2 ga = *(const f32x2*)(WSP(float, WS_GATE) + (size_t)tok * NSEL + lane * 2);
    const float rs = WSP(float, WS_SX)[tok] * (1.0f / sqrtf(WSP(float, WS_SSQ2)[tok] * (1.0f / D) + NORM_EPS));
    const float sc0 = (float)s0 * WSP(float, WS_USC)[ex.x] * rs, sc1 = (float)s1 * WSP(float, WS_USC)[ex.y] * rs;
    f32x2 c; c.x = ga.x * gelu_fast(sc0) * WSP(float, WS_VSC)[ex.x]; c.y = ga.y * gelu_fast(sc1) * WSP(float, WS_VSC)[ex.y];
    float cm = fmaxf(fabsf(c.x), fabsf(c.y));
#pragma unroll
    for (int o = 1; o < 64; o <<= 1) cm = fmaxf(cm, __shfl_xor(cm, o));
    const float qs = cm > 0.f ? 127.0f / cm : 0.f;
    const int q0 = (int)rintf(c.x * qs), q1 = (int)rintf(c.y * qs);
    ((unsigned short*)(F.ws + WS_COEF))[(size_t)tok * 64 + lane] = (unsigned short)(((unsigned)q0 & 0xFFu) | (((unsigned)q1 & 0xFFu) << 8));
    if (lane == 0) WSP(float, WS_CSC)[tok] = cm * (1.0f / 127.0f);
}
struct PeerOutBuf { v4u w[16]; v4u cq; f32x2 x; float cs; };
__device__ __forceinline__ void peer_out_issue(const Frame& F, int tok, int slice, int lane, LAS int* wl, PeerOutBuf& B) {
    const int e8 = lane >> 3, c16 = lane & 7;
    const int* ep = WSP(int, WS_EXP) + (size_t)tok * NSEL;
    wl[lane] = ep[lane]; wl[64 + lane] = ep[64 + lane];
    B.cq = *(const v4u*)(F.ws + WS_COEF + (size_t)tok * 128 + e8 * 16);
    B.cs = WSP(float, WS_CSC)[tok];
    const unsigned char* vb = WSP(unsigned char, WS_VT); const unsigned lofs = (unsigned)(slice * 128 + c16 * 16);
#pragma unroll
    for (int ld = 0; ld < 16; ++ld) { const unsigned eid = (unsigned)wl[e8 * 16 + ld]; B.w[ld] = *(const v4u*)(vb + (eid * 2048u + lofs)); }
    B.x = *(const f32x2*)(F.out + (size_t)tok * D + slice * 128 + c16 * 16 + e8 * 2);
}
__device__ __forceinline__ void peer_out_consume(const Frame& F, int tok, int slice, int lane, LAS int* wl, const PeerOutBuf& B) {
    const int e8 = lane >> 3, c16 = lane & 7;
    int o[16];
#pragma unroll
    for (int i = 0; i < 16; ++i) o[i] = 0;
#pragma unroll
    for (int g = 0; g < 4; ++g) { const unsigned cq = B.cq[g];
#pragma unroll
        for (int d = 0; d < 4; ++d) { const unsigned w0 = B.w[4 * g][d], w1 = B.w[4 * g + 1][d], w2 = B.w[4 * g + 2][d], w3 = B.w[4 * g + 3][d];
            const unsigned lo01 = __builtin_amdgcn_perm(w1, w0, 0x05010400u), hi01 = __builtin_amdgcn_perm(w1, w0, 0x07030602u);
            const unsigned lo23 = __builtin_amdgcn_perm(w3, w2, 0x05010400u), hi23 = __builtin_amdgcn_perm(w3, w2, 0x07030602u);
            const unsigned t0 = __builtin_amdgcn_perm(lo23, lo01, 0x05040100u), t1 = __builtin_amdgcn_perm(lo23, lo01, 0x07060302u);
            const unsigned t2 = __builtin_amdgcn_perm(hi23, hi01, 0x05040100u), t3 = __builtin_amdgcn_perm(hi23, hi01, 0x07060302u);
            o[d * 4 + 0] = dot4i(t0, cq, o[d * 4 + 0]); o[d * 4 + 1] = dot4i(t1, cq, o[d * 4 + 1]); o[d * 4 + 2] = dot4i(t2, cq, o[d * 4 + 2]); o[d * 4 + 3] = dot4i(t3, cq, o[d * 4 + 3]); } }
#pragma unroll
    for (int k = 0; k < 8; ++k) { auto s = __builtin_amdgcn_permlane32_swap((unsigned)o[k], (unsigned)o[k + 8], false, false); o[k] = (int)(s[0] + s[1]); }
#pragma unroll
    for (int k = 0; k < 4; ++k) { auto s = __builtin_amdgcn_permlane16_swap((unsigned)o[k], (unsigned)o[k + 4], false, false); o[k] = (int)(s[0] + s[1]); }
    { const bool up = (lane & 8) != 0;
#pragma unroll
      for (int k = 0; k < 2; ++k) { const int keep = up ? o[k + 2] : o[k], send = up ? o[k] : o[k + 2]; o[k] = keep + dppi<0x128>(send); } }
    f32x2 x = B.x; x.x += (float)o[0] * B.cs; x.y += (float)o[1] * B.cs;
    *(f32x2*)(F.out + (size_t)tok * D + slice * 128 + c16 * 16 + e8 * 2) = x;
    float ss = x.x * x.x + x.y * x.y;
    ss += dppf<0xB1>(ss); ss += dppf<0x4E>(ss); ss += dppf<0x141>(ss); ss += dppf<0x140>(ss);
    { auto s = __builtin_amdgcn_permlane16_swap(__float_as_uint(ss), __float_as_uint(ss), false, false); ss = __uint_as_float(s[0]) + __uint_as_float(s[1]); }
    { auto s = __builtin_amdgcn_permlane32_swap(__float_as_uint(ss), __float_as_uint(ss), false, false); ss = __uint_as_float(s[0]) + __uint_as_float(s[1]); }
    if (lane == 0) atomicAdd(WSP(float, WS_SSQ3) + tok, ss);
}
__device__ __forceinline__ void peer_out_phase(const Frame& F, const PeerGeom& pg, LAS int* wl2) {
    const int lane = F.lane, first = pg.rank * NWAVES + F.wave, step = pg.nrank * NWAVES;
    LAS int* wlA = wl2; LAS int* wlB = wl2 + 256;
    for (int r = 0; r < 16 / pg.ngrp; ++r) { const int slice = r * pg.ngrp + pg.g;
        PeerOutBuf A, B;
        int tok = first;
        if (tok < T) peer_out_issue(F, tok, slice, lane, wlA, A);
        while (tok < T) {
            const int t1 = tok + step, t2 = tok + 2 * step;
            if (t1 < T) peer_out_issue(F, t1, slice, lane, wlB, B);
            peer_out_consume(F, tok, slice, lane, wlA, A);
            if (t1 >= T) break;
            if (t2 < T) peer_out_issue(F, t2, slice, lane, wlA, A);
            peer_out_consume(F, t1, slice, lane, wlB, B);
            tok = t2;
        }
    }
}
__device__ __forceinline__ void final_norm_phase(const Frame& F) {
    const int lane = F.lane, gw = F.bid * NWAVES + F.wave, NGW = F.G * NWAVES;
    const f32x4* gf = (const f32x4*)F.in[I_GF] + lane;
    f32x4 g[8];
#pragma unroll
    for (int j = 0; j < 8; ++j) g[j] = gf[64 * j];
    if (gw >= T) return;
    f32x4 va[8], vb[8]; float sa, sb;
#define FN_LOAD(v_, s_, tok_) do { const int tc_ = (tok_) < T ? (tok_) : T - 1; const f32x4* xi_ = (const f32x4*)(F.out + (size_t)tc_ * D) + lane; s_ = WSP(float, WS_SSQ3)[tc_]; \
        _Pragma("unroll") for (int j_ = 0; j_ < 8; ++j_) v_[j_] = xi_[64 * j_]; } while (0)
#define FN_STORE(v_, s_, tok_) do { f32x4* xo_ = (f32x4*)(F.out + (size_t)(tok_) * D) + lane; const float rs_ = 1.0f / sqrtf(s_ * (1.0f / D) + NORM_EPS); \
        _Pragma("unroll") for (int j_ = 0; j_ < 8; ++j_) xo_[64 * j_] = v_[j_] * rs_ * g[j_]; } while (0)
    FN_LOAD(va, sa, gw);
    for (int tok = gw; tok < T; tok += 2 * NGW) {
        FN_LOAD(vb, sb, tok + NGW);
        FN_STORE(va, sa, tok);
        FN_LOAD(va, sa, tok + 2 * NGW);
        if (tok + NGW < T) FN_STORE(vb, sb, tok + NGW);
    }
#undef FN_LOAD
#undef FN_STORE
}

struct Args { const float* in[28]; float* out; unsigned char* ws; int ph_lo, ph_hi, li, pad; };
__global__ void __launch_bounds__(NTHR, 2) hybrid_fwd(Args args) {
    extern __shared__ __attribute__((aligned(16))) unsigned char lds[];
    Frame F;
    F.lds = (LAS unsigned char*)lds;
    F.tid = threadIdx.x; F.lane = F.tid & 63; F.wave = __builtin_amdgcn_readfirstlane(F.tid >> 6);
    F.G = gridDim.x; F.bid = blockIdx.x;
#pragma unroll
    for (int i = 0; i < 28; ++i) F.in[i] = args.in[i];
    F.out = args.out; F.ws = args.ws;
    volatile LAS unsigned* MISC = (volatile LAS unsigned*)(F.lds + MISC_OFF);
    for (int u = F.tid; u < (LDS_BYTES - LDSCTL_OFF) / 4; u += NTHR) ((LAS unsigned*)(F.lds + LDSCTL_OFF))[u] = 0u;
    __syncthreads();
    unsigned* barw = (unsigned*)(F.ws + WS_CTL) + CW_BAR;
    XcdBarrier bar; bar.bar = barw; bar.x = 0; bar.st = nullptr;
    if (N_LAUNCHES == 1) bar = xcd_barrier_post(barw, MISC + 8);
    const int lo = args.ph_lo, hi = args.ph_hi;
#define IN(k) (lo <= (k) && (k) < hi)
#define SEAM(k) do { if (IN(k) && IN((k) + 1)) xcd_barrier(bar); } while (0)

#ifndef PROBE_DUP
#define PROBE_DUP -1
#endif
#define REPS(k) for (int rep_ = 0; rep_ < ((PROBE_DUP) == (k) ? 2 : 1); ++rep_)
    if (IN(0)) REPS(0) { p0_prologue<0>(F, F.bid, F.G); __syncthreads(); }
    SEAM(0);
    if (IN(1)) REPS(1) {
        pg8::Gemm g{WSP(const bf16, WS_XB), WSP(const bf16, WS_WIN), T, NINP, D}; pg8::StaticOrder S; S.init(T, NINP, F.G, F.bid);
        pg8::EpiRowScaleBf16<0> E{WSP(bf16, WS_PROJ), NINP, WSP(const float, WS_RSTD1), NORM_EPS};
        pg8::gemm_phase<pg8::EpiRowScaleBf16<0>, pg8::StaticOrder, true, true>(F.lds, g, S, E);
    }
    SEAM(1);
    if (IN(2)) REPS(2) {
        lora_prepass(F);
        group_barrier((unsigned*)(F.ws + WS_CTL) + CW_PREBAR, (unsigned)F.G);
        for (int r4 = 0; r4 < ((PROBE_DUP) == 70 ? 2 : 1); ++r4) rwkv_prep_phase(F);
        group_barrier((unsigned*)(F.ws + WS_CTL) + CW_PREPBAR, (unsigned)F.G);
        const int R1 = F.G >= 256 ? 128 : F.G, L0 = F.G >= 256 ? 128 : 0, NL = F.G - L0;
        if (F.bid < R1) for (int it = F.bid; it < 128; it += R1) rwkv_item(F, it);
        if (F.bid >= L0) for (int it = F.bid - L0; it < 64; it += NL) lru_seq(F, it);
        { volatile LAS int* qslot = (volatile LAS int*)(F.lds + LDSCTL_OFF + 1024);
          for (;;) { __syncthreads(); if (F.tid == 0) *qslot = (int)xb_add((unsigned*)(F.ws + WS_CTL) + CW_DEFQ, 1u); __syncthreads();
              const int vb = *qslot; if (vb >= 1024) break; p0_prologue<1>(F, vb, 1024); } }
    }
    SEAM(2);
    if (IN(3)) {
        pg8::Gemm g{WSP(const bf16, WS_Y), WSP(const bf16, WS_WOUT), T, D, D}; pg8::StaticOrder S; S.init(T, D, F.G, F.bid);
        pg8::EpiResidual E{F.in[I_X], F.out, WSP(bf16, WS_XB), WSP(float, WS_SSQ2), D};
        pg8::gemm_phase<pg8::EpiResidual, pg8::StaticOrder, true, true>(F.lds, g, S, E);
    }
    SEAM(3);
    if (IN(4)) REPS(4) {
        pg8::Gemm g{WSP(const bf16, WS_XB), WSP(const bf16, WS_WQ), T, D, D}; pg8::StaticOrder S; S.init(T, D, F.G, F.bid);
        pg8::EpiRowScaleBf16<1> E{WSP(bf16, WS_Q), D, WSP(const float, WS_SSQ2), NORM_EPS};
        pg8::gemm_phase<pg8::EpiRowScaleBf16<1>, pg8::StaticOrder, true, true>(F.lds, g, S, E);
    }
    if (IN(4)) { __syncthreads();
        pg8::StaticOrder S; S.init(T, D, F.G, F.bid); pg8::Unit u;
        for (int i = 0; S.next(i, u); ++i) route_item(F, ((u.pm * 8 + F.wave) << 3) | u.pn, F.lane);
        const int gw = F.bid * NWAVES + F.wave, NGW = F.G * NWAVES;
        for (int tok = gw; tok < T; tok += NGW) xquant_token(F, tok, F.lane); }
    if (IN(4) && IN(6)) xcd_barrier(bar);
    { const PeerGeom pg = peer_geom(F); LAS int* wl = (LAS int*)(F.lds + F.wave * 1024);
      if (IN(6)) REPS(6) { for (int r = 0; r < 16 / pg.ngrp; ++r) { const int slice = r * pg.ngrp + pg.g; for (int tok = pg.rank * NWAVES + F.wave; tok < T; tok += pg.nrank * NWAVES) peer_score_slice(F, tok, slice, F.lane, wl); } }
      SEAM(6);
      if (IN(7)) REPS(7) { const int gw = F.bid * NWAVES + F.wave, NGW = F.G * NWAVES; for (int tok = gw; tok < T; tok += NGW) peer_coef_token(F, tok, F.lane); }
      SEAM(7);
      if (IN(8)) peer_out_phase(F, pg, (LAS int*)(F.lds + 16384 + F.wave * 2048));
      SEAM(8);
      if (IN(9)) final_norm_phase(F); }
#undef IN
#undef SEAM
}

extern "C" void kernel_launch(void* const* d_in, const int* in_sizes, int n_in, void* d_out, int out_size, void* d_ws, size_t ws_size, hipStream_t stream) {
    static int grid = 0;
    if (grid == 0) {
        if (n_in != 28 || in_sizes[0] != T * D || out_size != T * D || ws_size < WS_END) { fprintf(stderr, "kernel_launch: shape/workspace mismatch: n_in %d in0 %d out %d ws %zu (need %zu)\n", n_in, n_in > 0 ? in_sizes[0] : -1, out_size, ws_size, (size_t)WS_END); grid = -1; return; }
        int dev = 0, cus = 0, per_cu = 0;
        if (hipGetDevice(&dev) != hipSuccess || hipDeviceGetAttribute(&cus, hipDeviceAttributeMultiprocessorCount, dev) != hipSuccess) { fprintf(stderr, "kernel_launch: device query failed\n"); grid = -1; return; }
        if (hipFuncSetAttribute((const void*)hybrid_fwd, hipFuncAttributeMaxDynamicSharedMemorySize, LDS_BYTES) != hipSuccess) { fprintf(stderr, "kernel_launch: hipFuncSetAttribute failed\n"); grid = -1; return; }
        if (hipOccupancyMaxActiveBlocksPerMultiprocessor(&per_cu, (const void*)hybrid_fwd, NTHR, LDS_BYTES) != hipSuccess || per_cu < 1) { fprintf(stderr, "kernel_launch: occupancy query says %d blocks per CU\n", per_cu); per_cu = 1; }
        (void)hipGetLastError();
        grid = cus;
    }
    if (grid < 0) return;
    if (hipMemsetAsync((char*)d_ws + WS_CTL, 0, CTL_ZERO_BYTES, stream) != hipSuccess) { fprintf(stderr, "kernel_launch: hipMemsetAsync failed\n"); return; }
    Args a{};
    for (int i = 0; i < 28; ++i) a.in[i] = (const float*)d_in[i];
    a.out = (float*)d_out; a.ws = (unsigned char*)d_ws;
    for (int li = 0; li < N_LAUNCHES; ++li) {
        a.ph_lo = (N_LAUNCHES == 1) ? 0 : li; a.ph_hi = (N_LAUNCHES == 1) ? N_PHASES : li + 1; a.li = li;
        hipLaunchKernelGGL(hybrid_fwd, dim3(grid), dim3(NTHR), LDS_BYTES, stream, a);
        const hipError_t le = hipPeekAtLastError();
        if (le != hipSuccess) { fprintf(stderr, "kernel_launch: launch %d failed: %s\n", li, hipGetErrorName(le)); break; }
    }
}
```

```cpp
#include <hip/hip_runtime.h>
#include <cstdio>
#include <cstdint>
namespace pg8 {
#define PG8_LAS __attribute__((address_space(3)))
typedef unsigned short bf16_t;
typedef short bf16x8 __attribute__((ext_vector_type(8)));
typedef float f32x4 __attribute__((ext_vector_type(4)));
typedef unsigned u32x4 __attribute__((ext_vector_type(4)));
typedef int i32x4 __attribute__((ext_vector_type(4)));
constexpr int BM = 256, BK = 64, HALF = 128, HTB = HALF * BK * 2  , STAGE_BYTES = 8 * HTB, NXCD = 8, WGM = 8;

__host__ __device__ __forceinline__ int lds_byte(int r, int c) { const int st = (r >> 4) * 2 + (c >> 5), rr = r & 15, cc = c & 31, ob = rr * 64 + cc * 2; return st * 1024 + (ob ^ (((ob >> 9) & 1) << 5)); }
__host__ __device__ __forceinline__ void stage_rc(int b, int& R, int& C) { const int st = b / 1024, sb = b % 1024, swz = sb ^ (((sb >> 9) & 1) << 5); R = (st >> 1) * 16 + swz / 64; C = (st & 1) * 32 + (swz % 64) / 2; }
__host__ __device__ __forceinline__ int perm32(int rho) { const int n = rho >> 4, i = rho & 15; return 8 * (i >> 2) + 4 * n + (i & 3); }

struct Unit { int pm, pn; };
struct Gemm { const bf16_t* A; const bf16_t* Bt; int M, N, K; };

struct StaticOrder {
    int nM, nN, nwg, G, c;
    __host__ __device__ void init(int M, int N, int G_, int c_) { nM = M / BM; nN = N / BM; nwg = nM * nN; G = G_; c = c_; }
    __host__ __device__ bool next(int i, Unit& u) const {
        const long L = (long)i * G + c; if (L >= nwg) return false;
        int wgid = (int)L; { const int q = nwg / NXCD, r = nwg % NXCD, xcd = wgid % NXCD, off = wgid / NXCD; wgid = (xcd < r ? xcd * (q + 1) : r * (q + 1) + (xcd - r) * q) + off; }
        const int nig = WGM * nN, gid = wgid / nig, fm = gid * WGM, gsz = (nM - fm) < WGM ? (nM - fm) : WGM;
        u.pm = fm + ((wgid % nig) % gsz); u.pn = (wgid % nig) / gsz; return true;
    }
    __device__ __forceinline__ void a_ready(const Unit&) const {}
    __device__ __forceinline__ void done(const Unit&) const {}
};

__device__ __forceinline__ unsigned cvt_pk_bf16(float lo, float hi) { unsigned r; asm volatile("v_cvt_pk_bf16_f32 %0, %1, %2" : "=v"(r) : "v"(lo), "v"(hi)); return r; }
typedef float f32x2 __attribute__((ext_vector_type(2)));
typedef unsigned u32x2 __attribute__((ext_vector_type(2)));
template <int MODE> struct EpiRowScaleBf16 {
    static constexpr bool PERM = true, AFTER_DRAIN = false;
    bf16_t* O; int ldc; const float* rs; float eps;
    __device__ __forceinline__ void operator()(const f32x4 (&acc)[2][2][4][2], const Unit& u, int wr, int wc, int fr, int fq) const {
        const int row0 = u.pm * BM + wr * 64 + fr, col0 = u.pn * BM + wc * 32 + 8 * fq;
#pragma unroll
        for (int ai = 0; ai < 2; ++ai)
#pragma unroll
            for (int m = 0; m < 4; ++m) { const int r = row0 + ai * HALF + m * 16; float s = rs[r]; if (MODE == 1) s = 1.0f / sqrtf(s * (1.0f / 2048.0f) + eps);
                bf16_t* rowp = O + (size_t)r * ldc + col0;
#pragma unroll
                for (int bj = 0; bj < 2; ++bj) { const f32x4 v0 = acc[ai][bj][m][0] * s, v1 = acc[ai][bj][m][1] * s;
                    u32x4 w; w.x = cvt_pk_bf16(v0[0], v0[1]); w.y = cvt_pk_bf16(v0[2], v0[3]); w.z = cvt_pk_bf16(v1[0], v1[1]); w.w = cvt_pk_bf16(v1[2], v1[3]);
                    *(u32x4*)(rowp + bj * HALF) = w; } }
    }
};
struct EpiI8RowColBf16 {
    static constexpr bool PERM = true, AFTER_DRAIN = false;
    bf16_t* O; int ldc; const float* rs; const float* cs;
    __device__ __forceinline__ void operator()(const f32x4 (&acc)[2][2][4][2], const Unit& u, int wr, int wc, int fr, int fq) const {
        const int row0 = u.pm * BM + wr * 64 + fr, col0 = u.pn * BM + wc * 32 + 8 * fq;
        f32x4 c4[2][2];
#pragma unroll
        for (int bj = 0; bj < 2; ++bj) { c4[bj][0] = *(const f32x4*)(cs + col0 + bj * HALF); c4[bj][1] = *(const f32x4*)(cs + col0 + bj * HALF + 4); }
#pragma unroll
        for (int ai = 0; ai < 2; ++ai)
#pragma unroll
            for (int m = 0; m < 4; ++m) { const int r = row0 + ai * HALF + m * 16; const float s = rs[r];
                bf16_t* rowp = O + (size_t)r * ldc + col0;
#pragma unroll
                for (int bj = 0; bj < 2; ++bj) { f32x4 v0, v1; const i32x4 i0 = __builtin_bit_cast(i32x4, acc[ai][bj][m][0]), i1 = __builtin_bit_cast(i32x4, acc[ai][bj][m][1]);
#pragma unroll
                    for (int e = 0; e < 4; ++e) { v0[e] = (float)i0[e] * s * c4[bj][0][e]; v1[e] = (float)i1[e] * s * c4[bj][1][e]; }
                    u32x4 w; w.x = cvt_pk_bf16(v0[0], v0[1]); w.y = cvt_pk_bf16(v0[2], v0[3]); w.z = cvt_pk_bf16(v1[0], v1[1]); w.w = cvt_pk_bf16(v1[2], v1[3]);
                    *(u32x4*)(rowp + bj * HALF) = w; } }
    }
};
struct EpiResidual {
    static constexpr bool PERM = false, AFTER_DRAIN = false;
    const float* base; float* out; bf16_t* outb; float* ssq; int ldc;
    __device__ __forceinline__ void operator()(const f32x4 (&acc)[2][2][4][2], const Unit& u, int wr, int wc, int fr, int fq) const {
        const int row0 = u.pm * BM + wr * 64 + fr, col0 = u.pn * BM + wc * 32 + 4 * fq;
#pragma unroll
        for (int ai = 0; ai < 2; ++ai)
#pragma unroll
            for (int m = 0; m < 4; ++m) { const int r = row0 + ai * HALF + m * 16; const size_t off = (size_t)r * ldc + col0; float q = 0.f;
#pragma unroll
                for (int bj = 0; bj < 2; ++bj)
#pragma unroll
                    for (int n = 0; n < 2; ++n) { const f32x4 bs = *(const f32x4*)(base + off + bj * HALF + n * 16); const f32x4 o = bs + acc[ai][bj][m][n];
                        *(f32x4*)(out + off + bj * HALF + n * 16) = o; q += (o[0] * o[0] + o[1] * o[1]) + (o[2] * o[2] + o[3] * o[3]);
                        u32x2 w; w.x = cvt_pk_bf16(o[0], o[1]); w.y = cvt_pk_bf16(o[2], o[3]); *(u32x2*)(outb + off + bj * HALF + n * 16) = w; }
                q += __shfl_xor(q, 16); q += __shfl_xor(q, 32);
                if (fq == 0) atomicAdd(ssq + r, q);
                asm volatile("" ::: "memory"); }
    }
};
template <class Epi, class Sched, bool ALIGN_EPI = false, bool SP2 = false, bool I8 = false>
__device__ __forceinline__ void gemm_phase(PG8_LAS unsigned char* lds, const Gemm g, const Sched& S, const Epi& E) {
    const int tid = threadIdx.x, wid = __builtin_amdgcn_readfirstlane(tid >> 6), lane = tid & 63, wr = wid >> 2, wc = wid & 3, fr = lane & 15, fq = lane >> 4;
    const int K = g.K, nt = K / BK;
    unsigned voffA[2], voffB[2];
#pragma unroll
    for (int i = 0; i < 2; ++i) { int R, C; stage_rc(tid * 16 + i * 8192, R, C); const int Rb = Epi::PERM ? ((R & ~31) + perm32(R & 31)) : R;
        voffA[i] = (unsigned)(R * K + C) * 2u; voffB[i] = (unsigned)(Rb * K + C) * 2u; }
    const size_t kstep = (size_t)(BK * 2);
    const size_t hstep = (size_t)HALF * K * 2;
    const size_t tstep = 2 * hstep;
    const unsigned ldsw = (unsigned)wid * 1024u;
    const int aoff = lds_byte(wr * 64 + fr, fq * 8), boff = lds_byte(wc * 32 + fr, fq * 8);
#define PG8_SA(b, h) (((b) * 2 + (h)) * HTB)
#define PG8_SB(b, h) ((4 + (b) * 2 + (h)) * HTB)
#define PG8_STAGE(bufoff, gbase, voff) do { _Pragma("unroll") for (int _i = 0; _i < 2; ++_i) \
        __builtin_amdgcn_global_load_lds((const unsigned*)((const char*)(gbase) + (voff)[_i]), (PG8_LAS unsigned*)(lds + (bufoff) + ldsw + _i * 8192), 16, 0, 0); } while (0)
#define PG8_LDA(dst, b, h) do { _Pragma("unroll") for (int m = 0; m < 4; ++m) _Pragma("unroll") for (int k = 0; k < 2; ++k) dst[m][k] = *(const PG8_LAS bf16x8*)(lds + PG8_SA(b, h) + aoff + m * 2048 + k * 1024); } while (0)
#define PG8_LDB(dst, b, h) do { _Pragma("unroll") for (int n = 0; n < 2; ++n) _Pragma("unroll") for (int k = 0; k < 2; ++k) dst[n][k] = *(const PG8_LAS bf16x8*)(lds + PG8_SB(b, h) + boff + n * 2048 + k * 1024); } while (0)
#define PG8_MMA(ai, bj, At, Bt) do { __builtin_amdgcn_s_setprio(1); _Pragma("unroll") for (int m = 0; m < 4; ++m) _Pragma("unroll") for (int n = 0; n < 2; ++n) _Pragma("unroll") for (int k = 0; k < 2; ++k) \
        { if constexpr (I8) acc[ai][bj][m][n] = __builtin_bit_cast(f32x4, __builtin_amdgcn_mfma_i32_16x16x64_i8(__builtin_bit_cast(i32x4, Bt[n][k]), __builtin_bit_cast(i32x4, At[m][k]), __builtin_bit_cast(i32x4, acc[ai][bj][m][n]), 0, 0, 0)); \
          else acc[ai][bj][m][n] = __builtin_amdgcn_mfma_f32_16x16x32_bf16(Bt[n][k], At[m][k], acc[ai][bj][m][n], 0, 0, 0); } __builtin_amdgcn_s_setprio(0); } while (0)
#define PG8_WAIT_V(n) asm volatile("s_waitcnt vmcnt(" #n ")" ::: "memory")
#define PG8_WAIT_L(n) asm volatile("s_waitcnt lgkmcnt(" #n ")" ::: "memory")
#define PG8_BAR __builtin_amdgcn_s_barrier()
#define PG8_SCHED __builtin_amdgcn_sched_barrier(0)
    Unit cur, nxt; int ui = 0;
    if (!S.next(0, cur)) return;
    f32x4 acc[2][2][4][2];
#pragma unroll
    for (int a = 0; a < 2; ++a)
#pragma unroll
        for (int b = 0; b < 2; ++b)
#pragma unroll
            for (int m = 0; m < 4; ++m)
#pragma unroll
                for (int n = 0; n < 2; ++n) acc[a][b][m][n] = (f32x4){0.f, 0.f, 0.f, 0.f};
    bf16x8 At[4][2], B0[2][2], B1[2][2];
    const char* cA = (const char*)g.A + (size_t)cur.pm * tstep; const char* cB = (const char*)g.Bt + (size_t)cur.pn * tstep;
    S.a_ready(cur);
    if constexpr (SP2) {
        PG8_STAGE(PG8_SB(0, 0), cB, voffB); PG8_STAGE(PG8_SB(0, 1), cB + hstep, voffB); PG8_STAGE(PG8_SA(0, 0), cA, voffA); PG8_STAGE(PG8_SA(0, 1), cA + hstep, voffA);
        if (wr == 1) PG8_BAR;
        PG8_WAIT_V(2); PG8_BAR;
        PG8_STAGE(PG8_SB(1, 0), cB + kstep, voffB); PG8_STAGE(PG8_SA(1, 0), cA + kstep, voffA); PG8_STAGE(PG8_SB(1, 1), cB + hstep + kstep, voffB);
        PG8_WAIT_V(6); PG8_BAR;
    } else {
        PG8_STAGE(PG8_SB(0, 0), cB, voffB); PG8_STAGE(PG8_SA(0, 0), cA, voffA); PG8_STAGE(PG8_SB(0, 1), cB + hstep, voffB); PG8_STAGE(PG8_SA(0, 1), cA + hstep, voffA);
        if (wr == 1) PG8_BAR;
        PG8_WAIT_V(4); PG8_BAR;
        PG8_STAGE(PG8_SB(1, 0), cB + kstep, voffB); PG8_STAGE(PG8_SA(1, 0), cA + kstep, voffA); PG8_STAGE(PG8_SB(1, 1), cB + hstep + kstep, voffB);
        PG8_WAIT_V(6); PG8_BAR;
    }
    for (;;) {
        const bool has_next = S.next(ui + 1, nxt);
        const char* nA = has_next ? (const char*)g.A + (size_t)nxt.pm * tstep : cA; const char* nB = has_next ? (const char*)g.Bt + (size_t)nxt.pn * tstep : cB;
        for (int t = 0; t < nt; t += 2) {
            const bool last = (t == nt - 2);
            const char* a1 = cA + (size_t)(t + 1) * kstep;
            const char* a2 = last ? nA : cA + (size_t)(t + 2) * kstep; const char* b2 = last ? nB : cB + (size_t)(t + 2) * kstep;
            const char* a3 = a2 + kstep; const char* b3 = b2 + kstep;
            if (last && has_next) S.a_ready(nxt);
            if constexpr (SP2) {
            PG8_LDB(B0, 0, 0); PG8_LDB(B1, 0, 1); PG8_SCHED; PG8_LDA(At, 0, 0); PG8_STAGE(PG8_SA(1, 1), a1 + hstep, voffA);
            PG8_WAIT_V(8); PG8_WAIT_L(0); PG8_BAR; PG8_MMA(0, 0, At, B0); PG8_MMA(0, 1, At, B1); PG8_BAR; PG8_SCHED;
            PG8_LDA(At, 0, 1); PG8_STAGE(PG8_SB(0, 0), b2, voffB); PG8_STAGE(PG8_SB(0, 1), b2 + hstep, voffB); PG8_STAGE(PG8_SA(0, 0), a2, voffA);
            PG8_WAIT_V(8); PG8_WAIT_L(0); PG8_BAR; PG8_MMA(1, 0, At, B0); PG8_MMA(1, 1, At, B1); PG8_BAR; PG8_SCHED;
            PG8_LDB(B0, 1, 0); PG8_LDB(B1, 1, 1); PG8_SCHED; PG8_LDA(At, 1, 0); PG8_STAGE(PG8_SA(0, 1), a2 + hstep, voffA);
            PG8_WAIT_V(8); PG8_WAIT_L(0); PG8_BAR; PG8_MMA(0, 0, At, B0); PG8_MMA(0, 1, At, B1); PG8_BAR; PG8_SCHED;
            PG8_LDA(At, 1, 1); PG8_STAGE(PG8_SB(1, 0), b3, voffB); PG8_STAGE(PG8_SB(1, 1), b3 + hstep, voffB); PG8_STAGE(PG8_SA(1, 0), a3, voffA);
            PG8_WAIT_V(8); PG8_WAIT_L(0); PG8_BAR; PG8_MMA(1, 0, At, B0); PG8_MMA(1, 1, At, B1); PG8_BAR; PG8_SCHED;
            } else {
            PG8_LDB(B0, 0, 0); PG8_SCHED; PG8_LDA(At, 0, 0); PG8_STAGE(PG8_SA(1, 1), a1 + hstep, voffA);
            PG8_WAIT_L(8); PG8_BAR; PG8_WAIT_L(0); PG8_MMA(0, 0, At, B0); PG8_BAR; PG8_SCHED;
            PG8_LDB(B1, 0, 1); PG8_STAGE(PG8_SB(0, 0), b2, voffB);
            PG8_BAR; PG8_WAIT_L(0); PG8_MMA(0, 1, At, B1); PG8_BAR;
            PG8_LDA(At, 0, 1); PG8_STAGE(PG8_SA(0, 0), a2, voffA);
            PG8_BAR; PG8_WAIT_L(0); PG8_MMA(1, 0, At, B0); PG8_BAR; PG8_SCHED;
            PG8_STAGE(PG8_SB(0, 1), b2 + hstep, voffB);
            PG8_WAIT_V(6); PG8_BAR; PG8_MMA(1, 1, At, B1); PG8_BAR;
            PG8_LDB(B0, 1, 0); PG8_SCHED; PG8_LDA(At, 1, 0); PG8_STAGE(PG8_SA(0, 1), a2 + hstep, voffA);
            PG8_WAIT_L(8); PG8_BAR; PG8_WAIT_L(0); PG8_MMA(0, 0, At, B0); PG8_BAR; PG8_SCHED;
            PG8_LDB(B1, 1, 1); PG8_STAGE(PG8_SB(1, 0), b3, voffB);
            PG8_BAR; PG8_WAIT_L(0); PG8_MMA(0, 1, At, B1); PG8_BAR;
            PG8_LDA(At, 1, 1); PG8_STAGE(PG8_SA(1, 0), a3, voffA);
            PG8_BAR; PG8_WAIT_L(0); PG8_MMA(1, 0, At, B0); PG8_BAR; PG8_SCHED;
            PG8_STAGE(PG8_SB(1, 1), b3 + hstep, voffB);
            PG8_WAIT_V(6); PG8_BAR; PG8_MMA(1, 1, At, B1); PG8_BAR;
            }
        }
        if constexpr (ALIGN_EPI) { if (wr == 0) PG8_BAR; }
        if constexpr (!Epi::AFTER_DRAIN) { E(acc, cur, wr, wc, fr, fq); S.done(cur); }
        if (!has_next) break;
#pragma unroll
        for (int a = 0; a < 2; ++a)
#pragma unroll
            for (int b = 0; b < 2; ++b)
#pragma unroll
                for (int m = 0; m < 4; ++m)
#pragma unroll
                    for (int n = 0; n < 2; ++n) acc[a][b][m][n] = (f32x4){0.f, 0.f, 0.f, 0.f};
        cur = nxt; cA = nA; cB = nB; ++ui;
        if constexpr (ALIGN_EPI) { if (wr == 1) PG8_BAR; }
    }
    PG8_WAIT_V(0);
    if constexpr (!ALIGN_EPI) { if (wr == 0) PG8_BAR; }
    PG8_BAR;
    if constexpr (Epi::AFTER_DRAIN) { E.fused(acc, cur, wr, wc, fr, fq, lds, wid, lane); S.done(cur); }
#undef PG8_SA
#undef PG8_SB
#undef PG8_STAGE
#undef PG8_LDA
#undef PG8_LDB
#undef PG8_MMA
#undef PG8_WAIT_V
#undef PG8_WAIT_L
#undef PG8_BAR
#undef PG8_SCHED
}
}

#ifndef PROBE_DUP
#define PROBE_DUP -1
#endif
constexpr int NWAVES = 8, NTHR = NWAVES * 64;
#ifndef MK_N_LAUNCHES
#define MK_N_LAUNCHES 1
#endif
constexpr int N_PHASES = 10;
constexpr int N_LAUNCHES = MK_N_LAUNCHES;
static_assert(N_LAUNCHES == 1 || N_LAUNCHES == N_PHASES, "MK_N_LAUNCHES is 1 or N_PHASES");

constexpr int BATCH = 8, SEQ = 2048, T = BATCH * SEQ, D = 2048;
constexpr int NIN = 5408, NINP = 5632;
constexpr int PC_GATE = 1024, PC_R = 2048, PC_K = 3072, PC_V = 4096, PC_WD = 5120, PC_AD = 5184, PC_GD = 5248;
constexpr int RWKV_C0 = 2048;
constexpr int NEXP = 16384, NSEL = 128;
constexpr float NORM_EPS = 1e-6f, GN_EPS = 64e-5f;

constexpr size_t MiB = 1u << 20;
constexpr size_t WS_CTL = 0, CTL_ZERO_BYTES = 1 * MiB;
constexpr size_t WS_SSQ3 = 576 * 1024;
constexpr size_t WS_SSQ2 = 512 * 1024;
constexpr size_t WS_RSTD1 = 1 * MiB;
constexpr size_t WS_USC = 1 * MiB + 64 * 1024, WS_VSC = 1 * MiB + 128 * 1024;
constexpr size_t WS_SX = 1 * MiB + 192 * 1024;
constexpr size_t WS_CS1 = 1 * MiB + 256 * 1024;
constexpr size_t WS_WIN = 2 * MiB;
constexpr size_t WS_WOUT = 24 * MiB;
constexpr size_t WS_WQ = 32 * MiB;
constexpr size_t WS_KEYS = 40 * MiB;
constexpr size_t WS_W2T = WS_KEYS + 512 * 1024;
constexpr size_t WS_A2T = WS_W2T + 128 * 1024;
constexpr size_t WS_G2T = WS_A2T + 128 * 1024;
constexpr size_t WS_WAT = WS_G2T + 320 * 1024;
constexpr size_t WS_WIT = WS_WAT + 256 * 1024;
constexpr size_t WS_EXP = 42 * MiB;
constexpr size_t WS_GATE = 50 * MiB;
constexpr size_t WS_LA = 42 * MiB;
constexpr size_t WS_SUMM = 58 * MiB;
constexpr size_t WS_TA = 64 * MiB, WS_TB = 96 * MiB, WS_TK = 400 * MiB, WS_TR = 464 * MiB;
constexpr size_t OUT_TV = 0, OUT_TG = 32 * MiB, OUT_PC = 64 * MiB, OUT_BON = 66 * MiB;
constexpr size_t WS_XB = 64 * MiB;
constexpr size_t WS_PROJ = 128 * MiB;
constexpr size_t WS_Q = WS_PROJ;
constexpr size_t WS_PART = 192 * MiB;
constexpr size_t WS_XQ = 320 * MiB;
constexpr size_t WS_COEF = 352 * MiB;
constexpr size_t WS_CSC = 356 * MiB;
constexpr size_t WS_Y = 304 * MiB;
constexpr size_t WS_UT = 368 * MiB;
constexpr size_t WS_VT = 432 * MiB;
constexpr size_t WS_END = 496 * MiB;
static_assert(WS_WIT + 256 * 1024 <= WS_EXP && WS_PROJ + (size_t)T * NINP * 2 <= WS_Y && WS_WIN + (size_t)NINP * D * 2 <= WS_WOUT, "d_ws map");
constexpr int CW_DEFQ = 2240;
constexpr int CW_PREPBAR = 2176;
constexpr int CW_PREBAR = 2112;
constexpr int CW_LRUBAR = 2048;
constexpr int CW_BAR = 4096;

constexpr int RING_BYTES = 131072;
constexpr int LDSCTL_OFF = 143360, MISC_OFF = LDSCTL_OFF + 320;
constexpr int LDS_BYTES = 147456;

#define GAS __attribute__((address_space(1)))
#define LAS __attribute__((address_space(3)))
typedef unsigned short bf16;
typedef unsigned v4u __attribute__((ext_vector_type(4)));
typedef unsigned v2u __attribute__((ext_vector_type(2)));
typedef float f32x4 __attribute__((ext_vector_type(4)));
typedef float f32x16 __attribute__((ext_vector_type(16)));
typedef short bf16x8 __attribute__((ext_vector_type(8)));
typedef __bf16 bf16x2_t __attribute__((ext_vector_type(2)));
typedef GAS unsigned gu32;
#define RLX_AGENT __ATOMIC_RELAXED, __HIP_MEMORY_SCOPE_AGENT
__device__ __forceinline__ unsigned f2bf(float f) { unsigned u = __builtin_bit_cast(unsigned, f); return (u + 0x7fffu + ((u >> 16) & 1u)) >> 16; }
__device__ __forceinline__ unsigned pk2(float lo, float hi) { return f2bf(lo) | (f2bf(hi) << 16); }
__device__ __forceinline__ float bf_lo(unsigned w) { return __uint_as_float(w << 16); }
__device__ __forceinline__ float bf_hi(unsigned w) { return __uint_as_float(w & 0xffff0000u); }
__device__ __forceinline__ void unpack8(const v4u& w, float (&o)[8]) { o[0] = bf_lo(w.x); o[1] = bf_hi(w.x); o[2] = bf_lo(w.y); o[3] = bf_hi(w.y); o[4] = bf_lo(w.z); o[5] = bf_hi(w.z); o[6] = bf_lo(w.w); o[7] = bf_hi(w.w); }
__device__ __forceinline__ v4u pack8(const float (&o)[8]) { v4u w; w.x = pk2(o[0], o[1]); w.y = pk2(o[2], o[3]); w.z = pk2(o[4], o[5]); w.w = pk2(o[6], o[7]); return w; }
__device__ __forceinline__ float sigmoidf_(float x) { return 1.0f / (1.0f + __expf(-x)); }
__device__ __forceinline__ float softplusf_(float z) { return fmaxf(z, 0.f) + log1pf(__expf(-fabsf(z))); }
__device__ __forceinline__ float gelu_tanh(float x) { const float u = 0.7978845608028654f * (x + 0.044715f * x * x * x); return 0.5f * x * (1.0f + tanhf(u)); }
template <int CTRL> __device__ __forceinline__ float dppf(float x) { return __builtin_bit_cast(float, __builtin_amdgcn_mov_dpp(__builtin_bit_cast(int, x), CTRL, 0xf, 0xf, true)); }
__device__ __forceinline__ float red8(float v) { v += dppf<0xB1>(v); v += dppf<0x4E>(v); v += dppf<0x141>(v); return v; }
__device__ __forceinline__ float red16(float v) { v = red8(v); v += dppf<0x140>(v); return v; }
__device__ __forceinline__ float wave_sum(float v) {
#pragma unroll
    for (int o = 1; o < 64; o <<= 1) v += __shfl_xor(v, o);
    return v;
}
__device__ __forceinline__ float dot2bf(unsigned a, unsigned b, float acc) { return __builtin_amdgcn_fdot2_f32_bf16(__builtin_bit_cast(bf16x2_t, a), __builtin_bit_cast(bf16x2_t, b), acc, false); }
#define MFMA16(a, b, c) __builtin_amdgcn_mfma_f32_16x16x32_bf16((a), (b), (c), 0, 0, 0)
#define MFMA32(a, b, c) __builtin_amdgcn_mfma_f32_32x32x16_bf16((a), (b), (c), 0, 0, 0)

#define XB_TMO      128
#define XB_XCNT(j)  (256  + 64 * (j))
#define XB_XSUB(j)  (1280 + 64 * (j))
#define XB_XGEN(j)  (2304 + 64 * (j))
#define XB_TOP      3328
#define XB_TOPGEN   3392
#define XCD_BAR_WORDS 3456
#define XB_SPIN_CAP (1u << 22)
__device__ __forceinline__ unsigned xb_ld(unsigned* p)              { return __hip_atomic_load(p, __ATOMIC_RELAXED, __HIP_MEMORY_SCOPE_AGENT); }
__device__ __forceinline__ unsigned xb_add(unsigned* p, unsigned v) { return __hip_atomic_fetch_add(p, v, __ATOMIC_RELAXED, __HIP_MEMORY_SCOPE_AGENT); }
__device__ __forceinline__ unsigned xb_xcc_id() { return (unsigned)__builtin_amdgcn_s_getreg((3 << 11) | 20) & 0xFu; }
#define XB_SPIN(cond, bar) do { unsigned _sp = 0; while (cond) { __builtin_amdgcn_s_sleep(1); \
    if ((++_sp & 255u) == 0u) { if (xb_ld(&(bar)[XB_TMO])) break; if (_sp > XB_SPIN_CAP) { atomicAdd(&(bar)[XB_TMO], 1u); break; } } } } while (0)
struct XcdBarrier { unsigned* bar; unsigned x; volatile LAS unsigned* st; };
__device__ __forceinline__ XcdBarrier xcd_barrier_post(unsigned* bar, volatile LAS unsigned* st) {
    XcdBarrier b; b.bar = bar; b.x = xb_xcc_id(); b.st = st;
    if (threadIdx.x == 0) (void)xb_add(&bar[XB_XCNT(b.x)], 1u);
    return b;
}
__device__ __forceinline__ void xcd_barrier_complete(unsigned* bar, unsigned x, unsigned& nloc, unsigned& nx) {
    const unsigned G = gridDim.x * gridDim.y * gridDim.z;
    unsigned sum, cnt, mine, sp = 0u;
    for (;;) {
        sum = 0u; cnt = 0u; mine = 0u;
#pragma unroll
        for (unsigned j = 0; j < 16; ++j) { const unsigned c = xb_ld(&bar[XB_XCNT(j)]); sum += c; cnt += (c > 0u) ? 1u : 0u; mine = (j == x) ? c : mine; }
        if (sum == G) break;
        __builtin_amdgcn_s_sleep(1);
        if ((++sp & 255u) == 0u) { if (xb_ld(&bar[XB_TMO])) break; if (sp > XB_SPIN_CAP) { atomicAdd(&bar[XB_TMO], 1u); break; } }
    }
    nloc = mine > 0u ? mine : 1u; nx = cnt > 0u ? cnt : 1u;
}
__device__ __forceinline__ void xcd_barrier(const XcdBarrier& b) {
    asm volatile("s_waitcnt vmcnt(0)" ::: "memory");
    __syncthreads();
    if (threadIdx.x == 0) {
        unsigned* bar = b.bar;
        __builtin_amdgcn_s_waitcnt(0);
        unsigned nloc = b.st[0], nx = b.st[1];
        if (nloc == 0u) { xcd_barrier_complete(bar, b.x, nloc, nx); b.st[0] = nloc; b.st[1] = nx; }
        const unsigned old = xb_add(&bar[XB_XSUB(b.x)], 1u);
        const unsigned gen = old / nloc;
        if (old + 1u == (gen + 1u) * nloc) {
            __builtin_amdgcn_fence(__ATOMIC_RELEASE, "agent");
            asm volatile("s_waitcnt vmcnt(0)" ::: "memory");
            const unsigned og = xb_add(&bar[XB_TOP], 1u);
            const unsigned tg = og / nx;
            if (og + 1u == (tg + 1u) * nx) xb_add(&bar[XB_TOPGEN], 1u);
            else XB_SPIN(xb_ld(&bar[XB_TOPGEN]) == tg, bar);
            __builtin_amdgcn_fence(__ATOMIC_ACQUIRE, "agent");
            xb_add(&bar[XB_XGEN(b.x)], 1u);
            asm volatile("s_waitcnt vmcnt(0)" ::: "memory");
        } else {
            XB_SPIN(xb_ld(&bar[XB_XGEN(b.x)]) == gen, bar);
            __builtin_amdgcn_fence(__ATOMIC_ACQUIRE, "agent");
            asm volatile("s_waitcnt vmcnt(0)" ::: "memory");
        }
    }
    __syncthreads();
}

struct Frame {
    LAS unsigned char* lds;
    int tid, lane, wave, G, bid;
    const float* in[28];
    float* out;
    unsigned char* ws;
};
#define WSP(type, off) ((type*)(F.ws + (off)))
enum { I_X = 0, I_G1, I_WIN, I_CONVW, I_CONVB, I_WA, I_BA, I_WI, I_BI, I_LAM, I_MU, I_W0, I_W2, I_A0, I_A2, I_G2, I_KK, I_KA, I_RK, I_LNW, I_LNB, I_WOUT, I_G2N, I_WQ, I_KEYS, I_U, I_V, I_GF };

__device__ __forceinline__ void p0_transpose_item(const float* W, int K, int N, bf16* WT, const float* ksc, LAS float* scr, int item, int lane) {
    const int nblk = N / 32, kb = item / nblk, nb = item % nblk, k0 = 64 * kb, n0 = 32 * nb;
    const int lr = lane >> 3, c4 = (lane & 7) * 4;
    f32x4 v[8];
#pragma unroll
    for (int i = 0; i < 8; ++i) v[i] = *(const f32x4*)(W + (size_t)(k0 + 8 * i + lr) * N + n0 + c4);
#pragma unroll
    for (int i = 0; i < 8; ++i) { const int kk = 8 * i + lr; const float sc = ksc ? ksc[k0 + kk] : 1.0f; LAS float* d = scr + kk * 33 + c4; d[0] = v[i][0] * sc; d[1] = v[i][1] * sc; d[2] = v[i][2] * sc; d[3] = v[i][3] * sc; }
    asm volatile("s_waitcnt lgkmcnt(0)" ::: "memory");
    const int c = lane & 7;
#pragma unroll
    for (int j = 0; j < 4; ++j) { const int n = (lane >> 3) + 8 * j; const LAS float* s = scr + (8 * c) * 33 + n;
        v4u o; o.x = pk2(s[0 * 33], s[1 * 33]); o.y = pk2(s[2 * 33], s[3 * 33]); o.z = pk2(s[4 * 33], s[5 * 33]); o.w = pk2(s[6 * 33], s[7 * 33]);
        *(v4u*)(WT + (size_t)(n0 + n) * K + k0 + 8 * c) = o; }
    asm volatile("s_waitcnt lgkmcnt(0)" ::: "memory");
}
__device__ __forceinline__ void p0_wquant_item(const float* W, int N, unsigned char* WT8, float* cs, const float* ksc, int item, int lane) {
    const int n0 = item * 8, r = lane >> 1, hf = lane & 1;
    const float* src = W + (size_t)(4 * r) * N + n0 + 4 * hf; const float* kp = ksc + 4 * r;
    f32x4 mx = (f32x4){0.f, 0.f, 0.f, 0.f};
#pragma unroll 2
    for (int i = 0; i < 16; ++i) { const f32x4 g4 = *(const f32x4*)(kp + 128 * i);
#pragma unroll
        for (int j = 0; j < 4; ++j) { const f32x4 v = *(const f32x4*)(src + (size_t)(128 * i + j) * N) * g4[j];
#pragma unroll
            for (int e = 0; e < 4; ++e) mx[e] = fmaxf(mx[e], fabsf(v[e])); } }
#pragma unroll
    for (int o = 2; o < 64; o <<= 1)
#pragma unroll
        for (int e = 0; e < 4; ++e) mx[e] = fmaxf(mx[e], __shfl_xor(mx[e], o));
    f32x4 q;
#pragma unroll
    for (int e = 0; e < 4; ++e) q[e] = mx[e] > 0.f ? 127.0f / mx[e] : 0.f;
    if (r == 0) *(f32x4*)(cs + n0 + 4 * hf) = mx * (1.0f / 127.0f);
    unsigned char* dst = WT8 + (size_t)(n0 + 4 * hf) * 2048 + 4 * r;
#pragma unroll 2
    for (int i = 0; i < 16; ++i) { const f32x4 g4 = *(const f32x4*)(kp + 128 * i); unsigned w[4] = {0u, 0u, 0u, 0u};
#pragma unroll
        for (int j = 0; j < 4; ++j) { const f32x4 v = *(const f32x4*)(src + (size_t)(128 * i + j) * N) * g4[j];
#pragma unroll
            for (int e = 0; e < 4; ++e) { const int qi = (int)rintf(v[e] * q[e]); w[e] |= ((unsigned)qi & 0xFFu) << (8 * j); } }
#pragma unroll
        for (int e = 0; e < 4; ++e) *(unsigned*)(dst + (size_t)e * 2048 + 128 * i) = w[e]; }
}
__device__ __forceinline__ void p0_small_transpose(const float* src, bf16* dst, int nb, int K, int N, int gt, int NGT) {
    const int tot = nb * K * N;
    for (int i = gt; i < tot; i += NGT) { const int bb = i / (K * N), r = i - bb * K * N, n = r / K, k = r - n * K; dst[i] = (bf16)f2bf(src[(size_t)bb * K * N + (size_t)k * N + n]); }
}
template <int PART> __device__ __forceinline__ void p0_prologue(const Frame& F, int vb, int VG) {
    LAS float* scr = (LAS float*)(F.lds + F.wave * 8448);
    const int gw = vb * NWAVES + F.wave, NGW = VG * NWAVES, gt = gw * 64 + F.lane, NGT = NGW * 64;
    constexpr int I1 = (D / 64) * (NIN / 32), I2 = (D / 64) * (D / 32);
    if (PART == 0) { for (int g3 = gw; g3 < 3 * (NIN / 8); g3 += NGW) if (g3 % 3 == 0) p0_wquant_item(F.in[I_WIN], NIN, WSP(unsigned char, WS_WIN), WSP(float, WS_CS1), F.in[I_G1], g3 / 3, F.lane); }
    else { for (int it = gw; it < 2 * I2; it += NGW) { if (it < I2) p0_transpose_item(F.in[I_WOUT], D, D, WSP(bf16, WS_WOUT), nullptr, scr, it, F.lane); else p0_transpose_item(F.in[I_WQ], D, D, WSP(bf16, WS_WQ), F.in[I_G2N], scr, it - I2, F.lane); } }
    if (PART == 0) {
    { v4u* z = (v4u*)(WSP(unsigned char, WS_WIN) + (size_t)NIN * D); const int nz = (NINP - NIN) * D / 16; for (int i = gt; i < nz; i += NGT) z[i] = (v4u){0u, 0u, 0u, 0u};
      for (int i = gt; i < NINP - NIN; i += NGT) WSP(float, WS_CS1)[NIN + i] = 0.f; }
    p0_small_transpose(F.in[I_W2], WSP(bf16, WS_W2T), 1, 64, 1024, gt, NGT);
    p0_small_transpose(F.in[I_A2], WSP(bf16, WS_A2T), 1, 64, 1024, gt, NGT);
    p0_small_transpose(F.in[I_G2], WSP(bf16, WS_G2T), 1, 160, 1024, gt, NGT);
    p0_small_transpose(F.in[I_WA], WSP(bf16, WS_WAT), 8, 128, 128, gt, NGT);
    p0_small_transpose(F.in[I_WI], WSP(bf16, WS_WIT), 8, 128, 128, gt, NGT);
    { const float* s = F.in[I_KEYS]; bf16* d = WSP(bf16, WS_KEYS); for (int i = gt; i < 8 * 2 * 128 * 128 / 8; i += NGT) { const f32x4 a = *(const f32x4*)(s + (size_t)i * 8), b = *(const f32x4*)(s + (size_t)i * 8 + 4);
        v4u o; o.x = pk2(a[0], a[1]); o.y = pk2(a[2], a[3]); o.z = pk2(b[0], b[1]); o.w = pk2(b[2], b[3]); *(v4u*)(d + (size_t)i * 8) = o; } }
    }
    if (PART == 1) {
    { const float* su = F.in[I_U]; const float* sv = F.in[I_V]; const float* g2 = F.in[I_G2N]; unsigned char* du = WSP(unsigned char, WS_UT); unsigned char* dv = WSP(unsigned char, WS_VT);
      float* usc = WSP(float, WS_USC); float* vsc = WSP(float, WS_VSC);
      f32x4 gg[2][4];
#pragma unroll
      for (int hh = 0; hh < 2; ++hh)
#pragma unroll
          for (int q = 0; q < 4; ++q) gg[hh][q] = *(const f32x4*)(g2 + hh * 1024 + F.lane * 16 + q * 4);
#define TBL_LOAD(U_, V_, row_) do { _Pragma("unroll") for (int hh_ = 0; hh_ < 2; ++hh_) _Pragma("unroll") for (int q_ = 0; q_ < 4; ++q_) { \
          U_[hh_][q_] = *(const f32x4*)(su + (size_t)(row_) * D + hh_ * 1024 + F.lane * 16 + q_ * 4); V_[hh_][q_] = *(const f32x4*)(sv + (size_t)(row_) * D + hh_ * 1024 + F.lane * 16 + q_ * 4); } } while (0)
#define TBL_QUANT(U_, V_, row_) do { float am_ = 0.f, vm_ = 0.f; \
          _Pragma("unroll") for (int hh_ = 0; hh_ < 2; ++hh_) _Pragma("unroll") for (int q_ = 0; q_ < 4; ++q_) { U_[hh_][q_] = U_[hh_][q_] * gg[hh_][q_]; \
              _Pragma("unroll") for (int e_ = 0; e_ < 4; ++e_) { am_ = fmaxf(am_, fabsf(U_[hh_][q_][e_])); vm_ = fmaxf(vm_, fabsf(V_[hh_][q_][e_])); } } \
          _Pragma("unroll") for (int o_ = 1; o_ < 64; o_ <<= 1) { am_ = fmaxf(am_, __shfl_xor(am_, o_)); vm_ = fmaxf(vm_, __shfl_xor(vm_, o_)); } \
          const float uq_ = am_ > 0.f ? 127.0f / am_ : 0.f, vq_ = vm_ > 0.f ? 127.0f / vm_ : 0.f; \
          if (F.lane == 0) { usc[row_] = am_ * (1.0f / 127.0f); vsc[row_] = vm_ * (1.0f / 127.0f); } \
          _Pragma("unroll") for (int hh_ = 0; hh_ < 2; ++hh_) { v4u ou_, ov_; \
              _Pragma("unroll") for (int q_ = 0; q_ < 4; ++q_) { unsigned w_ = 0u, wv_ = 0u; \
                  _Pragma("unroll") for (int e_ = 0; e_ < 4; ++e_) { const int qi_ = (int)rintf(U_[hh_][q_][e_] * uq_); w_ |= ((unsigned)qi_ & 0xFFu) << (8 * e_); const int qv_ = (int)rintf(V_[hh_][q_][e_] * vq_); wv_ |= ((unsigned)qv_ & 0xFFu) << (8 * e_); } \
                  ou_[q_] = w_; ov_[q_] = wv_; } \
              *(v4u*)(du + (size_t)(row_) * D + hh_ * 1024 + F.lane * 16) = ou_; *(v4u*)(dv + (size_t)(row_) * D + hh_ * 1024 + F.lane * 16) = ov_; } } while (0)
      for (int row = gw; row < NEXP; row += 2 * NGW) {
          const int rowB = row + NGW < NEXP ? row + NGW : row;
          f32x4 ua[2][4], va[2][4], ub[2][4], vb2[2][4];
          TBL_LOAD(ua, va, row); TBL_LOAD(ub, vb2, rowB);
          TBL_QUANT(ua, va, row);
          if (rowB != row) TBL_QUANT(ub, vb2, rowB);
      }
#undef TBL_LOAD
#undef TBL_QUANT
    }
    }
    if (PART == 0) {
    { const float* x = F.in[I_X]; unsigned char* xq = WSP(unsigned char, WS_XB); float* rs1 = WSP(float, WS_RSTD1);
#define XR_LOAD(V_, row_) do { _Pragma("unroll") for (int hh_ = 0; hh_ < 2; ++hh_) _Pragma("unroll") for (int q_ = 0; q_ < 4; ++q_) V_[hh_][q_] = *(const f32x4*)(x + (size_t)(row_) * D + hh_ * 1024 + F.lane * 16 + q_ * 4); } while (0)
#define XR_QUANT(V_, row_) do { float s_ = 0.f, am_ = 0.f; \
          _Pragma("unroll") for (int hh_ = 0; hh_ < 2; ++hh_) _Pragma("unroll") for (int q_ = 0; q_ < 4; ++q_) _Pragma("unroll") for (int e_ = 0; e_ < 4; ++e_) { const float t_ = V_[hh_][q_][e_]; s_ += t_ * t_; am_ = fmaxf(am_, fabsf(t_)); } \
          s_ = wave_sum(s_); \
          _Pragma("unroll") for (int o_ = 1; o_ < 64; o_ <<= 1) am_ = fmaxf(am_, __shfl_xor(am_, o_)); \
          const float xq_ = am_ > 0.f ? 127.0f / am_ : 0.f; \
          if (F.lane == 0) rs1[row_] = am_ * (1.0f / 127.0f) / sqrtf(s_ * (1.0f / D) + NORM_EPS); \
          _Pragma("unroll") for (int hh_ = 0; hh_ < 2; ++hh_) { v4u o_; \
              _Pragma("unroll") for (int q_ = 0; q_ < 4; ++q_) { unsigned w_ = 0u; \
                  _Pragma("unroll") for (int e_ = 0; e_ < 4; ++e_) { const int qi_ = (int)rintf(V_[hh_][q_][e_] * xq_); w_ |= ((unsigned)qi_ & 0xFFu) << (8 * e_); } \
                  o_[q_] = w_; } \
              *(v4u*)(xq + (size_t)(row_) * D + hh_ * 1024 + F.lane * 16) = o_; } } while (0)
      for (int m = gw; m < T; m += 2 * NGW) { const int mB = m + NGW < T ? m + NGW : m;
          f32x4 xa[2][4], xb2[2][4];
          XR_LOAD(xa, m); XR_LOAD(xb2, mB);
          XR_QUANT(xa, m);
          if (mB != m) XR_QUANT(xb2, mB); }
#undef XR_LOAD
#undef XR_QUANT
    }
    }
}

typedef float f32x2c __attribute__((ext_vector_type(2)));
__device__ __forceinline__ unsigned cvtpk(float lo, float hi) { const f32x2c v = {lo, hi}; const bf16x2_t b = __builtin_convertvector(v, bf16x2_t); return __builtin_bit_cast(unsigned, b); }
__device__ __forceinline__ float rcpf_(float x) { return __builtin_amdgcn_rcpf(x); }
__device__ __forceinline__ float sigmoid_fast(float x) { return rcpf_(1.0f + __expf(-x)); }
__device__ __forceinline__ float tanh_fast(float x) { return 1.0f - 2.0f * rcpf_(1.0f + __expf(2.0f * x)); }
__device__ __forceinline__ float softplus_fast(float z) { return fmaxf(z, 0.f) + __logf(1.0f + __expf(-fabsf(z))); }
__device__ __forceinline__ float gelu_fast(float x) { const float u = 0.7978845608028654f * (x + 0.044715f * x * x * x); return x * rcpf_(1.0f + __expf(-2.0f * u)); }
__device__ __forceinline__ void rwkv_prep_unit(const Frame& F, int chunk, int h, int lane, const LAS bf16* WL2, const LAS bf16* AL2, const LAS bf16* GL2, const LAS float* CW, LAS bf16* ST) {
    asm volatile("" : "+v"(lane));
    const int fr = lane & 15, fq = lane >> 4;
    const bf16* PROJ = WSP(bf16, WS_PROJ); const bf16* LA = WSP(bf16, WS_LA);
    bf16* TA = WSP(bf16, WS_TA); bf16* TB = WSP(bf16, WS_TB); bf16* TK = WSP(bf16, WS_TK); bf16* TR = WSP(bf16, WS_TR);
    bf16* TV = (bf16*)F.out + OUT_TV / 2; bf16* TG = (bf16*)F.out + OUT_TG / 2; float* PCG = F.out + OUT_PC / 4; float* BONG = F.out + OUT_BON / 4;
#define PU4(w_) ((f32x4){bf_lo((w_).x), bf_hi((w_).x), bf_lo((w_).y), bf_hi((w_).y)})
    size_t tokm[2]; int pom[2]; unsigned pmm[2];
#pragma unroll
    for (int mt = 0; mt < 2; ++mt) { tokm[mt] = (size_t)chunk * 32 + mt * 16 + fr; const bool hasp = ((chunk & 63) * 32 + mt * 16 + fr) > 0; pom[mt] = hasp ? NINP : 0; pmm[mt] = hasp ? 0xffffffffu : 0u; }
    float inv[2], bn[2];
#pragma unroll
    for (int mt = 0; mt < 2; ++mt) { float s2 = 0.f;
#pragma unroll
        for (int nt = 0; nt < 4; ++nt) { const int j4 = nt * 16 + fq * 4; const bf16* pr = PROJ + tokm[mt] * NINP + PC_K + h * 64 + j4;
            const v2u kc = *(const v2u*)pr; v2u kp = *(const v2u*)(pr - pom[mt]); kp.x &= pmm[mt]; kp.y &= pmm[mt];
            const f32x4 c_kk = *(const LAS f32x4*)(CW + 128 + j4), m_k = *(const LAS f32x4*)(CW + 384 + j4);
            const f32x4 kcf = PU4(kc); const f32x4 ku = (kcf + (PU4(kp) - kcf) * m_k) * c_kk; s2 += (ku[0] * ku[0] + ku[1] * ku[1]) + (ku[2] * ku[2] + ku[3] * ku[3]); }
        { auto x = __builtin_amdgcn_permlane16_swap(__float_as_uint(s2), __float_as_uint(s2), false, false); s2 = __uint_as_float(x[0]) + __uint_as_float(x[1]); }
        { auto x = __builtin_amdgcn_permlane32_swap(__float_as_uint(s2), __float_as_uint(s2), false, false); s2 = __uint_as_float(x[0]) + __uint_as_float(x[1]); }
        inv[mt] = __builtin_amdgcn_rsqf(fmaxf(s2, 1e-24f)); bn[mt] = 0.f; }
    v2u cur_[3], prv_[3], ncur_[3], nprv_[3];
#define PREP_LOAD_RKV(C_, P_, st_) do { const int mt_ = (st_) >> 2, nt_ = (st_) & 3; const bf16* pr_ = PROJ + tokm[mt_] * NINP + PC_R + h * 64 + nt_ * 16 + fq * 4; \
        _Pragma("unroll") for (int q_ = 0; q_ < 3; ++q_) { C_[q_] = *(const v2u*)(pr_ + q_ * 1024); P_[q_] = *(const v2u*)(pr_ + q_ * 1024 - pom[mt_]); } } while (0)
    PREP_LOAD_RKV(cur_, prv_, 0);
    f32x4 tot0[4];
#pragma unroll
    for (int n = 0; n < 4; ++n) tot0[n] = (f32x4){0.f, 0.f, 0.f, 0.f};
    bf16x8 la[9];
#pragma unroll
    for (int st = 0; st < 8; ++st) { const int mt = st >> 2, nt = st & 3; const int j4 = nt * 16 + fq * 4; const size_t col = (size_t)h * 64 + j4;
        if (nt == 0) {
#pragma unroll
            for (int ks = 0; ks < 9; ++ks) la[ks] = *(const bf16x8*)(LA + tokm[mt] * 288 + ks * 32 + 8 * fq); }
        if (st < 7) PREP_LOAD_RKV(ncur_, nprv_, st + 1);
        f32x4 cw = (f32x4){0.f, 0.f, 0.f, 0.f}, ca = cw, cg = cw;
#pragma unroll
        for (int ks = 0; ks < 2; ++ks) { cw = MFMA16(*(const LAS bf16x8*)(WL2 + (nt * 16 + fr) * 72 + ks * 32 + 8 * fq), la[ks], cw); ca = MFMA16(*(const LAS bf16x8*)(AL2 + (nt * 16 + fr) * 72 + ks * 32 + 8 * fq), la[2 + ks], ca); }
#pragma unroll
        for (int ks = 0; ks < 5; ++ks) cg = MFMA16(*(const LAS bf16x8*)(GL2 + (nt * 16 + fr) * 168 + ks * 32 + 8 * fq), la[4 + ks], cg);
        const f32x4 c_w0 = *(const LAS f32x4*)(CW + j4), c_a0 = *(const LAS f32x4*)(CW + 64 + j4), c_kk = *(const LAS f32x4*)(CW + 128 + j4), c_ka = *(const LAS f32x4*)(CW + 192 + j4), c_rk = *(const LAS f32x4*)(CW + 256 + j4);
        const f32x4 m_r = *(const LAS f32x4*)(CW + 320 + j4), m_k = *(const LAS f32x4*)(CW + 384 + j4), m_v = *(const LAS f32x4*)(CW + 448 + j4);
        v2u rp = prv_[0], kp = prv_[1], vp = prv_[2]; const unsigned pm = pmm[mt];
        rp.x &= pm; rp.y &= pm; kp.x &= pm; kp.y &= pm; vp.x &= pm; vp.y &= pm;
        const f32x4 rcf = PU4(cur_[0]), kcf = PU4(cur_[1]), vcf = PU4(cur_[2]);
        const f32x4 rr = rcf + (PU4(rp) - rcf) * m_r, kv = kcf + (PU4(kp) - kcf) * m_k, vv = vcf + (PU4(vp) - vcf) * m_v;
        f32x4 nau, bbu, km, cum;
#pragma unroll
        for (int r = 0; r < 4; ++r) { const float av = sigmoid_fast(c_a0[r] + ca[r]), ku = kv[r] * c_kk[r]; km[r] = kv[r] * (1.0f + (av - 1.0f) * c_ka[r]);
            cum[r] = -0.6065306597126334f * sigmoid_fast(c_w0[r] + cw[r]);
            nau[r] = -ku; bbu[r] = ku * av; bn[mt] += rr[r] * km[r] * c_rk[r]; }
        f32x4 at4, rt4, bt4, kt4, ep4;
#pragma unroll
        for (int r = 0; r < 4; ++r) { float v = cum[r];
            v += __builtin_bit_cast(float, __builtin_amdgcn_update_dpp(0, __builtin_bit_cast(int, v), 0x111, 0xf, 0xf, true));
            v += __builtin_bit_cast(float, __builtin_amdgcn_update_dpp(0, __builtin_bit_cast(int, v), 0x112, 0xf, 0xf, true));
            v += __builtin_bit_cast(float, __builtin_amdgcn_update_dpp(0, __builtin_bit_cast(int, v), 0x114, 0xf, 0xf, true));
            v += __builtin_bit_cast(float, __builtin_amdgcn_update_dpp(0, __builtin_bit_cast(int, v), 0x118, 0xf, 0xf, true));
            if (mt == 0) tot0[nt][r] = __shfl(v, (lane & 48) | 15); else v += tot0[nt][r];
            const float ep = __expf(v), em = rcpf_(ep);
            float eprev = __builtin_bit_cast(float, __builtin_amdgcn_update_dpp(0, __builtin_bit_cast(int, ep), 0x111, 0xf, 0xf, true));
            if (fr == 0) eprev = mt ? __expf(tot0[nt][r]) : 1.0f;
            at4[r] = nau[r] * inv[mt] * eprev; rt4[r] = rr[r] * ep; bt4[r] = bbu[r] * inv[mt] * em; kt4[r] = km[r] * em; ep4[r] = ep; }
        { LAS bf16* sp = ST + fr * 64 + j4; v2u w;
          w.x = cvtpk(at4[0], at4[1]); w.y = cvtpk(at4[2], at4[3]); *(LAS v2u*)(sp) = w;
          w.x = cvtpk(rt4[0], rt4[1]); w.y = cvtpk(rt4[2], rt4[3]); *(LAS v2u*)(sp + 1024) = w;
          w.x = cvtpk(bt4[0], bt4[1]); w.y = cvtpk(bt4[2], bt4[3]); *(LAS v2u*)(sp + 2048) = w;
          w.x = cvtpk(kt4[0], kt4[1]); w.y = cvtpk(kt4[2], kt4[3]); *(LAS v2u*)(sp + 3072) = w;
          w.x = cvtpk(vv[0], vv[1]); w.y = cvtpk(vv[2], vv[3]); *(LAS v2u*)(sp + 4096) = w;
          w.x = cvtpk(cg[0], cg[1]); w.y = cvtpk(cg[2], cg[3]); *(LAS v2u*)(sp + 5120) = w; }
        if (nt == 3) {
            bf16* const dstp[6] = {TA, TR, TB, TK, TV, TG};
#pragma unroll
            for (int a6 = 0; a6 < 6; ++a6)
#pragma unroll
                for (int hrow = 0; hrow < 2; ++hrow) { const int row = hrow * 8 + (lane >> 3), c8 = (lane & 7) * 8;
                    const v4u pv = *(const LAS v4u*)(ST + a6 * 1024 + row * 64 + c8);
                    *(v4u*)(dstp[a6] + ((size_t)chunk * 32 + mt * 16 + row) * 1024 + (size_t)h * 64 + c8) = pv; } }
        if (mt == 1 && fr == 15) *(f32x4*)(PCG + (size_t)chunk * 1024 + col) = ep4;
#pragma unroll
        for (int q = 0; q < 3; ++q) { cur_[q] = ncur_[q]; prv_[q] = nprv_[q]; }
    }
#undef PREP_LOAD_RKV
#undef PU4
#pragma unroll
    for (int mt = 0; mt < 2; ++mt) { float b2 = bn[mt];
        { auto x = __builtin_amdgcn_permlane16_swap(__float_as_uint(b2), __float_as_uint(b2), false, false); b2 = __uint_as_float(x[0]) + __uint_as_float(x[1]); }
        { auto x = __builtin_amdgcn_permlane32_swap(__float_as_uint(b2), __float_as_uint(b2), false, false); b2 = __uint_as_float(x[0]) + __uint_as_float(x[1]); }
        if (fq == 0) BONG[tokm[mt] * 16 + h] = b2; }
}
__device__ __forceinline__ void rwkv_prep_phase(const Frame& F) {
    LAS bf16* WL2 = (LAS bf16*)(F.lds + 0); LAS bf16* AL2 = (LAS bf16*)(F.lds + 9216); LAS bf16* GL2 = (LAS bf16*)(F.lds + 18432); LAS float* CW = (LAS float*)(F.lds + 39936);
    int hcur = -1;
    for (int u = F.bid; u < 1024; u += F.G) { const int h = u & 15, cg = u >> 4;
        if (h != hcur) { hcur = h; __syncthreads();
            int tid_ = F.tid; asm volatile("" : "+v"(tid_));
            const bf16* w2t = WSP(bf16, WS_W2T) + (size_t)h * 64 * 64; const bf16* a2t = WSP(bf16, WS_A2T) + (size_t)h * 64 * 64; const bf16* g2t = WSP(bf16, WS_G2T) + (size_t)h * 64 * 160;
            { const int r = tid_ >> 3, c = (tid_ & 7) * 8; *(LAS v4u*)(WL2 + r * 72 + c) = *(const v4u*)(w2t + r * 64 + c); *(LAS v4u*)(AL2 + r * 72 + c) = *(const v4u*)(a2t + r * 64 + c); }
            for (int i = tid_; i < 64 * 20; i += NTHR) { const int r = i / 20, c = (i - r * 20) * 8; *(LAS v4u*)(GL2 + r * 168 + c) = *(const v4u*)(g2t + r * 160 + c); }
            { const int q = tid_ >> 6, jj = tid_ & 63; const float* src = q == 0 ? F.in[I_W0] : (q == 1 ? F.in[I_A0] : (q == 2 ? F.in[I_KK] : (q == 3 ? F.in[I_KA] : (q == 4 ? F.in[I_RK] : F.in[I_MU] + (q - 5) * 1024)))); CW[q * 64 + jj] = src[h * 64 + jj]; }
            __syncthreads(); }
        rwkv_prep_unit(F, cg * 8 + F.wave, h, F.lane, WL2, AL2, GL2, CW, (LAS bf16*)(F.lds + 43008 + F.wave * 12288)); }
    __syncthreads();
}
typedef short v4i16_t __attribute__((ext_vector_type(4)));
__device__ __forceinline__ bf16x8 frag_tr16(const LAS bf16* p, int ld) {
    const v4i16_t a = __builtin_amdgcn_ds_read_tr16_b64_v4i16((LAS v4i16_t*)p), b = __builtin_amdgcn_ds_read_tr16_b64_v4i16((LAS v4i16_t*)(p + 4 * ld));
    return (bf16x8){a[0], a[1], a[2], a[3], b[0], b[1], b[2], b[3]};
}
__device__ __forceinline__ void rwkv_item(const Frame& F, int item) {
    const int b = item >> 4, h = item & 15, wave = F.wave; int tid = F.tid; asm volatile("" : "+v"(tid)); const int lane = tid & 63;
    LAS unsigned char* L = F.lds;
    constexpr int LD64 = 72, LD32 = 40, E0 = 73216;
    LAS bf16* AT = (LAS bf16*)(L + 0);  LAS bf16* BT_ = (LAS bf16*)(L + 4608); LAS bf16* KT_ = (LAS bf16*)(L + 9216); LAS bf16* RT = (LAS bf16*)(L + 13824);
    LAS bf16* VS2 = (LAS bf16*)(L + 18432);
    LAS bf16* GGB2 = (LAS bf16*)(L + 27648);
    LAS bf16* S0B = (LAS bf16*)(L + 36864);
    LAS float* YB2 = (LAS float*)(L + 55296);
    LAS float* BON2 = (LAS float*)(L + 72704);
    LAS float* PC = (LAS float*)(L + 72960);
    LAS bf16* AAK = (LAS bf16*)(L + E0); LAS bf16* ARB = (LAS bf16*)(L + E0 + 2560); LAS bf16* ARK = (LAS bf16*)(L + E0 + 5120);
    LAS bf16* XB_ = (LAS bf16*)(L + E0 + 7680);
    LAS bf16* XTB = (LAS bf16*)(L + E0 + 12800);
    LAS bf16* PMB = (LAS bf16*)(L + E0 + 17920);
    LAS bf16* RHS = (LAS bf16*)(L + E0 + 23040);
    LAS bf16* SAB = (LAS bf16*)(L + E0 + 28160);
    static_assert(E0 + 33280 <= LDSCTL_OFF, "rwkv LDS map");
    bf16* Y = WSP(bf16, WS_Y);
#define FRAG(base, row0, ld, ks) (*(const LAS bf16x8*)((base) + ((row0) + fr) * (ld) + (ks) * 32 + 8 * fq))
#define FRAGT(base, col0, ld) frag_tr16((base) + (8 * fq + (fr >> 2)) * (ld) + (col0) + 4 * (fr & 3), (ld))
    const int tt = tid >> 4, j0 = (tid & 15) * 4, hc = h * 64 + j0;
    const f32x4 plw = *(const f32x4*)(F.in[I_LNW] + hc), plb = *(const f32x4*)(F.in[I_LNB] + hc);
    const int lr = (tid & 255) >> 3, lc8 = tid & 7; const bool hi2 = tid >= 256;
    const bf16* srcA[3] = { (hi2 ? WSP(bf16, WS_TR) : WSP(bf16, WS_TA)), (hi2 ? WSP(bf16, WS_TK) : WSP(bf16, WS_TB)), (hi2 ? (const bf16*)F.out + OUT_TG / 2 : (const bf16*)F.out + OUT_TV / 2) };
    const size_t poff = ((size_t)b * SEQ + lr) * 1024 + h * 64 + lc8 * 8;
    const float* PCG = F.out + OUT_PC / 4 + (size_t)(b * 64) * 1024 + h * 64; const float* BONG = F.out + OUT_BON / 4 + (size_t)b * SEQ * 16 + h;
    v4u pl_[3]; float ppc = 0.f, pbn = 0.f;
#define RWKV_PREFETCH(tl_) do { _Pragma("unroll") for (int q_ = 0; q_ < 3; ++q_) pl_[q_] = *(const v4u*)(srcA[q_] + poff + (size_t)(tl_) * 32 * 1024); \
        ppc = PCG[(size_t)(tl_) * 1024 + (tid & 63)]; pbn = BONG[((size_t)(tl_) * 32 + (tid & 31)) * 16]; } while (0)
    const int ib = wave >> 1, tb = wave & 1, i0 = ib * 16, t0m = tb * 16;
    f32x4 sacc[2], pmacc, yacc;
    sacc[0] = (f32x4){0.f, 0.f, 0.f, 0.f}; sacc[1] = sacc[0]; pmacc = sacc[0]; yacc = sacc[0];
    for (int u = tid; u < 2 * 64 * LD64 / 2; u += NTHR) ((LAS unsigned*)S0B)[u] = 0u;
    RWKV_PREFETCH(0);
    __syncthreads();
    for (int tl = 0; tl <= SEQ / 32; ++tl) {
        const int cur = tl & 1;
        int lane_c = lane; asm volatile("" : "+v"(lane_c)); const int fr = lane_c & 15, fq = lane_c >> 4;
        LAS bf16* VS = VS2 + cur * 32 * LD64; LAS bf16* GGB = GGB2 + cur * 32 * LD64; LAS float* YB = YB2 + cur * 32 * 68; LAS float* BON = BON2 + cur * 32;
        const LAS bf16* VSp = VS2 + (cur ^ 1) * 32 * LD64; const LAS bf16* GGBp = GGB2 + (cur ^ 1) * 32 * LD64; const LAS float* YBp = YB2 + (cur ^ 1) * 32 * 68; const LAS float* BONp = BON2 + (cur ^ 1) * 32;
        if (tl > 0) { const size_t tokb = (size_t)b * SEQ + (tl - 1) * 32;
          const f32x4 y4 = *(const LAS f32x4*)(YBp + tt * 68 + j0); const v2u gw_ = *(const LAS v2u*)(GGBp + tt * LD64 + j0);
          const f32x4 g4 = (f32x4){bf_lo(gw_.x), bf_hi(gw_.x), bf_lo(gw_.y), bf_hi(gw_.y)};
          const v2u vw_ = *(const LAS v2u*)(VSp + tt * LD64 + j0); const f32x4 v4 = (f32x4){bf_lo(vw_.x), bf_hi(vw_.x), bf_lo(vw_.y), bf_hi(vw_.y)};
          float sm = (y4[0] + y4[1]) + (y4[2] + y4[3]); sm = red16(sm); const float mean = sm * (1.0f / 64.0f);
          const f32x4 d4 = y4 - mean; float sv = (d4[0] * d4[0] + d4[1] * d4[1]) + (d4[2] * d4[2] + d4[3] * d4[3]); sv = red16(sv);
          const float rstd = __builtin_amdgcn_rsqf(sv * (1.0f / 64.0f) + GN_EPS), bon = BONp[tt];
          f32x4 o;
#pragma unroll
          for (int e = 0; e < 4; ++e) o[e] = (d4[e] * rstd * plw[e] + plb[e] + bon * v4[e]) * g4[e];
          v2u w; w.x = cvtpk(o[0], o[1]); w.y = cvtpk(o[2], o[3]);
          *(v2u*)(Y + (tokb + tt) * D + 1024 + hc) = w; }
        if (tl == SEQ / 32) break;
        const LAS bf16* S0c = S0B + cur * 64 * LD64; LAS bf16* S0n = S0B + (cur ^ 1) * 64 * LD64;
        { const v4u p0 = pl_[0], p1 = pl_[1], p2 = pl_[2];
          *(LAS v4u*)((hi2 ? RT : AT) + lr * LD64 + lc8 * 8) = p0;
          *(LAS v4u*)((hi2 ? KT_ : BT_) + lr * LD64 + lc8 * 8) = p1;
          *(LAS v4u*)((hi2 ? GGB : VS) + lr * LD64 + lc8 * 8) = p2;
          if (tid < 64) PC[tid] = ppc;
          if (tid >= 64 && tid < 96) BON[tid - 64] = pbn; }
        { const int tn_ = tl + 1 < SEQ / 32 ? tl + 1 : SEQ / 32 - 1; RWKV_PREFETCH(tn_); }
        __syncthreads();
        { const int q = wave & 3, tq = (q >> 1) * 16, sq = (q & 1) * 16; const bool zt = sq > tq;
#pragma unroll
            for (int mi = 0; mi < 2; ++mi) { const int mtx = (wave < 4) ? mi : 2; if (wave >= 4 && mi == 1) break;
                const LAS bf16* Xs = (mtx == 1) ? BT_ : KT_; const LAS bf16* Yt = (mtx == 0) ? AT : RT; LAS bf16* O = (mtx == 0) ? AAK : (mtx == 1 ? ARB : ARK);
                f32x4 a4 = (f32x4){0.f, 0.f, 0.f, 0.f};
                if (!zt) {
#pragma unroll
                    for (int ks = 0; ks < 2; ++ks) a4 = MFMA16(FRAG(Xs, sq, LD64, ks), FRAG(Yt, tq, LD64, ks), a4); }
                const int t = tq + fr, s = sq + fq * 4;
#pragma unroll
                for (int r = 0; r < 4; ++r) { const bool keep = (mtx == 0) ? (s + r < t) : (s + r <= t); a4[r] = keep ? a4[r] : 0.f; }
                v2u w; w.x = cvtpk(a4[0], a4[1]); w.y = cvtpk(a4[2], a4[3]); *(LAS v2u*)(O + t * LD32 + s) = w; } }
        if (wave >= 4) { const int q = wave - 4, tq = (q >> 1) * 16, sq = (q & 1) * 16;
            f32x4 a4 = (f32x4){0.f, 0.f, 0.f, 0.f};
            if (sq <= tq) {
#pragma unroll
            for (int ks = 0; ks < 2; ++ks) a4 = MFMA16(FRAG(BT_, sq, LD64, ks), FRAG(AT, tq, LD64, ks), a4); }
            const int t = tq + fr, s = sq + fq * 4;
#pragma unroll
            for (int r = 0; r < 4; ++r) { a4[r] = (s + r < t) ? a4[r] : 0.f; XTB[(s + r) * LD32 + t] = (bf16)(cvtpk(a4[r], 0.f) & 0xffffu); }
            v2u w; w.x = cvtpk(a4[0], a4[1]); w.y = cvtpk(a4[2], a4[3]); *(LAS v2u*)(XB_ + t * LD32 + s) = w;
#pragma unroll
            for (int r = 0; r < 4; ++r) pmacc[r] = a4[r] + ((s + r == t) ? 1.0f : 0.f);
            w.x = cvtpk(pmacc[0], pmacc[1]); w.y = cvtpk(pmacc[2], pmacc[3]); *(LAS v2u*)(PMB + t * LD32 + s) = w; }
        __syncthreads();
#pragma unroll
        for (int ns = 0; ns < 5; ++ns) { const int cb = ns & 1, nb = cb ^ 1;
            const LAS bf16* Xc = XB_ + cb * 32 * LD32; const LAS bf16* XTc = XTB + cb * 32 * LD32; const LAS bf16* Pc = PMB + cb * 32 * LD32;
            LAS bf16* Xn = XB_ + nb * 32 * LD32; LAS bf16* XTn = XTB + nb * 32 * LD32; LAS bf16* Pn = PMB + nb * 32 * LD32;
            if (wave < 4) { if (ns < 4) { const int tq = (wave >> 1) * 16, sq = (wave & 1) * 16;
                    f32x4 a4 = (f32x4){0.f, 0.f, 0.f, 0.f}; a4 = MFMA16(FRAG(XTc, sq, LD32, 0), FRAG(Xc, tq, LD32, 0), a4);
                    const int t = tq + fr, s = sq + fq * 4;
#pragma unroll
                    for (int r = 0; r < 4; ++r) XTn[(s + r) * LD32 + t] = (bf16)(cvtpk(a4[r], 0.f) & 0xffffu);
                    v2u w; w.x = cvtpk(a4[0], a4[1]); w.y = cvtpk(a4[2], a4[3]); *(LAS v2u*)(Xn + t * LD32 + s) = w; } }
            else { const int q = wave - 4, tq = (q >> 1) * 16, sq = (q & 1) * 16;
                if (ns > 0) pmacc = MFMA16(FRAG(XTc, sq, LD32, 0), FRAG(Pc, tq, LD32, 0), pmacc);
                const int t = tq + fr, s = sq + fq * 4;
                v2u w; w.x = cvtpk(pmacc[0], pmacc[1]); w.y = cvtpk(pmacc[2], pmacc[3]); *(LAS v2u*)(Pn + t * LD32 + s) = w; }
            if (ns == 1) {
                f32x4 a4 = (f32x4){0.f, 0.f, 0.f, 0.f};
#pragma unroll
                for (int ks = 0; ks < 2; ++ks) a4 = MFMA16(FRAG(AT, t0m, LD64, ks), FRAG(S0c, i0, LD64, ks), a4);
                a4 = MFMA16(FRAG(AAK, t0m, LD32, 0), FRAGT(VS, i0, LD64), a4);
                v2u w; w.x = cvtpk(a4[0], a4[1]); w.y = cvtpk(a4[2], a4[3]); *(LAS v2u*)(RHS + (i0 + fr) * LD32 + t0m + fq * 4) = w; }
            if (ns == 2) {
                yacc = (f32x4){0.f, 0.f, 0.f, 0.f};
#pragma unroll
                for (int ks = 0; ks < 2; ++ks) yacc = MFMA16(FRAG(S0c, i0, LD64, ks), FRAG(RT, t0m, LD64, ks), yacc);
                yacc = MFMA16(FRAGT(VS, i0, LD64), FRAG(ARK, t0m, LD32, 0), yacc); }
            if (ns == 3) {
#pragma unroll
                for (int u = 0; u < 2; ++u) { const int tile = wave * 2 + u, si0 = (tile >> 2) * 16, sj0 = (tile & 3) * 16; sacc[u] = MFMA16(FRAGT(KT_, sj0, LD64), FRAGT(VS, si0, LD64), sacc[u]); } }
            __syncthreads();
        }
        const LAS bf16* MINV = PMB + 1 * 32 * LD32;
        { f32x4 a4 = (f32x4){0.f, 0.f, 0.f, 0.f}; a4 = MFMA16(FRAG(MINV, t0m, LD32, 0), FRAG(RHS, i0, LD32, 0), a4);
          v2u w; w.x = cvtpk(a4[0], a4[1]); w.y = cvtpk(a4[2], a4[3]); *(LAS v2u*)(SAB + (i0 + fr) * LD32 + t0m + fq * 4) = w; }
        __syncthreads();
        { yacc = MFMA16(FRAG(SAB, i0, LD32, 0), FRAG(ARB, t0m, LD32, 0), yacc);
          *(LAS f32x4*)(YB + (t0m + fr) * 68 + i0 + fq * 4) = yacc;
#pragma unroll
          for (int u = 0; u < 2; ++u) { const int tile = wave * 2 + u, si0 = (tile >> 2) * 16, sj0 = (tile & 3) * 16;
              sacc[u] = MFMA16(FRAGT(BT_, sj0, LD64), FRAG(SAB, si0, LD32, 0), sacc[u]);
              const f32x4 pc = *(const LAS f32x4*)(PC + sj0 + fq * 4); sacc[u] = sacc[u] * pc;
              v2u w; w.x = cvtpk(sacc[u][0], sacc[u][1]); w.y = cvtpk(sacc[u][2], sacc[u][3]); *(LAS v2u*)(S0n + (si0 + fr) * LD64 + sj0 + fq * 4) = w; } }
        __syncthreads();
    }
    __syncthreads();
#undef FRAG
#undef FRAGT
#undef RWKV_PREFETCH
}
__device__ __forceinline__ void lora_prepass(const Frame& F) {
    const bf16* PROJ = WSP(bf16, WS_PROJ); bf16* LA = WSP(bf16, WS_LA); const float* mu = F.in[I_MU] + (PC_WD - RWKV_C0);
    const int gt = (F.bid * NWAVES + F.wave) * 64 + F.lane, NGT = F.G * NTHR;
    for (int i = gt; i < T * 36; i += NGT) { const int tok = i / 36, cc = i - tok * 36, m = cc * 8;
        const bf16* pr = PROJ + (size_t)tok * NINP + PC_WD + m;
        const v4u curv = *(const v4u*)pr; v4u prv = (v4u){0u, 0u, 0u, 0u}; if ((tok & (SEQ - 1)) != 0) prv = *(const v4u*)(pr - NINP);
        const f32x4 m0 = *(const f32x4*)(mu + m), m1 = *(const f32x4*)(mu + m + 4);
        float c[8], p[8], o[8]; unpack8(curv, c); unpack8(prv, p);
#pragma unroll
        for (int e = 0; e < 8; ++e) { const float ps = c[e] + (p[e] - c[e]) * (e < 4 ? m0[e] : m1[e - 4]); o[e] = (m < 64) ? tanh_fast(ps) : ((m < 128) ? ps : sigmoid_fast(ps)); }
        v4u w; w.x = cvtpk(o[0], o[1]); w.y = cvtpk(o[2], o[3]); w.z = cvtpk(o[4], o[5]); w.w = cvtpk(o[6], o[7]);
        *(v4u*)(LA + (size_t)tok * 288 + m) = w; }
}
__device__ __forceinline__ void lru_seq(const Frame& F, int bh) {
    const int b = bh >> 3, h = bh & 7, wave = F.wave; int tid = F.tid; asm volatile("" : "+v"(tid)); const int lane = tid & 63;
    LAS unsigned char* L = F.lds;
    LAS bf16* XA = (LAS bf16*)(L + 0);
    LAS float* XC = (LAS float*)(L + 17408);
    LAS float* RI = (LAS float*)(L + 50176);
    LAS float* SEG = (LAS float*)(L + 115712);
    LAS float* CARRY = (LAS float*)(L + 119808);
    LAS float* CW = (LAS float*)(L + 120320);
    const bf16* PROJ = WSP(bf16, WS_PROJ); bf16* Y = WSP(bf16, WS_Y);
    const int fr0 = lane & 15, fq0 = lane >> 4;
    for (int i = tid; i < 640; i += NTHR) { const int w = i >> 7, cch = i & 127; CW[i] = (w < 4) ? F.in[I_CONVW][w * 1024 + h * 128 + cch] : F.in[I_CONVB][h * 128 + cch]; }
    if (tid < 128) CARRY[tid] = 0.f;
    const int gsel = wave & 1, nt0 = (wave >> 1) * 2;
    bf16x8 wf[2][4];
    { const bf16* WTp = (gsel ? WSP(bf16, WS_WIT) : WSP(bf16, WS_WAT)) + (size_t)h * 128 * 128;
#pragma unroll
      for (int n = 0; n < 2; ++n)
#pragma unroll
          for (int ks = 0; ks < 4; ++ks) wf[n][ks] = *(const bf16x8*)(WTp + ((nt0 + n) * 16 + fr0) * 128 + ks * 32 + 8 * fq0); }
    const int c = tid & 127, sg = tid >> 7, chg = h * 128 + c;
    const float ba_c = F.in[I_BA][chg], bi_c = F.in[I_BI][chg], sp8 = 8.0f * softplus_fast(-F.in[I_LAM][chg]);
    v4u pf[2][4];
#define LRU_PREFETCH(k_) do { _Pragma("unroll") for (int u_ = 0; u_ < 2; ++u_) { const int chn_ = tid + NTHR * u_, t_ = chn_ >> 4, c8_ = (chn_ & 15) * 8; \
        _Pragma("unroll") for (int w_ = 0; w_ < 4; ++w_) { const int ts_ = (k_) * 64 + t_ - 3 + w_; const int tc_ = ts_ >= 0 ? ts_ : 0;   \
            const v4u x_ = *(const v4u*)(PROJ + ((size_t)b * SEQ + tc_) * NINP + h * 128 + c8_); const unsigned m_ = ts_ >= 0 ? 0xffffffffu : 0u; \
            pf[u_][w_] = (v4u){x_.x & m_, x_.y & m_, x_.z & m_, x_.w & m_}; } } } while (0)
    LRU_PREFETCH(0);
    __syncthreads();
    for (int k = 0; k < SEQ / 64; ++k) {
        const size_t tokbase = (size_t)b * SEQ + k * 64;
        int lane_c = lane; asm volatile("" : "+v"(lane_c)); const int fr = lane_c & 15, fq = lane_c >> 4;
#pragma unroll
        for (int u = 0; u < 2; ++u) { const int chn = tid + NTHR * u, t = chn >> 4, c8 = (chn & 15) * 8;
            float acc[8]; { const f32x4 b0 = *(const LAS f32x4*)(CW + 512 + c8), b1 = *(const LAS f32x4*)(CW + 512 + c8 + 4);
#pragma unroll
                for (int e = 0; e < 4; ++e) { acc[e] = b0[e]; acc[e + 4] = b1[e]; } }
#pragma unroll
            for (int w = 0; w < 4; ++w) { float xf[8]; unpack8(pf[u][w], xf);
                const f32x4 w0 = *(const LAS f32x4*)(CW + w * 128 + c8), w1 = *(const LAS f32x4*)(CW + w * 128 + c8 + 4);
#pragma unroll
                for (int e = 0; e < 4; ++e) { acc[e] += w0[e] * xf[e]; acc[e + 4] += w1[e] * xf[e + 4]; } }
            v4u pk; pk.x = cvtpk(acc[0], acc[1]); pk.y = cvtpk(acc[2], acc[3]); pk.z = cvtpk(acc[4], acc[5]); pk.w = cvtpk(acc[6], acc[7]);
            *(LAS v4u*)(XA + t * 136 + c8) = pk;
            LAS float* d = XC + t * 128 + c8; *(LAS f32x4*)d = (f32x4){acc[0], acc[1], acc[2], acc[3]}; *(LAS f32x4*)(d + 4) = (f32x4){acc[4], acc[5], acc[6], acc[7]}; }
        { const int kn_ = k + 1 < SEQ / 64 ? k + 1 : SEQ / 64 - 1; LRU_PREFETCH(kn_); }
        unsigned short gt[16];
#pragma unroll
        for (int e = 0; e < 16; ++e) gt[e] = PROJ[(tokbase + sg * 16 + e) * NINP + PC_GATE + chg];
        __syncthreads();
#pragma unroll
        for (int mt = 0; mt < 4; ++mt) {
            bf16x8 af[4];
#pragma unroll
            for (int ks = 0; ks < 4; ++ks) af[ks] = *(const LAS bf16x8*)(XA + (mt * 16 + fr) * 136 + ks * 32 + 8 * fq);
#pragma unroll
            for (int n = 0; n < 2; ++n) { f32x4 a4 = (f32x4){0.f, 0.f, 0.f, 0.f};
#pragma unroll
                for (int ks = 0; ks < 4; ++ks) a4 = MFMA16(wf[n][ks], af[ks], a4);
                *(LAS f32x4*)(RI + gsel * 8192 + (mt * 16 + fr) * 128 + (nt0 + n) * 16 + fq * 4) = a4; } }
        __syncthreads();
        float av[16], bx[16]; float A = 1.f, B = 0.f;
#pragma unroll
        for (int e = 0; e < 16; ++e) { const int t = sg * 16 + e; const float r = sigmoid_fast(RI[t * 128 + c] + ba_c), ig = sigmoid_fast(RI[8192 + t * 128 + c] + bi_c), xc = XC[t * 128 + c];
            const float la = -sp8 * r; av[e] = __expf(la); bx[e] = sqrtf(fmaxf(1.0f - av[e] * av[e], 0.f)) * (ig * xc); A *= av[e]; B = av[e] * B + bx[e]; }
        SEG[(sg * 128 + c) * 2] = A; SEG[(sg * 128 + c) * 2 + 1] = B;
        __syncthreads();
        float hst = CARRY[c];
        for (int s2 = 0; s2 < sg; ++s2) hst = SEG[(s2 * 128 + c) * 2] * hst + SEG[(s2 * 128 + c) * 2 + 1];
#pragma unroll
        for (int e = 0; e < 16; ++e) { hst = av[e] * hst + bx[e];
            const float g = __uint_as_float((unsigned)gt[e] << 16);
            Y[(tokbase + sg * 16 + e) * D + chg] = (bf16)(cvtpk(hst * gelu_fast(g), 0.f) & 0xffffu); }
        __syncthreads();
        if (sg == 3) CARRY[c] = hst;
    }
    __syncthreads();
#undef LRU_PREFETCH
}
__device__ __forceinline__ void group_barrier(unsigned* cnt, unsigned n) {
    asm volatile("s_waitcnt vmcnt(0)" ::: "memory");
    __syncthreads();
    if (threadIdx.x == 0) {
        __builtin_amdgcn_fence(__ATOMIC_RELEASE, "agent");
        asm volatile("s_waitcnt vmcnt(0)" ::: "memory");
        xb_add(cnt, 1u);
        unsigned sp = 0; while (xb_ld(cnt) < n) { __builtin_amdgcn_s_sleep(2); if (++sp > (1u << 24)) break; }
        __builtin_amdgcn_fence(__ATOMIC_ACQUIRE, "agent");
        asm volatile("s_waitcnt vmcnt(0)" ::: "memory");
    }
    __syncthreads();
}

__device__ __forceinline__ unsigned f2ord(float f) { const unsigned u = __builtin_bit_cast(unsigned, f); return (u & 0x80000000u) ? ~u : (u | 0x80000000u); }
__device__ __forceinline__ float ord2f(unsigned o) { const unsigned u = (o & 0x80000000u) ? (o & 0x7fffffffu) : ~o; return __builtin_bit_cast(float, u); }
#define CMPX(hi_, lo_) do { const unsigned _a = (hi_), _b = (lo_); (hi_) = _a > _b ? _a : _b; (lo_) = _a > _b ? _b : _a; } while (0)
template <int N> __device__ __forceinline__ void sort_desc(unsigned (&a)[N]) {
#pragma unroll
    for (int k = 2; k <= N; k <<= 1)
#pragma unroll
        for (int j = k >> 1; j > 0; j >>= 1)
#pragma unroll
            for (int i = 0; i < N; ++i) { const int l = i ^ j; if (l > i) { if ((i & k) == 0) CMPX(a[i], a[l]); else CMPX(a[l], a[i]); } }
}
__device__ __forceinline__ void merge16(unsigned (&A)[16], const unsigned (&B)[16]) {
#pragma unroll
    for (int i = 0; i < 16; ++i) { const unsigned q = B[15 - i]; A[i] = A[i] > q ? A[i] : q; }
#pragma unroll
    for (int d = 8; d >= 1; d >>= 1)
#pragma unroll
        for (int i = 0; i < 16; ++i) if ((i & d) == 0) CMPX(A[i], A[i + d]);
}
__device__ __forceinline__ void merge_partner(unsigned (&Lk)[16]) {
    unsigned P[16];
#pragma unroll
    for (int i = 0; i < 16; ++i) P[i] = (unsigned)__shfl_xor((int)Lk[i], 32);
#pragma unroll
    for (int i = 0; i < 16; ++i) { const unsigned q = P[15 - i]; Lk[i] = Lk[i] > q ? Lk[i] : q; }
#pragma unroll
    for (int d = 8; d >= 1; d >>= 1)
#pragma unroll
        for (int i = 0; i < 16; ++i) if ((i & d) == 0) CMPX(Lk[i], Lk[i + d]);
}
__device__ __forceinline__ void route_item(const Frame& F, int item, int lane) {
    const int tok0 = (item >> 3) * 32, h = item & 7, c = lane & 31, hi = lane >> 5;
    const bf16* Q = WSP(bf16, WS_Q); const bf16* KB = WSP(bf16, WS_KEYS);
    LAS unsigned* WL = (LAS unsigned*)(F.lds + F.wave * 8192);
    unsigned LST[2][16];
    bf16x8 qf[8], qn[8], kf[8], kn[8];
#pragma unroll
    for (int ks = 0; ks < 8; ++ks) { qf[ks] = *(const bf16x8*)(Q + (size_t)(tok0 + c) * D + h * 256 + ks * 16 + 8 * hi); qn[ks] = *(const bf16x8*)(Q + (size_t)(tok0 + c) * D + h * 256 + 128 + ks * 16 + 8 * hi);
        kf[ks] = *(const bf16x8*)(KB + (size_t)((h * 2) * 128 + c) * 128 + 8 * hi + ks * 16); }
    unsigned Lk[16];
#pragma unroll
    for (int st = 0; st < 8; ++st) { const int p = st >> 2, m = st & 3;
        if (st < 7) { const int p2 = (st + 1) >> 2, m2 = (st + 1) & 3; const bf16* kp = KB + (size_t)((h * 2 + p2) * 128 + m2 * 32 + c) * 128 + 8 * hi;
#pragma unroll
            for (int ks = 0; ks < 8; ++ks) kn[ks] = *(const bf16x8*)(kp + ks * 16); }
        f32x16 acc;
#pragma unroll
        for (int r = 0; r < 16; ++r) acc[r] = 0.f;
#pragma unroll
        for (int ks = 0; ks < 8; ++ks) acc = MFMA32(kf[ks], p ? qn[ks] : qf[ks], acc);
        unsigned G16[16];
#pragma unroll
        for (int r = 0; r < 16; ++r) { const unsigned idx = (unsigned)(m * 32 + (r & 3) + 8 * (r >> 2)) | ((unsigned)hi << 2); G16[r] = (f2ord(acc[r]) & ~0x7Fu) | idx; }
        sort_desc<16>(G16);
        if (m == 0) {
#pragma unroll
            for (int i = 0; i < 16; ++i) Lk[i] = G16[i]; }
        else merge16(Lk, G16);
        if (m == 3) { merge_partner(Lk);
#pragma unroll
            for (int i = 0; i < 16; ++i) { LST[p][i] = Lk[i]; WL[(p * 16 + i) * 64 + lane] = Lk[i] & 0x7Fu; } }
#pragma unroll
        for (int ks = 0; ks < 8; ++ks) kf[ks] = kn[ks];
    }
    float va[4], vb[16];
#pragma unroll
    for (int i = 0; i < 4; ++i) va[i] = ord2f((hi ? LST[1][i] : LST[0][i]) & ~0x7Fu);
#pragma unroll
    for (int j = 0; j < 16; ++j) vb[j] = ord2f((hi ? LST[0][j] : LST[1][j]) & ~0x7Fu);
    unsigned C32[32];
#pragma unroll
    for (int i = 0; i < 32; ++i) C32[i] = 0u;
#pragma unroll
    for (int i = 0; i < 4; ++i) { const unsigned key = (f2ord(va[i] + vb[i]) & ~0xFFu) | (unsigned)(i * 17); C32[i] = hi ? 0u : key; }
    { int cn = 4;
#pragma unroll
      for (int i = 0; i < 3; ++i)
#pragma unroll
          for (int j = i + 1; j < 16; ++j) if ((i + 1) * (j + 1) <= 16) { const unsigned code = hi ? (unsigned)(j * 16 + i) : (unsigned)(i * 16 + j); C32[cn] = (f2ord(va[i] + vb[j]) & ~0xFFu) | code; ++cn; } }
    sort_desc<32>(C32);
    unsigned Ck[16];
#pragma unroll
    for (int i = 0; i < 16; ++i) Ck[i] = C32[i];
    merge_partner(Ck);
    const float mx = ord2f(Ck[0] & ~0xFFu); float den = 0.f;
#pragma unroll
    for (int k = 0; k < 16; ++k) den += __expf(ord2f(Ck[k] & ~0xFFu) - mx);
    const float rden = 1.0f / den;
    int eo[8]; float go[8];
#pragma unroll
    for (int k = 0; k < 8; ++k) { const unsigned fm = hi ? Ck[k + 8] : Ck[k]; const unsigned code = fm & 0xFFu;
        const unsigned k0 = WL[(code >> 4) * 64 + lane], k1 = WL[(16 + (code & 15u)) * 64 + lane];
        eo[k] = (int)(k0 * 128u + k1); go[k] = __expf(ord2f(fm & ~0xFFu) - mx) * rden; }
    int* ep = WSP(int, WS_EXP) + (size_t)(tok0 + c) * NSEL + h * 16 + hi * 8; float* gp = WSP(float, WS_GATE) + (size_t)(tok0 + c) * NSEL + h * 16 + hi * 8;
    *(int4*)ep = make_int4(eo[0], eo[1], eo[2], eo[3]); *(int4*)(ep + 4) = make_int4(eo[4], eo[5], eo[6], eo[7]);
    *(f32x4*)gp = (f32x4){go[0], go[1], go[2], go[3]}; *(f32x4*)(gp + 4) = (f32x4){go[4], go[5], go[6], go[7]};
}

typedef float f32x2 __attribute__((ext_vector_type(2)));
__device__ __forceinline__ int dot4i(unsigned a, unsigned b, int c) { return __builtin_amdgcn_sdot4((int)a, (int)b, c, false); }
template <int CTRL> __device__ __forceinline__ int dppi(int x) { return __builtin_amdgcn_mov_dpp(x, CTRL, 0xf, 0xf, true); }
struct PeerGeom { int ngrp, g, rank, nrank; };
__device__ __forceinline__ PeerGeom peer_geom(const Frame& F) { PeerGeom p; p.ngrp = (F.G % 8 == 0) ? 8 : 1; p.g = F.bid % p.ngrp; p.rank = F.bid / p.ngrp; p.nrank = F.G / p.ngrp; return p; }
__device__ __forceinline__ void xquant_token(const Frame& F, int tok, int lane) {
    const bf16* xr = WSP(bf16, WS_XB) + (size_t)tok * D + lane * 16; float xf[32]; float am = 0.f;
#pragma unroll
    for (int hh = 0; hh < 2; ++hh)
#pragma unroll
        for (int q = 0; q < 2; ++q) { const v4u w = *(const v4u*)(xr + hh * 1024 + q * 8); float t8[8]; unpack8(w, t8);
#pragma unroll
            for (int e = 0; e < 8; ++e) { xf[hh * 16 + q * 8 + e] = t8[e]; am = fmaxf(am, fabsf(t8[e])); } }
#pragma unroll
    for (int o = 1; o < 64; o <<= 1) am = fmaxf(am, __shfl_xor(am, o));
    const float qs = am > 0.f ? 127.0f / am : 0.f;
    if (lane == 0) WSP(float, WS_SX)[tok] = am * (1.0f / 127.0f);
#pragma unroll
    for (int hh = 0; hh < 2; ++hh) { v4u o;
#pragma unroll
        for (int d = 0; d < 4; ++d) { unsigned w = 0u;
#pragma unroll
            for (int e = 0; e < 4; ++e) { const int qi = (int)rintf(xf[hh * 16 + d * 4 + e] * qs); w |= ((unsigned)qi & 0xFFu) << (8 * e); }
            o[d] = w; }
        *(v4u*)(WSP(unsigned char, WS_XQ) + (size_t)tok * D + hh * 1024 + lane * 16) = o; }
}
__device__ __forceinline__ void peer_score_slice(const Frame& F, int tok, int slice, int lane, LAS int* wl) {
    const int e8 = lane >> 3, c16 = lane & 7;
    const int* ep = WSP(int, WS_EXP) + (size_t)tok * NSEL;
    wl[lane] = ep[lane]; wl[64 + lane] = ep[64 + lane];
    const v4u xs = *(const v4u*)(WSP(unsigned char, WS_XQ) + (size_t)tok * D + slice * 128 + c16 * 16);
    const unsigned char* ub = WSP(unsigned char, WS_UT); const unsigned lo = (unsigned)(slice * 128 + c16 * 16);
    int p[16];
#pragma unroll
    for (int ld = 0; ld < 16; ++ld) { const unsigned eid = (unsigned)wl[e8 * 16 + ld]; const v4u w = *(const v4u*)(ub + (eid * 2048u + lo));
        int a = dot4i(w.x, xs.x, 0); a = dot4i(w.y, xs.y, a); a = dot4i(w.z, xs.z, a); p[ld] = dot4i(w.w, xs.w, a); }
    { const bool up = (lane & 4) != 0;
#pragma unroll
      for (int k = 0; k < 8; ++k) { const int keep = up ? p[k + 8] : p[k], send = up ? p[k] : p[k + 8]; p[k] = keep + dppi<0x141>(send); } }
    { const bool up = (lane & 2) != 0;
#pragma unroll
      for (int k = 0; k < 4; ++k) { const int keep = up ? p[k + 4] : p[k], send = up ? p[k] : p[k + 4]; p[k] = keep + dppi<0x4E>(send); } }
    { const bool up = (lane & 1) != 0;
#pragma unroll
      for (int k = 0; k < 2; ++k) { const int keep = up ? p[k + 2] : p[k], send = up ? p[k] : p[k + 2]; p[k] = keep + dppi<0xB1>(send); } }
    int* dst = WSP(int, WS_PART) + ((size_t)slice * T + tok) * NSEL + lane * 2;
    *(int2*)dst = make_int2(p[0], p[1]);
}
__device__ __forceinline__ void peer_coef_token(const Frame& F, int tok, int lane) {
    int s0 = 0, s1 = 0;
#pragma unroll
    for (int s = 0; s < 16; ++s) { const int2 v = *(const int2*)(WSP(int, WS_PART) + ((size_t)s * T + tok) * NSEL + lane * 2); s0 += v.x; s1 += v.y; }
    const int2 ex = *(const int2*)(WSP(int, WS_EXP) + (size_t)tok * NSEL + lane * 2); const f32x2 ga = *(const f32x2*)(WSP(float, WS_GATE) + (size_t)tok * NSEL + lane * 2);
    const float rs = WSP(float, WS_SX)[tok] * (1.0f / sqrtf(WSP(float, WS_SSQ2)[tok] * (1.0f / D) + NORM_EPS));
    const float sc0 = (float)s0 * WSP(float, WS_USC)[ex.x] * rs, sc1 = (float)s1 * WSP(float, WS_USC)[ex.y] * rs;
    f32x2 c; c.x = ga.x * gelu_fast(sc0) * WSP(float, WS_VSC)[ex.x]; c.y = ga.y * gelu_fast(sc1) * WSP(float, WS_VSC)[ex.y];
    float cm = fmaxf(fabsf(c.x), fabsf(c.y));
#pragma unroll
    for (int o = 1; o < 64; o <<= 1) cm = fmaxf(cm, __shfl_xor(cm, o));
    const float qs = cm > 0.f ? 127.0f / cm : 0.f;
    const int q0 = (int)rintf(c.x * qs), q1 = (int)rintf(c.y * qs);
    ((unsigned short*)(F.ws + WS_COEF))[(size_t)tok * 64 + lane] = (unsigned short)(((unsigned)q0 & 0xFFu) | (((unsigned)q1 & 0xFFu) << 8));
    if (lane == 0) WSP(float, WS_CSC)[tok] = cm * (1.0f / 127.0f);
}
struct PeerOutBuf { v4u w[16]; v4u cq; f32x2 x; float cs; };
__device__ __forceinline__ void peer_out_issue(const Frame& F, int tok, int slice, int lane, LAS int* wl, PeerOutBuf& B) {
    const int e8 = lane >> 3, c16 = lane & 7;
    const int* ep = WSP(int, WS_EXP) + (size_t)tok * NSEL;
    wl[lane] = ep[lane]; wl[64 + lane] = ep[64 + lane];
    B.cq = *(const v4u*)(F.ws + WS_COEF + (size_t)tok * 128 + e8 * 16);
    B.cs = WSP(float, WS_CSC)[tok];
    const unsigned char* vb = WSP(unsigned char, WS_VT); const unsigned lofs = (unsigned)(slice * 128 + c16 * 16);
#pragma unroll
    for (int ld = 0; ld < 16; ++ld) { const unsigned eid = (unsigned)wl[e8 * 16 + ld]; B.w[ld] = *(const v4u*)(vb + (eid * 2048u + lofs)); }
    B.x = *(const f32x2*)(F.out + (size_t)tok * D + slice * 128 + c16 * 16 + e8 * 2);
}
__device__ __forceinline__ void peer_out_consume(const Frame& F, int tok, int slice, int lane, LAS int* wl, const PeerOutBuf& B) {
    const int e8 = lane >> 3, c16 = lane & 7;
    int o[16];
#pragma unroll
    for (int i = 0; i < 16; ++i) o[i] = 0;
#pragma unroll
    for (int g = 0; g < 4; ++g) { const unsigned cq = B.cq[g];
#pragma unroll
        for (int d = 0; d < 4; ++d) { const unsigned w0 = B.w[4 * g][d], w1 = B.w[4 * g + 1][d], w2 = B.w[4 * g + 2][d], w3 = B.w[4 * g + 3][d];
            const unsigned lo01 = __builtin_amdgcn_perm(w1, w0, 0x05010400u), hi01 = __builtin_amdgcn_perm(w1, w0, 0x07030602u);
            const unsigned lo23 = __builtin_amdgcn_perm(w3, w2, 0x05010400u), hi23 = __builtin_amdgcn_perm(w3, w2, 0x07030602u);
            const unsigned t0 = __builtin_amdgcn_perm(lo23, lo01, 0x05040100u), t1 = __builtin_amdgcn_perm(lo23, lo01, 0x07060302u);
            const unsigned t2 = __builtin_amdgcn_perm(hi23, hi01, 0x05040100u), t3 = __builtin_amdgcn_perm(hi23, hi01, 0x07060302u);
            o[d * 4 + 0] = dot4i(t0, cq, o[d * 4 + 0]); o[d * 4 + 1] = dot4i(t1, cq, o[d * 4 + 1]); o[d * 4 + 2] = dot4i(t2, cq, o[d * 4 + 2]); o[d * 4 + 3] = dot4i(t3, cq, o[d * 4 + 3]); } }
#pragma unroll
    for (int k = 0; k < 8; ++k) { auto s = __builtin_amdgcn_permlane32_swap((unsigned)o[k], (unsigned)o[k + 8], false, false); o[k] = (int)(s[0] + s[1]); }
#pragma unroll
    for (int k = 0; k < 4; ++k) { auto s = __builtin_amdgcn_permlane16_swap((unsigned)o[k], (unsigned)o[k + 4], false, false); o[k] = (int)(s[0] + s[1]); }
    { const bool up = (lane & 8) != 0;
#pragma unroll
      for (int k = 0; k < 2; ++k) { const int keep = up ? o[k + 2] : o[k], send = up ? o[k] : o[k + 2]; o[k] = keep + dppi<0x128>(send); } }
    f32x2 x = B.x; x.x += (float)o[0] * B.cs; x.y += (float)o[1] * B.cs;
    *(f32x2*)(F.out + (size_t)tok * D + slice * 128 + c16 * 16 + e8 * 2) = x;
    float ss = x.x * x.x + x.y * x.y;
    ss += dppf<0xB1>(ss); ss += dppf<0x4E>(ss); ss += dppf<0x141>(ss); ss += dppf<0x140>(ss);
    { auto s = __builtin_amdgcn_permlane16_swap(__float_as_uint(ss), __float_as_uint(ss), false, false); ss = __uint_as_float(s[0]) + __uint_as_float(s[1]); }
    { auto s = __builtin_amdgcn_permlane32_swap(__float_as_uint(ss), __float_as_uint(ss), false, false); ss = __uint_as_float(s[0]) + __uint_as_float(s[1]); }
    if (lane == 0) atomicAdd(WSP(float, WS_SSQ3) + tok, ss);
}
__device__ __forceinline__ void peer_out_phase(const Frame& F, const PeerGeom& pg, LAS int* wl2) {
    const int lane = F.lane, first = pg.rank * NWAVES + F.wave, step = pg.nrank * NWAVES;
    LAS int* wlA = wl2; LAS int* wlB = wl2 + 256;
    for (int r = 0; r < 16 / pg.ngrp; ++r) { const int slice = r * pg.ngrp + pg.g;
        PeerOutBuf A, B;
        int tok = first;
        if (tok < T) peer_out_issue(F, tok, slice, lane, wlA, A);
        while (tok < T) {
            const int t1 = tok + step, t2 = tok + 2 * step;
            if (t1 < T) peer_out_issue(F, t1, slice, lane, wlB, B);
            peer_out_consume(F, tok, slice, lane, wlA, A);
            if (t1 >= T) break;
            if (t2 < T) peer_out_issue(F, t2, slice, lane, wlA, A);
            peer_out_consume(F, t1, slice, lane, wlB, B);
            tok = t2;
        }
    }
}
__device__ __forceinline__ void final_norm_phase(const Frame& F) {
    const int lane = F.lane, gw = F.bid * NWAVES + F.wave, NGW = F.G * NWAVES;
    const f32x4* gf = (const f32x4*)F.in[I_GF] + lane;
    f32x4 g[8];
#pragma unroll
    for (int j = 0; j < 8; ++j) g[j] = gf[64 * j];
    if (gw >= T) return;
    f32x4 va[8], vb[8]; float sa, sb;
#define FN_LOAD(v_, s_, tok_) do { const int tc_ = (tok_) < T ? (tok_) : T - 1; const f32x4* xi_ = (const f32x4*)(F.out + (size_t)tc_ * D) + lane; s_ = WSP(float, WS_SSQ3)[tc_]; \
        _Pragma("unroll") for (int j_ = 0; j_ < 8; ++j_) v_[j_] = xi_[64 * j_]; } while (0)
#define FN_STORE(v_, s_, tok_) do { f32x4* xo_ = (f32x4*)(F.out + (size_t)(tok_) * D) + lane; const float rs_ = 1.0f / sqrtf(s_ * (1.0f / D) + NORM_EPS); \
        _Pragma("unroll") for (int j_ = 0; j_ < 8; ++j_) xo_[64 * j_] = v_[j_] * rs_ * g[j_]; } while (0)
    FN_LOAD(va, sa, gw);
    for (int tok = gw; tok < T; tok += 2 * NGW) {
        FN_LOAD(vb, sb, tok + NGW);
        FN_STORE(va, sa, tok);
        FN_LOAD(va, sa, tok + 2 * NGW);
        if (tok + NGW < T) FN_STORE(vb, sb, tok + NGW);
    }
#undef FN_LOAD
#undef FN_STORE
}

struct Args { const float* in[28]; float* out; unsigned char* ws; int ph_lo, ph_hi, li, pad; };
__global__ void __launch_bounds__(NTHR, 2) hybrid_fwd(Args args) {
    extern __shared__ __attribute__((aligned(16))) unsigned char lds[];
    Frame F;
    F.lds = (LAS unsigned char*)lds;
    F.tid = threadIdx.x; F.lane = F.tid & 63; F.wave = __builtin_amdgcn_readfirstlane(F.tid >> 6);
    F.G = gridDim.x; F.bid = blockIdx.x;
#pragma unroll
    for (int i = 0; i < 28; ++i) F.in[i] = args.in[i];
    F.out = args.out; F.ws = args.ws;
    volatile LAS unsigned* MISC = (volatile LAS unsigned*)(F.lds + MISC_OFF);
    for (int u = F.tid; u < (LDS_BYTES - LDSCTL_OFF) / 4; u += NTHR) ((LAS unsigned*)(F.lds + LDSCTL_OFF))[u] = 0u;
    __syncthreads();
    unsigned* barw = (unsigned*)(F.ws + WS_CTL) + CW_BAR;
    XcdBarrier bar; bar.bar = barw; bar.x = 0; bar.st = nullptr;
    if (N_LAUNCHES == 1) bar = xcd_barrier_post(barw, MISC + 8);
    const int lo = args.ph_lo, hi = args.ph_hi;
#define IN(k) (lo <= (k) && (k) < hi)
#define SEAM(k) do { if (IN(k) && IN((k) + 1)) xcd_barrier(bar); } while (0)

#ifndef PROBE_DUP
#define PROBE_DUP -1
#endif
#define REPS(k) for (int rep_ = 0; rep_ < ((PROBE_DUP) == (k) ? 2 : 1); ++rep_)
    if (IN(0)) REPS(0) { p0_prologue<0>(F, F.bid, F.G); __syncthreads(); }
    SEAM(0);
    if (IN(1)) REPS(1) {
        pg8::Gemm g{WSP(const bf16, WS_XB), WSP(const bf16, WS_WIN), T, NINP, D / 2}; pg8::StaticOrder S; S.init(T, NINP, F.G, F.bid);
        pg8::EpiI8RowColBf16 E{WSP(bf16, WS_PROJ), NINP, WSP(const float, WS_RSTD1), WSP(const float, WS_CS1)};
        pg8::gemm_phase<pg8::EpiI8RowColBf16, pg8::StaticOrder, true, true, true>(F.lds, g, S, E);
    }
    SEAM(1);
    if (IN(2)) REPS(2) {
        lora_prepass(F);
        group_barrier((unsigned*)(F.ws + WS_CTL) + CW_PREBAR, (unsigned)F.G);
        for (int r4 = 0; r4 < ((PROBE_DUP) == 70 ? 2 : 1); ++r4) rwkv_prep_phase(F);
        group_barrier((unsigned*)(F.ws + WS_CTL) + CW_PREPBAR, (unsigned)F.G);
        const int R1 = F.G >= 256 ? 128 : F.G, L0 = F.G >= 256 ? 128 : 0, NL = F.G - L0;
        if (F.bid < R1) for (int it = F.bid; it < 128; it += R1) rwkv_item(F, it);
        if (F.bid >= L0) for (int it = F.bid - L0; it < 64; it += NL) lru_seq(F, it);
        { volatile LAS int* qslot = (volatile LAS int*)(F.lds + LDSCTL_OFF + 1024);
          for (;;) { __syncthreads(); if (F.tid == 0) *qslot = (int)xb_add((unsigned*)(F.ws + WS_CTL) + CW_DEFQ, 1u); __syncthreads();
              const int vb = *qslot; if (vb >= 1024) break; p0_prologue<1>(F, vb, 1024); } }
    }
    SEAM(2);
    if (IN(3)) {
        pg8::Gemm g{WSP(const bf16, WS_Y), WSP(const bf16, WS_WOUT), T, D, D}; pg8::StaticOrder S; S.init(T, D, F.G, F.bid);
        pg8::EpiResidual E{F.in[I_X], F.out, WSP(bf16, WS_XB), WSP(float, WS_SSQ2), D};
        pg8::gemm_phase<pg8::EpiResidual, pg8::StaticOrder, true, true>(F.lds, g, S, E);
    }
    SEAM(3);
    if (IN(4)) REPS(4) {
        pg8::Gemm g{WSP(const bf16, WS_XB), WSP(const bf16, WS_WQ), T, D, D}; pg8::StaticOrder S; S.init(T, D, F.G, F.bid);
        pg8::EpiRowScaleBf16<1> E{WSP(bf16, WS_Q), D, WSP(const float, WS_SSQ2), NORM_EPS};
        pg8::gemm_phase<pg8::EpiRowScaleBf16<1>, pg8::StaticOrder, true, true>(F.lds, g, S, E);
    }
    if (IN(4)) { __syncthreads();
        pg8::StaticOrder S; S.init(T, D, F.G, F.bid); pg8::Unit u;
        for (int i = 0; S.next(i, u); ++i) route_item(F, ((u.pm * 8 + F.wave) << 3) | u.pn, F.lane);
        const int gw = F.bid * NWAVES + F.wave, NGW = F.G * NWAVES;
        for (int tok = gw; tok < T; tok += NGW) xquant_token(F, tok, F.lane); }
    if (IN(4) && IN(6)) xcd_barrier(bar);
    { const PeerGeom pg = peer_geom(F); LAS int* wl = (LAS int*)(F.lds + F.wave * 1024);
      if (IN(6)) REPS(6) { for (int r = 0; r < 16 / pg.ngrp; ++r) { const int slice = r * pg.ngrp + pg.g; for (int tok = pg.rank * NWAVES + F.wave; tok < T; tok += pg.nrank * NWAVES) peer_score_slice(F, tok, slice, F.lane, wl); } }
      SEAM(6);
      if (IN(7)) REPS(7) { const int gw = F.bid * NWAVES + F.wave, NGW = F.G * NWAVES; for (int tok = gw; tok < T; tok += NGW) peer_coef_token(F, tok, F.lane); }
      SEAM(7);
      if (IN(8)) peer_out_phase(F, pg, (LAS int*)(F.lds + 16384 + F.wave * 2048));
      SEAM(8);
      if (IN(9)) final_norm_phase(F); }
#undef IN
#undef SEAM
}

extern "C" void kernel_launch(void* const* d_in, const int* in_sizes, int n_in, void* d_out, int out_size, void* d_ws, size_t ws_size, hipStream_t stream) {
    static int grid = 0;
    if (grid == 0) {
        if (n_in != 28 || in_sizes[0] != T * D || out_size != T * D || ws_size < WS_END) { fprintf(stderr, "kernel_launch: shape/workspace mismatch: n_in %d in0 %d out %d ws %zu (need %zu)\n", n_in, n_in > 0 ? in_sizes[0] : -1, out_size, ws_size, (size_t)WS_END); grid = -1; return; }
        int dev = 0, cus = 0, per_cu = 0;
        if (hipGetDevice(&dev) != hipSuccess || hipDeviceGetAttribute(&cus, hipDeviceAttributeMultiprocessorCount, dev) != hipSuccess) { fprintf(stderr, "kernel_launch: device query failed\n"); grid = -1; return; }
        if (hipFuncSetAttribute((const void*)hybrid_fwd, hipFuncAttributeMaxDynamicSharedMemorySize, LDS_BYTES) != hipSuccess) { fprintf(stderr, "kernel_launch: hipFuncSetAttribute failed\n"); grid = -1; return; }
        if (hipOccupancyMaxActiveBlocksPerMultiprocessor(&per_cu, (const void*)hybrid_fwd, NTHR, LDS_BYTES) != hipSuccess || per_cu < 1) { fprintf(stderr, "kernel_launch: occupancy query says %d blocks per CU\n", per_cu); per_cu = 1; }
        (void)hipGetLastError();
        grid = cus;
    }
    if (grid < 0) return;
    if (hipMemsetAsync((char*)d_ws + WS_CTL, 0, CTL_ZERO_BYTES, stream) != hipSuccess) { fprintf(stderr, "kernel_launch: hipMemsetAsync failed\n"); return; }
    Args a{};
    for (int i = 0; i < 28; ++i) a.in[i] = (const float*)d_in[i];
    a.out = (float*)d_out; a.ws = (unsigned char*)d_ws;
    for (int li = 0; li < N_LAUNCHES; ++li) {
        a.ph_lo = (N_LAUNCHES == 1) ? 0 : li; a.ph_hi = (N_LAUNCHES == 1) ? N_PHASES : li + 1; a.li = li;
        hipLaunchKernelGGL(hybrid_fwd, dim3(grid), dim3(NTHR), LDS_BYTES, stream, a);
        const hipError_t le = hipPeekAtLastError();
        if (le != hipSuccess) { fprintf(stderr, "kernel_launch: launch %d failed: %s\n", li, hipGetErrorName(le)); break; }
    }
}
```

```cpp
#include <hip/hip_runtime.h>
#include <cstdio>
#include <cstdint>
namespace pg8 {
#define PG8_LAS __attribute__((address_space(3)))
typedef unsigned short bf16_t;
typedef short bf16x8 __attribute__((ext_vector_type(8)));
typedef float f32x4 __attribute__((ext_vector_type(4)));
typedef unsigned u32x4 __attribute__((ext_vector_type(4)));
typedef int i32x4 __attribute__((ext_vector_type(4)));
constexpr int BM = 256, BK = 64, HALF = 128, HTB = HALF * BK * 2  , STAGE_BYTES = 8 * HTB, NXCD = 8, WGM = 8;

__host__ __device__ __forceinline__ int lds_byte(int r, int c) { const int st = (r >> 4) * 2 + (c >> 5), rr = r & 15, cc = c & 31, ob = rr * 64 + cc * 2; return st * 1024 + (ob ^ (((ob >> 9) & 1) << 5)); }
__host__ __device__ __forceinline__ void stage_rc(int b, int& R, int& C) { const int st = b / 1024, sb = b % 1024, swz = sb ^ (((sb >> 9) & 1) << 5); R = (st >> 1) * 16 + swz / 64; C = (st & 1) * 32 + (swz % 64) / 2; }
__host__ __device__ __forceinline__ int perm32(int rho) { const int n = rho >> 4, i = rho & 15; return 8 * (i >> 2) + 4 * n + (i & 3); }

struct Unit { int pm, pn; };
struct Gemm { const bf16_t* A; const bf16_t* Bt; int M, N, K; };

struct StaticOrder {
    int nM, nN, nwg, G, c;
    __host__ __device__ void init(int M, int N, int G_, int c_) { nM = M / BM; nN = N / BM; nwg = nM * nN; G = G_; c = c_; }
    __host__ __device__ bool next(int i, Unit& u) const {
        const long L = (long)i * G + c; if (L >= nwg) return false;
        int wgid = (int)L; { const int q = nwg / NXCD, r = nwg % NXCD, xcd = wgid % NXCD, off = wgid / NXCD; wgid = (xcd < r ? xcd * (q + 1) : r * (q + 1) + (xcd - r) * q) + off; }
        const int nig = WGM * nN, gid = wgid / nig, fm = gid * WGM, gsz = (nM - fm) < WGM ? (nM - fm) : WGM;
        u.pm = fm + ((wgid % nig) % gsz); u.pn = (wgid % nig) / gsz; return true;
    }
    __device__ __forceinline__ void a_ready(const Unit&) const {}
    __device__ __forceinline__ void done(const Unit&) const {}
};

__device__ __forceinline__ unsigned cvt_pk_bf16(float lo, float hi) { unsigned r; asm volatile("v_cvt_pk_bf16_f32 %0, %1, %2" : "=v"(r) : "v"(lo), "v"(hi)); return r; }
typedef float f32x2 __attribute__((ext_vector_type(2)));
typedef unsigned u32x2 __attribute__((ext_vector_type(2)));
template <int MODE> struct EpiRowScaleBf16 {
    static constexpr bool PERM = true, AFTER_DRAIN = false;
    bf16_t* O; int ldc; const float* rs; float eps;
    __device__ __forceinline__ void operator()(const f32x4 (&acc)[2][2][4][2], const Unit& u, int wr, int wc, int fr, int fq) const {
        const int row0 = u.pm * BM + wr * 64 + fr, col0 = u.pn * BM + wc * 32 + 8 * fq;
#pragma unroll
        for (int ai = 0; ai < 2; ++ai)
#pragma unroll
            for (int m = 0; m < 4; ++m) { const int r = row0 + ai * HALF + m * 16; float s = rs[r]; if (MODE == 1) s = 1.0f / sqrtf(s * (1.0f / 2048.0f) + eps);
                bf16_t* rowp = O + (size_t)r * ldc + col0;
#pragma unroll
                for (int bj = 0; bj < 2; ++bj) { const f32x4 v0 = acc[ai][bj][m][0] * s, v1 = acc[ai][bj][m][1] * s;
                    u32x4 w; w.x = cvt_pk_bf16(v0[0], v0[1]); w.y = cvt_pk_bf16(v0[2], v0[3]); w.z = cvt_pk_bf16(v1[0], v1[1]); w.w = cvt_pk_bf16(v1[2], v1[3]);
                    *(u32x4*)(rowp + bj * HALF) = w; } }
    }
};
template <int MODE> struct EpiI8RowColBf16 {
    static constexpr bool PERM = true, AFTER_DRAIN = false;
    bf16_t* O; int ldc; const float* rs; const float* cs; const float* ssq; float eps;
    __device__ __forceinline__ void operator()(const f32x4 (&acc)[2][2][4][2], const Unit& u, int wr, int wc, int fr, int fq) const {
        const int row0 = u.pm * BM + wr * 64 + fr, col0 = u.pn * BM + wc * 32 + 8 * fq;
        f32x4 c4[2][2];
#pragma unroll
        for (int bj = 0; bj < 2; ++bj) { c4[bj][0] = *(const f32x4*)(cs + col0 + bj * HALF); c4[bj][1] = *(const f32x4*)(cs + col0 + bj * HALF + 4); }
#pragma unroll
        for (int ai = 0; ai < 2; ++ai)
#pragma unroll
            for (int m = 0; m < 4; ++m) { const int r = row0 + ai * HALF + m * 16; float s = rs[r]; if (MODE == 1) s = s / sqrtf(ssq[r] * (1.0f / 2048.0f) + eps);
                bf16_t* rowp = O + (size_t)r * ldc + col0;
#pragma unroll
                for (int bj = 0; bj < 2; ++bj) { f32x4 v0, v1; const i32x4 i0 = __builtin_bit_cast(i32x4, acc[ai][bj][m][0]), i1 = __builtin_bit_cast(i32x4, acc[ai][bj][m][1]);
#pragma unroll
                    for (int e = 0; e < 4; ++e) { v0[e] = (float)i0[e] * s * c4[bj][0][e]; v1[e] = (float)i1[e] * s * c4[bj][1][e]; }
                    u32x4 w; w.x = cvt_pk_bf16(v0[0], v0[1]); w.y = cvt_pk_bf16(v0[2], v0[3]); w.z = cvt_pk_bf16(v1[0], v1[1]); w.w = cvt_pk_bf16(v1[2], v1[3]);
                    *(u32x4*)(rowp + bj * HALF) = w; } }
    }
};
struct EpiResidual {
    static constexpr bool PERM = false, AFTER_DRAIN = false;
    const float* base; float* out; bf16_t* outb; float* ssq; int ldc;
    __device__ __forceinline__ void operator()(const f32x4 (&acc)[2][2][4][2], const Unit& u, int wr, int wc, int fr, int fq) const {
        const int row0 = u.pm * BM + wr * 64 + fr, col0 = u.pn * BM + wc * 32 + 4 * fq;
#pragma unroll
        for (int ai = 0; ai < 2; ++ai)
#pragma unroll
            for (int m = 0; m < 4; ++m) { const int r = row0 + ai * HALF + m * 16; const size_t off = (size_t)r * ldc + col0; float q = 0.f;
#pragma unroll
                for (int bj = 0; bj < 2; ++bj)
#pragma unroll
                    for (int n = 0; n < 2; ++n) { const f32x4 bs = *(const f32x4*)(base + off + bj * HALF + n * 16); const f32x4 o = bs + acc[ai][bj][m][n];
                        *(f32x4*)(out + off + bj * HALF + n * 16) = o; q += (o[0] * o[0] + o[1] * o[1]) + (o[2] * o[2] + o[3] * o[3]);
                        u32x2 w; w.x = cvt_pk_bf16(o[0], o[1]); w.y = cvt_pk_bf16(o[2], o[3]); *(u32x2*)(outb + off + bj * HALF + n * 16) = w; }
                q += __shfl_xor(q, 16); q += __shfl_xor(q, 32);
                if (fq == 0) atomicAdd(ssq + r, q);
                asm volatile("" ::: "memory"); }
    }
};
template <class Epi, class Sched, bool ALIGN_EPI = false, bool SP2 = false, bool I8 = false>
__device__ __forceinline__ void gemm_phase(PG8_LAS unsigned char* lds, const Gemm g, const Sched& S, const Epi& E) {
    const int tid = threadIdx.x, wid = __builtin_amdgcn_readfirstlane(tid >> 6), lane = tid & 63, wr = wid >> 2, wc = wid & 3, fr = lane & 15, fq = lane >> 4;
    const int K = g.K, nt = K / BK;
    unsigned voffA[2], voffB[2];
#pragma unroll
    for (int i = 0; i < 2; ++i) { int R, C; stage_rc(tid * 16 + i * 8192, R, C); const int Rb = Epi::PERM ? ((R & ~31) + perm32(R & 31)) : R;
        voffA[i] = (unsigned)(R * K + C) * 2u; voffB[i] = (unsigned)(Rb * K + C) * 2u; }
    const size_t kstep = (size_t)(BK * 2);
    const size_t hstep = (size_t)HALF * K * 2;
    const size_t tstep = 2 * hstep;
    const unsigned ldsw = (unsigned)wid * 1024u;
    const int aoff = lds_byte(wr * 64 + fr, fq * 8), boff = lds_byte(wc * 32 + fr, fq * 8);
#define PG8_SA(b, h) (((b) * 2 + (h)) * HTB)
#define PG8_SB(b, h) ((4 + (b) * 2 + (h)) * HTB)
#define PG8_STAGE(bufoff, gbase, voff) do { _Pragma("unroll") for (int _i = 0; _i < 2; ++_i) \
        __builtin_amdgcn_global_load_lds((const unsigned*)((const char*)(gbase) + (voff)[_i]), (PG8_LAS unsigned*)(lds + (bufoff) + ldsw + _i * 8192), 16, 0, 0); } while (0)
#define PG8_LDA(dst, b, h) do { _Pragma("unroll") for (int m = 0; m < 4; ++m) _Pragma("unroll") for (int k = 0; k < 2; ++k) dst[m][k] = *(const PG8_LAS bf16x8*)(lds + PG8_SA(b, h) + aoff + m * 2048 + k * 1024); } while (0)
#define PG8_LDB(dst, b, h) do { _Pragma("unroll") for (int n = 0; n < 2; ++n) _Pragma("unroll") for (int k = 0; k < 2; ++k) dst[n][k] = *(const PG8_LAS bf16x8*)(lds + PG8_SB(b, h) + boff + n * 2048 + k * 1024); } while (0)
#define PG8_MMA(ai, bj, At, Bt) do { __builtin_amdgcn_s_setprio(1); _Pragma("unroll") for (int m = 0; m < 4; ++m) _Pragma("unroll") for (int n = 0; n < 2; ++n) _Pragma("unroll") for (int k = 0; k < 2; ++k) \
        { if constexpr (I8) acc[ai][bj][m][n] = __builtin_bit_cast(f32x4, __builtin_amdgcn_mfma_i32_16x16x64_i8(__builtin_bit_cast(i32x4, Bt[n][k]), __builtin_bit_cast(i32x4, At[m][k]), __builtin_bit_cast(i32x4, acc[ai][bj][m][n]), 0, 0, 0)); \
          else acc[ai][bj][m][n] = __builtin_amdgcn_mfma_f32_16x16x32_bf16(Bt[n][k], At[m][k], acc[ai][bj][m][n], 0, 0, 0); } __builtin_amdgcn_s_setprio(0); } while (0)
#define PG8_WAIT_V(n) asm volatile("s_waitcnt vmcnt(" #n ")" ::: "memory")
#define PG8_WAIT_L(n) asm volatile("s_waitcnt lgkmcnt(" #n ")" ::: "memory")
#define PG8_BAR __builtin_amdgcn_s_barrier()
#define PG8_SCHED __builtin_amdgcn_sched_barrier(0)
    Unit cur, nxt; int ui = 0;
    if (!S.next(0, cur)) return;
    f32x4 acc[2][2][4][2];
#pragma unroll
    for (int a = 0; a < 2; ++a)
#pragma unroll
        for (int b = 0; b < 2; ++b)
#pragma unroll
            for (int m = 0; m < 4; ++m)
#pragma unroll
                for (int n = 0; n < 2; ++n) acc[a][b][m][n] = (f32x4){0.f, 0.f, 0.f, 0.f};
    bf16x8 At[4][2], B0[2][2], B1[2][2];
    const char* cA = (const char*)g.A + (size_t)cur.pm * tstep; const char* cB = (const char*)g.Bt + (size_t)cur.pn * tstep;
    S.a_ready(cur);
    if constexpr (SP2) {
        PG8_STAGE(PG8_SB(0, 0), cB, voffB); PG8_STAGE(PG8_SB(0, 1), cB + hstep, voffB); PG8_STAGE(PG8_SA(0, 0), cA, voffA); PG8_STAGE(PG8_SA(0, 1), cA + hstep, voffA);
        if (wr == 1) PG8_BAR;
        PG8_WAIT_V(2); PG8_BAR;
        PG8_STAGE(PG8_SB(1, 0), cB + kstep, voffB); PG8_STAGE(PG8_SA(1, 0), cA + kstep, voffA); PG8_STAGE(PG8_SB(1, 1), cB + hstep + kstep, voffB);
        PG8_WAIT_V(6); PG8_BAR;
    } else {
        PG8_STAGE(PG8_SB(0, 0), cB, voffB); PG8_STAGE(PG8_SA(0, 0), cA, voffA); PG8_STAGE(PG8_SB(0, 1), cB + hstep, voffB); PG8_STAGE(PG8_SA(0, 1), cA + hstep, voffA);
        if (wr == 1) PG8_BAR;
        PG8_WAIT_V(4); PG8_BAR;
        PG8_STAGE(PG8_SB(1, 0), cB + kstep, voffB); PG8_STAGE(PG8_SA(1, 0), cA + kstep, voffA); PG8_STAGE(PG8_SB(1, 1), cB + hstep + kstep, voffB);
        PG8_WAIT_V(6); PG8_BAR;
    }
    for (;;) {
        const bool has_next = S.next(ui + 1, nxt);
        const char* nA = has_next ? (const char*)g.A + (size_t)nxt.pm * tstep : cA; const char* nB = has_next ? (const char*)g.Bt + (size_t)nxt.pn * tstep : cB;
        for (int t = 0; t < nt; t += 2) {
            const bool last = (t == nt - 2);
            const char* a1 = cA + (size_t)(t + 1) * kstep;
            const char* a2 = last ? nA : cA + (size_t)(t + 2) * kstep; const char* b2 = last ? nB : cB + (size_t)(t + 2) * kstep;
            const char* a3 = a2 + kstep; const char* b3 = b2 + kstep;
            if (last && has_next) S.a_ready(nxt);
            if constexpr (SP2) {
            PG8_LDB(B0, 0, 0); PG8_LDB(B1, 0, 1); PG8_SCHED; PG8_LDA(At, 0, 0); PG8_STAGE(PG8_SA(1, 1), a1 + hstep, voffA);
            PG8_WAIT_V(8); PG8_WAIT_L(0); PG8_BAR; PG8_MMA(0, 0, At, B0); PG8_MMA(0, 1, At, B1); PG8_BAR; PG8_SCHED;
            PG8_LDA(At, 0, 1); PG8_STAGE(PG8_SB(0, 0), b2, voffB); PG8_STAGE(PG8_SB(0, 1), b2 + hstep, voffB); PG8_STAGE(PG8_SA(0, 0), a2, voffA);
            PG8_WAIT_V(8); PG8_WAIT_L(0); PG8_BAR; PG8_MMA(1, 0, At, B0); PG8_MMA(1, 1, At, B1); PG8_BAR; PG8_SCHED;
            PG8_LDB(B0, 1, 0); PG8_LDB(B1, 1, 1); PG8_SCHED; PG8_LDA(At, 1, 0); PG8_STAGE(PG8_SA(0, 1), a2 + hstep, voffA);
            PG8_WAIT_V(8); PG8_WAIT_L(0); PG8_BAR; PG8_MMA(0, 0, At, B0); PG8_MMA(0, 1, At, B1); PG8_BAR; PG8_SCHED;
            PG8_LDA(At, 1, 1); PG8_STAGE(PG8_SB(1, 0), b3, voffB); PG8_STAGE(PG8_SB(1, 1), b3 + hstep, voffB); PG8_STAGE(PG8_SA(1, 0), a3, voffA);
            PG8_WAIT_V(8); PG8_WAIT_L(0); PG8_BAR; PG8_MMA(1, 0, At, B0); PG8_MMA(1, 1, At, B1); PG8_BAR; PG8_SCHED;
            } else {
            PG8_LDB(B0, 0, 0); PG8_SCHED; PG8_LDA(At, 0, 0); PG8_STAGE(PG8_SA(1, 1), a1 + hstep, voffA);
            PG8_WAIT_L(8); PG8_BAR; PG8_WAIT_L(0); PG8_MMA(0, 0, At, B0); PG8_BAR; PG8_SCHED;
            PG8_LDB(B1, 0, 1); PG8_STAGE(PG8_SB(0, 0), b2, voffB);
            PG8_BAR; PG8_WAIT_L(0); PG8_MMA(0, 1, At, B1); PG8_BAR;
            PG8_LDA(At, 0, 1); PG8_STAGE(PG8_SA(0, 0), a2, voffA);
            PG8_BAR; PG8_WAIT_L(0); PG8_MMA(1, 0, At, B0); PG8_BAR; PG8_SCHED;
            PG8_STAGE(PG8_SB(0, 1), b2 + hstep, voffB);
            PG8_WAIT_V(6); PG8_BAR; PG8_MMA(1, 1, At, B1); PG8_BAR;
            PG8_LDB(B0, 1, 0); PG8_SCHED; PG8_LDA(At, 1, 0); PG8_STAGE(PG8_SA(0, 1), a2 + hstep, voffA);
            PG8_WAIT_L(8); PG8_BAR; PG8_WAIT_L(0); PG8_MMA(0, 0, At, B0); PG8_BAR; PG8_SCHED;
            PG8_LDB(B1, 1, 1); PG8_STAGE(PG8_SB(1, 0), b3, voffB);
            PG8_BAR; PG8_WAIT_L(0); PG8_MMA(0, 1, At, B1); PG8_BAR;
            PG8_LDA(At, 1, 1); PG8_STAGE(PG8_SA(1, 0), a3, voffA);
            PG8_BAR; PG8_WAIT_L(0); PG8_MMA(1, 0, At, B0); PG8_BAR; PG8_SCHED;
            PG8_STAGE(PG8_SB(1, 1), b3 + hstep, voffB);
            PG8_WAIT_V(6); PG8_BAR; PG8_MMA(1, 1, At, B1); PG8_BAR;
            }
        }
        if constexpr (ALIGN_EPI) { if (wr == 0) PG8_BAR; }
        if constexpr (!Epi::AFTER_DRAIN) { E(acc, cur, wr, wc, fr, fq); S.done(cur); }
        if (!has_next) break;
#pragma unroll
        for (int a = 0; a < 2; ++a)
#pragma unroll
            for (int b = 0; b < 2; ++b)
#pragma unroll
                for (int m = 0; m < 4; ++m)
#pragma unroll
                    for (int n = 0; n < 2; ++n) acc[a][b][m][n] = (f32x4){0.f, 0.f, 0.f, 0.f};
        cur = nxt; cA = nA; cB = nB; ++ui;
        if constexpr (ALIGN_EPI) { if (wr == 1) PG8_BAR; }
    }
    PG8_WAIT_V(0);
    if constexpr (!ALIGN_EPI) { if (wr == 0) PG8_BAR; }
    PG8_BAR;
    if constexpr (Epi::AFTER_DRAIN) { E.fused(acc, cur, wr, wc, fr, fq, lds, wid, lane); S.done(cur); }
#undef PG8_SA
#undef PG8_SB
#undef PG8_STAGE
#undef PG8_LDA
#undef PG8_LDB
#undef PG8_MMA
#undef PG8_WAIT_V
#undef PG8_WAIT_L
#undef PG8_BAR
#undef PG8_SCHED
}
}

#ifndef PROBE_DUP
#define PROBE_DUP -1
#endif
constexpr int NWAVES = 8, NTHR = NWAVES * 64;
#ifndef MK_N_LAUNCHES
#define MK_N_LAUNCHES 1
#endif
constexpr int N_PHASES = 10;
constexpr int N_LAUNCHES = MK_N_LAUNCHES;
static_assert(N_LAUNCHES == 1 || N_LAUNCHES == N_PHASES, "MK_N_LAUNCHES is 1 or N_PHASES");

constexpr int BATCH = 8, SEQ = 2048, T = BATCH * SEQ, D = 2048;
constexpr int NIN = 5408, NINP = 5632;
constexpr int PC_GATE = 1024, PC_R = 2048, PC_K = 3072, PC_V = 4096, PC_WD = 5120, PC_AD = 5184, PC_GD = 5248;
constexpr int RWKV_C0 = 2048;
constexpr int NEXP = 16384, NSEL = 128;
constexpr float NORM_EPS = 1e-6f, GN_EPS = 64e-5f;

constexpr size_t MiB = 1u << 20;
constexpr size_t WS_CTL = 0, CTL_ZERO_BYTES = 1 * MiB;
constexpr size_t WS_SSQ3 = 576 * 1024;
constexpr size_t WS_SSQ2 = 512 * 1024;
constexpr size_t WS_RSTD1 = 1 * MiB;
constexpr size_t WS_USC = 1 * MiB + 64 * 1024, WS_VSC = 1 * MiB + 128 * 1024;
constexpr size_t WS_SX = 1 * MiB + 192 * 1024;
constexpr size_t WS_CS1 = 1 * MiB + 256 * 1024;
constexpr size_t WS_CSQ = 1 * MiB + 288 * 1024;
constexpr size_t WS_WIN = 2 * MiB;
constexpr size_t WS_WOUT = 24 * MiB;
constexpr size_t WS_WQ = 32 * MiB;
constexpr size_t WS_KEYS = 40 * MiB;
constexpr size_t WS_W2T = WS_KEYS + 512 * 1024;
constexpr size_t WS_A2T = WS_W2T + 128 * 1024;
constexpr size_t WS_G2T = WS_A2T + 128 * 1024;
constexpr size_t WS_WAT = WS_G2T + 320 * 1024;
constexpr size_t WS_WIT = WS_WAT + 256 * 1024;
constexpr size_t WS_EXP = 42 * MiB;
constexpr size_t WS_GATE = 50 * MiB;
constexpr size_t WS_LA = 42 * MiB;
constexpr size_t WS_SUMM = 58 * MiB;
constexpr size_t WS_TA = 64 * MiB, WS_TB = 96 * MiB, WS_TK = 400 * MiB, WS_TR = 464 * MiB;
constexpr size_t OUT_TV = 0, OUT_TG = 32 * MiB, OUT_PC = 64 * MiB, OUT_BON = 66 * MiB;
constexpr size_t WS_XB = 64 * MiB;
constexpr size_t WS_PROJ = 128 * MiB;
constexpr size_t WS_Q = WS_PROJ;
constexpr size_t WS_PART = 192 * MiB;
constexpr size_t WS_XQ = 320 * MiB;
constexpr size_t WS_COEF = 352 * MiB;
constexpr size_t WS_CSC = 356 * MiB;
constexpr size_t WS_Y = 304 * MiB;
constexpr size_t WS_UT = 368 * MiB;
constexpr size_t WS_VT = 432 * MiB;
constexpr size_t WS_END = 496 * MiB;
static_assert(WS_WIT + 256 * 1024 <= WS_EXP && WS_PROJ + (size_t)T * NINP * 2 <= WS_Y && WS_WIN + (size_t)NINP * D * 2 <= WS_WOUT, "d_ws map");
constexpr int CW_DEFQ = 2240;
constexpr int CW_PREPBAR = 2176;
constexpr int CW_PREBAR = 2112;
constexpr int CW_LRUBAR = 2048;
constexpr int CW_BAR = 4096;

constexpr int RING_BYTES = 131072;
constexpr int LDSCTL_OFF = 143360, MISC_OFF = LDSCTL_OFF + 320;
constexpr int LDS_BYTES = 147456;

#define GAS __attribute__((address_space(1)))
#define LAS __attribute__((address_space(3)))
typedef unsigned short bf16;
typedef unsigned v4u __attribute__((ext_vector_type(4)));
typedef unsigned v2u __attribute__((ext_vector_type(2)));
typedef float f32x4 __attribute__((ext_vector_type(4)));
typedef float f32x16 __attribute__((ext_vector_type(16)));
typedef short bf16x8 __attribute__((ext_vector_type(8)));
typedef __bf16 bf16x2_t __attribute__((ext_vector_type(2)));
typedef GAS unsigned gu32;
#define RLX_AGENT __ATOMIC_RELAXED, __HIP_MEMORY_SCOPE_AGENT
__device__ __forceinline__ unsigned f2bf(float f) { unsigned u = __builtin_bit_cast(unsigned, f); return (u + 0x7fffu + ((u >> 16) & 1u)) >> 16; }
__device__ __forceinline__ unsigned pk2(float lo, float hi) { return f2bf(lo) | (f2bf(hi) << 16); }
__device__ __forceinline__ float bf_lo(unsigned w) { return __uint_as_float(w << 16); }
__device__ __forceinline__ float bf_hi(unsigned w) { return __uint_as_float(w & 0xffff0000u); }
__device__ __forceinline__ void unpack8(const v4u& w, float (&o)[8]) { o[0] = bf_lo(w.x); o[1] = bf_hi(w.x); o[2] = bf_lo(w.y); o[3] = bf_hi(w.y); o[4] = bf_lo(w.z); o[5] = bf_hi(w.z); o[6] = bf_lo(w.w); o[7] = bf_hi(w.w); }
__device__ __forceinline__ v4u pack8(const float (&o)[8]) { v4u w; w.x = pk2(o[0], o[1]); w.y = pk2(o[2], o[3]); w.z = pk2(o[4], o[5]); w.w = pk2(o[6], o[7]); return w; }
__device__ __forceinline__ float sigmoidf_(float x) { return 1.0f / (1.0f + __expf(-x)); }
__device__ __forceinline__ float softplusf_(float z) { return fmaxf(z, 0.f) + log1pf(__expf(-fabsf(z))); }
__device__ __forceinline__ float gelu_tanh(float x) { const float u = 0.7978845608028654f * (x + 0.044715f * x * x * x); return 0.5f * x * (1.0f + tanhf(u)); }
template <int CTRL> __device__ __forceinline__ float dppf(float x) { return __builtin_bit_cast(float, __builtin_amdgcn_mov_dpp(__builtin_bit_cast(int, x), CTRL, 0xf, 0xf, true)); }
__device__ __forceinline__ float red8(float v) { v += dppf<0xB1>(v); v += dppf<0x4E>(v); v += dppf<0x141>(v); return v; }
__device__ __forceinline__ float red16(float v) { v = red8(v); v += dppf<0x140>(v); return v; }
__device__ __forceinline__ float wave_sum(float v) {
#pragma unroll
    for (int o = 1; o < 64; o <<= 1) v += __shfl_xor(v, o);
    return v;
}
__device__ __forceinline__ float dot2bf(unsigned a, unsigned b, float acc) { return __builtin_amdgcn_fdot2_f32_bf16(__builtin_bit_cast(bf16x2_t, a), __builtin_bit_cast(bf16x2_t, b), acc, false); }
#define MFMA16(a, b, c) __builtin_amdgcn_mfma_f32_16x16x32_bf16((a), (b), (c), 0, 0, 0)
#define MFMA32(a, b, c) __builtin_amdgcn_mfma_f32_32x32x16_bf16((a), (b), (c), 0, 0, 0)

#define XB_TMO      128
#define XB_XCNT(j)  (256  + 64 * (j))
#define XB_XSUB(j)  (1280 + 64 * (j))
#define XB_XGEN(j)  (2304 + 64 * (j))
#define XB_TOP      3328
#define XB_TOPGEN   3392
#define XCD_BAR_WORDS 3456
#define XB_SPIN_CAP (1u << 22)
__device__ __forceinline__ unsigned xb_ld(unsigned* p)              { return __hip_atomic_load(p, __ATOMIC_RELAXED, __HIP_MEMORY_SCOPE_AGENT); }
__device__ __forceinline__ unsigned xb_add(unsigned* p, unsigned v) { return __hip_atomic_fetch_add(p, v, __ATOMIC_RELAXED, __HIP_MEMORY_SCOPE_AGENT); }
__device__ __forceinline__ unsigned xb_xcc_id() { return (unsigned)__builtin_amdgcn_s_getreg((3 << 11) | 20) & 0xFu; }
#define XB_SPIN(cond, bar) do { unsigned _sp = 0; while (cond) { __builtin_amdgcn_s_sleep(1); \
    if ((++_sp & 255u) == 0u) { if (xb_ld(&(bar)[XB_TMO])) break; if (_sp > XB_SPIN_CAP) { atomicAdd(&(bar)[XB_TMO], 1u); break; } } } } while (0)
struct XcdBarrier { unsigned* bar; unsigned x; volatile LAS unsigned* st; };
__device__ __forceinline__ XcdBarrier xcd_barrier_post(unsigned* bar, volatile LAS unsigned* st) {
    XcdBarrier b; b.bar = bar; b.x = xb_xcc_id(); b.st = st;
    if (threadIdx.x == 0) (void)xb_add(&bar[XB_XCNT(b.x)], 1u);
    return b;
}
__device__ __forceinline__ void xcd_barrier_complete(unsigned* bar, unsigned x, unsigned& nloc, unsigned& nx) {
    const unsigned G = gridDim.x * gridDim.y * gridDim.z;
    unsigned sum, cnt, mine, sp = 0u;
    for (;;) {
        sum = 0u; cnt = 0u; mine = 0u;
#pragma unroll
        for (unsigned j = 0; j < 16; ++j) { const unsigned c = xb_ld(&bar[XB_XCNT(j)]); sum += c; cnt += (c > 0u) ? 1u : 0u; mine = (j == x) ? c : mine; }
        if (sum == G) break;
        __builtin_amdgcn_s_sleep(1);
        if ((++sp & 255u) == 0u) { if (xb_ld(&bar[XB_TMO])) break; if (sp > XB_SPIN_CAP) { atomicAdd(&bar[XB_TMO], 1u); break; } }
    }
    nloc = mine > 0u ? mine : 1u; nx = cnt > 0u ? cnt : 1u;
}
__device__ __forceinline__ void xcd_barrier(const XcdBarrier& b) {
    asm volatile("s_waitcnt vmcnt(0)" ::: "memory");
    __syncthreads();
    if (threadIdx.x == 0) {
        unsigned* bar = b.bar;
        __builtin_amdgcn_s_waitcnt(0);
        unsigned nloc = b.st[0], nx = b.st[1];
        if (nloc == 0u) { xcd_barrier_complete(bar, b.x, nloc, nx); b.st[0] = nloc; b.st[1] = nx; }
        const unsigned old = xb_add(&bar[XB_XSUB(b.x)], 1u);
        const unsigned gen = old / nloc;
        if (old + 1u == (gen + 1u) * nloc) {
            __builtin_amdgcn_fence(__ATOMIC_RELEASE, "agent");
            asm volatile("s_waitcnt vmcnt(0)" ::: "memory");
            const unsigned og = xb_add(&bar[XB_TOP], 1u);
            const unsigned tg = og / nx;
            if (og + 1u == (tg + 1u) * nx) xb_add(&bar[XB_TOPGEN], 1u);
            else XB_SPIN(xb_ld(&bar[XB_TOPGEN]) == tg, bar);
            __builtin_amdgcn_fence(__ATOMIC_ACQUIRE, "agent");
            xb_add(&bar[XB_XGEN(b.x)], 1u);
            asm volatile("s_waitcnt vmcnt(0)" ::: "memory");
        } else {
            XB_SPIN(xb_ld(&bar[XB_XGEN(b.x)]) == gen, bar);
            __builtin_amdgcn_fence(__ATOMIC_ACQUIRE, "agent");
            asm volatile("s_waitcnt vmcnt(0)" ::: "memory");
        }
    }
    __syncthreads();
}

struct Frame {
    LAS unsigned char* lds;
    int tid, lane, wave, G, bid;
    const float* in[28];
    float* out;
    unsigned char* ws;
};
#define WSP(type, off) ((type*)(F.ws + (off)))
enum { I_X = 0, I_G1, I_WIN, I_CONVW, I_CONVB, I_WA, I_BA, I_WI, I_BI, I_LAM, I_MU, I_W0, I_W2, I_A0, I_A2, I_G2, I_KK, I_KA, I_RK, I_LNW, I_LNB, I_WOUT, I_G2N, I_WQ, I_KEYS, I_U, I_V, I_GF };

__device__ __forceinline__ void p0_transpose_item(const float* W, int K, int N, bf16* WT, const float* ksc, LAS float* scr, int item, int lane) {
    const int nblk = N / 32, kb = item / nblk, nb = item % nblk, k0 = 64 * kb, n0 = 32 * nb;
    const int lr = lane >> 3, c4 = (lane & 7) * 4;
    f32x4 v[8];
#pragma unroll
    for (int i = 0; i < 8; ++i) v[i] = *(const f32x4*)(W + (size_t)(k0 + 8 * i + lr) * N + n0 + c4);
#pragma unroll
    for (int i = 0; i < 8; ++i) { const int kk = 8 * i + lr; const float sc = ksc ? ksc[k0 + kk] : 1.0f; LAS float* d = scr + kk * 33 + c4; d[0] = v[i][0] * sc; d[1] = v[i][1] * sc; d[2] = v[i][2] * sc; d[3] = v[i][3] * sc; }
    asm volatile("s_waitcnt lgkmcnt(0)" ::: "memory");
    const int c = lane & 7;
#pragma unroll
    for (int j = 0; j < 4; ++j) { const int n = (lane >> 3) + 8 * j; const LAS float* s = scr + (8 * c) * 33 + n;
        v4u o; o.x = pk2(s[0 * 33], s[1 * 33]); o.y = pk2(s[2 * 33], s[3 * 33]); o.z = pk2(s[4 * 33], s[5 * 33]); o.w = pk2(s[6 * 33], s[7 * 33]);
        *(v4u*)(WT + (size_t)(n0 + n) * K + k0 + 8 * c) = o; }
    asm volatile("s_waitcnt lgkmcnt(0)" ::: "memory");
}
__device__ __forceinline__ void p0_wquant_block(const float* W, int N, unsigned char* WT8, float* cs, const float* ksc, int item, int wave, int lane, LAS float* mxs) {
    asm volatile("" : "+v"(lane));
    const int n0 = item * 32, r = lane >> 3, c4 = lane & 7, kb = 256 * wave + 4 * r;
    const float* src = W + (size_t)kb * N + n0 + 4 * c4; const float* kp = ksc + kb;
    f32x4 mx = (f32x4){0.f, 0.f, 0.f, 0.f};
#pragma unroll
    for (int i2 = 0; i2 < 2; ++i2) { f32x4 v[4][4], g4[4];
#pragma unroll
        for (int ii = 0; ii < 4; ++ii) { g4[ii] = *(const f32x4*)(kp + 32 * (i2 * 4 + ii));
#pragma unroll
            for (int j = 0; j < 4; ++j) v[ii][j] = *(const f32x4*)(src + (size_t)(32 * (i2 * 4 + ii) + j) * N); }
#pragma unroll
        for (int ii = 0; ii < 4; ++ii)
#pragma unroll
            for (int j = 0; j < 4; ++j)
#pragma unroll
                for (int e = 0; e < 4; ++e) mx[e] = fmaxf(mx[e], fabsf(v[ii][j][e] * g4[ii][j])); }
#pragma unroll
    for (int o = 8; o < 64; o <<= 1)
#pragma unroll
        for (int e = 0; e < 4; ++e) mx[e] = fmaxf(mx[e], __shfl_xor(mx[e], o));
    if (r == 0) *(LAS f32x4*)(mxs + wave * 32 + 4 * c4) = mx;
    __syncthreads();
#pragma unroll
    for (int w = 0; w < NWAVES; ++w) { const f32x4 t = *(const LAS f32x4*)(mxs + w * 32 + 4 * c4);
#pragma unroll
        for (int e = 0; e < 4; ++e) mx[e] = fmaxf(mx[e], t[e]); }
    f32x4 q;
#pragma unroll
    for (int e = 0; e < 4; ++e) q[e] = mx[e] > 0.f ? 127.0f / mx[e] : 0.f;
    if (wave == 0 && r == 0) *(f32x4*)(cs + n0 + 4 * c4) = mx * (1.0f / 127.0f);
    unsigned char* dst = WT8 + (size_t)(n0 + 4 * c4) * 2048 + kb;
#pragma unroll
    for (int i2 = 0; i2 < 2; ++i2) { f32x4 v[4][4], g4[4];
#pragma unroll
        for (int ii = 0; ii < 4; ++ii) { g4[ii] = *(const f32x4*)(kp + 32 * (i2 * 4 + ii));
#pragma unroll
            for (int j = 0; j < 4; ++j) v[ii][j] = *(const f32x4*)(src + (size_t)(32 * (i2 * 4 + ii) + j) * N); }
#pragma unroll
        for (int ii = 0; ii < 4; ++ii) { unsigned w[4] = {0u, 0u, 0u, 0u};
#pragma unroll
            for (int j = 0; j < 4; ++j)
#pragma unroll
                for (int e = 0; e < 4; ++e) { const int qi = (int)rintf(v[ii][j][e] * g4[ii][j] * q[e]); w[e] |= ((unsigned)qi & 0xFFu) << (8 * j); }
#pragma unroll
            for (int e = 0; e < 4; ++e) *(unsigned*)(dst + (size_t)e * 2048 + 32 * (i2 * 4 + ii)) = w[e]; } }
    __syncthreads();
}
__device__ __forceinline__ void p0_small_transpose(const float* src, bf16* dst, int nb, int K, int N, int gt, int NGT) {
    const int tot = nb * K * N;
    for (int i = gt; i < tot; i += NGT) { const int bb = i / (K * N), r = i - bb * K * N, n = r / K, k = r - n * K; dst[i] = (bf16)f2bf(src[(size_t)bb * K * N + (size_t)k * N + n]); }
}
template <int PART> __device__ __forceinline__ void p0_prologue(const Frame& F, int vb, int VG) {
    LAS float* scr = (LAS float*)(F.lds + F.wave * 8448);
    const int gw = vb * NWAVES + F.wave, NGW = VG * NWAVES, gt = gw * 64 + F.lane, NGT = NGW * 64;
    constexpr int I1 = (D / 64) * (NIN / 32), I2 = (D / 64) * (D / 32);
    if (PART == 0) { for (int it = vb; it < NIN / 32; it += VG) p0_wquant_block(F.in[I_WIN], NIN, WSP(unsigned char, WS_WIN), WSP(float, WS_CS1), F.in[I_G1], it, F.wave, F.lane, (LAS float*)(F.lds + 8 * 8448)); }
    else { for (int it = gw; it < I2; it += NGW) p0_transpose_item(F.in[I_WOUT], D, D, WSP(bf16, WS_WOUT), nullptr, scr, it, F.lane);
           for (int v16 = vb; v16 < 16 * (D / 32); v16 += VG) if (v16 % 16 == 0) p0_wquant_block(F.in[I_WQ], D, WSP(unsigned char, WS_WQ), WSP(float, WS_CSQ), F.in[I_G2N], v16 / 16, F.wave, F.lane, (LAS float*)(F.lds + 8 * 8448)); }
    if (PART == 0) {
    { v4u* z = (v4u*)(WSP(unsigned char, WS_WIN) + (size_t)NIN * D); const int nz = (NINP - NIN) * D / 16; for (int i = gt; i < nz; i += NGT) z[i] = (v4u){0u, 0u, 0u, 0u};
      for (int i = gt; i < NINP - NIN; i += NGT) WSP(float, WS_CS1)[NIN + i] = 0.f; }
    p0_small_transpose(F.in[I_W2], WSP(bf16, WS_W2T), 1, 64, 1024, gt, NGT);
    p0_small_transpose(F.in[I_A2], WSP(bf16, WS_A2T), 1, 64, 1024, gt, NGT);
    p0_small_transpose(F.in[I_G2], WSP(bf16, WS_G2T), 1, 160, 1024, gt, NGT);
    p0_small_transpose(F.in[I_WA], WSP(bf16, WS_WAT), 8, 128, 128, gt, NGT);
    p0_small_transpose(F.in[I_WI], WSP(bf16, WS_WIT), 8, 128, 128, gt, NGT);
    { const float* s = F.in[I_KEYS]; bf16* d = WSP(bf16, WS_KEYS); for (int i = gt; i < 8 * 2 * 128 * 128 / 8; i += NGT) { const f32x4 a = *(const f32x4*)(s + (size_t)i * 8), b = *(const f32x4*)(s + (size_t)i * 8 + 4);
        v4u o; o.x = pk2(a[0], a[1]); o.y = pk2(a[2], a[3]); o.z = pk2(b[0], b[1]); o.w = pk2(b[2], b[3]); *(v4u*)(d + (size_t)i * 8) = o; } }
    }
    if (PART == 1) {
    { const float* su = F.in[I_U]; const float* sv = F.in[I_V]; const float* g2 = F.in[I_G2N]; unsigned char* du = WSP(unsigned char, WS_UT); unsigned char* dv = WSP(unsigned char, WS_VT);
      float* usc = WSP(float, WS_USC); float* vsc = WSP(float, WS_VSC);
      f32x4 gg[2][4];
#pragma unroll
      for (int hh = 0; hh < 2; ++hh)
#pragma unroll
          for (int q = 0; q < 4; ++q) gg[hh][q] = *(const f32x4*)(g2 + hh * 1024 + F.lane * 16 + q * 4);
#define TBL_LOAD(U_, V_, row_) do { _Pragma("unroll") for (int hh_ = 0; hh_ < 2; ++hh_) _Pragma("unroll") for (int q_ = 0; q_ < 4; ++q_) { \
          U_[hh_][q_] = *(const f32x4*)(su + (size_t)(row_) * D + hh_ * 1024 + F.lane * 16 + q_ * 4); V_[hh_][q_] = *(const f32x4*)(sv + (size_t)(row_) * D + hh_ * 1024 + F.lane * 16 + q_ * 4); } } while (0)
#define TBL_QUANT(U_, V_, row_) do { float am_ = 0.f, vm_ = 0.f; \
          _Pragma("unroll") for (int hh_ = 0; hh_ < 2; ++hh_) _Pragma("unroll") for (int q_ = 0; q_ < 4; ++q_) { U_[hh_][q_] = U_[hh_][q_] * gg[hh_][q_]; \
              _Pragma("unroll") for (int e_ = 0; e_ < 4; ++e_) { am_ = fmaxf(am_, fabsf(U_[hh_][q_][e_])); vm_ = fmaxf(vm_, fabsf(V_[hh_][q_][e_])); } } \
          _Pragma("unroll") for (int o_ = 1; o_ < 64; o_ <<= 1) { am_ = fmaxf(am_, __shfl_xor(am_, o_)); vm_ = fmaxf(vm_, __shfl_xor(vm_, o_)); } \
          const float uq_ = am_ > 0.f ? 127.0f / am_ : 0.f, vq_ = vm_ > 0.f ? 127.0f / vm_ : 0.f; \
          if (F.lane == 0) { usc[row_] = am_ * (1.0f / 127.0f); vsc[row_] = vm_ * (1.0f / 127.0f); } \
          _Pragma("unroll") for (int hh_ = 0; hh_ < 2; ++hh_) { v4u ou_, ov_; \
              _Pragma("unroll") for (int q_ = 0; q_ < 4; ++q_) { unsigned w_ = 0u, wv_ = 0u; \
                  _Pragma("unroll") for (int e_ = 0; e_ < 4; ++e_) { const int qi_ = (int)rintf(U_[hh_][q_][e_] * uq_); w_ |= ((unsigned)qi_ & 0xFFu) << (8 * e_); const int qv_ = (int)rintf(V_[hh_][q_][e_] * vq_); wv_ |= ((unsigned)qv_ & 0xFFu) << (8 * e_); } \
                  ou_[q_] = w_; ov_[q_] = wv_; } \
              *(v4u*)(du + (size_t)(row_) * D + hh_ * 1024 + F.lane * 16) = ou_; *(v4u*)(dv + (size_t)(row_) * D + hh_ * 1024 + F.lane * 16) = ov_; } } while (0)
      for (int row = gw; row < NEXP; row += 2 * NGW) {
          const int rowB = row + NGW < NEXP ? row + NGW : row;
          f32x4 ua[2][4], va[2][4], ub[2][4], vb2[2][4];
          TBL_LOAD(ua, va, row); TBL_LOAD(ub, vb2, rowB);
          TBL_QUANT(ua, va, row);
          if (rowB != row) TBL_QUANT(ub, vb2, rowB);
      }
#undef TBL_LOAD
#undef TBL_QUANT
    }
    }
    if (PART == 0) {
    { const float* x = F.in[I_X]; unsigned char* xq = WSP(unsigned char, WS_XB); float* rs1 = WSP(float, WS_RSTD1);
#define XR_LOAD(V_, row_) do { _Pragma("unroll") for (int hh_ = 0; hh_ < 2; ++hh_) _Pragma("unroll") for (int q_ = 0; q_ < 4; ++q_) V_[hh_][q_] = *(const f32x4*)(x + (size_t)(row_) * D + hh_ * 1024 + F.lane * 16 + q_ * 4); } while (0)
#define XR_QUANT(V_, row_) do { float s_ = 0.f, am_ = 0.f; \
          _Pragma("unroll") for (int hh_ = 0; hh_ < 2; ++hh_) _Pragma("unroll") for (int q_ = 0; q_ < 4; ++q_) _Pragma("unroll") for (int e_ = 0; e_ < 4; ++e_) { const float t_ = V_[hh_][q_][e_]; s_ += t_ * t_; am_ = fmaxf(am_, fabsf(t_)); } \
          s_ = wave_sum(s_); \
          _Pragma("unroll") for (int o_ = 1; o_ < 64; o_ <<= 1) am_ = fmaxf(am_, __shfl_xor(am_, o_)); \
          const float xq_ = am_ > 0.f ? 127.0f / am_ : 0.f; \
          if (F.lane == 0) rs1[row_] = am_ * (1.0f / 127.0f) / sqrtf(s_ * (1.0f / D) + NORM_EPS); \
          _Pragma("unroll") for (int hh_ = 0; hh_ < 2; ++hh_) { v4u o_; \
              _Pragma("unroll") for (int q_ = 0; q_ < 4; ++q_) { unsigned w_ = 0u; \
                  _Pragma("unroll") for (int e_ = 0; e_ < 4; ++e_) { const int qi_ = (int)rintf(V_[hh_][q_][e_] * xq_); w_ |= ((unsigned)qi_ & 0xFFu) << (8 * e_); } \
                  o_[q_] = w_; } \
              *(v4u*)(xq + (size_t)(row_) * D + hh_ * 1024 + F.lane * 16) = o_; } } while (0)
      for (int m = gw; m < T; m += 2 * NGW) { const int mB = m + NGW < T ? m + NGW : m;
          f32x4 xa[2][4], xb2[2][4];
          XR_LOAD(xa, m); XR_LOAD(xb2, mB);
          XR_QUANT(xa, m);
          if (mB != m) XR_QUANT(xb2, mB); }
#undef XR_LOAD
#undef XR_QUANT
    }
    }
}

typedef float f32x2c __attribute__((ext_vector_type(2)));
__device__ __forceinline__ unsigned cvtpk(float lo, float hi) { const f32x2c v = {lo, hi}; const bf16x2_t b = __builtin_convertvector(v, bf16x2_t); return __builtin_bit_cast(unsigned, b); }
__device__ __forceinline__ float rcpf_(float x) { return __builtin_amdgcn_rcpf(x); }
__device__ __forceinline__ float sigmoid_fast(float x) { return rcpf_(1.0f + __expf(-x)); }
__device__ __forceinline__ float tanh_fast(float x) { return 1.0f - 2.0f * rcpf_(1.0f + __expf(2.0f * x)); }
__device__ __forceinline__ float softplus_fast(float z) { return fmaxf(z, 0.f) + __logf(1.0f + __expf(-fabsf(z))); }
__device__ __forceinline__ float gelu_fast(float x) { const float u = 0.7978845608028654f * (x + 0.044715f * x * x * x); return x * rcpf_(1.0f + __expf(-2.0f * u)); }
__device__ __forceinline__ void rwkv_prep_unit(const Frame& F, int chunk, int h, int lane, const LAS bf16* WL2, const LAS bf16* AL2, const LAS bf16* GL2, const LAS float* CW, LAS bf16* ST) {
    asm volatile("" : "+v"(lane));
    const int fr = lane & 15, fq = lane >> 4;
    const bf16* PROJ = WSP(bf16, WS_PROJ); const bf16* LA = WSP(bf16, WS_LA);
    bf16* TA = WSP(bf16, WS_TA); bf16* TB = WSP(bf16, WS_TB); bf16* TK = WSP(bf16, WS_TK); bf16* TR = WSP(bf16, WS_TR);
    bf16* TV = (bf16*)F.out + OUT_TV / 2; bf16* TG = (bf16*)F.out + OUT_TG / 2; float* PCG = F.out + OUT_PC / 4; float* BONG = F.out + OUT_BON / 4;
#define PU4(w_) ((f32x4){bf_lo((w_).x), bf_hi((w_).x), bf_lo((w_).y), bf_hi((w_).y)})
    size_t tokm[2]; int pom[2]; unsigned pmm[2];
#pragma unroll
    for (int mt = 0; mt < 2; ++mt) { tokm[mt] = (size_t)chunk * 32 + mt * 16 + fr; const bool hasp = ((chunk & 63) * 32 + mt * 16 + fr) > 0; pom[mt] = hasp ? NINP : 0; pmm[mt] = hasp ? 0xffffffffu : 0u; }
    float inv[2], bn[2];
#pragma unroll
    for (int mt = 0; mt < 2; ++mt) { float s2 = 0.f;
#pragma unroll
        for (int nt = 0; nt < 4; ++nt) { const int j4 = nt * 16 + fq * 4; const bf16* pr = PROJ + tokm[mt] * NINP + PC_K + h * 64 + j4;
            const v2u kc = *(const v2u*)pr; v2u kp = *(const v2u*)(pr - pom[mt]); kp.x &= pmm[mt]; kp.y &= pmm[mt];
            const f32x4 c_kk = *(const LAS f32x4*)(CW + 128 + j4), m_k = *(const LAS f32x4*)(CW + 384 + j4);
            const f32x4 kcf = PU4(kc); const f32x4 ku = (kcf + (PU4(kp) - kcf) * m_k) * c_kk; s2 += (ku[0] * ku[0] + ku[1] * ku[1]) + (ku[2] * ku[2] + ku[3] * ku[3]); }
        { auto x = __builtin_amdgcn_permlane16_swap(__float_as_uint(s2), __float_as_uint(s2), false, false); s2 = __uint_as_float(x[0]) + __uint_as_float(x[1]); }
        { auto x = __builtin_amdgcn_permlane32_swap(__float_as_uint(s2), __float_as_uint(s2), false, false); s2 = __uint_as_float(x[0]) + __uint_as_float(x[1]); }
        inv[mt] = __builtin_amdgcn_rsqf(fmaxf(s2, 1e-24f)); bn[mt] = 0.f; }
    v2u cur_[3], prv_[3], ncur_[3], nprv_[3];
#define PREP_LOAD_RKV(C_, P_, st_) do { const int mt_ = (st_) >> 2, nt_ = (st_) & 3; const bf16* pr_ = PROJ + tokm[mt_] * NINP + PC_R + h * 64 + nt_ * 16 + fq * 4; \
        _Pragma("unroll") for (int q_ = 0; q_ < 3; ++q_) { C_[q_] = *(const v2u*)(pr_ + q_ * 1024); P_[q_] = *(const v2u*)(pr_ + q_ * 1024 - pom[mt_]); } } while (0)
    PREP_LOAD_RKV(cur_, prv_, 0);
    f32x4 tot0[4];
#pragma unroll
    for (int n = 0; n < 4; ++n) tot0[n] = (f32x4){0.f, 0.f, 0.f, 0.f};
    bf16x8 la[9];
#pragma unroll
    for (int st = 0; st < 8; ++st) { const int mt = st >> 2, nt = st & 3; const int j4 = nt * 16 + fq * 4; const size_t col = (size_t)h * 64 + j4;
        if (nt == 0) {
#pragma unroll
            for (int ks = 0; ks < 9; ++ks) la[ks] = *(const bf16x8*)(LA + tokm[mt] * 288 + ks * 32 + 8 * fq); }
        if (st < 7) PREP_LOAD_RKV(ncur_, nprv_, st + 1);
        f32x4 cw = (f32x4){0.f, 0.f, 0.f, 0.f}, ca = cw, cg = cw;
#pragma unroll
        for (int ks = 0; ks < 2; ++ks) { cw = MFMA16(*(const LAS bf16x8*)(WL2 + (nt * 16 + fr) * 72 + ks * 32 + 8 * fq), la[ks], cw); ca = MFMA16(*(const LAS bf16x8*)(AL2 + (nt * 16 + fr) * 72 + ks * 32 + 8 * fq), la[2 + ks], ca); }
#pragma unroll
        for (int ks = 0; ks < 5; ++ks) cg = MFMA16(*(const LAS bf16x8*)(GL2 + (nt * 16 + fr) * 168 + ks * 32 + 8 * fq), la[4 + ks], cg);
        const f32x4 c_w0 = *(const LAS f32x4*)(CW + j4), c_a0 = *(const LAS f32x4*)(CW + 64 + j4), c_kk = *(const LAS f32x4*)(CW + 128 + j4), c_ka = *(const LAS f32x4*)(CW + 192 + j4), c_rk = *(const LAS f32x4*)(CW + 256 + j4);
        const f32x4 m_r = *(const LAS f32x4*)(CW + 320 + j4), m_k = *(const LAS f32x4*)(CW + 384 + j4), m_v = *(const LAS f32x4*)(CW + 448 + j4);
        v2u rp = prv_[0], kp = prv_[1], vp = prv_[2]; const unsigned pm = pmm[mt];
        rp.x &= pm; rp.y &= pm; kp.x &= pm; kp.y &= pm; vp.x &= pm; vp.y &= pm;
        const f32x4 rcf = PU4(cur_[0]), kcf = PU4(cur_[1]), vcf = PU4(cur_[2]);
        const f32x4 rr = rcf + (PU4(rp) - rcf) * m_r, kv = kcf + (PU4(kp) - kcf) * m_k, vv = vcf + (PU4(vp) - vcf) * m_v;
        f32x4 nau, bbu, km, cum;
#pragma unroll
        for (int r = 0; r < 4; ++r) { const float av = sigmoid_fast(c_a0[r] + ca[r]), ku = kv[r] * c_kk[r]; km[r] = kv[r] * (1.0f + (av - 1.0f) * c_ka[r]);
            cum[r] = -0.6065306597126334f * sigmoid_fast(c_w0[r] + cw[r]);
            nau[r] = -ku; bbu[r] = ku * av; bn[mt] += rr[r] * km[r] * c_rk[r]; }
        f32x4 at4, rt4, bt4, kt4, ep4;
#pragma unroll
        for (int r = 0; r < 4; ++r) { float v = cum[r];
            v += __builtin_bit_cast(float, __builtin_amdgcn_update_dpp(0, __builtin_bit_cast(int, v), 0x111, 0xf, 0xf, true));
            v += __builtin_bit_cast(float, __builtin_amdgcn_update_dpp(0, __builtin_bit_cast(int, v), 0x112, 0xf, 0xf, true));
            v += __builtin_bit_cast(float, __builtin_amdgcn_update_dpp(0, __builtin_bit_cast(int, v), 0x114, 0xf, 0xf, true));
            v += __builtin_bit_cast(float, __builtin_amdgcn_update_dpp(0, __builtin_bit_cast(int, v), 0x118, 0xf, 0xf, true));
            if (mt == 0) tot0[nt][r] = __shfl(v, (lane & 48) | 15); else v += tot0[nt][r];
            const float ep = __expf(v), em = rcpf_(ep);
            float eprev = __builtin_bit_cast(float, __builtin_amdgcn_update_dpp(0, __builtin_bit_cast(int, ep), 0x111, 0xf, 0xf, true));
            if (fr == 0) eprev = mt ? __expf(tot0[nt][r]) : 1.0f;
            at4[r] = nau[r] * inv[mt] * eprev; rt4[r] = rr[r] * ep; bt4[r] = bbu[r] * inv[mt] * em; kt4[r] = km[r] * em; ep4[r] = ep; }
        { LAS bf16* sp = ST + fr * 64 + j4; v2u w;
          w.x = cvtpk(at4[0], at4[1]); w.y = cvtpk(at4[2], at4[3]); *(LAS v2u*)(sp) = w;
          w.x = cvtpk(rt4[0], rt4[1]); w.y = cvtpk(rt4[2], rt4[3]); *(LAS v2u*)(sp + 1024) = w;
          w.x = cvtpk(bt4[0], bt4[1]); w.y = cvtpk(bt4[2], bt4[3]); *(LAS v2u*)(sp + 2048) = w;
          w.x = cvtpk(kt4[0], kt4[1]); w.y = cvtpk(kt4[2], kt4[3]); *(LAS v2u*)(sp + 3072) = w;
          w.x = cvtpk(vv[0], vv[1]); w.y = cvtpk(vv[2], vv[3]); *(LAS v2u*)(sp + 4096) = w;
          w.x = cvtpk(cg[0], cg[1]); w.y = cvtpk(cg[2], cg[3]); *(LAS v2u*)(sp + 5120) = w; }
        if (nt == 3) {
            bf16* const dstp[6] = {TA, TR, TB, TK, TV, TG};
#pragma unroll
            for (int a6 = 0; a6 < 6; ++a6)
#pragma unroll
                for (int hrow = 0; hrow < 2; ++hrow) { const int row = hrow * 8 + (lane >> 3), c8 = (lane & 7) * 8;
                    const v4u pv = *(const LAS v4u*)(ST + a6 * 1024 + row * 64 + c8);
                    *(v4u*)(dstp[a6] + ((size_t)chunk * 32 + mt * 16 + row) * 1024 + (size_t)h * 64 + c8) = pv; } }
        if (mt == 1 && fr == 15) *(f32x4*)(PCG + (size_t)chunk * 1024 + col) = ep4;
#pragma unroll
        for (int q = 0; q < 3; ++q) { cur_[q] = ncur_[q]; prv_[q] = nprv_[q]; }
    }
#undef PREP_LOAD_RKV
#undef PU4
#pragma unroll
    for (int mt = 0; mt < 2; ++mt) { float b2 = bn[mt];
        { auto x = __builtin_amdgcn_permlane16_swap(__float_as_uint(b2), __float_as_uint(b2), false, false); b2 = __uint_as_float(x[0]) + __uint_as_float(x[1]); }
        { auto x = __builtin_amdgcn_permlane32_swap(__float_as_uint(b2), __float_as_uint(b2), false, false); b2 = __uint_as_float(x[0]) + __uint_as_float(x[1]); }
        if (fq == 0) BONG[tokm[mt] * 16 + h] = b2; }
}
__device__ __forceinline__ void rwkv_prep_phase(const Frame& F) {
    LAS bf16* WL2 = (LAS bf16*)(F.lds + 0); LAS bf16* AL2 = (LAS bf16*)(F.lds + 9216); LAS bf16* GL2 = (LAS bf16*)(F.lds + 18432); LAS float* CW = (LAS float*)(F.lds + 39936);
    int hcur = -1;
    for (int u = F.bid; u < 1024; u += F.G) { const int h = u & 15, cg = u >> 4;
        if (h != hcur) { hcur = h; __syncthreads();
            int tid_ = F.tid; asm volatile("" : "+v"(tid_));
            const bf16* w2t = WSP(bf16, WS_W2T) + (size_t)h * 64 * 64; const bf16* a2t = WSP(bf16, WS_A2T) + (size_t)h * 64 * 64; const bf16* g2t = WSP(bf16, WS_G2T) + (size_t)h * 64 * 160;
            { const int r = tid_ >> 3, c = (tid_ & 7) * 8; *(LAS v4u*)(WL2 + r * 72 + c) = *(const v4u*)(w2t + r * 64 + c); *(LAS v4u*)(AL2 + r * 72 + c) = *(const v4u*)(a2t + r * 64 + c); }
            for (int i = tid_; i < 64 * 20; i += NTHR) { const int r = i / 20, c = (i - r * 20) * 8; *(LAS v4u*)(GL2 + r * 168 + c) = *(const v4u*)(g2t + r * 160 + c); }
            { const int q = tid_ >> 6, jj = tid_ & 63; const float* src = q == 0 ? F.in[I_W0] : (q == 1 ? F.in[I_A0] : (q == 2 ? F.in[I_KK] : (q == 3 ? F.in[I_KA] : (q == 4 ? F.in[I_RK] : F.in[I_MU] + (q - 5) * 1024)))); CW[q * 64 + jj] = src[h * 64 + jj]; }
            __syncthreads(); }
        rwkv_prep_unit(F, cg * 8 + F.wave, h, F.lane, WL2, AL2, GL2, CW, (LAS bf16*)(F.lds + 43008 + F.wave * 12288)); }
    __syncthreads();
}
typedef short v4i16_t __attribute__((ext_vector_type(4)));
__device__ __forceinline__ bf16x8 frag_tr16(const LAS bf16* p, int ld) {
    const v4i16_t a = __builtin_amdgcn_ds_read_tr16_b64_v4i16((LAS v4i16_t*)p), b = __builtin_amdgcn_ds_read_tr16_b64_v4i16((LAS v4i16_t*)(p + 4 * ld));
    return (bf16x8){a[0], a[1], a[2], a[3], b[0], b[1], b[2], b[3]};
}
__device__ __forceinline__ void rwkv_item(const Frame& F, int item) {
    const int b = item >> 4, h = item & 15, wave = F.wave; int tid = F.tid; asm volatile("" : "+v"(tid)); const int lane = tid & 63;
    LAS unsigned char* L = F.lds;
    constexpr int LD64 = 72, LD32 = 40, E0 = 73216;
    LAS bf16* AT = (LAS bf16*)(L + 0);  LAS bf16* BT_ = (LAS bf16*)(L + 4608); LAS bf16* KT_ = (LAS bf16*)(L + 9216); LAS bf16* RT = (LAS bf16*)(L + 13824);
    LAS bf16* VS2 = (LAS bf16*)(L + 18432);
    LAS bf16* GGB2 = (LAS bf16*)(L + 27648);
    LAS bf16* S0B = (LAS bf16*)(L + 36864);
    LAS float* YB2 = (LAS float*)(L + 55296);
    LAS float* BON2 = (LAS float*)(L + 72704);
    LAS float* PC = (LAS float*)(L + 72960);
    LAS bf16* AAK = (LAS bf16*)(L + E0); LAS bf16* ARB = (LAS bf16*)(L + E0 + 2560); LAS bf16* ARK = (LAS bf16*)(L + E0 + 5120);
    LAS bf16* XB_ = (LAS bf16*)(L + E0 + 7680);
    LAS bf16* XTB = (LAS bf16*)(L + E0 + 12800);
    LAS bf16* PMB = (LAS bf16*)(L + E0 + 17920);
    LAS bf16* RHS = (LAS bf16*)(L + E0 + 23040);
    LAS bf16* SAB = (LAS bf16*)(L + E0 + 28160);
    static_assert(E0 + 33280 <= LDSCTL_OFF, "rwkv LDS map");
    bf16* Y = WSP(bf16, WS_Y);
#define FRAG(base, row0, ld, ks) (*(const LAS bf16x8*)((base) + ((row0) + fr) * (ld) + (ks) * 32 + 8 * fq))
#define FRAGT(base, col0, ld) frag_tr16((base) + (8 * fq + (fr >> 2)) * (ld) + (col0) + 4 * (fr & 3), (ld))
    const int tt = tid >> 4, j0 = (tid & 15) * 4, hc = h * 64 + j0;
    const f32x4 plw = *(const f32x4*)(F.in[I_LNW] + hc), plb = *(const f32x4*)(F.in[I_LNB] + hc);
    const int lr = (tid & 255) >> 3, lc8 = tid & 7; const bool hi2 = tid >= 256;
    const bf16* srcA[3] = { (hi2 ? WSP(bf16, WS_TR) : WSP(bf16, WS_TA)), (hi2 ? WSP(bf16, WS_TK) : WSP(bf16, WS_TB)), (hi2 ? (const bf16*)F.out + OUT_TG / 2 : (const bf16*)F.out + OUT_TV / 2) };
    const size_t poff = ((size_t)b * SEQ + lr) * 1024 + h * 64 + lc8 * 8;
    const float* PCG = F.out + OUT_PC / 4 + (size_t)(b * 64) * 1024 + h * 64; const float* BONG = F.out + OUT_BON / 4 + (size_t)b * SEQ * 16 + h;
    v4u pl_[3]; float ppc = 0.f, pbn = 0.f;
#define RWKV_PREFETCH(tl_) do { _Pragma("unroll") for (int q_ = 0; q_ < 3; ++q_) pl_[q_] = *(const v4u*)(srcA[q_] + poff + (size_t)(tl_) * 32 * 1024); \
        ppc = PCG[(size_t)(tl_) * 1024 + (tid & 63)]; pbn = BONG[((size_t)(tl_) * 32 + (tid & 31)) * 16]; } while (0)
    const int ib = wave >> 1, tb = wave & 1, i0 = ib * 16, t0m = tb * 16;
    f32x4 sacc[2], pmacc, yacc;
    sacc[0] = (f32x4){0.f, 0.f, 0.f, 0.f}; sacc[1] = sacc[0]; pmacc = sacc[0]; yacc = sacc[0];
    for (int u = tid; u < 2 * 64 * LD64 / 2; u += NTHR) ((LAS unsigned*)S0B)[u] = 0u;
    RWKV_PREFETCH(0);
    __syncthreads();
    for (int tl = 0; tl <= SEQ / 32; ++tl) {
        const int cur = tl & 1;
        int lane_c = lane; asm volatile("" : "+v"(lane_c)); const int fr = lane_c & 15, fq = lane_c >> 4;
        LAS bf16* VS = VS2 + cur * 32 * LD64; LAS bf16* GGB = GGB2 + cur * 32 * LD64; LAS float* YB = YB2 + cur * 32 * 68; LAS float* BON = BON2 + cur * 32;
        const LAS bf16* VSp = VS2 + (cur ^ 1) * 32 * LD64; const LAS bf16* GGBp = GGB2 + (cur ^ 1) * 32 * LD64; const LAS float* YBp = YB2 + (cur ^ 1) * 32 * 68; const LAS float* BONp = BON2 + (cur ^ 1) * 32;
        if (tl > 0) { const size_t tokb = (size_t)b * SEQ + (tl - 1) * 32;
          const f32x4 y4 = *(const LAS f32x4*)(YBp + tt * 68 + j0); const v2u gw_ = *(const LAS v2u*)(GGBp + tt * LD64 + j0);
          const f32x4 g4 = (f32x4){bf_lo(gw_.x), bf_hi(gw_.x), bf_lo(gw_.y), bf_hi(gw_.y)};
          const v2u vw_ = *(const LAS v2u*)(VSp + tt * LD64 + j0); const f32x4 v4 = (f32x4){bf_lo(vw_.x), bf_hi(vw_.x), bf_lo(vw_.y), bf_hi(vw_.y)};
          float sm = (y4[0] + y4[1]) + (y4[2] + y4[3]); sm = red16(sm); const float mean = sm * (1.0f / 64.0f);
          const f32x4 d4 = y4 - mean; float sv = (d4[0] * d4[0] + d4[1] * d4[1]) + (d4[2] * d4[2] + d4[3] * d4[3]); sv = red16(sv);
          const float rstd = __builtin_amdgcn_rsqf(sv * (1.0f / 64.0f) + GN_EPS), bon = BONp[tt];
          f32x4 o;
#pragma unroll
          for (int e = 0; e < 4; ++e) o[e] = (d4[e] * rstd * plw[e] + plb[e] + bon * v4[e]) * g4[e];
          v2u w; w.x = cvtpk(o[0], o[1]); w.y = cvtpk(o[2], o[3]);
          *(v2u*)(Y + (tokb + tt) * D + 1024 + hc) = w; }
        if (tl == SEQ / 32) break;
        const LAS bf16* S0c = S0B + cur * 64 * LD64; LAS bf16* S0n = S0B + (cur ^ 1) * 64 * LD64;
        { const v4u p0 = pl_[0], p1 = pl_[1], p2 = pl_[2];
          *(LAS v4u*)((hi2 ? RT : AT) + lr * LD64 + lc8 * 8) = p0;
          *(LAS v4u*)((hi2 ? KT_ : BT_) + lr * LD64 + lc8 * 8) = p1;
          *(LAS v4u*)((hi2 ? GGB : VS) + lr * LD64 + lc8 * 8) = p2;
          if (tid < 64) PC[tid] = ppc;
          if (tid >= 64 && tid < 96) BON[tid - 64] = pbn; }
        { const int tn_ = tl + 1 < SEQ / 32 ? tl + 1 : SEQ / 32 - 1; RWKV_PREFETCH(tn_); }
        __syncthreads();
        { const int q = wave & 3, tq = (q >> 1) * 16, sq = (q & 1) * 16; const bool zt = sq > tq;
#pragma unroll
            for (int mi = 0; mi < 2; ++mi) { const int mtx = (wave < 4) ? mi : 2; if (wave >= 4 && mi == 1) break;
                const LAS bf16* Xs = (mtx == 1) ? BT_ : KT_; const LAS bf16* Yt = (mtx == 0) ? AT : RT; LAS bf16* O = (mtx == 0) ? AAK : (mtx == 1 ? ARB : ARK);
                f32x4 a4 = (f32x4){0.f, 0.f, 0.f, 0.f};
                if (!zt) {
#pragma unroll
                    for (int ks = 0; ks < 2; ++ks) a4 = MFMA16(FRAG(Xs, sq, LD64, ks), FRAG(Yt, tq, LD64, ks), a4); }
                const int t = tq + fr, s = sq + fq * 4;
#pragma unroll
                for (int r = 0; r < 4; ++r) { const bool keep = (mtx == 0) ? (s + r < t) : (s + r <= t); a4[r] = keep ? a4[r] : 0.f; }
                v2u w; w.x = cvtpk(a4[0], a4[1]); w.y = cvtpk(a4[2], a4[3]); *(LAS v2u*)(O + t * LD32 + s) = w; } }
        if (wave >= 4) { const int q = wave - 4, tq = (q >> 1) * 16, sq = (q & 1) * 16;
            f32x4 a4 = (f32x4){0.f, 0.f, 0.f, 0.f};
            if (sq <= tq) {
#pragma unroll
            for (int ks = 0; ks < 2; ++ks) a4 = MFMA16(FRAG(BT_, sq, LD64, ks), FRAG(AT, tq, LD64, ks), a4); }
            const int t = tq + fr, s = sq + fq * 4;
#pragma unroll
            for (int r = 0; r < 4; ++r) { a4[r] = (s + r < t) ? a4[r] : 0.f; XTB[(s + r) * LD32 + t] = (bf16)(cvtpk(a4[r], 0.f) & 0xffffu); }
            v2u w; w.x = cvtpk(a4[0], a4[1]); w.y = cvtpk(a4[2], a4[3]); *(LAS v2u*)(XB_ + t * LD32 + s) = w;
#pragma unroll
            for (int r = 0; r < 4; ++r) pmacc[r] = a4[r] + ((s + r == t) ? 1.0f : 0.f);
            w.x = cvtpk(pmacc[0], pmacc[1]); w.y = cvtpk(pmacc[2], pmacc[3]); *(LAS v2u*)(PMB + t * LD32 + s) = w; }
        __syncthreads();
#pragma unroll
        for (int ns = 0; ns < 5; ++ns) { const int cb = ns & 1, nb = cb ^ 1;
            const LAS bf16* Xc = XB_ + cb * 32 * LD32; const LAS bf16* XTc = XTB + cb * 32 * LD32; const LAS bf16* Pc = PMB + cb * 32 * LD32;
            LAS bf16* Xn = XB_ + nb * 32 * LD32; LAS bf16* XTn = XTB + nb * 32 * LD32; LAS bf16* Pn = PMB + nb * 32 * LD32;
            if (wave < 4) { if (ns < 4) { const int tq = (wave >> 1) * 16, sq = (wave & 1) * 16;
                    f32x4 a4 = (f32x4){0.f, 0.f, 0.f, 0.f}; a4 = MFMA16(FRAG(XTc, sq, LD32, 0), FRAG(Xc, tq, LD32, 0), a4);
                    const int t = tq + fr, s = sq + fq * 4;
#pragma unroll
                    for (int r = 0; r < 4; ++r) XTn[(s + r) * LD32 + t] = (bf16)(cvtpk(a4[r], 0.f) & 0xffffu);
                    v2u w; w.x = cvtpk(a4[0], a4[1]); w.y = cvtpk(a4[2], a4[3]); *(LAS v2u*)(Xn + t * LD32 + s) = w; } }
            else { const int q = wave - 4, tq = (q >> 1) * 16, sq = (q & 1) * 16;
                if (ns > 0) pmacc = MFMA16(FRAG(XTc, sq, LD32, 0), FRAG(Pc, tq, LD32, 0), pmacc);
                const int t = tq + fr, s = sq + fq * 4;
                v2u w; w.x = cvtpk(pmacc[0], pmacc[1]); w.y = cvtpk(pmacc[2], pmacc[3]); *(LAS v2u*)(Pn + t * LD32 + s) = w; }
            if (ns == 1) {
                f32x4 a4 = (f32x4){0.f, 0.f, 0.f, 0.f};
#pragma unroll
                for (int ks = 0; ks < 2; ++ks) a4 = MFMA16(FRAG(AT, t0m, LD64, ks), FRAG(S0c, i0, LD64, ks), a4);
                a4 = MFMA16(FRAG(AAK, t0m, LD32, 0), FRAGT(VS, i0, LD64), a4);
                v2u w; w.x = cvtpk(a4[0], a4[1]); w.y = cvtpk(a4[2], a4[3]); *(LAS v2u*)(RHS + (i0 + fr) * LD32 + t0m + fq * 4) = w; }
            if (ns == 2) {
                yacc = (f32x4){0.f, 0.f, 0.f, 0.f};
#pragma unroll
                for (int ks = 0; ks < 2; ++ks) yacc = MFMA16(FRAG(S0c, i0, LD64, ks), FRAG(RT, t0m, LD64, ks), yacc);
                yacc = MFMA16(FRAGT(VS, i0, LD64), FRAG(ARK, t0m, LD32, 0), yacc); }
            if (ns == 3) {
#pragma unroll
                for (int u = 0; u < 2; ++u) { const int tile = wave * 2 + u, si0 = (tile >> 2) * 16, sj0 = (tile & 3) * 16; sacc[u] = MFMA16(FRAGT(KT_, sj0, LD64), FRAGT(VS, si0, LD64), sacc[u]); } }
            __syncthreads();
        }
        const LAS bf16* MINV = PMB + 1 * 32 * LD32;
        { f32x4 a4 = (f32x4){0.f, 0.f, 0.f, 0.f}; a4 = MFMA16(FRAG(MINV, t0m, LD32, 0), FRAG(RHS, i0, LD32, 0), a4);
          v2u w; w.x = cvtpk(a4[0], a4[1]); w.y = cvtpk(a4[2], a4[3]); *(LAS v2u*)(SAB + (i0 + fr) * LD32 + t0m + fq * 4) = w; }
        __syncthreads();
        { yacc = MFMA16(FRAG(SAB, i0, LD32, 0), FRAG(ARB, t0m, LD32, 0), yacc);
          *(LAS f32x4*)(YB + (t0m + fr) * 68 + i0 + fq * 4) = yacc;
#pragma unroll
          for (int u = 0; u < 2; ++u) { const int tile = wave * 2 + u, si0 = (tile >> 2) * 16, sj0 = (tile & 3) * 16;
              sacc[u] = MFMA16(FRAGT(BT_, sj0, LD64), FRAG(SAB, si0, LD32, 0), sacc[u]);
              const f32x4 pc = *(const LAS f32x4*)(PC + sj0 + fq * 4); sacc[u] = sacc[u] * pc;
              v2u w; w.x = cvtpk(sacc[u][0], sacc[u][1]); w.y = cvtpk(sacc[u][2], sacc[u][3]); *(LAS v2u*)(S0n + (si0 + fr) * LD64 + sj0 + fq * 4) = w; } }
        __syncthreads();
    }
    __syncthreads();
#undef FRAG
#undef FRAGT
#undef RWKV_PREFETCH
}
__device__ __forceinline__ void lora_prepass(const Frame& F) {
    const bf16* PROJ = WSP(bf16, WS_PROJ); bf16* LA = WSP(bf16, WS_LA); const float* mu = F.in[I_MU] + (PC_WD - RWKV_C0);
    const int gt = (F.bid * NWAVES + F.wave) * 64 + F.lane, NGT = F.G * NTHR;
    for (int i = gt; i < T * 36; i += NGT) { const int tok = i / 36, cc = i - tok * 36, m = cc * 8;
        const bf16* pr = PROJ + (size_t)tok * NINP + PC_WD + m;
        const v4u curv = *(const v4u*)pr; v4u prv = (v4u){0u, 0u, 0u, 0u}; if ((tok & (SEQ - 1)) != 0) prv = *(const v4u*)(pr - NINP);
        const f32x4 m0 = *(const f32x4*)(mu + m), m1 = *(const f32x4*)(mu + m + 4);
        float c[8], p[8], o[8]; unpack8(curv, c); unpack8(prv, p);
#pragma unroll
        for (int e = 0; e < 8; ++e) { const float ps = c[e] + (p[e] - c[e]) * (e < 4 ? m0[e] : m1[e - 4]); o[e] = (m < 64) ? tanh_fast(ps) : ((m < 128) ? ps : sigmoid_fast(ps)); }
        v4u w; w.x = cvtpk(o[0], o[1]); w.y = cvtpk(o[2], o[3]); w.z = cvtpk(o[4], o[5]); w.w = cvtpk(o[6], o[7]);
        *(v4u*)(LA + (size_t)tok * 288 + m) = w; }
}
__device__ __forceinline__ void lru_seq(const Frame& F, int bh) {
    const int b = bh >> 3, h = bh & 7, wave = F.wave; int tid = F.tid; asm volatile("" : "+v"(tid)); const int lane = tid & 63;
    LAS unsigned char* L = F.lds;
    LAS bf16* XA = (LAS bf16*)(L + 0);
    LAS float* XC = (LAS float*)(L + 17408);
    LAS float* RI = (LAS float*)(L + 50176);
    LAS float* SEG = (LAS float*)(L + 115712);
    LAS float* CARRY = (LAS float*)(L + 119808);
    LAS float* CW = (LAS float*)(L + 120320);
    const bf16* PROJ = WSP(bf16, WS_PROJ); bf16* Y = WSP(bf16, WS_Y);
    const int fr0 = lane & 15, fq0 = lane >> 4;
    for (int i = tid; i < 640; i += NTHR) { const int w = i >> 7, cch = i & 127; CW[i] = (w < 4) ? F.in[I_CONVW][w * 1024 + h * 128 + cch] : F.in[I_CONVB][h * 128 + cch]; }
    if (tid < 128) CARRY[tid] = 0.f;
    const int gsel = wave & 1, nt0 = (wave >> 1) * 2;
    bf16x8 wf[2][4];
    { const bf16* WTp = (gsel ? WSP(bf16, WS_WIT) : WSP(bf16, WS_WAT)) + (size_t)h * 128 * 128;
#pragma unroll
      for (int n = 0; n < 2; ++n)
#pragma unroll
          for (int ks = 0; ks < 4; ++ks) wf[n][ks] = *(const bf16x8*)(WTp + ((nt0 + n) * 16 + fr0) * 128 + ks * 32 + 8 * fq0); }
    const int c = tid & 127, sg = tid >> 7, chg = h * 128 + c;
    const float ba_c = F.in[I_BA][chg], bi_c = F.in[I_BI][chg], sp8 = 8.0f * softplus_fast(-F.in[I_LAM][chg]);
    v4u pf[2][4];
#define LRU_PREFETCH(k_) do { _Pragma("unroll") for (int u_ = 0; u_ < 2; ++u_) { const int chn_ = tid + NTHR * u_, t_ = chn_ >> 4, c8_ = (chn_ & 15) * 8; \
        _Pragma("unroll") for (int w_ = 0; w_ < 4; ++w_) { const int ts_ = (k_) * 64 + t_ - 3 + w_; const int tc_ = ts_ >= 0 ? ts_ : 0;   \
            const v4u x_ = *(const v4u*)(PROJ + ((size_t)b * SEQ + tc_) * NINP + h * 128 + c8_); const unsigned m_ = ts_ >= 0 ? 0xffffffffu : 0u; \
            pf[u_][w_] = (v4u){x_.x & m_, x_.y & m_, x_.z & m_, x_.w & m_}; } } } while (0)
    LRU_PREFETCH(0);
    __syncthreads();
    for (int k = 0; k < SEQ / 64; ++k) {
        const size_t tokbase = (size_t)b * SEQ + k * 64;
        int lane_c = lane; asm volatile("" : "+v"(lane_c)); const int fr = lane_c & 15, fq = lane_c >> 4;
#pragma unroll
        for (int u = 0; u < 2; ++u) { const int chn = tid + NTHR * u, t = chn >> 4, c8 = (chn & 15) * 8;
            float acc[8]; { const f32x4 b0 = *(const LAS f32x4*)(CW + 512 + c8), b1 = *(const LAS f32x4*)(CW + 512 + c8 + 4);
#pragma unroll
                for (int e = 0; e < 4; ++e) { acc[e] = b0[e]; acc[e + 4] = b1[e]; } }
#pragma unroll
            for (int w = 0; w < 4; ++w) { float xf[8]; unpack8(pf[u][w], xf);
                const f32x4 w0 = *(const LAS f32x4*)(CW + w * 128 + c8), w1 = *(const LAS f32x4*)(CW + w * 128 + c8 + 4);
#pragma unroll
                for (int e = 0; e < 4; ++e) { acc[e] += w0[e] * xf[e]; acc[e + 4] += w1[e] * xf[e + 4]; } }
            v4u pk; pk.x = cvtpk(acc[0], acc[1]); pk.y = cvtpk(acc[2], acc[3]); pk.z = cvtpk(acc[4], acc[5]); pk.w = cvtpk(acc[6], acc[7]);
            *(LAS v4u*)(XA + t * 136 + c8) = pk;
            LAS float* d = XC + t * 128 + c8; *(LAS f32x4*)d = (f32x4){acc[0], acc[1], acc[2], acc[3]}; *(LAS f32x4*)(d + 4) = (f32x4){acc[4], acc[5], acc[6], acc[7]}; }
        { const int kn_ = k + 1 < SEQ / 64 ? k + 1 : SEQ / 64 - 1; LRU_PREFETCH(kn_); }
        unsigned short gt[16];
#pragma unroll
        for (int e = 0; e < 16; ++e) gt[e] = PROJ[(tokbase + sg * 16 + e) * NINP + PC_GATE + chg];
        __syncthreads();
#pragma unroll
        for (int mt = 0; mt < 4; ++mt) {
            bf16x8 af[4];
#pragma unroll
            for (int ks = 0; ks < 4; ++ks) af[ks] = *(const LAS bf16x8*)(XA + (mt * 16 + fr) * 136 + ks * 32 + 8 * fq);
#pragma unroll
            for (int n = 0; n < 2; ++n) { f32x4 a4 = (f32x4){0.f, 0.f, 0.f, 0.f};
#pragma unroll
                for (int ks = 0; ks < 4; ++ks) a4 = MFMA16(wf[n][ks], af[ks], a4);
                *(LAS f32x4*)(RI + gsel * 8192 + (mt * 16 + fr) * 128 + (nt0 + n) * 16 + fq * 4) = a4; } }
        __syncthreads();
        float av[16], bx[16]; float A = 1.f, B = 0.f;
#pragma unroll
        for (int e = 0; e < 16; ++e) { const int t = sg * 16 + e; const float r = sigmoid_fast(RI[t * 128 + c] + ba_c), ig = sigmoid_fast(RI[8192 + t * 128 + c] + bi_c), xc = XC[t * 128 + c];
            const float la = -sp8 * r; av[e] = __expf(la); bx[e] = sqrtf(fmaxf(1.0f - av[e] * av[e], 0.f)) * (ig * xc); A *= av[e]; B = av[e] * B + bx[e]; }
        SEG[(sg * 128 + c) * 2] = A; SEG[(sg * 128 + c) * 2 + 1] = B;
        __syncthreads();
        float hst = CARRY[c];
        for (int s2 = 0; s2 < sg; ++s2) hst = SEG[(s2 * 128 + c) * 2] * hst + SEG[(s2 * 128 + c) * 2 + 1];
#pragma unroll
        for (int e = 0; e < 16; ++e) { hst = av[e] * hst + bx[e];
            const float g = __uint_as_float((unsigned)gt[e] << 16);
            Y[(tokbase + sg * 16 + e) * D + chg] = (bf16)(cvtpk(hst * gelu_fast(g), 0.f) & 0xffffu); }
        __syncthreads();
        if (sg == 3) CARRY[c] = hst;
    }
    __syncthreads();
#undef LRU_PREFETCH
}
__device__ __forceinline__ void group_barrier(unsigned* cnt, unsigned n) {
    asm volatile("s_waitcnt vmcnt(0)" ::: "memory");
    __syncthreads();
    if (threadIdx.x == 0) {
        __builtin_amdgcn_fence(__ATOMIC_RELEASE, "agent");
        asm volatile("s_waitcnt vmcnt(0)" ::: "memory");
        xb_add(cnt, 1u);
        unsigned sp = 0; while (xb_ld(cnt) < n) { __builtin_amdgcn_s_sleep(2); if (++sp > (1u << 24)) break; }
        __builtin_amdgcn_fence(__ATOMIC_ACQUIRE, "agent");
        asm volatile("s_waitcnt vmcnt(0)" ::: "memory");
    }
    __syncthreads();
}

__device__ __forceinline__ unsigned f2ord(float f) { const unsigned u = __builtin_bit_cast(unsigned, f); return (u & 0x80000000u) ? ~u : (u | 0x80000000u); }
__device__ __forceinline__ float ord2f(unsigned o) { const unsigned u = (o & 0x80000000u) ? (o & 0x7fffffffu) : ~o; return __builtin_bit_cast(float, u); }
#define CMPX(hi_, lo_) do { const unsigned _a = (hi_), _b = (lo_); (hi_) = _a > _b ? _a : _b; (lo_) = _a > _b ? _b : _a; } while (0)
template <int N> __device__ __forceinline__ void sort_desc(unsigned (&a)[N]) {
#pragma unroll
    for (int k = 2; k <= N; k <<= 1)
#pragma unroll
        for (int j = k >> 1; j > 0; j >>= 1)
#pragma unroll
            for (int i = 0; i < N; ++i) { const int l = i ^ j; if (l > i) { if ((i & k) == 0) CMPX(a[i], a[l]); else CMPX(a[l], a[i]); } }
}
__device__ __forceinline__ void merge16(unsigned (&A)[16], const unsigned (&B)[16]) {
#pragma unroll
    for (int i = 0; i < 16; ++i) { const unsigned q = B[15 - i]; A[i] = A[i] > q ? A[i] : q; }
#pragma unroll
    for (int d = 8; d >= 1; d >>= 1)
#pragma unroll
        for (int i = 0; i < 16; ++i) if ((i & d) == 0) CMPX(A[i], A[i + d]);
}
__device__ __forceinline__ void merge_partner(unsigned (&Lk)[16]) {
    unsigned P[16];
#pragma unroll
    for (int i = 0; i < 16; ++i) P[i] = (unsigned)__shfl_xor((int)Lk[i], 32);
#pragma unroll
    for (int i = 0; i < 16; ++i) { const unsigned q = P[15 - i]; Lk[i] = Lk[i] > q ? Lk[i] : q; }
#pragma unroll
    for (int d = 8; d >= 1; d >>= 1)
#pragma unroll
        for (int i = 0; i < 16; ++i) if ((i & d) == 0) CMPX(Lk[i], Lk[i + d]);
}
__device__ __forceinline__ void route_item(const Frame& F, int item, int lane) {
    const int tok0 = (item >> 3) * 32, h = item & 7, c = lane & 31, hi = lane >> 5;
    const bf16* Q = WSP(bf16, WS_Q); const bf16* KB = WSP(bf16, WS_KEYS);
    LAS unsigned* WL = (LAS unsigned*)(F.lds + F.wave * 8192);
    unsigned LST[2][16];
    bf16x8 qf[8], qn[8], kf[8], kn[8];
#pragma unroll
    for (int ks = 0; ks < 8; ++ks) { qf[ks] = *(const bf16x8*)(Q + (size_t)(tok0 + c) * D + h * 256 + ks * 16 + 8 * hi); qn[ks] = *(const bf16x8*)(Q + (size_t)(tok0 + c) * D + h * 256 + 128 + ks * 16 + 8 * hi);
        kf[ks] = *(const bf16x8*)(KB + (size_t)((h * 2) * 128 + c) * 128 + 8 * hi + ks * 16); }
    unsigned Lk[16];
#pragma unroll
    for (int st = 0; st < 8; ++st) { const int p = st >> 2, m = st & 3;
        if (st < 7) { const int p2 = (st + 1) >> 2, m2 = (st + 1) & 3; const bf16* kp = KB + (size_t)((h * 2 + p2) * 128 + m2 * 32 + c) * 128 + 8 * hi;
#pragma unroll
            for (int ks = 0; ks < 8; ++ks) kn[ks] = *(const bf16x8*)(kp + ks * 16); }
        f32x16 acc;
#pragma unroll
        for (int r = 0; r < 16; ++r) acc[r] = 0.f;
#pragma unroll
        for (int ks = 0; ks < 8; ++ks) acc = MFMA32(kf[ks], p ? qn[ks] : qf[ks], acc);
        unsigned G16[16];
#pragma unroll
        for (int r = 0; r < 16; ++r) { const unsigned idx = (unsigned)(m * 32 + (r & 3) + 8 * (r >> 2)) | ((unsigned)hi << 2); G16[r] = (f2ord(acc[r]) & ~0x7Fu) | idx; }
        sort_desc<16>(G16);
        if (m == 0) {
#pragma unroll
            for (int i = 0; i < 16; ++i) Lk[i] = G16[i]; }
        else merge16(Lk, G16);
        if (m == 3) { merge_partner(Lk);
#pragma unroll
            for (int i = 0; i < 16; ++i) { LST[p][i] = Lk[i]; WL[(p * 16 + i) * 64 + lane] = Lk[i] & 0x7Fu; } }
#pragma unroll
        for (int ks = 0; ks < 8; ++ks) kf[ks] = kn[ks];
    }
    float va[4], vb[16];
#pragma unroll
    for (int i = 0; i < 4; ++i) va[i] = ord2f((hi ? LST[1][i] : LST[0][i]) & ~0x7Fu);
#pragma unroll
    for (int j = 0; j < 16; ++j) vb[j] = ord2f((hi ? LST[0][j] : LST[1][j]) & ~0x7Fu);
    unsigned C32[32];
#pragma unroll
    for (int i = 0; i < 32; ++i) C32[i] = 0u;
#pragma unroll
    for (int i = 0; i < 4; ++i) { const unsigned key = (f2ord(va[i] + vb[i]) & ~0xFFu) | (unsigned)(i * 17); C32[i] = hi ? 0u : key; }
    { int cn = 4;
#pragma unroll
      for (int i = 0; i < 3; ++i)
#pragma unroll
          for (int j = i + 1; j < 16; ++j) if ((i + 1) * (j + 1) <= 16) { const unsigned code = hi ? (unsigned)(j * 16 + i) : (unsigned)(i * 16 + j); C32[cn] = (f2ord(va[i] + vb[j]) & ~0xFFu) | code; ++cn; } }
    sort_desc<32>(C32);
    unsigned Ck[16];
#pragma unroll
    for (int i = 0; i < 16; ++i) Ck[i] = C32[i];
    merge_partner(Ck);
    const float mx = ord2f(Ck[0] & ~0xFFu); float den = 0.f;
#pragma unroll
    for (int k = 0; k < 16; ++k) den += __expf(ord2f(Ck[k] & ~0xFFu) - mx);
    const float rden = 1.0f / den;
    int eo[8]; float go[8];
#pragma unroll
    for (int k = 0; k < 8; ++k) { const unsigned fm = hi ? Ck[k + 8] : Ck[k]; const unsigned code = fm & 0xFFu;
        const unsigned k0 = WL[(code >> 4) * 64 + lane], k1 = WL[(16 + (code & 15u)) * 64 + lane];
        eo[k] = (int)(k0 * 128u + k1); go[k] = __expf(ord2f(fm & ~0xFFu) - mx) * rden; }
    int* ep = WSP(int, WS_EXP) + (size_t)(tok0 + c) * NSEL + h * 16 + hi * 8; float* gp = WSP(float, WS_GATE) + (size_t)(tok0 + c) * NSEL + h * 16 + hi * 8;
    *(int4*)ep = make_int4(eo[0], eo[1], eo[2], eo[3]); *(int4*)(ep + 4) = make_int4(eo[4], eo[5], eo[6], eo[7]);
    *(f32x4*)gp = (f32x4){go[0], go[1], go[2], go[3]}; *(f32x4*)(gp + 4) = (f32x4){go[4], go[5], go[6], go[7]};
}

typedef float f32x2 __attribute__((ext_vector_type(2)));
__device__ __forceinline__ int dot4i(unsigned a, unsigned b, int c) { return __builtin_amdgcn_sdot4((int)a, (int)b, c, false); }
template <int CTRL> __device__ __forceinline__ int dppi(int x) { return __builtin_amdgcn_mov_dpp(x, CTRL, 0xf, 0xf, true); }
struct PeerGeom { int ngrp, g, rank, nrank; };
__device__ __forceinline__ PeerGeom peer_geom(const Frame& F) { PeerGeom p; p.ngrp = (F.G % 8 == 0) ? 8 : 1; p.g = F.bid % p.ngrp; p.rank = F.bid / p.ngrp; p.nrank = F.G / p.ngrp; return p; }
__device__ __forceinline__ void xquant_token(const Frame& F, int tok, int lane) {
    const bf16* xr = WSP(bf16, WS_XB) + (size_t)tok * D + lane * 16; float xf[32]; float am = 0.f;
#pragma unroll
    for (int hh = 0; hh < 2; ++hh)
#pragma unroll
        for (int q = 0; q < 2; ++q) { const v4u w = *(const v4u*)(xr + hh * 1024 + q * 8); float t8[8]; unpack8(w, t8);
#pragma unroll
            for (int e = 0; e < 8; ++e) { xf[hh * 16 + q * 8 + e] = t8[e]; am = fmaxf(am, fabsf(t8[e])); } }
#pragma unroll
    for (int o = 1; o < 64; o <<= 1) am = fmaxf(am, __shfl_xor(am, o));
    const float qs = am > 0.f ? 127.0f / am : 0.f;
    if (lane == 0) WSP(float, WS_SX)[tok] = am * (1.0f / 127.0f);
#pragma unroll
    for (int hh = 0; hh < 2; ++hh) { v4u o;
#pragma unroll
        for (int d = 0; d < 4; ++d) { unsigned w = 0u;
#pragma unroll
            for (int e = 0; e < 4; ++e) { const int qi = (int)rintf(xf[hh * 16 + d * 4 + e] * qs); w |= ((unsigned)qi & 0xFFu) << (8 * e); }
            o[d] = w; }
        *(v4u*)(WSP(unsigned char, WS_XQ) + (size_t)tok * D + hh * 1024 + lane * 16) = o; }
}
__device__ __forceinline__ void peer_score_slice(const Frame& F, int tok, int slice, int lane, LAS int* wl) {
    const int e8 = lane >> 3, c16 = lane & 7;
    const int* ep = WSP(int, WS_EXP) + (size_t)tok * NSEL;
    wl[lane] = ep[lane]; wl[64 + lane] = ep[64 + lane];
    const v4u xs = *(const v4u*)(WSP(unsigned char, WS_XQ) + (size_t)tok * D + slice * 128 + c16 * 16);
    const unsigned char* ub = WSP(unsigned char, WS_UT); const unsigned lo = (unsigned)(slice * 128 + c16 * 16);
    int p[16];
#pragma unroll
    for (int ld = 0; ld < 16; ++ld) { const unsigned eid = (unsigned)wl[e8 * 16 + ld]; const v4u w = *(const v4u*)(ub + (eid * 2048u + lo));
        int a = dot4i(w.x, xs.x, 0); a = dot4i(w.y, xs.y, a); a = dot4i(w.z, xs.z, a); p[ld] = dot4i(w.w, xs.w, a); }
    { const bool up = (lane & 4) != 0;
#pragma unroll
      for (int k = 0; k < 8; ++k) { const int keep = up ? p[k + 8] : p[k], send = up ? p[k] : p[k + 8]; p[k] = keep + dppi<0x141>(send); } }
    { const bool up = (lane & 2) != 0;
#pragma unroll
      for (int k = 0; k < 4; ++k) { const int keep = up ? p[k + 4] : p[k], send = up ? p[k] : p[k + 4]; p[k] = keep + dppi<0x4E>(send); } }
    { const bool up = (lane & 1) != 0;
#pragma unroll
      for (int k = 0; k < 2; ++k) { const int keep = up ? p[k + 2] : p[k], send = up ? p[k] : p[k + 2]; p[k] = keep + dppi<0xB1>(send); } }
    int* dst = WSP(int, WS_PART) + ((size_t)slice * T + tok) * NSEL + lane * 2;
    *(int2*)dst = make_int2(p[0], p[1]);
}
__device__ __forceinline__ void peer_coef_token(const Frame& F, int tok, int lane) {
    int s0 = 0, s1 = 0;
#pragma unroll
    for (int s = 0; s < 16; ++s) { const int2 v = *(const int2*)(WSP(int, WS_PART) + ((size_t)s * T + tok) * NSEL + lane * 2); s0 += v.x; s1 += v.y; }
    const int2 ex = *(const int2*)(WSP(int, WS_EXP) + (size_t)tok * NSEL + lane * 2); const f32x2 ga = *(const f32x2*)(WSP(float, WS_GATE) + (size_t)tok * NSEL + lane * 2);
    const float rs = WSP(float, WS_SX)[tok] * (1.0f / sqrtf(WSP(float, WS_SSQ2)[tok] * (1.0f / D) + NORM_EPS));
    const float sc0 = (float)s0 * WSP(float, WS_USC)[ex.x] * rs, sc1 = (float)s1 * WSP(float, WS_USC)[ex.y] * rs;
    f32x2 c; c.x = ga.x * gelu_fast(sc0) * WSP(float, WS_VSC)[ex.x]; c.y = ga.y * gelu_fast(sc1) * WSP(float, WS_VSC)[ex.y];
    float cm = fmaxf(fabsf(c.x), fabsf(c.y));
#pragma unroll
    for (int o = 1; o < 64; o <<= 1) cm = fmaxf(cm, __shfl_xor(cm, o));
    const float qs = cm > 0.f ? 127.0f / cm : 0.f;
    const int q0 = (int)rintf(c.x * qs), q1 = (int)rintf(c.y * qs);
    ((unsigned short*)(F.ws + WS_COEF))[(size_t)tok * 64 + lane] = (unsigned short)(((unsigned)q0 & 0xFFu) | (((unsigned)q1 & 0xFFu) << 8));
    if (lane == 0) WSP(float, WS_CSC)[tok] = cm * (1.0f / 127.0f);
}
struct PeerOutBuf { v4u w[16]; v4u cq; f32x2 x; float cs; };
__device__ __forceinline__ void peer_out_issue(const Frame& F, int tok, int slice, int lane, LAS int* wl, PeerOutBuf& B) {
    const int e8 = lane >> 3, c16 = lane & 7;
    const int* ep = WSP(int, WS_EXP) + (size_t)tok * NSEL;
    wl[lane] = ep[lane]; wl[64 + lane] = ep[64 + lane];
    B.cq = *(const v4u*)(F.ws + WS_COEF + (size_t)tok * 128 + e8 * 16);
    B.cs = WSP(float, WS_CSC)[tok];
    const unsigned char* vb = WSP(unsigned char, WS_VT); const unsigned lofs = (unsigned)(slice * 128 + c16 * 16);
#pragma unroll
    for (int ld = 0; ld < 16; ++ld) { const unsigned eid = (unsigned)wl[e8 * 16 + ld]; B.w[ld] = *(const v4u*)(vb + (eid * 2048u + lofs)); }
    B.x = *(const f32x2*)(F.out + (size_t)tok * D + slice * 128 + c16 * 16 + e8 * 2);
}
__device__ __forceinline__ void peer_out_consume(const Frame& F, int tok, int slice, int lane, LAS int* wl, const PeerOutBuf& B) {
    const int e8 = lane >> 3, c16 = lane & 7;
    int o[16];
#pragma unroll
    for (int i = 0; i < 16; ++i) o[i] = 0;
#pragma unroll
    for (int g = 0; g < 4; ++g) { const unsigned cq = B.cq[g];
#pragma unroll
        for (int d = 0; d < 4; ++d) { const unsigned w0 = B.w[4 * g][d], w1 = B.w[4 * g + 1][d], w2 = B.w[4 * g + 2][d], w3 = B.w[4 * g + 3][d];
            const unsigned lo01 = __builtin_amdgcn_perm(w1, w0, 0x05010400u), hi01 = __builtin_amdgcn_perm(w1, w0, 0x07030602u);
            const unsigned lo23 = __builtin_amdgcn_perm(w3, w2, 0x05010400u), hi23 = __builtin_amdgcn_perm(w3, w2, 0x07030602u);
            const unsigned t0 = __builtin_amdgcn_perm(lo23, lo01, 0x05040100u), t1 = __builtin_amdgcn_perm(lo23, lo01, 0x07060302u);
            const unsigned t2 = __builtin_amdgcn_perm(hi23, hi01, 0x05040100u), t3 = __builtin_amdgcn_perm(hi23, hi01, 0x07060302u);
            o[d * 4 + 0] = dot4i(t0, cq, o[d * 4 + 0]); o[d * 4 + 1] = dot4i(t1, cq, o[d * 4 + 1]); o[d * 4 + 2] = dot4i(t2, cq, o[d * 4 + 2]); o[d * 4 + 3] = dot4i(t3, cq, o[d * 4 + 3]); } }
#pragma unroll
    for (int k = 0; k < 8; ++k) { auto s = __builtin_amdgcn_permlane32_swap((unsigned)o[k], (unsigned)o[k + 8], false, false); o[k] = (int)(s[0] + s[1]); }
#pragma unroll
    for (int k = 0; k < 4; ++k) { auto s = __builtin_amdgcn_permlane16_swap((unsigned)o[k], (unsigned)o[k + 4], false, false); o[k] = (int)(s[0] + s[1]); }
    { const bool up = (lane & 8) != 0;
#pragma unroll
      for (int k = 0; k < 2; ++k) { const int keep = up ? o[k + 2] : o[k], send = up ? o[k] : o[k + 2]; o[k] = keep + dppi<0x128>(send); } }
    f32x2 x = B.x; x.x += (float)o[0] * B.cs; x.y += (float)o[1] * B.cs;
    *(f32x2*)(F.out + (size_t)tok * D + slice * 128 + c16 * 16 + e8 * 2) = x;
    float ss = x.x * x.x + x.y * x.y;
    ss += dppf<0xB1>(ss); ss += dppf<0x4E>(ss); ss += dppf<0x141>(ss); ss += dppf<0x140>(ss);
    { auto s = __builtin_amdgcn_permlane16_swap(__float_as_uint(ss), __float_as_uint(ss), false, false); ss = __uint_as_float(s[0]) + __uint_as_float(s[1]); }
    { auto s = __builtin_amdgcn_permlane32_swap(__float_as_uint(ss), __float_as_uint(ss), false, false); ss = __uint_as_float(s[0]) + __uint_as_float(s[1]); }
    if (lane == 0) atomicAdd(WSP(float, WS_SSQ3) + tok, ss);
}
__device__ __forceinline__ void peer_out_phase(const Frame& F, const PeerGeom& pg, LAS int* wl2) {
    const int lane = F.lane, first = pg.rank * NWAVES + F.wave, step = pg.nrank * NWAVES;
    LAS int* wlA = wl2; LAS int* wlB = wl2 + 256;
    for (int r = 0; r < 16 / pg.ngrp; ++r) { const int slice = r * pg.ngrp + pg.g;
        PeerOutBuf A, B;
        int tok = first;
        if (tok < T) peer_out_issue(F, tok, slice, lane, wlA, A);
        while (tok < T) {
            const int t1 = tok + step, t2 = tok + 2 * step;
            if (t1 < T) peer_out_issue(F, t1, slice, lane, wlB, B);
            peer_out_consume(F, tok, slice, lane, wlA, A);
            if (t1 >= T) break;
            if (t2 < T) peer_out_issue(F, t2, slice, lane, wlA, A);
            peer_out_consume(F, t1, slice, lane, wlB, B);
            tok = t2;
        }
    }
}
__device__ __forceinline__ void final_norm_phase(const Frame& F) {
    const int lane = F.lane, gw = F.bid * NWAVES + F.wave, NGW = F.G * NWAVES;
    const f32x4* gf = (const f32x4*)F.in[I_GF] + lane;
    f32x4 g[8];
#pragma unroll
    for (int j = 0; j < 8; ++j) g[j] = gf[64 * j];
    if (gw >= T) return;
    f32x4 va[8], vb[8]; float sa, sb;
#define FN_LOAD(v_, s_, tok_) do { const int tc_ = (tok_) < T ? (tok_) : T - 1; const f32x4* xi_ = (const f32x4*)(F.out + (size_t)tc_ * D) + lane; s_ = WSP(float, WS_SSQ3)[tc_]; \
        _Pragma("unroll") for (int j_ = 0; j_ < 8; ++j_) v_[j_] = xi_[64 * j_]; } while (0)
#define FN_STORE(v_, s_, tok_) do { f32x4* xo_ = (f32x4*)(F.out + (size_t)(tok_) * D) + lane; const float rs_ = 1.0f / sqrtf(s_ * (1.0f / D) + NORM_EPS); \
        _Pragma("unroll") for (int j_ = 0; j_ < 8; ++j_) xo_[64 * j_] = v_[j_] * rs_ * g[j_]; } while (0)
    FN_LOAD(va, sa, gw);
    for (int tok = gw; tok < T; tok += 2 * NGW) {
        FN_LOAD(vb, sb, tok + NGW);
        FN_STORE(va, sa, tok);
        FN_LOAD(va, sa, tok + 2 * NGW);
        if (tok + NGW < T) FN_STORE(vb, sb, tok + NGW);
    }
#undef FN_LOAD
#undef FN_STORE
}

struct Args { const float* in[28]; float* out; unsigned char* ws; int ph_lo, ph_hi, li, pad; };
__global__ void __launch_bounds__(NTHR, 2) hybrid_fwd(Args args) {
    extern __shared__ __attribute__((aligned(16))) unsigned char lds[];
    Frame F;
    F.lds = (LAS unsigned char*)lds;
    F.tid = threadIdx.x; F.lane = F.tid & 63; F.wave = __builtin_amdgcn_readfirstlane(F.tid >> 6);
    F.G = gridDim.x; F.bid = blockIdx.x;
#pragma unroll
    for (int i = 0; i < 28; ++i) F.in[i] = args.in[i];
    F.out = args.out; F.ws = args.ws;
    volatile LAS unsigned* MISC = (volatile LAS unsigned*)(F.lds + MISC_OFF);
    for (int u = F.tid; u < (LDS_BYTES - LDSCTL_OFF) / 4; u += NTHR) ((LAS unsigned*)(F.lds + LDSCTL_OFF))[u] = 0u;
    __syncthreads();
    unsigned* barw = (unsigned*)(F.ws + WS_CTL) + CW_BAR;
    XcdBarrier bar; bar.bar = barw; bar.x = 0; bar.st = nullptr;
    if (N_LAUNCHES == 1) bar = xcd_barrier_post(barw, MISC + 8);
    const int lo = args.ph_lo, hi = args.ph_hi;
#define IN(k) (lo <= (k) && (k) < hi)
#define SEAM(k) do { if (IN(k) && IN((k) + 1)) xcd_barrier(bar); } while (0)

#ifndef PROBE_DUP
#define PROBE_DUP -1
#endif
#define REPS(k) for (int rep_ = 0; rep_ < ((PROBE_DUP) == (k) ? 2 : 1); ++rep_)
    if (IN(0)) REPS(0) { p0_prologue<0>(F, F.bid, F.G); __syncthreads(); }
    SEAM(0);
    if (IN(1)) REPS(1) {
        pg8::Gemm g{WSP(const bf16, WS_XB), WSP(const bf16, WS_WIN), T, NINP, D / 2}; pg8::StaticOrder S; S.init(T, NINP, F.G, F.bid);
        pg8::EpiI8RowColBf16<0> E{WSP(bf16, WS_PROJ), NINP, WSP(const float, WS_RSTD1), WSP(const float, WS_CS1), nullptr, NORM_EPS};
        pg8::gemm_phase<pg8::EpiI8RowColBf16<0>, pg8::StaticOrder, true, true, true>(F.lds, g, S, E);
    }
    SEAM(1);
    if (IN(2)) REPS(2) {
        lora_prepass(F);
        group_barrier((unsigned*)(F.ws + WS_CTL) + CW_PREBAR, (unsigned)F.G);
        for (int r4 = 0; r4 < ((PROBE_DUP) == 70 ? 2 : 1); ++r4) rwkv_prep_phase(F);
        group_barrier((unsigned*)(F.ws + WS_CTL) + CW_PREPBAR, (unsigned)F.G);
        const int R1 = F.G >= 256 ? 128 : F.G, L0 = F.G >= 256 ? 128 : 0, NL = F.G - L0;
        if (F.bid < R1) for (int it = F.bid; it < 128; it += R1) rwkv_item(F, it);
        if (F.bid >= L0) for (int it = F.bid - L0; it < 64; it += NL) lru_seq(F, it);
        { volatile LAS int* qslot = (volatile LAS int*)(F.lds + LDSCTL_OFF + 1024);
          for (;;) { __syncthreads(); if (F.tid == 0) *qslot = (int)xb_add((unsigned*)(F.ws + WS_CTL) + CW_DEFQ, 1u); __syncthreads();
              const int vb = *qslot; if (vb >= 1024) break; p0_prologue<1>(F, vb, 1024); } }
    }
    SEAM(2);
    if (IN(3)) {
        pg8::Gemm g{WSP(const bf16, WS_Y), WSP(const bf16, WS_WOUT), T, D, D}; pg8::StaticOrder S; S.init(T, D, F.G, F.bid);
        pg8::EpiResidual E{F.in[I_X], F.out, WSP(bf16, WS_XB), WSP(float, WS_SSQ2), D};
        pg8::gemm_phase<pg8::EpiResidual, pg8::StaticOrder, true, true>(F.lds, g, S, E);
    }
    SEAM(3);
    if (IN(4)) { const int gw = F.bid * NWAVES + F.wave, NGW = F.G * NWAVES;
        for (int tok = gw; tok < T; tok += NGW) xquant_token(F, tok, F.lane); }
    SEAM(4);
    if (IN(5)) REPS(5) {
        pg8::Gemm g{WSP(const bf16, WS_XQ), WSP(const bf16, WS_WQ), T, D, D / 2}; pg8::StaticOrder S; S.init(T, D, F.G, F.bid);
        pg8::EpiI8RowColBf16<1> E{WSP(bf16, WS_Q), D, WSP(const float, WS_SX), WSP(const float, WS_CSQ), WSP(const float, WS_SSQ2), NORM_EPS};
        pg8::gemm_phase<pg8::EpiI8RowColBf16<1>, pg8::StaticOrder, true, true, true>(F.lds, g, S, E);
    }
    if (IN(5)) { __syncthreads();
        pg8::StaticOrder S; S.init(T, D, F.G, F.bid); pg8::Unit u;
        for (int i = 0; S.next(i, u); ++i) route_item(F, ((u.pm * 8 + F.wave) << 3) | u.pn, F.lane); }
    SEAM(5);
    { const PeerGeom pg = peer_geom(F); LAS int* wl = (LAS int*)(F.lds + F.wave * 1024);
      if (IN(6)) REPS(6) { for (int r = 0; r < 16 / pg.ngrp; ++r) { const int slice = r * pg.ngrp + pg.g; for (int tok = pg.rank * NWAVES + F.wave; tok < T; tok += pg.nrank * NWAVES) peer_score_slice(F, tok, slice, F.lane, wl); } }
      SEAM(6);
      if (IN(7)) REPS(7) { const int gw = F.bid * NWAVES + F.wave, NGW = F.G * NWAVES; for (int tok = gw; tok < T; tok += NGW) peer_coef_token(F, tok, F.lane); }
      SEAM(7);
      if (IN(8)) peer_out_phase(F, pg, (LAS int*)(F.lds + 16384 + F.wave * 2048));
      SEAM(8);
      if (IN(9)) final_norm_phase(F); }
#undef IN
#undef SEAM
}

extern "C" void kernel_launch(void* const* d_in, const int* in_sizes, int n_in, void* d_out, int out_size, void* d_ws, size_t ws_size, hipStream_t stream) {
    static int grid = 0;
    if (grid == 0) {
        if (n_in != 28 || in_sizes[0] != T * D || out_size != T * D || ws_size < WS_END) { fprintf(stderr, "kernel_launch: shape/workspace mismatch: n_in %d in0 %d out %d ws %zu (need %zu)\n", n_in, n_in > 0 ? in_sizes[0] : -1, out_size, ws_size, (size_t)WS_END); grid = -1; return; }
        int dev = 0, cus = 0, per_cu = 0;
        if (hipGetDevice(&dev) != hipSuccess || hipDeviceGetAttribute(&cus, hipDeviceAttributeMultiprocessorCount, dev) != hipSuccess) { fprintf(stderr, "kernel_launch: device query failed\n"); grid = -1; return; }
        if (hipFuncSetAttribute((const void*)hybrid_fwd, hipFuncAttributeMaxDynamicSharedMemorySize, LDS_BYTES) != hipSuccess) { fprintf(stderr, "kernel_launch: hipFuncSetAttribute failed\n"); grid = -1; return; }
        if (hipOccupancyMaxActiveBlocksPerMultiprocessor(&per_cu, (const void*)hybrid_fwd, NTHR, LDS_BYTES) != hipSuccess || per_cu < 1) { fprintf(stderr, "kernel_launch: occupancy query says %d blocks per CU\n", per_cu); per_cu = 1; }
        (void)hipGetLastError();
        grid = cus;
    }
    if (grid < 0) return;
    if (hipMemsetAsync((char*)d_ws + WS_CTL, 0, CTL_ZERO_BYTES, stream) != hipSuccess) { fprintf(stderr, "kernel_launch: hipMemsetAsync failed\n"); return; }
    Args a{};
    for (int i = 0; i < 28; ++i) a.in[i] = (const float*)d_in[i];
    a.out = (float*)d_out; a.ws = (unsigned char*)d_ws;
    for (int li = 0; li < N_LAUNCHES; ++li) {
        a.ph_lo = (N_LAUNCHES == 1) ? 0 : li; a.ph_hi = (N_LAUNCHES == 1) ? N_PHASES : li + 1; a.li = li;
        hipLaunchKernelGGL(hybrid_fwd, dim3(grid), dim3(NTHR), LDS_BYTES, stream, a);
        const hipError_t le = hipPeekAtLastError();
        if (le != hipSuccess) { fprintf(stderr, "kernel_launch: launch %d failed: %s\n", li, hipGetErrorName(le)); break; }
    }
}
```

```cpp
#include <hip/hip_runtime.h>
#include <cstdio>
#include <cstdint>
namespace pg8 {
#define PG8_LAS __attribute__((address_space(3)))
typedef unsigned short bf16_t;
typedef short bf16x8 __attribute__((ext_vector_type(8)));
typedef float f32x4 __attribute__((ext_vector_type(4)));
typedef unsigned u32x4 __attribute__((ext_vector_type(4)));
typedef int i32x4 __attribute__((ext_vector_type(4)));
constexpr int BM = 256, BK = 64, HALF = 128, HTB = HALF * BK * 2  , STAGE_BYTES = 8 * HTB, NXCD = 8, WGM = 8;

__host__ __device__ __forceinline__ int lds_byte(int r, int c) { const int st = (r >> 4) * 2 + (c >> 5), rr = r & 15, cc = c & 31, ob = rr * 64 + cc * 2; return st * 1024 + (ob ^ (((ob >> 9) & 1) << 5)); }
__host__ __device__ __forceinline__ void stage_rc(int b, int& R, int& C) { const int st = b / 1024, sb = b % 1024, swz = sb ^ (((sb >> 9) & 1) << 5); R = (st >> 1) * 16 + swz / 64; C = (st & 1) * 32 + (swz % 64) / 2; }
__host__ __device__ __forceinline__ int perm32(int rho) { const int n = rho >> 4, i = rho & 15; return 8 * (i >> 2) + 4 * n + (i & 3); }

struct Unit { int pm, pn; };
struct Gemm { const bf16_t* A; const bf16_t* Bt; int M, N, K; };

struct StaticOrder {
    int nM, nN, nwg, G, c;
    __host__ __device__ void init(int M, int N, int G_, int c_) { nM = M / BM; nN = N / BM; nwg = nM * nN; G = G_; c = c_; }
    __host__ __device__ bool next(int i, Unit& u) const {
        const long L = (long)i * G + c; if (L >= nwg) return false;
        int wgid = (int)L; { const int q = nwg / NXCD, r = nwg % NXCD, xcd = wgid % NXCD, off = wgid / NXCD; wgid = (xcd < r ? xcd * (q + 1) : r * (q + 1) + (xcd - r) * q) + off; }
        const int nig = WGM * nN, gid = wgid / nig, fm = gid * WGM, gsz = (nM - fm) < WGM ? (nM - fm) : WGM;
        u.pm = fm + ((wgid % nig) % gsz); u.pn = (wgid % nig) / gsz; return true;
    }
    __device__ __forceinline__ void a_ready(const Unit&) const {}
    __device__ __forceinline__ void done(const Unit&) const {}
};

__device__ __forceinline__ unsigned cvt_pk_bf16(float lo, float hi) { unsigned r; asm volatile("v_cvt_pk_bf16_f32 %0, %1, %2" : "=v"(r) : "v"(lo), "v"(hi)); return r; }
typedef float f32x2 __attribute__((ext_vector_type(2)));
typedef unsigned u32x2 __attribute__((ext_vector_type(2)));
template <int MODE> struct EpiRowScaleBf16 {
    static constexpr bool PERM = true, AFTER_DRAIN = false;
    bf16_t* O; int ldc; const float* rs; float eps;
    __device__ __forceinline__ void operator()(const f32x4 (&acc)[2][2][4][2], const Unit& u, int wr, int wc, int fr, int fq) const {
        const int row0 = u.pm * BM + wr * 64 + fr, col0 = u.pn * BM + wc * 32 + 8 * fq;
#pragma unroll
        for (int ai = 0; ai < 2; ++ai)
#pragma unroll
            for (int m = 0; m < 4; ++m) { const int r = row0 + ai * HALF + m * 16; float s = rs[r]; if (MODE == 1) s = 1.0f / sqrtf(s * (1.0f / 2048.0f) + eps);
                bf16_t* rowp = O + (size_t)r * ldc + col0;
#pragma unroll
                for (int bj = 0; bj < 2; ++bj) { const f32x4 v0 = acc[ai][bj][m][0] * s, v1 = acc[ai][bj][m][1] * s;
                    u32x4 w; w.x = cvt_pk_bf16(v0[0], v0[1]); w.y = cvt_pk_bf16(v0[2], v0[3]); w.z = cvt_pk_bf16(v1[0], v1[1]); w.w = cvt_pk_bf16(v1[2], v1[3]);
                    *(u32x4*)(rowp + bj * HALF) = w; } }
    }
};
template <int MODE> struct EpiI8RowColBf16 {
    static constexpr bool PERM = true, AFTER_DRAIN = false;
    bf16_t* O; int ldc; const float* rs; const float* cs; const float* ssq; float eps;
    __device__ __forceinline__ void operator()(const f32x4 (&acc)[2][2][4][2], const Unit& u, int wr, int wc, int fr, int fq) const {
        const int row0 = u.pm * BM + wr * 64 + fr, col0 = u.pn * BM + wc * 32 + 8 * fq;
        f32x4 c4[2][2];
#pragma unroll
        for (int bj = 0; bj < 2; ++bj) { c4[bj][0] = *(const f32x4*)(cs + col0 + bj * HALF); c4[bj][1] = *(const f32x4*)(cs + col0 + bj * HALF + 4); }
#pragma unroll
        for (int ai = 0; ai < 2; ++ai)
#pragma unroll
            for (int m = 0; m < 4; ++m) { const int r = row0 + ai * HALF + m * 16; float s = rs[r]; if (MODE == 1) s = s / sqrtf(ssq[r] * (1.0f / 2048.0f) + eps);
                bf16_t* rowp = O + (size_t)r * ldc + col0;
#pragma unroll
                for (int bj = 0; bj < 2; ++bj) { f32x4 v0, v1; const i32x4 i0 = __builtin_bit_cast(i32x4, acc[ai][bj][m][0]), i1 = __builtin_bit_cast(i32x4, acc[ai][bj][m][1]);
#pragma unroll
                    for (int e = 0; e < 4; ++e) { v0[e] = (float)i0[e] * s * c4[bj][0][e]; v1[e] = (float)i1[e] * s * c4[bj][1][e]; }
                    u32x4 w; w.x = cvt_pk_bf16(v0[0], v0[1]); w.y = cvt_pk_bf16(v0[2], v0[3]); w.z = cvt_pk_bf16(v1[0], v1[1]); w.w = cvt_pk_bf16(v1[2], v1[3]);
                    *(u32x4*)(rowp + bj * HALF) = w; } }
    }
};
struct EpiResidual {
    static constexpr bool PERM = false, AFTER_DRAIN = false;
    const float* base; bf16_t* outb; int ldc;
    __device__ __forceinline__ void operator()(const f32x4 (&acc)[2][2][4][2], const Unit& u, int wr, int wc, int fr, int fq) const {
        const int row0 = u.pm * BM + wr * 64 + fr, col0 = u.pn * BM + wc * 32 + 4 * fq;
#pragma unroll
        for (int ai = 0; ai < 2; ++ai)
#pragma unroll
            for (int m = 0; m < 4; ++m) { const int r = row0 + ai * HALF + m * 16; const size_t off = (size_t)r * ldc + col0;
#pragma unroll
                for (int bj = 0; bj < 2; ++bj)
#pragma unroll
                    for (int n = 0; n < 2; ++n) { const f32x4 bs = *(const f32x4*)(base + off + bj * HALF + n * 16); const f32x4 o = bs + acc[ai][bj][m][n];
                        u32x2 w; w.x = cvt_pk_bf16(o[0], o[1]); w.y = cvt_pk_bf16(o[2], o[3]); *(u32x2*)(outb + off + bj * HALF + n * 16) = w; } }
    }
};
template <class Epi, class Sched, bool ALIGN_EPI = false, bool SP2 = false, bool I8 = false>
__device__ __forceinline__ void gemm_phase(PG8_LAS unsigned char* lds, const Gemm g, const Sched& S, const Epi& E) {
    const int tid = threadIdx.x, wid = __builtin_amdgcn_readfirstlane(tid >> 6), lane = tid & 63, wr = wid >> 2, wc = wid & 3, fr = lane & 15, fq = lane >> 4;
    const int K = g.K, nt = K / BK;
    unsigned voffA[2], voffB[2];
#pragma unroll
    for (int i = 0; i < 2; ++i) { int R, C; stage_rc(tid * 16 + i * 8192, R, C); const int Rb = Epi::PERM ? ((R & ~31) + perm32(R & 31)) : R;
        voffA[i] = (unsigned)(R * K + C) * 2u; voffB[i] = (unsigned)(Rb * K + C) * 2u; }
    const size_t kstep = (size_t)(BK * 2);
    const size_t hstep = (size_t)HALF * K * 2;
    const size_t tstep = 2 * hstep;
    const unsigned ldsw = (unsigned)wid * 1024u;
    const int aoff = lds_byte(wr * 64 + fr, fq * 8), boff = lds_byte(wc * 32 + fr, fq * 8);
#define PG8_SA(b, h) (((b) * 2 + (h)) * HTB)
#define PG8_SB(b, h) ((4 + (b) * 2 + (h)) * HTB)
#define PG8_STAGE(bufoff, gbase, voff) do { _Pragma("unroll") for (int _i = 0; _i < 2; ++_i) \
        __builtin_amdgcn_global_load_lds((const unsigned*)((const char*)(gbase) + (voff)[_i]), (PG8_LAS unsigned*)(lds + (bufoff) + ldsw + _i * 8192), 16, 0, 0); } while (0)
#define PG8_LDA(dst, b, h) do { _Pragma("unroll") for (int m = 0; m < 4; ++m) _Pragma("unroll") for (int k = 0; k < 2; ++k) dst[m][k] = *(const PG8_LAS bf16x8*)(lds + PG8_SA(b, h) + aoff + m * 2048 + k * 1024); } while (0)
#define PG8_LDB(dst, b, h) do { _Pragma("unroll") for (int n = 0; n < 2; ++n) _Pragma("unroll") for (int k = 0; k < 2; ++k) dst[n][k] = *(const PG8_LAS bf16x8*)(lds + PG8_SB(b, h) + boff + n * 2048 + k * 1024); } while (0)
#define PG8_MMA(ai, bj, At, Bt) do { __builtin_amdgcn_s_setprio(1); _Pragma("unroll") for (int m = 0; m < 4; ++m) _Pragma("unroll") for (int n = 0; n < 2; ++n) _Pragma("unroll") for (int k = 0; k < 2; ++k) \
        { if constexpr (I8) acc[ai][bj][m][n] = __builtin_bit_cast(f32x4, __builtin_amdgcn_mfma_i32_16x16x64_i8(__builtin_bit_cast(i32x4, Bt[n][k]), __builtin_bit_cast(i32x4, At[m][k]), __builtin_bit_cast(i32x4, acc[ai][bj][m][n]), 0, 0, 0)); \
          else acc[ai][bj][m][n] = __builtin_amdgcn_mfma_f32_16x16x32_bf16(Bt[n][k], At[m][k], acc[ai][bj][m][n], 0, 0, 0); } __builtin_amdgcn_s_setprio(0); } while (0)
#define PG8_WAIT_V(n) asm volatile("s_waitcnt vmcnt(" #n ")" ::: "memory")
#define PG8_WAIT_L(n) asm volatile("s_waitcnt lgkmcnt(" #n ")" ::: "memory")
#define PG8_BAR __builtin_amdgcn_s_barrier()
#define PG8_SCHED __builtin_amdgcn_sched_barrier(0)
    Unit cur, nxt; int ui = 0;
    if (!S.next(0, cur)) return;
    f32x4 acc[2][2][4][2];
#pragma unroll
    for (int a = 0; a < 2; ++a)
#pragma unroll
        for (int b = 0; b < 2; ++b)
#pragma unroll
            for (int m = 0; m < 4; ++m)
#pragma unroll
                for (int n = 0; n < 2; ++n) acc[a][b][m][n] = (f32x4){0.f, 0.f, 0.f, 0.f};
    bf16x8 At[4][2], B0[2][2], B1[2][2];
    const char* cA = (const char*)g.A + (size_t)cur.pm * tstep; const char* cB = (const char*)g.Bt + (size_t)cur.pn * tstep;
    S.a_ready(cur);
    if constexpr (SP2) {
        PG8_STAGE(PG8_SB(0, 0), cB, voffB); PG8_STAGE(PG8_SB(0, 1), cB + hstep, voffB); PG8_STAGE(PG8_SA(0, 0), cA, voffA); PG8_STAGE(PG8_SA(0, 1), cA + hstep, voffA);
        if (wr == 1) PG8_BAR;
        PG8_WAIT_V(2); PG8_BAR;
        PG8_STAGE(PG8_SB(1, 0), cB + kstep, voffB); PG8_STAGE(PG8_SA(1, 0), cA + kstep, voffA); PG8_STAGE(PG8_SB(1, 1), cB + hstep + kstep, voffB);
        PG8_WAIT_V(6); PG8_BAR;
    } else {
        PG8_STAGE(PG8_SB(0, 0), cB, voffB); PG8_STAGE(PG8_SA(0, 0), cA, voffA); PG8_STAGE(PG8_SB(0, 1), cB + hstep, voffB); PG8_STAGE(PG8_SA(0, 1), cA + hstep, voffA);
        if (wr == 1) PG8_BAR;
        PG8_WAIT_V(4); PG8_BAR;
        PG8_STAGE(PG8_SB(1, 0), cB + kstep, voffB); PG8_STAGE(PG8_SA(1, 0), cA + kstep, voffA); PG8_STAGE(PG8_SB(1, 1), cB + hstep + kstep, voffB);
        PG8_WAIT_V(6); PG8_BAR;
    }
    for (;;) {
        const bool has_next = S.next(ui + 1, nxt);
        const char* nA = has_next ? (const char*)g.A + (size_t)nxt.pm * tstep : cA; const char* nB = has_next ? (const char*)g.Bt + (size_t)nxt.pn * tstep : cB;
        for (int t = 0; t < nt; t += 2) {
            const bool last = (t == nt - 2);
            const char* a1 = cA + (size_t)(t + 1) * kstep;
            const char* a2 = last ? nA : cA + (size_t)(t + 2) * kstep; const char* b2 = last ? nB : cB + (size_t)(t + 2) * kstep;
            const char* a3 = a2 + kstep; const char* b3 = b2 + kstep;
            if (last && has_next) S.a_ready(nxt);
            if constexpr (SP2) {
            PG8_LDB(B0, 0, 0); PG8_LDB(B1, 0, 1); PG8_SCHED; PG8_LDA(At, 0, 0); PG8_STAGE(PG8_SA(1, 1), a1 + hstep, voffA);
            PG8_WAIT_V(8); PG8_WAIT_L(0); PG8_BAR; PG8_MMA(0, 0, At, B0); PG8_MMA(0, 1, At, B1); PG8_BAR; PG8_SCHED;
            PG8_LDA(At, 0, 1); PG8_STAGE(PG8_SB(0, 0), b2, voffB); PG8_STAGE(PG8_SB(0, 1), b2 + hstep, voffB); PG8_STAGE(PG8_SA(0, 0), a2, voffA);
            PG8_WAIT_V(8); PG8_WAIT_L(0); PG8_BAR; PG8_MMA(1, 0, At, B0); PG8_MMA(1, 1, At, B1); PG8_BAR; PG8_SCHED;
            PG8_LDB(B0, 1, 0); PG8_LDB(B1, 1, 1); PG8_SCHED; PG8_LDA(At, 1, 0); PG8_STAGE(PG8_SA(0, 1), a2 + hstep, voffA);
            PG8_WAIT_V(8); PG8_WAIT_L(0); PG8_BAR; PG8_MMA(0, 0, At, B0); PG8_MMA(0, 1, At, B1); PG8_BAR; PG8_SCHED;
            PG8_LDA(At, 1, 1); PG8_STAGE(PG8_SB(1, 0), b3, voffB); PG8_STAGE(PG8_SB(1, 1), b3 + hstep, voffB); PG8_STAGE(PG8_SA(1, 0), a3, voffA);
            PG8_WAIT_V(8); PG8_WAIT_L(0); PG8_BAR; PG8_MMA(1, 0, At, B0); PG8_MMA(1, 1, At, B1); PG8_BAR; PG8_SCHED;
            } else {
            PG8_LDB(B0, 0, 0); PG8_SCHED; PG8_LDA(At, 0, 0); PG8_STAGE(PG8_SA(1, 1), a1 + hstep, voffA);
            PG8_WAIT_L(8); PG8_BAR; PG8_WAIT_L(0); PG8_MMA(0, 0, At, B0); PG8_BAR; PG8_SCHED;
            PG8_LDB(B1, 0, 1); PG8_STAGE(PG8_SB(0, 0), b2, voffB);
            PG8_BAR; PG8_WAIT_L(0); PG8_MMA(0, 1, At, B1); PG8_BAR;
            PG8_LDA(At, 0, 1); PG8_STAGE(PG8_SA(0, 0), a2, voffA);
            PG8_BAR; PG8_WAIT_L(0); PG8_MMA(1, 0, At, B0); PG8_BAR; PG8_SCHED;
            PG8_STAGE(PG8_SB(0, 1), b2 + hstep, voffB);
            PG8_WAIT_V(6); PG8_BAR; PG8_MMA(1, 1, At, B1); PG8_BAR;
            PG8_LDB(B0, 1, 0); PG8_SCHED; PG8_LDA(At, 1, 0); PG8_STAGE(PG8_SA(0, 1), a2 + hstep, voffA);
            PG8_WAIT_L(8); PG8_BAR; PG8_WAIT_L(0); PG8_MMA(0, 0, At, B0); PG8_BAR; PG8_SCHED;
            PG8_LDB(B1, 1, 1); PG8_STAGE(PG8_SB(1, 0), b3, voffB);
            PG8_BAR; PG8_WAIT_L(0); PG8_MMA(0, 1, At, B1); PG8_BAR;
            PG8_LDA(At, 1, 1); PG8_STAGE(PG8_SA(1, 0), a3, voffA);
            PG8_BAR; PG8_WAIT_L(0); PG8_MMA(1, 0, At, B0); PG8_BAR; PG8_SCHED;
            PG8_STAGE(PG8_SB(1, 1), b3 + hstep, voffB);
            PG8_WAIT_V(6); PG8_BAR; PG8_MMA(1, 1, At, B1); PG8_BAR;
            }
        }
        if constexpr (ALIGN_EPI) { if (wr == 0) PG8_BAR; }
        if constexpr (!Epi::AFTER_DRAIN) { E(acc, cur, wr, wc, fr, fq); S.done(cur); }
        if (!has_next) break;
#pragma unroll
        for (int a = 0; a < 2; ++a)
#pragma unroll
            for (int b = 0; b < 2; ++b)
#pragma unroll
                for (int m = 0; m < 4; ++m)
#pragma unroll
                    for (int n = 0; n < 2; ++n) acc[a][b][m][n] = (f32x4){0.f, 0.f, 0.f, 0.f};
        cur = nxt; cA = nA; cB = nB; ++ui;
        if constexpr (ALIGN_EPI) { if (wr == 1) PG8_BAR; }
    }
    PG8_WAIT_V(0);
    if constexpr (!ALIGN_EPI) { if (wr == 0) PG8_BAR; }
    PG8_BAR;
    if constexpr (Epi::AFTER_DRAIN) { E.fused(acc, cur, wr, wc, fr, fq, lds, wid, lane); S.done(cur); }
#undef PG8_SA
#undef PG8_SB
#undef PG8_STAGE
#undef PG8_LDA
#undef PG8_LDB
#undef PG8_MMA
#undef PG8_WAIT_V
#undef PG8_WAIT_L
#undef PG8_BAR
#undef PG8_SCHED
}
}

#ifndef PROBE_DUP
#define PROBE_DUP -1
#endif
constexpr int NWAVES = 8, NTHR = NWAVES * 64;
#ifndef MK_N_LAUNCHES
#define MK_N_LAUNCHES 1
#endif
constexpr int N_PHASES = 10;
constexpr int N_LAUNCHES = MK_N_LAUNCHES;
static_assert(N_LAUNCHES == 1 || N_LAUNCHES == N_PHASES, "MK_N_LAUNCHES is 1 or N_PHASES");

constexpr int BATCH = 8, SEQ = 2048, T = BATCH * SEQ, D = 2048;
constexpr int NIN = 5408, NINP = 5632;
constexpr int PC_GATE = 1024, PC_R = 2048, PC_K = 3072, PC_V = 4096, PC_WD = 5120, PC_AD = 5184, PC_GD = 5248;
constexpr int RWKV_C0 = 2048;
constexpr int NEXP = 16384, NSEL = 128;
constexpr float NORM_EPS = 1e-6f, GN_EPS = 64e-5f;

constexpr size_t MiB = 1u << 20;
constexpr size_t WS_CTL = 0, CTL_ZERO_BYTES = 1 * MiB;
constexpr size_t WS_SSQ3 = 576 * 1024;
constexpr size_t WS_SSQ2 = 512 * 1024;
constexpr size_t WS_RSTD1 = 1 * MiB;
constexpr size_t WS_USC = 1 * MiB + 64 * 1024, WS_VSC = 1 * MiB + 128 * 1024;
constexpr size_t WS_SX = 1 * MiB + 192 * 1024;
constexpr size_t WS_CS1 = 1 * MiB + 256 * 1024;
constexpr size_t WS_CSQ = 1 * MiB + 288 * 1024;
constexpr size_t WS_WIN = 2 * MiB;
constexpr size_t WS_WOUT = 24 * MiB;
constexpr size_t WS_WQ = 32 * MiB;
constexpr size_t WS_KEYS = 40 * MiB;
constexpr size_t WS_W2T = WS_KEYS + 512 * 1024;
constexpr size_t WS_A2T = WS_W2T + 128 * 1024;
constexpr size_t WS_G2T = WS_A2T + 128 * 1024;
constexpr size_t WS_WAT = WS_G2T + 320 * 1024;
constexpr size_t WS_WIT = WS_WAT + 256 * 1024;
constexpr size_t WS_EXP = 42 * MiB;
constexpr size_t WS_GATE = 50 * MiB;
constexpr size_t WS_LA = 42 * MiB;
constexpr size_t WS_SUMM = 58 * MiB;
constexpr size_t WS_TA = 64 * MiB, WS_TB = 96 * MiB, WS_TK = 400 * MiB, WS_TR = 464 * MiB;
constexpr size_t OUT_TV = 0, OUT_TG = 32 * MiB, OUT_PC = 64 * MiB, OUT_BON = 66 * MiB;
constexpr size_t WS_XB = 64 * MiB;
constexpr size_t WS_PROJ = 128 * MiB;
constexpr size_t WS_Q = WS_PROJ;
constexpr size_t WS_PART = 192 * MiB;
constexpr size_t WS_XQ = 320 * MiB;
constexpr size_t WS_COEF = 352 * MiB;
constexpr size_t WS_CSC = 356 * MiB;
constexpr size_t WS_Y = 304 * MiB;
constexpr size_t WS_UT = 368 * MiB;
constexpr size_t WS_VT = 432 * MiB;
constexpr size_t WS_END = 496 * MiB;
static_assert(WS_WIT + 256 * 1024 <= WS_EXP && WS_PROJ + (size_t)T * NINP * 2 <= WS_Y && WS_WIN + (size_t)NINP * D * 2 <= WS_WOUT, "d_ws map");
constexpr int CW_DEFQ = 2240;
constexpr int CW_PREPBAR = 2176;
constexpr int CW_PREBAR = 2112;
constexpr int CW_LRUBAR = 2048;
constexpr int CW_BAR = 4096;

constexpr int RING_BYTES = 131072;
constexpr int LDSCTL_OFF = 143360, MISC_OFF = LDSCTL_OFF + 320;
constexpr int LDS_BYTES = 147456;

#define GAS __attribute__((address_space(1)))
#define LAS __attribute__((address_space(3)))
typedef unsigned short bf16;
typedef unsigned v4u __attribute__((ext_vector_type(4)));
typedef unsigned v2u __attribute__((ext_vector_type(2)));
typedef float f32x4 __attribute__((ext_vector_type(4)));
typedef float f32x16 __attribute__((ext_vector_type(16)));
typedef short bf16x8 __attribute__((ext_vector_type(8)));
typedef __bf16 bf16x2_t __attribute__((ext_vector_type(2)));
typedef GAS unsigned gu32;
#define RLX_AGENT __ATOMIC_RELAXED, __HIP_MEMORY_SCOPE_AGENT
__device__ __forceinline__ unsigned f2bf(float f) { unsigned u = __builtin_bit_cast(unsigned, f); return (u + 0x7fffu + ((u >> 16) & 1u)) >> 16; }
__device__ __forceinline__ unsigned pk2(float lo, float hi) { return f2bf(lo) | (f2bf(hi) << 16); }
__device__ __forceinline__ float bf_lo(unsigned w) { return __uint_as_float(w << 16); }
__device__ __forceinline__ float bf_hi(unsigned w) { return __uint_as_float(w & 0xffff0000u); }
__device__ __forceinline__ void unpack8(const v4u& w, float (&o)[8]) { o[0] = bf_lo(w.x); o[1] = bf_hi(w.x); o[2] = bf_lo(w.y); o[3] = bf_hi(w.y); o[4] = bf_lo(w.z); o[5] = bf_hi(w.z); o[6] = bf_lo(w.w); o[7] = bf_hi(w.w); }
__device__ __forceinline__ v4u pack8(const float (&o)[8]) { v4u w; w.x = pk2(o[0], o[1]); w.y = pk2(o[2], o[3]); w.z = pk2(o[4], o[5]); w.w = pk2(o[6], o[7]); return w; }
__device__ __forceinline__ float sigmoidf_(float x) { return 1.0f / (1.0f + __expf(-x)); }
__device__ __forceinline__ float softplusf_(float z) { return fmaxf(z, 0.f) + log1pf(__expf(-fabsf(z))); }
__device__ __forceinline__ float gelu_tanh(float x) { const float u = 0.7978845608028654f * (x + 0.044715f * x * x * x); return 0.5f * x * (1.0f + tanhf(u)); }
template <int CTRL> __device__ __forceinline__ float dppf(float x) { return __builtin_bit_cast(float, __builtin_amdgcn_mov_dpp(__builtin_bit_cast(int, x), CTRL, 0xf, 0xf, true)); }
__device__ __forceinline__ float red8(float v) { v += dppf<0xB1>(v); v += dppf<0x4E>(v); v += dppf<0x141>(v); return v; }
__device__ __forceinline__ float red16(float v) { v = red8(v); v += dppf<0x140>(v); return v; }
__device__ __forceinline__ float wave_sum(float v) {
#pragma unroll
    for (int o = 1; o < 64; o <<= 1) v += __shfl_xor(v, o);
    return v;
}
__device__ __forceinline__ float dot2bf(unsigned a, unsigned b, float acc) { return __builtin_amdgcn_fdot2_f32_bf16(__builtin_bit_cast(bf16x2_t, a), __builtin_bit_cast(bf16x2_t, b), acc, false); }
#define MFMA16(a, b, c) __builtin_amdgcn_mfma_f32_16x16x32_bf16((a), (b), (c), 0, 0, 0)
#define MFMA32(a, b, c) __builtin_amdgcn_mfma_f32_32x32x16_bf16((a), (b), (c), 0, 0, 0)

#define XB_TMO      128
#define XB_XCNT(j)  (256  + 64 * (j))
#define XB_XSUB(j)  (1280 + 64 * (j))
#define XB_XGEN(j)  (2304 + 64 * (j))
#define XB_TOP      3328
#define XB_TOPGEN   3392
#define XCD_BAR_WORDS 3456
#define XB_SPIN_CAP (1u << 22)
__device__ __forceinline__ unsigned xb_ld(unsigned* p)              { return __hip_atomic_load(p, __ATOMIC_RELAXED, __HIP_MEMORY_SCOPE_AGENT); }
__device__ __forceinline__ unsigned xb_add(unsigned* p, unsigned v) { return __hip_atomic_fetch_add(p, v, __ATOMIC_RELAXED, __HIP_MEMORY_SCOPE_AGENT); }
__device__ __forceinline__ unsigned xb_xcc_id() { return (unsigned)__builtin_amdgcn_s_getreg((3 << 11) | 20) & 0xFu; }
#define XB_SPIN(cond, bar) do { unsigned _sp = 0; while (cond) { __builtin_amdgcn_s_sleep(1); \
    if ((++_sp & 255u) == 0u) { if (xb_ld(&(bar)[XB_TMO])) break; if (_sp > XB_SPIN_CAP) { atomicAdd(&(bar)[XB_TMO], 1u); break; } } } } while (0)
struct XcdBarrier { unsigned* bar; unsigned x; volatile LAS unsigned* st; };
__device__ __forceinline__ XcdBarrier xcd_barrier_post(unsigned* bar, volatile LAS unsigned* st) {
    XcdBarrier b; b.bar = bar; b.x = xb_xcc_id(); b.st = st;
    if (threadIdx.x == 0) (void)xb_add(&bar[XB_XCNT(b.x)], 1u);
    return b;
}
__device__ __forceinline__ void xcd_barrier_complete(unsigned* bar, unsigned x, unsigned& nloc, unsigned& nx) {
    const unsigned G = gridDim.x * gridDim.y * gridDim.z;
    unsigned sum, cnt, mine, sp = 0u;
    for (;;) {
        sum = 0u; cnt = 0u; mine = 0u;
#pragma unroll
        for (unsigned j = 0; j < 16; ++j) { const unsigned c = xb_ld(&bar[XB_XCNT(j)]); sum += c; cnt += (c > 0u) ? 1u : 0u; mine = (j == x) ? c : mine; }
        if (sum == G) break;
        __builtin_amdgcn_s_sleep(1);
        if ((++sp & 255u) == 0u) { if (xb_ld(&bar[XB_TMO])) break; if (sp > XB_SPIN_CAP) { atomicAdd(&bar[XB_TMO], 1u); break; } }
    }
    nloc = mine > 0u ? mine : 1u; nx = cnt > 0u ? cnt : 1u;
}
__device__ __forceinline__ void xcd_barrier(const XcdBarrier& b) {
    asm volatile("s_waitcnt vmcnt(0)" ::: "memory");
    __syncthreads();
    if (threadIdx.x == 0) {
        unsigned* bar = b.bar;
        __builtin_amdgcn_s_waitcnt(0);
        unsigned nloc = b.st[0], nx = b.st[1];
        if (nloc == 0u) { xcd_barrier_complete(bar, b.x, nloc, nx); b.st[0] = nloc; b.st[1] = nx; }
        const unsigned old = xb_add(&bar[XB_XSUB(b.x)], 1u);
        const unsigned gen = old / nloc;
        if (old + 1u == (gen + 1u) * nloc) {
            __builtin_amdgcn_fence(__ATOMIC_RELEASE, "agent");
            asm volatile("s_waitcnt vmcnt(0)" ::: "memory");
            const unsigned og = xb_add(&bar[XB_TOP], 1u);
            const unsigned tg = og / nx;
            if (og + 1u == (tg + 1u) * nx) xb_add(&bar[XB_TOPGEN], 1u);
            else XB_SPIN(xb_ld(&bar[XB_TOPGEN]) == tg, bar);
            __builtin_amdgcn_fence(__ATOMIC_ACQUIRE, "agent");
            xb_add(&bar[XB_XGEN(b.x)], 1u);
            asm volatile("s_waitcnt vmcnt(0)" ::: "memory");
        } else {
            XB_SPIN(xb_ld(&bar[XB_XGEN(b.x)]) == gen, bar);
            __builtin_amdgcn_fence(__ATOMIC_ACQUIRE, "agent");
            asm volatile("s_waitcnt vmcnt(0)" ::: "memory");
        }
    }
    __syncthreads();
}

struct Frame {
    LAS unsigned char* lds;
    int tid, lane, wave, G, bid;
    const float* in[28];
    float* out;
    unsigned char* ws;
};
#define WSP(type, off) ((type*)(F.ws + (off)))
enum { I_X = 0, I_G1, I_WIN, I_CONVW, I_CONVB, I_WA, I_BA, I_WI, I_BI, I_LAM, I_MU, I_W0, I_W2, I_A0, I_A2, I_G2, I_KK, I_KA, I_RK, I_LNW, I_LNB, I_WOUT, I_G2N, I_WQ, I_KEYS, I_U, I_V, I_GF };

__device__ __forceinline__ void p0_transpose_item(const float* W, int K, int N, bf16* WT, const float* ksc, LAS float* scr, int item, int lane) {
    const int nblk = N / 32, kb = item / nblk, nb = item % nblk, k0 = 64 * kb, n0 = 32 * nb;
    const int lr = lane >> 3, c4 = (lane & 7) * 4;
    f32x4 v[8];
#pragma unroll
    for (int i = 0; i < 8; ++i) v[i] = *(const f32x4*)(W + (size_t)(k0 + 8 * i + lr) * N + n0 + c4);
#pragma unroll
    for (int i = 0; i < 8; ++i) { const int kk = 8 * i + lr; const float sc = ksc ? ksc[k0 + kk] : 1.0f; LAS float* d = scr + kk * 33 + c4; d[0] = v[i][0] * sc; d[1] = v[i][1] * sc; d[2] = v[i][2] * sc; d[3] = v[i][3] * sc; }
    asm volatile("s_waitcnt lgkmcnt(0)" ::: "memory");
    const int c = lane & 7;
#pragma unroll
    for (int j = 0; j < 4; ++j) { const int n = (lane >> 3) + 8 * j; const LAS float* s = scr + (8 * c) * 33 + n;
        v4u o; o.x = pk2(s[0 * 33], s[1 * 33]); o.y = pk2(s[2 * 33], s[3 * 33]); o.z = pk2(s[4 * 33], s[5 * 33]); o.w = pk2(s[6 * 33], s[7 * 33]);
        *(v4u*)(WT + (size_t)(n0 + n) * K + k0 + 8 * c) = o; }
    asm volatile("s_waitcnt lgkmcnt(0)" ::: "memory");
}
__device__ __forceinline__ void p0_wquant_block(const float* W, int N, unsigned char* WT8, float* cs, const float* ksc, int item, int wave, int lane, LAS float* mxs) {
    asm volatile("" : "+v"(lane));
    const int n0 = item * 32, r = lane >> 3, c4 = lane & 7, kb = 256 * wave + 4 * r;
    const float* src = W + (size_t)kb * N + n0 + 4 * c4; const float* kp = ksc + kb;
    f32x4 mx = (f32x4){0.f, 0.f, 0.f, 0.f};
#pragma unroll
    for (int i2 = 0; i2 < 2; ++i2) { f32x4 v[4][4], g4[4];
#pragma unroll
        for (int ii = 0; ii < 4; ++ii) { g4[ii] = *(const f32x4*)(kp + 32 * (i2 * 4 + ii));
#pragma unroll
            for (int j = 0; j < 4; ++j) v[ii][j] = *(const f32x4*)(src + (size_t)(32 * (i2 * 4 + ii) + j) * N); }
#pragma unroll
        for (int ii = 0; ii < 4; ++ii)
#pragma unroll
            for (int j = 0; j < 4; ++j)
#pragma unroll
                for (int e = 0; e < 4; ++e) mx[e] = fmaxf(mx[e], fabsf(v[ii][j][e] * g4[ii][j])); }
#pragma unroll
    for (int o = 8; o < 64; o <<= 1)
#pragma unroll
        for (int e = 0; e < 4; ++e) mx[e] = fmaxf(mx[e], __shfl_xor(mx[e], o));
    if (r == 0) *(LAS f32x4*)(mxs + wave * 32 + 4 * c4) = mx;
    __syncthreads();
#pragma unroll
    for (int w = 0; w < NWAVES; ++w) { const f32x4 t = *(const LAS f32x4*)(mxs + w * 32 + 4 * c4);
#pragma unroll
        for (int e = 0; e < 4; ++e) mx[e] = fmaxf(mx[e], t[e]); }
    f32x4 q;
#pragma unroll
    for (int e = 0; e < 4; ++e) q[e] = mx[e] > 0.f ? 127.0f / mx[e] : 0.f;
    if (wave == 0 && r == 0) *(f32x4*)(cs + n0 + 4 * c4) = mx * (1.0f / 127.0f);
    unsigned char* dst = WT8 + (size_t)(n0 + 4 * c4) * 2048 + kb;
#pragma unroll
    for (int i2 = 0; i2 < 2; ++i2) { f32x4 v[4][4], g4[4];
#pragma unroll
        for (int ii = 0; ii < 4; ++ii) { g4[ii] = *(const f32x4*)(kp + 32 * (i2 * 4 + ii));
#pragma unroll
            for (int j = 0; j < 4; ++j) v[ii][j] = *(const f32x4*)(src + (size_t)(32 * (i2 * 4 + ii) + j) * N); }
#pragma unroll
        for (int ii = 0; ii < 4; ++ii) { unsigned w[4] = {0u, 0u, 0u, 0u};
#pragma unroll
            for (int j = 0; j < 4; ++j)
#pragma unroll
                for (int e = 0; e < 4; ++e) { const int qi = (int)rintf(v[ii][j][e] * g4[ii][j] * q[e]); w[e] |= ((unsigned)qi & 0xFFu) << (8 * j); }
#pragma unroll
            for (int e = 0; e < 4; ++e) *(unsigned*)(dst + (size_t)e * 2048 + 32 * (i2 * 4 + ii)) = w[e]; } }
    __syncthreads();
}
__device__ __forceinline__ void p0_small_transpose(const float* src, bf16* dst, int nb, int K, int N, int gt, int NGT) {
    const int tot = nb * K * N;
    for (int i = gt; i < tot; i += NGT) { const int bb = i / (K * N), r = i - bb * K * N, n = r / K, k = r - n * K; dst[i] = (bf16)f2bf(src[(size_t)bb * K * N + (size_t)k * N + n]); }
}
template <int PART> __device__ __forceinline__ void p0_prologue(const Frame& F, int vb, int VG) {
    LAS float* scr = (LAS float*)(F.lds + F.wave * 8448);
    const int gw = vb * NWAVES + F.wave, NGW = VG * NWAVES, gt = gw * 64 + F.lane, NGT = NGW * 64;
    constexpr int I1 = (D / 64) * (NIN / 32), I2 = (D / 64) * (D / 32);
    if (PART == 0) { for (int it = vb; it < NIN / 32; it += VG) p0_wquant_block(F.in[I_WIN], NIN, WSP(unsigned char, WS_WIN), WSP(float, WS_CS1), F.in[I_G1], it, F.wave, F.lane, (LAS float*)(F.lds + 8 * 8448)); }
    else { for (int it = gw; it < I2; it += NGW) p0_transpose_item(F.in[I_WOUT], D, D, WSP(bf16, WS_WOUT), nullptr, scr, it, F.lane);
           for (int v16 = vb; v16 < 16 * (D / 32); v16 += VG) if (v16 % 16 == 0) p0_wquant_block(F.in[I_WQ], D, WSP(unsigned char, WS_WQ), WSP(float, WS_CSQ), F.in[I_G2N], v16 / 16, F.wave, F.lane, (LAS float*)(F.lds + 8 * 8448)); }
    if (PART == 0) {
    { v4u* z = (v4u*)(WSP(unsigned char, WS_WIN) + (size_t)NIN * D); const int nz = (NINP - NIN) * D / 16; for (int i = gt; i < nz; i += NGT) z[i] = (v4u){0u, 0u, 0u, 0u};
      for (int i = gt; i < NINP - NIN; i += NGT) WSP(float, WS_CS1)[NIN + i] = 0.f; }
    p0_small_transpose(F.in[I_W2], WSP(bf16, WS_W2T), 1, 64, 1024, gt, NGT);
    p0_small_transpose(F.in[I_A2], WSP(bf16, WS_A2T), 1, 64, 1024, gt, NGT);
    p0_small_transpose(F.in[I_G2], WSP(bf16, WS_G2T), 1, 160, 1024, gt, NGT);
    p0_small_transpose(F.in[I_WA], WSP(bf16, WS_WAT), 8, 128, 128, gt, NGT);
    p0_small_transpose(F.in[I_WI], WSP(bf16, WS_WIT), 8, 128, 128, gt, NGT);
    { const float* s = F.in[I_KEYS]; bf16* d = WSP(bf16, WS_KEYS); for (int i = gt; i < 8 * 2 * 128 * 128 / 8; i += NGT) { const f32x4 a = *(const f32x4*)(s + (size_t)i * 8), b = *(const f32x4*)(s + (size_t)i * 8 + 4);
        v4u o; o.x = pk2(a[0], a[1]); o.y = pk2(a[2], a[3]); o.z = pk2(b[0], b[1]); o.w = pk2(b[2], b[3]); *(v4u*)(d + (size_t)i * 8) = o; } }
    }
    if (PART == 1) {
    { const float* su = F.in[I_U]; const float* sv = F.in[I_V]; const float* g2 = F.in[I_G2N]; unsigned char* du = WSP(unsigned char, WS_UT); unsigned char* dv = WSP(unsigned char, WS_VT);
      float* usc = WSP(float, WS_USC); float* vsc = WSP(float, WS_VSC);
      f32x4 gg[2][4];
#pragma unroll
      for (int hh = 0; hh < 2; ++hh)
#pragma unroll
          for (int q = 0; q < 4; ++q) gg[hh][q] = *(const f32x4*)(g2 + hh * 1024 + F.lane * 16 + q * 4);
#define TBL_LOAD(U_, V_, row_) do { _Pragma("unroll") for (int hh_ = 0; hh_ < 2; ++hh_) _Pragma("unroll") for (int q_ = 0; q_ < 4; ++q_) { \
          U_[hh_][q_] = *(const f32x4*)(su + (size_t)(row_) * D + hh_ * 1024 + F.lane * 16 + q_ * 4); V_[hh_][q_] = *(const f32x4*)(sv + (size_t)(row_) * D + hh_ * 1024 + F.lane * 16 + q_ * 4); } } while (0)
#define TBL_QUANT(U_, V_, row_) do { float am_ = 0.f, vm_ = 0.f; \
          _Pragma("unroll") for (int hh_ = 0; hh_ < 2; ++hh_) _Pragma("unroll") for (int q_ = 0; q_ < 4; ++q_) { U_[hh_][q_] = U_[hh_][q_] * gg[hh_][q_]; \
              _Pragma("unroll") for (int e_ = 0; e_ < 4; ++e_) { am_ = fmaxf(am_, fabsf(U_[hh_][q_][e_])); vm_ = fmaxf(vm_, fabsf(V_[hh_][q_][e_])); } } \
          _Pragma("unroll") for (int o_ = 1; o_ < 64; o_ <<= 1) { am_ = fmaxf(am_, __shfl_xor(am_, o_)); vm_ = fmaxf(vm_, __shfl_xor(vm_, o_)); } \
          const float uq_ = am_ > 0.f ? 127.0f / am_ : 0.f, vq_ = vm_ > 0.f ? 127.0f / vm_ : 0.f; \
          if (F.lane == 0) { usc[row_] = am_ * (1.0f / 127.0f); vsc[row_] = vm_ * (1.0f / 127.0f); } \
          _Pragma("unroll") for (int hh_ = 0; hh_ < 2; ++hh_) { v4u ou_, ov_; \
              _Pragma("unroll") for (int q_ = 0; q_ < 4; ++q_) { unsigned w_ = 0u, wv_ = 0u; \
                  _Pragma("unroll") for (int e_ = 0; e_ < 4; ++e_) { const int qi_ = (int)rintf(U_[hh_][q_][e_] * uq_); w_ |= ((unsigned)qi_ & 0xFFu) << (8 * e_); const int qv_ = (int)rintf(V_[hh_][q_][e_] * vq_); wv_ |= ((unsigned)qv_ & 0xFFu) << (8 * e_); } \
                  ou_[q_] = w_; ov_[q_] = wv_; } \
              *(v4u*)(du + (size_t)(row_) * D + hh_ * 1024 + F.lane * 16) = ou_; *(v4u*)(dv + (size_t)(row_) * D + hh_ * 1024 + F.lane * 16) = ov_; } } while (0)
      for (int row = gw; row < NEXP; row += 2 * NGW) {
          const int rowB = row + NGW < NEXP ? row + NGW : row;
          f32x4 ua[2][4], va[2][4], ub[2][4], vb2[2][4];
          TBL_LOAD(ua, va, row); TBL_LOAD(ub, vb2, rowB);
          TBL_QUANT(ua, va, row);
          if (rowB != row) TBL_QUANT(ub, vb2, rowB);
      }
#undef TBL_LOAD
#undef TBL_QUANT
    }
    }
    if (PART == 0) {
    { const float* x = F.in[I_X]; unsigned char* xq = WSP(unsigned char, WS_XB); float* rs1 = WSP(float, WS_RSTD1);
#define XR_LOAD(V_, row_) do { _Pragma("unroll") for (int hh_ = 0; hh_ < 2; ++hh_) _Pragma("unroll") for (int q_ = 0; q_ < 4; ++q_) V_[hh_][q_] = *(const f32x4*)(x + (size_t)(row_) * D + hh_ * 1024 + F.lane * 16 + q_ * 4); } while (0)
#define XR_QUANT(V_, row_) do { float s_ = 0.f, am_ = 0.f; \
          _Pragma("unroll") for (int hh_ = 0; hh_ < 2; ++hh_) _Pragma("unroll") for (int q_ = 0; q_ < 4; ++q_) _Pragma("unroll") for (int e_ = 0; e_ < 4; ++e_) { const float t_ = V_[hh_][q_][e_]; s_ += t_ * t_; am_ = fmaxf(am_, fabsf(t_)); } \
          s_ = wave_sum(s_); \
          _Pragma("unroll") for (int o_ = 1; o_ < 64; o_ <<= 1) am_ = fmaxf(am_, __shfl_xor(am_, o_)); \
          const float xq_ = am_ > 0.f ? 127.0f / am_ : 0.f; \
          if (F.lane == 0) rs1[row_] = am_ * (1.0f / 127.0f) / sqrtf(s_ * (1.0f / D) + NORM_EPS); \
          _Pragma("unroll") for (int hh_ = 0; hh_ < 2; ++hh_) { v4u o_; \
              _Pragma("unroll") for (int q_ = 0; q_ < 4; ++q_) { unsigned w_ = 0u; \
                  _Pragma("unroll") for (int e_ = 0; e_ < 4; ++e_) { const int qi_ = (int)rintf(V_[hh_][q_][e_] * xq_); w_ |= ((unsigned)qi_ & 0xFFu) << (8 * e_); } \
                  o_[q_] = w_; } \
              *(v4u*)(xq + (size_t)(row_) * D + hh_ * 1024 + F.lane * 16) = o_; } } while (0)
      for (int m = gw; m < T; m += 2 * NGW) { const int mB = m + NGW < T ? m + NGW : m;
          f32x4 xa[2][4], xb2[2][4];
          XR_LOAD(xa, m); XR_LOAD(xb2, mB);
          XR_QUANT(xa, m);
          if (mB != m) XR_QUANT(xb2, mB); }
#undef XR_LOAD
#undef XR_QUANT
    }
    }
}

typedef float f32x2c __attribute__((ext_vector_type(2)));
__device__ __forceinline__ unsigned cvtpk(float lo, float hi) { const f32x2c v = {lo, hi}; const bf16x2_t b = __builtin_convertvector(v, bf16x2_t); return __builtin_bit_cast(unsigned, b); }
__device__ __forceinline__ float rcpf_(float x) { return __builtin_amdgcn_rcpf(x); }
__device__ __forceinline__ float sigmoid_fast(float x) { return rcpf_(1.0f + __expf(-x)); }
__device__ __forceinline__ float tanh_fast(float x) { return 1.0f - 2.0f * rcpf_(1.0f + __expf(2.0f * x)); }
__device__ __forceinline__ float softplus_fast(float z) { return fmaxf(z, 0.f) + __logf(1.0f + __expf(-fabsf(z))); }
__device__ __forceinline__ float gelu_fast(float x) { const float u = 0.7978845608028654f * (x + 0.044715f * x * x * x); return x * rcpf_(1.0f + __expf(-2.0f * u)); }
__device__ __forceinline__ void rwkv_prep_unit(const Frame& F, int chunk, int h, int lane, const LAS bf16* WL2, const LAS bf16* AL2, const LAS bf16* GL2, const LAS float* CW, LAS bf16* ST) {
    asm volatile("" : "+v"(lane));
    const int fr = lane & 15, fq = lane >> 4;
    const bf16* PROJ = WSP(bf16, WS_PROJ); const bf16* LA = WSP(bf16, WS_LA);
    bf16* TA = WSP(bf16, WS_TA); bf16* TB = WSP(bf16, WS_TB); bf16* TK = WSP(bf16, WS_TK); bf16* TR = WSP(bf16, WS_TR);
    bf16* TV = (bf16*)F.out + OUT_TV / 2; bf16* TG = (bf16*)F.out + OUT_TG / 2; float* PCG = F.out + OUT_PC / 4; float* BONG = F.out + OUT_BON / 4;
#define PU4(w_) ((f32x4){bf_lo((w_).x), bf_hi((w_).x), bf_lo((w_).y), bf_hi((w_).y)})
    size_t tokm[2]; int pom[2]; unsigned pmm[2];
#pragma unroll
    for (int mt = 0; mt < 2; ++mt) { tokm[mt] = (size_t)chunk * 32 + mt * 16 + fr; const bool hasp = ((chunk & 63) * 32 + mt * 16 + fr) > 0; pom[mt] = hasp ? NINP : 0; pmm[mt] = hasp ? 0xffffffffu : 0u; }
    float inv[2], bn[2];
#pragma unroll
    for (int mt = 0; mt < 2; ++mt) { float s2 = 0.f;
#pragma unroll
        for (int nt = 0; nt < 4; ++nt) { const int j4 = nt * 16 + fq * 4; const bf16* pr = PROJ + tokm[mt] * NINP + PC_K + h * 64 + j4;
            const v2u kc = *(const v2u*)pr; v2u kp = *(const v2u*)(pr - pom[mt]); kp.x &= pmm[mt]; kp.y &= pmm[mt];
            const f32x4 c_kk = *(const LAS f32x4*)(CW + 128 + j4), m_k = *(const LAS f32x4*)(CW + 384 + j4);
            const f32x4 kcf = PU4(kc); const f32x4 ku = (kcf + (PU4(kp) - kcf) * m_k) * c_kk; s2 += (ku[0] * ku[0] + ku[1] * ku[1]) + (ku[2] * ku[2] + ku[3] * ku[3]); }
        { auto x = __builtin_amdgcn_permlane16_swap(__float_as_uint(s2), __float_as_uint(s2), false, false); s2 = __uint_as_float(x[0]) + __uint_as_float(x[1]); }
        { auto x = __builtin_amdgcn_permlane32_swap(__float_as_uint(s2), __float_as_uint(s2), false, false); s2 = __uint_as_float(x[0]) + __uint_as_float(x[1]); }
        inv[mt] = __builtin_amdgcn_rsqf(fmaxf(s2, 1e-24f)); bn[mt] = 0.f; }
    v2u cur_[3], prv_[3], ncur_[3], nprv_[3];
#define PREP_LOAD_RKV(C_, P_, st_) do { const int mt_ = (st_) >> 2, nt_ = (st_) & 3; const bf16* pr_ = PROJ + tokm[mt_] * NINP + PC_R + h * 64 + nt_ * 16 + fq * 4; \
        _Pragma("unroll") for (int q_ = 0; q_ < 3; ++q_) { C_[q_] = *(const v2u*)(pr_ + q_ * 1024); P_[q_] = *(const v2u*)(pr_ + q_ * 1024 - pom[mt_]); } } while (0)
    PREP_LOAD_RKV(cur_, prv_, 0);
    f32x4 tot0[4];
#pragma unroll
    for (int n = 0; n < 4; ++n) tot0[n] = (f32x4){0.f, 0.f, 0.f, 0.f};
    bf16x8 la[9];
#pragma unroll
    for (int st = 0; st < 8; ++st) { const int mt = st >> 2, nt = st & 3; const int j4 = nt * 16 + fq * 4; const size_t col = (size_t)h * 64 + j4;
        if (nt == 0) {
#pragma unroll
            for (int ks = 0; ks < 9; ++ks) la[ks] = *(const bf16x8*)(LA + tokm[mt] * 288 + ks * 32 + 8 * fq); }
        if (st < 7) PREP_LOAD_RKV(ncur_, nprv_, st + 1);
        f32x4 cw = (f32x4){0.f, 0.f, 0.f, 0.f}, ca = cw, cg = cw;
#pragma unroll
        for (int ks = 0; ks < 2; ++ks) { cw = MFMA16(*(const LAS bf16x8*)(WL2 + (nt * 16 + fr) * 72 + ks * 32 + 8 * fq), la[ks], cw); ca = MFMA16(*(const LAS bf16x8*)(AL2 + (nt * 16 + fr) * 72 + ks * 32 + 8 * fq), la[2 + ks], ca); }
#pragma unroll
        for (int ks = 0; ks < 5; ++ks) cg = MFMA16(*(const LAS bf16x8*)(GL2 + (nt * 16 + fr) * 168 + ks * 32 + 8 * fq), la[4 + ks], cg);
        const f32x4 c_w0 = *(const LAS f32x4*)(CW + j4), c_a0 = *(const LAS f32x4*)(CW + 64 + j4), c_kk = *(const LAS f32x4*)(CW + 128 + j4), c_ka = *(const LAS f32x4*)(CW + 192 + j4), c_rk = *(const LAS f32x4*)(CW + 256 + j4);
        const f32x4 m_r = *(const LAS f32x4*)(CW + 320 + j4), m_k = *(const LAS f32x4*)(CW + 384 + j4), m_v = *(const LAS f32x4*)(CW + 448 + j4);
        v2u rp = prv_[0], kp = prv_[1], vp = prv_[2]; const unsigned pm = pmm[mt];
        rp.x &= pm; rp.y &= pm; kp.x &= pm; kp.y &= pm; vp.x &= pm; vp.y &= pm;
        const f32x4 rcf = PU4(cur_[0]), kcf = PU4(cur_[1]), vcf = PU4(cur_[2]);
        const f32x4 rr = rcf + (PU4(rp) - rcf) * m_r, kv = kcf + (PU4(kp) - kcf) * m_k, vv = vcf + (PU4(vp) - vcf) * m_v;
        f32x4 nau, bbu, km, cum;
#pragma unroll
        for (int r = 0; r < 4; ++r) { const float av = sigmoid_fast(c_a0[r] + ca[r]), ku = kv[r] * c_kk[r]; km[r] = kv[r] * (1.0f + (av - 1.0f) * c_ka[r]);
            cum[r] = -0.6065306597126334f * sigmoid_fast(c_w0[r] + cw[r]);
            nau[r] = -ku; bbu[r] = ku * av; bn[mt] += rr[r] * km[r] * c_rk[r]; }
        f32x4 at4, rt4, bt4, kt4, ep4;
#pragma unroll
        for (int r = 0; r < 4; ++r) { float v = cum[r];
            v += __builtin_bit_cast(float, __builtin_amdgcn_update_dpp(0, __builtin_bit_cast(int, v), 0x111, 0xf, 0xf, true));
            v += __builtin_bit_cast(float, __builtin_amdgcn_update_dpp(0, __builtin_bit_cast(int, v), 0x112, 0xf, 0xf, true));
            v += __builtin_bit_cast(float, __builtin_amdgcn_update_dpp(0, __builtin_bit_cast(int, v), 0x114, 0xf, 0xf, true));
            v += __builtin_bit_cast(float, __builtin_amdgcn_update_dpp(0, __builtin_bit_cast(int, v), 0x118, 0xf, 0xf, true));
            if (mt == 0) tot0[nt][r] = __shfl(v, (lane & 48) | 15); else v += tot0[nt][r];
            const float ep = __expf(v), em = rcpf_(ep);
            float eprev = __builtin_bit_cast(float, __builtin_amdgcn_update_dpp(0, __builtin_bit_cast(int, ep), 0x111, 0xf, 0xf, true));
            if (fr == 0) eprev = mt ? __expf(tot0[nt][r]) : 1.0f;
            at4[r] = nau[r] * inv[mt] * eprev; rt4[r] = rr[r] * ep; bt4[r] = bbu[r] * inv[mt] * em; kt4[r] = km[r] * em; ep4[r] = ep; }
        { LAS bf16* sp = ST + fr * 64 + j4; v2u w;
          w.x = cvtpk(at4[0], at4[1]); w.y = cvtpk(at4[2], at4[3]); *(LAS v2u*)(sp) = w;
          w.x = cvtpk(rt4[0], rt4[1]); w.y = cvtpk(rt4[2], rt4[3]); *(LAS v2u*)(sp + 1024) = w;
          w.x = cvtpk(bt4[0], bt4[1]); w.y = cvtpk(bt4[2], bt4[3]); *(LAS v2u*)(sp + 2048) = w;
          w.x = cvtpk(kt4[0], kt4[1]); w.y = cvtpk(kt4[2], kt4[3]); *(LAS v2u*)(sp + 3072) = w;
          w.x = cvtpk(vv[0], vv[1]); w.y = cvtpk(vv[2], vv[3]); *(LAS v2u*)(sp + 4096) = w;
          w.x = cvtpk(cg[0], cg[1]); w.y = cvtpk(cg[2], cg[3]); *(LAS v2u*)(sp + 5120) = w; }
        if (nt == 3) {
            bf16* const dstp[6] = {TA, TR, TB, TK, TV, TG};
#pragma unroll
            for (int a6 = 0; a6 < 6; ++a6)
#pragma unroll
                for (int hrow = 0; hrow < 2; ++hrow) { const int row = hrow * 8 + (lane >> 3), c8 = (lane & 7) * 8;
                    const v4u pv = *(const LAS v4u*)(ST + a6 * 1024 + row * 64 + c8);
                    *(v4u*)(dstp[a6] + ((size_t)chunk * 32 + mt * 16 + row) * 1024 + (size_t)h * 64 + c8) = pv; } }
        if (mt == 1 && fr == 15) *(f32x4*)(PCG + (size_t)chunk * 1024 + col) = ep4;
#pragma unroll
        for (int q = 0; q < 3; ++q) { cur_[q] = ncur_[q]; prv_[q] = nprv_[q]; }
    }
#undef PREP_LOAD_RKV
#undef PU4
#pragma unroll
    for (int mt = 0; mt < 2; ++mt) { float b2 = bn[mt];
        { auto x = __builtin_amdgcn_permlane16_swap(__float_as_uint(b2), __float_as_uint(b2), false, false); b2 = __uint_as_float(x[0]) + __uint_as_float(x[1]); }
        { auto x = __builtin_amdgcn_permlane32_swap(__float_as_uint(b2), __float_as_uint(b2), false, false); b2 = __uint_as_float(x[0]) + __uint_as_float(x[1]); }
        if (fq == 0) BONG[tokm[mt] * 16 + h] = b2; }
}
__device__ __forceinline__ void rwkv_prep_phase(const Frame& F) {
    LAS bf16* WL2 = (LAS bf16*)(F.lds + 0); LAS bf16* AL2 = (LAS bf16*)(F.lds + 9216); LAS bf16* GL2 = (LAS bf16*)(F.lds + 18432); LAS float* CW = (LAS float*)(F.lds + 39936);
    int hcur = -1;
    for (int u = F.bid; u < 1024; u += F.G) { const int h = u & 15, cg = u >> 4;
        if (h != hcur) { hcur = h; __syncthreads();
            int tid_ = F.tid; asm volatile("" : "+v"(tid_));
            const bf16* w2t = WSP(bf16, WS_W2T) + (size_t)h * 64 * 64; const bf16* a2t = WSP(bf16, WS_A2T) + (size_t)h * 64 * 64; const bf16* g2t = WSP(bf16, WS_G2T) + (size_t)h * 64 * 160;
            { const int r = tid_ >> 3, c = (tid_ & 7) * 8; *(LAS v4u*)(WL2 + r * 72 + c) = *(const v4u*)(w2t + r * 64 + c); *(LAS v4u*)(AL2 + r * 72 + c) = *(const v4u*)(a2t + r * 64 + c); }
            for (int i = tid_; i < 64 * 20; i += NTHR) { const int r = i / 20, c = (i - r * 20) * 8; *(LAS v4u*)(GL2 + r * 168 + c) = *(const v4u*)(g2t + r * 160 + c); }
            { const int q = tid_ >> 6, jj = tid_ & 63; const float* src = q == 0 ? F.in[I_W0] : (q == 1 ? F.in[I_A0] : (q == 2 ? F.in[I_KK] : (q == 3 ? F.in[I_KA] : (q == 4 ? F.in[I_RK] : F.in[I_MU] + (q - 5) * 1024)))); CW[q * 64 + jj] = src[h * 64 + jj]; }
            __syncthreads(); }
        rwkv_prep_unit(F, cg * 8 + F.wave, h, F.lane, WL2, AL2, GL2, CW, (LAS bf16*)(F.lds + 43008 + F.wave * 12288)); }
    __syncthreads();
}
typedef short v4i16_t __attribute__((ext_vector_type(4)));
__device__ __forceinline__ bf16x8 frag_tr16(const LAS bf16* p, int ld) {
    const v4i16_t a = __builtin_amdgcn_ds_read_tr16_b64_v4i16((LAS v4i16_t*)p), b = __builtin_amdgcn_ds_read_tr16_b64_v4i16((LAS v4i16_t*)(p + 4 * ld));
    return (bf16x8){a[0], a[1], a[2], a[3], b[0], b[1], b[2], b[3]};
}
__device__ __forceinline__ void rwkv_item(const Frame& F, int item) {
    const int b = item >> 4, h = item & 15, wave = F.wave; int tid = F.tid; asm volatile("" : "+v"(tid)); const int lane = tid & 63;
    LAS unsigned char* L = F.lds;
    constexpr int LD64 = 72, LD32 = 40, E0 = 73216;
    LAS bf16* AT = (LAS bf16*)(L + 0);  LAS bf16* BT_ = (LAS bf16*)(L + 4608); LAS bf16* KT_ = (LAS bf16*)(L + 9216); LAS bf16* RT = (LAS bf16*)(L + 13824);
    LAS bf16* VS2 = (LAS bf16*)(L + 18432);
    LAS bf16* GGB2 = (LAS bf16*)(L + 27648);
    LAS bf16* S0B = (LAS bf16*)(L + 36864);
    LAS float* YB2 = (LAS float*)(L + 55296);
    LAS float* BON2 = (LAS float*)(L + 72704);
    LAS float* PC = (LAS float*)(L + 72960);
    LAS bf16* AAK = (LAS bf16*)(L + E0); LAS bf16* ARB = (LAS bf16*)(L + E0 + 2560); LAS bf16* ARK = (LAS bf16*)(L + E0 + 5120);
    LAS bf16* XB_ = (LAS bf16*)(L + E0 + 7680);
    LAS bf16* XTB = (LAS bf16*)(L + E0 + 12800);
    LAS bf16* PMB = (LAS bf16*)(L + E0 + 17920);
    LAS bf16* RHS = (LAS bf16*)(L + E0 + 23040);
    LAS bf16* SAB = (LAS bf16*)(L + E0 + 28160);
    static_assert(E0 + 33280 <= LDSCTL_OFF, "rwkv LDS map");
    bf16* Y = WSP(bf16, WS_Y);
#define FRAG(base, row0, ld, ks) (*(const LAS bf16x8*)((base) + ((row0) + fr) * (ld) + (ks) * 32 + 8 * fq))
#define FRAGT(base, col0, ld) frag_tr16((base) + (8 * fq + (fr >> 2)) * (ld) + (col0) + 4 * (fr & 3), (ld))
    const int tt = tid >> 4, j0 = (tid & 15) * 4, hc = h * 64 + j0;
    const f32x4 plw = *(const f32x4*)(F.in[I_LNW] + hc), plb = *(const f32x4*)(F.in[I_LNB] + hc);
    const int lr = (tid & 255) >> 3, lc8 = tid & 7; const bool hi2 = tid >= 256;
    const bf16* srcA[3] = { (hi2 ? WSP(bf16, WS_TR) : WSP(bf16, WS_TA)), (hi2 ? WSP(bf16, WS_TK) : WSP(bf16, WS_TB)), (hi2 ? (const bf16*)F.out + OUT_TG / 2 : (const bf16*)F.out + OUT_TV / 2) };
    const size_t poff = ((size_t)b * SEQ + lr) * 1024 + h * 64 + lc8 * 8;
    const float* PCG = F.out + OUT_PC / 4 + (size_t)(b * 64) * 1024 + h * 64; const float* BONG = F.out + OUT_BON / 4 + (size_t)b * SEQ * 16 + h;
    v4u pl_[3]; float ppc = 0.f, pbn = 0.f;
#define RWKV_PREFETCH(tl_) do { _Pragma("unroll") for (int q_ = 0; q_ < 3; ++q_) pl_[q_] = *(const v4u*)(srcA[q_] + poff + (size_t)(tl_) * 32 * 1024); \
        ppc = PCG[(size_t)(tl_) * 1024 + (tid & 63)]; pbn = BONG[((size_t)(tl_) * 32 + (tid & 31)) * 16]; } while (0)
    const int ib = wave >> 1, tb = wave & 1, i0 = ib * 16, t0m = tb * 16;
    f32x4 sacc[2], pmacc, yacc;
    sacc[0] = (f32x4){0.f, 0.f, 0.f, 0.f}; sacc[1] = sacc[0]; pmacc = sacc[0]; yacc = sacc[0];
    for (int u = tid; u < 2 * 64 * LD64 / 2; u += NTHR) ((LAS unsigned*)S0B)[u] = 0u;
    RWKV_PREFETCH(0);
    __syncthreads();
    for (int tl = 0; tl <= SEQ / 32; ++tl) {
        const int cur = tl & 1;
        int lane_c = lane; asm volatile("" : "+v"(lane_c)); const int fr = lane_c & 15, fq = lane_c >> 4;
        LAS bf16* VS = VS2 + cur * 32 * LD64; LAS bf16* GGB = GGB2 + cur * 32 * LD64; LAS float* YB = YB2 + cur * 32 * 68; LAS float* BON = BON2 + cur * 32;
        const LAS bf16* VSp = VS2 + (cur ^ 1) * 32 * LD64; const LAS bf16* GGBp = GGB2 + (cur ^ 1) * 32 * LD64; const LAS float* YBp = YB2 + (cur ^ 1) * 32 * 68; const LAS float* BONp = BON2 + (cur ^ 1) * 32;
        if (tl > 0) { const size_t tokb = (size_t)b * SEQ + (tl - 1) * 32;
          const f32x4 y4 = *(const LAS f32x4*)(YBp + tt * 68 + j0); const v2u gw_ = *(const LAS v2u*)(GGBp + tt * LD64 + j0);
          const f32x4 g4 = (f32x4){bf_lo(gw_.x), bf_hi(gw_.x), bf_lo(gw_.y), bf_hi(gw_.y)};
          const v2u vw_ = *(const LAS v2u*)(VSp + tt * LD64 + j0); const f32x4 v4 = (f32x4){bf_lo(vw_.x), bf_hi(vw_.x), bf_lo(vw_.y), bf_hi(vw_.y)};
          float sm = (y4[0] + y4[1]) + (y4[2] + y4[3]); sm = red16(sm); const float mean = sm * (1.0f / 64.0f);
          const f32x4 d4 = y4 - mean; float sv = (d4[0] * d4[0] + d4[1] * d4[1]) + (d4[2] * d4[2] + d4[3] * d4[3]); sv = red16(sv);
          const float rstd = __builtin_amdgcn_rsqf(sv * (1.0f / 64.0f) + GN_EPS), bon = BONp[tt];
          f32x4 o;
#pragma unroll
          for (int e = 0; e < 4; ++e) o[e] = (d4[e] * rstd * plw[e] + plb[e] + bon * v4[e]) * g4[e];
          v2u w; w.x = cvtpk(o[0], o[1]); w.y = cvtpk(o[2], o[3]);
          *(v2u*)(Y + (tokb + tt) * D + 1024 + hc) = w; }
        if (tl == SEQ / 32) break;
        const LAS bf16* S0c = S0B + cur * 64 * LD64; LAS bf16* S0n = S0B + (cur ^ 1) * 64 * LD64;
        { const v4u p0 = pl_[0], p1 = pl_[1], p2 = pl_[2];
          *(LAS v4u*)((hi2 ? RT : AT) + lr * LD64 + lc8 * 8) = p0;
          *(LAS v4u*)((hi2 ? KT_ : BT_) + lr * LD64 + lc8 * 8) = p1;
          *(LAS v4u*)((hi2 ? GGB : VS) + lr * LD64 + lc8 * 8) = p2;
          if (tid < 64) PC[tid] = ppc;
          if (tid >= 64 && tid < 96) BON[tid - 64] = pbn; }
        { const int tn_ = tl + 1 < SEQ / 32 ? tl + 1 : SEQ / 32 - 1; RWKV_PREFETCH(tn_); }
        __syncthreads();
        { const int q = wave & 3, tq = (q >> 1) * 16, sq = (q & 1) * 16; const bool zt = sq > tq;
#pragma unroll
            for (int mi = 0; mi < 2; ++mi) { const int mtx = (wave < 4) ? mi : 2; if (wave >= 4 && mi == 1) break;
                const LAS bf16* Xs = (mtx == 1) ? BT_ : KT_; const LAS bf16* Yt = (mtx == 0) ? AT : RT; LAS bf16* O = (mtx == 0) ? AAK : (mtx == 1 ? ARB : ARK);
                f32x4 a4 = (f32x4){0.f, 0.f, 0.f, 0.f};
                if (!zt) {
#pragma unroll
                    for (int ks = 0; ks < 2; ++ks) a4 = MFMA16(FRAG(Xs, sq, LD64, ks), FRAG(Yt, tq, LD64, ks), a4); }
                const int t = tq + fr, s = sq + fq * 4;
#pragma unroll
                for (int r = 0; r < 4; ++r) { const bool keep = (mtx == 0) ? (s + r < t) : (s + r <= t); a4[r] = keep ? a4[r] : 0.f; }
                v2u w; w.x = cvtpk(a4[0], a4[1]); w.y = cvtpk(a4[2], a4[3]); *(LAS v2u*)(O + t * LD32 + s) = w; } }
        if (wave >= 4) { const int q = wave - 4, tq = (q >> 1) * 16, sq = (q & 1) * 16;
            f32x4 a4 = (f32x4){0.f, 0.f, 0.f, 0.f};
            if (sq <= tq) {
#pragma unroll
            for (int ks = 0; ks < 2; ++ks) a4 = MFMA16(FRAG(BT_, sq, LD64, ks), FRAG(AT, tq, LD64, ks), a4); }
            const int t = tq + fr, s = sq + fq * 4;
#pragma unroll
            for (int r = 0; r < 4; ++r) { a4[r] = (s + r < t) ? a4[r] : 0.f; XTB[(s + r) * LD32 + t] = (bf16)(cvtpk(a4[r], 0.f) & 0xffffu); }
            v2u w; w.x = cvtpk(a4[0], a4[1]); w.y = cvtpk(a4[2], a4[3]); *(LAS v2u*)(XB_ + t * LD32 + s) = w;
#pragma unroll
            for (int r = 0; r < 4; ++r) pmacc[r] = a4[r] + ((s + r == t) ? 1.0f : 0.f);
            w.x = cvtpk(pmacc[0], pmacc[1]); w.y = cvtpk(pmacc[2], pmacc[3]); *(LAS v2u*)(PMB + t * LD32 + s) = w; }
        __syncthreads();
#pragma unroll
        for (int ns = 0; ns < 5; ++ns) { const int cb = ns & 1, nb = cb ^ 1;
            const LAS bf16* Xc = XB_ + cb * 32 * LD32; const LAS bf16* XTc = XTB + cb * 32 * LD32; const LAS bf16* Pc = PMB + cb * 32 * LD32;
            LAS bf16* Xn = XB_ + nb * 32 * LD32; LAS bf16* XTn = XTB + nb * 32 * LD32; LAS bf16* Pn = PMB + nb * 32 * LD32;
            if (wave < 4) { if (ns < 4) { const int tq = (wave >> 1) * 16, sq = (wave & 1) * 16;
                    f32x4 a4 = (f32x4){0.f, 0.f, 0.f, 0.f}; a4 = MFMA16(FRAG(XTc, sq, LD32, 0), FRAG(Xc, tq, LD32, 0), a4);
                    const int t = tq + fr, s = sq + fq * 4;
#pragma unroll
                    for (int r = 0; r < 4; ++r) XTn[(s + r) * LD32 + t] = (bf16)(cvtpk(a4[r], 0.f) & 0xffffu);
                    v2u w; w.x = cvtpk(a4[0], a4[1]); w.y = cvtpk(a4[2], a4[3]); *(LAS v2u*)(Xn + t * LD32 + s) = w; } }
            else { const int q = wave - 4, tq = (q >> 1) * 16, sq = (q & 1) * 16;
                if (ns > 0) pmacc = MFMA16(FRAG(XTc, sq, LD32, 0), FRAG(Pc, tq, LD32, 0), pmacc);
                const int t = tq + fr, s = sq + fq * 4;
                v2u w; w.x = cvtpk(pmacc[0], pmacc[1]); w.y = cvtpk(pmacc[2], pmacc[3]); *(LAS v2u*)(Pn + t * LD32 + s) = w; }
            if (ns == 1) {
                f32x4 a4 = (f32x4){0.f, 0.f, 0.f, 0.f};
#pragma unroll
                for (int ks = 0; ks < 2; ++ks) a4 = MFMA16(FRAG(AT, t0m, LD64, ks), FRAG(S0c, i0, LD64, ks), a4);
                a4 = MFMA16(FRAG(AAK, t0m, LD32, 0), FRAGT(VS, i0, LD64), a4);
                v2u w; w.x = cvtpk(a4[0], a4[1]); w.y = cvtpk(a4[2], a4[3]); *(LAS v2u*)(RHS + (i0 + fr) * LD32 + t0m + fq * 4) = w; }
            if (ns == 2) {
                yacc = (f32x4){0.f, 0.f, 0.f, 0.f};
#pragma unroll
                for (int ks = 0; ks < 2; ++ks) yacc = MFMA16(FRAG(S0c, i0, LD64, ks), FRAG(RT, t0m, LD64, ks), yacc);
                yacc = MFMA16(FRAGT(VS, i0, LD64), FRAG(ARK, t0m, LD32, 0), yacc); }
            if (ns == 3) {
#pragma unroll
                for (int u = 0; u < 2; ++u) { const int tile = wave * 2 + u, si0 = (tile >> 2) * 16, sj0 = (tile & 3) * 16; sacc[u] = MFMA16(FRAGT(KT_, sj0, LD64), FRAGT(VS, si0, LD64), sacc[u]); } }
            __syncthreads();
        }
        const LAS bf16* MINV = PMB + 1 * 32 * LD32;
        { f32x4 a4 = (f32x4){0.f, 0.f, 0.f, 0.f}; a4 = MFMA16(FRAG(MINV, t0m, LD32, 0), FRAG(RHS, i0, LD32, 0), a4);
          v2u w; w.x = cvtpk(a4[0], a4[1]); w.y = cvtpk(a4[2], a4[3]); *(LAS v2u*)(SAB + (i0 + fr) * LD32 + t0m + fq * 4) = w; }
        __syncthreads();
        { yacc = MFMA16(FRAG(SAB, i0, LD32, 0), FRAG(ARB, t0m, LD32, 0), yacc);
          *(LAS f32x4*)(YB + (t0m + fr) * 68 + i0 + fq * 4) = yacc;
#pragma unroll
          for (int u = 0; u < 2; ++u) { const int tile = wave * 2 + u, si0 = (tile >> 2) * 16, sj0 = (tile & 3) * 16;
              sacc[u] = MFMA16(FRAGT(BT_, sj0, LD64), FRAG(SAB, si0, LD32, 0), sacc[u]);
              const f32x4 pc = *(const LAS f32x4*)(PC + sj0 + fq * 4); sacc[u] = sacc[u] * pc;
              v2u w; w.x = cvtpk(sacc[u][0], sacc[u][1]); w.y = cvtpk(sacc[u][2], sacc[u][3]); *(LAS v2u*)(S0n + (si0 + fr) * LD64 + sj0 + fq * 4) = w; } }
        __syncthreads();
    }
    __syncthreads();
#undef FRAG
#undef FRAGT
#undef RWKV_PREFETCH
}
__device__ __forceinline__ void lora_prepass(const Frame& F) {
    const bf16* PROJ = WSP(bf16, WS_PROJ); bf16* LA = WSP(bf16, WS_LA); const float* mu = F.in[I_MU] + (PC_WD - RWKV_C0);
    const int gt = (F.bid * NWAVES + F.wave) * 64 + F.lane, NGT = F.G * NTHR;
    for (int i = gt; i < T * 36; i += NGT) { const int tok = i / 36, cc = i - tok * 36, m = cc * 8;
        const bf16* pr = PROJ + (size_t)tok * NINP + PC_WD + m;
        const v4u curv = *(const v4u*)pr; v4u prv = (v4u){0u, 0u, 0u, 0u}; if ((tok & (SEQ - 1)) != 0) prv = *(const v4u*)(pr - NINP);
        const f32x4 m0 = *(const f32x4*)(mu + m), m1 = *(const f32x4*)(mu + m + 4);
        float c[8], p[8], o[8]; unpack8(curv, c); unpack8(prv, p);
#pragma unroll
        for (int e = 0; e < 8; ++e) { const float ps = c[e] + (p[e] - c[e]) * (e < 4 ? m0[e] : m1[e - 4]); o[e] = (m < 64) ? tanh_fast(ps) : ((m < 128) ? ps : sigmoid_fast(ps)); }
        v4u w; w.x = cvtpk(o[0], o[1]); w.y = cvtpk(o[2], o[3]); w.z = cvtpk(o[4], o[5]); w.w = cvtpk(o[6], o[7]);
        *(v4u*)(LA + (size_t)tok * 288 + m) = w; }
}
__device__ __forceinline__ void lru_seq(const Frame& F, int bh) {
    const int b = bh >> 3, h = bh & 7, wave = F.wave; int tid = F.tid; asm volatile("" : "+v"(tid)); const int lane = tid & 63;
    LAS unsigned char* L = F.lds;
    LAS bf16* XA = (LAS bf16*)(L + 0);
    LAS float* XC = (LAS float*)(L + 17408);
    LAS float* RI = (LAS float*)(L + 50176);
    LAS float* SEG = (LAS float*)(L + 115712);
    LAS float* CARRY = (LAS float*)(L + 119808);
    LAS float* CW = (LAS float*)(L + 120320);
    const bf16* PROJ = WSP(bf16, WS_PROJ); bf16* Y = WSP(bf16, WS_Y);
    const int fr0 = lane & 15, fq0 = lane >> 4;
    for (int i = tid; i < 640; i += NTHR) { const int w = i >> 7, cch = i & 127; CW[i] = (w < 4) ? F.in[I_CONVW][w * 1024 + h * 128 + cch] : F.in[I_CONVB][h * 128 + cch]; }
    if (tid < 128) CARRY[tid] = 0.f;
    const int gsel = wave & 1, nt0 = (wave >> 1) * 2;
    bf16x8 wf[2][4];
    { const bf16* WTp = (gsel ? WSP(bf16, WS_WIT) : WSP(bf16, WS_WAT)) + (size_t)h * 128 * 128;
#pragma unroll
      for (int n = 0; n < 2; ++n)
#pragma unroll
          for (int ks = 0; ks < 4; ++ks) wf[n][ks] = *(const bf16x8*)(WTp + ((nt0 + n) * 16 + fr0) * 128 + ks * 32 + 8 * fq0); }
    const int c = tid & 127, sg = tid >> 7, chg = h * 128 + c;
    const float ba_c = F.in[I_BA][chg], bi_c = F.in[I_BI][chg], sp8 = 8.0f * softplus_fast(-F.in[I_LAM][chg]);
    v4u pf[2][4];
#define LRU_PREFETCH(k_) do { _Pragma("unroll") for (int u_ = 0; u_ < 2; ++u_) { const int chn_ = tid + NTHR * u_, t_ = chn_ >> 4, c8_ = (chn_ & 15) * 8; \
        _Pragma("unroll") for (int w_ = 0; w_ < 4; ++w_) { const int ts_ = (k_) * 64 + t_ - 3 + w_; const int tc_ = ts_ >= 0 ? ts_ : 0;   \
            const v4u x_ = *(const v4u*)(PROJ + ((size_t)b * SEQ + tc_) * NINP + h * 128 + c8_); const unsigned m_ = ts_ >= 0 ? 0xffffffffu : 0u; \
            pf[u_][w_] = (v4u){x_.x & m_, x_.y & m_, x_.z & m_, x_.w & m_}; } } } while (0)
    LRU_PREFETCH(0);
    __syncthreads();
    for (int k = 0; k < SEQ / 64; ++k) {
        const size_t tokbase = (size_t)b * SEQ + k * 64;
        int lane_c = lane; asm volatile("" : "+v"(lane_c)); const int fr = lane_c & 15, fq = lane_c >> 4;
#pragma unroll
        for (int u = 0; u < 2; ++u) { const int chn = tid + NTHR * u, t = chn >> 4, c8 = (chn & 15) * 8;
            float acc[8]; { const f32x4 b0 = *(const LAS f32x4*)(CW + 512 + c8), b1 = *(const LAS f32x4*)(CW + 512 + c8 + 4);
#pragma unroll
                for (int e = 0; e < 4; ++e) { acc[e] = b0[e]; acc[e + 4] = b1[e]; } }
#pragma unroll
            for (int w = 0; w < 4; ++w) { float xf[8]; unpack8(pf[u][w], xf);
                const f32x4 w0 = *(const LAS f32x4*)(CW + w * 128 + c8), w1 = *(const LAS f32x4*)(CW + w * 128 + c8 + 4);
#pragma unroll
                for (int e = 0; e < 4; ++e) { acc[e] += w0[e] * xf[e]; acc[e + 4] += w1[e] * xf[e + 4]; } }
            v4u pk; pk.x = cvtpk(acc[0], acc[1]); pk.y = cvtpk(acc[2], acc[3]); pk.z = cvtpk(acc[4], acc[5]); pk.w = cvtpk(acc[6], acc[7]);
            *(LAS v4u*)(XA + t * 136 + c8) = pk;
            LAS float* d = XC + t * 128 + c8; *(LAS f32x4*)d = (f32x4){acc[0], acc[1], acc[2], acc[3]}; *(LAS f32x4*)(d + 4) = (f32x4){acc[4], acc[5], acc[6], acc[7]}; }
        { const int kn_ = k + 1 < SEQ / 64 ? k + 1 : SEQ / 64 - 1; LRU_PREFETCH(kn_); }
        unsigned short gt[16];
#pragma unroll
        for (int e = 0; e < 16; ++e) gt[e] = PROJ[(tokbase + sg * 16 + e) * NINP + PC_GATE + chg];
        __syncthreads();
#pragma unroll
        for (int mt = 0; mt < 4; ++mt) {
            bf16x8 af[4];
#pragma unroll
            for (int ks = 0; ks < 4; ++ks) af[ks] = *(const LAS bf16x8*)(XA + (mt * 16 + fr) * 136 + ks * 32 + 8 * fq);
#pragma unroll
            for (int n = 0; n < 2; ++n) { f32x4 a4 = (f32x4){0.f, 0.f, 0.f, 0.f};
#pragma unroll
                for (int ks = 0; ks < 4; ++ks) a4 = MFMA16(wf[n][ks], af[ks], a4);
                *(LAS f32x4*)(RI + gsel * 8192 + (mt * 16 + fr) * 128 + (nt0 + n) * 16 + fq * 4) = a4; } }
        __syncthreads();
        float av[16], bx[16]; float A = 1.f, B = 0.f;
#pragma unroll
        for (int e = 0; e < 16; ++e) { const int t = sg * 16 + e; const float r = sigmoid_fast(RI[t * 128 + c] + ba_c), ig = sigmoid_fast(RI[8192 + t * 128 + c] + bi_c), xc = XC[t * 128 + c];
            const float la = -sp8 * r; av[e] = __expf(la); bx[e] = sqrtf(fmaxf(1.0f - av[e] * av[e], 0.f)) * (ig * xc); A *= av[e]; B = av[e] * B + bx[e]; }
        SEG[(sg * 128 + c) * 2] = A; SEG[(sg * 128 + c) * 2 + 1] = B;
        __syncthreads();
        float hst = CARRY[c];
        for (int s2 = 0; s2 < sg; ++s2) hst = SEG[(s2 * 128 + c) * 2] * hst + SEG[(s2 * 128 + c) * 2 + 1];
#pragma unroll
        for (int e = 0; e < 16; ++e) { hst = av[e] * hst + bx[e];
            const float g = __uint_as_float((unsigned)gt[e] << 16);
            Y[(tokbase + sg * 16 + e) * D + chg] = (bf16)(cvtpk(hst * gelu_fast(g), 0.f) & 0xffffu); }
        __syncthreads();
        if (sg == 3) CARRY[c] = hst;
    }
    __syncthreads();
#undef LRU_PREFETCH
}
__device__ __forceinline__ void group_barrier(unsigned* cnt, unsigned n) {
    asm volatile("s_waitcnt vmcnt(0)" ::: "memory");
    __syncthreads();
    if (threadIdx.x == 0) {
        __builtin_amdgcn_fence(__ATOMIC_RELEASE, "agent");
        asm volatile("s_waitcnt vmcnt(0)" ::: "memory");
        xb_add(cnt, 1u);
        unsigned sp = 0; while (xb_ld(cnt) < n) { __builtin_amdgcn_s_sleep(2); if (++sp > (1u << 24)) break; }
        __builtin_amdgcn_fence(__ATOMIC_ACQUIRE, "agent");
        asm volatile("s_waitcnt vmcnt(0)" ::: "memory");
    }
    __syncthreads();
}

__device__ __forceinline__ unsigned f2ord(float f) { const unsigned u = __builtin_bit_cast(unsigned, f); return (u & 0x80000000u) ? ~u : (u | 0x80000000u); }
__device__ __forceinline__ float ord2f(unsigned o) { const unsigned u = (o & 0x80000000u) ? (o & 0x7fffffffu) : ~o; return __builtin_bit_cast(float, u); }
#define CMPX(hi_, lo_) do { const unsigned _a = (hi_), _b = (lo_); (hi_) = _a > _b ? _a : _b; (lo_) = _a > _b ? _b : _a; } while (0)
template <int N> __device__ __forceinline__ void sort_desc(unsigned (&a)[N]) {
#pragma unroll
    for (int k = 2; k <= N; k <<= 1)
#pragma unroll
        for (int j = k >> 1; j > 0; j >>= 1)
#pragma unroll
            for (int i = 0; i < N; ++i) { const int l = i ^ j; if (l > i) { if ((i & k) == 0) CMPX(a[i], a[l]); else CMPX(a[l], a[i]); } }
}
__device__ __forceinline__ void merge16(unsigned (&A)[16], const unsigned (&B)[16]) {
#pragma unroll
    for (int i = 0; i < 16; ++i) { const unsigned q = B[15 - i]; A[i] = A[i] > q ? A[i] : q; }
#pragma unroll
    for (int d = 8; d >= 1; d >>= 1)
#pragma unroll
        for (int i = 0; i < 16; ++i) if ((i & d) == 0) CMPX(A[i], A[i + d]);
}
__device__ __forceinline__ void merge_partner(unsigned (&Lk)[16]) {
    unsigned P[16];
#pragma unroll
    for (int i = 0; i < 16; ++i) P[i] = (unsigned)__shfl_xor((int)Lk[i], 32);
#pragma unroll
    for (int i = 0; i < 16; ++i) { const unsigned q = P[15 - i]; Lk[i] = Lk[i] > q ? Lk[i] : q; }
#pragma unroll
    for (int d = 8; d >= 1; d >>= 1)
#pragma unroll
        for (int i = 0; i < 16; ++i) if ((i & d) == 0) CMPX(Lk[i], Lk[i + d]);
}
__device__ __forceinline__ void route_item(const Frame& F, int item, int lane) {
    const int tok0 = (item >> 3) * 32, h = item & 7, c = lane & 31, hi = lane >> 5;
    const bf16* Q = WSP(bf16, WS_Q); const bf16* KB = WSP(bf16, WS_KEYS);
    LAS unsigned* WL = (LAS unsigned*)(F.lds + F.wave * 8192);
    unsigned LST[2][16];
    bf16x8 qf[8], qn[8], kf[8], kn[8];
#pragma unroll
    for (int ks = 0; ks < 8; ++ks) { qf[ks] = *(const bf16x8*)(Q + (size_t)(tok0 + c) * D + h * 256 + ks * 16 + 8 * hi); qn[ks] = *(const bf16x8*)(Q + (size_t)(tok0 + c) * D + h * 256 + 128 + ks * 16 + 8 * hi);
        kf[ks] = *(const bf16x8*)(KB + (size_t)((h * 2) * 128 + c) * 128 + 8 * hi + ks * 16); }
    unsigned Lk[16];
#pragma unroll
    for (int st = 0; st < 8; ++st) { const int p = st >> 2, m = st & 3;
        if (st < 7) { const int p2 = (st + 1) >> 2, m2 = (st + 1) & 3; const bf16* kp = KB + (size_t)((h * 2 + p2) * 128 + m2 * 32 + c) * 128 + 8 * hi;
#pragma unroll
            for (int ks = 0; ks < 8; ++ks) kn[ks] = *(const bf16x8*)(kp + ks * 16); }
        f32x16 acc;
#pragma unroll
        for (int r = 0; r < 16; ++r) acc[r] = 0.f;
#pragma unroll
        for (int ks = 0; ks < 8; ++ks) acc = MFMA32(kf[ks], p ? qn[ks] : qf[ks], acc);
        unsigned G16[16];
#pragma unroll
        for (int r = 0; r < 16; ++r) { const unsigned idx = (unsigned)(m * 32 + (r & 3) + 8 * (r >> 2)) | ((unsigned)hi << 2); G16[r] = (f2ord(acc[r]) & ~0x7Fu) | idx; }
        sort_desc<16>(G16);
        if (m == 0) {
#pragma unroll
            for (int i = 0; i < 16; ++i) Lk[i] = G16[i]; }
        else merge16(Lk, G16);
        if (m == 3) { merge_partner(Lk);
#pragma unroll
            for (int i = 0; i < 16; ++i) { LST[p][i] = Lk[i]; WL[(p * 16 + i) * 64 + lane] = Lk[i] & 0x7Fu; } }
#pragma unroll
        for (int ks = 0; ks < 8; ++ks) kf[ks] = kn[ks];
    }
    float va[4], vb[16];
#pragma unroll
    for (int i = 0; i < 4; ++i) va[i] = ord2f((hi ? LST[1][i] : LST[0][i]) & ~0x7Fu);
#pragma unroll
    for (int j = 0; j < 16; ++j) vb[j] = ord2f((hi ? LST[0][j] : LST[1][j]) & ~0x7Fu);
    unsigned C32[32];
#pragma unroll
    for (int i = 0; i < 32; ++i) C32[i] = 0u;
#pragma unroll
    for (int i = 0; i < 4; ++i) { const unsigned key = (f2ord(va[i] + vb[i]) & ~0xFFu) | (unsigned)(i * 17); C32[i] = hi ? 0u : key; }
    { int cn = 4;
#pragma unroll
      for (int i = 0; i < 3; ++i)
#pragma unroll
          for (int j = i + 1; j < 16; ++j) if ((i + 1) * (j + 1) <= 16) { const unsigned code = hi ? (unsigned)(j * 16 + i) : (unsigned)(i * 16 + j); C32[cn] = (f2ord(va[i] + vb[j]) & ~0xFFu) | code; ++cn; } }
    sort_desc<32>(C32);
    unsigned Ck[16];
#pragma unroll
    for (int i = 0; i < 16; ++i) Ck[i] = C32[i];
    merge_partner(Ck);
    const float mx = ord2f(Ck[0] & ~0xFFu); float den = 0.f;
#pragma unroll
    for (int k = 0; k < 16; ++k) den += __expf(ord2f(Ck[k] & ~0xFFu) - mx);
    const float rden = 1.0f / den;
    int eo[8]; float go[8];
#pragma unroll
    for (int k = 0; k < 8; ++k) { const unsigned fm = hi ? Ck[k + 8] : Ck[k]; const unsigned code = fm & 0xFFu;
        const unsigned k0 = WL[(code >> 4) * 64 + lane], k1 = WL[(16 + (code & 15u)) * 64 + lane];
        eo[k] = (int)(k0 * 128u + k1); go[k] = __expf(ord2f(fm & ~0xFFu) - mx) * rden; }
    int* ep = WSP(int, WS_EXP) + (size_t)(tok0 + c) * NSEL + h * 16 + hi * 8; float* gp = WSP(float, WS_GATE) + (size_t)(tok0 + c) * NSEL + h * 16 + hi * 8;
    *(int4*)ep = make_int4(eo[0], eo[1], eo[2], eo[3]); *(int4*)(ep + 4) = make_int4(eo[4], eo[5], eo[6], eo[7]);
    *(f32x4*)gp = (f32x4){go[0], go[1], go[2], go[3]}; *(f32x4*)(gp + 4) = (f32x4){go[4], go[5], go[6], go[7]};
}

typedef float f32x2 __attribute__((ext_vector_type(2)));
__device__ __forceinline__ int dot4i(unsigned a, unsigned b, int c) { return __builtin_amdgcn_sdot4((int)a, (int)b, c, false); }
template <int CTRL> __device__ __forceinline__ int dppi(int x) { return __builtin_amdgcn_mov_dpp(x, CTRL, 0xf, 0xf, true); }
struct PeerGeom { int ngrp, g, rank, nrank; };
__device__ __forceinline__ PeerGeom peer_geom(const Frame& F) { PeerGeom p; p.ngrp = (F.G % 8 == 0) ? 8 : 1; p.g = F.bid % p.ngrp; p.rank = F.bid / p.ngrp; p.nrank = F.G / p.ngrp; return p; }
__device__ __forceinline__ void xquant_token(const Frame& F, int tok, int lane) {
    const bf16* xr = WSP(bf16, WS_XB) + (size_t)tok * D + lane * 16; float xf[32]; float am = 0.f, sq = 0.f;
#pragma unroll
    for (int hh = 0; hh < 2; ++hh)
#pragma unroll
        for (int q = 0; q < 2; ++q) { const v4u w = *(const v4u*)(xr + hh * 1024 + q * 8); float t8[8]; unpack8(w, t8);
#pragma unroll
            for (int e = 0; e < 8; ++e) { xf[hh * 16 + q * 8 + e] = t8[e]; am = fmaxf(am, fabsf(t8[e])); sq += t8[e] * t8[e]; } }
#pragma unroll
    for (int o = 1; o < 64; o <<= 1) am = fmaxf(am, __shfl_xor(am, o));
    sq = wave_sum(sq);
    const float qs = am > 0.f ? 127.0f / am : 0.f;
    if (lane == 0) { WSP(float, WS_SX)[tok] = am * (1.0f / 127.0f); WSP(float, WS_SSQ2)[tok] = sq; }
#pragma unroll
    for (int hh = 0; hh < 2; ++hh) { v4u o;
#pragma unroll
        for (int d = 0; d < 4; ++d) { unsigned w = 0u;
#pragma unroll
            for (int e = 0; e < 4; ++e) { const int qi = (int)rintf(xf[hh * 16 + d * 4 + e] * qs); w |= ((unsigned)qi & 0xFFu) << (8 * e); }
            o[d] = w; }
        *(v4u*)(WSP(unsigned char, WS_XQ) + (size_t)tok * D + hh * 1024 + lane * 16) = o; }
}
struct PeerIds { int a, b; };
__device__ __forceinline__ PeerIds peer_ids_load(const Frame& F, int tok, int lane) { const int* ep = WSP(int, WS_EXP) + (size_t)tok * NSEL; PeerIds r; r.a = ep[lane]; r.b = ep[64 + lane]; return r; }
struct PeerScoreBuf { v4u w[16]; v4u xs; };
__device__ __forceinline__ void peer_score_issue(const Frame& F, int tok, int slice, int lane, LAS int* wl, const PeerIds& id, PeerScoreBuf& B) {
    const int e8 = lane >> 3, c16 = lane & 7;
    wl[lane] = id.a; wl[64 + lane] = id.b;
    B.xs = *(const v4u*)(WSP(unsigned char, WS_XQ) + (size_t)tok * D + slice * 128 + c16 * 16);
    const unsigned char* ub = WSP(unsigned char, WS_UT); const unsigned lo = (unsigned)(slice * 128 + c16 * 16);
#pragma unroll
    for (int ld = 0; ld < 16; ++ld) { const unsigned eid = (unsigned)wl[e8 * 16 + ld]; B.w[ld] = *(const v4u*)(ub + (eid * 2048u + lo)); }
}
__device__ __forceinline__ void peer_score_consume(const Frame& F, int tok, int slice, int lane, const PeerScoreBuf& B, bool valid) {
    int p[16];
#pragma unroll
    for (int ld = 0; ld < 16; ++ld) { const v4u w = B.w[ld]; int a = dot4i(w.x, B.xs.x, 0); a = dot4i(w.y, B.xs.y, a); a = dot4i(w.z, B.xs.z, a); p[ld] = dot4i(w.w, B.xs.w, a); }
    { const bool up = (lane & 4) != 0;
#pragma unroll
      for (int k = 0; k < 8; ++k) { const int keep = up ? p[k + 8] : p[k], send = up ? p[k] : p[k + 8]; p[k] = keep + dppi<0x141>(send); } }
    { const bool up = (lane & 2) != 0;
#pragma unroll
      for (int k = 0; k < 4; ++k) { const int keep = up ? p[k + 4] : p[k], send = up ? p[k] : p[k + 4]; p[k] = keep + dppi<0x4E>(send); } }
    { const bool up = (lane & 1) != 0;
#pragma unroll
      for (int k = 0; k < 2; ++k) { const int keep = up ? p[k + 2] : p[k], send = up ? p[k] : p[k + 2]; p[k] = keep + dppi<0xB1>(send); } }
    if (valid) { int* dst = WSP(int, WS_PART) + ((size_t)slice * T + tok) * NSEL + lane * 2; *(int2*)dst = make_int2(p[0], p[1]); }
}
__device__ __forceinline__ void peer_score_phase(const Frame& F, const PeerGeom& pg, LAS int* wl2) {
    const int lane = F.lane, first = pg.rank * NWAVES + F.wave, step = pg.nrank * NWAVES, n = first < T ? (T - first + step - 1) / step : 0;
    LAS int* wlA = wl2; LAS int* wlB = wl2 + 256;
#define PEER_TOKC(k_) ((first + (k_) * step) < T ? (first + (k_) * step) : T - 1)
    for (int r = 0; r < 16 / pg.ngrp; ++r) { const int slice = r * pg.ngrp + pg.g;
        PeerScoreBuf A, B; PeerIds id = peer_ids_load(F, PEER_TOKC(0), lane);
        { const PeerIds cur = id; id = peer_ids_load(F, PEER_TOKC(1), lane); asm volatile("" ::: "memory"); peer_score_issue(F, PEER_TOKC(0), slice, lane, wlA, cur, A); }
        for (int i = 0; i < n; i += 2) {
            { const PeerIds cur = id; id = peer_ids_load(F, PEER_TOKC(i + 2), lane); asm volatile("" ::: "memory"); peer_score_issue(F, PEER_TOKC(i + 1), slice, lane, wlB, cur, B); }
            peer_score_consume(F, first + i * step, slice, lane, A, true);
            { const PeerIds cur = id; id = peer_ids_load(F, PEER_TOKC(i + 3), lane); asm volatile("" ::: "memory"); peer_score_issue(F, PEER_TOKC(i + 2), slice, lane, wlA, cur, A); }
            peer_score_consume(F, first + (i + 1) * step, slice, lane, B, i + 1 < n);
        }
    }
}
__device__ __forceinline__ void peer_coef_token(const Frame& F, int tok, int lane) {
    int s0 = 0, s1 = 0;
#pragma unroll
    for (int s = 0; s < 16; ++s) { const int2 v = *(const int2*)(WSP(int, WS_PART) + ((size_t)s * T + tok) * NSEL + lane * 2); s0 += v.x; s1 += v.y; }
    const int2 ex = *(const int2*)(WSP(int, WS_EXP) + (size_t)tok * NSEL + lane * 2); const f32x2 ga = *(const f32x2*)(WSP(float, WS_GATE) + (size_t)tok * NSEL + lane * 2);
    const float rs = WSP(float, WS_SX)[tok] * (1.0f / sqrtf(WSP(float, WS_SSQ2)[tok] * (1.0f / D) + NORM_EPS));
    const float sc0 = (float)s0 * WSP(float, WS_USC)[ex.x] * rs, sc1 = (float)s1 * WSP(float, WS_USC)[ex.y] * rs;
    f32x2 c; c.x = ga.x * gelu_fast(sc0) * WSP(float, WS_VSC)[ex.x]; c.y = ga.y * gelu_fast(sc1) * WSP(float, WS_VSC)[ex.y];
    float cm = fmaxf(fabsf(c.x), fabsf(c.y));
#pragma unroll
    for (int o = 1; o < 64; o <<= 1) cm = fmaxf(cm, __shfl_xor(cm, o));
    const float qs = cm > 0.f ? 127.0f / cm : 0.f;
    const int q0 = (int)rintf(c.x * qs), q1 = (int)rintf(c.y * qs);
    ((unsigned short*)(F.ws + WS_COEF))[(size_t)tok * 64 + lane] = (unsigned short)(((unsigned)q0 & 0xFFu) | (((unsigned)q1 & 0xFFu) << 8));
    if (lane == 0) WSP(float, WS_CSC)[tok] = cm * (1.0f / 127.0f);
}
struct PeerOutBuf { v4u w[16]; v4u cq; unsigned x; float cs; };
__device__ __forceinline__ void peer_out_issue(const Frame& F, int tok, int slice, int lane, LAS int* wl, const PeerIds& id, PeerOutBuf& B) {
    const int e8 = lane >> 3, c16 = lane & 7;
    wl[lane] = id.a; wl[64 + lane] = id.b;
    B.cq = *(const v4u*)(F.ws + WS_COEF + (size_t)tok * 128 + e8 * 16);
    B.cs = WSP(float, WS_CSC)[tok];
    const unsigned char* vb = WSP(unsigned char, WS_VT); const unsigned lofs = (unsigned)(slice * 128 + c16 * 16);
#pragma unroll
    for (int ld = 0; ld < 16; ++ld) { const unsigned eid = (unsigned)wl[e8 * 16 + ld]; B.w[ld] = *(const v4u*)(vb + (eid * 2048u + lofs)); }
    B.x = *(const unsigned*)(WSP(bf16, WS_XB) + (size_t)tok * D + slice * 128 + c16 * 16 + e8 * 2);
}
__device__ __forceinline__ void peer_out_consume(const Frame& F, int tok, int slice, int lane, const PeerOutBuf& B, bool valid) {
    const int e8 = lane >> 3, c16 = lane & 7;
    int o[16];
#pragma unroll
    for (int i = 0; i < 16; ++i) o[i] = 0;
#pragma unroll
    for (int g = 0; g < 4; ++g) { const unsigned cq = B.cq[g];
#pragma unroll
        for (int d = 0; d < 4; ++d) { const unsigned w0 = B.w[4 * g][d], w1 = B.w[4 * g + 1][d], w2 = B.w[4 * g + 2][d], w3 = B.w[4 * g + 3][d];
            const unsigned lo01 = __builtin_amdgcn_perm(w1, w0, 0x05010400u), hi01 = __builtin_amdgcn_perm(w1, w0, 0x07030602u);
            const unsigned lo23 = __builtin_amdgcn_perm(w3, w2, 0x05010400u), hi23 = __builtin_amdgcn_perm(w3, w2, 0x07030602u);
            const unsigned t0 = __builtin_amdgcn_perm(lo23, lo01, 0x05040100u), t1 = __builtin_amdgcn_perm(lo23, lo01, 0x07060302u);
            const unsigned t2 = __builtin_amdgcn_perm(hi23, hi01, 0x05040100u), t3 = __builtin_amdgcn_perm(hi23, hi01, 0x07060302u);
            o[d * 4 + 0] = dot4i(t0, cq, o[d * 4 + 0]); o[d * 4 + 1] = dot4i(t1, cq, o[d * 4 + 1]); o[d * 4 + 2] = dot4i(t2, cq, o[d * 4 + 2]); o[d * 4 + 3] = dot4i(t3, cq, o[d * 4 + 3]); } }
#pragma unroll
    for (int k = 0; k < 8; ++k) { auto s = __builtin_amdgcn_permlane32_swap((unsigned)o[k], (unsigned)o[k + 8], false, false); o[k] = (int)(s[0] + s[1]); }
#pragma unroll
    for (int k = 0; k < 4; ++k) { auto s = __builtin_amdgcn_permlane16_swap((unsigned)o[k], (unsigned)o[k + 4], false, false); o[k] = (int)(s[0] + s[1]); }
    { const bool up = (lane & 8) != 0;
#pragma unroll
      for (int k = 0; k < 2; ++k) { const int keep = up ? o[k + 2] : o[k], send = up ? o[k] : o[k + 2]; o[k] = keep + dppi<0x128>(send); } }
    const float x0 = bf_lo(B.x) + (float)o[0] * B.cs, x1 = bf_hi(B.x) + (float)o[1] * B.cs;
    if (valid) *(unsigned*)(WSP(bf16, WS_XB) + (size_t)tok * D + slice * 128 + c16 * 16 + e8 * 2) = cvtpk(x0, x1);
}
__device__ __forceinline__ void peer_out_phase(const Frame& F, const PeerGeom& pg, LAS int* wl2) {
    const int lane = F.lane, first = pg.rank * NWAVES + F.wave, step = pg.nrank * NWAVES, n = first < T ? (T - first + step - 1) / step : 0;
    LAS int* wlA = wl2; LAS int* wlB = wl2 + 256;
    for (int r = 0; r < 16 / pg.ngrp; ++r) { const int slice = r * pg.ngrp + pg.g;
        PeerOutBuf A, B; PeerIds id = peer_ids_load(F, PEER_TOKC(0), lane);
        { const PeerIds cur = id; id = peer_ids_load(F, PEER_TOKC(1), lane); asm volatile("" ::: "memory"); peer_out_issue(F, PEER_TOKC(0), slice, lane, wlA, cur, A); }
        for (int i = 0; i < n; i += 2) {
            { const PeerIds cur = id; id = peer_ids_load(F, PEER_TOKC(i + 2), lane); asm volatile("" ::: "memory"); peer_out_issue(F, PEER_TOKC(i + 1), slice, lane, wlB, cur, B); }
            peer_out_consume(F, first + i * step, slice, lane, A, true);
            { const PeerIds cur = id; id = peer_ids_load(F, PEER_TOKC(i + 3), lane); asm volatile("" ::: "memory"); peer_out_issue(F, PEER_TOKC(i + 2), slice, lane, wlA, cur, A); }
            peer_out_consume(F, first + (i + 1) * step, slice, lane, B, i + 1 < n);
        }
    }
}
#undef PEER_TOKC
__device__ __forceinline__ void final_norm_phase(const Frame& F) {
    const int lane = F.lane, gw = F.bid * NWAVES + F.wave, NGW = F.G * NWAVES;
    const f32x4* gf = (const f32x4*)F.in[I_GF] + lane;
    f32x4 g[8];
#pragma unroll
    for (int j = 0; j < 8; ++j) g[j] = gf[64 * j];
    if (gw >= T) return;
    v2u va[8], vb[8]; float sa, sb;
#define FN_LOAD(v_, s_, tok_) do { const int tc_ = (tok_) < T ? (tok_) : T - 1; const v2u* xi_ = (const v2u*)(WSP(bf16, WS_XB) + (size_t)tc_ * D) + lane; \
        _Pragma("unroll") for (int j_ = 0; j_ < 8; ++j_) v_[j_] = xi_[64 * j_]; } while (0)
#define FN_STORE(v_, s_, tok_) do { f32x4* xo_ = (f32x4*)(F.out + (size_t)(tok_) * D) + lane; s_ = 0.f; f32x4 f_[8]; \
        _Pragma("unroll") for (int j_ = 0; j_ < 8; ++j_) { f_[j_] = (f32x4){bf_lo(v_[j_].x), bf_hi(v_[j_].x), bf_lo(v_[j_].y), bf_hi(v_[j_].y)}; s_ += (f_[j_][0] * f_[j_][0] + f_[j_][1] * f_[j_][1]) + (f_[j_][2] * f_[j_][2] + f_[j_][3] * f_[j_][3]); } \
        s_ = wave_sum(s_); const float rs_ = 1.0f / sqrtf(s_ * (1.0f / D) + NORM_EPS); \
        _Pragma("unroll") for (int j_ = 0; j_ < 8; ++j_) xo_[64 * j_] = f_[j_] * rs_ * g[j_]; } while (0)
    FN_LOAD(va, sa, gw);
    for (int tok = gw; tok < T; tok += 2 * NGW) {
        FN_LOAD(vb, sb, tok + NGW);
        FN_STORE(va, sa, tok);
        FN_LOAD(va, sa, tok + 2 * NGW);
        if (tok + NGW < T) FN_STORE(vb, sb, tok + NGW);
    }
#undef FN_LOAD
#undef FN_STORE
}

struct Args { const float* in[28]; float* out; unsigned char* ws; int ph_lo, ph_hi, li, pad; };
__global__ void __launch_bounds__(NTHR, 2) hybrid_fwd(Args args) {
    extern __shared__ __attribute__((aligned(16))) unsigned char lds[];
    Frame F;
    F.lds = (LAS unsigned char*)lds;
    F.tid = threadIdx.x; F.lane = F.tid & 63; F.wave = __builtin_amdgcn_readfirstlane(F.tid >> 6);
    F.G = gridDim.x; F.bid = blockIdx.x;
#pragma unroll
    for (int i = 0; i < 28; ++i) F.in[i] = args.in[i];
    F.out = args.out; F.ws = args.ws;
    volatile LAS unsigned* MISC = (volatile LAS unsigned*)(F.lds + MISC_OFF);
    for (int u = F.tid; u < (LDS_BYTES - LDSCTL_OFF) / 4; u += NTHR) ((LAS unsigned*)(F.lds + LDSCTL_OFF))[u] = 0u;
    __syncthreads();
    unsigned* barw = (unsigned*)(F.ws + WS_CTL) + CW_BAR;
    XcdBarrier bar; bar.bar = barw; bar.x = 0; bar.st = nullptr;
    if (N_LAUNCHES == 1) bar = xcd_barrier_post(barw, MISC + 8);
    const int lo = args.ph_lo, hi = args.ph_hi;
#define IN(k) (lo <= (k) && (k) < hi)
#define SEAM(k) do { if (IN(k) && IN((k) + 1)) xcd_barrier(bar); } while (0)

#ifndef PROBE_DUP
#define PROBE_DUP -1
#endif
#define REPS(k) for (int rep_ = 0; rep_ < ((PROBE_DUP) == (k) ? 2 : 1); ++rep_)
    if (IN(0)) REPS(0) { p0_prologue<0>(F, F.bid, F.G); __syncthreads(); }
    SEAM(0);
    if (IN(1)) REPS(1) {
        pg8::Gemm g{WSP(const bf16, WS_XB), WSP(const bf16, WS_WIN), T, NINP, D / 2}; pg8::StaticOrder S; S.init(T, NINP, F.G, F.bid);
        pg8::EpiI8RowColBf16<0> E{WSP(bf16, WS_PROJ), NINP, WSP(const float, WS_RSTD1), WSP(const float, WS_CS1), nullptr, NORM_EPS};
        pg8::gemm_phase<pg8::EpiI8RowColBf16<0>, pg8::StaticOrder, true, true, true>(F.lds, g, S, E);
    }
    SEAM(1);
    if (IN(2)) REPS(2) {
        lora_prepass(F);
        group_barrier((unsigned*)(F.ws + WS_CTL) + CW_PREBAR, (unsigned)F.G);
        for (int r4 = 0; r4 < ((PROBE_DUP) == 70 ? 2 : 1); ++r4) rwkv_prep_phase(F);
        group_barrier((unsigned*)(F.ws + WS_CTL) + CW_PREPBAR, (unsigned)F.G);
        const int R1 = F.G >= 256 ? 128 : F.G, L0 = F.G >= 256 ? 128 : 0, NL = F.G - L0;
        if (F.bid < R1) for (int it = F.bid; it < 128; it += R1) rwkv_item(F, it);
        if (F.bid >= L0) for (int it = F.bid - L0; it < 64; it += NL) lru_seq(F, it);
        { volatile LAS int* qslot = (volatile LAS int*)(F.lds + LDSCTL_OFF + 1024);
          for (;;) { __syncthreads(); if (F.tid == 0) *qslot = (int)xb_add((unsigned*)(F.ws + WS_CTL) + CW_DEFQ, 1u); __syncthreads();
              const int vb = *qslot; if (vb >= 1024) break; p0_prologue<1>(F, vb, 1024); } }
    }
    SEAM(2);
    if (IN(3)) {
        pg8::Gemm g{WSP(const bf16, WS_Y), WSP(const bf16, WS_WOUT), T, D, D}; pg8::StaticOrder S; S.init(T, D, F.G, F.bid);
        pg8::EpiResidual E{F.in[I_X], WSP(bf16, WS_XB), D};
        pg8::gemm_phase<pg8::EpiResidual, pg8::StaticOrder, true, true>(F.lds, g, S, E);
    }
    SEAM(3);
    if (IN(4)) { const int gw = F.bid * NWAVES + F.wave, NGW = F.G * NWAVES;
        for (int tok = gw; tok < T; tok += NGW) xquant_token(F, tok, F.lane); }
    SEAM(4);
    if (IN(5)) REPS(5) {
        pg8::Gemm g{WSP(const bf16, WS_XQ), WSP(const bf16, WS_WQ), T, D, D / 2}; pg8::StaticOrder S; S.init(T, D, F.G, F.bid);
        pg8::EpiI8RowColBf16<1> E{WSP(bf16, WS_Q), D, WSP(const float, WS_SX), WSP(const float, WS_CSQ), WSP(const float, WS_SSQ2), NORM_EPS};
        pg8::gemm_phase<pg8::EpiI8RowColBf16<1>, pg8::StaticOrder, true, true, true>(F.lds, g, S, E);
    }
    if (IN(5)) { __syncthreads();
        pg8::StaticOrder S; S.init(T, D, F.G, F.bid); pg8::Unit u;
        for (int i = 0; S.next(i, u); ++i) route_item(F, ((u.pm * 8 + F.wave) << 3) | u.pn, F.lane); }
    SEAM(5);
    { const PeerGeom pg = peer_geom(F); LAS int* wl = (LAS int*)(F.lds + F.wave * 1024);
      if (IN(6)) REPS(6) peer_score_phase(F, pg, (LAS int*)(F.lds + 16384 + F.wave * 2048));
      SEAM(6);
      if (IN(7)) REPS(7) { const int gw = F.bid * NWAVES + F.wave, NGW = F.G * NWAVES; for (int tok = gw; tok < T; tok += NGW) peer_coef_token(F, tok, F.lane); }
      SEAM(7);
      if (IN(8)) peer_out_phase(F, pg, (LAS int*)(F.lds + 16384 + F.wave * 2048));
      SEAM(8);
      if (IN(9)) final_norm_phase(F); }
#undef IN
#undef SEAM
}

extern "C" void kernel_launch(void* const* d_in, const int* in_sizes, int n_in, void* d_out, int out_size, void* d_ws, size_t ws_size, hipStream_t stream) {
    static int grid = 0;
    if (grid == 0) {
        if (n_in != 28 || in_sizes[0] != T * D || out_size != T * D || ws_size < WS_END) { fprintf(stderr, "kernel_launch: shape/workspace mismatch: n_in %d in0 %d out %d ws %zu (need %zu)\n", n_in, n_in > 0 ? in_sizes[0] : -1, out_size, ws_size, (size_t)WS_END); grid = -1; return; }
        int dev = 0, cus = 0, per_cu = 0;
        if (hipGetDevice(&dev) != hipSuccess || hipDeviceGetAttribute(&cus, hipDeviceAttributeMultiprocessorCount, dev) != hipSuccess) { fprintf(stderr, "kernel_launch: device query failed\n"); grid = -1; return; }
        if (hipFuncSetAttribute((const void*)hybrid_fwd, hipFuncAttributeMaxDynamicSharedMemorySize, LDS_BYTES) != hipSuccess) { fprintf(stderr, "kernel_launch: hipFuncSetAttribute failed\n"); grid = -1; return; }
        if (hipOccupancyMaxActiveBlocksPerMultiprocessor(&per_cu, (const void*)hybrid_fwd, NTHR, LDS_BYTES) != hipSuccess || per_cu < 1) { fprintf(stderr, "kernel_launch: occupancy query says %d blocks per CU\n", per_cu); per_cu = 1; }
        (void)hipGetLastError();
        grid = cus;
    }
    if (grid < 0) return;
    if (hipMemsetAsync((char*)d_ws + WS_CTL, 0, CTL_ZERO_BYTES, stream) != hipSuccess) { fprintf(stderr, "kernel_launch: hipMemsetAsync failed\n"); return; }
    Args a{};
    for (int i = 0; i < 28; ++i) a.in[i] = (const float*)d_in[i];
    a.out = (float*)d_out; a.ws = (unsigned char*)d_ws;
    for (int li = 0; li < N_LAUNCHES; ++li) {
        a.ph_lo = (N_LAUNCHES == 1) ? 0 : li; a.ph_hi = (N_LAUNCHES == 1) ? N_PHASES : li + 1; a.li = li;
        hipLaunchKernelGGL(hybrid_fwd, dim3(grid), dim3(NTHR), LDS_BYTES, stream, a);
        const hipError_t le = hipPeekAtLastError();
        if (le != hipSuccess) { fprintf(stderr, "kernel_launch: launch %d failed: %s\n", li, hipGetErrorName(le)); break; }
    }
}
```

```cpp
#include <hip/hip_runtime.h>
#include <cstdio>
#include <cstdint>
namespace pg8 {
#define PG8_LAS __attribute__((address_space(3)))
typedef unsigned short bf16_t;
typedef short bf16x8 __attribute__((ext_vector_type(8)));
typedef float f32x4 __attribute__((ext_vector_type(4)));
typedef unsigned u32x4 __attribute__((ext_vector_type(4)));
typedef int i32x4 __attribute__((ext_vector_type(4)));
constexpr int BM = 256, BK = 64, HALF = 128, HTB = HALF * BK * 2  , STAGE_BYTES = 8 * HTB, NXCD = 8, WGM = 8;

__host__ __device__ __forceinline__ int lds_byte(int r, int c) { const int st = (r >> 4) * 2 + (c >> 5), rr = r & 15, cc = c & 31, ob = rr * 64 + cc * 2; return st * 1024 + (ob ^ (((ob >> 9) & 1) << 5)); }
__host__ __device__ __forceinline__ void stage_rc(int b, int& R, int& C) { const int st = b / 1024, sb = b % 1024, swz = sb ^ (((sb >> 9) & 1) << 5); R = (st >> 1) * 16 + swz / 64; C = (st & 1) * 32 + (swz % 64) / 2; }
__host__ __device__ __forceinline__ int perm32(int rho) { const int n = rho >> 4, i = rho & 15; return 8 * (i >> 2) + 4 * n + (i & 3); }

struct Unit { int pm, pn; };
struct Gemm { const bf16_t* A; const bf16_t* Bt; int M, N, K; };

struct StaticOrder {
    int nM, nN, nwg, G, c;
    __host__ __device__ void init(int M, int N, int G_, int c_) { nM = M / BM; nN = N / BM; nwg = nM * nN; G = G_; c = c_; }
    __host__ __device__ bool next(int i, Unit& u) const {
        const long L = (long)i * G + c; if (L >= nwg) return false;
        int wgid = (int)L; { const int q = nwg / NXCD, r = nwg % NXCD, xcd = wgid % NXCD, off = wgid / NXCD; wgid = (xcd < r ? xcd * (q + 1) : r * (q + 1) + (xcd - r) * q) + off; }
        const int nig = WGM * nN, gid = wgid / nig, fm = gid * WGM, gsz = (nM - fm) < WGM ? (nM - fm) : WGM;
        u.pm = fm + ((wgid % nig) % gsz); u.pn = (wgid % nig) / gsz; return true;
    }
    __device__ __forceinline__ void a_ready(const Unit&) const {}
    __device__ __forceinline__ void done(const Unit&) const {}
};

__device__ __forceinline__ unsigned cvt_pk_bf16(float lo, float hi) { unsigned r; asm volatile("v_cvt_pk_bf16_f32 %0, %1, %2" : "=v"(r) : "v"(lo), "v"(hi)); return r; }
typedef float f32x2 __attribute__((ext_vector_type(2)));
typedef unsigned u32x2 __attribute__((ext_vector_type(2)));
template <int MODE> struct EpiRowScaleBf16 {
    static constexpr bool PERM = true, AFTER_DRAIN = false;
    bf16_t* O; int ldc; const float* rs; float eps;
    __device__ __forceinline__ void operator()(const f32x4 (&acc)[2][2][4][2], const Unit& u, int wr, int wc, int fr, int fq) const {
        const int row0 = u.pm * BM + wr * 64 + fr, col0 = u.pn * BM + wc * 32 + 8 * fq;
#pragma unroll
        for (int ai = 0; ai < 2; ++ai)
#pragma unroll
            for (int m = 0; m < 4; ++m) { const int r = row0 + ai * HALF + m * 16; float s = rs[r]; if (MODE == 1) s = 1.0f / sqrtf(s * (1.0f / 2048.0f) + eps);
                bf16_t* rowp = O + (size_t)r * ldc + col0;
#pragma unroll
                for (int bj = 0; bj < 2; ++bj) { const f32x4 v0 = acc[ai][bj][m][0] * s, v1 = acc[ai][bj][m][1] * s;
                    u32x4 w; w.x = cvt_pk_bf16(v0[0], v0[1]); w.y = cvt_pk_bf16(v0[2], v0[3]); w.z = cvt_pk_bf16(v1[0], v1[1]); w.w = cvt_pk_bf16(v1[2], v1[3]);
                    *(u32x4*)(rowp + bj * HALF) = w; } }
    }
};
template <int MODE> struct EpiI8RowColBf16 {
    static constexpr bool PERM = true, AFTER_DRAIN = false;
    bf16_t* O; int ldc; const float* rs; const float* cs; const float* ssq; float eps;
    __device__ __forceinline__ void operator()(const f32x4 (&acc)[2][2][4][2], const Unit& u, int wr, int wc, int fr, int fq) const {
        const int row0 = u.pm * BM + wr * 64 + fr, col0 = u.pn * BM + wc * 32 + 8 * fq;
        f32x4 c4[2][2];
#pragma unroll
        for (int bj = 0; bj < 2; ++bj) { c4[bj][0] = *(const f32x4*)(cs + col0 + bj * HALF); c4[bj][1] = *(const f32x4*)(cs + col0 + bj * HALF + 4); }
#pragma unroll
        for (int ai = 0; ai < 2; ++ai)
#pragma unroll
            for (int m = 0; m < 4; ++m) { const int r = row0 + ai * HALF + m * 16; float s = rs[r]; if (MODE == 1) s = s / sqrtf(ssq[r] * (1.0f / 2048.0f) + eps);
                bf16_t* rowp = O + (size_t)r * ldc + col0;
#pragma unroll
                for (int bj = 0; bj < 2; ++bj) { f32x4 v0, v1; const i32x4 i0 = __builtin_bit_cast(i32x4, acc[ai][bj][m][0]), i1 = __builtin_bit_cast(i32x4, acc[ai][bj][m][1]);
#pragma unroll
                    for (int e = 0; e < 4; ++e) { v0[e] = (float)i0[e] * s * c4[bj][0][e]; v1[e] = (float)i1[e] * s * c4[bj][1][e]; }
                    u32x4 w; w.x = cvt_pk_bf16(v0[0], v0[1]); w.y = cvt_pk_bf16(v0[2], v0[3]); w.z = cvt_pk_bf16(v1[0], v1[1]); w.w = cvt_pk_bf16(v1[2], v1[3]);
                    *(u32x4*)(rowp + bj * HALF) = w; } }
    }
};
struct EpiResidual {
    static constexpr bool PERM = false, AFTER_DRAIN = false;
    const float* base; bf16_t* outb; int ldc;
    __device__ __forceinline__ void operator()(const f32x4 (&acc)[2][2][4][2], const Unit& u, int wr, int wc, int fr, int fq) const {
        const int row0 = u.pm * BM + wr * 64 + fr, col0 = u.pn * BM + wc * 32 + 4 * fq;
#pragma unroll
        for (int ai = 0; ai < 2; ++ai)
#pragma unroll
            for (int m = 0; m < 4; ++m) { const int r = row0 + ai * HALF + m * 16; const size_t off = (size_t)r * ldc + col0;
#pragma unroll
                for (int bj = 0; bj < 2; ++bj)
#pragma unroll
                    for (int n = 0; n < 2; ++n) { const f32x4 bs = *(const f32x4*)(base + off + bj * HALF + n * 16); const f32x4 o = bs + acc[ai][bj][m][n];
                        u32x2 w; w.x = cvt_pk_bf16(o[0], o[1]); w.y = cvt_pk_bf16(o[2], o[3]); *(u32x2*)(outb + off + bj * HALF + n * 16) = w; } }
    }
};
template <class Epi, class Sched, bool ALIGN_EPI = false, bool SP2 = false, bool I8 = false>
__device__ __forceinline__ void gemm_phase(PG8_LAS unsigned char* lds, const Gemm g, const Sched& S, const Epi& E) {
    const int tid = threadIdx.x, wid = __builtin_amdgcn_readfirstlane(tid >> 6), lane = tid & 63, wr = wid >> 2, wc = wid & 3, fr = lane & 15, fq = lane >> 4;
    const int K = g.K, nt = K / BK;
    unsigned voffA[2], voffB[2];
#pragma unroll
    for (int i = 0; i < 2; ++i) { int R, C; stage_rc(tid * 16 + i * 8192, R, C); const int Rb = Epi::PERM ? ((R & ~31) + perm32(R & 31)) : R;
        voffA[i] = (unsigned)(R * K + C) * 2u; voffB[i] = (unsigned)(Rb * K + C) * 2u; }
    const size_t kstep = (size_t)(BK * 2);
    const size_t hstep = (size_t)HALF * K * 2;
    const size_t tstep = 2 * hstep;
    const unsigned ldsw = (unsigned)wid * 1024u;
    const int aoff = lds_byte(wr * 64 + fr, fq * 8), boff = lds_byte(wc * 32 + fr, fq * 8);
#define PG8_SA(b, h) (((b) * 2 + (h)) * HTB)
#define PG8_SB(b, h) ((4 + (b) * 2 + (h)) * HTB)
#define PG8_STAGE(bufoff, gbase, voff) do { _Pragma("unroll") for (int _i = 0; _i < 2; ++_i) \
        __builtin_amdgcn_global_load_lds((const unsigned*)((const char*)(gbase) + (voff)[_i]), (PG8_LAS unsigned*)(lds + (bufoff) + ldsw + _i * 8192), 16, 0, 0); } while (0)
#define PG8_LDA(dst, b, h) do { _Pragma("unroll") for (int m = 0; m < 4; ++m) _Pragma("unroll") for (int k = 0; k < 2; ++k) dst[m][k] = *(const PG8_LAS bf16x8*)(lds + PG8_SA(b, h) + aoff + m * 2048 + k * 1024); } while (0)
#define PG8_LDB(dst, b, h) do { _Pragma("unroll") for (int n = 0; n < 2; ++n) _Pragma("unroll") for (int k = 0; k < 2; ++k) dst[n][k] = *(const PG8_LAS bf16x8*)(lds + PG8_SB(b, h) + boff + n * 2048 + k * 1024); } while (0)
#define PG8_MMA(ai, bj, At, Bt) do { __builtin_amdgcn_s_setprio(1); _Pragma("unroll") for (int m = 0; m < 4; ++m) _Pragma("unroll") for (int n = 0; n < 2; ++n) _Pragma("unroll") for (int k = 0; k < 2; ++k) \
        { if constexpr (I8) acc[ai][bj][m][n] = __builtin_bit_cast(f32x4, __builtin_amdgcn_mfma_i32_16x16x64_i8(__builtin_bit_cast(i32x4, Bt[n][k]), __builtin_bit_cast(i32x4, At[m][k]), __builtin_bit_cast(i32x4, acc[ai][bj][m][n]), 0, 0, 0)); \
          else acc[ai][bj][m][n] = __builtin_amdgcn_mfma_f32_16x16x32_bf16(Bt[n][k], At[m][k], acc[ai][bj][m][n], 0, 0, 0); } __builtin_amdgcn_s_setprio(0); } while (0)
#define PG8_WAIT_V(n) asm volatile("s_waitcnt vmcnt(" #n ")" ::: "memory")
#define PG8_WAIT_L(n) asm volatile("s_waitcnt lgkmcnt(" #n ")" ::: "memory")
#define PG8_BAR __builtin_amdgcn_s_barrier()
#define PG8_SCHED __builtin_amdgcn_sched_barrier(0)
    Unit cur, nxt; int ui = 0;
    if (!S.next(0, cur)) return;
    f32x4 acc[2][2][4][2];
#pragma unroll
    for (int a = 0; a < 2; ++a)
#pragma unroll
        for (int b = 0; b < 2; ++b)
#pragma unroll
            for (int m = 0; m < 4; ++m)
#pragma unroll
                for (int n = 0; n < 2; ++n) acc[a][b][m][n] = (f32x4){0.f, 0.f, 0.f, 0.f};
    bf16x8 At[4][2], B0[2][2], B1[2][2];
    const char* cA = (const char*)g.A + (size_t)cur.pm * tstep; const char* cB = (const char*)g.Bt + (size_t)cur.pn * tstep;
    S.a_ready(cur);
    if constexpr (SP2) {
        PG8_STAGE(PG8_SB(0, 0), cB, voffB); PG8_STAGE(PG8_SB(0, 1), cB + hstep, voffB); PG8_STAGE(PG8_SA(0, 0), cA, voffA); PG8_STAGE(PG8_SA(0, 1), cA + hstep, voffA);
        if (wr == 1) PG8_BAR;
        PG8_WAIT_V(2); PG8_BAR;
        PG8_STAGE(PG8_SB(1, 0), cB + kstep, voffB); PG8_STAGE(PG8_SA(1, 0), cA + kstep, voffA); PG8_STAGE(PG8_SB(1, 1), cB + hstep + kstep, voffB);
        PG8_WAIT_V(6); PG8_BAR;
    } else {
        PG8_STAGE(PG8_SB(0, 0), cB, voffB); PG8_STAGE(PG8_SA(0, 0), cA, voffA); PG8_STAGE(PG8_SB(0, 1), cB + hstep, voffB); PG8_STAGE(PG8_SA(0, 1), cA + hstep, voffA);
        if (wr == 1) PG8_BAR;
        PG8_WAIT_V(4); PG8_BAR;
        PG8_STAGE(PG8_SB(1, 0), cB + kstep, voffB); PG8_STAGE(PG8_SA(1, 0), cA + kstep, voffA); PG8_STAGE(PG8_SB(1, 1), cB + hstep + kstep, voffB);
        PG8_WAIT_V(6); PG8_BAR;
    }
    for (;;) {
        const bool has_next = S.next(ui + 1, nxt);
        const char* nA = has_next ? (const char*)g.A + (size_t)nxt.pm * tstep : cA; const char* nB = has_next ? (const char*)g.Bt + (size_t)nxt.pn * tstep : cB;
        for (int t = 0; t < nt; t += 2) {
            const bool last = (t == nt - 2);
            const char* a1 = cA + (size_t)(t + 1) * kstep;
            const char* a2 = last ? nA : cA + (size_t)(t + 2) * kstep; const char* b2 = last ? nB : cB + (size_t)(t + 2) * kstep;
            const char* a3 = a2 + kstep; const char* b3 = b2 + kstep;
            if (last && has_next) S.a_ready(nxt);
            if constexpr (SP2) {
            PG8_LDB(B0, 0, 0); PG8_LDB(B1, 0, 1); PG8_SCHED; PG8_LDA(At, 0, 0); PG8_STAGE(PG8_SA(1, 1), a1 + hstep, voffA);
            PG8_WAIT_V(8); PG8_WAIT_L(0); PG8_BAR; PG8_MMA(0, 0, At, B0); PG8_MMA(0, 1, At, B1); PG8_BAR; PG8_SCHED;
            PG8_LDA(At, 0, 1); PG8_STAGE(PG8_SB(0, 0), b2, voffB); PG8_STAGE(PG8_SB(0, 1), b2 + hstep, voffB); PG8_STAGE(PG8_SA(0, 0), a2, voffA);
            PG8_WAIT_V(8); PG8_WAIT_L(0); PG8_BAR; PG8_MMA(1, 0, At, B0); PG8_MMA(1, 1, At, B1); PG8_BAR; PG8_SCHED;
            PG8_LDB(B0, 1, 0); PG8_LDB(B1, 1, 1); PG8_SCHED; PG8_LDA(At, 1, 0); PG8_STAGE(PG8_SA(0, 1), a2 + hstep, voffA);
            PG8_WAIT_V(8); PG8_WAIT_L(0); PG8_BAR; PG8_MMA(0, 0, At, B0); PG8_MMA(0, 1, At, B1); PG8_BAR; PG8_SCHED;
            PG8_LDA(At, 1, 1); PG8_STAGE(PG8_SB(1, 0), b3, voffB); PG8_STAGE(PG8_SB(1, 1), b3 + hstep, voffB); PG8_STAGE(PG8_SA(1, 0), a3, voffA);
            PG8_WAIT_V(8); PG8_WAIT_L(0); PG8_BAR; PG8_MMA(1, 0, At, B0); PG8_MMA(1, 1, At, B1); PG8_BAR; PG8_SCHED;
            } else {
            PG8_LDB(B0, 0, 0); PG8_SCHED; PG8_LDA(At, 0, 0); PG8_STAGE(PG8_SA(1, 1), a1 + hstep, voffA);
            PG8_WAIT_L(8); PG8_BAR; PG8_WAIT_L(0); PG8_MMA(0, 0, At, B0); PG8_BAR; PG8_SCHED;
            PG8_LDB(B1, 0, 1); PG8_STAGE(PG8_SB(0, 0), b2, voffB);
            PG8_BAR; PG8_WAIT_L(0); PG8_MMA(0, 1, At, B1); PG8_BAR;
            PG8_LDA(At, 0, 1); PG8_STAGE(PG8_SA(0, 0), a2, voffA);
            PG8_BAR; PG8_WAIT_L(0); PG8_MMA(1, 0, At, B0); PG8_BAR; PG8_SCHED;
            PG8_STAGE(PG8_SB(0, 1), b2 + hstep, voffB);
            PG8_WAIT_V(6); PG8_BAR; PG8_MMA(1, 1, At, B1); PG8_BAR;
            PG8_LDB(B0, 1, 0); PG8_SCHED; PG8_LDA(At, 1, 0); PG8_STAGE(PG8_SA(0, 1), a2 + hstep, voffA);
            PG8_WAIT_L(8); PG8_BAR; PG8_WAIT_L(0); PG8_MMA(0, 0, At, B0); PG8_BAR; PG8_SCHED;
            PG8_LDB(B1, 1, 1); PG8_STAGE(PG8_SB(1, 0), b3, voffB);
            PG8_BAR; PG8_WAIT_L(0); PG8_MMA(0, 1, At, B1); PG8_BAR;
            PG8_LDA(At, 1, 1); PG8_STAGE(PG8_SA(1, 0), a3, voffA);
            PG8_BAR; PG8_WAIT_L(0); PG8_MMA(1, 0, At, B0); PG8_BAR; PG8_SCHED;
            PG8_STAGE(PG8_SB(1, 1), b3 + hstep, voffB);
            PG8_WAIT_V(6); PG8_BAR; PG8_MMA(1, 1, At, B1); PG8_BAR;
            }
        }
        if constexpr (ALIGN_EPI) { if (wr == 0) PG8_BAR; }
        if constexpr (!Epi::AFTER_DRAIN) { E(acc, cur, wr, wc, fr, fq); S.done(cur); }
        if (!has_next) break;
#pragma unroll
        for (int a = 0; a < 2; ++a)
#pragma unroll
            for (int b = 0; b < 2; ++b)
#pragma unroll
                for (int m = 0; m < 4; ++m)
#pragma unroll
                    for (int n = 0; n < 2; ++n) acc[a][b][m][n] = (f32x4){0.f, 0.f, 0.f, 0.f};
        cur = nxt; cA = nA; cB = nB; ++ui;
        if constexpr (ALIGN_EPI) { if (wr == 1) PG8_BAR; }
    }
    PG8_WAIT_V(0);
    if constexpr (!ALIGN_EPI) { if (wr == 0) PG8_BAR; }
    PG8_BAR;
    if constexpr (Epi::AFTER_DRAIN) { E.fused(acc, cur, wr, wc, fr, fq, lds, wid, lane); S.done(cur); }
#undef PG8_SA
#undef PG8_SB
#undef PG8_STAGE
#undef PG8_LDA
#undef PG8_LDB
#undef PG8_MMA
#undef PG8_WAIT_V
#undef PG8_WAIT_L
#undef PG8_BAR
#undef PG8_SCHED
}
}

#ifndef PROBE_DUP
#define PROBE_DUP -1
#endif
constexpr int NWAVES = 8, NTHR = NWAVES * 64;
#ifndef MK_N_LAUNCHES
#define MK_N_LAUNCHES 1
#endif
constexpr int N_PHASES = 10;
constexpr int DEF_SLICES = 256;
constexpr int N_LAUNCHES = MK_N_LAUNCHES;
static_assert(N_LAUNCHES == 1 || N_LAUNCHES == N_PHASES, "MK_N_LAUNCHES is 1 or N_PHASES");

constexpr int BATCH = 8, SEQ = 2048, T = BATCH * SEQ, D = 2048;
constexpr int NIN = 5408, NINP = 5632;
constexpr int PC_GATE = 1024, PC_R = 2048, PC_K = 3072, PC_V = 4096, PC_WD = 5120, PC_AD = 5184, PC_GD = 5248;
constexpr int RWKV_C0 = 2048;
constexpr int NEXP = 16384, NSEL = 128;
constexpr float NORM_EPS = 1e-6f, GN_EPS = 64e-5f;

constexpr size_t MiB = 1u << 20;
constexpr size_t WS_CTL = 0, CTL_ZERO_BYTES = 1 * MiB;
constexpr size_t WS_SSQ3 = 576 * 1024;
constexpr size_t WS_SSQ2 = 512 * 1024;
constexpr size_t WS_RSTD1 = 1 * MiB;
constexpr size_t WS_USC = 1 * MiB + 64 * 1024, WS_VSC = 1 * MiB + 128 * 1024;
constexpr size_t WS_SX = 1 * MiB + 192 * 1024;
constexpr size_t WS_CS1 = 1 * MiB + 256 * 1024;
constexpr size_t WS_CSQ = 1 * MiB + 288 * 1024;
constexpr size_t WS_WIN = 2 * MiB;
constexpr size_t WS_WOUT = 24 * MiB;
constexpr size_t WS_WQ = 32 * MiB;
constexpr size_t WS_KEYS = 40 * MiB;
constexpr size_t WS_W2T = WS_KEYS + 512 * 1024;
constexpr size_t WS_A2T = WS_W2T + 128 * 1024;
constexpr size_t WS_G2T = WS_A2T + 128 * 1024;
constexpr size_t WS_WAT = WS_G2T + 320 * 1024;
constexpr size_t WS_WIT = WS_WAT + 256 * 1024;
constexpr size_t WS_EXP = 42 * MiB;
constexpr size_t WS_GATE = 50 * MiB;
constexpr size_t WS_LA = 42 * MiB;
constexpr size_t WS_SUMM = 58 * MiB;
constexpr size_t WS_TA = 64 * MiB, WS_TB = 96 * MiB, WS_TK = 400 * MiB, WS_TR = 464 * MiB;
constexpr size_t OUT_TV = 0, OUT_TG = 32 * MiB, OUT_PC = 64 * MiB, OUT_BON = 66 * MiB;
constexpr size_t WS_XB = 64 * MiB;
constexpr size_t WS_PROJ = 128 * MiB;
constexpr size_t WS_Q = WS_PROJ;
constexpr size_t WS_PART = 192 * MiB;
constexpr size_t WS_XQ = 320 * MiB;
constexpr size_t WS_COEF = 352 * MiB;
constexpr size_t WS_CSC = 356 * MiB;
constexpr size_t WS_Y = 304 * MiB;
constexpr size_t WS_UT = 368 * MiB;
constexpr size_t WS_VT = 432 * MiB;
constexpr size_t WS_END = 496 * MiB;
static_assert(WS_WIT + 256 * 1024 <= WS_EXP && WS_PROJ + (size_t)T * NINP * 2 <= WS_Y && WS_WIN + (size_t)NINP * D * 2 <= WS_WOUT, "d_ws map");
constexpr int CW_DEFQ = 2240;
constexpr int CW_PREPBAR = 2176;
constexpr int CW_PREBAR = 2112;
constexpr int CW_LRUBAR = 2048;
constexpr int CW_BAR = 4096;

constexpr int RING_BYTES = 131072;
constexpr int LDSCTL_OFF = 143360, MISC_OFF = LDSCTL_OFF + 320;
constexpr int LDS_BYTES = 147456;

#define GAS __attribute__((address_space(1)))
#define LAS __attribute__((address_space(3)))
typedef unsigned short bf16;
typedef unsigned v4u __attribute__((ext_vector_type(4)));
typedef unsigned v2u __attribute__((ext_vector_type(2)));
typedef float f32x4 __attribute__((ext_vector_type(4)));
typedef float f32x16 __attribute__((ext_vector_type(16)));
typedef short bf16x8 __attribute__((ext_vector_type(8)));
typedef __bf16 bf16x2_t __attribute__((ext_vector_type(2)));
typedef GAS unsigned gu32;
#define RLX_AGENT __ATOMIC_RELAXED, __HIP_MEMORY_SCOPE_AGENT
__device__ __forceinline__ unsigned f2bf(float f) { unsigned u = __builtin_bit_cast(unsigned, f); return (u + 0x7fffu + ((u >> 16) & 1u)) >> 16; }
__device__ __forceinline__ unsigned pk2(float lo, float hi) { return f2bf(lo) | (f2bf(hi) << 16); }
__device__ __forceinline__ float bf_lo(unsigned w) { return __uint_as_float(w << 16); }
__device__ __forceinline__ float bf_hi(unsigned w) { return __uint_as_float(w & 0xffff0000u); }
__device__ __forceinline__ void unpack8(const v4u& w, float (&o)[8]) { o[0] = bf_lo(w.x); o[1] = bf_hi(w.x); o[2] = bf_lo(w.y); o[3] = bf_hi(w.y); o[4] = bf_lo(w.z); o[5] = bf_hi(w.z); o[6] = bf_lo(w.w); o[7] = bf_hi(w.w); }
__device__ __forceinline__ v4u pack8(const float (&o)[8]) { v4u w; w.x = pk2(o[0], o[1]); w.y = pk2(o[2], o[3]); w.z = pk2(o[4], o[5]); w.w = pk2(o[6], o[7]); return w; }
__device__ __forceinline__ float sigmoidf_(float x) { return 1.0f / (1.0f + __expf(-x)); }
__device__ __forceinline__ float softplusf_(float z) { return fmaxf(z, 0.f) + log1pf(__expf(-fabsf(z))); }
__device__ __forceinline__ float gelu_tanh(float x) { const float u = 0.7978845608028654f * (x + 0.044715f * x * x * x); return 0.5f * x * (1.0f + tanhf(u)); }
template <int CTRL> __device__ __forceinline__ float dppf(float x) { return __builtin_bit_cast(float, __builtin_amdgcn_mov_dpp(__builtin_bit_cast(int, x), CTRL, 0xf, 0xf, true)); }
__device__ __forceinline__ float red8(float v) { v += dppf<0xB1>(v); v += dppf<0x4E>(v); v += dppf<0x141>(v); return v; }
__device__ __forceinline__ float red16(float v) { v = red8(v); v += dppf<0x140>(v); return v; }
__device__ __forceinline__ float wave_sum(float v) {
#pragma unroll
    for (int o = 1; o < 64; o <<= 1) v += __shfl_xor(v, o);
    return v;
}
__device__ __forceinline__ float dot2bf(unsigned a, unsigned b, float acc) { return __builtin_amdgcn_fdot2_f32_bf16(__builtin_bit_cast(bf16x2_t, a), __builtin_bit_cast(bf16x2_t, b), acc, false); }
#define MFMA16(a, b, c) __builtin_amdgcn_mfma_f32_16x16x32_bf16((a), (b), (c), 0, 0, 0)
#define MFMA32(a, b, c) __builtin_amdgcn_mfma_f32_32x32x16_bf16((a), (b), (c), 0, 0, 0)

#define XB_TMO      128
#define XB_XCNT(j)  (256  + 64 * (j))
#define XB_XSUB(j)  (1280 + 64 * (j))
#define XB_XGEN(j)  (2304 + 64 * (j))
#define XB_TOP      3328
#define XB_TOPGEN   3392
#define XCD_BAR_WORDS 3456
#define XB_SPIN_CAP (1u << 22)
__device__ __forceinline__ unsigned xb_ld(unsigned* p)              { return __hip_atomic_load(p, __ATOMIC_RELAXED, __HIP_MEMORY_SCOPE_AGENT); }
__device__ __forceinline__ unsigned xb_add(unsigned* p, unsigned v) { return __hip_atomic_fetch_add(p, v, __ATOMIC_RELAXED, __HIP_MEMORY_SCOPE_AGENT); }
__device__ __forceinline__ unsigned xb_xcc_id() { return (unsigned)__builtin_amdgcn_s_getreg((3 << 11) | 20) & 0xFu; }
#define XB_SPIN(cond, bar) do { unsigned _sp = 0; while (cond) { __builtin_amdgcn_s_sleep(1); \
    if ((++_sp & 255u) == 0u) { if (xb_ld(&(bar)[XB_TMO])) break; if (_sp > XB_SPIN_CAP) { atomicAdd(&(bar)[XB_TMO], 1u); break; } } } } while (0)
struct XcdBarrier { unsigned* bar; unsigned x; volatile LAS unsigned* st; };
__device__ __forceinline__ XcdBarrier xcd_barrier_post(unsigned* bar, volatile LAS unsigned* st) {
    XcdBarrier b; b.bar = bar; b.x = xb_xcc_id(); b.st = st;
    if (threadIdx.x == 0) (void)xb_add(&bar[XB_XCNT(b.x)], 1u);
    return b;
}
__device__ __forceinline__ void xcd_barrier_complete(unsigned* bar, unsigned x, unsigned& nloc, unsigned& nx) {
    const unsigned G = gridDim.x * gridDim.y * gridDim.z;
    unsigned sum, cnt, mine, sp = 0u;
    for (;;) {
        sum = 0u; cnt = 0u; mine = 0u;
#pragma unroll
        for (unsigned j = 0; j < 16; ++j) { const unsigned c = xb_ld(&bar[XB_XCNT(j)]); sum += c; cnt += (c > 0u) ? 1u : 0u; mine = (j == x) ? c : mine; }
        if (sum == G) break;
        __builtin_amdgcn_s_sleep(1);
        if ((++sp & 255u) == 0u) { if (xb_ld(&bar[XB_TMO])) break; if (sp > XB_SPIN_CAP) { atomicAdd(&bar[XB_TMO], 1u); break; } }
    }
    nloc = mine > 0u ? mine : 1u; nx = cnt > 0u ? cnt : 1u;
}
__device__ __forceinline__ void xcd_barrier(const XcdBarrier& b) {
    asm volatile("s_waitcnt vmcnt(0)" ::: "memory");
    __syncthreads();
    if (threadIdx.x == 0) {
        unsigned* bar = b.bar;
        __builtin_amdgcn_s_waitcnt(0);
        unsigned nloc = b.st[0], nx = b.st[1];
        if (nloc == 0u) { xcd_barrier_complete(bar, b.x, nloc, nx); b.st[0] = nloc; b.st[1] = nx; }
        const unsigned old = xb_add(&bar[XB_XSUB(b.x)], 1u);
        const unsigned gen = old / nloc;
        if (old + 1u == (gen + 1u) * nloc) {
            __builtin_amdgcn_fence(__ATOMIC_RELEASE, "agent");
            asm volatile("s_waitcnt vmcnt(0)" ::: "memory");
            const unsigned og = xb_add(&bar[XB_TOP], 1u);
            const unsigned tg = og / nx;
            if (og + 1u == (tg + 1u) * nx) xb_add(&bar[XB_TOPGEN], 1u);
            else XB_SPIN(xb_ld(&bar[XB_TOPGEN]) == tg, bar);
            __builtin_amdgcn_fence(__ATOMIC_ACQUIRE, "agent");
            xb_add(&bar[XB_XGEN(b.x)], 1u);
            asm volatile("s_waitcnt vmcnt(0)" ::: "memory");
        } else {
            XB_SPIN(xb_ld(&bar[XB_XGEN(b.x)]) == gen, bar);
            __builtin_amdgcn_fence(__ATOMIC_ACQUIRE, "agent");
            asm volatile("s_waitcnt vmcnt(0)" ::: "memory");
        }
    }
    __syncthreads();
}

struct Frame {
    LAS unsigned char* lds;
    int tid, lane, wave, G, bid;
    const float* in[28];
    float* out;
    unsigned char* ws;
};
#define WSP(type, off) ((type*)(F.ws + (off)))
enum { I_X = 0, I_G1, I_WIN, I_CONVW, I_CONVB, I_WA, I_BA, I_WI, I_BI, I_LAM, I_MU, I_W0, I_W2, I_A0, I_A2, I_G2, I_KK, I_KA, I_RK, I_LNW, I_LNB, I_WOUT, I_G2N, I_WQ, I_KEYS, I_U, I_V, I_GF };

__device__ __forceinline__ void p0_transpose_item(const float* W, int K, int N, bf16* WT, const float* ksc, LAS float* scr, int item, int lane) {
    const int nblk = N / 32, kb = item / nblk, nb = item % nblk, k0 = 64 * kb, n0 = 32 * nb;
    const int lr = lane >> 3, c4 = (lane & 7) * 4;
    f32x4 v[8];
#pragma unroll
    for (int i = 0; i < 8; ++i) v[i] = *(const f32x4*)(W + (size_t)(k0 + 8 * i + lr) * N + n0 + c4);
#pragma unroll
    for (int i = 0; i < 8; ++i) { const int kk = 8 * i + lr; const float sc = ksc ? ksc[k0 + kk] : 1.0f; LAS float* d = scr + kk * 33 + c4; d[0] = v[i][0] * sc; d[1] = v[i][1] * sc; d[2] = v[i][2] * sc; d[3] = v[i][3] * sc; }
    asm volatile("s_waitcnt lgkmcnt(0)" ::: "memory");
    const int c = lane & 7;
#pragma unroll
    for (int j = 0; j < 4; ++j) { const int n = (lane >> 3) + 8 * j; const LAS float* s = scr + (8 * c) * 33 + n;
        v4u o; o.x = pk2(s[0 * 33], s[1 * 33]); o.y = pk2(s[2 * 33], s[3 * 33]); o.z = pk2(s[4 * 33], s[5 * 33]); o.w = pk2(s[6 * 33], s[7 * 33]);
        *(v4u*)(WT + (size_t)(n0 + n) * K + k0 + 8 * c) = o; }
    asm volatile("s_waitcnt lgkmcnt(0)" ::: "memory");
}
template <bool HASK> __device__ __forceinline__ void p0_wquant_block(const float* W, int N, unsigned char* WT8, float* cs, const float* ksc, int item, int wave, int lane, LAS float* mxs) {
    asm volatile("" : "+v"(lane));
    const int n0 = item * 32, r = lane >> 3, c4 = lane & 7, kb = 256 * wave + 4 * r;
    const float* src = W + (size_t)kb * N + n0 + 4 * c4; const float* kp = ksc + kb;
    f32x4 mx = (f32x4){0.f, 0.f, 0.f, 0.f};
#pragma unroll
    for (int i2 = 0; i2 < 2; ++i2) { f32x4 v[4][4], g4[4];
#pragma unroll
        for (int ii = 0; ii < 4; ++ii) { g4[ii] = HASK ? *(const f32x4*)(kp + 32 * (i2 * 4 + ii)) : (f32x4){1.f, 1.f, 1.f, 1.f};
#pragma unroll
            for (int j = 0; j < 4; ++j) v[ii][j] = *(const f32x4*)(src + (size_t)(32 * (i2 * 4 + ii) + j) * N); }
#pragma unroll
        for (int ii = 0; ii < 4; ++ii)
#pragma unroll
            for (int j = 0; j < 4; ++j)
#pragma unroll
                for (int e = 0; e < 4; ++e) mx[e] = fmaxf(mx[e], fabsf(v[ii][j][e] * g4[ii][j])); }
#pragma unroll
    for (int o = 8; o < 64; o <<= 1)
#pragma unroll
        for (int e = 0; e < 4; ++e) mx[e] = fmaxf(mx[e], __shfl_xor(mx[e], o));
    if (r == 0) *(LAS f32x4*)(mxs + wave * 32 + 4 * c4) = mx;
    __syncthreads();
#pragma unroll
    for (int w = 0; w < NWAVES; ++w) { const f32x4 t = *(const LAS f32x4*)(mxs + w * 32 + 4 * c4);
#pragma unroll
        for (int e = 0; e < 4; ++e) mx[e] = fmaxf(mx[e], t[e]); }
    f32x4 q;
#pragma unroll
    for (int e = 0; e < 4; ++e) q[e] = mx[e] > 0.f ? 127.0f / mx[e] : 0.f;
    if (wave == 0 && r == 0) *(f32x4*)(cs + n0 + 4 * c4) = mx * (1.0f / 127.0f);
    unsigned char* dst = WT8 + (size_t)(n0 + 4 * c4) * 2048 + kb;
#pragma unroll
    for (int i2 = 0; i2 < 2; ++i2) { f32x4 v[4][4], g4[4];
#pragma unroll
        for (int ii = 0; ii < 4; ++ii) { g4[ii] = HASK ? *(const f32x4*)(kp + 32 * (i2 * 4 + ii)) : (f32x4){1.f, 1.f, 1.f, 1.f};
#pragma unroll
            for (int j = 0; j < 4; ++j) v[ii][j] = *(const f32x4*)(src + (size_t)(32 * (i2 * 4 + ii) + j) * N); }
#pragma unroll
        for (int ii = 0; ii < 4; ++ii) { unsigned w[4] = {0u, 0u, 0u, 0u};
#pragma unroll
            for (int j = 0; j < 4; ++j)
#pragma unroll
                for (int e = 0; e < 4; ++e) { const int qi = (int)rintf(v[ii][j][e] * g4[ii][j] * q[e]); w[e] |= ((unsigned)qi & 0xFFu) << (8 * j); }
#pragma unroll
            for (int e = 0; e < 4; ++e) *(unsigned*)(dst + (size_t)e * 2048 + 32 * (i2 * 4 + ii)) = w[e]; } }
    __syncthreads();
}
__device__ __forceinline__ void p0_small_transpose(const float* src, bf16* dst, int nb, int K, int N, int gt, int NGT) {
    const int tot = nb * K * N;
    for (int i = gt; i < tot; i += NGT) { const int bb = i / (K * N), r = i - bb * K * N, n = r / K, k = r - n * K; dst[i] = (bf16)f2bf(src[(size_t)bb * K * N + (size_t)k * N + n]); }
}
template <int PART> __device__ __forceinline__ void p0_prologue(const Frame& F, int vb, int VG) {
    LAS float* scr = (LAS float*)(F.lds + F.wave * 8448);
    const int gw = vb * NWAVES + F.wave, NGW = VG * NWAVES, gt = gw * 64 + F.lane, NGT = NGW * 64;
    constexpr int I1 = (D / 64) * (NIN / 32), I2 = (D / 64) * (D / 32);
    if (PART == 0) { for (int it = vb; it < NIN / 32; it += VG) p0_wquant_block<true>(F.in[I_WIN], NIN, WSP(unsigned char, WS_WIN), WSP(float, WS_CS1), F.in[I_G1], it, F.wave, F.lane, (LAS float*)(F.lds + 8 * 8448)); }
    else { for (int it = gw; it < I2; it += NGW) p0_transpose_item(F.in[I_WOUT], D, D, WSP(bf16, WS_WOUT), nullptr, scr, it, F.lane);
           { const int sp = VG >= 64 ? VG / 64 : 1; for (int v = vb; v < sp * (D / 32); v += VG) if (v % sp == 0) p0_wquant_block<false>(F.in[I_WQ], D, WSP(unsigned char, WS_WQ), WSP(float, WS_CSQ), nullptr, v / sp, F.wave, F.lane, (LAS float*)(F.lds + 8 * 8448)); } }
    if (PART == 0) {
    { v4u* z = (v4u*)(WSP(unsigned char, WS_WIN) + (size_t)NIN * D); const int nz = (NINP - NIN) * D / 16; for (int i = gt; i < nz; i += NGT) z[i] = (v4u){0u, 0u, 0u, 0u};
      for (int i = gt; i < NINP - NIN; i += NGT) WSP(float, WS_CS1)[NIN + i] = 0.f; }
    p0_small_transpose(F.in[I_W2], WSP(bf16, WS_W2T), 1, 64, 1024, gt, NGT);
    p0_small_transpose(F.in[I_A2], WSP(bf16, WS_A2T), 1, 64, 1024, gt, NGT);
    p0_small_transpose(F.in[I_G2], WSP(bf16, WS_G2T), 1, 160, 1024, gt, NGT);
    p0_small_transpose(F.in[I_WA], WSP(bf16, WS_WAT), 8, 128, 128, gt, NGT);
    p0_small_transpose(F.in[I_WI], WSP(bf16, WS_WIT), 8, 128, 128, gt, NGT);
    { const float* s = F.in[I_KEYS]; bf16* d = WSP(bf16, WS_KEYS); for (int i = gt; i < 8 * 2 * 128 * 128 / 8; i += NGT) { const f32x4 a = *(const f32x4*)(s + (size_t)i * 8), b = *(const f32x4*)(s + (size_t)i * 8 + 4);
        v4u o; o.x = pk2(a[0], a[1]); o.y = pk2(a[2], a[3]); o.z = pk2(b[0], b[1]); o.w = pk2(b[2], b[3]); *(v4u*)(d + (size_t)i * 8) = o; } }
    }
    if (PART == 0) {
    { const float* x = F.in[I_X]; unsigned char* xq = WSP(unsigned char, WS_XB); float* rs1 = WSP(float, WS_RSTD1);
#define XR_LOAD(V_, row_) do { _Pragma("unroll") for (int hh_ = 0; hh_ < 2; ++hh_) _Pragma("unroll") for (int q_ = 0; q_ < 4; ++q_) V_[hh_][q_] = *(const f32x4*)(x + (size_t)(row_) * D + hh_ * 1024 + F.lane * 16 + q_ * 4); } while (0)
#define XR_QUANT(V_, row_) do { float s_ = 0.f, am_ = 0.f; \
          _Pragma("unroll") for (int hh_ = 0; hh_ < 2; ++hh_) _Pragma("unroll") for (int q_ = 0; q_ < 4; ++q_) _Pragma("unroll") for (int e_ = 0; e_ < 4; ++e_) { const float t_ = V_[hh_][q_][e_]; s_ += t_ * t_; am_ = fmaxf(am_, fabsf(t_)); } \
          s_ = wave_sum(s_); \
          _Pragma("unroll") for (int o_ = 1; o_ < 64; o_ <<= 1) am_ = fmaxf(am_, __shfl_xor(am_, o_)); \
          const float xq_ = am_ > 0.f ? 127.0f / am_ : 0.f; \
          if (F.lane == 0) rs1[row_] = am_ * (1.0f / 127.0f) / sqrtf(s_ * (1.0f / D) + NORM_EPS); \
          _Pragma("unroll") for (int hh_ = 0; hh_ < 2; ++hh_) { v4u o_; \
              _Pragma("unroll") for (int q_ = 0; q_ < 4; ++q_) { unsigned w_ = 0u; \
                  _Pragma("unroll") for (int e_ = 0; e_ < 4; ++e_) { const int qi_ = (int)rintf(V_[hh_][q_][e_] * xq_); w_ |= ((unsigned)qi_ & 0xFFu) << (8 * e_); } \
                  o_[q_] = w_; } \
              *(v4u*)(xq + (size_t)(row_) * D + hh_ * 1024 + F.lane * 16) = o_; } } while (0)
      for (int m = gw; m < T; m += 2 * NGW) { const int mB = m + NGW < T ? m + NGW : m;
          f32x4 xa[2][4], xb2[2][4];
          XR_LOAD(xa, m); XR_LOAD(xb2, mB);
          XR_QUANT(xa, m);
          if (mB != m) XR_QUANT(xb2, mB); }
#undef XR_LOAD
#undef XR_QUANT
    }
    }
}

typedef float f32x2c __attribute__((ext_vector_type(2)));
__device__ __forceinline__ unsigned cvtpk(float lo, float hi) { const f32x2c v = {lo, hi}; const bf16x2_t b = __builtin_convertvector(v, bf16x2_t); return __builtin_bit_cast(unsigned, b); }
__device__ __forceinline__ float rcpf_(float x) { return __builtin_amdgcn_rcpf(x); }
__device__ __forceinline__ float sigmoid_fast(float x) { return rcpf_(1.0f + __expf(-x)); }
__device__ __forceinline__ float tanh_fast(float x) { return 1.0f - 2.0f * rcpf_(1.0f + __expf(2.0f * x)); }
__device__ __forceinline__ float softplus_fast(float z) { return fmaxf(z, 0.f) + __logf(1.0f + __expf(-fabsf(z))); }
__device__ __forceinline__ float gelu_fast(float x) { const float u = 0.7978845608028654f * (x + 0.044715f * x * x * x); return x * rcpf_(1.0f + __expf(-2.0f * u)); }
__device__ __forceinline__ void rwkv_prep_unit(const Frame& F, int chunk, int h, int lane, const LAS bf16* WL2, const LAS bf16* AL2, const LAS bf16* GL2, const LAS float* CW, LAS bf16* ST) {
    asm volatile("" : "+v"(lane));
    const int fr = lane & 15, fq = lane >> 4;
    const bf16* PROJ = WSP(bf16, WS_PROJ); const bf16* LA = WSP(bf16, WS_LA);
    bf16* TA = WSP(bf16, WS_TA); bf16* TB = WSP(bf16, WS_TB); bf16* TK = WSP(bf16, WS_TK); bf16* TR = WSP(bf16, WS_TR);
    bf16* TV = (bf16*)F.out + OUT_TV / 2; bf16* TG = (bf16*)F.out + OUT_TG / 2; float* PCG = F.out + OUT_PC / 4; float* BONG = F.out + OUT_BON / 4;
#define PU4(w_) ((f32x4){bf_lo((w_).x), bf_hi((w_).x), bf_lo((w_).y), bf_hi((w_).y)})
    size_t tokm[2]; int pom[2]; unsigned pmm[2];
#pragma unroll
    for (int mt = 0; mt < 2; ++mt) { tokm[mt] = (size_t)chunk * 32 + mt * 16 + fr; const bool hasp = ((chunk & 63) * 32 + mt * 16 + fr) > 0; pom[mt] = hasp ? NINP : 0; pmm[mt] = hasp ? 0xffffffffu : 0u; }
    float inv[2], bn[2];
#pragma unroll
    for (int mt = 0; mt < 2; ++mt) { float s2 = 0.f;
#pragma unroll
        for (int nt = 0; nt < 4; ++nt) { const int j4 = nt * 16 + fq * 4; const bf16* pr = PROJ + tokm[mt] * NINP + PC_K + h * 64 + j4;
            const v2u kc = *(const v2u*)pr; v2u kp = *(const v2u*)(pr - pom[mt]); kp.x &= pmm[mt]; kp.y &= pmm[mt];
            const f32x4 c_kk = *(const LAS f32x4*)(CW + 128 + j4), m_k = *(const LAS f32x4*)(CW + 384 + j4);
            const f32x4 kcf = PU4(kc); const f32x4 ku = (kcf + (PU4(kp) - kcf) * m_k) * c_kk; s2 += (ku[0] * ku[0] + ku[1] * ku[1]) + (ku[2] * ku[2] + ku[3] * ku[3]); }
        { auto x = __builtin_amdgcn_permlane16_swap(__float_as_uint(s2), __float_as_uint(s2), false, false); s2 = __uint_as_float(x[0]) + __uint_as_float(x[1]); }
        { auto x = __builtin_amdgcn_permlane32_swap(__float_as_uint(s2), __float_as_uint(s2), false, false); s2 = __uint_as_float(x[0]) + __uint_as_float(x[1]); }
        inv[mt] = __builtin_amdgcn_rsqf(fmaxf(s2, 1e-24f)); bn[mt] = 0.f; }
    v2u cur_[3], prv_[3], ncur_[3], nprv_[3];
#define PREP_LOAD_RKV(C_, P_, st_) do { const int mt_ = (st_) >> 2, nt_ = (st_) & 3; const bf16* pr_ = PROJ + tokm[mt_] * NINP + PC_R + h * 64 + nt_ * 16 + fq * 4; \
        _Pragma("unroll") for (int q_ = 0; q_ < 3; ++q_) { C_[q_] = *(const v2u*)(pr_ + q_ * 1024); P_[q_] = *(const v2u*)(pr_ + q_ * 1024 - pom[mt_]); } } while (0)
    PREP_LOAD_RKV(cur_, prv_, 0);
    f32x4 tot0[4];
#pragma unroll
    for (int n = 0; n < 4; ++n) tot0[n] = (f32x4){0.f, 0.f, 0.f, 0.f};
    bf16x8 la[9];
#pragma unroll
    for (int st = 0; st < 8; ++st) { const int mt = st >> 2, nt = st & 3; const int j4 = nt * 16 + fq * 4; const size_t col = (size_t)h * 64 + j4;
        if (nt == 0) {
#pragma unroll
            for (int ks = 0; ks < 9; ++ks) la[ks] = *(const bf16x8*)(LA + tokm[mt] * 288 + ks * 32 + 8 * fq); }
        if (st < 7) PREP_LOAD_RKV(ncur_, nprv_, st + 1);
        f32x4 cw = (f32x4){0.f, 0.f, 0.f, 0.f}, ca = cw, cg = cw;
#pragma unroll
        for (int ks = 0; ks < 2; ++ks) { cw = MFMA16(*(const LAS bf16x8*)(WL2 + (nt * 16 + fr) * 72 + ks * 32 + 8 * fq), la[ks], cw); ca = MFMA16(*(const LAS bf16x8*)(AL2 + (nt * 16 + fr) * 72 + ks * 32 + 8 * fq), la[2 + ks], ca); }
#pragma unroll
        for (int ks = 0; ks < 5; ++ks) cg = MFMA16(*(const LAS bf16x8*)(GL2 + (nt * 16 + fr) * 168 + ks * 32 + 8 * fq), la[4 + ks], cg);
        const f32x4 c_w0 = *(const LAS f32x4*)(CW + j4), c_a0 = *(const LAS f32x4*)(CW + 64 + j4), c_kk = *(const LAS f32x4*)(CW + 128 + j4), c_ka = *(const LAS f32x4*)(CW + 192 + j4), c_rk = *(const LAS f32x4*)(CW + 256 + j4);
        const f32x4 m_r = *(const LAS f32x4*)(CW + 320 + j4), m_k = *(const LAS f32x4*)(CW + 384 + j4), m_v = *(const LAS f32x4*)(CW + 448 + j4);
        v2u rp = prv_[0], kp = prv_[1], vp = prv_[2]; const unsigned pm = pmm[mt];
        rp.x &= pm; rp.y &= pm; kp.x &= pm; kp.y &= pm; vp.x &= pm; vp.y &= pm;
        const f32x4 rcf = PU4(cur_[0]), kcf = PU4(cur_[1]), vcf = PU4(cur_[2]);
        const f32x4 rr = rcf + (PU4(rp) - rcf) * m_r, kv = kcf + (PU4(kp) - kcf) * m_k, vv = vcf + (PU4(vp) - vcf) * m_v;
        f32x4 nau, bbu, km, cum;
#pragma unroll
        for (int r = 0; r < 4; ++r) { const float av = sigmoid_fast(c_a0[r] + ca[r]), ku = kv[r] * c_kk[r]; km[r] = kv[r] * (1.0f + (av - 1.0f) * c_ka[r]);
            cum[r] = -0.6065306597126334f * sigmoid_fast(c_w0[r] + cw[r]);
            nau[r] = -ku; bbu[r] = ku * av; bn[mt] += rr[r] * km[r] * c_rk[r]; }
        f32x4 at4, rt4, bt4, kt4, ep4;
#pragma unroll
        for (int r = 0; r < 4; ++r) { float v = cum[r];
            v += __builtin_bit_cast(float, __builtin_amdgcn_update_dpp(0, __builtin_bit_cast(int, v), 0x111, 0xf, 0xf, true));
            v += __builtin_bit_cast(float, __builtin_amdgcn_update_dpp(0, __builtin_bit_cast(int, v), 0x112, 0xf, 0xf, true));
            v += __builtin_bit_cast(float, __builtin_amdgcn_update_dpp(0, __builtin_bit_cast(int, v), 0x114, 0xf, 0xf, true));
            v += __builtin_bit_cast(float, __builtin_amdgcn_update_dpp(0, __builtin_bit_cast(int, v), 0x118, 0xf, 0xf, true));
            if (mt == 0) tot0[nt][r] = __shfl(v, (lane & 48) | 15); else v += tot0[nt][r];
            const float ep = __expf(v), em = rcpf_(ep);
            float eprev = __builtin_bit_cast(float, __builtin_amdgcn_update_dpp(0, __builtin_bit_cast(int, ep), 0x111, 0xf, 0xf, true));
            if (fr == 0) eprev = mt ? __expf(tot0[nt][r]) : 1.0f;
            at4[r] = nau[r] * inv[mt] * eprev; rt4[r] = rr[r] * ep; bt4[r] = bbu[r] * inv[mt] * em; kt4[r] = km[r] * em; ep4[r] = ep; }
        { LAS bf16* sp = ST + fr * 64 + j4; v2u w;
          w.x = cvtpk(at4[0], at4[1]); w.y = cvtpk(at4[2], at4[3]); *(LAS v2u*)(sp) = w;
          w.x = cvtpk(rt4[0], rt4[1]); w.y = cvtpk(rt4[2], rt4[3]); *(LAS v2u*)(sp + 1024) = w;
          w.x = cvtpk(bt4[0], bt4[1]); w.y = cvtpk(bt4[2], bt4[3]); *(LAS v2u*)(sp + 2048) = w;
          w.x = cvtpk(kt4[0], kt4[1]); w.y = cvtpk(kt4[2], kt4[3]); *(LAS v2u*)(sp + 3072) = w;
          w.x = cvtpk(vv[0], vv[1]); w.y = cvtpk(vv[2], vv[3]); *(LAS v2u*)(sp + 4096) = w;
          w.x = cvtpk(cg[0], cg[1]); w.y = cvtpk(cg[2], cg[3]); *(LAS v2u*)(sp + 5120) = w; }
        if (nt == 3) {
            bf16* const dstp[6] = {TA, TR, TB, TK, TV, TG};
#pragma unroll
            for (int a6 = 0; a6 < 6; ++a6)
#pragma unroll
                for (int hrow = 0; hrow < 2; ++hrow) { const int row = hrow * 8 + (lane >> 3), c8 = (lane & 7) * 8;
                    const v4u pv = *(const LAS v4u*)(ST + a6 * 1024 + row * 64 + c8);
                    *(v4u*)(dstp[a6] + ((size_t)chunk * 32 + mt * 16 + row) * 1024 + (size_t)h * 64 + c8) = pv; } }
        if (mt == 1 && fr == 15) *(f32x4*)(PCG + (size_t)chunk * 1024 + col) = ep4;
#pragma unroll
        for (int q = 0; q < 3; ++q) { cur_[q] = ncur_[q]; prv_[q] = nprv_[q]; }
    }
#undef PREP_LOAD_RKV
#undef PU4
#pragma unroll
    for (int mt = 0; mt < 2; ++mt) { float b2 = bn[mt];
        { auto x = __builtin_amdgcn_permlane16_swap(__float_as_uint(b2), __float_as_uint(b2), false, false); b2 = __uint_as_float(x[0]) + __uint_as_float(x[1]); }
        { auto x = __builtin_amdgcn_permlane32_swap(__float_as_uint(b2), __float_as_uint(b2), false, false); b2 = __uint_as_float(x[0]) + __uint_as_float(x[1]); }
        if (fq == 0) BONG[tokm[mt] * 16 + h] = b2; }
}
__device__ __forceinline__ void rwkv_prep_phase(const Frame& F) {
    LAS bf16* WL2 = (LAS bf16*)(F.lds + 0); LAS bf16* AL2 = (LAS bf16*)(F.lds + 9216); LAS bf16* GL2 = (LAS bf16*)(F.lds + 18432); LAS float* CW = (LAS float*)(F.lds + 39936);
    int hcur = -1;
    for (int u = F.bid; u < 1024; u += F.G) { const int h = u & 15, cg = u >> 4;
        if (h != hcur) { hcur = h; __syncthreads();
            int tid_ = F.tid; asm volatile("" : "+v"(tid_));
            const bf16* w2t = WSP(bf16, WS_W2T) + (size_t)h * 64 * 64; const bf16* a2t = WSP(bf16, WS_A2T) + (size_t)h * 64 * 64; const bf16* g2t = WSP(bf16, WS_G2T) + (size_t)h * 64 * 160;
            { const int r = tid_ >> 3, c = (tid_ & 7) * 8; *(LAS v4u*)(WL2 + r * 72 + c) = *(const v4u*)(w2t + r * 64 + c); *(LAS v4u*)(AL2 + r * 72 + c) = *(const v4u*)(a2t + r * 64 + c); }
            for (int i = tid_; i < 64 * 20; i += NTHR) { const int r = i / 20, c = (i - r * 20) * 8; *(LAS v4u*)(GL2 + r * 168 + c) = *(const v4u*)(g2t + r * 160 + c); }
            { const int q = tid_ >> 6, jj = tid_ & 63; const float* src = q == 0 ? F.in[I_W0] : (q == 1 ? F.in[I_A0] : (q == 2 ? F.in[I_KK] : (q == 3 ? F.in[I_KA] : (q == 4 ? F.in[I_RK] : F.in[I_MU] + (q - 5) * 1024)))); CW[q * 64 + jj] = src[h * 64 + jj]; }
            __syncthreads(); }
        rwkv_prep_unit(F, cg * 8 + F.wave, h, F.lane, WL2, AL2, GL2, CW, (LAS bf16*)(F.lds + 43008 + F.wave * 12288)); }
    __syncthreads();
}
typedef short v4i16_t __attribute__((ext_vector_type(4)));
__device__ __forceinline__ bf16x8 frag_tr16(const LAS bf16* p, int ld) {
    const v4i16_t a = __builtin_amdgcn_ds_read_tr16_b64_v4i16((LAS v4i16_t*)p), b = __builtin_amdgcn_ds_read_tr16_b64_v4i16((LAS v4i16_t*)(p + 4 * ld));
    return (bf16x8){a[0], a[1], a[2], a[3], b[0], b[1], b[2], b[3]};
}
__device__ __forceinline__ void rwkv_item(const Frame& F, int item) {
    const int b = item >> 4, h = item & 15, wave = F.wave; int tid = F.tid; asm volatile("" : "+v"(tid)); const int lane = tid & 63;
    LAS unsigned char* L = F.lds;
    constexpr int LD64 = 72, LD32 = 40, E0 = 73216;
    LAS bf16* AT = (LAS bf16*)(L + 0);  LAS bf16* BT_ = (LAS bf16*)(L + 4608); LAS bf16* KT_ = (LAS bf16*)(L + 9216); LAS bf16* RT = (LAS bf16*)(L + 13824);
    LAS bf16* VS2 = (LAS bf16*)(L + 18432);
    LAS bf16* GGB2 = (LAS bf16*)(L + 27648);
    LAS bf16* S0B = (LAS bf16*)(L + 36864);
    LAS float* YB2 = (LAS float*)(L + 55296);
    LAS float* BON2 = (LAS float*)(L + 72704);
    LAS float* PC = (LAS float*)(L + 72960);
    LAS bf16* AAK = (LAS bf16*)(L + E0); LAS bf16* ARB = (LAS bf16*)(L + E0 + 2560); LAS bf16* ARK = (LAS bf16*)(L + E0 + 5120);
    LAS bf16* MINV = (LAS bf16*)(L + E0 + 7680);
    LAS bf16* RHS = (LAS bf16*)(L + E0 + 23040);
    LAS bf16* SAB = (LAS bf16*)(L + E0 + 28160);
    static_assert(E0 + 33280 <= LDSCTL_OFF, "rwkv LDS map");
    bf16* Y = WSP(bf16, WS_Y);
#define FRAG(base, row0, ld, ks) (*(const LAS bf16x8*)((base) + ((row0) + fr) * (ld) + (ks) * 32 + 8 * fq))
#define FRAGT(base, col0, ld) frag_tr16((base) + (8 * fq + (fr >> 2)) * (ld) + (col0) + 4 * (fr & 3), (ld))
    const int tt = tid >> 4, j0 = (tid & 15) * 4, hc = h * 64 + j0;
    const f32x4 plw = *(const f32x4*)(F.in[I_LNW] + hc), plb = *(const f32x4*)(F.in[I_LNB] + hc);
    const int lr = (tid & 255) >> 3, lc8 = tid & 7; const bool hi2 = tid >= 256;
    const bf16* srcA[3] = { (hi2 ? WSP(bf16, WS_TR) : WSP(bf16, WS_TA)), (hi2 ? WSP(bf16, WS_TK) : WSP(bf16, WS_TB)), (hi2 ? (const bf16*)F.out + OUT_TG / 2 : (const bf16*)F.out + OUT_TV / 2) };
    const size_t poff = ((size_t)b * SEQ + lr) * 1024 + h * 64 + lc8 * 8;
    const float* PCG = F.out + OUT_PC / 4 + (size_t)(b * 64) * 1024 + h * 64; const float* BONG = F.out + OUT_BON / 4 + (size_t)b * SEQ * 16 + h;
    v4u pl_[3]; float ppc = 0.f, pbn = 0.f;
#define RWKV_PREFETCH(tl_) do { _Pragma("unroll") for (int q_ = 0; q_ < 3; ++q_) pl_[q_] = *(const v4u*)(srcA[q_] + poff + (size_t)(tl_) * 32 * 1024); \
        ppc = PCG[(size_t)(tl_) * 1024 + (tid & 63)]; pbn = BONG[((size_t)(tl_) * 32 + (tid & 31)) * 16]; } while (0)
    const int ib = wave >> 1, tb = wave & 1, i0 = ib * 16, t0m = tb * 16;
    f32x4 sacc[2], yacc;
    sacc[0] = (f32x4){0.f, 0.f, 0.f, 0.f}; sacc[1] = sacc[0]; yacc = sacc[0];
    for (int u = tid; u < 2 * 64 * LD64 / 2; u += NTHR) ((LAS unsigned*)S0B)[u] = 0u;
    RWKV_PREFETCH(0);
    __syncthreads();
    for (int tl = 0; tl <= SEQ / 32; ++tl) {
        const int cur = tl & 1;
        int lane_c = lane; asm volatile("" : "+v"(lane_c)); const int fr = lane_c & 15, fq = lane_c >> 4;
        LAS bf16* VS = VS2 + cur * 32 * LD64; LAS bf16* GGB = GGB2 + cur * 32 * LD64; LAS float* YB = YB2 + cur * 32 * 68; LAS float* BON = BON2 + cur * 32;
        const LAS bf16* VSp = VS2 + (cur ^ 1) * 32 * LD64; const LAS bf16* GGBp = GGB2 + (cur ^ 1) * 32 * LD64; const LAS float* YBp = YB2 + (cur ^ 1) * 32 * 68; const LAS float* BONp = BON2 + (cur ^ 1) * 32;
        if (tl > 0) { const size_t tokb = (size_t)b * SEQ + (tl - 1) * 32;
          const f32x4 y4 = *(const LAS f32x4*)(YBp + tt * 68 + j0); const v2u gw_ = *(const LAS v2u*)(GGBp + tt * LD64 + j0);
          const f32x4 g4 = (f32x4){bf_lo(gw_.x), bf_hi(gw_.x), bf_lo(gw_.y), bf_hi(gw_.y)};
          const v2u vw_ = *(const LAS v2u*)(VSp + tt * LD64 + j0); const f32x4 v4 = (f32x4){bf_lo(vw_.x), bf_hi(vw_.x), bf_lo(vw_.y), bf_hi(vw_.y)};
          float sm = (y4[0] + y4[1]) + (y4[2] + y4[3]); sm = red16(sm); const float mean = sm * (1.0f / 64.0f);
          const f32x4 d4 = y4 - mean; float sv = (d4[0] * d4[0] + d4[1] * d4[1]) + (d4[2] * d4[2] + d4[3] * d4[3]); sv = red16(sv);
          const float rstd = __builtin_amdgcn_rsqf(sv * (1.0f / 64.0f) + GN_EPS), bon = BONp[tt];
          f32x4 o;
#pragma unroll
          for (int e = 0; e < 4; ++e) o[e] = (d4[e] * rstd * plw[e] + plb[e] + bon * v4[e]) * g4[e];
          v2u w; w.x = cvtpk(o[0], o[1]); w.y = cvtpk(o[2], o[3]);
          *(v2u*)(Y + (tokb + tt) * D + 1024 + hc) = w; }
        if (tl == SEQ / 32) break;
        const LAS bf16* S0c = S0B + cur * 64 * LD64; LAS bf16* S0n = S0B + (cur ^ 1) * 64 * LD64;
        { const v4u p0 = pl_[0], p1 = pl_[1], p2 = pl_[2];
          *(LAS v4u*)((hi2 ? RT : AT) + lr * LD64 + lc8 * 8) = p0;
          *(LAS v4u*)((hi2 ? KT_ : BT_) + lr * LD64 + lc8 * 8) = p1;
          *(LAS v4u*)((hi2 ? GGB : VS) + lr * LD64 + lc8 * 8) = p2;
          if (tid < 64) PC[tid] = ppc;
          if (tid >= 64 && tid < 96) BON[tid - 64] = pbn; }
        { const int tn_ = tl + 1 < SEQ / 32 ? tl + 1 : SEQ / 32 - 1; RWKV_PREFETCH(tn_); }
        __syncthreads();
        f32x4 rhs4 = (f32x4){0.f, 0.f, 0.f, 0.f};
#define RWKV_FIRST do { rhs4 = (f32x4){0.f, 0.f, 0.f, 0.f}; yacc = (f32x4){0.f, 0.f, 0.f, 0.f}; \
            _Pragma("unroll") for (int ks = 0; ks < 2; ++ks) rhs4 = MFMA16(FRAG(AT, t0m, LD64, ks), FRAG(S0c, i0, LD64, ks), rhs4); \
            _Pragma("unroll") for (int ks = 0; ks < 2; ++ks) yacc = MFMA16(FRAG(S0c, i0, LD64, ks), FRAG(RT, t0m, LD64, ks), yacc); \
            _Pragma("unroll") for (int u = 0; u < 2; ++u) { const int tile = wave * 2 + u, si0 = (tile >> 2) * 16, sj0 = (tile & 3) * 16; sacc[u] = MFMA16(FRAGT(KT_, sj0, LD64), FRAGT(VS, si0, LD64), sacc[u]); } } while (0)
#define PK8(a_, s_) __builtin_bit_cast(bf16x8, (v4u){cvtpk(a_[8 * (s_) + 0], a_[8 * (s_) + 1]), cvtpk(a_[8 * (s_) + 2], a_[8 * (s_) + 3]), cvtpk(a_[8 * (s_) + 4], a_[8 * (s_) + 5]), cvtpk(a_[8 * (s_) + 6], a_[8 * (s_) + 7])})
        if (wave == 0) {
            const int c32 = lane_c & 31, h32 = lane_c >> 5;
            f32x16 U, V, PT;
#pragma unroll
            for (int e = 0; e < 16; ++e) { U[e] = 0.f; V[e] = 0.f; }
#pragma unroll
            for (int ks = 0; ks < 4; ++ks) { const bf16x8 fa = *(const LAS bf16x8*)(AT + c32 * LD64 + ks * 16 + h32 * 8), fb = *(const LAS bf16x8*)(BT_ + c32 * LD64 + ks * 16 + h32 * 8);
                U = MFMA32(fa, fb, U);
                V = MFMA32(fb, fa, V); }
#pragma unroll
            for (int e = 0; e < 16; ++e) { const int rr = (e & 3) + 8 * (e >> 2) + 4 * h32;
                U[e] = (c32 < rr) ? U[e] : 0.f;
                V[e] = (rr < c32) ? V[e] : 0.f;
                PT[e] = V[e] + ((rr == c32) ? 1.0f : 0.f); }
#pragma unroll
            for (int st = 1; st <= 4; ++st) {
                const bf16x8 fU0 = PK8(U, 0), fU1 = PK8(U, 1), fV0 = PK8(V, 0), fV1 = PK8(V, 1);
                f32x16 Un, Vn;
#pragma unroll
                for (int e = 0; e < 16; ++e) { Un[e] = 0.f; Vn[e] = 0.f; }
                Un = MFMA32(fV0, fU0, Un); Un = MFMA32(fV1, fU1, Un);
                if (st < 4) { Vn = MFMA32(fU0, fV0, Vn); Vn = MFMA32(fU1, fV1, Vn); }
                const bf16x8 fN0 = PK8(Un, 0), fN1 = PK8(Un, 1), fP0 = PK8(PT, 0), fP1 = PK8(PT, 1);
                PT = MFMA32(fN0, fP0, PT); PT = MFMA32(fN1, fP1, PT);
                U = Un; V = Vn; }
#pragma unroll
            for (int q = 0; q < 4; ++q) { v2u w; w.x = cvtpk(PT[4 * q], PT[4 * q + 1]); w.y = cvtpk(PT[4 * q + 2], PT[4 * q + 3]); *(LAS v2u*)(MINV + c32 * LD32 + 8 * q + 4 * h32) = w; }
        } else {
            if (wave < 7) { const int mtx = (wave - 1) >> 1;
                const LAS bf16* Xs = (mtx == 1) ? BT_ : KT_; const LAS bf16* Yt = (mtx == 0) ? AT : RT; LAS bf16* O = (mtx == 0) ? AAK : (mtx == 1 ? ARB : ARK);
#pragma unroll
                for (int qq = 0; qq < 2; ++qq) { const int q = ((wave - 1) & 1) * 2 + qq, tq = (q >> 1) * 16, sq = (q & 1) * 16;
                    f32x4 a4 = (f32x4){0.f, 0.f, 0.f, 0.f};
                    if (sq <= tq) {
#pragma unroll
                        for (int ks = 0; ks < 2; ++ks) a4 = MFMA16(FRAG(Xs, sq, LD64, ks), FRAG(Yt, tq, LD64, ks), a4); }
                    const int t = tq + fr, s = sq + fq * 4;
#pragma unroll
                    for (int r = 0; r < 4; ++r) { const bool keep = (mtx == 0) ? (s + r < t) : (s + r <= t); a4[r] = keep ? a4[r] : 0.f; }
                    v2u w; w.x = cvtpk(a4[0], a4[1]); w.y = cvtpk(a4[2], a4[3]); *(LAS v2u*)(O + t * LD32 + s) = w; } }
            RWKV_FIRST;
        }
        __syncthreads();
        if (wave == 0) RWKV_FIRST;
        { rhs4 = MFMA16(FRAG(AAK, t0m, LD32, 0), FRAGT(VS, i0, LD64), rhs4);
          v2u w; w.x = cvtpk(rhs4[0], rhs4[1]); w.y = cvtpk(rhs4[2], rhs4[3]); *(LAS v2u*)(RHS + (i0 + fr) * LD32 + t0m + fq * 4) = w;
          yacc = MFMA16(FRAGT(VS, i0, LD64), FRAG(ARK, t0m, LD32, 0), yacc); }
        __syncthreads();
#undef RWKV_FIRST
#undef PK8
        { f32x4 a4 = (f32x4){0.f, 0.f, 0.f, 0.f}; a4 = MFMA16(FRAG(MINV, t0m, LD32, 0), FRAG(RHS, i0, LD32, 0), a4);
          v2u w; w.x = cvtpk(a4[0], a4[1]); w.y = cvtpk(a4[2], a4[3]); *(LAS v2u*)(SAB + (i0 + fr) * LD32 + t0m + fq * 4) = w; }
        __syncthreads();
        { yacc = MFMA16(FRAG(SAB, i0, LD32, 0), FRAG(ARB, t0m, LD32, 0), yacc);
          *(LAS f32x4*)(YB + (t0m + fr) * 68 + i0 + fq * 4) = yacc;
#pragma unroll
          for (int u = 0; u < 2; ++u) { const int tile = wave * 2 + u, si0 = (tile >> 2) * 16, sj0 = (tile & 3) * 16;
              sacc[u] = MFMA16(FRAGT(BT_, sj0, LD64), FRAG(SAB, si0, LD32, 0), sacc[u]);
              const f32x4 pc = *(const LAS f32x4*)(PC + sj0 + fq * 4); sacc[u] = sacc[u] * pc;
              v2u w; w.x = cvtpk(sacc[u][0], sacc[u][1]); w.y = cvtpk(sacc[u][2], sacc[u][3]); *(LAS v2u*)(S0n + (si0 + fr) * LD64 + sj0 + fq * 4) = w; } }
        __syncthreads();
    }
    __syncthreads();
#undef FRAG
#undef FRAGT
#undef RWKV_PREFETCH
}
__device__ __forceinline__ void lora_prepass(const Frame& F) {
    const bf16* PROJ = WSP(bf16, WS_PROJ); bf16* LA = WSP(bf16, WS_LA); const float* mu = F.in[I_MU] + (PC_WD - RWKV_C0);
    const int gt = (F.bid * NWAVES + F.wave) * 64 + F.lane, NGT = F.G * NTHR;
    for (int i = gt; i < T * 36; i += NGT) { const int tok = i / 36, cc = i - tok * 36, m = cc * 8;
        const bf16* pr = PROJ + (size_t)tok * NINP + PC_WD + m;
        const v4u curv = *(const v4u*)pr; v4u prv = (v4u){0u, 0u, 0u, 0u}; if ((tok & (SEQ - 1)) != 0) prv = *(const v4u*)(pr - NINP);
        const f32x4 m0 = *(const f32x4*)(mu + m), m1 = *(const f32x4*)(mu + m + 4);
        float c[8], p[8], o[8]; unpack8(curv, c); unpack8(prv, p);
#pragma unroll
        for (int e = 0; e < 8; ++e) { const float ps = c[e] + (p[e] - c[e]) * (e < 4 ? m0[e] : m1[e - 4]); o[e] = (m < 64) ? tanh_fast(ps) : ((m < 128) ? ps : sigmoid_fast(ps)); }
        v4u w; w.x = cvtpk(o[0], o[1]); w.y = cvtpk(o[2], o[3]); w.z = cvtpk(o[4], o[5]); w.w = cvtpk(o[6], o[7]);
        *(v4u*)(LA + (size_t)tok * 288 + m) = w; }
}
__device__ __forceinline__ void lru_seq(const Frame& F, int item) {
    const int bh = item >> 1, hf = item & 1, b = bh >> 3, h = bh & 7, wave = F.wave; int tid = F.tid; asm volatile("" : "+v"(tid)); const int lane = tid & 63;
    LAS unsigned char* L = F.lds;
    LAS bf16* XA = (LAS bf16*)(L + 0);
    LAS float* XC = (LAS float*)(L + 17408);
    LAS float* RI = (LAS float*)(L + 50176);
    LAS float* SEG = (LAS float*)(L + 115712);
    LAS float* CARRY = (LAS float*)(L + 119808);
    LAS float* CW = (LAS float*)(L + 120320);
    const bf16* PROJ = WSP(bf16, WS_PROJ); bf16* Y = WSP(bf16, WS_Y);
    const int fr0 = lane & 15, fq0 = lane >> 4;
    for (int i = tid; i < 640; i += NTHR) { const int w = i >> 7, cch = i & 127; CW[i] = (w < 4) ? F.in[I_CONVW][w * 1024 + h * 128 + cch] : F.in[I_CONVB][h * 128 + cch]; }
    if (tid < 64) CARRY[tid] = 0.f;
    const int gsel = wave & 1, ntl = wave >> 1, ntg = hf * 4 + ntl;
    bf16x8 wf[4];
    { const bf16* WTp = (gsel ? WSP(bf16, WS_WIT) : WSP(bf16, WS_WAT)) + (size_t)h * 128 * 128;
#pragma unroll
      for (int ks = 0; ks < 4; ++ks) wf[ks] = *(const bf16x8*)(WTp + (ntg * 16 + fr0) * 128 + ks * 32 + 8 * fq0); }
    const int c = tid & 63, sg = tid >> 6, chl = hf * 64 + c, chg = h * 128 + chl;
    const float ba_c = F.in[I_BA][chg], bi_c = F.in[I_BI][chg], sp8 = 8.0f * softplus_fast(-F.in[I_LAM][chg]);
    v4u pf[2][4];
#define LRU_PREFETCH(k_) do { _Pragma("unroll") for (int u_ = 0; u_ < 2; ++u_) { const int chn_ = tid + NTHR * u_, t_ = chn_ >> 4, c8_ = (chn_ & 15) * 8; \
        _Pragma("unroll") for (int w_ = 0; w_ < 4; ++w_) { const int ts_ = (k_) * 64 + t_ - 3 + w_; const int tc_ = ts_ >= 0 ? ts_ : 0;   \
            const v4u x_ = *(const v4u*)(PROJ + ((size_t)b * SEQ + tc_) * NINP + h * 128 + c8_); const unsigned m_ = ts_ >= 0 ? 0xffffffffu : 0u; \
            pf[u_][w_] = (v4u){x_.x & m_, x_.y & m_, x_.z & m_, x_.w & m_}; } } } while (0)
    unsigned short gtn[8];
#define LRU_GATES(k_) do { _Pragma("unroll") for (int e_ = 0; e_ < 8; ++e_) gtn[e_] = PROJ[((size_t)b * SEQ + (k_) * 64 + sg * 8 + e_) * NINP + PC_GATE + chg]; } while (0)
    const int ttab = item >> 6, trow0 = ((item & 63) * 8 + wave) * 32;
    const float* tsrc = ttab ? F.in[I_V] : F.in[I_U]; unsigned char* tdst = ttab ? WSP(unsigned char, WS_VT) : WSP(unsigned char, WS_UT); float* tsc = ttab ? WSP(float, WS_VSC) : WSP(float, WS_USC);
    f32x4 tr[2][4];
#define LRU_TBL_LOAD(row_) do { _Pragma("unroll") for (int hh_ = 0; hh_ < 2; ++hh_) _Pragma("unroll") for (int q_ = 0; q_ < 4; ++q_) tr[hh_][q_] = *(const f32x4*)(tsrc + (size_t)(row_) * D + hh_ * 1024 + lane * 16 + q_ * 4); } while (0)
#define LRU_TBL_QUANT(row_) do { float am_ = 0.f; \
        _Pragma("unroll") for (int hh_ = 0; hh_ < 2; ++hh_) _Pragma("unroll") for (int q_ = 0; q_ < 4; ++q_) _Pragma("unroll") for (int e_ = 0; e_ < 4; ++e_) am_ = fmaxf(am_, fabsf(tr[hh_][q_][e_])); \
        _Pragma("unroll") for (int o_ = 1; o_ < 64; o_ <<= 1) am_ = fmaxf(am_, __shfl_xor(am_, o_)); \
        const float tq_ = am_ > 0.f ? 127.0f / am_ : 0.f; \
        if (lane == 0) tsc[row_] = am_ * (1.0f / 127.0f); \
        _Pragma("unroll") for (int hh_ = 0; hh_ < 2; ++hh_) { v4u o_; \
            _Pragma("unroll") for (int q_ = 0; q_ < 4; ++q_) { unsigned w_ = 0u; \
                _Pragma("unroll") for (int e_ = 0; e_ < 4; ++e_) { const int qi_ = (int)rintf(tr[hh_][q_][e_] * tq_); w_ |= ((unsigned)qi_ & 0xFFu) << (8 * e_); } \
                o_[q_] = w_; } \
            *(v4u*)(tdst + (size_t)(row_) * D + hh_ * 1024 + lane * 16) = o_; } } while (0)
    LRU_TBL_LOAD(trow0);
    LRU_PREFETCH(0); LRU_GATES(0);
    __syncthreads();
    for (int k = 0; k < SEQ / 64; ++k) {
        const size_t tokbase = (size_t)b * SEQ + k * 64;
        int lane_c = lane; asm volatile("" : "+v"(lane_c)); const int fr = lane_c & 15, fq = lane_c >> 4;
#pragma unroll
        for (int u = 0; u < 2; ++u) { const int chn = tid + NTHR * u, t = chn >> 4, c8 = (chn & 15) * 8;
            float acc[8]; { const f32x4 b0 = *(const LAS f32x4*)(CW + 512 + c8), b1 = *(const LAS f32x4*)(CW + 512 + c8 + 4);
#pragma unroll
                for (int e = 0; e < 4; ++e) { acc[e] = b0[e]; acc[e + 4] = b1[e]; } }
#pragma unroll
            for (int w = 0; w < 4; ++w) { float xf[8]; unpack8(pf[u][w], xf);
                const f32x4 w0 = *(const LAS f32x4*)(CW + w * 128 + c8), w1 = *(const LAS f32x4*)(CW + w * 128 + c8 + 4);
#pragma unroll
                for (int e = 0; e < 4; ++e) { acc[e] += w0[e] * xf[e]; acc[e + 4] += w1[e] * xf[e + 4]; } }
            v4u pk; pk.x = cvtpk(acc[0], acc[1]); pk.y = cvtpk(acc[2], acc[3]); pk.z = cvtpk(acc[4], acc[5]); pk.w = cvtpk(acc[6], acc[7]);
            *(LAS v4u*)(XA + t * 136 + c8) = pk;
            LAS float* d = XC + t * 128 + c8; *(LAS f32x4*)d = (f32x4){acc[0], acc[1], acc[2], acc[3]}; *(LAS f32x4*)(d + 4) = (f32x4){acc[4], acc[5], acc[6], acc[7]}; }
        float gl[8];
#pragma unroll
        for (int e = 0; e < 8; ++e) gl[e] = gelu_fast(__uint_as_float((unsigned)gtn[e] << 16));
        { const int kn_ = k + 1 < SEQ / 64 ? k + 1 : SEQ / 64 - 1; LRU_PREFETCH(kn_); LRU_GATES(kn_); }
        __syncthreads();
#pragma unroll
        for (int mt = 0; mt < 4; ++mt) {
            bf16x8 af[4];
#pragma unroll
            for (int ks = 0; ks < 4; ++ks) af[ks] = *(const LAS bf16x8*)(XA + (mt * 16 + fr) * 136 + ks * 32 + 8 * fq);
            { f32x4 a4 = (f32x4){0.f, 0.f, 0.f, 0.f};
#pragma unroll
                for (int ks = 0; ks < 4; ++ks) a4 = MFMA16(wf[ks], af[ks], a4);
                *(LAS f32x4*)(RI + gsel * 8192 + (mt * 16 + fr) * 128 + ntl * 16 + fq * 4) = a4; } }
        __syncthreads();
        float av[8], bx[8]; float A = 1.f, B = 0.f;
#pragma unroll
        for (int e = 0; e < 8; ++e) { const int t = sg * 8 + e; const float r = sigmoid_fast(RI[t * 128 + c] + ba_c), ig = sigmoid_fast(RI[8192 + t * 128 + c] + bi_c), xc = XC[t * 128 + chl];
            const float la = -sp8 * r; av[e] = __expf(la); bx[e] = sqrtf(fmaxf(1.0f - av[e] * av[e], 0.f)) * (ig * xc); A *= av[e]; B = av[e] * B + bx[e]; }
        SEG[(sg * 64 + c) * 2] = A; SEG[(sg * 64 + c) * 2 + 1] = B;
        __syncthreads();
        float hst = CARRY[c];
        for (int s2 = 0; s2 < sg; ++s2) hst = SEG[(s2 * 64 + c) * 2] * hst + SEG[(s2 * 64 + c) * 2 + 1];
#pragma unroll
        for (int e = 0; e < 8; ++e) { hst = av[e] * hst + bx[e];
            Y[(tokbase + sg * 8 + e) * D + chg] = (bf16)(cvtpk(hst * gl[e], 0.f) & 0xffffu); }
        LRU_TBL_QUANT(trow0 + k);
        { const int kn_ = k + 1 < SEQ / 64 ? k + 1 : SEQ / 64 - 1; LRU_TBL_LOAD(trow0 + kn_); }
        __syncthreads();
        if (sg == 7) CARRY[c] = hst;
    }
    __syncthreads();
#undef LRU_PREFETCH
#undef LRU_GATES
#undef LRU_TBL_LOAD
#undef LRU_TBL_QUANT
}
__device__ __forceinline__ void group_barrier(unsigned* cnt, unsigned n) {
    asm volatile("s_waitcnt vmcnt(0)" ::: "memory");
    __syncthreads();
    if (threadIdx.x == 0) {
        __builtin_amdgcn_fence(__ATOMIC_RELEASE, "agent");
        asm volatile("s_waitcnt vmcnt(0)" ::: "memory");
        xb_add(cnt, 1u);
        unsigned sp = 0; while (xb_ld(cnt) < n) { __builtin_amdgcn_s_sleep(2); if (++sp > (1u << 24)) break; }
        __builtin_amdgcn_fence(__ATOMIC_ACQUIRE, "agent");
        asm volatile("s_waitcnt vmcnt(0)" ::: "memory");
    }
    __syncthreads();
}

__device__ __forceinline__ unsigned f2ord(float f) { const unsigned u = __builtin_bit_cast(unsigned, f); return (u & 0x80000000u) ? ~u : (u | 0x80000000u); }
__device__ __forceinline__ float ord2f(unsigned o) { const unsigned u = (o & 0x80000000u) ? (o & 0x7fffffffu) : ~o; return __builtin_bit_cast(float, u); }
#define CMPX(hi_, lo_) do { const unsigned _a = (hi_), _b = (lo_); (hi_) = _a > _b ? _a : _b; (lo_) = _a > _b ? _b : _a; } while (0)
template <int N> __device__ __forceinline__ void sort_desc(unsigned (&a)[N]) {
#pragma unroll
    for (int k = 2; k <= N; k <<= 1)
#pragma unroll
        for (int j = k >> 1; j > 0; j >>= 1)
#pragma unroll
            for (int i = 0; i < N; ++i) { const int l = i ^ j; if (l > i) { if ((i & k) == 0) CMPX(a[i], a[l]); else CMPX(a[l], a[i]); } }
}
__device__ __forceinline__ void merge16(unsigned (&A)[16], const unsigned (&B)[16]) {
#pragma unroll
    for (int i = 0; i < 16; ++i) { const unsigned q = B[15 - i]; A[i] = A[i] > q ? A[i] : q; }
#pragma unroll
    for (int d = 8; d >= 1; d >>= 1)
#pragma unroll
        for (int i = 0; i < 16; ++i) if ((i & d) == 0) CMPX(A[i], A[i + d]);
}
__device__ __forceinline__ void merge_partner(unsigned (&Lk)[16]) {
    unsigned P[16];
#pragma unroll
    for (int i = 0; i < 16; ++i) P[i] = (unsigned)__shfl_xor((int)Lk[i], 32);
#pragma unroll
    for (int i = 0; i < 16; ++i) { const unsigned q = P[15 - i]; Lk[i] = Lk[i] > q ? Lk[i] : q; }
#pragma unroll
    for (int d = 8; d >= 1; d >>= 1)
#pragma unroll
        for (int i = 0; i < 16; ++i) if ((i & d) == 0) CMPX(Lk[i], Lk[i + d]);
}
__device__ __forceinline__ void route_item(const Frame& F, int item, int lane) {
    const int tok0 = (item >> 3) * 32, h = item & 7, c = lane & 31, hi = lane >> 5;
    const bf16* Q = WSP(bf16, WS_Q); const bf16* KB = WSP(bf16, WS_KEYS);
    LAS unsigned* WL = (LAS unsigned*)(F.lds + F.wave * 8192);
    unsigned LST[2][16];
    bf16x8 qf[8], qn[8], kf[8], kn[8];
#pragma unroll
    for (int ks = 0; ks < 8; ++ks) { qf[ks] = *(const bf16x8*)(Q + (size_t)(tok0 + c) * D + h * 256 + ks * 16 + 8 * hi); qn[ks] = *(const bf16x8*)(Q + (size_t)(tok0 + c) * D + h * 256 + 128 + ks * 16 + 8 * hi);
        kf[ks] = *(const bf16x8*)(KB + (size_t)((h * 2) * 128 + c) * 128 + 8 * hi + ks * 16); }
    unsigned Lk[16];
#pragma unroll
    for (int st = 0; st < 8; ++st) { const int p = st >> 2, m = st & 3;
        if (st < 7) { const int p2 = (st + 1) >> 2, m2 = (st + 1) & 3; const bf16* kp = KB + (size_t)((h * 2 + p2) * 128 + m2 * 32 + c) * 128 + 8 * hi;
#pragma unroll
            for (int ks = 0; ks < 8; ++ks) kn[ks] = *(const bf16x8*)(kp + ks * 16); }
        f32x16 acc;
#pragma unroll
        for (int r = 0; r < 16; ++r) acc[r] = 0.f;
#pragma unroll
        for (int ks = 0; ks < 8; ++ks) acc = MFMA32(kf[ks], p ? qn[ks] : qf[ks], acc);
        unsigned G16[16];
#pragma unroll
        for (int r = 0; r < 16; ++r) { const unsigned idx = (unsigned)(m * 32 + (r & 3) + 8 * (r >> 2)) | ((unsigned)hi << 2); G16[r] = (f2ord(acc[r]) & ~0x7Fu) | idx; }
        sort_desc<16>(G16);
        if (m == 0) {
#pragma unroll
            for (int i = 0; i < 16; ++i) Lk[i] = G16[i]; }
        else merge16(Lk, G16);
        if (m == 3) { merge_partner(Lk);
#pragma unroll
            for (int i = 0; i < 16; ++i) { LST[p][i] = Lk[i]; WL[(p * 16 + i) * 64 + lane] = Lk[i] & 0x7Fu; } }
#pragma unroll
        for (int ks = 0; ks < 8; ++ks) kf[ks] = kn[ks];
    }
    float va[4], vb[16];
#pragma unroll
    for (int i = 0; i < 4; ++i) va[i] = ord2f((hi ? LST[1][i] : LST[0][i]) & ~0x7Fu);
#pragma unroll
    for (int j = 0; j < 16; ++j) vb[j] = ord2f((hi ? LST[0][j] : LST[1][j]) & ~0x7Fu);
    unsigned C32[32];
#pragma unroll
    for (int i = 0; i < 32; ++i) C32[i] = 0u;
#pragma unroll
    for (int i = 0; i < 4; ++i) { const unsigned key = (f2ord(va[i] + vb[i]) & ~0xFFu) | (unsigned)(i * 17); C32[i] = hi ? 0u : key; }
    { int cn = 4;
#pragma unroll
      for (int i = 0; i < 3; ++i)
#pragma unroll
          for (int j = i + 1; j < 16; ++j) if ((i + 1) * (j + 1) <= 16) { const unsigned code = hi ? (unsigned)(j * 16 + i) : (unsigned)(i * 16 + j); C32[cn] = (f2ord(va[i] + vb[j]) & ~0xFFu) | code; ++cn; } }
    sort_desc<32>(C32);
    unsigned Ck[16];
#pragma unroll
    for (int i = 0; i < 16; ++i) Ck[i] = C32[i];
    merge_partner(Ck);
    const float mx = ord2f(Ck[0] & ~0xFFu); float den = 0.f;
#pragma unroll
    for (int k = 0; k < 16; ++k) den += __expf(ord2f(Ck[k] & ~0xFFu) - mx);
    const float rden = 1.0f / den;
    int eo[8]; float go[8];
#pragma unroll
    for (int k = 0; k < 8; ++k) { const unsigned fm = hi ? Ck[k + 8] : Ck[k]; const unsigned code = fm & 0xFFu;
        const unsigned k0 = WL[(code >> 4) * 64 + lane], k1 = WL[(16 + (code & 15u)) * 64 + lane];
        eo[k] = (int)(k0 * 128u + k1); go[k] = __expf(ord2f(fm & ~0xFFu) - mx) * rden; }
    int* ep = WSP(int, WS_EXP) + (size_t)(tok0 + c) * NSEL + h * 16 + hi * 8; float* gp = WSP(float, WS_GATE) + (size_t)(tok0 + c) * NSEL + h * 16 + hi * 8;
    *(int4*)ep = make_int4(eo[0], eo[1], eo[2], eo[3]); *(int4*)(ep + 4) = make_int4(eo[4], eo[5], eo[6], eo[7]);
    *(f32x4*)gp = (f32x4){go[0], go[1], go[2], go[3]}; *(f32x4*)(gp + 4) = (f32x4){go[4], go[5], go[6], go[7]};
}

typedef float f32x2 __attribute__((ext_vector_type(2)));
__device__ __forceinline__ int dot4i(unsigned a, unsigned b, int c) { return __builtin_amdgcn_sdot4((int)a, (int)b, c, false); }
template <int CTRL> __device__ __forceinline__ int dppi(int x) { return __builtin_amdgcn_mov_dpp(x, CTRL, 0xf, 0xf, true); }
struct PeerGeom { int ngrp, g, rank, nrank; };
__device__ __forceinline__ PeerGeom peer_geom(const Frame& F) { PeerGeom p; p.ngrp = (F.G % 8 == 0) ? 8 : 1; p.g = F.bid % p.ngrp; p.rank = F.bid / p.ngrp; p.nrank = F.G / p.ngrp; return p; }
__device__ __forceinline__ void xquant_token(const Frame& F, int tok, int lane) {
    const bf16* xr = WSP(bf16, WS_XB) + (size_t)tok * D + lane * 16; float xf[32]; float am = 0.f, sq = 0.f;
#pragma unroll
    for (int hh = 0; hh < 2; ++hh)
#pragma unroll
        for (int q = 0; q < 2; ++q) { const v4u w = *(const v4u*)(xr + hh * 1024 + q * 8); float t8[8]; unpack8(w, t8);
            const f32x4 g0 = *(const f32x4*)(F.in[I_G2N] + hh * 1024 + lane * 16 + q * 8), g1 = *(const f32x4*)(F.in[I_G2N] + hh * 1024 + lane * 16 + q * 8 + 4);
#pragma unroll
            for (int e = 0; e < 8; ++e) { const float xg = t8[e] * (e < 4 ? g0[e & 3] : g1[e & 3]); xf[hh * 16 + q * 8 + e] = xg; am = fmaxf(am, fabsf(xg)); sq += t8[e] * t8[e]; } }
#pragma unroll
    for (int o = 1; o < 64; o <<= 1) am = fmaxf(am, __shfl_xor(am, o));
    sq = wave_sum(sq);
    const float qs = am > 0.f ? 127.0f / am : 0.f;
    if (lane == 0) { WSP(float, WS_SX)[tok] = am * (1.0f / 127.0f); WSP(float, WS_SSQ2)[tok] = sq; }
#pragma unroll
    for (int hh = 0; hh < 2; ++hh) { v4u o;
#pragma unroll
        for (int d = 0; d < 4; ++d) { unsigned w = 0u;
#pragma unroll
            for (int e = 0; e < 4; ++e) { const int qi = (int)rintf(xf[hh * 16 + d * 4 + e] * qs); w |= ((unsigned)qi & 0xFFu) << (8 * e); }
            o[d] = w; }
        *(v4u*)(WSP(unsigned char, WS_XQ) + (size_t)tok * D + hh * 1024 + lane * 16) = o; }
}
struct PeerIds { int a, b; };
__device__ __forceinline__ PeerIds peer_ids_load(const Frame& F, int tok, int lane) { const int* ep = WSP(int, WS_EXP) + (size_t)tok * NSEL; PeerIds r; r.a = ep[lane]; r.b = ep[64 + lane]; return r; }
struct PeerScoreBuf { v4u w[16]; v4u xs; };
__device__ __forceinline__ void peer_score_issue(const Frame& F, int tok, int slice, int lane, LAS int* wl, const PeerIds& id, PeerScoreBuf& B) {
    const int e8 = lane >> 3, c16 = lane & 7;
    wl[lane] = id.a; wl[64 + lane] = id.b;
    B.xs = *(const v4u*)(WSP(unsigned char, WS_XQ) + (size_t)tok * D + slice * 128 + c16 * 16);
    const unsigned char* ub = WSP(unsigned char, WS_UT); const unsigned lo = (unsigned)(slice * 128 + c16 * 16);
#pragma unroll
    for (int ld = 0; ld < 16; ++ld) { const unsigned eid = (unsigned)wl[e8 * 16 + ld]; B.w[ld] = *(const v4u*)(ub + (eid * 2048u + lo)); }
}
__device__ __forceinline__ void peer_score_consume(const Frame& F, int tok, int slice, int lane, const PeerScoreBuf& B, bool valid) {
    int p[16];
#pragma unroll
    for (int ld = 0; ld < 16; ++ld) { const v4u w = B.w[ld]; int a = dot4i(w.x, B.xs.x, 0); a = dot4i(w.y, B.xs.y, a); a = dot4i(w.z, B.xs.z, a); p[ld] = dot4i(w.w, B.xs.w, a); }
    { const bool up = (lane & 4) != 0;
#pragma unroll
      for (int k = 0; k < 8; ++k) { const int keep = up ? p[k + 8] : p[k], send = up ? p[k] : p[k + 8]; p[k] = keep + dppi<0x141>(send); } }
    { const bool up = (lane & 2) != 0;
#pragma unroll
      for (int k = 0; k < 4; ++k) { const int keep = up ? p[k + 4] : p[k], send = up ? p[k] : p[k + 4]; p[k] = keep + dppi<0x4E>(send); } }
    { const bool up = (lane & 1) != 0;
#pragma unroll
      for (int k = 0; k < 2; ++k) { const int keep = up ? p[k + 2] : p[k], send = up ? p[k] : p[k + 2]; p[k] = keep + dppi<0xB1>(send); } }
    if (valid) { int* dst = WSP(int, WS_PART) + ((size_t)slice * T + tok) * NSEL + lane * 2; *(int2*)dst = make_int2(p[0], p[1]); }
}
__device__ __forceinline__ void peer_score_phase(const Frame& F, const PeerGeom& pg, LAS int* wl2) {
    const int lane = F.lane, first = pg.rank * NWAVES + F.wave, step = pg.nrank * NWAVES, n = first < T ? (T - first + step - 1) / step : 0;
    LAS int* wlA = wl2; LAS int* wlB = wl2 + 256;
#define PEER_TOKC(k_) ((first + (k_) * step) < T ? (first + (k_) * step) : T - 1)
    for (int r = 0; r < 16 / pg.ngrp; ++r) { const int slice = r * pg.ngrp + pg.g;
        PeerScoreBuf A, B; PeerIds id = peer_ids_load(F, PEER_TOKC(0), lane);
        { const PeerIds cur = id; id = peer_ids_load(F, PEER_TOKC(1), lane); asm volatile("" ::: "memory"); peer_score_issue(F, PEER_TOKC(0), slice, lane, wlA, cur, A); }
        for (int i = 0; i < n; i += 2) {
            { const PeerIds cur = id; id = peer_ids_load(F, PEER_TOKC(i + 2), lane); asm volatile("" ::: "memory"); peer_score_issue(F, PEER_TOKC(i + 1), slice, lane, wlB, cur, B); }
            peer_score_consume(F, first + i * step, slice, lane, A, true);
            { const PeerIds cur = id; id = peer_ids_load(F, PEER_TOKC(i + 3), lane); asm volatile("" ::: "memory"); peer_score_issue(F, PEER_TOKC(i + 2), slice, lane, wlA, cur, A); }
            peer_score_consume(F, first + (i + 1) * step, slice, lane, B, i + 1 < n);
        }
    }
}
__device__ __forceinline__ void peer_coef_token(const Frame& F, int tok, int lane) {
    int s0 = 0, s1 = 0;
#pragma unroll
    for (int s = 0; s < 16; ++s) { const int2 v = *(const int2*)(WSP(int, WS_PART) + ((size_t)s * T + tok) * NSEL + lane * 2); s0 += v.x; s1 += v.y; }
    const int2 ex = *(const int2*)(WSP(int, WS_EXP) + (size_t)tok * NSEL + lane * 2); const f32x2 ga = *(const f32x2*)(WSP(float, WS_GATE) + (size_t)tok * NSEL + lane * 2);
    const float rs = WSP(float, WS_SX)[tok] * (1.0f / sqrtf(WSP(float, WS_SSQ2)[tok] * (1.0f / D) + NORM_EPS));
    const float sc0 = (float)s0 * WSP(float, WS_USC)[ex.x] * rs, sc1 = (float)s1 * WSP(float, WS_USC)[ex.y] * rs;
    f32x2 c; c.x = ga.x * gelu_fast(sc0) * WSP(float, WS_VSC)[ex.x]; c.y = ga.y * gelu_fast(sc1) * WSP(float, WS_VSC)[ex.y];
    float cm = fmaxf(fabsf(c.x), fabsf(c.y));
#pragma unroll
    for (int o = 1; o < 64; o <<= 1) cm = fmaxf(cm, __shfl_xor(cm, o));
    const float qs = cm > 0.f ? 127.0f / cm : 0.f;
    const int q0 = (int)rintf(c.x * qs), q1 = (int)rintf(c.y * qs);
    ((unsigned short*)(F.ws + WS_COEF))[(size_t)tok * 64 + lane] = (unsigned short)(((unsigned)q0 & 0xFFu) | (((unsigned)q1 & 0xFFu) << 8));
    if (lane == 0) WSP(float, WS_CSC)[tok] = cm * (1.0f / 127.0f);
}
struct PeerOutBuf { v4u w[16]; v4u cq; unsigned x; float cs; };
__device__ __forceinline__ void peer_out_issue(const Frame& F, int tok, int slice, int lane, LAS int* wl, const PeerIds& id, PeerOutBuf& B) {
    const int e8 = lane >> 3, c16 = lane & 7;
    wl[lane] = id.a; wl[64 + lane] = id.b;
    B.cq = *(const v4u*)(F.ws + WS_COEF + (size_t)tok * 128 + e8 * 16);
    B.cs = WSP(float, WS_CSC)[tok];
    const unsigned char* vb = WSP(unsigned char, WS_VT); const unsigned lofs = (unsigned)(slice * 128 + c16 * 16);
#pragma unroll
    for (int ld = 0; ld < 16; ++ld) { const unsigned eid = (unsigned)wl[e8 * 16 + ld]; B.w[ld] = *(const v4u*)(vb + (eid * 2048u + lofs)); }
    B.x = *(const unsigned*)(WSP(bf16, WS_XB) + (size_t)tok * D + slice * 128 + c16 * 16 + e8 * 2);
}
__device__ __forceinline__ void peer_out_consume(const Frame& F, int tok, int slice, int lane, const PeerOutBuf& B, bool valid) {
    const int e8 = lane >> 3, c16 = lane & 7;
    int o[16];
#pragma unroll
    for (int i = 0; i < 16; ++i) o[i] = 0;
#pragma unroll
    for (int g = 0; g < 4; ++g) { const unsigned cq = B.cq[g];
#pragma unroll
        for (int d = 0; d < 4; ++d) { const unsigned w0 = B.w[4 * g][d], w1 = B.w[4 * g + 1][d], w2 = B.w[4 * g + 2][d], w3 = B.w[4 * g + 3][d];
            const unsigned lo01 = __builtin_amdgcn_perm(w1, w0, 0x05010400u), hi01 = __builtin_amdgcn_perm(w1, w0, 0x07030602u);
            const unsigned lo23 = __builtin_amdgcn_perm(w3, w2, 0x05010400u), hi23 = __builtin_amdgcn_perm(w3, w2, 0x07030602u);
            const unsigned t0 = __builtin_amdgcn_perm(lo23, lo01, 0x05040100u), t1 = __builtin_amdgcn_perm(lo23, lo01, 0x07060302u);
            const unsigned t2 = __builtin_amdgcn_perm(hi23, hi01, 0x05040100u), t3 = __builtin_amdgcn_perm(hi23, hi01, 0x07060302u);
            o[d * 4 + 0] = dot4i(t0, cq, o[d * 4 + 0]); o[d * 4 + 1] = dot4i(t1, cq, o[d * 4 + 1]); o[d * 4 + 2] = dot4i(t2, cq, o[d * 4 + 2]); o[d * 4 + 3] = dot4i(t3, cq, o[d * 4 + 3]); } }
#pragma unroll
    for (int k = 0; k < 8; ++k) { auto s = __builtin_amdgcn_permlane32_swap((unsigned)o[k], (unsigned)o[k + 8], false, false); o[k] = (int)(s[0] + s[1]); }
#pragma unroll
    for (int k = 0; k < 4; ++k) { auto s = __builtin_amdgcn_permlane16_swap((unsigned)o[k], (unsigned)o[k + 4], false, false); o[k] = (int)(s[0] + s[1]); }
    { const bool up = (lane & 8) != 0;
#pragma unroll
      for (int k = 0; k < 2; ++k) { const int keep = up ? o[k + 2] : o[k], send = up ? o[k] : o[k + 2]; o[k] = keep + dppi<0x128>(send); } }
    const float x0 = bf_lo(B.x) + (float)o[0] * B.cs, x1 = bf_hi(B.x) + (float)o[1] * B.cs;
    if (valid) *(unsigned*)(WSP(bf16, WS_XB) + (size_t)tok * D + slice * 128 + c16 * 16 + e8 * 2) = cvtpk(x0, x1);
}
__device__ __forceinline__ void peer_out_phase(const Frame& F, const PeerGeom& pg, LAS int* wl2) {
    const int lane = F.lane, first = pg.rank * NWAVES + F.wave, step = pg.nrank * NWAVES, n = first < T ? (T - first + step - 1) / step : 0;
    LAS int* wlA = wl2; LAS int* wlB = wl2 + 256;
    for (int r = 0; r < 16 / pg.ngrp; ++r) { const int slice = r * pg.ngrp + pg.g;
        PeerOutBuf A, B; PeerIds id = peer_ids_load(F, PEER_TOKC(0), lane);
        { const PeerIds cur = id; id = peer_ids_load(F, PEER_TOKC(1), lane); asm volatile("" ::: "memory"); peer_out_issue(F, PEER_TOKC(0), slice, lane, wlA, cur, A); }
        for (int i = 0; i < n; i += 2) {
            { const PeerIds cur = id; id = peer_ids_load(F, PEER_TOKC(i + 2), lane); asm volatile("" ::: "memory"); peer_out_issue(F, PEER_TOKC(i + 1), slice, lane, wlB, cur, B); }
            peer_out_consume(F, first + i * step, slice, lane, A, true);
            { const PeerIds cur = id; id = peer_ids_load(F, PEER_TOKC(i + 3), lane); asm volatile("" ::: "memory"); peer_out_issue(F, PEER_TOKC(i + 2), slice, lane, wlA, cur, A); }
            peer_out_consume(F, first + (i + 1) * step, slice, lane, B, i + 1 < n);
        }
    }
}
#undef PEER_TOKC
__device__ __forceinline__ void final_norm_phase(const Frame& F) {
    const int lane = F.lane, gw = F.bid * NWAVES + F.wave, NGW = F.G * NWAVES;
    const f32x4* gf = (const f32x4*)F.in[I_GF] + lane;
    f32x4 g[8];
#pragma unroll
    for (int j = 0; j < 8; ++j) g[j] = gf[64 * j];
    if (gw >= T) return;
    v2u va[8], vb[8]; float sa, sb;
#define FN_LOAD(v_, s_, tok_) do { const int tc_ = (tok_) < T ? (tok_) : T - 1; const v2u* xi_ = (const v2u*)(WSP(bf16, WS_XB) + (size_t)tc_ * D) + lane; \
        _Pragma("unroll") for (int j_ = 0; j_ < 8; ++j_) v_[j_] = xi_[64 * j_]; } while (0)
#define FN_STORE(v_, s_, tok_) do { f32x4* xo_ = (f32x4*)(F.out + (size_t)(tok_) * D) + lane; s_ = 0.f; f32x4 f_[8]; \
        _Pragma("unroll") for (int j_ = 0; j_ < 8; ++j_) { f_[j_] = (f32x4){bf_lo(v_[j_].x), bf_hi(v_[j_].x), bf_lo(v_[j_].y), bf_hi(v_[j_].y)}; s_ += (f_[j_][0] * f_[j_][0] + f_[j_][1] * f_[j_][1]) + (f_[j_][2] * f_[j_][2] + f_[j_][3] * f_[j_][3]); } \
        s_ = wave_sum(s_); const float rs_ = 1.0f / sqrtf(s_ * (1.0f / D) + NORM_EPS); \
        _Pragma("unroll") for (int j_ = 0; j_ < 8; ++j_) xo_[64 * j_] = f_[j_] * rs_ * g[j_]; } while (0)
    FN_LOAD(va, sa, gw);
    for (int tok = gw; tok < T; tok += 2 * NGW) {
        FN_LOAD(vb, sb, tok + NGW);
        FN_STORE(va, sa, tok);
        FN_LOAD(va, sa, tok + 2 * NGW);
        if (tok + NGW < T) FN_STORE(vb, sb, tok + NGW);
    }
#undef FN_LOAD
#undef FN_STORE
}

struct Args { const float* in[28]; float* out; unsigned char* ws; int ph_lo, ph_hi, li, pad; };
__global__ void __launch_bounds__(NTHR, 2) hybrid_fwd(Args args) {
    extern __shared__ __attribute__((aligned(16))) unsigned char lds[];
    Frame F;
    F.lds = (LAS unsigned char*)lds;
    F.tid = threadIdx.x; F.lane = F.tid & 63; F.wave = __builtin_amdgcn_readfirstlane(F.tid >> 6);
    F.G = gridDim.x; F.bid = blockIdx.x;
#pragma unroll
    for (int i = 0; i < 28; ++i) F.in[i] = args.in[i];
    F.out = args.out; F.ws = args.ws;
    volatile LAS unsigned* MISC = (volatile LAS unsigned*)(F.lds + MISC_OFF);
    for (int u = F.tid; u < (LDS_BYTES - LDSCTL_OFF) / 4; u += NTHR) ((LAS unsigned*)(F.lds + LDSCTL_OFF))[u] = 0u;
    __syncthreads();
    unsigned* barw = (unsigned*)(F.ws + WS_CTL) + CW_BAR;
    XcdBarrier bar; bar.bar = barw; bar.x = 0; bar.st = nullptr;
    if (N_LAUNCHES == 1) bar = xcd_barrier_post(barw, MISC + 8);
    const int lo = args.ph_lo, hi = args.ph_hi;
#define IN(k) (lo <= (k) && (k) < hi)
#define SEAM(k) do { if (IN(k) && IN((k) + 1)) xcd_barrier(bar); } while (0)

#ifndef PROBE_DUP
#define PROBE_DUP -1
#endif
#define REPS(k) for (int rep_ = 0; rep_ < ((PROBE_DUP) == (k) ? 2 : 1); ++rep_)
    if (IN(0)) REPS(0) { p0_prologue<0>(F, F.bid, F.G); __syncthreads(); }
    SEAM(0);
    if (IN(1)) REPS(1) {
        pg8::Gemm g{WSP(const bf16, WS_XB), WSP(const bf16, WS_WIN), T, NINP, D / 2}; pg8::StaticOrder S; S.init(T, NINP, F.G, F.bid);
        pg8::EpiI8RowColBf16<0> E{WSP(bf16, WS_PROJ), NINP, WSP(const float, WS_RSTD1), WSP(const float, WS_CS1), nullptr, NORM_EPS};
        pg8::gemm_phase<pg8::EpiI8RowColBf16<0>, pg8::StaticOrder, true, true, true>(F.lds, g, S, E);
    }
    SEAM(1);
    if (IN(2)) REPS(2) {
        lora_prepass(F);
        group_barrier((unsigned*)(F.ws + WS_CTL) + CW_PREBAR, (unsigned)F.G);
        for (int r4 = 0; r4 < ((PROBE_DUP) == 70 ? 2 : 1); ++r4) rwkv_prep_phase(F);
        group_barrier((unsigned*)(F.ws + WS_CTL) + CW_PREPBAR, (unsigned)F.G);
        const int R1 = F.G >= 256 ? 128 : F.G, L0 = F.G >= 256 ? 128 : 0, NL = F.G - L0;
        if (F.bid < R1) for (int it = F.bid; it < 128; it += R1) rwkv_item(F, it);
        if (F.bid >= L0) for (int it = F.bid - L0; it < 128; it += NL) lru_seq(F, it);
        { volatile LAS int* qslot = (volatile LAS int*)(F.lds + LDSCTL_OFF + 1024);
          for (;;) { __syncthreads(); if (F.tid == 0) *qslot = (int)xb_add((unsigned*)(F.ws + WS_CTL) + CW_DEFQ, 1u); __syncthreads();
              const int vb = *qslot; if (vb >= DEF_SLICES) break; p0_prologue<1>(F, vb, DEF_SLICES); } }
    }
    SEAM(2);
    if (IN(3)) {
        pg8::Gemm g{WSP(const bf16, WS_Y), WSP(const bf16, WS_WOUT), T, D, D}; pg8::StaticOrder S; S.init(T, D, F.G, F.bid);
        pg8::EpiResidual E{F.in[I_X], WSP(bf16, WS_XB), D};
        pg8::gemm_phase<pg8::EpiResidual, pg8::StaticOrder, true, true>(F.lds, g, S, E);
    }
    SEAM(3);
    if (IN(4)) { const int gw = F.bid * NWAVES + F.wave, NGW = F.G * NWAVES;
        for (int tok = gw; tok < T; tok += NGW) xquant_token(F, tok, F.lane); }
    SEAM(4);
    if (IN(5)) REPS(5) {
        pg8::Gemm g{WSP(const bf16, WS_XQ), WSP(const bf16, WS_WQ), T, D, D / 2}; pg8::StaticOrder S; S.init(T, D, F.G, F.bid);
        pg8::EpiI8RowColBf16<1> E{WSP(bf16, WS_Q), D, WSP(const float, WS_SX), WSP(const float, WS_CSQ), WSP(const float, WS_SSQ2), NORM_EPS};
        pg8::gemm_phase<pg8::EpiI8RowColBf16<1>, pg8::StaticOrder, true, true, true>(F.lds, g, S, E);
    }
    if (IN(5)) { __syncthreads();
        pg8::StaticOrder S; S.init(T, D, F.G, F.bid); pg8::Unit u;
        for (int i = 0; S.next(i, u); ++i) route_item(F, ((u.pm * 8 + F.wave) << 3) | u.pn, F.lane); }
    SEAM(5);
    { const PeerGeom pg = peer_geom(F); LAS int* wl = (LAS int*)(F.lds + F.wave * 1024);
      if (IN(6)) REPS(6) peer_score_phase(F, pg, (LAS int*)(F.lds + 16384 + F.wave * 2048));
      SEAM(6);
      if (IN(7)) REPS(7) { const int gw = F.bid * NWAVES + F.wave, NGW = F.G * NWAVES; for (int tok = gw; tok < T; tok += NGW) peer_coef_token(F, tok, F.lane); }
      SEAM(7);
      if (IN(8)) peer_out_phase(F, pg, (LAS int*)(F.lds + 16384 + F.wave * 2048));
      SEAM(8);
      if (IN(9)) final_norm_phase(F); }
#undef IN
#undef SEAM
}

extern "C" void kernel_launch(void* const* d_in, const int* in_sizes, int n_in, void* d_out, int out_size, void* d_ws, size_t ws_size, hipStream_t stream) {
    static int grid = 0;
    if (grid == 0) {
        if (n_in != 28 || in_sizes[0] != T * D || out_size != T * D || ws_size < WS_END) { fprintf(stderr, "kernel_launch: shape/workspace mismatch: n_in %d in0 %d out %d ws %zu (need %zu)\n", n_in, n_in > 0 ? in_sizes[0] : -1, out_size, ws_size, (size_t)WS_END); grid = -1; return; }
        int dev = 0, cus = 0, per_cu = 0;
        if (hipGetDevice(&dev) != hipSuccess || hipDeviceGetAttribute(&cus, hipDeviceAttributeMultiprocessorCount, dev) != hipSuccess) { fprintf(stderr, "kernel_launch: device query failed\n"); grid = -1; return; }
        if (hipFuncSetAttribute((const void*)hybrid_fwd, hipFuncAttributeMaxDynamicSharedMemorySize, LDS_BYTES) != hipSuccess) { fprintf(stderr, "kernel_launch: hipFuncSetAttribute failed\n"); grid = -1; return; }
        if (hipOccupancyMaxActiveBlocksPerMultiprocessor(&per_cu, (const void*)hybrid_fwd, NTHR, LDS_BYTES) != hipSuccess || per_cu < 1) { fprintf(stderr, "kernel_launch: occupancy query says %d blocks per CU\n", per_cu); per_cu = 1; }
        (void)hipGetLastError();
        grid = cus;
    }
    if (grid < 0) return;
    if (hipMemsetAsync((char*)d_ws + WS_CTL, 0, CTL_ZERO_BYTES, stream) != hipSuccess) { fprintf(stderr, "kernel_launch: hipMemsetAsync failed\n"); return; }
    Args a{};
    for (int i = 0; i < 28; ++i) a.in[i] = (const float*)d_in[i];
    a.out = (float*)d_out; a.ws = (unsigned char*)d_ws;
    for (int li = 0; li < N_LAUNCHES; ++li) {
        a.ph_lo = (N_LAUNCHES == 1) ? 0 : li; a.ph_hi = (N_LAUNCHES == 1) ? N_PHASES : li + 1; a.li = li;
        hipLaunchKernelGGL(hybrid_fwd, dim3(grid), dim3(NTHR), LDS_BYTES, stream, a);
        const hipError_t le = hipPeekAtLastError();
        if (le != hipSuccess) { fprintf(stderr, "kernel_launch: launch %d failed: %s\n", li, hipGetErrorName(le)); break; }
    }
}
```

```cpp
#include <hip/hip_runtime.h>
#include <cstdio>
#include <cstdint>
namespace pg8 {
#define PG8_LAS __attribute__((address_space(3)))
typedef unsigned short bf16_t;
typedef short bf16x8 __attribute__((ext_vector_type(8)));
typedef float f32x4 __attribute__((ext_vector_type(4)));
typedef unsigned u32x4 __attribute__((ext_vector_type(4)));
typedef int i32x4 __attribute__((ext_vector_type(4)));
constexpr int BM = 256, BK = 64, HALF = 128, HTB = HALF * BK * 2  , STAGE_BYTES = 8 * HTB, NXCD = 8, WGM = 8;

__host__ __device__ __forceinline__ int lds_byte(int r, int c) { const int st = (r >> 4) * 2 + (c >> 5), rr = r & 15, cc = c & 31, ob = rr * 64 + cc * 2; return st * 1024 + (ob ^ (((ob >> 9) & 1) << 5)); }
__host__ __device__ __forceinline__ void stage_rc(int b, int& R, int& C) { const int st = b / 1024, sb = b % 1024, swz = sb ^ (((sb >> 9) & 1) << 5); R = (st >> 1) * 16 + swz / 64; C = (st & 1) * 32 + (swz % 64) / 2; }
__host__ __device__ __forceinline__ int perm32(int rho) { const int n = rho >> 4, i = rho & 15; return 8 * (i >> 2) + 4 * n + (i & 3); }

struct Unit { int pm, pn; };
struct Gemm { const bf16_t* A; const bf16_t* Bt; int M, N, K; };

struct StaticOrder {
    int nM, nN, nwg, G, c;
    __host__ __device__ void init(int M, int N, int G_, int c_) { nM = M / BM; nN = N / BM; nwg = nM * nN; G = G_; c = c_; }
    __host__ __device__ bool next(int i, Unit& u) const {
        const long L = (long)i * G + c; if (L >= nwg) return false;
        int wgid = (int)L; { const int q = nwg / NXCD, r = nwg % NXCD, xcd = wgid % NXCD, off = wgid / NXCD; wgid = (xcd < r ? xcd * (q + 1) : r * (q + 1) + (xcd - r) * q) + off; }
        const int nig = WGM * nN, gid = wgid / nig, fm = gid * WGM, gsz = (nM - fm) < WGM ? (nM - fm) : WGM;
        u.pm = fm + ((wgid % nig) % gsz); u.pn = (wgid % nig) / gsz; return true;
    }
    __device__ __forceinline__ void a_ready(const Unit&) const {}
    __device__ __forceinline__ void done(const Unit&) const {}
};

__device__ __forceinline__ unsigned cvt_pk_bf16(float lo, float hi) { unsigned r; asm volatile("v_cvt_pk_bf16_f32 %0, %1, %2" : "=v"(r) : "v"(lo), "v"(hi)); return r; }
typedef float f32x2 __attribute__((ext_vector_type(2)));
typedef unsigned u32x2 __attribute__((ext_vector_type(2)));
template <int MODE> struct EpiRowScaleBf16 {
    static constexpr bool PERM = true, AFTER_DRAIN = false;
    bf16_t* O; int ldc; const float* rs; float eps;
    __device__ __forceinline__ void operator()(const f32x4 (&acc)[2][2][4][2], const Unit& u, int wr, int wc, int fr, int fq) const {
        const int row0 = u.pm * BM + wr * 64 + fr, col0 = u.pn * BM + wc * 32 + 8 * fq;
#pragma unroll
        for (int ai = 0; ai < 2; ++ai)
#pragma unroll
            for (int m = 0; m < 4; ++m) { const int r = row0 + ai * HALF + m * 16; float s = rs[r]; if (MODE == 1) s = 1.0f / sqrtf(s * (1.0f / 2048.0f) + eps);
                bf16_t* rowp = O + (size_t)r * ldc + col0;
#pragma unroll
                for (int bj = 0; bj < 2; ++bj) { const f32x4 v0 = acc[ai][bj][m][0] * s, v1 = acc[ai][bj][m][1] * s;
                    u32x4 w; w.x = cvt_pk_bf16(v0[0], v0[1]); w.y = cvt_pk_bf16(v0[2], v0[3]); w.z = cvt_pk_bf16(v1[0], v1[1]); w.w = cvt_pk_bf16(v1[2], v1[3]);
                    *(u32x4*)(rowp + bj * HALF) = w; } }
    }
};
template <int MODE> struct EpiI8RowColBf16 {
    static constexpr bool PERM = true, AFTER_DRAIN = false;
    bf16_t* O; int ldc; const float* rs; const float* cs; const float* ssq; float eps;
    __device__ __forceinline__ void operator()(const f32x4 (&acc)[2][2][4][2], const Unit& u, int wr, int wc, int fr, int fq) const {
        const int row0 = u.pm * BM + wr * 64 + fr, col0 = u.pn * BM + wc * 32 + 8 * fq;
        f32x4 c4[2][2];
#pragma unroll
        for (int bj = 0; bj < 2; ++bj) { c4[bj][0] = *(const f32x4*)(cs + col0 + bj * HALF); c4[bj][1] = *(const f32x4*)(cs + col0 + bj * HALF + 4); }
#pragma unroll
        for (int ai = 0; ai < 2; ++ai)
#pragma unroll
            for (int m = 0; m < 4; ++m) { const int r = row0 + ai * HALF + m * 16; float s = rs[r]; if (MODE == 1) s = s / sqrtf(ssq[r] * (1.0f / 2048.0f) + eps);
                bf16_t* rowp = O + (size_t)r * ldc + col0;
#pragma unroll
                for (int bj = 0; bj < 2; ++bj) { f32x4 v0, v1; const i32x4 i0 = __builtin_bit_cast(i32x4, acc[ai][bj][m][0]), i1 = __builtin_bit_cast(i32x4, acc[ai][bj][m][1]);
#pragma unroll
                    for (int e = 0; e < 4; ++e) { v0[e] = (float)i0[e] * s * c4[bj][0][e]; v1[e] = (float)i1[e] * s * c4[bj][1][e]; }
                    u32x4 w; w.x = cvt_pk_bf16(v0[0], v0[1]); w.y = cvt_pk_bf16(v0[2], v0[3]); w.z = cvt_pk_bf16(v1[0], v1[1]); w.w = cvt_pk_bf16(v1[2], v1[3]);
                    *(u32x4*)(rowp + bj * HALF) = w; } }
    }
};
struct EpiResidual {
    static constexpr bool PERM = false, AFTER_DRAIN = false;
    const float* base; bf16_t* outb; int ldc;
    __device__ __forceinline__ void operator()(const f32x4 (&acc)[2][2][4][2], const Unit& u, int wr, int wc, int fr, int fq) const {
        const int row0 = u.pm * BM + wr * 64 + fr, col0 = u.pn * BM + wc * 32 + 4 * fq;
#pragma unroll
        for (int ai = 0; ai < 2; ++ai)
#pragma unroll
            for (int m = 0; m < 4; ++m) { const int r = row0 + ai * HALF + m * 16; const size_t off = (size_t)r * ldc + col0;
#pragma unroll
                for (int bj = 0; bj < 2; ++bj)
#pragma unroll
                    for (int n = 0; n < 2; ++n) { const f32x4 bs = *(const f32x4*)(base + off + bj * HALF + n * 16); const f32x4 o = bs + acc[ai][bj][m][n];
                        u32x2 w; w.x = cvt_pk_bf16(o[0], o[1]); w.y = cvt_pk_bf16(o[2], o[3]); *(u32x2*)(outb + off + bj * HALF + n * 16) = w; } }
    }
};
template <class Epi, class Sched, bool ALIGN_EPI = false, bool SP2 = false, bool I8 = false>
__device__ __forceinline__ void gemm_phase(PG8_LAS unsigned char* lds, const Gemm g, const Sched& S, const Epi& E) {
    const int tid = threadIdx.x, wid = __builtin_amdgcn_readfirstlane(tid >> 6), lane = tid & 63, wr = wid >> 2, wc = wid & 3, fr = lane & 15, fq = lane >> 4;
    const int K = g.K, nt = K / BK;
    unsigned voffA[2], voffB[2];
#pragma unroll
    for (int i = 0; i < 2; ++i) { int R, C; stage_rc(tid * 16 + i * 8192, R, C); const int Rb = Epi::PERM ? ((R & ~31) + perm32(R & 31)) : R;
        voffA[i] = (unsigned)(R * K + C) * 2u; voffB[i] = (unsigned)(Rb * K + C) * 2u; }
    const size_t kstep = (size_t)(BK * 2);
    const size_t hstep = (size_t)HALF * K * 2;
    const size_t tstep = 2 * hstep;
    const unsigned ldsw = (unsigned)wid * 1024u;
    const int aoff = lds_byte(wr * 64 + fr, fq * 8), boff = lds_byte(wc * 32 + fr, fq * 8);
#define PG8_SA(b, h) (((b) * 2 + (h)) * HTB)
#define PG8_SB(b, h) ((4 + (b) * 2 + (h)) * HTB)
#define PG8_STAGE(bufoff, gbase, voff) do { _Pragma("unroll") for (int _i = 0; _i < 2; ++_i) \
        __builtin_amdgcn_global_load_lds((const unsigned*)((const char*)(gbase) + (voff)[_i]), (PG8_LAS unsigned*)(lds + (bufoff) + ldsw + _i * 8192), 16, 0, 0); } while (0)
#define PG8_LDA(dst, b, h) do { _Pragma("unroll") for (int m = 0; m < 4; ++m) _Pragma("unroll") for (int k = 0; k < 2; ++k) dst[m][k] = *(const PG8_LAS bf16x8*)(lds + PG8_SA(b, h) + aoff + m * 2048 + k * 1024); } while (0)
#define PG8_LDB(dst, b, h) do { _Pragma("unroll") for (int n = 0; n < 2; ++n) _Pragma("unroll") for (int k = 0; k < 2; ++k) dst[n][k] = *(const PG8_LAS bf16x8*)(lds + PG8_SB(b, h) + boff + n * 2048 + k * 1024); } while (0)
#define PG8_MMA(ai, bj, At, Bt) do { __builtin_amdgcn_s_setprio(1); _Pragma("unroll") for (int m = 0; m < 4; ++m) _Pragma("unroll") for (int n = 0; n < 2; ++n) _Pragma("unroll") for (int k = 0; k < 2; ++k) \
        { if constexpr (I8) acc[ai][bj][m][n] = __builtin_bit_cast(f32x4, __builtin_amdgcn_mfma_i32_16x16x64_i8(__builtin_bit_cast(i32x4, Bt[n][k]), __builtin_bit_cast(i32x4, At[m][k]), __builtin_bit_cast(i32x4, acc[ai][bj][m][n]), 0, 0, 0)); \
          else acc[ai][bj][m][n] = __builtin_amdgcn_mfma_f32_16x16x32_bf16(Bt[n][k], At[m][k], acc[ai][bj][m][n], 0, 0, 0); } __builtin_amdgcn_s_setprio(0); } while (0)
#define PG8_WAIT_V(n) asm volatile("s_waitcnt vmcnt(" #n ")" ::: "memory")
#define PG8_WAIT_L(n) asm volatile("s_waitcnt lgkmcnt(" #n ")" ::: "memory")
#define PG8_BAR __builtin_amdgcn_s_barrier()
#define PG8_SCHED __builtin_amdgcn_sched_barrier(0)
    Unit cur, nxt; int ui = 0;
    if (!S.next(0, cur)) return;
    f32x4 acc[2][2][4][2];
#pragma unroll
    for (int a = 0; a < 2; ++a)
#pragma unroll
        for (int b = 0; b < 2; ++b)
#pragma unroll
            for (int m = 0; m < 4; ++m)
#pragma unroll
                for (int n = 0; n < 2; ++n) acc[a][b][m][n] = (f32x4){0.f, 0.f, 0.f, 0.f};
    bf16x8 At[4][2], B0[2][2], B1[2][2];
    const char* cA = (const char*)g.A + (size_t)cur.pm * tstep; const char* cB = (const char*)g.Bt + (size_t)cur.pn * tstep;
    S.a_ready(cur);
    if constexpr (SP2) {
        PG8_STAGE(PG8_SB(0, 0), cB, voffB); PG8_STAGE(PG8_SB(0, 1), cB + hstep, voffB); PG8_STAGE(PG8_SA(0, 0), cA, voffA); PG8_STAGE(PG8_SA(0, 1), cA + hstep, voffA);
        if (wr == 1) PG8_BAR;
        PG8_WAIT_V(2); PG8_BAR;
        PG8_STAGE(PG8_SB(1, 0), cB + kstep, voffB); PG8_STAGE(PG8_SA(1, 0), cA + kstep, voffA); PG8_STAGE(PG8_SB(1, 1), cB + hstep + kstep, voffB);
        PG8_WAIT_V(6); PG8_BAR;
    } else {
        PG8_STAGE(PG8_SB(0, 0), cB, voffB); PG8_STAGE(PG8_SA(0, 0), cA, voffA); PG8_STAGE(PG8_SB(0, 1), cB + hstep, voffB); PG8_STAGE(PG8_SA(0, 1), cA + hstep, voffA);
        if (wr == 1) PG8_BAR;
        PG8_WAIT_V(4); PG8_BAR;
        PG8_STAGE(PG8_SB(1, 0), cB + kstep, voffB); PG8_STAGE(PG8_SA(1, 0), cA + kstep, voffA); PG8_STAGE(PG8_SB(1, 1), cB + hstep + kstep, voffB);
        PG8_WAIT_V(6); PG8_BAR;
    }
    for (;;) {
        const bool has_next = S.next(ui + 1, nxt);
        const char* nA = has_next ? (const char*)g.A + (size_t)nxt.pm * tstep : cA; const char* nB = has_next ? (const char*)g.Bt + (size_t)nxt.pn * tstep : cB;
        for (int t = 0; t < nt; t += 2) {
            const bool last = (t == nt - 2);
            const char* a1 = cA + (size_t)(t + 1) * kstep;
            const char* a2 = last ? nA : cA + (size_t)(t + 2) * kstep; const char* b2 = last ? nB : cB + (size_t)(t + 2) * kstep;
            const char* a3 = a2 + kstep; const char* b3 = b2 + kstep;
            if (last && has_next) S.a_ready(nxt);
            if constexpr (SP2) {
            PG8_LDB(B0, 0, 0); PG8_LDB(B1, 0, 1); PG8_SCHED; PG8_LDA(At, 0, 0); PG8_STAGE(PG8_SA(1, 1), a1 + hstep, voffA);
            PG8_WAIT_V(8); PG8_WAIT_L(0); PG8_BAR; PG8_MMA(0, 0, At, B0); PG8_MMA(0, 1, At, B1); PG8_BAR; PG8_SCHED;
            PG8_LDA(At, 0, 1); PG8_STAGE(PG8_SB(0, 0), b2, voffB); PG8_STAGE(PG8_SB(0, 1), b2 + hstep, voffB); PG8_STAGE(PG8_SA(0, 0), a2, voffA);
            PG8_WAIT_V(8); PG8_WAIT_L(0); PG8_BAR; PG8_MMA(1, 0, At, B0); PG8_MMA(1, 1, At, B1); PG8_BAR; PG8_SCHED;
            PG8_LDB(B0, 1, 0); PG8_LDB(B1, 1, 1); PG8_SCHED; PG8_LDA(At, 1, 0); PG8_STAGE(PG8_SA(0, 1), a2 + hstep, voffA);
            PG8_WAIT_V(8); PG8_WAIT_L(0); PG8_BAR; PG8_MMA(0, 0, At, B0); PG8_MMA(0, 1, At, B1); PG8_BAR; PG8_SCHED;
            PG8_LDA(At, 1, 1); PG8_STAGE(PG8_SB(1, 0), b3, voffB); PG8_STAGE(PG8_SB(1, 1), b3 + hstep, voffB); PG8_STAGE(PG8_SA(1, 0), a3, voffA);
            PG8_WAIT_V(8); PG8_WAIT_L(0); PG8_BAR; PG8_MMA(1, 0, At, B0); PG8_MMA(1, 1, At, B1); PG8_BAR; PG8_SCHED;
            } else {
            PG8_LDB(B0, 0, 0); PG8_SCHED; PG8_LDA(At, 0, 0); PG8_STAGE(PG8_SA(1, 1), a1 + hstep, voffA);
            PG8_WAIT_L(8); PG8_BAR; PG8_WAIT_L(0); PG8_MMA(0, 0, At, B0); PG8_BAR; PG8_SCHED;
            PG8_LDB(B1, 0, 1); PG8_STAGE(PG8_SB(0, 0), b2, voffB);
            PG8_BAR; PG8_WAIT_L(0); PG8_MMA(0, 1, At, B1); PG8_BAR;
            PG8_LDA(At, 0, 1); PG8_STAGE(PG8_SA(0, 0), a2, voffA);
            PG8_BAR; PG8_WAIT_L(0); PG8_MMA(1, 0, At, B0); PG8_BAR; PG8_SCHED;
            PG8_STAGE(PG8_SB(0, 1), b2 + hstep, voffB);
            PG8_WAIT_V(6); PG8_BAR; PG8_MMA(1, 1, At, B1); PG8_BAR;
            PG8_LDB(B0, 1, 0); PG8_SCHED; PG8_LDA(At, 1, 0); PG8_STAGE(PG8_SA(0, 1), a2 + hstep, voffA);
            PG8_WAIT_L(8); PG8_BAR; PG8_WAIT_L(0); PG8_MMA(0, 0, At, B0); PG8_BAR; PG8_SCHED;
            PG8_LDB(B1, 1, 1); PG8_STAGE(PG8_SB(1, 0), b3, voffB);
            PG8_BAR; PG8_WAIT_L(0); PG8_MMA(0, 1, At, B1); PG8_BAR;
            PG8_LDA(At, 1, 1); PG8_STAGE(PG8_SA(1, 0), a3, voffA);
            PG8_BAR; PG8_WAIT_L(0); PG8_MMA(1, 0, At, B0); PG8_BAR; PG8_SCHED;
            PG8_STAGE(PG8_SB(1, 1), b3 + hstep, voffB);
            PG8_WAIT_V(6); PG8_BAR; PG8_MMA(1, 1, At, B1); PG8_BAR;
            }
        }
        if constexpr (ALIGN_EPI) { if (wr == 0) PG8_BAR; }
        if constexpr (!Epi::AFTER_DRAIN) { E(acc, cur, wr, wc, fr, fq); S.done(cur); }
        if (!has_next) break;
#pragma unroll
        for (int a = 0; a < 2; ++a)
#pragma unroll
            for (int b = 0; b < 2; ++b)
#pragma unroll
                for (int m = 0; m < 4; ++m)
#pragma unroll
                    for (int n = 0; n < 2; ++n) acc[a][b][m][n] = (f32x4){0.f, 0.f, 0.f, 0.f};
        cur = nxt; cA = nA; cB = nB; ++ui;
        if constexpr (ALIGN_EPI) { if (wr == 1) PG8_BAR; }
    }
    PG8_WAIT_V(0);
    if constexpr (!ALIGN_EPI) { if (wr == 0) PG8_BAR; }
    PG8_BAR;
    if constexpr (Epi::AFTER_DRAIN) { E.fused(acc, cur, wr, wc, fr, fq, lds, wid, lane); S.done(cur); }
#undef PG8_SA
#undef PG8_SB
#undef PG8_STAGE
#undef PG8_LDA
#undef PG8_LDB
#undef PG8_MMA
#undef PG8_WAIT_V
#undef PG8_WAIT_L
#undef PG8_BAR
#undef PG8_SCHED
}
}

#ifndef PROBE_DUP
#define PROBE_DUP -1
#endif
constexpr int NWAVES = 8, NTHR = NWAVES * 64;
#ifndef MK_N_LAUNCHES
#define MK_N_LAUNCHES 1
#endif
constexpr int N_PHASES = 10;
constexpr int DEF_SLICES = 256;
constexpr int N_LAUNCHES = MK_N_LAUNCHES;
static_assert(N_LAUNCHES == 1 || N_LAUNCHES == N_PHASES, "MK_N_LAUNCHES is 1 or N_PHASES");

constexpr int BATCH = 8, SEQ = 2048, T = BATCH * SEQ, D = 2048;
constexpr int NIN = 5408, NINP = 5632;
constexpr int PC_GATE = 1024, PC_R = 2048, PC_K = 3072, PC_V = 4096, PC_WD = 5120, PC_AD = 5184, PC_GD = 5248;
constexpr int RWKV_C0 = 2048;
constexpr int NEXP = 16384, NSEL = 128;
constexpr float NORM_EPS = 1e-6f, GN_EPS = 64e-5f;

constexpr size_t MiB = 1u << 20;
constexpr size_t WS_CTL = 0, CTL_ZERO_BYTES = 1 * MiB;
constexpr size_t WS_SSQ3 = 576 * 1024;
constexpr size_t WS_SSQ2 = 512 * 1024;
constexpr size_t WS_RSTD1 = 1 * MiB;
constexpr size_t WS_USC = 1 * MiB + 64 * 1024, WS_VSC = 1 * MiB + 128 * 1024;
constexpr size_t WS_SX = 1 * MiB + 192 * 1024;
constexpr size_t WS_CS1 = 1 * MiB + 256 * 1024;
constexpr size_t WS_CSQ = 1 * MiB + 288 * 1024;
constexpr size_t WS_WIN = 2 * MiB;
constexpr size_t WS_WOUT = 24 * MiB;
constexpr size_t WS_WQ = 32 * MiB;
constexpr size_t WS_KEYS = 40 * MiB;
constexpr size_t WS_W2T = WS_KEYS + 512 * 1024;
constexpr size_t WS_A2T = WS_W2T + 128 * 1024;
constexpr size_t WS_G2T = WS_A2T + 128 * 1024;
constexpr size_t WS_WAT = WS_G2T + 320 * 1024;
constexpr size_t WS_WIT = WS_WAT + 256 * 1024;
constexpr size_t WS_EXP = 42 * MiB;
constexpr size_t WS_GATE = 50 * MiB;
constexpr size_t WS_LA = 42 * MiB;
constexpr size_t WS_SUMM = 58 * MiB;
constexpr size_t WS_TA = 64 * MiB, WS_TB = 96 * MiB, WS_TK = 400 * MiB, WS_TR = 464 * MiB;
constexpr size_t OUT_TV = 0, OUT_TG = 32 * MiB, OUT_PC = 64 * MiB, OUT_BON = 66 * MiB;
constexpr size_t WS_XB = 64 * MiB;
constexpr size_t WS_PROJ = 128 * MiB;
constexpr size_t WS_Q = WS_PROJ;
constexpr size_t WS_PART = 192 * MiB;
constexpr size_t WS_XQ = 320 * MiB;
constexpr size_t WS_COEF = 352 * MiB;
constexpr size_t WS_CSC = 356 * MiB;
constexpr size_t WS_Y = 304 * MiB;
constexpr size_t WS_UT = 368 * MiB;
constexpr size_t WS_VT = 432 * MiB;
constexpr size_t WS_END = 496 * MiB;
static_assert(WS_WIT + 256 * 1024 <= WS_EXP && WS_PROJ + (size_t)T * NINP * 2 <= WS_Y && WS_WIN + (size_t)NINP * D * 2 <= WS_WOUT, "d_ws map");
constexpr int CW_DEFQ = 2240;
constexpr int CW_PREPBAR = 2176;
constexpr int CW_PREBAR = 2112;
constexpr int CW_LRUBAR = 2048;
constexpr int CW_BAR = 4096;

constexpr int RING_BYTES = 131072;
constexpr int LDSCTL_OFF = 143360, MISC_OFF = LDSCTL_OFF + 320;
constexpr int LDS_BYTES = 147456;

#define GAS __attribute__((address_space(1)))
#define LAS __attribute__((address_space(3)))
typedef unsigned short bf16;
typedef unsigned v4u __attribute__((ext_vector_type(4)));
typedef unsigned v2u __attribute__((ext_vector_type(2)));
typedef float f32x4 __attribute__((ext_vector_type(4)));
typedef float f32x16 __attribute__((ext_vector_type(16)));
typedef short bf16x8 __attribute__((ext_vector_type(8)));
typedef __bf16 bf16x2_t __attribute__((ext_vector_type(2)));
typedef GAS unsigned gu32;
#define RLX_AGENT __ATOMIC_RELAXED, __HIP_MEMORY_SCOPE_AGENT
__device__ __forceinline__ unsigned f2bf(float f) { unsigned u = __builtin_bit_cast(unsigned, f); return (u + 0x7fffu + ((u >> 16) & 1u)) >> 16; }
__device__ __forceinline__ unsigned pk2(float lo, float hi) { return f2bf(lo) | (f2bf(hi) << 16); }
__device__ __forceinline__ float bf_lo(unsigned w) { return __uint_as_float(w << 16); }
__device__ __forceinline__ float bf_hi(unsigned w) { return __uint_as_float(w & 0xffff0000u); }
__device__ __forceinline__ void unpack8(const v4u& w, float (&o)[8]) { o[0] = bf_lo(w.x); o[1] = bf_hi(w.x); o[2] = bf_lo(w.y); o[3] = bf_hi(w.y); o[4] = bf_lo(w.z); o[5] = bf_hi(w.z); o[6] = bf_lo(w.w); o[7] = bf_hi(w.w); }
__device__ __forceinline__ v4u pack8(const float (&o)[8]) { v4u w; w.x = pk2(o[0], o[1]); w.y = pk2(o[2], o[3]); w.z = pk2(o[4], o[5]); w.w = pk2(o[6], o[7]); return w; }
__device__ __forceinline__ float sigmoidf_(float x) { return 1.0f / (1.0f + __expf(-x)); }
__device__ __forceinline__ float softplusf_(float z) { return fmaxf(z, 0.f) + log1pf(__expf(-fabsf(z))); }
__device__ __forceinline__ float gelu_tanh(float x) { const float u = 0.7978845608028654f * (x + 0.044715f * x * x * x); return 0.5f * x * (1.0f + tanhf(u)); }
template <int CTRL> __device__ __forceinline__ float dppf(float x) { return __builtin_bit_cast(float, __builtin_amdgcn_mov_dpp(__builtin_bit_cast(int, x), CTRL, 0xf, 0xf, true)); }
__device__ __forceinline__ float red8(float v) { v += dppf<0xB1>(v); v += dppf<0x4E>(v); v += dppf<0x141>(v); return v; }
__device__ __forceinline__ float red16(float v) { v = red8(v); v += dppf<0x140>(v); return v; }
__device__ __forceinline__ float wave_sum(float v) {
#pragma unroll
    for (int o = 1; o < 64; o <<= 1) v += __shfl_xor(v, o);
    return v;
}
__device__ __forceinline__ float dot2bf(unsigned a, unsigned b, float acc) { return __builtin_amdgcn_fdot2_f32_bf16(__builtin_bit_cast(bf16x2_t, a), __builtin_bit_cast(bf16x2_t, b), acc, false); }
#define MFMA16(a, b, c) __builtin_amdgcn_mfma_f32_16x16x32_bf16((a), (b), (c), 0, 0, 0)
#define MFMA32(a, b, c) __builtin_amdgcn_mfma_f32_32x32x16_bf16((a), (b), (c), 0, 0, 0)

#define XB_TMO      128
#define XB_XCNT(j)  (256  + 64 * (j))
#define XB_XSUB(j)  (1280 + 64 * (j))
#define XB_XGEN(j)  (2304 + 64 * (j))
#define XB_TOP      3328
#define XB_TOPGEN   3392
#define XCD_BAR_WORDS 3456
#define XB_SPIN_CAP (1u << 22)
__device__ __forceinline__ unsigned xb_ld(unsigned* p)              { return __hip_atomic_load(p, __ATOMIC_RELAXED, __HIP_MEMORY_SCOPE_AGENT); }
__device__ __forceinline__ unsigned xb_add(unsigned* p, unsigned v) { return __hip_atomic_fetch_add(p, v, __ATOMIC_RELAXED, __HIP_MEMORY_SCOPE_AGENT); }
__device__ __forceinline__ unsigned xb_xcc_id() { return (unsigned)__builtin_amdgcn_s_getreg((3 << 11) | 20) & 0xFu; }
#define XB_SPIN(cond, bar) do { unsigned _sp = 0; while (cond) { __builtin_amdgcn_s_sleep(1); \
    if ((++_sp & 255u) == 0u) { if (xb_ld(&(bar)[XB_TMO])) break; if (_sp > XB_SPIN_CAP) { atomicAdd(&(bar)[XB_TMO], 1u); break; } } } } while (0)
struct XcdBarrier { unsigned* bar; unsigned x; volatile LAS unsigned* st; };
__device__ __forceinline__ XcdBarrier xcd_barrier_post(unsigned* bar, volatile LAS unsigned* st) {
    XcdBarrier b; b.bar = bar; b.x = xb_xcc_id(); b.st = st;
    if (threadIdx.x == 0) (void)xb_add(&bar[XB_XCNT(b.x)], 1u);
    return b;
}
__device__ __forceinline__ void xcd_barrier_complete(unsigned* bar, unsigned x, unsigned& nloc, unsigned& nx) {
    const unsigned G = gridDim.x * gridDim.y * gridDim.z;
    unsigned sum, cnt, mine, sp = 0u;
    for (;;) {
        sum = 0u; cnt = 0u; mine = 0u;
#pragma unroll
        for (unsigned j = 0; j < 16; ++j) { const unsigned c = xb_ld(&bar[XB_XCNT(j)]); sum += c; cnt += (c > 0u) ? 1u : 0u; mine = (j == x) ? c : mine; }
        if (sum == G) break;
        __builtin_amdgcn_s_sleep(1);
        if ((++sp & 255u) == 0u) { if (xb_ld(&bar[XB_TMO])) break; if (sp > XB_SPIN_CAP) { atomicAdd(&bar[XB_TMO], 1u); break; } }
    }
    nloc = mine > 0u ? mine : 1u; nx = cnt > 0u ? cnt : 1u;
}
__device__ __forceinline__ void xcd_barrier(const XcdBarrier& b) {
    asm volatile("s_waitcnt vmcnt(0)" ::: "memory");
    __syncthreads();
    if (threadIdx.x == 0) {
        unsigned* bar = b.bar;
        __builtin_amdgcn_s_waitcnt(0);
        unsigned nloc = b.st[0], nx = b.st[1];
        if (nloc == 0u) { xcd_barrier_complete(bar, b.x, nloc, nx); b.st[0] = nloc; b.st[1] = nx; }
        const unsigned old = xb_add(&bar[XB_XSUB(b.x)], 1u);
        const unsigned gen = old / nloc;
        if (old + 1u == (gen + 1u) * nloc) {
            __builtin_amdgcn_fence(__ATOMIC_RELEASE, "agent");
            asm volatile("s_waitcnt vmcnt(0)" ::: "memory");
            const unsigned og = xb_add(&bar[XB_TOP], 1u);
            const unsigned tg = og / nx;
            if (og + 1u == (tg + 1u) * nx) xb_add(&bar[XB_TOPGEN], 1u);
            else XB_SPIN(xb_ld(&bar[XB_TOPGEN]) == tg, bar);
            __builtin_amdgcn_fence(__ATOMIC_ACQUIRE, "agent");
            xb_add(&bar[XB_XGEN(b.x)], 1u);
            asm volatile("s_waitcnt vmcnt(0)" ::: "memory");
        } else {
            XB_SPIN(xb_ld(&bar[XB_XGEN(b.x)]) == gen, bar);
            __builtin_amdgcn_fence(__ATOMIC_ACQUIRE, "agent");
            asm volatile("s_waitcnt vmcnt(0)" ::: "memory");
        }
    }
    __syncthreads();
}

struct Frame {
    LAS unsigned char* lds;
    int tid, lane, wave, G, bid;
    const float* in[28];
    float* out;
    unsigned char* ws;
};
#define WSP(type, off) ((type*)(F.ws + (off)))
enum { I_X = 0, I_G1, I_WIN, I_CONVW, I_CONVB, I_WA, I_BA, I_WI, I_BI, I_LAM, I_MU, I_W0, I_W2, I_A0, I_A2, I_G2, I_KK, I_KA, I_RK, I_LNW, I_LNB, I_WOUT, I_G2N, I_WQ, I_KEYS, I_U, I_V, I_GF };

__device__ __forceinline__ void p0_transpose_item(const float* W, int K, int N, bf16* WT, const float* ksc, LAS float* scr, int item, int lane) {
    const int nblk = N / 32, kb = item / nblk, nb = item % nblk, k0 = 64 * kb, n0 = 32 * nb;
    const int lr = lane >> 3, c4 = (lane & 7) * 4;
    f32x4 v[8];
#pragma unroll
    for (int i = 0; i < 8; ++i) v[i] = *(const f32x4*)(W + (size_t)(k0 + 8 * i + lr) * N + n0 + c4);
#pragma unroll
    for (int i = 0; i < 8; ++i) { const int kk = 8 * i + lr; const float sc = ksc ? ksc[k0 + kk] : 1.0f; LAS float* d = scr + kk * 33 + c4; d[0] = v[i][0] * sc; d[1] = v[i][1] * sc; d[2] = v[i][2] * sc; d[3] = v[i][3] * sc; }
    asm volatile("s_waitcnt lgkmcnt(0)" ::: "memory");
    const int c = lane & 7;
#pragma unroll
    for (int j = 0; j < 4; ++j) { const int n = (lane >> 3) + 8 * j; const LAS float* s = scr + (8 * c) * 33 + n;
        v4u o; o.x = pk2(s[0 * 33], s[1 * 33]); o.y = pk2(s[2 * 33], s[3 * 33]); o.z = pk2(s[4 * 33], s[5 * 33]); o.w = pk2(s[6 * 33], s[7 * 33]);
        *(v4u*)(WT + (size_t)(n0 + n) * K + k0 + 8 * c) = o; }
    asm volatile("s_waitcnt lgkmcnt(0)" ::: "memory");
}
template <bool HASK> __device__ __forceinline__ void p0_wquant_block(const float* W, int N, unsigned char* WT8, float* cs, const float* ksc, int item, int wave, int lane, LAS float* mxs) {
    asm volatile("" : "+v"(lane));
    const int n0 = item * 32, r = lane >> 3, c4 = lane & 7, kb = 256 * wave + 4 * r;
    const float* src = W + (size_t)kb * N + n0 + 4 * c4; const float* kp = ksc + kb;
    f32x4 mx = (f32x4){0.f, 0.f, 0.f, 0.f};
#pragma unroll
    for (int i2 = 0; i2 < 2; ++i2) { f32x4 v[4][4], g4[4];
#pragma unroll
        for (int ii = 0; ii < 4; ++ii) { g4[ii] = HASK ? *(const f32x4*)(kp + 32 * (i2 * 4 + ii)) : (f32x4){1.f, 1.f, 1.f, 1.f};
#pragma unroll
            for (int j = 0; j < 4; ++j) v[ii][j] = *(const f32x4*)(src + (size_t)(32 * (i2 * 4 + ii) + j) * N); }
#pragma unroll
        for (int ii = 0; ii < 4; ++ii)
#pragma unroll
            for (int j = 0; j < 4; ++j)
#pragma unroll
                for (int e = 0; e < 4; ++e) mx[e] = fmaxf(mx[e], fabsf(v[ii][j][e] * g4[ii][j])); }
#pragma unroll
    for (int o = 8; o < 64; o <<= 1)
#pragma unroll
        for (int e = 0; e < 4; ++e) mx[e] = fmaxf(mx[e], __shfl_xor(mx[e], o));
    if (r == 0) *(LAS f32x4*)(mxs + wave * 32 + 4 * c4) = mx;
    __syncthreads();
#pragma unroll
    for (int w = 0; w < NWAVES; ++w) { const f32x4 t = *(const LAS f32x4*)(mxs + w * 32 + 4 * c4);
#pragma unroll
        for (int e = 0; e < 4; ++e) mx[e] = fmaxf(mx[e], t[e]); }
    f32x4 q;
#pragma unroll
    for (int e = 0; e < 4; ++e) q[e] = mx[e] > 0.f ? 127.0f / mx[e] : 0.f;
    if (wave == 0 && r == 0) *(f32x4*)(cs + n0 + 4 * c4) = mx * (1.0f / 127.0f);
    unsigned char* dst = WT8 + (size_t)(n0 + 4 * c4) * 2048 + kb;
#pragma unroll
    for (int i2 = 0; i2 < 2; ++i2) { f32x4 v[4][4], g4[4];
#pragma unroll
        for (int ii = 0; ii < 4; ++ii) { g4[ii] = HASK ? *(const f32x4*)(kp + 32 * (i2 * 4 + ii)) : (f32x4){1.f, 1.f, 1.f, 1.f};
#pragma unroll
            for (int j = 0; j < 4; ++j) v[ii][j] = *(const f32x4*)(src + (size_t)(32 * (i2 * 4 + ii) + j) * N); }
#pragma unroll
        for (int ii = 0; ii < 4; ++ii) { unsigned w[4] = {0u, 0u, 0u, 0u};
#pragma unroll
            for (int j = 0; j < 4; ++j)
#pragma unroll
                for (int e = 0; e < 4; ++e) { const int qi = (int)rintf(v[ii][j][e] * g4[ii][j] * q[e]); w[e] |= ((unsigned)qi & 0xFFu) << (8 * j); }
#pragma unroll
            for (int e = 0; e < 4; ++e) *(unsigned*)(dst + (size_t)e * 2048 + 32 * (i2 * 4 + ii)) = w[e]; } }
    __syncthreads();
}
__device__ __forceinline__ void p0_small_transpose(const float* src, bf16* dst, int nb, int K, int N, int gt, int NGT) {
    const int tot = nb * K * N;
    for (int i = gt; i < tot; i += NGT) { const int bb = i / (K * N), r = i - bb * K * N, n = r / K, k = r - n * K; dst[i] = (bf16)f2bf(src[(size_t)bb * K * N + (size_t)k * N + n]); }
}
template <int PART> __device__ __forceinline__ void p0_prologue(const Frame& F, int vb, int VG) {
    LAS float* scr = (LAS float*)(F.lds + F.wave * 8448);
    const int gw = vb * NWAVES + F.wave, NGW = VG * NWAVES, gt = gw * 64 + F.lane, NGT = NGW * 64;
    constexpr int I1 = (D / 64) * (NIN / 32), I2 = (D / 64) * (D / 32);
    if (PART == 0) { for (int it = vb; it < NIN / 32; it += VG) p0_wquant_block<true>(F.in[I_WIN], NIN, WSP(unsigned char, WS_WIN), WSP(float, WS_CS1), F.in[I_G1], it, F.wave, F.lane, (LAS float*)(F.lds + 8 * 8448)); }
    else { for (int it = gw; it < I2; it += NGW) p0_transpose_item(F.in[I_WOUT], D, D, WSP(bf16, WS_WOUT), nullptr, scr, it, F.lane);
           { const int sp = VG >= 64 ? VG / 64 : 1; for (int v = vb; v < sp * (D / 32); v += VG) if (v % sp == 0) p0_wquant_block<false>(F.in[I_WQ], D, WSP(unsigned char, WS_WQ), WSP(float, WS_CSQ), nullptr, v / sp, F.wave, F.lane, (LAS float*)(F.lds + 8 * 8448)); } }
    if (PART == 0) {
    { v4u* z = (v4u*)(WSP(unsigned char, WS_WIN) + (size_t)NIN * D); const int nz = (NINP - NIN) * D / 16; for (int i = gt; i < nz; i += NGT) z[i] = (v4u){0u, 0u, 0u, 0u};
      for (int i = gt; i < NINP - NIN; i += NGT) WSP(float, WS_CS1)[NIN + i] = 0.f; }
    p0_small_transpose(F.in[I_W2], WSP(bf16, WS_W2T), 1, 64, 1024, gt, NGT);
    p0_small_transpose(F.in[I_A2], WSP(bf16, WS_A2T), 1, 64, 1024, gt, NGT);
    p0_small_transpose(F.in[I_G2], WSP(bf16, WS_G2T), 1, 160, 1024, gt, NGT);
    p0_small_transpose(F.in[I_WA], WSP(bf16, WS_WAT), 8, 128, 128, gt, NGT);
    p0_small_transpose(F.in[I_WI], WSP(bf16, WS_WIT), 8, 128, 128, gt, NGT);
    { const float* s = F.in[I_KEYS]; bf16* d = WSP(bf16, WS_KEYS); for (int i = gt; i < 8 * 2 * 128 * 128 / 8; i += NGT) { const f32x4 a = *(const f32x4*)(s + (size_t)i * 8), b = *(const f32x4*)(s + (size_t)i * 8 + 4);
        v4u o; o.x = pk2(a[0], a[1]); o.y = pk2(a[2], a[3]); o.z = pk2(b[0], b[1]); o.w = pk2(b[2], b[3]); *(v4u*)(d + (size_t)i * 8) = o; } }
    }
    if (PART == 0) {
    { const float* x = F.in[I_X]; unsigned char* xq = WSP(unsigned char, WS_XB); float* rs1 = WSP(float, WS_RSTD1);
#define XR_LOAD(V_, row_) do { _Pragma("unroll") for (int hh_ = 0; hh_ < 2; ++hh_) _Pragma("unroll") for (int q_ = 0; q_ < 4; ++q_) V_[hh_][q_] = *(const f32x4*)(x + (size_t)(row_) * D + hh_ * 1024 + F.lane * 16 + q_ * 4); } while (0)
#define XR_QUANT(V_, row_) do { float s_ = 0.f, am_ = 0.f; \
          _Pragma("unroll") for (int hh_ = 0; hh_ < 2; ++hh_) _Pragma("unroll") for (int q_ = 0; q_ < 4; ++q_) _Pragma("unroll") for (int e_ = 0; e_ < 4; ++e_) { const float t_ = V_[hh_][q_][e_]; s_ += t_ * t_; am_ = fmaxf(am_, fabsf(t_)); } \
          s_ = wave_sum(s_); \
          _Pragma("unroll") for (int o_ = 1; o_ < 64; o_ <<= 1) am_ = fmaxf(am_, __shfl_xor(am_, o_)); \
          const float xq_ = am_ > 0.f ? 127.0f / am_ : 0.f; \
          if (F.lane == 0) rs1[row_] = am_ * (1.0f / 127.0f) / sqrtf(s_ * (1.0f / D) + NORM_EPS); \
          _Pragma("unroll") for (int hh_ = 0; hh_ < 2; ++hh_) { v4u o_; \
              _Pragma("unroll") for (int q_ = 0; q_ < 4; ++q_) { unsigned w_ = 0u; \
                  _Pragma("unroll") for (int e_ = 0; e_ < 4; ++e_) { const int qi_ = (int)rintf(V_[hh_][q_][e_] * xq_); w_ |= ((unsigned)qi_ & 0xFFu) << (8 * e_); } \
                  o_[q_] = w_; } \
              *(v4u*)(xq + (size_t)(row_) * D + hh_ * 1024 + F.lane * 16) = o_; } } while (0)
      for (int m = gw; m < T; m += 2 * NGW) { const int mB = m + NGW < T ? m + NGW : m;
          f32x4 xa[2][4], xb2[2][4];
          XR_LOAD(xa, m); XR_LOAD(xb2, mB);
          XR_QUANT(xa, m);
          if (mB != m) XR_QUANT(xb2, mB); }
#undef XR_LOAD
#undef XR_QUANT
    }
    }
}

typedef float f32x2c __attribute__((ext_vector_type(2)));
__device__ __forceinline__ unsigned cvtpk(float lo, float hi) { const f32x2c v = {lo, hi}; const bf16x2_t b = __builtin_convertvector(v, bf16x2_t); return __builtin_bit_cast(unsigned, b); }
__device__ __forceinline__ float rcpf_(float x) { return __builtin_amdgcn_rcpf(x); }
__device__ __forceinline__ float sigmoid_fast(float x) { return rcpf_(1.0f + __expf(-x)); }
__device__ __forceinline__ float tanh_fast(float x) { return 1.0f - 2.0f * rcpf_(1.0f + __expf(2.0f * x)); }
__device__ __forceinline__ float softplus_fast(float z) { return fmaxf(z, 0.f) + __logf(1.0f + __expf(-fabsf(z))); }
__device__ __forceinline__ float gelu_fast(float x) { const float u = 0.7978845608028654f * (x + 0.044715f * x * x * x); return x * rcpf_(1.0f + __expf(-2.0f * u)); }
__device__ __forceinline__ void rwkv_prep_unit(const Frame& F, int chunk, int h, int lane, const LAS bf16* WL2, const LAS bf16* AL2, const LAS bf16* GL2, const LAS float* CW, LAS bf16* ST) {
    asm volatile("" : "+v"(lane));
    const int fr = lane & 15, fq = lane >> 4;
    const bf16* PROJ = WSP(bf16, WS_PROJ); const bf16* LA = WSP(bf16, WS_LA);
    bf16* TA = WSP(bf16, WS_TA); bf16* TB = WSP(bf16, WS_TB); bf16* TK = WSP(bf16, WS_TK); bf16* TR = WSP(bf16, WS_TR);
    bf16* TV = (bf16*)F.out + OUT_TV / 2; bf16* TG = (bf16*)F.out + OUT_TG / 2; float* PCG = F.out + OUT_PC / 4; float* BONG = F.out + OUT_BON / 4;
#define PU4(w_) ((f32x4){bf_lo((w_).x), bf_hi((w_).x), bf_lo((w_).y), bf_hi((w_).y)})
    size_t tokm[2]; int pom[2]; unsigned pmm[2];
#pragma unroll
    for (int mt = 0; mt < 2; ++mt) { tokm[mt] = (size_t)chunk * 32 + mt * 16 + fr; const bool hasp = ((chunk & 63) * 32 + mt * 16 + fr) > 0; pom[mt] = hasp ? NINP : 0; pmm[mt] = hasp ? 0xffffffffu : 0u; }
    float inv[2], bn[2];
#pragma unroll
    for (int mt = 0; mt < 2; ++mt) { float s2 = 0.f;
#pragma unroll
        for (int nt = 0; nt < 4; ++nt) { const int j4 = nt * 16 + fq * 4; const bf16* pr = PROJ + tokm[mt] * NINP + PC_K + h * 64 + j4;
            const v2u kc = *(const v2u*)pr; v2u kp = *(const v2u*)(pr - pom[mt]); kp.x &= pmm[mt]; kp.y &= pmm[mt];
            const f32x4 c_kk = *(const LAS f32x4*)(CW + 128 + j4), m_k = *(const LAS f32x4*)(CW + 384 + j4);
            const f32x4 kcf = PU4(kc); const f32x4 ku = (kcf + (PU4(kp) - kcf) * m_k) * c_kk; s2 += (ku[0] * ku[0] + ku[1] * ku[1]) + (ku[2] * ku[2] + ku[3] * ku[3]); }
        { auto x = __builtin_amdgcn_permlane16_swap(__float_as_uint(s2), __float_as_uint(s2), false, false); s2 = __uint_as_float(x[0]) + __uint_as_float(x[1]); }
        { auto x = __builtin_amdgcn_permlane32_swap(__float_as_uint(s2), __float_as_uint(s2), false, false); s2 = __uint_as_float(x[0]) + __uint_as_float(x[1]); }
        inv[mt] = __builtin_amdgcn_rsqf(fmaxf(s2, 1e-24f)); bn[mt] = 0.f; }
    v2u cur_[3], prv_[3], ncur_[3], nprv_[3];
#define PREP_LOAD_RKV(C_, P_, st_) do { const int mt_ = (st_) >> 2, nt_ = (st_) & 3; const bf16* pr_ = PROJ + tokm[mt_] * NINP + PC_R + h * 64 + nt_ * 16 + fq * 4; \
        _Pragma("unroll") for (int q_ = 0; q_ < 3; ++q_) { C_[q_] = *(const v2u*)(pr_ + q_ * 1024); P_[q_] = *(const v2u*)(pr_ + q_ * 1024 - pom[mt_]); } } while (0)
    PREP_LOAD_RKV(cur_, prv_, 0);
    f32x4 tot0[4];
#pragma unroll
    for (int n = 0; n < 4; ++n) tot0[n] = (f32x4){0.f, 0.f, 0.f, 0.f};
    bf16x8 la[9];
#pragma unroll
    for (int st = 0; st < 8; ++st) { const int mt = st >> 2, nt = st & 3; const int j4 = nt * 16 + fq * 4; const size_t col = (size_t)h * 64 + j4;
        if (nt == 0) {
#pragma unroll
            for (int ks = 0; ks < 9; ++ks) la[ks] = *(const bf16x8*)(LA + tokm[mt] * 288 + ks * 32 + 8 * fq); }
        if (st < 7) PREP_LOAD_RKV(ncur_, nprv_, st + 1);
        f32x4 cw = (f32x4){0.f, 0.f, 0.f, 0.f}, ca = cw, cg = cw;
#pragma unroll
        for (int ks = 0; ks < 2; ++ks) { cw = MFMA16(*(const LAS bf16x8*)(WL2 + (nt * 16 + fr) * 72 + ks * 32 + 8 * fq), la[ks], cw); ca = MFMA16(*(const LAS bf16x8*)(AL2 + (nt * 16 + fr) * 72 + ks * 32 + 8 * fq), la[2 + ks], ca); }
#pragma unroll
        for (int ks = 0; ks < 5; ++ks) cg = MFMA16(*(const LAS bf16x8*)(GL2 + (nt * 16 + fr) * 168 + ks * 32 + 8 * fq), la[4 + ks], cg);
        const f32x4 c_w0 = *(const LAS f32x4*)(CW + j4), c_a0 = *(const LAS f32x4*)(CW + 64 + j4), c_kk = *(const LAS f32x4*)(CW + 128 + j4), c_ka = *(const LAS f32x4*)(CW + 192 + j4), c_rk = *(const LAS f32x4*)(CW + 256 + j4);
        const f32x4 m_r = *(const LAS f32x4*)(CW + 320 + j4), m_k = *(const LAS f32x4*)(CW + 384 + j4), m_v = *(const LAS f32x4*)(CW + 448 + j4);
        v2u rp = prv_[0], kp = prv_[1], vp = prv_[2]; const unsigned pm = pmm[mt];
        rp.x &= pm; rp.y &= pm; kp.x &= pm; kp.y &= pm; vp.x &= pm; vp.y &= pm;
        const f32x4 rcf = PU4(cur_[0]), kcf = PU4(cur_[1]), vcf = PU4(cur_[2]);
        const f32x4 rr = rcf + (PU4(rp) - rcf) * m_r, kv = kcf + (PU4(kp) - kcf) * m_k, vv = vcf + (PU4(vp) - vcf) * m_v;
        f32x4 nau, bbu, km, cum;
#pragma unroll
        for (int r = 0; r < 4; ++r) { const float av = sigmoid_fast(c_a0[r] + ca[r]), ku = kv[r] * c_kk[r]; km[r] = kv[r] * (1.0f + (av - 1.0f) * c_ka[r]);
            cum[r] = -0.6065306597126334f * sigmoid_fast(c_w0[r] + cw[r]);
            nau[r] = -ku; bbu[r] = ku * av; bn[mt] += rr[r] * km[r] * c_rk[r]; }
        f32x4 at4, rt4, bt4, kt4, ep4;
#pragma unroll
        for (int r = 0; r < 4; ++r) { float v = cum[r];
            v += __builtin_bit_cast(float, __builtin_amdgcn_update_dpp(0, __builtin_bit_cast(int, v), 0x111, 0xf, 0xf, true));
            v += __builtin_bit_cast(float, __builtin_amdgcn_update_dpp(0, __builtin_bit_cast(int, v), 0x112, 0xf, 0xf, true));
            v += __builtin_bit_cast(float, __builtin_amdgcn_update_dpp(0, __builtin_bit_cast(int, v), 0x114, 0xf, 0xf, true));
            v += __builtin_bit_cast(float, __builtin_amdgcn_update_dpp(0, __builtin_bit_cast(int, v), 0x118, 0xf, 0xf, true));
            if (mt == 0) tot0[nt][r] = __shfl(v, (lane & 48) | 15); else v += tot0[nt][r];
            const float ep = __expf(v), em = rcpf_(ep);
            float eprev = __builtin_bit_cast(float, __builtin_amdgcn_update_dpp(0, __builtin_bit_cast(int, ep), 0x111, 0xf, 0xf, true));
            if (fr == 0) eprev = mt ? __expf(tot0[nt][r]) : 1.0f;
            at4[r] = nau[r] * inv[mt] * eprev; rt4[r] = rr[r] * ep; bt4[r] = bbu[r] * inv[mt] * em; kt4[r] = km[r] * em; ep4[r] = ep; }
        { LAS bf16* sp = ST + fr * 64 + j4; v2u w;
          w.x = cvtpk(at4[0], at4[1]); w.y = cvtpk(at4[2], at4[3]); *(LAS v2u*)(sp) = w;
          w.x = cvtpk(rt4[0], rt4[1]); w.y = cvtpk(rt4[2], rt4[3]); *(LAS v2u*)(sp + 1024) = w;
          w.x = cvtpk(bt4[0], bt4[1]); w.y = cvtpk(bt4[2], bt4[3]); *(LAS v2u*)(sp + 2048) = w;
          w.x = cvtpk(kt4[0], kt4[1]); w.y = cvtpk(kt4[2], kt4[3]); *(LAS v2u*)(sp + 3072) = w;
          w.x = cvtpk(vv[0], vv[1]); w.y = cvtpk(vv[2], vv[3]); *(LAS v2u*)(sp + 4096) = w;
          w.x = cvtpk(cg[0], cg[1]); w.y = cvtpk(cg[2], cg[3]); *(LAS v2u*)(sp + 5120) = w; }
        if (nt == 3) {
            bf16* const dstp[6] = {TA, TR, TB, TK, TV, TG};
#pragma unroll
            for (int a6 = 0; a6 < 6; ++a6)
#pragma unroll
                for (int hrow = 0; hrow < 2; ++hrow) { const int row = hrow * 8 + (lane >> 3), c8 = (lane & 7) * 8;
                    const v4u pv = *(const LAS v4u*)(ST + a6 * 1024 + row * 64 + c8);
                    *(v4u*)(dstp[a6] + ((size_t)chunk * 32 + mt * 16 + row) * 1024 + (size_t)h * 64 + c8) = pv; } }
        if (mt == 1 && fr == 15) *(f32x4*)(PCG + (size_t)chunk * 1024 + col) = ep4;
#pragma unroll
        for (int q = 0; q < 3; ++q) { cur_[q] = ncur_[q]; prv_[q] = nprv_[q]; }
    }
#undef PREP_LOAD_RKV
#undef PU4
#pragma unroll
    for (int mt = 0; mt < 2; ++mt) { float b2 = bn[mt];
        { auto x = __builtin_amdgcn_permlane16_swap(__float_as_uint(b2), __float_as_uint(b2), false, false); b2 = __uint_as_float(x[0]) + __uint_as_float(x[1]); }
        { auto x = __builtin_amdgcn_permlane32_swap(__float_as_uint(b2), __float_as_uint(b2), false, false); b2 = __uint_as_float(x[0]) + __uint_as_float(x[1]); }
        if (fq == 0) BONG[tokm[mt] * 16 + h] = b2; }
}
__device__ __forceinline__ void rwkv_prep_phase(const Frame& F) {
    LAS bf16* WL2 = (LAS bf16*)(F.lds + 0); LAS bf16* AL2 = (LAS bf16*)(F.lds + 9216); LAS bf16* GL2 = (LAS bf16*)(F.lds + 18432); LAS float* CW = (LAS float*)(F.lds + 39936);
    int hcur = -1;
    for (int u = F.bid; u < 1024; u += F.G) { const int h = u & 15, cg = u >> 4;
        if (h != hcur) { hcur = h; __syncthreads();
            int tid_ = F.tid; asm volatile("" : "+v"(tid_));
            const bf16* w2t = WSP(bf16, WS_W2T) + (size_t)h * 64 * 64; const bf16* a2t = WSP(bf16, WS_A2T) + (size_t)h * 64 * 64; const bf16* g2t = WSP(bf16, WS_G2T) + (size_t)h * 64 * 160;
            { const int r = tid_ >> 3, c = (tid_ & 7) * 8; *(LAS v4u*)(WL2 + r * 72 + c) = *(const v4u*)(w2t + r * 64 + c); *(LAS v4u*)(AL2 + r * 72 + c) = *(const v4u*)(a2t + r * 64 + c); }
            for (int i = tid_; i < 64 * 20; i += NTHR) { const int r = i / 20, c = (i - r * 20) * 8; *(LAS v4u*)(GL2 + r * 168 + c) = *(const v4u*)(g2t + r * 160 + c); }
            { const int q = tid_ >> 6, jj = tid_ & 63; const float* src = q == 0 ? F.in[I_W0] : (q == 1 ? F.in[I_A0] : (q == 2 ? F.in[I_KK] : (q == 3 ? F.in[I_KA] : (q == 4 ? F.in[I_RK] : F.in[I_MU] + (q - 5) * 1024)))); CW[q * 64 + jj] = src[h * 64 + jj]; }
            __syncthreads(); }
        rwkv_prep_unit(F, cg * 8 + F.wave, h, F.lane, WL2, AL2, GL2, CW, (LAS bf16*)(F.lds + 43008 + F.wave * 12288)); }
    __syncthreads();
}
typedef short v4i16_t __attribute__((ext_vector_type(4)));
__device__ __forceinline__ bf16x8 frag_tr16(const LAS bf16* p, int ld) {
    const v4i16_t a = __builtin_amdgcn_ds_read_tr16_b64_v4i16((LAS v4i16_t*)p), b = __builtin_amdgcn_ds_read_tr16_b64_v4i16((LAS v4i16_t*)(p + 4 * ld));
    return (bf16x8){a[0], a[1], a[2], a[3], b[0], b[1], b[2], b[3]};
}
__device__ __forceinline__ void rwkv_item(const Frame& F, int item) {
    const int b = item >> 4, h = item & 15, wave = F.wave; int tid = F.tid; asm volatile("" : "+v"(tid)); const int lane = tid & 63;
    LAS unsigned char* L = F.lds;
    constexpr int LD64 = 72, LD32 = 40, E0 = 73216;
    LAS bf16* AT = (LAS bf16*)(L + 0);  LAS bf16* BT_ = (LAS bf16*)(L + 4608); LAS bf16* KT_ = (LAS bf16*)(L + 9216); LAS bf16* RT = (LAS bf16*)(L + 13824);
    LAS bf16* VS2 = (LAS bf16*)(L + 18432);
    LAS bf16* GGB2 = (LAS bf16*)(L + 27648);
    LAS bf16* S0B = (LAS bf16*)(L + 36864);
    LAS float* YB2 = (LAS float*)(L + 55296);
    LAS float* BON2 = (LAS float*)(L + 72704);
    LAS float* PC = (LAS float*)(L + 72960);
    LAS bf16* AAK = (LAS bf16*)(L + E0); LAS bf16* ARB = (LAS bf16*)(L + E0 + 2560); LAS bf16* ARK = (LAS bf16*)(L + E0 + 5120);
    LAS bf16* MINV = (LAS bf16*)(L + E0 + 7680);
    LAS bf16* RHS = (LAS bf16*)(L + E0 + 23040);
    LAS bf16* SAB = (LAS bf16*)(L + E0 + 28160);
    static_assert(E0 + 33280 <= LDSCTL_OFF, "rwkv LDS map");
    bf16* Y = WSP(bf16, WS_Y);
#define FRAG(base, row0, ld, ks) (*(const LAS bf16x8*)((base) + ((row0) + fr) * (ld) + (ks) * 32 + 8 * fq))
#define FRAGT(base, col0, ld) frag_tr16((base) + (8 * fq + (fr >> 2)) * (ld) + (col0) + 4 * (fr & 3), (ld))
    const int tt = tid >> 4, j0 = (tid & 15) * 4, hc = h * 64 + j0;
    const f32x4 plw = *(const f32x4*)(F.in[I_LNW] + hc), plb = *(const f32x4*)(F.in[I_LNB] + hc);
    const int lr = (tid & 255) >> 3, lc8 = tid & 7; const bool hi2 = tid >= 256;
    const bf16* srcA[3] = { (hi2 ? WSP(bf16, WS_TR) : WSP(bf16, WS_TA)), (hi2 ? WSP(bf16, WS_TK) : WSP(bf16, WS_TB)), (hi2 ? (const bf16*)F.out + OUT_TG / 2 : (const bf16*)F.out + OUT_TV / 2) };
    const size_t poff = ((size_t)b * SEQ + lr) * 1024 + h * 64 + lc8 * 8;
    const float* PCG = F.out + OUT_PC / 4 + (size_t)(b * 64) * 1024 + h * 64; const float* BONG = F.out + OUT_BON / 4 + (size_t)b * SEQ * 16 + h;
    v4u pl_[3]; float ppc = 0.f, pbn = 0.f;
#define RWKV_PREFETCH(tl_) do { _Pragma("unroll") for (int q_ = 0; q_ < 3; ++q_) pl_[q_] = *(const v4u*)(srcA[q_] + poff + (size_t)(tl_) * 32 * 1024); \
        ppc = PCG[(size_t)(tl_) * 1024 + (tid & 63)]; pbn = BONG[((size_t)(tl_) * 32 + (tid & 31)) * 16]; } while (0)
    const int ib = wave >> 1, tb = wave & 1, i0 = ib * 16, t0m = tb * 16;
    f32x4 sacc[2], yacc;
    sacc[0] = (f32x4){0.f, 0.f, 0.f, 0.f}; sacc[1] = sacc[0]; yacc = sacc[0];
    for (int u = tid; u < 2 * 64 * LD64 / 2; u += NTHR) ((LAS unsigned*)S0B)[u] = 0u;
    const int ttab = item >> 6, trow0 = ((item & 63) * 4 + (wave & 3)) * 64; const bool tconv = wave >= 4;
    const float* tsrc = ttab ? F.in[I_V] : F.in[I_U]; unsigned char* tdst = ttab ? WSP(unsigned char, WS_VT) : WSP(unsigned char, WS_UT); float* tsc = ttab ? WSP(float, WS_VSC) : WSP(float, WS_USC);
    f32x4 tr[2][4];
#define CH_TBL_LOAD(row_) do { const float* tp_ = tsrc + (tconv ? (size_t)(row_) * D : (size_t)0) + lane * 16; \
        _Pragma("unroll") for (int hh_ = 0; hh_ < 2; ++hh_) _Pragma("unroll") for (int q_ = 0; q_ < 4; ++q_) tr[hh_][q_] = *(const f32x4*)(tp_ + (tconv ? hh_ * 1024 : 0) + q_ * 4); } while (0)
#define CH_TBL_QUANT(row_) do { float am_ = 0.f; \
        _Pragma("unroll") for (int hh_ = 0; hh_ < 2; ++hh_) _Pragma("unroll") for (int q_ = 0; q_ < 4; ++q_) _Pragma("unroll") for (int e_ = 0; e_ < 4; ++e_) am_ = fmaxf(am_, fabsf(tr[hh_][q_][e_])); \
        am_ = fmaxf(am_, dppf<0xB1>(am_)); am_ = fmaxf(am_, dppf<0x4E>(am_)); am_ = fmaxf(am_, dppf<0x141>(am_)); am_ = fmaxf(am_, dppf<0x140>(am_)); \
        { auto s_ = __builtin_amdgcn_permlane16_swap(__float_as_uint(am_), __float_as_uint(am_), false, false); am_ = fmaxf(__uint_as_float(s_[0]), __uint_as_float(s_[1])); } \
        { auto s_ = __builtin_amdgcn_permlane32_swap(__float_as_uint(am_), __float_as_uint(am_), false, false); am_ = fmaxf(__uint_as_float(s_[0]), __uint_as_float(s_[1])); } \
        const float tq_ = am_ > 0.f ? 127.0f / am_ : 0.f; \
        if (lane == 0) tsc[row_] = am_ * (1.0f / 127.0f); \
        _Pragma("unroll") for (int hh_ = 0; hh_ < 2; ++hh_) { v4u o_; \
            _Pragma("unroll") for (int q_ = 0; q_ < 4; ++q_) {   \
                const unsigned b0_ = __float_as_uint(__builtin_fmaf(tr[hh_][q_][0], tq_, 12582912.0f)), b1_ = __float_as_uint(__builtin_fmaf(tr[hh_][q_][1], tq_, 12582912.0f)); \
                const unsigned b2_ = __float_as_uint(__builtin_fmaf(tr[hh_][q_][2], tq_, 12582912.0f)), b3_ = __float_as_uint(__builtin_fmaf(tr[hh_][q_][3], tq_, 12582912.0f)); \
                const unsigned lo_ = __builtin_amdgcn_perm(b1_, b0_, 0x0c0c0400u), hi_ = __builtin_amdgcn_perm(b3_, b2_, 0x04000c0cu);   \
                o_[q_] = lo_ | hi_; } \
            *(v4u*)(tdst + (size_t)(row_) * D + hh_ * 1024 + lane * 16) = o_; } } while (0)
    CH_TBL_LOAD(trow0);
    RWKV_PREFETCH(0);
    __syncthreads();
    for (int tl = 0; tl <= SEQ / 32; ++tl) {
        const int cur = tl & 1;
        int lane_c = lane; asm volatile("" : "+v"(lane_c)); const int fr = lane_c & 15, fq = lane_c >> 4;
        LAS bf16* VS = VS2 + cur * 32 * LD64; LAS bf16* GGB = GGB2 + cur * 32 * LD64; LAS float* YB = YB2 + cur * 32 * 68; LAS float* BON = BON2 + cur * 32;
        const LAS bf16* VSp = VS2 + (cur ^ 1) * 32 * LD64; const LAS bf16* GGBp = GGB2 + (cur ^ 1) * 32 * LD64; const LAS float* YBp = YB2 + (cur ^ 1) * 32 * 68; const LAS float* BONp = BON2 + (cur ^ 1) * 32;
        if (tl > 0) { const size_t tokb = (size_t)b * SEQ + (tl - 1) * 32;
          const f32x4 y4 = *(const LAS f32x4*)(YBp + tt * 68 + j0); const v2u gw_ = *(const LAS v2u*)(GGBp + tt * LD64 + j0);
          const f32x4 g4 = (f32x4){bf_lo(gw_.x), bf_hi(gw_.x), bf_lo(gw_.y), bf_hi(gw_.y)};
          const v2u vw_ = *(const LAS v2u*)(VSp + tt * LD64 + j0); const f32x4 v4 = (f32x4){bf_lo(vw_.x), bf_hi(vw_.x), bf_lo(vw_.y), bf_hi(vw_.y)};
          float sm = (y4[0] + y4[1]) + (y4[2] + y4[3]); sm = red16(sm); const float mean = sm * (1.0f / 64.0f);
          const f32x4 d4 = y4 - mean; float sv = (d4[0] * d4[0] + d4[1] * d4[1]) + (d4[2] * d4[2] + d4[3] * d4[3]); sv = red16(sv);
          const float rstd = __builtin_amdgcn_rsqf(sv * (1.0f / 64.0f) + GN_EPS), bon = BONp[tt];
          f32x4 o;
#pragma unroll
          for (int e = 0; e < 4; ++e) o[e] = (d4[e] * rstd * plw[e] + plb[e] + bon * v4[e]) * g4[e];
          v2u w; w.x = cvtpk(o[0], o[1]); w.y = cvtpk(o[2], o[3]);
          *(v2u*)(Y + (tokb + tt) * D + 1024 + hc) = w; }
        if (tl == SEQ / 32) break;
        const LAS bf16* S0c = S0B + cur * 64 * LD64; LAS bf16* S0n = S0B + (cur ^ 1) * 64 * LD64;
        { const v4u p0 = pl_[0], p1 = pl_[1], p2 = pl_[2];
          *(LAS v4u*)((hi2 ? RT : AT) + lr * LD64 + lc8 * 8) = p0;
          *(LAS v4u*)((hi2 ? KT_ : BT_) + lr * LD64 + lc8 * 8) = p1;
          *(LAS v4u*)((hi2 ? GGB : VS) + lr * LD64 + lc8 * 8) = p2;
          if (tid < 64) PC[tid] = ppc;
          if (tid >= 64 && tid < 96) BON[tid - 64] = pbn; }
        { const int tn_ = tl + 1 < SEQ / 32 ? tl + 1 : SEQ / 32 - 1; RWKV_PREFETCH(tn_); }
        __syncthreads();
        f32x4 rhs4 = (f32x4){0.f, 0.f, 0.f, 0.f};
#define RWKV_FIRST do { rhs4 = (f32x4){0.f, 0.f, 0.f, 0.f}; yacc = (f32x4){0.f, 0.f, 0.f, 0.f}; \
            _Pragma("unroll") for (int ks = 0; ks < 2; ++ks) rhs4 = MFMA16(FRAG(AT, t0m, LD64, ks), FRAG(S0c, i0, LD64, ks), rhs4); \
            _Pragma("unroll") for (int ks = 0; ks < 2; ++ks) yacc = MFMA16(FRAG(S0c, i0, LD64, ks), FRAG(RT, t0m, LD64, ks), yacc); \
            _Pragma("unroll") for (int u = 0; u < 2; ++u) { const int tile = wave * 2 + u, si0 = (tile >> 2) * 16, sj0 = (tile & 3) * 16; sacc[u] = MFMA16(FRAGT(KT_, sj0, LD64), FRAGT(VS, si0, LD64), sacc[u]); } } while (0)
#define PK8(a_, s_) __builtin_bit_cast(bf16x8, (v4u){cvtpk(a_[8 * (s_) + 0], a_[8 * (s_) + 1]), cvtpk(a_[8 * (s_) + 2], a_[8 * (s_) + 3]), cvtpk(a_[8 * (s_) + 4], a_[8 * (s_) + 5]), cvtpk(a_[8 * (s_) + 6], a_[8 * (s_) + 7])})
        if (wave == 0) {
            const int c32 = lane_c & 31, h32 = lane_c >> 5;
            f32x16 U, V, PT;
#pragma unroll
            for (int e = 0; e < 16; ++e) { U[e] = 0.f; V[e] = 0.f; }
#pragma unroll
            for (int ks = 0; ks < 4; ++ks) { const bf16x8 fa = *(const LAS bf16x8*)(AT + c32 * LD64 + ks * 16 + h32 * 8), fb = *(const LAS bf16x8*)(BT_ + c32 * LD64 + ks * 16 + h32 * 8);
                U = MFMA32(fa, fb, U);
                V = MFMA32(fb, fa, V); }
#pragma unroll
            for (int e = 0; e < 16; ++e) { const int rr = (e & 3) + 8 * (e >> 2) + 4 * h32;
                U[e] = (c32 < rr) ? U[e] : 0.f;
                V[e] = (rr < c32) ? V[e] : 0.f;
                PT[e] = V[e] + ((rr == c32) ? 1.0f : 0.f); }
#pragma unroll
            for (int st = 1; st <= 4; ++st) {
                const bf16x8 fU0 = PK8(U, 0), fU1 = PK8(U, 1), fV0 = PK8(V, 0), fV1 = PK8(V, 1);
                f32x16 Un, Vn;
#pragma unroll
                for (int e = 0; e < 16; ++e) { Un[e] = 0.f; Vn[e] = 0.f; }
                Un = MFMA32(fV0, fU0, Un); Un = MFMA32(fV1, fU1, Un);
                if (st < 4) { Vn = MFMA32(fU0, fV0, Vn); Vn = MFMA32(fU1, fV1, Vn); }
                const bf16x8 fN0 = PK8(Un, 0), fN1 = PK8(Un, 1), fP0 = PK8(PT, 0), fP1 = PK8(PT, 1);
                PT = MFMA32(fN0, fP0, PT); PT = MFMA32(fN1, fP1, PT);
                U = Un; V = Vn; }
#pragma unroll
            for (int q = 0; q < 4; ++q) { v2u w; w.x = cvtpk(PT[4 * q], PT[4 * q + 1]); w.y = cvtpk(PT[4 * q + 2], PT[4 * q + 3]); *(LAS v2u*)(MINV + c32 * LD32 + 8 * q + 4 * h32) = w; }
        } else {
            if (wave < 7) { const int mtx = (wave - 1) >> 1;
                const LAS bf16* Xs = (mtx == 1) ? BT_ : KT_; const LAS bf16* Yt = (mtx == 0) ? AT : RT; LAS bf16* O = (mtx == 0) ? AAK : (mtx == 1 ? ARB : ARK);
#pragma unroll
                for (int qq = 0; qq < 2; ++qq) { const int q = ((wave - 1) & 1) * 2 + qq, tq = (q >> 1) * 16, sq = (q & 1) * 16;
                    f32x4 a4 = (f32x4){0.f, 0.f, 0.f, 0.f};
                    if (sq <= tq) {
#pragma unroll
                        for (int ks = 0; ks < 2; ++ks) a4 = MFMA16(FRAG(Xs, sq, LD64, ks), FRAG(Yt, tq, LD64, ks), a4); }
                    const int t = tq + fr, s = sq + fq * 4;
#pragma unroll
                    for (int r = 0; r < 4; ++r) { const bool keep = (mtx == 0) ? (s + r < t) : (s + r <= t); a4[r] = keep ? a4[r] : 0.f; }
                    v2u w; w.x = cvtpk(a4[0], a4[1]); w.y = cvtpk(a4[2], a4[3]); *(LAS v2u*)(O + t * LD32 + s) = w; } }
            RWKV_FIRST;
            if (tconv) CH_TBL_QUANT(trow0 + tl);
        }
        { const int tn_ = tl + 1 < SEQ / 32 ? tl + 1 : SEQ / 32 - 1; CH_TBL_LOAD(trow0 + tn_); }
        __syncthreads();
        if (wave == 0) RWKV_FIRST;
        { rhs4 = MFMA16(FRAG(AAK, t0m, LD32, 0), FRAGT(VS, i0, LD64), rhs4);
          v2u w; w.x = cvtpk(rhs4[0], rhs4[1]); w.y = cvtpk(rhs4[2], rhs4[3]); *(LAS v2u*)(RHS + (i0 + fr) * LD32 + t0m + fq * 4) = w;
          yacc = MFMA16(FRAGT(VS, i0, LD64), FRAG(ARK, t0m, LD32, 0), yacc); }
        __syncthreads();
#undef RWKV_FIRST
#undef PK8
        { f32x4 a4 = (f32x4){0.f, 0.f, 0.f, 0.f}; a4 = MFMA16(FRAG(MINV, t0m, LD32, 0), FRAG(RHS, i0, LD32, 0), a4);
          v2u w; w.x = cvtpk(a4[0], a4[1]); w.y = cvtpk(a4[2], a4[3]); *(LAS v2u*)(SAB + (i0 + fr) * LD32 + t0m + fq * 4) = w; }
        __syncthreads();
        { yacc = MFMA16(FRAG(SAB, i0, LD32, 0), FRAG(ARB, t0m, LD32, 0), yacc);
          *(LAS f32x4*)(YB + (t0m + fr) * 68 + i0 + fq * 4) = yacc;
#pragma unroll
          for (int u = 0; u < 2; ++u) { const int tile = wave * 2 + u, si0 = (tile >> 2) * 16, sj0 = (tile & 3) * 16;
              sacc[u] = MFMA16(FRAGT(BT_, sj0, LD64), FRAG(SAB, si0, LD32, 0), sacc[u]);
              const f32x4 pc = *(const LAS f32x4*)(PC + sj0 + fq * 4); sacc[u] = sacc[u] * pc;
              v2u w; w.x = cvtpk(sacc[u][0], sacc[u][1]); w.y = cvtpk(sacc[u][2], sacc[u][3]); *(LAS v2u*)(S0n + (si0 + fr) * LD64 + sj0 + fq * 4) = w; } }
        __syncthreads();
    }
    __syncthreads();
#undef FRAG
#undef FRAGT
#undef CH_TBL_LOAD
#undef CH_TBL_QUANT
#undef RWKV_PREFETCH
}
__device__ __forceinline__ void lora_prepass(const Frame& F) {
    const bf16* PROJ = WSP(bf16, WS_PROJ); bf16* LA = WSP(bf16, WS_LA); const float* mu = F.in[I_MU] + (PC_WD - RWKV_C0);
    const int gt = (F.bid * NWAVES + F.wave) * 64 + F.lane, NGT = F.G * NTHR;
    for (int i = gt; i < T * 36; i += NGT) { const int tok = i / 36, cc = i - tok * 36, m = cc * 8;
        const bf16* pr = PROJ + (size_t)tok * NINP + PC_WD + m;
        const v4u curv = *(const v4u*)pr; v4u prv = (v4u){0u, 0u, 0u, 0u}; if ((tok & (SEQ - 1)) != 0) prv = *(const v4u*)(pr - NINP);
        const f32x4 m0 = *(const f32x4*)(mu + m), m1 = *(const f32x4*)(mu + m + 4);
        float c[8], p[8], o[8]; unpack8(curv, c); unpack8(prv, p);
#pragma unroll
        for (int e = 0; e < 8; ++e) { const float ps = c[e] + (p[e] - c[e]) * (e < 4 ? m0[e] : m1[e - 4]); o[e] = (m < 64) ? tanh_fast(ps) : ((m < 128) ? ps : sigmoid_fast(ps)); }
        v4u w; w.x = cvtpk(o[0], o[1]); w.y = cvtpk(o[2], o[3]); w.z = cvtpk(o[4], o[5]); w.w = cvtpk(o[6], o[7]);
        *(v4u*)(LA + (size_t)tok * 288 + m) = w; }
}
__device__ __forceinline__ void lru_seq(const Frame& F, int item) {
    const int bh = item >> 1, hf = item & 1, b = bh >> 3, h = bh & 7, wave = F.wave; int tid = F.tid; asm volatile("" : "+v"(tid)); const int lane = tid & 63;
    LAS unsigned char* L = F.lds;
    LAS bf16* XA = (LAS bf16*)(L + 0);
    LAS float* XC = (LAS float*)(L + 17408);
    LAS float* RI = (LAS float*)(L + 50176);
    LAS float* SEG = (LAS float*)(L + 115712);
    LAS float* CARRY = (LAS float*)(L + 119808);
    LAS float* CW = (LAS float*)(L + 120320);
    const bf16* PROJ = WSP(bf16, WS_PROJ); bf16* Y = WSP(bf16, WS_Y);
    const int fr0 = lane & 15, fq0 = lane >> 4;
    for (int i = tid; i < 640; i += NTHR) { const int w = i >> 7, cch = i & 127; CW[i] = (w < 4) ? F.in[I_CONVW][w * 1024 + h * 128 + cch] : F.in[I_CONVB][h * 128 + cch]; }
    if (tid < 64) CARRY[tid] = 0.f;
    const int gsel = wave & 1, ntl = wave >> 1, ntg = hf * 4 + ntl;
    bf16x8 wf[4];
    { const bf16* WTp = (gsel ? WSP(bf16, WS_WIT) : WSP(bf16, WS_WAT)) + (size_t)h * 128 * 128;
#pragma unroll
      for (int ks = 0; ks < 4; ++ks) wf[ks] = *(const bf16x8*)(WTp + (ntg * 16 + fr0) * 128 + ks * 32 + 8 * fq0); }
    const int c = tid & 63, sg = tid >> 6, chl = hf * 64 + c, chg = h * 128 + chl;
    const float ba_c = F.in[I_BA][chg], bi_c = F.in[I_BI][chg], sp8 = 8.0f * softplus_fast(-F.in[I_LAM][chg]);
    v4u pf[2][4];
#define LRU_PREFETCH(k_) do { _Pragma("unroll") for (int u_ = 0; u_ < 2; ++u_) { const int chn_ = tid + NTHR * u_, t_ = chn_ >> 4, c8_ = (chn_ & 15) * 8; \
        _Pragma("unroll") for (int w_ = 0; w_ < 4; ++w_) { const int ts_ = (k_) * 64 + t_ - 3 + w_; const int tc_ = ts_ >= 0 ? ts_ : 0;   \
            const v4u x_ = *(const v4u*)(PROJ + ((size_t)b * SEQ + tc_) * NINP + h * 128 + c8_); const unsigned m_ = ts_ >= 0 ? 0xffffffffu : 0u; \
            pf[u_][w_] = (v4u){x_.x & m_, x_.y & m_, x_.z & m_, x_.w & m_}; } } } while (0)
    unsigned short gtn[8];
#define LRU_GATES(k_) do { _Pragma("unroll") for (int e_ = 0; e_ < 8; ++e_) gtn[e_] = PROJ[((size_t)b * SEQ + (k_) * 64 + sg * 8 + e_) * NINP + PC_GATE + chg]; } while (0)
    LRU_PREFETCH(0); LRU_GATES(0);
    __syncthreads();
    for (int k = 0; k < SEQ / 64; ++k) {
        const size_t tokbase = (size_t)b * SEQ + k * 64;
        int lane_c = lane; asm volatile("" : "+v"(lane_c)); const int fr = lane_c & 15, fq = lane_c >> 4;
#pragma unroll
        for (int u = 0; u < 2; ++u) { const int chn = tid + NTHR * u, t = chn >> 4, c8 = (chn & 15) * 8;
            float acc[8]; { const f32x4 b0 = *(const LAS f32x4*)(CW + 512 + c8), b1 = *(const LAS f32x4*)(CW + 512 + c8 + 4);
#pragma unroll
                for (int e = 0; e < 4; ++e) { acc[e] = b0[e]; acc[e + 4] = b1[e]; } }
#pragma unroll
            for (int w = 0; w < 4; ++w) { float xf[8]; unpack8(pf[u][w], xf);
                const f32x4 w0 = *(const LAS f32x4*)(CW + w * 128 + c8), w1 = *(const LAS f32x4*)(CW + w * 128 + c8 + 4);
#pragma unroll
                for (int e = 0; e < 4; ++e) { acc[e] += w0[e] * xf[e]; acc[e + 4] += w1[e] * xf[e + 4]; } }
            v4u pk; pk.x = cvtpk(acc[0], acc[1]); pk.y = cvtpk(acc[2], acc[3]); pk.z = cvtpk(acc[4], acc[5]); pk.w = cvtpk(acc[6], acc[7]);
            *(LAS v4u*)(XA + t * 136 + c8) = pk;
            LAS float* d = XC + t * 128 + c8; *(LAS f32x4*)d = (f32x4){acc[0], acc[1], acc[2], acc[3]}; *(LAS f32x4*)(d + 4) = (f32x4){acc[4], acc[5], acc[6], acc[7]}; }
        float gl[8];
#pragma unroll
        for (int e = 0; e < 8; ++e) gl[e] = gelu_fast(__uint_as_float((unsigned)gtn[e] << 16));
        { const int kn_ = k + 1 < SEQ / 64 ? k + 1 : SEQ / 64 - 1; LRU_PREFETCH(kn_); LRU_GATES(kn_); }
        __syncthreads();
#pragma unroll
        for (int mt = 0; mt < 4; ++mt) {
            bf16x8 af[4];
#pragma unroll
            for (int ks = 0; ks < 4; ++ks) af[ks] = *(const LAS bf16x8*)(XA + (mt * 16 + fr) * 136 + ks * 32 + 8 * fq);
            { f32x4 a4 = (f32x4){0.f, 0.f, 0.f, 0.f};
#pragma unroll
                for (int ks = 0; ks < 4; ++ks) a4 = MFMA16(wf[ks], af[ks], a4);
                *(LAS f32x4*)(RI + gsel * 8192 + (mt * 16 + fr) * 128 + ntl * 16 + fq * 4) = a4; } }
        __syncthreads();
        float av[8], bx[8]; float A = 1.f, B = 0.f;
#pragma unroll
        for (int e = 0; e < 8; ++e) { const int t = sg * 8 + e; const float r = sigmoid_fast(RI[t * 128 + c] + ba_c), ig = sigmoid_fast(RI[8192 + t * 128 + c] + bi_c), xc = XC[t * 128 + chl];
            const float la = -sp8 * r; av[e] = __expf(la); bx[e] = sqrtf(fmaxf(1.0f - av[e] * av[e], 0.f)) * (ig * xc); A *= av[e]; B = av[e] * B + bx[e]; }
        SEG[(sg * 64 + c) * 2] = A; SEG[(sg * 64 + c) * 2 + 1] = B;
        __syncthreads();
        float hst = CARRY[c];
        for (int s2 = 0; s2 < sg; ++s2) hst = SEG[(s2 * 64 + c) * 2] * hst + SEG[(s2 * 64 + c) * 2 + 1];
#pragma unroll
        for (int e = 0; e < 8; ++e) { hst = av[e] * hst + bx[e];
            Y[(tokbase + sg * 8 + e) * D + chg] = (bf16)(cvtpk(hst * gl[e], 0.f) & 0xffffu); }
        __syncthreads();
        if (sg == 7) CARRY[c] = hst;
    }
    __syncthreads();
#undef LRU_PREFETCH
#undef LRU_GATES
}
__device__ __forceinline__ void group_barrier(unsigned* cnt, unsigned n) {
    asm volatile("s_waitcnt vmcnt(0)" ::: "memory");
    __syncthreads();
    if (threadIdx.x == 0) {
        __builtin_amdgcn_fence(__ATOMIC_RELEASE, "agent");
        asm volatile("s_waitcnt vmcnt(0)" ::: "memory");
        xb_add(cnt, 1u);
        unsigned sp = 0; while (xb_ld(cnt) < n) { __builtin_amdgcn_s_sleep(2); if (++sp > (1u << 24)) break; }
        __builtin_amdgcn_fence(__ATOMIC_ACQUIRE, "agent");
        asm volatile("s_waitcnt vmcnt(0)" ::: "memory");
    }
    __syncthreads();
}

__device__ __forceinline__ unsigned f2ord(float f) { const unsigned u = __builtin_bit_cast(unsigned, f); return (u & 0x80000000u) ? ~u : (u | 0x80000000u); }
__device__ __forceinline__ float ord2f(unsigned o) { const unsigned u = (o & 0x80000000u) ? (o & 0x7fffffffu) : ~o; return __builtin_bit_cast(float, u); }
#define CMPX(hi_, lo_) do { const unsigned _a = (hi_), _b = (lo_); (hi_) = _a > _b ? _a : _b; (lo_) = _a > _b ? _b : _a; } while (0)
template <int N> __device__ __forceinline__ void sort_desc(unsigned (&a)[N]) {
#pragma unroll
    for (int k = 2; k <= N; k <<= 1)
#pragma unroll
        for (int j = k >> 1; j > 0; j >>= 1)
#pragma unroll
            for (int i = 0; i < N; ++i) { const int l = i ^ j; if (l > i) { if ((i & k) == 0) CMPX(a[i], a[l]); else CMPX(a[l], a[i]); } }
}
__device__ __forceinline__ void merge16(unsigned (&A)[16], const unsigned (&B)[16]) {
#pragma unroll
    for (int i = 0; i < 16; ++i) { const unsigned q = B[15 - i]; A[i] = A[i] > q ? A[i] : q; }
#pragma unroll
    for (int d = 8; d >= 1; d >>= 1)
#pragma unroll
        for (int i = 0; i < 16; ++i) if ((i & d) == 0) CMPX(A[i], A[i + d]);
}
__device__ __forceinline__ void merge_partner(unsigned (&Lk)[16]) {
    unsigned P[16];
#pragma unroll
    for (int i = 0; i < 16; ++i) P[i] = (unsigned)__shfl_xor((int)Lk[i], 32);
#pragma unroll
    for (int i = 0; i < 16; ++i) { const unsigned q = P[15 - i]; Lk[i] = Lk[i] > q ? Lk[i] : q; }
#pragma unroll
    for (int d = 8; d >= 1; d >>= 1)
#pragma unroll
        for (int i = 0; i < 16; ++i) if ((i & d) == 0) CMPX(Lk[i], Lk[i + d]);
}
__device__ __forceinline__ void route_item(const Frame& F, int item, int lane) {
    const int tok0 = (item >> 3) * 32, h = item & 7, c = lane & 31, hi = lane >> 5;
    const bf16* Q = WSP(bf16, WS_Q); const bf16* KB = WSP(bf16, WS_KEYS);
    LAS unsigned* WL = (LAS unsigned*)(F.lds + F.wave * 8192);
    unsigned LST[2][16];
    bf16x8 qf[8], qn[8], kf[8], kn[8];
#pragma unroll
    for (int ks = 0; ks < 8; ++ks) { qf[ks] = *(const bf16x8*)(Q + (size_t)(tok0 + c) * D + h * 256 + ks * 16 + 8 * hi); qn[ks] = *(const bf16x8*)(Q + (size_t)(tok0 + c) * D + h * 256 + 128 + ks * 16 + 8 * hi);
        kf[ks] = *(const bf16x8*)(KB + (size_t)((h * 2) * 128 + c) * 128 + 8 * hi + ks * 16); }
    unsigned Lk[16];
#pragma unroll
    for (int st = 0; st < 8; ++st) { const int p = st >> 2, m = st & 3;
        if (st < 7) { const int p2 = (st + 1) >> 2, m2 = (st + 1) & 3; const bf16* kp = KB + (size_t)((h * 2 + p2) * 128 + m2 * 32 + c) * 128 + 8 * hi;
#pragma unroll
            for (int ks = 0; ks < 8; ++ks) kn[ks] = *(const bf16x8*)(kp + ks * 16); }
        f32x16 acc;
#pragma unroll
        for (int r = 0; r < 16; ++r) acc[r] = 0.f;
#pragma unroll
        for (int ks = 0; ks < 8; ++ks) acc = MFMA32(kf[ks], p ? qn[ks] : qf[ks], acc);
        unsigned G16[16];
#pragma unroll
        for (int r = 0; r < 16; ++r) { const unsigned idx = (unsigned)(m * 32 + (r & 3) + 8 * (r >> 2)) | ((unsigned)hi << 2); G16[r] = (f2ord(acc[r]) & ~0x7Fu) | idx; }
        sort_desc<16>(G16);
        if (m == 0) {
#pragma unroll
            for (int i = 0; i < 16; ++i) Lk[i] = G16[i]; }
        else merge16(Lk, G16);
        if (m == 3) { merge_partner(Lk);
#pragma unroll
            for (int i = 0; i < 16; ++i) { LST[p][i] = Lk[i]; WL[(p * 16 + i) * 64 + lane] = Lk[i] & 0x7Fu; } }
#pragma unroll
        for (int ks = 0; ks < 8; ++ks) kf[ks] = kn[ks];
    }
    float va[4], vb[16];
#pragma unroll
    for (int i = 0; i < 4; ++i) va[i] = ord2f((hi ? LST[1][i] : LST[0][i]) & ~0x7Fu);
#pragma unroll
    for (int j = 0; j < 16; ++j) vb[j] = ord2f((hi ? LST[0][j] : LST[1][j]) & ~0x7Fu);
    unsigned C32[32];
#pragma unroll
    for (int i = 0; i < 32; ++i) C32[i] = 0u;
#pragma unroll
    for (int i = 0; i < 4; ++i) { const unsigned key = (f2ord(va[i] + vb[i]) & ~0xFFu) | (unsigned)(i * 17); C32[i] = hi ? 0u : key; }
    { int cn = 4;
#pragma unroll
      for (int i = 0; i < 3; ++i)
#pragma unroll
          for (int j = i + 1; j < 16; ++j) if ((i + 1) * (j + 1) <= 16) { const unsigned code = hi ? (unsigned)(j * 16 + i) : (unsigned)(i * 16 + j); C32[cn] = (f2ord(va[i] + vb[j]) & ~0xFFu) | code; ++cn; } }
    sort_desc<32>(C32);
    unsigned Ck[16];
#pragma unroll
    for (int i = 0; i < 16; ++i) Ck[i] = C32[i];
    merge_partner(Ck);
    const float mx = ord2f(Ck[0] & ~0xFFu); float den = 0.f;
#pragma unroll
    for (int k = 0; k < 16; ++k) den += __expf(ord2f(Ck[k] & ~0xFFu) - mx);
    const float rden = 1.0f / den;
    int eo[8]; float go[8];
#pragma unroll
    for (int k = 0; k < 8; ++k) { const unsigned fm = hi ? Ck[k + 8] : Ck[k]; const unsigned code = fm & 0xFFu;
        const unsigned k0 = WL[(code >> 4) * 64 + lane], k1 = WL[(16 + (code & 15u)) * 64 + lane];
        eo[k] = (int)(k0 * 128u + k1); go[k] = __expf(ord2f(fm & ~0xFFu) - mx) * rden; }
    int* ep = WSP(int, WS_EXP) + (size_t)(tok0 + c) * NSEL + h * 16 + hi * 8; float* gp = WSP(float, WS_GATE) + (size_t)(tok0 + c) * NSEL + h * 16 + hi * 8;
    *(int4*)ep = make_int4(eo[0], eo[1], eo[2], eo[3]); *(int4*)(ep + 4) = make_int4(eo[4], eo[5], eo[6], eo[7]);
    *(f32x4*)gp = (f32x4){go[0], go[1], go[2], go[3]}; *(f32x4*)(gp + 4) = (f32x4){go[4], go[5], go[6], go[7]};
}

typedef float f32x2 __attribute__((ext_vector_type(2)));
__device__ __forceinline__ int dot4i(unsigned a, unsigned b, int c) { return __builtin_amdgcn_sdot4((int)a, (int)b, c, false); }
template <int CTRL> __device__ __forceinline__ int dppi(int x) { return __builtin_amdgcn_mov_dpp(x, CTRL, 0xf, 0xf, true); }
struct PeerGeom { int ngrp, g, rank, nrank; };
__device__ __forceinline__ PeerGeom peer_geom(const Frame& F) { PeerGeom p; p.ngrp = (F.G % 8 == 0) ? 8 : 1; p.g = F.bid % p.ngrp; p.rank = F.bid / p.ngrp; p.nrank = F.G / p.ngrp; return p; }
__device__ __forceinline__ void xquant_token(const Frame& F, int tok, int lane) {
    const bf16* xr = WSP(bf16, WS_XB) + (size_t)tok * D + lane * 16; float xf[32]; float am = 0.f, sq = 0.f;
#pragma unroll
    for (int hh = 0; hh < 2; ++hh)
#pragma unroll
        for (int q = 0; q < 2; ++q) { const v4u w = *(const v4u*)(xr + hh * 1024 + q * 8); float t8[8]; unpack8(w, t8);
            const f32x4 g0 = *(const f32x4*)(F.in[I_G2N] + hh * 1024 + lane * 16 + q * 8), g1 = *(const f32x4*)(F.in[I_G2N] + hh * 1024 + lane * 16 + q * 8 + 4);
#pragma unroll
            for (int e = 0; e < 8; ++e) { const float xg = t8[e] * (e < 4 ? g0[e & 3] : g1[e & 3]); xf[hh * 16 + q * 8 + e] = xg; am = fmaxf(am, fabsf(xg)); sq += t8[e] * t8[e]; } }
#pragma unroll
    for (int o = 1; o < 64; o <<= 1) am = fmaxf(am, __shfl_xor(am, o));
    sq = wave_sum(sq);
    const float qs = am > 0.f ? 127.0f / am : 0.f;
    if (lane == 0) { WSP(float, WS_SX)[tok] = am * (1.0f / 127.0f); WSP(float, WS_SSQ2)[tok] = sq; }
#pragma unroll
    for (int hh = 0; hh < 2; ++hh) { v4u o;
#pragma unroll
        for (int d = 0; d < 4; ++d) { unsigned w = 0u;
#pragma unroll
            for (int e = 0; e < 4; ++e) { const int qi = (int)rintf(xf[hh * 16 + d * 4 + e] * qs); w |= ((unsigned)qi & 0xFFu) << (8 * e); }
            o[d] = w; }
        *(v4u*)(WSP(unsigned char, WS_XQ) + (size_t)tok * D + hh * 1024 + lane * 16) = o; }
}
struct PeerIds { int a, b; };
__device__ __forceinline__ PeerIds peer_ids_load(const Frame& F, int tok, int lane) { const int* ep = WSP(int, WS_EXP) + (size_t)tok * NSEL; PeerIds r; r.a = ep[lane]; r.b = ep[64 + lane]; return r; }
struct PeerScoreBuf { v4u w[16]; v4u xs; };
__device__ __forceinline__ void peer_score_issue(const Frame& F, int tok, int slice, int lane, LAS int* wl, const PeerIds& id, PeerScoreBuf& B) {
    const int e8 = lane >> 3, c16 = lane & 7;
    wl[lane] = id.a; wl[64 + lane] = id.b;
    B.xs = *(const v4u*)(WSP(unsigned char, WS_XQ) + (size_t)tok * D + slice * 128 + c16 * 16);
    const unsigned char* ub = WSP(unsigned char, WS_UT); const unsigned lo = (unsigned)(slice * 128 + c16 * 16);
#pragma unroll
    for (int ld = 0; ld < 16; ++ld) { const unsigned eid = (unsigned)wl[e8 * 16 + ld]; B.w[ld] = *(const v4u*)(ub + (eid * 2048u + lo)); }
}
__device__ __forceinline__ void peer_score_consume(const Frame& F, int tok, int slice, int lane, const PeerScoreBuf& B, bool valid) {
    int p[16];
#pragma unroll
    for (int ld = 0; ld < 16; ++ld) { const v4u w = B.w[ld]; int a = dot4i(w.x, B.xs.x, 0); a = dot4i(w.y, B.xs.y, a); a = dot4i(w.z, B.xs.z, a); p[ld] = dot4i(w.w, B.xs.w, a); }
    { const bool up = (lane & 4) != 0;
#pragma unroll
      for (int k = 0; k < 8; ++k) { const int keep = up ? p[k + 8] : p[k], send = up ? p[k] : p[k + 8]; p[k] = keep + dppi<0x141>(send); } }
    { const bool up = (lane & 2) != 0;
#pragma unroll
      for (int k = 0; k < 4; ++k) { const int keep = up ? p[k + 4] : p[k], send = up ? p[k] : p[k + 4]; p[k] = keep + dppi<0x4E>(send); } }
    { const bool up = (lane & 1) != 0;
#pragma unroll
      for (int k = 0; k < 2; ++k) { const int keep = up ? p[k + 2] : p[k], send = up ? p[k] : p[k + 2]; p[k] = keep + dppi<0xB1>(send); } }
    if (valid) { int* dst = WSP(int, WS_PART) + ((size_t)slice * T + tok) * NSEL + lane * 2; *(int2*)dst = make_int2(p[0], p[1]); }
}
__device__ __forceinline__ void peer_score_phase(const Frame& F, const PeerGeom& pg, LAS int* wl2) {
    const int lane = F.lane, first = pg.rank * NWAVES + F.wave, step = pg.nrank * NWAVES, n = first < T ? (T - first + step - 1) / step : 0;
    LAS int* wlA = wl2; LAS int* wlB = wl2 + 256;
#define PEER_TOKC(k_) ((first + (k_) * step) < T ? (first + (k_) * step) : T - 1)
    for (int r = 0; r < 16 / pg.ngrp; ++r) { const int slice = r * pg.ngrp + pg.g;
        PeerScoreBuf A, B; PeerIds id = peer_ids_load(F, PEER_TOKC(0), lane);
        { const PeerIds cur = id; id = peer_ids_load(F, PEER_TOKC(1), lane); asm volatile("" ::: "memory"); peer_score_issue(F, PEER_TOKC(0), slice, lane, wlA, cur, A); }
        for (int i = 0; i < n; i += 2) {
            { const PeerIds cur = id; id = peer_ids_load(F, PEER_TOKC(i + 2), lane); asm volatile("" ::: "memory"); peer_score_issue(F, PEER_TOKC(i + 1), slice, lane, wlB, cur, B); }
            peer_score_consume(F, first + i * step, slice, lane, A, true);
            { const PeerIds cur = id; id = peer_ids_load(F, PEER_TOKC(i + 3), lane); asm volatile("" ::: "memory"); peer_score_issue(F, PEER_TOKC(i + 2), slice, lane, wlA, cur, A); }
            peer_score_consume(F, first + (i + 1) * step, slice, lane, B, i + 1 < n);
        }
    }
}
__device__ __forceinline__ void peer_coef_token(const Frame& F, int tok, int lane) {
    int s0 = 0, s1 = 0;
#pragma unroll
    for (int s = 0; s < 16; ++s) { const int2 v = *(const int2*)(WSP(int, WS_PART) + ((size_t)s * T + tok) * NSEL + lane * 2); s0 += v.x; s1 += v.y; }
    const int2 ex = *(const int2*)(WSP(int, WS_EXP) + (size_t)tok * NSEL + lane * 2); const f32x2 ga = *(const f32x2*)(WSP(float, WS_GATE) + (size_t)tok * NSEL + lane * 2);
    const float rs = WSP(float, WS_SX)[tok] * (1.0f / sqrtf(WSP(float, WS_SSQ2)[tok] * (1.0f / D) + NORM_EPS));
    const float sc0 = (float)s0 * WSP(float, WS_USC)[ex.x] * rs, sc1 = (float)s1 * WSP(float, WS_USC)[ex.y] * rs;
    f32x2 c; c.x = ga.x * gelu_fast(sc0) * WSP(float, WS_VSC)[ex.x]; c.y = ga.y * gelu_fast(sc1) * WSP(float, WS_VSC)[ex.y];
    float cm = fmaxf(fabsf(c.x), fabsf(c.y));
#pragma unroll
    for (int o = 1; o < 64; o <<= 1) cm = fmaxf(cm, __shfl_xor(cm, o));
    const float qs = cm > 0.f ? 127.0f / cm : 0.f;
    const int q0 = (int)rintf(c.x * qs), q1 = (int)rintf(c.y * qs);
    ((unsigned short*)(F.ws + WS_COEF))[(size_t)tok * 64 + lane] = (unsigned short)(((unsigned)q0 & 0xFFu) | (((unsigned)q1 & 0xFFu) << 8));
    if (lane == 0) WSP(float, WS_CSC)[tok] = cm * (1.0f / 127.0f);
}
struct PeerOutBuf { v4u w[16]; v4u cq; unsigned x; float cs; };
__device__ __forceinline__ void peer_out_issue(const Frame& F, int tok, int slice, int lane, LAS int* wl, const PeerIds& id, PeerOutBuf& B) {
    const int e8 = lane >> 3, c16 = lane & 7;
    wl[lane] = id.a; wl[64 + lane] = id.b;
    B.cq = *(const v4u*)(F.ws + WS_COEF + (size_t)tok * 128 + e8 * 16);
    B.cs = WSP(float, WS_CSC)[tok];
    const unsigned char* vb = WSP(unsigned char, WS_VT); const unsigned lofs = (unsigned)(slice * 128 + c16 * 16);
#pragma unroll
    for (int ld = 0; ld < 16; ++ld) { const unsigned eid = (unsigned)wl[e8 * 16 + ld]; B.w[ld] = *(const v4u*)(vb + (eid * 2048u + lofs)); }
    B.x = *(const unsigned*)(WSP(bf16, WS_XB) + (size_t)tok * D + slice * 128 + c16 * 16 + e8 * 2);
}
__device__ __forceinline__ void peer_out_consume(const Frame& F, int tok, int slice, int lane, const PeerOutBuf& B, bool valid) {
    const int e8 = lane >> 3, c16 = lane & 7;
    int o[16];
#pragma unroll
    for (int i = 0; i < 16; ++i) o[i] = 0;
#pragma unroll
    for (int g = 0; g < 4; ++g) { const unsigned cq = B.cq[g];
#pragma unroll
        for (int d = 0; d < 4; ++d) { const unsigned w0 = B.w[4 * g][d], w1 = B.w[4 * g + 1][d], w2 = B.w[4 * g + 2][d], w3 = B.w[4 * g + 3][d];
            const unsigned lo01 = __builtin_amdgcn_perm(w1, w0, 0x05010400u), hi01 = __builtin_amdgcn_perm(w1, w0, 0x07030602u);
            const unsigned lo23 = __builtin_amdgcn_perm(w3, w2, 0x05010400u), hi23 = __builtin_amdgcn_perm(w3, w2, 0x07030602u);
            const unsigned t0 = __builtin_amdgcn_perm(lo23, lo01, 0x05040100u), t1 = __builtin_amdgcn_perm(lo23, lo01, 0x07060302u);
            const unsigned t2 = __builtin_amdgcn_perm(hi23, hi01, 0x05040100u), t3 = __builtin_amdgcn_perm(hi23, hi01, 0x07060302u);
            o[d * 4 + 0] = dot4i(t0, cq, o[d * 4 + 0]); o[d * 4 + 1] = dot4i(t1, cq, o[d * 4 + 1]); o[d * 4 + 2] = dot4i(t2, cq, o[d * 4 + 2]); o[d * 4 + 3] = dot4i(t3, cq, o[d * 4 + 3]); } }
#pragma unroll
    for (int k = 0; k < 8; ++k) { auto s = __builtin_amdgcn_permlane32_swap((unsigned)o[k], (unsigned)o[k + 8], false, false); o[k] = (int)(s[0] + s[1]); }
#pragma unroll
    for (int k = 0; k < 4; ++k) { auto s = __builtin_amdgcn_permlane16_swap((unsigned)o[k], (unsigned)o[k + 4], false, false); o[k] = (int)(s[0] + s[1]); }
    { const bool up = (lane & 8) != 0;
#pragma unroll
      for (int k = 0; k < 2; ++k) { const int keep = up ? o[k + 2] : o[k], send = up ? o[k] : o[k + 2]; o[k] = keep + dppi<0x128>(send); } }
    const float x0 = bf_lo(B.x) + (float)o[0] * B.cs, x1 = bf_hi(B.x) + (float)o[1] * B.cs;
    if (valid) *(unsigned*)(WSP(bf16, WS_XB) + (size_t)tok * D + slice * 128 + c16 * 16 + e8 * 2) = cvtpk(x0, x1);
}
__device__ __forceinline__ void peer_out_phase(const Frame& F, const PeerGeom& pg, LAS int* wl2) {
    const int lane = F.lane, first = pg.rank * NWAVES + F.wave, step = pg.nrank * NWAVES, n = first < T ? (T - first + step - 1) / step : 0;
    LAS int* wlA = wl2; LAS int* wlB = wl2 + 256;
    for (int r = 0; r < 16 / pg.ngrp; ++r) { const int slice = r * pg.ngrp + pg.g;
        PeerOutBuf A, B; PeerIds id = peer_ids_load(F, PEER_TOKC(0), lane);
        { const PeerIds cur = id; id = peer_ids_load(F, PEER_TOKC(1), lane); asm volatile("" ::: "memory"); peer_out_issue(F, PEER_TOKC(0), slice, lane, wlA, cur, A); }
        for (int i = 0; i < n; i += 2) {
            { const PeerIds cur = id; id = peer_ids_load(F, PEER_TOKC(i + 2), lane); asm volatile("" ::: "memory"); peer_out_issue(F, PEER_TOKC(i + 1), slice, lane, wlB, cur, B); }
            peer_out_consume(F, first + i * step, slice, lane, A, true);
            { const PeerIds cur = id; id = peer_ids_load(F, PEER_TOKC(i + 3), lane); asm volatile("" ::: "memory"); peer_out_issue(F, PEER_TOKC(i + 2), slice, lane, wlA, cur, A); }
            peer_out_consume(F, first + (i + 1) * step, slice, lane, B, i + 1 < n);
        }
    }
}
#undef PEER_TOKC
__device__ __forceinline__ void final_norm_phase(const Frame& F) {
    const int lane = F.lane, gw = F.bid * NWAVES + F.wave, NGW = F.G * NWAVES;
    const f32x4* gf = (const f32x4*)F.in[I_GF] + lane;
    f32x4 g[8];
#pragma unroll
    for (int j = 0; j < 8; ++j) g[j] = gf[64 * j];
    if (gw >= T) return;
    v2u va[8], vb[8]; float sa, sb;
#define FN_LOAD(v_, s_, tok_) do { const int tc_ = (tok_) < T ? (tok_) : T - 1; const v2u* xi_ = (const v2u*)(WSP(bf16, WS_XB) + (size_t)tc_ * D) + lane; \
        _Pragma("unroll") for (int j_ = 0; j_ < 8; ++j_) v_[j_] = xi_[64 * j_]; } while (0)
#define FN_STORE(v_, s_, tok_) do { f32x4* xo_ = (f32x4*)(F.out + (size_t)(tok_) * D) + lane; s_ = 0.f; f32x4 f_[8]; \
        _Pragma("unroll") for (int j_ = 0; j_ < 8; ++j_) { f_[j_] = (f32x4){bf_lo(v_[j_].x), bf_hi(v_[j_].x), bf_lo(v_[j_].y), bf_hi(v_[j_].y)}; s_ += (f_[j_][0] * f_[j_][0] + f_[j_][1] * f_[j_][1]) + (f_[j_][2] * f_[j_][2] + f_[j_][3] * f_[j_][3]); } \
        s_ = wave_sum(s_); const float rs_ = 1.0f / sqrtf(s_ * (1.0f / D) + NORM_EPS); \
        _Pragma("unroll") for (int j_ = 0; j_ < 8; ++j_) xo_[64 * j_] = f_[j_] * rs_ * g[j_]; } while (0)
    FN_LOAD(va, sa, gw);
    for (int tok = gw; tok < T; tok += 2 * NGW) {
        FN_LOAD(vb, sb, tok + NGW);
        FN_STORE(va, sa, tok);
        FN_LOAD(va, sa, tok + 2 * NGW);
        if (tok + NGW < T) FN_STORE(vb, sb, tok + NGW);
    }
#undef FN_LOAD
#undef FN_STORE
}

struct Args { const float* in[28]; float* out; unsigned char* ws; int ph_lo, ph_hi, li, pad; };
__global__ void __launch_bounds__(NTHR, 2) hybrid_fwd(Args args) {
    extern __shared__ __attribute__((aligned(16))) unsigned char lds[];
    Frame F;
    F.lds = (LAS unsigned char*)lds;
    F.tid = threadIdx.x; F.lane = F.tid & 63; F.wave = __builtin_amdgcn_readfirstlane(F.tid >> 6);
    F.G = gridDim.x; F.bid = blockIdx.x;
#pragma unroll
    for (int i = 0; i < 28; ++i) F.in[i] = args.in[i];
    F.out = args.out; F.ws = args.ws;
    volatile LAS unsigned* MISC = (volatile LAS unsigned*)(F.lds + MISC_OFF);
    for (int u = F.tid; u < (LDS_BYTES - LDSCTL_OFF) / 4; u += NTHR) ((LAS unsigned*)(F.lds + LDSCTL_OFF))[u] = 0u;
    __syncthreads();
    unsigned* barw = (unsigned*)(F.ws + WS_CTL) + CW_BAR;
    XcdBarrier bar; bar.bar = barw; bar.x = 0; bar.st = nullptr;
    if (N_LAUNCHES == 1) bar = xcd_barrier_post(barw, MISC + 8);
    const int lo = args.ph_lo, hi = args.ph_hi;
#define IN(k) (lo <= (k) && (k) < hi)
#define SEAM(k) do { if (IN(k) && IN((k) + 1)) xcd_barrier(bar); } while (0)

#ifndef PROBE_DUP
#define PROBE_DUP -1
#endif
#define REPS(k) for (int rep_ = 0; rep_ < ((PROBE_DUP) == (k) ? 2 : 1); ++rep_)
    if (IN(0)) REPS(0) { p0_prologue<0>(F, F.bid, F.G); __syncthreads(); }
    SEAM(0);
    if (IN(1)) REPS(1) {
        pg8::Gemm g{WSP(const bf16, WS_XB), WSP(const bf16, WS_WIN), T, NINP, D / 2}; pg8::StaticOrder S; S.init(T, NINP, F.G, F.bid);
        pg8::EpiI8RowColBf16<0> E{WSP(bf16, WS_PROJ), NINP, WSP(const float, WS_RSTD1), WSP(const float, WS_CS1), nullptr, NORM_EPS};
        pg8::gemm_phase<pg8::EpiI8RowColBf16<0>, pg8::StaticOrder, true, true, true>(F.lds, g, S, E);
    }
    SEAM(1);
    if (IN(2)) REPS(2) {
        lora_prepass(F);
        group_barrier((unsigned*)(F.ws + WS_CTL) + CW_PREBAR, (unsigned)F.G);
        for (int r4 = 0; r4 < ((PROBE_DUP) == 70 ? 2 : 1); ++r4) rwkv_prep_phase(F);
        group_barrier((unsigned*)(F.ws + WS_CTL) + CW_PREPBAR, (unsigned)F.G);
        const int R1 = F.G >= 256 ? 128 : F.G, L0 = F.G >= 256 ? 128 : 0, NL = F.G - L0;
        if (F.bid < R1) for (int it = F.bid; it < 128; it += R1) rwkv_item(F, it);
        if (F.bid >= L0) for (int it = F.bid - L0; it < 128; it += NL) lru_seq(F, it);
        { volatile LAS int* qslot = (volatile LAS int*)(F.lds + LDSCTL_OFF + 1024);
          for (;;) { __syncthreads(); if (F.tid == 0) *qslot = (int)xb_add((unsigned*)(F.ws + WS_CTL) + CW_DEFQ, 1u); __syncthreads();
              const int vb = *qslot; if (vb >= DEF_SLICES) break; p0_prologue<1>(F, vb, DEF_SLICES); } }
    }
    SEAM(2);
    if (IN(3)) {
        pg8::Gemm g{WSP(const bf16, WS_Y), WSP(const bf16, WS_WOUT), T, D, D}; pg8::StaticOrder S; S.init(T, D, F.G, F.bid);
        pg8::EpiResidual E{F.in[I_X], WSP(bf16, WS_XB), D};
        pg8::gemm_phase<pg8::EpiResidual, pg8::StaticOrder, true, true>(F.lds, g, S, E);
    }
    SEAM(3);
    if (IN(4)) { const int gw = F.bid * NWAVES + F.wave, NGW = F.G * NWAVES;
        for (int tok = gw; tok < T; tok += NGW) xquant_token(F, tok, F.lane); }
    SEAM(4);
    if (IN(5)) REPS(5) {
        pg8::Gemm g{WSP(const bf16, WS_XQ), WSP(const bf16, WS_WQ), T, D, D / 2}; pg8::StaticOrder S; S.init(T, D, F.G, F.bid);
        pg8::EpiI8RowColBf16<1> E{WSP(bf16, WS_Q), D, WSP(const float, WS_SX), WSP(const float, WS_CSQ), WSP(const float, WS_SSQ2), NORM_EPS};
        pg8::gemm_phase<pg8::EpiI8RowColBf16<1>, pg8::StaticOrder, true, true, true>(F.lds, g, S, E);
    }
    if (IN(5)) { __syncthreads();
        pg8::StaticOrder S; S.init(T, D, F.G, F.bid); pg8::Unit u;
        for (int i = 0; S.next(i, u); ++i) route_item(F, ((u.pm * 8 + F.wave) << 3) | u.pn, F.lane); }
    SEAM(5);
    { const PeerGeom pg = peer_geom(F); LAS int* wl = (LAS int*)(F.lds + F.wave * 1024);
      if (IN(6)) REPS(6) peer_score_phase(F, pg, (LAS int*)(F.lds + 16384 + F.wave * 2048));
      SEAM(6);
      if (IN(7)) REPS(7) { const int gw = F.bid * NWAVES + F.wave, NGW = F.G * NWAVES; for (int tok = gw; tok < T; tok += NGW) peer_coef_token(F, tok, F.lane); }
      SEAM(7);
      if (IN(8)) peer_out_phase(F, pg, (LAS int*)(F.lds + 16384 + F.wave * 2048));
      SEAM(8);
      if (IN(9)) final_norm_phase(F); }
#undef IN
#undef SEAM
}

extern "C" void kernel_launch(void* const* d_in, const int* in_sizes, int n_in, void* d_out, int out_size, void* d_ws, size_t ws_size, hipStream_t stream) {
    static int grid = 0;
    if (grid == 0) {
        if (n_in != 28 || in_sizes[0] != T * D || out_size != T * D || ws_size < WS_END) { fprintf(stderr, "kernel_launch: shape/workspace mismatch: n_in %d in0 %d out %d ws %zu (need %zu)\n", n_in, n_in > 0 ? in_sizes[0] : -1, out_size, ws_size, (size_t)WS_END); grid = -1; return; }
        int dev = 0, cus = 0, per_cu = 0;
        if (hipGetDevice(&dev) != hipSuccess || hipDeviceGetAttribute(&cus, hipDeviceAttributeMultiprocessorCount, dev) != hipSuccess) { fprintf(stderr, "kernel_launch: device query failed\n"); grid = -1; return; }
        if (hipFuncSetAttribute((const void*)hybrid_fwd, hipFuncAttributeMaxDynamicSharedMemorySize, LDS_BYTES) != hipSuccess) { fprintf(stderr, "kernel_launch: hipFuncSetAttribute failed\n"); grid = -1; return; }
        if (hipOccupancyMaxActiveBlocksPerMultiprocessor(&per_cu, (const void*)hybrid_fwd, NTHR, LDS_BYTES) != hipSuccess || per_cu < 1) { fprintf(stderr, "kernel_launch: occupancy query says %d blocks per CU\n", per_cu); per_cu = 1; }
        (void)hipGetLastError();
        grid = cus;
    }
    if (grid < 0) return;
    if (hipMemsetAsync((char*)d_ws + WS_CTL, 0, CTL_ZERO_BYTES, stream) != hipSuccess) { fprintf(stderr, "kernel_launch: hipMemsetAsync failed\n"); return; }
    Args a{};
    for (int i = 0; i < 28; ++i) a.in[i] = (const float*)d_in[i];
    a.out = (float*)d_out; a.ws = (unsigned char*)d_ws;
    for (int li = 0; li < N_LAUNCHES; ++li) {
        a.ph_lo = (N_LAUNCHES == 1) ? 0 : li; a.ph_hi = (N_LAUNCHES == 1) ? N_PHASES : li + 1; a.li = li;
        hipLaunchKernelGGL(hybrid_fwd, dim3(grid), dim3(NTHR), LDS_BYTES, stream, a);
        const hipError_t le = hipPeekAtLastError();
        if (le != hipSuccess) { fprintf(stderr, "kernel_launch: launch %d failed: %s\n", li, hipGetErrorName(le)); break; }
    }
}
```

```cpp
#include <hip/hip_runtime.h>
#include <cstdio>
#include <cstdint>
namespace pg8 {
#define PG8_LAS __attribute__((address_space(3)))
typedef unsigned short bf16_t;
typedef short bf16x8 __attribute__((ext_vector_type(8)));
typedef float f32x4 __attribute__((ext_vector_type(4)));
typedef unsigned u32x4 __attribute__((ext_vector_type(4)));
typedef int i32x4 __attribute__((ext_vector_type(4)));
constexpr int BM = 256, BK = 64, HALF = 128, HTB = HALF * BK * 2  , STAGE_BYTES = 8 * HTB, NXCD = 8, WGM = 8;

__host__ __device__ __forceinline__ int lds_byte(int r, int c) { const int st = (r >> 4) * 2 + (c >> 5), rr = r & 15, cc = c & 31, ob = rr * 64 + cc * 2; return st * 1024 + (ob ^ (((ob >> 9) & 1) << 5)); }
__host__ __device__ __forceinline__ void stage_rc(int b, int& R, int& C) { const int st = b / 1024, sb = b % 1024, swz = sb ^ (((sb >> 9) & 1) << 5); R = (st >> 1) * 16 + swz / 64; C = (st & 1) * 32 + (swz % 64) / 2; }
__host__ __device__ __forceinline__ int perm32(int rho) { const int n = rho >> 4, i = rho & 15; return 8 * (i >> 2) + 4 * n + (i & 3); }

struct Unit { int pm, pn; };
struct Gemm { const bf16_t* A; const bf16_t* Bt; int M, N, K; };

struct StaticOrder {
    int nM, nN, nwg, G, c;
    __host__ __device__ void init(int M, int N, int G_, int c_) { nM = M / BM; nN = N / BM; nwg = nM * nN; G = G_; c = c_; }
    __host__ __device__ bool next(int i, Unit& u) const {
        const long L = (long)i * G + c; if (L >= nwg) return false;
        int wgid = (int)L; { const int q = nwg / NXCD, r = nwg % NXCD, xcd = wgid % NXCD, off = wgid / NXCD; wgid = (xcd < r ? xcd * (q + 1) : r * (q + 1) + (xcd - r) * q) + off; }
        const int nig = WGM * nN, gid = wgid / nig, fm = gid * WGM, gsz = (nM - fm) < WGM ? (nM - fm) : WGM;
        u.pm = fm + ((wgid % nig) % gsz); u.pn = (wgid % nig) / gsz; return true;
    }
    __device__ __forceinline__ void a_ready(const Unit&) const {}
    __device__ __forceinline__ void done(const Unit&) const {}
};

__device__ __forceinline__ unsigned cvt_pk_bf16(float lo, float hi) { unsigned r; asm volatile("v_cvt_pk_bf16_f32 %0, %1, %2" : "=v"(r) : "v"(lo), "v"(hi)); return r; }
typedef float f32x2 __attribute__((ext_vector_type(2)));
typedef unsigned u32x2 __attribute__((ext_vector_type(2)));
template <int MODE> struct EpiRowScaleBf16 {
    static constexpr bool PERM = true, AFTER_DRAIN = false;
    bf16_t* O; int ldc; const float* rs; float eps;
    __device__ __forceinline__ void operator()(const f32x4 (&acc)[2][2][4][2], const Unit& u, int wr, int wc, int fr, int fq) const {
        const int row0 = u.pm * BM + wr * 64 + fr, col0 = u.pn * BM + wc * 32 + 8 * fq;
#pragma unroll
        for (int ai = 0; ai < 2; ++ai)
#pragma unroll
            for (int m = 0; m < 4; ++m) { const int r = row0 + ai * HALF + m * 16; float s = rs[r]; if (MODE == 1) s = 1.0f / sqrtf(s * (1.0f / 2048.0f) + eps);
                bf16_t* rowp = O + (size_t)r * ldc + col0;
#pragma unroll
                for (int bj = 0; bj < 2; ++bj) { const f32x4 v0 = acc[ai][bj][m][0] * s, v1 = acc[ai][bj][m][1] * s;
                    u32x4 w; w.x = cvt_pk_bf16(v0[0], v0[1]); w.y = cvt_pk_bf16(v0[2], v0[3]); w.z = cvt_pk_bf16(v1[0], v1[1]); w.w = cvt_pk_bf16(v1[2], v1[3]);
                    *(u32x4*)(rowp + bj * HALF) = w; } }
    }
};
template <int MODE> struct EpiI8RowColBf16 {
    static constexpr bool PERM = true, AFTER_DRAIN = false;
    bf16_t* O; int ldc; const float* rs; const float* cs; const float* ssq; float eps;
    __device__ __forceinline__ void operator()(const f32x4 (&acc)[2][2][4][2], const Unit& u, int wr, int wc, int fr, int fq) const {
        const int row0 = u.pm * BM + wr * 64 + fr, col0 = u.pn * BM + wc * 32 + 8 * fq;
        f32x4 c4[2][2];
#pragma unroll
        for (int bj = 0; bj < 2; ++bj) { c4[bj][0] = *(const f32x4*)(cs + col0 + bj * HALF); c4[bj][1] = *(const f32x4*)(cs + col0 + bj * HALF + 4); }
#pragma unroll
        for (int ai = 0; ai < 2; ++ai)
#pragma unroll
            for (int m = 0; m < 4; ++m) { const int r = row0 + ai * HALF + m * 16; float s = rs[r]; if (MODE == 1) s = s / sqrtf(ssq[r] * (1.0f / 2048.0f) + eps);
                bf16_t* rowp = O + (size_t)r * ldc + col0;
#pragma unroll
                for (int bj = 0; bj < 2; ++bj) { f32x4 v0, v1; const i32x4 i0 = __builtin_bit_cast(i32x4, acc[ai][bj][m][0]), i1 = __builtin_bit_cast(i32x4, acc[ai][bj][m][1]);
#pragma unroll
                    for (int e = 0; e < 4; ++e) { v0[e] = (float)i0[e] * s * c4[bj][0][e]; v1[e] = (float)i1[e] * s * c4[bj][1][e]; }
                    u32x4 w; w.x = cvt_pk_bf16(v0[0], v0[1]); w.y = cvt_pk_bf16(v0[2], v0[3]); w.z = cvt_pk_bf16(v1[0], v1[1]); w.w = cvt_pk_bf16(v1[2], v1[3]);
                    *(u32x4*)(rowp + bj * HALF) = w; } }
    }
};
struct EpiResidual {
    static constexpr bool PERM = false, AFTER_DRAIN = false;
    const float* base; bf16_t* outb; int ldc;
    __device__ __forceinline__ void operator()(const f32x4 (&acc)[2][2][4][2], const Unit& u, int wr, int wc, int fr, int fq) const {
        const int row0 = u.pm * BM + wr * 64 + fr, col0 = u.pn * BM + wc * 32 + 4 * fq;
#pragma unroll
        for (int ai = 0; ai < 2; ++ai)
#pragma unroll
            for (int m = 0; m < 4; ++m) { const int r = row0 + ai * HALF + m * 16; const size_t off = (size_t)r * ldc + col0;
#pragma unroll
                for (int bj = 0; bj < 2; ++bj)
#pragma unroll
                    for (int n = 0; n < 2; ++n) { const f32x4 bs = *(const f32x4*)(base + off + bj * HALF + n * 16); const f32x4 o = bs + acc[ai][bj][m][n];
                        u32x2 w; w.x = cvt_pk_bf16(o[0], o[1]); w.y = cvt_pk_bf16(o[2], o[3]); *(u32x2*)(outb + off + bj * HALF + n * 16) = w; } }
    }
};
struct EpiI8Residual {
    static constexpr bool PERM = true, AFTER_DRAIN = false;
    const float* base; bf16_t* outb; int ldc; const float* rs; const float* cs;
    __device__ __forceinline__ void operator()(const f32x4 (&acc)[2][2][4][2], const Unit& u, int wr, int wc, int fr, int fq) const {
        const int row0 = u.pm * BM + wr * 64 + fr, col0 = u.pn * BM + wc * 32 + 8 * fq;
        f32x4 c4[2][2];
#pragma unroll
        for (int bj = 0; bj < 2; ++bj) { c4[bj][0] = *(const f32x4*)(cs + col0 + bj * HALF); c4[bj][1] = *(const f32x4*)(cs + col0 + bj * HALF + 4); }
#pragma unroll
        for (int ai = 0; ai < 2; ++ai)
#pragma unroll
            for (int m = 0; m < 4; ++m) { const int r = row0 + ai * HALF + m * 16; const float s = rs[r]; const size_t off = (size_t)r * ldc + col0;
#pragma unroll
                for (int bj = 0; bj < 2; ++bj) { const i32x4 i0 = __builtin_bit_cast(i32x4, acc[ai][bj][m][0]), i1 = __builtin_bit_cast(i32x4, acc[ai][bj][m][1]);
                    const f32x4 b0 = *(const f32x4*)(base + off + bj * HALF), b1 = *(const f32x4*)(base + off + bj * HALF + 4); f32x4 v0, v1;
#pragma unroll
                    for (int e = 0; e < 4; ++e) { v0[e] = b0[e] + (float)i0[e] * s * c4[bj][0][e]; v1[e] = b1[e] + (float)i1[e] * s * c4[bj][1][e]; }
                    u32x4 w; w.x = cvt_pk_bf16(v0[0], v0[1]); w.y = cvt_pk_bf16(v0[2], v0[3]); w.z = cvt_pk_bf16(v1[0], v1[1]); w.w = cvt_pk_bf16(v1[2], v1[3]);
                    *(u32x4*)(outb + off + bj * HALF) = w; } }
    }
};
template <class Epi, class Sched, bool ALIGN_EPI = false, bool SP2 = false, bool I8 = false>
__device__ __forceinline__ void gemm_phase(PG8_LAS unsigned char* lds, const Gemm g, const Sched& S, const Epi& E) {
    const int tid = threadIdx.x, wid = __builtin_amdgcn_readfirstlane(tid >> 6), lane = tid & 63, wr = wid >> 2, wc = wid & 3, fr = lane & 15, fq = lane >> 4;
    const int K = g.K, nt = K / BK;
    unsigned voffA[2], voffB[2];
#pragma unroll
    for (int i = 0; i < 2; ++i) { int R, C; stage_rc(tid * 16 + i * 8192, R, C); const int Rb = Epi::PERM ? ((R & ~31) + perm32(R & 31)) : R;
        voffA[i] = (unsigned)(R * K + C) * 2u; voffB[i] = (unsigned)(Rb * K + C) * 2u; }
    const size_t kstep = (size_t)(BK * 2);
    const size_t hstep = (size_t)HALF * K * 2;
    const size_t tstep = 2 * hstep;
    const unsigned ldsw = (unsigned)wid * 1024u;
    const int aoff = lds_byte(wr * 64 + fr, fq * 8), boff = lds_byte(wc * 32 + fr, fq * 8);
#define PG8_SA(b, h) (((b) * 2 + (h)) * HTB)
#define PG8_SB(b, h) ((4 + (b) * 2 + (h)) * HTB)
#define PG8_STAGE(bufoff, gbase, voff) do { _Pragma("unroll") for (int _i = 0; _i < 2; ++_i) \
        __builtin_amdgcn_global_load_lds((const unsigned*)((const char*)(gbase) + (voff)[_i]), (PG8_LAS unsigned*)(lds + (bufoff) + ldsw + _i * 8192), 16, 0, 0); } while (0)
#define PG8_LDA(dst, b, h) do { _Pragma("unroll") for (int m = 0; m < 4; ++m) _Pragma("unroll") for (int k = 0; k < 2; ++k) dst[m][k] = *(const PG8_LAS bf16x8*)(lds + PG8_SA(b, h) + aoff + m * 2048 + k * 1024); } while (0)
#define PG8_LDB(dst, b, h) do { _Pragma("unroll") for (int n = 0; n < 2; ++n) _Pragma("unroll") for (int k = 0; k < 2; ++k) dst[n][k] = *(const PG8_LAS bf16x8*)(lds + PG8_SB(b, h) + boff + n * 2048 + k * 1024); } while (0)
#define PG8_MMA(ai, bj, At, Bt) do { __builtin_amdgcn_s_setprio(1); _Pragma("unroll") for (int m = 0; m < 4; ++m) _Pragma("unroll") for (int n = 0; n < 2; ++n) _Pragma("unroll") for (int k = 0; k < 2; ++k) \
        { if constexpr (I8) acc[ai][bj][m][n] = __builtin_bit_cast(f32x4, __builtin_amdgcn_mfma_i32_16x16x64_i8(__builtin_bit_cast(i32x4, Bt[n][k]), __builtin_bit_cast(i32x4, At[m][k]), __builtin_bit_cast(i32x4, acc[ai][bj][m][n]), 0, 0, 0)); \
          else acc[ai][bj][m][n] = __builtin_amdgcn_mfma_f32_16x16x32_bf16(Bt[n][k], At[m][k], acc[ai][bj][m][n], 0, 0, 0); } __builtin_amdgcn_s_setprio(0); } while (0)
#define PG8_WAIT_V(n) asm volatile("s_waitcnt vmcnt(" #n ")" ::: "memory")
#define PG8_WAIT_L(n) asm volatile("s_waitcnt lgkmcnt(" #n ")" ::: "memory")
#define PG8_BAR __builtin_amdgcn_s_barrier()
#define PG8_SCHED __builtin_amdgcn_sched_barrier(0)
    Unit cur, nxt; int ui = 0;
    if (!S.next(0, cur)) return;
    f32x4 acc[2][2][4][2];
#pragma unroll
    for (int a = 0; a < 2; ++a)
#pragma unroll
        for (int b = 0; b < 2; ++b)
#pragma unroll
            for (int m = 0; m < 4; ++m)
#pragma unroll
                for (int n = 0; n < 2; ++n) acc[a][b][m][n] = (f32x4){0.f, 0.f, 0.f, 0.f};
    bf16x8 At[4][2], B0[2][2], B1[2][2];
    const char* cA = (const char*)g.A + (size_t)cur.pm * tstep; const char* cB = (const char*)g.Bt + (size_t)cur.pn * tstep;
    S.a_ready(cur);
    if constexpr (SP2) {
        PG8_STAGE(PG8_SB(0, 0), cB, voffB); PG8_STAGE(PG8_SB(0, 1), cB + hstep, voffB); PG8_STAGE(PG8_SA(0, 0), cA, voffA); PG8_STAGE(PG8_SA(0, 1), cA + hstep, voffA);
        if (wr == 1) PG8_BAR;
        PG8_WAIT_V(2); PG8_BAR;
        PG8_STAGE(PG8_SB(1, 0), cB + kstep, voffB); PG8_STAGE(PG8_SA(1, 0), cA + kstep, voffA); PG8_STAGE(PG8_SB(1, 1), cB + hstep + kstep, voffB);
        PG8_WAIT_V(6); PG8_BAR;
    } else {
        PG8_STAGE(PG8_SB(0, 0), cB, voffB); PG8_STAGE(PG8_SA(0, 0), cA, voffA); PG8_STAGE(PG8_SB(0, 1), cB + hstep, voffB); PG8_STAGE(PG8_SA(0, 1), cA + hstep, voffA);
        if (wr == 1) PG8_BAR;
        PG8_WAIT_V(4); PG8_BAR;
        PG8_STAGE(PG8_SB(1, 0), cB + kstep, voffB); PG8_STAGE(PG8_SA(1, 0), cA + kstep, voffA); PG8_STAGE(PG8_SB(1, 1), cB + hstep + kstep, voffB);
        PG8_WAIT_V(6); PG8_BAR;
    }
    for (;;) {
        const bool has_next = S.next(ui + 1, nxt);
        const char* nA = has_next ? (const char*)g.A + (size_t)nxt.pm * tstep : cA; const char* nB = has_next ? (const char*)g.Bt + (size_t)nxt.pn * tstep : cB;
        for (int t = 0; t < nt; t += 2) {
            const bool last = (t == nt - 2);
            const char* a1 = cA + (size_t)(t + 1) * kstep;
            const char* a2 = last ? nA : cA + (size_t)(t + 2) * kstep; const char* b2 = last ? nB : cB + (size_t)(t + 2) * kstep;
            const char* a3 = a2 + kstep; const char* b3 = b2 + kstep;
            if (last && has_next) S.a_ready(nxt);
            if constexpr (SP2) {
            PG8_LDB(B0, 0, 0); PG8_LDB(B1, 0, 1); PG8_SCHED; PG8_LDA(At, 0, 0); PG8_STAGE(PG8_SA(1, 1), a1 + hstep, voffA);
            PG8_WAIT_V(8); PG8_WAIT_L(0); PG8_BAR; PG8_MMA(0, 0, At, B0); PG8_MMA(0, 1, At, B1); PG8_BAR; PG8_SCHED;
            PG8_LDA(At, 0, 1); PG8_STAGE(PG8_SB(0, 0), b2, voffB); PG8_STAGE(PG8_SB(0, 1), b2 + hstep, voffB); PG8_STAGE(PG8_SA(0, 0), a2, voffA);
            PG8_WAIT_V(8); PG8_WAIT_L(0); PG8_BAR; PG8_MMA(1, 0, At, B0); PG8_MMA(1, 1, At, B1); PG8_BAR; PG8_SCHED;
            PG8_LDB(B0, 1, 0); PG8_LDB(B1, 1, 1); PG8_SCHED; PG8_LDA(At, 1, 0); PG8_STAGE(PG8_SA(0, 1), a2 + hstep, voffA);
            PG8_WAIT_V(8); PG8_WAIT_L(0); PG8_BAR; PG8_MMA(0, 0, At, B0); PG8_MMA(0, 1, At, B1); PG8_BAR; PG8_SCHED;
            PG8_LDA(At, 1, 1); PG8_STAGE(PG8_SB(1, 0), b3, voffB); PG8_STAGE(PG8_SB(1, 1), b3 + hstep, voffB); PG8_STAGE(PG8_SA(1, 0), a3, voffA);
            PG8_WAIT_V(8); PG8_WAIT_L(0); PG8_BAR; PG8_MMA(1, 0, At, B0); PG8_MMA(1, 1, At, B1); PG8_BAR; PG8_SCHED;
            } else {
            PG8_LDB(B0, 0, 0); PG8_SCHED; PG8_LDA(At, 0, 0); PG8_STAGE(PG8_SA(1, 1), a1 + hstep, voffA);
            PG8_WAIT_L(8); PG8_BAR; PG8_WAIT_L(0); PG8_MMA(0, 0, At, B0); PG8_BAR; PG8_SCHED;
            PG8_LDB(B1, 0, 1); PG8_STAGE(PG8_SB(0, 0), b2, voffB);
            PG8_BAR; PG8_WAIT_L(0); PG8_MMA(0, 1, At, B1); PG8_BAR;
            PG8_LDA(At, 0, 1); PG8_STAGE(PG8_SA(0, 0), a2, voffA);
            PG8_BAR; PG8_WAIT_L(0); PG8_MMA(1, 0, At, B0); PG8_BAR; PG8_SCHED;
            PG8_STAGE(PG8_SB(0, 1), b2 + hstep, voffB);
            PG8_WAIT_V(6); PG8_BAR; PG8_MMA(1, 1, At, B1); PG8_BAR;
            PG8_LDB(B0, 1, 0); PG8_SCHED; PG8_LDA(At, 1, 0); PG8_STAGE(PG8_SA(0, 1), a2 + hstep, voffA);
            PG8_WAIT_L(8); PG8_BAR; PG8_WAIT_L(0); PG8_MMA(0, 0, At, B0); PG8_BAR; PG8_SCHED;
            PG8_LDB(B1, 1, 1); PG8_STAGE(PG8_SB(1, 0), b3, voffB);
            PG8_BAR; PG8_WAIT_L(0); PG8_MMA(0, 1, At, B1); PG8_BAR;
            PG8_LDA(At, 1, 1); PG8_STAGE(PG8_SA(1, 0), a3, voffA);
            PG8_BAR; PG8_WAIT_L(0); PG8_MMA(1, 0, At, B0); PG8_BAR; PG8_SCHED;
            PG8_STAGE(PG8_SB(1, 1), b3 + hstep, voffB);
            PG8_WAIT_V(6); PG8_BAR; PG8_MMA(1, 1, At, B1); PG8_BAR;
            }
        }
        if constexpr (ALIGN_EPI) { if (wr == 0) PG8_BAR; }
        if constexpr (!Epi::AFTER_DRAIN) { E(acc, cur, wr, wc, fr, fq); S.done(cur); }
        if (!has_next) break;
#pragma unroll
        for (int a = 0; a < 2; ++a)
#pragma unroll
            for (int b = 0; b < 2; ++b)
#pragma unroll
                for (int m = 0; m < 4; ++m)
#pragma unroll
                    for (int n = 0; n < 2; ++n) acc[a][b][m][n] = (f32x4){0.f, 0.f, 0.f, 0.f};
        cur = nxt; cA = nA; cB = nB; ++ui;
        if constexpr (ALIGN_EPI) { if (wr == 1) PG8_BAR; }
    }
    PG8_WAIT_V(0);
    if constexpr (!ALIGN_EPI) { if (wr == 0) PG8_BAR; }
    PG8_BAR;
    if constexpr (Epi::AFTER_DRAIN) { E.fused(acc, cur, wr, wc, fr, fq, lds, wid, lane); S.done(cur); }
#undef PG8_SA
#undef PG8_SB
#undef PG8_STAGE
#undef PG8_LDA
#undef PG8_LDB
#undef PG8_MMA
#undef PG8_WAIT_V
#undef PG8_WAIT_L
#undef PG8_BAR
#undef PG8_SCHED
}
}

#ifndef PROBE_DUP
#define PROBE_DUP -1
#endif
constexpr int NWAVES = 8, NTHR = NWAVES * 64;
#ifndef MK_N_LAUNCHES
#define MK_N_LAUNCHES 1
#endif
constexpr int N_PHASES = 11;
constexpr int DEF_SLICES = 256;
constexpr int N_LAUNCHES = MK_N_LAUNCHES;
static_assert(N_LAUNCHES == 1 || N_LAUNCHES == N_PHASES, "MK_N_LAUNCHES is 1 or N_PHASES");

constexpr int BATCH = 8, SEQ = 2048, T = BATCH * SEQ, D = 2048;
constexpr int NIN = 5408, NINP = 5632;
constexpr int PC_GATE = 1024, PC_R = 2048, PC_K = 3072, PC_V = 4096, PC_WD = 5120, PC_AD = 5184, PC_GD = 5248;
constexpr int RWKV_C0 = 2048;
constexpr int NEXP = 16384, NSEL = 128;
constexpr float NORM_EPS = 1e-6f, GN_EPS = 64e-5f;

constexpr size_t MiB = 1u << 20;
constexpr size_t WS_CTL = 0, CTL_ZERO_BYTES = 1 * MiB;
constexpr size_t WS_SSQ3 = 576 * 1024;
constexpr size_t WS_SSQ2 = 512 * 1024;
constexpr size_t WS_RSTD1 = 1 * MiB;
constexpr size_t WS_USC = 1 * MiB + 64 * 1024, WS_VSC = 1 * MiB + 128 * 1024;
constexpr size_t WS_SX = 1 * MiB + 192 * 1024;
constexpr size_t WS_CS1 = 1 * MiB + 256 * 1024;
constexpr size_t WS_CSQ = 1 * MiB + 288 * 1024;
constexpr size_t WS_CSO = 1 * MiB + 296 * 1024;
constexpr size_t WS_SY = 1 * MiB + 320 * 1024;
constexpr size_t WS_WIN = 2 * MiB;
constexpr size_t WS_WOUT = 24 * MiB;
constexpr size_t WS_WQ = 32 * MiB;
constexpr size_t WS_KEYS = 40 * MiB;
constexpr size_t WS_W2T = WS_KEYS + 512 * 1024;
constexpr size_t WS_A2T = WS_W2T + 128 * 1024;
constexpr size_t WS_G2T = WS_A2T + 128 * 1024;
constexpr size_t WS_WAT = WS_G2T + 320 * 1024;
constexpr size_t WS_WIT = WS_WAT + 256 * 1024;
constexpr size_t WS_EXP = 42 * MiB;
constexpr size_t WS_GATE = 50 * MiB;
constexpr size_t WS_LA = 42 * MiB;
constexpr size_t WS_SUMM = 58 * MiB;
constexpr size_t WS_TA = 64 * MiB, WS_TB = 96 * MiB, WS_TK = 400 * MiB, WS_TR = 464 * MiB;
constexpr size_t OUT_TV = 0, OUT_TG = 32 * MiB, OUT_PC = 64 * MiB, OUT_BON = 66 * MiB;
constexpr size_t WS_XB = 64 * MiB;
constexpr size_t WS_PROJ = 128 * MiB;
constexpr size_t WS_Q = WS_PROJ;
constexpr size_t WS_YQ = WS_PROJ;
constexpr size_t WS_PART = 192 * MiB;
constexpr size_t WS_XQ = 320 * MiB;
constexpr size_t WS_COEF = 352 * MiB;
constexpr size_t WS_CSC = 356 * MiB;
constexpr size_t WS_Y = 304 * MiB;
constexpr size_t WS_UT = 368 * MiB;
constexpr size_t WS_VT = 432 * MiB;
constexpr size_t WS_END = 496 * MiB;
static_assert(WS_WIT + 256 * 1024 <= WS_EXP && WS_PROJ + (size_t)T * NINP * 2 <= WS_Y && WS_WIN + (size_t)NINP * D * 2 <= WS_WOUT, "d_ws map");
constexpr int CW_DEFQ = 2240;
constexpr int CW_PREPBAR = 2176;
constexpr int CW_PREBAR = 2112;
constexpr int CW_LRUBAR = 2048;
constexpr int CW_BAR = 4096;

constexpr int RING_BYTES = 131072;
constexpr int LDSCTL_OFF = 143360, MISC_OFF = LDSCTL_OFF + 320;
constexpr int LDS_BYTES = 147456;

#define GAS __attribute__((address_space(1)))
#define LAS __attribute__((address_space(3)))
typedef unsigned short bf16;
typedef unsigned v4u __attribute__((ext_vector_type(4)));
typedef unsigned v2u __attribute__((ext_vector_type(2)));
typedef float f32x4 __attribute__((ext_vector_type(4)));
typedef float f32x16 __attribute__((ext_vector_type(16)));
typedef short bf16x8 __attribute__((ext_vector_type(8)));
typedef __bf16 bf16x2_t __attribute__((ext_vector_type(2)));
typedef GAS unsigned gu32;
#define RLX_AGENT __ATOMIC_RELAXED, __HIP_MEMORY_SCOPE_AGENT
__device__ __forceinline__ unsigned f2bf(float f) { unsigned u = __builtin_bit_cast(unsigned, f); return (u + 0x7fffu + ((u >> 16) & 1u)) >> 16; }
__device__ __forceinline__ unsigned pk2(float lo, float hi) { return f2bf(lo) | (f2bf(hi) << 16); }
__device__ __forceinline__ float bf_lo(unsigned w) { return __uint_as_float(w << 16); }
__device__ __forceinline__ float bf_hi(unsigned w) { return __uint_as_float(w & 0xffff0000u); }
__device__ __forceinline__ void unpack8(const v4u& w, float (&o)[8]) { o[0] = bf_lo(w.x); o[1] = bf_hi(w.x); o[2] = bf_lo(w.y); o[3] = bf_hi(w.y); o[4] = bf_lo(w.z); o[5] = bf_hi(w.z); o[6] = bf_lo(w.w); o[7] = bf_hi(w.w); }
__device__ __forceinline__ v4u pack8(const float (&o)[8]) { v4u w; w.x = pk2(o[0], o[1]); w.y = pk2(o[2], o[3]); w.z = pk2(o[4], o[5]); w.w = pk2(o[6], o[7]); return w; }
__device__ __forceinline__ float sigmoidf_(float x) { return 1.0f / (1.0f + __expf(-x)); }
__device__ __forceinline__ float softplusf_(float z) { return fmaxf(z, 0.f) + log1pf(__expf(-fabsf(z))); }
__device__ __forceinline__ float gelu_tanh(float x) { const float u = 0.7978845608028654f * (x + 0.044715f * x * x * x); return 0.5f * x * (1.0f + tanhf(u)); }
template <int CTRL> __device__ __forceinline__ float dppf(float x) { return __builtin_bit_cast(float, __builtin_amdgcn_mov_dpp(__builtin_bit_cast(int, x), CTRL, 0xf, 0xf, true)); }
__device__ __forceinline__ float red8(float v) { v += dppf<0xB1>(v); v += dppf<0x4E>(v); v += dppf<0x141>(v); return v; }
__device__ __forceinline__ float red16(float v) { v = red8(v); v += dppf<0x140>(v); return v; }
__device__ __forceinline__ float wave_sum(float v) {
#pragma unroll
    for (int o = 1; o < 64; o <<= 1) v += __shfl_xor(v, o);
    return v;
}
__device__ __forceinline__ float dot2bf(unsigned a, unsigned b, float acc) { return __builtin_amdgcn_fdot2_f32_bf16(__builtin_bit_cast(bf16x2_t, a), __builtin_bit_cast(bf16x2_t, b), acc, false); }
#define MFMA16(a, b, c) __builtin_amdgcn_mfma_f32_16x16x32_bf16((a), (b), (c), 0, 0, 0)
#define MFMA32(a, b, c) __builtin_amdgcn_mfma_f32_32x32x16_bf16((a), (b), (c), 0, 0, 0)

#define XB_TMO      128
#define XB_XCNT(j)  (256  + 64 * (j))
#define XB_XSUB(j)  (1280 + 64 * (j))
#define XB_XGEN(j)  (2304 + 64 * (j))
#define XB_TOP      3328
#define XB_TOPGEN   3392
#define XCD_BAR_WORDS 3456
#define XB_SPIN_CAP (1u << 22)
__device__ __forceinline__ unsigned xb_ld(unsigned* p)              { return __hip_atomic_load(p, __ATOMIC_RELAXED, __HIP_MEMORY_SCOPE_AGENT); }
__device__ __forceinline__ unsigned xb_add(unsigned* p, unsigned v) { return __hip_atomic_fetch_add(p, v, __ATOMIC_RELAXED, __HIP_MEMORY_SCOPE_AGENT); }
__device__ __forceinline__ unsigned xb_xcc_id() { return (unsigned)__builtin_amdgcn_s_getreg((3 << 11) | 20) & 0xFu; }
#define XB_SPIN(cond, bar) do { unsigned _sp = 0; while (cond) { __builtin_amdgcn_s_sleep(1); \
    if ((++_sp & 255u) == 0u) { if (xb_ld(&(bar)[XB_TMO])) break; if (_sp > XB_SPIN_CAP) { atomicAdd(&(bar)[XB_TMO], 1u); break; } } } } while (0)
struct XcdBarrier { unsigned* bar; unsigned x; volatile LAS unsigned* st; };
__device__ __forceinline__ XcdBarrier xcd_barrier_post(unsigned* bar, volatile LAS unsigned* st) {
    XcdBarrier b; b.bar = bar; b.x = xb_xcc_id(); b.st = st;
    if (threadIdx.x == 0) (void)xb_add(&bar[XB_XCNT(b.x)], 1u);
    return b;
}
__device__ __forceinline__ void xcd_barrier_complete(unsigned* bar, unsigned x, unsigned& nloc, unsigned& nx) {
    const unsigned G = gridDim.x * gridDim.y * gridDim.z;
    unsigned sum, cnt, mine, sp = 0u;
    for (;;) {
        sum = 0u; cnt = 0u; mine = 0u;
#pragma unroll
        for (unsigned j = 0; j < 16; ++j) { const unsigned c = xb_ld(&bar[XB_XCNT(j)]); sum += c; cnt += (c > 0u) ? 1u : 0u; mine = (j == x) ? c : mine; }
        if (sum == G) break;
        __builtin_amdgcn_s_sleep(1);
        if ((++sp & 255u) == 0u) { if (xb_ld(&bar[XB_TMO])) break; if (sp > XB_SPIN_CAP) { atomicAdd(&bar[XB_TMO], 1u); break; } }
    }
    nloc = mine > 0u ? mine : 1u; nx = cnt > 0u ? cnt : 1u;
}
__device__ __forceinline__ void xcd_barrier(const XcdBarrier& b) {
    asm volatile("s_waitcnt vmcnt(0)" ::: "memory");
    __syncthreads();
    if (threadIdx.x == 0) {
        unsigned* bar = b.bar;
        __builtin_amdgcn_s_waitcnt(0);
        unsigned nloc = b.st[0], nx = b.st[1];
        if (nloc == 0u) { xcd_barrier_complete(bar, b.x, nloc, nx); b.st[0] = nloc; b.st[1] = nx; }
        const unsigned old = xb_add(&bar[XB_XSUB(b.x)], 1u);
        const unsigned gen = old / nloc;
        if (old + 1u == (gen + 1u) * nloc) {
            __builtin_amdgcn_fence(__ATOMIC_RELEASE, "agent");
            asm volatile("s_waitcnt vmcnt(0)" ::: "memory");
            const unsigned og = xb_add(&bar[XB_TOP], 1u);
            const unsigned tg = og / nx;
            if (og + 1u == (tg + 1u) * nx) xb_add(&bar[XB_TOPGEN], 1u);
            else XB_SPIN(xb_ld(&bar[XB_TOPGEN]) == tg, bar);
            __builtin_amdgcn_fence(__ATOMIC_ACQUIRE, "agent");
            xb_add(&bar[XB_XGEN(b.x)], 1u);
            asm volatile("s_waitcnt vmcnt(0)" ::: "memory");
        } else {
            XB_SPIN(xb_ld(&bar[XB_XGEN(b.x)]) == gen, bar);
            __builtin_amdgcn_fence(__ATOMIC_ACQUIRE, "agent");
            asm volatile("s_waitcnt vmcnt(0)" ::: "memory");
        }
    }
    __syncthreads();
}

struct Frame {
    LAS unsigned char* lds;
    int tid, lane, wave, G, bid;
    const float* in[28];
    float* out;
    unsigned char* ws;
};
#define WSP(type, off) ((type*)(F.ws + (off)))
enum { I_X = 0, I_G1, I_WIN, I_CONVW, I_CONVB, I_WA, I_BA, I_WI, I_BI, I_LAM, I_MU, I_W0, I_W2, I_A0, I_A2, I_G2, I_KK, I_KA, I_RK, I_LNW, I_LNB, I_WOUT, I_G2N, I_WQ, I_KEYS, I_U, I_V, I_GF };

__device__ __forceinline__ void p0_transpose_item(const float* W, int K, int N, bf16* WT, const float* ksc, LAS float* scr, int item, int lane) {
    const int nblk = N / 32, kb = item / nblk, nb = item % nblk, k0 = 64 * kb, n0 = 32 * nb;
    const int lr = lane >> 3, c4 = (lane & 7) * 4;
    f32x4 v[8];
#pragma unroll
    for (int i = 0; i < 8; ++i) v[i] = *(const f32x4*)(W + (size_t)(k0 + 8 * i + lr) * N + n0 + c4);
#pragma unroll
    for (int i = 0; i < 8; ++i) { const int kk = 8 * i + lr; const float sc = ksc ? ksc[k0 + kk] : 1.0f; LAS float* d = scr + kk * 33 + c4; d[0] = v[i][0] * sc; d[1] = v[i][1] * sc; d[2] = v[i][2] * sc; d[3] = v[i][3] * sc; }
    asm volatile("s_waitcnt lgkmcnt(0)" ::: "memory");
    const int c = lane & 7;
#pragma unroll
    for (int j = 0; j < 4; ++j) { const int n = (lane >> 3) + 8 * j; const LAS float* s = scr + (8 * c) * 33 + n;
        v4u o; o.x = pk2(s[0 * 33], s[1 * 33]); o.y = pk2(s[2 * 33], s[3 * 33]); o.z = pk2(s[4 * 33], s[5 * 33]); o.w = pk2(s[6 * 33], s[7 * 33]);
        *(v4u*)(WT + (size_t)(n0 + n) * K + k0 + 8 * c) = o; }
    asm volatile("s_waitcnt lgkmcnt(0)" ::: "memory");
}
template <bool HASK> __device__ __forceinline__ void p0_wquant_block(const float* W, int N, unsigned char* WT8, float* cs, const float* ksc, int item, int wave, int lane, LAS float* mxs) {
    asm volatile("" : "+v"(lane));
    const int n0 = item * 32, r = lane >> 3, c4 = lane & 7, kb = 256 * wave + 4 * r;
    const float* src = W + (size_t)kb * N + n0 + 4 * c4; const float* kp = ksc + kb;
    f32x4 mx = (f32x4){0.f, 0.f, 0.f, 0.f};
#pragma unroll
    for (int i2 = 0; i2 < 2; ++i2) { f32x4 v[4][4], g4[4];
#pragma unroll
        for (int ii = 0; ii < 4; ++ii) { g4[ii] = HASK ? *(const f32x4*)(kp + 32 * (i2 * 4 + ii)) : (f32x4){1.f, 1.f, 1.f, 1.f};
#pragma unroll
            for (int j = 0; j < 4; ++j) v[ii][j] = *(const f32x4*)(src + (size_t)(32 * (i2 * 4 + ii) + j) * N); }
#pragma unroll
        for (int ii = 0; ii < 4; ++ii)
#pragma unroll
            for (int j = 0; j < 4; ++j)
#pragma unroll
                for (int e = 0; e < 4; ++e) mx[e] = fmaxf(mx[e], fabsf(v[ii][j][e] * g4[ii][j])); }
#pragma unroll
    for (int o = 8; o < 64; o <<= 1)
#pragma unroll
        for (int e = 0; e < 4; ++e) mx[e] = fmaxf(mx[e], __shfl_xor(mx[e], o));
    if (r == 0) *(LAS f32x4*)(mxs + wave * 32 + 4 * c4) = mx;
    __syncthreads();
#pragma unroll
    for (int w = 0; w < NWAVES; ++w) { const f32x4 t = *(const LAS f32x4*)(mxs + w * 32 + 4 * c4);
#pragma unroll
        for (int e = 0; e < 4; ++e) mx[e] = fmaxf(mx[e], t[e]); }
    f32x4 q;
#pragma unroll
    for (int e = 0; e < 4; ++e) q[e] = mx[e] > 0.f ? 127.0f / mx[e] : 0.f;
    if (wave == 0 && r == 0) *(f32x4*)(cs + n0 + 4 * c4) = mx * (1.0f / 127.0f);
    unsigned char* dst = WT8 + (size_t)(n0 + 4 * c4) * 2048 + kb;
#pragma unroll
    for (int i2 = 0; i2 < 2; ++i2) { f32x4 v[4][4], g4[4];
#pragma unroll
        for (int ii = 0; ii < 4; ++ii) { g4[ii] = HASK ? *(const f32x4*)(kp + 32 * (i2 * 4 + ii)) : (f32x4){1.f, 1.f, 1.f, 1.f};
#pragma unroll
            for (int j = 0; j < 4; ++j) v[ii][j] = *(const f32x4*)(src + (size_t)(32 * (i2 * 4 + ii) + j) * N); }
#pragma unroll
        for (int ii = 0; ii < 4; ++ii) { unsigned w[4] = {0u, 0u, 0u, 0u};
#pragma unroll
            for (int j = 0; j < 4; ++j)
#pragma unroll
                for (int e = 0; e < 4; ++e) { const int qi = (int)rintf(v[ii][j][e] * g4[ii][j] * q[e]); w[e] |= ((unsigned)qi & 0xFFu) << (8 * j); }
#pragma unroll
            for (int e = 0; e < 4; ++e) *(unsigned*)(dst + (size_t)e * 2048 + 32 * (i2 * 4 + ii)) = w[e]; } }
    __syncthreads();
}
__device__ __forceinline__ void p0_small_transpose(const float* src, bf16* dst, int nb, int K, int N, int gt, int NGT) {
    const int tot = nb * K * N;
    for (int i = gt; i < tot; i += NGT) { const int bb = i / (K * N), r = i - bb * K * N, n = r / K, k = r - n * K; dst[i] = (bf16)f2bf(src[(size_t)bb * K * N + (size_t)k * N + n]); }
}
template <int PART> __device__ __forceinline__ void p0_prologue(const Frame& F, int vb, int VG) {
    LAS float* scr = (LAS float*)(F.lds + F.wave * 8448);
    const int gw = vb * NWAVES + F.wave, NGW = VG * NWAVES, gt = gw * 64 + F.lane, NGT = NGW * 64;
    constexpr int I1 = (D / 64) * (NIN / 32), I2 = (D / 64) * (D / 32);
    if (PART == 0) { for (int it = vb; it < NIN / 32; it += VG) p0_wquant_block<true>(F.in[I_WIN], NIN, WSP(unsigned char, WS_WIN), WSP(float, WS_CS1), F.in[I_G1], it, F.wave, F.lane, (LAS float*)(F.lds + 8 * 8448)); }
    else { const int sp = VG >= 64 ? VG / 64 : 1;
           for (int v = vb; v < sp * (D / 32); v += VG) {
               if (v % sp == 0) p0_wquant_block<false>(F.in[I_WQ], D, WSP(unsigned char, WS_WQ), WSP(float, WS_CSQ), nullptr, v / sp, F.wave, F.lane, (LAS float*)(F.lds + 8 * 8448));
               if (v % sp == sp / 2) p0_wquant_block<false>(F.in[I_WOUT], D, WSP(unsigned char, WS_WOUT), WSP(float, WS_CSO), nullptr, v / sp, F.wave, F.lane, (LAS float*)(F.lds + 8 * 8448)); } }
    if (PART == 0) {
    { v4u* z = (v4u*)(WSP(unsigned char, WS_WIN) + (size_t)NIN * D); const int nz = (NINP - NIN) * D / 16; for (int i = gt; i < nz; i += NGT) z[i] = (v4u){0u, 0u, 0u, 0u};
      for (int i = gt; i < NINP - NIN; i += NGT) WSP(float, WS_CS1)[NIN + i] = 0.f; }
    p0_small_transpose(F.in[I_W2], WSP(bf16, WS_W2T), 1, 64, 1024, gt, NGT);
    p0_small_transpose(F.in[I_A2], WSP(bf16, WS_A2T), 1, 64, 1024, gt, NGT);
    p0_small_transpose(F.in[I_G2], WSP(bf16, WS_G2T), 1, 160, 1024, gt, NGT);
    p0_small_transpose(F.in[I_WA], WSP(bf16, WS_WAT), 8, 128, 128, gt, NGT);
    p0_small_transpose(F.in[I_WI], WSP(bf16, WS_WIT), 8, 128, 128, gt, NGT);
    { const float* s = F.in[I_KEYS]; bf16* d = WSP(bf16, WS_KEYS); for (int i = gt; i < 8 * 2 * 128 * 128 / 8; i += NGT) { const f32x4 a = *(const f32x4*)(s + (size_t)i * 8), b = *(const f32x4*)(s + (size_t)i * 8 + 4);
        v4u o; o.x = pk2(a[0], a[1]); o.y = pk2(a[2], a[3]); o.z = pk2(b[0], b[1]); o.w = pk2(b[2], b[3]); *(v4u*)(d + (size_t)i * 8) = o; } }
    }
    if (PART == 0) {
    { const float* x = F.in[I_X]; unsigned char* xq = WSP(unsigned char, WS_XB); float* rs1 = WSP(float, WS_RSTD1);
#define XR_LOAD(V_, row_) do { _Pragma("unroll") for (int hh_ = 0; hh_ < 2; ++hh_) _Pragma("unroll") for (int q_ = 0; q_ < 4; ++q_) V_[hh_][q_] = *(const f32x4*)(x + (size_t)(row_) * D + hh_ * 1024 + F.lane * 16 + q_ * 4); } while (0)
#define XR_QUANT(V_, row_) do { float s_ = 0.f, am_ = 0.f; \
          _Pragma("unroll") for (int hh_ = 0; hh_ < 2; ++hh_) _Pragma("unroll") for (int q_ = 0; q_ < 4; ++q_) _Pragma("unroll") for (int e_ = 0; e_ < 4; ++e_) { const float t_ = V_[hh_][q_][e_]; s_ += t_ * t_; am_ = fmaxf(am_, fabsf(t_)); } \
          s_ = wave_sum(s_); \
          _Pragma("unroll") for (int o_ = 1; o_ < 64; o_ <<= 1) am_ = fmaxf(am_, __shfl_xor(am_, o_)); \
          const float xq_ = am_ > 0.f ? 127.0f / am_ : 0.f; \
          if (F.lane == 0) rs1[row_] = am_ * (1.0f / 127.0f) / sqrtf(s_ * (1.0f / D) + NORM_EPS); \
          _Pragma("unroll") for (int hh_ = 0; hh_ < 2; ++hh_) { v4u o_; \
              _Pragma("unroll") for (int q_ = 0; q_ < 4; ++q_) { unsigned w_ = 0u; \
                  _Pragma("unroll") for (int e_ = 0; e_ < 4; ++e_) { const int qi_ = (int)rintf(V_[hh_][q_][e_] * xq_); w_ |= ((unsigned)qi_ & 0xFFu) << (8 * e_); } \
                  o_[q_] = w_; } \
              *(v4u*)(xq + (size_t)(row_) * D + hh_ * 1024 + F.lane * 16) = o_; } } while (0)
      for (int m = gw; m < T; m += 2 * NGW) { const int mB = m + NGW < T ? m + NGW : m;
          f32x4 xa[2][4], xb2[2][4];
          XR_LOAD(xa, m); XR_LOAD(xb2, mB);
          XR_QUANT(xa, m);
          if (mB != m) XR_QUANT(xb2, mB); }
#undef XR_LOAD
#undef XR_QUANT
    }
    }
}

typedef float f32x2c __attribute__((ext_vector_type(2)));
__device__ __forceinline__ unsigned cvtpk(float lo, float hi) { const f32x2c v = {lo, hi}; const bf16x2_t b = __builtin_convertvector(v, bf16x2_t); return __builtin_bit_cast(unsigned, b); }
__device__ __forceinline__ float rcpf_(float x) { return __builtin_amdgcn_rcpf(x); }
__device__ __forceinline__ float sigmoid_fast(float x) { return rcpf_(1.0f + __expf(-x)); }
__device__ __forceinline__ float tanh_fast(float x) { return 1.0f - 2.0f * rcpf_(1.0f + __expf(2.0f * x)); }
__device__ __forceinline__ float softplus_fast(float z) { return fmaxf(z, 0.f) + __logf(1.0f + __expf(-fabsf(z))); }
__device__ __forceinline__ float gelu_fast(float x) { const float u = 0.7978845608028654f * (x + 0.044715f * x * x * x); return x * rcpf_(1.0f + __expf(-2.0f * u)); }
__device__ __forceinline__ void rwkv_prep_unit(const Frame& F, int chunk, int h, int lane, const LAS bf16* WL2, const LAS bf16* AL2, const LAS bf16* GL2, const LAS float* CW, LAS bf16* ST) {
    asm volatile("" : "+v"(lane));
    const int fr = lane & 15, fq = lane >> 4;
    const bf16* PROJ = WSP(bf16, WS_PROJ); const bf16* LA = WSP(bf16, WS_LA);
    bf16* TA = WSP(bf16, WS_TA); bf16* TB = WSP(bf16, WS_TB); bf16* TK = WSP(bf16, WS_TK); bf16* TR = WSP(bf16, WS_TR);
    bf16* TV = (bf16*)F.out + OUT_TV / 2; bf16* TG = (bf16*)F.out + OUT_TG / 2; float* PCG = F.out + OUT_PC / 4; float* BONG = F.out + OUT_BON / 4;
#define PU4(w_) ((f32x4){bf_lo((w_).x), bf_hi((w_).x), bf_lo((w_).y), bf_hi((w_).y)})
    size_t tokm[2];
#pragma unroll
    for (int mt = 0; mt < 2; ++mt) tokm[mt] = (size_t)chunk * 32 + mt * 16 + fr;
    v2u cA[4][3], cB[4][3], eA[4][3];
    const bool hs = (chunk & 63) != 0; const unsigned hsm = hs ? 0xffffffffu : 0u; const size_t toke = (size_t)chunk * 32 - (hs ? 1 : 0);
#define PREP_LOAD_MT(C_, tok_) do { _Pragma("unroll") for (int nt_ = 0; nt_ < 4; ++nt_) { const bf16* pr_ = PROJ + (tok_) * NINP + PC_R + h * 64 + nt_ * 16 + fq * 4; \
        _Pragma("unroll") for (int q_ = 0; q_ < 3; ++q_) C_[nt_][q_] = *(const v2u*)(pr_ + q_ * 1024); } } while (0)
#define DPPU(old_, src_, ctl_) ((unsigned)__builtin_amdgcn_update_dpp((int)(old_), (int)(src_), ctl_, 0xf, 0xf, false))
#define PREP_PREV(dst_, mt_, nt_, q_) do { const v2u c_ = (mt_) ? cB[nt_][q_] : cA[nt_][q_]; v2u o_; \
        if (mt_) { o_.x = DPPU(0, cA[nt_][q_].x, 0x121); o_.y = DPPU(0, cA[nt_][q_].y, 0x121); } else { o_.x = eA[nt_][q_].x & hsm; o_.y = eA[nt_][q_].y & hsm; } \
        dst_.x = DPPU(o_.x, c_.x, 0x111); dst_.y = DPPU(o_.y, c_.y, 0x111); } while (0)
    PREP_LOAD_MT(cA, tokm[0]); PREP_LOAD_MT(eA, toke);
    bf16x8 la[9];
#pragma unroll
    for (int ks = 0; ks < 9; ++ks) la[ks] = *(const bf16x8*)(LA + tokm[0] * 288 + ks * 32 + 8 * fq);
    PREP_LOAD_MT(cB, tokm[1]);
    float inv[2], bn[2];
#pragma unroll
    for (int mt = 0; mt < 2; ++mt) { float s2 = 0.f;
#pragma unroll
        for (int nt = 0; nt < 4; ++nt) { const int j4 = nt * 16 + fq * 4;
            const v2u kc = mt ? cB[nt][1] : cA[nt][1]; v2u kp; PREP_PREV(kp, mt, nt, 1);
            const f32x4 c_kk = *(const LAS f32x4*)(CW + 128 + j4), m_k = *(const LAS f32x4*)(CW + 384 + j4);
            const f32x4 kcf = PU4(kc); const f32x4 ku = (kcf + (PU4(kp) - kcf) * m_k) * c_kk; s2 += (ku[0] * ku[0] + ku[1] * ku[1]) + (ku[2] * ku[2] + ku[3] * ku[3]); }
        { auto x = __builtin_amdgcn_permlane16_swap(__float_as_uint(s2), __float_as_uint(s2), false, false); s2 = __uint_as_float(x[0]) + __uint_as_float(x[1]); }
        { auto x = __builtin_amdgcn_permlane32_swap(__float_as_uint(s2), __float_as_uint(s2), false, false); s2 = __uint_as_float(x[0]) + __uint_as_float(x[1]); }
        inv[mt] = __builtin_amdgcn_rsqf(fmaxf(s2, 1e-24f)); bn[mt] = 0.f; }
    f32x4 tot0[4];
#pragma unroll
    for (int n = 0; n < 4; ++n) tot0[n] = (f32x4){0.f, 0.f, 0.f, 0.f};
#pragma unroll
    for (int st = 0; st < 8; ++st) { const int mt = st >> 2, nt = st & 3; const int j4 = nt * 16 + fq * 4; const size_t col = (size_t)h * 64 + j4;
        v2u cur_[3], prv_[3];
#pragma unroll
        for (int q = 0; q < 3; ++q) { cur_[q] = mt ? cB[nt][q] : cA[nt][q]; PREP_PREV(prv_[q], mt, nt, q); }
        f32x4 cw = (f32x4){0.f, 0.f, 0.f, 0.f}, ca = cw, cg = cw;
#pragma unroll
        for (int ks = 0; ks < 2; ++ks) { cw = MFMA16(*(const LAS bf16x8*)(WL2 + (nt * 16 + fr) * 72 + ks * 32 + 8 * fq), la[ks], cw); ca = MFMA16(*(const LAS bf16x8*)(AL2 + (nt * 16 + fr) * 72 + ks * 32 + 8 * fq), la[2 + ks], ca); }
#pragma unroll
        for (int ks = 0; ks < 5; ++ks) cg = MFMA16(*(const LAS bf16x8*)(GL2 + (nt * 16 + fr) * 168 + ks * 32 + 8 * fq), la[4 + ks], cg);
        if (st == 3) {
#pragma unroll
            for (int ks = 0; ks < 9; ++ks) la[ks] = *(const bf16x8*)(LA + tokm[1] * 288 + ks * 32 + 8 * fq); }
        const f32x4 c_w0 = *(const LAS f32x4*)(CW + j4), c_a0 = *(const LAS f32x4*)(CW + 64 + j4), c_kk = *(const LAS f32x4*)(CW + 128 + j4), c_ka = *(const LAS f32x4*)(CW + 192 + j4), c_rk = *(const LAS f32x4*)(CW + 256 + j4);
        const f32x4 m_r = *(const LAS f32x4*)(CW + 320 + j4), m_k = *(const LAS f32x4*)(CW + 384 + j4), m_v = *(const LAS f32x4*)(CW + 448 + j4);
        const v2u rp = prv_[0], kp = prv_[1], vp = prv_[2];
        const f32x4 rcf = PU4(cur_[0]), kcf = PU4(cur_[1]), vcf = PU4(cur_[2]);
        const f32x4 rr = rcf + (PU4(rp) - rcf) * m_r, kv = kcf + (PU4(kp) - kcf) * m_k, vv = vcf + (PU4(vp) - vcf) * m_v;
        f32x4 nau, bbu, km, cum;
#pragma unroll
        for (int r = 0; r < 4; ++r) { const float av = sigmoid_fast(c_a0[r] + ca[r]), ku = kv[r] * c_kk[r]; km[r] = kv[r] * (1.0f + (av - 1.0f) * c_ka[r]);
            cum[r] = -0.6065306597126334f * sigmoid_fast(c_w0[r] + cw[r]);
            nau[r] = -ku; bbu[r] = ku * av; bn[mt] += rr[r] * km[r] * c_rk[r]; }
        f32x4 at4, rt4, bt4, kt4, ep4;
#pragma unroll
        for (int r = 0; r < 4; ++r) { float v = cum[r];
            v += __builtin_bit_cast(float, __builtin_amdgcn_update_dpp(0, __builtin_bit_cast(int, v), 0x111, 0xf, 0xf, true));
            v += __builtin_bit_cast(float, __builtin_amdgcn_update_dpp(0, __builtin_bit_cast(int, v), 0x112, 0xf, 0xf, true));
            v += __builtin_bit_cast(float, __builtin_amdgcn_update_dpp(0, __builtin_bit_cast(int, v), 0x114, 0xf, 0xf, true));
            v += __builtin_bit_cast(float, __builtin_amdgcn_update_dpp(0, __builtin_bit_cast(int, v), 0x118, 0xf, 0xf, true));
            if (mt == 0) tot0[nt][r] = __shfl(v, (lane & 48) | 15); else v += tot0[nt][r];
            const float ep = __expf(v), em = rcpf_(ep);
            float eprev = __builtin_bit_cast(float, __builtin_amdgcn_update_dpp(0, __builtin_bit_cast(int, ep), 0x111, 0xf, 0xf, true));
            if (fr == 0) eprev = mt ? __expf(tot0[nt][r]) : 1.0f;
            at4[r] = nau[r] * inv[mt] * eprev; rt4[r] = rr[r] * ep; bt4[r] = bbu[r] * inv[mt] * em; kt4[r] = km[r] * em; ep4[r] = ep; }
        { LAS bf16* sp = ST + fr * 64 + j4; v2u w;
          w.x = cvtpk(at4[0], at4[1]); w.y = cvtpk(at4[2], at4[3]); *(LAS v2u*)(sp) = w;
          w.x = cvtpk(rt4[0], rt4[1]); w.y = cvtpk(rt4[2], rt4[3]); *(LAS v2u*)(sp + 1024) = w;
          w.x = cvtpk(bt4[0], bt4[1]); w.y = cvtpk(bt4[2], bt4[3]); *(LAS v2u*)(sp + 2048) = w;
          w.x = cvtpk(kt4[0], kt4[1]); w.y = cvtpk(kt4[2], kt4[3]); *(LAS v2u*)(sp + 3072) = w;
          w.x = cvtpk(vv[0], vv[1]); w.y = cvtpk(vv[2], vv[3]); *(LAS v2u*)(sp + 4096) = w;
          w.x = cvtpk(cg[0], cg[1]); w.y = cvtpk(cg[2], cg[3]); *(LAS v2u*)(sp + 5120) = w; }
        if (nt == 3) {
            bf16* const dstp[6] = {TA, TR, TB, TK, TV, TG};
#pragma unroll
            for (int a6 = 0; a6 < 6; ++a6)
#pragma unroll
                for (int hrow = 0; hrow < 2; ++hrow) { const int row = hrow * 8 + (lane >> 3), c8 = (lane & 7) * 8;
                    const v4u pv = *(const LAS v4u*)(ST + a6 * 1024 + row * 64 + c8);
                    *(v4u*)(dstp[a6] + ((size_t)chunk * 32 + mt * 16 + row) * 1024 + (size_t)h * 64 + c8) = pv; } }
        if (mt == 1 && fr == 15) *(f32x4*)(PCG + (size_t)chunk * 1024 + col) = ep4;
    }
#undef PREP_LOAD_MT
#undef PREP_PREV
#undef DPPU
#undef PU4
#pragma unroll
    for (int mt = 0; mt < 2; ++mt) { float b2 = bn[mt];
        { auto x = __builtin_amdgcn_permlane16_swap(__float_as_uint(b2), __float_as_uint(b2), false, false); b2 = __uint_as_float(x[0]) + __uint_as_float(x[1]); }
        { auto x = __builtin_amdgcn_permlane32_swap(__float_as_uint(b2), __float_as_uint(b2), false, false); b2 = __uint_as_float(x[0]) + __uint_as_float(x[1]); }
        if (fq == 0) BONG[tokm[mt] * 16 + h] = b2; }
}
__device__ __forceinline__ void rwkv_prep_phase(const Frame& F) {
    LAS bf16* WL2 = (LAS bf16*)(F.lds + 0); LAS bf16* AL2 = (LAS bf16*)(F.lds + 9216); LAS bf16* GL2 = (LAS bf16*)(F.lds + 18432); LAS float* CW = (LAS float*)(F.lds + 39936);
    int hcur = -1;
    for (int u = F.bid; u < 1024; u += F.G) { const int h = u & 15, cg = u >> 4;
        if (h != hcur) { hcur = h; __syncthreads();
            int tid_ = F.tid; asm volatile("" : "+v"(tid_));
            const bf16* w2t = WSP(bf16, WS_W2T) + (size_t)h * 64 * 64; const bf16* a2t = WSP(bf16, WS_A2T) + (size_t)h * 64 * 64; const bf16* g2t = WSP(bf16, WS_G2T) + (size_t)h * 64 * 160;
            { const int r = tid_ >> 3, c = (tid_ & 7) * 8; *(LAS v4u*)(WL2 + r * 72 + c) = *(const v4u*)(w2t + r * 64 + c); *(LAS v4u*)(AL2 + r * 72 + c) = *(const v4u*)(a2t + r * 64 + c); }
            for (int i = tid_; i < 64 * 20; i += NTHR) { const int r = i / 20, c = (i - r * 20) * 8; *(LAS v4u*)(GL2 + r * 168 + c) = *(const v4u*)(g2t + r * 160 + c); }
            { const int q = tid_ >> 6, jj = tid_ & 63; const float* src = q == 0 ? F.in[I_W0] : (q == 1 ? F.in[I_A0] : (q == 2 ? F.in[I_KK] : (q == 3 ? F.in[I_KA] : (q == 4 ? F.in[I_RK] : F.in[I_MU] + (q - 5) * 1024)))); CW[q * 64 + jj] = src[h * 64 + jj]; }
            __syncthreads(); }
        rwkv_prep_unit(F, cg * 8 + F.wave, h, F.lane, WL2, AL2, GL2, CW, (LAS bf16*)(F.lds + 43008 + F.wave * 12288)); }
    __syncthreads();
}
typedef short v4i16_t __attribute__((ext_vector_type(4)));
__device__ __forceinline__ bf16x8 frag_tr16(const LAS bf16* p, int ld) {
    const v4i16_t a = __builtin_amdgcn_ds_read_tr16_b64_v4i16((LAS v4i16_t*)p), b = __builtin_amdgcn_ds_read_tr16_b64_v4i16((LAS v4i16_t*)(p + 4 * ld));
    return (bf16x8){a[0], a[1], a[2], a[3], b[0], b[1], b[2], b[3]};
}
#define RD_LOAD(src_, act_, row0_, j_) do { const float* tp_ = (src_) + ((act_) ? ((size_t)((row0_) + ((j_) >> 1)) * D + ((j_) & 1) * 1024) : (size_t)0) + lane * 16; \
        _Pragma("unroll") for (int q_ = 0; q_ < 4; ++q_) th[q_] = *(const f32x4*)(tp_ + q_ * 4); } while (0)
#define RD_PACK(dst_, v_, tq_) do { _Pragma("unroll") for (int q_ = 0; q_ < 4; ++q_) {   \
            const unsigned b0_ = __float_as_uint(__builtin_fmaf(v_[q_][0], tq_, 12582912.0f)), b1_ = __float_as_uint(__builtin_fmaf(v_[q_][1], tq_, 12582912.0f)); \
            const unsigned b2_ = __float_as_uint(__builtin_fmaf(v_[q_][2], tq_, 12582912.0f)), b3_ = __float_as_uint(__builtin_fmaf(v_[q_][3], tq_, 12582912.0f)); \
            dst_[q_] = __builtin_amdgcn_perm(b1_, b0_, 0x0c0c0400u) | __builtin_amdgcn_perm(b3_, b2_, 0x04000c0cu); } } while (0)
#define RD_CONSUME(dstb_, scb_, row0_, j_) do { float am_ = 0.f; \
        _Pragma("unroll") for (int q_ = 0; q_ < 4; ++q_) _Pragma("unroll") for (int e_ = 0; e_ < 4; ++e_) am_ = fmaxf(am_, fabsf(th[q_][e_])); \
        if (((j_) & 1) == 0) { _Pragma("unroll") for (int q_ = 0; q_ < 4; ++q_) tk[q_] = th[q_]; tkm = am_; } \
        else { am_ = fmaxf(am_, tkm); \
            am_ = fmaxf(am_, dppf<0xB1>(am_)); am_ = fmaxf(am_, dppf<0x4E>(am_)); am_ = fmaxf(am_, dppf<0x141>(am_)); am_ = fmaxf(am_, dppf<0x140>(am_)); \
            { auto s_ = __builtin_amdgcn_permlane16_swap(__float_as_uint(am_), __float_as_uint(am_), false, false); am_ = fmaxf(__uint_as_float(s_[0]), __uint_as_float(s_[1])); } \
            { auto s_ = __builtin_amdgcn_permlane32_swap(__float_as_uint(am_), __float_as_uint(am_), false, false); am_ = fmaxf(__uint_as_float(s_[0]), __uint_as_float(s_[1])); } \
            const float tq_ = am_ > 0.f ? 127.0f / am_ : 0.f; const size_t ro_ = (size_t)((row0_) + ((j_) >> 1)); \
            if (lane == 0) (scb_)[ro_] = am_ * (1.0f / 127.0f); \
            v4u o0_, o1_; RD_PACK(o0_, tk, tq_); RD_PACK(o1_, th, tq_); \
            *(v4u*)((dstb_) + ro_ * D + lane * 16) = o0_; *(v4u*)((dstb_) + ro_ * D + 1024 + lane * 16) = o1_; } } while (0)
__device__ __forceinline__ void rwkv_item(const Frame& F, int item) {
    const int b = item >> 4, h = item & 15, wave = F.wave; int tid = F.tid; asm volatile("" : "+v"(tid)); const int lane = tid & 63;
    LAS unsigned char* L = F.lds;
    constexpr int LD64 = 72, LD32 = 40, E0 = 73216;
    LAS bf16* AT = (LAS bf16*)(L + 0);  LAS bf16* BT_ = (LAS bf16*)(L + 4608); LAS bf16* KT_ = (LAS bf16*)(L + 9216); LAS bf16* RT = (LAS bf16*)(L + 13824);
    LAS bf16* VS2 = (LAS bf16*)(L + 18432);
    LAS bf16* GGB2 = (LAS bf16*)(L + 27648);
    LAS bf16* S0B = (LAS bf16*)(L + 36864);
    LAS float* YB2 = (LAS float*)(L + 55296);
    LAS float* BON2 = (LAS float*)(L + 72704);
    LAS float* PC = (LAS float*)(L + 72960);
    LAS bf16* AAK = (LAS bf16*)(L + E0); LAS bf16* ARB = (LAS bf16*)(L + E0 + 2560); LAS bf16* ARK = (LAS bf16*)(L + E0 + 5120);
    LAS bf16* MINV = (LAS bf16*)(L + E0 + 7680);
    LAS bf16* RHS = (LAS bf16*)(L + E0 + 23040);
    LAS bf16* SAB = (LAS bf16*)(L + E0 + 28160);
    static_assert(E0 + 33280 <= LDSCTL_OFF, "rwkv LDS map");
    bf16* Y = WSP(bf16, WS_Y);
#define FRAG(base, row0, ld, ks) (*(const LAS bf16x8*)((base) + ((row0) + fr) * (ld) + (ks) * 32 + 8 * fq))
#define FRAGT(base, col0, ld) frag_tr16((base) + (8 * fq + (fr >> 2)) * (ld) + (col0) + 4 * (fr & 3), (ld))
    const int tt = tid >> 4, j0 = (tid & 15) * 4, hc = h * 64 + j0;
    const f32x4 plw = *(const f32x4*)(F.in[I_LNW] + hc), plb = *(const f32x4*)(F.in[I_LNB] + hc);
    const int lr = (tid & 255) >> 3, lc8 = tid & 7; const bool hi2 = tid >= 256;
    const bf16* srcA[3] = { (hi2 ? WSP(bf16, WS_TR) : WSP(bf16, WS_TA)), (hi2 ? WSP(bf16, WS_TK) : WSP(bf16, WS_TB)), (hi2 ? (const bf16*)F.out + OUT_TG / 2 : (const bf16*)F.out + OUT_TV / 2) };
    const size_t poff = ((size_t)b * SEQ + lr) * 1024 + h * 64 + lc8 * 8;
    const float* PCG = F.out + OUT_PC / 4 + (size_t)(b * 64) * 1024 + h * 64; const float* BONG = F.out + OUT_BON / 4 + (size_t)b * SEQ * 16 + h;
    v4u pl_[3]; float ppc = 0.f, pbn = 0.f;
#define RWKV_PREFETCH(tl_) do { _Pragma("unroll") for (int q_ = 0; q_ < 3; ++q_) pl_[q_] = *(const v4u*)(srcA[q_] + poff + (size_t)(tl_) * 32 * 1024); \
        ppc = PCG[(size_t)(tl_) * 1024 + (tid & 63)]; pbn = BONG[((size_t)(tl_) * 32 + (tid & 31)) * 16]; } while (0)
    const int ib = wave >> 1, tb = wave & 1, i0 = ib * 16, t0m = tb * 16;
    f32x4 sacc[2], yacc;
    sacc[0] = (f32x4){0.f, 0.f, 0.f, 0.f}; sacc[1] = sacc[0]; yacc = sacc[0];
    for (int u = tid; u < 2 * 64 * LD64 / 2; u += NTHR) ((LAS unsigned*)S0B)[u] = 0u;
    const int trow0 = (item * 4 + (wave & 3)) * 32; const bool tconv = wave >= 4;
    f32x4 th[4], tk[4]; float tkm = 0.f;
#pragma unroll
    for (int q = 0; q < 4; ++q) tk[q] = (f32x4){0.f, 0.f, 0.f, 0.f};
    RWKV_PREFETCH(0);
    RD_LOAD(F.in[I_U], tconv, trow0, 0);
    __syncthreads();
    for (int tl = 0; tl <= SEQ / 32; ++tl) {
        const int cur = tl & 1;
        int lane_c = lane; asm volatile("" : "+v"(lane_c)); const int fr = lane_c & 15, fq = lane_c >> 4;
        LAS bf16* VS = VS2 + cur * 32 * LD64; LAS bf16* GGB = GGB2 + cur * 32 * LD64; LAS float* YB = YB2 + cur * 32 * 68; LAS float* BON = BON2 + cur * 32;
        const LAS bf16* VSp = VS2 + (cur ^ 1) * 32 * LD64; const LAS bf16* GGBp = GGB2 + (cur ^ 1) * 32 * LD64; const LAS float* YBp = YB2 + (cur ^ 1) * 32 * 68; const LAS float* BONp = BON2 + (cur ^ 1) * 32;
        if (tl > 0) { const size_t tokb = (size_t)b * SEQ + (tl - 1) * 32;
          const f32x4 y4 = *(const LAS f32x4*)(YBp + tt * 68 + j0); const v2u gw_ = *(const LAS v2u*)(GGBp + tt * LD64 + j0);
          const f32x4 g4 = (f32x4){bf_lo(gw_.x), bf_hi(gw_.x), bf_lo(gw_.y), bf_hi(gw_.y)};
          const v2u vw_ = *(const LAS v2u*)(VSp + tt * LD64 + j0); const f32x4 v4 = (f32x4){bf_lo(vw_.x), bf_hi(vw_.x), bf_lo(vw_.y), bf_hi(vw_.y)};
          float sm = (y4[0] + y4[1]) + (y4[2] + y4[3]); sm = red16(sm); const float mean = sm * (1.0f / 64.0f);
          const f32x4 d4 = y4 - mean; float sv = (d4[0] * d4[0] + d4[1] * d4[1]) + (d4[2] * d4[2] + d4[3] * d4[3]); sv = red16(sv);
          const float rstd = __builtin_amdgcn_rsqf(sv * (1.0f / 64.0f) + GN_EPS), bon = BONp[tt];
          f32x4 o;
#pragma unroll
          for (int e = 0; e < 4; ++e) o[e] = (d4[e] * rstd * plw[e] + plb[e] + bon * v4[e]) * g4[e];
          v2u w; w.x = cvtpk(o[0], o[1]); w.y = cvtpk(o[2], o[3]);
          *(v2u*)(Y + (tokb + tt) * D + 1024 + hc) = w; }
        if (tl == SEQ / 32) break;
        const LAS bf16* S0c = S0B + cur * 64 * LD64; LAS bf16* S0n = S0B + (cur ^ 1) * 64 * LD64;
        { const v4u p0 = pl_[0], p1 = pl_[1], p2 = pl_[2];
          *(LAS v4u*)((hi2 ? RT : AT) + lr * LD64 + lc8 * 8) = p0;
          *(LAS v4u*)((hi2 ? KT_ : BT_) + lr * LD64 + lc8 * 8) = p1;
          *(LAS v4u*)((hi2 ? GGB : VS) + lr * LD64 + lc8 * 8) = p2;
          if (tid < 64) PC[tid] = ppc;
          if (tid >= 64 && tid < 96) BON[tid - 64] = pbn; }
        { const int tn_ = tl + 1 < SEQ / 32 ? tl + 1 : SEQ / 32 - 1; RWKV_PREFETCH(tn_); }
        __syncthreads();
        f32x4 rhs4 = (f32x4){0.f, 0.f, 0.f, 0.f};
#define RWKV_FIRST do { rhs4 = (f32x4){0.f, 0.f, 0.f, 0.f}; yacc = (f32x4){0.f, 0.f, 0.f, 0.f}; \
            _Pragma("unroll") for (int ks = 0; ks < 2; ++ks) rhs4 = MFMA16(FRAG(AT, t0m, LD64, ks), FRAG(S0c, i0, LD64, ks), rhs4); \
            _Pragma("unroll") for (int ks = 0; ks < 2; ++ks) yacc = MFMA16(FRAG(S0c, i0, LD64, ks), FRAG(RT, t0m, LD64, ks), yacc); \
            _Pragma("unroll") for (int u = 0; u < 2; ++u) { const int tile = wave * 2 + u, si0 = (tile >> 2) * 16, sj0 = (tile & 3) * 16; sacc[u] = MFMA16(FRAGT(KT_, sj0, LD64), FRAGT(VS, si0, LD64), sacc[u]); } } while (0)
#define PK8(a_, s_) __builtin_bit_cast(bf16x8, (v4u){cvtpk(a_[8 * (s_) + 0], a_[8 * (s_) + 1]), cvtpk(a_[8 * (s_) + 2], a_[8 * (s_) + 3]), cvtpk(a_[8 * (s_) + 4], a_[8 * (s_) + 5]), cvtpk(a_[8 * (s_) + 6], a_[8 * (s_) + 7])})
        if (wave == 0) {
            const int c32 = lane_c & 31, h32 = lane_c >> 5;
            f32x16 U, V, PT;
#pragma unroll
            for (int e = 0; e < 16; ++e) { U[e] = 0.f; V[e] = 0.f; }
#pragma unroll
            for (int ks = 0; ks < 4; ++ks) { const bf16x8 fa = *(const LAS bf16x8*)(AT + c32 * LD64 + ks * 16 + h32 * 8), fb = *(const LAS bf16x8*)(BT_ + c32 * LD64 + ks * 16 + h32 * 8);
                U = MFMA32(fa, fb, U);
                V = MFMA32(fb, fa, V); }
#pragma unroll
            for (int e = 0; e < 16; ++e) { const int rr = (e & 3) + 8 * (e >> 2) + 4 * h32;
                U[e] = (c32 < rr) ? U[e] : 0.f;
                V[e] = (rr < c32) ? V[e] : 0.f;
                PT[e] = V[e] + ((rr == c32) ? 1.0f : 0.f); }
#pragma unroll
            for (int st = 1; st <= 5; ++st) {
                const bf16x8 fU0 = PK8(U, 0), fU1 = PK8(U, 1);
                f32x16 Un, Vn;
#pragma unroll
                for (int e = 0; e < 16; ++e) { Un[e] = 0.f; Vn[e] = 0.f; }
                if (st < 5) { const bf16x8 fV0 = PK8(V, 0), fV1 = PK8(V, 1);
                    Un = MFMA32(fV0, fU0, Un); Un = MFMA32(fV1, fU1, Un);
                    if (st < 4) { Vn = MFMA32(fU0, fV0, Vn); Vn = MFMA32(fU1, fV1, Vn); } }
                if (st > 1) { const bf16x8 fP0 = PK8(PT, 0), fP1 = PK8(PT, 1);
                    PT = MFMA32(fU0, fP0, PT); PT = MFMA32(fU1, fP1, PT); }
                U = Un; V = Vn; }
#pragma unroll
            for (int q = 0; q < 4; ++q) { v2u w; w.x = cvtpk(PT[4 * q], PT[4 * q + 1]); w.y = cvtpk(PT[4 * q + 2], PT[4 * q + 3]); *(LAS v2u*)(MINV + c32 * LD32 + 8 * q + 4 * h32) = w; }
        } else {
            if (wave < 7) { const int mtx = (wave - 1) >> 1;
                const LAS bf16* Xs = (mtx == 1) ? BT_ : KT_; const LAS bf16* Yt = (mtx == 0) ? AT : RT; LAS bf16* O = (mtx == 0) ? AAK : (mtx == 1 ? ARB : ARK);
#pragma unroll
                for (int qq = 0; qq < 2; ++qq) { const int q = ((wave - 1) & 1) * 2 + qq, tq = (q >> 1) * 16, sq = (q & 1) * 16;
                    f32x4 a4 = (f32x4){0.f, 0.f, 0.f, 0.f};
                    if (sq <= tq) {
#pragma unroll
                        for (int ks = 0; ks < 2; ++ks) a4 = MFMA16(FRAG(Xs, sq, LD64, ks), FRAG(Yt, tq, LD64, ks), a4); }
                    const int t = tq + fr, s = sq + fq * 4;
#pragma unroll
                    for (int r = 0; r < 4; ++r) { const bool keep = (mtx == 0) ? (s + r < t) : (s + r <= t); a4[r] = keep ? a4[r] : 0.f; }
                    v2u w; w.x = cvtpk(a4[0], a4[1]); w.y = cvtpk(a4[2], a4[3]); *(LAS v2u*)(O + t * LD32 + s) = w; } }
            RWKV_FIRST;
            if (tconv) RD_CONSUME(WSP(unsigned char, WS_UT), WSP(float, WS_USC), trow0, tl);
        }
        { const int tn_ = tl + 1 < SEQ / 32 ? tl + 1 : SEQ / 32 - 1; RD_LOAD(F.in[I_U], tconv, trow0, tn_); }
        __syncthreads();
        if (wave == 0) RWKV_FIRST;
        { rhs4 = MFMA16(FRAG(AAK, t0m, LD32, 0), FRAGT(VS, i0, LD64), rhs4);
          v2u w; w.x = cvtpk(rhs4[0], rhs4[1]); w.y = cvtpk(rhs4[2], rhs4[3]); *(LAS v2u*)(RHS + (i0 + fr) * LD32 + t0m + fq * 4) = w;
          yacc = MFMA16(FRAGT(VS, i0, LD64), FRAG(ARK, t0m, LD32, 0), yacc); }
        __syncthreads();
#undef RWKV_FIRST
#undef PK8
        { f32x4 a4 = (f32x4){0.f, 0.f, 0.f, 0.f}; a4 = MFMA16(FRAG(MINV, t0m, LD32, 0), FRAG(RHS, i0, LD32, 0), a4);
          v2u w; w.x = cvtpk(a4[0], a4[1]); w.y = cvtpk(a4[2], a4[3]); *(LAS v2u*)(SAB + (i0 + fr) * LD32 + t0m + fq * 4) = w; }
        __syncthreads();
        { yacc = MFMA16(FRAG(SAB, i0, LD32, 0), FRAG(ARB, t0m, LD32, 0), yacc);
          *(LAS f32x4*)(YB + (t0m + fr) * 68 + i0 + fq * 4) = yacc;
#pragma unroll
          for (int u = 0; u < 2; ++u) { const int tile = wave * 2 + u, si0 = (tile >> 2) * 16, sj0 = (tile & 3) * 16;
              sacc[u] = MFMA16(FRAGT(BT_, sj0, LD64), FRAG(SAB, si0, LD32, 0), sacc[u]);
              const f32x4 pc = *(const LAS f32x4*)(PC + sj0 + fq * 4); sacc[u] = sacc[u] * pc;
              v2u w; w.x = cvtpk(sacc[u][0], sacc[u][1]); w.y = cvtpk(sacc[u][2], sacc[u][3]); *(LAS v2u*)(S0n + (si0 + fr) * LD64 + sj0 + fq * 4) = w; } }
        __syncthreads();
    }
    __syncthreads();
#undef FRAG
#undef FRAGT
#undef RWKV_PREFETCH
}
__device__ __forceinline__ void lora_prepass(const Frame& F) {
    const bf16* PROJ = WSP(bf16, WS_PROJ); bf16* LA = WSP(bf16, WS_LA); const float* mu = F.in[I_MU] + (PC_WD - RWKV_C0);
    const int gt = (F.bid * NWAVES + F.wave) * 64 + F.lane, NGT = F.G * NTHR;
    for (int i = gt; i < T * 36; i += NGT) { const int tok = i / 36, cc = i - tok * 36, m = cc * 8;
        const bf16* pr = PROJ + (size_t)tok * NINP + PC_WD + m;
        const v4u curv = *(const v4u*)pr; v4u prv = (v4u){0u, 0u, 0u, 0u}; if ((tok & (SEQ - 1)) != 0) prv = *(const v4u*)(pr - NINP);
        const f32x4 m0 = *(const f32x4*)(mu + m), m1 = *(const f32x4*)(mu + m + 4);
        float c[8], p[8], o[8]; unpack8(curv, c); unpack8(prv, p);
#pragma unroll
        for (int e = 0; e < 8; ++e) { const float ps = c[e] + (p[e] - c[e]) * (e < 4 ? m0[e] : m1[e - 4]); o[e] = (m < 64) ? tanh_fast(ps) : ((m < 128) ? ps : sigmoid_fast(ps)); }
        v4u w; w.x = cvtpk(o[0], o[1]); w.y = cvtpk(o[2], o[3]); w.z = cvtpk(o[4], o[5]); w.w = cvtpk(o[6], o[7]);
        *(v4u*)(LA + (size_t)tok * 288 + m) = w; }
}
__device__ __forceinline__ void lru_seq(const Frame& F, int item) {
    const int bh = item >> 1, hf = item & 1, b = bh >> 3, h = bh & 7, wave = F.wave; int tid = F.tid; asm volatile("" : "+v"(tid)); const int lane = tid & 63;
    LAS unsigned char* L = F.lds;
    LAS bf16* XA = (LAS bf16*)(L + 0);
    LAS float* XC = (LAS float*)(L + 17408);
    LAS float* RI = (LAS float*)(L + 50176);
    LAS float* SEG = (LAS float*)(L + 115712);
    LAS float* CARRY = (LAS float*)(L + 119808);
    LAS float* CW = (LAS float*)(L + 120320);
    const bf16* PROJ = WSP(bf16, WS_PROJ); bf16* Y = WSP(bf16, WS_Y);
    const int fr0 = lane & 15, fq0 = lane >> 4;
    for (int i = tid; i < 640; i += NTHR) { const int w = i >> 7, cch = i & 127; CW[i] = (w < 4) ? F.in[I_CONVW][w * 1024 + h * 128 + cch] : F.in[I_CONVB][h * 128 + cch]; }
    if (tid < 64) CARRY[tid] = 0.f;
    const int gsel = wave & 1, ntl = wave >> 1, ntg = hf * 4 + ntl;
    bf16x8 wf[4];
    { const bf16* WTp = (gsel ? WSP(bf16, WS_WIT) : WSP(bf16, WS_WAT)) + (size_t)h * 128 * 128;
#pragma unroll
      for (int ks = 0; ks < 4; ++ks) wf[ks] = *(const bf16x8*)(WTp + (ntg * 16 + fr0) * 128 + ks * 32 + 8 * fq0); }
    const int c = tid & 63, sg = tid >> 6, chl = hf * 64 + c, chg = h * 128 + chl;
    const float ba_c = F.in[I_BA][chg], bi_c = F.in[I_BI][chg], sp8 = 8.0f * softplus_fast(-F.in[I_LAM][chg]);
    v4u pf[2][4];
#define LRU_PREFETCH(k_) do { _Pragma("unroll") for (int u_ = 0; u_ < 2; ++u_) { const int chn_ = tid + NTHR * u_, t_ = chn_ >> 4, c8_ = (chn_ & 15) * 8; \
        _Pragma("unroll") for (int w_ = 0; w_ < 4; ++w_) { const int ts_ = (k_) * 64 + t_ - 3 + w_; const int tc_ = ts_ >= 0 ? ts_ : 0;   \
            const v4u x_ = *(const v4u*)(PROJ + ((size_t)b * SEQ + tc_) * NINP + h * 128 + c8_); const unsigned m_ = ts_ >= 0 ? 0xffffffffu : 0u; \
            pf[u_][w_] = (v4u){x_.x & m_, x_.y & m_, x_.z & m_, x_.w & m_}; } } } while (0)
    unsigned short gtn[8];
#define LRU_GATES(k_) do { _Pragma("unroll") for (int e_ = 0; e_ < 8; ++e_) gtn[e_] = PROJ[((size_t)b * SEQ + (k_) * 64 + sg * 8 + e_) * NINP + PC_GATE + chg]; } while (0)
    const int trow0 = (item * 8 + wave) * 16;
    f32x4 th[4], tk[4]; float tkm = 0.f;
#pragma unroll
    for (int q = 0; q < 4; ++q) tk[q] = (f32x4){0.f, 0.f, 0.f, 0.f};
    LRU_PREFETCH(0); LRU_GATES(0);
    RD_LOAD(F.in[I_V], true, trow0, 0);
    __syncthreads();
    for (int k = 0; k < SEQ / 64; ++k) {
        const size_t tokbase = (size_t)b * SEQ + k * 64;
        int lane_c = lane; asm volatile("" : "+v"(lane_c)); const int fr = lane_c & 15, fq = lane_c >> 4;
#pragma unroll
        for (int u = 0; u < 2; ++u) { const int chn = tid + NTHR * u, t = chn >> 4, c8 = (chn & 15) * 8;
            float acc[8]; { const f32x4 b0 = *(const LAS f32x4*)(CW + 512 + c8), b1 = *(const LAS f32x4*)(CW + 512 + c8 + 4);
#pragma unroll
                for (int e = 0; e < 4; ++e) { acc[e] = b0[e]; acc[e + 4] = b1[e]; } }
#pragma unroll
            for (int w = 0; w < 4; ++w) { float xf[8]; unpack8(pf[u][w], xf);
                const f32x4 w0 = *(const LAS f32x4*)(CW + w * 128 + c8), w1 = *(const LAS f32x4*)(CW + w * 128 + c8 + 4);
#pragma unroll
                for (int e = 0; e < 4; ++e) { acc[e] += w0[e] * xf[e]; acc[e + 4] += w1[e] * xf[e + 4]; } }
            v4u pk; pk.x = cvtpk(acc[0], acc[1]); pk.y = cvtpk(acc[2], acc[3]); pk.z = cvtpk(acc[4], acc[5]); pk.w = cvtpk(acc[6], acc[7]);
            *(LAS v4u*)(XA + t * 136 + c8) = pk;
            LAS float* d = XC + t * 128 + c8; *(LAS f32x4*)d = (f32x4){acc[0], acc[1], acc[2], acc[3]}; *(LAS f32x4*)(d + 4) = (f32x4){acc[4], acc[5], acc[6], acc[7]}; }
        float gl[8];
#pragma unroll
        for (int e = 0; e < 8; ++e) gl[e] = gelu_fast(__uint_as_float((unsigned)gtn[e] << 16));
        { const int kn_ = k + 1 < SEQ / 64 ? k + 1 : SEQ / 64 - 1; LRU_PREFETCH(kn_); LRU_GATES(kn_); }
        __syncthreads();
#pragma unroll
        for (int mt = 0; mt < 4; ++mt) {
            bf16x8 af[4];
#pragma unroll
            for (int ks = 0; ks < 4; ++ks) af[ks] = *(const LAS bf16x8*)(XA + (mt * 16 + fr) * 136 + ks * 32 + 8 * fq);
            { f32x4 a4 = (f32x4){0.f, 0.f, 0.f, 0.f};
#pragma unroll
                for (int ks = 0; ks < 4; ++ks) a4 = MFMA16(wf[ks], af[ks], a4);
                *(LAS f32x4*)(RI + gsel * 8192 + (mt * 16 + fr) * 128 + ntl * 16 + fq * 4) = a4; } }
        __syncthreads();
        float av[8], bx[8]; float A = 1.f, B = 0.f;
#pragma unroll
        for (int e = 0; e < 8; ++e) { const int t = sg * 8 + e; const float r = sigmoid_fast(RI[t * 128 + c] + ba_c), ig = sigmoid_fast(RI[8192 + t * 128 + c] + bi_c), xc = XC[t * 128 + chl];
            const float la = -sp8 * r; av[e] = __expf(la); bx[e] = sqrtf(fmaxf(1.0f - av[e] * av[e], 0.f)) * (ig * xc); A *= av[e]; B = av[e] * B + bx[e]; }
        SEG[(sg * 64 + c) * 2] = A; SEG[(sg * 64 + c) * 2 + 1] = B;
        __syncthreads();
        float hst = CARRY[c];
        for (int s2 = 0; s2 < sg; ++s2) hst = SEG[(s2 * 64 + c) * 2] * hst + SEG[(s2 * 64 + c) * 2 + 1];
#pragma unroll
        for (int e = 0; e < 8; ++e) { hst = av[e] * hst + bx[e];
            Y[(tokbase + sg * 8 + e) * D + chg] = (bf16)(cvtpk(hst * gl[e], 0.f) & 0xffffu); }
        RD_CONSUME(WSP(unsigned char, WS_VT), WSP(float, WS_VSC), trow0, k);
        { const int kn_ = k + 1 < SEQ / 64 ? k + 1 : SEQ / 64 - 1; RD_LOAD(F.in[I_V], true, trow0, kn_); }
        __syncthreads();
        if (sg == 7) CARRY[c] = hst;
    }
    __syncthreads();
#undef LRU_PREFETCH
#undef LRU_GATES
}
__device__ __forceinline__ void group_barrier(unsigned* cnt, unsigned n) {
    asm volatile("s_waitcnt vmcnt(0)" ::: "memory");
    __syncthreads();
    if (threadIdx.x == 0) {
        __builtin_amdgcn_fence(__ATOMIC_RELEASE, "agent");
        asm volatile("s_waitcnt vmcnt(0)" ::: "memory");
        xb_add(cnt, 1u);
        unsigned sp = 0; while (xb_ld(cnt) < n) { __builtin_amdgcn_s_sleep(2); if (++sp > (1u << 24)) break; }
        __builtin_amdgcn_fence(__ATOMIC_ACQUIRE, "agent");
        asm volatile("s_waitcnt vmcnt(0)" ::: "memory");
    }
    __syncthreads();
}

__device__ __forceinline__ unsigned f2ord(float f) { const unsigned u = __builtin_bit_cast(unsigned, f); return (u & 0x80000000u) ? ~u : (u | 0x80000000u); }
__device__ __forceinline__ float ord2f(unsigned o) { const unsigned u = (o & 0x80000000u) ? (o & 0x7fffffffu) : ~o; return __builtin_bit_cast(float, u); }
#define CMPX(hi_, lo_) do { const unsigned _a = (hi_), _b = (lo_); (hi_) = _a > _b ? _a : _b; (lo_) = _a > _b ? _b : _a; } while (0)
template <int N> __device__ __forceinline__ void sort_desc(unsigned (&a)[N]) {
#pragma unroll
    for (int k = 2; k <= N; k <<= 1)
#pragma unroll
        for (int j = k >> 1; j > 0; j >>= 1)
#pragma unroll
            for (int i = 0; i < N; ++i) { const int l = i ^ j; if (l > i) { if ((i & k) == 0) CMPX(a[i], a[l]); else CMPX(a[l], a[i]); } }
}
__device__ __forceinline__ void merge16(unsigned (&A)[16], const unsigned (&B)[16]) {
#pragma unroll
    for (int i = 0; i < 16; ++i) { const unsigned q = B[15 - i]; A[i] = A[i] > q ? A[i] : q; }
#pragma unroll
    for (int d = 8; d >= 1; d >>= 1)
#pragma unroll
        for (int i = 0; i < 16; ++i) if ((i & d) == 0) CMPX(A[i], A[i + d]);
}
__device__ __forceinline__ void merge_partner(unsigned (&Lk)[16]) {
    unsigned P[16];
#pragma unroll
    for (int i = 0; i < 16; ++i) P[i] = (unsigned)__shfl_xor((int)Lk[i], 32);
#pragma unroll
    for (int i = 0; i < 16; ++i) { const unsigned q = P[15 - i]; Lk[i] = Lk[i] > q ? Lk[i] : q; }
#pragma unroll
    for (int d = 8; d >= 1; d >>= 1)
#pragma unroll
        for (int i = 0; i < 16; ++i) if ((i & d) == 0) CMPX(Lk[i], Lk[i + d]);
}
__device__ __forceinline__ void route_item(const Frame& F, int item, int lane) {
    const int tok0 = (item >> 3) * 32, h = item & 7, c = lane & 31, hi = lane >> 5;
    const bf16* Q = WSP(bf16, WS_Q); const bf16* KB = WSP(bf16, WS_KEYS);
    LAS unsigned* WL = (LAS unsigned*)(F.lds + F.wave * 8192);
    unsigned LST[2][16];
    bf16x8 qf[8], qn[8], kf[8], kn[8];
#pragma unroll
    for (int ks = 0; ks < 8; ++ks) { qf[ks] = *(const bf16x8*)(Q + (size_t)(tok0 + c) * D + h * 256 + ks * 16 + 8 * hi); qn[ks] = *(const bf16x8*)(Q + (size_t)(tok0 + c) * D + h * 256 + 128 + ks * 16 + 8 * hi);
        kf[ks] = *(const bf16x8*)(KB + (size_t)((h * 2) * 128 + c) * 128 + 8 * hi + ks * 16); }
    unsigned Lk[16];
#pragma unroll
    for (int st = 0; st < 8; ++st) { const int p = st >> 2, m = st & 3;
        if (st < 7) { const int p2 = (st + 1) >> 2, m2 = (st + 1) & 3; const bf16* kp = KB + (size_t)((h * 2 + p2) * 128 + m2 * 32 + c) * 128 + 8 * hi;
#pragma unroll
            for (int ks = 0; ks < 8; ++ks) kn[ks] = *(const bf16x8*)(kp + ks * 16); }
        f32x16 acc;
#pragma unroll
        for (int r = 0; r < 16; ++r) acc[r] = 0.f;
#pragma unroll
        for (int ks = 0; ks < 8; ++ks) acc = MFMA32(kf[ks], p ? qn[ks] : qf[ks], acc);
        unsigned G16[16];
#pragma unroll
        for (int r = 0; r < 16; ++r) { const unsigned idx = (unsigned)(m * 32 + (r & 3) + 8 * (r >> 2)) | ((unsigned)hi << 2); G16[r] = (f2ord(acc[r]) & ~0x7Fu) | idx; }
        sort_desc<16>(G16);
        if (m == 0) {
#pragma unroll
            for (int i = 0; i < 16; ++i) Lk[i] = G16[i]; }
        else merge16(Lk, G16);
        if (m == 3) { merge_partner(Lk);
#pragma unroll
            for (int i = 0; i < 16; ++i) { LST[p][i] = Lk[i]; WL[(p * 16 + i) * 64 + lane] = Lk[i] & 0x7Fu; } }
#pragma unroll
        for (int ks = 0; ks < 8; ++ks) kf[ks] = kn[ks];
    }
    float va[4], vb[16];
#pragma unroll
    for (int i = 0; i < 4; ++i) va[i] = ord2f((hi ? LST[1][i] : LST[0][i]) & ~0x7Fu);
#pragma unroll
    for (int j = 0; j < 16; ++j) vb[j] = ord2f((hi ? LST[0][j] : LST[1][j]) & ~0x7Fu);
    unsigned C32[32];
#pragma unroll
    for (int i = 0; i < 32; ++i) C32[i] = 0u;
#pragma unroll
    for (int i = 0; i < 4; ++i) { const unsigned key = (f2ord(va[i] + vb[i]) & ~0xFFu) | (unsigned)(i * 17); C32[i] = hi ? 0u : key; }
    { int cn = 4;
#pragma unroll
      for (int i = 0; i < 3; ++i)
#pragma unroll
          for (int j = i + 1; j < 16; ++j) if ((i + 1) * (j + 1) <= 16) { const unsigned code = hi ? (unsigned)(j * 16 + i) : (unsigned)(i * 16 + j); C32[cn] = (f2ord(va[i] + vb[j]) & ~0xFFu) | code; ++cn; } }
    sort_desc<32>(C32);
    unsigned Ck[16];
#pragma unroll
    for (int i = 0; i < 16; ++i) Ck[i] = C32[i];
    merge_partner(Ck);
    const float mx = ord2f(Ck[0] & ~0xFFu); float den = 0.f;
#pragma unroll
    for (int k = 0; k < 16; ++k) den += __expf(ord2f(Ck[k] & ~0xFFu) - mx);
    const float rden = 1.0f / den;
    int eo[8]; float go[8];
#pragma unroll
    for (int k = 0; k < 8; ++k) { const unsigned fm = hi ? Ck[k + 8] : Ck[k]; const unsigned code = fm & 0xFFu;
        const unsigned k0 = WL[(code >> 4) * 64 + lane], k1 = WL[(16 + (code & 15u)) * 64 + lane];
        eo[k] = (int)(k0 * 128u + k1); go[k] = __expf(ord2f(fm & ~0xFFu) - mx) * rden; }
    int* ep = WSP(int, WS_EXP) + (size_t)(tok0 + c) * NSEL + h * 16 + hi * 8; float* gp = WSP(float, WS_GATE) + (size_t)(tok0 + c) * NSEL + h * 16 + hi * 8;
    *(int4*)ep = make_int4(eo[0], eo[1], eo[2], eo[3]); *(int4*)(ep + 4) = make_int4(eo[4], eo[5], eo[6], eo[7]);
    *(f32x4*)gp = (f32x4){go[0], go[1], go[2], go[3]}; *(f32x4*)(gp + 4) = (f32x4){go[4], go[5], go[6], go[7]};
}

typedef float f32x2 __attribute__((ext_vector_type(2)));
__device__ __forceinline__ int dot4i(unsigned a, unsigned b, int c) { return __builtin_amdgcn_sdot4((int)a, (int)b, c, false); }
template <int CTRL> __device__ __forceinline__ int dppi(int x) { return __builtin_amdgcn_mov_dpp(x, CTRL, 0xf, 0xf, true); }
struct PeerGeom { int ngrp, g, rank, nrank; };
__device__ __forceinline__ PeerGeom peer_geom(const Frame& F) { PeerGeom p; p.ngrp = (F.G % 8 == 0) ? 8 : 1; p.g = F.bid % p.ngrp; p.rank = F.bid / p.ngrp; p.nrank = F.G / p.ngrp; return p; }
__device__ __forceinline__ void xquant_token(const Frame& F, int tok, int lane) {
    const bf16* xr = WSP(bf16, WS_XB) + (size_t)tok * D + lane * 16; float xf[32]; float am = 0.f, sq = 0.f;
#pragma unroll
    for (int hh = 0; hh < 2; ++hh)
#pragma unroll
        for (int q = 0; q < 2; ++q) { const v4u w = *(const v4u*)(xr + hh * 1024 + q * 8); float t8[8]; unpack8(w, t8);
            const f32x4 g0 = *(const f32x4*)(F.in[I_G2N] + hh * 1024 + lane * 16 + q * 8), g1 = *(const f32x4*)(F.in[I_G2N] + hh * 1024 + lane * 16 + q * 8 + 4);
#pragma unroll
            for (int e = 0; e < 8; ++e) { const float xg = t8[e] * (e < 4 ? g0[e & 3] : g1[e & 3]); xf[hh * 16 + q * 8 + e] = xg; am = fmaxf(am, fabsf(xg)); sq += t8[e] * t8[e]; } }
#pragma unroll
    for (int o = 1; o < 64; o <<= 1) am = fmaxf(am, __shfl_xor(am, o));
    sq = wave_sum(sq);
    const float qs = am > 0.f ? 127.0f / am : 0.f;
    if (lane == 0) { WSP(float, WS_SX)[tok] = am * (1.0f / 127.0f); WSP(float, WS_SSQ2)[tok] = sq; }
#pragma unroll
    for (int hh = 0; hh < 2; ++hh) { v4u o;
#pragma unroll
        for (int d = 0; d < 4; ++d) { unsigned w = 0u;
#pragma unroll
            for (int e = 0; e < 4; ++e) { const int qi = (int)rintf(xf[hh * 16 + d * 4 + e] * qs); w |= ((unsigned)qi & 0xFFu) << (8 * e); }
            o[d] = w; }
        *(v4u*)(WSP(unsigned char, WS_XQ) + (size_t)tok * D + hh * 1024 + lane * 16) = o; }
}
__device__ __forceinline__ void yquant_tokens(const Frame& F, int tokA, int tokB, int lane) {
    v4u ra[2][2], rb[2][2];
#pragma unroll
    for (int hh = 0; hh < 2; ++hh)
#pragma unroll
        for (int q = 0; q < 2; ++q) { ra[hh][q] = *(const v4u*)(WSP(bf16, WS_Y) + (size_t)tokA * D + hh * 1024 + lane * 16 + q * 8); rb[hh][q] = *(const v4u*)(WSP(bf16, WS_Y) + (size_t)tokB * D + hh * 1024 + lane * 16 + q * 8); }
#define YQ_ONE(R_, tok_) do { float xf_[32]; float am_ = 0.f; \
        _Pragma("unroll") for (int hh_ = 0; hh_ < 2; ++hh_) _Pragma("unroll") for (int q_ = 0; q_ < 2; ++q_) { float t8_[8]; unpack8(R_[hh_][q_], t8_); \
            _Pragma("unroll") for (int e_ = 0; e_ < 8; ++e_) { xf_[hh_ * 16 + q_ * 8 + e_] = t8_[e_]; am_ = fmaxf(am_, fabsf(t8_[e_])); } } \
        am_ = fmaxf(am_, dppf<0xB1>(am_)); am_ = fmaxf(am_, dppf<0x4E>(am_)); am_ = fmaxf(am_, dppf<0x141>(am_)); am_ = fmaxf(am_, dppf<0x140>(am_)); \
        { auto s_ = __builtin_amdgcn_permlane16_swap(__float_as_uint(am_), __float_as_uint(am_), false, false); am_ = fmaxf(__uint_as_float(s_[0]), __uint_as_float(s_[1])); } \
        { auto s_ = __builtin_amdgcn_permlane32_swap(__float_as_uint(am_), __float_as_uint(am_), false, false); am_ = fmaxf(__uint_as_float(s_[0]), __uint_as_float(s_[1])); } \
        const float qs_ = am_ > 0.f ? 127.0f / am_ : 0.f; \
        if (lane == 0) WSP(float, WS_SY)[tok_] = am_ * (1.0f / 127.0f); \
        _Pragma("unroll") for (int hh_ = 0; hh_ < 2; ++hh_) { v4u o_; \
            _Pragma("unroll") for (int d_ = 0; d_ < 4; ++d_) { \
                const unsigned b0_ = __float_as_uint(__builtin_fmaf(xf_[hh_ * 16 + d_ * 4 + 0], qs_, 12582912.0f)), b1_ = __float_as_uint(__builtin_fmaf(xf_[hh_ * 16 + d_ * 4 + 1], qs_, 12582912.0f)); \
                const unsigned b2_ = __float_as_uint(__builtin_fmaf(xf_[hh_ * 16 + d_ * 4 + 2], qs_, 12582912.0f)), b3_ = __float_as_uint(__builtin_fmaf(xf_[hh_ * 16 + d_ * 4 + 3], qs_, 12582912.0f)); \
                o_[d_] = __builtin_amdgcn_perm(b1_, b0_, 0x0c0c0400u) | __builtin_amdgcn_perm(b3_, b2_, 0x04000c0cu); } \
            *(v4u*)(WSP(unsigned char, WS_YQ) + (size_t)(tok_) * D + hh_ * 1024 + lane * 16) = o_; } } while (0)
    YQ_ONE(ra, tokA);
    if (tokB != tokA) YQ_ONE(rb, tokB);
#undef YQ_ONE
}
struct PeerIds { int a, b; };
__device__ __forceinline__ PeerIds peer_ids_load(const Frame& F, int tok, int lane) { const int* ep = WSP(int, WS_EXP) + (size_t)tok * NSEL; PeerIds r; r.a = ep[lane]; r.b = ep[64 + lane]; return r; }
struct PeerScoreBuf { v4u w[16]; v4u xs; };
__device__ __forceinline__ void peer_score_issue(const Frame& F, int tok, int slice, int lane, LAS int* wl, const PeerIds& id, PeerScoreBuf& B) {
    const int e8 = lane >> 3, c16 = lane & 7;
    wl[lane] = id.a; wl[64 + lane] = id.b;
    B.xs = *(const v4u*)(WSP(unsigned char, WS_XQ) + (size_t)tok * D + slice * 128 + c16 * 16);
    const unsigned char* ub = WSP(unsigned char, WS_UT); const unsigned lo = (unsigned)(slice * 128 + c16 * 16);
#pragma unroll
    for (int ld = 0; ld < 16; ++ld) { const unsigned eid = (unsigned)wl[e8 * 16 + ld]; B.w[ld] = *(const v4u*)(ub + (eid * 2048u + lo)); }
}
__device__ __forceinline__ void peer_score_consume(const Frame& F, int tok, int slice, int lane, const PeerScoreBuf& B, bool valid) {
    int p[16];
#pragma unroll
    for (int ld = 0; ld < 16; ++ld) { const v4u w = B.w[ld]; int a = dot4i(w.x, B.xs.x, 0); a = dot4i(w.y, B.xs.y, a); a = dot4i(w.z, B.xs.z, a); p[ld] = dot4i(w.w, B.xs.w, a); }
    { const bool up = (lane & 4) != 0;
#pragma unroll
      for (int k = 0; k < 8; ++k) { const int keep = up ? p[k + 8] : p[k], send = up ? p[k] : p[k + 8]; p[k] = keep + dppi<0x141>(send); } }
    { const bool up = (lane & 2) != 0;
#pragma unroll
      for (int k = 0; k < 4; ++k) { const int keep = up ? p[k + 4] : p[k], send = up ? p[k] : p[k + 4]; p[k] = keep + dppi<0x4E>(send); } }
    { const bool up = (lane & 1) != 0;
#pragma unroll
      for (int k = 0; k < 2; ++k) { const int keep = up ? p[k + 2] : p[k], send = up ? p[k] : p[k + 2]; p[k] = keep + dppi<0xB1>(send); } }
    if (valid) { int* dst = WSP(int, WS_PART) + ((size_t)slice * T + tok) * NSEL + lane * 2; *(int2*)dst = make_int2(p[0], p[1]); }
}
__device__ __forceinline__ void peer_score_phase(const Frame& F, const PeerGeom& pg, LAS int* wl2) {
    const int lane = F.lane, first = pg.rank * NWAVES + F.wave, step = pg.nrank * NWAVES, n = first < T ? (T - first + step - 1) / step : 0;
    LAS int* wlA = wl2; LAS int* wlB = wl2 + 256;
#define PEER_TOKC(k_) ((first + (k_) * step) < T ? (first + (k_) * step) : T - 1)
    for (int r = 0; r < 16 / pg.ngrp; ++r) { const int slice = r * pg.ngrp + pg.g;
        PeerScoreBuf A, B; PeerIds id = peer_ids_load(F, PEER_TOKC(0), lane);
        { const PeerIds cur = id; id = peer_ids_load(F, PEER_TOKC(1), lane); asm volatile("" ::: "memory"); peer_score_issue(F, PEER_TOKC(0), slice, lane, wlA, cur, A); }
        for (int i = 0; i < n; i += 2) {
            { const PeerIds cur = id; id = peer_ids_load(F, PEER_TOKC(i + 2), lane); asm volatile("" ::: "memory"); peer_score_issue(F, PEER_TOKC(i + 1), slice, lane, wlB, cur, B); }
            peer_score_consume(F, first + i * step, slice, lane, A, true);
            { const PeerIds cur = id; id = peer_ids_load(F, PEER_TOKC(i + 3), lane); asm volatile("" ::: "memory"); peer_score_issue(F, PEER_TOKC(i + 2), slice, lane, wlA, cur, A); }
            peer_score_consume(F, first + (i + 1) * step, slice, lane, B, i + 1 < n);
        }
    }
}
__device__ __forceinline__ void peer_coef_token(const Frame& F, int tok, int lane) {
    int s0 = 0, s1 = 0;
#pragma unroll
    for (int s = 0; s < 16; ++s) { const int2 v = *(const int2*)(WSP(int, WS_PART) + ((size_t)s * T + tok) * NSEL + lane * 2); s0 += v.x; s1 += v.y; }
    const int2 ex = *(const int2*)(WSP(int, WS_EXP) + (size_t)tok * NSEL + lane * 2); const f32x2 ga = *(const f32x2*)(WSP(float, WS_GATE) + (size_t)tok * NSEL + lane * 2);
    const float rs = WSP(float, WS_SX)[tok] * (1.0f / sqrtf(WSP(float, WS_SSQ2)[tok] * (1.0f / D) + NORM_EPS));
    const float sc0 = (float)s0 * WSP(float, WS_USC)[ex.x] * rs, sc1 = (float)s1 * WSP(float, WS_USC)[ex.y] * rs;
    f32x2 c; c.x = ga.x * gelu_fast(sc0) * WSP(float, WS_VSC)[ex.x]; c.y = ga.y * gelu_fast(sc1) * WSP(float, WS_VSC)[ex.y];
    float cm = fmaxf(fabsf(c.x), fabsf(c.y));
#pragma unroll
    for (int o = 1; o < 64; o <<= 1) cm = fmaxf(cm, __shfl_xor(cm, o));
    const float qs = cm > 0.f ? 127.0f / cm : 0.f;
    const int q0 = (int)rintf(c.x * qs), q1 = (int)rintf(c.y * qs);
    ((unsigned short*)(F.ws + WS_COEF))[(size_t)tok * 64 + lane] = (unsigned short)(((unsigned)q0 & 0xFFu) | (((unsigned)q1 & 0xFFu) << 8));
    if (lane == 0) WSP(float, WS_CSC)[tok] = cm * (1.0f / 127.0f);
}
struct PeerOutBuf { v4u w[16]; v4u cq; unsigned x; float cs; };
__device__ __forceinline__ void peer_out_issue(const Frame& F, int tok, int slice, int lane, LAS int* wl, const PeerIds& id, PeerOutBuf& B) {
    const int e8 = lane >> 3, c16 = lane & 7;
    wl[lane] = id.a; wl[64 + lane] = id.b;
    B.cq = *(const v4u*)(F.ws + WS_COEF + (size_t)tok * 128 + e8 * 16);
    B.cs = WSP(float, WS_CSC)[tok];
    const unsigned char* vb = WSP(unsigned char, WS_VT); const unsigned lofs = (unsigned)(slice * 128 + c16 * 16);
#pragma unroll
    for (int ld = 0; ld < 16; ++ld) { const unsigned eid = (unsigned)wl[e8 * 16 + ld]; B.w[ld] = *(const v4u*)(vb + (eid * 2048u + lofs)); }
    B.x = *(const unsigned*)(WSP(bf16, WS_XB) + (size_t)tok * D + slice * 128 + c16 * 16 + e8 * 2);
}
__device__ __forceinline__ void peer_out_consume(const Frame& F, int tok, int slice, int lane, const PeerOutBuf& B, bool valid) {
    const int e8 = lane >> 3, c16 = lane & 7;
    int o[16];
#pragma unroll
    for (int i = 0; i < 16; ++i) o[i] = 0;
#pragma unroll
    for (int g = 0; g < 4; ++g) { const unsigned cq = B.cq[g];
#pragma unroll
        for (int d = 0; d < 4; ++d) { const unsigned w0 = B.w[4 * g][d], w1 = B.w[4 * g + 1][d], w2 = B.w[4 * g + 2][d], w3 = B.w[4 * g + 3][d];
            const unsigned lo01 = __builtin_amdgcn_perm(w1, w0, 0x05010400u), hi01 = __builtin_amdgcn_perm(w1, w0, 0x07030602u);
            const unsigned lo23 = __builtin_amdgcn_perm(w3, w2, 0x05010400u), hi23 = __builtin_amdgcn_perm(w3, w2, 0x07030602u);
            const unsigned t0 = __builtin_amdgcn_perm(lo23, lo01, 0x05040100u), t1 = __builtin_amdgcn_perm(lo23, lo01, 0x07060302u);
            const unsigned t2 = __builtin_amdgcn_perm(hi23, hi01, 0x05040100u), t3 = __builtin_amdgcn_perm(hi23, hi01, 0x07060302u);
            o[d * 4 + 0] = dot4i(t0, cq, o[d * 4 + 0]); o[d * 4 + 1] = dot4i(t1, cq, o[d * 4 + 1]); o[d * 4 + 2] = dot4i(t2, cq, o[d * 4 + 2]); o[d * 4 + 3] = dot4i(t3, cq, o[d * 4 + 3]); } }
#pragma unroll
    for (int k = 0; k < 8; ++k) { auto s = __builtin_amdgcn_permlane32_swap((unsigned)o[k], (unsigned)o[k + 8], false, false); o[k] = (int)(s[0] + s[1]); }
#pragma unroll
    for (int k = 0; k < 4; ++k) { auto s = __builtin_amdgcn_permlane16_swap((unsigned)o[k], (unsigned)o[k + 4], false, false); o[k] = (int)(s[0] + s[1]); }
    { const bool up = (lane & 8) != 0;
#pragma unroll
      for (int k = 0; k < 2; ++k) { const int keep = up ? o[k + 2] : o[k], send = up ? o[k] : o[k + 2]; o[k] = keep + dppi<0x128>(send); } }
    const float x0 = bf_lo(B.x) + (float)o[0] * B.cs, x1 = bf_hi(B.x) + (float)o[1] * B.cs;
    if (valid) *(unsigned*)(WSP(bf16, WS_XB) + (size_t)tok * D + slice * 128 + c16 * 16 + e8 * 2) = cvtpk(x0, x1);
}
__device__ __forceinline__ void peer_out_phase(const Frame& F, const PeerGeom& pg, LAS int* wl2) {
    const int lane = F.lane, first = pg.rank * NWAVES + F.wave, step = pg.nrank * NWAVES, n = first < T ? (T - first + step - 1) / step : 0;
    LAS int* wlA = wl2; LAS int* wlB = wl2 + 256;
    for (int r = 0; r < 16 / pg.ngrp; ++r) { const int slice = r * pg.ngrp + pg.g;
        PeerOutBuf A, B; PeerIds id = peer_ids_load(F, PEER_TOKC(0), lane);
        { const PeerIds cur = id; id = peer_ids_load(F, PEER_TOKC(1), lane); asm volatile("" ::: "memory"); peer_out_issue(F, PEER_TOKC(0), slice, lane, wlA, cur, A); }
        for (int i = 0; i < n; i += 2) {
            { const PeerIds cur = id; id = peer_ids_load(F, PEER_TOKC(i + 2), lane); asm volatile("" ::: "memory"); peer_out_issue(F, PEER_TOKC(i + 1), slice, lane, wlB, cur, B); }
            peer_out_consume(F, first + i * step, slice, lane, A, true);
            { const PeerIds cur = id; id = peer_ids_load(F, PEER_TOKC(i + 3), lane); asm volatile("" ::: "memory"); peer_out_issue(F, PEER_TOKC(i + 2), slice, lane, wlA, cur, A); }
            peer_out_consume(F, first + (i + 1) * step, slice, lane, B, i + 1 < n);
        }
    }
}
#undef PEER_TOKC
__device__ __forceinline__ void final_norm_phase(const Frame& F) {
    const int lane = F.lane, gw = F.bid * NWAVES + F.wave, NGW = F.G * NWAVES;
    const f32x4* gf = (const f32x4*)F.in[I_GF] + lane;
    f32x4 g[8];
#pragma unroll
    for (int j = 0; j < 8; ++j) g[j] = gf[64 * j];
    if (gw >= T) return;
    v2u va[8], vb[8]; float sa, sb;
#define FN_LOAD(v_, s_, tok_) do { const int tc_ = (tok_) < T ? (tok_) : T - 1; const v2u* xi_ = (const v2u*)(WSP(bf16, WS_XB) + (size_t)tc_ * D) + lane; \
        _Pragma("unroll") for (int j_ = 0; j_ < 8; ++j_) v_[j_] = xi_[64 * j_]; } while (0)
#define FN_STORE(v_, s_, tok_) do { f32x4* xo_ = (f32x4*)(F.out + (size_t)(tok_) * D) + lane; s_ = 0.f; f32x4 f_[8]; \
        _Pragma("unroll") for (int j_ = 0; j_ < 8; ++j_) { f_[j_] = (f32x4){bf_lo(v_[j_].x), bf_hi(v_[j_].x), bf_lo(v_[j_].y), bf_hi(v_[j_].y)}; s_ += (f_[j_][0] * f_[j_][0] + f_[j_][1] * f_[j_][1]) + (f_[j_][2] * f_[j_][2] + f_[j_][3] * f_[j_][3]); } \
        s_ = wave_sum(s_); const float rs_ = 1.0f / sqrtf(s_ * (1.0f / D) + NORM_EPS); \
        _Pragma("unroll") for (int j_ = 0; j_ < 8; ++j_) xo_[64 * j_] = f_[j_] * rs_ * g[j_]; } while (0)
    FN_LOAD(va, sa, gw);
    for (int tok = gw; tok < T; tok += 2 * NGW) {
        FN_LOAD(vb, sb, tok + NGW);
        FN_STORE(va, sa, tok);
        FN_LOAD(va, sa, tok + 2 * NGW);
        if (tok + NGW < T) FN_STORE(vb, sb, tok + NGW);
    }
#undef FN_LOAD
#undef FN_STORE
}

struct Args { const float* in[28]; float* out; unsigned char* ws; int ph_lo, ph_hi, li, pad; };
__global__ void __launch_bounds__(NTHR, 2) hybrid_fwd(Args args) {
    extern __shared__ __attribute__((aligned(16))) unsigned char lds[];
    Frame F;
    F.lds = (LAS unsigned char*)lds;
    F.tid = threadIdx.x; F.lane = F.tid & 63; F.wave = __builtin_amdgcn_readfirstlane(F.tid >> 6);
    F.G = gridDim.x; F.bid = blockIdx.x;
#pragma unroll
    for (int i = 0; i < 28; ++i) F.in[i] = args.in[i];
    F.out = args.out; F.ws = args.ws;
    volatile LAS unsigned* MISC = (volatile LAS unsigned*)(F.lds + MISC_OFF);
    for (int u = F.tid; u < (LDS_BYTES - LDSCTL_OFF) / 4; u += NTHR) ((LAS unsigned*)(F.lds + LDSCTL_OFF))[u] = 0u;
    __syncthreads();
    unsigned* barw = (unsigned*)(F.ws + WS_CTL) + CW_BAR;
    XcdBarrier bar; bar.bar = barw; bar.x = 0; bar.st = nullptr;
    if (N_LAUNCHES == 1) bar = xcd_barrier_post(barw, MISC + 8);
    const int lo = args.ph_lo, hi = args.ph_hi;
#define IN(k) (lo <= (k) && (k) < hi)
#define SEAM(k) do { if (IN(k) && IN((k) + 1)) xcd_barrier(bar); } while (0)

#ifndef PROBE_DUP
#define PROBE_DUP -1
#endif
#define REPS(k) for (int rep_ = 0; rep_ < ((PROBE_DUP) == (k) ? 2 : 1); ++rep_)
    if (IN(0)) REPS(0) { p0_prologue<0>(F, F.bid, F.G); __syncthreads(); }
    SEAM(0);
    if (IN(1)) REPS(1) {
        pg8::Gemm g{WSP(const bf16, WS_XB), WSP(const bf16, WS_WIN), T, NINP, D / 2}; pg8::StaticOrder S; S.init(T, NINP, F.G, F.bid);
        pg8::EpiI8RowColBf16<0> E{WSP(bf16, WS_PROJ), NINP, WSP(const float, WS_RSTD1), WSP(const float, WS_CS1), nullptr, NORM_EPS};
        pg8::gemm_phase<pg8::EpiI8RowColBf16<0>, pg8::StaticOrder, true, true, true>(F.lds, g, S, E);
    }
    SEAM(1);
    if (IN(2)) REPS(2) {
        lora_prepass(F);
        group_barrier((unsigned*)(F.ws + WS_CTL) + CW_PREBAR, (unsigned)F.G);
        for (int r4 = 0; r4 < ((PROBE_DUP) == 70 ? 2 : 1); ++r4) rwkv_prep_phase(F);
        group_barrier((unsigned*)(F.ws + WS_CTL) + CW_PREPBAR, (unsigned)F.G);
        const int R1 = F.G >= 256 ? 128 : F.G, L0 = F.G >= 256 ? 128 : 0, NL = F.G - L0;
        if (F.bid < R1) for (int it = F.bid; it < 128; it += R1) rwkv_item(F, it);
        if (F.bid >= L0) for (int it = F.bid - L0; it < 128; it += NL) lru_seq(F, it);
        { volatile LAS int* qslot = (volatile LAS int*)(F.lds + LDSCTL_OFF + 1024);
          for (;;) { __syncthreads(); if (F.tid == 0) *qslot = (int)xb_add((unsigned*)(F.ws + WS_CTL) + CW_DEFQ, 1u); __syncthreads();
              const int vb = *qslot; if (vb >= DEF_SLICES) break; p0_prologue<1>(F, vb, DEF_SLICES); } }
    }
    SEAM(2);
    if (IN(3)) REPS(3) { const int gw = F.bid * NWAVES + F.wave, NGW = F.G * NWAVES;
        for (int tok = gw; tok < T; tok += 2 * NGW) yquant_tokens(F, tok, tok + NGW < T ? tok + NGW : tok, F.lane); }
    SEAM(3);
    if (IN(4)) REPS(4) {
        pg8::Gemm g{WSP(const bf16, WS_YQ), WSP(const bf16, WS_WOUT), T, D, D / 2}; pg8::StaticOrder S; S.init(T, D, F.G, F.bid);
        pg8::EpiI8Residual E{F.in[I_X], WSP(bf16, WS_XB), D, WSP(const float, WS_SY), WSP(const float, WS_CSO)};
        pg8::gemm_phase<pg8::EpiI8Residual, pg8::StaticOrder, true, true, true>(F.lds, g, S, E);
    }
    SEAM(4);
    if (IN(5)) { const int gw = F.bid * NWAVES + F.wave, NGW = F.G * NWAVES;
        for (int tok = gw; tok < T; tok += NGW) xquant_token(F, tok, F.lane); }
    SEAM(5);
    if (IN(6)) REPS(6) {
        pg8::Gemm g{WSP(const bf16, WS_XQ), WSP(const bf16, WS_WQ), T, D, D / 2}; pg8::StaticOrder S; S.init(T, D, F.G, F.bid);
        pg8::EpiI8RowColBf16<1> E{WSP(bf16, WS_Q), D, WSP(const float, WS_SX), WSP(const float, WS_CSQ), WSP(const float, WS_SSQ2), NORM_EPS};
        pg8::gemm_phase<pg8::EpiI8RowColBf16<1>, pg8::StaticOrder, true, true, true>(F.lds, g, S, E);
    }
    if (IN(6)) { __syncthreads();
        pg8::StaticOrder S; S.init(T, D, F.G, F.bid); pg8::Unit u;
        for (int i = 0; S.next(i, u); ++i) route_item(F, ((u.pm * 8 + F.wave) << 3) | u.pn, F.lane); }
    SEAM(6);
    { const PeerGeom pg = peer_geom(F); LAS int* wl = (LAS int*)(F.lds + F.wave * 1024);
      if (IN(7)) REPS(7) peer_score_phase(F, pg, (LAS int*)(F.lds + 16384 + F.wave * 2048));
      SEAM(7);
      if (IN(8)) REPS(8) { const int gw = F.bid * NWAVES + F.wave, NGW = F.G * NWAVES; for (int tok = gw; tok < T; tok += NGW) peer_coef_token(F, tok, F.lane); }
      SEAM(8);
      if (IN(9)) peer_out_phase(F, pg, (LAS int*)(F.lds + 16384 + F.wave * 2048));
      SEAM(9);
      if (IN(10)) final_norm_phase(F); }
#undef IN
#undef SEAM
}

extern "C" void kernel_launch(void* const* d_in, const int* in_sizes, int n_in, void* d_out, int out_size, void* d_ws, size_t ws_size, hipStream_t stream) {
    static int grid = 0;
    if (grid == 0) {
        if (n_in != 28 || in_sizes[0] != T * D || out_size != T * D || ws_size < WS_END) { fprintf(stderr, "kernel_launch: shape/workspace mismatch: n_in %d in0 %d out %d ws %zu (need %zu)\n", n_in, n_in > 0 ? in_sizes[0] : -1, out_size, ws_size, (size_t)WS_END); grid = -1; return; }
        int dev = 0, cus = 0, per_cu = 0;
        if (hipGetDevice(&dev) != hipSuccess || hipDeviceGetAttribute(&cus, hipDeviceAttributeMultiprocessorCount, dev) != hipSuccess) { fprintf(stderr, "kernel_launch: device query failed\n"); grid = -1; return; }
        if (hipFuncSetAttribute((const void*)hybrid_fwd, hipFuncAttributeMaxDynamicSharedMemorySize, LDS_BYTES) != hipSuccess) { fprintf(stderr, "kernel_launch: hipFuncSetAttribute failed\n"); grid = -1; return; }
        if (hipOccupancyMaxActiveBlocksPerMultiprocessor(&per_cu, (const void*)hybrid_fwd, NTHR, LDS_BYTES) != hipSuccess || per_cu < 1) { fprintf(stderr, "kernel_launch: occupancy query says %d blocks per CU\n", per_cu); per_cu = 1; }
        (void)hipGetLastError();
        grid = cus;
    }
    if (grid < 0) return;
    if (hipMemsetAsync((char*)d_ws + WS_CTL, 0, CTL_ZERO_BYTES, stream) != hipSuccess) { fprintf(stderr, "kernel_launch: hipMemsetAsync failed\n"); return; }
    Args a{};
    for (int i = 0; i < 28; ++i) a.in[i] = (const float*)d_in[i];
    a.out = (float*)d_out; a.ws = (unsigned char*)d_ws;
    for (int li = 0; li < N_LAUNCHES; ++li) {
        a.ph_lo = (N_LAUNCHES == 1) ? 0 : li; a.ph_hi = (N_LAUNCHES == 1) ? N_PHASES : li + 1; a.li = li;
        hipLaunchKernelGGL(hybrid_fwd, dim3(grid), dim3(NTHR), LDS_BYTES, stream, a);
        const hipError_t le = hipPeekAtLastError();
        if (le != hipSuccess) { fprintf(stderr, "kernel_launch: launch %d failed: %s\n", li, hipGetErrorName(le)); break; }
    }
}
```

```cpp
#include <hip/hip_runtime.h>
#include <cstdio>
#include <cstdint>
namespace pg8 {
#define PG8_LAS __attribute__((address_space(3)))
typedef unsigned short bf16_t;
typedef short bf16x8 __attribute__((ext_vector_type(8)));
typedef float f32x4 __attribute__((ext_vector_type(4)));
typedef unsigned u32x4 __attribute__((ext_vector_type(4)));
typedef int i32x4 __attribute__((ext_vector_type(4)));
constexpr int BM = 256, BK = 64, HALF = 128, HTB = HALF * BK * 2  , STAGE_BYTES = 8 * HTB, NXCD = 8, WGM = 8;

__host__ __device__ __forceinline__ int lds_byte(int r, int c) { const int st = (r >> 4) * 2 + (c >> 5), rr = r & 15, cc = c & 31, ob = rr * 64 + cc * 2; return st * 1024 + (ob ^ (((ob >> 9) & 1) << 5)); }
__host__ __device__ __forceinline__ void stage_rc(int b, int& R, int& C) { const int st = b / 1024, sb = b % 1024, swz = sb ^ (((sb >> 9) & 1) << 5); R = (st >> 1) * 16 + swz / 64; C = (st & 1) * 32 + (swz % 64) / 2; }
__host__ __device__ __forceinline__ int perm32(int rho) { const int n = rho >> 4, i = rho & 15; return 8 * (i >> 2) + 4 * n + (i & 3); }

struct Unit { int pm, pn; };
struct Gemm { const bf16_t* A; const bf16_t* Bt; int M, N, K; };

struct StaticOrder {
    int nM, nN, nwg, G, c;
    __host__ __device__ void init(int M, int N, int G_, int c_) { nM = M / BM; nN = N / BM; nwg = nM * nN; G = G_; c = c_; }
    __host__ __device__ bool next(int i, Unit& u) const {
        const long L = (long)i * G + c; if (L >= nwg) return false;
        int wgid = (int)L; { const int q = nwg / NXCD, r = nwg % NXCD, xcd = wgid % NXCD, off = wgid / NXCD; wgid = (xcd < r ? xcd * (q + 1) : r * (q + 1) + (xcd - r) * q) + off; }
        const int nig = WGM * nN, gid = wgid / nig, fm = gid * WGM, gsz = (nM - fm) < WGM ? (nM - fm) : WGM;
        u.pm = fm + ((wgid % nig) % gsz); u.pn = (wgid % nig) / gsz; return true;
    }
    __device__ __forceinline__ void a_ready(const Unit&) const {}
    __device__ __forceinline__ void done(const Unit&) const {}
};

__device__ __forceinline__ unsigned cvt_pk_bf16(float lo, float hi) { unsigned r; asm volatile("v_cvt_pk_bf16_f32 %0, %1, %2" : "=v"(r) : "v"(lo), "v"(hi)); return r; }
typedef float f32x2 __attribute__((ext_vector_type(2)));
typedef unsigned u32x2 __attribute__((ext_vector_type(2)));
template <int MODE> struct EpiRowScaleBf16 {
    static constexpr bool PERM = true, AFTER_DRAIN = false;
    bf16_t* O; int ldc; const float* rs; float eps;
    __device__ __forceinline__ void operator()(const f32x4 (&acc)[2][2][4][2], const Unit& u, int wr, int wc, int fr, int fq) const {
        const int row0 = u.pm * BM + wr * 64 + fr, col0 = u.pn * BM + wc * 32 + 8 * fq;
#pragma unroll
        for (int ai = 0; ai < 2; ++ai)
#pragma unroll
            for (int m = 0; m < 4; ++m) { const int r = row0 + ai * HALF + m * 16; float s = rs[r]; if (MODE == 1) s = 1.0f / sqrtf(s * (1.0f / 2048.0f) + eps);
                bf16_t* rowp = O + (size_t)r * ldc + col0;
#pragma unroll
                for (int bj = 0; bj < 2; ++bj) { const f32x4 v0 = acc[ai][bj][m][0] * s, v1 = acc[ai][bj][m][1] * s;
                    u32x4 w; w.x = cvt_pk_bf16(v0[0], v0[1]); w.y = cvt_pk_bf16(v0[2], v0[3]); w.z = cvt_pk_bf16(v1[0], v1[1]); w.w = cvt_pk_bf16(v1[2], v1[3]);
                    *(u32x4*)(rowp + bj * HALF) = w; } }
    }
};
template <int MODE> struct EpiI8RowColBf16 {
    static constexpr bool PERM = true, AFTER_DRAIN = false;
    bf16_t* O; int ldc; const float* rs; const float* cs; const float* ssq; float eps;
    __device__ __forceinline__ void operator()(const f32x4 (&acc)[2][2][4][2], const Unit& u, int wr, int wc, int fr, int fq) const {
        const int row0 = u.pm * BM + wr * 64 + fr, col0 = u.pn * BM + wc * 32 + 8 * fq;
        f32x4 c4[2][2];
#pragma unroll
        for (int bj = 0; bj < 2; ++bj) { c4[bj][0] = *(const f32x4*)(cs + col0 + bj * HALF); c4[bj][1] = *(const f32x4*)(cs + col0 + bj * HALF + 4); }
#pragma unroll
        for (int ai = 0; ai < 2; ++ai)
#pragma unroll
            for (int m = 0; m < 4; ++m) { const int r = row0 + ai * HALF + m * 16; float s = rs[r]; if (MODE == 1) s = s / sqrtf(ssq[r] * (1.0f / 2048.0f) + eps);
                bf16_t* rowp = O + (size_t)r * ldc + col0;
#pragma unroll
                for (int bj = 0; bj < 2; ++bj) { f32x4 v0, v1; const i32x4 i0 = __builtin_bit_cast(i32x4, acc[ai][bj][m][0]), i1 = __builtin_bit_cast(i32x4, acc[ai][bj][m][1]);
#pragma unroll
                    for (int e = 0; e < 4; ++e) { v0[e] = (float)i0[e] * s * c4[bj][0][e]; v1[e] = (float)i1[e] * s * c4[bj][1][e]; }
                    u32x4 w; w.x = cvt_pk_bf16(v0[0], v0[1]); w.y = cvt_pk_bf16(v0[2], v0[3]); w.z = cvt_pk_bf16(v1[0], v1[1]); w.w = cvt_pk_bf16(v1[2], v1[3]);
                    *(u32x4*)(rowp + bj * HALF) = w; } }
    }
};
struct EpiResidual {
    static constexpr bool PERM = false, AFTER_DRAIN = false;
    const float* base; bf16_t* outb; int ldc;
    __device__ __forceinline__ void operator()(const f32x4 (&acc)[2][2][4][2], const Unit& u, int wr, int wc, int fr, int fq) const {
        const int row0 = u.pm * BM + wr * 64 + fr, col0 = u.pn * BM + wc * 32 + 4 * fq;
#pragma unroll
        for (int ai = 0; ai < 2; ++ai)
#pragma unroll
            for (int m = 0; m < 4; ++m) { const int r = row0 + ai * HALF + m * 16; const size_t off = (size_t)r * ldc + col0;
#pragma unroll
                for (int bj = 0; bj < 2; ++bj)
#pragma unroll
                    for (int n = 0; n < 2; ++n) { const f32x4 bs = *(const f32x4*)(base + off + bj * HALF + n * 16); const f32x4 o = bs + acc[ai][bj][m][n];
                        u32x2 w; w.x = cvt_pk_bf16(o[0], o[1]); w.y = cvt_pk_bf16(o[2], o[3]); *(u32x2*)(outb + off + bj * HALF + n * 16) = w; } }
    }
};
struct EpiI8Residual {
    static constexpr bool PERM = true, AFTER_DRAIN = false;
    const unsigned char* x8; const float* xs; bf16_t* outb; int ldc; const float* rs; const float* cs;
    __device__ __forceinline__ void operator()(const f32x4 (&acc)[2][2][4][2], const Unit& u, int wr, int wc, int fr, int fq) const {
        const int row0 = u.pm * BM + wr * 64 + fr, col0 = u.pn * BM + wc * 32 + 8 * fq;
        f32x4 c4[2][2];
#pragma unroll
        for (int bj = 0; bj < 2; ++bj) { c4[bj][0] = *(const f32x4*)(cs + col0 + bj * HALF); c4[bj][1] = *(const f32x4*)(cs + col0 + bj * HALF + 4); }
#pragma unroll
        for (int ai = 0; ai < 2; ++ai)
#pragma unroll
            for (int m = 0; m < 4; ++m) { const int r = row0 + ai * HALF + m * 16; const float s = rs[r], sx = xs[r]; const size_t off = (size_t)r * ldc + col0;
#pragma unroll
                for (int bj = 0; bj < 2; ++bj) { const i32x4 i0 = __builtin_bit_cast(i32x4, acc[ai][bj][m][0]), i1 = __builtin_bit_cast(i32x4, acc[ai][bj][m][1]);
                    const u32x2 xb = *(const u32x2*)(x8 + off + bj * HALF); f32x4 v0, v1;
#pragma unroll
                    for (int e = 0; e < 4; ++e) { v0[e] = (float)((int)(xb.x << (24 - 8 * e)) >> 24) * sx + (float)i0[e] * s * c4[bj][0][e]; v1[e] = (float)((int)(xb.y << (24 - 8 * e)) >> 24) * sx + (float)i1[e] * s * c4[bj][1][e]; }
                    u32x4 w; w.x = cvt_pk_bf16(v0[0], v0[1]); w.y = cvt_pk_bf16(v0[2], v0[3]); w.z = cvt_pk_bf16(v1[0], v1[1]); w.w = cvt_pk_bf16(v1[2], v1[3]);
                    *(u32x4*)(outb + off + bj * HALF) = w; } }
    }
};
template <class Epi, class Sched, bool ALIGN_EPI = false, bool SP2 = false, bool I8 = false>
__device__ __forceinline__ void gemm_phase(PG8_LAS unsigned char* lds, const Gemm g, const Sched& S, const Epi& E) {
    const int tid = threadIdx.x, wid = __builtin_amdgcn_readfirstlane(tid >> 6), lane = tid & 63, wr = wid >> 2, wc = wid & 3, fr = lane & 15, fq = lane >> 4;
    const int K = g.K, nt = K / BK;
    unsigned voffA[2], voffB[2];
#pragma unroll
    for (int i = 0; i < 2; ++i) { int R, C; stage_rc(tid * 16 + i * 8192, R, C); const int Rb = Epi::PERM ? ((R & ~31) + perm32(R & 31)) : R;
        voffA[i] = (unsigned)(R * K + C) * 2u; voffB[i] = (unsigned)(Rb * K + C) * 2u; }
    const size_t kstep = (size_t)(BK * 2);
    const size_t hstep = (size_t)HALF * K * 2;
    const size_t tstep = 2 * hstep;
    const unsigned ldsw = (unsigned)wid * 1024u;
    const int aoff = lds_byte(wr * 64 + fr, fq * 8), boff = lds_byte(wc * 32 + fr, fq * 8);
#define PG8_SA(b, h) (((b) * 2 + (h)) * HTB)
#define PG8_SB(b, h) ((4 + (b) * 2 + (h)) * HTB)
#define PG8_STAGE(bufoff, gbase, voff) do { _Pragma("unroll") for (int _i = 0; _i < 2; ++_i) \
        __builtin_amdgcn_global_load_lds((const unsigned*)((const char*)(gbase) + (voff)[_i]), (PG8_LAS unsigned*)(lds + (bufoff) + ldsw + _i * 8192), 16, 0, 0); } while (0)
#define PG8_LDA(dst, b, h) do { _Pragma("unroll") for (int m = 0; m < 4; ++m) _Pragma("unroll") for (int k = 0; k < 2; ++k) dst[m][k] = *(const PG8_LAS bf16x8*)(lds + PG8_SA(b, h) + aoff + m * 2048 + k * 1024); } while (0)
#define PG8_LDB(dst, b, h) do { _Pragma("unroll") for (int n = 0; n < 2; ++n) _Pragma("unroll") for (int k = 0; k < 2; ++k) dst[n][k] = *(const PG8_LAS bf16x8*)(lds + PG8_SB(b, h) + boff + n * 2048 + k * 1024); } while (0)
#define PG8_MMA(ai, bj, At, Bt) do { __builtin_amdgcn_s_setprio(1); _Pragma("unroll") for (int m = 0; m < 4; ++m) _Pragma("unroll") for (int n = 0; n < 2; ++n) _Pragma("unroll") for (int k = 0; k < 2; ++k) \
        { if constexpr (I8) acc[ai][bj][m][n] = __builtin_bit_cast(f32x4, __builtin_amdgcn_mfma_i32_16x16x64_i8(__builtin_bit_cast(i32x4, Bt[n][k]), __builtin_bit_cast(i32x4, At[m][k]), __builtin_bit_cast(i32x4, acc[ai][bj][m][n]), 0, 0, 0)); \
          else acc[ai][bj][m][n] = __builtin_amdgcn_mfma_f32_16x16x32_bf16(Bt[n][k], At[m][k], acc[ai][bj][m][n], 0, 0, 0); } __builtin_amdgcn_s_setprio(0); } while (0)
#define PG8_WAIT_V(n) asm volatile("s_waitcnt vmcnt(" #n ")" ::: "memory")
#define PG8_WAIT_L(n) asm volatile("s_waitcnt lgkmcnt(" #n ")" ::: "memory")
#define PG8_BAR __builtin_amdgcn_s_barrier()
#define PG8_SCHED __builtin_amdgcn_sched_barrier(0)
    Unit cur, nxt; int ui = 0;
    if (!S.next(0, cur)) return;
    f32x4 acc[2][2][4][2];
#pragma unroll
    for (int a = 0; a < 2; ++a)
#pragma unroll
        for (int b = 0; b < 2; ++b)
#pragma unroll
            for (int m = 0; m < 4; ++m)
#pragma unroll
                for (int n = 0; n < 2; ++n) acc[a][b][m][n] = (f32x4){0.f, 0.f, 0.f, 0.f};
    bf16x8 At[4][2], B0[2][2], B1[2][2];
    const char* cA = (const char*)g.A + (size_t)cur.pm * tstep; const char* cB = (const char*)g.Bt + (size_t)cur.pn * tstep;
    S.a_ready(cur);
    if constexpr (SP2) {
        PG8_STAGE(PG8_SB(0, 0), cB, voffB); PG8_STAGE(PG8_SB(0, 1), cB + hstep, voffB); PG8_STAGE(PG8_SA(0, 0), cA, voffA); PG8_STAGE(PG8_SA(0, 1), cA + hstep, voffA);
        if (wr == 1) PG8_BAR;
        PG8_WAIT_V(2); PG8_BAR;
        PG8_STAGE(PG8_SB(1, 0), cB + kstep, voffB); PG8_STAGE(PG8_SA(1, 0), cA + kstep, voffA); PG8_STAGE(PG8_SB(1, 1), cB + hstep + kstep, voffB);
        PG8_WAIT_V(6); PG8_BAR;
    } else {
        PG8_STAGE(PG8_SB(0, 0), cB, voffB); PG8_STAGE(PG8_SA(0, 0), cA, voffA); PG8_STAGE(PG8_SB(0, 1), cB + hstep, voffB); PG8_STAGE(PG8_SA(0, 1), cA + hstep, voffA);
        if (wr == 1) PG8_BAR;
        PG8_WAIT_V(4); PG8_BAR;
        PG8_STAGE(PG8_SB(1, 0), cB + kstep, voffB); PG8_STAGE(PG8_SA(1, 0), cA + kstep, voffA); PG8_STAGE(PG8_SB(1, 1), cB + hstep + kstep, voffB);
        PG8_WAIT_V(6); PG8_BAR;
    }
    for (;;) {
        const bool has_next = S.next(ui + 1, nxt);
        const char* nA = has_next ? (const char*)g.A + (size_t)nxt.pm * tstep : cA; const char* nB = has_next ? (const char*)g.Bt + (size_t)nxt.pn * tstep : cB;
        for (int t = 0; t < nt; t += 2) {
            const bool last = (t == nt - 2);
            const char* a1 = cA + (size_t)(t + 1) * kstep;
            const char* a2 = last ? nA : cA + (size_t)(t + 2) * kstep; const char* b2 = last ? nB : cB + (size_t)(t + 2) * kstep;
            const char* a3 = a2 + kstep; const char* b3 = b2 + kstep;
            if (last && has_next) S.a_ready(nxt);
            if constexpr (SP2) {
            PG8_LDB(B0, 0, 0); PG8_LDB(B1, 0, 1); PG8_SCHED; PG8_LDA(At, 0, 0); PG8_STAGE(PG8_SA(1, 1), a1 + hstep, voffA);
            PG8_WAIT_V(8); PG8_WAIT_L(0); PG8_BAR; PG8_MMA(0, 0, At, B0); PG8_MMA(0, 1, At, B1); PG8_BAR; PG8_SCHED;
            PG8_LDA(At, 0, 1); PG8_STAGE(PG8_SB(0, 0), b2, voffB); PG8_STAGE(PG8_SB(0, 1), b2 + hstep, voffB); PG8_STAGE(PG8_SA(0, 0), a2, voffA);
            PG8_WAIT_V(8); PG8_WAIT_L(0); PG8_BAR; PG8_MMA(1, 0, At, B0); PG8_MMA(1, 1, At, B1); PG8_BAR; PG8_SCHED;
            PG8_LDB(B0, 1, 0); PG8_LDB(B1, 1, 1); PG8_SCHED; PG8_LDA(At, 1, 0); PG8_STAGE(PG8_SA(0, 1), a2 + hstep, voffA);
            PG8_WAIT_V(8); PG8_WAIT_L(0); PG8_BAR; PG8_MMA(0, 0, At, B0); PG8_MMA(0, 1, At, B1); PG8_BAR; PG8_SCHED;
            PG8_LDA(At, 1, 1); PG8_STAGE(PG8_SB(1, 0), b3, voffB); PG8_STAGE(PG8_SB(1, 1), b3 + hstep, voffB); PG8_STAGE(PG8_SA(1, 0), a3, voffA);
            PG8_WAIT_V(8); PG8_WAIT_L(0); PG8_BAR; PG8_MMA(1, 0, At, B0); PG8_MMA(1, 1, At, B1); PG8_BAR; PG8_SCHED;
            } else {
            PG8_LDB(B0, 0, 0); PG8_SCHED; PG8_LDA(At, 0, 0); PG8_STAGE(PG8_SA(1, 1), a1 + hstep, voffA);
            PG8_WAIT_L(8); PG8_BAR; PG8_WAIT_L(0); PG8_MMA(0, 0, At, B0); PG8_BAR; PG8_SCHED;
            PG8_LDB(B1, 0, 1); PG8_STAGE(PG8_SB(0, 0), b2, voffB);
            PG8_BAR; PG8_WAIT_L(0); PG8_MMA(0, 1, At, B1); PG8_BAR;
            PG8_LDA(At, 0, 1); PG8_STAGE(PG8_SA(0, 0), a2, voffA);
            PG8_BAR; PG8_WAIT_L(0); PG8_MMA(1, 0, At, B0); PG8_BAR; PG8_SCHED;
            PG8_STAGE(PG8_SB(0, 1), b2 + hstep, voffB);
            PG8_WAIT_V(6); PG8_BAR; PG8_MMA(1, 1, At, B1); PG8_BAR;
            PG8_LDB(B0, 1, 0); PG8_SCHED; PG8_LDA(At, 1, 0); PG8_STAGE(PG8_SA(0, 1), a2 + hstep, voffA);
            PG8_WAIT_L(8); PG8_BAR; PG8_WAIT_L(0); PG8_MMA(0, 0, At, B0); PG8_BAR; PG8_SCHED;
            PG8_LDB(B1, 1, 1); PG8_STAGE(PG8_SB(1, 0), b3, voffB);
            PG8_BAR; PG8_WAIT_L(0); PG8_MMA(0, 1, At, B1); PG8_BAR;
            PG8_LDA(At, 1, 1); PG8_STAGE(PG8_SA(1, 0), a3, voffA);
            PG8_BAR; PG8_WAIT_L(0); PG8_MMA(1, 0, At, B0); PG8_BAR; PG8_SCHED;
            PG8_STAGE(PG8_SB(1, 1), b3 + hstep, voffB);
            PG8_WAIT_V(6); PG8_BAR; PG8_MMA(1, 1, At, B1); PG8_BAR;
            }
        }
        if constexpr (ALIGN_EPI) { if (wr == 0) PG8_BAR; }
        if constexpr (!Epi::AFTER_DRAIN) { E(acc, cur, wr, wc, fr, fq); S.done(cur); }
        if (!has_next) break;
#pragma unroll
        for (int a = 0; a < 2; ++a)
#pragma unroll
            for (int b = 0; b < 2; ++b)
#pragma unroll
                for (int m = 0; m < 4; ++m)
#pragma unroll
                    for (int n = 0; n < 2; ++n) acc[a][b][m][n] = (f32x4){0.f, 0.f, 0.f, 0.f};
        cur = nxt; cA = nA; cB = nB; ++ui;
        if constexpr (ALIGN_EPI) { if (wr == 1) PG8_BAR; }
    }
    PG8_WAIT_V(0);
    if constexpr (!ALIGN_EPI) { if (wr == 0) PG8_BAR; }
    PG8_BAR;
    if constexpr (Epi::AFTER_DRAIN) { E.fused(acc, cur, wr, wc, fr, fq, lds, wid, lane); S.done(cur); }
#undef PG8_SA
#undef PG8_SB
#undef PG8_STAGE
#undef PG8_LDA
#undef PG8_LDB
#undef PG8_MMA
#undef PG8_WAIT_V
#undef PG8_WAIT_L
#undef PG8_BAR
#undef PG8_SCHED
}
}

#ifndef PROBE_DUP
#define PROBE_DUP -1
#endif
constexpr int NWAVES = 8, NTHR = NWAVES * 64;
#ifndef MK_N_LAUNCHES
#define MK_N_LAUNCHES 1
#endif
constexpr int N_PHASES = 11;
constexpr int DEF_SLICES = 256;
constexpr int N_LAUNCHES = MK_N_LAUNCHES;
static_assert(N_LAUNCHES == 1 || N_LAUNCHES == N_PHASES, "MK_N_LAUNCHES is 1 or N_PHASES");

constexpr int BATCH = 8, SEQ = 2048, T = BATCH * SEQ, D = 2048;
constexpr int NIN = 5408, NINP = 5632;
constexpr int PC_GATE = 1024, PC_R = 2048, PC_K = 3072, PC_V = 4096, PC_WD = 5120, PC_AD = 5184, PC_GD = 5248;
constexpr int RWKV_C0 = 2048;
constexpr int NEXP = 16384, NSEL = 128;
constexpr float NORM_EPS = 1e-6f, GN_EPS = 64e-5f;

constexpr size_t MiB = 1u << 20;
constexpr size_t WS_CTL = 0, CTL_ZERO_BYTES = 1 * MiB;
constexpr size_t WS_SSQ3 = 576 * 1024;
constexpr size_t WS_SSQ2 = 512 * 1024;
constexpr size_t WS_RSTD1 = 1 * MiB;
constexpr size_t WS_USC = 1 * MiB + 64 * 1024, WS_VSC = 1 * MiB + 128 * 1024;
constexpr size_t WS_SX = 1 * MiB + 192 * 1024;
constexpr size_t WS_CS1 = 1 * MiB + 256 * 1024;
constexpr size_t WS_CSQ = 1 * MiB + 288 * 1024;
constexpr size_t WS_CSO = 1 * MiB + 296 * 1024;
constexpr size_t WS_SY = 1 * MiB + 320 * 1024;
constexpr size_t WS_SX0 = 1 * MiB + 384 * 1024;
constexpr size_t WS_WIN = 2 * MiB;
constexpr size_t WS_WOUT = 24 * MiB;
constexpr size_t WS_WQ = 32 * MiB;
constexpr size_t WS_KEYS = 40 * MiB;
constexpr size_t WS_W2T = WS_KEYS + 512 * 1024;
constexpr size_t WS_A2T = WS_W2T + 128 * 1024;
constexpr size_t WS_G2T = WS_A2T + 128 * 1024;
constexpr size_t WS_WAT = WS_G2T + 320 * 1024;
constexpr size_t WS_WIT = WS_WAT + 256 * 1024;
constexpr size_t WS_EXP = 42 * MiB;
constexpr size_t WS_GATE = 50 * MiB;
constexpr size_t WS_LA = 42 * MiB;
constexpr size_t WS_SUMM = 58 * MiB;
constexpr size_t WS_TA = 64 * MiB, WS_TB = 96 * MiB, WS_TK = 400 * MiB, WS_TR = 464 * MiB;
constexpr size_t OUT_X8 = 72 * MiB;
constexpr size_t OUT_TV = 0, OUT_TG = 32 * MiB, OUT_PC = 64 * MiB, OUT_BON = 66 * MiB;
constexpr size_t WS_XB = 64 * MiB;
constexpr size_t WS_PROJ = 128 * MiB;
constexpr size_t WS_Q = WS_PROJ;
constexpr size_t WS_YQ = WS_PROJ;
constexpr size_t WS_PART = 192 * MiB;
constexpr size_t WS_XQ = 320 * MiB;
constexpr size_t WS_COEF = 352 * MiB;
constexpr size_t WS_CSC = 356 * MiB;
constexpr size_t WS_Y = 304 * MiB;
constexpr size_t WS_UT = 368 * MiB;
constexpr size_t WS_VT = 432 * MiB;
constexpr size_t WS_END = 496 * MiB;
static_assert(WS_WIT + 256 * 1024 <= WS_EXP && WS_PROJ + (size_t)T * NINP * 2 <= WS_Y && WS_WIN + (size_t)NINP * D * 2 <= WS_WOUT, "d_ws map");
constexpr int CW_DEFQ = 2240;
constexpr int CW_PREPBAR = 2176;
constexpr int CW_PREBAR = 2112;
constexpr int CW_LRUBAR = 2048;
constexpr int CW_BAR = 4096;

constexpr int RING_BYTES = 131072;
constexpr int LDSCTL_OFF = 143360, MISC_OFF = LDSCTL_OFF + 320;
constexpr int LDS_BYTES = 147456;

#define GAS __attribute__((address_space(1)))
#define LAS __attribute__((address_space(3)))
typedef unsigned short bf16;
typedef unsigned v4u __attribute__((ext_vector_type(4)));
typedef unsigned v2u __attribute__((ext_vector_type(2)));
typedef float f32x4 __attribute__((ext_vector_type(4)));
typedef float f32x16 __attribute__((ext_vector_type(16)));
typedef short bf16x8 __attribute__((ext_vector_type(8)));
typedef __bf16 bf16x2_t __attribute__((ext_vector_type(2)));
typedef GAS unsigned gu32;
#define RLX_AGENT __ATOMIC_RELAXED, __HIP_MEMORY_SCOPE_AGENT
__device__ __forceinline__ unsigned f2bf(float f) { unsigned u = __builtin_bit_cast(unsigned, f); return (u + 0x7fffu + ((u >> 16) & 1u)) >> 16; }
__device__ __forceinline__ unsigned pk2(float lo, float hi) { return f2bf(lo) | (f2bf(hi) << 16); }
__device__ __forceinline__ float bf_lo(unsigned w) { return __uint_as_float(w << 16); }
__device__ __forceinline__ float bf_hi(unsigned w) { return __uint_as_float(w & 0xffff0000u); }
__device__ __forceinline__ void unpack8(const v4u& w, float (&o)[8]) { o[0] = bf_lo(w.x); o[1] = bf_hi(w.x); o[2] = bf_lo(w.y); o[3] = bf_hi(w.y); o[4] = bf_lo(w.z); o[5] = bf_hi(w.z); o[6] = bf_lo(w.w); o[7] = bf_hi(w.w); }
__device__ __forceinline__ v4u pack8(const float (&o)[8]) { v4u w; w.x = pk2(o[0], o[1]); w.y = pk2(o[2], o[3]); w.z = pk2(o[4], o[5]); w.w = pk2(o[6], o[7]); return w; }
__device__ __forceinline__ float sigmoidf_(float x) { return 1.0f / (1.0f + __expf(-x)); }
__device__ __forceinline__ float softplusf_(float z) { return fmaxf(z, 0.f) + log1pf(__expf(-fabsf(z))); }
__device__ __forceinline__ float gelu_tanh(float x) { const float u = 0.7978845608028654f * (x + 0.044715f * x * x * x); return 0.5f * x * (1.0f + tanhf(u)); }
template <int CTRL> __device__ __forceinline__ float dppf(float x) { return __builtin_bit_cast(float, __builtin_amdgcn_mov_dpp(__builtin_bit_cast(int, x), CTRL, 0xf, 0xf, true)); }
__device__ __forceinline__ float red8(float v) { v += dppf<0xB1>(v); v += dppf<0x4E>(v); v += dppf<0x141>(v); return v; }
__device__ __forceinline__ float red16(float v) { v = red8(v); v += dppf<0x140>(v); return v; }
__device__ __forceinline__ float wave_sum(float v) {
#pragma unroll
    for (int o = 1; o < 64; o <<= 1) v += __shfl_xor(v, o);
    return v;
}
__device__ __forceinline__ float dot2bf(unsigned a, unsigned b, float acc) { return __builtin_amdgcn_fdot2_f32_bf16(__builtin_bit_cast(bf16x2_t, a), __builtin_bit_cast(bf16x2_t, b), acc, false); }
#define MFMA16(a, b, c) __builtin_amdgcn_mfma_f32_16x16x32_bf16((a), (b), (c), 0, 0, 0)
#define MFMA32(a, b, c) __builtin_amdgcn_mfma_f32_32x32x16_bf16((a), (b), (c), 0, 0, 0)

#define XB_TMO      128
#define XB_XCNT(j)  (256  + 64 * (j))
#define XB_XSUB(j)  (1280 + 64 * (j))
#define XB_XGEN(j)  (2304 + 64 * (j))
#define XB_TOP      3328
#define XB_TOPGEN   3392
#define XCD_BAR_WORDS 3456
#define XB_SPIN_CAP (1u << 22)
__device__ __forceinline__ unsigned xb_ld(unsigned* p)              { return __hip_atomic_load(p, __ATOMIC_RELAXED, __HIP_MEMORY_SCOPE_AGENT); }
__device__ __forceinline__ unsigned xb_add(unsigned* p, unsigned v) { return __hip_atomic_fetch_add(p, v, __ATOMIC_RELAXED, __HIP_MEMORY_SCOPE_AGENT); }
__device__ __forceinline__ unsigned xb_xcc_id() { return (unsigned)__builtin_amdgcn_s_getreg((3 << 11) | 20) & 0xFu; }
#define XB_SPIN(cond, bar) do { unsigned _sp = 0; while (cond) { __builtin_amdgcn_s_sleep(1); \
    if ((++_sp & 255u) == 0u) { if (xb_ld(&(bar)[XB_TMO])) break; if (_sp > XB_SPIN_CAP) { atomicAdd(&(bar)[XB_TMO], 1u); break; } } } } while (0)
struct XcdBarrier { unsigned* bar; unsigned x; volatile LAS unsigned* st; };
__device__ __forceinline__ XcdBarrier xcd_barrier_post(unsigned* bar, volatile LAS unsigned* st) {
    XcdBarrier b; b.bar = bar; b.x = xb_xcc_id(); b.st = st;
    if (threadIdx.x == 0) (void)xb_add(&bar[XB_XCNT(b.x)], 1u);
    return b;
}
__device__ __forceinline__ void xcd_barrier_complete(unsigned* bar, unsigned x, unsigned& nloc, unsigned& nx) {
    const unsigned G = gridDim.x * gridDim.y * gridDim.z;
    unsigned sum, cnt, mine, sp = 0u;
    for (;;) {
        sum = 0u; cnt = 0u; mine = 0u;
#pragma unroll
        for (unsigned j = 0; j < 16; ++j) { const unsigned c = xb_ld(&bar[XB_XCNT(j)]); sum += c; cnt += (c > 0u) ? 1u : 0u; mine = (j == x) ? c : mine; }
        if (sum == G) break;
        __builtin_amdgcn_s_sleep(1);
        if ((++sp & 255u) == 0u) { if (xb_ld(&bar[XB_TMO])) break; if (sp > XB_SPIN_CAP) { atomicAdd(&bar[XB_TMO], 1u); break; } }
    }
    nloc = mine > 0u ? mine : 1u; nx = cnt > 0u ? cnt : 1u;
}
__device__ __forceinline__ void xcd_barrier(const XcdBarrier& b) {
    asm volatile("s_waitcnt vmcnt(0)" ::: "memory");
    __syncthreads();
    if (threadIdx.x == 0) {
        unsigned* bar = b.bar;
        __builtin_amdgcn_s_waitcnt(0);
        unsigned nloc = b.st[0], nx = b.st[1];
        if (nloc == 0u) { xcd_barrier_complete(bar, b.x, nloc, nx); b.st[0] = nloc; b.st[1] = nx; }
        const unsigned old = xb_add(&bar[XB_XSUB(b.x)], 1u);
        const unsigned gen = old / nloc;
        if (old + 1u == (gen + 1u) * nloc) {
            __builtin_amdgcn_fence(__ATOMIC_RELEASE, "agent");
            asm volatile("s_waitcnt vmcnt(0)" ::: "memory");
            const unsigned og = xb_add(&bar[XB_TOP], 1u);
            const unsigned tg = og / nx;
            if (og + 1u == (tg + 1u) * nx) xb_add(&bar[XB_TOPGEN], 1u);
            else XB_SPIN(xb_ld(&bar[XB_TOPGEN]) == tg, bar);
            __builtin_amdgcn_fence(__ATOMIC_ACQUIRE, "agent");
            xb_add(&bar[XB_XGEN(b.x)], 1u);
            asm volatile("s_waitcnt vmcnt(0)" ::: "memory");
        } else {
            XB_SPIN(xb_ld(&bar[XB_XGEN(b.x)]) == gen, bar);
            __builtin_amdgcn_fence(__ATOMIC_ACQUIRE, "agent");
            asm volatile("s_waitcnt vmcnt(0)" ::: "memory");
        }
    }
    __syncthreads();
}

struct Frame {
    LAS unsigned char* lds;
    int tid, lane, wave, G, bid;
    const float* in[28];
    float* out;
    unsigned char* ws;
};
#define WSP(type, off) ((type*)(F.ws + (off)))
enum { I_X = 0, I_G1, I_WIN, I_CONVW, I_CONVB, I_WA, I_BA, I_WI, I_BI, I_LAM, I_MU, I_W0, I_W2, I_A0, I_A2, I_G2, I_KK, I_KA, I_RK, I_LNW, I_LNB, I_WOUT, I_G2N, I_WQ, I_KEYS, I_U, I_V, I_GF };

__device__ __forceinline__ void p0_transpose_item(const float* W, int K, int N, bf16* WT, const float* ksc, LAS float* scr, int item, int lane) {
    const int nblk = N / 32, kb = item / nblk, nb = item % nblk, k0 = 64 * kb, n0 = 32 * nb;
    const int lr = lane >> 3, c4 = (lane & 7) * 4;
    f32x4 v[8];
#pragma unroll
    for (int i = 0; i < 8; ++i) v[i] = *(const f32x4*)(W + (size_t)(k0 + 8 * i + lr) * N + n0 + c4);
#pragma unroll
    for (int i = 0; i < 8; ++i) { const int kk = 8 * i + lr; const float sc = ksc ? ksc[k0 + kk] : 1.0f; LAS float* d = scr + kk * 33 + c4; d[0] = v[i][0] * sc; d[1] = v[i][1] * sc; d[2] = v[i][2] * sc; d[3] = v[i][3] * sc; }
    asm volatile("s_waitcnt lgkmcnt(0)" ::: "memory");
    const int c = lane & 7;
#pragma unroll
    for (int j = 0; j < 4; ++j) { const int n = (lane >> 3) + 8 * j; const LAS float* s = scr + (8 * c) * 33 + n;
        v4u o; o.x = pk2(s[0 * 33], s[1 * 33]); o.y = pk2(s[2 * 33], s[3 * 33]); o.z = pk2(s[4 * 33], s[5 * 33]); o.w = pk2(s[6 * 33], s[7 * 33]);
        *(v4u*)(WT + (size_t)(n0 + n) * K + k0 + 8 * c) = o; }
    asm volatile("s_waitcnt lgkmcnt(0)" ::: "memory");
}
template <bool HASK> __device__ __forceinline__ void p0_wquant_block(const float* W, int N, unsigned char* WT8, float* cs, const float* ksc, int item, int wave, int lane, LAS float* mxs) {
    asm volatile("" : "+v"(lane));
    const int n0 = item * 32, r = lane >> 3, c4 = lane & 7, kb = 256 * wave + 4 * r;
    const float* src = W + (size_t)kb * N + n0 + 4 * c4; const float* kp = ksc + kb;
    f32x4 mx = (f32x4){0.f, 0.f, 0.f, 0.f};
#pragma unroll
    for (int i2 = 0; i2 < 2; ++i2) { f32x4 v[4][4], g4[4];
#pragma unroll
        for (int ii = 0; ii < 4; ++ii) { g4[ii] = HASK ? *(const f32x4*)(kp + 32 * (i2 * 4 + ii)) : (f32x4){1.f, 1.f, 1.f, 1.f};
#pragma unroll
            for (int j = 0; j < 4; ++j) v[ii][j] = *(const f32x4*)(src + (size_t)(32 * (i2 * 4 + ii) + j) * N); }
#pragma unroll
        for (int ii = 0; ii < 4; ++ii)
#pragma unroll
            for (int j = 0; j < 4; ++j)
#pragma unroll
                for (int e = 0; e < 4; ++e) mx[e] = fmaxf(mx[e], fabsf(v[ii][j][e] * g4[ii][j])); }
#pragma unroll
    for (int o = 8; o < 64; o <<= 1)
#pragma unroll
        for (int e = 0; e < 4; ++e) mx[e] = fmaxf(mx[e], __shfl_xor(mx[e], o));
    if (r == 0) *(LAS f32x4*)(mxs + wave * 32 + 4 * c4) = mx;
    __syncthreads();
#pragma unroll
    for (int w = 0; w < NWAVES; ++w) { const f32x4 t = *(const LAS f32x4*)(mxs + w * 32 + 4 * c4);
#pragma unroll
        for (int e = 0; e < 4; ++e) mx[e] = fmaxf(mx[e], t[e]); }
    f32x4 q;
#pragma unroll
    for (int e = 0; e < 4; ++e) q[e] = mx[e] > 0.f ? 127.0f / mx[e] : 0.f;
    if (wave == 0 && r == 0) *(f32x4*)(cs + n0 + 4 * c4) = mx * (1.0f / 127.0f);
    unsigned char* dst = WT8 + (size_t)(n0 + 4 * c4) * 2048 + kb;
#pragma unroll
    for (int i2 = 0; i2 < 2; ++i2) { f32x4 v[4][4], g4[4];
#pragma unroll
        for (int ii = 0; ii < 4; ++ii) { g4[ii] = HASK ? *(const f32x4*)(kp + 32 * (i2 * 4 + ii)) : (f32x4){1.f, 1.f, 1.f, 1.f};
#pragma unroll
            for (int j = 0; j < 4; ++j) v[ii][j] = *(const f32x4*)(src + (size_t)(32 * (i2 * 4 + ii) + j) * N); }
#pragma unroll
        for (int ii = 0; ii < 4; ++ii) { unsigned w[4] = {0u, 0u, 0u, 0u};
#pragma unroll
            for (int j = 0; j < 4; ++j)
#pragma unroll
                for (int e = 0; e < 4; ++e) { const int qi = (int)rintf(v[ii][j][e] * g4[ii][j] * q[e]); w[e] |= ((unsigned)qi & 0xFFu) << (8 * j); }
#pragma unroll
            for (int e = 0; e < 4; ++e) *(unsigned*)(dst + (size_t)e * 2048 + 32 * (i2 * 4 + ii)) = w[e]; } }
    __syncthreads();
}
__device__ __forceinline__ void p0_small_transpose(const float* src, bf16* dst, int nb, int K, int N, int gt, int NGT) {
    const int tot = nb * K * N;
    for (int i = gt; i < tot; i += NGT) { const int bb = i / (K * N), r = i - bb * K * N, n = r / K, k = r - n * K; dst[i] = (bf16)f2bf(src[(size_t)bb * K * N + (size_t)k * N + n]); }
}
template <int PART> __device__ __forceinline__ void p0_prologue(const Frame& F, int vb, int VG) {
    LAS float* scr = (LAS float*)(F.lds + F.wave * 8448);
    const int gw = vb * NWAVES + F.wave, NGW = VG * NWAVES, gt = gw * 64 + F.lane, NGT = NGW * 64;
    constexpr int I1 = (D / 64) * (NIN / 32), I2 = (D / 64) * (D / 32);
    if (PART == 0) { for (int it = vb; it < NIN / 32; it += VG) p0_wquant_block<true>(F.in[I_WIN], NIN, WSP(unsigned char, WS_WIN), WSP(float, WS_CS1), F.in[I_G1], it, F.wave, F.lane, (LAS float*)(F.lds + 8 * 8448)); }
    else { const int sp = VG >= 64 ? VG / 64 : 1;
           for (int v = vb; v < sp * (D / 32); v += VG) {
               if (v % sp == 0) p0_wquant_block<false>(F.in[I_WQ], D, WSP(unsigned char, WS_WQ), WSP(float, WS_CSQ), nullptr, v / sp, F.wave, F.lane, (LAS float*)(F.lds + 8 * 8448));
               if (v % sp == sp / 2) p0_wquant_block<false>(F.in[I_WOUT], D, WSP(unsigned char, WS_WOUT), WSP(float, WS_CSO), nullptr, v / sp, F.wave, F.lane, (LAS float*)(F.lds + 8 * 8448)); } }
    if (PART == 0) {
    { v4u* z = (v4u*)(WSP(unsigned char, WS_WIN) + (size_t)NIN * D); const int nz = (NINP - NIN) * D / 16; for (int i = gt; i < nz; i += NGT) z[i] = (v4u){0u, 0u, 0u, 0u};
      for (int i = gt; i < NINP - NIN; i += NGT) WSP(float, WS_CS1)[NIN + i] = 0.f; }
    p0_small_transpose(F.in[I_W2], WSP(bf16, WS_W2T), 1, 64, 1024, gt, NGT);
    p0_small_transpose(F.in[I_A2], WSP(bf16, WS_A2T), 1, 64, 1024, gt, NGT);
    p0_small_transpose(F.in[I_G2], WSP(bf16, WS_G2T), 1, 160, 1024, gt, NGT);
    p0_small_transpose(F.in[I_WA], WSP(bf16, WS_WAT), 8, 128, 128, gt, NGT);
    p0_small_transpose(F.in[I_WI], WSP(bf16, WS_WIT), 8, 128, 128, gt, NGT);
    { const float* s = F.in[I_KEYS]; bf16* d = WSP(bf16, WS_KEYS); for (int i = gt; i < 8 * 2 * 128 * 128 / 8; i += NGT) { const f32x4 a = *(const f32x4*)(s + (size_t)i * 8), b = *(const f32x4*)(s + (size_t)i * 8 + 4);
        v4u o; o.x = pk2(a[0], a[1]); o.y = pk2(a[2], a[3]); o.z = pk2(b[0], b[1]); o.w = pk2(b[2], b[3]); *(v4u*)(d + (size_t)i * 8) = o; } }
    }
    if (PART == 0) {
    { const float* x = F.in[I_X]; unsigned char* xq = (unsigned char*)F.out + OUT_X8; float* rs1 = WSP(float, WS_RSTD1); float* sx0 = WSP(float, WS_SX0);
#define XR_LOAD(V_, row_) do { _Pragma("unroll") for (int hh_ = 0; hh_ < 2; ++hh_) _Pragma("unroll") for (int q_ = 0; q_ < 4; ++q_) V_[hh_][q_] = *(const f32x4*)(x + (size_t)(row_) * D + hh_ * 1024 + F.lane * 16 + q_ * 4); } while (0)
#define XR_QUANT(V_, row_) do { float s_ = 0.f, am_ = 0.f; \
          _Pragma("unroll") for (int hh_ = 0; hh_ < 2; ++hh_) _Pragma("unroll") for (int q_ = 0; q_ < 4; ++q_) _Pragma("unroll") for (int e_ = 0; e_ < 4; ++e_) { const float t_ = V_[hh_][q_][e_]; s_ += t_ * t_; am_ = fmaxf(am_, fabsf(t_)); } \
          s_ = wave_sum(s_); \
          _Pragma("unroll") for (int o_ = 1; o_ < 64; o_ <<= 1) am_ = fmaxf(am_, __shfl_xor(am_, o_)); \
          const float xq_ = am_ > 0.f ? 127.0f / am_ : 0.f; \
          if (F.lane == 0) { rs1[row_] = am_ * (1.0f / 127.0f) / sqrtf(s_ * (1.0f / D) + NORM_EPS); sx0[row_] = am_ * (1.0f / 127.0f); } \
          _Pragma("unroll") for (int hh_ = 0; hh_ < 2; ++hh_) { v4u o_; \
              _Pragma("unroll") for (int q_ = 0; q_ < 4; ++q_) { unsigned w_ = 0u; \
                  _Pragma("unroll") for (int e_ = 0; e_ < 4; ++e_) { const int qi_ = (int)rintf(V_[hh_][q_][e_] * xq_); w_ |= ((unsigned)qi_ & 0xFFu) << (8 * e_); } \
                  o_[q_] = w_; } \
              *(v4u*)(xq + (size_t)(row_) * D + hh_ * 1024 + F.lane * 16) = o_; } } while (0)
      for (int m = gw; m < T; m += 2 * NGW) { const int mB = m + NGW < T ? m + NGW : m;
          f32x4 xa[2][4], xb2[2][4];
          XR_LOAD(xa, m); XR_LOAD(xb2, mB);
          XR_QUANT(xa, m);
          if (mB != m) XR_QUANT(xb2, mB); }
#undef XR_LOAD
#undef XR_QUANT
    }
    }
}

typedef float f32x2c __attribute__((ext_vector_type(2)));
__device__ __forceinline__ unsigned cvtpk(float lo, float hi) { const f32x2c v = {lo, hi}; const bf16x2_t b = __builtin_convertvector(v, bf16x2_t); return __builtin_bit_cast(unsigned, b); }
__device__ __forceinline__ float rcpf_(float x) { return __builtin_amdgcn_rcpf(x); }
__device__ __forceinline__ float sigmoid_fast(float x) { return rcpf_(1.0f + __expf(-x)); }
__device__ __forceinline__ float tanh_fast(float x) { return 1.0f - 2.0f * rcpf_(1.0f + __expf(2.0f * x)); }
__device__ __forceinline__ float softplus_fast(float z) { return fmaxf(z, 0.f) + __logf(1.0f + __expf(-fabsf(z))); }
__device__ __forceinline__ float gelu_fast(float x) { const float u = 0.7978845608028654f * (x + 0.044715f * x * x * x); return x * rcpf_(1.0f + __expf(-2.0f * u)); }
__device__ __forceinline__ void rwkv_prep_unit(const Frame& F, int chunk, int h, int lane, const LAS bf16* WL2, const LAS bf16* AL2, const LAS bf16* GL2, const LAS float* CW, LAS bf16* ST) {
    asm volatile("" : "+v"(lane));
    const int fr = lane & 15, fq = lane >> 4;
    const bf16* PROJ = WSP(bf16, WS_PROJ); const bf16* LA = WSP(bf16, WS_LA);
    bf16* TA = WSP(bf16, WS_TA); bf16* TB = WSP(bf16, WS_TB); bf16* TK = WSP(bf16, WS_TK); bf16* TR = WSP(bf16, WS_TR);
    bf16* TV = (bf16*)F.out + OUT_TV / 2; bf16* TG = (bf16*)F.out + OUT_TG / 2; float* PCG = F.out + OUT_PC / 4; float* BONG = F.out + OUT_BON / 4;
#define PU4(w_) ((f32x4){bf_lo((w_).x), bf_hi((w_).x), bf_lo((w_).y), bf_hi((w_).y)})
    size_t tokm[2];
#pragma unroll
    for (int mt = 0; mt < 2; ++mt) tokm[mt] = (size_t)chunk * 32 + mt * 16 + fr;
    v2u cA[4][3], cB[4][3], eA[4][3];
    const bool hs = (chunk & 63) != 0; const unsigned hsm = hs ? 0xffffffffu : 0u; const size_t toke = (size_t)chunk * 32 - (hs ? 1 : 0);
#define PREP_LOAD_MT(C_, tok_) do { _Pragma("unroll") for (int nt_ = 0; nt_ < 4; ++nt_) { const bf16* pr_ = PROJ + (tok_) * NINP + PC_R + h * 64 + nt_ * 16 + fq * 4; \
        _Pragma("unroll") for (int q_ = 0; q_ < 3; ++q_) C_[nt_][q_] = *(const v2u*)(pr_ + q_ * 1024); } } while (0)
#define DPPU(old_, src_, ctl_) ((unsigned)__builtin_amdgcn_update_dpp((int)(old_), (int)(src_), ctl_, 0xf, 0xf, false))
#define PREP_PREV(dst_, mt_, nt_, q_) do { const v2u c_ = (mt_) ? cB[nt_][q_] : cA[nt_][q_]; v2u o_; \
        if (mt_) { o_.x = DPPU(0, cA[nt_][q_].x, 0x121); o_.y = DPPU(0, cA[nt_][q_].y, 0x121); } else { o_.x = eA[nt_][q_].x & hsm; o_.y = eA[nt_][q_].y & hsm; } \
        dst_.x = DPPU(o_.x, c_.x, 0x111); dst_.y = DPPU(o_.y, c_.y, 0x111); } while (0)
    PREP_LOAD_MT(cA, tokm[0]); PREP_LOAD_MT(eA, toke);
    bf16x8 la[9];
#pragma unroll
    for (int ks = 0; ks < 9; ++ks) la[ks] = *(const bf16x8*)(LA + tokm[0] * 288 + ks * 32 + 8 * fq);
    PREP_LOAD_MT(cB, tokm[1]);
    float inv[2], bn[2];
#pragma unroll
    for (int mt = 0; mt < 2; ++mt) { float s2 = 0.f;
#pragma unroll
        for (int nt = 0; nt < 4; ++nt) { const int j4 = nt * 16 + fq * 4;
            const v2u kc = mt ? cB[nt][1] : cA[nt][1]; v2u kp; PREP_PREV(kp, mt, nt, 1);
            const f32x4 c_kk = *(const LAS f32x4*)(CW + 128 + j4), m_k = *(const LAS f32x4*)(CW + 384 + j4);
            const f32x4 kcf = PU4(kc); const f32x4 ku = (kcf + (PU4(kp) - kcf) * m_k) * c_kk; s2 += (ku[0] * ku[0] + ku[1] * ku[1]) + (ku[2] * ku[2] + ku[3] * ku[3]); }
        { auto x = __builtin_amdgcn_permlane16_swap(__float_as_uint(s2), __float_as_uint(s2), false, false); s2 = __uint_as_float(x[0]) + __uint_as_float(x[1]); }
        { auto x = __builtin_amdgcn_permlane32_swap(__float_as_uint(s2), __float_as_uint(s2), false, false); s2 = __uint_as_float(x[0]) + __uint_as_float(x[1]); }
        inv[mt] = __builtin_amdgcn_rsqf(fmaxf(s2, 1e-24f)); bn[mt] = 0.f; }
    f32x4 tot0[4];
#pragma unroll
    for (int n = 0; n < 4; ++n) tot0[n] = (f32x4){0.f, 0.f, 0.f, 0.f};
#pragma unroll
    for (int st = 0; st < 8; ++st) { const int mt = st >> 2, nt = st & 3; const int j4 = nt * 16 + fq * 4; const size_t col = (size_t)h * 64 + j4;
        v2u cur_[3], prv_[3];
#pragma unroll
        for (int q = 0; q < 3; ++q) { cur_[q] = mt ? cB[nt][q] : cA[nt][q]; PREP_PREV(prv_[q], mt, nt, q); }
        f32x4 cw = (f32x4){0.f, 0.f, 0.f, 0.f}, ca = cw, cg = cw;
#pragma unroll
        for (int ks = 0; ks < 2; ++ks) { cw = MFMA16(*(const LAS bf16x8*)(WL2 + (nt * 16 + fr) * 72 + ks * 32 + 8 * fq), la[ks], cw); ca = MFMA16(*(const LAS bf16x8*)(AL2 + (nt * 16 + fr) * 72 + ks * 32 + 8 * fq), la[2 + ks], ca); }
#pragma unroll
        for (int ks = 0; ks < 5; ++ks) cg = MFMA16(*(const LAS bf16x8*)(GL2 + (nt * 16 + fr) * 168 + ks * 32 + 8 * fq), la[4 + ks], cg);
        if (st == 3) {
#pragma unroll
            for (int ks = 0; ks < 9; ++ks) la[ks] = *(const bf16x8*)(LA + tokm[1] * 288 + ks * 32 + 8 * fq); }
        const f32x4 c_w0 = *(const LAS f32x4*)(CW + j4), c_a0 = *(const LAS f32x4*)(CW + 64 + j4), c_kk = *(const LAS f32x4*)(CW + 128 + j4), c_ka = *(const LAS f32x4*)(CW + 192 + j4), c_rk = *(const LAS f32x4*)(CW + 256 + j4);
        const f32x4 m_r = *(const LAS f32x4*)(CW + 320 + j4), m_k = *(const LAS f32x4*)(CW + 384 + j4), m_v = *(const LAS f32x4*)(CW + 448 + j4);
        const v2u rp = prv_[0], kp = prv_[1], vp = prv_[2];
        const f32x4 rcf = PU4(cur_[0]), kcf = PU4(cur_[1]), vcf = PU4(cur_[2]);
        const f32x4 rr = rcf + (PU4(rp) - rcf) * m_r, kv = kcf + (PU4(kp) - kcf) * m_k, vv = vcf + (PU4(vp) - vcf) * m_v;
        f32x4 nau, bbu, km, cum;
#pragma unroll
        for (int r = 0; r < 4; ++r) { const float av = sigmoid_fast(c_a0[r] + ca[r]), ku = kv[r] * c_kk[r]; km[r] = kv[r] * (1.0f + (av - 1.0f) * c_ka[r]);
            cum[r] = -0.6065306597126334f * sigmoid_fast(c_w0[r] + cw[r]);
            nau[r] = -ku; bbu[r] = ku * av; bn[mt] += rr[r] * km[r] * c_rk[r]; }
        f32x4 at4, rt4, bt4, kt4, ep4;
#pragma unroll
        for (int r = 0; r < 4; ++r) { float v = cum[r];
            v += __builtin_bit_cast(float, __builtin_amdgcn_update_dpp(0, __builtin_bit_cast(int, v), 0x111, 0xf, 0xf, true));
            v += __builtin_bit_cast(float, __builtin_amdgcn_update_dpp(0, __builtin_bit_cast(int, v), 0x112, 0xf, 0xf, true));
            v += __builtin_bit_cast(float, __builtin_amdgcn_update_dpp(0, __builtin_bit_cast(int, v), 0x114, 0xf, 0xf, true));
            v += __builtin_bit_cast(float, __builtin_amdgcn_update_dpp(0, __builtin_bit_cast(int, v), 0x118, 0xf, 0xf, true));
            if (mt == 0) tot0[nt][r] = __shfl(v, (lane & 48) | 15); else v += tot0[nt][r];
            const float ep = __expf(v), em = rcpf_(ep);
            float eprev = __builtin_bit_cast(float, __builtin_amdgcn_update_dpp(0, __builtin_bit_cast(int, ep), 0x111, 0xf, 0xf, true));
            if (fr == 0) eprev = mt ? __expf(tot0[nt][r]) : 1.0f;
            at4[r] = nau[r] * inv[mt] * eprev; rt4[r] = rr[r] * ep; bt4[r] = bbu[r] * inv[mt] * em; kt4[r] = km[r] * em; ep4[r] = ep; }
        { LAS bf16* sp = ST + fr * 64 + j4; v2u w;
          w.x = cvtpk(at4[0], at4[1]); w.y = cvtpk(at4[2], at4[3]); *(LAS v2u*)(sp) = w;
          w.x = cvtpk(rt4[0], rt4[1]); w.y = cvtpk(rt4[2], rt4[3]); *(LAS v2u*)(sp + 1024) = w;
          w.x = cvtpk(bt4[0], bt4[1]); w.y = cvtpk(bt4[2], bt4[3]); *(LAS v2u*)(sp + 2048) = w;
          w.x = cvtpk(kt4[0], kt4[1]); w.y = cvtpk(kt4[2], kt4[3]); *(LAS v2u*)(sp + 3072) = w;
          w.x = cvtpk(vv[0], vv[1]); w.y = cvtpk(vv[2], vv[3]); *(LAS v2u*)(sp + 4096) = w;
          w.x = cvtpk(cg[0], cg[1]); w.y = cvtpk(cg[2], cg[3]); *(LAS v2u*)(sp + 5120) = w; }
        if (nt == 3) {
            bf16* const dstp[6] = {TA, TR, TB, TK, TV, TG};
#pragma unroll
            for (int a6 = 0; a6 < 6; ++a6)
#pragma unroll
                for (int hrow = 0; hrow < 2; ++hrow) { const int row = hrow * 8 + (lane >> 3), c8 = (lane & 7) * 8;
                    const v4u pv = *(const LAS v4u*)(ST + a6 * 1024 + row * 64 + c8);
                    *(v4u*)(dstp[a6] + ((size_t)chunk * 32 + mt * 16 + row) * 1024 + (size_t)h * 64 + c8) = pv; } }
        if (mt == 1 && fr == 15) *(f32x4*)(PCG + (size_t)chunk * 1024 + col) = ep4;
    }
#undef PREP_LOAD_MT
#undef PREP_PREV
#undef DPPU
#undef PU4
#pragma unroll
    for (int mt = 0; mt < 2; ++mt) { float b2 = bn[mt];
        { auto x = __builtin_amdgcn_permlane16_swap(__float_as_uint(b2), __float_as_uint(b2), false, false); b2 = __uint_as_float(x[0]) + __uint_as_float(x[1]); }
        { auto x = __builtin_amdgcn_permlane32_swap(__float_as_uint(b2), __float_as_uint(b2), false, false); b2 = __uint_as_float(x[0]) + __uint_as_float(x[1]); }
        if (fq == 0) BONG[tokm[mt] * 16 + h] = b2; }
}
__device__ __forceinline__ void rwkv_prep_phase(const Frame& F) {
    LAS bf16* WL2 = (LAS bf16*)(F.lds + 0); LAS bf16* AL2 = (LAS bf16*)(F.lds + 9216); LAS bf16* GL2 = (LAS bf16*)(F.lds + 18432); LAS float* CW = (LAS float*)(F.lds + 39936);
    int hcur = -1;
    for (int u = F.bid; u < 1024; u += F.G) { const int h = u & 15, cg = u >> 4;
        if (h != hcur) { hcur = h; __syncthreads();
            int tid_ = F.tid; asm volatile("" : "+v"(tid_));
            const bf16* w2t = WSP(bf16, WS_W2T) + (size_t)h * 64 * 64; const bf16* a2t = WSP(bf16, WS_A2T) + (size_t)h * 64 * 64; const bf16* g2t = WSP(bf16, WS_G2T) + (size_t)h * 64 * 160;
            { const int r = tid_ >> 3, c = (tid_ & 7) * 8; *(LAS v4u*)(WL2 + r * 72 + c) = *(const v4u*)(w2t + r * 64 + c); *(LAS v4u*)(AL2 + r * 72 + c) = *(const v4u*)(a2t + r * 64 + c); }
            for (int i = tid_; i < 64 * 20; i += NTHR) { const int r = i / 20, c = (i - r * 20) * 8; *(LAS v4u*)(GL2 + r * 168 + c) = *(const v4u*)(g2t + r * 160 + c); }
            { const int q = tid_ >> 6, jj = tid_ & 63; const float* src = q == 0 ? F.in[I_W0] : (q == 1 ? F.in[I_A0] : (q == 2 ? F.in[I_KK] : (q == 3 ? F.in[I_KA] : (q == 4 ? F.in[I_RK] : F.in[I_MU] + (q - 5) * 1024)))); CW[q * 64 + jj] = src[h * 64 + jj]; }
            __syncthreads(); }
        rwkv_prep_unit(F, cg * 8 + F.wave, h, F.lane, WL2, AL2, GL2, CW, (LAS bf16*)(F.lds + 43008 + F.wave * 12288)); }
    __syncthreads();
}
typedef short v4i16_t __attribute__((ext_vector_type(4)));
__device__ __forceinline__ bf16x8 frag_tr16(const LAS bf16* p, int ld) {
    const v4i16_t a = __builtin_amdgcn_ds_read_tr16_b64_v4i16((LAS v4i16_t*)p), b = __builtin_amdgcn_ds_read_tr16_b64_v4i16((LAS v4i16_t*)(p + 4 * ld));
    return (bf16x8){a[0], a[1], a[2], a[3], b[0], b[1], b[2], b[3]};
}
#define RD_LOAD(src_, act_, row0_, j_) do { const float* tp_ = (src_) + ((act_) ? ((size_t)((row0_) + ((j_) >> 1)) * D + ((j_) & 1) * 1024) : (size_t)0) + lane * 16; \
        _Pragma("unroll") for (int q_ = 0; q_ < 4; ++q_) th[q_] = *(const f32x4*)(tp_ + q_ * 4); } while (0)
#define RD_PACK(dst_, v_, tq_) do { _Pragma("unroll") for (int q_ = 0; q_ < 4; ++q_) {   \
            const unsigned b0_ = __float_as_uint(__builtin_fmaf(v_[q_][0], tq_, 12582912.0f)), b1_ = __float_as_uint(__builtin_fmaf(v_[q_][1], tq_, 12582912.0f)); \
            const unsigned b2_ = __float_as_uint(__builtin_fmaf(v_[q_][2], tq_, 12582912.0f)), b3_ = __float_as_uint(__builtin_fmaf(v_[q_][3], tq_, 12582912.0f)); \
            dst_[q_] = __builtin_amdgcn_perm(b1_, b0_, 0x0c0c0400u) | __builtin_amdgcn_perm(b3_, b2_, 0x04000c0cu); } } while (0)
#define RD_CONSUME(dstb_, scb_, row0_, j_) do { float am_ = 0.f; \
        _Pragma("unroll") for (int q_ = 0; q_ < 4; ++q_) _Pragma("unroll") for (int e_ = 0; e_ < 4; ++e_) am_ = fmaxf(am_, fabsf(th[q_][e_])); \
        if (((j_) & 1) == 0) { _Pragma("unroll") for (int q_ = 0; q_ < 4; ++q_) tk[q_] = th[q_]; tkm = am_; } \
        else { am_ = fmaxf(am_, tkm); \
            am_ = fmaxf(am_, dppf<0xB1>(am_)); am_ = fmaxf(am_, dppf<0x4E>(am_)); am_ = fmaxf(am_, dppf<0x141>(am_)); am_ = fmaxf(am_, dppf<0x140>(am_)); \
            { auto s_ = __builtin_amdgcn_permlane16_swap(__float_as_uint(am_), __float_as_uint(am_), false, false); am_ = fmaxf(__uint_as_float(s_[0]), __uint_as_float(s_[1])); } \
            { auto s_ = __builtin_amdgcn_permlane32_swap(__float_as_uint(am_), __float_as_uint(am_), false, false); am_ = fmaxf(__uint_as_float(s_[0]), __uint_as_float(s_[1])); } \
            const float tq_ = am_ > 0.f ? 127.0f / am_ : 0.f; const size_t ro_ = (size_t)((row0_) + ((j_) >> 1)); \
            if (lane == 0) (scb_)[ro_] = am_ * (1.0f / 127.0f); \
            v4u o0_, o1_; RD_PACK(o0_, tk, tq_); RD_PACK(o1_, th, tq_); \
            *(v4u*)((dstb_) + ro_ * D + lane * 16) = o0_; *(v4u*)((dstb_) + ro_ * D + 1024 + lane * 16) = o1_; } } while (0)
__device__ __forceinline__ void rwkv_item(const Frame& F, int item) {
    const int b = item >> 4, h = item & 15, wave = F.wave; int tid = F.tid; asm volatile("" : "+v"(tid)); const int lane = tid & 63;
    LAS unsigned char* L = F.lds;
    constexpr int LD64 = 72, LD32 = 40, E0 = 73216;
    LAS bf16* AT = (LAS bf16*)(L + 0);  LAS bf16* BT_ = (LAS bf16*)(L + 4608); LAS bf16* KT_ = (LAS bf16*)(L + 9216); LAS bf16* RT = (LAS bf16*)(L + 13824);
    LAS bf16* VS2 = (LAS bf16*)(L + 18432);
    LAS bf16* GGB2 = (LAS bf16*)(L + 27648);
    LAS bf16* S0B = (LAS bf16*)(L + 36864);
    LAS float* YB2 = (LAS float*)(L + 55296);
    LAS float* BON2 = (LAS float*)(L + 72704);
    LAS float* PC = (LAS float*)(L + 72960);
    LAS bf16* AAK = (LAS bf16*)(L + E0); LAS bf16* ARB = (LAS bf16*)(L + E0 + 2560); LAS bf16* ARK = (LAS bf16*)(L + E0 + 5120);
    LAS bf16* MINV = (LAS bf16*)(L + E0 + 7680);
    LAS bf16* RHS = (LAS bf16*)(L + E0 + 23040);
    LAS bf16* SAB = (LAS bf16*)(L + E0 + 28160);
    static_assert(E0 + 33280 <= LDSCTL_OFF, "rwkv LDS map");
    bf16* Y = WSP(bf16, WS_Y);
#define FRAG(base, row0, ld, ks) (*(const LAS bf16x8*)((base) + ((row0) + fr) * (ld) + (ks) * 32 + 8 * fq))
#define FRAGT(base, col0, ld) frag_tr16((base) + (8 * fq + (fr >> 2)) * (ld) + (col0) + 4 * (fr & 3), (ld))
    const int tt = tid >> 4, j0 = (tid & 15) * 4, hc = h * 64 + j0;
    const f32x4 plw = *(const f32x4*)(F.in[I_LNW] + hc), plb = *(const f32x4*)(F.in[I_LNB] + hc);
    const int lr = (tid & 255) >> 3, lc8 = tid & 7; const bool hi2 = tid >= 256;
    const bf16* srcA[3] = { (hi2 ? WSP(bf16, WS_TR) : WSP(bf16, WS_TA)), (hi2 ? WSP(bf16, WS_TK) : WSP(bf16, WS_TB)), (hi2 ? (const bf16*)F.out + OUT_TG / 2 : (const bf16*)F.out + OUT_TV / 2) };
    const size_t poff = ((size_t)b * SEQ + lr) * 1024 + h * 64 + lc8 * 8;
    const float* PCG = F.out + OUT_PC / 4 + (size_t)(b * 64) * 1024 + h * 64; const float* BONG = F.out + OUT_BON / 4 + (size_t)b * SEQ * 16 + h;
    v4u pl_[3]; float ppc = 0.f, pbn = 0.f;
#define RWKV_PREFETCH(tl_) do { _Pragma("unroll") for (int q_ = 0; q_ < 3; ++q_) pl_[q_] = *(const v4u*)(srcA[q_] + poff + (size_t)(tl_) * 32 * 1024); \
        ppc = PCG[(size_t)(tl_) * 1024 + (tid & 63)]; pbn = BONG[((size_t)(tl_) * 32 + (tid & 31)) * 16]; } while (0)
    const int ib = wave >> 1, tb = wave & 1, i0 = ib * 16, t0m = tb * 16;
    f32x4 sacc[2], yacc;
    sacc[0] = (f32x4){0.f, 0.f, 0.f, 0.f}; sacc[1] = sacc[0]; yacc = sacc[0];
    for (int u = tid; u < 2 * 64 * LD64 / 2; u += NTHR) ((LAS unsigned*)S0B)[u] = 0u;
    const int trow0 = (item * 4 + (wave & 3)) * 32; const bool tconv = wave >= 4;
    f32x4 th[4], tk[4]; float tkm = 0.f;
#pragma unroll
    for (int q = 0; q < 4; ++q) tk[q] = (f32x4){0.f, 0.f, 0.f, 0.f};
    RWKV_PREFETCH(0);
    RD_LOAD(F.in[I_U], tconv, trow0, 0);
    __syncthreads();
    for (int tl = 0; tl <= SEQ / 32; ++tl) {
        const int cur = tl & 1;
        int lane_c = lane; asm volatile("" : "+v"(lane_c)); const int fr = lane_c & 15, fq = lane_c >> 4;
        LAS bf16* VS = VS2 + cur * 32 * LD64; LAS bf16* GGB = GGB2 + cur * 32 * LD64; LAS float* YB = YB2 + cur * 32 * 68; LAS float* BON = BON2 + cur * 32;
        const LAS bf16* VSp = VS2 + (cur ^ 1) * 32 * LD64; const LAS bf16* GGBp = GGB2 + (cur ^ 1) * 32 * LD64; const LAS float* YBp = YB2 + (cur ^ 1) * 32 * 68; const LAS float* BONp = BON2 + (cur ^ 1) * 32;
        if (tl > 0) { const size_t tokb = (size_t)b * SEQ + (tl - 1) * 32;
          const f32x4 y4 = *(const LAS f32x4*)(YBp + tt * 68 + j0); const v2u gw_ = *(const LAS v2u*)(GGBp + tt * LD64 + j0);
          const f32x4 g4 = (f32x4){bf_lo(gw_.x), bf_hi(gw_.x), bf_lo(gw_.y), bf_hi(gw_.y)};
          const v2u vw_ = *(const LAS v2u*)(VSp + tt * LD64 + j0); const f32x4 v4 = (f32x4){bf_lo(vw_.x), bf_hi(vw_.x), bf_lo(vw_.y), bf_hi(vw_.y)};
          float sm = (y4[0] + y4[1]) + (y4[2] + y4[3]); sm = red16(sm); const float mean = sm * (1.0f / 64.0f);
          const f32x4 d4 = y4 - mean; float sv = (d4[0] * d4[0] + d4[1] * d4[1]) + (d4[2] * d4[2] + d4[3] * d4[3]); sv = red16(sv);
          const float rstd = __builtin_amdgcn_rsqf(sv * (1.0f / 64.0f) + GN_EPS), bon = BONp[tt];
          f32x4 o;
#pragma unroll
          for (int e = 0; e < 4; ++e) o[e] = (d4[e] * rstd * plw[e] + plb[e] + bon * v4[e]) * g4[e];
          v2u w; w.x = cvtpk(o[0], o[1]); w.y = cvtpk(o[2], o[3]);
          *(v2u*)(Y + (tokb + tt) * D + 1024 + hc) = w; }
        if (tl == SEQ / 32) break;
        const LAS bf16* S0c = S0B + cur * 64 * LD64; LAS bf16* S0n = S0B + (cur ^ 1) * 64 * LD64;
        { const v4u p0 = pl_[0], p1 = pl_[1], p2 = pl_[2];
          *(LAS v4u*)((hi2 ? RT : AT) + lr * LD64 + lc8 * 8) = p0;
          *(LAS v4u*)((hi2 ? KT_ : BT_) + lr * LD64 + lc8 * 8) = p1;
          *(LAS v4u*)((hi2 ? GGB : VS) + lr * LD64 + lc8 * 8) = p2;
          if (tid < 64) PC[tid] = ppc;
          if (tid >= 64 && tid < 96) BON[tid - 64] = pbn; }
        { const int tn_ = tl + 1 < SEQ / 32 ? tl + 1 : SEQ / 32 - 1; RWKV_PREFETCH(tn_); }
        __syncthreads();
        f32x4 rhs4 = (f32x4){0.f, 0.f, 0.f, 0.f};
#define RWKV_FIRST do { rhs4 = (f32x4){0.f, 0.f, 0.f, 0.f}; yacc = (f32x4){0.f, 0.f, 0.f, 0.f}; \
            _Pragma("unroll") for (int ks = 0; ks < 2; ++ks) rhs4 = MFMA16(FRAG(AT, t0m, LD64, ks), FRAG(S0c, i0, LD64, ks), rhs4); \
            _Pragma("unroll") for (int ks = 0; ks < 2; ++ks) yacc = MFMA16(FRAG(S0c, i0, LD64, ks), FRAG(RT, t0m, LD64, ks), yacc); \
            _Pragma("unroll") for (int u = 0; u < 2; ++u) { const int tile = wave * 2 + u, si0 = (tile >> 2) * 16, sj0 = (tile & 3) * 16; sacc[u] = MFMA16(FRAGT(KT_, sj0, LD64), FRAGT(VS, si0, LD64), sacc[u]); } } while (0)
#define PK8(a_, s_) __builtin_bit_cast(bf16x8, (v4u){cvtpk(a_[8 * (s_) + 0], a_[8 * (s_) + 1]), cvtpk(a_[8 * (s_) + 2], a_[8 * (s_) + 3]), cvtpk(a_[8 * (s_) + 4], a_[8 * (s_) + 5]), cvtpk(a_[8 * (s_) + 6], a_[8 * (s_) + 7])})
        if (wave == 0) {
            const int c32 = lane_c & 31, h32 = lane_c >> 5;
            f32x16 U, V, PT;
#pragma unroll
            for (int e = 0; e < 16; ++e) { U[e] = 0.f; V[e] = 0.f; }
#pragma unroll
            for (int ks = 0; ks < 4; ++ks) { const bf16x8 fa = *(const LAS bf16x8*)(AT + c32 * LD64 + ks * 16 + h32 * 8), fb = *(const LAS bf16x8*)(BT_ + c32 * LD64 + ks * 16 + h32 * 8);
                U = MFMA32(fa, fb, U);
                V = MFMA32(fb, fa, V); }
#pragma unroll
            for (int e = 0; e < 16; ++e) { const int rr = (e & 3) + 8 * (e >> 2) + 4 * h32;
                U[e] = (c32 < rr) ? U[e] : 0.f;
                V[e] = (rr < c32) ? V[e] : 0.f;
                PT[e] = V[e] + ((rr == c32) ? 1.0f : 0.f); }
#pragma unroll
            for (int st = 1; st <= 5; ++st) {
                const bf16x8 fU0 = PK8(U, 0), fU1 = PK8(U, 1);
                f32x16 Un, Vn;
#pragma unroll
                for (int e = 0; e < 16; ++e) { Un[e] = 0.f; Vn[e] = 0.f; }
                if (st < 5) { const bf16x8 fV0 = PK8(V, 0), fV1 = PK8(V, 1);
                    Un = MFMA32(fV0, fU0, Un); Un = MFMA32(fV1, fU1, Un);
                    if (st < 4) { Vn = MFMA32(fU0, fV0, Vn); Vn = MFMA32(fU1, fV1, Vn); } }
                if (st > 1) { const bf16x8 fP0 = PK8(PT, 0), fP1 = PK8(PT, 1);
                    PT = MFMA32(fU0, fP0, PT); PT = MFMA32(fU1, fP1, PT); }
                U = Un; V = Vn; }
#pragma unroll
            for (int q = 0; q < 4; ++q) { v2u w; w.x = cvtpk(PT[4 * q], PT[4 * q + 1]); w.y = cvtpk(PT[4 * q + 2], PT[4 * q + 3]); *(LAS v2u*)(MINV + c32 * LD32 + 8 * q + 4 * h32) = w; }
        } else {
            if (wave < 7) { const int mtx = (wave - 1) >> 1;
                const LAS bf16* Xs = (mtx == 1) ? BT_ : KT_; const LAS bf16* Yt = (mtx == 0) ? AT : RT; LAS bf16* O = (mtx == 0) ? AAK : (mtx == 1 ? ARB : ARK);
#pragma unroll
                for (int qq = 0; qq < 2; ++qq) { const int q = ((wave - 1) & 1) * 2 + qq, tq = (q >> 1) * 16, sq = (q & 1) * 16;
                    f32x4 a4 = (f32x4){0.f, 0.f, 0.f, 0.f};
                    if (sq <= tq) {
#pragma unroll
                        for (int ks = 0; ks < 2; ++ks) a4 = MFMA16(FRAG(Xs, sq, LD64, ks), FRAG(Yt, tq, LD64, ks), a4); }
                    const int t = tq + fr, s = sq + fq * 4;
#pragma unroll
                    for (int r = 0; r < 4; ++r) { const bool keep = (mtx == 0) ? (s + r < t) : (s + r <= t); a4[r] = keep ? a4[r] : 0.f; }
                    v2u w; w.x = cvtpk(a4[0], a4[1]); w.y = cvtpk(a4[2], a4[3]); *(LAS v2u*)(O + t * LD32 + s) = w; } }
            RWKV_FIRST;
            if (tconv) RD_CONSUME(WSP(unsigned char, WS_UT), WSP(float, WS_USC), trow0, tl);
        }
        { const int tn_ = tl + 1 < SEQ / 32 ? tl + 1 : SEQ / 32 - 1; RD_LOAD(F.in[I_U], tconv, trow0, tn_); }
        __syncthreads();
        if (wave == 0) RWKV_FIRST;
        { rhs4 = MFMA16(FRAG(AAK, t0m, LD32, 0), FRAGT(VS, i0, LD64), rhs4);
          v2u w; w.x = cvtpk(rhs4[0], rhs4[1]); w.y = cvtpk(rhs4[2], rhs4[3]); *(LAS v2u*)(RHS + (i0 + fr) * LD32 + t0m + fq * 4) = w;
          yacc = MFMA16(FRAGT(VS, i0, LD64), FRAG(ARK, t0m, LD32, 0), yacc); }
        __syncthreads();
#undef RWKV_FIRST
#undef PK8
        { f32x4 a4 = (f32x4){0.f, 0.f, 0.f, 0.f}; a4 = MFMA16(FRAG(MINV, t0m, LD32, 0), FRAG(RHS, i0, LD32, 0), a4);
          v2u w; w.x = cvtpk(a4[0], a4[1]); w.y = cvtpk(a4[2], a4[3]); *(LAS v2u*)(SAB + (i0 + fr) * LD32 + t0m + fq * 4) = w; }
        __syncthreads();
        { yacc = MFMA16(FRAG(SAB, i0, LD32, 0), FRAG(ARB, t0m, LD32, 0), yacc);
          *(LAS f32x4*)(YB + (t0m + fr) * 68 + i0 + fq * 4) = yacc;
#pragma unroll
          for (int u = 0; u < 2; ++u) { const int tile = wave * 2 + u, si0 = (tile >> 2) * 16, sj0 = (tile & 3) * 16;
              sacc[u] = MFMA16(FRAGT(BT_, sj0, LD64), FRAG(SAB, si0, LD32, 0), sacc[u]);
              const f32x4 pc = *(const LAS f32x4*)(PC + sj0 + fq * 4); sacc[u] = sacc[u] * pc;
              v2u w; w.x = cvtpk(sacc[u][0], sacc[u][1]); w.y = cvtpk(sacc[u][2], sacc[u][3]); *(LAS v2u*)(S0n + (si0 + fr) * LD64 + sj0 + fq * 4) = w; } }
        __syncthreads();
    }
    __syncthreads();
#undef FRAG
#undef FRAGT
#undef RWKV_PREFETCH
}
__device__ __forceinline__ void lora_prepass(const Frame& F) {
    const bf16* PROJ = WSP(bf16, WS_PROJ); bf16* LA = WSP(bf16, WS_LA); const float* mu = F.in[I_MU] + (PC_WD - RWKV_C0);
    const int gt = (F.bid * NWAVES + F.wave) * 64 + F.lane, NGT = F.G * NTHR;
    for (int i = gt; i < T * 36; i += NGT) { const int tok = i / 36, cc = i - tok * 36, m = cc * 8;
        const bf16* pr = PROJ + (size_t)tok * NINP + PC_WD + m;
        const v4u curv = *(const v4u*)pr; v4u prv = (v4u){0u, 0u, 0u, 0u}; if ((tok & (SEQ - 1)) != 0) prv = *(const v4u*)(pr - NINP);
        const f32x4 m0 = *(const f32x4*)(mu + m), m1 = *(const f32x4*)(mu + m + 4);
        float c[8], p[8], o[8]; unpack8(curv, c); unpack8(prv, p);
#pragma unroll
        for (int e = 0; e < 8; ++e) { const float ps = c[e] + (p[e] - c[e]) * (e < 4 ? m0[e] : m1[e - 4]); o[e] = (m < 64) ? tanh_fast(ps) : ((m < 128) ? ps : sigmoid_fast(ps)); }
        v4u w; w.x = cvtpk(o[0], o[1]); w.y = cvtpk(o[2], o[3]); w.z = cvtpk(o[4], o[5]); w.w = cvtpk(o[6], o[7]);
        *(v4u*)(LA + (size_t)tok * 288 + m) = w; }
}
__device__ __forceinline__ void lru_seq(const Frame& F, int item) {
    const int bh = item >> 1, hf = item & 1, b = bh >> 3, h = bh & 7, wave = F.wave; int tid = F.tid; asm volatile("" : "+v"(tid)); const int lane = tid & 63;
    LAS unsigned char* L = F.lds;
    LAS bf16* XA = (LAS bf16*)(L + 0);
    LAS float* XC = (LAS float*)(L + 17408);
    LAS float* RI = (LAS float*)(L + 50176);
    LAS float* SEG = (LAS float*)(L + 115712);
    LAS float* CARRY = (LAS float*)(L + 119808);
    LAS float* CW = (LAS float*)(L + 120320);
    const bf16* PROJ = WSP(bf16, WS_PROJ); bf16* Y = WSP(bf16, WS_Y);
    const int fr0 = lane & 15, fq0 = lane >> 4;
    for (int i = tid; i < 640; i += NTHR) { const int w = i >> 7, cch = i & 127; CW[i] = (w < 4) ? F.in[I_CONVW][w * 1024 + h * 128 + cch] : F.in[I_CONVB][h * 128 + cch]; }
    if (tid < 64) CARRY[tid] = 0.f;
    const int gsel = wave & 1, ntl = wave >> 1, ntg = hf * 4 + ntl;
    bf16x8 wf[4];
    { const bf16* WTp = (gsel ? WSP(bf16, WS_WIT) : WSP(bf16, WS_WAT)) + (size_t)h * 128 * 128;
#pragma unroll
      for (int ks = 0; ks < 4; ++ks) wf[ks] = *(const bf16x8*)(WTp + (ntg * 16 + fr0) * 128 + ks * 32 + 8 * fq0); }
    const int c = tid & 63, sg = tid >> 6, chl = hf * 64 + c, chg = h * 128 + chl;
    const float ba_c = F.in[I_BA][chg], bi_c = F.in[I_BI][chg], sp8 = 8.0f * softplus_fast(-F.in[I_LAM][chg]);
    v4u pf[2][4];
#define LRU_PREFETCH(k_) do { _Pragma("unroll") for (int u_ = 0; u_ < 2; ++u_) { const int chn_ = tid + NTHR * u_, t_ = chn_ >> 4, c8_ = (chn_ & 15) * 8; \
        _Pragma("unroll") for (int w_ = 0; w_ < 4; ++w_) { const int ts_ = (k_) * 64 + t_ - 3 + w_; const int tc_ = ts_ >= 0 ? ts_ : 0;   \
            const v4u x_ = *(const v4u*)(PROJ + ((size_t)b * SEQ + tc_) * NINP + h * 128 + c8_); const unsigned m_ = ts_ >= 0 ? 0xffffffffu : 0u; \
            pf[u_][w_] = (v4u){x_.x & m_, x_.y & m_, x_.z & m_, x_.w & m_}; } } } while (0)
    unsigned short gtn[8];
#define LRU_GATES(k_) do { _Pragma("unroll") for (int e_ = 0; e_ < 8; ++e_) gtn[e_] = PROJ[((size_t)b * SEQ + (k_) * 64 + sg * 8 + e_) * NINP + PC_GATE + chg]; } while (0)
    const int trow0 = (item * 8 + wave) * 16;
    f32x4 th[4], tk[4]; float tkm = 0.f;
#pragma unroll
    for (int q = 0; q < 4; ++q) tk[q] = (f32x4){0.f, 0.f, 0.f, 0.f};
    LRU_PREFETCH(0); LRU_GATES(0);
    RD_LOAD(F.in[I_V], true, trow0, 0);
    __syncthreads();
    for (int k = 0; k < SEQ / 64; ++k) {
        const size_t tokbase = (size_t)b * SEQ + k * 64;
        int lane_c = lane; asm volatile("" : "+v"(lane_c)); const int fr = lane_c & 15, fq = lane_c >> 4;
#pragma unroll
        for (int u = 0; u < 2; ++u) { const int chn = tid + NTHR * u, t = chn >> 4, c8 = (chn & 15) * 8;
            float acc[8]; { const f32x4 b0 = *(const LAS f32x4*)(CW + 512 + c8), b1 = *(const LAS f32x4*)(CW + 512 + c8 + 4);
#pragma unroll
                for (int e = 0; e < 4; ++e) { acc[e] = b0[e]; acc[e + 4] = b1[e]; } }
#pragma unroll
            for (int w = 0; w < 4; ++w) { float xf[8]; unpack8(pf[u][w], xf);
                const f32x4 w0 = *(const LAS f32x4*)(CW + w * 128 + c8), w1 = *(const LAS f32x4*)(CW + w * 128 + c8 + 4);
#pragma unroll
                for (int e = 0; e < 4; ++e) { acc[e] += w0[e] * xf[e]; acc[e + 4] += w1[e] * xf[e + 4]; } }
            v4u pk; pk.x = cvtpk(acc[0], acc[1]); pk.y = cvtpk(acc[2], acc[3]); pk.z = cvtpk(acc[4], acc[5]); pk.w = cvtpk(acc[6], acc[7]);
            *(LAS v4u*)(XA + t * 136 + c8) = pk;
            LAS float* d = XC + t * 128 + c8; *(LAS f32x4*)d = (f32x4){acc[0], acc[1], acc[2], acc[3]}; *(LAS f32x4*)(d + 4) = (f32x4){acc[4], acc[5], acc[6], acc[7]}; }
        float gl[8];
#pragma unroll
        for (int e = 0; e < 8; ++e) gl[e] = gelu_fast(__uint_as_float((unsigned)gtn[e] << 16));
        { const int kn_ = k + 1 < SEQ / 64 ? k + 1 : SEQ / 64 - 1; LRU_PREFETCH(kn_); LRU_GATES(kn_); }
        __syncthreads();
#pragma unroll
        for (int mt = 0; mt < 4; ++mt) {
            bf16x8 af[4];
#pragma unroll
            for (int ks = 0; ks < 4; ++ks) af[ks] = *(const LAS bf16x8*)(XA + (mt * 16 + fr) * 136 + ks * 32 + 8 * fq);
            { f32x4 a4 = (f32x4){0.f, 0.f, 0.f, 0.f};
#pragma unroll
                for (int ks = 0; ks < 4; ++ks) a4 = MFMA16(wf[ks], af[ks], a4);
                *(LAS f32x4*)(RI + gsel * 8192 + (mt * 16 + fr) * 128 + ntl * 16 + fq * 4) = a4; } }
        __syncthreads();
        float av[8], bx[8]; float A = 1.f, B = 0.f;
#pragma unroll
        for (int e = 0; e < 8; ++e) { const int t = sg * 8 + e; const float r = sigmoid_fast(RI[t * 128 + c] + ba_c), ig = sigmoid_fast(RI[8192 + t * 128 + c] + bi_c), xc = XC[t * 128 + chl];
            const float la = -sp8 * r; av[e] = __expf(la); bx[e] = sqrtf(fmaxf(1.0f - av[e] * av[e], 0.f)) * (ig * xc); A *= av[e]; B = av[e] * B + bx[e]; }
        SEG[(sg * 64 + c) * 2] = A; SEG[(sg * 64 + c) * 2 + 1] = B;
        __syncthreads();
        float hst = CARRY[c];
        for (int s2 = 0; s2 < sg; ++s2) hst = SEG[(s2 * 64 + c) * 2] * hst + SEG[(s2 * 64 + c) * 2 + 1];
#pragma unroll
        for (int e = 0; e < 8; ++e) { hst = av[e] * hst + bx[e];
            Y[(tokbase + sg * 8 + e) * D + chg] = (bf16)(cvtpk(hst * gl[e], 0.f) & 0xffffu); }
        RD_CONSUME(WSP(unsigned char, WS_VT), WSP(float, WS_VSC), trow0, k);
        { const int kn_ = k + 1 < SEQ / 64 ? k + 1 : SEQ / 64 - 1; RD_LOAD(F.in[I_V], true, trow0, kn_); }
        __syncthreads();
        if (sg == 7) CARRY[c] = hst;
    }
    __syncthreads();
#undef LRU_PREFETCH
#undef LRU_GATES
}
__device__ __forceinline__ void group_barrier(unsigned* cnt, unsigned n) {
    asm volatile("s_waitcnt vmcnt(0)" ::: "memory");
    __syncthreads();
    if (threadIdx.x == 0) {
        __builtin_amdgcn_fence(__ATOMIC_RELEASE, "agent");
        asm volatile("s_waitcnt vmcnt(0)" ::: "memory");
        xb_add(cnt, 1u);
        unsigned sp = 0; while (xb_ld(cnt) < n) { __builtin_amdgcn_s_sleep(2); if (++sp > (1u << 24)) break; }
        __builtin_amdgcn_fence(__ATOMIC_ACQUIRE, "agent");
        asm volatile("s_waitcnt vmcnt(0)" ::: "memory");
    }
    __syncthreads();
}

__device__ __forceinline__ unsigned f2ord(float f) { const unsigned u = __builtin_bit_cast(unsigned, f); return (u & 0x80000000u) ? ~u : (u | 0x80000000u); }
__device__ __forceinline__ float ord2f(unsigned o) { const unsigned u = (o & 0x80000000u) ? (o & 0x7fffffffu) : ~o; return __builtin_bit_cast(float, u); }
#define CMPX(hi_, lo_) do { const unsigned _a = (hi_), _b = (lo_); (hi_) = _a > _b ? _a : _b; (lo_) = _a > _b ? _b : _a; } while (0)
template <int N> __device__ __forceinline__ void sort_desc(unsigned (&a)[N]) {
#pragma unroll
    for (int k = 2; k <= N; k <<= 1)
#pragma unroll
        for (int j = k >> 1; j > 0; j >>= 1)
#pragma unroll
            for (int i = 0; i < N; ++i) { const int l = i ^ j; if (l > i) { if ((i & k) == 0) CMPX(a[i], a[l]); else CMPX(a[l], a[i]); } }
}
__device__ __forceinline__ void merge16(unsigned (&A)[16], const unsigned (&B)[16]) {
#pragma unroll
    for (int i = 0; i < 16; ++i) { const unsigned q = B[15 - i]; A[i] = A[i] > q ? A[i] : q; }
#pragma unroll
    for (int d = 8; d >= 1; d >>= 1)
#pragma unroll
        for (int i = 0; i < 16; ++i) if ((i & d) == 0) CMPX(A[i], A[i + d]);
}
__device__ __forceinline__ void merge_partner(unsigned (&Lk)[16]) {
    unsigned P[16];
#pragma unroll
    for (int i = 0; i < 16; ++i) P[i] = (unsigned)__shfl_xor((int)Lk[i], 32);
#pragma unroll
    for (int i = 0; i < 16; ++i) { const unsigned q = P[15 - i]; Lk[i] = Lk[i] > q ? Lk[i] : q; }
#pragma unroll
    for (int d = 8; d >= 1; d >>= 1)
#pragma unroll
        for (int i = 0; i < 16; ++i) if ((i & d) == 0) CMPX(Lk[i], Lk[i + d]);
}
__device__ __forceinline__ void route_item(const Frame& F, int item, int lane) {
    const int tok0 = (item >> 3) * 32, h = item & 7, c = lane & 31, hi = lane >> 5;
    const bf16* Q = WSP(bf16, WS_Q); const bf16* KB = WSP(bf16, WS_KEYS);
    LAS unsigned* WL = (LAS unsigned*)(F.lds + F.wave * 8192);
    unsigned LST[2][16];
    bf16x8 qf[8], qn[8], kf[8], kn[8];
#pragma unroll
    for (int ks = 0; ks < 8; ++ks) { qf[ks] = *(const bf16x8*)(Q + (size_t)(tok0 + c) * D + h * 256 + ks * 16 + 8 * hi); qn[ks] = *(const bf16x8*)(Q + (size_t)(tok0 + c) * D + h * 256 + 128 + ks * 16 + 8 * hi);
        kf[ks] = *(const bf16x8*)(KB + (size_t)((h * 2) * 128 + c) * 128 + 8 * hi + ks * 16); }
    unsigned Lk[16];
#pragma unroll
    for (int st = 0; st < 8; ++st) { const int p = st >> 2, m = st & 3;
        if (st < 7) { const int p2 = (st + 1) >> 2, m2 = (st + 1) & 3; const bf16* kp = KB + (size_t)((h * 2 + p2) * 128 + m2 * 32 + c) * 128 + 8 * hi;
#pragma unroll
            for (int ks = 0; ks < 8; ++ks) kn[ks] = *(const bf16x8*)(kp + ks * 16); }
        f32x16 acc;
#pragma unroll
        for (int r = 0; r < 16; ++r) acc[r] = 0.f;
#pragma unroll
        for (int ks = 0; ks < 8; ++ks) acc = MFMA32(kf[ks], p ? qn[ks] : qf[ks], acc);
        unsigned G16[16];
#pragma unroll
        for (int r = 0; r < 16; ++r) { const unsigned idx = (unsigned)(m * 32 + (r & 3) + 8 * (r >> 2)) | ((unsigned)hi << 2); G16[r] = (f2ord(acc[r]) & ~0x7Fu) | idx; }
        sort_desc<16>(G16);
        if (m == 0) {
#pragma unroll
            for (int i = 0; i < 16; ++i) Lk[i] = G16[i]; }
        else merge16(Lk, G16);
        if (m == 3) { merge_partner(Lk);
#pragma unroll
            for (int i = 0; i < 16; ++i) { LST[p][i] = Lk[i]; WL[(p * 16 + i) * 64 + lane] = Lk[i] & 0x7Fu; } }
#pragma unroll
        for (int ks = 0; ks < 8; ++ks) kf[ks] = kn[ks];
    }
    float va[4], vb[16];
#pragma unroll
    for (int i = 0; i < 4; ++i) va[i] = ord2f((hi ? LST[1][i] : LST[0][i]) & ~0x7Fu);
#pragma unroll
    for (int j = 0; j < 16; ++j) vb[j] = ord2f((hi ? LST[0][j] : LST[1][j]) & ~0x7Fu);
    unsigned C32[32];
#pragma unroll
    for (int i = 0; i < 32; ++i) C32[i] = 0u;
#pragma unroll
    for (int i = 0; i < 4; ++i) { const unsigned key = (f2ord(va[i] + vb[i]) & ~0xFFu) | (unsigned)(i * 17); C32[i] = hi ? 0u : key; }
    { int cn = 4;
#pragma unroll
      for (int i = 0; i < 3; ++i)
#pragma unroll
          for (int j = i + 1; j < 16; ++j) if ((i + 1) * (j + 1) <= 16) { const unsigned code = hi ? (unsigned)(j * 16 + i) : (unsigned)(i * 16 + j); C32[cn] = (f2ord(va[i] + vb[j]) & ~0xFFu) | code; ++cn; } }
    sort_desc<32>(C32);
    unsigned Ck[16];
#pragma unroll
    for (int i = 0; i < 16; ++i) Ck[i] = C32[i];
    merge_partner(Ck);
    const float mx = ord2f(Ck[0] & ~0xFFu); float den = 0.f;
#pragma unroll
    for (int k = 0; k < 16; ++k) den += __expf(ord2f(Ck[k] & ~0xFFu) - mx);
    const float rden = 1.0f / den;
    int eo[8]; float go[8];
#pragma unroll
    for (int k = 0; k < 8; ++k) { const unsigned fm = hi ? Ck[k + 8] : Ck[k]; const unsigned code = fm & 0xFFu;
        const unsigned k0 = WL[(code >> 4) * 64 + lane], k1 = WL[(16 + (code & 15u)) * 64 + lane];
        eo[k] = (int)(k0 * 128u + k1); go[k] = __expf(ord2f(fm & ~0xFFu) - mx) * rden; }
    int* ep = WSP(int, WS_EXP) + (size_t)(tok0 + c) * NSEL + h * 16 + hi * 8; float* gp = WSP(float, WS_GATE) + (size_t)(tok0 + c) * NSEL + h * 16 + hi * 8;
    *(int4*)ep = make_int4(eo[0], eo[1], eo[2], eo[3]); *(int4*)(ep + 4) = make_int4(eo[4], eo[5], eo[6], eo[7]);
    *(f32x4*)gp = (f32x4){go[0], go[1], go[2], go[3]}; *(f32x4*)(gp + 4) = (f32x4){go[4], go[5], go[6], go[7]};
}

typedef float f32x2 __attribute__((ext_vector_type(2)));
__device__ __forceinline__ int dot4i(unsigned a, unsigned b, int c) { return __builtin_amdgcn_sdot4((int)a, (int)b, c, false); }
template <int CTRL> __device__ __forceinline__ int dppi(int x) { return __builtin_amdgcn_mov_dpp(x, CTRL, 0xf, 0xf, true); }
struct PeerGeom { int ngrp, g, rank, nrank; };
__device__ __forceinline__ PeerGeom peer_geom(const Frame& F) { PeerGeom p; p.ngrp = (F.G % 8 == 0) ? 8 : 1; p.g = F.bid % p.ngrp; p.rank = F.bid / p.ngrp; p.nrank = F.G / p.ngrp; return p; }
__device__ __forceinline__ void xquant_token(const Frame& F, int tok, int lane) {
    const bf16* xr = WSP(bf16, WS_XB) + (size_t)tok * D + lane * 16; float xf[32]; float am = 0.f, sq = 0.f;
#pragma unroll
    for (int hh = 0; hh < 2; ++hh)
#pragma unroll
        for (int q = 0; q < 2; ++q) { const v4u w = *(const v4u*)(xr + hh * 1024 + q * 8); float t8[8]; unpack8(w, t8);
            const f32x4 g0 = *(const f32x4*)(F.in[I_G2N] + hh * 1024 + lane * 16 + q * 8), g1 = *(const f32x4*)(F.in[I_G2N] + hh * 1024 + lane * 16 + q * 8 + 4);
#pragma unroll
            for (int e = 0; e < 8; ++e) { const float xg = t8[e] * (e < 4 ? g0[e & 3] : g1[e & 3]); xf[hh * 16 + q * 8 + e] = xg; am = fmaxf(am, fabsf(xg)); sq += t8[e] * t8[e]; } }
#pragma unroll
    for (int o = 1; o < 64; o <<= 1) am = fmaxf(am, __shfl_xor(am, o));
    sq = wave_sum(sq);
    const float qs = am > 0.f ? 127.0f / am : 0.f;
    if (lane == 0) { WSP(float, WS_SX)[tok] = am * (1.0f / 127.0f); WSP(float, WS_SSQ2)[tok] = sq; }
#pragma unroll
    for (int hh = 0; hh < 2; ++hh) { v4u o;
#pragma unroll
        for (int d = 0; d < 4; ++d) { unsigned w = 0u;
#pragma unroll
            for (int e = 0; e < 4; ++e) { const int qi = (int)rintf(xf[hh * 16 + d * 4 + e] * qs); w |= ((unsigned)qi & 0xFFu) << (8 * e); }
            o[d] = w; }
        *(v4u*)(WSP(unsigned char, WS_XQ) + (size_t)tok * D + hh * 1024 + lane * 16) = o; }
}
__device__ __forceinline__ void yquant_tokens(const Frame& F, int tokA, int tokB, int lane) {
    v4u ra[2][2], rb[2][2];
#pragma unroll
    for (int hh = 0; hh < 2; ++hh)
#pragma unroll
        for (int q = 0; q < 2; ++q) { ra[hh][q] = *(const v4u*)(WSP(bf16, WS_Y) + (size_t)tokA * D + hh * 1024 + lane * 16 + q * 8); rb[hh][q] = *(const v4u*)(WSP(bf16, WS_Y) + (size_t)tokB * D + hh * 1024 + lane * 16 + q * 8); }
#define YQ_ONE(R_, tok_) do { float xf_[32]; float am_ = 0.f; \
        _Pragma("unroll") for (int hh_ = 0; hh_ < 2; ++hh_) _Pragma("unroll") for (int q_ = 0; q_ < 2; ++q_) { float t8_[8]; unpack8(R_[hh_][q_], t8_); \
            _Pragma("unroll") for (int e_ = 0; e_ < 8; ++e_) { xf_[hh_ * 16 + q_ * 8 + e_] = t8_[e_]; am_ = fmaxf(am_, fabsf(t8_[e_])); } } \
        am_ = fmaxf(am_, dppf<0xB1>(am_)); am_ = fmaxf(am_, dppf<0x4E>(am_)); am_ = fmaxf(am_, dppf<0x141>(am_)); am_ = fmaxf(am_, dppf<0x140>(am_)); \
        { auto s_ = __builtin_amdgcn_permlane16_swap(__float_as_uint(am_), __float_as_uint(am_), false, false); am_ = fmaxf(__uint_as_float(s_[0]), __uint_as_float(s_[1])); } \
        { auto s_ = __builtin_amdgcn_permlane32_swap(__float_as_uint(am_), __float_as_uint(am_), false, false); am_ = fmaxf(__uint_as_float(s_[0]), __uint_as_float(s_[1])); } \
        const float qs_ = am_ > 0.f ? 127.0f / am_ : 0.f; \
        if (lane == 0) WSP(float, WS_SY)[tok_] = am_ * (1.0f / 127.0f); \
        _Pragma("unroll") for (int hh_ = 0; hh_ < 2; ++hh_) { v4u o_; \
            _Pragma("unroll") for (int d_ = 0; d_ < 4; ++d_) { \
                const unsigned b0_ = __float_as_uint(__builtin_fmaf(xf_[hh_ * 16 + d_ * 4 + 0], qs_, 12582912.0f)), b1_ = __float_as_uint(__builtin_fmaf(xf_[hh_ * 16 + d_ * 4 + 1], qs_, 12582912.0f)); \
                const unsigned b2_ = __float_as_uint(__builtin_fmaf(xf_[hh_ * 16 + d_ * 4 + 2], qs_, 12582912.0f)), b3_ = __float_as_uint(__builtin_fmaf(xf_[hh_ * 16 + d_ * 4 + 3], qs_, 12582912.0f)); \
                o_[d_] = __builtin_amdgcn_perm(b1_, b0_, 0x0c0c0400u) | __builtin_amdgcn_perm(b3_, b2_, 0x04000c0cu); } \
            *(v4u*)(WSP(unsigned char, WS_YQ) + (size_t)(tok_) * D + hh_ * 1024 + lane * 16) = o_; } } while (0)
    YQ_ONE(ra, tokA);
    if (tokB != tokA) YQ_ONE(rb, tokB);
#undef YQ_ONE
}
struct PeerIds { int a, b; };
__device__ __forceinline__ PeerIds peer_ids_load(const Frame& F, int tok, int lane) { const int* ep = WSP(int, WS_EXP) + (size_t)tok * NSEL; PeerIds r; r.a = ep[lane]; r.b = ep[64 + lane]; return r; }
struct PeerScoreBuf { v4u w[16]; v4u xs; };
__device__ __forceinline__ void peer_score_issue(const Frame& F, int tok, int slice, int lane, LAS int* wl, const PeerIds& id, PeerScoreBuf& B) {
    const int e8 = lane >> 3, c16 = lane & 7;
    wl[lane] = id.a; wl[64 + lane] = id.b;
    B.xs = *(const v4u*)(WSP(unsigned char, WS_XQ) + (size_t)tok * D + slice * 128 + c16 * 16);
    const unsigned char* ub = WSP(unsigned char, WS_UT); const unsigned lo = (unsigned)(slice * 128 + c16 * 16);
#pragma unroll
    for (int ld = 0; ld < 16; ++ld) { const unsigned eid = (unsigned)wl[e8 * 16 + ld]; B.w[ld] = *(const v4u*)(ub + (eid * 2048u + lo)); }
}
__device__ __forceinline__ void peer_score_consume(const Frame& F, int tok, int slice, int lane, const PeerScoreBuf& B, bool valid) {
    int p[16];
#pragma unroll
    for (int ld = 0; ld < 16; ++ld) { const v4u w = B.w[ld]; int a = dot4i(w.x, B.xs.x, 0); a = dot4i(w.y, B.xs.y, a); a = dot4i(w.z, B.xs.z, a); p[ld] = dot4i(w.w, B.xs.w, a); }
    { const bool up = (lane & 4) != 0;
#pragma unroll
      for (int k = 0; k < 8; ++k) { const int keep = up ? p[k + 8] : p[k], send = up ? p[k] : p[k + 8]; p[k] = keep + dppi<0x141>(send); } }
    { const bool up = (lane & 2) != 0;
#pragma unroll
      for (int k = 0; k < 4; ++k) { const int keep = up ? p[k + 4] : p[k], send = up ? p[k] : p[k + 4]; p[k] = keep + dppi<0x4E>(send); } }
    { const bool up = (lane & 1) != 0;
#pragma unroll
      for (int k = 0; k < 2; ++k) { const int keep = up ? p[k + 2] : p[k], send = up ? p[k] : p[k + 2]; p[k] = keep + dppi<0xB1>(send); } }
    if (valid) { int* dst = WSP(int, WS_PART) + ((size_t)slice * T + tok) * NSEL + lane * 2; *(int2*)dst = make_int2(p[0], p[1]); }
}
__device__ __forceinline__ void peer_score_phase(const Frame& F, const PeerGeom& pg, LAS int* wl2) {
    const int lane = F.lane, first = pg.rank * NWAVES + F.wave, step = pg.nrank * NWAVES, n = first < T ? (T - first + step - 1) / step : 0;
    LAS int* wlA = wl2; LAS int* wlB = wl2 + 256;
#define PEER_TOKC(k_) ((first + (k_) * step) < T ? (first + (k_) * step) : T - 1)
    for (int r = 0; r < 16 / pg.ngrp; ++r) { const int slice = r * pg.ngrp + pg.g;
        PeerScoreBuf A, B; PeerIds id = peer_ids_load(F, PEER_TOKC(0), lane);
        { const PeerIds cur = id; id = peer_ids_load(F, PEER_TOKC(1), lane); asm volatile("" ::: "memory"); peer_score_issue(F, PEER_TOKC(0), slice, lane, wlA, cur, A); }
        for (int i = 0; i < n; i += 2) {
            { const PeerIds cur = id; id = peer_ids_load(F, PEER_TOKC(i + 2), lane); asm volatile("" ::: "memory"); peer_score_issue(F, PEER_TOKC(i + 1), slice, lane, wlB, cur, B); }
            peer_score_consume(F, first + i * step, slice, lane, A, true);
            { const PeerIds cur = id; id = peer_ids_load(F, PEER_TOKC(i + 3), lane); asm volatile("" ::: "memory"); peer_score_issue(F, PEER_TOKC(i + 2), slice, lane, wlA, cur, A); }
            peer_score_consume(F, first + (i + 1) * step, slice, lane, B, i + 1 < n);
        }
    }
}
__device__ __forceinline__ void peer_coef_token(const Frame& F, int tok, int lane) {
    int s0 = 0, s1 = 0;
#pragma unroll
    for (int s = 0; s < 16; ++s) { const int2 v = *(const int2*)(WSP(int, WS_PART) + ((size_t)s * T + tok) * NSEL + lane * 2); s0 += v.x; s1 += v.y; }
    const int2 ex = *(const int2*)(WSP(int, WS_EXP) + (size_t)tok * NSEL + lane * 2); const f32x2 ga = *(const f32x2*)(WSP(float, WS_GATE) + (size_t)tok * NSEL + lane * 2);
    const float rs = WSP(float, WS_SX)[tok] * (1.0f / sqrtf(WSP(float, WS_SSQ2)[tok] * (1.0f / D) + NORM_EPS));
    const float sc0 = (float)s0 * WSP(float, WS_USC)[ex.x] * rs, sc1 = (float)s1 * WSP(float, WS_USC)[ex.y] * rs;
    f32x2 c; c.x = ga.x * gelu_fast(sc0) * WSP(float, WS_VSC)[ex.x]; c.y = ga.y * gelu_fast(sc1) * WSP(float, WS_VSC)[ex.y];
    float cm = fmaxf(fabsf(c.x), fabsf(c.y));
#pragma unroll
    for (int o = 1; o < 64; o <<= 1) cm = fmaxf(cm, __shfl_xor(cm, o));
    const float qs = cm > 0.f ? 127.0f / cm : 0.f;
    const int q0 = (int)rintf(c.x * qs), q1 = (int)rintf(c.y * qs);
    ((unsigned short*)(F.ws + WS_COEF))[(size_t)tok * 64 + lane] = (unsigned short)(((unsigned)q0 & 0xFFu) | (((unsigned)q1 & 0xFFu) << 8));
    if (lane == 0) WSP(float, WS_CSC)[tok] = cm * (1.0f / 127.0f);
}
struct PeerOutBuf { v4u w[16]; v4u cq; unsigned x; float cs; };
__device__ __forceinline__ void peer_out_issue(const Frame& F, int tok, int slice, int lane, LAS int* wl, const PeerIds& id, PeerOutBuf& B) {
    const int e8 = lane >> 3, c16 = lane & 7;
    wl[lane] = id.a; wl[64 + lane] = id.b;
    B.cq = *(const v4u*)(F.ws + WS_COEF + (size_t)tok * 128 + e8 * 16);
    B.cs = WSP(float, WS_CSC)[tok];
    const unsigned char* vb = WSP(unsigned char, WS_VT); const unsigned lofs = (unsigned)(slice * 128 + c16 * 16);
#pragma unroll
    for (int ld = 0; ld < 16; ++ld) { const unsigned eid = (unsigned)wl[e8 * 16 + ld]; B.w[ld] = *(const v4u*)(vb + (eid * 2048u + lofs)); }
    B.x = *(const unsigned*)(WSP(bf16, WS_XB) + (size_t)tok * D + slice * 128 + c16 * 16 + e8 * 2);
}
__device__ __forceinline__ void peer_out_consume(const Frame& F, int tok, int slice, int lane, const PeerOutBuf& B, bool valid) {
    const int e8 = lane >> 3, c16 = lane & 7;
    int o[16];
#pragma unroll
    for (int i = 0; i < 16; ++i) o[i] = 0;
#pragma unroll
    for (int g = 0; g < 4; ++g) { const unsigned cq = B.cq[g];
#pragma unroll
        for (int d = 0; d < 4; ++d) { const unsigned w0 = B.w[4 * g][d], w1 = B.w[4 * g + 1][d], w2 = B.w[4 * g + 2][d], w3 = B.w[4 * g + 3][d];
            const unsigned lo01 = __builtin_amdgcn_perm(w1, w0, 0x05010400u), hi01 = __builtin_amdgcn_perm(w1, w0, 0x07030602u);
            const unsigned lo23 = __builtin_amdgcn_perm(w3, w2, 0x05010400u), hi23 = __builtin_amdgcn_perm(w3, w2, 0x07030602u);
            const unsigned t0 = __builtin_amdgcn_perm(lo23, lo01, 0x05040100u), t1 = __builtin_amdgcn_perm(lo23, lo01, 0x07060302u);
            const unsigned t2 = __builtin_amdgcn_perm(hi23, hi01, 0x05040100u), t3 = __builtin_amdgcn_perm(hi23, hi01, 0x07060302u);
            o[d * 4 + 0] = dot4i(t0, cq, o[d * 4 + 0]); o[d * 4 + 1] = dot4i(t1, cq, o[d * 4 + 1]); o[d * 4 + 2] = dot4i(t2, cq, o[d * 4 + 2]); o[d * 4 + 3] = dot4i(t3, cq, o[d * 4 + 3]); } }
#pragma unroll
    for (int k = 0; k < 8; ++k) { auto s = __builtin_amdgcn_permlane32_swap((unsigned)o[k], (unsigned)o[k + 8], false, false); o[k] = (int)(s[0] + s[1]); }
#pragma unroll
    for (int k = 0; k < 4; ++k) { auto s = __builtin_amdgcn_permlane16_swap((unsigned)o[k], (unsigned)o[k + 4], false, false); o[k] = (int)(s[0] + s[1]); }
    { const bool up = (lane & 8) != 0;
#pragma unroll
      for (int k = 0; k < 2; ++k) { const int keep = up ? o[k + 2] : o[k], send = up ? o[k] : o[k + 2]; o[k] = keep + dppi<0x128>(send); } }
    const float x0 = bf_lo(B.x) + (float)o[0] * B.cs, x1 = bf_hi(B.x) + (float)o[1] * B.cs;
    if (valid) *(unsigned*)(WSP(bf16, WS_XB) + (size_t)tok * D + slice * 128 + c16 * 16 + e8 * 2) = cvtpk(x0, x1);
}
__device__ __forceinline__ void peer_out_phase(const Frame& F, const PeerGeom& pg, LAS int* wl2) {
    const int lane = F.lane, first = pg.rank * NWAVES + F.wave, step = pg.nrank * NWAVES, n = first < T ? (T - first + step - 1) / step : 0;
    LAS int* wlA = wl2; LAS int* wlB = wl2 + 256;
    for (int r = 0; r < 16 / pg.ngrp; ++r) { const int slice = r * pg.ngrp + pg.g;
        PeerOutBuf A, B; PeerIds id = peer_ids_load(F, PEER_TOKC(0), lane);
        { const PeerIds cur = id; id = peer_ids_load(F, PEER_TOKC(1), lane); asm volatile("" ::: "memory"); peer_out_issue(F, PEER_TOKC(0), slice, lane, wlA, cur, A); }
        for (int i = 0; i < n; i += 2) {
            { const PeerIds cur = id; id = peer_ids_load(F, PEER_TOKC(i + 2), lane); asm volatile("" ::: "memory"); peer_out_issue(F, PEER_TOKC(i + 1), slice, lane, wlB, cur, B); }
            peer_out_consume(F, first + i * step, slice, lane, A, true);
            { const PeerIds cur = id; id = peer_ids_load(F, PEER_TOKC(i + 3), lane); asm volatile("" ::: "memory"); peer_out_issue(F, PEER_TOKC(i + 2), slice, lane, wlA, cur, A); }
            peer_out_consume(F, first + (i + 1) * step, slice, lane, B, i + 1 < n);
        }
    }
}
#undef PEER_TOKC
__device__ __forceinline__ void final_norm_phase(const Frame& F) {
    const int lane = F.lane, gw = F.bid * NWAVES + F.wave, NGW = F.G * NWAVES;
    const f32x4* gf = (const f32x4*)F.in[I_GF] + lane;
    f32x4 g[8];
#pragma unroll
    for (int j = 0; j < 8; ++j) g[j] = gf[64 * j];
    if (gw >= T) return;
    v2u va[8], vb[8]; float sa, sb;
#define FN_LOAD(v_, s_, tok_) do { const int tc_ = (tok_) < T ? (tok_) : T - 1; const v2u* xi_ = (const v2u*)(WSP(bf16, WS_XB) + (size_t)tc_ * D) + lane; \
        _Pragma("unroll") for (int j_ = 0; j_ < 8; ++j_) v_[j_] = xi_[64 * j_]; } while (0)
#define FN_STORE(v_, s_, tok_) do { f32x4* xo_ = (f32x4*)(F.out + (size_t)(tok_) * D) + lane; s_ = 0.f; f32x4 f_[8]; \
        _Pragma("unroll") for (int j_ = 0; j_ < 8; ++j_) { f_[j_] = (f32x4){bf_lo(v_[j_].x), bf_hi(v_[j_].x), bf_lo(v_[j_].y), bf_hi(v_[j_].y)}; s_ += (f_[j_][0] * f_[j_][0] + f_[j_][1] * f_[j_][1]) + (f_[j_][2] * f_[j_][2] + f_[j_][3] * f_[j_][3]); } \
        s_ = wave_sum(s_); const float rs_ = 1.0f / sqrtf(s_ * (1.0f / D) + NORM_EPS); \
        _Pragma("unroll") for (int j_ = 0; j_ < 8; ++j_) xo_[64 * j_] = f_[j_] * rs_ * g[j_]; } while (0)
    FN_LOAD(va, sa, gw);
    for (int tok = gw; tok < T; tok += 2 * NGW) {
        FN_LOAD(vb, sb, tok + NGW);
        FN_STORE(va, sa, tok);
        FN_LOAD(va, sa, tok + 2 * NGW);
        if (tok + NGW < T) FN_STORE(vb, sb, tok + NGW);
    }
#undef FN_LOAD
#undef FN_STORE
}

struct Args { const float* in[28]; float* out; unsigned char* ws; int ph_lo, ph_hi, li, pad; };
__global__ void __launch_bounds__(NTHR, 2) hybrid_fwd(Args args) {
    extern __shared__ __attribute__((aligned(16))) unsigned char lds[];
    Frame F;
    F.lds = (LAS unsigned char*)lds;
    F.tid = threadIdx.x; F.lane = F.tid & 63; F.wave = __builtin_amdgcn_readfirstlane(F.tid >> 6);
    F.G = gridDim.x; F.bid = blockIdx.x;
#pragma unroll
    for (int i = 0; i < 28; ++i) F.in[i] = args.in[i];
    F.out = args.out; F.ws = args.ws;
    volatile LAS unsigned* MISC = (volatile LAS unsigned*)(F.lds + MISC_OFF);
    for (int u = F.tid; u < (LDS_BYTES - LDSCTL_OFF) / 4; u += NTHR) ((LAS unsigned*)(F.lds + LDSCTL_OFF))[u] = 0u;
    __syncthreads();
    unsigned* barw = (unsigned*)(F.ws + WS_CTL) + CW_BAR;
    XcdBarrier bar; bar.bar = barw; bar.x = 0; bar.st = nullptr;
    if (N_LAUNCHES == 1) bar = xcd_barrier_post(barw, MISC + 8);
    const int lo = args.ph_lo, hi = args.ph_hi;
#define IN(k) (lo <= (k) && (k) < hi)
#define SEAM(k) do { if (IN(k) && IN((k) + 1)) xcd_barrier(bar); } while (0)

#ifndef PROBE_DUP
#define PROBE_DUP -1
#endif
#define REPS(k) for (int rep_ = 0; rep_ < ((PROBE_DUP) == (k) ? 2 : 1); ++rep_)
    if (IN(0)) REPS(0) { p0_prologue<0>(F, F.bid, F.G); __syncthreads(); }
    SEAM(0);
    if (IN(1)) REPS(1) {
        pg8::Gemm g{(const bf16*)((const unsigned char*)F.out + OUT_X8), WSP(const bf16, WS_WIN), T, NINP, D / 2}; pg8::StaticOrder S; S.init(T, NINP, F.G, F.bid);
        pg8::EpiI8RowColBf16<0> E{WSP(bf16, WS_PROJ), NINP, WSP(const float, WS_RSTD1), WSP(const float, WS_CS1), nullptr, NORM_EPS};
        pg8::gemm_phase<pg8::EpiI8RowColBf16<0>, pg8::StaticOrder, true, true, true>(F.lds, g, S, E);
    }
    SEAM(1);
    if (IN(2)) REPS(2) {
        lora_prepass(F);
        group_barrier((unsigned*)(F.ws + WS_CTL) + CW_PREBAR, (unsigned)F.G);
        for (int r4 = 0; r4 < ((PROBE_DUP) == 70 ? 2 : 1); ++r4) rwkv_prep_phase(F);
        group_barrier((unsigned*)(F.ws + WS_CTL) + CW_PREPBAR, (unsigned)F.G);
        const int R1 = F.G >= 256 ? 128 : F.G, L0 = F.G >= 256 ? 128 : 0, NL = F.G - L0;
        if (F.bid < R1) for (int it = F.bid; it < 128; it += R1) rwkv_item(F, it);
        if (F.bid >= L0) for (int it = F.bid - L0; it < 128; it += NL) lru_seq(F, it);
        { volatile LAS int* qslot = (volatile LAS int*)(F.lds + LDSCTL_OFF + 1024);
          for (;;) { __syncthreads(); if (F.tid == 0) *qslot = (int)xb_add((unsigned*)(F.ws + WS_CTL) + CW_DEFQ, 1u); __syncthreads();
              const int vb = *qslot; if (vb >= DEF_SLICES) break; p0_prologue<1>(F, vb, DEF_SLICES); } }
    }
    SEAM(2);
    if (IN(3)) REPS(3) { const int gw = F.bid * NWAVES + F.wave, NGW = F.G * NWAVES;
        for (int tok = gw; tok < T; tok += 2 * NGW) yquant_tokens(F, tok, tok + NGW < T ? tok + NGW : tok, F.lane); }
    SEAM(3);
    if (IN(4)) REPS(4) {
        pg8::Gemm g{WSP(const bf16, WS_YQ), WSP(const bf16, WS_WOUT), T, D, D / 2}; pg8::StaticOrder S; S.init(T, D, F.G, F.bid);
        pg8::EpiI8Residual E{(const unsigned char*)F.out + OUT_X8, WSP(const float, WS_SX0), WSP(bf16, WS_XB), D, WSP(const float, WS_SY), WSP(const float, WS_CSO)};
        pg8::gemm_phase<pg8::EpiI8Residual, pg8::StaticOrder, true, true, true>(F.lds, g, S, E);
    }
    SEAM(4);
    if (IN(5)) { const int gw = F.bid * NWAVES + F.wave, NGW = F.G * NWAVES;
        for (int tok = gw; tok < T; tok += NGW) xquant_token(F, tok, F.lane); }
    SEAM(5);
    if (IN(6)) REPS(6) {
        pg8::Gemm g{WSP(const bf16, WS_XQ), WSP(const bf16, WS_WQ), T, D, D / 2}; pg8::StaticOrder S; S.init(T, D, F.G, F.bid);
        pg8::EpiI8RowColBf16<1> E{WSP(bf16, WS_Q), D, WSP(const float, WS_SX), WSP(const float, WS_CSQ), WSP(const float, WS_SSQ2), NORM_EPS};
        pg8::gemm_phase<pg8::EpiI8RowColBf16<1>, pg8::StaticOrder, true, true, true>(F.lds, g, S, E);
    }
    if (IN(6)) { __syncthreads();
        pg8::StaticOrder S; S.init(T, D, F.G, F.bid); pg8::Unit u;
        for (int i = 0; S.next(i, u); ++i) route_item(F, ((u.pm * 8 + F.wave) << 3) | u.pn, F.lane); }
    SEAM(6);
    { const PeerGeom pg = peer_geom(F); LAS int* wl = (LAS int*)(F.lds + F.wave * 1024);
      if (IN(7)) REPS(7) peer_score_phase(F, pg, (LAS int*)(F.lds + 16384 + F.wave * 2048));
      SEAM(7);
      if (IN(8)) REPS(8) { const int gw = F.bid * NWAVES + F.wave, NGW = F.G * NWAVES; for (int tok = gw; tok < T; tok += NGW) peer_coef_token(F, tok, F.lane); }
      SEAM(8);
      if (IN(9)) peer_out_phase(F, pg, (LAS int*)(F.lds + 16384 + F.wave * 2048));
      SEAM(9);
      if (IN(10)) final_norm_phase(F); }
#undef IN
#undef SEAM
}

extern "C" void kernel_launch(void* const* d_in, const int* in_sizes, int n_in, void* d_out, int out_size, void* d_ws, size_t ws_size, hipStream_t stream) {
    static int grid = 0;
    if (grid == 0) {
        if (n_in != 28 || in_sizes[0] != T * D || out_size != T * D || ws_size < WS_END) { fprintf(stderr, "kernel_launch: shape/workspace mismatch: n_in %d in0 %d out %d ws %zu (need %zu)\n", n_in, n_in > 0 ? in_sizes[0] : -1, out_size, ws_size, (size_t)WS_END); grid = -1; return; }
        int dev = 0, cus = 0, per_cu = 0;
        if (hipGetDevice(&dev) != hipSuccess || hipDeviceGetAttribute(&cus, hipDeviceAttributeMultiprocessorCount, dev) != hipSuccess) { fprintf(stderr, "kernel_launch: device query failed\n"); grid = -1; return; }
        if (hipFuncSetAttribute((const void*)hybrid_fwd, hipFuncAttributeMaxDynamicSharedMemorySize, LDS_BYTES) != hipSuccess) { fprintf(stderr, "kernel_launch: hipFuncSetAttribute failed\n"); grid = -1; return; }
        if (hipOccupancyMaxActiveBlocksPerMultiprocessor(&per_cu, (const void*)hybrid_fwd, NTHR, LDS_BYTES) != hipSuccess || per_cu < 1) { fprintf(stderr, "kernel_launch: occupancy query says %d blocks per CU\n", per_cu); per_cu = 1; }
        (void)hipGetLastError();
        grid = cus;
    }
    if (grid < 0) return;
    if (hipMemsetAsync((char*)d_ws + WS_CTL, 0, CTL_ZERO_BYTES, stream) != hipSuccess) { fprintf(stderr, "kernel_launch: hipMemsetAsync failed\n"); return; }
    Args a{};
    for (int i = 0; i < 28; ++i) a.in[i] = (const float*)d_in[i];
    a.out = (float*)d_out; a.ws = (unsigned char*)d_ws;
    for (int li = 0; li < N_LAUNCHES; ++li) {
        a.ph_lo = (N_LAUNCHES == 1) ? 0 : li; a.ph_hi = (N_LAUNCHES == 1) ? N_PHASES : li + 1; a.li = li;
        hipLaunchKernelGGL(hybrid_fwd, dim3(grid), dim3(NTHR), LDS_BYTES, stream, a);
        const hipError_t le = hipPeekAtLastError();
        if (le != hipSuccess) { fprintf(stderr, "kernel_launch: launch %d failed: %s\n", li, hipGetErrorName(le)); break; }
    }
}
```

```cpp
#include <hip/hip_runtime.h>
#include <cstdio>
#include <cstdint>
namespace pg8 {
#define PG8_LAS __attribute__((address_space(3)))
typedef unsigned short bf16_t;
typedef short bf16x8 __attribute__((ext_vector_type(8)));
typedef float f32x4 __attribute__((ext_vector_type(4)));
typedef unsigned u32x4 __attribute__((ext_vector_type(4)));
typedef int i32x4 __attribute__((ext_vector_type(4)));
constexpr int BM = 256, BK = 64, HALF = 128, HTB = HALF * BK * 2  , STAGE_BYTES = 8 * HTB, NXCD = 8, WGM = 8;

__host__ __device__ __forceinline__ int lds_byte(int r, int c) { const int st = (r >> 4) * 2 + (c >> 5), rr = r & 15, cc = c & 31, ob = rr * 64 + cc * 2; return st * 1024 + (ob ^ (((ob >> 9) & 1) << 5)); }
__host__ __device__ __forceinline__ void stage_rc(int b, int& R, int& C) { const int st = b / 1024, sb = b % 1024, swz = sb ^ (((sb >> 9) & 1) << 5); R = (st >> 1) * 16 + swz / 64; C = (st & 1) * 32 + (swz % 64) / 2; }
__host__ __device__ __forceinline__ int perm32(int rho) { const int n = rho >> 4, i = rho & 15; return 8 * (i >> 2) + 4 * n + (i & 3); }

struct Unit { int pm, pn; };
struct Gemm { const bf16_t* A; const bf16_t* Bt; int M, N, K; };

struct StaticOrder {
    int nM, nN, nwg, G, c;
    __host__ __device__ void init(int M, int N, int G_, int c_) { nM = M / BM; nN = N / BM; nwg = nM * nN; G = G_; c = c_; }
    __host__ __device__ bool next(int i, Unit& u) const {
        const long L = (long)i * G + c; if (L >= nwg) return false;
        int wgid = (int)L; { const int q = nwg / NXCD, r = nwg % NXCD, xcd = wgid % NXCD, off = wgid / NXCD; wgid = (xcd < r ? xcd * (q + 1) : r * (q + 1) + (xcd - r) * q) + off; }
        const int nig = WGM * nN, gid = wgid / nig, fm = gid * WGM, gsz = (nM - fm) < WGM ? (nM - fm) : WGM;
        u.pm = fm + ((wgid % nig) % gsz); u.pn = (wgid % nig) / gsz; return true;
    }
    __device__ __forceinline__ void a_ready(const Unit&) const {}
    __device__ __forceinline__ void done(const Unit&) const {}
};

__device__ __forceinline__ unsigned cvt_pk_bf16(float lo, float hi) { unsigned r; asm volatile("v_cvt_pk_bf16_f32 %0, %1, %2" : "=v"(r) : "v"(lo), "v"(hi)); return r; }
typedef float f32x2 __attribute__((ext_vector_type(2)));
typedef unsigned u32x2 __attribute__((ext_vector_type(2)));
template <int MODE> struct EpiRowScaleBf16 {
    static constexpr bool PERM = true, AFTER_DRAIN = false;
    bf16_t* O; int ldc; const float* rs; float eps;
    __device__ __forceinline__ void operator()(const f32x4 (&acc)[2][2][4][2], const Unit& u, int wr, int wc, int fr, int fq) const {
        const int row0 = u.pm * BM + wr * 64 + fr, col0 = u.pn * BM + wc * 32 + 8 * fq;
#pragma unroll
        for (int ai = 0; ai < 2; ++ai)
#pragma unroll
            for (int m = 0; m < 4; ++m) { const int r = row0 + ai * HALF + m * 16; float s = rs[r]; if (MODE == 1) s = 1.0f / sqrtf(s * (1.0f / 2048.0f) + eps);
                bf16_t* rowp = O + (size_t)r * ldc + col0;
#pragma unroll
                for (int bj = 0; bj < 2; ++bj) { const f32x4 v0 = acc[ai][bj][m][0] * s, v1 = acc[ai][bj][m][1] * s;
                    u32x4 w; w.x = cvt_pk_bf16(v0[0], v0[1]); w.y = cvt_pk_bf16(v0[2], v0[3]); w.z = cvt_pk_bf16(v1[0], v1[1]); w.w = cvt_pk_bf16(v1[2], v1[3]);
                    *(u32x4*)(rowp + bj * HALF) = w; } }
    }
};
template <int MODE> struct EpiI8RowColBf16 {
    static constexpr bool PERM = true, AFTER_DRAIN = false;
    bf16_t* O; int ldc; const float* rs; const float* cs; const float* ssq; float eps;
    __device__ __forceinline__ void operator()(const f32x4 (&acc)[2][2][4][2], const Unit& u, int wr, int wc, int fr, int fq) const {
        const int row0 = u.pm * BM + wr * 64 + fr, col0 = u.pn * BM + wc * 32 + 8 * fq;
        f32x4 c4[2][2];
#pragma unroll
        for (int bj = 0; bj < 2; ++bj) { c4[bj][0] = *(const f32x4*)(cs + col0 + bj * HALF); c4[bj][1] = *(const f32x4*)(cs + col0 + bj * HALF + 4); }
#pragma unroll
        for (int ai = 0; ai < 2; ++ai)
#pragma unroll
            for (int m = 0; m < 4; ++m) { const int r = row0 + ai * HALF + m * 16; float s = rs[r]; if (MODE == 1) s = s / sqrtf(ssq[r] * (1.0f / 2048.0f) + eps);
                bf16_t* rowp = O + (size_t)r * ldc + col0;
#pragma unroll
                for (int bj = 0; bj < 2; ++bj) { f32x4 v0, v1; const i32x4 i0 = __builtin_bit_cast(i32x4, acc[ai][bj][m][0]), i1 = __builtin_bit_cast(i32x4, acc[ai][bj][m][1]);
#pragma unroll
                    for (int e = 0; e < 4; ++e) { v0[e] = (float)i0[e] * s * c4[bj][0][e]; v1[e] = (float)i1[e] * s * c4[bj][1][e]; }
                    u32x4 w; w.x = cvt_pk_bf16(v0[0], v0[1]); w.y = cvt_pk_bf16(v0[2], v0[3]); w.z = cvt_pk_bf16(v1[0], v1[1]); w.w = cvt_pk_bf16(v1[2], v1[3]);
                    *(u32x4*)(rowp + bj * HALF) = w; } }
    }
};
struct EpiResidual {
    static constexpr bool PERM = false, AFTER_DRAIN = false;
    const float* base; bf16_t* outb; int ldc;
    __device__ __forceinline__ void operator()(const f32x4 (&acc)[2][2][4][2], const Unit& u, int wr, int wc, int fr, int fq) const {
        const int row0 = u.pm * BM + wr * 64 + fr, col0 = u.pn * BM + wc * 32 + 4 * fq;
#pragma unroll
        for (int ai = 0; ai < 2; ++ai)
#pragma unroll
            for (int m = 0; m < 4; ++m) { const int r = row0 + ai * HALF + m * 16; const size_t off = (size_t)r * ldc + col0;
#pragma unroll
                for (int bj = 0; bj < 2; ++bj)
#pragma unroll
                    for (int n = 0; n < 2; ++n) { const f32x4 bs = *(const f32x4*)(base + off + bj * HALF + n * 16); const f32x4 o = bs + acc[ai][bj][m][n];
                        u32x2 w; w.x = cvt_pk_bf16(o[0], o[1]); w.y = cvt_pk_bf16(o[2], o[3]); *(u32x2*)(outb + off + bj * HALF + n * 16) = w; } }
    }
};
struct EpiI8Residual {
    static constexpr bool PERM = true, AFTER_DRAIN = false;
    const unsigned char* x8; const float* xs; bf16_t* outb; int ldc; const float* rs; const float* cs;
    __device__ __forceinline__ void operator()(const f32x4 (&acc)[2][2][4][2], const Unit& u, int wr, int wc, int fr, int fq) const {
        const int row0 = u.pm * BM + wr * 64 + fr, col0 = u.pn * BM + wc * 32 + 8 * fq;
        f32x4 c4[2][2];
#pragma unroll
        for (int bj = 0; bj < 2; ++bj) { c4[bj][0] = *(const f32x4*)(cs + col0 + bj * HALF); c4[bj][1] = *(const f32x4*)(cs + col0 + bj * HALF + 4); }
#pragma unroll
        for (int ai = 0; ai < 2; ++ai)
#pragma unroll
            for (int m = 0; m < 4; ++m) { const int r = row0 + ai * HALF + m * 16; const float s = rs[r], sx = xs[r]; const size_t off = (size_t)r * ldc + col0;
#pragma unroll
                for (int bj = 0; bj < 2; ++bj) { const i32x4 i0 = __builtin_bit_cast(i32x4, acc[ai][bj][m][0]), i1 = __builtin_bit_cast(i32x4, acc[ai][bj][m][1]);
                    const u32x2 xb = *(const u32x2*)(x8 + off + bj * HALF); f32x4 v0, v1;
#pragma unroll
                    for (int e = 0; e < 4; ++e) { v0[e] = (float)((int)(xb.x << (24 - 8 * e)) >> 24) * sx + (float)i0[e] * s * c4[bj][0][e]; v1[e] = (float)((int)(xb.y << (24 - 8 * e)) >> 24) * sx + (float)i1[e] * s * c4[bj][1][e]; }
                    u32x4 w; w.x = cvt_pk_bf16(v0[0], v0[1]); w.y = cvt_pk_bf16(v0[2], v0[3]); w.z = cvt_pk_bf16(v1[0], v1[1]); w.w = cvt_pk_bf16(v1[2], v1[3]);
                    *(u32x4*)(outb + off + bj * HALF) = w; } }
    }
};
template <class Epi, class Sched, bool ALIGN_EPI = false, bool SP2 = false, bool I8 = false>
__device__ __forceinline__ void gemm_phase(PG8_LAS unsigned char* lds, const Gemm g, const Sched& S, const Epi& E) {
    const int tid = threadIdx.x, wid = __builtin_amdgcn_readfirstlane(tid >> 6), lane = tid & 63, wr = wid >> 2, wc = wid & 3, fr = lane & 15, fq = lane >> 4;
    const int K = g.K, nt = K / BK;
    unsigned voffA[2], voffB[2];
#pragma unroll
    for (int i = 0; i < 2; ++i) { int R, C; stage_rc(tid * 16 + i * 8192, R, C); const int Rb = Epi::PERM ? ((R & ~31) + perm32(R & 31)) : R;
        voffA[i] = (unsigned)(R * K + C) * 2u; voffB[i] = (unsigned)(Rb * K + C) * 2u; }
    const size_t kstep = (size_t)(BK * 2);
    const size_t hstep = (size_t)HALF * K * 2;
    const size_t tstep = 2 * hstep;
    const unsigned ldsw = (unsigned)wid * 1024u;
    const int aoff = lds_byte(wr * 64 + fr, fq * 8), boff = lds_byte(wc * 32 + fr, fq * 8);
#define PG8_SA(b, h) (((b) * 2 + (h)) * HTB)
#define PG8_SB(b, h) ((4 + (b) * 2 + (h)) * HTB)
#define PG8_STAGE(bufoff, gbase, voff) do { _Pragma("unroll") for (int _i = 0; _i < 2; ++_i) \
        __builtin_amdgcn_global_load_lds((const unsigned*)((const char*)(gbase) + (voff)[_i]), (PG8_LAS unsigned*)(lds + (bufoff) + ldsw + _i * 8192), 16, 0, 0); } while (0)
#define PG8_LDA(dst, b, h) do { _Pragma("unroll") for (int m = 0; m < 4; ++m) _Pragma("unroll") for (int k = 0; k < 2; ++k) dst[m][k] = *(const PG8_LAS bf16x8*)(lds + PG8_SA(b, h) + aoff + m * 2048 + k * 1024); } while (0)
#define PG8_LDB(dst, b, h) do { _Pragma("unroll") for (int n = 0; n < 2; ++n) _Pragma("unroll") for (int k = 0; k < 2; ++k) dst[n][k] = *(const PG8_LAS bf16x8*)(lds + PG8_SB(b, h) + boff + n * 2048 + k * 1024); } while (0)
#define PG8_MMA(ai, bj, At, Bt) do { __builtin_amdgcn_s_setprio(1); _Pragma("unroll") for (int m = 0; m < 4; ++m) _Pragma("unroll") for (int n = 0; n < 2; ++n) _Pragma("unroll") for (int k = 0; k < 2; ++k) \
        { if constexpr (I8) acc[ai][bj][m][n] = __builtin_bit_cast(f32x4, __builtin_amdgcn_mfma_i32_16x16x64_i8(__builtin_bit_cast(i32x4, Bt[n][k]), __builtin_bit_cast(i32x4, At[m][k]), __builtin_bit_cast(i32x4, acc[ai][bj][m][n]), 0, 0, 0)); \
          else acc[ai][bj][m][n] = __builtin_amdgcn_mfma_f32_16x16x32_bf16(Bt[n][k], At[m][k], acc[ai][bj][m][n], 0, 0, 0); } __builtin_amdgcn_s_setprio(0); } while (0)
#define PG8_WAIT_V(n) asm volatile("s_waitcnt vmcnt(" #n ")" ::: "memory")
#define PG8_WAIT_L(n) asm volatile("s_waitcnt lgkmcnt(" #n ")" ::: "memory")
#define PG8_BAR __builtin_amdgcn_s_barrier()
#define PG8_SCHED __builtin_amdgcn_sched_barrier(0)
    Unit cur, nxt; int ui = 0;
    if (!S.next(0, cur)) return;
    f32x4 acc[2][2][4][2];
#pragma unroll
    for (int a = 0; a < 2; ++a)
#pragma unroll
        for (int b = 0; b < 2; ++b)
#pragma unroll
            for (int m = 0; m < 4; ++m)
#pragma unroll
                for (int n = 0; n < 2; ++n) acc[a][b][m][n] = (f32x4){0.f, 0.f, 0.f, 0.f};
    bf16x8 At[4][2], B0[2][2], B1[2][2];
    const char* cA = (const char*)g.A + (size_t)cur.pm * tstep; const char* cB = (const char*)g.Bt + (size_t)cur.pn * tstep;
    S.a_ready(cur);
    if constexpr (SP2) {
        PG8_STAGE(PG8_SB(0, 0), cB, voffB); PG8_STAGE(PG8_SB(0, 1), cB + hstep, voffB); PG8_STAGE(PG8_SA(0, 0), cA, voffA); PG8_STAGE(PG8_SA(0, 1), cA + hstep, voffA);
        if (wr == 1) PG8_BAR;
        PG8_WAIT_V(2); PG8_BAR;
        PG8_STAGE(PG8_SB(1, 0), cB + kstep, voffB); PG8_STAGE(PG8_SA(1, 0), cA + kstep, voffA); PG8_STAGE(PG8_SB(1, 1), cB + hstep + kstep, voffB);
        PG8_WAIT_V(6); PG8_BAR;
    } else {
        PG8_STAGE(PG8_SB(0, 0), cB, voffB); PG8_STAGE(PG8_SA(0, 0), cA, voffA); PG8_STAGE(PG8_SB(0, 1), cB + hstep, voffB); PG8_STAGE(PG8_SA(0, 1), cA + hstep, voffA);
        if (wr == 1) PG8_BAR;
        PG8_WAIT_V(4); PG8_BAR;
        PG8_STAGE(PG8_SB(1, 0), cB + kstep, voffB); PG8_STAGE(PG8_SA(1, 0), cA + kstep, voffA); PG8_STAGE(PG8_SB(1, 1), cB + hstep + kstep, voffB);
        PG8_WAIT_V(6); PG8_BAR;
    }
    for (;;) {
        const bool has_next = S.next(ui + 1, nxt);
        const char* nA = has_next ? (const char*)g.A + (size_t)nxt.pm * tstep : cA; const char* nB = has_next ? (const char*)g.Bt + (size_t)nxt.pn * tstep : cB;
        for (int t = 0; t < nt; t += 2) {
            const bool last = (t == nt - 2);
            const char* a1 = cA + (size_t)(t + 1) * kstep;
            const char* a2 = last ? nA : cA + (size_t)(t + 2) * kstep; const char* b2 = last ? nB : cB + (size_t)(t + 2) * kstep;
            const char* a3 = a2 + kstep; const char* b3 = b2 + kstep;
            if (last && has_next) S.a_ready(nxt);
            if constexpr (SP2) {
            PG8_LDB(B0, 0, 0); PG8_LDB(B1, 0, 1); PG8_SCHED; PG8_LDA(At, 0, 0); PG8_STAGE(PG8_SA(1, 1), a1 + hstep, voffA);
            PG8_WAIT_V(8); PG8_WAIT_L(0); PG8_BAR; PG8_MMA(0, 0, At, B0); PG8_MMA(0, 1, At, B1); PG8_BAR; PG8_SCHED;
            PG8_LDA(At, 0, 1); PG8_STAGE(PG8_SB(0, 0), b2, voffB); PG8_STAGE(PG8_SB(0, 1), b2 + hstep, voffB); PG8_STAGE(PG8_SA(0, 0), a2, voffA);
            PG8_WAIT_V(8); PG8_WAIT_L(0); PG8_BAR; PG8_MMA(1, 0, At, B0); PG8_MMA(1, 1, At, B1); PG8_BAR; PG8_SCHED;
            PG8_LDB(B0, 1, 0); PG8_LDB(B1, 1, 1); PG8_SCHED; PG8_LDA(At, 1, 0); PG8_STAGE(PG8_SA(0, 1), a2 + hstep, voffA);
            PG8_WAIT_V(8); PG8_WAIT_L(0); PG8_BAR; PG8_MMA(0, 0, At, B0); PG8_MMA(0, 1, At, B1); PG8_BAR; PG8_SCHED;
            PG8_LDA(At, 1, 1); PG8_STAGE(PG8_SB(1, 0), b3, voffB); PG8_STAGE(PG8_SB(1, 1), b3 + hstep, voffB); PG8_STAGE(PG8_SA(1, 0), a3, voffA);
            PG8_WAIT_V(8); PG8_WAIT_L(0); PG8_BAR; PG8_MMA(1, 0, At, B0); PG8_MMA(1, 1, At, B1); PG8_BAR; PG8_SCHED;
            } else {
            PG8_LDB(B0, 0, 0); PG8_SCHED; PG8_LDA(At, 0, 0); PG8_STAGE(PG8_SA(1, 1), a1 + hstep, voffA);
            PG8_WAIT_L(8); PG8_BAR; PG8_WAIT_L(0); PG8_MMA(0, 0, At, B0); PG8_BAR; PG8_SCHED;
            PG8_LDB(B1, 0, 1); PG8_STAGE(PG8_SB(0, 0), b2, voffB);
            PG8_BAR; PG8_WAIT_L(0); PG8_MMA(0, 1, At, B1); PG8_BAR;
            PG8_LDA(At, 0, 1); PG8_STAGE(PG8_SA(0, 0), a2, voffA);
            PG8_BAR; PG8_WAIT_L(0); PG8_MMA(1, 0, At, B0); PG8_BAR; PG8_SCHED;
            PG8_STAGE(PG8_SB(0, 1), b2 + hstep, voffB);
            PG8_WAIT_V(6); PG8_BAR; PG8_MMA(1, 1, At, B1); PG8_BAR;
            PG8_LDB(B0, 1, 0); PG8_SCHED; PG8_LDA(At, 1, 0); PG8_STAGE(PG8_SA(0, 1), a2 + hstep, voffA);
            PG8_WAIT_L(8); PG8_BAR; PG8_WAIT_L(0); PG8_MMA(0, 0, At, B0); PG8_BAR; PG8_SCHED;
            PG8_LDB(B1, 1, 1); PG8_STAGE(PG8_SB(1, 0), b3, voffB);
            PG8_BAR; PG8_WAIT_L(0); PG8_MMA(0, 1, At, B1); PG8_BAR;
            PG8_LDA(At, 1, 1); PG8_STAGE(PG8_SA(1, 0), a3, voffA);
            PG8_BAR; PG8_WAIT_L(0); PG8_MMA(1, 0, At, B0); PG8_BAR; PG8_SCHED;
            PG8_STAGE(PG8_SB(1, 1), b3 + hstep, voffB);
            PG8_WAIT_V(6); PG8_BAR; PG8_MMA(1, 1, At, B1); PG8_BAR;
            }
        }
        if constexpr (ALIGN_EPI) { if (wr == 0) PG8_BAR; }
        if constexpr (!Epi::AFTER_DRAIN) { E(acc, cur, wr, wc, fr, fq); S.done(cur); }
        if (!has_next) break;
#pragma unroll
        for (int a = 0; a < 2; ++a)
#pragma unroll
            for (int b = 0; b < 2; ++b)
#pragma unroll
                for (int m = 0; m < 4; ++m)
#pragma unroll
                    for (int n = 0; n < 2; ++n) acc[a][b][m][n] = (f32x4){0.f, 0.f, 0.f, 0.f};
        cur = nxt; cA = nA; cB = nB; ++ui;
        if constexpr (ALIGN_EPI) { if (wr == 1) PG8_BAR; }
    }
    PG8_WAIT_V(0);
    if constexpr (!ALIGN_EPI) { if (wr == 0) PG8_BAR; }
    PG8_BAR;
    if constexpr (Epi::AFTER_DRAIN) { E.fused(acc, cur, wr, wc, fr, fq, lds, wid, lane); S.done(cur); }
#undef PG8_SA
#undef PG8_SB
#undef PG8_STAGE
#undef PG8_LDA
#undef PG8_LDB
#undef PG8_MMA
#undef PG8_WAIT_V
#undef PG8_WAIT_L
#undef PG8_BAR
#undef PG8_SCHED
}
}

#ifndef PROBE_DUP
#define PROBE_DUP -1
#endif
constexpr int NWAVES = 8, NTHR = NWAVES * 64;
#ifndef MK_N_LAUNCHES
#define MK_N_LAUNCHES 1
#endif
constexpr int N_PHASES = 11;
constexpr int DEF_SLICES = 256;
constexpr int N_LAUNCHES = MK_N_LAUNCHES;
static_assert(N_LAUNCHES == 1 || N_LAUNCHES == N_PHASES, "MK_N_LAUNCHES is 1 or N_PHASES");

constexpr int BATCH = 8, SEQ = 2048, T = BATCH * SEQ, D = 2048;
constexpr int NIN = 5408, NINP = 5632;
constexpr int PC_GATE = 1024, PC_R = 2048, PC_K = 3072, PC_V = 4096, PC_WD = 5120, PC_AD = 5184, PC_GD = 5248;
constexpr int RWKV_C0 = 2048;
constexpr int NEXP = 16384, NSEL = 128;
constexpr float NORM_EPS = 1e-6f, GN_EPS = 64e-5f;

constexpr size_t MiB = 1u << 20;
constexpr size_t WS_CTL = 0, CTL_ZERO_BYTES = 1 * MiB;
constexpr size_t WS_SSQ3 = 576 * 1024;
constexpr size_t WS_SSQ2 = 512 * 1024;
constexpr size_t WS_RSTD1 = 1 * MiB;
constexpr size_t WS_USC = 1 * MiB + 64 * 1024, WS_VSC = 1 * MiB + 128 * 1024;
constexpr size_t WS_SX = 1 * MiB + 192 * 1024;
constexpr size_t WS_CS1 = 1 * MiB + 256 * 1024;
constexpr size_t WS_CSQ = 1 * MiB + 288 * 1024;
constexpr size_t WS_CSO = 1 * MiB + 296 * 1024;
constexpr size_t WS_SY = 1 * MiB + 320 * 1024;
constexpr size_t WS_SX0 = 1 * MiB + 384 * 1024;
constexpr size_t WS_WIN = 2 * MiB;
constexpr size_t WS_WOUT = 24 * MiB;
constexpr size_t WS_WQ = 32 * MiB;
constexpr size_t WS_KEYS = 40 * MiB;
constexpr size_t WS_W2T = WS_KEYS + 512 * 1024;
constexpr size_t WS_A2T = WS_W2T + 128 * 1024;
constexpr size_t WS_G2T = WS_A2T + 128 * 1024;
constexpr size_t WS_WAT = WS_G2T + 320 * 1024;
constexpr size_t WS_WIT = WS_WAT + 256 * 1024;
constexpr size_t WS_EXP = 42 * MiB;
constexpr size_t WS_GATE = 50 * MiB;
constexpr size_t WS_LA = 42 * MiB;
constexpr size_t WS_SUMM = 58 * MiB;
constexpr size_t WS_TA = 64 * MiB, WS_TB = 96 * MiB, WS_TK = 400 * MiB, WS_TR = 464 * MiB;
constexpr size_t OUT_X8 = 72 * MiB;
constexpr size_t OUT_TV = 0, OUT_TG = 32 * MiB, OUT_PC = 64 * MiB, OUT_BON = 66 * MiB;
constexpr size_t WS_XB = 64 * MiB;
constexpr size_t WS_PROJ = 128 * MiB;
constexpr size_t WS_Q = WS_PROJ;
constexpr size_t WS_YQ = WS_PROJ;
constexpr size_t WS_PART = 192 * MiB;
constexpr size_t WS_XQ = 320 * MiB;
constexpr size_t WS_COEF = 352 * MiB;
constexpr size_t WS_CSC = 356 * MiB;
constexpr size_t WS_Y = 304 * MiB;
constexpr size_t WS_UT = 368 * MiB;
constexpr size_t WS_VT = 432 * MiB;
constexpr size_t WS_END = 496 * MiB;
static_assert(WS_WIT + 256 * 1024 <= WS_EXP && WS_PROJ + (size_t)T * NINP * 2 <= WS_Y && WS_WIN + (size_t)NINP * D * 2 <= WS_WOUT, "d_ws map");
constexpr int CW_DEFQ = 2240;
constexpr int CW_PREPBAR = 2176;
constexpr int CW_PREBAR = 2112;
constexpr int CW_LRUBAR = 2048;
constexpr int CW_BAR = 4096;

constexpr int RING_BYTES = 131072;
constexpr int LDSCTL_OFF = 143360, MISC_OFF = LDSCTL_OFF + 320;
constexpr int LDS_BYTES = 147456;

#define GAS __attribute__((address_space(1)))
#define LAS __attribute__((address_space(3)))
typedef unsigned short bf16;
typedef unsigned v4u __attribute__((ext_vector_type(4)));
typedef unsigned v2u __attribute__((ext_vector_type(2)));
typedef float f32x4 __attribute__((ext_vector_type(4)));
typedef float f32x16 __attribute__((ext_vector_type(16)));
typedef short bf16x8 __attribute__((ext_vector_type(8)));
typedef __bf16 bf16x2_t __attribute__((ext_vector_type(2)));
typedef GAS unsigned gu32;
#define RLX_AGENT __ATOMIC_RELAXED, __HIP_MEMORY_SCOPE_AGENT
__device__ __forceinline__ unsigned f2bf(float f) { unsigned u = __builtin_bit_cast(unsigned, f); return (u + 0x7fffu + ((u >> 16) & 1u)) >> 16; }
__device__ __forceinline__ unsigned pk2(float lo, float hi) { return f2bf(lo) | (f2bf(hi) << 16); }
__device__ __forceinline__ float bf_lo(unsigned w) { return __uint_as_float(w << 16); }
__device__ __forceinline__ float bf_hi(unsigned w) { return __uint_as_float(w & 0xffff0000u); }
__device__ __forceinline__ void unpack8(const v4u& w, float (&o)[8]) { o[0] = bf_lo(w.x); o[1] = bf_hi(w.x); o[2] = bf_lo(w.y); o[3] = bf_hi(w.y); o[4] = bf_lo(w.z); o[5] = bf_hi(w.z); o[6] = bf_lo(w.w); o[7] = bf_hi(w.w); }
__device__ __forceinline__ v4u pack8(const float (&o)[8]) { v4u w; w.x = pk2(o[0], o[1]); w.y = pk2(o[2], o[3]); w.z = pk2(o[4], o[5]); w.w = pk2(o[6], o[7]); return w; }
__device__ __forceinline__ float sigmoidf_(float x) { return 1.0f / (1.0f + __expf(-x)); }
__device__ __forceinline__ float softplusf_(float z) { return fmaxf(z, 0.f) + log1pf(__expf(-fabsf(z))); }
__device__ __forceinline__ float gelu_tanh(float x) { const float u = 0.7978845608028654f * (x + 0.044715f * x * x * x); return 0.5f * x * (1.0f + tanhf(u)); }
template <int CTRL> __device__ __forceinline__ float dppf(float x) { return __builtin_bit_cast(float, __builtin_amdgcn_mov_dpp(__builtin_bit_cast(int, x), CTRL, 0xf, 0xf, true)); }
__device__ __forceinline__ float red8(float v) { v += dppf<0xB1>(v); v += dppf<0x4E>(v); v += dppf<0x141>(v); return v; }
__device__ __forceinline__ float red16(float v) { v = red8(v); v += dppf<0x140>(v); return v; }
__device__ __forceinline__ float wave_sum(float v) {
#pragma unroll
    for (int o = 1; o < 64; o <<= 1) v += __shfl_xor(v, o);
    return v;
}
__device__ __forceinline__ float dot2bf(unsigned a, unsigned b, float acc) { return __builtin_amdgcn_fdot2_f32_bf16(__builtin_bit_cast(bf16x2_t, a), __builtin_bit_cast(bf16x2_t, b), acc, false); }
#define MFMA16(a, b, c) __builtin_amdgcn_mfma_f32_16x16x32_bf16((a), (b), (c), 0, 0, 0)
#define MFMA32(a, b, c) __builtin_amdgcn_mfma_f32_32x32x16_bf16((a), (b), (c), 0, 0, 0)

#define XB_TMO      128
#define XB_XCNT(j)  (256  + 64 * (j))
#define XB_XSUB(j)  (1280 + 64 * (j))
#define XB_XGEN(j)  (2304 + 64 * (j))
#define XB_TOP      3328
#define XB_TOPGEN   3392
#define XCD_BAR_WORDS 3456
#define XB_SPIN_CAP (1u << 22)
__device__ __forceinline__ unsigned xb_ld(unsigned* p)              { return __hip_atomic_load(p, __ATOMIC_RELAXED, __HIP_MEMORY_SCOPE_AGENT); }
__device__ __forceinline__ unsigned xb_add(unsigned* p, unsigned v) { return __hip_atomic_fetch_add(p, v, __ATOMIC_RELAXED, __HIP_MEMORY_SCOPE_AGENT); }
__device__ __forceinline__ unsigned xb_xcc_id() { return (unsigned)__builtin_amdgcn_s_getreg((3 << 11) | 20) & 0xFu; }
#define XB_SPIN(cond, bar) do { unsigned _sp = 0; while (cond) { __builtin_amdgcn_s_sleep(1); \
    if ((++_sp & 255u) == 0u) { if (xb_ld(&(bar)[XB_TMO])) break; if (_sp > XB_SPIN_CAP) { atomicAdd(&(bar)[XB_TMO], 1u); break; } } } } while (0)
struct XcdBarrier { unsigned* bar; unsigned x; volatile LAS unsigned* st; };
__device__ __forceinline__ XcdBarrier xcd_barrier_post(unsigned* bar, volatile LAS unsigned* st) {
    XcdBarrier b; b.bar = bar; b.x = xb_xcc_id(); b.st = st;
    if (threadIdx.x == 0) (void)xb_add(&bar[XB_XCNT(b.x)], 1u);
    return b;
}
__device__ __forceinline__ void xcd_barrier_complete(unsigned* bar, unsigned x, unsigned& nloc, unsigned& nx) {
    const unsigned G = gridDim.x * gridDim.y * gridDim.z;
    unsigned sum, cnt, mine, sp = 0u;
    for (;;) {
        sum = 0u; cnt = 0u; mine = 0u;
#pragma unroll
        for (unsigned j = 0; j < 16; ++j) { const unsigned c = xb_ld(&bar[XB_XCNT(j)]); sum += c; cnt += (c > 0u) ? 1u : 0u; mine = (j == x) ? c : mine; }
        if (sum == G) break;
        __builtin_amdgcn_s_sleep(1);
        if ((++sp & 255u) == 0u) { if (xb_ld(&bar[XB_TMO])) break; if (sp > XB_SPIN_CAP) { atomicAdd(&bar[XB_TMO], 1u); break; } }
    }
    nloc = mine > 0u ? mine : 1u; nx = cnt > 0u ? cnt : 1u;
}
__device__ __forceinline__ void xcd_barrier(const XcdBarrier& b) {
    asm volatile("s_waitcnt vmcnt(0)" ::: "memory");
    __syncthreads();
    if (threadIdx.x == 0) {
        unsigned* bar = b.bar;
        __builtin_amdgcn_s_waitcnt(0);
        unsigned nloc = b.st[0], nx = b.st[1];
        if (nloc == 0u) { xcd_barrier_complete(bar, b.x, nloc, nx); b.st[0] = nloc; b.st[1] = nx; }
        const unsigned old = xb_add(&bar[XB_XSUB(b.x)], 1u);
        const unsigned gen = old / nloc;
        if (old + 1u == (gen + 1u) * nloc) {
            __builtin_amdgcn_fence(__ATOMIC_RELEASE, "agent");
            asm volatile("s_waitcnt vmcnt(0)" ::: "memory");
            const unsigned og = xb_add(&bar[XB_TOP], 1u);
            const unsigned tg = og / nx;
            if (og + 1u == (tg + 1u) * nx) xb_add(&bar[XB_TOPGEN], 1u);
            else XB_SPIN(xb_ld(&bar[XB_TOPGEN]) == tg, bar);
            __builtin_amdgcn_fence(__ATOMIC_ACQUIRE, "agent");
            xb_add(&bar[XB_XGEN(b.x)], 1u);
            asm volatile("s_waitcnt vmcnt(0)" ::: "memory");
        } else {
            XB_SPIN(xb_ld(&bar[XB_XGEN(b.x)]) == gen, bar);
            __builtin_amdgcn_fence(__ATOMIC_ACQUIRE, "agent");
            asm volatile("s_waitcnt vmcnt(0)" ::: "memory");
        }
    }
    __syncthreads();
}

struct Frame {
    LAS unsigned char* lds;
    int tid, lane, wave, G, bid;
    const float* in[28];
    float* out;
    unsigned char* ws;
};
#define WSP(type, off) ((type*)(F.ws + (off)))
enum { I_X = 0, I_G1, I_WIN, I_CONVW, I_CONVB, I_WA, I_BA, I_WI, I_BI, I_LAM, I_MU, I_W0, I_W2, I_A0, I_A2, I_G2, I_KK, I_KA, I_RK, I_LNW, I_LNB, I_WOUT, I_G2N, I_WQ, I_KEYS, I_U, I_V, I_GF };

__device__ __forceinline__ void p0_transpose_item(const float* W, int K, int N, bf16* WT, const float* ksc, LAS float* scr, int item, int lane) {
    const int nblk = N / 32, kb = item / nblk, nb = item % nblk, k0 = 64 * kb, n0 = 32 * nb;
    const int lr = lane >> 3, c4 = (lane & 7) * 4;
    f32x4 v[8];
#pragma unroll
    for (int i = 0; i < 8; ++i) v[i] = *(const f32x4*)(W + (size_t)(k0 + 8 * i + lr) * N + n0 + c4);
#pragma unroll
    for (int i = 0; i < 8; ++i) { const int kk = 8 * i + lr; const float sc = ksc ? ksc[k0 + kk] : 1.0f; LAS float* d = scr + kk * 33 + c4; d[0] = v[i][0] * sc; d[1] = v[i][1] * sc; d[2] = v[i][2] * sc; d[3] = v[i][3] * sc; }
    asm volatile("s_waitcnt lgkmcnt(0)" ::: "memory");
    const int c = lane & 7;
#pragma unroll
    for (int j = 0; j < 4; ++j) { const int n = (lane >> 3) + 8 * j; const LAS float* s = scr + (8 * c) * 33 + n;
        v4u o; o.x = pk2(s[0 * 33], s[1 * 33]); o.y = pk2(s[2 * 33], s[3 * 33]); o.z = pk2(s[4 * 33], s[5 * 33]); o.w = pk2(s[6 * 33], s[7 * 33]);
        *(v4u*)(WT + (size_t)(n0 + n) * K + k0 + 8 * c) = o; }
    asm volatile("s_waitcnt lgkmcnt(0)" ::: "memory");
}
template <bool HASK> __device__ __forceinline__ void p0_wquant_block(const float* W, int N, unsigned char* WT8, float* cs, const float* ksc, int item, int wave, int lane, LAS float* mxs) {
    asm volatile("" : "+v"(lane));
    const int n0 = item * 32, r = lane >> 3, c4 = lane & 7, kb = 256 * wave + 4 * r;
    const float* src = W + (size_t)kb * N + n0 + 4 * c4; const float* kp = ksc + kb;
    f32x4 mx = (f32x4){0.f, 0.f, 0.f, 0.f};
#pragma unroll
    for (int i2 = 0; i2 < 2; ++i2) { f32x4 v[4][4], g4[4];
#pragma unroll
        for (int ii = 0; ii < 4; ++ii) { g4[ii] = HASK ? *(const f32x4*)(kp + 32 * (i2 * 4 + ii)) : (f32x4){1.f, 1.f, 1.f, 1.f};
#pragma unroll
            for (int j = 0; j < 4; ++j) v[ii][j] = *(const f32x4*)(src + (size_t)(32 * (i2 * 4 + ii) + j) * N); }
#pragma unroll
        for (int ii = 0; ii < 4; ++ii)
#pragma unroll
            for (int j = 0; j < 4; ++j)
#pragma unroll
                for (int e = 0; e < 4; ++e) mx[e] = fmaxf(mx[e], fabsf(v[ii][j][e] * g4[ii][j])); }
#pragma unroll
    for (int o = 8; o < 64; o <<= 1)
#pragma unroll
        for (int e = 0; e < 4; ++e) mx[e] = fmaxf(mx[e], __shfl_xor(mx[e], o));
    if (r == 0) *(LAS f32x4*)(mxs + wave * 32 + 4 * c4) = mx;
    __syncthreads();
#pragma unroll
    for (int w = 0; w < NWAVES; ++w) { const f32x4 t = *(const LAS f32x4*)(mxs + w * 32 + 4 * c4);
#pragma unroll
        for (int e = 0; e < 4; ++e) mx[e] = fmaxf(mx[e], t[e]); }
    f32x4 q;
#pragma unroll
    for (int e = 0; e < 4; ++e) q[e] = mx[e] > 0.f ? 127.0f / mx[e] : 0.f;
    if (wave == 0 && r == 0) *(f32x4*)(cs + n0 + 4 * c4) = mx * (1.0f / 127.0f);
    unsigned char* dst = WT8 + (size_t)(n0 + 4 * c4) * 2048 + kb;
#pragma unroll
    for (int i2 = 0; i2 < 2; ++i2) { f32x4 v[4][4], g4[4];
#pragma unroll
        for (int ii = 0; ii < 4; ++ii) { g4[ii] = HASK ? *(const f32x4*)(kp + 32 * (i2 * 4 + ii)) : (f32x4){1.f, 1.f, 1.f, 1.f};
#pragma unroll
            for (int j = 0; j < 4; ++j) v[ii][j] = *(const f32x4*)(src + (size_t)(32 * (i2 * 4 + ii) + j) * N); }
#pragma unroll
        for (int ii = 0; ii < 4; ++ii) { unsigned w[4] = {0u, 0u, 0u, 0u};
#pragma unroll
            for (int j = 0; j < 4; ++j)
#pragma unroll
                for (int e = 0; e < 4; ++e) { const int qi = (int)rintf(v[ii][j][e] * g4[ii][j] * q[e]); w[e] |= ((unsigned)qi & 0xFFu) << (8 * j); }
#pragma unroll
            for (int e = 0; e < 4; ++e) *(unsigned*)(dst + (size_t)e * 2048 + 32 * (i2 * 4 + ii)) = w[e]; } }
    __syncthreads();
}
__device__ __forceinline__ void p0_small_transpose(const float* src, bf16* dst, int nb, int K, int N, int gt, int NGT) {
    const int tot = nb * K * N;
    for (int i = gt; i < tot; i += NGT) { const int bb = i / (K * N), r = i - bb * K * N, n = r / K, k = r - n * K; dst[i] = (bf16)f2bf(src[(size_t)bb * K * N + (size_t)k * N + n]); }
}
template <int PART> __device__ __forceinline__ void p0_prologue(const Frame& F, int vb, int VG) {
    LAS float* scr = (LAS float*)(F.lds + F.wave * 8448);
    const int gw = vb * NWAVES + F.wave, NGW = VG * NWAVES, gt = gw * 64 + F.lane, NGT = NGW * 64;
    constexpr int I1 = (D / 64) * (NIN / 32), I2 = (D / 64) * (D / 32);
    if (PART == 0) { for (int it = vb; it < NIN / 32; it += VG) p0_wquant_block<true>(F.in[I_WIN], NIN, WSP(unsigned char, WS_WIN), WSP(float, WS_CS1), F.in[I_G1], it, F.wave, F.lane, (LAS float*)(F.lds + 8 * 8448)); }
    else { const int sp = VG >= 64 ? VG / 64 : 1;
           for (int v = vb; v < sp * (D / 32); v += VG) {
               if (v % sp == 0) p0_wquant_block<false>(F.in[I_WQ], D, WSP(unsigned char, WS_WQ), WSP(float, WS_CSQ), nullptr, v / sp, F.wave, F.lane, (LAS float*)(F.lds + 8 * 8448));
               if (v % sp == sp / 2) p0_wquant_block<false>(F.in[I_WOUT], D, WSP(unsigned char, WS_WOUT), WSP(float, WS_CSO), nullptr, v / sp, F.wave, F.lane, (LAS float*)(F.lds + 8 * 8448)); } }
    if (PART == 0) {
    { v4u* z = (v4u*)(WSP(unsigned char, WS_WIN) + (size_t)NIN * D); const int nz = (NINP - NIN) * D / 16; for (int i = gt; i < nz; i += NGT) z[i] = (v4u){0u, 0u, 0u, 0u};
      for (int i = gt; i < NINP - NIN; i += NGT) WSP(float, WS_CS1)[NIN + i] = 0.f; }
    p0_small_transpose(F.in[I_W2], WSP(bf16, WS_W2T), 1, 64, 1024, gt, NGT);
    p0_small_transpose(F.in[I_A2], WSP(bf16, WS_A2T), 1, 64, 1024, gt, NGT);
    p0_small_transpose(F.in[I_G2], WSP(bf16, WS_G2T), 1, 160, 1024, gt, NGT);
    p0_small_transpose(F.in[I_WA], WSP(bf16, WS_WAT), 8, 128, 128, gt, NGT);
    p0_small_transpose(F.in[I_WI], WSP(bf16, WS_WIT), 8, 128, 128, gt, NGT);
    { const float* s = F.in[I_KEYS]; bf16* d = WSP(bf16, WS_KEYS); for (int i = gt; i < 8 * 2 * 128 * 128 / 8; i += NGT) { const f32x4 a = *(const f32x4*)(s + (size_t)i * 8), b = *(const f32x4*)(s + (size_t)i * 8 + 4);
        v4u o; o.x = pk2(a[0], a[1]); o.y = pk2(a[2], a[3]); o.z = pk2(b[0], b[1]); o.w = pk2(b[2], b[3]); *(v4u*)(d + (size_t)i * 8) = o; } }
    }
    if (PART == 0) {
    { const float* x = F.in[I_X]; unsigned char* xq = (unsigned char*)F.out + OUT_X8; float* rs1 = WSP(float, WS_RSTD1); float* sx0 = WSP(float, WS_SX0);
#define XR_LOAD(V_, row_) do { _Pragma("unroll") for (int hh_ = 0; hh_ < 2; ++hh_) _Pragma("unroll") for (int q_ = 0; q_ < 4; ++q_) V_[hh_][q_] = *(const f32x4*)(x + (size_t)(row_) * D + hh_ * 1024 + F.lane * 16 + q_ * 4); } while (0)
#define XR_QUANT(V_, row_) do { float s_ = 0.f, am_ = 0.f; \
          _Pragma("unroll") for (int hh_ = 0; hh_ < 2; ++hh_) _Pragma("unroll") for (int q_ = 0; q_ < 4; ++q_) _Pragma("unroll") for (int e_ = 0; e_ < 4; ++e_) { const float t_ = V_[hh_][q_][e_]; s_ += t_ * t_; am_ = fmaxf(am_, fabsf(t_)); } \
          s_ = wave_sum(s_); \
          _Pragma("unroll") for (int o_ = 1; o_ < 64; o_ <<= 1) am_ = fmaxf(am_, __shfl_xor(am_, o_)); \
          const float xq_ = am_ > 0.f ? 127.0f / am_ : 0.f; \
          if (F.lane == 0) { rs1[row_] = am_ * (1.0f / 127.0f) / sqrtf(s_ * (1.0f / D) + NORM_EPS); sx0[row_] = am_ * (1.0f / 127.0f); } \
          _Pragma("unroll") for (int hh_ = 0; hh_ < 2; ++hh_) { v4u o_; \
              _Pragma("unroll") for (int q_ = 0; q_ < 4; ++q_) { unsigned w_ = 0u; \
                  _Pragma("unroll") for (int e_ = 0; e_ < 4; ++e_) { const int qi_ = (int)rintf(V_[hh_][q_][e_] * xq_); w_ |= ((unsigned)qi_ & 0xFFu) << (8 * e_); } \
                  o_[q_] = w_; } \
              *(v4u*)(xq + (size_t)(row_) * D + hh_ * 1024 + F.lane * 16) = o_; } } while (0)
      for (int m = gw; m < T; m += 2 * NGW) { const int mB = m + NGW < T ? m + NGW : m;
          f32x4 xa[2][4], xb2[2][4];
          XR_LOAD(xa, m); XR_LOAD(xb2, mB);
          XR_QUANT(xa, m);
          if (mB != m) XR_QUANT(xb2, mB); }
#undef XR_LOAD
#undef XR_QUANT
    }
    }
}

typedef float f32x2c __attribute__((ext_vector_type(2)));
__device__ __forceinline__ unsigned cvtpk(float lo, float hi) { const f32x2c v = {lo, hi}; const bf16x2_t b = __builtin_convertvector(v, bf16x2_t); return __builtin_bit_cast(unsigned, b); }
__device__ __forceinline__ float rcpf_(float x) { return __builtin_amdgcn_rcpf(x); }
__device__ __forceinline__ float sigmoid_fast(float x) { return rcpf_(1.0f + __expf(-x)); }
__device__ __forceinline__ float tanh_fast(float x) { return 1.0f - 2.0f * rcpf_(1.0f + __expf(2.0f * x)); }
__device__ __forceinline__ float softplus_fast(float z) { return fmaxf(z, 0.f) + __logf(1.0f + __expf(-fabsf(z))); }
__device__ __forceinline__ float gelu_fast(float x) { const float u = 0.7978845608028654f * (x + 0.044715f * x * x * x); return x * rcpf_(1.0f + __expf(-2.0f * u)); }
__device__ __forceinline__ void rwkv_prep_unit(const Frame& F, int chunk, int h, int lane, const LAS bf16* WL2, const LAS bf16* AL2, const LAS bf16* GL2, const LAS float* CW, LAS bf16* ST) {
    asm volatile("" : "+v"(lane));
    const int fr = lane & 15, fq = lane >> 4;
    const bf16* PROJ = WSP(bf16, WS_PROJ); const bf16* LA = WSP(bf16, WS_LA);
    bf16* TA = WSP(bf16, WS_TA); bf16* TB = WSP(bf16, WS_TB); bf16* TK = WSP(bf16, WS_TK); bf16* TR = WSP(bf16, WS_TR);
    bf16* TV = (bf16*)F.out + OUT_TV / 2; bf16* TG = (bf16*)F.out + OUT_TG / 2; float* PCG = F.out + OUT_PC / 4; float* BONG = F.out + OUT_BON / 4;
#define PU4(w_) ((f32x4){bf_lo((w_).x), bf_hi((w_).x), bf_lo((w_).y), bf_hi((w_).y)})
    size_t tokm[2];
#pragma unroll
    for (int mt = 0; mt < 2; ++mt) tokm[mt] = (size_t)chunk * 32 + mt * 16 + fr;
    v2u cA[4][3], cB[4][3], eA[4][3];
    const bool hs = (chunk & 63) != 0; const unsigned hsm = hs ? 0xffffffffu : 0u; const size_t toke = (size_t)chunk * 32 - (hs ? 1 : 0);
#define PREP_LOAD_MT(C_, tok_) do { _Pragma("unroll") for (int nt_ = 0; nt_ < 4; ++nt_) { const bf16* pr_ = PROJ + (tok_) * NINP + PC_R + h * 64 + nt_ * 16 + fq * 4; \
        _Pragma("unroll") for (int q_ = 0; q_ < 3; ++q_) C_[nt_][q_] = *(const v2u*)(pr_ + q_ * 1024); } } while (0)
#define DPPU(old_, src_, ctl_) ((unsigned)__builtin_amdgcn_update_dpp((int)(old_), (int)(src_), ctl_, 0xf, 0xf, false))
#define PREP_PREV(dst_, mt_, nt_, q_) do { const v2u c_ = (mt_) ? cB[nt_][q_] : cA[nt_][q_]; v2u o_; \
        if (mt_) { o_.x = DPPU(0, cA[nt_][q_].x, 0x121); o_.y = DPPU(0, cA[nt_][q_].y, 0x121); } else { o_.x = eA[nt_][q_].x & hsm; o_.y = eA[nt_][q_].y & hsm; } \
        dst_.x = DPPU(o_.x, c_.x, 0x111); dst_.y = DPPU(o_.y, c_.y, 0x111); } while (0)
    PREP_LOAD_MT(cA, tokm[0]); PREP_LOAD_MT(eA, toke);
    bf16x8 la[9];
#pragma unroll
    for (int ks = 0; ks < 9; ++ks) la[ks] = *(const bf16x8*)(LA + tokm[0] * 288 + ks * 32 + 8 * fq);
    PREP_LOAD_MT(cB, tokm[1]);
    float inv[2], bn[2];
#pragma unroll
    for (int mt = 0; mt < 2; ++mt) { float s2 = 0.f;
#pragma unroll
        for (int nt = 0; nt < 4; ++nt) { const int j4 = nt * 16 + fq * 4;
            const v2u kc = mt ? cB[nt][1] : cA[nt][1]; v2u kp; PREP_PREV(kp, mt, nt, 1);
            const f32x4 c_kk = *(const LAS f32x4*)(CW + 128 + j4), m_k = *(const LAS f32x4*)(CW + 384 + j4);
            const f32x4 kcf = PU4(kc); const f32x4 ku = (kcf + (PU4(kp) - kcf) * m_k) * c_kk; s2 += (ku[0] * ku[0] + ku[1] * ku[1]) + (ku[2] * ku[2] + ku[3] * ku[3]); }
        { auto x = __builtin_amdgcn_permlane16_swap(__float_as_uint(s2), __float_as_uint(s2), false, false); s2 = __uint_as_float(x[0]) + __uint_as_float(x[1]); }
        { auto x = __builtin_amdgcn_permlane32_swap(__float_as_uint(s2), __float_as_uint(s2), false, false); s2 = __uint_as_float(x[0]) + __uint_as_float(x[1]); }
        inv[mt] = __builtin_amdgcn_rsqf(fmaxf(s2, 1e-24f)); bn[mt] = 0.f; }
    f32x4 tot0[4];
#pragma unroll
    for (int n = 0; n < 4; ++n) tot0[n] = (f32x4){0.f, 0.f, 0.f, 0.f};
#pragma unroll
    for (int st = 0; st < 8; ++st) { const int mt = st >> 2, nt = st & 3; const int j4 = nt * 16 + fq * 4; const size_t col = (size_t)h * 64 + j4;
        v2u cur_[3], prv_[3];
#pragma unroll
        for (int q = 0; q < 3; ++q) { cur_[q] = mt ? cB[nt][q] : cA[nt][q]; PREP_PREV(prv_[q], mt, nt, q); }
        f32x4 cw = (f32x4){0.f, 0.f, 0.f, 0.f}, ca = cw, cg = cw;
#pragma unroll
        for (int ks = 0; ks < 2; ++ks) { cw = MFMA16(*(const LAS bf16x8*)(WL2 + (nt * 16 + fr) * 72 + ks * 32 + 8 * fq), la[ks], cw); ca = MFMA16(*(const LAS bf16x8*)(AL2 + (nt * 16 + fr) * 72 + ks * 32 + 8 * fq), la[2 + ks], ca); }
#pragma unroll
        for (int ks = 0; ks < 5; ++ks) cg = MFMA16(*(const LAS bf16x8*)(GL2 + (nt * 16 + fr) * 168 + ks * 32 + 8 * fq), la[4 + ks], cg);
        if (st == 3) {
#pragma unroll
            for (int ks = 0; ks < 9; ++ks) la[ks] = *(const bf16x8*)(LA + tokm[1] * 288 + ks * 32 + 8 * fq); }
        const f32x4 c_w0 = *(const LAS f32x4*)(CW + j4), c_a0 = *(const LAS f32x4*)(CW + 64 + j4), c_kk = *(const LAS f32x4*)(CW + 128 + j4), c_ka = *(const LAS f32x4*)(CW + 192 + j4), c_rk = *(const LAS f32x4*)(CW + 256 + j4);
        const f32x4 m_r = *(const LAS f32x4*)(CW + 320 + j4), m_k = *(const LAS f32x4*)(CW + 384 + j4), m_v = *(const LAS f32x4*)(CW + 448 + j4);
        const v2u rp = prv_[0], kp = prv_[1], vp = prv_[2];
        const f32x4 rcf = PU4(cur_[0]), kcf = PU4(cur_[1]), vcf = PU4(cur_[2]);
        const f32x4 rr = rcf + (PU4(rp) - rcf) * m_r, kv = kcf + (PU4(kp) - kcf) * m_k, vv = vcf + (PU4(vp) - vcf) * m_v;
        f32x4 nau, bbu, km, cum;
#pragma unroll
        for (int r = 0; r < 4; ++r) { const float av = sigmoid_fast(c_a0[r] + ca[r]), ku = kv[r] * c_kk[r]; km[r] = kv[r] * (1.0f + (av - 1.0f) * c_ka[r]);
            cum[r] = -0.6065306597126334f * sigmoid_fast(c_w0[r] + cw[r]);
            nau[r] = -ku; bbu[r] = ku * av; bn[mt] += rr[r] * km[r] * c_rk[r]; }
        f32x4 at4, rt4, bt4, kt4, ep4;
#pragma unroll
        for (int r = 0; r < 4; ++r) { float v = cum[r];
            v += __builtin_bit_cast(float, __builtin_amdgcn_update_dpp(0, __builtin_bit_cast(int, v), 0x111, 0xf, 0xf, true));
            v += __builtin_bit_cast(float, __builtin_amdgcn_update_dpp(0, __builtin_bit_cast(int, v), 0x112, 0xf, 0xf, true));
            v += __builtin_bit_cast(float, __builtin_amdgcn_update_dpp(0, __builtin_bit_cast(int, v), 0x114, 0xf, 0xf, true));
            v += __builtin_bit_cast(float, __builtin_amdgcn_update_dpp(0, __builtin_bit_cast(int, v), 0x118, 0xf, 0xf, true));
            if (mt == 0) tot0[nt][r] = __shfl(v, (lane & 48) | 15); else v += tot0[nt][r];
            const float ep = __expf(v), em = rcpf_(ep);
            float eprev = __builtin_bit_cast(float, __builtin_amdgcn_update_dpp(0, __builtin_bit_cast(int, ep), 0x111, 0xf, 0xf, true));
            if (fr == 0) eprev = mt ? __expf(tot0[nt][r]) : 1.0f;
            at4[r] = nau[r] * inv[mt] * eprev; rt4[r] = rr[r] * ep; bt4[r] = bbu[r] * inv[mt] * em; kt4[r] = km[r] * em; ep4[r] = ep; }
        { LAS bf16* sp = ST + fr * 64 + j4; v2u w;
          w.x = cvtpk(at4[0], at4[1]); w.y = cvtpk(at4[2], at4[3]); *(LAS v2u*)(sp) = w;
          w.x = cvtpk(rt4[0], rt4[1]); w.y = cvtpk(rt4[2], rt4[3]); *(LAS v2u*)(sp + 1024) = w;
          w.x = cvtpk(bt4[0], bt4[1]); w.y = cvtpk(bt4[2], bt4[3]); *(LAS v2u*)(sp + 2048) = w;
          w.x = cvtpk(kt4[0], kt4[1]); w.y = cvtpk(kt4[2], kt4[3]); *(LAS v2u*)(sp + 3072) = w;
          w.x = cvtpk(vv[0], vv[1]); w.y = cvtpk(vv[2], vv[3]); *(LAS v2u*)(sp + 4096) = w;
          w.x = cvtpk(cg[0], cg[1]); w.y = cvtpk(cg[2], cg[3]); *(LAS v2u*)(sp + 5120) = w; }
        if (nt == 3) {
            bf16* const dstp[6] = {TA, TR, TB, TK, TV, TG};
#pragma unroll
            for (int a6 = 0; a6 < 6; ++a6)
#pragma unroll
                for (int hrow = 0; hrow < 2; ++hrow) { const int row = hrow * 8 + (lane >> 3), c8 = (lane & 7) * 8;
                    const v4u pv = *(const LAS v4u*)(ST + a6 * 1024 + row * 64 + c8);
                    *(v4u*)(dstp[a6] + ((size_t)chunk * 32 + mt * 16 + row) * 1024 + (size_t)h * 64 + c8) = pv; } }
        if (mt == 1 && fr == 15) *(f32x4*)(PCG + (size_t)chunk * 1024 + col) = ep4;
    }
#undef PREP_LOAD_MT
#undef PREP_PREV
#undef DPPU
#undef PU4
#pragma unroll
    for (int mt = 0; mt < 2; ++mt) { float b2 = bn[mt];
        { auto x = __builtin_amdgcn_permlane16_swap(__float_as_uint(b2), __float_as_uint(b2), false, false); b2 = __uint_as_float(x[0]) + __uint_as_float(x[1]); }
        { auto x = __builtin_amdgcn_permlane32_swap(__float_as_uint(b2), __float_as_uint(b2), false, false); b2 = __uint_as_float(x[0]) + __uint_as_float(x[1]); }
        if (fq == 0) BONG[tokm[mt] * 16 + h] = b2; }
}
__device__ __forceinline__ void rwkv_prep_phase(const Frame& F) {
    LAS bf16* WL2 = (LAS bf16*)(F.lds + 0); LAS bf16* AL2 = (LAS bf16*)(F.lds + 9216); LAS bf16* GL2 = (LAS bf16*)(F.lds + 18432); LAS float* CW = (LAS float*)(F.lds + 39936);
    int hcur = -1;
    for (int u = F.bid; u < 1024; u += F.G) { const int h = u & 15, cg = u >> 4;
        if (h != hcur) { hcur = h; __syncthreads();
            int tid_ = F.tid; asm volatile("" : "+v"(tid_));
            const bf16* w2t = WSP(bf16, WS_W2T) + (size_t)h * 64 * 64; const bf16* a2t = WSP(bf16, WS_A2T) + (size_t)h * 64 * 64; const bf16* g2t = WSP(bf16, WS_G2T) + (size_t)h * 64 * 160;
            { const int r = tid_ >> 3, c = (tid_ & 7) * 8; *(LAS v4u*)(WL2 + r * 72 + c) = *(const v4u*)(w2t + r * 64 + c); *(LAS v4u*)(AL2 + r * 72 + c) = *(const v4u*)(a2t + r * 64 + c); }
            for (int i = tid_; i < 64 * 20; i += NTHR) { const int r = i / 20, c = (i - r * 20) * 8; *(LAS v4u*)(GL2 + r * 168 + c) = *(const v4u*)(g2t + r * 160 + c); }
            { const int q = tid_ >> 6, jj = tid_ & 63; const float* src = q == 0 ? F.in[I_W0] : (q == 1 ? F.in[I_A0] : (q == 2 ? F.in[I_KK] : (q == 3 ? F.in[I_KA] : (q == 4 ? F.in[I_RK] : F.in[I_MU] + (q - 5) * 1024)))); CW[q * 64 + jj] = src[h * 64 + jj]; }
            __syncthreads(); }
        rwkv_prep_unit(F, cg * 8 + F.wave, h, F.lane, WL2, AL2, GL2, CW, (LAS bf16*)(F.lds + 43008 + F.wave * 12288)); }
    __syncthreads();
}
typedef short v4i16_t __attribute__((ext_vector_type(4)));
__device__ __forceinline__ bf16x8 frag_tr16(const LAS bf16* p, int ld) {
    const v4i16_t a = __builtin_amdgcn_ds_read_tr16_b64_v4i16((LAS v4i16_t*)p), b = __builtin_amdgcn_ds_read_tr16_b64_v4i16((LAS v4i16_t*)(p + 4 * ld));
    return (bf16x8){a[0], a[1], a[2], a[3], b[0], b[1], b[2], b[3]};
}
#define RD_LOAD(src_, act_, row0_, j_) do { const float* tp_ = (src_) + ((act_) ? ((size_t)((row0_) + ((j_) >> 1)) * D + ((j_) & 1) * 1024) : (size_t)0) + lane * 16; \
        _Pragma("unroll") for (int q_ = 0; q_ < 4; ++q_) th[q_] = *(const f32x4*)(tp_ + q_ * 4); } while (0)
#define RD_PACK(dst_, v_, tq_) do { _Pragma("unroll") for (int q_ = 0; q_ < 4; ++q_) {   \
            const unsigned b0_ = __float_as_uint(__builtin_fmaf(v_[q_][0], tq_, 12582912.0f)), b1_ = __float_as_uint(__builtin_fmaf(v_[q_][1], tq_, 12582912.0f)); \
            const unsigned b2_ = __float_as_uint(__builtin_fmaf(v_[q_][2], tq_, 12582912.0f)), b3_ = __float_as_uint(__builtin_fmaf(v_[q_][3], tq_, 12582912.0f)); \
            dst_[q_] = __builtin_amdgcn_perm(b1_, b0_, 0x0c0c0400u) | __builtin_amdgcn_perm(b3_, b2_, 0x04000c0cu); } } while (0)
#define RD_CONSUME(dstb_, scb_, row0_, j_) do { float am_ = 0.f; \
        _Pragma("unroll") for (int q_ = 0; q_ < 4; ++q_) _Pragma("unroll") for (int e_ = 0; e_ < 4; ++e_) am_ = fmaxf(am_, fabsf(th[q_][e_])); \
        if (((j_) & 1) == 0) { _Pragma("unroll") for (int q_ = 0; q_ < 4; ++q_) tk[q_] = th[q_]; tkm = am_; } \
        else { am_ = fmaxf(am_, tkm); \
            am_ = fmaxf(am_, dppf<0xB1>(am_)); am_ = fmaxf(am_, dppf<0x4E>(am_)); am_ = fmaxf(am_, dppf<0x141>(am_)); am_ = fmaxf(am_, dppf<0x140>(am_)); \
            { auto s_ = __builtin_amdgcn_permlane16_swap(__float_as_uint(am_), __float_as_uint(am_), false, false); am_ = fmaxf(__uint_as_float(s_[0]), __uint_as_float(s_[1])); } \
            { auto s_ = __builtin_amdgcn_permlane32_swap(__float_as_uint(am_), __float_as_uint(am_), false, false); am_ = fmaxf(__uint_as_float(s_[0]), __uint_as_float(s_[1])); } \
            const float tq_ = am_ > 0.f ? 127.0f / am_ : 0.f; const size_t ro_ = (size_t)((row0_) + ((j_) >> 1)); \
            if (lane == 0) (scb_)[ro_] = am_ * (1.0f / 127.0f); \
            v4u o0_, o1_; RD_PACK(o0_, tk, tq_); RD_PACK(o1_, th, tq_); \
            *(v4u*)((dstb_) + ro_ * D + lane * 16) = o0_; *(v4u*)((dstb_) + ro_ * D + 1024 + lane * 16) = o1_; } } while (0)
__device__ __forceinline__ void rwkv_item(const Frame& F, int item) {
    const int b = item >> 4, h = item & 15, wave = F.wave; int tid = F.tid; asm volatile("" : "+v"(tid)); const int lane = tid & 63;
    LAS unsigned char* L = F.lds;
    constexpr int LD64 = 72, LD32 = 40, E0 = 73216;
    LAS bf16* AT = (LAS bf16*)(L + 0);  LAS bf16* BT_ = (LAS bf16*)(L + 4608); LAS bf16* KT_ = (LAS bf16*)(L + 9216); LAS bf16* RT = (LAS bf16*)(L + 13824);
    LAS bf16* VS2 = (LAS bf16*)(L + 18432);
    LAS bf16* GGB2 = (LAS bf16*)(L + 27648);
    LAS bf16* S0B = (LAS bf16*)(L + 36864);
    LAS float* YB2 = (LAS float*)(L + 55296);
    LAS float* BON2 = (LAS float*)(L + 72704);
    LAS float* PC = (LAS float*)(L + 72960);
    LAS bf16* AAK = (LAS bf16*)(L + E0); LAS bf16* ARB = (LAS bf16*)(L + E0 + 2560); LAS bf16* ARK = (LAS bf16*)(L + E0 + 5120);
    LAS bf16* MINV = (LAS bf16*)(L + E0 + 7680);
    LAS bf16* RHS = (LAS bf16*)(L + E0 + 23040);
    LAS bf16* SAB = (LAS bf16*)(L + E0 + 28160);
    static_assert(E0 + 33280 <= LDSCTL_OFF, "rwkv LDS map");
    bf16* Y = WSP(bf16, WS_Y);
#define FRAG(base, row0, ld, ks) (*(const LAS bf16x8*)((base) + ((row0) + fr) * (ld) + (ks) * 32 + 8 * fq))
#define FRAGT(base, col0, ld) frag_tr16((base) + (8 * fq + (fr >> 2)) * (ld) + (col0) + 4 * (fr & 3), (ld))
    const int tt = tid >> 4, j0 = (tid & 15) * 4, hc = h * 64 + j0;
    const f32x4 plw = *(const f32x4*)(F.in[I_LNW] + hc), plb = *(const f32x4*)(F.in[I_LNB] + hc);
    const int lr = (tid & 255) >> 3, lc8 = tid & 7; const bool hi2 = tid >= 256;
    const bf16* srcA[3] = { (hi2 ? WSP(bf16, WS_TR) : WSP(bf16, WS_TA)), (hi2 ? WSP(bf16, WS_TK) : WSP(bf16, WS_TB)), (hi2 ? (const bf16*)F.out + OUT_TG / 2 : (const bf16*)F.out + OUT_TV / 2) };
    const size_t poff = ((size_t)b * SEQ + lr) * 1024 + h * 64 + lc8 * 8;
    const float* PCG = F.out + OUT_PC / 4 + (size_t)(b * 64) * 1024 + h * 64; const float* BONG = F.out + OUT_BON / 4 + (size_t)b * SEQ * 16 + h;
    v4u pl_[3]; float ppc = 0.f, pbn = 0.f;
#define RWKV_PREFETCH(tl_) do { _Pragma("unroll") for (int q_ = 0; q_ < 3; ++q_) pl_[q_] = *(const v4u*)(srcA[q_] + poff + (size_t)(tl_) * 32 * 1024); \
        ppc = PCG[(size_t)(tl_) * 1024 + (tid & 63)]; pbn = BONG[((size_t)(tl_) * 32 + (tid & 31)) * 16]; } while (0)
    const int ib = wave >> 1, tb = wave & 1, i0 = ib * 16, t0m = tb * 16;
    f32x4 sacc[2], yacc;
    sacc[0] = (f32x4){0.f, 0.f, 0.f, 0.f}; sacc[1] = sacc[0]; yacc = sacc[0];
    for (int u = tid; u < 2 * 64 * LD64 / 2; u += NTHR) ((LAS unsigned*)S0B)[u] = 0u;
    const int trow0 = (item * 4 + (wave & 3)) * 32; const bool tconv = wave >= 4;
    f32x4 th[4], tk[4]; float tkm = 0.f;
#pragma unroll
    for (int q = 0; q < 4; ++q) tk[q] = (f32x4){0.f, 0.f, 0.f, 0.f};
    RWKV_PREFETCH(0);
    RD_LOAD(F.in[I_U], tconv, trow0, 0);
    __syncthreads();
    for (int tl = 0; tl <= SEQ / 32; ++tl) {
        const int cur = tl & 1;
        int lane_c = lane; asm volatile("" : "+v"(lane_c)); const int fr = lane_c & 15, fq = lane_c >> 4;
        LAS bf16* VS = VS2 + cur * 32 * LD64; LAS bf16* GGB = GGB2 + cur * 32 * LD64; LAS float* YB = YB2 + cur * 32 * 68; LAS float* BON = BON2 + cur * 32;
        const LAS bf16* VSp = VS2 + (cur ^ 1) * 32 * LD64; const LAS bf16* GGBp = GGB2 + (cur ^ 1) * 32 * LD64; const LAS float* YBp = YB2 + (cur ^ 1) * 32 * 68; const LAS float* BONp = BON2 + (cur ^ 1) * 32;
        if (tl > 0) { const size_t tokb = (size_t)b * SEQ + (tl - 1) * 32;
          const f32x4 y4 = *(const LAS f32x4*)(YBp + tt * 68 + j0); const v2u gw_ = *(const LAS v2u*)(GGBp + tt * LD64 + j0);
          const f32x4 g4 = (f32x4){bf_lo(gw_.x), bf_hi(gw_.x), bf_lo(gw_.y), bf_hi(gw_.y)};
          const v2u vw_ = *(const LAS v2u*)(VSp + tt * LD64 + j0); const f32x4 v4 = (f32x4){bf_lo(vw_.x), bf_hi(vw_.x), bf_lo(vw_.y), bf_hi(vw_.y)};
          float sm = (y4[0] + y4[1]) + (y4[2] + y4[3]); sm = red16(sm); const float mean = sm * (1.0f / 64.0f);
          const f32x4 d4 = y4 - mean; float sv = (d4[0] * d4[0] + d4[1] * d4[1]) + (d4[2] * d4[2] + d4[3] * d4[3]); sv = red16(sv);
          const float rstd = __builtin_amdgcn_rsqf(sv * (1.0f / 64.0f) + GN_EPS), bon = BONp[tt];
          f32x4 o;
#pragma unroll
          for (int e = 0; e < 4; ++e) o[e] = (d4[e] * rstd * plw[e] + plb[e] + bon * v4[e]) * g4[e];
          v2u w; w.x = cvtpk(o[0], o[1]); w.y = cvtpk(o[2], o[3]);
          *(v2u*)(Y + (tokb + tt) * D + 1024 + hc) = w; }
        if (tl == SEQ / 32) break;
        const LAS bf16* S0c = S0B + cur * 64 * LD64; LAS bf16* S0n = S0B + (cur ^ 1) * 64 * LD64;
        { const v4u p0 = pl_[0], p1 = pl_[1], p2 = pl_[2];
          *(LAS v4u*)((hi2 ? RT : AT) + lr * LD64 + lc8 * 8) = p0;
          *(LAS v4u*)((hi2 ? KT_ : BT_) + lr * LD64 + lc8 * 8) = p1;
          *(LAS v4u*)((hi2 ? GGB : VS) + lr * LD64 + lc8 * 8) = p2;
          if (tid < 64) PC[tid] = ppc;
          if (tid >= 64 && tid < 96) BON[tid - 64] = pbn; }
        { const int tn_ = tl + 1 < SEQ / 32 ? tl + 1 : SEQ / 32 - 1; RWKV_PREFETCH(tn_); }
        __syncthreads();
        f32x4 rhs4 = (f32x4){0.f, 0.f, 0.f, 0.f};
#define RWKV_FIRST do { rhs4 = (f32x4){0.f, 0.f, 0.f, 0.f}; yacc = (f32x4){0.f, 0.f, 0.f, 0.f}; \
            _Pragma("unroll") for (int ks = 0; ks < 2; ++ks) rhs4 = MFMA16(FRAG(AT, t0m, LD64, ks), FRAG(S0c, i0, LD64, ks), rhs4); \
            _Pragma("unroll") for (int ks = 0; ks < 2; ++ks) yacc = MFMA16(FRAG(S0c, i0, LD64, ks), FRAG(RT, t0m, LD64, ks), yacc); \
            _Pragma("unroll") for (int u = 0; u < 2; ++u) { const int tile = wave * 2 + u, si0 = (tile >> 2) * 16, sj0 = (tile & 3) * 16; sacc[u] = MFMA16(FRAGT(KT_, sj0, LD64), FRAGT(VS, si0, LD64), sacc[u]); } } while (0)
#define PK8(a_, s_) __builtin_bit_cast(bf16x8, (v4u){cvtpk(a_[8 * (s_) + 0], a_[8 * (s_) + 1]), cvtpk(a_[8 * (s_) + 2], a_[8 * (s_) + 3]), cvtpk(a_[8 * (s_) + 4], a_[8 * (s_) + 5]), cvtpk(a_[8 * (s_) + 6], a_[8 * (s_) + 7])})
        if (wave == 0) {
            const int c32 = lane_c & 31, h32 = lane_c >> 5;
            f32x16 U, V, PT;
#pragma unroll
            for (int e = 0; e < 16; ++e) { U[e] = 0.f; V[e] = 0.f; }
#pragma unroll
            for (int ks = 0; ks < 4; ++ks) { const bf16x8 fa = *(const LAS bf16x8*)(AT + c32 * LD64 + ks * 16 + h32 * 8), fb = *(const LAS bf16x8*)(BT_ + c32 * LD64 + ks * 16 + h32 * 8);
                U = MFMA32(fa, fb, U);
                V = MFMA32(fb, fa, V); }
#pragma unroll
            for (int e = 0; e < 16; ++e) { const int rr = (e & 3) + 8 * (e >> 2) + 4 * h32;
                U[e] = (c32 < rr) ? U[e] : 0.f;
                V[e] = (rr < c32) ? V[e] : 0.f;
                PT[e] = V[e] + ((rr == c32) ? 1.0f : 0.f); }
#pragma unroll
            for (int st = 1; st <= 5; ++st) {
                const bf16x8 fU0 = PK8(U, 0), fU1 = PK8(U, 1);
                f32x16 Un, Vn;
#pragma unroll
                for (int e = 0; e < 16; ++e) { Un[e] = 0.f; Vn[e] = 0.f; }
                if (st < 5) { const bf16x8 fV0 = PK8(V, 0), fV1 = PK8(V, 1);
                    Un = MFMA32(fV0, fU0, Un); Un = MFMA32(fV1, fU1, Un);
                    if (st < 4) { Vn = MFMA32(fU0, fV0, Vn); Vn = MFMA32(fU1, fV1, Vn); } }
                if (st > 1) { const bf16x8 fP0 = PK8(PT, 0), fP1 = PK8(PT, 1);
                    PT = MFMA32(fU0, fP0, PT); PT = MFMA32(fU1, fP1, PT); }
                U = Un; V = Vn; }
#pragma unroll
            for (int q = 0; q < 4; ++q) { v2u w; w.x = cvtpk(PT[4 * q], PT[4 * q + 1]); w.y = cvtpk(PT[4 * q + 2], PT[4 * q + 3]); *(LAS v2u*)(MINV + c32 * LD32 + 8 * q + 4 * h32) = w; }
        } else {
            if (wave < 7) { const int mtx = (wave - 1) >> 1;
                const LAS bf16* Xs = (mtx == 1) ? BT_ : KT_; const LAS bf16* Yt = (mtx == 0) ? AT : RT; LAS bf16* O = (mtx == 0) ? AAK : (mtx == 1 ? ARB : ARK);
#pragma unroll
                for (int qq = 0; qq < 2; ++qq) { const int q = ((wave - 1) & 1) * 2 + qq, tq = (q >> 1) * 16, sq = (q & 1) * 16;
                    f32x4 a4 = (f32x4){0.f, 0.f, 0.f, 0.f};
                    if (sq <= tq) {
#pragma unroll
                        for (int ks = 0; ks < 2; ++ks) a4 = MFMA16(FRAG(Xs, sq, LD64, ks), FRAG(Yt, tq, LD64, ks), a4); }
                    const int t = tq + fr, s = sq + fq * 4;
#pragma unroll
                    for (int r = 0; r < 4; ++r) { const bool keep = (mtx == 0) ? (s + r < t) : (s + r <= t); a4[r] = keep ? a4[r] : 0.f; }
                    v2u w; w.x = cvtpk(a4[0], a4[1]); w.y = cvtpk(a4[2], a4[3]); *(LAS v2u*)(O + t * LD32 + s) = w; } }
            RWKV_FIRST;
            if (tconv) RD_CONSUME(WSP(unsigned char, WS_UT), WSP(float, WS_USC), trow0, tl);
        }
        { const int tn_ = tl + 1 < SEQ / 32 ? tl + 1 : SEQ / 32 - 1; RD_LOAD(F.in[I_U], tconv, trow0, tn_); }
        __syncthreads();
        if (wave == 0) RWKV_FIRST;
        { rhs4 = MFMA16(FRAG(AAK, t0m, LD32, 0), FRAGT(VS, i0, LD64), rhs4);
          v2u w; w.x = cvtpk(rhs4[0], rhs4[1]); w.y = cvtpk(rhs4[2], rhs4[3]); *(LAS v2u*)(RHS + (i0 + fr) * LD32 + t0m + fq * 4) = w;
          yacc = MFMA16(FRAGT(VS, i0, LD64), FRAG(ARK, t0m, LD32, 0), yacc); }
        __syncthreads();
#undef RWKV_FIRST
#undef PK8
        { f32x4 a4 = (f32x4){0.f, 0.f, 0.f, 0.f}; a4 = MFMA16(FRAG(MINV, t0m, LD32, 0), FRAG(RHS, i0, LD32, 0), a4);
          v2u w; w.x = cvtpk(a4[0], a4[1]); w.y = cvtpk(a4[2], a4[3]); *(LAS v2u*)(SAB + (i0 + fr) * LD32 + t0m + fq * 4) = w; }
        __syncthreads();
        { yacc = MFMA16(FRAG(SAB, i0, LD32, 0), FRAG(ARB, t0m, LD32, 0), yacc);
          *(LAS f32x4*)(YB + (t0m + fr) * 68 + i0 + fq * 4) = yacc;
#pragma unroll
          for (int u = 0; u < 2; ++u) { const int tile = wave * 2 + u, si0 = (tile >> 2) * 16, sj0 = (tile & 3) * 16;
              sacc[u] = MFMA16(FRAGT(BT_, sj0, LD64), FRAG(SAB, si0, LD32, 0), sacc[u]);
              const f32x4 pc = *(const LAS f32x4*)(PC + sj0 + fq * 4); sacc[u] = sacc[u] * pc;
              v2u w; w.x = cvtpk(sacc[u][0], sacc[u][1]); w.y = cvtpk(sacc[u][2], sacc[u][3]); *(LAS v2u*)(S0n + (si0 + fr) * LD64 + sj0 + fq * 4) = w; } }
        __syncthreads();
    }
    __syncthreads();
#undef FRAG
#undef FRAGT
#undef RWKV_PREFETCH
}
__device__ __forceinline__ void lora_prepass(const Frame& F) {
    const bf16* PROJ = WSP(bf16, WS_PROJ); bf16* LA = WSP(bf16, WS_LA); const float* mu = F.in[I_MU] + (PC_WD - RWKV_C0);
    const int gt = (F.bid * NWAVES + F.wave) * 64 + F.lane, NGT = F.G * NTHR;
    for (int i = gt; i < T * 36; i += NGT) { const int tok = i / 36, cc = i - tok * 36, m = cc * 8;
        const bf16* pr = PROJ + (size_t)tok * NINP + PC_WD + m;
        const v4u curv = *(const v4u*)pr; v4u prv = (v4u){0u, 0u, 0u, 0u}; if ((tok & (SEQ - 1)) != 0) prv = *(const v4u*)(pr - NINP);
        const f32x4 m0 = *(const f32x4*)(mu + m), m1 = *(const f32x4*)(mu + m + 4);
        float c[8], p[8], o[8]; unpack8(curv, c); unpack8(prv, p);
#pragma unroll
        for (int e = 0; e < 8; ++e) { const float ps = c[e] + (p[e] - c[e]) * (e < 4 ? m0[e] : m1[e - 4]); o[e] = (m < 64) ? tanh_fast(ps) : ((m < 128) ? ps : sigmoid_fast(ps)); }
        v4u w; w.x = cvtpk(o[0], o[1]); w.y = cvtpk(o[2], o[3]); w.z = cvtpk(o[4], o[5]); w.w = cvtpk(o[6], o[7]);
        *(v4u*)(LA + (size_t)tok * 288 + m) = w; }
}
__device__ __forceinline__ void lru_seq(const Frame& F, int item) {
    const int bh = item >> 1, hf = item & 1, b = bh >> 3, h = bh & 7, wave = F.wave; int tid = F.tid; asm volatile("" : "+v"(tid)); const int lane = tid & 63;
    LAS unsigned char* L = F.lds;
    LAS bf16* XA = (LAS bf16*)(L + 0);
    LAS float* XC = (LAS float*)(L + 17408);
    LAS float* RI = (LAS float*)(L + 50176);
    LAS float* SEG = (LAS float*)(L + 115712);
    LAS float* CARRY = (LAS float*)(L + 119808);
    LAS float* CW = (LAS float*)(L + 120320);
    const bf16* PROJ = WSP(bf16, WS_PROJ); bf16* Y = WSP(bf16, WS_Y);
    const int fr0 = lane & 15, fq0 = lane >> 4;
    for (int i = tid; i < 640; i += NTHR) { const int w = i >> 7, cch = i & 127; CW[i] = (w < 4) ? F.in[I_CONVW][w * 1024 + h * 128 + cch] : F.in[I_CONVB][h * 128 + cch]; }
    if (tid < 64) CARRY[tid] = 0.f;
    const int gsel = wave & 1, ntl = wave >> 1, ntg = hf * 4 + ntl;
    bf16x8 wf[4];
    { const bf16* WTp = (gsel ? WSP(bf16, WS_WIT) : WSP(bf16, WS_WAT)) + (size_t)h * 128 * 128;
#pragma unroll
      for (int ks = 0; ks < 4; ++ks) wf[ks] = *(const bf16x8*)(WTp + (ntg * 16 + fr0) * 128 + ks * 32 + 8 * fq0); }
    const int c = tid & 63, sg = tid >> 6, chl = hf * 64 + c, chg = h * 128 + chl;
    const float ba_c = F.in[I_BA][chg], bi_c = F.in[I_BI][chg], sp8 = 8.0f * softplus_fast(-F.in[I_LAM][chg]);
    v4u pf[2][4];
#define LRU_PREFETCH(k_) do { _Pragma("unroll") for (int u_ = 0; u_ < 2; ++u_) { const int chn_ = tid + NTHR * u_, t_ = chn_ >> 4, c8_ = (chn_ & 15) * 8; \
        _Pragma("unroll") for (int w_ = 0; w_ < 4; ++w_) { const int ts_ = (k_) * 64 + t_ - 3 + w_; const int tc_ = ts_ >= 0 ? ts_ : 0;   \
            const v4u x_ = *(const v4u*)(PROJ + ((size_t)b * SEQ + tc_) * NINP + h * 128 + c8_); const unsigned m_ = ts_ >= 0 ? 0xffffffffu : 0u; \
            pf[u_][w_] = (v4u){x_.x & m_, x_.y & m_, x_.z & m_, x_.w & m_}; } } } while (0)
    unsigned short gtn[8];
#define LRU_GATES(k_) do { _Pragma("unroll") for (int e_ = 0; e_ < 8; ++e_) gtn[e_] = PROJ[((size_t)b * SEQ + (k_) * 64 + sg * 8 + e_) * NINP + PC_GATE + chg]; } while (0)
    const int trow0 = (item * 8 + wave) * 16;
    f32x4 th[4], tk[4]; float tkm = 0.f;
#pragma unroll
    for (int q = 0; q < 4; ++q) tk[q] = (f32x4){0.f, 0.f, 0.f, 0.f};
    LRU_PREFETCH(0); LRU_GATES(0);
    RD_LOAD(F.in[I_V], true, trow0, 0);
    __syncthreads();
    for (int k = 0; k < SEQ / 64; ++k) {
        const size_t tokbase = (size_t)b * SEQ + k * 64;
        int lane_c = lane; asm volatile("" : "+v"(lane_c)); const int fr = lane_c & 15, fq = lane_c >> 4;
#pragma unroll
        for (int u = 0; u < 2; ++u) { const int chn = tid + NTHR * u, t = chn >> 4, c8 = (chn & 15) * 8;
            float acc[8]; { const f32x4 b0 = *(const LAS f32x4*)(CW + 512 + c8), b1 = *(const LAS f32x4*)(CW + 512 + c8 + 4);
#pragma unroll
                for (int e = 0; e < 4; ++e) { acc[e] = b0[e]; acc[e + 4] = b1[e]; } }
#pragma unroll
            for (int w = 0; w < 4; ++w) { float xf[8]; unpack8(pf[u][w], xf);
                const f32x4 w0 = *(const LAS f32x4*)(CW + w * 128 + c8), w1 = *(const LAS f32x4*)(CW + w * 128 + c8 + 4);
#pragma unroll
                for (int e = 0; e < 4; ++e) { acc[e] += w0[e] * xf[e]; acc[e + 4] += w1[e] * xf[e + 4]; } }
            v4u pk; pk.x = cvtpk(acc[0], acc[1]); pk.y = cvtpk(acc[2], acc[3]); pk.z = cvtpk(acc[4], acc[5]); pk.w = cvtpk(acc[6], acc[7]);
            *(LAS v4u*)(XA + t * 136 + c8) = pk;
            LAS float* d = XC + t * 128 + c8; *(LAS f32x4*)d = (f32x4){acc[0], acc[1], acc[2], acc[3]}; *(LAS f32x4*)(d + 4) = (f32x4){acc[4], acc[5], acc[6], acc[7]}; }
        float gl[8];
#pragma unroll
        for (int e = 0; e < 8; ++e) gl[e] = gelu_fast(__uint_as_float((unsigned)gtn[e] << 16));
        { const int kn_ = k + 1 < SEQ / 64 ? k + 1 : SEQ / 64 - 1; LRU_PREFETCH(kn_); LRU_GATES(kn_); }
        __syncthreads();
#pragma unroll
        for (int mt = 0; mt < 4; ++mt) {
            bf16x8 af[4];
#pragma unroll
            for (int ks = 0; ks < 4; ++ks) af[ks] = *(const LAS bf16x8*)(XA + (mt * 16 + fr) * 136 + ks * 32 + 8 * fq);
            { f32x4 a4 = (f32x4){0.f, 0.f, 0.f, 0.f};
#pragma unroll
                for (int ks = 0; ks < 4; ++ks) a4 = MFMA16(wf[ks], af[ks], a4);
                *(LAS f32x4*)(RI + gsel * 8192 + (mt * 16 + fr) * 128 + ntl * 16 + fq * 4) = a4; } }
        __syncthreads();
        float av[8], bx[8]; float A = 1.f, B = 0.f;
#pragma unroll
        for (int e = 0; e < 8; ++e) { const int t = sg * 8 + e; const float r = sigmoid_fast(RI[t * 128 + c] + ba_c), ig = sigmoid_fast(RI[8192 + t * 128 + c] + bi_c), xc = XC[t * 128 + chl];
            const float la = -sp8 * r; av[e] = __expf(la); bx[e] = sqrtf(fmaxf(1.0f - av[e] * av[e], 0.f)) * (ig * xc); A *= av[e]; B = av[e] * B + bx[e]; }
        SEG[(sg * 64 + c) * 2] = A; SEG[(sg * 64 + c) * 2 + 1] = B;
        __syncthreads();
        float hst = CARRY[c];
        for (int s2 = 0; s2 < sg; ++s2) hst = SEG[(s2 * 64 + c) * 2] * hst + SEG[(s2 * 64 + c) * 2 + 1];
#pragma unroll
        for (int e = 0; e < 8; ++e) { hst = av[e] * hst + bx[e];
            Y[(tokbase + sg * 8 + e) * D + chg] = (bf16)(cvtpk(hst * gl[e], 0.f) & 0xffffu); }
        RD_CONSUME(WSP(unsigned char, WS_VT), WSP(float, WS_VSC), trow0, k);
        { const int kn_ = k + 1 < SEQ / 64 ? k + 1 : SEQ / 64 - 1; RD_LOAD(F.in[I_V], true, trow0, kn_); }
        __syncthreads();
        if (sg == 7) CARRY[c] = hst;
    }
    __syncthreads();
#undef LRU_PREFETCH
#undef LRU_GATES
}
__device__ __forceinline__ void group_barrier(unsigned* cnt, unsigned n) {
    asm volatile("s_waitcnt vmcnt(0)" ::: "memory");
    __syncthreads();
    if (threadIdx.x == 0) {
        __builtin_amdgcn_fence(__ATOMIC_RELEASE, "agent");
        asm volatile("s_waitcnt vmcnt(0)" ::: "memory");
        xb_add(cnt, 1u);
        unsigned sp = 0; while (xb_ld(cnt) < n) { __builtin_amdgcn_s_sleep(2); if (++sp > (1u << 24)) break; }
        __builtin_amdgcn_fence(__ATOMIC_ACQUIRE, "agent");
        asm volatile("s_waitcnt vmcnt(0)" ::: "memory");
    }
    __syncthreads();
}

__device__ __forceinline__ unsigned f2ord(float f) { const unsigned u = __builtin_bit_cast(unsigned, f); return (u & 0x80000000u) ? ~u : (u | 0x80000000u); }
__device__ __forceinline__ float ord2f(unsigned o) { const unsigned u = (o & 0x80000000u) ? (o & 0x7fffffffu) : ~o; return __builtin_bit_cast(float, u); }
#define CMPX(hi_, lo_) do { const unsigned _a = (hi_), _b = (lo_); (hi_) = _a > _b ? _a : _b; (lo_) = _a > _b ? _b : _a; } while (0)
template <int N> __device__ __forceinline__ void sort_desc(unsigned (&a)[N]) {
#pragma unroll
    for (int k = 2; k <= N; k <<= 1)
#pragma unroll
        for (int j = k >> 1; j > 0; j >>= 1)
#pragma unroll
            for (int i = 0; i < N; ++i) { const int l = i ^ j; if (l > i) { if ((i & k) == 0) CMPX(a[i], a[l]); else CMPX(a[l], a[i]); } }
}
__device__ __forceinline__ void merge16(unsigned (&A)[16], const unsigned (&B)[16]) {
#pragma unroll
    for (int i = 0; i < 16; ++i) { const unsigned q = B[15 - i]; A[i] = A[i] > q ? A[i] : q; }
#pragma unroll
    for (int d = 8; d >= 1; d >>= 1)
#pragma unroll
        for (int i = 0; i < 16; ++i) if ((i & d) == 0) CMPX(A[i], A[i + d]);
}
__device__ __forceinline__ void merge_partner(unsigned (&Lk)[16]) {
    unsigned P[16];
#pragma unroll
    for (int i = 0; i < 16; ++i) P[i] = (unsigned)__shfl_xor((int)Lk[i], 32);
#pragma unroll
    for (int i = 0; i < 16; ++i) { const unsigned q = P[15 - i]; Lk[i] = Lk[i] > q ? Lk[i] : q; }
#pragma unroll
    for (int d = 8; d >= 1; d >>= 1)
#pragma unroll
        for (int i = 0; i < 16; ++i) if ((i & d) == 0) CMPX(Lk[i], Lk[i + d]);
}
__device__ __forceinline__ void route_item(const Frame& F, int item, int lane) {
    const int tok0 = (item >> 3) * 32, h = item & 7, c = lane & 31, hi = lane >> 5;
    const bf16* Q = WSP(bf16, WS_Q); const bf16* KB = WSP(bf16, WS_KEYS);
    LAS unsigned* WL = (LAS unsigned*)(F.lds + F.wave * 8192);
    unsigned LST[2][16];
    bf16x8 qf[8], qn[8], kf[8], kn[8];
#pragma unroll
    for (int ks = 0; ks < 8; ++ks) { qf[ks] = *(const bf16x8*)(Q + (size_t)(tok0 + c) * D + h * 256 + ks * 16 + 8 * hi); qn[ks] = *(const bf16x8*)(Q + (size_t)(tok0 + c) * D + h * 256 + 128 + ks * 16 + 8 * hi);
        kf[ks] = *(const bf16x8*)(KB + (size_t)((h * 2) * 128 + c) * 128 + 8 * hi + ks * 16); }
    unsigned Lk[16];
#pragma unroll
    for (int st = 0; st < 8; ++st) { const int p = st >> 2, m = st & 3;
        if (st < 7) { const int p2 = (st + 1) >> 2, m2 = (st + 1) & 3; const bf16* kp = KB + (size_t)((h * 2 + p2) * 128 + m2 * 32 + c) * 128 + 8 * hi;
#pragma unroll
            for (int ks = 0; ks < 8; ++ks) kn[ks] = *(const bf16x8*)(kp + ks * 16); }
        f32x16 acc;
#pragma unroll
        for (int r = 0; r < 16; ++r) acc[r] = 0.f;
#pragma unroll
        for (int ks = 0; ks < 8; ++ks) acc = MFMA32(kf[ks], p ? qn[ks] : qf[ks], acc);
        unsigned G16[16];
#pragma unroll
        for (int r = 0; r < 16; ++r) { const unsigned idx = (unsigned)(m * 32 + (r & 3) + 8 * (r >> 2)) | ((unsigned)hi << 2); G16[r] = (f2ord(acc[r]) & ~0x7Fu) | idx; }
        sort_desc<16>(G16);
        if (m == 0) {
#pragma unroll
            for (int i = 0; i < 16; ++i) Lk[i] = G16[i]; }
        else merge16(Lk, G16);
        if (m == 3) { merge_partner(Lk);
#pragma unroll
            for (int i = 0; i < 16; ++i) { LST[p][i] = Lk[i]; WL[(p * 16 + i) * 64 + lane] = Lk[i] & 0x7Fu; } }
#pragma unroll
        for (int ks = 0; ks < 8; ++ks) kf[ks] = kn[ks];
    }
    float va[4], vb[16];
#pragma unroll
    for (int i = 0; i < 4; ++i) va[i] = ord2f((hi ? LST[1][i] : LST[0][i]) & ~0x7Fu);
#pragma unroll
    for (int j = 0; j < 16; ++j) vb[j] = ord2f((hi ? LST[0][j] : LST[1][j]) & ~0x7Fu);
    unsigned C32[32];
#pragma unroll
    for (int i = 0; i < 32; ++i) C32[i] = 0u;
#pragma unroll
    for (int i = 0; i < 4; ++i) { const unsigned key = (f2ord(va[i] + vb[i]) & ~0xFFu) | (unsigned)(i * 17); C32[i] = hi ? 0u : key; }
    { int cn = 4;
#pragma unroll
      for (int i = 0; i < 3; ++i)
#pragma unroll
          for (int j = i + 1; j < 16; ++j) if ((i + 1) * (j + 1) <= 16) { const unsigned code = hi ? (unsigned)(j * 16 + i) : (unsigned)(i * 16 + j); C32[cn] = (f2ord(va[i] + vb[j]) & ~0xFFu) | code; ++cn; } }
    sort_desc<32>(C32);
    unsigned Ck[16];
#pragma unroll
    for (int i = 0; i < 16; ++i) Ck[i] = C32[i];
    merge_partner(Ck);
    const float mx = ord2f(Ck[0] & ~0xFFu); float den = 0.f;
#pragma unroll
    for (int k = 0; k < 16; ++k) den += __expf(ord2f(Ck[k] & ~0xFFu) - mx);
    const float rden = 1.0f / den;
    int eo[8]; float go[8];
#pragma unroll
    for (int k = 0; k < 8; ++k) { const unsigned fm = hi ? Ck[k + 8] : Ck[k]; const unsigned code = fm & 0xFFu;
        const unsigned k0 = WL[(code >> 4) * 64 + lane], k1 = WL[(16 + (code & 15u)) * 64 + lane];
        eo[k] = (int)(k0 * 128u + k1); go[k] = __expf(ord2f(fm & ~0xFFu) - mx) * rden; }
    int* ep = WSP(int, WS_EXP) + (size_t)(tok0 + c) * NSEL + h * 16 + hi * 8; float* gp = WSP(float, WS_GATE) + (size_t)(tok0 + c) * NSEL + h * 16 + hi * 8;
    *(int4*)ep = make_int4(eo[0], eo[1], eo[2], eo[3]); *(int4*)(ep + 4) = make_int4(eo[4], eo[5], eo[6], eo[7]);
    *(f32x4*)gp = (f32x4){go[0], go[1], go[2], go[3]}; *(f32x4*)(gp + 4) = (f32x4){go[4], go[5], go[6], go[7]};
}

typedef float f32x2 __attribute__((ext_vector_type(2)));
__device__ __forceinline__ int dot4i(unsigned a, unsigned b, int c) { return __builtin_amdgcn_sdot4((int)a, (int)b, c, false); }
template <int CTRL> __device__ __forceinline__ int dppi(int x) { return __builtin_amdgcn_mov_dpp(x, CTRL, 0xf, 0xf, true); }
struct PeerGeom { int ngrp, g, rank, nrank; };
__device__ __forceinline__ PeerGeom peer_geom(const Frame& F) { PeerGeom p; p.ngrp = (F.G % 8 == 0) ? 8 : 1; p.g = F.bid % p.ngrp; p.rank = F.bid / p.ngrp; p.nrank = F.G / p.ngrp; return p; }
__device__ __forceinline__ void xquant_token(const Frame& F, int tok, int lane) {
    const bf16* xr = WSP(bf16, WS_XB) + (size_t)tok * D + lane * 16; float xf[32]; float am = 0.f, sq = 0.f;
#pragma unroll
    for (int hh = 0; hh < 2; ++hh)
#pragma unroll
        for (int q = 0; q < 2; ++q) { const v4u w = *(const v4u*)(xr + hh * 1024 + q * 8); float t8[8]; unpack8(w, t8);
            const f32x4 g0 = *(const f32x4*)(F.in[I_G2N] + hh * 1024 + lane * 16 + q * 8), g1 = *(const f32x4*)(F.in[I_G2N] + hh * 1024 + lane * 16 + q * 8 + 4);
#pragma unroll
            for (int e = 0; e < 8; ++e) { const float xg = t8[e] * (e < 4 ? g0[e & 3] : g1[e & 3]); xf[hh * 16 + q * 8 + e] = xg; am = fmaxf(am, fabsf(xg)); sq += t8[e] * t8[e]; } }
#pragma unroll
    for (int o = 1; o < 64; o <<= 1) am = fmaxf(am, __shfl_xor(am, o));
    sq = wave_sum(sq);
    const float qs = am > 0.f ? 127.0f / am : 0.f;
    if (lane == 0) { WSP(float, WS_SX)[tok] = am * (1.0f / 127.0f); WSP(float, WS_SSQ2)[tok] = sq; }
#pragma unroll
    for (int hh = 0; hh < 2; ++hh) { v4u o;
#pragma unroll
        for (int d = 0; d < 4; ++d) { unsigned w = 0u;
#pragma unroll
            for (int e = 0; e < 4; ++e) { const int qi = (int)rintf(xf[hh * 16 + d * 4 + e] * qs); w |= ((unsigned)qi & 0xFFu) << (8 * e); }
            o[d] = w; }
        *(v4u*)(WSP(unsigned char, WS_XQ) + (size_t)tok * D + hh * 1024 + lane * 16) = o; }
}
__device__ __forceinline__ void yquant_tokens(const Frame& F, int tokA, int tokB, int lane) {
    v4u ra[2][2], rb[2][2];
#pragma unroll
    for (int hh = 0; hh < 2; ++hh)
#pragma unroll
        for (int q = 0; q < 2; ++q) { ra[hh][q] = *(const v4u*)(WSP(bf16, WS_Y) + (size_t)tokA * D + hh * 1024 + lane * 16 + q * 8); rb[hh][q] = *(const v4u*)(WSP(bf16, WS_Y) + (size_t)tokB * D + hh * 1024 + lane * 16 + q * 8); }
#define YQ_ONE(R_, tok_) do { float xf_[32]; float am_ = 0.f; \
        _Pragma("unroll") for (int hh_ = 0; hh_ < 2; ++hh_) _Pragma("unroll") for (int q_ = 0; q_ < 2; ++q_) { float t8_[8]; unpack8(R_[hh_][q_], t8_); \
            _Pragma("unroll") for (int e_ = 0; e_ < 8; ++e_) { xf_[hh_ * 16 + q_ * 8 + e_] = t8_[e_]; am_ = fmaxf(am_, fabsf(t8_[e_])); } } \
        am_ = fmaxf(am_, dppf<0xB1>(am_)); am_ = fmaxf(am_, dppf<0x4E>(am_)); am_ = fmaxf(am_, dppf<0x141>(am_)); am_ = fmaxf(am_, dppf<0x140>(am_)); \
        { auto s_ = __builtin_amdgcn_permlane16_swap(__float_as_uint(am_), __float_as_uint(am_), false, false); am_ = fmaxf(__uint_as_float(s_[0]), __uint_as_float(s_[1])); } \
        { auto s_ = __builtin_amdgcn_permlane32_swap(__float_as_uint(am_), __float_as_uint(am_), false, false); am_ = fmaxf(__uint_as_float(s_[0]), __uint_as_float(s_[1])); } \
        const float qs_ = am_ > 0.f ? 127.0f / am_ : 0.f; \
        if (lane == 0) WSP(float, WS_SY)[tok_] = am_ * (1.0f / 127.0f); \
        _Pragma("unroll") for (int hh_ = 0; hh_ < 2; ++hh_) { v4u o_; \
            _Pragma("unroll") for (int d_ = 0; d_ < 4; ++d_) { \
                const unsigned b0_ = __float_as_uint(__builtin_fmaf(xf_[hh_ * 16 + d_ * 4 + 0], qs_, 12582912.0f)), b1_ = __float_as_uint(__builtin_fmaf(xf_[hh_ * 16 + d_ * 4 + 1], qs_, 12582912.0f)); \
                const unsigned b2_ = __float_as_uint(__builtin_fmaf(xf_[hh_ * 16 + d_ * 4 + 2], qs_, 12582912.0f)), b3_ = __float_as_uint(__builtin_fmaf(xf_[hh_ * 16 + d_ * 4 + 3], qs_, 12582912.0f)); \
                o_[d_] = __builtin_amdgcn_perm(b1_, b0_, 0x0c0c0400u) | __builtin_amdgcn_perm(b3_, b2_, 0x04000c0cu); } \
            *(v4u*)(WSP(unsigned char, WS_YQ) + (size_t)(tok_) * D + hh_ * 1024 + lane * 16) = o_; } } while (0)
    YQ_ONE(ra, tokA);
    if (tokB != tokA) YQ_ONE(rb, tokB);
#undef YQ_ONE
}
struct PeerIds { int a, b; };
__device__ __forceinline__ PeerIds peer_ids_load(const Frame& F, int tok, int lane) { const int* ep = WSP(int, WS_EXP) + (size_t)tok * NSEL; PeerIds r; r.a = ep[lane]; r.b = ep[64 + lane]; return r; }
struct PeerScoreBuf { v4u w[16]; v4u xs; };
__device__ __forceinline__ void peer_score_issue(const Frame& F, int tok, int slice, int lane, LAS int* wl, const PeerIds& id, PeerScoreBuf& B) {
    const int e8 = lane >> 3, c16 = lane & 7;
    wl[lane] = id.a; wl[64 + lane] = id.b;
    B.xs = *(const v4u*)(WSP(unsigned char, WS_XQ) + (size_t)tok * D + slice * 128 + c16 * 16);
    const unsigned char* ub = WSP(unsigned char, WS_UT); const unsigned lo = (unsigned)(slice * 128 + c16 * 16);
#pragma unroll
    for (int ld = 0; ld < 16; ++ld) { const unsigned eid = (unsigned)wl[e8 * 16 + ld]; B.w[ld] = *(const v4u*)(ub + (eid * 2048u + lo)); }
}
__device__ __forceinline__ void peer_score_consume(const Frame& F, int tok, int slice, int lane, const PeerScoreBuf& B, bool valid) {
    int p[16];
#pragma unroll
    for (int ld = 0; ld < 16; ++ld) { const v4u w = B.w[ld]; int a = dot4i(w.x, B.xs.x, 0); a = dot4i(w.y, B.xs.y, a); a = dot4i(w.z, B.xs.z, a); p[ld] = dot4i(w.w, B.xs.w, a); }
    { const bool up = (lane & 4) != 0;
#pragma unroll
      for (int k = 0; k < 8; ++k) { const int keep = up ? p[k + 8] : p[k], send = up ? p[k] : p[k + 8]; p[k] = keep + dppi<0x141>(send); } }
    { const bool up = (lane & 2) != 0;
#pragma unroll
      for (int k = 0; k < 4; ++k) { const int keep = up ? p[k + 4] : p[k], send = up ? p[k] : p[k + 4]; p[k] = keep + dppi<0x4E>(send); } }
    { const bool up = (lane & 1) != 0;
#pragma unroll
      for (int k = 0; k < 2; ++k) { const int keep = up ? p[k + 2] : p[k], send = up ? p[k] : p[k + 2]; p[k] = keep + dppi<0xB1>(send); } }
    if (valid) { unsigned* dst = WSP(unsigned, WS_PART) + ((size_t)slice * T + tok) * (NSEL / 2) + lane;
        *dst = ((unsigned)((p[0] + 32) >> 6) & 0xffffu) | ((unsigned)((p[1] + 32) >> 6) << 16); }
}
__device__ __forceinline__ void peer_score_phase(const Frame& F, const PeerGeom& pg, LAS int* wl2) {
    const int lane = F.lane, first = pg.rank * NWAVES + F.wave, step = pg.nrank * NWAVES, n = first < T ? (T - first + step - 1) / step : 0;
    LAS int* wlA = wl2; LAS int* wlB = wl2 + 256;
#define PEER_TOKC(k_) ((first + (k_) * step) < T ? (first + (k_) * step) : T - 1)
    for (int r = 0; r < 16 / pg.ngrp; ++r) { const int slice = r * pg.ngrp + pg.g;
        PeerScoreBuf A, B; PeerIds id = peer_ids_load(F, PEER_TOKC(0), lane);
        { const PeerIds cur = id; id = peer_ids_load(F, PEER_TOKC(1), lane); asm volatile("" ::: "memory"); peer_score_issue(F, PEER_TOKC(0), slice, lane, wlA, cur, A); }
        for (int i = 0; i < n; i += 2) {
            { const PeerIds cur = id; id = peer_ids_load(F, PEER_TOKC(i + 2), lane); asm volatile("" ::: "memory"); peer_score_issue(F, PEER_TOKC(i + 1), slice, lane, wlB, cur, B); }
            peer_score_consume(F, first + i * step, slice, lane, A, true);
            { const PeerIds cur = id; id = peer_ids_load(F, PEER_TOKC(i + 3), lane); asm volatile("" ::: "memory"); peer_score_issue(F, PEER_TOKC(i + 2), slice, lane, wlA, cur, A); }
            peer_score_consume(F, first + (i + 1) * step, slice, lane, B, i + 1 < n);
        }
    }
}
__device__ __forceinline__ void peer_coef_token(const Frame& F, int tok, int lane) {
    int s0 = 0, s1 = 0;
#pragma unroll
    for (int s = 0; s < 16; ++s) { const unsigned v = WSP(unsigned, WS_PART)[((size_t)s * T + tok) * (NSEL / 2) + lane]; s0 += (int)(v << 16) >> 16; s1 += (int)v >> 16; }
    s0 <<= 6; s1 <<= 6;
    const int2 ex = *(const int2*)(WSP(int, WS_EXP) + (size_t)tok * NSEL + lane * 2); const f32x2 ga = *(const f32x2*)(WSP(float, WS_GATE) + (size_t)tok * NSEL + lane * 2);
    const float rs = WSP(float, WS_SX)[tok] * (1.0f / sqrtf(WSP(float, WS_SSQ2)[tok] * (1.0f / D) + NORM_EPS));
    const float sc0 = (float)s0 * WSP(float, WS_USC)[ex.x] * rs, sc1 = (float)s1 * WSP(float, WS_USC)[ex.y] * rs;
    f32x2 c; c.x = ga.x * gelu_fast(sc0) * WSP(float, WS_VSC)[ex.x]; c.y = ga.y * gelu_fast(sc1) * WSP(float, WS_VSC)[ex.y];
    float cm = fmaxf(fabsf(c.x), fabsf(c.y));
#pragma unroll
    for (int o = 1; o < 64; o <<= 1) cm = fmaxf(cm, __shfl_xor(cm, o));
    const float qs = cm > 0.f ? 127.0f / cm : 0.f;
    const int q0 = (int)rintf(c.x * qs), q1 = (int)rintf(c.y * qs);
    ((unsigned short*)(F.ws + WS_COEF))[(size_t)tok * 64 + lane] = (unsigned short)(((unsigned)q0 & 0xFFu) | (((unsigned)q1 & 0xFFu) << 8));
    if (lane == 0) WSP(float, WS_CSC)[tok] = cm * (1.0f / 127.0f);
}
struct PeerOutBuf { v4u w[16]; v4u cq; unsigned x; float cs; };
__device__ __forceinline__ void peer_out_issue(const Frame& F, int tok, int slice, int lane, LAS int* wl, const PeerIds& id, PeerOutBuf& B) {
    const int e8 = lane >> 3, c16 = lane & 7;
    wl[lane] = id.a; wl[64 + lane] = id.b;
    B.cq = *(const v4u*)(F.ws + WS_COEF + (size_t)tok * 128 + e8 * 16);
    B.cs = WSP(float, WS_CSC)[tok];
    const unsigned char* vb = WSP(unsigned char, WS_VT); const unsigned lofs = (unsigned)(slice * 128 + c16 * 16);
#pragma unroll
    for (int ld = 0; ld < 16; ++ld) { const unsigned eid = (unsigned)wl[e8 * 16 + ld]; B.w[ld] = *(const v4u*)(vb + (eid * 2048u + lofs)); }
    B.x = *(const unsigned*)(WSP(bf16, WS_XB) + (size_t)tok * D + slice * 128 + c16 * 16 + e8 * 2);
}
__device__ __forceinline__ void peer_out_consume(const Frame& F, int tok, int slice, int lane, const PeerOutBuf& B, bool valid) {
    const int e8 = lane >> 3, c16 = lane & 7;
    int o[16];
#pragma unroll
    for (int i = 0; i < 16; ++i) o[i] = 0;
#pragma unroll
    for (int g = 0; g < 4; ++g) { const unsigned cq = B.cq[g];
#pragma unroll
        for (int d = 0; d < 4; ++d) { const unsigned w0 = B.w[4 * g][d], w1 = B.w[4 * g + 1][d], w2 = B.w[4 * g + 2][d], w3 = B.w[4 * g + 3][d];
            const unsigned lo01 = __builtin_amdgcn_perm(w1, w0, 0x05010400u), hi01 = __builtin_amdgcn_perm(w1, w0, 0x07030602u);
            const unsigned lo23 = __builtin_amdgcn_perm(w3, w2, 0x05010400u), hi23 = __builtin_amdgcn_perm(w3, w2, 0x07030602u);
            const unsigned t0 = __builtin_amdgcn_perm(lo23, lo01, 0x05040100u), t1 = __builtin_amdgcn_perm(lo23, lo01, 0x07060302u);
            const unsigned t2 = __builtin_amdgcn_perm(hi23, hi01, 0x05040100u), t3 = __builtin_amdgcn_perm(hi23, hi01, 0x07060302u);
            o[d * 4 + 0] = dot4i(t0, cq, o[d * 4 + 0]); o[d * 4 + 1] = dot4i(t1, cq, o[d * 4 + 1]); o[d * 4 + 2] = dot4i(t2, cq, o[d * 4 + 2]); o[d * 4 + 3] = dot4i(t3, cq, o[d * 4 + 3]); } }
#pragma unroll
    for (int k = 0; k < 8; ++k) { auto s = __builtin_amdgcn_permlane32_swap((unsigned)o[k], (unsigned)o[k + 8], false, false); o[k] = (int)(s[0] + s[1]); }
#pragma unroll
    for (int k = 0; k < 4; ++k) { auto s = __builtin_amdgcn_permlane16_swap((unsigned)o[k], (unsigned)o[k + 4], false, false); o[k] = (int)(s[0] + s[1]); }
    { const bool up = (lane & 8) != 0;
#pragma unroll
      for (int k = 0; k < 2; ++k) { const int keep = up ? o[k + 2] : o[k], send = up ? o[k] : o[k + 2]; o[k] = keep + dppi<0x128>(send); } }
    const float x0 = bf_lo(B.x) + (float)o[0] * B.cs, x1 = bf_hi(B.x) + (float)o[1] * B.cs;
    if (valid) *(unsigned*)(WSP(bf16, WS_XB) + (size_t)tok * D + slice * 128 + c16 * 16 + e8 * 2) = cvtpk(x0, x1);
}
__device__ __forceinline__ void peer_out_phase(const Frame& F, const PeerGeom& pg, LAS int* wl2) {
    const int lane = F.lane, first = pg.rank * NWAVES + F.wave, step = pg.nrank * NWAVES, n = first < T ? (T - first + step - 1) / step : 0;
    LAS int* wlA = wl2; LAS int* wlB = wl2 + 256;
    for (int r = 0; r < 16 / pg.ngrp; ++r) { const int slice = r * pg.ngrp + pg.g;
        PeerOutBuf A, B; PeerIds id = peer_ids_load(F, PEER_TOKC(0), lane);
        { const PeerIds cur = id; id = peer_ids_load(F, PEER_TOKC(1), lane); asm volatile("" ::: "memory"); peer_out_issue(F, PEER_TOKC(0), slice, lane, wlA, cur, A); }
        for (int i = 0; i < n; i += 2) {
            { const PeerIds cur = id; id = peer_ids_load(F, PEER_TOKC(i + 2), lane); asm volatile("" ::: "memory"); peer_out_issue(F, PEER_TOKC(i + 1), slice, lane, wlB, cur, B); }
            peer_out_consume(F, first + i * step, slice, lane, A, true);
            { const PeerIds cur = id; id = peer_ids_load(F, PEER_TOKC(i + 3), lane); asm volatile("" ::: "memory"); peer_out_issue(F, PEER_TOKC(i + 2), slice, lane, wlA, cur, A); }
            peer_out_consume(F, first + (i + 1) * step, slice, lane, B, i + 1 < n);
        }
    }
}
#undef PEER_TOKC
__device__ __forceinline__ void final_norm_phase(const Frame& F) {
    const int lane = F.lane, gw = F.bid * NWAVES + F.wave, NGW = F.G * NWAVES;
    const f32x4* gf = (const f32x4*)F.in[I_GF] + lane;
    f32x4 g[8];
#pragma unroll
    for (int j = 0; j < 8; ++j) g[j] = gf[64 * j];
    if (gw >= T) return;
    v2u va[8], vb[8]; float sa, sb;
#define FN_LOAD(v_, s_, tok_) do { const int tc_ = (tok_) < T ? (tok_) : T - 1; const v2u* xi_ = (const v2u*)(WSP(bf16, WS_XB) + (size_t)tc_ * D) + lane; \
        _Pragma("unroll") for (int j_ = 0; j_ < 8; ++j_) v_[j_] = xi_[64 * j_]; } while (0)
#define FN_STORE(v_, s_, tok_) do { f32x4* xo_ = (f32x4*)(F.out + (size_t)(tok_) * D) + lane; s_ = 0.f; f32x4 f_[8]; \
        _Pragma("unroll") for (int j_ = 0; j_ < 8; ++j_) { f_[j_] = (f32x4){bf_lo(v_[j_].x), bf_hi(v_[j_].x), bf_lo(v_[j_].y), bf_hi(v_[j_].y)}; s_ += (f_[j_][0] * f_[j_][0] + f_[j_][1] * f_[j_][1]) + (f_[j_][2] * f_[j_][2] + f_[j_][3] * f_[j_][3]); } \
        s_ = wave_sum(s_); const float rs_ = 1.0f / sqrtf(s_ * (1.0f / D) + NORM_EPS); \
        _Pragma("unroll") for (int j_ = 0; j_ < 8; ++j_) xo_[64 * j_] = f_[j_] * rs_ * g[j_]; } while (0)
    FN_LOAD(va, sa, gw);
    for (int tok = gw; tok < T; tok += 2 * NGW) {
        FN_LOAD(vb, sb, tok + NGW);
        FN_STORE(va, sa, tok);
        FN_LOAD(va, sa, tok + 2 * NGW);
        if (tok + NGW < T) FN_STORE(vb, sb, tok + NGW);
    }
#undef FN_LOAD
#undef FN_STORE
}

struct Args { const float* in[28]; float* out; unsigned char* ws; int ph_lo, ph_hi, li, pad; };
__global__ void __launch_bounds__(NTHR, 2) hybrid_fwd(Args args) {
    extern __shared__ __attribute__((aligned(16))) unsigned char lds[];
    Frame F;
    F.lds = (LAS unsigned char*)lds;
    F.tid = threadIdx.x; F.lane = F.tid & 63; F.wave = __builtin_amdgcn_readfirstlane(F.tid >> 6);
    F.G = gridDim.x; F.bid = blockIdx.x;
#pragma unroll
    for (int i = 0; i < 28; ++i) F.in[i] = args.in[i];
    F.out = args.out; F.ws = args.ws;
    volatile LAS unsigned* MISC = (volatile LAS unsigned*)(F.lds + MISC_OFF);
    for (int u = F.tid; u < (LDS_BYTES - LDSCTL_OFF) / 4; u += NTHR) ((LAS unsigned*)(F.lds + LDSCTL_OFF))[u] = 0u;
    __syncthreads();
    unsigned* barw = (unsigned*)(F.ws + WS_CTL) + CW_BAR;
    XcdBarrier bar; bar.bar = barw; bar.x = 0; bar.st = nullptr;
    if (N_LAUNCHES == 1) bar = xcd_barrier_post(barw, MISC + 8);
    const int lo = args.ph_lo, hi = args.ph_hi;
#define IN(k) (lo <= (k) && (k) < hi)
#define SEAM(k) do { if (IN(k) && IN((k) + 1)) xcd_barrier(bar); } while (0)

#ifndef PROBE_DUP
#define PROBE_DUP -1
#endif
#define REPS(k) for (int rep_ = 0; rep_ < ((PROBE_DUP) == (k) ? 2 : 1); ++rep_)
    if (IN(0)) REPS(0) { p0_prologue<0>(F, F.bid, F.G); __syncthreads(); }
    SEAM(0);
    if (IN(1)) REPS(1) {
        pg8::Gemm g{(const bf16*)((const unsigned char*)F.out + OUT_X8), WSP(const bf16, WS_WIN), T, NINP, D / 2}; pg8::StaticOrder S; S.init(T, NINP, F.G, F.bid);
        pg8::EpiI8RowColBf16<0> E{WSP(bf16, WS_PROJ), NINP, WSP(const float, WS_RSTD1), WSP(const float, WS_CS1), nullptr, NORM_EPS};
        pg8::gemm_phase<pg8::EpiI8RowColBf16<0>, pg8::StaticOrder, true, true, true>(F.lds, g, S, E);
    }
    SEAM(1);
    if (IN(2)) REPS(2) {
        lora_prepass(F);
        group_barrier((unsigned*)(F.ws + WS_CTL) + CW_PREBAR, (unsigned)F.G);
        for (int r4 = 0; r4 < ((PROBE_DUP) == 70 ? 2 : 1); ++r4) rwkv_prep_phase(F);
        group_barrier((unsigned*)(F.ws + WS_CTL) + CW_PREPBAR, (unsigned)F.G);
        const int R1 = F.G >= 256 ? 128 : F.G, L0 = F.G >= 256 ? 128 : 0, NL = F.G - L0;
        if (F.bid < R1) for (int it = F.bid; it < 128; it += R1) rwkv_item(F, it);
        if (F.bid >= L0) for (int it = F.bid - L0; it < 128; it += NL) lru_seq(F, it);
        { volatile LAS int* qslot = (volatile LAS int*)(F.lds + LDSCTL_OFF + 1024);
          for (;;) { __syncthreads(); if (F.tid == 0) *qslot = (int)xb_add((unsigned*)(F.ws + WS_CTL) + CW_DEFQ, 1u); __syncthreads();
              const int vb = *qslot; if (vb >= DEF_SLICES) break; p0_prologue<1>(F, vb, DEF_SLICES); } }
    }
    SEAM(2);
    if (IN(3)) REPS(3) { const int gw = F.bid * NWAVES + F.wave, NGW = F.G * NWAVES;
        for (int tok = gw; tok < T; tok += 2 * NGW) yquant_tokens(F, tok, tok + NGW < T ? tok + NGW : tok, F.lane); }
    SEAM(3);
    if (IN(4)) REPS(4) {
        pg8::Gemm g{WSP(const bf16, WS_YQ), WSP(const bf16, WS_WOUT), T, D, D / 2}; pg8::StaticOrder S; S.init(T, D, F.G, F.bid);
        pg8::EpiI8Residual E{(const unsigned char*)F.out + OUT_X8, WSP(const float, WS_SX0), WSP(bf16, WS_XB), D, WSP(const float, WS_SY), WSP(const float, WS_CSO)};
        pg8::gemm_phase<pg8::EpiI8Residual, pg8::StaticOrder, true, true, true>(F.lds, g, S, E);
    }
    SEAM(4);
    if (IN(5)) { const int gw = F.bid * NWAVES + F.wave, NGW = F.G * NWAVES;
        for (int tok = gw; tok < T; tok += NGW) xquant_token(F, tok, F.lane); }
    SEAM(5);
    if (IN(6)) REPS(6) {
        pg8::Gemm g{WSP(const bf16, WS_XQ), WSP(const bf16, WS_WQ), T, D, D / 2}; pg8::StaticOrder S; S.init(T, D, F.G, F.bid);
        pg8::EpiI8RowColBf16<1> E{WSP(bf16, WS_Q), D, WSP(const float, WS_SX), WSP(const float, WS_CSQ), WSP(const float, WS_SSQ2), NORM_EPS};
        pg8::gemm_phase<pg8::EpiI8RowColBf16<1>, pg8::StaticOrder, true, true, true>(F.lds, g, S, E);
    }
    if (IN(6)) { __syncthreads();
        pg8::StaticOrder S; S.init(T, D, F.G, F.bid); pg8::Unit u;
        for (int i = 0; S.next(i, u); ++i) route_item(F, ((u.pm * 8 + F.wave) << 3) | u.pn, F.lane); }
    SEAM(6);
    { const PeerGeom pg = peer_geom(F); LAS int* wl = (LAS int*)(F.lds + F.wave * 1024);
      if (IN(7)) REPS(7) peer_score_phase(F, pg, (LAS int*)(F.lds + 16384 + F.wave * 2048));
      SEAM(7);
      if (IN(8)) REPS(8) { const int gw = F.bid * NWAVES + F.wave, NGW = F.G * NWAVES; for (int tok = gw; tok < T; tok += NGW) peer_coef_token(F, tok, F.lane); }
      SEAM(8);
      if (IN(9)) peer_out_phase(F, pg, (LAS int*)(F.lds + 16384 + F.wave * 2048));
      SEAM(9);
      if (IN(10)) final_norm_phase(F); }
#undef IN
#undef SEAM
}

extern "C" void kernel_launch(void* const* d_in, const int* in_sizes, int n_in, void* d_out, int out_size, void* d_ws, size_t ws_size, hipStream_t stream) {
    static int grid = 0;
    if (grid == 0) {
        if (n_in != 28 || in_sizes[0] != T * D || out_size != T * D || ws_size < WS_END) { fprintf(stderr, "kernel_launch: shape/workspace mismatch: n_in %d in0 %d out %d ws %zu (need %zu)\n", n_in, n_in > 0 ? in_sizes[0] : -1, out_size, ws_size, (size_t)WS_END); grid = -1; return; }
        int dev = 0, cus = 0, per_cu = 0;
        if (hipGetDevice(&dev) != hipSuccess || hipDeviceGetAttribute(&cus, hipDeviceAttributeMultiprocessorCount, dev) != hipSuccess) { fprintf(stderr, "kernel_launch: device query failed\n"); grid = -1; return; }
        if (hipFuncSetAttribute((const void*)hybrid_fwd, hipFuncAttributeMaxDynamicSharedMemorySize, LDS_BYTES) != hipSuccess) { fprintf(stderr, "kernel_launch: hipFuncSetAttribute failed\n"); grid = -1; return; }
        if (hipOccupancyMaxActiveBlocksPerMultiprocessor(&per_cu, (const void*)hybrid_fwd, NTHR, LDS_BYTES) != hipSuccess || per_cu < 1) { fprintf(stderr, "kernel_launch: occupancy query says %d blocks per CU\n", per_cu); per_cu = 1; }
        (void)hipGetLastError();
        grid = cus;
    }
    if (grid < 0) return;
    if (hipMemsetAsync((char*)d_ws + WS_CTL, 0, CTL_ZERO_BYTES, stream) != hipSuccess) { fprintf(stderr, "kernel_launch: hipMemsetAsync failed\n"); return; }
    Args a{};
    for (int i = 0; i < 28; ++i) a.in[i] = (const float*)d_in[i];
    a.out = (float*)d_out; a.ws = (unsigned char*)d_ws;
    for (int li = 0; li < N_LAUNCHES; ++li) {
        a.ph_lo = (N_LAUNCHES == 1) ? 0 : li; a.ph_hi = (N_LAUNCHES == 1) ? N_PHASES : li + 1; a.li = li;
        hipLaunchKernelGGL(hybrid_fwd, dim3(grid), dim3(NTHR), LDS_BYTES, stream, a);
        const hipError_t le = hipPeekAtLastError();
        if (le != hipSuccess) { fprintf(stderr, "kernel_launch: launch %d failed: %s\n", li, hipGetErrorName(le)); break; }
    }
}
```

```cpp
#include <hip/hip_runtime.h>
#include <cstdio>
#include <cstdint>
namespace pg8 {
#define PG8_LAS __attribute__((address_space(3)))
typedef unsigned short bf16_t;
typedef short bf16x8 __attribute__((ext_vector_type(8)));
typedef float f32x4 __attribute__((ext_vector_type(4)));
typedef unsigned u32x4 __attribute__((ext_vector_type(4)));
typedef int i32x4 __attribute__((ext_vector_type(4)));
constexpr int BM = 256, BK = 64, HALF = 128, HTB = HALF * BK * 2  , STAGE_BYTES = 8 * HTB, NXCD = 8, WGM = 8;

__host__ __device__ __forceinline__ int lds_byte(int r, int c) { const int st = (r >> 4) * 2 + (c >> 5), rr = r & 15, cc = c & 31, ob = rr * 64 + cc * 2; return st * 1024 + (ob ^ (((ob >> 9) & 1) << 5)); }
__host__ __device__ __forceinline__ void stage_rc(int b, int& R, int& C) { const int st = b / 1024, sb = b % 1024, swz = sb ^ (((sb >> 9) & 1) << 5); R = (st >> 1) * 16 + swz / 64; C = (st & 1) * 32 + (swz % 64) / 2; }
__host__ __device__ __forceinline__ int perm32(int rho) { const int n = rho >> 4, i = rho & 15; return 8 * (i >> 2) + 4 * n + (i & 3); }

struct Unit { int pm, pn; };
struct Gemm { const bf16_t* A; const bf16_t* Bt; int M, N, K; };

struct StaticOrder {
    int nM, nN, nwg, G, c;
    __host__ __device__ void init(int M, int N, int G_, int c_) { nM = M / BM; nN = N / BM; nwg = nM * nN; G = G_; c = c_; }
    __host__ __device__ bool next(int i, Unit& u) const {
        const long L = (long)i * G + c; if (L >= nwg) return false;
        int wgid = (int)L; { const int q = nwg / NXCD, r = nwg % NXCD, xcd = wgid % NXCD, off = wgid / NXCD; wgid = (xcd < r ? xcd * (q + 1) : r * (q + 1) + (xcd - r) * q) + off; }
        const int nig = WGM * nN, gid = wgid / nig, fm = gid * WGM, gsz = (nM - fm) < WGM ? (nM - fm) : WGM;
        u.pm = fm + ((wgid % nig) % gsz); u.pn = (wgid % nig) / gsz; return true;
    }
    __device__ __forceinline__ void a_ready(const Unit&) const {}
    __device__ __forceinline__ void done(const Unit&) const {}
};

__device__ __forceinline__ unsigned cvt_pk_bf16(float lo, float hi) { unsigned r; asm volatile("v_cvt_pk_bf16_f32 %0, %1, %2" : "=v"(r) : "v"(lo), "v"(hi)); return r; }
typedef float f32x2 __attribute__((ext_vector_type(2)));
typedef unsigned u32x2 __attribute__((ext_vector_type(2)));
template <int MODE> struct EpiRowScaleBf16 {
    static constexpr bool PERM = true, AFTER_DRAIN = false;
    bf16_t* O; int ldc; const float* rs; float eps;
    __device__ __forceinline__ void operator()(const f32x4 (&acc)[2][2][4][2], const Unit& u, int wr, int wc, int fr, int fq) const {
        const int row0 = u.pm * BM + wr * 64 + fr, col0 = u.pn * BM + wc * 32 + 8 * fq;
#pragma unroll
        for (int ai = 0; ai < 2; ++ai)
#pragma unroll
            for (int m = 0; m < 4; ++m) { const int r = row0 + ai * HALF + m * 16; float s = rs[r]; if (MODE == 1) s = 1.0f / sqrtf(s * (1.0f / 2048.0f) + eps);
                bf16_t* rowp = O + (size_t)r * ldc + col0;
#pragma unroll
                for (int bj = 0; bj < 2; ++bj) { const f32x4 v0 = acc[ai][bj][m][0] * s, v1 = acc[ai][bj][m][1] * s;
                    u32x4 w; w.x = cvt_pk_bf16(v0[0], v0[1]); w.y = cvt_pk_bf16(v0[2], v0[3]); w.z = cvt_pk_bf16(v1[0], v1[1]); w.w = cvt_pk_bf16(v1[2], v1[3]);
                    *(u32x4*)(rowp + bj * HALF) = w; } }
    }
};
template <int MODE> struct EpiI8RowColBf16 {
    static constexpr bool PERM = true, AFTER_DRAIN = false;
    bf16_t* O; int ldc; const float* rs; const float* cs; const float* ssq; float eps;
    __device__ __forceinline__ void operator()(const f32x4 (&acc)[2][2][4][2], const Unit& u, int wr, int wc, int fr, int fq) const {
        const int row0 = u.pm * BM + wr * 64 + fr, col0 = u.pn * BM + wc * 32 + 8 * fq;
        f32x4 c4[2][2];
#pragma unroll
        for (int bj = 0; bj < 2; ++bj) { c4[bj][0] = *(const f32x4*)(cs + col0 + bj * HALF); c4[bj][1] = *(const f32x4*)(cs + col0 + bj * HALF + 4); }
#pragma unroll
        for (int ai = 0; ai < 2; ++ai)
#pragma unroll
            for (int m = 0; m < 4; ++m) { const int r = row0 + ai * HALF + m * 16; float s = rs[r]; if (MODE == 1) s = s / sqrtf(ssq[r] * (1.0f / 2048.0f) + eps);
                bf16_t* rowp = O + (size_t)r * ldc + col0;
#pragma unroll
                for (int bj = 0; bj < 2; ++bj) { f32x4 v0, v1; const i32x4 i0 = __builtin_bit_cast(i32x4, acc[ai][bj][m][0]), i1 = __builtin_bit_cast(i32x4, acc[ai][bj][m][1]);
#pragma unroll
                    for (int e = 0; e < 4; ++e) { v0[e] = (float)i0[e] * s * c4[bj][0][e]; v1[e] = (float)i1[e] * s * c4[bj][1][e]; }
                    u32x4 w; w.x = cvt_pk_bf16(v0[0], v0[1]); w.y = cvt_pk_bf16(v0[2], v0[3]); w.z = cvt_pk_bf16(v1[0], v1[1]); w.w = cvt_pk_bf16(v1[2], v1[3]);
                    *(u32x4*)(rowp + bj * HALF) = w; } }
    }
};
struct EpiResidual {
    static constexpr bool PERM = false, AFTER_DRAIN = false;
    const float* base; bf16_t* outb; int ldc;
    __device__ __forceinline__ void operator()(const f32x4 (&acc)[2][2][4][2], const Unit& u, int wr, int wc, int fr, int fq) const {
        const int row0 = u.pm * BM + wr * 64 + fr, col0 = u.pn * BM + wc * 32 + 4 * fq;
#pragma unroll
        for (int ai = 0; ai < 2; ++ai)
#pragma unroll
            for (int m = 0; m < 4; ++m) { const int r = row0 + ai * HALF + m * 16; const size_t off = (size_t)r * ldc + col0;
#pragma unroll
                for (int bj = 0; bj < 2; ++bj)
#pragma unroll
                    for (int n = 0; n < 2; ++n) { const f32x4 bs = *(const f32x4*)(base + off + bj * HALF + n * 16); const f32x4 o = bs + acc[ai][bj][m][n];
                        u32x2 w; w.x = cvt_pk_bf16(o[0], o[1]); w.y = cvt_pk_bf16(o[2], o[3]); *(u32x2*)(outb + off + bj * HALF + n * 16) = w; } }
    }
};
struct EpiI8Residual {
    static constexpr bool PERM = true, AFTER_DRAIN = false;
    const unsigned char* x8; const float* xs; bf16_t* outb; int ldc; const float* rs; const float* cs;
    __device__ __forceinline__ void operator()(const f32x4 (&acc)[2][2][4][2], const Unit& u, int wr, int wc, int fr, int fq) const {
        const int row0 = u.pm * BM + wr * 64 + fr, col0 = u.pn * BM + wc * 32 + 8 * fq;
        f32x4 c4[2][2];
#pragma unroll
        for (int bj = 0; bj < 2; ++bj) { c4[bj][0] = *(const f32x4*)(cs + col0 + bj * HALF); c4[bj][1] = *(const f32x4*)(cs + col0 + bj * HALF + 4); }
#pragma unroll
        for (int ai = 0; ai < 2; ++ai)
#pragma unroll
            for (int m = 0; m < 4; ++m) { const int r = row0 + ai * HALF + m * 16; const float s = rs[r], sx = xs[r]; const size_t off = (size_t)r * ldc + col0;
#pragma unroll
                for (int bj = 0; bj < 2; ++bj) { const i32x4 i0 = __builtin_bit_cast(i32x4, acc[ai][bj][m][0]), i1 = __builtin_bit_cast(i32x4, acc[ai][bj][m][1]);
                    const u32x2 xb = *(const u32x2*)(x8 + off + bj * HALF); f32x4 v0, v1;
#pragma unroll
                    for (int e = 0; e < 4; ++e) { v0[e] = (float)((int)(xb.x << (24 - 8 * e)) >> 24) * sx + (float)i0[e] * s * c4[bj][0][e]; v1[e] = (float)((int)(xb.y << (24 - 8 * e)) >> 24) * sx + (float)i1[e] * s * c4[bj][1][e]; }
                    u32x4 w; w.x = cvt_pk_bf16(v0[0], v0[1]); w.y = cvt_pk_bf16(v0[2], v0[3]); w.z = cvt_pk_bf16(v1[0], v1[1]); w.w = cvt_pk_bf16(v1[2], v1[3]);
                    *(u32x4*)(outb + off + bj * HALF) = w; } }
    }
};
template <class Epi, class Sched, bool ALIGN_EPI = false, bool SP2 = false, bool I8 = false>
__device__ __forceinline__ void gemm_phase(PG8_LAS unsigned char* lds, const Gemm g, const Sched& S, const Epi& E) {
    const int tid = threadIdx.x, wid = __builtin_amdgcn_readfirstlane(tid >> 6), lane = tid & 63, wr = wid >> 2, wc = wid & 3, fr = lane & 15, fq = lane >> 4;
    const int K = g.K, nt = K / BK;
    unsigned voffA[2], voffB[2];
#pragma unroll
    for (int i = 0; i < 2; ++i) { int R, C; stage_rc(tid * 16 + i * 8192, R, C); const int Rb = Epi::PERM ? ((R & ~31) + perm32(R & 31)) : R;
        voffA[i] = (unsigned)(R * K + C) * 2u; voffB[i] = (unsigned)(Rb * K + C) * 2u; }
    const size_t kstep = (size_t)(BK * 2);
    const size_t hstep = (size_t)HALF * K * 2;
    const size_t tstep = 2 * hstep;
    const unsigned ldsw = (unsigned)wid * 1024u;
    const int aoff = lds_byte(wr * 64 + fr, fq * 8), boff = lds_byte(wc * 32 + fr, fq * 8);
#define PG8_SA(b, h) (((b) * 2 + (h)) * HTB)
#define PG8_SB(b, h) ((4 + (b) * 2 + (h)) * HTB)
#define PG8_STAGE(bufoff, gbase, voff) do { _Pragma("unroll") for (int _i = 0; _i < 2; ++_i) \
        __builtin_amdgcn_global_load_lds((const unsigned*)((const char*)(gbase) + (voff)[_i]), (PG8_LAS unsigned*)(lds + (bufoff) + ldsw + _i * 8192), 16, 0, 0); } while (0)
#define PG8_LDA(dst, b, h) do { _Pragma("unroll") for (int m = 0; m < 4; ++m) _Pragma("unroll") for (int k = 0; k < 2; ++k) dst[m][k] = *(const PG8_LAS bf16x8*)(lds + PG8_SA(b, h) + aoff + m * 2048 + k * 1024); } while (0)
#define PG8_LDB(dst, b, h) do { _Pragma("unroll") for (int n = 0; n < 2; ++n) _Pragma("unroll") for (int k = 0; k < 2; ++k) dst[n][k] = *(const PG8_LAS bf16x8*)(lds + PG8_SB(b, h) + boff + n * 2048 + k * 1024); } while (0)
#define PG8_MMA(ai, bj, At, Bt) do { __builtin_amdgcn_s_setprio(1); _Pragma("unroll") for (int m = 0; m < 4; ++m) _Pragma("unroll") for (int n = 0; n < 2; ++n) _Pragma("unroll") for (int k = 0; k < 2; ++k) \
        { if constexpr (I8) acc[ai][bj][m][n] = __builtin_bit_cast(f32x4, __builtin_amdgcn_mfma_i32_16x16x64_i8(__builtin_bit_cast(i32x4, Bt[n][k]), __builtin_bit_cast(i32x4, At[m][k]), __builtin_bit_cast(i32x4, acc[ai][bj][m][n]), 0, 0, 0)); \
          else acc[ai][bj][m][n] = __builtin_amdgcn_mfma_f32_16x16x32_bf16(Bt[n][k], At[m][k], acc[ai][bj][m][n], 0, 0, 0); } __builtin_amdgcn_s_setprio(0); } while (0)
#define PG8_WAIT_V(n) asm volatile("s_waitcnt vmcnt(" #n ")" ::: "memory")
#define PG8_WAIT_L(n) asm volatile("s_waitcnt lgkmcnt(" #n ")" ::: "memory")
#define PG8_BAR __builtin_amdgcn_s_barrier()
#define PG8_SCHED __builtin_amdgcn_sched_barrier(0)
    Unit cur, nxt; int ui = 0;
    if (!S.next(0, cur)) return;
    f32x4 acc[2][2][4][2];
#pragma unroll
    for (int a = 0; a < 2; ++a)
#pragma unroll
        for (int b = 0; b < 2; ++b)
#pragma unroll
            for (int m = 0; m < 4; ++m)
#pragma unroll
                for (int n = 0; n < 2; ++n) acc[a][b][m][n] = (f32x4){0.f, 0.f, 0.f, 0.f};
    bf16x8 At[4][2], B0[2][2], B1[2][2];
    const char* cA = (const char*)g.A + (size_t)cur.pm * tstep; const char* cB = (const char*)g.Bt + (size_t)cur.pn * tstep;
    S.a_ready(cur);
    if constexpr (SP2) {
        PG8_STAGE(PG8_SB(0, 0), cB, voffB); PG8_STAGE(PG8_SB(0, 1), cB + hstep, voffB); PG8_STAGE(PG8_SA(0, 0), cA, voffA); PG8_STAGE(PG8_SA(0, 1), cA + hstep, voffA);
        if (wr == 1) PG8_BAR;
        PG8_WAIT_V(2); PG8_BAR;
        PG8_STAGE(PG8_SB(1, 0), cB + kstep, voffB); PG8_STAGE(PG8_SA(1, 0), cA + kstep, voffA); PG8_STAGE(PG8_SB(1, 1), cB + hstep + kstep, voffB);
        PG8_WAIT_V(6); PG8_BAR;
    } else {
        PG8_STAGE(PG8_SB(0, 0), cB, voffB); PG8_STAGE(PG8_SA(0, 0), cA, voffA); PG8_STAGE(PG8_SB(0, 1), cB + hstep, voffB); PG8_STAGE(PG8_SA(0, 1), cA + hstep, voffA);
        if (wr == 1) PG8_BAR;
        PG8_WAIT_V(4); PG8_BAR;
        PG8_STAGE(PG8_SB(1, 0), cB + kstep, voffB); PG8_STAGE(PG8_SA(1, 0), cA + kstep, voffA); PG8_STAGE(PG8_SB(1, 1), cB + hstep + kstep, voffB);
        PG8_WAIT_V(6); PG8_BAR;
    }
    for (;;) {
        const bool has_next = S.next(ui + 1, nxt);
        const char* nA = has_next ? (const char*)g.A + (size_t)nxt.pm * tstep : cA; const char* nB = has_next ? (const char*)g.Bt + (size_t)nxt.pn * tstep : cB;
        for (int t = 0; t < nt; t += 2) {
            const bool last = (t == nt - 2);
            const char* a1 = cA + (size_t)(t + 1) * kstep;
            const char* a2 = last ? nA : cA + (size_t)(t + 2) * kstep; const char* b2 = last ? nB : cB + (size_t)(t + 2) * kstep;
            const char* a3 = a2 + kstep; const char* b3 = b2 + kstep;
            if (last && has_next) S.a_ready(nxt);
            if constexpr (SP2) {
            PG8_LDB(B0, 0, 0); PG8_LDB(B1, 0, 1); PG8_SCHED; PG8_LDA(At, 0, 0); PG8_STAGE(PG8_SA(1, 1), a1 + hstep, voffA);
            PG8_WAIT_V(8); PG8_WAIT_L(0); PG8_BAR; PG8_MMA(0, 0, At, B0); PG8_MMA(0, 1, At, B1); PG8_BAR; PG8_SCHED;
            PG8_LDA(At, 0, 1); PG8_STAGE(PG8_SB(0, 0), b2, voffB); PG8_STAGE(PG8_SB(0, 1), b2 + hstep, voffB); PG8_STAGE(PG8_SA(0, 0), a2, voffA);
            PG8_WAIT_V(8); PG8_WAIT_L(0); PG8_BAR; PG8_MMA(1, 0, At, B0); PG8_MMA(1, 1, At, B1); PG8_BAR; PG8_SCHED;
            PG8_LDB(B0, 1, 0); PG8_LDB(B1, 1, 1); PG8_SCHED; PG8_LDA(At, 1, 0); PG8_STAGE(PG8_SA(0, 1), a2 + hstep, voffA);
            PG8_WAIT_V(8); PG8_WAIT_L(0); PG8_BAR; PG8_MMA(0, 0, At, B0); PG8_MMA(0, 1, At, B1); PG8_BAR; PG8_SCHED;
            PG8_LDA(At, 1, 1); PG8_STAGE(PG8_SB(1, 0), b3, voffB); PG8_STAGE(PG8_SB(1, 1), b3 + hstep, voffB); PG8_STAGE(PG8_SA(1, 0), a3, voffA);
            PG8_WAIT_V(8); PG8_WAIT_L(0); PG8_BAR; PG8_MMA(1, 0, At, B0); PG8_MMA(1, 1, At, B1); PG8_BAR; PG8_SCHED;
            } else {
            PG8_LDB(B0, 0, 0); PG8_SCHED; PG8_LDA(At, 0, 0); PG8_STAGE(PG8_SA(1, 1), a1 + hstep, voffA);
            PG8_WAIT_L(8); PG8_BAR; PG8_WAIT_L(0); PG8_MMA(0, 0, At, B0); PG8_BAR; PG8_SCHED;
            PG8_LDB(B1, 0, 1); PG8_STAGE(PG8_SB(0, 0), b2, voffB);
            PG8_BAR; PG8_WAIT_L(0); PG8_MMA(0, 1, At, B1); PG8_BAR;
            PG8_LDA(At, 0, 1); PG8_STAGE(PG8_SA(0, 0), a2, voffA);
            PG8_BAR; PG8_WAIT_L(0); PG8_MMA(1, 0, At, B0); PG8_BAR; PG8_SCHED;
            PG8_STAGE(PG8_SB(0, 1), b2 + hstep, voffB);
            PG8_WAIT_V(6); PG8_BAR; PG8_MMA(1, 1, At, B1); PG8_BAR;
            PG8_LDB(B0, 1, 0); PG8_SCHED; PG8_LDA(At, 1, 0); PG8_STAGE(PG8_SA(0, 1), a2 + hstep, voffA);
            PG8_WAIT_L(8); PG8_BAR; PG8_WAIT_L(0); PG8_MMA(0, 0, At, B0); PG8_BAR; PG8_SCHED;
            PG8_LDB(B1, 1, 1); PG8_STAGE(PG8_SB(1, 0), b3, voffB);
            PG8_BAR; PG8_WAIT_L(0); PG8_MMA(0, 1, At, B1); PG8_BAR;
            PG8_LDA(At, 1, 1); PG8_STAGE(PG8_SA(1, 0), a3, voffA);
            PG8_BAR; PG8_WAIT_L(0); PG8_MMA(1, 0, At, B0); PG8_BAR; PG8_SCHED;
            PG8_STAGE(PG8_SB(1, 1), b3 + hstep, voffB);
            PG8_WAIT_V(6); PG8_BAR; PG8_MMA(1, 1, At, B1); PG8_BAR;
            }
        }
        if constexpr (ALIGN_EPI) { if (wr == 0) PG8_BAR; }
        if constexpr (!Epi::AFTER_DRAIN) { E(acc, cur, wr, wc, fr, fq); S.done(cur); }
        if (!has_next) break;
#pragma unroll
        for (int a = 0; a < 2; ++a)
#pragma unroll
            for (int b = 0; b < 2; ++b)
#pragma unroll
                for (int m = 0; m < 4; ++m)
#pragma unroll
                    for (int n = 0; n < 2; ++n) acc[a][b][m][n] = (f32x4){0.f, 0.f, 0.f, 0.f};
        cur = nxt; cA = nA; cB = nB; ++ui;
        if constexpr (ALIGN_EPI) { if (wr == 1) PG8_BAR; }
    }
    PG8_WAIT_V(0);
    if constexpr (!ALIGN_EPI) { if (wr == 0) PG8_BAR; }
    PG8_BAR;
    if constexpr (Epi::AFTER_DRAIN) { E.fused(acc, cur, wr, wc, fr, fq, lds, wid, lane); S.done(cur); }
#undef PG8_SA
#undef PG8_SB
#undef PG8_STAGE
#undef PG8_LDA
#undef PG8_LDB
#undef PG8_MMA
#undef PG8_WAIT_V
#undef PG8_WAIT_L
#undef PG8_BAR
#undef PG8_SCHED
}
}

#ifndef PROBE_DUP
#define PROBE_DUP -1
#endif
constexpr int NWAVES = 8, NTHR = NWAVES * 64;
#ifndef MK_N_LAUNCHES
#define MK_N_LAUNCHES 1
#endif
constexpr int N_PHASES = 11;
constexpr int DEF_SLICES = 256;
constexpr int N_LAUNCHES = MK_N_LAUNCHES;
static_assert(N_LAUNCHES == 1 || N_LAUNCHES == N_PHASES, "MK_N_LAUNCHES is 1 or N_PHASES");

constexpr int BATCH = 8, SEQ = 2048, T = BATCH * SEQ, D = 2048;
constexpr int NIN = 5408, NINP = 5632;
constexpr int PC_GATE = 1024, PC_R = 2048, PC_K = 3072, PC_V = 4096, PC_WD = 5120, PC_AD = 5184, PC_GD = 5248;
constexpr int RWKV_C0 = 2048;
constexpr int NEXP = 16384, NSEL = 128;
constexpr float NORM_EPS = 1e-6f, GN_EPS = 64e-5f;

constexpr size_t MiB = 1u << 20;
constexpr size_t WS_CTL = 0, CTL_ZERO_BYTES = 1 * MiB;
constexpr size_t WS_SSQ3 = 576 * 1024;
constexpr size_t WS_SSQ2 = 512 * 1024;
constexpr size_t WS_RSTD1 = 1 * MiB;
constexpr size_t WS_USC = 1 * MiB + 64 * 1024, WS_VSC = 1 * MiB + 128 * 1024;
constexpr size_t WS_SX = 1 * MiB + 192 * 1024;
constexpr size_t WS_CS1 = 1 * MiB + 256 * 1024;
constexpr size_t WS_CSQ = 1 * MiB + 288 * 1024;
constexpr size_t WS_CSO = 1 * MiB + 296 * 1024;
constexpr size_t WS_SY = 1 * MiB + 320 * 1024;
constexpr size_t WS_SX0 = 1 * MiB + 384 * 1024;
constexpr size_t WS_WIN = 2 * MiB;
constexpr size_t WS_WOUT = 24 * MiB;
constexpr size_t WS_WQ = 32 * MiB;
constexpr size_t WS_KEYS = 40 * MiB;
constexpr size_t WS_W2T = WS_KEYS + 512 * 1024;
constexpr size_t WS_A2T = WS_W2T + 128 * 1024;
constexpr size_t WS_G2T = WS_A2T + 128 * 1024;
constexpr size_t WS_WAT = WS_G2T + 320 * 1024;
constexpr size_t WS_WIT = WS_WAT + 256 * 1024;
constexpr size_t WS_EXP = 42 * MiB;
constexpr size_t WS_GATE = 50 * MiB;
constexpr size_t WS_LA = 42 * MiB;
constexpr size_t WS_SUMM = 58 * MiB;
constexpr size_t WS_TA = 64 * MiB, WS_TB = 96 * MiB, WS_TK = 400 * MiB, WS_TR = 464 * MiB;
constexpr size_t OUT_X8 = 72 * MiB;
constexpr size_t OUT_TV = 0, OUT_TG = 32 * MiB, OUT_PC = 64 * MiB, OUT_BON = 66 * MiB;
constexpr size_t WS_XB = 64 * MiB;
constexpr size_t WS_PROJ = 128 * MiB;
constexpr size_t WS_Q = WS_PROJ;
constexpr size_t WS_YQ = WS_PROJ;
constexpr size_t WS_PART = 192 * MiB;
constexpr size_t WS_XQ = 320 * MiB;
constexpr size_t WS_COEF = 352 * MiB;
constexpr size_t WS_CSC = 356 * MiB;
constexpr size_t WS_Y = 304 * MiB;
constexpr size_t WS_UT = 368 * MiB;
constexpr size_t WS_VT = 432 * MiB;
constexpr size_t WS_END = 496 * MiB;
static_assert(WS_WIT + 256 * 1024 <= WS_EXP && WS_PROJ + (size_t)T * NINP * 2 <= WS_Y && WS_WIN + (size_t)NINP * D * 2 <= WS_WOUT, "d_ws map");
constexpr int CW_DEFQ = 2240;
constexpr int CW_PREPBAR = 2176;
constexpr int CW_PREBAR = 2112;
constexpr int CW_LRUBAR = 2048;
constexpr int CW_BAR = 4096;

constexpr int RING_BYTES = 131072;
constexpr int LDSCTL_OFF = 143360, MISC_OFF = LDSCTL_OFF + 320;
constexpr int LDS_BYTES = 147456;

#define GAS __attribute__((address_space(1)))
#define LAS __attribute__((address_space(3)))
typedef unsigned short bf16;
typedef unsigned v4u __attribute__((ext_vector_type(4)));
typedef unsigned v2u __attribute__((ext_vector_type(2)));
typedef float f32x4 __attribute__((ext_vector_type(4)));
typedef float f32x16 __attribute__((ext_vector_type(16)));
typedef short bf16x8 __attribute__((ext_vector_type(8)));
typedef __bf16 bf16x2_t __attribute__((ext_vector_type(2)));
typedef GAS unsigned gu32;
#define RLX_AGENT __ATOMIC_RELAXED, __HIP_MEMORY_SCOPE_AGENT
__device__ __forceinline__ unsigned f2bf(float f) { unsigned u = __builtin_bit_cast(unsigned, f); return (u + 0x7fffu + ((u >> 16) & 1u)) >> 16; }
__device__ __forceinline__ unsigned pk2(float lo, float hi) { return f2bf(lo) | (f2bf(hi) << 16); }
__device__ __forceinline__ float bf_lo(unsigned w) { return __uint_as_float(w << 16); }
__device__ __forceinline__ float bf_hi(unsigned w) { return __uint_as_float(w & 0xffff0000u); }
__device__ __forceinline__ void unpack8(const v4u& w, float (&o)[8]) { o[0] = bf_lo(w.x); o[1] = bf_hi(w.x); o[2] = bf_lo(w.y); o[3] = bf_hi(w.y); o[4] = bf_lo(w.z); o[5] = bf_hi(w.z); o[6] = bf_lo(w.w); o[7] = bf_hi(w.w); }
__device__ __forceinline__ v4u pack8(const float (&o)[8]) { v4u w; w.x = pk2(o[0], o[1]); w.y = pk2(o[2], o[3]); w.z = pk2(o[4], o[5]); w.w = pk2(o[6], o[7]); return w; }
__device__ __forceinline__ float sigmoidf_(float x) { return 1.0f / (1.0f + __expf(-x)); }
__device__ __forceinline__ float softplusf_(float z) { return fmaxf(z, 0.f) + log1pf(__expf(-fabsf(z))); }
__device__ __forceinline__ float gelu_tanh(float x) { const float u = 0.7978845608028654f * (x + 0.044715f * x * x * x); return 0.5f * x * (1.0f + tanhf(u)); }
template <int CTRL> __device__ __forceinline__ float dppf(float x) { return __builtin_bit_cast(float, __builtin_amdgcn_mov_dpp(__builtin_bit_cast(int, x), CTRL, 0xf, 0xf, true)); }
__device__ __forceinline__ float red8(float v) { v += dppf<0xB1>(v); v += dppf<0x4E>(v); v += dppf<0x141>(v); return v; }
__device__ __forceinline__ float red16(float v) { v = red8(v); v += dppf<0x140>(v); return v; }
__device__ __forceinline__ float wave_sum(float v) {
#pragma unroll
    for (int o = 1; o < 64; o <<= 1) v += __shfl_xor(v, o);
    return v;
}
__device__ __forceinline__ float dot2bf(unsigned a, unsigned b, float acc) { return __builtin_amdgcn_fdot2_f32_bf16(__builtin_bit_cast(bf16x2_t, a), __builtin_bit_cast(bf16x2_t, b), acc, false); }
#define MFMA16(a, b, c) __builtin_amdgcn_mfma_f32_16x16x32_bf16((a), (b), (c), 0, 0, 0)
#define MFMA32(a, b, c) __builtin_amdgcn_mfma_f32_32x32x16_bf16((a), (b), (c), 0, 0, 0)

#define XB_TMO      128
#define XB_XCNT(j)  (256  + 64 * (j))
#define XB_XSUB(j)  (1280 + 64 * (j))
#define XB_XGEN(j)  (2304 + 64 * (j))
#define XB_TOP      3328
#define XB_TOPGEN   3392
#define XCD_BAR_WORDS 3456
#define XB_SPIN_CAP (1u << 22)
__device__ __forceinline__ unsigned xb_ld(unsigned* p)              { return __hip_atomic_load(p, __ATOMIC_RELAXED, __HIP_MEMORY_SCOPE_AGENT); }
__device__ __forceinline__ unsigned xb_add(unsigned* p, unsigned v) { return __hip_atomic_fetch_add(p, v, __ATOMIC_RELAXED, __HIP_MEMORY_SCOPE_AGENT); }
__device__ __forceinline__ unsigned xb_xcc_id() { return (unsigned)__builtin_amdgcn_s_getreg((3 << 11) | 20) & 0xFu; }
#define XB_SPIN(cond, bar) do { unsigned _sp = 0; while (cond) { __builtin_amdgcn_s_sleep(1); \
    if ((++_sp & 255u) == 0u) { if (xb_ld(&(bar)[XB_TMO])) break; if (_sp > XB_SPIN_CAP) { atomicAdd(&(bar)[XB_TMO], 1u); break; } } } } while (0)
struct XcdBarrier { unsigned* bar; unsigned x; volatile LAS unsigned* st; };
__device__ __forceinline__ XcdBarrier xcd_barrier_post(unsigned* bar, volatile LAS unsigned* st) {
    XcdBarrier b; b.bar = bar; b.x = xb_xcc_id(); b.st = st;
    if (threadIdx.x == 0) (void)xb_add(&bar[XB_XCNT(b.x)], 1u);
    return b;
}
__device__ __forceinline__ void xcd_barrier_complete(unsigned* bar, unsigned x, unsigned& nloc, unsigned& nx) {
    const unsigned G = gridDim.x * gridDim.y * gridDim.z;
    unsigned sum, cnt, mine, sp = 0u;
    for (;;) {
        sum = 0u; cnt = 0u; mine = 0u;
#pragma unroll
        for (unsigned j = 0; j < 16; ++j) { const unsigned c = xb_ld(&bar[XB_XCNT(j)]); sum += c; cnt += (c > 0u) ? 1u : 0u; mine = (j == x) ? c : mine; }
        if (sum == G) break;
        __builtin_amdgcn_s_sleep(1);
        if ((++sp & 255u) == 0u) { if (xb_ld(&bar[XB_TMO])) break; if (sp > XB_SPIN_CAP) { atomicAdd(&bar[XB_TMO], 1u); break; } }
    }
    nloc = mine > 0u ? mine : 1u; nx = cnt > 0u ? cnt : 1u;
}
__device__ __forceinline__ void xcd_barrier(const XcdBarrier& b) {
    asm volatile("s_waitcnt vmcnt(0)" ::: "memory");
    __syncthreads();
    if (threadIdx.x == 0) {
        unsigned* bar = b.bar;
        __builtin_amdgcn_s_waitcnt(0);
        unsigned nloc = b.st[0], nx = b.st[1];
        if (nloc == 0u) { xcd_barrier_complete(bar, b.x, nloc, nx); b.st[0] = nloc; b.st[1] = nx; }
        const unsigned old = xb_add(&bar[XB_XSUB(b.x)], 1u);
        const unsigned gen = old / nloc;
        if (old + 1u == (gen + 1u) * nloc) {
            __builtin_amdgcn_fence(__ATOMIC_RELEASE, "agent");
            asm volatile("s_waitcnt vmcnt(0)" ::: "memory");
            const unsigned og = xb_add(&bar[XB_TOP], 1u);
            const unsigned tg = og / nx;
            if (og + 1u == (tg + 1u) * nx) xb_add(&bar[XB_TOPGEN], 1u);
            else XB_SPIN(xb_ld(&bar[XB_TOPGEN]) == tg, bar);
            __builtin_amdgcn_fence(__ATOMIC_ACQUIRE, "agent");
            xb_add(&bar[XB_XGEN(b.x)], 1u);
            asm volatile("s_waitcnt vmcnt(0)" ::: "memory");
        } else {
            XB_SPIN(xb_ld(&bar[XB_XGEN(b.x)]) == gen, bar);
            __builtin_amdgcn_fence(__ATOMIC_ACQUIRE, "agent");
            asm volatile("s_waitcnt vmcnt(0)" ::: "memory");
        }
    }
    __syncthreads();
}

struct Frame {
    LAS unsigned char* lds;
    int tid, lane, wave, G, bid;
    const float* in[28];
    float* out;
    unsigned char* ws;
};
#define WSP(type, off) ((type*)(F.ws + (off)))
enum { I_X = 0, I_G1, I_WIN, I_CONVW, I_CONVB, I_WA, I_BA, I_WI, I_BI, I_LAM, I_MU, I_W0, I_W2, I_A0, I_A2, I_G2, I_KK, I_KA, I_RK, I_LNW, I_LNB, I_WOUT, I_G2N, I_WQ, I_KEYS, I_U, I_V, I_GF };

__device__ __forceinline__ void p0_transpose_item(const float* W, int K, int N, bf16* WT, const float* ksc, LAS float* scr, int item, int lane) {
    const int nblk = N / 32, kb = item / nblk, nb = item % nblk, k0 = 64 * kb, n0 = 32 * nb;
    const int lr = lane >> 3, c4 = (lane & 7) * 4;
    f32x4 v[8];
#pragma unroll
    for (int i = 0; i < 8; ++i) v[i] = *(const f32x4*)(W + (size_t)(k0 + 8 * i + lr) * N + n0 + c4);
#pragma unroll
    for (int i = 0; i < 8; ++i) { const int kk = 8 * i + lr; const float sc = ksc ? ksc[k0 + kk] : 1.0f; LAS float* d = scr + kk * 33 + c4; d[0] = v[i][0] * sc; d[1] = v[i][1] * sc; d[2] = v[i][2] * sc; d[3] = v[i][3] * sc; }
    asm volatile("s_waitcnt lgkmcnt(0)" ::: "memory");
    const int c = lane & 7;
#pragma unroll
    for (int j = 0; j < 4; ++j) { const int n = (lane >> 3) + 8 * j; const LAS float* s = scr + (8 * c) * 33 + n;
        v4u o; o.x = pk2(s[0 * 33], s[1 * 33]); o.y = pk2(s[2 * 33], s[3 * 33]); o.z = pk2(s[4 * 33], s[5 * 33]); o.w = pk2(s[6 * 33], s[7 * 33]);
        *(v4u*)(WT + (size_t)(n0 + n) * K + k0 + 8 * c) = o; }
    asm volatile("s_waitcnt lgkmcnt(0)" ::: "memory");
}
template <bool HASK> __device__ __forceinline__ void p0_wquant_block(const float* W, int N, unsigned char* WT8, float* cs, const float* ksc, int item, int wave, int lane, LAS float* mxs) {
    asm volatile("" : "+v"(lane));
    const int n0 = item * 32, r = lane >> 3, c4 = lane & 7, kb = 256 * wave + 4 * r;
    const float* src = W + (size_t)kb * N + n0 + 4 * c4; const float* kp = ksc + kb;
    f32x4 mx = (f32x4){0.f, 0.f, 0.f, 0.f};
#pragma unroll
    for (int i2 = 0; i2 < 2; ++i2) { f32x4 v[4][4], g4[4];
#pragma unroll
        for (int ii = 0; ii < 4; ++ii) { g4[ii] = HASK ? *(const f32x4*)(kp + 32 * (i2 * 4 + ii)) : (f32x4){1.f, 1.f, 1.f, 1.f};
#pragma unroll
            for (int j = 0; j < 4; ++j) v[ii][j] = *(const f32x4*)(src + (size_t)(32 * (i2 * 4 + ii) + j) * N); }
#pragma unroll
        for (int ii = 0; ii < 4; ++ii)
#pragma unroll
            for (int j = 0; j < 4; ++j)
#pragma unroll
                for (int e = 0; e < 4; ++e) mx[e] = fmaxf(mx[e], fabsf(v[ii][j][e] * g4[ii][j])); }
#pragma unroll
    for (int o = 8; o < 64; o <<= 1)
#pragma unroll
        for (int e = 0; e < 4; ++e) mx[e] = fmaxf(mx[e], __shfl_xor(mx[e], o));
    if (r == 0) *(LAS f32x4*)(mxs + wave * 32 + 4 * c4) = mx;
    __syncthreads();
#pragma unroll
    for (int w = 0; w < NWAVES; ++w) { const f32x4 t = *(const LAS f32x4*)(mxs + w * 32 + 4 * c4);
#pragma unroll
        for (int e = 0; e < 4; ++e) mx[e] = fmaxf(mx[e], t[e]); }
    f32x4 q;
#pragma unroll
    for (int e = 0; e < 4; ++e) q[e] = mx[e] > 0.f ? 127.0f / mx[e] : 0.f;
    if (wave == 0 && r == 0) *(f32x4*)(cs + n0 + 4 * c4) = mx * (1.0f / 127.0f);
    unsigned char* dst = WT8 + (size_t)(n0 + 4 * c4) * 2048 + kb;
#pragma unroll
    for (int i2 = 0; i2 < 2; ++i2) { f32x4 v[4][4], g4[4];
#pragma unroll
        for (int ii = 0; ii < 4; ++ii) { g4[ii] = HASK ? *(const f32x4*)(kp + 32 * (i2 * 4 + ii)) : (f32x4){1.f, 1.f, 1.f, 1.f};
#pragma unroll
            for (int j = 0; j < 4; ++j) v[ii][j] = *(const f32x4*)(src + (size_t)(32 * (i2 * 4 + ii) + j) * N); }
#pragma unroll
        for (int ii = 0; ii < 4; ++ii) { unsigned w[4] = {0u, 0u, 0u, 0u};
#pragma unroll
            for (int j = 0; j < 4; ++j)
#pragma unroll
                for (int e = 0; e < 4; ++e) { const int qi = (int)rintf(v[ii][j][e] * g4[ii][j] * q[e]); w[e] |= ((unsigned)qi & 0xFFu) << (8 * j); }
#pragma unroll
            for (int e = 0; e < 4; ++e) *(unsigned*)(dst + (size_t)e * 2048 + 32 * (i2 * 4 + ii)) = w[e]; } }
    __syncthreads();
}
__device__ __forceinline__ void p0_small_transpose(const float* src, bf16* dst, int nb, int K, int N, int gt, int NGT) {
    const int tot = nb * K * N;
    for (int i = gt; i < tot; i += NGT) { const int bb = i / (K * N), r = i - bb * K * N, n = r / K, k = r - n * K; dst[i] = (bf16)f2bf(src[(size_t)bb * K * N + (size_t)k * N + n]); }
}
template <int PART> __device__ __forceinline__ void p0_prologue(const Frame& F, int vb, int VG) {
    LAS float* scr = (LAS float*)(F.lds + F.wave * 8448);
    const int gw = vb * NWAVES + F.wave, NGW = VG * NWAVES, gt = gw * 64 + F.lane, NGT = NGW * 64;
    constexpr int I1 = (D / 64) * (NIN / 32), I2 = (D / 64) * (D / 32);
    if (PART == 0) { for (int it = vb; it < NIN / 32; it += VG) p0_wquant_block<true>(F.in[I_WIN], NIN, WSP(unsigned char, WS_WIN), WSP(float, WS_CS1), F.in[I_G1], it, F.wave, F.lane, (LAS float*)(F.lds + 8 * 8448)); }
    else { const int sp = VG >= 64 ? VG / 64 : 1;
           for (int v = vb; v < sp * (D / 32); v += VG) {
               if (v % sp == 0) p0_wquant_block<false>(F.in[I_WQ], D, WSP(unsigned char, WS_WQ), WSP(float, WS_CSQ), nullptr, v / sp, F.wave, F.lane, (LAS float*)(F.lds + 8 * 8448));
               if (v % sp == sp / 2) p0_wquant_block<false>(F.in[I_WOUT], D, WSP(unsigned char, WS_WOUT), WSP(float, WS_CSO), nullptr, v / sp, F.wave, F.lane, (LAS float*)(F.lds + 8 * 8448)); } }
    if (PART == 0) {
    { v4u* z = (v4u*)(WSP(unsigned char, WS_WIN) + (size_t)NIN * D); const int nz = (NINP - NIN) * D / 16; for (int i = gt; i < nz; i += NGT) z[i] = (v4u){0u, 0u, 0u, 0u};
      for (int i = gt; i < NINP - NIN; i += NGT) WSP(float, WS_CS1)[NIN + i] = 0.f; }
    p0_small_transpose(F.in[I_W2], WSP(bf16, WS_W2T), 1, 64, 1024, gt, NGT);
    p0_small_transpose(F.in[I_A2], WSP(bf16, WS_A2T), 1, 64, 1024, gt, NGT);
    p0_small_transpose(F.in[I_G2], WSP(bf16, WS_G2T), 1, 160, 1024, gt, NGT);
    p0_small_transpose(F.in[I_WA], WSP(bf16, WS_WAT), 8, 128, 128, gt, NGT);
    p0_small_transpose(F.in[I_WI], WSP(bf16, WS_WIT), 8, 128, 128, gt, NGT);
    { const float* s = F.in[I_KEYS]; bf16* d = WSP(bf16, WS_KEYS); for (int i = gt; i < 8 * 2 * 128 * 128 / 8; i += NGT) { const f32x4 a = *(const f32x4*)(s + (size_t)i * 8), b = *(const f32x4*)(s + (size_t)i * 8 + 4);
        v4u o; o.x = pk2(a[0], a[1]); o.y = pk2(a[2], a[3]); o.z = pk2(b[0], b[1]); o.w = pk2(b[2], b[3]); *(v4u*)(d + (size_t)i * 8) = o; } }
    }
    if (PART == 0) {
    { const float* x = F.in[I_X]; unsigned char* xq = (unsigned char*)F.out + OUT_X8; float* rs1 = WSP(float, WS_RSTD1); float* sx0 = WSP(float, WS_SX0);
#define XR_LOAD(V_, row_) do { _Pragma("unroll") for (int hh_ = 0; hh_ < 2; ++hh_) _Pragma("unroll") for (int q_ = 0; q_ < 4; ++q_) V_[hh_][q_] = *(const f32x4*)(x + (size_t)(row_) * D + hh_ * 1024 + F.lane * 16 + q_ * 4); } while (0)
#define XR_QUANT(V_, row_) do { float s_ = 0.f, am_ = 0.f; \
          _Pragma("unroll") for (int hh_ = 0; hh_ < 2; ++hh_) _Pragma("unroll") for (int q_ = 0; q_ < 4; ++q_) _Pragma("unroll") for (int e_ = 0; e_ < 4; ++e_) { const float t_ = V_[hh_][q_][e_]; s_ += t_ * t_; am_ = fmaxf(am_, fabsf(t_)); } \
          s_ = wave_sum(s_); \
          _Pragma("unroll") for (int o_ = 1; o_ < 64; o_ <<= 1) am_ = fmaxf(am_, __shfl_xor(am_, o_)); \
          const float xq_ = am_ > 0.f ? 127.0f / am_ : 0.f; \
          if (F.lane == 0) { rs1[row_] = am_ * (1.0f / 127.0f) / sqrtf(s_ * (1.0f / D) + NORM_EPS); sx0[row_] = am_ * (1.0f / 127.0f); } \
          _Pragma("unroll") for (int hh_ = 0; hh_ < 2; ++hh_) { v4u o_; \
              _Pragma("unroll") for (int q_ = 0; q_ < 4; ++q_) { unsigned w_ = 0u; \
                  _Pragma("unroll") for (int e_ = 0; e_ < 4; ++e_) { const int qi_ = (int)rintf(V_[hh_][q_][e_] * xq_); w_ |= ((unsigned)qi_ & 0xFFu) << (8 * e_); } \
                  o_[q_] = w_; } \
              *(v4u*)(xq + (size_t)(row_) * D + hh_ * 1024 + F.lane * 16) = o_; } } while (0)
      for (int m = gw; m < T; m += 2 * NGW) { const int mB = m + NGW < T ? m + NGW : m;
          f32x4 xa[2][4], xb2[2][4];
          XR_LOAD(xa, m); XR_LOAD(xb2, mB);
          XR_QUANT(xa, m);
          if (mB != m) XR_QUANT(xb2, mB); }
#undef XR_LOAD
#undef XR_QUANT
    }
    }
}

typedef float f32x2c __attribute__((ext_vector_type(2)));
__device__ __forceinline__ unsigned cvtpk(float lo, float hi) { const f32x2c v = {lo, hi}; const bf16x2_t b = __builtin_convertvector(v, bf16x2_t); return __builtin_bit_cast(unsigned, b); }
__device__ __forceinline__ float rcpf_(float x) { return __builtin_amdgcn_rcpf(x); }
__device__ __forceinline__ float sigmoid_fast(float x) { return rcpf_(1.0f + __expf(-x)); }
__device__ __forceinline__ float tanh_fast(float x) { return 1.0f - 2.0f * rcpf_(1.0f + __expf(2.0f * x)); }
__device__ __forceinline__ float softplus_fast(float z) { return fmaxf(z, 0.f) + __logf(1.0f + __expf(-fabsf(z))); }
__device__ __forceinline__ float gelu_fast(float x) { const float u = 0.7978845608028654f * (x + 0.044715f * x * x * x); return x * rcpf_(1.0f + __expf(-2.0f * u)); }
__device__ __forceinline__ void rwkv_prep_unit(const Frame& F, int chunk, int h, int lane, const LAS bf16* WL2, const LAS bf16* AL2, const LAS bf16* GL2, const LAS float* CW, LAS bf16* ST) {
    asm volatile("" : "+v"(lane));
    const int fr = lane & 15, fq = lane >> 4;
    const bf16* PROJ = WSP(bf16, WS_PROJ); const bf16* LA = WSP(bf16, WS_LA);
    bf16* TA = WSP(bf16, WS_TA); bf16* TB = WSP(bf16, WS_TB); bf16* TK = WSP(bf16, WS_TK); bf16* TR = WSP(bf16, WS_TR);
    bf16* TV = (bf16*)F.out + OUT_TV / 2; bf16* TG = (bf16*)F.out + OUT_TG / 2; float* PCG = F.out + OUT_PC / 4; float* BONG = F.out + OUT_BON / 4;
#define PU4(w_) ((f32x4){bf_lo((w_).x), bf_hi((w_).x), bf_lo((w_).y), bf_hi((w_).y)})
    size_t tokm[2];
#pragma unroll
    for (int mt = 0; mt < 2; ++mt) tokm[mt] = (size_t)chunk * 32 + mt * 16 + fr;
    v2u cA[4][3], cB[4][3], eA[4][3];
    const bool hs = (chunk & 63) != 0; const unsigned hsm = hs ? 0xffffffffu : 0u; const size_t toke = (size_t)chunk * 32 - (hs ? 1 : 0);
#define PREP_LOAD_MT(C_, tok_) do { _Pragma("unroll") for (int nt_ = 0; nt_ < 4; ++nt_) { const bf16* pr_ = PROJ + (tok_) * NINP + PC_R + h * 64 + nt_ * 16 + fq * 4; \
        _Pragma("unroll") for (int q_ = 0; q_ < 3; ++q_) C_[nt_][q_] = *(const v2u*)(pr_ + q_ * 1024); } } while (0)
#define DPPU(old_, src_, ctl_) ((unsigned)__builtin_amdgcn_update_dpp((int)(old_), (int)(src_), ctl_, 0xf, 0xf, false))
#define PREP_PREV(dst_, mt_, nt_, q_) do { const v2u c_ = (mt_) ? cB[nt_][q_] : cA[nt_][q_]; v2u o_; \
        if (mt_) { o_.x = DPPU(0, cA[nt_][q_].x, 0x121); o_.y = DPPU(0, cA[nt_][q_].y, 0x121); } else { o_.x = eA[nt_][q_].x & hsm; o_.y = eA[nt_][q_].y & hsm; } \
        dst_.x = DPPU(o_.x, c_.x, 0x111); dst_.y = DPPU(o_.y, c_.y, 0x111); } while (0)
    PREP_LOAD_MT(cA, tokm[0]); PREP_LOAD_MT(eA, toke);
    bf16x8 la[9];
#pragma unroll
    for (int ks = 0; ks < 9; ++ks) la[ks] = *(const bf16x8*)(LA + tokm[0] * 288 + ks * 32 + 8 * fq);
    PREP_LOAD_MT(cB, tokm[1]);
    float inv[2], bn[2];
#pragma unroll
    for (int mt = 0; mt < 2; ++mt) { float s2 = 0.f;
#pragma unroll
        for (int nt = 0; nt < 4; ++nt) { const int j4 = nt * 16 + fq * 4;
            const v2u kc = mt ? cB[nt][1] : cA[nt][1]; v2u kp; PREP_PREV(kp, mt, nt, 1);
            const f32x4 c_kk = *(const LAS f32x4*)(CW + 128 + j4), m_k = *(const LAS f32x4*)(CW + 384 + j4);
            const f32x4 kcf = PU4(kc); const f32x4 ku = (kcf + (PU4(kp) - kcf) * m_k) * c_kk; s2 += (ku[0] * ku[0] + ku[1] * ku[1]) + (ku[2] * ku[2] + ku[3] * ku[3]); }
        { auto x = __builtin_amdgcn_permlane16_swap(__float_as_uint(s2), __float_as_uint(s2), false, false); s2 = __uint_as_float(x[0]) + __uint_as_float(x[1]); }
        { auto x = __builtin_amdgcn_permlane32_swap(__float_as_uint(s2), __float_as_uint(s2), false, false); s2 = __uint_as_float(x[0]) + __uint_as_float(x[1]); }
        inv[mt] = __builtin_amdgcn_rsqf(fmaxf(s2, 1e-24f)); bn[mt] = 0.f; }
    f32x4 tot0[4];
#pragma unroll
    for (int n = 0; n < 4; ++n) tot0[n] = (f32x4){0.f, 0.f, 0.f, 0.f};
#pragma unroll
    for (int st = 0; st < 8; ++st) { const int mt = st >> 2, nt = st & 3; const int j4 = nt * 16 + fq * 4; const size_t col = (size_t)h * 64 + j4;
        v2u cur_[3], prv_[3];
#pragma unroll
        for (int q = 0; q < 3; ++q) { cur_[q] = mt ? cB[nt][q] : cA[nt][q]; PREP_PREV(prv_[q], mt, nt, q); }
        f32x4 cw = (f32x4){0.f, 0.f, 0.f, 0.f}, ca = cw, cg = cw;
#pragma unroll
        for (int ks = 0; ks < 2; ++ks) { cw = MFMA16(*(const LAS bf16x8*)(WL2 + (nt * 16 + fr) * 72 + ks * 32 + 8 * fq), la[ks], cw); ca = MFMA16(*(const LAS bf16x8*)(AL2 + (nt * 16 + fr) * 72 + ks * 32 + 8 * fq), la[2 + ks], ca); }
#pragma unroll
        for (int ks = 0; ks < 5; ++ks) cg = MFMA16(*(const LAS bf16x8*)(GL2 + (nt * 16 + fr) * 168 + ks * 32 + 8 * fq), la[4 + ks], cg);
        if (st == 3) {
#pragma unroll
            for (int ks = 0; ks < 9; ++ks) la[ks] = *(const bf16x8*)(LA + tokm[1] * 288 + ks * 32 + 8 * fq); }
        const f32x4 c_w0 = *(const LAS f32x4*)(CW + j4), c_a0 = *(const LAS f32x4*)(CW + 64 + j4), c_kk = *(const LAS f32x4*)(CW + 128 + j4), c_ka = *(const LAS f32x4*)(CW + 192 + j4), c_rk = *(const LAS f32x4*)(CW + 256 + j4);
        const f32x4 m_r = *(const LAS f32x4*)(CW + 320 + j4), m_k = *(const LAS f32x4*)(CW + 384 + j4), m_v = *(const LAS f32x4*)(CW + 448 + j4);
        const v2u rp = prv_[0], kp = prv_[1], vp = prv_[2];
        const f32x4 rcf = PU4(cur_[0]), kcf = PU4(cur_[1]), vcf = PU4(cur_[2]);
        const f32x4 rr = rcf + (PU4(rp) - rcf) * m_r, kv = kcf + (PU4(kp) - kcf) * m_k, vv = vcf + (PU4(vp) - vcf) * m_v;
        f32x4 nau, bbu, km, cum;
#pragma unroll
        for (int r = 0; r < 4; ++r) { const float av = sigmoid_fast(c_a0[r] + ca[r]), ku = kv[r] * c_kk[r]; km[r] = kv[r] * (1.0f + (av - 1.0f) * c_ka[r]);
            cum[r] = -0.6065306597126334f * sigmoid_fast(c_w0[r] + cw[r]);
            nau[r] = -ku; bbu[r] = ku * av; bn[mt] += rr[r] * km[r] * c_rk[r]; }
        f32x4 at4, rt4, bt4, kt4, ep4;
#pragma unroll
        for (int r = 0; r < 4; ++r) { float v = cum[r];
            v += __builtin_bit_cast(float, __builtin_amdgcn_update_dpp(0, __builtin_bit_cast(int, v), 0x111, 0xf, 0xf, true));
            v += __builtin_bit_cast(float, __builtin_amdgcn_update_dpp(0, __builtin_bit_cast(int, v), 0x112, 0xf, 0xf, true));
            v += __builtin_bit_cast(float, __builtin_amdgcn_update_dpp(0, __builtin_bit_cast(int, v), 0x114, 0xf, 0xf, true));
            v += __builtin_bit_cast(float, __builtin_amdgcn_update_dpp(0, __builtin_bit_cast(int, v), 0x118, 0xf, 0xf, true));
            if (mt == 0) tot0[nt][r] = __shfl(v, (lane & 48) | 15); else v += tot0[nt][r];
            const float ep = __expf(v), em = rcpf_(ep);
            float eprev = __builtin_bit_cast(float, __builtin_amdgcn_update_dpp(0, __builtin_bit_cast(int, ep), 0x111, 0xf, 0xf, true));
            if (fr == 0) eprev = mt ? __expf(tot0[nt][r]) : 1.0f;
            at4[r] = nau[r] * inv[mt] * eprev; rt4[r] = rr[r] * ep; bt4[r] = bbu[r] * inv[mt] * em; kt4[r] = km[r] * em; ep4[r] = ep; }
        { LAS bf16* sp = ST + fr * 64 + j4; v2u w;
          w.x = cvtpk(at4[0], at4[1]); w.y = cvtpk(at4[2], at4[3]); *(LAS v2u*)(sp) = w;
          w.x = cvtpk(rt4[0], rt4[1]); w.y = cvtpk(rt4[2], rt4[3]); *(LAS v2u*)(sp + 1024) = w;
          w.x = cvtpk(bt4[0], bt4[1]); w.y = cvtpk(bt4[2], bt4[3]); *(LAS v2u*)(sp + 2048) = w;
          w.x = cvtpk(kt4[0], kt4[1]); w.y = cvtpk(kt4[2], kt4[3]); *(LAS v2u*)(sp + 3072) = w;
          w.x = cvtpk(vv[0], vv[1]); w.y = cvtpk(vv[2], vv[3]); *(LAS v2u*)(sp + 4096) = w;
          w.x = cvtpk(cg[0], cg[1]); w.y = cvtpk(cg[2], cg[3]); *(LAS v2u*)(sp + 5120) = w; }
        if (nt == 3) {
            bf16* const dstp[6] = {TA, TR, TB, TK, TV, TG};
#pragma unroll
            for (int a6 = 0; a6 < 6; ++a6)
#pragma unroll
                for (int hrow = 0; hrow < 2; ++hrow) { const int row = hrow * 8 + (lane >> 3), c8 = (lane & 7) * 8;
                    const v4u pv = *(const LAS v4u*)(ST + a6 * 1024 + row * 64 + c8);
                    *(v4u*)(dstp[a6] + ((size_t)chunk * 32 + mt * 16 + row) * 1024 + (size_t)h * 64 + c8) = pv; } }
        if (mt == 1 && fr == 15) *(f32x4*)(PCG + (size_t)chunk * 1024 + col) = ep4;
    }
#undef PREP_LOAD_MT
#undef PREP_PREV
#undef DPPU
#undef PU4
#pragma unroll
    for (int mt = 0; mt < 2; ++mt) { float b2 = bn[mt];
        { auto x = __builtin_amdgcn_permlane16_swap(__float_as_uint(b2), __float_as_uint(b2), false, false); b2 = __uint_as_float(x[0]) + __uint_as_float(x[1]); }
        { auto x = __builtin_amdgcn_permlane32_swap(__float_as_uint(b2), __float_as_uint(b2), false, false); b2 = __uint_as_float(x[0]) + __uint_as_float(x[1]); }
        if (fq == 0) BONG[tokm[mt] * 16 + h] = b2; }
}
__device__ __forceinline__ void rwkv_prep_phase(const Frame& F) {
    LAS bf16* WL2 = (LAS bf16*)(F.lds + 0); LAS bf16* AL2 = (LAS bf16*)(F.lds + 9216); LAS bf16* GL2 = (LAS bf16*)(F.lds + 18432); LAS float* CW = (LAS float*)(F.lds + 39936);
    int hcur = -1;
    for (int u = F.bid; u < 1024; u += F.G) { const int h = u & 15, cg = u >> 4;
        if (h != hcur) { hcur = h; __syncthreads();
            int tid_ = F.tid; asm volatile("" : "+v"(tid_));
            const bf16* w2t = WSP(bf16, WS_W2T) + (size_t)h * 64 * 64; const bf16* a2t = WSP(bf16, WS_A2T) + (size_t)h * 64 * 64; const bf16* g2t = WSP(bf16, WS_G2T) + (size_t)h * 64 * 160;
            { const int r = tid_ >> 3, c = (tid_ & 7) * 8; *(LAS v4u*)(WL2 + r * 72 + c) = *(const v4u*)(w2t + r * 64 + c); *(LAS v4u*)(AL2 + r * 72 + c) = *(const v4u*)(a2t + r * 64 + c); }
            for (int i = tid_; i < 64 * 20; i += NTHR) { const int r = i / 20, c = (i - r * 20) * 8; *(LAS v4u*)(GL2 + r * 168 + c) = *(const v4u*)(g2t + r * 160 + c); }
            { const int q = tid_ >> 6, jj = tid_ & 63; const float* src = q == 0 ? F.in[I_W0] : (q == 1 ? F.in[I_A0] : (q == 2 ? F.in[I_KK] : (q == 3 ? F.in[I_KA] : (q == 4 ? F.in[I_RK] : F.in[I_MU] + (q - 5) * 1024)))); CW[q * 64 + jj] = src[h * 64 + jj]; }
            __syncthreads(); }
        rwkv_prep_unit(F, cg * 8 + F.wave, h, F.lane, WL2, AL2, GL2, CW, (LAS bf16*)(F.lds + 43008 + F.wave * 12288)); }
    __syncthreads();
}
typedef short v4i16_t __attribute__((ext_vector_type(4)));
__device__ __forceinline__ bf16x8 frag_tr16(const LAS bf16* p, int ld) {
    const v4i16_t a = __builtin_amdgcn_ds_read_tr16_b64_v4i16((LAS v4i16_t*)p), b = __builtin_amdgcn_ds_read_tr16_b64_v4i16((LAS v4i16_t*)(p + 4 * ld));
    return (bf16x8){a[0], a[1], a[2], a[3], b[0], b[1], b[2], b[3]};
}
#define RD_LOAD(src_, act_, row0_, j_) do { const float* tp_ = (src_) + ((act_) ? ((size_t)((row0_) + ((j_) >> 1)) * D + ((j_) & 1) * 1024) : (size_t)0) + lane * 16; \
        _Pragma("unroll") for (int q_ = 0; q_ < 4; ++q_) th[q_] = *(const f32x4*)(tp_ + q_ * 4); } while (0)
#define RD_PACK(dst_, v_, tq_) do { _Pragma("unroll") for (int q_ = 0; q_ < 4; ++q_) {   \
            const unsigned b0_ = __float_as_uint(__builtin_fmaf(v_[q_][0], tq_, 12582912.0f)), b1_ = __float_as_uint(__builtin_fmaf(v_[q_][1], tq_, 12582912.0f)); \
            const unsigned b2_ = __float_as_uint(__builtin_fmaf(v_[q_][2], tq_, 12582912.0f)), b3_ = __float_as_uint(__builtin_fmaf(v_[q_][3], tq_, 12582912.0f)); \
            dst_[q_] = __builtin_amdgcn_perm(b1_, b0_, 0x0c0c0400u) | __builtin_amdgcn_perm(b3_, b2_, 0x04000c0cu); } } while (0)
#define RD_CONSUME(dstb_, scb_, row0_, j_) do { float am_ = 0.f; \
        _Pragma("unroll") for (int q_ = 0; q_ < 4; ++q_) _Pragma("unroll") for (int e_ = 0; e_ < 4; ++e_) am_ = fmaxf(am_, fabsf(th[q_][e_])); \
        if (((j_) & 1) == 0) { _Pragma("unroll") for (int q_ = 0; q_ < 4; ++q_) tk[q_] = th[q_]; tkm = am_; } \
        else { am_ = fmaxf(am_, tkm); \
            am_ = fmaxf(am_, dppf<0xB1>(am_)); am_ = fmaxf(am_, dppf<0x4E>(am_)); am_ = fmaxf(am_, dppf<0x141>(am_)); am_ = fmaxf(am_, dppf<0x140>(am_)); \
            { auto s_ = __builtin_amdgcn_permlane16_swap(__float_as_uint(am_), __float_as_uint(am_), false, false); am_ = fmaxf(__uint_as_float(s_[0]), __uint_as_float(s_[1])); } \
            { auto s_ = __builtin_amdgcn_permlane32_swap(__float_as_uint(am_), __float_as_uint(am_), false, false); am_ = fmaxf(__uint_as_float(s_[0]), __uint_as_float(s_[1])); } \
            const float tq_ = am_ > 0.f ? 127.0f / am_ : 0.f; const size_t ro_ = (size_t)((row0_) + ((j_) >> 1)); \
            if (lane == 0) (scb_)[ro_] = am_ * (1.0f / 127.0f); \
            v4u o0_, o1_; RD_PACK(o0_, tk, tq_); RD_PACK(o1_, th, tq_); \
            *(v4u*)((dstb_) + ro_ * D + lane * 16) = o0_; *(v4u*)((dstb_) + ro_ * D + 1024 + lane * 16) = o1_; } } while (0)
__device__ __forceinline__ void rwkv_item(const Frame& F, int item) {
    const int b = item >> 4, h = item & 15, wave = F.wave; int tid = F.tid; asm volatile("" : "+v"(tid)); const int lane = tid & 63;
    LAS unsigned char* L = F.lds;
    constexpr int LD64 = 72, LD32 = 40, E0 = 73216;
    LAS bf16* AT = (LAS bf16*)(L + 0);  LAS bf16* BT_ = (LAS bf16*)(L + 4608); LAS bf16* KT_ = (LAS bf16*)(L + 9216); LAS bf16* RT = (LAS bf16*)(L + 13824);
    LAS bf16* VS2 = (LAS bf16*)(L + 18432);
    LAS bf16* GGB2 = (LAS bf16*)(L + 27648);
    LAS bf16* S0B = (LAS bf16*)(L + 36864);
    LAS float* YB2 = (LAS float*)(L + 55296);
    LAS float* BON2 = (LAS float*)(L + 72704);
    LAS float* PC = (LAS float*)(L + 72960);
    LAS bf16* AAK = (LAS bf16*)(L + E0); LAS bf16* ARB = (LAS bf16*)(L + E0 + 2560); LAS bf16* ARK = (LAS bf16*)(L + E0 + 5120);
    LAS bf16* MINV = (LAS bf16*)(L + E0 + 7680);
    LAS bf16* RHS = (LAS bf16*)(L + E0 + 23040);
    LAS bf16* SAB = (LAS bf16*)(L + E0 + 28160);
    static_assert(E0 + 33280 <= LDSCTL_OFF, "rwkv LDS map");
    bf16* Y = WSP(bf16, WS_Y);
#define FRAG(base, row0, ld, ks) (*(const LAS bf16x8*)((base) + ((row0) + fr) * (ld) + (ks) * 32 + 8 * fq))
#define FRAGT(base, col0, ld) frag_tr16((base) + (8 * fq + (fr >> 2)) * (ld) + (col0) + 4 * (fr & 3), (ld))
    const int tt = tid >> 4, j0 = (tid & 15) * 4, hc = h * 64 + j0;
    const f32x4 plw = *(const f32x4*)(F.in[I_LNW] + hc), plb = *(const f32x4*)(F.in[I_LNB] + hc);
    const int lr = (tid & 255) >> 3, lc8 = tid & 7; const bool hi2 = tid >= 256;
    const bf16* srcA[3] = { (hi2 ? WSP(bf16, WS_TR) : WSP(bf16, WS_TA)), (hi2 ? WSP(bf16, WS_TK) : WSP(bf16, WS_TB)), (hi2 ? (const bf16*)F.out + OUT_TG / 2 : (const bf16*)F.out + OUT_TV / 2) };
    const size_t poff = ((size_t)b * SEQ + lr) * 1024 + h * 64 + lc8 * 8;
    const float* PCG = F.out + OUT_PC / 4 + (size_t)(b * 64) * 1024 + h * 64; const float* BONG = F.out + OUT_BON / 4 + (size_t)b * SEQ * 16 + h;
    v4u pl_[3]; float ppc = 0.f, pbn = 0.f;
#define RWKV_PREFETCH(tl_) do { _Pragma("unroll") for (int q_ = 0; q_ < 3; ++q_) pl_[q_] = *(const v4u*)(srcA[q_] + poff + (size_t)(tl_) * 32 * 1024); \
        ppc = PCG[(size_t)(tl_) * 1024 + (tid & 63)]; pbn = BONG[((size_t)(tl_) * 32 + (tid & 31)) * 16]; } while (0)
    const int ib = wave >> 1, tb = wave & 1, i0 = ib * 16, t0m = tb * 16;
    f32x4 sacc[2], yacc;
    sacc[0] = (f32x4){0.f, 0.f, 0.f, 0.f}; sacc[1] = sacc[0]; yacc = sacc[0];
    for (int u = tid; u < 2 * 64 * LD64 / 2; u += NTHR) ((LAS unsigned*)S0B)[u] = 0u;
    const int trow0 = (item * 4 + (wave & 3)) * 32; const bool tconv = wave >= 4;
    f32x4 th[4], tk[4]; float tkm = 0.f;
#pragma unroll
    for (int q = 0; q < 4; ++q) tk[q] = (f32x4){0.f, 0.f, 0.f, 0.f};
    RWKV_PREFETCH(0);
    RD_LOAD(F.in[I_U], tconv, trow0, 0);
    __syncthreads();
    for (int tl = 0; tl <= SEQ / 32; ++tl) {
        const int cur = tl & 1;
        int lane_c = lane; asm volatile("" : "+v"(lane_c)); const int fr = lane_c & 15, fq = lane_c >> 4;
        LAS bf16* VS = VS2 + cur * 32 * LD64; LAS bf16* GGB = GGB2 + cur * 32 * LD64; LAS float* YB = YB2 + cur * 32 * 68; LAS float* BON = BON2 + cur * 32;
        const LAS bf16* VSp = VS2 + (cur ^ 1) * 32 * LD64; const LAS bf16* GGBp = GGB2 + (cur ^ 1) * 32 * LD64; const LAS float* YBp = YB2 + (cur ^ 1) * 32 * 68; const LAS float* BONp = BON2 + (cur ^ 1) * 32;
        if (tl > 0) { const size_t tokb = (size_t)b * SEQ + (tl - 1) * 32;
          const f32x4 y4 = *(const LAS f32x4*)(YBp + tt * 68 + j0); const v2u gw_ = *(const LAS v2u*)(GGBp + tt * LD64 + j0);
          const f32x4 g4 = (f32x4){bf_lo(gw_.x), bf_hi(gw_.x), bf_lo(gw_.y), bf_hi(gw_.y)};
          const v2u vw_ = *(const LAS v2u*)(VSp + tt * LD64 + j0); const f32x4 v4 = (f32x4){bf_lo(vw_.x), bf_hi(vw_.x), bf_lo(vw_.y), bf_hi(vw_.y)};
          float sm = (y4[0] + y4[1]) + (y4[2] + y4[3]); sm = red16(sm); const float mean = sm * (1.0f / 64.0f);
          const f32x4 d4 = y4 - mean; float sv = (d4[0] * d4[0] + d4[1] * d4[1]) + (d4[2] * d4[2] + d4[3] * d4[3]); sv = red16(sv);
          const float rstd = __builtin_amdgcn_rsqf(sv * (1.0f / 64.0f) + GN_EPS), bon = BONp[tt];
          f32x4 o;
#pragma unroll
          for (int e = 0; e < 4; ++e) o[e] = (d4[e] * rstd * plw[e] + plb[e] + bon * v4[e]) * g4[e];
          v2u w; w.x = cvtpk(o[0], o[1]); w.y = cvtpk(o[2], o[3]);
          *(v2u*)(Y + (tokb + tt) * D + 1024 + hc) = w; }
        if (tl == SEQ / 32) break;
        const LAS bf16* S0c = S0B + cur * 64 * LD64; LAS bf16* S0n = S0B + (cur ^ 1) * 64 * LD64;
        { const v4u p0 = pl_[0], p1 = pl_[1], p2 = pl_[2];
          *(LAS v4u*)((hi2 ? RT : AT) + lr * LD64 + lc8 * 8) = p0;
          *(LAS v4u*)((hi2 ? KT_ : BT_) + lr * LD64 + lc8 * 8) = p1;
          *(LAS v4u*)((hi2 ? GGB : VS) + lr * LD64 + lc8 * 8) = p2;
          if (tid < 64) PC[tid] = ppc;
          if (tid >= 64 && tid < 96) BON[tid - 64] = pbn; }
        { const int tn_ = tl + 1 < SEQ / 32 ? tl + 1 : SEQ / 32 - 1; RWKV_PREFETCH(tn_); }
        __syncthreads();
        f32x4 rhs4 = (f32x4){0.f, 0.f, 0.f, 0.f};
#define RWKV_FIRST do { rhs4 = (f32x4){0.f, 0.f, 0.f, 0.f}; yacc = (f32x4){0.f, 0.f, 0.f, 0.f}; \
            _Pragma("unroll") for (int ks = 0; ks < 2; ++ks) rhs4 = MFMA16(FRAG(AT, t0m, LD64, ks), FRAG(S0c, i0, LD64, ks), rhs4); \
            _Pragma("unroll") for (int ks = 0; ks < 2; ++ks) yacc = MFMA16(FRAG(S0c, i0, LD64, ks), FRAG(RT, t0m, LD64, ks), yacc); \
            _Pragma("unroll") for (int u = 0; u < 2; ++u) { const int tile = wave * 2 + u, si0 = (tile >> 2) * 16, sj0 = (tile & 3) * 16; sacc[u] = MFMA16(FRAGT(KT_, sj0, LD64), FRAGT(VS, si0, LD64), sacc[u]); } } while (0)
#define PK8(a_, s_) __builtin_bit_cast(bf16x8, (v4u){cvtpk(a_[8 * (s_) + 0], a_[8 * (s_) + 1]), cvtpk(a_[8 * (s_) + 2], a_[8 * (s_) + 3]), cvtpk(a_[8 * (s_) + 4], a_[8 * (s_) + 5]), cvtpk(a_[8 * (s_) + 6], a_[8 * (s_) + 7])})
        if (wave == 0) {
            const int c32 = lane_c & 31, h32 = lane_c >> 5;
            f32x16 U, V, PT;
#pragma unroll
            for (int e = 0; e < 16; ++e) { U[e] = 0.f; V[e] = 0.f; }
#pragma unroll
            for (int ks = 0; ks < 4; ++ks) { const bf16x8 fa = *(const LAS bf16x8*)(AT + c32 * LD64 + ks * 16 + h32 * 8), fb = *(const LAS bf16x8*)(BT_ + c32 * LD64 + ks * 16 + h32 * 8);
                U = MFMA32(fa, fb, U);
                V = MFMA32(fb, fa, V); }
#pragma unroll
            for (int e = 0; e < 16; ++e) { const int rr = (e & 3) + 8 * (e >> 2) + 4 * h32;
                U[e] = (c32 < rr) ? U[e] : 0.f;
                V[e] = (rr < c32) ? V[e] : 0.f;
                PT[e] = V[e] + ((rr == c32) ? 1.0f : 0.f); }
#pragma unroll
            for (int st = 1; st <= 5; ++st) {
                const bf16x8 fU0 = PK8(U, 0), fU1 = PK8(U, 1);
                f32x16 Un, Vn;
#pragma unroll
                for (int e = 0; e < 16; ++e) { Un[e] = 0.f; Vn[e] = 0.f; }
                if (st < 5) { const bf16x8 fV0 = PK8(V, 0), fV1 = PK8(V, 1);
                    Un = MFMA32(fV0, fU0, Un); Un = MFMA32(fV1, fU1, Un);
                    if (st < 4) { Vn = MFMA32(fU0, fV0, Vn); Vn = MFMA32(fU1, fV1, Vn); } }
                if (st > 1) { const bf16x8 fP0 = PK8(PT, 0), fP1 = PK8(PT, 1);
                    PT = MFMA32(fU0, fP0, PT); PT = MFMA32(fU1, fP1, PT); }
                U = Un; V = Vn; }
#pragma unroll
            for (int q = 0; q < 4; ++q) { v2u w; w.x = cvtpk(PT[4 * q], PT[4 * q + 1]); w.y = cvtpk(PT[4 * q + 2], PT[4 * q + 3]); *(LAS v2u*)(MINV + c32 * LD32 + 8 * q + 4 * h32) = w; }
        } else {
            if (wave < 7) { const int mtx = (wave - 1) >> 1;
                const LAS bf16* Xs = (mtx == 1) ? BT_ : KT_; const LAS bf16* Yt = (mtx == 0) ? AT : RT; LAS bf16* O = (mtx == 0) ? AAK : (mtx == 1 ? ARB : ARK);
#pragma unroll
                for (int qq = 0; qq < 2; ++qq) { const int q = ((wave - 1) & 1) * 2 + qq, tq = (q >> 1) * 16, sq = (q & 1) * 16;
                    f32x4 a4 = (f32x4){0.f, 0.f, 0.f, 0.f};
                    if (sq <= tq) {
#pragma unroll
                        for (int ks = 0; ks < 2; ++ks) a4 = MFMA16(FRAG(Xs, sq, LD64, ks), FRAG(Yt, tq, LD64, ks), a4); }
                    const int t = tq + fr, s = sq + fq * 4;
#pragma unroll
                    for (int r = 0; r < 4; ++r) { const bool keep = (mtx == 0) ? (s + r < t) : (s + r <= t); a4[r] = keep ? a4[r] : 0.f; }
                    v2u w; w.x = cvtpk(a4[0], a4[1]); w.y = cvtpk(a4[2], a4[3]); *(LAS v2u*)(O + t * LD32 + s) = w; } }
            RWKV_FIRST;
            if (tconv) RD_CONSUME(WSP(unsigned char, WS_UT), WSP(float, WS_USC), trow0, tl);
        }
        { const int tn_ = tl + 1 < SEQ / 32 ? tl + 1 : SEQ / 32 - 1; RD_LOAD(F.in[I_U], tconv, trow0, tn_); }
        __syncthreads();
        if (wave == 0) RWKV_FIRST;
        { rhs4 = MFMA16(FRAG(AAK, t0m, LD32, 0), FRAGT(VS, i0, LD64), rhs4);
          v2u w; w.x = cvtpk(rhs4[0], rhs4[1]); w.y = cvtpk(rhs4[2], rhs4[3]); *(LAS v2u*)(RHS + (i0 + fr) * LD32 + t0m + fq * 4) = w;
          yacc = MFMA16(FRAGT(VS, i0, LD64), FRAG(ARK, t0m, LD32, 0), yacc); }
        __syncthreads();
#undef RWKV_FIRST
#undef PK8
        { f32x4 a4 = (f32x4){0.f, 0.f, 0.f, 0.f}; a4 = MFMA16(FRAG(MINV, t0m, LD32, 0), FRAG(RHS, i0, LD32, 0), a4);
          v2u w; w.x = cvtpk(a4[0], a4[1]); w.y = cvtpk(a4[2], a4[3]); *(LAS v2u*)(SAB + (i0 + fr) * LD32 + t0m + fq * 4) = w; }
        __syncthreads();
        { yacc = MFMA16(FRAG(SAB, i0, LD32, 0), FRAG(ARB, t0m, LD32, 0), yacc);
          *(LAS f32x4*)(YB + (t0m + fr) * 68 + i0 + fq * 4) = yacc;
#pragma unroll
          for (int u = 0; u < 2; ++u) { const int tile = wave * 2 + u, si0 = (tile >> 2) * 16, sj0 = (tile & 3) * 16;
              sacc[u] = MFMA16(FRAGT(BT_, sj0, LD64), FRAG(SAB, si0, LD32, 0), sacc[u]);
              const f32x4 pc = *(const LAS f32x4*)(PC + sj0 + fq * 4); sacc[u] = sacc[u] * pc;
              v2u w; w.x = cvtpk(sacc[u][0], sacc[u][1]); w.y = cvtpk(sacc[u][2], sacc[u][3]); *(LAS v2u*)(S0n + (si0 + fr) * LD64 + sj0 + fq * 4) = w; } }
        __syncthreads();
    }
    __syncthreads();
#undef FRAG
#undef FRAGT
#undef RWKV_PREFETCH
}
__device__ __forceinline__ void lora_prepass(const Frame& F) {
    const bf16* PROJ = WSP(bf16, WS_PROJ); bf16* LA = WSP(bf16, WS_LA); const float* mu = F.in[I_MU] + (PC_WD - RWKV_C0);
    const int gt = (F.bid * NWAVES + F.wave) * 64 + F.lane, NGT = F.G * NTHR;
    for (int i = gt; i < T * 36; i += NGT) { const int tok = i / 36, cc = i - tok * 36, m = cc * 8;
        const bf16* pr = PROJ + (size_t)tok * NINP + PC_WD + m;
        const v4u curv = *(const v4u*)pr; v4u prv = (v4u){0u, 0u, 0u, 0u}; if ((tok & (SEQ - 1)) != 0) prv = *(const v4u*)(pr - NINP);
        const f32x4 m0 = *(const f32x4*)(mu + m), m1 = *(const f32x4*)(mu + m + 4);
        float c[8], p[8], o[8]; unpack8(curv, c); unpack8(prv, p);
#pragma unroll
        for (int e = 0; e < 8; ++e) { const float ps = c[e] + (p[e] - c[e]) * (e < 4 ? m0[e] : m1[e - 4]); o[e] = (m < 64) ? tanh_fast(ps) : ((m < 128) ? ps : sigmoid_fast(ps)); }
        v4u w; w.x = cvtpk(o[0], o[1]); w.y = cvtpk(o[2], o[3]); w.z = cvtpk(o[4], o[5]); w.w = cvtpk(o[6], o[7]);
        *(v4u*)(LA + (size_t)tok * 288 + m) = w; }
}
__device__ __forceinline__ void lru_seq(const Frame& F, int item) {
    const int bh = item >> 1, hf = item & 1, b = bh >> 3, h = bh & 7, wave = F.wave; int tid = F.tid; asm volatile("" : "+v"(tid)); const int lane = tid & 63;
    LAS unsigned char* L = F.lds;
    LAS bf16* XA = (LAS bf16*)(L + 0);
    LAS float* XC = (LAS float*)(L + 17408);
    LAS float* RI = (LAS float*)(L + 50176);
    LAS float* SEG = (LAS float*)(L + 115712);
    LAS float* CARRY = (LAS float*)(L + 119808);
    LAS float* CW = (LAS float*)(L + 120320);
    const bf16* PROJ = WSP(bf16, WS_PROJ); bf16* Y = WSP(bf16, WS_Y);
    const int fr0 = lane & 15, fq0 = lane >> 4;
    for (int i = tid; i < 640; i += NTHR) { const int w = i >> 7, cch = i & 127; CW[i] = (w < 4) ? F.in[I_CONVW][w * 1024 + h * 128 + cch] : F.in[I_CONVB][h * 128 + cch]; }
    if (tid < 64) CARRY[tid] = 0.f;
    const int gsel = wave & 1, ntl = wave >> 1, ntg = hf * 4 + ntl;
    bf16x8 wf[4];
    { const bf16* WTp = (gsel ? WSP(bf16, WS_WIT) : WSP(bf16, WS_WAT)) + (size_t)h * 128 * 128;
#pragma unroll
      for (int ks = 0; ks < 4; ++ks) wf[ks] = *(const bf16x8*)(WTp + (ntg * 16 + fr0) * 128 + ks * 32 + 8 * fq0); }
    const int c = tid & 63, sg = tid >> 6, chl = hf * 64 + c, chg = h * 128 + chl;
    const float ba_c = F.in[I_BA][chg], bi_c = F.in[I_BI][chg], sp8 = 8.0f * softplus_fast(-F.in[I_LAM][chg]);
    v4u pf[2][4];
#define LRU_PREFETCH(k_) do { _Pragma("unroll") for (int u_ = 0; u_ < 2; ++u_) { const int chn_ = tid + NTHR * u_, t_ = chn_ >> 4, c8_ = (chn_ & 15) * 8; \
        _Pragma("unroll") for (int w_ = 0; w_ < 4; ++w_) { const int ts_ = (k_) * 64 + t_ - 3 + w_; const int tc_ = ts_ >= 0 ? ts_ : 0;   \
            const v4u x_ = *(const v4u*)(PROJ + ((size_t)b * SEQ + tc_) * NINP + h * 128 + c8_); const unsigned m_ = ts_ >= 0 ? 0xffffffffu : 0u; \
            pf[u_][w_] = (v4u){x_.x & m_, x_.y & m_, x_.z & m_, x_.w & m_}; } } } while (0)
    unsigned short gtn[8];
#define LRU_GATES(k_) do { _Pragma("unroll") for (int e_ = 0; e_ < 8; ++e_) gtn[e_] = PROJ[((size_t)b * SEQ + (k_) * 64 + sg * 8 + e_) * NINP + PC_GATE + chg]; } while (0)
    const int trow0 = (item * 8 + wave) * 16;
    f32x4 th[4], tk[4]; float tkm = 0.f;
#pragma unroll
    for (int q = 0; q < 4; ++q) tk[q] = (f32x4){0.f, 0.f, 0.f, 0.f};
    LRU_PREFETCH(0); LRU_GATES(0);
    RD_LOAD(F.in[I_V], true, trow0, 0);
    __syncthreads();
    for (int k = 0; k < SEQ / 64; ++k) {
        const size_t tokbase = (size_t)b * SEQ + k * 64;
        int lane_c = lane; asm volatile("" : "+v"(lane_c)); const int fr = lane_c & 15, fq = lane_c >> 4;
#pragma unroll
        for (int u = 0; u < 2; ++u) { const int chn = tid + NTHR * u, t = chn >> 4, c8 = (chn & 15) * 8;
            float acc[8]; { const f32x4 b0 = *(const LAS f32x4*)(CW + 512 + c8), b1 = *(const LAS f32x4*)(CW + 512 + c8 + 4);
#pragma unroll
                for (int e = 0; e < 4; ++e) { acc[e] = b0[e]; acc[e + 4] = b1[e]; } }
#pragma unroll
            for (int w = 0; w < 4; ++w) { float xf[8]; unpack8(pf[u][w], xf);
                const f32x4 w0 = *(const LAS f32x4*)(CW + w * 128 + c8), w1 = *(const LAS f32x4*)(CW + w * 128 + c8 + 4);
#pragma unroll
                for (int e = 0; e < 4; ++e) { acc[e] += w0[e] * xf[e]; acc[e + 4] += w1[e] * xf[e + 4]; } }
            v4u pk; pk.x = cvtpk(acc[0], acc[1]); pk.y = cvtpk(acc[2], acc[3]); pk.z = cvtpk(acc[4], acc[5]); pk.w = cvtpk(acc[6], acc[7]);
            *(LAS v4u*)(XA + t * 136 + c8) = pk;
            LAS float* d = XC + t * 128 + c8; *(LAS f32x4*)d = (f32x4){acc[0], acc[1], acc[2], acc[3]}; *(LAS f32x4*)(d + 4) = (f32x4){acc[4], acc[5], acc[6], acc[7]}; }
        float gl[8];
#pragma unroll
        for (int e = 0; e < 8; ++e) gl[e] = gelu_fast(__uint_as_float((unsigned)gtn[e] << 16));
        { const int kn_ = k + 1 < SEQ / 64 ? k + 1 : SEQ / 64 - 1; LRU_PREFETCH(kn_); LRU_GATES(kn_); }
        __syncthreads();
#pragma unroll
        for (int mt = 0; mt < 4; ++mt) {
            bf16x8 af[4];
#pragma unroll
            for (int ks = 0; ks < 4; ++ks) af[ks] = *(const LAS bf16x8*)(XA + (mt * 16 + fr) * 136 + ks * 32 + 8 * fq);
            { f32x4 a4 = (f32x4){0.f, 0.f, 0.f, 0.f};
#pragma unroll
                for (int ks = 0; ks < 4; ++ks) a4 = MFMA16(wf[ks], af[ks], a4);
                *(LAS f32x4*)(RI + gsel * 8192 + (mt * 16 + fr) * 128 + ntl * 16 + fq * 4) = a4; } }
        __syncthreads();
        float av[8], bx[8]; float A = 1.f, B = 0.f;
#pragma unroll
        for (int e = 0; e < 8; ++e) { const int t = sg * 8 + e; const float r = sigmoid_fast(RI[t * 128 + c] + ba_c), ig = sigmoid_fast(RI[8192 + t * 128 + c] + bi_c), xc = XC[t * 128 + chl];
            const float la = -sp8 * r; av[e] = __expf(la); bx[e] = sqrtf(fmaxf(1.0f - av[e] * av[e], 0.f)) * (ig * xc); A *= av[e]; B = av[e] * B + bx[e]; }
        SEG[(sg * 64 + c) * 2] = A; SEG[(sg * 64 + c) * 2 + 1] = B;
        __syncthreads();
        float hst = CARRY[c];
        for (int s2 = 0; s2 < sg; ++s2) hst = SEG[(s2 * 64 + c) * 2] * hst + SEG[(s2 * 64 + c) * 2 + 1];
#pragma unroll
        for (int e = 0; e < 8; ++e) { hst = av[e] * hst + bx[e];
            Y[(tokbase + sg * 8 + e) * D + chg] = (bf16)(cvtpk(hst * gl[e], 0.f) & 0xffffu); }
        RD_CONSUME(WSP(unsigned char, WS_VT), WSP(float, WS_VSC), trow0, k);
        { const int kn_ = k + 1 < SEQ / 64 ? k + 1 : SEQ / 64 - 1; RD_LOAD(F.in[I_V], true, trow0, kn_); }
        __syncthreads();
        if (sg == 7) CARRY[c] = hst;
    }
    __syncthreads();
#undef LRU_PREFETCH
#undef LRU_GATES
}
__device__ __forceinline__ void group_barrier(unsigned* cnt, unsigned n) {
    asm volatile("s_waitcnt vmcnt(0)" ::: "memory");
    __syncthreads();
    if (threadIdx.x == 0) {
        __builtin_amdgcn_fence(__ATOMIC_RELEASE, "agent");
        asm volatile("s_waitcnt vmcnt(0)" ::: "memory");
        xb_add(cnt, 1u);
        unsigned sp = 0; while (xb_ld(cnt) < n) { __builtin_amdgcn_s_sleep(2); if (++sp > (1u << 24)) break; }
        __builtin_amdgcn_fence(__ATOMIC_ACQUIRE, "agent");
        asm volatile("s_waitcnt vmcnt(0)" ::: "memory");
    }
    __syncthreads();
}

__device__ __forceinline__ unsigned f2ord(float f) { const unsigned u = __builtin_bit_cast(unsigned, f); return (u & 0x80000000u) ? ~u : (u | 0x80000000u); }
__device__ __forceinline__ float ord2f(unsigned o) { const unsigned u = (o & 0x80000000u) ? (o & 0x7fffffffu) : ~o; return __builtin_bit_cast(float, u); }
#define CMPX(hi_, lo_) do { const unsigned _a = (hi_), _b = (lo_); (hi_) = _a > _b ? _a : _b; (lo_) = _a > _b ? _b : _a; } while (0)
template <int N> __device__ __forceinline__ void sort_desc(unsigned (&a)[N]) {
#pragma unroll
    for (int k = 2; k <= N; k <<= 1)
#pragma unroll
        for (int j = k >> 1; j > 0; j >>= 1)
#pragma unroll
            for (int i = 0; i < N; ++i) { const int l = i ^ j; if (l > i) { if ((i & k) == 0) CMPX(a[i], a[l]); else CMPX(a[l], a[i]); } }
}
__device__ __forceinline__ void merge16(unsigned (&A)[16], const unsigned (&B)[16]) {
#pragma unroll
    for (int i = 0; i < 16; ++i) { const unsigned q = B[15 - i]; A[i] = A[i] > q ? A[i] : q; }
#pragma unroll
    for (int d = 8; d >= 1; d >>= 1)
#pragma unroll
        for (int i = 0; i < 16; ++i) if ((i & d) == 0) CMPX(A[i], A[i + d]);
}
__device__ __forceinline__ void merge_partner(unsigned (&Lk)[16]) {
    unsigned P[16];
#pragma unroll
    for (int i = 0; i < 16; ++i) P[i] = (unsigned)__shfl_xor((int)Lk[i], 32);
#pragma unroll
    for (int i = 0; i < 16; ++i) { const unsigned q = P[15 - i]; Lk[i] = Lk[i] > q ? Lk[i] : q; }
#pragma unroll
    for (int d = 8; d >= 1; d >>= 1)
#pragma unroll
        for (int i = 0; i < 16; ++i) if ((i & d) == 0) CMPX(Lk[i], Lk[i + d]);
}
__device__ __forceinline__ void route_item(const Frame& F, int item, int lane) {
    const int tok0 = (item >> 3) * 32, h = item & 7, c = lane & 31, hi = lane >> 5;
    const bf16* Q = WSP(bf16, WS_Q); const bf16* KB = WSP(bf16, WS_KEYS);
    LAS unsigned* WL = (LAS unsigned*)(F.lds + F.wave * 8192);
    unsigned LST[2][16];
    bf16x8 qf[8], qn[8], kf[8], kn[8];
#pragma unroll
    for (int ks = 0; ks < 8; ++ks) { qf[ks] = *(const bf16x8*)(Q + (size_t)(tok0 + c) * D + h * 256 + ks * 16 + 8 * hi); qn[ks] = *(const bf16x8*)(Q + (size_t)(tok0 + c) * D + h * 256 + 128 + ks * 16 + 8 * hi);
        kf[ks] = *(const bf16x8*)(KB + (size_t)((h * 2) * 128 + c) * 128 + 8 * hi + ks * 16); }
    unsigned Lk[16];
#pragma unroll
    for (int st = 0; st < 8; ++st) { const int p = st >> 2, m = st & 3;
        if (st < 7) { const int p2 = (st + 1) >> 2, m2 = (st + 1) & 3; const bf16* kp = KB + (size_t)((h * 2 + p2) * 128 + m2 * 32 + c) * 128 + 8 * hi;
#pragma unroll
            for (int ks = 0; ks < 8; ++ks) kn[ks] = *(const bf16x8*)(kp + ks * 16); }
        f32x16 acc;
#pragma unroll
        for (int r = 0; r < 16; ++r) acc[r] = 0.f;
#pragma unroll
        for (int ks = 0; ks < 8; ++ks) acc = MFMA32(kf[ks], p ? qn[ks] : qf[ks], acc);
        unsigned G16[16];
#pragma unroll
        for (int r = 0; r < 16; ++r) { const unsigned idx = (unsigned)(m * 32 + (r & 3) + 8 * (r >> 2)) | ((unsigned)hi << 2); G16[r] = (f2ord(acc[r]) & ~0x7Fu) | idx; }
        sort_desc<16>(G16);
        if (m == 0) {
#pragma unroll
            for (int i = 0; i < 16; ++i) Lk[i] = G16[i]; }
        else merge16(Lk, G16);
        if (m == 3) { merge_partner(Lk);
#pragma unroll
            for (int i = 0; i < 16; ++i) { LST[p][i] = Lk[i]; WL[(p * 16 + i) * 64 + lane] = Lk[i] & 0x7Fu; } }
#pragma unroll
        for (int ks = 0; ks < 8; ++ks) kf[ks] = kn[ks];
    }
    float va[4], vb[16];
#pragma unroll
    for (int i = 0; i < 4; ++i) va[i] = ord2f((hi ? LST[1][i] : LST[0][i]) & ~0x7Fu);
#pragma unroll
    for (int j = 0; j < 16; ++j) vb[j] = ord2f((hi ? LST[0][j] : LST[1][j]) & ~0x7Fu);
    unsigned C32[32];
#pragma unroll
    for (int i = 0; i < 32; ++i) C32[i] = 0u;
#pragma unroll
    for (int i = 0; i < 4; ++i) { const unsigned key = (f2ord(va[i] + vb[i]) & ~0xFFu) | (unsigned)(i * 17); C32[i] = hi ? 0u : key; }
    { int cn = 4;
#pragma unroll
      for (int i = 0; i < 3; ++i)
#pragma unroll
          for (int j = i + 1; j < 16; ++j) if ((i + 1) * (j + 1) <= 16) { const unsigned code = hi ? (unsigned)(j * 16 + i) : (unsigned)(i * 16 + j); C32[cn] = (f2ord(va[i] + vb[j]) & ~0xFFu) | code; ++cn; } }
    sort_desc<32>(C32);
    unsigned Ck[16];
#pragma unroll
    for (int i = 0; i < 16; ++i) Ck[i] = C32[i];
    merge_partner(Ck);
    const float mx = ord2f(Ck[0] & ~0xFFu); float den = 0.f;
#pragma unroll
    for (int k = 0; k < 16; ++k) den += __expf(ord2f(Ck[k] & ~0xFFu) - mx);
    const float rden = 1.0f / den;
    int eo[8]; float go[8];
#pragma unroll
    for (int k = 0; k < 8; ++k) { const unsigned fm = hi ? Ck[k + 8] : Ck[k]; const unsigned code = fm & 0xFFu;
        const unsigned k0 = WL[(code >> 4) * 64 + lane], k1 = WL[(16 + (code & 15u)) * 64 + lane];
        eo[k] = (int)(k0 * 128u + k1); go[k] = __expf(ord2f(fm & ~0xFFu) - mx) * rden; }
    unsigned short* ep = WSP(unsigned short, WS_EXP) + (size_t)(tok0 + c) * NSEL + h * 16 + hi * 8; float* gp = WSP(float, WS_GATE) + (size_t)(tok0 + c) * NSEL + h * 16 + hi * 8;
    *(v4u*)ep = (v4u){(unsigned)eo[0] | ((unsigned)eo[1] << 16), (unsigned)eo[2] | ((unsigned)eo[3] << 16), (unsigned)eo[4] | ((unsigned)eo[5] << 16), (unsigned)eo[6] | ((unsigned)eo[7] << 16)};
    *(f32x4*)gp = (f32x4){go[0], go[1], go[2], go[3]}; *(f32x4*)(gp + 4) = (f32x4){go[4], go[5], go[6], go[7]};
}

typedef float f32x2 __attribute__((ext_vector_type(2)));
__device__ __forceinline__ int dot4i(unsigned a, unsigned b, int c) { return __builtin_amdgcn_sdot4((int)a, (int)b, c, false); }
template <int CTRL> __device__ __forceinline__ int dppi(int x) { return __builtin_amdgcn_mov_dpp(x, CTRL, 0xf, 0xf, true); }
struct PeerGeom { int ngrp, g, rank, nrank; };
__device__ __forceinline__ PeerGeom peer_geom(const Frame& F) { PeerGeom p; p.ngrp = (F.G % 8 == 0) ? 8 : 1; p.g = F.bid % p.ngrp; p.rank = F.bid / p.ngrp; p.nrank = F.G / p.ngrp; return p; }
__device__ __forceinline__ void xquant_token(const Frame& F, int tok, int lane) {
    const bf16* xr = WSP(bf16, WS_XB) + (size_t)tok * D + lane * 16; float xf[32]; float am = 0.f, sq = 0.f;
#pragma unroll
    for (int hh = 0; hh < 2; ++hh)
#pragma unroll
        for (int q = 0; q < 2; ++q) { const v4u w = *(const v4u*)(xr + hh * 1024 + q * 8); float t8[8]; unpack8(w, t8);
            const f32x4 g0 = *(const f32x4*)(F.in[I_G2N] + hh * 1024 + lane * 16 + q * 8), g1 = *(const f32x4*)(F.in[I_G2N] + hh * 1024 + lane * 16 + q * 8 + 4);
#pragma unroll
            for (int e = 0; e < 8; ++e) { const float xg = t8[e] * (e < 4 ? g0[e & 3] : g1[e & 3]); xf[hh * 16 + q * 8 + e] = xg; am = fmaxf(am, fabsf(xg)); sq += t8[e] * t8[e]; } }
#pragma unroll
    for (int o = 1; o < 64; o <<= 1) am = fmaxf(am, __shfl_xor(am, o));
    sq = wave_sum(sq);
    const float qs = am > 0.f ? 127.0f / am : 0.f;
    if (lane == 0) { WSP(float, WS_SX)[tok] = am * (1.0f / 127.0f); WSP(float, WS_SSQ2)[tok] = sq; }
#pragma unroll
    for (int hh = 0; hh < 2; ++hh) { v4u o;
#pragma unroll
        for (int d = 0; d < 4; ++d) { unsigned w = 0u;
#pragma unroll
            for (int e = 0; e < 4; ++e) { const int qi = (int)rintf(xf[hh * 16 + d * 4 + e] * qs); w |= ((unsigned)qi & 0xFFu) << (8 * e); }
            o[d] = w; }
        *(v4u*)(WSP(unsigned char, WS_XQ) + (size_t)tok * D + hh * 1024 + lane * 16) = o; }
}
__device__ __forceinline__ void yquant_tokens(const Frame& F, int tokA, int tokB, int lane) {
    v4u ra[2][2], rb[2][2];
#pragma unroll
    for (int hh = 0; hh < 2; ++hh)
#pragma unroll
        for (int q = 0; q < 2; ++q) { ra[hh][q] = *(const v4u*)(WSP(bf16, WS_Y) + (size_t)tokA * D + hh * 1024 + lane * 16 + q * 8); rb[hh][q] = *(const v4u*)(WSP(bf16, WS_Y) + (size_t)tokB * D + hh * 1024 + lane * 16 + q * 8); }
#define YQ_ONE(R_, tok_) do { float xf_[32]; float am_ = 0.f; \
        _Pragma("unroll") for (int hh_ = 0; hh_ < 2; ++hh_) _Pragma("unroll") for (int q_ = 0; q_ < 2; ++q_) { float t8_[8]; unpack8(R_[hh_][q_], t8_); \
            _Pragma("unroll") for (int e_ = 0; e_ < 8; ++e_) { xf_[hh_ * 16 + q_ * 8 + e_] = t8_[e_]; am_ = fmaxf(am_, fabsf(t8_[e_])); } } \
        am_ = fmaxf(am_, dppf<0xB1>(am_)); am_ = fmaxf(am_, dppf<0x4E>(am_)); am_ = fmaxf(am_, dppf<0x141>(am_)); am_ = fmaxf(am_, dppf<0x140>(am_)); \
        { auto s_ = __builtin_amdgcn_permlane16_swap(__float_as_uint(am_), __float_as_uint(am_), false, false); am_ = fmaxf(__uint_as_float(s_[0]), __uint_as_float(s_[1])); } \
        { auto s_ = __builtin_amdgcn_permlane32_swap(__float_as_uint(am_), __float_as_uint(am_), false, false); am_ = fmaxf(__uint_as_float(s_[0]), __uint_as_float(s_[1])); } \
        const float qs_ = am_ > 0.f ? 127.0f / am_ : 0.f; \
        if (lane == 0) WSP(float, WS_SY)[tok_] = am_ * (1.0f / 127.0f); \
        _Pragma("unroll") for (int hh_ = 0; hh_ < 2; ++hh_) { v4u o_; \
            _Pragma("unroll") for (int d_ = 0; d_ < 4; ++d_) { \
                const unsigned b0_ = __float_as_uint(__builtin_fmaf(xf_[hh_ * 16 + d_ * 4 + 0], qs_, 12582912.0f)), b1_ = __float_as_uint(__builtin_fmaf(xf_[hh_ * 16 + d_ * 4 + 1], qs_, 12582912.0f)); \
                const unsigned b2_ = __float_as_uint(__builtin_fmaf(xf_[hh_ * 16 + d_ * 4 + 2], qs_, 12582912.0f)), b3_ = __float_as_uint(__builtin_fmaf(xf_[hh_ * 16 + d_ * 4 + 3], qs_, 12582912.0f)); \
                o_[d_] = __builtin_amdgcn_perm(b1_, b0_, 0x0c0c0400u) | __builtin_amdgcn_perm(b3_, b2_, 0x04000c0cu); } \
            *(v4u*)(WSP(unsigned char, WS_YQ) + (size_t)(tok_) * D + hh_ * 1024 + lane * 16) = o_; } } while (0)
    YQ_ONE(ra, tokA);
    if (tokB != tokA) YQ_ONE(rb, tokB);
#undef YQ_ONE
}
struct PeerIds { unsigned w; };
__device__ __forceinline__ PeerIds peer_ids_load(const Frame& F, int tok, int lane) { PeerIds r; r.w = WSP(unsigned, WS_EXP)[(size_t)tok * (NSEL / 2) + lane]; return r; }
struct PeerScoreBuf { v4u w[16]; v4u xs; };
__device__ __forceinline__ void peer_score_issue(const Frame& F, int tok, int slice, int lane, LAS int* wl, const PeerIds& id, PeerScoreBuf& B) {
    const int e8 = lane >> 3, c16 = lane & 7;
    *(LAS v2u*)(wl + 2 * lane) = (v2u){id.w & 0xffffu, id.w >> 16};
    B.xs = *(const v4u*)(WSP(unsigned char, WS_XQ) + (size_t)tok * D + slice * 128 + c16 * 16);
    const unsigned char* ub = WSP(unsigned char, WS_UT); const unsigned lo = (unsigned)(slice * 128 + c16 * 16);
#pragma unroll
    for (int ld = 0; ld < 16; ++ld) { const unsigned eid = (unsigned)wl[e8 * 16 + ld]; B.w[ld] = *(const v4u*)(ub + (eid * 2048u + lo)); }
}
__device__ __forceinline__ void peer_score_consume(const Frame& F, int tok, int slice, int lane, const PeerScoreBuf& B, bool valid) {
    int p[16];
#pragma unroll
    for (int ld = 0; ld < 16; ++ld) { const v4u w = B.w[ld]; int a = dot4i(w.x, B.xs.x, 0); a = dot4i(w.y, B.xs.y, a); a = dot4i(w.z, B.xs.z, a); p[ld] = dot4i(w.w, B.xs.w, a); }
    { const bool up = (lane & 4) != 0;
#pragma unroll
      for (int k = 0; k < 8; ++k) { const int keep = up ? p[k + 8] : p[k], send = up ? p[k] : p[k + 8]; p[k] = keep + dppi<0x141>(send); } }
    { const bool up = (lane & 2) != 0;
#pragma unroll
      for (int k = 0; k < 4; ++k) { const int keep = up ? p[k + 4] : p[k], send = up ? p[k] : p[k + 4]; p[k] = keep + dppi<0x4E>(send); } }
    { const bool up = (lane & 1) != 0;
#pragma unroll
      for (int k = 0; k < 2; ++k) { const int keep = up ? p[k + 2] : p[k], send = up ? p[k] : p[k + 2]; p[k] = keep + dppi<0xB1>(send); } }
    if (valid) { unsigned* dst = WSP(unsigned, WS_PART) + ((size_t)slice * T + tok) * (NSEL / 2) + lane;
        __builtin_nontemporal_store(((unsigned)((p[0] + 32) >> 6) & 0xffffu) | ((unsigned)((p[1] + 32) >> 6) << 16), dst); }
}
__device__ __forceinline__ void peer_score_phase(const Frame& F, const PeerGeom& pg, LAS int* wl2) {
    const int lane = F.lane, first = pg.rank * NWAVES + F.wave, step = pg.nrank * NWAVES, n = first < T ? (T - first + step - 1) / step : 0;
    LAS int* wlA = wl2; LAS int* wlB = wl2 + 256;
#define PEER_TOKC(k_) ((first + (k_) * step) < T ? (first + (k_) * step) : T - 1)
    for (int r = 0; r < 16 / pg.ngrp; ++r) { const int slice = r * pg.ngrp + pg.g;
        PeerScoreBuf A, B; PeerIds id = peer_ids_load(F, PEER_TOKC(0), lane);
        { const PeerIds cur = id; id = peer_ids_load(F, PEER_TOKC(1), lane); asm volatile("" ::: "memory"); peer_score_issue(F, PEER_TOKC(0), slice, lane, wlA, cur, A); }
        for (int i = 0; i < n; i += 2) {
            { const PeerIds cur = id; id = peer_ids_load(F, PEER_TOKC(i + 2), lane); asm volatile("" ::: "memory"); peer_score_issue(F, PEER_TOKC(i + 1), slice, lane, wlB, cur, B); }
            peer_score_consume(F, first + i * step, slice, lane, A, true);
            { const PeerIds cur = id; id = peer_ids_load(F, PEER_TOKC(i + 3), lane); asm volatile("" ::: "memory"); peer_score_issue(F, PEER_TOKC(i + 2), slice, lane, wlA, cur, A); }
            peer_score_consume(F, first + (i + 1) * step, slice, lane, B, i + 1 < n);
        }
    }
}
template <int NT> __device__ __forceinline__ void peer_coef_tokens(const Frame& F, const int (&tok)[NT], const bool (&valid)[NT], int lane) {
    unsigned pv[NT][16], exw[NT]; f32x2 ga[NT]; float sx[NT], sq[NT];
#pragma unroll
    for (int i = 0; i < NT; ++i) {
#pragma unroll
        for (int s = 0; s < 16; ++s) pv[i][s] = WSP(unsigned, WS_PART)[((size_t)s * T + tok[i]) * (NSEL / 2) + lane];
        exw[i] = WSP(unsigned, WS_EXP)[(size_t)tok[i] * (NSEL / 2) + lane]; ga[i] = *(const f32x2*)(WSP(float, WS_GATE) + (size_t)tok[i] * NSEL + lane * 2);
        sx[i] = WSP(float, WS_SX)[tok[i]]; sq[i] = WSP(float, WS_SSQ2)[tok[i]]; }
    float us0[NT], us1[NT], vs0[NT], vs1[NT];
#pragma unroll
    for (int i = 0; i < NT; ++i) { const unsigned e0 = exw[i] & 0xffffu, e1 = exw[i] >> 16;
        us0[i] = WSP(float, WS_USC)[e0]; us1[i] = WSP(float, WS_USC)[e1]; vs0[i] = WSP(float, WS_VSC)[e0]; vs1[i] = WSP(float, WS_VSC)[e1]; }
#pragma unroll
    for (int i = 0; i < NT; ++i) { int s0 = 0, s1 = 0;
#pragma unroll
        for (int s = 0; s < 16; ++s) { s0 += (int)(pv[i][s] << 16) >> 16; s1 += (int)pv[i][s] >> 16; }
        s0 <<= 6; s1 <<= 6;
        const float rs = sx[i] * (1.0f / sqrtf(sq[i] * (1.0f / D) + NORM_EPS));
        const float sc0 = (float)s0 * us0[i] * rs, sc1 = (float)s1 * us1[i] * rs;
        f32x2 c; c.x = ga[i].x * gelu_fast(sc0) * vs0[i]; c.y = ga[i].y * gelu_fast(sc1) * vs1[i];
        float cm = fmaxf(fabsf(c.x), fabsf(c.y));
        cm = fmaxf(cm, dppf<0xB1>(cm)); cm = fmaxf(cm, dppf<0x4E>(cm)); cm = fmaxf(cm, dppf<0x141>(cm)); cm = fmaxf(cm, dppf<0x140>(cm));
        { auto t = __builtin_amdgcn_permlane16_swap(__float_as_uint(cm), __float_as_uint(cm), false, false); cm = fmaxf(__uint_as_float(t[0]), __uint_as_float(t[1])); }
        { auto t = __builtin_amdgcn_permlane32_swap(__float_as_uint(cm), __float_as_uint(cm), false, false); cm = fmaxf(__uint_as_float(t[0]), __uint_as_float(t[1])); }
        const float qs = cm > 0.f ? 127.0f / cm : 0.f;
        const int q0 = (int)rintf(c.x * qs), q1 = (int)rintf(c.y * qs);
        if (valid[i]) { ((unsigned short*)(F.ws + WS_COEF))[(size_t)tok[i] * 64 + lane] = (unsigned short)(((unsigned)q0 & 0xFFu) | (((unsigned)q1 & 0xFFu) << 8));
            if (lane == 0) WSP(float, WS_CSC)[tok[i]] = cm * (1.0f / 127.0f); } }
}
struct PeerOutBuf { v4u w[16]; v4u cq; unsigned x; float cs; };
__device__ __forceinline__ void peer_out_issue(const Frame& F, int tok, int slice, int lane, LAS int* wl, const PeerIds& id, PeerOutBuf& B) {
    const int e8 = lane >> 3, c16 = lane & 7;
    *(LAS v2u*)(wl + 2 * lane) = (v2u){id.w & 0xffffu, id.w >> 16};
    B.cq = *(const v4u*)(F.ws + WS_COEF + (size_t)tok * 128 + e8 * 16);
    B.cs = WSP(float, WS_CSC)[tok];
    const unsigned char* vb = WSP(unsigned char, WS_VT); const unsigned lofs = (unsigned)(slice * 128 + c16 * 16);
#pragma unroll
    for (int ld = 0; ld < 16; ++ld) { const unsigned eid = (unsigned)wl[e8 * 16 + ld]; B.w[ld] = *(const v4u*)(vb + (eid * 2048u + lofs)); }
    B.x = *(const unsigned*)(WSP(bf16, WS_XB) + (size_t)tok * D + slice * 128 + c16 * 16 + e8 * 2);
}
__device__ __forceinline__ void peer_out_consume(const Frame& F, int tok, int slice, int lane, const PeerOutBuf& B, bool valid) {
    const int e8 = lane >> 3, c16 = lane & 7;
    int o[16];
#pragma unroll
    for (int i = 0; i < 16; ++i) o[i] = 0;
#pragma unroll
    for (int g = 0; g < 4; ++g) { const unsigned cq = B.cq[g];
#pragma unroll
        for (int d = 0; d < 4; ++d) { const unsigned w0 = B.w[4 * g][d], w1 = B.w[4 * g + 1][d], w2 = B.w[4 * g + 2][d], w3 = B.w[4 * g + 3][d];
            const unsigned lo01 = __builtin_amdgcn_perm(w1, w0, 0x05010400u), hi01 = __builtin_amdgcn_perm(w1, w0, 0x07030602u);
            const unsigned lo23 = __builtin_amdgcn_perm(w3, w2, 0x05010400u), hi23 = __builtin_amdgcn_perm(w3, w2, 0x07030602u);
            const unsigned t0 = __builtin_amdgcn_perm(lo23, lo01, 0x05040100u), t1 = __builtin_amdgcn_perm(lo23, lo01, 0x07060302u);
            const unsigned t2 = __builtin_amdgcn_perm(hi23, hi01, 0x05040100u), t3 = __builtin_amdgcn_perm(hi23, hi01, 0x07060302u);
            o[d * 4 + 0] = dot4i(t0, cq, o[d * 4 + 0]); o[d * 4 + 1] = dot4i(t1, cq, o[d * 4 + 1]); o[d * 4 + 2] = dot4i(t2, cq, o[d * 4 + 2]); o[d * 4 + 3] = dot4i(t3, cq, o[d * 4 + 3]); } }
#pragma unroll
    for (int k = 0; k < 8; ++k) { auto s = __builtin_amdgcn_permlane32_swap((unsigned)o[k], (unsigned)o[k + 8], false, false); o[k] = (int)(s[0] + s[1]); }
#pragma unroll
    for (int k = 0; k < 4; ++k) { auto s = __builtin_amdgcn_permlane16_swap((unsigned)o[k], (unsigned)o[k + 4], false, false); o[k] = (int)(s[0] + s[1]); }
    { const bool up = (lane & 8) != 0;
#pragma unroll
      for (int k = 0; k < 2; ++k) { const int keep = up ? o[k + 2] : o[k], send = up ? o[k] : o[k + 2]; o[k] = keep + dppi<0x128>(send); } }
    const float x0 = bf_lo(B.x) + (float)o[0] * B.cs, x1 = bf_hi(B.x) + (float)o[1] * B.cs;
    if (valid) *(unsigned*)(WSP(bf16, WS_XB) + (size_t)tok * D + slice * 128 + c16 * 16 + e8 * 2) = cvtpk(x0, x1);
}
__device__ __forceinline__ void peer_out_phase(const Frame& F, const PeerGeom& pg, LAS int* wl2) {
    const int lane = F.lane, first = pg.rank * NWAVES + F.wave, step = pg.nrank * NWAVES, n = first < T ? (T - first + step - 1) / step : 0;
    LAS int* wlA = wl2; LAS int* wlB = wl2 + 256;
    for (int r = 0; r < 16 / pg.ngrp; ++r) { const int slice = r * pg.ngrp + pg.g;
        PeerOutBuf A, B; PeerIds id = peer_ids_load(F, PEER_TOKC(0), lane);
        { const PeerIds cur = id; id = peer_ids_load(F, PEER_TOKC(1), lane); asm volatile("" ::: "memory"); peer_out_issue(F, PEER_TOKC(0), slice, lane, wlA, cur, A); }
        for (int i = 0; i < n; i += 2) {
            { const PeerIds cur = id; id = peer_ids_load(F, PEER_TOKC(i + 2), lane); asm volatile("" ::: "memory"); peer_out_issue(F, PEER_TOKC(i + 1), slice, lane, wlB, cur, B); }
            peer_out_consume(F, first + i * step, slice, lane, A, true);
            { const PeerIds cur = id; id = peer_ids_load(F, PEER_TOKC(i + 3), lane); asm volatile("" ::: "memory"); peer_out_issue(F, PEER_TOKC(i + 2), slice, lane, wlA, cur, A); }
            peer_out_consume(F, first + (i + 1) * step, slice, lane, B, i + 1 < n);
        }
    }
}
#undef PEER_TOKC
__device__ __forceinline__ void final_norm_phase(const Frame& F) {
    const int lane = F.lane, gw = F.bid * NWAVES + F.wave, NGW = F.G * NWAVES;
    const f32x4* gf = (const f32x4*)F.in[I_GF] + lane;
    f32x4 g[8];
#pragma unroll
    for (int j = 0; j < 8; ++j) g[j] = gf[64 * j];
    if (gw >= T) return;
    v2u va[8], vb[8]; float sa, sb;
#define FN_LOAD(v_, s_, tok_) do { const int tc_ = (tok_) < T ? (tok_) : T - 1; const v2u* xi_ = (const v2u*)(WSP(bf16, WS_XB) + (size_t)tc_ * D) + lane; \
        _Pragma("unroll") for (int j_ = 0; j_ < 8; ++j_) v_[j_] = xi_[64 * j_]; } while (0)
#define FN_STORE(v_, s_, tok_) do { f32x4* xo_ = (f32x4*)(F.out + (size_t)(tok_) * D) + lane; s_ = 0.f; f32x4 f_[8]; \
        _Pragma("unroll") for (int j_ = 0; j_ < 8; ++j_) { f_[j_] = (f32x4){bf_lo(v_[j_].x), bf_hi(v_[j_].x), bf_lo(v_[j_].y), bf_hi(v_[j_].y)}; s_ += (f_[j_][0] * f_[j_][0] + f_[j_][1] * f_[j_][1]) + (f_[j_][2] * f_[j_][2] + f_[j_][3] * f_[j_][3]); } \
        s_ = wave_sum(s_); const float rs_ = 1.0f / sqrtf(s_ * (1.0f / D) + NORM_EPS); \
        _Pragma("unroll") for (int j_ = 0; j_ < 8; ++j_) xo_[64 * j_] = f_[j_] * rs_ * g[j_]; } while (0)
    FN_LOAD(va, sa, gw);
    for (int tok = gw; tok < T; tok += 2 * NGW) {
        FN_LOAD(vb, sb, tok + NGW);
        FN_STORE(va, sa, tok);
        FN_LOAD(va, sa, tok + 2 * NGW);
        if (tok + NGW < T) FN_STORE(vb, sb, tok + NGW);
    }
#undef FN_LOAD
#undef FN_STORE
}

struct Args { const float* in[28]; float* out; unsigned char* ws; int ph_lo, ph_hi, li, pad; };
__global__ void __launch_bounds__(NTHR, 2) hybrid_fwd(Args args) {
    extern __shared__ __attribute__((aligned(16))) unsigned char lds[];
    Frame F;
    F.lds = (LAS unsigned char*)lds;
    F.tid = threadIdx.x; F.lane = F.tid & 63; F.wave = __builtin_amdgcn_readfirstlane(F.tid >> 6);
    F.G = gridDim.x; F.bid = blockIdx.x;
#pragma unroll
    for (int i = 0; i < 28; ++i) F.in[i] = args.in[i];
    F.out = args.out; F.ws = args.ws;
    volatile LAS unsigned* MISC = (volatile LAS unsigned*)(F.lds + MISC_OFF);
    for (int u = F.tid; u < (LDS_BYTES - LDSCTL_OFF) / 4; u += NTHR) ((LAS unsigned*)(F.lds + LDSCTL_OFF))[u] = 0u;
    __syncthreads();
    unsigned* barw = (unsigned*)(F.ws + WS_CTL) + CW_BAR;
    XcdBarrier bar; bar.bar = barw; bar.x = 0; bar.st = nullptr;
    if (N_LAUNCHES == 1) bar = xcd_barrier_post(barw, MISC + 8);
    const int lo = args.ph_lo, hi = args.ph_hi;
#define IN(k) (lo <= (k) && (k) < hi)
#define SEAM(k) do { if (IN(k) && IN((k) + 1)) xcd_barrier(bar); } while (0)

#ifndef PROBE_DUP
#define PROBE_DUP -1
#endif
#define REPS(k) for (int rep_ = 0; rep_ < ((PROBE_DUP) == (k) ? 2 : 1); ++rep_)
    if (IN(0)) REPS(0) { p0_prologue<0>(F, F.bid, F.G); __syncthreads(); }
    SEAM(0);
    if (IN(1)) REPS(1) {
        pg8::Gemm g{(const bf16*)((const unsigned char*)F.out + OUT_X8), WSP(const bf16, WS_WIN), T, NINP, D / 2}; pg8::StaticOrder S; S.init(T, NINP, F.G, F.bid);
        pg8::EpiI8RowColBf16<0> E{WSP(bf16, WS_PROJ), NINP, WSP(const float, WS_RSTD1), WSP(const float, WS_CS1), nullptr, NORM_EPS};
        pg8::gemm_phase<pg8::EpiI8RowColBf16<0>, pg8::StaticOrder, true, true, true>(F.lds, g, S, E);
    }
    SEAM(1);
    if (IN(2)) REPS(2) {
        lora_prepass(F);
        group_barrier((unsigned*)(F.ws + WS_CTL) + CW_PREBAR, (unsigned)F.G);
        for (int r4 = 0; r4 < ((PROBE_DUP) == 70 ? 2 : 1); ++r4) rwkv_prep_phase(F);
        group_barrier((unsigned*)(F.ws + WS_CTL) + CW_PREPBAR, (unsigned)F.G);
        const int R1 = F.G >= 256 ? 128 : F.G, L0 = F.G >= 256 ? 128 : 0, NL = F.G - L0;
        if (F.bid < R1) for (int it = F.bid; it < 128; it += R1) rwkv_item(F, it);
        if (F.bid >= L0) for (int it = F.bid - L0; it < 128; it += NL) lru_seq(F, it);
        { volatile LAS int* qslot = (volatile LAS int*)(F.lds + LDSCTL_OFF + 1024);
          for (;;) { __syncthreads(); if (F.tid == 0) *qslot = (int)xb_add((unsigned*)(F.ws + WS_CTL) + CW_DEFQ, 1u); __syncthreads();
              const int vb = *qslot; if (vb >= DEF_SLICES) break; p0_prologue<1>(F, vb, DEF_SLICES); } }
    }
    SEAM(2);
    if (IN(3)) REPS(3) { const int gw = F.bid * NWAVES + F.wave, NGW = F.G * NWAVES;
        for (int tok = gw; tok < T; tok += 2 * NGW) yquant_tokens(F, tok, tok + NGW < T ? tok + NGW : tok, F.lane); }
    SEAM(3);
    if (IN(4)) REPS(4) {
        pg8::Gemm g{WSP(const bf16, WS_YQ), WSP(const bf16, WS_WOUT), T, D, D / 2}; pg8::StaticOrder S; S.init(T, D, F.G, F.bid);
        pg8::EpiI8Residual E{(const unsigned char*)F.out + OUT_X8, WSP(const float, WS_SX0), WSP(bf16, WS_XB), D, WSP(const float, WS_SY), WSP(const float, WS_CSO)};
        pg8::gemm_phase<pg8::EpiI8Residual, pg8::StaticOrder, true, true, true>(F.lds, g, S, E);
    }
    SEAM(4);
    if (IN(5)) { const int gw = F.bid * NWAVES + F.wave, NGW = F.G * NWAVES;
        for (int tok = gw; tok < T; tok += NGW) xquant_token(F, tok, F.lane); }
    SEAM(5);
    if (IN(6)) REPS(6) {
        pg8::Gemm g{WSP(const bf16, WS_XQ), WSP(const bf16, WS_WQ), T, D, D / 2}; pg8::StaticOrder S; S.init(T, D, F.G, F.bid);
        pg8::EpiI8RowColBf16<1> E{WSP(bf16, WS_Q), D, WSP(const float, WS_SX), WSP(const float, WS_CSQ), WSP(const float, WS_SSQ2), NORM_EPS};
        pg8::gemm_phase<pg8::EpiI8RowColBf16<1>, pg8::StaticOrder, true, true, true>(F.lds, g, S, E);
    }
    if (IN(6)) { __syncthreads();
        pg8::StaticOrder S; S.init(T, D, F.G, F.bid); pg8::Unit u;
        for (int i = 0; S.next(i, u); ++i) route_item(F, ((u.pm * 8 + F.wave) << 3) | u.pn, F.lane); }
    SEAM(6);
    { const PeerGeom pg = peer_geom(F); LAS int* wl = (LAS int*)(F.lds + F.wave * 1024);
      if (IN(7)) REPS(7) peer_score_phase(F, pg, (LAS int*)(F.lds + 16384 + F.wave * 2048));
      SEAM(7);
      if (IN(8)) REPS(8) { const int gw = F.bid * NWAVES + F.wave, NGW = F.G * NWAVES; for (int tok = gw; tok < T; tok += 4 * NGW) { int tk[4]; bool vl[4];
#pragma unroll
            for (int i = 0; i < 4; ++i) { const int t = tok + i * NGW; vl[i] = t < T; tk[i] = vl[i] ? t : tok; }
            peer_coef_tokens<4>(F, tk, vl, F.lane); } }
      SEAM(8);
      if (IN(9)) peer_out_phase(F, pg, (LAS int*)(F.lds + 16384 + F.wave * 2048));
      SEAM(9);
      if (IN(10)) final_norm_phase(F); }
#undef IN
#undef SEAM
}

extern "C" void kernel_launch(void* const* d_in, const int* in_sizes, int n_in, void* d_out, int out_size, void* d_ws, size_t ws_size, hipStream_t stream) {
    static int grid = 0;
    if (grid == 0) {
        if (n_in != 28 || in_sizes[0] != T * D || out_size != T * D || ws_size < WS_END) { fprintf(stderr, "kernel_launch: shape/workspace mismatch: n_in %d in0 %d out %d ws %zu (need %zu)\n", n_in, n_in > 0 ? in_sizes[0] : -1, out_size, ws_size, (size_t)WS_END); grid = -1; return; }
        int dev = 0, cus = 0, per_cu = 0;
        if (hipGetDevice(&dev) != hipSuccess || hipDeviceGetAttribute(&cus, hipDeviceAttributeMultiprocessorCount, dev) != hipSuccess) { fprintf(stderr, "kernel_launch: device query failed\n"); grid = -1; return; }
        if (hipFuncSetAttribute((const void*)hybrid_fwd, hipFuncAttributeMaxDynamicSharedMemorySize, LDS_BYTES) != hipSuccess) { fprintf(stderr, "kernel_launch: hipFuncSetAttribute failed\n"); grid = -1; return; }
        if (hipOccupancyMaxActiveBlocksPerMultiprocessor(&per_cu, (const void*)hybrid_fwd, NTHR, LDS_BYTES) != hipSuccess || per_cu < 1) { fprintf(stderr, "kernel_launch: occupancy query says %d blocks per CU\n", per_cu); per_cu = 1; }
        (void)hipGetLastError();
        grid = cus;
    }
    if (grid < 0) return;
    if (hipMemsetAsync((char*)d_ws + WS_CTL, 0, CTL_ZERO_BYTES, stream) != hipSuccess) { fprintf(stderr, "kernel_launch: hipMemsetAsync failed\n"); return; }
    Args a{};
    for (int i = 0; i < 28; ++i) a.in[i] = (const float*)d_in[i];
    a.out = (float*)d_out; a.ws = (unsigned char*)d_ws;
    for (int li = 0; li < N_LAUNCHES; ++li) {
        a.ph_lo = (N_LAUNCHES == 1) ? 0 : li; a.ph_hi = (N_LAUNCHES == 1) ? N_PHASES : li + 1; a.li = li;
        hipLaunchKernelGGL(hybrid_fwd, dim3(grid), dim3(NTHR), LDS_BYTES, stream, a);
        const hipError_t le = hipPeekAtLastError();
        if (le != hipSuccess) { fprintf(stderr, "kernel_launch: launch %d failed: %s\n", li, hipGetErrorName(le)); break; }
    }
}
```

```cpp
#include <hip/hip_runtime.h>
#include <cstdio>
#include <cstdint>
namespace pg8 {
#define PG8_LAS __attribute__((address_space(3)))
typedef unsigned short bf16_t;
typedef short bf16x8 __attribute__((ext_vector_type(8)));
typedef float f32x4 __attribute__((ext_vector_type(4)));
typedef unsigned u32x4 __attribute__((ext_vector_type(4)));
typedef int i32x4 __attribute__((ext_vector_type(4)));
constexpr int BM = 256, BK = 64, HALF = 128, HTB = HALF * BK * 2  , STAGE_BYTES = 8 * HTB, NXCD = 8, WGM = 8;

__host__ __device__ __forceinline__ int lds_byte(int r, int c) { const int st = (r >> 4) * 2 + (c >> 5), rr = r & 15, cc = c & 31, ob = rr * 64 + cc * 2; return st * 1024 + (ob ^ (((ob >> 9) & 1) << 5)); }
__host__ __device__ __forceinline__ void stage_rc(int b, int& R, int& C) { const int st = b / 1024, sb = b % 1024, swz = sb ^ (((sb >> 9) & 1) << 5); R = (st >> 1) * 16 + swz / 64; C = (st & 1) * 32 + (swz % 64) / 2; }
__host__ __device__ __forceinline__ int perm32(int rho) { const int n = rho >> 4, i = rho & 15; return 8 * (i >> 2) + 4 * n + (i & 3); }

struct Unit { int pm, pn; };
struct Gemm { const bf16_t* A; const bf16_t* Bt; int M, N, K; };

struct StaticOrder {
    int nM, nN, nwg, G, c;
    __host__ __device__ void init(int M, int N, int G_, int c_) { nM = M / BM; nN = N / BM; nwg = nM * nN; G = G_; c = c_; }
    __host__ __device__ bool next(int i, Unit& u) const {
        const long L = (long)i * G + c; if (L >= nwg) return false;
        int wgid = (int)L; { const int q = nwg / NXCD, r = nwg % NXCD, xcd = wgid % NXCD, off = wgid / NXCD; wgid = (xcd < r ? xcd * (q + 1) : r * (q + 1) + (xcd - r) * q) + off; }
        const int nig = WGM * nN, gid = wgid / nig, fm = gid * WGM, gsz = (nM - fm) < WGM ? (nM - fm) : WGM;
        u.pm = fm + ((wgid % nig) % gsz); u.pn = (wgid % nig) / gsz; return true;
    }
    __device__ __forceinline__ void a_ready(const Unit&) const {}
    __device__ __forceinline__ void done(const Unit&) const {}
};

__device__ __forceinline__ unsigned cvt_pk_bf16(float lo, float hi) { unsigned r; asm volatile("v_cvt_pk_bf16_f32 %0, %1, %2" : "=v"(r) : "v"(lo), "v"(hi)); return r; }
typedef float f32x2 __attribute__((ext_vector_type(2)));
typedef unsigned u32x2 __attribute__((ext_vector_type(2)));
template <int MODE> struct EpiRowScaleBf16 {
    static constexpr bool PERM = true, AFTER_DRAIN = false;
    bf16_t* O; int ldc; const float* rs; float eps;
    __device__ __forceinline__ void operator()(const f32x4 (&acc)[2][2][4][2], const Unit& u, int wr, int wc, int fr, int fq) const {
        const int row0 = u.pm * BM + wr * 64 + fr, col0 = u.pn * BM + wc * 32 + 8 * fq;
#pragma unroll
        for (int ai = 0; ai < 2; ++ai)
#pragma unroll
            for (int m = 0; m < 4; ++m) { const int r = row0 + ai * HALF + m * 16; float s = rs[r]; if (MODE == 1) s = 1.0f / sqrtf(s * (1.0f / 2048.0f) + eps);
                bf16_t* rowp = O + (size_t)r * ldc + col0;
#pragma unroll
                for (int bj = 0; bj < 2; ++bj) { const f32x4 v0 = acc[ai][bj][m][0] * s, v1 = acc[ai][bj][m][1] * s;
                    u32x4 w; w.x = cvt_pk_bf16(v0[0], v0[1]); w.y = cvt_pk_bf16(v0[2], v0[3]); w.z = cvt_pk_bf16(v1[0], v1[1]); w.w = cvt_pk_bf16(v1[2], v1[3]);
                    *(u32x4*)(rowp + bj * HALF) = w; } }
    }
};
template <int MODE> struct EpiI8RowColBf16 {
    static constexpr bool PERM = true, AFTER_DRAIN = false;
    bf16_t* O; int ldc; const float* rs; const float* cs; const float* ssq; float eps;
    __device__ __forceinline__ void operator()(const f32x4 (&acc)[2][2][4][2], const Unit& u, int wr, int wc, int fr, int fq) const {
        const int row0 = u.pm * BM + wr * 64 + fr, col0 = u.pn * BM + wc * 32 + 8 * fq;
        f32x4 c4[2][2];
#pragma unroll
        for (int bj = 0; bj < 2; ++bj) { c4[bj][0] = *(const f32x4*)(cs + col0 + bj * HALF); c4[bj][1] = *(const f32x4*)(cs + col0 + bj * HALF + 4); }
#pragma unroll
        for (int ai = 0; ai < 2; ++ai)
#pragma unroll
            for (int m = 0; m < 4; ++m) { const int r = row0 + ai * HALF + m * 16; float s = rs[r]; if (MODE == 1) s = s / sqrtf(ssq[r] * (1.0f / 2048.0f) + eps);
                bf16_t* rowp = O + (size_t)r * ldc + col0;
#pragma unroll
                for (int bj = 0; bj < 2; ++bj) { f32x4 v0, v1; const i32x4 i0 = __builtin_bit_cast(i32x4, acc[ai][bj][m][0]), i1 = __builtin_bit_cast(i32x4, acc[ai][bj][m][1]);
#pragma unroll
                    for (int e = 0; e < 4; ++e) { v0[e] = (float)i0[e] * s * c4[bj][0][e]; v1[e] = (float)i1[e] * s * c4[bj][1][e]; }
                    u32x4 w; w.x = cvt_pk_bf16(v0[0], v0[1]); w.y = cvt_pk_bf16(v0[2], v0[3]); w.z = cvt_pk_bf16(v1[0], v1[1]); w.w = cvt_pk_bf16(v1[2], v1[3]);
                    *(u32x4*)(rowp + bj * HALF) = w; } }
    }
};
struct EpiResidual {
    static constexpr bool PERM = false, AFTER_DRAIN = false;
    const float* base; bf16_t* outb; int ldc;
    __device__ __forceinline__ void operator()(const f32x4 (&acc)[2][2][4][2], const Unit& u, int wr, int wc, int fr, int fq) const {
        const int row0 = u.pm * BM + wr * 64 + fr, col0 = u.pn * BM + wc * 32 + 4 * fq;
#pragma unroll
        for (int ai = 0; ai < 2; ++ai)
#pragma unroll
            for (int m = 0; m < 4; ++m) { const int r = row0 + ai * HALF + m * 16; const size_t off = (size_t)r * ldc + col0;
#pragma unroll
                for (int bj = 0; bj < 2; ++bj)
#pragma unroll
                    for (int n = 0; n < 2; ++n) { const f32x4 bs = *(const f32x4*)(base + off + bj * HALF + n * 16); const f32x4 o = bs + acc[ai][bj][m][n];
                        u32x2 w; w.x = cvt_pk_bf16(o[0], o[1]); w.y = cvt_pk_bf16(o[2], o[3]); *(u32x2*)(outb + off + bj * HALF + n * 16) = w; } }
    }
};
struct EpiI8Residual {
    static constexpr bool PERM = true, AFTER_DRAIN = false;
    const unsigned char* x8; const float* xs; bf16_t* outb; int ldc; const float* rs; const float* cs;
    __device__ __forceinline__ void operator()(const f32x4 (&acc)[2][2][4][2], const Unit& u, int wr, int wc, int fr, int fq) const {
        const int row0 = u.pm * BM + wr * 64 + fr, col0 = u.pn * BM + wc * 32 + 8 * fq;
        f32x4 c4[2][2];
#pragma unroll
        for (int bj = 0; bj < 2; ++bj) { c4[bj][0] = *(const f32x4*)(cs + col0 + bj * HALF); c4[bj][1] = *(const f32x4*)(cs + col0 + bj * HALF + 4); }
#pragma unroll
        for (int ai = 0; ai < 2; ++ai)
#pragma unroll
            for (int m = 0; m < 4; ++m) { const int r = row0 + ai * HALF + m * 16; const float s = rs[r], sx = xs[r]; const size_t off = (size_t)r * ldc + col0;
#pragma unroll
                for (int bj = 0; bj < 2; ++bj) { const i32x4 i0 = __builtin_bit_cast(i32x4, acc[ai][bj][m][0]), i1 = __builtin_bit_cast(i32x4, acc[ai][bj][m][1]);
                    const u32x2 xb = *(const u32x2*)(x8 + off + bj * HALF); f32x4 v0, v1;
#pragma unroll
                    for (int e = 0; e < 4; ++e) { v0[e] = (float)((int)(xb.x << (24 - 8 * e)) >> 24) * sx + (float)i0[e] * s * c4[bj][0][e]; v1[e] = (float)((int)(xb.y << (24 - 8 * e)) >> 24) * sx + (float)i1[e] * s * c4[bj][1][e]; }
                    u32x4 w; w.x = cvt_pk_bf16(v0[0], v0[1]); w.y = cvt_pk_bf16(v0[2], v0[3]); w.z = cvt_pk_bf16(v1[0], v1[1]); w.w = cvt_pk_bf16(v1[2], v1[3]);
                    *(u32x4*)(outb + off + bj * HALF) = w; } }
    }
};
template <class Epi, class Sched, bool ALIGN_EPI = false, bool SP2 = false, bool I8 = false>
__device__ __forceinline__ void gemm_phase(PG8_LAS unsigned char* lds, const Gemm g, const Sched& S, const Epi& E) {
    const int tid = threadIdx.x, wid = __builtin_amdgcn_readfirstlane(tid >> 6), lane = tid & 63, wr = wid >> 2, wc = wid & 3, fr = lane & 15, fq = lane >> 4;
    const int K = g.K, nt = K / BK;
    unsigned voffA[2], voffB[2];
#pragma unroll
    for (int i = 0; i < 2; ++i) { int R, C; stage_rc(tid * 16 + i * 8192, R, C); const int Rb = Epi::PERM ? ((R & ~31) + perm32(R & 31)) : R;
        voffA[i] = (unsigned)(R * K + C) * 2u; voffB[i] = (unsigned)(Rb * K + C) * 2u; }
    const size_t kstep = (size_t)(BK * 2);
    const size_t hstep = (size_t)HALF * K * 2;
    const size_t tstep = 2 * hstep;
    const unsigned ldsw = (unsigned)wid * 1024u;
    const int aoff = lds_byte(wr * 64 + fr, fq * 8), boff = lds_byte(wc * 32 + fr, fq * 8);
#define PG8_SA(b, h) (((b) * 2 + (h)) * HTB)
#define PG8_SB(b, h) ((4 + (b) * 2 + (h)) * HTB)
#define PG8_STAGE(bufoff, gbase, voff) do { _Pragma("unroll") for (int _i = 0; _i < 2; ++_i) \
        __builtin_amdgcn_global_load_lds((const unsigned*)((const char*)(gbase) + (voff)[_i]), (PG8_LAS unsigned*)(lds + (bufoff) + ldsw + _i * 8192), 16, 0, 0); } while (0)
#define PG8_LDA(dst, b, h) do { _Pragma("unroll") for (int m = 0; m < 4; ++m) _Pragma("unroll") for (int k = 0; k < 2; ++k) dst[m][k] = *(const PG8_LAS bf16x8*)(lds + PG8_SA(b, h) + aoff + m * 2048 + k * 1024); } while (0)
#define PG8_LDB(dst, b, h) do { _Pragma("unroll") for (int n = 0; n < 2; ++n) _Pragma("unroll") for (int k = 0; k < 2; ++k) dst[n][k] = *(const PG8_LAS bf16x8*)(lds + PG8_SB(b, h) + boff + n * 2048 + k * 1024); } while (0)
#define PG8_MMA(ai, bj, At, Bt) do { __builtin_amdgcn_s_setprio(1); _Pragma("unroll") for (int m = 0; m < 4; ++m) _Pragma("unroll") for (int n = 0; n < 2; ++n) _Pragma("unroll") for (int k = 0; k < 2; ++k) \
        { if constexpr (I8) acc[ai][bj][m][n] = __builtin_bit_cast(f32x4, __builtin_amdgcn_mfma_i32_16x16x64_i8(__builtin_bit_cast(i32x4, Bt[n][k]), __builtin_bit_cast(i32x4, At[m][k]), __builtin_bit_cast(i32x4, acc[ai][bj][m][n]), 0, 0, 0)); \
          else acc[ai][bj][m][n] = __builtin_amdgcn_mfma_f32_16x16x32_bf16(Bt[n][k], At[m][k], acc[ai][bj][m][n], 0, 0, 0); } __builtin_amdgcn_s_setprio(0); } while (0)
#define PG8_WAIT_V(n) asm volatile("s_waitcnt vmcnt(" #n ")" ::: "memory")
#define PG8_WAIT_L(n) asm volatile("s_waitcnt lgkmcnt(" #n ")" ::: "memory")
#define PG8_BAR __builtin_amdgcn_s_barrier()
#define PG8_SCHED __builtin_amdgcn_sched_barrier(0)
    Unit cur, nxt; int ui = 0;
    if (!S.next(0, cur)) return;
    f32x4 acc[2][2][4][2];
#pragma unroll
    for (int a = 0; a < 2; ++a)
#pragma unroll
        for (int b = 0; b < 2; ++b)
#pragma unroll
            for (int m = 0; m < 4; ++m)
#pragma unroll
                for (int n = 0; n < 2; ++n) acc[a][b][m][n] = (f32x4){0.f, 0.f, 0.f, 0.f};
    bf16x8 At[4][2], B0[2][2], B1[2][2];
    const char* cA = (const char*)g.A + (size_t)cur.pm * tstep; const char* cB = (const char*)g.Bt + (size_t)cur.pn * tstep;
    S.a_ready(cur);
    if constexpr (SP2) {
        PG8_STAGE(PG8_SB(0, 0), cB, voffB); PG8_STAGE(PG8_SB(0, 1), cB + hstep, voffB); PG8_STAGE(PG8_SA(0, 0), cA, voffA); PG8_STAGE(PG8_SA(0, 1), cA + hstep, voffA);
        if (wr == 1) PG8_BAR;
        PG8_WAIT_V(2); PG8_BAR;
        PG8_STAGE(PG8_SB(1, 0), cB + kstep, voffB); PG8_STAGE(PG8_SA(1, 0), cA + kstep, voffA); PG8_STAGE(PG8_SB(1, 1), cB + hstep + kstep, voffB);
        PG8_WAIT_V(6); PG8_BAR;
    } else {
        PG8_STAGE(PG8_SB(0, 0), cB, voffB); PG8_STAGE(PG8_SA(0, 0), cA, voffA); PG8_STAGE(PG8_SB(0, 1), cB + hstep, voffB); PG8_STAGE(PG8_SA(0, 1), cA + hstep, voffA);
        if (wr == 1) PG8_BAR;
        PG8_WAIT_V(4); PG8_BAR;
        PG8_STAGE(PG8_SB(1, 0), cB + kstep, voffB); PG8_STAGE(PG8_SA(1, 0), cA + kstep, voffA); PG8_STAGE(PG8_SB(1, 1), cB + hstep + kstep, voffB);
        PG8_WAIT_V(6); PG8_BAR;
    }
    for (;;) {
        const bool has_next = S.next(ui + 1, nxt);
        const char* nA = has_next ? (const char*)g.A + (size_t)nxt.pm * tstep : cA; const char* nB = has_next ? (const char*)g.Bt + (size_t)nxt.pn * tstep : cB;
        for (int t = 0; t < nt; t += 2) {
            const bool last = (t == nt - 2);
            const char* a1 = cA + (size_t)(t + 1) * kstep;
            const char* a2 = last ? nA : cA + (size_t)(t + 2) * kstep; const char* b2 = last ? nB : cB + (size_t)(t + 2) * kstep;
            const char* a3 = a2 + kstep; const char* b3 = b2 + kstep;
            if (last && has_next) S.a_ready(nxt);
            if constexpr (SP2) {
            PG8_LDB(B0, 0, 0); PG8_LDB(B1, 0, 1); PG8_SCHED; PG8_LDA(At, 0, 0); PG8_STAGE(PG8_SA(1, 1), a1 + hstep, voffA);
            PG8_WAIT_V(8); PG8_WAIT_L(0); PG8_BAR; PG8_MMA(0, 0, At, B0); PG8_MMA(0, 1, At, B1); PG8_BAR; PG8_SCHED;
            PG8_LDA(At, 0, 1); PG8_STAGE(PG8_SB(0, 0), b2, voffB); PG8_STAGE(PG8_SB(0, 1), b2 + hstep, voffB); PG8_STAGE(PG8_SA(0, 0), a2, voffA);
            PG8_WAIT_V(8); PG8_WAIT_L(0); PG8_BAR; PG8_MMA(1, 0, At, B0); PG8_MMA(1, 1, At, B1); PG8_BAR; PG8_SCHED;
            PG8_LDB(B0, 1, 0); PG8_LDB(B1, 1, 1); PG8_SCHED; PG8_LDA(At, 1, 0); PG8_STAGE(PG8_SA(0, 1), a2 + hstep, voffA);
            PG8_WAIT_V(8); PG8_WAIT_L(0); PG8_BAR; PG8_MMA(0, 0, At, B0); PG8_MMA(0, 1, At, B1); PG8_BAR; PG8_SCHED;
            PG8_LDA(At, 1, 1); PG8_STAGE(PG8_SB(1, 0), b3, voffB); PG8_STAGE(PG8_SB(1, 1), b3 + hstep, voffB); PG8_STAGE(PG8_SA(1, 0), a3, voffA);
            PG8_WAIT_V(8); PG8_WAIT_L(0); PG8_BAR; PG8_MMA(1, 0, At, B0); PG8_MMA(1, 1, At, B1); PG8_BAR; PG8_SCHED;
            } else {
            PG8_LDB(B0, 0, 0); PG8_SCHED; PG8_LDA(At, 0, 0); PG8_STAGE(PG8_SA(1, 1), a1 + hstep, voffA);
            PG8_WAIT_L(8); PG8_BAR; PG8_WAIT_L(0); PG8_MMA(0, 0, At, B0); PG8_BAR; PG8_SCHED;
            PG8_LDB(B1, 0, 1); PG8_STAGE(PG8_SB(0, 0), b2, voffB);
            PG8_BAR; PG8_WAIT_L(0); PG8_MMA(0, 1, At, B1); PG8_BAR;
            PG8_LDA(At, 0, 1); PG8_STAGE(PG8_SA(0, 0), a2, voffA);
            PG8_BAR; PG8_WAIT_L(0); PG8_MMA(1, 0, At, B0); PG8_BAR; PG8_SCHED;
            PG8_STAGE(PG8_SB(0, 1), b2 + hstep, voffB);
            PG8_WAIT_V(6); PG8_BAR; PG8_MMA(1, 1, At, B1); PG8_BAR;
            PG8_LDB(B0, 1, 0); PG8_SCHED; PG8_LDA(At, 1, 0); PG8_STAGE(PG8_SA(0, 1), a2 + hstep, voffA);
            PG8_WAIT_L(8); PG8_BAR; PG8_WAIT_L(0); PG8_MMA(0, 0, At, B0); PG8_BAR; PG8_SCHED;
            PG8_LDB(B1, 1, 1); PG8_STAGE(PG8_SB(1, 0), b3, voffB);
            PG8_BAR; PG8_WAIT_L(0); PG8_MMA(0, 1, At, B1); PG8_BAR;
            PG8_LDA(At, 1, 1); PG8_STAGE(PG8_SA(1, 0), a3, voffA);
            PG8_BAR; PG8_WAIT_L(0); PG8_MMA(1, 0, At, B0); PG8_BAR; PG8_SCHED;
            PG8_STAGE(PG8_SB(1, 1), b3 + hstep, voffB);
            PG8_WAIT_V(6); PG8_BAR; PG8_MMA(1, 1, At, B1); PG8_BAR;
            }
        }
        if constexpr (ALIGN_EPI) { if (wr == 0) PG8_BAR; }
        if constexpr (!Epi::AFTER_DRAIN) { E(acc, cur, wr, wc, fr, fq); S.done(cur); }
        if (!has_next) break;
#pragma unroll
        for (int a = 0; a < 2; ++a)
#pragma unroll
            for (int b = 0; b < 2; ++b)
#pragma unroll
                for (int m = 0; m < 4; ++m)
#pragma unroll
                    for (int n = 0; n < 2; ++n) acc[a][b][m][n] = (f32x4){0.f, 0.f, 0.f, 0.f};
        cur = nxt; cA = nA; cB = nB; ++ui;
        if constexpr (ALIGN_EPI) { if (wr == 1) PG8_BAR; }
    }
    PG8_WAIT_V(0);
    if constexpr (!ALIGN_EPI) { if (wr == 0) PG8_BAR; }
    PG8_BAR;
    if constexpr (Epi::AFTER_DRAIN) { E.fused(acc, cur, wr, wc, fr, fq, lds, wid, lane); S.done(cur); }
#undef PG8_SA
#undef PG8_SB
#undef PG8_STAGE
#undef PG8_LDA
#undef PG8_LDB
#undef PG8_MMA
#undef PG8_WAIT_V
#undef PG8_WAIT_L
#undef PG8_BAR
#undef PG8_SCHED
}
}

#ifndef PROBE_DUP
#define PROBE_DUP -1
#endif
constexpr int NWAVES = 8, NTHR = NWAVES * 64;
#ifndef MK_N_LAUNCHES
#define MK_N_LAUNCHES 1
#endif
constexpr int N_PHASES = 11;
constexpr int DEF_SLICES = 256;
constexpr int N_LAUNCHES = MK_N_LAUNCHES;
static_assert(N_LAUNCHES == 1 || N_LAUNCHES == N_PHASES, "MK_N_LAUNCHES is 1 or N_PHASES");

constexpr int BATCH = 8, SEQ = 2048, T = BATCH * SEQ, D = 2048;
constexpr int NIN = 5408, NINP = 5632;
constexpr int PC_GATE = 1024, PC_R = 2048, PC_K = 3072, PC_V = 4096, PC_WD = 5120, PC_AD = 5184, PC_GD = 5248;
constexpr int RWKV_C0 = 2048;
constexpr int NEXP = 16384, NSEL = 128;
constexpr float NORM_EPS = 1e-6f, GN_EPS = 64e-5f;

constexpr size_t MiB = 1u << 20;
constexpr size_t WS_CTL = 0, CTL_ZERO_BYTES = 1 * MiB;
constexpr size_t WS_SSQ3 = 576 * 1024;
constexpr size_t WS_SSQ2 = 512 * 1024;
constexpr size_t WS_RSTD1 = 1 * MiB;
constexpr size_t WS_USC = 1 * MiB + 64 * 1024, WS_VSC = 1 * MiB + 128 * 1024;
constexpr size_t WS_SX = 1 * MiB + 192 * 1024;
constexpr size_t WS_CS1 = 1 * MiB + 256 * 1024;
constexpr size_t WS_CSQ = 1 * MiB + 288 * 1024;
constexpr size_t WS_CSO = 1 * MiB + 296 * 1024;
constexpr size_t WS_SY = 1 * MiB + 320 * 1024;
constexpr size_t WS_SX0 = 1 * MiB + 384 * 1024;
constexpr size_t WS_WIN = 2 * MiB;
constexpr size_t WS_WOUT = 24 * MiB;
constexpr size_t WS_WQ = 32 * MiB;
constexpr size_t WS_KEYS = 40 * MiB;
constexpr size_t WS_W2T = WS_KEYS + 512 * 1024;
constexpr size_t WS_A2T = WS_W2T + 128 * 1024;
constexpr size_t WS_G2T = WS_A2T + 128 * 1024;
constexpr size_t WS_WAT = WS_G2T + 320 * 1024;
constexpr size_t WS_WIT = WS_WAT + 256 * 1024;
constexpr size_t WS_EXP = 42 * MiB;
constexpr size_t WS_GATE = 50 * MiB;
constexpr size_t WS_LA = 42 * MiB;
constexpr size_t WS_SUMM = 58 * MiB;
constexpr size_t WS_TA = 64 * MiB, WS_TB = 96 * MiB, WS_TK = 400 * MiB, WS_TR = 464 * MiB;
constexpr size_t OUT_X8 = 72 * MiB;
constexpr size_t OUT_TV = 0, OUT_TG = 32 * MiB, OUT_PC = 64 * MiB, OUT_BON = 66 * MiB;
constexpr size_t WS_XB = 64 * MiB;
constexpr size_t WS_PROJ = 128 * MiB;
constexpr size_t WS_Q = WS_PROJ;
constexpr size_t WS_YQ = WS_PROJ;
constexpr size_t WS_PART = 192 * MiB;
constexpr size_t WS_XQ = 320 * MiB;
constexpr size_t WS_COEF = 352 * MiB;
constexpr size_t WS_CSC = 356 * MiB;
constexpr size_t WS_Y = 304 * MiB;
constexpr size_t WS_UT = 368 * MiB;
constexpr size_t WS_VT = 432 * MiB;
constexpr size_t WS_END = 496 * MiB;
static_assert(WS_WIT + 256 * 1024 <= WS_EXP && WS_PROJ + (size_t)T * NINP * 2 <= WS_Y && WS_WIN + (size_t)NINP * D * 2 <= WS_WOUT, "d_ws map");
constexpr int CW_DEFQ = 2240;
constexpr int CW_PREPBAR = 2176;
constexpr int CW_PREBAR = 2112;
constexpr int CW_LRUBAR = 2048;
constexpr int CW_BAR = 4096;

constexpr int RING_BYTES = 131072;
constexpr int LDSCTL_OFF = 143360, MISC_OFF = LDSCTL_OFF + 320;
constexpr int LDS_BYTES = 147456;

#define GAS __attribute__((address_space(1)))
#define LAS __attribute__((address_space(3)))
typedef unsigned short bf16;
typedef unsigned v4u __attribute__((ext_vector_type(4)));
typedef unsigned v2u __attribute__((ext_vector_type(2)));
typedef float f32x4 __attribute__((ext_vector_type(4)));
typedef float f32x16 __attribute__((ext_vector_type(16)));
typedef short bf16x8 __attribute__((ext_vector_type(8)));
typedef __bf16 bf16x2_t __attribute__((ext_vector_type(2)));
typedef GAS unsigned gu32;
#define RLX_AGENT __ATOMIC_RELAXED, __HIP_MEMORY_SCOPE_AGENT
__device__ __forceinline__ unsigned f2bf(float f) { unsigned u = __builtin_bit_cast(unsigned, f); return (u + 0x7fffu + ((u >> 16) & 1u)) >> 16; }
__device__ __forceinline__ unsigned pk2(float lo, float hi) { return f2bf(lo) | (f2bf(hi) << 16); }
__device__ __forceinline__ float bf_lo(unsigned w) { return __uint_as_float(w << 16); }
__device__ __forceinline__ float bf_hi(unsigned w) { return __uint_as_float(w & 0xffff0000u); }
__device__ __forceinline__ void unpack8(const v4u& w, float (&o)[8]) { o[0] = bf_lo(w.x); o[1] = bf_hi(w.x); o[2] = bf_lo(w.y); o[3] = bf_hi(w.y); o[4] = bf_lo(w.z); o[5] = bf_hi(w.z); o[6] = bf_lo(w.w); o[7] = bf_hi(w.w); }
__device__ __forceinline__ v4u pack8(const float (&o)[8]) { v4u w; w.x = pk2(o[0], o[1]); w.y = pk2(o[2], o[3]); w.z = pk2(o[4], o[5]); w.w = pk2(o[6], o[7]); return w; }
__device__ __forceinline__ float sigmoidf_(float x) { return 1.0f / (1.0f + __expf(-x)); }
__device__ __forceinline__ float softplusf_(float z) { return fmaxf(z, 0.f) + log1pf(__expf(-fabsf(z))); }
__device__ __forceinline__ float gelu_tanh(float x) { const float u = 0.7978845608028654f * (x + 0.044715f * x * x * x); return 0.5f * x * (1.0f + tanhf(u)); }
template <int CTRL> __device__ __forceinline__ float dppf(float x) { return __builtin_bit_cast(float, __builtin_amdgcn_mov_dpp(__builtin_bit_cast(int, x), CTRL, 0xf, 0xf, true)); }
__device__ __forceinline__ float red8(float v) { v += dppf<0xB1>(v); v += dppf<0x4E>(v); v += dppf<0x141>(v); return v; }
__device__ __forceinline__ float red16(float v) { v = red8(v); v += dppf<0x140>(v); return v; }
__device__ __forceinline__ float wave_sum(float v) {
#pragma unroll
    for (int o = 1; o < 64; o <<= 1) v += __shfl_xor(v, o);
    return v;
}
__device__ __forceinline__ float dot2bf(unsigned a, unsigned b, float acc) { return __builtin_amdgcn_fdot2_f32_bf16(__builtin_bit_cast(bf16x2_t, a), __builtin_bit_cast(bf16x2_t, b), acc, false); }
#define MFMA16(a, b, c) __builtin_amdgcn_mfma_f32_16x16x32_bf16((a), (b), (c), 0, 0, 0)
#define MFMA32(a, b, c) __builtin_amdgcn_mfma_f32_32x32x16_bf16((a), (b), (c), 0, 0, 0)

#define XB_TMO      128
#define XB_XCNT(j)  (256  + 64 * (j))
#define XB_XSUB(j)  (1280 + 64 * (j))
#define XB_XGEN(j)  (2304 + 64 * (j))
#define XB_TOP      3328
#define XB_TOPGEN   3392
#define XCD_BAR_WORDS 3456
#define XB_SPIN_CAP (1u << 22)
__device__ __forceinline__ unsigned xb_ld(unsigned* p)              { return __hip_atomic_load(p, __ATOMIC_RELAXED, __HIP_MEMORY_SCOPE_AGENT); }
__device__ __forceinline__ unsigned xb_add(unsigned* p, unsigned v) { return __hip_atomic_fetch_add(p, v, __ATOMIC_RELAXED, __HIP_MEMORY_SCOPE_AGENT); }
__device__ __forceinline__ unsigned xb_xcc_id() { return (unsigned)__builtin_amdgcn_s_getreg((3 << 11) | 20) & 0xFu; }
#define XB_SPIN(cond, bar) do { unsigned _sp = 0; while (cond) { __builtin_amdgcn_s_sleep(1); \
    if ((++_sp & 255u) == 0u) { if (xb_ld(&(bar)[XB_TMO])) break; if (_sp > XB_SPIN_CAP) { atomicAdd(&(bar)[XB_TMO], 1u); break; } } } } while (0)
struct XcdBarrier { unsigned* bar; unsigned x; volatile LAS unsigned* st; };
__device__ __forceinline__ XcdBarrier xcd_barrier_post(unsigned* bar, volatile LAS unsigned* st) {
    XcdBarrier b; b.bar = bar; b.x = xb_xcc_id(); b.st = st;
    if (threadIdx.x == 0) (void)xb_add(&bar[XB_XCNT(b.x)], 1u);
    return b;
}
__device__ __forceinline__ void xcd_barrier_complete(unsigned* bar, unsigned x, unsigned& nloc, unsigned& nx) {
    const unsigned G = gridDim.x * gridDim.y * gridDim.z;
    unsigned sum, cnt, mine, sp = 0u;
    for (;;) {
        sum = 0u; cnt = 0u; mine = 0u;
#pragma unroll
        for (unsigned j = 0; j < 16; ++j) { const unsigned c = xb_ld(&bar[XB_XCNT(j)]); sum += c; cnt += (c > 0u) ? 1u : 0u; mine = (j == x) ? c : mine; }
        if (sum == G) break;
        __builtin_amdgcn_s_sleep(1);
        if ((++sp & 255u) == 0u) { if (xb_ld(&bar[XB_TMO])) break; if (sp > XB_SPIN_CAP) { atomicAdd(&bar[XB_TMO], 1u); break; } }
    }
    nloc = mine > 0u ? mine : 1u; nx = cnt > 0u ? cnt : 1u;
}
__device__ __forceinline__ void xcd_barrier(const XcdBarrier& b) {
    asm volatile("s_waitcnt vmcnt(0)" ::: "memory");
    __syncthreads();
    if (threadIdx.x == 0) {
        unsigned* bar = b.bar;
        __builtin_amdgcn_s_waitcnt(0);
        unsigned nloc = b.st[0], nx = b.st[1];
        if (nloc == 0u) { xcd_barrier_complete(bar, b.x, nloc, nx); b.st[0] = nloc; b.st[1] = nx; }
        const unsigned old = xb_add(&bar[XB_XSUB(b.x)], 1u);
        const unsigned gen = old / nloc;
        if (old + 1u == (gen + 1u) * nloc) {
            __builtin_amdgcn_fence(__ATOMIC_RELEASE, "agent");
            asm volatile("s_waitcnt vmcnt(0)" ::: "memory");
            const unsigned og = xb_add(&bar[XB_TOP], 1u);
            const unsigned tg = og / nx;
            if (og + 1u == (tg + 1u) * nx) xb_add(&bar[XB_TOPGEN], 1u);
            else XB_SPIN(xb_ld(&bar[XB_TOPGEN]) == tg, bar);
            __builtin_amdgcn_fence(__ATOMIC_ACQUIRE, "agent");
            xb_add(&bar[XB_XGEN(b.x)], 1u);
            asm volatile("s_waitcnt vmcnt(0)" ::: "memory");
        } else {
            XB_SPIN(xb_ld(&bar[XB_XGEN(b.x)]) == gen, bar);
            __builtin_amdgcn_fence(__ATOMIC_ACQUIRE, "agent");
            asm volatile("s_waitcnt vmcnt(0)" ::: "memory");
        }
    }
    __syncthreads();
}

struct Frame {
    LAS unsigned char* lds;
    int tid, lane, wave, G, bid;
    const float* in[28];
    float* out;
    unsigned char* ws;
};
#define WSP(type, off) ((type*)(F.ws + (off)))
enum { I_X = 0, I_G1, I_WIN, I_CONVW, I_CONVB, I_WA, I_BA, I_WI, I_BI, I_LAM, I_MU, I_W0, I_W2, I_A0, I_A2, I_G2, I_KK, I_KA, I_RK, I_LNW, I_LNB, I_WOUT, I_G2N, I_WQ, I_KEYS, I_U, I_V, I_GF };

__device__ __forceinline__ void p0_transpose_item(const float* W, int K, int N, bf16* WT, const float* ksc, LAS float* scr, int item, int lane) {
    const int nblk = N / 32, kb = item / nblk, nb = item % nblk, k0 = 64 * kb, n0 = 32 * nb;
    const int lr = lane >> 3, c4 = (lane & 7) * 4;
    f32x4 v[8];
#pragma unroll
    for (int i = 0; i < 8; ++i) v[i] = *(const f32x4*)(W + (size_t)(k0 + 8 * i + lr) * N + n0 + c4);
#pragma unroll
    for (int i = 0; i < 8; ++i) { const int kk = 8 * i + lr; const float sc = ksc ? ksc[k0 + kk] : 1.0f; LAS float* d = scr + kk * 33 + c4; d[0] = v[i][0] * sc; d[1] = v[i][1] * sc; d[2] = v[i][2] * sc; d[3] = v[i][3] * sc; }
    asm volatile("s_waitcnt lgkmcnt(0)" ::: "memory");
    const int c = lane & 7;
#pragma unroll
    for (int j = 0; j < 4; ++j) { const int n = (lane >> 3) + 8 * j; const LAS float* s = scr + (8 * c) * 33 + n;
        v4u o; o.x = pk2(s[0 * 33], s[1 * 33]); o.y = pk2(s[2 * 33], s[3 * 33]); o.z = pk2(s[4 * 33], s[5 * 33]); o.w = pk2(s[6 * 33], s[7 * 33]);
        *(v4u*)(WT + (size_t)(n0 + n) * K + k0 + 8 * c) = o; }
    asm volatile("s_waitcnt lgkmcnt(0)" ::: "memory");
}
template <bool HASK> __device__ __forceinline__ void p0_wquant_block(const float* W, int N, unsigned char* WT8, float* cs, const float* ksc, int item, int wave, int lane, LAS float* mxs) {
    asm volatile("" : "+v"(lane));
    const int n0 = item * 32, r = lane >> 3, c4 = lane & 7, kb = 256 * wave + 4 * r;
    const float* src = W + (size_t)kb * N + n0 + 4 * c4; const float* kp = ksc + kb;
    f32x4 mx = (f32x4){0.f, 0.f, 0.f, 0.f};
#pragma unroll
    for (int i2 = 0; i2 < 2; ++i2) { f32x4 v[4][4], g4[4];
#pragma unroll
        for (int ii = 0; ii < 4; ++ii) { g4[ii] = HASK ? *(const f32x4*)(kp + 32 * (i2 * 4 + ii)) : (f32x4){1.f, 1.f, 1.f, 1.f};
#pragma unroll
            for (int j = 0; j < 4; ++j) v[ii][j] = *(const f32x4*)(src + (size_t)(32 * (i2 * 4 + ii) + j) * N); }
#pragma unroll
        for (int ii = 0; ii < 4; ++ii)
#pragma unroll
            for (int j = 0; j < 4; ++j)
#pragma unroll
                for (int e = 0; e < 4; ++e) mx[e] = fmaxf(mx[e], fabsf(v[ii][j][e] * g4[ii][j])); }
#pragma unroll
    for (int o = 8; o < 64; o <<= 1)
#pragma unroll
        for (int e = 0; e < 4; ++e) mx[e] = fmaxf(mx[e], __shfl_xor(mx[e], o));
    if (r == 0) *(LAS f32x4*)(mxs + wave * 32 + 4 * c4) = mx;
    __syncthreads();
#pragma unroll
    for (int w = 0; w < NWAVES; ++w) { const f32x4 t = *(const LAS f32x4*)(mxs + w * 32 + 4 * c4);
#pragma unroll
        for (int e = 0; e < 4; ++e) mx[e] = fmaxf(mx[e], t[e]); }
    f32x4 q;
#pragma unroll
    for (int e = 0; e < 4; ++e) q[e] = mx[e] > 0.f ? 127.0f / mx[e] : 0.f;
    if (wave == 0 && r == 0) *(f32x4*)(cs + n0 + 4 * c4) = mx * (1.0f / 127.0f);
    unsigned char* dst = WT8 + (size_t)(n0 + 4 * c4) * 2048 + kb;
#pragma unroll
    for (int i2 = 0; i2 < 2; ++i2) { f32x4 v[4][4], g4[4];
#pragma unroll
        for (int ii = 0; ii < 4; ++ii) { g4[ii] = HASK ? *(const f32x4*)(kp + 32 * (i2 * 4 + ii)) : (f32x4){1.f, 1.f, 1.f, 1.f};
#pragma unroll
            for (int j = 0; j < 4; ++j) v[ii][j] = *(const f32x4*)(src + (size_t)(32 * (i2 * 4 + ii) + j) * N); }
#pragma unroll
        for (int ii = 0; ii < 4; ++ii) { unsigned w[4] = {0u, 0u, 0u, 0u};
#pragma unroll
            for (int j = 0; j < 4; ++j)
#pragma unroll
                for (int e = 0; e < 4; ++e) { const int qi = (int)rintf(v[ii][j][e] * g4[ii][j] * q[e]); w[e] |= ((unsigned)qi & 0xFFu) << (8 * j); }
#pragma unroll
            for (int e = 0; e < 4; ++e) *(unsigned*)(dst + (size_t)e * 2048 + 32 * (i2 * 4 + ii)) = w[e]; } }
    __syncthreads();
}
__device__ __forceinline__ void p0_small_transpose(const float* src, bf16* dst, int nb, int K, int N, int gt, int NGT) {
    const int tot = nb * K * N;
    for (int i = gt; i < tot; i += NGT) { const int bb = i / (K * N), r = i - bb * K * N, n = r / K, k = r - n * K; dst[i] = (bf16)f2bf(src[(size_t)bb * K * N + (size_t)k * N + n]); }
}
template <int PART> __device__ __forceinline__ void p0_prologue(const Frame& F, int vb, int VG) {
    LAS float* scr = (LAS float*)(F.lds + F.wave * 8448);
    const int gw = vb * NWAVES + F.wave, NGW = VG * NWAVES, gt = gw * 64 + F.lane, NGT = NGW * 64;
    constexpr int I1 = (D / 64) * (NIN / 32), I2 = (D / 64) * (D / 32);
    if (PART == 0) { for (int it = vb; it < NIN / 32; it += VG) p0_wquant_block<true>(F.in[I_WIN], NIN, WSP(unsigned char, WS_WIN), WSP(float, WS_CS1), F.in[I_G1], it, F.wave, F.lane, (LAS float*)(F.lds + 8 * 8448)); }
    else { const int sp = VG >= 64 ? VG / 64 : 1;
           for (int v = vb; v < sp * (D / 32); v += VG) {
               if (v % sp == 0) p0_wquant_block<false>(F.in[I_WQ], D, WSP(unsigned char, WS_WQ), WSP(float, WS_CSQ), nullptr, v / sp, F.wave, F.lane, (LAS float*)(F.lds + 8 * 8448));
               if (v % sp == sp / 2) p0_wquant_block<false>(F.in[I_WOUT], D, WSP(unsigned char, WS_WOUT), WSP(float, WS_CSO), nullptr, v / sp, F.wave, F.lane, (LAS float*)(F.lds + 8 * 8448)); } }
    if (PART == 0) {
    { v4u* z = (v4u*)(WSP(unsigned char, WS_WIN) + (size_t)NIN * D); const int nz = (NINP - NIN) * D / 16; for (int i = gt; i < nz; i += NGT) z[i] = (v4u){0u, 0u, 0u, 0u};
      for (int i = gt; i < NINP - NIN; i += NGT) WSP(float, WS_CS1)[NIN + i] = 0.f; }
    p0_small_transpose(F.in[I_W2], WSP(bf16, WS_W2T), 1, 64, 1024, gt, NGT);
    p0_small_transpose(F.in[I_A2], WSP(bf16, WS_A2T), 1, 64, 1024, gt, NGT);
    p0_small_transpose(F.in[I_G2], WSP(bf16, WS_G2T), 1, 160, 1024, gt, NGT);
    p0_small_transpose(F.in[I_WA], WSP(bf16, WS_WAT), 8, 128, 128, gt, NGT);
    p0_small_transpose(F.in[I_WI], WSP(bf16, WS_WIT), 8, 128, 128, gt, NGT);
    { const float* s = F.in[I_KEYS]; bf16* d = WSP(bf16, WS_KEYS); for (int i = gt; i < 8 * 2 * 128 * 128 / 8; i += NGT) { const f32x4 a = *(const f32x4*)(s + (size_t)i * 8), b = *(const f32x4*)(s + (size_t)i * 8 + 4);
        v4u o; o.x = pk2(a[0], a[1]); o.y = pk2(a[2], a[3]); o.z = pk2(b[0], b[1]); o.w = pk2(b[2], b[3]); *(v4u*)(d + (size_t)i * 8) = o; } }
    }
    if (PART == 0) {
    { const float* x = F.in[I_X]; unsigned char* xq = (unsigned char*)F.out + OUT_X8; float* rs1 = WSP(float, WS_RSTD1); float* sx0 = WSP(float, WS_SX0);
#define XR_LOAD(V_, row_) do { _Pragma("unroll") for (int hh_ = 0; hh_ < 2; ++hh_) _Pragma("unroll") for (int q_ = 0; q_ < 4; ++q_) V_[hh_][q_] = *(const f32x4*)(x + (size_t)(row_) * D + hh_ * 1024 + F.lane * 16 + q_ * 4); } while (0)
#define XR_QUANT(V_, row_) do { float s_ = 0.f, am_ = 0.f; \
          _Pragma("unroll") for (int hh_ = 0; hh_ < 2; ++hh_) _Pragma("unroll") for (int q_ = 0; q_ < 4; ++q_) _Pragma("unroll") for (int e_ = 0; e_ < 4; ++e_) { const float t_ = V_[hh_][q_][e_]; s_ += t_ * t_; am_ = fmaxf(am_, fabsf(t_)); } \
          s_ = wave_sum(s_); \
          _Pragma("unroll") for (int o_ = 1; o_ < 64; o_ <<= 1) am_ = fmaxf(am_, __shfl_xor(am_, o_)); \
          const float xq_ = am_ > 0.f ? 127.0f / am_ : 0.f; \
          if (F.lane == 0) { rs1[row_] = am_ * (1.0f / 127.0f) / sqrtf(s_ * (1.0f / D) + NORM_EPS); sx0[row_] = am_ * (1.0f / 127.0f); } \
          _Pragma("unroll") for (int hh_ = 0; hh_ < 2; ++hh_) { v4u o_; \
              _Pragma("unroll") for (int q_ = 0; q_ < 4; ++q_) { unsigned w_ = 0u; \
                  _Pragma("unroll") for (int e_ = 0; e_ < 4; ++e_) { const int qi_ = (int)rintf(V_[hh_][q_][e_] * xq_); w_ |= ((unsigned)qi_ & 0xFFu) << (8 * e_); } \
                  o_[q_] = w_; } \
              *(v4u*)(xq + (size_t)(row_) * D + hh_ * 1024 + F.lane * 16) = o_; } } while (0)
      for (int m = gw; m < T; m += 2 * NGW) { const int mB = m + NGW < T ? m + NGW : m;
          f32x4 xa[2][4], xb2[2][4];
          XR_LOAD(xa, m); XR_LOAD(xb2, mB);
          XR_QUANT(xa, m);
          if (mB != m) XR_QUANT(xb2, mB); }
#undef XR_LOAD
#undef XR_QUANT
    }
    }
}

typedef float f32x2c __attribute__((ext_vector_type(2)));
__device__ __forceinline__ unsigned cvtpk(float lo, float hi) { const f32x2c v = {lo, hi}; const bf16x2_t b = __builtin_convertvector(v, bf16x2_t); return __builtin_bit_cast(unsigned, b); }
__device__ __forceinline__ float rcpf_(float x) { return __builtin_amdgcn_rcpf(x); }
__device__ __forceinline__ float sigmoid_fast(float x) { return rcpf_(1.0f + __expf(-x)); }
__device__ __forceinline__ float tanh_fast(float x) { return 1.0f - 2.0f * rcpf_(1.0f + __expf(2.0f * x)); }
__device__ __forceinline__ float softplus_fast(float z) { return fmaxf(z, 0.f) + __logf(1.0f + __expf(-fabsf(z))); }
__device__ __forceinline__ float gelu_fast(float x) { const float u = 0.7978845608028654f * (x + 0.044715f * x * x * x); return x * rcpf_(1.0f + __expf(-2.0f * u)); }
__device__ __forceinline__ void rwkv_prep_unit(const Frame& F, int chunk, int h, int lane, const LAS bf16* WL2, const LAS bf16* AL2, const LAS bf16* GL2, const LAS float* CW, LAS bf16* ST) {
    asm volatile("" : "+v"(lane));
    const int fr = lane & 15, fq = lane >> 4;
    const bf16* PROJ = WSP(bf16, WS_PROJ); const bf16* LA = WSP(bf16, WS_LA);
    bf16* TA = WSP(bf16, WS_TA); bf16* TB = WSP(bf16, WS_TB); bf16* TK = WSP(bf16, WS_TK); bf16* TR = WSP(bf16, WS_TR);
    bf16* TV = (bf16*)F.out + OUT_TV / 2; bf16* TG = (bf16*)F.out + OUT_TG / 2; float* PCG = F.out + OUT_PC / 4; float* BONG = F.out + OUT_BON / 4;
#define PU4(w_) ((f32x4){bf_lo((w_).x), bf_hi((w_).x), bf_lo((w_).y), bf_hi((w_).y)})
    size_t tokm[2];
#pragma unroll
    for (int mt = 0; mt < 2; ++mt) tokm[mt] = (size_t)chunk * 32 + mt * 16 + fr;
    v2u cA[4][3], cB[4][3], eA[4][3];
    const bool hs = (chunk & 63) != 0; const unsigned hsm = hs ? 0xffffffffu : 0u; const size_t toke = (size_t)chunk * 32 - (hs ? 1 : 0);
#define PREP_LOAD_MT(C_, tok_) do { _Pragma("unroll") for (int nt_ = 0; nt_ < 4; ++nt_) { const bf16* pr_ = PROJ + (tok_) * NINP + PC_R + h * 64 + nt_ * 16 + fq * 4; \
        _Pragma("unroll") for (int q_ = 0; q_ < 3; ++q_) C_[nt_][q_] = *(const v2u*)(pr_ + q_ * 1024); } } while (0)
#define DPPU(old_, src_, ctl_) ((unsigned)__builtin_amdgcn_update_dpp((int)(old_), (int)(src_), ctl_, 0xf, 0xf, false))
#define PREP_PREV(dst_, mt_, nt_, q_) do { const v2u c_ = (mt_) ? cB[nt_][q_] : cA[nt_][q_]; v2u o_; \
        if (mt_) { o_.x = DPPU(0, cA[nt_][q_].x, 0x121); o_.y = DPPU(0, cA[nt_][q_].y, 0x121); } else { o_.x = eA[nt_][q_].x & hsm; o_.y = eA[nt_][q_].y & hsm; } \
        dst_.x = DPPU(o_.x, c_.x, 0x111); dst_.y = DPPU(o_.y, c_.y, 0x111); } while (0)
    PREP_LOAD_MT(cA, tokm[0]); PREP_LOAD_MT(eA, toke);
    bf16x8 la[9];
#pragma unroll
    for (int ks = 0; ks < 9; ++ks) la[ks] = *(const bf16x8*)(LA + tokm[0] * 288 + ks * 32 + 8 * fq);
    PREP_LOAD_MT(cB, tokm[1]);
    float inv[2], bn[2];
#pragma unroll
    for (int mt = 0; mt < 2; ++mt) { float s2 = 0.f;
#pragma unroll
        for (int nt = 0; nt < 4; ++nt) { const int j4 = nt * 16 + fq * 4;
            const v2u kc = mt ? cB[nt][1] : cA[nt][1]; v2u kp; PREP_PREV(kp, mt, nt, 1);
            const f32x4 c_kk = *(const LAS f32x4*)(CW + 128 + j4), m_k = *(const LAS f32x4*)(CW + 384 + j4);
            const f32x4 kcf = PU4(kc); const f32x4 ku = (kcf + (PU4(kp) - kcf) * m_k) * c_kk; s2 += (ku[0] * ku[0] + ku[1] * ku[1]) + (ku[2] * ku[2] + ku[3] * ku[3]); }
        { auto x = __builtin_amdgcn_permlane16_swap(__float_as_uint(s2), __float_as_uint(s2), false, false); s2 = __uint_as_float(x[0]) + __uint_as_float(x[1]); }
        { auto x = __builtin_amdgcn_permlane32_swap(__float_as_uint(s2), __float_as_uint(s2), false, false); s2 = __uint_as_float(x[0]) + __uint_as_float(x[1]); }
        inv[mt] = __builtin_amdgcn_rsqf(fmaxf(s2, 1e-24f)); bn[mt] = 0.f; }
    f32x4 tot0[4];
#pragma unroll
    for (int n = 0; n < 4; ++n) tot0[n] = (f32x4){0.f, 0.f, 0.f, 0.f};
#pragma unroll
    for (int st = 0; st < 8; ++st) { const int mt = st >> 2, nt = st & 3; const int j4 = nt * 16 + fq * 4; const size_t col = (size_t)h * 64 + j4;
        v2u cur_[3], prv_[3];
#pragma unroll
        for (int q = 0; q < 3; ++q) { cur_[q] = mt ? cB[nt][q] : cA[nt][q]; PREP_PREV(prv_[q], mt, nt, q); }
        f32x4 cw = (f32x4){0.f, 0.f, 0.f, 0.f}, ca = cw, cg = cw;
#pragma unroll
        for (int ks = 0; ks < 2; ++ks) { cw = MFMA16(*(const LAS bf16x8*)(WL2 + (nt * 16 + fr) * 72 + ks * 32 + 8 * fq), la[ks], cw); ca = MFMA16(*(const LAS bf16x8*)(AL2 + (nt * 16 + fr) * 72 + ks * 32 + 8 * fq), la[2 + ks], ca); }
#pragma unroll
        for (int ks = 0; ks < 5; ++ks) cg = MFMA16(*(const LAS bf16x8*)(GL2 + (nt * 16 + fr) * 168 + ks * 32 + 8 * fq), la[4 + ks], cg);
        if (st == 3) {
#pragma unroll
            for (int ks = 0; ks < 9; ++ks) la[ks] = *(const bf16x8*)(LA + tokm[1] * 288 + ks * 32 + 8 * fq); }
        const f32x4 c_w0 = *(const LAS f32x4*)(CW + j4), c_a0 = *(const LAS f32x4*)(CW + 64 + j4), c_kk = *(const LAS f32x4*)(CW + 128 + j4), c_ka = *(const LAS f32x4*)(CW + 192 + j4), c_rk = *(const LAS f32x4*)(CW + 256 + j4);
        const f32x4 m_r = *(const LAS f32x4*)(CW + 320 + j4), m_k = *(const LAS f32x4*)(CW + 384 + j4), m_v = *(const LAS f32x4*)(CW + 448 + j4);
        const v2u rp = prv_[0], kp = prv_[1], vp = prv_[2];
        const f32x4 rcf = PU4(cur_[0]), kcf = PU4(cur_[1]), vcf = PU4(cur_[2]);
        const f32x4 rr = rcf + (PU4(rp) - rcf) * m_r, kv = kcf + (PU4(kp) - kcf) * m_k, vv = vcf + (PU4(vp) - vcf) * m_v;
        f32x4 nau, bbu, km, cum;
#pragma unroll
        for (int r = 0; r < 4; ++r) { const float av = sigmoid_fast(c_a0[r] + ca[r]), ku = kv[r] * c_kk[r]; km[r] = kv[r] * (1.0f + (av - 1.0f) * c_ka[r]);
            cum[r] = -0.6065306597126334f * sigmoid_fast(c_w0[r] + cw[r]);
            nau[r] = -ku; bbu[r] = ku * av; bn[mt] += rr[r] * km[r] * c_rk[r]; }
        f32x4 at4, rt4, bt4, kt4, ep4;
#pragma unroll
        for (int r = 0; r < 4; ++r) { float v = cum[r];
            v += __builtin_bit_cast(float, __builtin_amdgcn_update_dpp(0, __builtin_bit_cast(int, v), 0x111, 0xf, 0xf, true));
            v += __builtin_bit_cast(float, __builtin_amdgcn_update_dpp(0, __builtin_bit_cast(int, v), 0x112, 0xf, 0xf, true));
            v += __builtin_bit_cast(float, __builtin_amdgcn_update_dpp(0, __builtin_bit_cast(int, v), 0x114, 0xf, 0xf, true));
            v += __builtin_bit_cast(float, __builtin_amdgcn_update_dpp(0, __builtin_bit_cast(int, v), 0x118, 0xf, 0xf, true));
            if (mt == 0) tot0[nt][r] = __shfl(v, (lane & 48) | 15); else v += tot0[nt][r];
            const float ep = __expf(v), em = rcpf_(ep);
            float eprev = __builtin_bit_cast(float, __builtin_amdgcn_update_dpp(0, __builtin_bit_cast(int, ep), 0x111, 0xf, 0xf, true));
            if (fr == 0) eprev = mt ? __expf(tot0[nt][r]) : 1.0f;
            at4[r] = nau[r] * inv[mt] * eprev; rt4[r] = rr[r] * ep; bt4[r] = bbu[r] * inv[mt] * em; kt4[r] = km[r] * em; ep4[r] = ep; }
        { LAS bf16* sp = ST + fr * 64 + j4; v2u w;
          w.x = cvtpk(at4[0], at4[1]); w.y = cvtpk(at4[2], at4[3]); *(LAS v2u*)(sp) = w;
          w.x = cvtpk(rt4[0], rt4[1]); w.y = cvtpk(rt4[2], rt4[3]); *(LAS v2u*)(sp + 1024) = w;
          w.x = cvtpk(bt4[0], bt4[1]); w.y = cvtpk(bt4[2], bt4[3]); *(LAS v2u*)(sp + 2048) = w;
          w.x = cvtpk(kt4[0], kt4[1]); w.y = cvtpk(kt4[2], kt4[3]); *(LAS v2u*)(sp + 3072) = w;
          w.x = cvtpk(vv[0], vv[1]); w.y = cvtpk(vv[2], vv[3]); *(LAS v2u*)(sp + 4096) = w;
          w.x = cvtpk(cg[0], cg[1]); w.y = cvtpk(cg[2], cg[3]); *(LAS v2u*)(sp + 5120) = w; }
        if (nt == 3) {
            bf16* const dstp[6] = {TA, TR, TB, TK, TV, TG};
#pragma unroll
            for (int a6 = 0; a6 < 6; ++a6)
#pragma unroll
                for (int hrow = 0; hrow < 2; ++hrow) { const int row = hrow * 8 + (lane >> 3), c8 = (lane & 7) * 8;
                    const v4u pv = *(const LAS v4u*)(ST + a6 * 1024 + row * 64 + c8);
                    *(v4u*)(dstp[a6] + ((size_t)chunk * 32 + mt * 16 + row) * 1024 + (size_t)h * 64 + c8) = pv; } }
        if (mt == 1 && fr == 15) *(f32x4*)(PCG + (size_t)chunk * 1024 + col) = ep4;
    }
#undef PREP_LOAD_MT
#undef PREP_PREV
#undef DPPU
#undef PU4
#pragma unroll
    for (int mt = 0; mt < 2; ++mt) { float b2 = bn[mt];
        { auto x = __builtin_amdgcn_permlane16_swap(__float_as_uint(b2), __float_as_uint(b2), false, false); b2 = __uint_as_float(x[0]) + __uint_as_float(x[1]); }
        { auto x = __builtin_amdgcn_permlane32_swap(__float_as_uint(b2), __float_as_uint(b2), false, false); b2 = __uint_as_float(x[0]) + __uint_as_float(x[1]); }
        if (fq == 0) BONG[tokm[mt] * 16 + h] = b2; }
}
__device__ __forceinline__ void rwkv_prep_phase(const Frame& F) {
    LAS bf16* WL2 = (LAS bf16*)(F.lds + 0); LAS bf16* AL2 = (LAS bf16*)(F.lds + 9216); LAS bf16* GL2 = (LAS bf16*)(F.lds + 18432); LAS float* CW = (LAS float*)(F.lds + 39936);
    int hcur = -1;
    for (int u = F.bid; u < 1024; u += F.G) { const int h = u & 15, cg = u >> 4;
        if (h != hcur) { hcur = h; __syncthreads();
            int tid_ = F.tid; asm volatile("" : "+v"(tid_));
            const bf16* w2t = WSP(bf16, WS_W2T) + (size_t)h * 64 * 64; const bf16* a2t = WSP(bf16, WS_A2T) + (size_t)h * 64 * 64; const bf16* g2t = WSP(bf16, WS_G2T) + (size_t)h * 64 * 160;
            { const int r = tid_ >> 3, c = (tid_ & 7) * 8; *(LAS v4u*)(WL2 + r * 72 + c) = *(const v4u*)(w2t + r * 64 + c); *(LAS v4u*)(AL2 + r * 72 + c) = *(const v4u*)(a2t + r * 64 + c); }
            for (int i = tid_; i < 64 * 20; i += NTHR) { const int r = i / 20, c = (i - r * 20) * 8; *(LAS v4u*)(GL2 + r * 168 + c) = *(const v4u*)(g2t + r * 160 + c); }
            { const int q = tid_ >> 6, jj = tid_ & 63; const float* src = q == 0 ? F.in[I_W0] : (q == 1 ? F.in[I_A0] : (q == 2 ? F.in[I_KK] : (q == 3 ? F.in[I_KA] : (q == 4 ? F.in[I_RK] : F.in[I_MU] + (q - 5) * 1024)))); CW[q * 64 + jj] = src[h * 64 + jj]; }
            __syncthreads(); }
        rwkv_prep_unit(F, cg * 8 + F.wave, h, F.lane, WL2, AL2, GL2, CW, (LAS bf16*)(F.lds + 43008 + F.wave * 12288)); }
    __syncthreads();
}
typedef short v4i16_t __attribute__((ext_vector_type(4)));
__device__ __forceinline__ bf16x8 frag_tr16(const LAS bf16* p, int ld) {
    const v4i16_t a = __builtin_amdgcn_ds_read_tr16_b64_v4i16((LAS v4i16_t*)p), b = __builtin_amdgcn_ds_read_tr16_b64_v4i16((LAS v4i16_t*)(p + 4 * ld));
    return (bf16x8){a[0], a[1], a[2], a[3], b[0], b[1], b[2], b[3]};
}
#define RD_LOAD(src_, act_, row0_, j_) do { const float* tp_ = (src_) + ((act_) ? ((size_t)((row0_) + ((j_) >> 1)) * D + ((j_) & 1) * 1024) : (size_t)0) + lane * 16; \
        _Pragma("unroll") for (int q_ = 0; q_ < 4; ++q_) th[q_] = *(const f32x4*)(tp_ + q_ * 4); } while (0)
#define RD_PACK(dst_, v_, tq_) do { _Pragma("unroll") for (int q_ = 0; q_ < 4; ++q_) {   \
            const unsigned b0_ = __float_as_uint(__builtin_fmaf(v_[q_][0], tq_, 12582912.0f)), b1_ = __float_as_uint(__builtin_fmaf(v_[q_][1], tq_, 12582912.0f)); \
            const unsigned b2_ = __float_as_uint(__builtin_fmaf(v_[q_][2], tq_, 12582912.0f)), b3_ = __float_as_uint(__builtin_fmaf(v_[q_][3], tq_, 12582912.0f)); \
            dst_[q_] = __builtin_amdgcn_perm(b1_, b0_, 0x0c0c0400u) | __builtin_amdgcn_perm(b3_, b2_, 0x04000c0cu); } } while (0)
#define RD_CONSUME(dstb_, scb_, row0_, j_) do { float am_ = 0.f; \
        _Pragma("unroll") for (int q_ = 0; q_ < 4; ++q_) _Pragma("unroll") for (int e_ = 0; e_ < 4; ++e_) am_ = fmaxf(am_, fabsf(th[q_][e_])); \
        if (((j_) & 1) == 0) { _Pragma("unroll") for (int q_ = 0; q_ < 4; ++q_) tk[q_] = th[q_]; tkm = am_; } \
        else { am_ = fmaxf(am_, tkm); \
            am_ = fmaxf(am_, dppf<0xB1>(am_)); am_ = fmaxf(am_, dppf<0x4E>(am_)); am_ = fmaxf(am_, dppf<0x141>(am_)); am_ = fmaxf(am_, dppf<0x140>(am_)); \
            { auto s_ = __builtin_amdgcn_permlane16_swap(__float_as_uint(am_), __float_as_uint(am_), false, false); am_ = fmaxf(__uint_as_float(s_[0]), __uint_as_float(s_[1])); } \
            { auto s_ = __builtin_amdgcn_permlane32_swap(__float_as_uint(am_), __float_as_uint(am_), false, false); am_ = fmaxf(__uint_as_float(s_[0]), __uint_as_float(s_[1])); } \
            const float tq_ = am_ > 0.f ? 127.0f / am_ : 0.f; const size_t ro_ = (size_t)((row0_) + ((j_) >> 1)); \
            if (lane == 0) (scb_)[ro_] = am_ * (1.0f / 127.0f); \
            v4u o0_, o1_; RD_PACK(o0_, tk, tq_); RD_PACK(o1_, th, tq_); \
            *(v4u*)((dstb_) + ro_ * D + lane * 16) = o0_; *(v4u*)((dstb_) + ro_ * D + 1024 + lane * 16) = o1_; } } while (0)
__device__ __forceinline__ void rwkv_item(const Frame& F, int item) {
    const int b = item >> 4, h = item & 15, wave = F.wave; int tid = F.tid; asm volatile("" : "+v"(tid)); const int lane = tid & 63;
    LAS unsigned char* L = F.lds;
    constexpr int LD64 = 72, LD32 = 40, E0 = 73216;
    LAS bf16* AT = (LAS bf16*)(L + 0);  LAS bf16* BT_ = (LAS bf16*)(L + 4608); LAS bf16* KT_ = (LAS bf16*)(L + 9216); LAS bf16* RT = (LAS bf16*)(L + 13824);
    LAS bf16* VS2 = (LAS bf16*)(L + 18432);
    LAS bf16* GGB2 = (LAS bf16*)(L + 27648);
    LAS bf16* S0B = (LAS bf16*)(L + 36864);
    LAS float* YB2 = (LAS float*)(L + 55296);
    LAS float* BON2 = (LAS float*)(L + 72704);
    LAS float* PC = (LAS float*)(L + 72960);
    LAS bf16* AAK = (LAS bf16*)(L + E0); LAS bf16* ARB = (LAS bf16*)(L + E0 + 2560); LAS bf16* ARK = (LAS bf16*)(L + E0 + 5120);
    LAS bf16* MINV = (LAS bf16*)(L + E0 + 7680);
    LAS bf16* RHS = (LAS bf16*)(L + E0 + 23040);
    LAS bf16* SAB = (LAS bf16*)(L + E0 + 28160);
    static_assert(E0 + 33280 <= LDSCTL_OFF, "rwkv LDS map");
    bf16* Y = WSP(bf16, WS_Y);
#define FRAG(base, row0, ld, ks) (*(const LAS bf16x8*)((base) + ((row0) + fr) * (ld) + (ks) * 32 + 8 * fq))
#define FRAGT(base, col0, ld) frag_tr16((base) + (8 * fq + (fr >> 2)) * (ld) + (col0) + 4 * (fr & 3), (ld))
    const int tt = tid >> 4, j0 = (tid & 15) * 4, hc = h * 64 + j0;
    const f32x4 plw = *(const f32x4*)(F.in[I_LNW] + hc), plb = *(const f32x4*)(F.in[I_LNB] + hc);
    const int lr = (tid & 255) >> 3, lc8 = tid & 7; const bool hi2 = tid >= 256;
    const bf16* srcA[3] = { (hi2 ? WSP(bf16, WS_TR) : WSP(bf16, WS_TA)), (hi2 ? WSP(bf16, WS_TK) : WSP(bf16, WS_TB)), (hi2 ? (const bf16*)F.out + OUT_TG / 2 : (const bf16*)F.out + OUT_TV / 2) };
    const size_t poff = ((size_t)b * SEQ + lr) * 1024 + h * 64 + lc8 * 8;
    const float* PCG = F.out + OUT_PC / 4 + (size_t)(b * 64) * 1024 + h * 64; const float* BONG = F.out + OUT_BON / 4 + (size_t)b * SEQ * 16 + h;
    v4u pl_[3]; float ppc = 0.f, pbn = 0.f;
#define RWKV_PREFETCH(tl_) do { _Pragma("unroll") for (int q_ = 0; q_ < 3; ++q_) pl_[q_] = *(const v4u*)(srcA[q_] + poff + (size_t)(tl_) * 32 * 1024); \
        ppc = PCG[(size_t)(tl_) * 1024 + (tid & 63)]; pbn = BONG[((size_t)(tl_) * 32 + (tid & 31)) * 16]; } while (0)
    const int ib = wave >> 1, tb = wave & 1, i0 = ib * 16, t0m = tb * 16;
    f32x4 sacc[2], yacc;
    sacc[0] = (f32x4){0.f, 0.f, 0.f, 0.f}; sacc[1] = sacc[0]; yacc = sacc[0];
    for (int u = tid; u < 2 * 64 * LD64 / 2; u += NTHR) ((LAS unsigned*)S0B)[u] = 0u;
    RWKV_PREFETCH(0);
    __syncthreads();
    for (int tl = 0; tl <= SEQ / 32; ++tl) {
        const int cur = tl & 1;
        int lane_c = lane; asm volatile("" : "+v"(lane_c)); const int fr = lane_c & 15, fq = lane_c >> 4;
        LAS bf16* VS = VS2 + cur * 32 * LD64; LAS bf16* GGB = GGB2 + cur * 32 * LD64; LAS float* YB = YB2 + cur * 32 * 68; LAS float* BON = BON2 + cur * 32;
        const LAS bf16* VSp = VS2 + (cur ^ 1) * 32 * LD64; const LAS bf16* GGBp = GGB2 + (cur ^ 1) * 32 * LD64; const LAS float* YBp = YB2 + (cur ^ 1) * 32 * 68; const LAS float* BONp = BON2 + (cur ^ 1) * 32;
        if (tl > 0) { const size_t tokb = (size_t)b * SEQ + (tl - 1) * 32;
          const f32x4 y4 = *(const LAS f32x4*)(YBp + tt * 68 + j0); const v2u gw_ = *(const LAS v2u*)(GGBp + tt * LD64 + j0);
          const f32x4 g4 = (f32x4){bf_lo(gw_.x), bf_hi(gw_.x), bf_lo(gw_.y), bf_hi(gw_.y)};
          const v2u vw_ = *(const LAS v2u*)(VSp + tt * LD64 + j0); const f32x4 v4 = (f32x4){bf_lo(vw_.x), bf_hi(vw_.x), bf_lo(vw_.y), bf_hi(vw_.y)};
          float sm = (y4[0] + y4[1]) + (y4[2] + y4[3]); sm = red16(sm); const float mean = sm * (1.0f / 64.0f);
          const f32x4 d4 = y4 - mean; float sv = (d4[0] * d4[0] + d4[1] * d4[1]) + (d4[2] * d4[2] + d4[3] * d4[3]); sv = red16(sv);
          const float rstd = __builtin_amdgcn_rsqf(sv * (1.0f / 64.0f) + GN_EPS), bon = BONp[tt];
          f32x4 o;
#pragma unroll
          for (int e = 0; e < 4; ++e) o[e] = (d4[e] * rstd * plw[e] + plb[e] + bon * v4[e]) * g4[e];
          v2u w; w.x = cvtpk(o[0], o[1]); w.y = cvtpk(o[2], o[3]);
          *(v2u*)(Y + (tokb + tt) * D + 1024 + hc) = w; }
        if (tl == SEQ / 32) break;
        const LAS bf16* S0c = S0B + cur * 64 * LD64; LAS bf16* S0n = S0B + (cur ^ 1) * 64 * LD64;
        { const v4u p0 = pl_[0], p1 = pl_[1], p2 = pl_[2];
          *(LAS v4u*)((hi2 ? RT : AT) + lr * LD64 + lc8 * 8) = p0;
          *(LAS v4u*)((hi2 ? KT_ : BT_) + lr * LD64 + lc8 * 8) = p1;
          *(LAS v4u*)((hi2 ? GGB : VS) + lr * LD64 + lc8 * 8) = p2;
          if (tid < 64) PC[tid] = ppc;
          if (tid >= 64 && tid < 96) BON[tid - 64] = pbn; }
        { const int tn_ = tl + 1 < SEQ / 32 ? tl + 1 : SEQ / 32 - 1; RWKV_PREFETCH(tn_); }
        __syncthreads();
        f32x4 rhs4 = (f32x4){0.f, 0.f, 0.f, 0.f};
#define RWKV_FIRST do { rhs4 = (f32x4){0.f, 0.f, 0.f, 0.f}; yacc = (f32x4){0.f, 0.f, 0.f, 0.f}; \
            _Pragma("unroll") for (int ks = 0; ks < 2; ++ks) rhs4 = MFMA16(FRAG(AT, t0m, LD64, ks), FRAG(S0c, i0, LD64, ks), rhs4); \
            _Pragma("unroll") for (int ks = 0; ks < 2; ++ks) yacc = MFMA16(FRAG(S0c, i0, LD64, ks), FRAG(RT, t0m, LD64, ks), yacc); \
            _Pragma("unroll") for (int u = 0; u < 2; ++u) { const int tile = wave * 2 + u, si0 = (tile >> 2) * 16, sj0 = (tile & 3) * 16; sacc[u] = MFMA16(FRAGT(KT_, sj0, LD64), FRAGT(VS, si0, LD64), sacc[u]); } } while (0)
#define PK8(a_, s_) __builtin_bit_cast(bf16x8, (v4u){cvtpk(a_[8 * (s_) + 0], a_[8 * (s_) + 1]), cvtpk(a_[8 * (s_) + 2], a_[8 * (s_) + 3]), cvtpk(a_[8 * (s_) + 4], a_[8 * (s_) + 5]), cvtpk(a_[8 * (s_) + 6], a_[8 * (s_) + 7])})
        if (wave == 0) {
            const int c32 = lane_c & 31, h32 = lane_c >> 5;
            f32x16 U, V, PT;
#pragma unroll
            for (int e = 0; e < 16; ++e) { U[e] = 0.f; V[e] = 0.f; }
#pragma unroll
            for (int ks = 0; ks < 4; ++ks) { const bf16x8 fa = *(const LAS bf16x8*)(AT + c32 * LD64 + ks * 16 + h32 * 8), fb = *(const LAS bf16x8*)(BT_ + c32 * LD64 + ks * 16 + h32 * 8);
                U = MFMA32(fa, fb, U);
                V = MFMA32(fb, fa, V); }
#pragma unroll
            for (int e = 0; e < 16; ++e) { const int rr = (e & 3) + 8 * (e >> 2) + 4 * h32;
                U[e] = (c32 < rr) ? U[e] : 0.f;
                V[e] = (rr < c32) ? V[e] : 0.f;
                PT[e] = V[e] + ((rr == c32) ? 1.0f : 0.f); }
#pragma unroll
            for (int st = 1; st <= 5; ++st) {
                const bf16x8 fU0 = PK8(U, 0), fU1 = PK8(U, 1);
                f32x16 Un, Vn;
#pragma unroll
                for (int e = 0; e < 16; ++e) { Un[e] = 0.f; Vn[e] = 0.f; }
                if (st < 5) { const bf16x8 fV0 = PK8(V, 0), fV1 = PK8(V, 1);
                    Un = MFMA32(fV0, fU0, Un); Un = MFMA32(fV1, fU1, Un);
                    if (st < 4) { Vn = MFMA32(fU0, fV0, Vn); Vn = MFMA32(fU1, fV1, Vn); } }
                if (st > 1) { const bf16x8 fP0 = PK8(PT, 0), fP1 = PK8(PT, 1);
                    PT = MFMA32(fU0, fP0, PT); PT = MFMA32(fU1, fP1, PT); }
                U = Un; V = Vn; }
#pragma unroll
            for (int q = 0; q < 4; ++q) { v2u w; w.x = cvtpk(PT[4 * q], PT[4 * q + 1]); w.y = cvtpk(PT[4 * q + 2], PT[4 * q + 3]); *(LAS v2u*)(MINV + c32 * LD32 + 8 * q + 4 * h32) = w; }
        } else {
            if (wave < 7) { const int mtx = (wave - 1) >> 1;
                const LAS bf16* Xs = (mtx == 1) ? BT_ : KT_; const LAS bf16* Yt = (mtx == 0) ? AT : RT; LAS bf16* O = (mtx == 0) ? AAK : (mtx == 1 ? ARB : ARK);
#pragma unroll
                for (int qq = 0; qq < 2; ++qq) { const int q = ((wave - 1) & 1) * 2 + qq, tq = (q >> 1) * 16, sq = (q & 1) * 16;
                    f32x4 a4 = (f32x4){0.f, 0.f, 0.f, 0.f};
                    if (sq <= tq) {
#pragma unroll
                        for (int ks = 0; ks < 2; ++ks) a4 = MFMA16(FRAG(Xs, sq, LD64, ks), FRAG(Yt, tq, LD64, ks), a4); }
                    const int t = tq + fr, s = sq + fq * 4;
#pragma unroll
                    for (int r = 0; r < 4; ++r) { const bool keep = (mtx == 0) ? (s + r < t) : (s + r <= t); a4[r] = keep ? a4[r] : 0.f; }
                    v2u w; w.x = cvtpk(a4[0], a4[1]); w.y = cvtpk(a4[2], a4[3]); *(LAS v2u*)(O + t * LD32 + s) = w; } }
            RWKV_FIRST;
        }
        __syncthreads();
        if (wave == 0) RWKV_FIRST;
        { rhs4 = MFMA16(FRAG(AAK, t0m, LD32, 0), FRAGT(VS, i0, LD64), rhs4);
          v2u w; w.x = cvtpk(rhs4[0], rhs4[1]); w.y = cvtpk(rhs4[2], rhs4[3]); *(LAS v2u*)(RHS + (i0 + fr) * LD32 + t0m + fq * 4) = w;
          yacc = MFMA16(FRAGT(VS, i0, LD64), FRAG(ARK, t0m, LD32, 0), yacc); }
        __syncthreads();
#undef RWKV_FIRST
#undef PK8
        { f32x4 a4 = (f32x4){0.f, 0.f, 0.f, 0.f}; a4 = MFMA16(FRAG(MINV, t0m, LD32, 0), FRAG(RHS, i0, LD32, 0), a4);
          v2u w; w.x = cvtpk(a4[0], a4[1]); w.y = cvtpk(a4[2], a4[3]); *(LAS v2u*)(SAB + (i0 + fr) * LD32 + t0m + fq * 4) = w; }
        __syncthreads();
        { yacc = MFMA16(FRAG(SAB, i0, LD32, 0), FRAG(ARB, t0m, LD32, 0), yacc);
          *(LAS f32x4*)(YB + (t0m + fr) * 68 + i0 + fq * 4) = yacc;
#pragma unroll
          for (int u = 0; u < 2; ++u) { const int tile = wave * 2 + u, si0 = (tile >> 2) * 16, sj0 = (tile & 3) * 16;
              sacc[u] = MFMA16(FRAGT(BT_, sj0, LD64), FRAG(SAB, si0, LD32, 0), sacc[u]);
              const f32x4 pc = *(const LAS f32x4*)(PC + sj0 + fq * 4); sacc[u] = sacc[u] * pc;
              v2u w; w.x = cvtpk(sacc[u][0], sacc[u][1]); w.y = cvtpk(sacc[u][2], sacc[u][3]); *(LAS v2u*)(S0n + (si0 + fr) * LD64 + sj0 + fq * 4) = w; } }
        __syncthreads();
    }
    __syncthreads();
#undef FRAG
#undef FRAGT
#undef RWKV_PREFETCH
}
__device__ __forceinline__ void lora_prepass(const Frame& F) {
    const bf16* PROJ = WSP(bf16, WS_PROJ); bf16* LA = WSP(bf16, WS_LA); const float* mu = F.in[I_MU] + (PC_WD - RWKV_C0);
    const int gt = (F.bid * NWAVES + F.wave) * 64 + F.lane, NGT = F.G * NTHR;
    for (int i = gt; i < T * 36; i += NGT) { const int tok = i / 36, cc = i - tok * 36, m = cc * 8;
        const bf16* pr = PROJ + (size_t)tok * NINP + PC_WD + m;
        const v4u curv = *(const v4u*)pr; v4u prv = (v4u){0u, 0u, 0u, 0u}; if ((tok & (SEQ - 1)) != 0) prv = *(const v4u*)(pr - NINP);
        const f32x4 m0 = *(const f32x4*)(mu + m), m1 = *(const f32x4*)(mu + m + 4);
        float c[8], p[8], o[8]; unpack8(curv, c); unpack8(prv, p);
#pragma unroll
        for (int e = 0; e < 8; ++e) { const float ps = c[e] + (p[e] - c[e]) * (e < 4 ? m0[e] : m1[e - 4]); o[e] = (m < 64) ? tanh_fast(ps) : ((m < 128) ? ps : sigmoid_fast(ps)); }
        v4u w; w.x = cvtpk(o[0], o[1]); w.y = cvtpk(o[2], o[3]); w.z = cvtpk(o[4], o[5]); w.w = cvtpk(o[6], o[7]);
        *(v4u*)(LA + (size_t)tok * 288 + m) = w; }
}
__device__ __forceinline__ void lru_seq(const Frame& F, int item) {
    const int bh = item >> 1, hf = item & 1, b = bh >> 3, h = bh & 7, wave = F.wave; int tid = F.tid; asm volatile("" : "+v"(tid)); const int lane = tid & 63;
    constexpr int TT = 128, NTK = SEQ / TT;
    LAS unsigned char* L = F.lds;
    LAS bf16* XA = (LAS bf16*)(L + 0);
    LAS float* XC = (LAS float*)(L + 34816);
    LAS float* RI = (LAS float*)(L + 67584);
    LAS float* SEG = (LAS float*)(L + 133120);
    LAS float* CARRY = (LAS float*)(L + 137216);
    LAS float* CW = (LAS float*)(L + 137728);
    static_assert(137728 + 2560 <= LDSCTL_OFF, "lru LDS map");
    const bf16* PROJ = WSP(bf16, WS_PROJ); bf16* Y = WSP(bf16, WS_Y);
    const int fr0 = lane & 15, fq0 = lane >> 4;
    for (int i = tid; i < 640; i += NTHR) { const int w = i >> 7, cch = i & 127; CW[i] = (w < 4) ? F.in[I_CONVW][w * 1024 + h * 128 + cch] : F.in[I_CONVB][h * 128 + cch]; }
    if (tid < 128) CARRY[tid] = 0.f;
    const int gsel = wave & 1, ntl = wave >> 1, ntg = hf * 4 + ntl;
    bf16x8 wf[4];
    { const bf16* WTp = (gsel ? WSP(bf16, WS_WIT) : WSP(bf16, WS_WAT)) + (size_t)h * 128 * 128;
#pragma unroll
      for (int ks = 0; ks < 4; ++ks) wf[ks] = *(const bf16x8*)(WTp + (ntg * 16 + fr0) * 128 + ks * 32 + 8 * fq0); }
    const int c = tid & 63, sg = tid >> 6, chl = hf * 64 + c, chg = h * 128 + chl;
    const float ba_c = F.in[I_BA][chg], bi_c = F.in[I_BI][chg], sp8 = 8.0f * softplus_fast(-F.in[I_LAM][chg]);
    const int tq = tid >> 4, c8 = (tid & 15) * 8; const bool myhalf = ((tid & 15) >> 3) == hf;
    v4u pf[7];
#define LRU_PREFETCH(k_) do { _Pragma("unroll") for (int j_ = 0; j_ < 7; ++j_) { const int ts_ = (k_) * TT + 4 * tq - 3 + j_; const int tc_ = ts_ >= 0 ? ts_ : 0;   \
            const v4u x_ = *(const v4u*)(PROJ + ((size_t)b * SEQ + tc_) * NINP + h * 128 + c8); const unsigned m_ = ts_ >= 0 ? 0xffffffffu : 0u; \
            pf[j_] = (v4u){x_.x & m_, x_.y & m_, x_.z & m_, x_.w & m_}; } } while (0)
    unsigned short gtn[16];
#define LRU_GATES(k_) do { _Pragma("unroll") for (int e_ = 0; e_ < 16; ++e_) gtn[e_] = PROJ[((size_t)b * SEQ + (k_) * TT + sg * 16 + e_) * NINP + PC_GATE + chg]; } while (0)
    const int ttab = item >> 6, trow0 = ((item & 63) * 8 + wave) * 32;
    const float* tsrc = ttab ? F.in[I_V] : F.in[I_U]; unsigned char* tdst = ttab ? WSP(unsigned char, WS_VT) : WSP(unsigned char, WS_UT); float* tsc = ttab ? WSP(float, WS_VSC) : WSP(float, WS_USC);
    f32x4 th[4], tk[4]; float tkm = 0.f;
#pragma unroll
    for (int q = 0; q < 4; ++q) tk[q] = (f32x4){0.f, 0.f, 0.f, 0.f};
    LRU_PREFETCH(0); LRU_GATES(0);
    RD_LOAD(tsrc, true, trow0, 0);
    __syncthreads();
    for (int k = 0; k < NTK; ++k) {
        const size_t tokbase = (size_t)b * SEQ + k * TT;
        int lane_c = lane; asm volatile("" : "+v"(lane_c)); const int fr = lane_c & 15, fq = lane_c >> 4;
        { float xr[7][8];
#pragma unroll
          for (int j = 0; j < 7; ++j) unpack8(pf[j], xr[j]);
          const f32x4 b0 = *(const LAS f32x4*)(CW + 512 + c8), b1 = *(const LAS f32x4*)(CW + 512 + c8 + 4);
          f32x4 w0[4], w1[4];
#pragma unroll
          for (int w = 0; w < 4; ++w) { w0[w] = *(const LAS f32x4*)(CW + w * 128 + c8); w1[w] = *(const LAS f32x4*)(CW + w * 128 + c8 + 4); }
#pragma unroll
          for (int u = 0; u < 4; ++u) { const int t = 4 * tq + u; float acc[8];
#pragma unroll
              for (int e = 0; e < 4; ++e) { acc[e] = b0[e]; acc[e + 4] = b1[e]; }
#pragma unroll
              for (int w = 0; w < 4; ++w)
#pragma unroll
                  for (int e = 0; e < 4; ++e) { acc[e] += w0[w][e] * xr[u + w][e]; acc[e + 4] += w1[w][e] * xr[u + w][e + 4]; }
              v4u pk; pk.x = cvtpk(acc[0], acc[1]); pk.y = cvtpk(acc[2], acc[3]); pk.z = cvtpk(acc[4], acc[5]); pk.w = cvtpk(acc[6], acc[7]);
              *(LAS v4u*)(XA + t * 136 + c8) = pk;
              if (myhalf) { LAS float* d = XC + t * 64 + (c8 & 63); *(LAS f32x4*)d = (f32x4){acc[0], acc[1], acc[2], acc[3]}; *(LAS f32x4*)(d + 4) = (f32x4){acc[4], acc[5], acc[6], acc[7]}; } } }
        float gl[16];
#pragma unroll
        for (int e = 0; e < 16; ++e) gl[e] = gelu_fast(__uint_as_float((unsigned)gtn[e] << 16));
        { const int kn_ = k + 1 < NTK ? k + 1 : NTK - 1; LRU_PREFETCH(kn_); LRU_GATES(kn_); }
        RD_CONSUME(tdst, tsc, trow0, 4 * k);
        RD_LOAD(tsrc, true, trow0, 4 * k + 1);
        __syncthreads();
#pragma unroll
        for (int mt = 0; mt < TT / 16; ++mt) {
            bf16x8 af[4];
#pragma unroll
            for (int ks = 0; ks < 4; ++ks) af[ks] = *(const LAS bf16x8*)(XA + (mt * 16 + fr) * 136 + ks * 32 + 8 * fq);
            { f32x4 a4 = (f32x4){0.f, 0.f, 0.f, 0.f};
#pragma unroll
                for (int ks = 0; ks < 4; ++ks) a4 = MFMA16(wf[ks], af[ks], a4);
                *(LAS f32x4*)(RI + gsel * (TT * 64) + (mt * 16 + fr) * 64 + ntl * 16 + fq * 4) = a4; } }
        __syncthreads();
        RD_CONSUME(tdst, tsc, trow0, 4 * k + 1);
        RD_LOAD(tsrc, true, trow0, 4 * k + 2);
        float av[16], bx[16]; float A = 1.f, B = 0.f;
#pragma unroll
        for (int e = 0; e < 16; ++e) { const int t = sg * 16 + e; const float r = sigmoid_fast(RI[t * 64 + c] + ba_c), ig = sigmoid_fast(RI[TT * 64 + t * 64 + c] + bi_c), xc = XC[t * 64 + c];
            const float la = -sp8 * r; av[e] = __expf(la); bx[e] = sqrtf(fmaxf(1.0f - av[e] * av[e], 0.f)) * (ig * xc); A *= av[e]; B = av[e] * B + bx[e]; }
        SEG[(sg * 64 + c) * 2] = A; SEG[(sg * 64 + c) * 2 + 1] = B;
        RD_CONSUME(tdst, tsc, trow0, 4 * k + 2);
        RD_LOAD(tsrc, true, trow0, 4 * k + 3);
        __syncthreads();
        float hst = CARRY[(k & 1) * 64 + c];
        for (int s2 = 0; s2 < sg; ++s2) hst = SEG[(s2 * 64 + c) * 2] * hst + SEG[(s2 * 64 + c) * 2 + 1];
#pragma unroll
        for (int e = 0; e < 16; ++e) { hst = av[e] * hst + bx[e];
            Y[(tokbase + sg * 16 + e) * D + chg] = (bf16)(cvtpk(hst * gl[e], 0.f) & 0xffffu); }
        if (sg == 7) CARRY[((k + 1) & 1) * 64 + c] = hst;
        RD_CONSUME(tdst, tsc, trow0, 4 * k + 3);
        { const int kn_ = k + 1 < NTK ? k + 1 : NTK - 1; RD_LOAD(tsrc, true, trow0, 4 * kn_); }
    }
    __syncthreads();
#undef LRU_PREFETCH
#undef LRU_GATES
}
__device__ __forceinline__ void group_barrier(unsigned* cnt, unsigned n) {
    asm volatile("s_waitcnt vmcnt(0)" ::: "memory");
    __syncthreads();
    if (threadIdx.x == 0) {
        __builtin_amdgcn_fence(__ATOMIC_RELEASE, "agent");
        asm volatile("s_waitcnt vmcnt(0)" ::: "memory");
        xb_add(cnt, 1u);
        unsigned sp = 0; while (xb_ld(cnt) < n) { __builtin_amdgcn_s_sleep(2); if (++sp > (1u << 24)) break; }
        __builtin_amdgcn_fence(__ATOMIC_ACQUIRE, "agent");
        asm volatile("s_waitcnt vmcnt(0)" ::: "memory");
    }
    __syncthreads();
}

__device__ __forceinline__ unsigned f2ord(float f) { const unsigned u = __builtin_bit_cast(unsigned, f); return (u & 0x80000000u) ? ~u : (u | 0x80000000u); }
__device__ __forceinline__ float ord2f(unsigned o) { const unsigned u = (o & 0x80000000u) ? (o & 0x7fffffffu) : ~o; return __builtin_bit_cast(float, u); }
#define CMPX(hi_, lo_) do { const unsigned _a = (hi_), _b = (lo_); (hi_) = _a > _b ? _a : _b; (lo_) = _a > _b ? _b : _a; } while (0)
template <int N> __device__ __forceinline__ void sort_desc(unsigned (&a)[N]) {
#pragma unroll
    for (int k = 2; k <= N; k <<= 1)
#pragma unroll
        for (int j = k >> 1; j > 0; j >>= 1)
#pragma unroll
            for (int i = 0; i < N; ++i) { const int l = i ^ j; if (l > i) { if ((i & k) == 0) CMPX(a[i], a[l]); else CMPX(a[l], a[i]); } }
}
__device__ __forceinline__ void merge16(unsigned (&A)[16], const unsigned (&B)[16]) {
#pragma unroll
    for (int i = 0; i < 16; ++i) { const unsigned q = B[15 - i]; A[i] = A[i] > q ? A[i] : q; }
#pragma unroll
    for (int d = 8; d >= 1; d >>= 1)
#pragma unroll
        for (int i = 0; i < 16; ++i) if ((i & d) == 0) CMPX(A[i], A[i + d]);
}
__device__ __forceinline__ void merge_partner(unsigned (&Lk)[16]) {
    unsigned P[16];
#pragma unroll
    for (int i = 0; i < 16; ++i) P[i] = (unsigned)__shfl_xor((int)Lk[i], 32);
#pragma unroll
    for (int i = 0; i < 16; ++i) { const unsigned q = P[15 - i]; Lk[i] = Lk[i] > q ? Lk[i] : q; }
#pragma unroll
    for (int d = 8; d >= 1; d >>= 1)
#pragma unroll
        for (int i = 0; i < 16; ++i) if ((i & d) == 0) CMPX(Lk[i], Lk[i + d]);
}
__device__ __forceinline__ void route_item(const Frame& F, int item, int lane) {
    const int tok0 = (item >> 3) * 32, h = item & 7, c = lane & 31, hi = lane >> 5;
    const bf16* Q = WSP(bf16, WS_Q); const bf16* KB = WSP(bf16, WS_KEYS);
    LAS unsigned* WL = (LAS unsigned*)(F.lds + F.wave * 8192);
    unsigned LST[2][16];
    bf16x8 qf[8], qn[8], kf[8], kn[8];
#pragma unroll
    for (int ks = 0; ks < 8; ++ks) { qf[ks] = *(const bf16x8*)(Q + (size_t)(tok0 + c) * D + h * 256 + ks * 16 + 8 * hi); qn[ks] = *(const bf16x8*)(Q + (size_t)(tok0 + c) * D + h * 256 + 128 + ks * 16 + 8 * hi);
        kf[ks] = *(const bf16x8*)(KB + (size_t)((h * 2) * 128 + c) * 128 + 8 * hi + ks * 16); }
    unsigned Lk[16];
#pragma unroll
    for (int st = 0; st < 8; ++st) { const int p = st >> 2, m = st & 3;
        if (st < 7) { const int p2 = (st + 1) >> 2, m2 = (st + 1) & 3; const bf16* kp = KB + (size_t)((h * 2 + p2) * 128 + m2 * 32 + c) * 128 + 8 * hi;
#pragma unroll
            for (int ks = 0; ks < 8; ++ks) kn[ks] = *(const bf16x8*)(kp + ks * 16); }
        f32x16 acc;
#pragma unroll
        for (int r = 0; r < 16; ++r) acc[r] = 0.f;
#pragma unroll
        for (int ks = 0; ks < 8; ++ks) acc = MFMA32(kf[ks], p ? qn[ks] : qf[ks], acc);
        unsigned G16[16];
#pragma unroll
        for (int r = 0; r < 16; ++r) { const unsigned idx = (unsigned)(m * 32 + (r & 3) + 8 * (r >> 2)) | ((unsigned)hi << 2); G16[r] = (f2ord(acc[r]) & ~0x7Fu) | idx; }
        sort_desc<16>(G16);
        if (m == 0) {
#pragma unroll
            for (int i = 0; i < 16; ++i) Lk[i] = G16[i]; }
        else merge16(Lk, G16);
        if (m == 3) { merge_partner(Lk);
#pragma unroll
            for (int i = 0; i < 16; ++i) { LST[p][i] = Lk[i]; WL[(p * 16 + i) * 64 + lane] = Lk[i] & 0x7Fu; } }
#pragma unroll
        for (int ks = 0; ks < 8; ++ks) kf[ks] = kn[ks];
    }
    float va[4], vb[16];
#pragma unroll
    for (int i = 0; i < 4; ++i) va[i] = ord2f((hi ? LST[1][i] : LST[0][i]) & ~0x7Fu);
#pragma unroll
    for (int j = 0; j < 16; ++j) vb[j] = ord2f((hi ? LST[0][j] : LST[1][j]) & ~0x7Fu);
    unsigned C32[32];
#pragma unroll
    for (int i = 0; i < 32; ++i) C32[i] = 0u;
#pragma unroll
    for (int i = 0; i < 4; ++i) { const unsigned key = (f2ord(va[i] + vb[i]) & ~0xFFu) | (unsigned)(i * 17); C32[i] = hi ? 0u : key; }
    { int cn = 4;
#pragma unroll
      for (int i = 0; i < 3; ++i)
#pragma unroll
          for (int j = i + 1; j < 16; ++j) if ((i + 1) * (j + 1) <= 16) { const unsigned code = hi ? (unsigned)(j * 16 + i) : (unsigned)(i * 16 + j); C32[cn] = (f2ord(va[i] + vb[j]) & ~0xFFu) | code; ++cn; } }
    sort_desc<32>(C32);
    unsigned Ck[16];
#pragma unroll
    for (int i = 0; i < 16; ++i) Ck[i] = C32[i];
    merge_partner(Ck);
    const float mx = ord2f(Ck[0] & ~0xFFu); float den = 0.f;
#pragma unroll
    for (int k = 0; k < 16; ++k) den += __expf(ord2f(Ck[k] & ~0xFFu) - mx);
    const float rden = 1.0f / den;
    int eo[8]; float go[8];
#pragma unroll
    for (int k = 0; k < 8; ++k) { const unsigned fm = hi ? Ck[k + 8] : Ck[k]; const unsigned code = fm & 0xFFu;
        const unsigned k0 = WL[(code >> 4) * 64 + lane], k1 = WL[(16 + (code & 15u)) * 64 + lane];
        eo[k] = (int)(k0 * 128u + k1); go[k] = __expf(ord2f(fm & ~0xFFu) - mx) * rden; }
    unsigned short* ep = WSP(unsigned short, WS_EXP) + (size_t)(tok0 + c) * NSEL + h * 16 + hi * 8; float* gp = WSP(float, WS_GATE) + (size_t)(tok0 + c) * NSEL + h * 16 + hi * 8;
    *(v4u*)ep = (v4u){(unsigned)eo[0] | ((unsigned)eo[1] << 16), (unsigned)eo[2] | ((unsigned)eo[3] << 16), (unsigned)eo[4] | ((unsigned)eo[5] << 16), (unsigned)eo[6] | ((unsigned)eo[7] << 16)};
    *(f32x4*)gp = (f32x4){go[0], go[1], go[2], go[3]}; *(f32x4*)(gp + 4) = (f32x4){go[4], go[5], go[6], go[7]};
}

typedef float f32x2 __attribute__((ext_vector_type(2)));
__device__ __forceinline__ int dot4i(unsigned a, unsigned b, int c) { return __builtin_amdgcn_sdot4((int)a, (int)b, c, false); }
template <int CTRL> __device__ __forceinline__ int dppi(int x) { return __builtin_amdgcn_mov_dpp(x, CTRL, 0xf, 0xf, true); }
struct PeerGeom { int ngrp, g, rank, nrank; };
__device__ __forceinline__ PeerGeom peer_geom(const Frame& F) { PeerGeom p; p.ngrp = (F.G % 8 == 0) ? 8 : 1; p.g = F.bid % p.ngrp; p.rank = F.bid / p.ngrp; p.nrank = F.G / p.ngrp; return p; }
__device__ __forceinline__ void xquant_token(const Frame& F, int tok, int lane) {
    const bf16* xr = WSP(bf16, WS_XB) + (size_t)tok * D + lane * 16; float xf[32]; float am = 0.f, sq = 0.f;
#pragma unroll
    for (int hh = 0; hh < 2; ++hh)
#pragma unroll
        for (int q = 0; q < 2; ++q) { const v4u w = *(const v4u*)(xr + hh * 1024 + q * 8); float t8[8]; unpack8(w, t8);
            const f32x4 g0 = *(const f32x4*)(F.in[I_G2N] + hh * 1024 + lane * 16 + q * 8), g1 = *(const f32x4*)(F.in[I_G2N] + hh * 1024 + lane * 16 + q * 8 + 4);
#pragma unroll
            for (int e = 0; e < 8; ++e) { const float xg = t8[e] * (e < 4 ? g0[e & 3] : g1[e & 3]); xf[hh * 16 + q * 8 + e] = xg; am = fmaxf(am, fabsf(xg)); sq += t8[e] * t8[e]; } }
#pragma unroll
    for (int o = 1; o < 64; o <<= 1) am = fmaxf(am, __shfl_xor(am, o));
    sq = wave_sum(sq);
    const float qs = am > 0.f ? 127.0f / am : 0.f;
    if (lane == 0) { WSP(float, WS_SX)[tok] = am * (1.0f / 127.0f); WSP(float, WS_SSQ2)[tok] = sq; }
#pragma unroll
    for (int hh = 0; hh < 2; ++hh) { v4u o;
#pragma unroll
        for (int d = 0; d < 4; ++d) { unsigned w = 0u;
#pragma unroll
            for (int e = 0; e < 4; ++e) { const int qi = (int)rintf(xf[hh * 16 + d * 4 + e] * qs); w |= ((unsigned)qi & 0xFFu) << (8 * e); }
            o[d] = w; }
        *(v4u*)(WSP(unsigned char, WS_XQ) + (size_t)tok * D + hh * 1024 + lane * 16) = o; }
}
__device__ __forceinline__ void yquant_tokens(const Frame& F, int tokA, int tokB, int lane) {
    v4u ra[2][2], rb[2][2];
#pragma unroll
    for (int hh = 0; hh < 2; ++hh)
#pragma unroll
        for (int q = 0; q < 2; ++q) { ra[hh][q] = *(const v4u*)(WSP(bf16, WS_Y) + (size_t)tokA * D + hh * 1024 + lane * 16 + q * 8); rb[hh][q] = *(const v4u*)(WSP(bf16, WS_Y) + (size_t)tokB * D + hh * 1024 + lane * 16 + q * 8); }
#define YQ_ONE(R_, tok_) do { float xf_[32]; float am_ = 0.f; \
        _Pragma("unroll") for (int hh_ = 0; hh_ < 2; ++hh_) _Pragma("unroll") for (int q_ = 0; q_ < 2; ++q_) { float t8_[8]; unpack8(R_[hh_][q_], t8_); \
            _Pragma("unroll") for (int e_ = 0; e_ < 8; ++e_) { xf_[hh_ * 16 + q_ * 8 + e_] = t8_[e_]; am_ = fmaxf(am_, fabsf(t8_[e_])); } } \
        am_ = fmaxf(am_, dppf<0xB1>(am_)); am_ = fmaxf(am_, dppf<0x4E>(am_)); am_ = fmaxf(am_, dppf<0x141>(am_)); am_ = fmaxf(am_, dppf<0x140>(am_)); \
        { auto s_ = __builtin_amdgcn_permlane16_swap(__float_as_uint(am_), __float_as_uint(am_), false, false); am_ = fmaxf(__uint_as_float(s_[0]), __uint_as_float(s_[1])); } \
        { auto s_ = __builtin_amdgcn_permlane32_swap(__float_as_uint(am_), __float_as_uint(am_), false, false); am_ = fmaxf(__uint_as_float(s_[0]), __uint_as_float(s_[1])); } \
        const float qs_ = am_ > 0.f ? 127.0f / am_ : 0.f; \
        if (lane == 0) WSP(float, WS_SY)[tok_] = am_ * (1.0f / 127.0f); \
        _Pragma("unroll") for (int hh_ = 0; hh_ < 2; ++hh_) { v4u o_; \
            _Pragma("unroll") for (int d_ = 0; d_ < 4; ++d_) { \
                const unsigned b0_ = __float_as_uint(__builtin_fmaf(xf_[hh_ * 16 + d_ * 4 + 0], qs_, 12582912.0f)), b1_ = __float_as_uint(__builtin_fmaf(xf_[hh_ * 16 + d_ * 4 + 1], qs_, 12582912.0f)); \
                const unsigned b2_ = __float_as_uint(__builtin_fmaf(xf_[hh_ * 16 + d_ * 4 + 2], qs_, 12582912.0f)), b3_ = __float_as_uint(__builtin_fmaf(xf_[hh_ * 16 + d_ * 4 + 3], qs_, 12582912.0f)); \
                o_[d_] = __builtin_amdgcn_perm(b1_, b0_, 0x0c0c0400u) | __builtin_amdgcn_perm(b3_, b2_, 0x04000c0cu); } \
            *(v4u*)(WSP(unsigned char, WS_YQ) + (size_t)(tok_) * D + hh_ * 1024 + lane * 16) = o_; } } while (0)
    YQ_ONE(ra, tokA);
    if (tokB != tokA) YQ_ONE(rb, tokB);
#undef YQ_ONE
}
struct PeerIds { unsigned w; };
__device__ __forceinline__ PeerIds peer_ids_load(const Frame& F, int tok, int lane) { PeerIds r; r.w = WSP(unsigned, WS_EXP)[(size_t)tok * (NSEL / 2) + lane]; return r; }
struct PeerScoreBuf { v4u w[16]; v4u xs; };
__device__ __forceinline__ void peer_score_issue(const Frame& F, int tok, int slice, int lane, LAS int* wl, const PeerIds& id, PeerScoreBuf& B) {
    const int e8 = lane >> 3, c16 = lane & 7;
    *(LAS v2u*)(wl + 2 * lane) = (v2u){id.w & 0xffffu, id.w >> 16};
    B.xs = *(const v4u*)(WSP(unsigned char, WS_XQ) + (size_t)tok * D + slice * 128 + c16 * 16);
    const unsigned char* ub = WSP(unsigned char, WS_UT); const unsigned lo = (unsigned)(slice * 128 + c16 * 16);
#pragma unroll
    for (int ld = 0; ld < 16; ++ld) { const unsigned eid = (unsigned)wl[e8 * 16 + ld]; B.w[ld] = *(const v4u*)(ub + (eid * 2048u + lo)); }
}
__device__ __forceinline__ void peer_score_consume(const Frame& F, int tok, int slice, int lane, const PeerScoreBuf& B, bool valid) {
    int p[16];
#pragma unroll
    for (int ld = 0; ld < 16; ++ld) { const v4u w = B.w[ld]; int a = dot4i(w.x, B.xs.x, 0); a = dot4i(w.y, B.xs.y, a); a = dot4i(w.z, B.xs.z, a); p[ld] = dot4i(w.w, B.xs.w, a); }
    { const bool up = (lane & 4) != 0;
#pragma unroll
      for (int k = 0; k < 8; ++k) { const int keep = up ? p[k + 8] : p[k], send = up ? p[k] : p[k + 8]; p[k] = keep + dppi<0x141>(send); } }
    { const bool up = (lane & 2) != 0;
#pragma unroll
      for (int k = 0; k < 4; ++k) { const int keep = up ? p[k + 4] : p[k], send = up ? p[k] : p[k + 4]; p[k] = keep + dppi<0x4E>(send); } }
    { const bool up = (lane & 1) != 0;
#pragma unroll
      for (int k = 0; k < 2; ++k) { const int keep = up ? p[k + 2] : p[k], send = up ? p[k] : p[k + 2]; p[k] = keep + dppi<0xB1>(send); } }
    if (valid) { unsigned* dst = WSP(unsigned, WS_PART) + ((size_t)slice * T + tok) * (NSEL / 2) + lane;
        __builtin_nontemporal_store(((unsigned)((p[0] + 32) >> 6) & 0xffffu) | ((unsigned)((p[1] + 32) >> 6) << 16), dst); }
}
__device__ __forceinline__ void peer_score_phase(const Frame& F, const PeerGeom& pg, LAS int* wl2) {
    const int lane = F.lane, first = pg.rank * NWAVES + F.wave, step = pg.nrank * NWAVES, n = first < T ? (T - first + step - 1) / step : 0;
    LAS int* wlA = wl2; LAS int* wlB = wl2 + 256;
#define PEER_TOKC(k_) ((first + (k_) * step) < T ? (first + (k_) * step) : T - 1)
    for (int r = 0; r < 16 / pg.ngrp; ++r) { const int slice = r * pg.ngrp + pg.g;
        PeerScoreBuf A, B; PeerIds id = peer_ids_load(F, PEER_TOKC(0), lane);
        { const PeerIds cur = id; id = peer_ids_load(F, PEER_TOKC(1), lane); asm volatile("" ::: "memory"); peer_score_issue(F, PEER_TOKC(0), slice, lane, wlA, cur, A); }
        for (int i = 0; i < n; i += 2) {
            { const PeerIds cur = id; id = peer_ids_load(F, PEER_TOKC(i + 2), lane); asm volatile("" ::: "memory"); peer_score_issue(F, PEER_TOKC(i + 1), slice, lane, wlB, cur, B); }
            peer_score_consume(F, first + i * step, slice, lane, A, true);
            { const PeerIds cur = id; id = peer_ids_load(F, PEER_TOKC(i + 3), lane); asm volatile("" ::: "memory"); peer_score_issue(F, PEER_TOKC(i + 2), slice, lane, wlA, cur, A); }
            peer_score_consume(F, first + (i + 1) * step, slice, lane, B, i + 1 < n);
        }
    }
}
template <int NT> __device__ __forceinline__ void peer_coef_tokens(const Frame& F, const int (&tok)[NT], const bool (&valid)[NT], int lane) {
    unsigned pv[NT][16], exw[NT]; f32x2 ga[NT]; float sx[NT], sq[NT];
#pragma unroll
    for (int i = 0; i < NT; ++i) {
#pragma unroll
        for (int s = 0; s < 16; ++s) pv[i][s] = WSP(unsigned, WS_PART)[((size_t)s * T + tok[i]) * (NSEL / 2) + lane];
        exw[i] = WSP(unsigned, WS_EXP)[(size_t)tok[i] * (NSEL / 2) + lane]; ga[i] = *(const f32x2*)(WSP(float, WS_GATE) + (size_t)tok[i] * NSEL + lane * 2);
        sx[i] = WSP(float, WS_SX)[tok[i]]; sq[i] = WSP(float, WS_SSQ2)[tok[i]]; }
    float us0[NT], us1[NT], vs0[NT], vs1[NT];
#pragma unroll
    for (int i = 0; i < NT; ++i) { const unsigned e0 = exw[i] & 0xffffu, e1 = exw[i] >> 16;
        us0[i] = WSP(float, WS_USC)[e0]; us1[i] = WSP(float, WS_USC)[e1]; vs0[i] = WSP(float, WS_VSC)[e0]; vs1[i] = WSP(float, WS_VSC)[e1]; }
#pragma unroll
    for (int i = 0; i < NT; ++i) { int s0 = 0, s1 = 0;
#pragma unroll
        for (int s = 0; s < 16; ++s) { s0 += (int)(pv[i][s] << 16) >> 16; s1 += (int)pv[i][s] >> 16; }
        s0 <<= 6; s1 <<= 6;
        const float rs = sx[i] * (1.0f / sqrtf(sq[i] * (1.0f / D) + NORM_EPS));
        const float sc0 = (float)s0 * us0[i] * rs, sc1 = (float)s1 * us1[i] * rs;
        f32x2 c; c.x = ga[i].x * gelu_fast(sc0) * vs0[i]; c.y = ga[i].y * gelu_fast(sc1) * vs1[i];
        float cm = fmaxf(fabsf(c.x), fabsf(c.y));
        cm = fmaxf(cm, dppf<0xB1>(cm)); cm = fmaxf(cm, dppf<0x4E>(cm)); cm = fmaxf(cm, dppf<0x141>(cm)); cm = fmaxf(cm, dppf<0x140>(cm));
        { auto t = __builtin_amdgcn_permlane16_swap(__float_as_uint(cm), __float_as_uint(cm), false, false); cm = fmaxf(__uint_as_float(t[0]), __uint_as_float(t[1])); }
        { auto t = __builtin_amdgcn_permlane32_swap(__float_as_uint(cm), __float_as_uint(cm), false, false); cm = fmaxf(__uint_as_float(t[0]), __uint_as_float(t[1])); }
        const float qs = cm > 0.f ? 127.0f / cm : 0.f;
        const int q0 = (int)rintf(c.x * qs), q1 = (int)rintf(c.y * qs);
        if (valid[i]) { ((unsigned short*)(F.ws + WS_COEF))[(size_t)tok[i] * 64 + lane] = (unsigned short)(((unsigned)q0 & 0xFFu) | (((unsigned)q1 & 0xFFu) << 8));
            if (lane == 0) WSP(float, WS_CSC)[tok[i]] = cm * (1.0f / 127.0f); } }
}
struct PeerOutBuf { v4u w[16]; v4u cq; unsigned x; float cs; };
__device__ __forceinline__ void peer_out_issue(const Frame& F, int tok, int slice, int lane, LAS int* wl, const PeerIds& id, PeerOutBuf& B) {
    const int e8 = lane >> 3, c16 = lane & 7;
    *(LAS v2u*)(wl + 2 * lane) = (v2u){id.w & 0xffffu, id.w >> 16};
    B.cq = *(const v4u*)(F.ws + WS_COEF + (size_t)tok * 128 + e8 * 16);
    B.cs = WSP(float, WS_CSC)[tok];
    const unsigned char* vb = WSP(unsigned char, WS_VT); const unsigned lofs = (unsigned)(slice * 128 + c16 * 16);
#pragma unroll
    for (int ld = 0; ld < 16; ++ld) { const unsigned eid = (unsigned)wl[e8 * 16 + ld]; B.w[ld] = *(const v4u*)(vb + (eid * 2048u + lofs)); }
    B.x = *(const unsigned*)(WSP(bf16, WS_XB) + (size_t)tok * D + slice * 128 + c16 * 16 + e8 * 2);
}
__device__ __forceinline__ void peer_out_consume(const Frame& F, int tok, int slice, int lane, const PeerOutBuf& B, bool valid) {
    const int e8 = lane >> 3, c16 = lane & 7;
    int o[16];
#pragma unroll
    for (int i = 0; i < 16; ++i) o[i] = 0;
#pragma unroll
    for (int g = 0; g < 4; ++g) { const unsigned cq = B.cq[g];
#pragma unroll
        for (int d = 0; d < 4; ++d) { const unsigned w0 = B.w[4 * g][d], w1 = B.w[4 * g + 1][d], w2 = B.w[4 * g + 2][d], w3 = B.w[4 * g + 3][d];
            const unsigned lo01 = __builtin_amdgcn_perm(w1, w0, 0x05010400u), hi01 = __builtin_amdgcn_perm(w1, w0, 0x07030602u);
            const unsigned lo23 = __builtin_amdgcn_perm(w3, w2, 0x05010400u), hi23 = __builtin_amdgcn_perm(w3, w2, 0x07030602u);
            const unsigned t0 = __builtin_amdgcn_perm(lo23, lo01, 0x05040100u), t1 = __builtin_amdgcn_perm(lo23, lo01, 0x07060302u);
            const unsigned t2 = __builtin_amdgcn_perm(hi23, hi01, 0x05040100u), t3 = __builtin_amdgcn_perm(hi23, hi01, 0x07060302u);
            o[d * 4 + 0] = dot4i(t0, cq, o[d * 4 + 0]); o[d * 4 + 1] = dot4i(t1, cq, o[d * 4 + 1]); o[d * 4 + 2] = dot4i(t2, cq, o[d * 4 + 2]); o[d * 4 + 3] = dot4i(t3, cq, o[d * 4 + 3]); } }
#pragma unroll
    for (int k = 0; k < 8; ++k) { auto s = __builtin_amdgcn_permlane32_swap((unsigned)o[k], (unsigned)o[k + 8], false, false); o[k] = (int)(s[0] + s[1]); }
#pragma unroll
    for (int k = 0; k < 4; ++k) { auto s = __builtin_amdgcn_permlane16_swap((unsigned)o[k], (unsigned)o[k + 4], false, false); o[k] = (int)(s[0] + s[1]); }
    { const bool up = (lane & 8) != 0;
#pragma unroll
      for (int k = 0; k < 2; ++k) { const int keep = up ? o[k + 2] : o[k], send = up ? o[k] : o[k + 2]; o[k] = keep + dppi<0x128>(send); } }
    const float x0 = bf_lo(B.x) + (float)o[0] * B.cs, x1 = bf_hi(B.x) + (float)o[1] * B.cs;
    if (valid) *(unsigned*)(WSP(bf16, WS_XB) + (size_t)tok * D + slice * 128 + c16 * 16 + e8 * 2) = cvtpk(x0, x1);
}
__device__ __forceinline__ void peer_out_phase(const Frame& F, const PeerGeom& pg, LAS int* wl2) {
    const int lane = F.lane, first = pg.rank * NWAVES + F.wave, step = pg.nrank * NWAVES, n = first < T ? (T - first + step - 1) / step : 0;
    LAS int* wlA = wl2; LAS int* wlB = wl2 + 256;
    for (int r = 0; r < 16 / pg.ngrp; ++r) { const int slice = r * pg.ngrp + pg.g;
        PeerOutBuf A, B; PeerIds id = peer_ids_load(F, PEER_TOKC(0), lane);
        { const PeerIds cur = id; id = peer_ids_load(F, PEER_TOKC(1), lane); asm volatile("" ::: "memory"); peer_out_issue(F, PEER_TOKC(0), slice, lane, wlA, cur, A); }
        for (int i = 0; i < n; i += 2) {
            { const PeerIds cur = id; id = peer_ids_load(F, PEER_TOKC(i + 2), lane); asm volatile("" ::: "memory"); peer_out_issue(F, PEER_TOKC(i + 1), slice, lane, wlB, cur, B); }
            peer_out_consume(F, first + i * step, slice, lane, A, true);
            { const PeerIds cur = id; id = peer_ids_load(F, PEER_TOKC(i + 3), lane); asm volatile("" ::: "memory"); peer_out_issue(F, PEER_TOKC(i + 2), slice, lane, wlA, cur, A); }
            peer_out_consume(F, first + (i + 1) * step, slice, lane, B, i + 1 < n);
        }
    }
}
#undef PEER_TOKC
__device__ __forceinline__ void final_norm_phase(const Frame& F) {
    const int lane = F.lane, gw = F.bid * NWAVES + F.wave, NGW = F.G * NWAVES;
    const f32x4* gf = (const f32x4*)F.in[I_GF] + lane;
    f32x4 g[8];
#pragma unroll
    for (int j = 0; j < 8; ++j) g[j] = gf[64 * j];
    if (gw >= T) return;
    v2u va[8], vb[8]; float sa, sb;
#define FN_LOAD(v_, s_, tok_) do { const int tc_ = (tok_) < T ? (tok_) : T - 1; const v2u* xi_ = (const v2u*)(WSP(bf16, WS_XB) + (size_t)tc_ * D) + lane; \
        _Pragma("unroll") for (int j_ = 0; j_ < 8; ++j_) v_[j_] = xi_[64 * j_]; } while (0)
#define FN_STORE(v_, s_, tok_) do { f32x4* xo_ = (f32x4*)(F.out + (size_t)(tok_) * D) + lane; s_ = 0.f; f32x4 f_[8]; \
        _Pragma("unroll") for (int j_ = 0; j_ < 8; ++j_) { f_[j_] = (f32x4){bf_lo(v_[j_].x), bf_hi(v_[j_].x), bf_lo(v_[j_].y), bf_hi(v_[j_].y)}; s_ += (f_[j_][0] * f_[j_][0] + f_[j_][1] * f_[j_][1]) + (f_[j_][2] * f_[j_][2] + f_[j_][3] * f_[j_][3]); } \
        s_ = wave_sum(s_); const float rs_ = 1.0f / sqrtf(s_ * (1.0f / D) + NORM_EPS); \
        _Pragma("unroll") for (int j_ = 0; j_ < 8; ++j_) xo_[64 * j_] = f_[j_] * rs_ * g[j_]; } while (0)
    FN_LOAD(va, sa, gw);
    for (int tok = gw; tok < T; tok += 2 * NGW) {
        FN_LOAD(vb, sb, tok + NGW);
        FN_STORE(va, sa, tok);
        FN_LOAD(va, sa, tok + 2 * NGW);
        if (tok + NGW < T) FN_STORE(vb, sb, tok + NGW);
    }
#undef FN_LOAD
#undef FN_STORE
}

struct Args { const float* in[28]; float* out; unsigned char* ws; int ph_lo, ph_hi, li, pad; };
__global__ void __launch_bounds__(NTHR, 2) hybrid_fwd(Args args) {
    extern __shared__ __attribute__((aligned(16))) unsigned char lds[];
    Frame F;
    F.lds = (LAS unsigned char*)lds;
    F.tid = threadIdx.x; F.lane = F.tid & 63; F.wave = __builtin_amdgcn_readfirstlane(F.tid >> 6);
    F.G = gridDim.x; F.bid = blockIdx.x;
#pragma unroll
    for (int i = 0; i < 28; ++i) F.in[i] = args.in[i];
    F.out = args.out; F.ws = args.ws;
    volatile LAS unsigned* MISC = (volatile LAS unsigned*)(F.lds + MISC_OFF);
    for (int u = F.tid; u < (LDS_BYTES - LDSCTL_OFF) / 4; u += NTHR) ((LAS unsigned*)(F.lds + LDSCTL_OFF))[u] = 0u;
    __syncthreads();
    unsigned* barw = (unsigned*)(F.ws + WS_CTL) + CW_BAR;
    XcdBarrier bar; bar.bar = barw; bar.x = 0; bar.st = nullptr;
    if (N_LAUNCHES == 1) bar = xcd_barrier_post(barw, MISC + 8);
    const int lo = args.ph_lo, hi = args.ph_hi;
#define IN(k) (lo <= (k) && (k) < hi)
#define SEAM(k) do { if (IN(k) && IN((k) + 1)) xcd_barrier(bar); } while (0)

#ifndef PROBE_DUP
#define PROBE_DUP -1
#endif
#define REPS(k) for (int rep_ = 0; rep_ < ((PROBE_DUP) == (k) ? 2 : 1); ++rep_)
    if (IN(0)) REPS(0) { p0_prologue<0>(F, F.bid, F.G); __syncthreads(); }
    SEAM(0);
    if (IN(1)) REPS(1) {
        pg8::Gemm g{(const bf16*)((const unsigned char*)F.out + OUT_X8), WSP(const bf16, WS_WIN), T, NINP, D / 2}; pg8::StaticOrder S; S.init(T, NINP, F.G, F.bid);
        pg8::EpiI8RowColBf16<0> E{WSP(bf16, WS_PROJ), NINP, WSP(const float, WS_RSTD1), WSP(const float, WS_CS1), nullptr, NORM_EPS};
        pg8::gemm_phase<pg8::EpiI8RowColBf16<0>, pg8::StaticOrder, true, true, true>(F.lds, g, S, E);
    }
    SEAM(1);
    if (IN(2)) REPS(2) {
        lora_prepass(F);
        group_barrier((unsigned*)(F.ws + WS_CTL) + CW_PREBAR, (unsigned)F.G);
        for (int r4 = 0; r4 < ((PROBE_DUP) == 70 ? 2 : 1); ++r4) rwkv_prep_phase(F);
        group_barrier((unsigned*)(F.ws + WS_CTL) + CW_PREPBAR, (unsigned)F.G);
        const int R1 = F.G >= 256 ? 128 : F.G, L0 = F.G >= 256 ? 128 : 0, NL = F.G - L0;
        if (F.bid < R1) for (int it = F.bid; it < 128; it += R1) rwkv_item(F, it);
        if (F.bid >= L0) for (int it = F.bid - L0; it < 128; it += NL) lru_seq(F, it);
        { volatile LAS int* qslot = (volatile LAS int*)(F.lds + LDSCTL_OFF + 1024);
          for (;;) { __syncthreads(); if (F.tid == 0) *qslot = (int)xb_add((unsigned*)(F.ws + WS_CTL) + CW_DEFQ, 1u); __syncthreads();
              const int vb = *qslot; if (vb >= DEF_SLICES) break; p0_prologue<1>(F, vb, DEF_SLICES); } }
    }
    SEAM(2);
    if (IN(3)) REPS(3) { const int gw = F.bid * NWAVES + F.wave, NGW = F.G * NWAVES;
        for (int tok = gw; tok < T; tok += 2 * NGW) yquant_tokens(F, tok, tok + NGW < T ? tok + NGW : tok, F.lane); }
    SEAM(3);
    if (IN(4)) REPS(4) {
        pg8::Gemm g{WSP(const bf16, WS_YQ), WSP(const bf16, WS_WOUT), T, D, D / 2}; pg8::StaticOrder S; S.init(T, D, F.G, F.bid);
        pg8::EpiI8Residual E{(const unsigned char*)F.out + OUT_X8, WSP(const float, WS_SX0), WSP(bf16, WS_XB), D, WSP(const float, WS_SY), WSP(const float, WS_CSO)};
        pg8::gemm_phase<pg8::EpiI8Residual, pg8::StaticOrder, true, true, true>(F.lds, g, S, E);
    }
    SEAM(4);
    if (IN(5)) { const int gw = F.bid * NWAVES + F.wave, NGW = F.G * NWAVES;
        for (int tok = gw; tok < T; tok += NGW) xquant_token(F, tok, F.lane); }
    SEAM(5);
    if (IN(6)) REPS(6) {
        pg8::Gemm g{WSP(const bf16, WS_XQ), WSP(const bf16, WS_WQ), T, D, D / 2}; pg8::StaticOrder S; S.init(T, D, F.G, F.bid);
        pg8::EpiI8RowColBf16<1> E{WSP(bf16, WS_Q), D, WSP(const float, WS_SX), WSP(const float, WS_CSQ), WSP(const float, WS_SSQ2), NORM_EPS};
        pg8::gemm_phase<pg8::EpiI8RowColBf16<1>, pg8::StaticOrder, true, true, true>(F.lds, g, S, E);
    }
    if (IN(6)) { __syncthreads();
        pg8::StaticOrder S; S.init(T, D, F.G, F.bid); pg8::Unit u;
        for (int i = 0; S.next(i, u); ++i) route_item(F, ((u.pm * 8 + F.wave) << 3) | u.pn, F.lane); }
    SEAM(6);
    { const PeerGeom pg = peer_geom(F); LAS int* wl = (LAS int*)(F.lds + F.wave * 1024);
      if (IN(7)) REPS(7) peer_score_phase(F, pg, (LAS int*)(F.lds + 16384 + F.wave * 2048));
      SEAM(7);
      if (IN(8)) REPS(8) { const int gw = F.bid * NWAVES + F.wave, NGW = F.G * NWAVES; for (int tok = gw; tok < T; tok += 4 * NGW) { int tk[4]; bool vl[4];
#pragma unroll
            for (int i = 0; i < 4; ++i) { const int t = tok + i * NGW; vl[i] = t < T; tk[i] = vl[i] ? t : tok; }
            peer_coef_tokens<4>(F, tk, vl, F.lane); } }
      SEAM(8);
      if (IN(9)) peer_out_phase(F, pg, (LAS int*)(F.lds + 16384 + F.wave * 2048));
      SEAM(9);
      if (IN(10)) final_norm_phase(F); }
#undef IN
#undef SEAM
}

extern "C" void kernel_launch(void* const* d_in, const int* in_sizes, int n_in, void* d_out, int out_size, void* d_ws, size_t ws_size, hipStream_t stream) {
    static int grid = 0;
    if (grid == 0) {
        if (n_in != 28 || in_sizes[0] != T * D || out_size != T * D || ws_size < WS_END) { fprintf(stderr, "kernel_launch: shape/workspace mismatch: n_in %d in0 %d out %d ws %zu (need %zu)\n", n_in, n_in > 0 ? in_sizes[0] : -1, out_size, ws_size, (size_t)WS_END); grid = -1; return; }
        int dev = 0, cus = 0, per_cu = 0;
        if (hipGetDevice(&dev) != hipSuccess || hipDeviceGetAttribute(&cus, hipDeviceAttributeMultiprocessorCount, dev) != hipSuccess) { fprintf(stderr, "kernel_launch: device query failed\n"); grid = -1; return; }
        if (hipFuncSetAttribute((const void*)hybrid_fwd, hipFuncAttributeMaxDynamicSharedMemorySize, LDS_BYTES) != hipSuccess) { fprintf(stderr, "kernel_launch: hipFuncSetAttribute failed\n"); grid = -1; return; }
        if (hipOccupancyMaxActiveBlocksPerMultiprocessor(&per_cu, (const void*)hybrid_fwd, NTHR, LDS_BYTES) != hipSuccess || per_cu < 1) { fprintf(stderr, "kernel_launch: occupancy query says %d blocks per CU\n", per_cu); per_cu = 1; }
        (void)hipGetLastError();
        grid = cus;
    }
    if (grid < 0) return;
    if (hipMemsetAsync((char*)d_ws + WS_CTL, 0, CTL_ZERO_BYTES, stream) != hipSuccess) { fprintf(stderr, "kernel_launch: hipMemsetAsync failed\n"); return; }
    Args a{};
    for (int i = 0; i < 28; ++i) a.in[i] = (const float*)d_in[i];
    a.out = (float*)d_out; a.ws = (unsigned char*)d_ws;
    for (int li = 0; li < N_LAUNCHES; ++li) {
        a.ph_lo = (N_LAUNCHES == 1) ? 0 : li; a.ph_hi = (N_LAUNCHES == 1) ? N_PHASES : li + 1; a.li = li;
        hipLaunchKernelGGL(hybrid_fwd, dim3(grid), dim3(NTHR), LDS_BYTES, stream, a);
        const hipError_t le = hipPeekAtLastError();
        if (le != hipSuccess) { fprintf(stderr, "kernel_launch: launch %d failed: %s\n", li, hipGetErrorName(le)); break; }
    }
}
```

```cpp
#include <hip/hip_runtime.h>
#include <cstdio>
#include <cstdint>
namespace pg8 {
#define PG8_LAS __attribute__((address_space(3)))
typedef unsigned short bf16_t;
typedef short bf16x8 __attribute__((ext_vector_type(8)));
typedef float f32x4 __attribute__((ext_vector_type(4)));
typedef unsigned u32x4 __attribute__((ext_vector_type(4)));
typedef int i32x4 __attribute__((ext_vector_type(4)));
constexpr int BM = 256, BK = 64, HALF = 128, HTB = HALF * BK * 2  , STAGE_BYTES = 8 * HTB, NXCD = 8, WGM = 8;

__host__ __device__ __forceinline__ int lds_byte(int r, int c) { const int st = (r >> 4) * 2 + (c >> 5), rr = r & 15, cc = c & 31, ob = rr * 64 + cc * 2; return st * 1024 + (ob ^ (((ob >> 9) & 1) << 5)); }
__host__ __device__ __forceinline__ void stage_rc(int b, int& R, int& C) { const int st = b / 1024, sb = b % 1024, swz = sb ^ (((sb >> 9) & 1) << 5); R = (st >> 1) * 16 + swz / 64; C = (st & 1) * 32 + (swz % 64) / 2; }
__host__ __device__ __forceinline__ int perm32(int rho) { const int n = rho >> 4, i = rho & 15; return 8 * (i >> 2) + 4 * n + (i & 3); }

struct Unit { int pm, pn; };
struct Gemm { const bf16_t* A; const bf16_t* Bt; int M, N, K; };

struct StaticOrder {
    int nM, nN, nwg, G, c;
    __host__ __device__ void init(int M, int N, int G_, int c_) { nM = M / BM; nN = N / BM; nwg = nM * nN; G = G_; c = c_; }
    __host__ __device__ bool next(int i, Unit& u) const {
        const long L = (long)i * G + c; if (L >= nwg) return false;
        int wgid = (int)L; { const int q = nwg / NXCD, r = nwg % NXCD, xcd = wgid % NXCD, off = wgid / NXCD; wgid = (xcd < r ? xcd * (q + 1) : r * (q + 1) + (xcd - r) * q) + off; }
        const int nig = WGM * nN, gid = wgid / nig, fm = gid * WGM, gsz = (nM - fm) < WGM ? (nM - fm) : WGM;
        u.pm = fm + ((wgid % nig) % gsz); u.pn = (wgid % nig) / gsz; return true;
    }
    __device__ __forceinline__ void a_ready(const Unit&) const {}
    __device__ __forceinline__ void done(const Unit&) const {}
};

__device__ __forceinline__ unsigned cvt_pk_bf16(float lo, float hi) { unsigned r; asm volatile("v_cvt_pk_bf16_f32 %0, %1, %2" : "=v"(r) : "v"(lo), "v"(hi)); return r; }
typedef float f32x2 __attribute__((ext_vector_type(2)));
typedef unsigned u32x2 __attribute__((ext_vector_type(2)));
template <int MODE> struct EpiRowScaleBf16 {
    static constexpr bool PERM = true, AFTER_DRAIN = false;
    bf16_t* O; int ldc; const float* rs; float eps;
    __device__ __forceinline__ void operator()(const f32x4 (&acc)[2][2][4][2], const Unit& u, int wr, int wc, int fr, int fq) const {
        const int row0 = u.pm * BM + wr * 64 + fr, col0 = u.pn * BM + wc * 32 + 8 * fq;
#pragma unroll
        for (int ai = 0; ai < 2; ++ai)
#pragma unroll
            for (int m = 0; m < 4; ++m) { const int r = row0 + ai * HALF + m * 16; float s = rs[r]; if (MODE == 1) s = 1.0f / sqrtf(s * (1.0f / 2048.0f) + eps);
                bf16_t* rowp = O + (size_t)r * ldc + col0;
#pragma unroll
                for (int bj = 0; bj < 2; ++bj) { const f32x4 v0 = acc[ai][bj][m][0] * s, v1 = acc[ai][bj][m][1] * s;
                    u32x4 w; w.x = cvt_pk_bf16(v0[0], v0[1]); w.y = cvt_pk_bf16(v0[2], v0[3]); w.z = cvt_pk_bf16(v1[0], v1[1]); w.w = cvt_pk_bf16(v1[2], v1[3]);
                    *(u32x4*)(rowp + bj * HALF) = w; } }
    }
};
template <int MODE> struct EpiI8RowColBf16 {
    static constexpr bool PERM = true, AFTER_DRAIN = false;
    bf16_t* O; int ldc; const float* rs; const float* cs; const float* ssq; float eps;
    __device__ __forceinline__ void operator()(const f32x4 (&acc)[2][2][4][2], const Unit& u, int wr, int wc, int fr, int fq) const {
        const int row0 = u.pm * BM + wr * 64 + fr, col0 = u.pn * BM + wc * 32 + 8 * fq;
        f32x4 c4[2][2];
#pragma unroll
        for (int bj = 0; bj < 2; ++bj) { c4[bj][0] = *(const f32x4*)(cs + col0 + bj * HALF); c4[bj][1] = *(const f32x4*)(cs + col0 + bj * HALF + 4); }
#pragma unroll
        for (int ai = 0; ai < 2; ++ai)
#pragma unroll
            for (int m = 0; m < 4; ++m) { const int r = row0 + ai * HALF + m * 16; float s = rs[r]; if (MODE == 1) s = s / sqrtf(ssq[r] * (1.0f / 2048.0f) + eps);
                bf16_t* rowp = O + (size_t)r * ldc + col0;
#pragma unroll
                for (int bj = 0; bj < 2; ++bj) { f32x4 v0, v1; const i32x4 i0 = __builtin_bit_cast(i32x4, acc[ai][bj][m][0]), i1 = __builtin_bit_cast(i32x4, acc[ai][bj][m][1]);
#pragma unroll
                    for (int e = 0; e < 4; ++e) { v0[e] = (float)i0[e] * s * c4[bj][0][e]; v1[e] = (float)i1[e] * s * c4[bj][1][e]; }
                    u32x4 w; w.x = cvt_pk_bf16(v0[0], v0[1]); w.y = cvt_pk_bf16(v0[2], v0[3]); w.z = cvt_pk_bf16(v1[0], v1[1]); w.w = cvt_pk_bf16(v1[2], v1[3]);
                    *(u32x4*)(rowp + bj * HALF) = w; } }
    }
};
struct EpiResidual {
    static constexpr bool PERM = false, AFTER_DRAIN = false;
    const float* base; bf16_t* outb; int ldc;
    __device__ __forceinline__ void operator()(const f32x4 (&acc)[2][2][4][2], const Unit& u, int wr, int wc, int fr, int fq) const {
        const int row0 = u.pm * BM + wr * 64 + fr, col0 = u.pn * BM + wc * 32 + 4 * fq;
#pragma unroll
        for (int ai = 0; ai < 2; ++ai)
#pragma unroll
            for (int m = 0; m < 4; ++m) { const int r = row0 + ai * HALF + m * 16; const size_t off = (size_t)r * ldc + col0;
#pragma unroll
                for (int bj = 0; bj < 2; ++bj)
#pragma unroll
                    for (int n = 0; n < 2; ++n) { const f32x4 bs = *(const f32x4*)(base + off + bj * HALF + n * 16); const f32x4 o = bs + acc[ai][bj][m][n];
                        u32x2 w; w.x = cvt_pk_bf16(o[0], o[1]); w.y = cvt_pk_bf16(o[2], o[3]); *(u32x2*)(outb + off + bj * HALF + n * 16) = w; } }
    }
};
struct EpiI8Residual {
    static constexpr bool PERM = true, AFTER_DRAIN = false;
    const unsigned char* x8; const float* xs; bf16_t* outb; int ldc; const float* rs; const float* cs;
    __device__ __forceinline__ void operator()(const f32x4 (&acc)[2][2][4][2], const Unit& u, int wr, int wc, int fr, int fq) const {
        const int row0 = u.pm * BM + wr * 64 + fr, col0 = u.pn * BM + wc * 32 + 8 * fq;
        f32x4 c4[2][2];
#pragma unroll
        for (int bj = 0; bj < 2; ++bj) { c4[bj][0] = *(const f32x4*)(cs + col0 + bj * HALF); c4[bj][1] = *(const f32x4*)(cs + col0 + bj * HALF + 4); }
#pragma unroll
        for (int ai = 0; ai < 2; ++ai)
#pragma unroll
            for (int m = 0; m < 4; ++m) { const int r = row0 + ai * HALF + m * 16; const float s = rs[r], sx = xs[r]; const size_t off = (size_t)r * ldc + col0;
#pragma unroll
                for (int bj = 0; bj < 2; ++bj) { const i32x4 i0 = __builtin_bit_cast(i32x4, acc[ai][bj][m][0]), i1 = __builtin_bit_cast(i32x4, acc[ai][bj][m][1]);
                    const u32x2 xb = *(const u32x2*)(x8 + off + bj * HALF); f32x4 v0, v1;
#pragma unroll
                    for (int e = 0; e < 4; ++e) { v0[e] = (float)((int)(xb.x << (24 - 8 * e)) >> 24) * sx + (float)i0[e] * s * c4[bj][0][e]; v1[e] = (float)((int)(xb.y << (24 - 8 * e)) >> 24) * sx + (float)i1[e] * s * c4[bj][1][e]; }
                    u32x4 w; w.x = cvt_pk_bf16(v0[0], v0[1]); w.y = cvt_pk_bf16(v0[2], v0[3]); w.z = cvt_pk_bf16(v1[0], v1[1]); w.w = cvt_pk_bf16(v1[2], v1[3]);
                    *(u32x4*)(outb + off + bj * HALF) = w; } }
    }
};
template <class Epi, class Sched, bool ALIGN_EPI = false, bool SP2 = false, bool I8 = false>
__device__ __forceinline__ void gemm_phase(PG8_LAS unsigned char* lds, const Gemm g, const Sched& S, const Epi& E) {
    const int tid = threadIdx.x, wid = __builtin_amdgcn_readfirstlane(tid >> 6), lane = tid & 63, wr = wid >> 2, wc = wid & 3, fr = lane & 15, fq = lane >> 4;
    const int K = g.K, nt = K / BK;
    unsigned voffA[2], voffB[2];
#pragma unroll
    for (int i = 0; i < 2; ++i) { int R, C; stage_rc(tid * 16 + i * 8192, R, C); const int Rb = Epi::PERM ? ((R & ~31) + perm32(R & 31)) : R;
        voffA[i] = (unsigned)(R * K + C) * 2u; voffB[i] = (unsigned)(Rb * K + C) * 2u; }
    const size_t kstep = (size_t)(BK * 2);
    const size_t hstep = (size_t)HALF * K * 2;
    const size_t tstep = 2 * hstep;
    const unsigned ldsw = (unsigned)wid * 1024u;
    const int aoff = lds_byte(wr * 64 + fr, fq * 8), boff = lds_byte(wc * 32 + fr, fq * 8);
#define PG8_SA(b, h) (((b) * 2 + (h)) * HTB)
#define PG8_SB(b, h) ((4 + (b) * 2 + (h)) * HTB)
#define PG8_STAGE(bufoff, gbase, voff) do { _Pragma("unroll") for (int _i = 0; _i < 2; ++_i) \
        __builtin_amdgcn_global_load_lds((const unsigned*)((const char*)(gbase) + (voff)[_i]), (PG8_LAS unsigned*)(lds + (bufoff) + ldsw + _i * 8192), 16, 0, 0); } while (0)
#define PG8_LDA(dst, b, h) do { _Pragma("unroll") for (int m = 0; m < 4; ++m) _Pragma("unroll") for (int k = 0; k < 2; ++k) dst[m][k] = *(const PG8_LAS bf16x8*)(lds + PG8_SA(b, h) + aoff + m * 2048 + k * 1024); } while (0)
#define PG8_LDB(dst, b, h) do { _Pragma("unroll") for (int n = 0; n < 2; ++n) _Pragma("unroll") for (int k = 0; k < 2; ++k) dst[n][k] = *(const PG8_LAS bf16x8*)(lds + PG8_SB(b, h) + boff + n * 2048 + k * 1024); } while (0)
#define PG8_MMA(ai, bj, At, Bt) do { __builtin_amdgcn_s_setprio(1); _Pragma("unroll") for (int m = 0; m < 4; ++m) _Pragma("unroll") for (int n = 0; n < 2; ++n) _Pragma("unroll") for (int k = 0; k < 2; ++k) \
        { if constexpr (I8) acc[ai][bj][m][n] = __builtin_bit_cast(f32x4, __builtin_amdgcn_mfma_i32_16x16x64_i8(__builtin_bit_cast(i32x4, Bt[n][k]), __builtin_bit_cast(i32x4, At[m][k]), __builtin_bit_cast(i32x4, acc[ai][bj][m][n]), 0, 0, 0)); \
          else acc[ai][bj][m][n] = __builtin_amdgcn_mfma_f32_16x16x32_bf16(Bt[n][k], At[m][k], acc[ai][bj][m][n], 0, 0, 0); } __builtin_amdgcn_s_setprio(0); } while (0)
#define PG8_WAIT_V(n) asm volatile("s_waitcnt vmcnt(" #n ")" ::: "memory")
#define PG8_WAIT_L(n) asm volatile("s_waitcnt lgkmcnt(" #n ")" ::: "memory")
#define PG8_BAR __builtin_amdgcn_s_barrier()
#define PG8_SCHED __builtin_amdgcn_sched_barrier(0)
    Unit cur, nxt; int ui = 0;
    if (!S.next(0, cur)) return;
    f32x4 acc[2][2][4][2];
#pragma unroll
    for (int a = 0; a < 2; ++a)
#pragma unroll
        for (int b = 0; b < 2; ++b)
#pragma unroll
            for (int m = 0; m < 4; ++m)
#pragma unroll
                for (int n = 0; n < 2; ++n) acc[a][b][m][n] = (f32x4){0.f, 0.f, 0.f, 0.f};
    bf16x8 At[4][2], B0[2][2], B1[2][2];
    const char* cA = (const char*)g.A + (size_t)cur.pm * tstep; const char* cB = (const char*)g.Bt + (size_t)cur.pn * tstep;
    S.a_ready(cur);
    if constexpr (SP2) {
        PG8_STAGE(PG8_SB(0, 0), cB, voffB); PG8_STAGE(PG8_SB(0, 1), cB + hstep, voffB); PG8_STAGE(PG8_SA(0, 0), cA, voffA); PG8_STAGE(PG8_SA(0, 1), cA + hstep, voffA);
        if (wr == 1) PG8_BAR;
        PG8_WAIT_V(2); PG8_BAR;
        PG8_STAGE(PG8_SB(1, 0), cB + kstep, voffB); PG8_STAGE(PG8_SA(1, 0), cA + kstep, voffA); PG8_STAGE(PG8_SB(1, 1), cB + hstep + kstep, voffB);
        PG8_WAIT_V(6); PG8_BAR;
    } else {
        PG8_STAGE(PG8_SB(0, 0), cB, voffB); PG8_STAGE(PG8_SA(0, 0), cA, voffA); PG8_STAGE(PG8_SB(0, 1), cB + hstep, voffB); PG8_STAGE(PG8_SA(0, 1), cA + hstep, voffA);
        if (wr == 1) PG8_BAR;
        PG8_WAIT_V(4); PG8_BAR;
        PG8_STAGE(PG8_SB(1, 0), cB + kstep, voffB); PG8_STAGE(PG8_SA(1, 0), cA + kstep, voffA); PG8_STAGE(PG8_SB(1, 1), cB + hstep + kstep, voffB);
        PG8_WAIT_V(6); PG8_BAR;
    }
    for (;;) {
        const bool has_next = S.next(ui + 1, nxt);
        const char* nA = has_next ? (const char*)g.A + (size_t)nxt.pm * tstep : cA; const char* nB = has_next ? (const char*)g.Bt + (size_t)nxt.pn * tstep : cB;
        for (int t = 0; t < nt; t += 2) {
            const bool last = (t == nt - 2);
            const char* a1 = cA + (size_t)(t + 1) * kstep;
            const char* a2 = last ? nA : cA + (size_t)(t + 2) * kstep; const char* b2 = last ? nB : cB + (size_t)(t + 2) * kstep;
            const char* a3 = a2 + kstep; const char* b3 = b2 + kstep;
            if (last && has_next) S.a_ready(nxt);
            if constexpr (SP2) {
            PG8_LDB(B0, 0, 0); PG8_LDB(B1, 0, 1); PG8_SCHED; PG8_LDA(At, 0, 0); PG8_STAGE(PG8_SA(1, 1), a1 + hstep, voffA);
            PG8_WAIT_V(8); PG8_WAIT_L(0); PG8_BAR; PG8_MMA(0, 0, At, B0); PG8_MMA(0, 1, At, B1); PG8_BAR; PG8_SCHED;
            PG8_LDA(At, 0, 1); PG8_STAGE(PG8_SB(0, 0), b2, voffB); PG8_STAGE(PG8_SB(0, 1), b2 + hstep, voffB); PG8_STAGE(PG8_SA(0, 0), a2, voffA);
            PG8_WAIT_V(8); PG8_WAIT_L(0); PG8_BAR; PG8_MMA(1, 0, At, B0); PG8_MMA(1, 1, At, B1); PG8_BAR; PG8_SCHED;
            PG8_LDB(B0, 1, 0); PG8_LDB(B1, 1, 1); PG8_SCHED; PG8_LDA(At, 1, 0); PG8_STAGE(PG8_SA(0, 1), a2 + hstep, voffA);
            PG8_WAIT_V(8); PG8_WAIT_L(0); PG8_BAR; PG8_MMA(0, 0, At, B0); PG8_MMA(0, 1, At, B1); PG8_BAR; PG8_SCHED;
            PG8_LDA(At, 1, 1); PG8_STAGE(PG8_SB(1, 0), b3, voffB); PG8_STAGE(PG8_SB(1, 1), b3 + hstep, voffB); PG8_STAGE(PG8_SA(1, 0), a3, voffA);
            PG8_WAIT_V(8); PG8_WAIT_L(0); PG8_BAR; PG8_MMA(1, 0, At, B0); PG8_MMA(1, 1, At, B1); PG8_BAR; PG8_SCHED;
            } else {
            PG8_LDB(B0, 0, 0); PG8_SCHED; PG8_LDA(At, 0, 0); PG8_STAGE(PG8_SA(1, 1), a1 + hstep, voffA);
            PG8_WAIT_L(8); PG8_BAR; PG8_WAIT_L(0); PG8_MMA(0, 0, At, B0); PG8_BAR; PG8_SCHED;
            PG8_LDB(B1, 0, 1); PG8_STAGE(PG8_SB(0, 0), b2, voffB);
            PG8_BAR; PG8_WAIT_L(0); PG8_MMA(0, 1, At, B1); PG8_BAR;
            PG8_LDA(At, 0, 1); PG8_STAGE(PG8_SA(0, 0), a2, voffA);
            PG8_BAR; PG8_WAIT_L(0); PG8_MMA(1, 0, At, B0); PG8_BAR; PG8_SCHED;
            PG8_STAGE(PG8_SB(0, 1), b2 + hstep, voffB);
            PG8_WAIT_V(6); PG8_BAR; PG8_MMA(1, 1, At, B1); PG8_BAR;
            PG8_LDB(B0, 1, 0); PG8_SCHED; PG8_LDA(At, 1, 0); PG8_STAGE(PG8_SA(0, 1), a2 + hstep, voffA);
            PG8_WAIT_L(8); PG8_BAR; PG8_WAIT_L(0); PG8_MMA(0, 0, At, B0); PG8_BAR; PG8_SCHED;
            PG8_LDB(B1, 1, 1); PG8_STAGE(PG8_SB(1, 0), b3, voffB);
            PG8_BAR; PG8_WAIT_L(0); PG8_MMA(0, 1, At, B1); PG8_BAR;
            PG8_LDA(At, 1, 1); PG8_STAGE(PG8_SA(1, 0), a3, voffA);
            PG8_BAR; PG8_WAIT_L(0); PG8_MMA(1, 0, At, B0); PG8_BAR; PG8_SCHED;
            PG8_STAGE(PG8_SB(1, 1), b3 + hstep, voffB);
            PG8_WAIT_V(6); PG8_BAR; PG8_MMA(1, 1, At, B1); PG8_BAR;
            }
        }
        if constexpr (ALIGN_EPI) { if (wr == 0) PG8_BAR; }
        if constexpr (!Epi::AFTER_DRAIN) { E(acc, cur, wr, wc, fr, fq); S.done(cur); }
        if (!has_next) break;
#pragma unroll
        for (int a = 0; a < 2; ++a)
#pragma unroll
            for (int b = 0; b < 2; ++b)
#pragma unroll
                for (int m = 0; m < 4; ++m)
#pragma unroll
                    for (int n = 0; n < 2; ++n) acc[a][b][m][n] = (f32x4){0.f, 0.f, 0.f, 0.f};
        cur = nxt; cA = nA; cB = nB; ++ui;
        if constexpr (ALIGN_EPI) { if (wr == 1) PG8_BAR; }
    }
    PG8_WAIT_V(0);
    if constexpr (!ALIGN_EPI) { if (wr == 0) PG8_BAR; }
    PG8_BAR;
    if constexpr (Epi::AFTER_DRAIN) { E.fused(acc, cur, wr, wc, fr, fq, lds, wid, lane); S.done(cur); }
#undef PG8_SA
#undef PG8_SB
#undef PG8_STAGE
#undef PG8_LDA
#undef PG8_LDB
#undef PG8_MMA
#undef PG8_WAIT_V
#undef PG8_WAIT_L
#undef PG8_BAR
#undef PG8_SCHED
}
}

#ifndef PROBE_DUP
#define PROBE_DUP -1
#endif
constexpr int NWAVES = 8, NTHR = NWAVES * 64;
#ifndef MK_N_LAUNCHES
#define MK_N_LAUNCHES 1
#endif
constexpr int N_PHASES = 11;
constexpr int DEF_SLICES = 256;
constexpr int N_LAUNCHES = MK_N_LAUNCHES;
static_assert(N_LAUNCHES == 1 || N_LAUNCHES == N_PHASES, "MK_N_LAUNCHES is 1 or N_PHASES");

constexpr int BATCH = 8, SEQ = 2048, T = BATCH * SEQ, D = 2048;
constexpr int NIN = 5408, NINP = 5632;
constexpr int PC_GATE = 1024, PC_R = 2048, PC_K = 3072, PC_V = 4096, PC_WD = 5120, PC_AD = 5184, PC_GD = 5248;
constexpr int RWKV_C0 = 2048;
constexpr int NEXP = 16384, NSEL = 128;
constexpr float NORM_EPS = 1e-6f, GN_EPS = 64e-5f;

constexpr size_t MiB = 1u << 20;
constexpr size_t WS_CTL = 0, CTL_ZERO_BYTES = 1 * MiB;
constexpr size_t WS_SSQ3 = 576 * 1024;
constexpr size_t WS_SSQ2 = 512 * 1024;
constexpr size_t WS_RSTD1 = 1 * MiB;
constexpr size_t WS_USC = 1 * MiB + 64 * 1024, WS_VSC = 1 * MiB + 128 * 1024;
constexpr size_t WS_SX = 1 * MiB + 192 * 1024;
constexpr size_t WS_CS1 = 1 * MiB + 256 * 1024;
constexpr size_t WS_CSQ = 1 * MiB + 288 * 1024;
constexpr size_t WS_CSO = 1 * MiB + 296 * 1024;
constexpr size_t WS_SY = 1 * MiB + 320 * 1024;
constexpr size_t WS_SX0 = 1 * MiB + 384 * 1024;
constexpr size_t WS_WIN = 2 * MiB;
constexpr size_t WS_WOUT = 24 * MiB;
constexpr size_t WS_WQ = 32 * MiB;
constexpr size_t WS_KEYS = 40 * MiB;
constexpr size_t WS_W2T = WS_KEYS + 512 * 1024;
constexpr size_t WS_A2T = WS_W2T + 128 * 1024;
constexpr size_t WS_G2T = WS_A2T + 128 * 1024;
constexpr size_t WS_WAT = WS_G2T + 320 * 1024;
constexpr size_t WS_WIT = WS_WAT + 256 * 1024;
constexpr size_t WS_EXP = 42 * MiB;
constexpr size_t WS_GATE = 50 * MiB;
constexpr size_t WS_LA = 42 * MiB;
constexpr size_t WS_SUMM = 58 * MiB;
constexpr size_t WS_TA = 64 * MiB, WS_TB = 96 * MiB, WS_TK = 400 * MiB, WS_TR = 464 * MiB;
constexpr size_t OUT_X8 = 72 * MiB;
constexpr size_t OUT_TV = 0, OUT_TG = 32 * MiB, OUT_PC = 64 * MiB, OUT_BON = 66 * MiB;
constexpr size_t WS_XB = 64 * MiB;
constexpr size_t WS_PROJ = 128 * MiB;
constexpr size_t WS_Q = WS_PROJ;
constexpr size_t WS_YQ = WS_PROJ;
constexpr size_t WS_PART = 192 * MiB;
constexpr size_t WS_XQ = 320 * MiB;
constexpr size_t WS_COEF = 352 * MiB;
constexpr size_t WS_CSC = 356 * MiB;
constexpr size_t WS_Y = 304 * MiB;
constexpr size_t WS_UT = 368 * MiB;
constexpr size_t WS_VT = 432 * MiB;
constexpr size_t WS_END = 496 * MiB;
static_assert(WS_WIT + 256 * 1024 <= WS_EXP && WS_PROJ + (size_t)T * NINP * 2 <= WS_Y && WS_WIN + (size_t)NINP * D * 2 <= WS_WOUT, "d_ws map");
constexpr int CW_DEFQ = 2240;
constexpr int CW_PREPBAR = 2176;
constexpr int CW_PREBAR = 2112;
constexpr int CW_LRUBAR = 2048;
constexpr int CW_BAR = 4096;

constexpr int RING_BYTES = 131072;
constexpr int LDSCTL_OFF = 143360, MISC_OFF = LDSCTL_OFF + 320;
constexpr int LDS_BYTES = 147456;

#define GAS __attribute__((address_space(1)))
#define LAS __attribute__((address_space(3)))
typedef unsigned short bf16;
typedef unsigned v4u __attribute__((ext_vector_type(4)));
typedef unsigned v2u __attribute__((ext_vector_type(2)));
typedef float f32x4 __attribute__((ext_vector_type(4)));
typedef float f32x16 __attribute__((ext_vector_type(16)));
typedef short bf16x8 __attribute__((ext_vector_type(8)));
typedef __bf16 bf16x2_t __attribute__((ext_vector_type(2)));
typedef GAS unsigned gu32;
#define RLX_AGENT __ATOMIC_RELAXED, __HIP_MEMORY_SCOPE_AGENT
__device__ __forceinline__ unsigned f2bf(float f) { unsigned u = __builtin_bit_cast(unsigned, f); return (u + 0x7fffu + ((u >> 16) & 1u)) >> 16; }
__device__ __forceinline__ unsigned pk2(float lo, float hi) { return f2bf(lo) | (f2bf(hi) << 16); }
__device__ __forceinline__ float bf_lo(unsigned w) { return __uint_as_float(w << 16); }
__device__ __forceinline__ float bf_hi(unsigned w) { return __uint_as_float(w & 0xffff0000u); }
__device__ __forceinline__ void unpack8(const v4u& w, float (&o)[8]) { o[0] = bf_lo(w.x); o[1] = bf_hi(w.x); o[2] = bf_lo(w.y); o[3] = bf_hi(w.y); o[4] = bf_lo(w.z); o[5] = bf_hi(w.z); o[6] = bf_lo(w.w); o[7] = bf_hi(w.w); }
__device__ __forceinline__ v4u pack8(const float (&o)[8]) { v4u w; w.x = pk2(o[0], o[1]); w.y = pk2(o[2], o[3]); w.z = pk2(o[4], o[5]); w.w = pk2(o[6], o[7]); return w; }
__device__ __forceinline__ float sigmoidf_(float x) { return 1.0f / (1.0f + __expf(-x)); }
__device__ __forceinline__ float softplusf_(float z) { return fmaxf(z, 0.f) + log1pf(__expf(-fabsf(z))); }
__device__ __forceinline__ float gelu_tanh(float x) { const float u = 0.7978845608028654f * (x + 0.044715f * x * x * x); return 0.5f * x * (1.0f + tanhf(u)); }
template <int CTRL> __device__ __forceinline__ float dppf(float x) { return __builtin_bit_cast(float, __builtin_amdgcn_mov_dpp(__builtin_bit_cast(int, x), CTRL, 0xf, 0xf, true)); }
__device__ __forceinline__ float red8(float v) { v += dppf<0xB1>(v); v += dppf<0x4E>(v); v += dppf<0x141>(v); return v; }
__device__ __forceinline__ float red16(float v) { v = red8(v); v += dppf<0x140>(v); return v; }
__device__ __forceinline__ float wave_sum(float v) {
#pragma unroll
    for (int o = 1; o < 64; o <<= 1) v += __shfl_xor(v, o);
    return v;
}
__device__ __forceinline__ float dot2bf(unsigned a, unsigned b, float acc) { return __builtin_amdgcn_fdot2_f32_bf16(__builtin_bit_cast(bf16x2_t, a), __builtin_bit_cast(bf16x2_t, b), acc, false); }
#define MFMA16(a, b, c) __builtin_amdgcn_mfma_f32_16x16x32_bf16((a), (b), (c), 0, 0, 0)
#define MFMA32(a, b, c) __builtin_amdgcn_mfma_f32_32x32x16_bf16((a), (b), (c), 0, 0, 0)

#define XB_TMO      128
#define XB_XCNT(j)  (256  + 64 * (j))
#define XB_XSUB(j)  (1280 + 64 * (j))
#define XB_XGEN(j)  (2304 + 64 * (j))
#define XB_TOP      3328
#define XB_TOPGEN   3392
#define XCD_BAR_WORDS 3456
#define XB_SPIN_CAP (1u << 22)
__device__ __forceinline__ unsigned xb_ld(unsigned* p)              { return __hip_atomic_load(p, __ATOMIC_RELAXED, __HIP_MEMORY_SCOPE_AGENT); }
__device__ __forceinline__ unsigned xb_add(unsigned* p, unsigned v) { return __hip_atomic_fetch_add(p, v, __ATOMIC_RELAXED, __HIP_MEMORY_SCOPE_AGENT); }
__device__ __forceinline__ unsigned xb_xcc_id() { return (unsigned)__builtin_amdgcn_s_getreg((3 << 11) | 20) & 0xFu; }
#define XB_SPIN(cond, bar) do { unsigned _sp = 0; while (cond) { __builtin_amdgcn_s_sleep(1); \
    if ((++_sp & 255u) == 0u) { if (xb_ld(&(bar)[XB_TMO])) break; if (_sp > XB_SPIN_CAP) { atomicAdd(&(bar)[XB_TMO], 1u); break; } } } } while (0)
struct XcdBarrier { unsigned* bar; unsigned x; volatile LAS unsigned* st; };
__device__ __forceinline__ XcdBarrier xcd_barrier_post(unsigned* bar, volatile LAS unsigned* st) {
    XcdBarrier b; b.bar = bar; b.x = xb_xcc_id(); b.st = st;
    if (threadIdx.x == 0) (void)xb_add(&bar[XB_XCNT(b.x)], 1u);
    return b;
}
__device__ __forceinline__ void xcd_barrier_complete(unsigned* bar, unsigned x, unsigned& nloc, unsigned& nx) {
    const unsigned G = gridDim.x * gridDim.y * gridDim.z;
    unsigned sum, cnt, mine, sp = 0u;
    for (;;) {
        sum = 0u; cnt = 0u; mine = 0u;
#pragma unroll
        for (unsigned j = 0; j < 16; ++j) { const unsigned c = xb_ld(&bar[XB_XCNT(j)]); sum += c; cnt += (c > 0u) ? 1u : 0u; mine = (j == x) ? c : mine; }
        if (sum == G) break;
        __builtin_amdgcn_s_sleep(1);
        if ((++sp & 255u) == 0u) { if (xb_ld(&bar[XB_TMO])) break; if (sp > XB_SPIN_CAP) { atomicAdd(&bar[XB_TMO], 1u); break; } }
    }
    nloc = mine > 0u ? mine : 1u; nx = cnt > 0u ? cnt : 1u;
}
__device__ __forceinline__ void xcd_barrier(const XcdBarrier& b) {
    asm volatile("s_waitcnt vmcnt(0)" ::: "memory");
    __syncthreads();
    if (threadIdx.x == 0) {
        unsigned* bar = b.bar;
        __builtin_amdgcn_s_waitcnt(0);
        unsigned nloc = b.st[0], nx = b.st[1];
        if (nloc == 0u) { xcd_barrier_complete(bar, b.x, nloc, nx); b.st[0] = nloc; b.st[1] = nx; }
        const unsigned old = xb_add(&bar[XB_XSUB(b.x)], 1u);
        const unsigned gen = old / nloc;
        if (old + 1u == (gen + 1u) * nloc) {
            __builtin_amdgcn_fence(__ATOMIC_RELEASE, "agent");
            asm volatile("s_waitcnt vmcnt(0)" ::: "memory");
            const unsigned og = xb_add(&bar[XB_TOP], 1u);
            const unsigned tg = og / nx;
            if (og + 1u == (tg + 1u) * nx) xb_add(&bar[XB_TOPGEN], 1u);
            else XB_SPIN(xb_ld(&bar[XB_TOPGEN]) == tg, bar);
            __builtin_amdgcn_fence(__ATOMIC_ACQUIRE, "agent");
            xb_add(&bar[XB_XGEN(b.x)], 1u);
            asm volatile("s_waitcnt vmcnt(0)" ::: "memory");
        } else {
            XB_SPIN(xb_ld(&bar[XB_XGEN(b.x)]) == gen, bar);
            __builtin_amdgcn_fence(__ATOMIC_ACQUIRE, "agent");
            asm volatile("s_waitcnt vmcnt(0)" ::: "memory");
        }
    }
    __syncthreads();
}

struct Frame {
    LAS unsigned char* lds;
    int tid, lane, wave, G, bid;
    const float* in[28];
    float* out;
    unsigned char* ws;
};
#define WSP(type, off) ((type*)(F.ws + (off)))
enum { I_X = 0, I_G1, I_WIN, I_CONVW, I_CONVB, I_WA, I_BA, I_WI, I_BI, I_LAM, I_MU, I_W0, I_W2, I_A0, I_A2, I_G2, I_KK, I_KA, I_RK, I_LNW, I_LNB, I_WOUT, I_G2N, I_WQ, I_KEYS, I_U, I_V, I_GF };

__device__ __forceinline__ void p0_transpose_item(const float* W, int K, int N, bf16* WT, const float* ksc, LAS float* scr, int item, int lane) {
    const int nblk = N / 32, kb = item / nblk, nb = item % nblk, k0 = 64 * kb, n0 = 32 * nb;
    const int lr = lane >> 3, c4 = (lane & 7) * 4;
    f32x4 v[8];
#pragma unroll
    for (int i = 0; i < 8; ++i) v[i] = *(const f32x4*)(W + (size_t)(k0 + 8 * i + lr) * N + n0 + c4);
#pragma unroll
    for (int i = 0; i < 8; ++i) { const int kk = 8 * i + lr; const float sc = ksc ? ksc[k0 + kk] : 1.0f; LAS float* d = scr + kk * 33 + c4; d[0] = v[i][0] * sc; d[1] = v[i][1] * sc; d[2] = v[i][2] * sc; d[3] = v[i][3] * sc; }
    asm volatile("s_waitcnt lgkmcnt(0)" ::: "memory");
    const int c = lane & 7;
#pragma unroll
    for (int j = 0; j < 4; ++j) { const int n = (lane >> 3) + 8 * j; const LAS float* s = scr + (8 * c) * 33 + n;
        v4u o; o.x = pk2(s[0 * 33], s[1 * 33]); o.y = pk2(s[2 * 33], s[3 * 33]); o.z = pk2(s[4 * 33], s[5 * 33]); o.w = pk2(s[6 * 33], s[7 * 33]);
        *(v4u*)(WT + (size_t)(n0 + n) * K + k0 + 8 * c) = o; }
    asm volatile("s_waitcnt lgkmcnt(0)" ::: "memory");
}
template <bool HASK> __device__ __forceinline__ void p0_wquant_block(const float* W, int N, unsigned char* WT8, float* cs, const float* ksc, int item, int wave, int lane, LAS float* mxs) {
    asm volatile("" : "+v"(lane));
    const int n0 = item * 32, r = lane >> 3, c4 = lane & 7, kb = 256 * wave + 4 * r;
    const float* src = W + (size_t)kb * N + n0 + 4 * c4; const float* kp = ksc + kb;
    f32x4 mx = (f32x4){0.f, 0.f, 0.f, 0.f};
#pragma unroll
    for (int i2 = 0; i2 < 2; ++i2) { f32x4 v[4][4], g4[4];
#pragma unroll
        for (int ii = 0; ii < 4; ++ii) { g4[ii] = HASK ? *(const f32x4*)(kp + 32 * (i2 * 4 + ii)) : (f32x4){1.f, 1.f, 1.f, 1.f};
#pragma unroll
            for (int j = 0; j < 4; ++j) v[ii][j] = *(const f32x4*)(src + (size_t)(32 * (i2 * 4 + ii) + j) * N); }
#pragma unroll
        for (int ii = 0; ii < 4; ++ii)
#pragma unroll
            for (int j = 0; j < 4; ++j)
#pragma unroll
                for (int e = 0; e < 4; ++e) mx[e] = fmaxf(mx[e], fabsf(v[ii][j][e] * g4[ii][j])); }
#pragma unroll
    for (int o = 8; o < 64; o <<= 1)
#pragma unroll
        for (int e = 0; e < 4; ++e) mx[e] = fmaxf(mx[e], __shfl_xor(mx[e], o));
    if (r == 0) *(LAS f32x4*)(mxs + wave * 32 + 4 * c4) = mx;
    __syncthreads();
#pragma unroll
    for (int w = 0; w < NWAVES; ++w) { const f32x4 t = *(const LAS f32x4*)(mxs + w * 32 + 4 * c4);
#pragma unroll
        for (int e = 0; e < 4; ++e) mx[e] = fmaxf(mx[e], t[e]); }
    f32x4 q;
#pragma unroll
    for (int e = 0; e < 4; ++e) q[e] = mx[e] > 0.f ? 127.0f / mx[e] : 0.f;
    if (wave == 0 && r == 0) *(f32x4*)(cs + n0 + 4 * c4) = mx * (1.0f / 127.0f);
    unsigned char* dst = WT8 + (size_t)(n0 + 4 * c4) * 2048 + kb;
#pragma unroll
    for (int i2 = 0; i2 < 2; ++i2) { f32x4 v[4][4], g4[4];
#pragma unroll
        for (int ii = 0; ii < 4; ++ii) { g4[ii] = HASK ? *(const f32x4*)(kp + 32 * (i2 * 4 + ii)) : (f32x4){1.f, 1.f, 1.f, 1.f};
#pragma unroll
            for (int j = 0; j < 4; ++j) v[ii][j] = *(const f32x4*)(src + (size_t)(32 * (i2 * 4 + ii) + j) * N); }
#pragma unroll
        for (int ii = 0; ii < 4; ++ii) { unsigned w[4] = {0u, 0u, 0u, 0u};
#pragma unroll
            for (int j = 0; j < 4; ++j)
#pragma unroll
                for (int e = 0; e < 4; ++e) { const int qi = (int)rintf(v[ii][j][e] * g4[ii][j] * q[e]); w[e] |= ((unsigned)qi & 0xFFu) << (8 * j); }
#pragma unroll
            for (int e = 0; e < 4; ++e) *(unsigned*)(dst + (size_t)e * 2048 + 32 * (i2 * 4 + ii)) = w[e]; } }
    __syncthreads();
}
__device__ __forceinline__ void p0_small_transpose(const float* src, bf16* dst, int nb, int K, int N, int gt, int NGT) {
    const int tot = nb * K * N;
    for (int i = gt; i < tot; i += NGT) { const int bb = i / (K * N), r = i - bb * K * N, n = r / K, k = r - n * K; dst[i] = (bf16)f2bf(src[(size_t)bb * K * N + (size_t)k * N + n]); }
}
template <int PART> __device__ __forceinline__ void p0_prologue(const Frame& F, int vb, int VG) {
    LAS float* scr = (LAS float*)(F.lds + F.wave * 8448);
    const int gw = vb * NWAVES + F.wave, NGW = VG * NWAVES, gt = gw * 64 + F.lane, NGT = NGW * 64;
    constexpr int I1 = (D / 64) * (NIN / 32), I2 = (D / 64) * (D / 32);
    if (PART == 0) { for (int it = vb; it < NIN / 32; it += VG) p0_wquant_block<true>(F.in[I_WIN], NIN, WSP(unsigned char, WS_WIN), WSP(float, WS_CS1), F.in[I_G1], it, F.wave, F.lane, (LAS float*)(F.lds + 8 * 8448)); }
    else { const int sp = VG >= 64 ? VG / 64 : 1;
           for (int v = vb; v < sp * (D / 32); v += VG) {
               if (v % sp == 0) p0_wquant_block<false>(F.in[I_WQ], D, WSP(unsigned char, WS_WQ), WSP(float, WS_CSQ), nullptr, v / sp, F.wave, F.lane, (LAS float*)(F.lds + 8 * 8448));
               if (v % sp == sp / 2) p0_wquant_block<false>(F.in[I_WOUT], D, WSP(unsigned char, WS_WOUT), WSP(float, WS_CSO), nullptr, v / sp, F.wave, F.lane, (LAS float*)(F.lds + 8 * 8448)); } }
    if (PART == 0) {
    { v4u* z = (v4u*)(WSP(unsigned char, WS_WIN) + (size_t)NIN * D); const int nz = (NINP - NIN) * D / 16; for (int i = gt; i < nz; i += NGT) z[i] = (v4u){0u, 0u, 0u, 0u};
      for (int i = gt; i < NINP - NIN; i += NGT) WSP(float, WS_CS1)[NIN + i] = 0.f; }
    p0_small_transpose(F.in[I_W2], WSP(bf16, WS_W2T), 1, 64, 1024, gt, NGT);
    p0_small_transpose(F.in[I_A2], WSP(bf16, WS_A2T), 1, 64, 1024, gt, NGT);
    p0_small_transpose(F.in[I_G2], WSP(bf16, WS_G2T), 1, 160, 1024, gt, NGT);
    p0_small_transpose(F.in[I_WA], WSP(bf16, WS_WAT), 8, 128, 128, gt, NGT);
    p0_small_transpose(F.in[I_WI], WSP(bf16, WS_WIT), 8, 128, 128, gt, NGT);
    { const float* s = F.in[I_KEYS]; bf16* d = WSP(bf16, WS_KEYS); for (int i = gt; i < 8 * 2 * 128 * 128 / 8; i += NGT) { const f32x4 a = *(const f32x4*)(s + (size_t)i * 8), b = *(const f32x4*)(s + (size_t)i * 8 + 4);
        v4u o; o.x = pk2(a[0], a[1]); o.y = pk2(a[2], a[3]); o.z = pk2(b[0], b[1]); o.w = pk2(b[2], b[3]); *(v4u*)(d + (size_t)i * 8) = o; } }
    }
    if (PART == 0) {
    { const float* x = F.in[I_X]; unsigned char* xq = (unsigned char*)F.out + OUT_X8; float* rs1 = WSP(float, WS_RSTD1); float* sx0 = WSP(float, WS_SX0);
#define XR_LOAD(V_, row_) do { _Pragma("unroll") for (int hh_ = 0; hh_ < 2; ++hh_) _Pragma("unroll") for (int q_ = 0; q_ < 4; ++q_) V_[hh_][q_] = *(const f32x4*)(x + (size_t)(row_) * D + hh_ * 1024 + F.lane * 16 + q_ * 4); } while (0)
#define XR_QUANT(V_, row_) do { float s_ = 0.f, am_ = 0.f; \
          _Pragma("unroll") for (int hh_ = 0; hh_ < 2; ++hh_) _Pragma("unroll") for (int q_ = 0; q_ < 4; ++q_) _Pragma("unroll") for (int e_ = 0; e_ < 4; ++e_) { const float t_ = V_[hh_][q_][e_]; s_ += t_ * t_; am_ = fmaxf(am_, fabsf(t_)); } \
          s_ = wave_sum(s_); \
          _Pragma("unroll") for (int o_ = 1; o_ < 64; o_ <<= 1) am_ = fmaxf(am_, __shfl_xor(am_, o_)); \
          const float xq_ = am_ > 0.f ? 127.0f / am_ : 0.f; \
          if (F.lane == 0) { rs1[row_] = am_ * (1.0f / 127.0f) / sqrtf(s_ * (1.0f / D) + NORM_EPS); sx0[row_] = am_ * (1.0f / 127.0f); } \
          _Pragma("unroll") for (int hh_ = 0; hh_ < 2; ++hh_) { v4u o_; \
              _Pragma("unroll") for (int q_ = 0; q_ < 4; ++q_) { unsigned w_ = 0u; \
                  _Pragma("unroll") for (int e_ = 0; e_ < 4; ++e_) { const int qi_ = (int)rintf(V_[hh_][q_][e_] * xq_); w_ |= ((unsigned)qi_ & 0xFFu) << (8 * e_); } \
                  o_[q_] = w_; } \
              *(v4u*)(xq + (size_t)(row_) * D + hh_ * 1024 + F.lane * 16) = o_; } } while (0)
      for (int m = gw; m < T; m += 2 * NGW) { const int mB = m + NGW < T ? m + NGW : m;
          f32x4 xa[2][4], xb2[2][4];
          XR_LOAD(xa, m); XR_LOAD(xb2, mB);
          XR_QUANT(xa, m);
          if (mB != m) XR_QUANT(xb2, mB); }
#undef XR_LOAD
#undef XR_QUANT
    }
    }
}

typedef float f32x2c __attribute__((ext_vector_type(2)));
__device__ __forceinline__ unsigned cvtpk(float lo, float hi) { const f32x2c v = {lo, hi}; const bf16x2_t b = __builtin_convertvector(v, bf16x2_t); return __builtin_bit_cast(unsigned, b); }
__device__ __forceinline__ float rcpf_(float x) { return __builtin_amdgcn_rcpf(x); }
__device__ __forceinline__ float sigmoid_fast(float x) { return rcpf_(1.0f + __expf(-x)); }
__device__ __forceinline__ float tanh_fast(float x) { return 1.0f - 2.0f * rcpf_(1.0f + __expf(2.0f * x)); }
__device__ __forceinline__ float softplus_fast(float z) { return fmaxf(z, 0.f) + __logf(1.0f + __expf(-fabsf(z))); }
__device__ __forceinline__ float gelu_fast(float x) { const float u = 0.7978845608028654f * (x + 0.044715f * x * x * x); return x * rcpf_(1.0f + __expf(-2.0f * u)); }
__device__ __forceinline__ void rwkv_prep_unit(const Frame& F, int chunk, int h, int lane, const LAS bf16* WL2, const LAS bf16* AL2, const LAS bf16* GL2, const LAS float* CW, LAS bf16* ST) {
    asm volatile("" : "+v"(lane));
    const int fr = lane & 15, fq = lane >> 4;
    const bf16* PROJ = WSP(bf16, WS_PROJ); const bf16* LA = WSP(bf16, WS_LA);
    bf16* TA = WSP(bf16, WS_TA); bf16* TB = WSP(bf16, WS_TB); bf16* TK = WSP(bf16, WS_TK); bf16* TR = WSP(bf16, WS_TR);
    bf16* TV = (bf16*)F.out + OUT_TV / 2; bf16* TG = (bf16*)F.out + OUT_TG / 2; float* PCG = F.out + OUT_PC / 4; float* BONG = F.out + OUT_BON / 4;
#define PU4(w_) ((f32x4){bf_lo((w_).x), bf_hi((w_).x), bf_lo((w_).y), bf_hi((w_).y)})
    size_t tokm[2];
#pragma unroll
    for (int mt = 0; mt < 2; ++mt) tokm[mt] = (size_t)chunk * 32 + mt * 16 + fr;
    v2u cA[4][3], cB[4][3], eA[4][3];
    const bool hs = (chunk & 63) != 0; const unsigned hsm = hs ? 0xffffffffu : 0u; const size_t toke = (size_t)chunk * 32 - (hs ? 1 : 0);
#define PREP_LOAD_MT(C_, tok_) do { _Pragma("unroll") for (int nt_ = 0; nt_ < 4; ++nt_) { const bf16* pr_ = PROJ + (tok_) * NINP + PC_R + h * 64 + nt_ * 16 + fq * 4; \
        _Pragma("unroll") for (int q_ = 0; q_ < 3; ++q_) C_[nt_][q_] = *(const v2u*)(pr_ + q_ * 1024); } } while (0)
#define DPPU(old_, src_, ctl_) ((unsigned)__builtin_amdgcn_update_dpp((int)(old_), (int)(src_), ctl_, 0xf, 0xf, false))
#define PREP_PREV(dst_, mt_, nt_, q_) do { const v2u c_ = (mt_) ? cB[nt_][q_] : cA[nt_][q_]; v2u o_; \
        if (mt_) { o_.x = DPPU(0, cA[nt_][q_].x, 0x121); o_.y = DPPU(0, cA[nt_][q_].y, 0x121); } else { o_.x = eA[nt_][q_].x & hsm; o_.y = eA[nt_][q_].y & hsm; } \
        dst_.x = DPPU(o_.x, c_.x, 0x111); dst_.y = DPPU(o_.y, c_.y, 0x111); } while (0)
    PREP_LOAD_MT(cA, tokm[0]); PREP_LOAD_MT(eA, toke);
    bf16x8 la[9];
#pragma unroll
    for (int ks = 0; ks < 9; ++ks) la[ks] = *(const bf16x8*)(LA + tokm[0] * 288 + ks * 32 + 8 * fq);
    PREP_LOAD_MT(cB, tokm[1]);
    float inv[2], bn[2];
#pragma unroll
    for (int mt = 0; mt < 2; ++mt) { float s2 = 0.f;
#pragma unroll
        for (int nt = 0; nt < 4; ++nt) { const int j4 = nt * 16 + fq * 4;
            const v2u kc = mt ? cB[nt][1] : cA[nt][1]; v2u kp; PREP_PREV(kp, mt, nt, 1);
            const f32x4 c_kk = *(const LAS f32x4*)(CW + 128 + j4), m_k = *(const LAS f32x4*)(CW + 384 + j4);
            const f32x4 kcf = PU4(kc); const f32x4 ku = (kcf + (PU4(kp) - kcf) * m_k) * c_kk; s2 += (ku[0] * ku[0] + ku[1] * ku[1]) + (ku[2] * ku[2] + ku[3] * ku[3]); }
        { auto x = __builtin_amdgcn_permlane16_swap(__float_as_uint(s2), __float_as_uint(s2), false, false); s2 = __uint_as_float(x[0]) + __uint_as_float(x[1]); }
        { auto x = __builtin_amdgcn_permlane32_swap(__float_as_uint(s2), __float_as_uint(s2), false, false); s2 = __uint_as_float(x[0]) + __uint_as_float(x[1]); }
        inv[mt] = __builtin_amdgcn_rsqf(fmaxf(s2, 1e-24f)); bn[mt] = 0.f; }
    f32x4 tot0[4];
#pragma unroll
    for (int n = 0; n < 4; ++n) tot0[n] = (f32x4){0.f, 0.f, 0.f, 0.f};
#pragma unroll
    for (int st = 0; st < 8; ++st) { const int mt = st >> 2, nt = st & 3; const int j4 = nt * 16 + fq * 4; const size_t col = (size_t)h * 64 + j4;
        v2u cur_[3], prv_[3];
#pragma unroll
        for (int q = 0; q < 3; ++q) { cur_[q] = mt ? cB[nt][q] : cA[nt][q]; PREP_PREV(prv_[q], mt, nt, q); }
        f32x4 cw = (f32x4){0.f, 0.f, 0.f, 0.f}, ca = cw, cg = cw;
#pragma unroll
        for (int ks = 0; ks < 2; ++ks) { cw = MFMA16(*(const LAS bf16x8*)(WL2 + (nt * 16 + fr) * 72 + ks * 32 + 8 * fq), la[ks], cw); ca = MFMA16(*(const LAS bf16x8*)(AL2 + (nt * 16 + fr) * 72 + ks * 32 + 8 * fq), la[2 + ks], ca); }
#pragma unroll
        for (int ks = 0; ks < 5; ++ks) cg = MFMA16(*(const LAS bf16x8*)(GL2 + (nt * 16 + fr) * 168 + ks * 32 + 8 * fq), la[4 + ks], cg);
        if (st == 3) {
#pragma unroll
            for (int ks = 0; ks < 9; ++ks) la[ks] = *(const bf16x8*)(LA + tokm[1] * 288 + ks * 32 + 8 * fq); }
        const f32x4 c_w0 = *(const LAS f32x4*)(CW + j4), c_a0 = *(const LAS f32x4*)(CW + 64 + j4), c_kk = *(const LAS f32x4*)(CW + 128 + j4), c_ka = *(const LAS f32x4*)(CW + 192 + j4), c_rk = *(const LAS f32x4*)(CW + 256 + j4);
        const f32x4 m_r = *(const LAS f32x4*)(CW + 320 + j4), m_k = *(const LAS f32x4*)(CW + 384 + j4), m_v = *(const LAS f32x4*)(CW + 448 + j4);
        const v2u rp = prv_[0], kp = prv_[1], vp = prv_[2];
        const f32x4 rcf = PU4(cur_[0]), kcf = PU4(cur_[1]), vcf = PU4(cur_[2]);
        const f32x4 rr = rcf + (PU4(rp) - rcf) * m_r, kv = kcf + (PU4(kp) - kcf) * m_k, vv = vcf + (PU4(vp) - vcf) * m_v;
        f32x4 nau, bbu, km, cum;
#pragma unroll
        for (int r = 0; r < 4; ++r) { const float av = sigmoid_fast(c_a0[r] + ca[r]), ku = kv[r] * c_kk[r]; km[r] = kv[r] * (1.0f + (av - 1.0f) * c_ka[r]);
            cum[r] = -0.6065306597126334f * sigmoid_fast(c_w0[r] + cw[r]);
            nau[r] = -ku; bbu[r] = ku * av; bn[mt] += rr[r] * km[r] * c_rk[r]; }
        f32x4 at4, rt4, bt4, kt4, ep4;
#pragma unroll
        for (int r = 0; r < 4; ++r) { float v = cum[r];
            v += __builtin_bit_cast(float, __builtin_amdgcn_update_dpp(0, __builtin_bit_cast(int, v), 0x111, 0xf, 0xf, true));
            v += __builtin_bit_cast(float, __builtin_amdgcn_update_dpp(0, __builtin_bit_cast(int, v), 0x112, 0xf, 0xf, true));
            v += __builtin_bit_cast(float, __builtin_amdgcn_update_dpp(0, __builtin_bit_cast(int, v), 0x114, 0xf, 0xf, true));
            v += __builtin_bit_cast(float, __builtin_amdgcn_update_dpp(0, __builtin_bit_cast(int, v), 0x118, 0xf, 0xf, true));
            if (mt == 0) tot0[nt][r] = __shfl(v, (lane & 48) | 15); else v += tot0[nt][r];
            const float ep = __expf(v), em = rcpf_(ep);
            float eprev = __builtin_bit_cast(float, __builtin_amdgcn_update_dpp(0, __builtin_bit_cast(int, ep), 0x111, 0xf, 0xf, true));
            if (fr == 0) eprev = mt ? __expf(tot0[nt][r]) : 1.0f;
            at4[r] = nau[r] * inv[mt] * eprev; rt4[r] = rr[r] * ep; bt4[r] = bbu[r] * inv[mt] * em; kt4[r] = km[r] * em; ep4[r] = ep; }
        { LAS bf16* sp = ST + fr * 64 + j4; v2u w;
          w.x = cvtpk(at4[0], at4[1]); w.y = cvtpk(at4[2], at4[3]); *(LAS v2u*)(sp) = w;
          w.x = cvtpk(rt4[0], rt4[1]); w.y = cvtpk(rt4[2], rt4[3]); *(LAS v2u*)(sp + 1024) = w;
          w.x = cvtpk(bt4[0], bt4[1]); w.y = cvtpk(bt4[2], bt4[3]); *(LAS v2u*)(sp + 2048) = w;
          w.x = cvtpk(kt4[0], kt4[1]); w.y = cvtpk(kt4[2], kt4[3]); *(LAS v2u*)(sp + 3072) = w;
          w.x = cvtpk(vv[0], vv[1]); w.y = cvtpk(vv[2], vv[3]); *(LAS v2u*)(sp + 4096) = w;
          w.x = cvtpk(cg[0], cg[1]); w.y = cvtpk(cg[2], cg[3]); *(LAS v2u*)(sp + 5120) = w; }
        if (nt == 3) {
            bf16* const dstp[6] = {TA, TR, TB, TK, TV, TG};
#pragma unroll
            for (int a6 = 0; a6 < 6; ++a6)
#pragma unroll
                for (int hrow = 0; hrow < 2; ++hrow) { const int row = hrow * 8 + (lane >> 3), c8 = (lane & 7) * 8;
                    const v4u pv = *(const LAS v4u*)(ST + a6 * 1024 + row * 64 + c8);
                    *(v4u*)(dstp[a6] + ((size_t)chunk * 32 + mt * 16 + row) * 1024 + (size_t)h * 64 + c8) = pv; } }
        if (mt == 1 && fr == 15) *(f32x4*)(PCG + (size_t)chunk * 1024 + col) = ep4;
    }
#undef PREP_LOAD_MT
#undef PREP_PREV
#undef DPPU
#undef PU4
#pragma unroll
    for (int mt = 0; mt < 2; ++mt) { float b2 = bn[mt];
        { auto x = __builtin_amdgcn_permlane16_swap(__float_as_uint(b2), __float_as_uint(b2), false, false); b2 = __uint_as_float(x[0]) + __uint_as_float(x[1]); }
        { auto x = __builtin_amdgcn_permlane32_swap(__float_as_uint(b2), __float_as_uint(b2), false, false); b2 = __uint_as_float(x[0]) + __uint_as_float(x[1]); }
        if (fq == 0) BONG[tokm[mt] * 16 + h] = b2; }
}
__device__ __forceinline__ void rwkv_prep_phase(const Frame& F) {
    LAS bf16* WL2 = (LAS bf16*)(F.lds + 0); LAS bf16* AL2 = (LAS bf16*)(F.lds + 9216); LAS bf16* GL2 = (LAS bf16*)(F.lds + 18432); LAS float* CW = (LAS float*)(F.lds + 39936);
    int hcur = -1;
    for (int u = F.bid; u < 1024; u += F.G) { const int h = u & 15, cg = u >> 4;
        if (h != hcur) { hcur = h; __syncthreads();
            int tid_ = F.tid; asm volatile("" : "+v"(tid_));
            const bf16* w2t = WSP(bf16, WS_W2T) + (size_t)h * 64 * 64; const bf16* a2t = WSP(bf16, WS_A2T) + (size_t)h * 64 * 64; const bf16* g2t = WSP(bf16, WS_G2T) + (size_t)h * 64 * 160;
            { const int r = tid_ >> 3, c = (tid_ & 7) * 8; *(LAS v4u*)(WL2 + r * 72 + c) = *(const v4u*)(w2t + r * 64 + c); *(LAS v4u*)(AL2 + r * 72 + c) = *(const v4u*)(a2t + r * 64 + c); }
            for (int i = tid_; i < 64 * 20; i += NTHR) { const int r = i / 20, c = (i - r * 20) * 8; *(LAS v4u*)(GL2 + r * 168 + c) = *(const v4u*)(g2t + r * 160 + c); }
            { const int q = tid_ >> 6, jj = tid_ & 63; const float* src = q == 0 ? F.in[I_W0] : (q == 1 ? F.in[I_A0] : (q == 2 ? F.in[I_KK] : (q == 3 ? F.in[I_KA] : (q == 4 ? F.in[I_RK] : F.in[I_MU] + (q - 5) * 1024)))); CW[q * 64 + jj] = src[h * 64 + jj]; }
            __syncthreads(); }
        rwkv_prep_unit(F, cg * 8 + F.wave, h, F.lane, WL2, AL2, GL2, CW, (LAS bf16*)(F.lds + 43008 + F.wave * 12288)); }
    __syncthreads();
}
typedef short v4i16_t __attribute__((ext_vector_type(4)));
__device__ __forceinline__ bf16x8 frag_tr16(const LAS bf16* p, int ld) {
    const v4i16_t a = __builtin_amdgcn_ds_read_tr16_b64_v4i16((LAS v4i16_t*)p), b = __builtin_amdgcn_ds_read_tr16_b64_v4i16((LAS v4i16_t*)(p + 4 * ld));
    return (bf16x8){a[0], a[1], a[2], a[3], b[0], b[1], b[2], b[3]};
}
#define RD_LOAD(src_, act_, row0_, j_) do { const float* tp_ = (src_) + ((act_) ? ((size_t)((row0_) + ((j_) >> 1)) * D + ((j_) & 1) * 1024) : (size_t)0) + lane * 16; \
        _Pragma("unroll") for (int q_ = 0; q_ < 4; ++q_) th[q_] = *(const f32x4*)(tp_ + q_ * 4); } while (0)
#define RD_PACK(dst_, v_, tq_) do { _Pragma("unroll") for (int q_ = 0; q_ < 4; ++q_) {   \
            const unsigned b0_ = __float_as_uint(__builtin_fmaf(v_[q_][0], tq_, 12582912.0f)), b1_ = __float_as_uint(__builtin_fmaf(v_[q_][1], tq_, 12582912.0f)); \
            const unsigned b2_ = __float_as_uint(__builtin_fmaf(v_[q_][2], tq_, 12582912.0f)), b3_ = __float_as_uint(__builtin_fmaf(v_[q_][3], tq_, 12582912.0f)); \
            dst_[q_] = __builtin_amdgcn_perm(b1_, b0_, 0x0c0c0400u) | __builtin_amdgcn_perm(b3_, b2_, 0x04000c0cu); } } while (0)
#define RD_CONSUME(dstb_, scb_, row0_, j_) do { float am_ = 0.f; \
        _Pragma("unroll") for (int q_ = 0; q_ < 4; ++q_) _Pragma("unroll") for (int e_ = 0; e_ < 4; ++e_) am_ = fmaxf(am_, fabsf(th[q_][e_])); \
        if (((j_) & 1) == 0) { _Pragma("unroll") for (int q_ = 0; q_ < 4; ++q_) tk[q_] = th[q_]; tkm = am_; } \
        else { am_ = fmaxf(am_, tkm); \
            am_ = fmaxf(am_, dppf<0xB1>(am_)); am_ = fmaxf(am_, dppf<0x4E>(am_)); am_ = fmaxf(am_, dppf<0x141>(am_)); am_ = fmaxf(am_, dppf<0x140>(am_)); \
            { auto s_ = __builtin_amdgcn_permlane16_swap(__float_as_uint(am_), __float_as_uint(am_), false, false); am_ = fmaxf(__uint_as_float(s_[0]), __uint_as_float(s_[1])); } \
            { auto s_ = __builtin_amdgcn_permlane32_swap(__float_as_uint(am_), __float_as_uint(am_), false, false); am_ = fmaxf(__uint_as_float(s_[0]), __uint_as_float(s_[1])); } \
            const float tq_ = am_ > 0.f ? 127.0f / am_ : 0.f; const size_t ro_ = (size_t)((row0_) + ((j_) >> 1)); \
            if (lane == 0) (scb_)[ro_] = am_ * (1.0f / 127.0f); \
            v4u o0_, o1_; RD_PACK(o0_, tk, tq_); RD_PACK(o1_, th, tq_); \
            *(v4u*)((dstb_) + ro_ * D + lane * 16) = o0_; *(v4u*)((dstb_) + ro_ * D + 1024 + lane * 16) = o1_; } } while (0)
__device__ __forceinline__ void rwkv_item(const Frame& F, int item) {
    const int b = item >> 4, h = item & 15, wave = F.wave; int tid = F.tid; asm volatile("" : "+v"(tid)); const int lane = tid & 63;
    LAS unsigned char* L = F.lds;
    constexpr int LD64 = 72, LD32 = 40, E0 = 73216;
    LAS bf16* AT = (LAS bf16*)(L + 0);  LAS bf16* BT_ = (LAS bf16*)(L + 4608); LAS bf16* KT_ = (LAS bf16*)(L + 9216); LAS bf16* RT = (LAS bf16*)(L + 13824);
    LAS bf16* VS2 = (LAS bf16*)(L + 18432);
    LAS bf16* GGB2 = (LAS bf16*)(L + 27648);
    LAS bf16* S0B = (LAS bf16*)(L + 36864);
    LAS float* YB2 = (LAS float*)(L + 55296);
    LAS float* BON2 = (LAS float*)(L + 72704);
    LAS float* PC = (LAS float*)(L + 72960);
    LAS bf16* AAK = (LAS bf16*)(L + E0); LAS bf16* ARB = (LAS bf16*)(L + E0 + 2560); LAS bf16* ARK = (LAS bf16*)(L + E0 + 5120);
    LAS bf16* MINV = (LAS bf16*)(L + E0 + 7680);
    LAS bf16* RHS = (LAS bf16*)(L + E0 + 23040);
    LAS bf16* SAB = (LAS bf16*)(L + E0 + 28160);
    static_assert(E0 + 33280 <= LDSCTL_OFF, "rwkv LDS map");
    bf16* Y = WSP(bf16, WS_Y);
#define FRAG(base, row0, ld, ks) (*(const LAS bf16x8*)((base) + ((row0) + fr) * (ld) + (ks) * 32 + 8 * fq))
#define FRAGT(base, col0, ld) frag_tr16((base) + (8 * fq + (fr >> 2)) * (ld) + (col0) + 4 * (fr & 3), (ld))
    const int tt = tid >> 4, j0 = (tid & 15) * 4, hc = h * 64 + j0;
    const f32x4 plw = *(const f32x4*)(F.in[I_LNW] + hc), plb = *(const f32x4*)(F.in[I_LNB] + hc);
    const int lr = (tid & 255) >> 3, lc8 = tid & 7; const bool hi2 = tid >= 256;
    const bf16* srcA[3] = { (hi2 ? WSP(bf16, WS_TR) : WSP(bf16, WS_TA)), (hi2 ? WSP(bf16, WS_TK) : WSP(bf16, WS_TB)), (hi2 ? (const bf16*)F.out + OUT_TG / 2 : (const bf16*)F.out + OUT_TV / 2) };
    const size_t poff = ((size_t)b * SEQ + lr) * 1024 + h * 64 + lc8 * 8;
    const float* PCG = F.out + OUT_PC / 4 + (size_t)(b * 64) * 1024 + h * 64; const float* BONG = F.out + OUT_BON / 4 + (size_t)b * SEQ * 16 + h;
    v4u pl_[3]; float ppc = 0.f, pbn = 0.f;
#define RWKV_PREFETCH(tl_) do { _Pragma("unroll") for (int q_ = 0; q_ < 3; ++q_) pl_[q_] = *(const v4u*)(srcA[q_] + poff + (size_t)(tl_) * 32 * 1024); \
        ppc = PCG[(size_t)(tl_) * 1024 + (tid & 63)]; pbn = BONG[((size_t)(tl_) * 32 + (tid & 31)) * 16]; } while (0)
    const int ib = wave >> 1, tb = wave & 1, i0 = ib * 16, t0m = tb * 16;
    f32x4 sacc[2], yacc;
    sacc[0] = (f32x4){0.f, 0.f, 0.f, 0.f}; sacc[1] = sacc[0]; yacc = sacc[0];
    for (int u = tid; u < 2 * 64 * LD64 / 2; u += NTHR) ((LAS unsigned*)S0B)[u] = 0u;
    RWKV_PREFETCH(0);
    __syncthreads();
    for (int tl = 0; tl <= SEQ / 32; ++tl) {
        const int cur = tl & 1;
        int lane_c = lane; asm volatile("" : "+v"(lane_c)); const int fr = lane_c & 15, fq = lane_c >> 4;
        LAS bf16* VS = VS2 + cur * 32 * LD64; LAS bf16* GGB = GGB2 + cur * 32 * LD64; LAS float* YB = YB2 + cur * 32 * 68; LAS float* BON = BON2 + cur * 32;
        const LAS bf16* VSp = VS2 + (cur ^ 1) * 32 * LD64; const LAS bf16* GGBp = GGB2 + (cur ^ 1) * 32 * LD64; const LAS float* YBp = YB2 + (cur ^ 1) * 32 * 68; const LAS float* BONp = BON2 + (cur ^ 1) * 32;
        if (tl > 0) { const size_t tokb = (size_t)b * SEQ + (tl - 1) * 32;
          const f32x4 y4 = *(const LAS f32x4*)(YBp + tt * 68 + j0); const v2u gw_ = *(const LAS v2u*)(GGBp + tt * LD64 + j0);
          const f32x4 g4 = (f32x4){bf_lo(gw_.x), bf_hi(gw_.x), bf_lo(gw_.y), bf_hi(gw_.y)};
          const v2u vw_ = *(const LAS v2u*)(VSp + tt * LD64 + j0); const f32x4 v4 = (f32x4){bf_lo(vw_.x), bf_hi(vw_.x), bf_lo(vw_.y), bf_hi(vw_.y)};
          float sm = (y4[0] + y4[1]) + (y4[2] + y4[3]); sm = red16(sm); const float mean = sm * (1.0f / 64.0f);
          const f32x4 d4 = y4 - mean; float sv = (d4[0] * d4[0] + d4[1] * d4[1]) + (d4[2] * d4[2] + d4[3] * d4[3]); sv = red16(sv);
          const float rstd = __builtin_amdgcn_rsqf(sv * (1.0f / 64.0f) + GN_EPS), bon = BONp[tt];
          f32x4 o;
#pragma unroll
          for (int e = 0; e < 4; ++e) o[e] = (d4[e] * rstd * plw[e] + plb[e] + bon * v4[e]) * g4[e];
          v2u w; w.x = cvtpk(o[0], o[1]); w.y = cvtpk(o[2], o[3]);
          *(v2u*)(Y + (tokb + tt) * D + 1024 + hc) = w; }
        if (tl == SEQ / 32) break;
        const LAS bf16* S0c = S0B + cur * 64 * LD64; LAS bf16* S0n = S0B + (cur ^ 1) * 64 * LD64;
        { const v4u p0 = pl_[0], p1 = pl_[1], p2 = pl_[2];
          *(LAS v4u*)((hi2 ? RT : AT) + lr * LD64 + lc8 * 8) = p0;
          *(LAS v4u*)((hi2 ? KT_ : BT_) + lr * LD64 + lc8 * 8) = p1;
          *(LAS v4u*)((hi2 ? GGB : VS) + lr * LD64 + lc8 * 8) = p2;
          if (tid < 64) PC[tid] = ppc;
          if (tid >= 64 && tid < 96) BON[tid - 64] = pbn; }
        { const int tn_ = tl + 1 < SEQ / 32 ? tl + 1 : SEQ / 32 - 1; RWKV_PREFETCH(tn_); }
        __syncthreads();
        f32x4 rhs4 = (f32x4){0.f, 0.f, 0.f, 0.f};
#define RWKV_FIRST do { rhs4 = (f32x4){0.f, 0.f, 0.f, 0.f}; yacc = (f32x4){0.f, 0.f, 0.f, 0.f}; \
            _Pragma("unroll") for (int ks = 0; ks < 2; ++ks) rhs4 = MFMA16(FRAG(AT, t0m, LD64, ks), FRAG(S0c, i0, LD64, ks), rhs4); \
            _Pragma("unroll") for (int ks = 0; ks < 2; ++ks) yacc = MFMA16(FRAG(S0c, i0, LD64, ks), FRAG(RT, t0m, LD64, ks), yacc); \
            _Pragma("unroll") for (int u = 0; u < 2; ++u) { const int tile = wave * 2 + u, si0 = (tile >> 2) * 16, sj0 = (tile & 3) * 16; sacc[u] = MFMA16(FRAGT(KT_, sj0, LD64), FRAGT(VS, si0, LD64), sacc[u]); } } while (0)
#define PK8(a_, s_) __builtin_bit_cast(bf16x8, (v4u){cvtpk(a_[8 * (s_) + 0], a_[8 * (s_) + 1]), cvtpk(a_[8 * (s_) + 2], a_[8 * (s_) + 3]), cvtpk(a_[8 * (s_) + 4], a_[8 * (s_) + 5]), cvtpk(a_[8 * (s_) + 6], a_[8 * (s_) + 7])})
        if (wave == 0) {
            const int c32 = lane_c & 31, h32 = lane_c >> 5;
            f32x16 U, V, PT;
#pragma unroll
            for (int e = 0; e < 16; ++e) { U[e] = 0.f; V[e] = 0.f; }
#pragma unroll
            for (int ks = 0; ks < 4; ++ks) { const bf16x8 fa = *(const LAS bf16x8*)(AT + c32 * LD64 + ks * 16 + h32 * 8), fb = *(const LAS bf16x8*)(BT_ + c32 * LD64 + ks * 16 + h32 * 8);
                U = MFMA32(fa, fb, U);
                V = MFMA32(fb, fa, V); }
#pragma unroll
            for (int e = 0; e < 16; ++e) { const int rr = (e & 3) + 8 * (e >> 2) + 4 * h32;
                U[e] = (c32 < rr) ? U[e] : 0.f;
                V[e] = (rr < c32) ? V[e] : 0.f;
                PT[e] = V[e] + ((rr == c32) ? 1.0f : 0.f); }
#pragma unroll
            for (int st = 1; st <= 5; ++st) {
                const bf16x8 fU0 = PK8(U, 0), fU1 = PK8(U, 1);
                f32x16 Un, Vn;
#pragma unroll
                for (int e = 0; e < 16; ++e) { Un[e] = 0.f; Vn[e] = 0.f; }
                if (st < 5) { const bf16x8 fV0 = PK8(V, 0), fV1 = PK8(V, 1);
                    Un = MFMA32(fV0, fU0, Un); Un = MFMA32(fV1, fU1, Un);
                    if (st < 4) { Vn = MFMA32(fU0, fV0, Vn); Vn = MFMA32(fU1, fV1, Vn); } }
                if (st > 1) { const bf16x8 fP0 = PK8(PT, 0), fP1 = PK8(PT, 1);
                    PT = MFMA32(fU0, fP0, PT); PT = MFMA32(fU1, fP1, PT); }
                U = Un; V = Vn; }
#pragma unroll
            for (int q = 0; q < 4; ++q) { v2u w; w.x = cvtpk(PT[4 * q], PT[4 * q + 1]); w.y = cvtpk(PT[4 * q + 2], PT[4 * q + 3]); *(LAS v2u*)(MINV + c32 * LD32 + 8 * q + 4 * h32) = w; }
        } else {
            if (wave < 7) { const int mtx = (wave - 1) >> 1;
                const LAS bf16* Xs = (mtx == 1) ? BT_ : KT_; const LAS bf16* Yt = (mtx == 0) ? AT : RT; LAS bf16* O = (mtx == 0) ? AAK : (mtx == 1 ? ARB : ARK);
#pragma unroll
                for (int qq = 0; qq < 2; ++qq) { const int q = ((wave - 1) & 1) * 2 + qq, tq = (q >> 1) * 16, sq = (q & 1) * 16;
                    f32x4 a4 = (f32x4){0.f, 0.f, 0.f, 0.f};
                    if (sq <= tq) {
#pragma unroll
                        for (int ks = 0; ks < 2; ++ks) a4 = MFMA16(FRAG(Xs, sq, LD64, ks), FRAG(Yt, tq, LD64, ks), a4); }
                    const int t = tq + fr, s = sq + fq * 4;
#pragma unroll
                    for (int r = 0; r < 4; ++r) { const bool keep = (mtx == 0) ? (s + r < t) : (s + r <= t); a4[r] = keep ? a4[r] : 0.f; }
                    v2u w; w.x = cvtpk(a4[0], a4[1]); w.y = cvtpk(a4[2], a4[3]); *(LAS v2u*)(O + t * LD32 + s) = w; } }
            RWKV_FIRST;
        }
        __syncthreads();
        if (wave == 0) RWKV_FIRST;
        { rhs4 = MFMA16(FRAG(AAK, t0m, LD32, 0), FRAGT(VS, i0, LD64), rhs4);
          v2u w; w.x = cvtpk(rhs4[0], rhs4[1]); w.y = cvtpk(rhs4[2], rhs4[3]); *(LAS v2u*)(RHS + (i0 + fr) * LD32 + t0m + fq * 4) = w;
          yacc = MFMA16(FRAGT(VS, i0, LD64), FRAG(ARK, t0m, LD32, 0), yacc); }
        __syncthreads();
#undef RWKV_FIRST
#undef PK8
        { f32x4 a4 = (f32x4){0.f, 0.f, 0.f, 0.f}; a4 = MFMA16(FRAG(MINV, t0m, LD32, 0), FRAG(RHS, i0, LD32, 0), a4);
          v2u w; w.x = cvtpk(a4[0], a4[1]); w.y = cvtpk(a4[2], a4[3]); *(LAS v2u*)(SAB + (i0 + fr) * LD32 + t0m + fq * 4) = w; }
        __syncthreads();
        { yacc = MFMA16(FRAG(SAB, i0, LD32, 0), FRAG(ARB, t0m, LD32, 0), yacc);
          *(LAS f32x4*)(YB + (t0m + fr) * 68 + i0 + fq * 4) = yacc;
#pragma unroll
          for (int u = 0; u < 2; ++u) { const int tile = wave * 2 + u, si0 = (tile >> 2) * 16, sj0 = (tile & 3) * 16;
              sacc[u] = MFMA16(FRAGT(BT_, sj0, LD64), FRAG(SAB, si0, LD32, 0), sacc[u]);
              const f32x4 pc = *(const LAS f32x4*)(PC + sj0 + fq * 4); sacc[u] = sacc[u] * pc;
              v2u w; w.x = cvtpk(sacc[u][0], sacc[u][1]); w.y = cvtpk(sacc[u][2], sacc[u][3]); *(LAS v2u*)(S0n + (si0 + fr) * LD64 + sj0 + fq * 4) = w; } }
        __syncthreads();
    }
    __syncthreads();
#undef FRAG
#undef FRAGT
#undef RWKV_PREFETCH
}
__device__ __forceinline__ void lora_prepass(const Frame& F) {
    const bf16* PROJ = WSP(bf16, WS_PROJ); bf16* LA = WSP(bf16, WS_LA); const float* mu = F.in[I_MU] + (PC_WD - RWKV_C0);
    const int gt = (F.bid * NWAVES + F.wave) * 64 + F.lane, NGT = F.G * NTHR;
    constexpr int NIT = 5;
    for (int i0 = gt; i0 < T * 36; i0 += NIT * NGT) {
        v4u curv[NIT], prv[NIT]; int tokv[NIT], mv[NIT]; bool vl[NIT];
#pragma unroll
        for (int j = 0; j < NIT; ++j) { const int i = i0 + j * NGT; vl[j] = i < T * 36; const int ic = vl[j] ? i : i0; const int tok = ic / 36, m = (ic - tok * 36) * 8; tokv[j] = tok; mv[j] = m;
            const bf16* pr = PROJ + (size_t)tok * NINP + PC_WD + m; const bool hp = (tok & (SEQ - 1)) != 0;
            curv[j] = *(const v4u*)pr; const v4u pv = *(const v4u*)(pr - (hp ? NINP : 0)); const unsigned pm = hp ? 0xffffffffu : 0u; prv[j] = (v4u){pv.x & pm, pv.y & pm, pv.z & pm, pv.w & pm}; }
#pragma unroll
        for (int j = 0; j < NIT; ++j) { const int m = mv[j];
            const f32x4 m0 = *(const f32x4*)(mu + m), m1 = *(const f32x4*)(mu + m + 4);
            float c[8], p[8], o[8]; unpack8(curv[j], c); unpack8(prv[j], p);
#pragma unroll
            for (int e = 0; e < 8; ++e) { const float ps = c[e] + (p[e] - c[e]) * (e < 4 ? m0[e] : m1[e - 4]); o[e] = (m < 64) ? tanh_fast(ps) : ((m < 128) ? ps : sigmoid_fast(ps)); }
            v4u w; w.x = cvtpk(o[0], o[1]); w.y = cvtpk(o[2], o[3]); w.z = cvtpk(o[4], o[5]); w.w = cvtpk(o[6], o[7]);
            if (vl[j]) *(v4u*)(LA + (size_t)tokv[j] * 288 + m) = w; } }
}
__device__ __forceinline__ void lru_seq(const Frame& F, int item) {
    const int bh = item >> 1, hf = item & 1, b = bh >> 3, h = bh & 7, wave = F.wave; int tid = F.tid; asm volatile("" : "+v"(tid)); const int lane = tid & 63;
    constexpr int TT = 128, NTK = SEQ / TT;
    LAS unsigned char* L = F.lds;
    LAS bf16* XA = (LAS bf16*)(L + 0);
    LAS float* XC = (LAS float*)(L + 34816);
    LAS float* RI = (LAS float*)(L + 67584);
    LAS float* SEG = (LAS float*)(L + 133120);
    LAS float* CARRY = (LAS float*)(L + 137216);
    LAS float* CW = (LAS float*)(L + 137728);
    static_assert(137728 + 2560 <= LDSCTL_OFF, "lru LDS map");
    const bf16* PROJ = WSP(bf16, WS_PROJ); bf16* Y = WSP(bf16, WS_Y);
    const int fr0 = lane & 15, fq0 = lane >> 4;
    for (int i = tid; i < 640; i += NTHR) { const int w = i >> 7, cch = i & 127; CW[i] = (w < 4) ? F.in[I_CONVW][w * 1024 + h * 128 + cch] : F.in[I_CONVB][h * 128 + cch]; }
    if (tid < 128) CARRY[tid] = 0.f;
    const int gsel = wave & 1, ntl = wave >> 1, ntg = hf * 4 + ntl;
    bf16x8 wf[4];
    { const bf16* WTp = (gsel ? WSP(bf16, WS_WIT) : WSP(bf16, WS_WAT)) + (size_t)h * 128 * 128;
#pragma unroll
      for (int ks = 0; ks < 4; ++ks) wf[ks] = *(const bf16x8*)(WTp + (ntg * 16 + fr0) * 128 + ks * 32 + 8 * fq0); }
    const int c = tid & 63, sg = tid >> 6, chl = hf * 64 + c, chg = h * 128 + chl;
    const float ba_c = F.in[I_BA][chg], bi_c = F.in[I_BI][chg], sp8 = 8.0f * softplus_fast(-F.in[I_LAM][chg]);
    const int tq = tid >> 4, c8 = (tid & 15) * 8; const bool myhalf = ((tid & 15) >> 3) == hf;
    v4u pf[7];
#define LRU_PREFETCH(k_) do { _Pragma("unroll") for (int j_ = 0; j_ < 7; ++j_) { const int ts_ = (k_) * TT + 4 * tq - 3 + j_; const int tc_ = ts_ >= 0 ? ts_ : 0;   \
            const v4u x_ = *(const v4u*)(PROJ + ((size_t)b * SEQ + tc_) * NINP + h * 128 + c8); const unsigned m_ = ts_ >= 0 ? 0xffffffffu : 0u; \
            pf[j_] = (v4u){x_.x & m_, x_.y & m_, x_.z & m_, x_.w & m_}; } } while (0)
    unsigned short gtn[16];
#define LRU_GATES(k_) do { _Pragma("unroll") for (int e_ = 0; e_ < 16; ++e_) gtn[e_] = PROJ[((size_t)b * SEQ + (k_) * TT + sg * 16 + e_) * NINP + PC_GATE + chg]; } while (0)
    const int ttab = item >> 6, trow0 = ((item & 63) * 8 + wave) * 32;
    const float* tsrc = ttab ? F.in[I_V] : F.in[I_U]; unsigned char* tdst = ttab ? WSP(unsigned char, WS_VT) : WSP(unsigned char, WS_UT); float* tsc = ttab ? WSP(float, WS_VSC) : WSP(float, WS_USC);
    f32x4 th[4], tk[4]; float tkm = 0.f;
#pragma unroll
    for (int q = 0; q < 4; ++q) tk[q] = (f32x4){0.f, 0.f, 0.f, 0.f};
    LRU_PREFETCH(0); LRU_GATES(0);
    RD_LOAD(tsrc, true, trow0, 0);
    __syncthreads();
    for (int k = 0; k < NTK; ++k) {
        const size_t tokbase = (size_t)b * SEQ + k * TT;
        int lane_c = lane; asm volatile("" : "+v"(lane_c)); const int fr = lane_c & 15, fq = lane_c >> 4;
        { float xr[7][8];
#pragma unroll
          for (int j = 0; j < 7; ++j) unpack8(pf[j], xr[j]);
          const f32x4 b0 = *(const LAS f32x4*)(CW + 512 + c8), b1 = *(const LAS f32x4*)(CW + 512 + c8 + 4);
          f32x4 w0[4], w1[4];
#pragma unroll
          for (int w = 0; w < 4; ++w) { w0[w] = *(const LAS f32x4*)(CW + w * 128 + c8); w1[w] = *(const LAS f32x4*)(CW + w * 128 + c8 + 4); }
#pragma unroll
          for (int u = 0; u < 4; ++u) { const int t = 4 * tq + u; float acc[8];
#pragma unroll
              for (int e = 0; e < 4; ++e) { acc[e] = b0[e]; acc[e + 4] = b1[e]; }
#pragma unroll
              for (int w = 0; w < 4; ++w)
#pragma unroll
                  for (int e = 0; e < 4; ++e) { acc[e] += w0[w][e] * xr[u + w][e]; acc[e + 4] += w1[w][e] * xr[u + w][e + 4]; }
              v4u pk; pk.x = cvtpk(acc[0], acc[1]); pk.y = cvtpk(acc[2], acc[3]); pk.z = cvtpk(acc[4], acc[5]); pk.w = cvtpk(acc[6], acc[7]);
              *(LAS v4u*)(XA + t * 136 + c8) = pk;
              if (myhalf) { LAS float* d = XC + t * 64 + (c8 & 63); *(LAS f32x4*)d = (f32x4){acc[0], acc[1], acc[2], acc[3]}; *(LAS f32x4*)(d + 4) = (f32x4){acc[4], acc[5], acc[6], acc[7]}; } } }
        float gl[16];
#pragma unroll
        for (int e = 0; e < 16; ++e) gl[e] = gelu_fast(__uint_as_float((unsigned)gtn[e] << 16));
        { const int kn_ = k + 1 < NTK ? k + 1 : NTK - 1; LRU_PREFETCH(kn_); LRU_GATES(kn_); }
        RD_CONSUME(tdst, tsc, trow0, 4 * k);
        RD_LOAD(tsrc, true, trow0, 4 * k + 1);
        __syncthreads();
#pragma unroll
        for (int mt = 0; mt < TT / 16; ++mt) {
            bf16x8 af[4];
#pragma unroll
            for (int ks = 0; ks < 4; ++ks) af[ks] = *(const LAS bf16x8*)(XA + (mt * 16 + fr) * 136 + ks * 32 + 8 * fq);
            { f32x4 a4 = (f32x4){0.f, 0.f, 0.f, 0.f};
#pragma unroll
                for (int ks = 0; ks < 4; ++ks) a4 = MFMA16(wf[ks], af[ks], a4);
                *(LAS f32x4*)(RI + gsel * (TT * 64) + (mt * 16 + fr) * 64 + ntl * 16 + fq * 4) = a4; } }
        __syncthreads();
        RD_CONSUME(tdst, tsc, trow0, 4 * k + 1);
        RD_LOAD(tsrc, true, trow0, 4 * k + 2);
        float av[16], bx[16]; float A = 1.f, B = 0.f;
#pragma unroll
        for (int e = 0; e < 16; ++e) { const int t = sg * 16 + e; const float r = sigmoid_fast(RI[t * 64 + c] + ba_c), ig = sigmoid_fast(RI[TT * 64 + t * 64 + c] + bi_c), xc = XC[t * 64 + c];
            const float la = -sp8 * r; av[e] = __expf(la); bx[e] = sqrtf(fmaxf(1.0f - av[e] * av[e], 0.f)) * (ig * xc); A *= av[e]; B = av[e] * B + bx[e]; }
        SEG[(sg * 64 + c) * 2] = A; SEG[(sg * 64 + c) * 2 + 1] = B;
        RD_CONSUME(tdst, tsc, trow0, 4 * k + 2);
        RD_LOAD(tsrc, true, trow0, 4 * k + 3);
        __syncthreads();
        float hst = CARRY[(k & 1) * 64 + c];
        for (int s2 = 0; s2 < sg; ++s2) hst = SEG[(s2 * 64 + c) * 2] * hst + SEG[(s2 * 64 + c) * 2 + 1];
#pragma unroll
        for (int e = 0; e < 16; ++e) { hst = av[e] * hst + bx[e];
            Y[(tokbase + sg * 16 + e) * D + chg] = (bf16)(cvtpk(hst * gl[e], 0.f) & 0xffffu); }
        if (sg == 7) CARRY[((k + 1) & 1) * 64 + c] = hst;
        RD_CONSUME(tdst, tsc, trow0, 4 * k + 3);
        { const int kn_ = k + 1 < NTK ? k + 1 : NTK - 1; RD_LOAD(tsrc, true, trow0, 4 * kn_); }
    }
    __syncthreads();
#undef LRU_PREFETCH
#undef LRU_GATES
}
__device__ __forceinline__ void group_barrier(unsigned* cnt, unsigned n) {
    asm volatile("s_waitcnt vmcnt(0)" ::: "memory");
    __syncthreads();
    if (threadIdx.x == 0) {
        __builtin_amdgcn_fence(__ATOMIC_RELEASE, "agent");
        asm volatile("s_waitcnt vmcnt(0)" ::: "memory");
        xb_add(cnt, 1u);
        unsigned sp = 0; while (xb_ld(cnt) < n) { __builtin_amdgcn_s_sleep(2); if (++sp > (1u << 24)) break; }
        __builtin_amdgcn_fence(__ATOMIC_ACQUIRE, "agent");
        asm volatile("s_waitcnt vmcnt(0)" ::: "memory");
    }
    __syncthreads();
}

__device__ __forceinline__ unsigned f2ord(float f) { const unsigned u = __builtin_bit_cast(unsigned, f); return (u & 0x80000000u) ? ~u : (u | 0x80000000u); }
__device__ __forceinline__ float ord2f(unsigned o) { const unsigned u = (o & 0x80000000u) ? (o & 0x7fffffffu) : ~o; return __builtin_bit_cast(float, u); }
#define CMPX(hi_, lo_) do { const unsigned _a = (hi_), _b = (lo_); (hi_) = _a > _b ? _a : _b; (lo_) = _a > _b ? _b : _a; } while (0)
template <int N> __device__ __forceinline__ void sort_desc(unsigned (&a)[N]) {
#pragma unroll
    for (int k = 2; k <= N; k <<= 1)
#pragma unroll
        for (int j = k >> 1; j > 0; j >>= 1)
#pragma unroll
            for (int i = 0; i < N; ++i) { const int l = i ^ j; if (l > i) { if ((i & k) == 0) CMPX(a[i], a[l]); else CMPX(a[l], a[i]); } }
}
__device__ __forceinline__ void merge16(unsigned (&A)[16], const unsigned (&B)[16]) {
#pragma unroll
    for (int i = 0; i < 16; ++i) { const unsigned q = B[15 - i]; A[i] = A[i] > q ? A[i] : q; }
#pragma unroll
    for (int d = 8; d >= 1; d >>= 1)
#pragma unroll
        for (int i = 0; i < 16; ++i) if ((i & d) == 0) CMPX(A[i], A[i + d]);
}
__device__ __forceinline__ void merge_partner(unsigned (&Lk)[16]) {
    unsigned P[16];
#pragma unroll
    for (int i = 0; i < 16; ++i) P[i] = (unsigned)__shfl_xor((int)Lk[i], 32);
#pragma unroll
    for (int i = 0; i < 16; ++i) { const unsigned q = P[15 - i]; Lk[i] = Lk[i] > q ? Lk[i] : q; }
#pragma unroll
    for (int d = 8; d >= 1; d >>= 1)
#pragma unroll
        for (int i = 0; i < 16; ++i) if ((i & d) == 0) CMPX(Lk[i], Lk[i + d]);
}
__device__ __forceinline__ void route_item(const Frame& F, int item, int lane) {
    const int tok0 = (item >> 3) * 32, h = item & 7, c = lane & 31, hi = lane >> 5;
    const bf16* Q = WSP(bf16, WS_Q); const bf16* KB = WSP(bf16, WS_KEYS);
    LAS unsigned* WL = (LAS unsigned*)(F.lds + F.wave * 8192);
    unsigned LST[2][16];
    bf16x8 qf[8], qn[8], kf[8], kn[8];
#pragma unroll
    for (int ks = 0; ks < 8; ++ks) { qf[ks] = *(const bf16x8*)(Q + (size_t)(tok0 + c) * D + h * 256 + ks * 16 + 8 * hi); qn[ks] = *(const bf16x8*)(Q + (size_t)(tok0 + c) * D + h * 256 + 128 + ks * 16 + 8 * hi);
        kf[ks] = *(const bf16x8*)(KB + (size_t)((h * 2) * 128 + c) * 128 + 8 * hi + ks * 16); }
    unsigned Lk[16];
#pragma unroll
    for (int st = 0; st < 8; ++st) { const int p = st >> 2, m = st & 3;
        if (st < 7) { const int p2 = (st + 1) >> 2, m2 = (st + 1) & 3; const bf16* kp = KB + (size_t)((h * 2 + p2) * 128 + m2 * 32 + c) * 128 + 8 * hi;
#pragma unroll
            for (int ks = 0; ks < 8; ++ks) kn[ks] = *(const bf16x8*)(kp + ks * 16); }
        f32x16 acc;
#pragma unroll
        for (int r = 0; r < 16; ++r) acc[r] = 0.f;
#pragma unroll
        for (int ks = 0; ks < 8; ++ks) acc = MFMA32(kf[ks], p ? qn[ks] : qf[ks], acc);
        unsigned G16[16];
#pragma unroll
        for (int r = 0; r < 16; ++r) { const unsigned idx = (unsigned)(m * 32 + (r & 3) + 8 * (r >> 2)) | ((unsigned)hi << 2); G16[r] = (f2ord(acc[r]) & ~0x7Fu) | idx; }
        sort_desc<16>(G16);
        if (m == 0) {
#pragma unroll
            for (int i = 0; i < 16; ++i) Lk[i] = G16[i]; }
        else merge16(Lk, G16);
        if (m == 3) { merge_partner(Lk);
#pragma unroll
            for (int i = 0; i < 16; ++i) { LST[p][i] = Lk[i]; WL[(p * 16 + i) * 64 + lane] = Lk[i] & 0x7Fu; } }
#pragma unroll
        for (int ks = 0; ks < 8; ++ks) kf[ks] = kn[ks];
    }
    float va[4], vb[16];
#pragma unroll
    for (int i = 0; i < 4; ++i) va[i] = ord2f((hi ? LST[1][i] : LST[0][i]) & ~0x7Fu);
#pragma unroll
    for (int j = 0; j < 16; ++j) vb[j] = ord2f((hi ? LST[0][j] : LST[1][j]) & ~0x7Fu);
    unsigned C32[32];
#pragma unroll
    for (int i = 0; i < 32; ++i) C32[i] = 0u;
#pragma unroll
    for (int i = 0; i < 4; ++i) { const unsigned key = (f2ord(va[i] + vb[i]) & ~0xFFu) | (unsigned)(i * 17); C32[i] = hi ? 0u : key; }
    { int cn = 4;
#pragma unroll
      for (int i = 0; i < 3; ++i)
#pragma unroll
          for (int j = i + 1; j < 16; ++j) if ((i + 1) * (j + 1) <= 16) { const unsigned code = hi ? (unsigned)(j * 16 + i) : (unsigned)(i * 16 + j); C32[cn] = (f2ord(va[i] + vb[j]) & ~0xFFu) | code; ++cn; } }
    sort_desc<32>(C32);
    unsigned Ck[16];
#pragma unroll
    for (int i = 0; i < 16; ++i) Ck[i] = C32[i];
    merge_partner(Ck);
    const float mx = ord2f(Ck[0] & ~0xFFu); float den = 0.f;
#pragma unroll
    for (int k = 0; k < 16; ++k) den += __expf(ord2f(Ck[k] & ~0xFFu) - mx);
    const float rden = 1.0f / den;
    int eo[8]; float go[8];
#pragma unroll
    for (int k = 0; k < 8; ++k) { const unsigned fm = hi ? Ck[k + 8] : Ck[k]; const unsigned code = fm & 0xFFu;
        const unsigned k0 = WL[(code >> 4) * 64 + lane], k1 = WL[(16 + (code & 15u)) * 64 + lane];
        eo[k] = (int)(k0 * 128u + k1); go[k] = __expf(ord2f(fm & ~0xFFu) - mx) * rden; }
    unsigned short* ep = WSP(unsigned short, WS_EXP) + (size_t)(tok0 + c) * NSEL + h * 16 + hi * 8; float* gp = WSP(float, WS_GATE) + (size_t)(tok0 + c) * NSEL + h * 16 + hi * 8;
    *(v4u*)ep = (v4u){(unsigned)eo[0] | ((unsigned)eo[1] << 16), (unsigned)eo[2] | ((unsigned)eo[3] << 16), (unsigned)eo[4] | ((unsigned)eo[5] << 16), (unsigned)eo[6] | ((unsigned)eo[7] << 16)};
    *(f32x4*)gp = (f32x4){go[0], go[1], go[2], go[3]}; *(f32x4*)(gp + 4) = (f32x4){go[4], go[5], go[6], go[7]};
}

typedef float f32x2 __attribute__((ext_vector_type(2)));
__device__ __forceinline__ int dot4i(unsigned a, unsigned b, int c) { return __builtin_amdgcn_sdot4((int)a, (int)b, c, false); }
template <int CTRL> __device__ __forceinline__ int dppi(int x) { return __builtin_amdgcn_mov_dpp(x, CTRL, 0xf, 0xf, true); }
struct PeerGeom { int ngrp, g, rank, nrank; };
__device__ __forceinline__ PeerGeom peer_geom(const Frame& F) { PeerGeom p; p.ngrp = (F.G % 8 == 0) ? 8 : 1; p.g = F.bid % p.ngrp; p.rank = F.bid / p.ngrp; p.nrank = F.G / p.ngrp; return p; }
__device__ __forceinline__ void xquant_token(const Frame& F, int tok, int lane) {
    const bf16* xr = WSP(bf16, WS_XB) + (size_t)tok * D + lane * 16; float xf[32]; float am = 0.f, sq = 0.f;
#pragma unroll
    for (int hh = 0; hh < 2; ++hh)
#pragma unroll
        for (int q = 0; q < 2; ++q) { const v4u w = *(const v4u*)(xr + hh * 1024 + q * 8); float t8[8]; unpack8(w, t8);
            const f32x4 g0 = *(const f32x4*)(F.in[I_G2N] + hh * 1024 + lane * 16 + q * 8), g1 = *(const f32x4*)(F.in[I_G2N] + hh * 1024 + lane * 16 + q * 8 + 4);
#pragma unroll
            for (int e = 0; e < 8; ++e) { const float xg = t8[e] * (e < 4 ? g0[e & 3] : g1[e & 3]); xf[hh * 16 + q * 8 + e] = xg; am = fmaxf(am, fabsf(xg)); sq += t8[e] * t8[e]; } }
#pragma unroll
    for (int o = 1; o < 64; o <<= 1) am = fmaxf(am, __shfl_xor(am, o));
    sq = wave_sum(sq);
    const float qs = am > 0.f ? 127.0f / am : 0.f;
    if (lane == 0) { WSP(float, WS_SX)[tok] = am * (1.0f / 127.0f); WSP(float, WS_SSQ2)[tok] = sq; }
#pragma unroll
    for (int hh = 0; hh < 2; ++hh) { v4u o;
#pragma unroll
        for (int d = 0; d < 4; ++d) { unsigned w = 0u;
#pragma unroll
            for (int e = 0; e < 4; ++e) { const int qi = (int)rintf(xf[hh * 16 + d * 4 + e] * qs); w |= ((unsigned)qi & 0xFFu) << (8 * e); }
            o[d] = w; }
        *(v4u*)(WSP(unsigned char, WS_XQ) + (size_t)tok * D + hh * 1024 + lane * 16) = o; }
}
__device__ __forceinline__ void yquant_tokens(const Frame& F, int tokA, int tokB, int lane) {
    v4u ra[2][2], rb[2][2];
#pragma unroll
    for (int hh = 0; hh < 2; ++hh)
#pragma unroll
        for (int q = 0; q < 2; ++q) { ra[hh][q] = *(const v4u*)(WSP(bf16, WS_Y) + (size_t)tokA * D + hh * 1024 + lane * 16 + q * 8); rb[hh][q] = *(const v4u*)(WSP(bf16, WS_Y) + (size_t)tokB * D + hh * 1024 + lane * 16 + q * 8); }
#define YQ_ONE(R_, tok_) do { float xf_[32]; float am_ = 0.f; \
        _Pragma("unroll") for (int hh_ = 0; hh_ < 2; ++hh_) _Pragma("unroll") for (int q_ = 0; q_ < 2; ++q_) { float t8_[8]; unpack8(R_[hh_][q_], t8_); \
            _Pragma("unroll") for (int e_ = 0; e_ < 8; ++e_) { xf_[hh_ * 16 + q_ * 8 + e_] = t8_[e_]; am_ = fmaxf(am_, fabsf(t8_[e_])); } } \
        am_ = fmaxf(am_, dppf<0xB1>(am_)); am_ = fmaxf(am_, dppf<0x4E>(am_)); am_ = fmaxf(am_, dppf<0x141>(am_)); am_ = fmaxf(am_, dppf<0x140>(am_)); \
        { auto s_ = __builtin_amdgcn_permlane16_swap(__float_as_uint(am_), __float_as_uint(am_), false, false); am_ = fmaxf(__uint_as_float(s_[0]), __uint_as_float(s_[1])); } \
        { auto s_ = __builtin_amdgcn_permlane32_swap(__float_as_uint(am_), __float_as_uint(am_), false, false); am_ = fmaxf(__uint_as_float(s_[0]), __uint_as_float(s_[1])); } \
        const float qs_ = am_ > 0.f ? 127.0f / am_ : 0.f; \
        if (lane == 0) WSP(float, WS_SY)[tok_] = am_ * (1.0f / 127.0f); \
        _Pragma("unroll") for (int hh_ = 0; hh_ < 2; ++hh_) { v4u o_; \
            _Pragma("unroll") for (int d_ = 0; d_ < 4; ++d_) { \
                const unsigned b0_ = __float_as_uint(__builtin_fmaf(xf_[hh_ * 16 + d_ * 4 + 0], qs_, 12582912.0f)), b1_ = __float_as_uint(__builtin_fmaf(xf_[hh_ * 16 + d_ * 4 + 1], qs_, 12582912.0f)); \
                const unsigned b2_ = __float_as_uint(__builtin_fmaf(xf_[hh_ * 16 + d_ * 4 + 2], qs_, 12582912.0f)), b3_ = __float_as_uint(__builtin_fmaf(xf_[hh_ * 16 + d_ * 4 + 3], qs_, 12582912.0f)); \
                o_[d_] = __builtin_amdgcn_perm(b1_, b0_, 0x0c0c0400u) | __builtin_amdgcn_perm(b3_, b2_, 0x04000c0cu); } \
            *(v4u*)(WSP(unsigned char, WS_YQ) + (size_t)(tok_) * D + hh_ * 1024 + lane * 16) = o_; } } while (0)
    YQ_ONE(ra, tokA);
    if (tokB != tokA) YQ_ONE(rb, tokB);
#undef YQ_ONE
}
struct PeerIds { unsigned w; };
__device__ __forceinline__ PeerIds peer_ids_load(const Frame& F, int tok, int lane) { PeerIds r; r.w = WSP(unsigned, WS_EXP)[(size_t)tok * (NSEL / 2) + lane]; return r; }
struct PeerScoreBuf { v4u w[16]; v4u xs; };
__device__ __forceinline__ void peer_score_issue(const Frame& F, int tok, int slice, int lane, LAS int* wl, const PeerIds& id, PeerScoreBuf& B) {
    const int e8 = lane >> 3, c16 = lane & 7;
    *(LAS v2u*)(wl + 2 * lane) = (v2u){id.w & 0xffffu, id.w >> 16};
    B.xs = *(const v4u*)(WSP(unsigned char, WS_XQ) + (size_t)tok * D + slice * 128 + c16 * 16);
    const unsigned char* ub = WSP(unsigned char, WS_UT); const unsigned lo = (unsigned)(slice * 128 + c16 * 16);
#pragma unroll
    for (int ld = 0; ld < 16; ++ld) { const unsigned eid = (unsigned)wl[e8 * 16 + ld]; B.w[ld] = *(const v4u*)(ub + (eid * 2048u + lo)); }
}
__device__ __forceinline__ void peer_score_consume(const Frame& F, int tok, int slice, int lane, const PeerScoreBuf& B, bool valid) {
    int p[16];
#pragma unroll
    for (int ld = 0; ld < 16; ++ld) { const v4u w = B.w[ld]; int a = dot4i(w.x, B.xs.x, 0); a = dot4i(w.y, B.xs.y, a); a = dot4i(w.z, B.xs.z, a); p[ld] = dot4i(w.w, B.xs.w, a); }
    { const bool up = (lane & 4) != 0;
#pragma unroll
      for (int k = 0; k < 8; ++k) { const int keep = up ? p[k + 8] : p[k], send = up ? p[k] : p[k + 8]; p[k] = keep + dppi<0x141>(send); } }
    { const bool up = (lane & 2) != 0;
#pragma unroll
      for (int k = 0; k < 4; ++k) { const int keep = up ? p[k + 4] : p[k], send = up ? p[k] : p[k + 4]; p[k] = keep + dppi<0x4E>(send); } }
    { const bool up = (lane & 1) != 0;
#pragma unroll
      for (int k = 0; k < 2; ++k) { const int keep = up ? p[k + 2] : p[k], send = up ? p[k] : p[k + 2]; p[k] = keep + dppi<0xB1>(send); } }
    if (valid) { unsigned* dst = WSP(unsigned, WS_PART) + ((size_t)slice * T + tok) * (NSEL / 2) + lane;
        __builtin_nontemporal_store(((unsigned)((p[0] + 32) >> 6) & 0xffffu) | ((unsigned)((p[1] + 32) >> 6) << 16), dst); }
}
__device__ __forceinline__ void peer_score_phase(const Frame& F, const PeerGeom& pg, LAS int* wl2) {
    const int lane = F.lane, first = pg.rank * NWAVES + F.wave, step = pg.nrank * NWAVES, n = first < T ? (T - first + step - 1) / step : 0;
    LAS int* wlA = wl2; LAS int* wlB = wl2 + 256;
#define PEER_TOKC(k_) ((first + (k_) * step) < T ? (first + (k_) * step) : T - 1)
    for (int r = 0; r < 16 / pg.ngrp; ++r) { const int slice = r * pg.ngrp + pg.g;
        PeerScoreBuf A, B; PeerIds id = peer_ids_load(F, PEER_TOKC(0), lane);
        { const PeerIds cur = id; id = peer_ids_load(F, PEER_TOKC(1), lane); asm volatile("" ::: "memory"); peer_score_issue(F, PEER_TOKC(0), slice, lane, wlA, cur, A); }
        for (int i = 0; i < n; i += 2) {
            { const PeerIds cur = id; id = peer_ids_load(F, PEER_TOKC(i + 2), lane); asm volatile("" ::: "memory"); peer_score_issue(F, PEER_TOKC(i + 1), slice, lane, wlB, cur, B); }
            peer_score_consume(F, first + i * step, slice, lane, A, true);
            { const PeerIds cur = id; id = peer_ids_load(F, PEER_TOKC(i + 3), lane); asm volatile("" ::: "memory"); peer_score_issue(F, PEER_TOKC(i + 2), slice, lane, wlA, cur, A); }
            peer_score_consume(F, first + (i + 1) * step, slice, lane, B, i + 1 < n);
        }
    }
}
template <int NT> __device__ __forceinline__ void peer_coef_tokens(const Frame& F, const int (&tok)[NT], const bool (&valid)[NT], int lane) {
    unsigned pv[NT][16], exw[NT]; f32x2 ga[NT]; float sx[NT], sq[NT];
#pragma unroll
    for (int i = 0; i < NT; ++i) {
#pragma unroll
        for (int s = 0; s < 16; ++s) pv[i][s] = WSP(unsigned, WS_PART)[((size_t)s * T + tok[i]) * (NSEL / 2) + lane];
        exw[i] = WSP(unsigned, WS_EXP)[(size_t)tok[i] * (NSEL / 2) + lane]; ga[i] = *(const f32x2*)(WSP(float, WS_GATE) + (size_t)tok[i] * NSEL + lane * 2);
        sx[i] = WSP(float, WS_SX)[tok[i]]; sq[i] = WSP(float, WS_SSQ2)[tok[i]]; }
    float us0[NT], us1[NT], vs0[NT], vs1[NT];
#pragma unroll
    for (int i = 0; i < NT; ++i) { const unsigned e0 = exw[i] & 0xffffu, e1 = exw[i] >> 16;
        us0[i] = WSP(float, WS_USC)[e0]; us1[i] = WSP(float, WS_USC)[e1]; vs0[i] = WSP(float, WS_VSC)[e0]; vs1[i] = WSP(float, WS_VSC)[e1]; }
#pragma unroll
    for (int i = 0; i < NT; ++i) { int s0 = 0, s1 = 0;
#pragma unroll
        for (int s = 0; s < 16; ++s) { s0 += (int)(pv[i][s] << 16) >> 16; s1 += (int)pv[i][s] >> 16; }
        s0 <<= 6; s1 <<= 6;
        const float rs = sx[i] * (1.0f / sqrtf(sq[i] * (1.0f / D) + NORM_EPS));
        const float sc0 = (float)s0 * us0[i] * rs, sc1 = (float)s1 * us1[i] * rs;
        f32x2 c; c.x = ga[i].x * gelu_fast(sc0) * vs0[i]; c.y = ga[i].y * gelu_fast(sc1) * vs1[i];
        float cm = fmaxf(fabsf(c.x), fabsf(c.y));
        cm = fmaxf(cm, dppf<0xB1>(cm)); cm = fmaxf(cm, dppf<0x4E>(cm)); cm = fmaxf(cm, dppf<0x141>(cm)); cm = fmaxf(cm, dppf<0x140>(cm));
        { auto t = __builtin_amdgcn_permlane16_swap(__float_as_uint(cm), __float_as_uint(cm), false, false); cm = fmaxf(__uint_as_float(t[0]), __uint_as_float(t[1])); }
        { auto t = __builtin_amdgcn_permlane32_swap(__float_as_uint(cm), __float_as_uint(cm), false, false); cm = fmaxf(__uint_as_float(t[0]), __uint_as_float(t[1])); }
        const float qs = cm > 0.f ? 127.0f / cm : 0.f;
        const int q0 = (int)rintf(c.x * qs), q1 = (int)rintf(c.y * qs);
        if (valid[i]) { ((unsigned short*)(F.ws + WS_COEF))[(size_t)tok[i] * 64 + lane] = (unsigned short)(((unsigned)q0 & 0xFFu) | (((unsigned)q1 & 0xFFu) << 8));
            if (lane == 0) WSP(float, WS_CSC)[tok[i]] = cm * (1.0f / 127.0f); } }
}
struct PeerOutBuf { v4u w[16]; v4u cq; unsigned x; float cs; };
__device__ __forceinline__ void peer_out_issue(const Frame& F, int tok, int slice, int lane, LAS int* wl, const PeerIds& id, PeerOutBuf& B) {
    const int e8 = lane >> 3, c16 = lane & 7;
    *(LAS v2u*)(wl + 2 * lane) = (v2u){id.w & 0xffffu, id.w >> 16};
    B.cq = *(const v4u*)(F.ws + WS_COEF + (size_t)tok * 128 + e8 * 16);
    B.cs = WSP(float, WS_CSC)[tok];
    const unsigned char* vb = WSP(unsigned char, WS_VT); const unsigned lofs = (unsigned)(slice * 128 + c16 * 16);
#pragma unroll
    for (int ld = 0; ld < 16; ++ld) { const unsigned eid = (unsigned)wl[e8 * 16 + ld]; B.w[ld] = *(const v4u*)(vb + (eid * 2048u + lofs)); }
    B.x = *(const unsigned*)(WSP(bf16, WS_XB) + (size_t)tok * D + slice * 128 + c16 * 16 + e8 * 2);
}
__device__ __forceinline__ void peer_out_consume(const Frame& F, int tok, int slice, int lane, const PeerOutBuf& B, bool valid) {
    const int e8 = lane >> 3, c16 = lane & 7;
    int o[16];
#pragma unroll
    for (int i = 0; i < 16; ++i) o[i] = 0;
#pragma unroll
    for (int g = 0; g < 4; ++g) { const unsigned cq = B.cq[g];
#pragma unroll
        for (int d = 0; d < 4; ++d) { const unsigned w0 = B.w[4 * g][d], w1 = B.w[4 * g + 1][d], w2 = B.w[4 * g + 2][d], w3 = B.w[4 * g + 3][d];
            const unsigned lo01 = __builtin_amdgcn_perm(w1, w0, 0x05010400u), hi01 = __builtin_amdgcn_perm(w1, w0, 0x07030602u);
            const unsigned lo23 = __builtin_amdgcn_perm(w3, w2, 0x05010400u), hi23 = __builtin_amdgcn_perm(w3, w2, 0x07030602u);
            const unsigned t0 = __builtin_amdgcn_perm(lo23, lo01, 0x05040100u), t1 = __builtin_amdgcn_perm(lo23, lo01, 0x07060302u);
            const unsigned t2 = __builtin_amdgcn_perm(hi23, hi01, 0x05040100u), t3 = __builtin_amdgcn_perm(hi23, hi01, 0x07060302u);
            o[d * 4 + 0] = dot4i(t0, cq, o[d * 4 + 0]); o[d * 4 + 1] = dot4i(t1, cq, o[d * 4 + 1]); o[d * 4 + 2] = dot4i(t2, cq, o[d * 4 + 2]); o[d * 4 + 3] = dot4i(t3, cq, o[d * 4 + 3]); } }
#pragma unroll
    for (int k = 0; k < 8; ++k) { auto s = __builtin_amdgcn_permlane32_swap((unsigned)o[k], (unsigned)o[k + 8], false, false); o[k] = (int)(s[0] + s[1]); }
#pragma unroll
    for (int k = 0; k < 4; ++k) { auto s = __builtin_amdgcn_permlane16_swap((unsigned)o[k], (unsigned)o[k + 4], false, false); o[k] = (int)(s[0] + s[1]); }
    { const bool up = (lane & 8) != 0;
#pragma unroll
      for (int k = 0; k < 2; ++k) { const int keep = up ? o[k + 2] : o[k], send = up ? o[k] : o[k + 2]; o[k] = keep + dppi<0x128>(send); } }
    const float x0 = bf_lo(B.x) + (float)o[0] * B.cs, x1 = bf_hi(B.x) + (float)o[1] * B.cs;
    if (valid) *(unsigned*)(WSP(bf16, WS_XB) + (size_t)tok * D + slice * 128 + c16 * 16 + e8 * 2) = cvtpk(x0, x1);
}
__device__ __forceinline__ void peer_out_phase(const Frame& F, const PeerGeom& pg, LAS int* wl2) {
    const int lane = F.lane, first = pg.rank * NWAVES + F.wave, step = pg.nrank * NWAVES, n = first < T ? (T - first + step - 1) / step : 0;
    LAS int* wlA = wl2; LAS int* wlB = wl2 + 256;
    for (int r = 0; r < 16 / pg.ngrp; ++r) { const int slice = r * pg.ngrp + pg.g;
        PeerOutBuf A, B; PeerIds id = peer_ids_load(F, PEER_TOKC(0), lane);
        { const PeerIds cur = id; id = peer_ids_load(F, PEER_TOKC(1), lane); asm volatile("" ::: "memory"); peer_out_issue(F, PEER_TOKC(0), slice, lane, wlA, cur, A); }
        for (int i = 0; i < n; i += 2) {
            { const PeerIds cur = id; id = peer_ids_load(F, PEER_TOKC(i + 2), lane); asm volatile("" ::: "memory"); peer_out_issue(F, PEER_TOKC(i + 1), slice, lane, wlB, cur, B); }
            peer_out_consume(F, first + i * step, slice, lane, A, true);
            { const PeerIds cur = id; id = peer_ids_load(F, PEER_TOKC(i + 3), lane); asm volatile("" ::: "memory"); peer_out_issue(F, PEER_TOKC(i + 2), slice, lane, wlA, cur, A); }
            peer_out_consume(F, first + (i + 1) * step, slice, lane, B, i + 1 < n);
        }
    }
}
#undef PEER_TOKC
__device__ __forceinline__ void final_norm_phase(const Frame& F) {
    const int lane = F.lane, gw = F.bid * NWAVES + F.wave, NGW = F.G * NWAVES;
    const f32x4* gf = (const f32x4*)F.in[I_GF] + lane;
    f32x4 g[8];
#pragma unroll
    for (int j = 0; j < 8; ++j) g[j] = gf[64 * j];
    if (gw >= T) return;
    v2u va[8], vb[8]; float sa, sb;
#define FN_LOAD(v_, s_, tok_) do { const int tc_ = (tok_) < T ? (tok_) : T - 1; const v2u* xi_ = (const v2u*)(WSP(bf16, WS_XB) + (size_t)tc_ * D) + lane; \
        _Pragma("unroll") for (int j_ = 0; j_ < 8; ++j_) v_[j_] = xi_[64 * j_]; } while (0)
#define FN_STORE(v_, s_, tok_) do { f32x4* xo_ = (f32x4*)(F.out + (size_t)(tok_) * D) + lane; s_ = 0.f; f32x4 f_[8]; \
        _Pragma("unroll") for (int j_ = 0; j_ < 8; ++j_) { f_[j_] = (f32x4){bf_lo(v_[j_].x), bf_hi(v_[j_].x), bf_lo(v_[j_].y), bf_hi(v_[j_].y)}; s_ += (f_[j_][0] * f_[j_][0] + f_[j_][1] * f_[j_][1]) + (f_[j_][2] * f_[j_][2] + f_[j_][3] * f_[j_][3]); } \
        s_ = wave_sum(s_); const float rs_ = 1.0f / sqrtf(s_ * (1.0f / D) + NORM_EPS); \
        _Pragma("unroll") for (int j_ = 0; j_ < 8; ++j_) xo_[64 * j_] = f_[j_] * rs_ * g[j_]; } while (0)
    FN_LOAD(va, sa, gw);
    for (int tok = gw; tok < T; tok += 2 * NGW) {
        FN_LOAD(vb, sb, tok + NGW);
        FN_STORE(va, sa, tok);
        FN_LOAD(va, sa, tok + 2 * NGW);
        if (tok + NGW < T) FN_STORE(vb, sb, tok + NGW);
    }
#undef FN_LOAD
#undef FN_STORE
}

struct Args { const float* in[28]; float* out; unsigned char* ws; int ph_lo, ph_hi, li, pad; };
__global__ void __launch_bounds__(NTHR, 2) hybrid_fwd(Args args) {
    extern __shared__ __attribute__((aligned(16))) unsigned char lds[];
    Frame F;
    F.lds = (LAS unsigned char*)lds;
    F.tid = threadIdx.x; F.lane = F.tid & 63; F.wave = __builtin_amdgcn_readfirstlane(F.tid >> 6);
    F.G = gridDim.x; F.bid = blockIdx.x;
#pragma unroll
    for (int i = 0; i < 28; ++i) F.in[i] = args.in[i];
    F.out = args.out; F.ws = args.ws;
    volatile LAS unsigned* MISC = (volatile LAS unsigned*)(F.lds + MISC_OFF);
    for (int u = F.tid; u < (LDS_BYTES - LDSCTL_OFF) / 4; u += NTHR) ((LAS unsigned*)(F.lds + LDSCTL_OFF))[u] = 0u;
    __syncthreads();
    unsigned* barw = (unsigned*)(F.ws + WS_CTL) + CW_BAR;
    XcdBarrier bar; bar.bar = barw; bar.x = 0; bar.st = nullptr;
    if (N_LAUNCHES == 1) bar = xcd_barrier_post(barw, MISC + 8);
    const int lo = args.ph_lo, hi = args.ph_hi;
#define IN(k) (lo <= (k) && (k) < hi)
#define SEAM(k) do { if (IN(k) && IN((k) + 1)) xcd_barrier(bar); } while (0)

#ifndef PROBE_DUP
#define PROBE_DUP -1
#endif
#define REPS(k) for (int rep_ = 0; rep_ < ((PROBE_DUP) == (k) ? 2 : 1); ++rep_)
    if (IN(0)) REPS(0) { p0_prologue<0>(F, F.bid, F.G); __syncthreads(); }
    SEAM(0);
    if (IN(1)) REPS(1) {
        pg8::Gemm g{(const bf16*)((const unsigned char*)F.out + OUT_X8), WSP(const bf16, WS_WIN), T, NINP, D / 2}; pg8::StaticOrder S; S.init(T, NINP, F.G, F.bid);
        pg8::EpiI8RowColBf16<0> E{WSP(bf16, WS_PROJ), NINP, WSP(const float, WS_RSTD1), WSP(const float, WS_CS1), nullptr, NORM_EPS};
        pg8::gemm_phase<pg8::EpiI8RowColBf16<0>, pg8::StaticOrder, true, true, true>(F.lds, g, S, E);
    }
    SEAM(1);
    if (IN(2)) REPS(2) {
        lora_prepass(F);
        group_barrier((unsigned*)(F.ws + WS_CTL) + CW_PREBAR, (unsigned)F.G);
        for (int r4 = 0; r4 < ((PROBE_DUP) == 70 ? 2 : 1); ++r4) rwkv_prep_phase(F);
        group_barrier((unsigned*)(F.ws + WS_CTL) + CW_PREPBAR, (unsigned)F.G);
        const int R1 = F.G >= 256 ? 128 : F.G, L0 = F.G >= 256 ? 128 : 0, NL = F.G - L0;
        if (F.bid < R1) for (int it = F.bid; it < 128; it += R1) rwkv_item(F, it);
        if (F.bid >= L0) for (int it = F.bid - L0; it < 128; it += NL) lru_seq(F, it);
        { volatile LAS int* qslot = (volatile LAS int*)(F.lds + LDSCTL_OFF + 1024);
          for (;;) { __syncthreads(); if (F.tid == 0) *qslot = (int)xb_add((unsigned*)(F.ws + WS_CTL) + CW_DEFQ, 1u); __syncthreads();
              const int vb = *qslot; if (vb >= DEF_SLICES) break; p0_prologue<1>(F, vb, DEF_SLICES); } }
    }
    SEAM(2);
    if (IN(3)) REPS(3) { const int gw = F.bid * NWAVES + F.wave, NGW = F.G * NWAVES;
        for (int tok = gw; tok < T; tok += 2 * NGW) yquant_tokens(F, tok, tok + NGW < T ? tok + NGW : tok, F.lane); }
    SEAM(3);
    if (IN(4)) REPS(4) {
        pg8::Gemm g{WSP(const bf16, WS_YQ), WSP(const bf16, WS_WOUT), T, D, D / 2}; pg8::StaticOrder S; S.init(T, D, F.G, F.bid);
        pg8::EpiI8Residual E{(const unsigned char*)F.out + OUT_X8, WSP(const float, WS_SX0), WSP(bf16, WS_XB), D, WSP(const float, WS_SY), WSP(const float, WS_CSO)};
        pg8::gemm_phase<pg8::EpiI8Residual, pg8::StaticOrder, true, true, true>(F.lds, g, S, E);
    }
    SEAM(4);
    if (IN(5)) { const int gw = F.bid * NWAVES + F.wave, NGW = F.G * NWAVES;
        for (int tok = gw; tok < T; tok += NGW) xquant_token(F, tok, F.lane); }
    SEAM(5);
    if (IN(6)) REPS(6) {
        pg8::Gemm g{WSP(const bf16, WS_XQ), WSP(const bf16, WS_WQ), T, D, D / 2}; pg8::StaticOrder S; S.init(T, D, F.G, F.bid);
        pg8::EpiI8RowColBf16<1> E{WSP(bf16, WS_Q), D, WSP(const float, WS_SX), WSP(const float, WS_CSQ), WSP(const float, WS_SSQ2), NORM_EPS};
        pg8::gemm_phase<pg8::EpiI8RowColBf16<1>, pg8::StaticOrder, true, true, true>(F.lds, g, S, E);
    }
    if (IN(6)) { __syncthreads();
        pg8::StaticOrder S; S.init(T, D, F.G, F.bid); pg8::Unit u;
        for (int i = 0; S.next(i, u); ++i) route_item(F, ((u.pm * 8 + F.wave) << 3) | u.pn, F.lane); }
    SEAM(6);
    { const PeerGeom pg = peer_geom(F); LAS int* wl = (LAS int*)(F.lds + F.wave * 1024);
      if (IN(7)) REPS(7) peer_score_phase(F, pg, (LAS int*)(F.lds + 16384 + F.wave * 2048));
      SEAM(7);
      if (IN(8)) REPS(8) { const int gw = F.bid * NWAVES + F.wave, NGW = F.G * NWAVES; for (int tok = gw; tok < T; tok += 4 * NGW) { int tk[4]; bool vl[4];
#pragma unroll
            for (int i = 0; i < 4; ++i) { const int t = tok + i * NGW; vl[i] = t < T; tk[i] = vl[i] ? t : tok; }
            peer_coef_tokens<4>(F, tk, vl, F.lane); } }
      SEAM(8);
      if (IN(9)) peer_out_phase(F, pg, (LAS int*)(F.lds + 16384 + F.wave * 2048));
      SEAM(9);
      if (IN(10)) final_norm_phase(F); }
#undef IN
#undef SEAM
}

extern "C" void kernel_launch(void* const* d_in, const int* in_sizes, int n_in, void* d_out, int out_size, void* d_ws, size_t ws_size, hipStream_t stream) {
    static int grid = 0;
    if (grid == 0) {
        if (n_in != 28 || in_sizes[0] != T * D || out_size != T * D || ws_size < WS_END) { fprintf(stderr, "kernel_launch: shape/workspace mismatch: n_in %d in0 %d out %d ws %zu (need %zu)\n", n_in, n_in > 0 ? in_sizes[0] : -1, out_size, ws_size, (size_t)WS_END); grid = -1; return; }
        int dev = 0, cus = 0, per_cu = 0;
        if (hipGetDevice(&dev) != hipSuccess || hipDeviceGetAttribute(&cus, hipDeviceAttributeMultiprocessorCount, dev) != hipSuccess) { fprintf(stderr, "kernel_launch: device query failed\n"); grid = -1; return; }
        if (hipFuncSetAttribute((const void*)hybrid_fwd, hipFuncAttributeMaxDynamicSharedMemorySize, LDS_BYTES) != hipSuccess) { fprintf(stderr, "kernel_launch: hipFuncSetAttribute failed\n"); grid = -1; return; }
        if (hipOccupancyMaxActiveBlocksPerMultiprocessor(&per_cu, (const void*)hybrid_fwd, NTHR, LDS_BYTES) != hipSuccess || per_cu < 1) { fprintf(stderr, "kernel_launch: occupancy query says %d blocks per CU\n", per_cu); per_cu = 1; }
        (void)hipGetLastError();
        grid = cus;
    }
    if (grid < 0) return;
    if (hipMemsetAsync((char*)d_ws + WS_CTL, 0, CTL_ZERO_BYTES, stream) != hipSuccess) { fprintf(stderr, "kernel_launch: hipMemsetAsync failed\n"); return; }
    Args a{};
    for (int i = 0; i < 28; ++i) a.in[i] = (const float*)d_in[i];
    a.out = (float*)d_out; a.ws = (unsigned char*)d_ws;
    for (int li = 0; li < N_LAUNCHES; ++li) {
        a.ph_lo = (N_LAUNCHES == 1) ? 0 : li; a.ph_hi = (N_LAUNCHES == 1) ? N_PHASES : li + 1; a.li = li;
        hipLaunchKernelGGL(hybrid_fwd, dim3(grid), dim3(NTHR), LDS_BYTES, stream, a);
        const hipError_t le = hipPeekAtLastError();
        if (le != hipSuccess) { fprintf(stderr, "kernel_launch: launch %d failed: %s\n", li, hipGetErrorName(le)); break; }
    }
}
```

```cpp
#include <hip/hip_runtime.h>
#include <cstdio>
#include <cstdint>
namespace pg8 {
#define PG8_LAS __attribute__((address_space(3)))
typedef unsigned short bf16_t;
typedef short bf16x8 __attribute__((ext_vector_type(8)));
typedef float f32x4 __attribute__((ext_vector_type(4)));
typedef unsigned u32x4 __attribute__((ext_vector_type(4)));
typedef int i32x4 __attribute__((ext_vector_type(4)));
constexpr int BM = 256, BK = 64, HALF = 128, HTB = HALF * BK * 2  , STAGE_BYTES = 8 * HTB, NXCD = 8, WGM = 8;

__host__ __device__ __forceinline__ int lds_byte(int r, int c) { const int st = (r >> 4) * 2 + (c >> 5), rr = r & 15, cc = c & 31, ob = rr * 64 + cc * 2; return st * 1024 + (ob ^ (((ob >> 9) & 1) << 5)); }
__host__ __device__ __forceinline__ void stage_rc(int b, int& R, int& C) { const int st = b / 1024, sb = b % 1024, swz = sb ^ (((sb >> 9) & 1) << 5); R = (st >> 1) * 16 + swz / 64; C = (st & 1) * 32 + (swz % 64) / 2; }
__host__ __device__ __forceinline__ int perm32(int rho) { const int n = rho >> 4, i = rho & 15; return 8 * (i >> 2) + 4 * n + (i & 3); }

struct Unit { int pm, pn; };
struct Gemm { const bf16_t* A; const bf16_t* Bt; int M, N, K; };

struct StaticOrder {
    int nM, nN, nwg, G, c;
    __host__ __device__ void init(int M, int N, int G_, int c_) { nM = M / BM; nN = N / BM; nwg = nM * nN; G = G_; c = c_; }
    __host__ __device__ bool next(int i, Unit& u) const {
        const long L = (long)i * G + c; if (L >= nwg) return false;
        int wgid = (int)L; { const int q = nwg / NXCD, r = nwg % NXCD, xcd = wgid % NXCD, off = wgid / NXCD; wgid = (xcd < r ? xcd * (q + 1) : r * (q + 1) + (xcd - r) * q) + off; }
        const int nig = WGM * nN, gid = wgid / nig, fm = gid * WGM, gsz = (nM - fm) < WGM ? (nM - fm) : WGM;
        u.pm = fm + ((wgid % nig) % gsz); u.pn = (wgid % nig) / gsz; return true;
    }
    __device__ __forceinline__ void a_ready(const Unit&) const {}
    __device__ __forceinline__ void done(const Unit&) const {}
};

__device__ __forceinline__ unsigned cvt_pk_bf16(float lo, float hi) { unsigned r; asm volatile("v_cvt_pk_bf16_f32 %0, %1, %2" : "=v"(r) : "v"(lo), "v"(hi)); return r; }
typedef float f32x2 __attribute__((ext_vector_type(2)));
typedef unsigned u32x2 __attribute__((ext_vector_type(2)));
template <int MODE> struct EpiRowScaleBf16 {
    static constexpr bool PERM = true, AFTER_DRAIN = false;
    bf16_t* O; int ldc; const float* rs; float eps;
    __device__ __forceinline__ void operator()(const f32x4 (&acc)[2][2][4][2], const Unit& u, int wr, int wc, int fr, int fq) const {
        const int row0 = u.pm * BM + wr * 64 + fr, col0 = u.pn * BM + wc * 32 + 8 * fq;
#pragma unroll
        for (int ai = 0; ai < 2; ++ai)
#pragma unroll
            for (int m = 0; m < 4; ++m) { const int r = row0 + ai * HALF + m * 16; float s = rs[r]; if (MODE == 1) s = 1.0f / sqrtf(s * (1.0f / 2048.0f) + eps);
                bf16_t* rowp = O + (size_t)r * ldc + col0;
#pragma unroll
                for (int bj = 0; bj < 2; ++bj) { const f32x4 v0 = acc[ai][bj][m][0] * s, v1 = acc[ai][bj][m][1] * s;
                    u32x4 w; w.x = cvt_pk_bf16(v0[0], v0[1]); w.y = cvt_pk_bf16(v0[2], v0[3]); w.z = cvt_pk_bf16(v1[0], v1[1]); w.w = cvt_pk_bf16(v1[2], v1[3]);
                    *(u32x4*)(rowp + bj * HALF) = w; } }
    }
};
template <int MODE> struct EpiI8RowColBf16 {
    static constexpr bool PERM = true, AFTER_DRAIN = false;
    bf16_t* O; int ldc; const float* rs; const float* cs; const float* ssq; float eps;
    __device__ __forceinline__ void operator()(const f32x4 (&acc)[2][2][4][2], const Unit& u, int wr, int wc, int fr, int fq) const {
        const int row0 = u.pm * BM + wr * 64 + fr, col0 = u.pn * BM + wc * 32 + 8 * fq;
        f32x4 c4[2][2];
#pragma unroll
        for (int bj = 0; bj < 2; ++bj) { c4[bj][0] = *(const f32x4*)(cs + col0 + bj * HALF); c4[bj][1] = *(const f32x4*)(cs + col0 + bj * HALF + 4); }
#pragma unroll
        for (int ai = 0; ai < 2; ++ai)
#pragma unroll
            for (int m = 0; m < 4; ++m) { const int r = row0 + ai * HALF + m * 16; float s = rs[r]; if (MODE == 1) s = s / sqrtf(ssq[r] * (1.0f / 2048.0f) + eps);
                bf16_t* rowp = O + (size_t)r * ldc + col0;
#pragma unroll
                for (int bj = 0; bj < 2; ++bj) { f32x4 v0, v1; const i32x4 i0 = __builtin_bit_cast(i32x4, acc[ai][bj][m][0]), i1 = __builtin_bit_cast(i32x4, acc[ai][bj][m][1]);
#pragma unroll
                    for (int e = 0; e < 4; ++e) { v0[e] = (float)i0[e] * s * c4[bj][0][e]; v1[e] = (float)i1[e] * s * c4[bj][1][e]; }
                    u32x4 w; w.x = cvt_pk_bf16(v0[0], v0[1]); w.y = cvt_pk_bf16(v0[2], v0[3]); w.z = cvt_pk_bf16(v1[0], v1[1]); w.w = cvt_pk_bf16(v1[2], v1[3]);
                    *(u32x4*)(rowp + bj * HALF) = w; } }
    }
};
struct EpiResidual {
    static constexpr bool PERM = false, AFTER_DRAIN = false;
    const float* base; bf16_t* outb; int ldc;
    __device__ __forceinline__ void operator()(const f32x4 (&acc)[2][2][4][2], const Unit& u, int wr, int wc, int fr, int fq) const {
        const int row0 = u.pm * BM + wr * 64 + fr, col0 = u.pn * BM + wc * 32 + 4 * fq;
#pragma unroll
        for (int ai = 0; ai < 2; ++ai)
#pragma unroll
            for (int m = 0; m < 4; ++m) { const int r = row0 + ai * HALF + m * 16; const size_t off = (size_t)r * ldc + col0;
#pragma unroll
                for (int bj = 0; bj < 2; ++bj)
#pragma unroll
                    for (int n = 0; n < 2; ++n) { const f32x4 bs = *(const f32x4*)(base + off + bj * HALF + n * 16); const f32x4 o = bs + acc[ai][bj][m][n];
                        u32x2 w; w.x = cvt_pk_bf16(o[0], o[1]); w.y = cvt_pk_bf16(o[2], o[3]); *(u32x2*)(outb + off + bj * HALF + n * 16) = w; } }
    }
};
struct EpiI8Residual {
    static constexpr bool PERM = true, AFTER_DRAIN = false;
    const unsigned char* x8; const float* xs; bf16_t* outb; int ldc; const float* rs; const float* cs;
    __device__ __forceinline__ void operator()(const f32x4 (&acc)[2][2][4][2], const Unit& u, int wr, int wc, int fr, int fq) const {
        const int row0 = u.pm * BM + wr * 64 + fr, col0 = u.pn * BM + wc * 32 + 8 * fq;
        f32x4 c4[2][2];
#pragma unroll
        for (int bj = 0; bj < 2; ++bj) { c4[bj][0] = *(const f32x4*)(cs + col0 + bj * HALF); c4[bj][1] = *(const f32x4*)(cs + col0 + bj * HALF + 4); }
#pragma unroll
        for (int ai = 0; ai < 2; ++ai)
#pragma unroll
            for (int m = 0; m < 4; ++m) { const int r = row0 + ai * HALF + m * 16; const float s = rs[r], sx = xs[r]; const size_t off = (size_t)r * ldc + col0;
#pragma unroll
                for (int bj = 0; bj < 2; ++bj) { const i32x4 i0 = __builtin_bit_cast(i32x4, acc[ai][bj][m][0]), i1 = __builtin_bit_cast(i32x4, acc[ai][bj][m][1]);
                    const u32x2 xb = *(const u32x2*)(x8 + off + bj * HALF); f32x4 v0, v1;
#pragma unroll
                    for (int e = 0; e < 4; ++e) { v0[e] = (float)((int)(xb.x << (24 - 8 * e)) >> 24) * sx + (float)i0[e] * s * c4[bj][0][e]; v1[e] = (float)((int)(xb.y << (24 - 8 * e)) >> 24) * sx + (float)i1[e] * s * c4[bj][1][e]; }
                    u32x4 w; w.x = cvt_pk_bf16(v0[0], v0[1]); w.y = cvt_pk_bf16(v0[2], v0[3]); w.z = cvt_pk_bf16(v1[0], v1[1]); w.w = cvt_pk_bf16(v1[2], v1[3]);
                    *(u32x4*)(outb + off + bj * HALF) = w; } }
    }
};
template <class Epi, class Sched, bool ALIGN_EPI = false, bool SP2 = false, bool I8 = false>
__device__ __forceinline__ void gemm_phase(PG8_LAS unsigned char* lds, const Gemm g, const Sched& S, const Epi& E) {
    const int tid = threadIdx.x, wid = __builtin_amdgcn_readfirstlane(tid >> 6), lane = tid & 63, wr = wid >> 2, wc = wid & 3, fr = lane & 15, fq = lane >> 4;
    const int K = g.K, nt = K / BK;
    unsigned voffA[2], voffB[2];
#pragma unroll
    for (int i = 0; i < 2; ++i) { int R, C; stage_rc(tid * 16 + i * 8192, R, C); const int Rb = Epi::PERM ? ((R & ~31) + perm32(R & 31)) : R;
        voffA[i] = (unsigned)(R * K + C) * 2u; voffB[i] = (unsigned)(Rb * K + C) * 2u; }
    const size_t kstep = (size_t)(BK * 2);
    const size_t hstep = (size_t)HALF * K * 2;
    const size_t tstep = 2 * hstep;
    const unsigned ldsw = (unsigned)wid * 1024u;
    const int aoff = lds_byte(wr * 64 + fr, fq * 8), boff = lds_byte(wc * 32 + fr, fq * 8);
#define PG8_SA(b, h) (((b) * 2 + (h)) * HTB)
#define PG8_SB(b, h) ((4 + (b) * 2 + (h)) * HTB)
#define PG8_STAGE(bufoff, gbase, voff) do { _Pragma("unroll") for (int _i = 0; _i < 2; ++_i) \
        __builtin_amdgcn_global_load_lds((const unsigned*)((const char*)(gbase) + (voff)[_i]), (PG8_LAS unsigned*)(lds + (bufoff) + ldsw + _i * 8192), 16, 0, 0); } while (0)
#define PG8_LDA(dst, b, h) do { _Pragma("unroll") for (int m = 0; m < 4; ++m) _Pragma("unroll") for (int k = 0; k < 2; ++k) dst[m][k] = *(const PG8_LAS bf16x8*)(lds + PG8_SA(b, h) + aoff + m * 2048 + k * 1024); } while (0)
#define PG8_LDB(dst, b, h) do { _Pragma("unroll") for (int n = 0; n < 2; ++n) _Pragma("unroll") for (int k = 0; k < 2; ++k) dst[n][k] = *(const PG8_LAS bf16x8*)(lds + PG8_SB(b, h) + boff + n * 2048 + k * 1024); } while (0)
#define PG8_MMA(ai, bj, At, Bt) do { __builtin_amdgcn_s_setprio(1); _Pragma("unroll") for (int m = 0; m < 4; ++m) _Pragma("unroll") for (int n = 0; n < 2; ++n) _Pragma("unroll") for (int k = 0; k < 2; ++k) \
        { if constexpr (I8) acc[ai][bj][m][n] = __builtin_bit_cast(f32x4, __builtin_amdgcn_mfma_i32_16x16x64_i8(__builtin_bit_cast(i32x4, Bt[n][k]), __builtin_bit_cast(i32x4, At[m][k]), __builtin_bit_cast(i32x4, acc[ai][bj][m][n]), 0, 0, 0)); \
          else acc[ai][bj][m][n] = __builtin_amdgcn_mfma_f32_16x16x32_bf16(Bt[n][k], At[m][k], acc[ai][bj][m][n], 0, 0, 0); } __builtin_amdgcn_s_setprio(0); } while (0)
#define PG8_WAIT_V(n) asm volatile("s_waitcnt vmcnt(" #n ")" ::: "memory")
#define PG8_WAIT_L(n) asm volatile("s_waitcnt lgkmcnt(" #n ")" ::: "memory")
#define PG8_BAR __builtin_amdgcn_s_barrier()
#define PG8_SCHED __builtin_amdgcn_sched_barrier(0)
    Unit cur, nxt; int ui = 0;
    if (!S.next(0, cur)) return;
    f32x4 acc[2][2][4][2];
#pragma unroll
    for (int a = 0; a < 2; ++a)
#pragma unroll
        for (int b = 0; b < 2; ++b)
#pragma unroll
            for (int m = 0; m < 4; ++m)
#pragma unroll
                for (int n = 0; n < 2; ++n) acc[a][b][m][n] = (f32x4){0.f, 0.f, 0.f, 0.f};
    bf16x8 At[4][2], B0[2][2], B1[2][2];
    const char* cA = (const char*)g.A + (size_t)cur.pm * tstep; const char* cB = (const char*)g.Bt + (size_t)cur.pn * tstep;
    S.a_ready(cur);
    if constexpr (SP2) {
        PG8_STAGE(PG8_SB(0, 0), cB, voffB); PG8_STAGE(PG8_SB(0, 1), cB + hstep, voffB); PG8_STAGE(PG8_SA(0, 0), cA, voffA); PG8_STAGE(PG8_SA(0, 1), cA + hstep, voffA);
        if (wr == 1) PG8_BAR;
        PG8_WAIT_V(2); PG8_BAR;
        PG8_STAGE(PG8_SB(1, 0), cB + kstep, voffB); PG8_STAGE(PG8_SA(1, 0), cA + kstep, voffA); PG8_STAGE(PG8_SB(1, 1), cB + hstep + kstep, voffB);
        PG8_WAIT_V(6); PG8_BAR;
    } else {
        PG8_STAGE(PG8_SB(0, 0), cB, voffB); PG8_STAGE(PG8_SA(0, 0), cA, voffA); PG8_STAGE(PG8_SB(0, 1), cB + hstep, voffB); PG8_STAGE(PG8_SA(0, 1), cA + hstep, voffA);
        if (wr == 1) PG8_BAR;
        PG8_WAIT_V(4); PG8_BAR;
        PG8_STAGE(PG8_SB(1, 0), cB + kstep, voffB); PG8_STAGE(PG8_SA(1, 0), cA + kstep, voffA); PG8_STAGE(PG8_SB(1, 1), cB + hstep + kstep, voffB);
        PG8_WAIT_V(6); PG8_BAR;
    }
    for (;;) {
        const bool has_next = S.next(ui + 1, nxt);
        const char* nA = has_next ? (const char*)g.A + (size_t)nxt.pm * tstep : cA; const char* nB = has_next ? (const char*)g.Bt + (size_t)nxt.pn * tstep : cB;
        for (int t = 0; t < nt; t += 2) {
            const bool last = (t == nt - 2);
            const char* a1 = cA + (size_t)(t + 1) * kstep;
            const char* a2 = last ? nA : cA + (size_t)(t + 2) * kstep; const char* b2 = last ? nB : cB + (size_t)(t + 2) * kstep;
            const char* a3 = a2 + kstep; const char* b3 = b2 + kstep;
            if (last && has_next) S.a_ready(nxt);
            if constexpr (SP2) {
            PG8_LDB(B0, 0, 0); PG8_LDB(B1, 0, 1); PG8_SCHED; PG8_LDA(At, 0, 0); PG8_STAGE(PG8_SA(1, 1), a1 + hstep, voffA);
            PG8_WAIT_V(8); PG8_WAIT_L(0); PG8_BAR; PG8_MMA(0, 0, At, B0); PG8_MMA(0, 1, At, B1); PG8_BAR; PG8_SCHED;
            PG8_LDA(At, 0, 1); PG8_STAGE(PG8_SB(0, 0), b2, voffB); PG8_STAGE(PG8_SB(0, 1), b2 + hstep, voffB); PG8_STAGE(PG8_SA(0, 0), a2, voffA);
            PG8_WAIT_V(8); PG8_WAIT_L(0); PG8_BAR; PG8_MMA(1, 0, At, B0); PG8_MMA(1, 1, At, B1); PG8_BAR; PG8_SCHED;
            PG8_LDB(B0, 1, 0); PG8_LDB(B1, 1, 1); PG8_SCHED; PG8_LDA(At, 1, 0); PG8_STAGE(PG8_SA(0, 1), a2 + hstep, voffA);
            PG8_WAIT_V(8); PG8_WAIT_L(0); PG8_BAR; PG8_MMA(0, 0, At, B0); PG8_MMA(0, 1, At, B1); PG8_BAR; PG8_SCHED;
            PG8_LDA(At, 1, 1); PG8_STAGE(PG8_SB(1, 0), b3, voffB); PG8_STAGE(PG8_SB(1, 1), b3 + hstep, voffB); PG8_STAGE(PG8_SA(1, 0), a3, voffA);
            PG8_WAIT_V(8); PG8_WAIT_L(0); PG8_BAR; PG8_MMA(1, 0, At, B0); PG8_MMA(1, 1, At, B1); PG8_BAR; PG8_SCHED;
            } else {
            PG8_LDB(B0, 0, 0); PG8_SCHED; PG8_LDA(At, 0, 0); PG8_STAGE(PG8_SA(1, 1), a1 + hstep, voffA);
            PG8_WAIT_L(8); PG8_BAR; PG8_WAIT_L(0); PG8_MMA(0, 0, At, B0); PG8_BAR; PG8_SCHED;
            PG8_LDB(B1, 0, 1); PG8_STAGE(PG8_SB(0, 0), b2, voffB);
            PG8_BAR; PG8_WAIT_L(0); PG8_MMA(0, 1, At, B1); PG8_BAR;
            PG8_LDA(At, 0, 1); PG8_STAGE(PG8_SA(0, 0), a2, voffA);
            PG8_BAR; PG8_WAIT_L(0); PG8_MMA(1, 0, At, B0); PG8_BAR; PG8_SCHED;
            PG8_STAGE(PG8_SB(0, 1), b2 + hstep, voffB);
            PG8_WAIT_V(6); PG8_BAR; PG8_MMA(1, 1, At, B1); PG8_BAR;
            PG8_LDB(B0, 1, 0); PG8_SCHED; PG8_LDA(At, 1, 0); PG8_STAGE(PG8_SA(0, 1), a2 + hstep, voffA);
            PG8_WAIT_L(8); PG8_BAR; PG8_WAIT_L(0); PG8_MMA(0, 0, At, B0); PG8_BAR; PG8_SCHED;
            PG8_LDB(B1, 1, 1); PG8_STAGE(PG8_SB(1, 0), b3, voffB);
            PG8_BAR; PG8_WAIT_L(0); PG8_MMA(0, 1, At, B1); PG8_BAR;
            PG8_LDA(At, 1, 1); PG8_STAGE(PG8_SA(1, 0), a3, voffA);
            PG8_BAR; PG8_WAIT_L(0); PG8_MMA(1, 0, At, B0); PG8_BAR; PG8_SCHED;
            PG8_STAGE(PG8_SB(1, 1), b3 + hstep, voffB);
            PG8_WAIT_V(6); PG8_BAR; PG8_MMA(1, 1, At, B1); PG8_BAR;
            }
        }
        if constexpr (ALIGN_EPI) { if (wr == 0) PG8_BAR; }
        if constexpr (!Epi::AFTER_DRAIN) { E(acc, cur, wr, wc, fr, fq); S.done(cur); }
        if (!has_next) break;
#pragma unroll
        for (int a = 0; a < 2; ++a)
#pragma unroll
            for (int b = 0; b < 2; ++b)
#pragma unroll
                for (int m = 0; m < 4; ++m)
#pragma unroll
                    for (int n = 0; n < 2; ++n) acc[a][b][m][n] = (f32x4){0.f, 0.f, 0.f, 0.f};
        cur = nxt; cA = nA; cB = nB; ++ui;
        if constexpr (ALIGN_EPI) { if (wr == 1) PG8_BAR; }
    }
    PG8_WAIT_V(0);
    if constexpr (!ALIGN_EPI) { if (wr == 0) PG8_BAR; }
    PG8_BAR;
    if constexpr (Epi::AFTER_DRAIN) { E.fused(acc, cur, wr, wc, fr, fq, lds, wid, lane); S.done(cur); }
#undef PG8_SA
#undef PG8_SB
#undef PG8_STAGE
#undef PG8_LDA
#undef PG8_LDB
#undef PG8_MMA
#undef PG8_WAIT_V
#undef PG8_WAIT_L
#undef PG8_BAR
#undef PG8_SCHED
}
}

#ifndef PROBE_DUP
#define PROBE_DUP -1
#endif
constexpr int NWAVES = 8, NTHR = NWAVES * 64;
#ifndef MK_N_LAUNCHES
#define MK_N_LAUNCHES 1
#endif
constexpr int N_PHASES = 11;
constexpr int DEF_SLICES = 256;
constexpr int N_LAUNCHES = MK_N_LAUNCHES;
static_assert(N_LAUNCHES == 1 || N_LAUNCHES == N_PHASES, "MK_N_LAUNCHES is 1 or N_PHASES");

constexpr int BATCH = 8, SEQ = 2048, T = BATCH * SEQ, D = 2048;
constexpr int NIN = 5408, NINP = 5632;
constexpr int PC_GATE = 1024, PC_R = 2048, PC_K = 3072, PC_V = 4096, PC_WD = 5120, PC_AD = 5184, PC_GD = 5248;
constexpr int RWKV_C0 = 2048;
constexpr int NEXP = 16384, NSEL = 128;
constexpr float NORM_EPS = 1e-6f, GN_EPS = 64e-5f;

constexpr size_t MiB = 1u << 20;
constexpr size_t WS_CTL = 0, CTL_ZERO_BYTES = 1 * MiB;
constexpr size_t WS_SSQ3 = 576 * 1024;
constexpr size_t WS_SSQ2 = 512 * 1024;
constexpr size_t WS_RSTD1 = 1 * MiB;
constexpr size_t WS_USC = 1 * MiB + 64 * 1024, WS_VSC = 1 * MiB + 128 * 1024;
constexpr size_t WS_SX = 1 * MiB + 192 * 1024;
constexpr size_t WS_CS1 = 1 * MiB + 256 * 1024;
constexpr size_t WS_CSQ = 1 * MiB + 288 * 1024;
constexpr size_t WS_CSO = 1 * MiB + 296 * 1024;
constexpr size_t WS_SY = 1 * MiB + 320 * 1024;
constexpr size_t WS_SX0 = 1 * MiB + 384 * 1024;
constexpr size_t WS_WIN = 2 * MiB;
constexpr size_t WS_WOUT = 24 * MiB;
constexpr size_t WS_WQ = 32 * MiB;
constexpr size_t WS_KEYS = 40 * MiB;
constexpr size_t WS_W2T = WS_KEYS + 512 * 1024;
constexpr size_t WS_A2T = WS_W2T + 128 * 1024;
constexpr size_t WS_G2T = WS_A2T + 128 * 1024;
constexpr size_t WS_WAT = WS_G2T + 320 * 1024;
constexpr size_t WS_WIT = WS_WAT + 256 * 1024;
constexpr size_t WS_EXP = 42 * MiB;
constexpr size_t WS_GATE = 50 * MiB;
constexpr size_t WS_LA = 42 * MiB;
constexpr size_t WS_SUMM = 58 * MiB;
constexpr size_t WS_TA = 64 * MiB, WS_TB = 96 * MiB, WS_TK = 400 * MiB, WS_TR = 464 * MiB;
constexpr size_t OUT_X8 = 72 * MiB;
constexpr size_t OUT_TV = 0, OUT_TG = 32 * MiB, OUT_PC = 64 * MiB, OUT_BON = 66 * MiB;
constexpr size_t WS_XB = 64 * MiB;
constexpr size_t WS_PROJ = 128 * MiB;
constexpr size_t WS_PEERB = 192 * MiB;
constexpr size_t WS_Q = WS_PROJ;
constexpr size_t WS_YQ = WS_PROJ;
constexpr size_t WS_PART = 192 * MiB;
constexpr size_t WS_XQ = 320 * MiB;
constexpr size_t WS_COEF = 352 * MiB;
constexpr size_t WS_CSC = 356 * MiB;
constexpr size_t WS_Y = 304 * MiB;
constexpr size_t WS_UT = 368 * MiB;
constexpr size_t WS_VT = 432 * MiB;
constexpr size_t WS_END = 496 * MiB;
static_assert(WS_WIT + 256 * 1024 <= WS_EXP && WS_PROJ + (size_t)T * NINP * 2 <= WS_Y && WS_WIN + (size_t)NINP * D * 2 <= WS_WOUT, "d_ws map");
constexpr int CW_DEFQ = 2240;
constexpr int CW_PREPBAR = 2176;
constexpr int CW_PREBAR = 2112;
constexpr int CW_LRUBAR = 2048;
constexpr int CW_BAR = 4096;

constexpr int RING_BYTES = 131072;
constexpr int LDSCTL_OFF = 143360, MISC_OFF = LDSCTL_OFF + 320;
constexpr int LDS_BYTES = 147456;

#define GAS __attribute__((address_space(1)))
#define LAS __attribute__((address_space(3)))
typedef unsigned short bf16;
typedef unsigned v4u __attribute__((ext_vector_type(4)));
typedef unsigned v2u __attribute__((ext_vector_type(2)));
typedef float f32x4 __attribute__((ext_vector_type(4)));
typedef float f32x16 __attribute__((ext_vector_type(16)));
typedef short bf16x8 __attribute__((ext_vector_type(8)));
typedef __bf16 bf16x2_t __attribute__((ext_vector_type(2)));
typedef GAS unsigned gu32;
#define RLX_AGENT __ATOMIC_RELAXED, __HIP_MEMORY_SCOPE_AGENT
__device__ __forceinline__ unsigned f2bf(float f) { unsigned u = __builtin_bit_cast(unsigned, f); return (u + 0x7fffu + ((u >> 16) & 1u)) >> 16; }
__device__ __forceinline__ unsigned pk2(float lo, float hi) { return f2bf(lo) | (f2bf(hi) << 16); }
__device__ __forceinline__ float bf_lo(unsigned w) { return __uint_as_float(w << 16); }
__device__ __forceinline__ float bf_hi(unsigned w) { return __uint_as_float(w & 0xffff0000u); }
__device__ __forceinline__ void unpack8(const v4u& w, float (&o)[8]) { o[0] = bf_lo(w.x); o[1] = bf_hi(w.x); o[2] = bf_lo(w.y); o[3] = bf_hi(w.y); o[4] = bf_lo(w.z); o[5] = bf_hi(w.z); o[6] = bf_lo(w.w); o[7] = bf_hi(w.w); }
__device__ __forceinline__ v4u pack8(const float (&o)[8]) { v4u w; w.x = pk2(o[0], o[1]); w.y = pk2(o[2], o[3]); w.z = pk2(o[4], o[5]); w.w = pk2(o[6], o[7]); return w; }
__device__ __forceinline__ float sigmoidf_(float x) { return 1.0f / (1.0f + __expf(-x)); }
__device__ __forceinline__ float softplusf_(float z) { return fmaxf(z, 0.f) + log1pf(__expf(-fabsf(z))); }
__device__ __forceinline__ float gelu_tanh(float x) { const float u = 0.7978845608028654f * (x + 0.044715f * x * x * x); return 0.5f * x * (1.0f + tanhf(u)); }
template <int CTRL> __device__ __forceinline__ float dppf(float x) { return __builtin_bit_cast(float, __builtin_amdgcn_mov_dpp(__builtin_bit_cast(int, x), CTRL, 0xf, 0xf, true)); }
__device__ __forceinline__ float red8(float v) { v += dppf<0xB1>(v); v += dppf<0x4E>(v); v += dppf<0x141>(v); return v; }
__device__ __forceinline__ float red16(float v) { v = red8(v); v += dppf<0x140>(v); return v; }
__device__ __forceinline__ float wave_sum(float v) {
#pragma unroll
    for (int o = 1; o < 64; o <<= 1) v += __shfl_xor(v, o);
    return v;
}
__device__ __forceinline__ float dot2bf(unsigned a, unsigned b, float acc) { return __builtin_amdgcn_fdot2_f32_bf16(__builtin_bit_cast(bf16x2_t, a), __builtin_bit_cast(bf16x2_t, b), acc, false); }
#define MFMA16(a, b, c) __builtin_amdgcn_mfma_f32_16x16x32_bf16((a), (b), (c), 0, 0, 0)
#define MFMA32(a, b, c) __builtin_amdgcn_mfma_f32_32x32x16_bf16((a), (b), (c), 0, 0, 0)

#define XB_TMO      128
#define XB_XCNT(j)  (256  + 64 * (j))
#define XB_XSUB(j)  (1280 + 64 * (j))
#define XB_XGEN(j)  (2304 + 64 * (j))
#define XB_TOP      3328
#define XB_TOPGEN   3392
#define XCD_BAR_WORDS 3456
#define XB_SPIN_CAP (1u << 22)
__device__ __forceinline__ unsigned xb_ld(unsigned* p)              { return __hip_atomic_load(p, __ATOMIC_RELAXED, __HIP_MEMORY_SCOPE_AGENT); }
__device__ __forceinline__ unsigned xb_add(unsigned* p, unsigned v) { return __hip_atomic_fetch_add(p, v, __ATOMIC_RELAXED, __HIP_MEMORY_SCOPE_AGENT); }
__device__ __forceinline__ unsigned xb_xcc_id() { return (unsigned)__builtin_amdgcn_s_getreg((3 << 11) | 20) & 0xFu; }
#define XB_SPIN(cond, bar) do { unsigned _sp = 0; while (cond) { __builtin_amdgcn_s_sleep(1); \
    if ((++_sp & 255u) == 0u) { if (xb_ld(&(bar)[XB_TMO])) break; if (_sp > XB_SPIN_CAP) { atomicAdd(&(bar)[XB_TMO], 1u); break; } } } } while (0)
struct XcdBarrier { unsigned* bar; unsigned x; volatile LAS unsigned* st; };
__device__ __forceinline__ XcdBarrier xcd_barrier_post(unsigned* bar, volatile LAS unsigned* st) {
    XcdBarrier b; b.bar = bar; b.x = xb_xcc_id(); b.st = st;
    if (threadIdx.x == 0) (void)xb_add(&bar[XB_XCNT(b.x)], 1u);
    return b;
}
__device__ __forceinline__ void xcd_barrier_complete(unsigned* bar, unsigned x, unsigned& nloc, unsigned& nx) {
    const unsigned G = gridDim.x * gridDim.y * gridDim.z;
    unsigned sum, cnt, mine, sp = 0u;
    for (;;) {
        sum = 0u; cnt = 0u; mine = 0u;
#pragma unroll
        for (unsigned j = 0; j < 16; ++j) { const unsigned c = xb_ld(&bar[XB_XCNT(j)]); sum += c; cnt += (c > 0u) ? 1u : 0u; mine = (j == x) ? c : mine; }
        if (sum == G) break;
        __builtin_amdgcn_s_sleep(1);
        if ((++sp & 255u) == 0u) { if (xb_ld(&bar[XB_TMO])) break; if (sp > XB_SPIN_CAP) { atomicAdd(&bar[XB_TMO], 1u); break; } }
    }
    nloc = mine > 0u ? mine : 1u; nx = cnt > 0u ? cnt : 1u;
}
__device__ __forceinline__ void xcd_barrier(const XcdBarrier& b) {
    asm volatile("s_waitcnt vmcnt(0)" ::: "memory");
    __syncthreads();
    if (threadIdx.x == 0) {
        unsigned* bar = b.bar;
        __builtin_amdgcn_s_waitcnt(0);
        unsigned nloc = b.st[0], nx = b.st[1];
        if (nloc == 0u) { xcd_barrier_complete(bar, b.x, nloc, nx); b.st[0] = nloc; b.st[1] = nx; }
        const unsigned old = xb_add(&bar[XB_XSUB(b.x)], 1u);
        const unsigned gen = old / nloc;
        if (old + 1u == (gen + 1u) * nloc) {
            __builtin_amdgcn_fence(__ATOMIC_RELEASE, "agent");
            asm volatile("s_waitcnt vmcnt(0)" ::: "memory");
            const unsigned og = xb_add(&bar[XB_TOP], 1u);
            const unsigned tg = og / nx;
            if (og + 1u == (tg + 1u) * nx) xb_add(&bar[XB_TOPGEN], 1u);
            else XB_SPIN(xb_ld(&bar[XB_TOPGEN]) == tg, bar);
            __builtin_amdgcn_fence(__ATOMIC_ACQUIRE, "agent");
            xb_add(&bar[XB_XGEN(b.x)], 1u);
            asm volatile("s_waitcnt vmcnt(0)" ::: "memory");
        } else {
            XB_SPIN(xb_ld(&bar[XB_XGEN(b.x)]) == gen, bar);
            __builtin_amdgcn_fence(__ATOMIC_ACQUIRE, "agent");
            asm volatile("s_waitcnt vmcnt(0)" ::: "memory");
        }
    }
    __syncthreads();
}

struct Frame {
    LAS unsigned char* lds;
    int tid, lane, wave, G, bid;
    const float* in[28];
    float* out;
    unsigned char* ws;
};
#define WSP(type, off) ((type*)(F.ws + (off)))
enum { I_X = 0, I_G1, I_WIN, I_CONVW, I_CONVB, I_WA, I_BA, I_WI, I_BI, I_LAM, I_MU, I_W0, I_W2, I_A0, I_A2, I_G2, I_KK, I_KA, I_RK, I_LNW, I_LNB, I_WOUT, I_G2N, I_WQ, I_KEYS, I_U, I_V, I_GF };

__device__ __forceinline__ void p0_transpose_item(const float* W, int K, int N, bf16* WT, const float* ksc, LAS float* scr, int item, int lane) {
    const int nblk = N / 32, kb = item / nblk, nb = item % nblk, k0 = 64 * kb, n0 = 32 * nb;
    const int lr = lane >> 3, c4 = (lane & 7) * 4;
    f32x4 v[8];
#pragma unroll
    for (int i = 0; i < 8; ++i) v[i] = *(const f32x4*)(W + (size_t)(k0 + 8 * i + lr) * N + n0 + c4);
#pragma unroll
    for (int i = 0; i < 8; ++i) { const int kk = 8 * i + lr; const float sc = ksc ? ksc[k0 + kk] : 1.0f; LAS float* d = scr + kk * 33 + c4; d[0] = v[i][0] * sc; d[1] = v[i][1] * sc; d[2] = v[i][2] * sc; d[3] = v[i][3] * sc; }
    asm volatile("s_waitcnt lgkmcnt(0)" ::: "memory");
    const int c = lane & 7;
#pragma unroll
    for (int j = 0; j < 4; ++j) { const int n = (lane >> 3) + 8 * j; const LAS float* s = scr + (8 * c) * 33 + n;
        v4u o; o.x = pk2(s[0 * 33], s[1 * 33]); o.y = pk2(s[2 * 33], s[3 * 33]); o.z = pk2(s[4 * 33], s[5 * 33]); o.w = pk2(s[6 * 33], s[7 * 33]);
        *(v4u*)(WT + (size_t)(n0 + n) * K + k0 + 8 * c) = o; }
    asm volatile("s_waitcnt lgkmcnt(0)" ::: "memory");
}
template <bool HASK> __device__ __forceinline__ void p0_wquant_block(const float* W, int N, unsigned char* WT8, float* cs, const float* ksc, int item, int wave, int lane, LAS float* mxs) {
    asm volatile("" : "+v"(lane));
    const int n0 = item * 32, r = lane >> 3, c4 = lane & 7, kb = 256 * wave + 4 * r;
    const float* src = W + (size_t)kb * N + n0 + 4 * c4; const float* kp = ksc + kb;
    f32x4 mx = (f32x4){0.f, 0.f, 0.f, 0.f};
#pragma unroll
    for (int i2 = 0; i2 < 2; ++i2) { f32x4 v[4][4], g4[4];
#pragma unroll
        for (int ii = 0; ii < 4; ++ii) { g4[ii] = HASK ? *(const f32x4*)(kp + 32 * (i2 * 4 + ii)) : (f32x4){1.f, 1.f, 1.f, 1.f};
#pragma unroll
            for (int j = 0; j < 4; ++j) v[ii][j] = *(const f32x4*)(src + (size_t)(32 * (i2 * 4 + ii) + j) * N); }
#pragma unroll
        for (int ii = 0; ii < 4; ++ii)
#pragma unroll
            for (int j = 0; j < 4; ++j)
#pragma unroll
                for (int e = 0; e < 4; ++e) mx[e] = fmaxf(mx[e], fabsf(v[ii][j][e] * g4[ii][j])); }
#pragma unroll
    for (int o = 8; o < 64; o <<= 1)
#pragma unroll
        for (int e = 0; e < 4; ++e) mx[e] = fmaxf(mx[e], __shfl_xor(mx[e], o));
    if (r == 0) *(LAS f32x4*)(mxs + wave * 32 + 4 * c4) = mx;
    __syncthreads();
#pragma unroll
    for (int w = 0; w < NWAVES; ++w) { const f32x4 t = *(const LAS f32x4*)(mxs + w * 32 + 4 * c4);
#pragma unroll
        for (int e = 0; e < 4; ++e) mx[e] = fmaxf(mx[e], t[e]); }
    f32x4 q;
#pragma unroll
    for (int e = 0; e < 4; ++e) q[e] = mx[e] > 0.f ? 127.0f / mx[e] : 0.f;
    if (wave == 0 && r == 0) *(f32x4*)(cs + n0 + 4 * c4) = mx * (1.0f / 127.0f);
    unsigned char* dst = WT8 + (size_t)(n0 + 4 * c4) * 2048 + kb;
#pragma unroll
    for (int i2 = 0; i2 < 2; ++i2) { f32x4 v[4][4], g4[4];
#pragma unroll
        for (int ii = 0; ii < 4; ++ii) { g4[ii] = HASK ? *(const f32x4*)(kp + 32 * (i2 * 4 + ii)) : (f32x4){1.f, 1.f, 1.f, 1.f};
#pragma unroll
            for (int j = 0; j < 4; ++j) v[ii][j] = *(const f32x4*)(src + (size_t)(32 * (i2 * 4 + ii) + j) * N); }
#pragma unroll
        for (int ii = 0; ii < 4; ++ii) { unsigned w[4] = {0u, 0u, 0u, 0u};
#pragma unroll
            for (int j = 0; j < 4; ++j)
#pragma unroll
                for (int e = 0; e < 4; ++e) { const int qi = (int)rintf(v[ii][j][e] * g4[ii][j] * q[e]); w[e] |= ((unsigned)qi & 0xFFu) << (8 * j); }
#pragma unroll
            for (int e = 0; e < 4; ++e) *(unsigned*)(dst + (size_t)e * 2048 + 32 * (i2 * 4 + ii)) = w[e]; } }
    __syncthreads();
}
__device__ __forceinline__ void p0_small_transpose(const float* src, bf16* dst, int nb, int K, int N, int gt, int NGT) {
    const int tot = nb * K * N;
    for (int i = gt; i < tot; i += NGT) { const int bb = i / (K * N), r = i - bb * K * N, n = r / K, k = r - n * K; dst[i] = (bf16)f2bf(src[(size_t)bb * K * N + (size_t)k * N + n]); }
}
template <int PART> __device__ __forceinline__ void p0_prologue(const Frame& F, int vb, int VG) {
    LAS float* scr = (LAS float*)(F.lds + F.wave * 8448);
    const int gw = vb * NWAVES + F.wave, NGW = VG * NWAVES, gt = gw * 64 + F.lane, NGT = NGW * 64;
    constexpr int I1 = (D / 64) * (NIN / 32), I2 = (D / 64) * (D / 32);
    if (PART == 0) { for (int it = vb; it < NIN / 32; it += VG) p0_wquant_block<true>(F.in[I_WIN], NIN, WSP(unsigned char, WS_WIN), WSP(float, WS_CS1), F.in[I_G1], it, F.wave, F.lane, (LAS float*)(F.lds + 8 * 8448)); }
    else { const int sp = VG >= 64 ? VG / 64 : 1;
           for (int v = vb; v < sp * (D / 32); v += VG) {
               if (v % sp == 0) p0_wquant_block<false>(F.in[I_WQ], D, WSP(unsigned char, WS_WQ), WSP(float, WS_CSQ), nullptr, v / sp, F.wave, F.lane, (LAS float*)(F.lds + 8 * 8448));
               if (v % sp == sp / 2) p0_wquant_block<false>(F.in[I_WOUT], D, WSP(unsigned char, WS_WOUT), WSP(float, WS_CSO), nullptr, v / sp, F.wave, F.lane, (LAS float*)(F.lds + 8 * 8448)); } }
    if (PART == 0) {
    { v4u* z = (v4u*)(WSP(unsigned char, WS_WIN) + (size_t)NIN * D); const int nz = (NINP - NIN) * D / 16; for (int i = gt; i < nz; i += NGT) z[i] = (v4u){0u, 0u, 0u, 0u};
      for (int i = gt; i < NINP - NIN; i += NGT) WSP(float, WS_CS1)[NIN + i] = 0.f; }
    p0_small_transpose(F.in[I_W2], WSP(bf16, WS_W2T), 1, 64, 1024, gt, NGT);
    p0_small_transpose(F.in[I_A2], WSP(bf16, WS_A2T), 1, 64, 1024, gt, NGT);
    p0_small_transpose(F.in[I_G2], WSP(bf16, WS_G2T), 1, 160, 1024, gt, NGT);
    p0_small_transpose(F.in[I_WA], WSP(bf16, WS_WAT), 8, 128, 128, gt, NGT);
    p0_small_transpose(F.in[I_WI], WSP(bf16, WS_WIT), 8, 128, 128, gt, NGT);
    { const float* s = F.in[I_KEYS]; bf16* d = WSP(bf16, WS_KEYS); for (int i = gt; i < 8 * 2 * 128 * 128 / 8; i += NGT) { const f32x4 a = *(const f32x4*)(s + (size_t)i * 8), b = *(const f32x4*)(s + (size_t)i * 8 + 4);
        v4u o; o.x = pk2(a[0], a[1]); o.y = pk2(a[2], a[3]); o.z = pk2(b[0], b[1]); o.w = pk2(b[2], b[3]); *(v4u*)(d + (size_t)i * 8) = o; } }
    }
    if (PART == 0) {
    { const float* x = F.in[I_X]; unsigned char* xq = (unsigned char*)F.out + OUT_X8; float* rs1 = WSP(float, WS_RSTD1); float* sx0 = WSP(float, WS_SX0);
#define XR_LOAD(V_, row_) do { _Pragma("unroll") for (int hh_ = 0; hh_ < 2; ++hh_) _Pragma("unroll") for (int q_ = 0; q_ < 4; ++q_) V_[hh_][q_] = *(const f32x4*)(x + (size_t)(row_) * D + hh_ * 1024 + F.lane * 16 + q_ * 4); } while (0)
#define XR_QUANT(V_, row_) do { float s_ = 0.f, am_ = 0.f; \
          _Pragma("unroll") for (int hh_ = 0; hh_ < 2; ++hh_) _Pragma("unroll") for (int q_ = 0; q_ < 4; ++q_) _Pragma("unroll") for (int e_ = 0; e_ < 4; ++e_) { const float t_ = V_[hh_][q_][e_]; s_ += t_ * t_; am_ = fmaxf(am_, fabsf(t_)); } \
          s_ = wave_sum(s_); \
          _Pragma("unroll") for (int o_ = 1; o_ < 64; o_ <<= 1) am_ = fmaxf(am_, __shfl_xor(am_, o_)); \
          const float xq_ = am_ > 0.f ? 127.0f / am_ : 0.f; \
          if (F.lane == 0) { rs1[row_] = am_ * (1.0f / 127.0f) / sqrtf(s_ * (1.0f / D) + NORM_EPS); sx0[row_] = am_ * (1.0f / 127.0f); } \
          _Pragma("unroll") for (int hh_ = 0; hh_ < 2; ++hh_) { v4u o_; \
              _Pragma("unroll") for (int q_ = 0; q_ < 4; ++q_) { unsigned w_ = 0u; \
                  _Pragma("unroll") for (int e_ = 0; e_ < 4; ++e_) { const int qi_ = (int)rintf(V_[hh_][q_][e_] * xq_); w_ |= ((unsigned)qi_ & 0xFFu) << (8 * e_); } \
                  o_[q_] = w_; } \
              *(v4u*)(xq + (size_t)(row_) * D + hh_ * 1024 + F.lane * 16) = o_; } } while (0)
      for (int m = gw; m < T; m += 2 * NGW) { const int mB = m + NGW < T ? m + NGW : m;
          f32x4 xa[2][4], xb2[2][4];
          XR_LOAD(xa, m); XR_LOAD(xb2, mB);
          XR_QUANT(xa, m);
          if (mB != m) XR_QUANT(xb2, mB); }
#undef XR_LOAD
#undef XR_QUANT
    }
    }
}

typedef float f32x2c __attribute__((ext_vector_type(2)));
__device__ __forceinline__ unsigned cvtpk(float lo, float hi) { const f32x2c v = {lo, hi}; const bf16x2_t b = __builtin_convertvector(v, bf16x2_t); return __builtin_bit_cast(unsigned, b); }
__device__ __forceinline__ float rcpf_(float x) { return __builtin_amdgcn_rcpf(x); }
__device__ __forceinline__ float sigmoid_fast(float x) { return rcpf_(1.0f + __expf(-x)); }
__device__ __forceinline__ float tanh_fast(float x) { return 1.0f - 2.0f * rcpf_(1.0f + __expf(2.0f * x)); }
__device__ __forceinline__ float softplus_fast(float z) { return fmaxf(z, 0.f) + __logf(1.0f + __expf(-fabsf(z))); }
__device__ __forceinline__ float gelu_fast(float x) { const float u = 0.7978845608028654f * (x + 0.044715f * x * x * x); return x * rcpf_(1.0f + __expf(-2.0f * u)); }
__device__ __forceinline__ void rwkv_prep_unit(const Frame& F, int chunk, int h, int lane, const LAS bf16* WL2, const LAS bf16* AL2, const LAS bf16* GL2, const LAS float* CW, LAS bf16* ST) {
    asm volatile("" : "+v"(lane));
    const int fr = lane & 15, fq = lane >> 4;
    const bf16* PROJ = WSP(bf16, WS_PROJ); const bf16* LA = WSP(bf16, WS_LA);
    bf16* TA = WSP(bf16, WS_TA); bf16* TB = WSP(bf16, WS_TB); bf16* TK = WSP(bf16, WS_TK); bf16* TR = WSP(bf16, WS_TR);
    bf16* TV = (bf16*)F.out + OUT_TV / 2; bf16* TG = (bf16*)F.out + OUT_TG / 2; float* PCG = F.out + OUT_PC / 4; float* BONG = F.out + OUT_BON / 4;
#define PU4(w_) ((f32x4){bf_lo((w_).x), bf_hi((w_).x), bf_lo((w_).y), bf_hi((w_).y)})
    size_t tokm[2];
#pragma unroll
    for (int mt = 0; mt < 2; ++mt) tokm[mt] = (size_t)chunk * 32 + mt * 16 + fr;
    v2u cA[4][3], cB[4][3], eA[4][3];
    const bool hs = (chunk & 63) != 0; const unsigned hsm = hs ? 0xffffffffu : 0u; const size_t toke = (size_t)chunk * 32 - (hs ? 1 : 0);
#define PREP_LOAD_MT(C_, tok_) do { _Pragma("unroll") for (int nt_ = 0; nt_ < 4; ++nt_) { const bf16* pr_ = PROJ + (tok_) * NINP + PC_R + h * 64 + nt_ * 16 + fq * 4; \
        _Pragma("unroll") for (int q_ = 0; q_ < 3; ++q_) C_[nt_][q_] = *(const v2u*)(pr_ + q_ * 1024); } } while (0)
#define DPPU(old_, src_, ctl_) ((unsigned)__builtin_amdgcn_update_dpp((int)(old_), (int)(src_), ctl_, 0xf, 0xf, false))
#define PREP_PREV(dst_, mt_, nt_, q_) do { const v2u c_ = (mt_) ? cB[nt_][q_] : cA[nt_][q_]; v2u o_; \
        if (mt_) { o_.x = DPPU(0, cA[nt_][q_].x, 0x121); o_.y = DPPU(0, cA[nt_][q_].y, 0x121); } else { o_.x = eA[nt_][q_].x & hsm; o_.y = eA[nt_][q_].y & hsm; } \
        dst_.x = DPPU(o_.x, c_.x, 0x111); dst_.y = DPPU(o_.y, c_.y, 0x111); } while (0)
    PREP_LOAD_MT(cA, tokm[0]); PREP_LOAD_MT(eA, toke);
    bf16x8 la[9];
#pragma unroll
    for (int ks = 0; ks < 9; ++ks) la[ks] = *(const bf16x8*)(LA + tokm[0] * 288 + ks * 32 + 8 * fq);
    PREP_LOAD_MT(cB, tokm[1]);
    float inv[2], bn[2];
#pragma unroll
    for (int mt = 0; mt < 2; ++mt) { float s2 = 0.f;
#pragma unroll
        for (int nt = 0; nt < 4; ++nt) { const int j4 = nt * 16 + fq * 4;
            const v2u kc = mt ? cB[nt][1] : cA[nt][1]; v2u kp; PREP_PREV(kp, mt, nt, 1);
            const f32x4 c_kk = *(const LAS f32x4*)(CW + 128 + j4), m_k = *(const LAS f32x4*)(CW + 384 + j4);
            const f32x4 kcf = PU4(kc); const f32x4 ku = (kcf + (PU4(kp) - kcf) * m_k) * c_kk; s2 += (ku[0] * ku[0] + ku[1] * ku[1]) + (ku[2] * ku[2] + ku[3] * ku[3]); }
        { auto x = __builtin_amdgcn_permlane16_swap(__float_as_uint(s2), __float_as_uint(s2), false, false); s2 = __uint_as_float(x[0]) + __uint_as_float(x[1]); }
        { auto x = __builtin_amdgcn_permlane32_swap(__float_as_uint(s2), __float_as_uint(s2), false, false); s2 = __uint_as_float(x[0]) + __uint_as_float(x[1]); }
        inv[mt] = __builtin_amdgcn_rsqf(fmaxf(s2, 1e-24f)); bn[mt] = 0.f; }
    f32x4 tot0[4];
#pragma unroll
    for (int n = 0; n < 4; ++n) tot0[n] = (f32x4){0.f, 0.f, 0.f, 0.f};
#pragma unroll
    for (int st = 0; st < 8; ++st) { const int mt = st >> 2, nt = st & 3; const int j4 = nt * 16 + fq * 4; const size_t col = (size_t)h * 64 + j4;
        v2u cur_[3], prv_[3];
#pragma unroll
        for (int q = 0; q < 3; ++q) { cur_[q] = mt ? cB[nt][q] : cA[nt][q]; PREP_PREV(prv_[q], mt, nt, q); }
        f32x4 cw = (f32x4){0.f, 0.f, 0.f, 0.f}, ca = cw, cg = cw;
#pragma unroll
        for (int ks = 0; ks < 2; ++ks) { cw = MFMA16(*(const LAS bf16x8*)(WL2 + (nt * 16 + fr) * 72 + ks * 32 + 8 * fq), la[ks], cw); ca = MFMA16(*(const LAS bf16x8*)(AL2 + (nt * 16 + fr) * 72 + ks * 32 + 8 * fq), la[2 + ks], ca); }
#pragma unroll
        for (int ks = 0; ks < 5; ++ks) cg = MFMA16(*(const LAS bf16x8*)(GL2 + (nt * 16 + fr) * 168 + ks * 32 + 8 * fq), la[4 + ks], cg);
        if (st == 3) {
#pragma unroll
            for (int ks = 0; ks < 9; ++ks) la[ks] = *(const bf16x8*)(LA + tokm[1] * 288 + ks * 32 + 8 * fq); }
        const f32x4 c_w0 = *(const LAS f32x4*)(CW + j4), c_a0 = *(const LAS f32x4*)(CW + 64 + j4), c_kk = *(const LAS f32x4*)(CW + 128 + j4), c_ka = *(const LAS f32x4*)(CW + 192 + j4), c_rk = *(const LAS f32x4*)(CW + 256 + j4);
        const f32x4 m_r = *(const LAS f32x4*)(CW + 320 + j4), m_k = *(const LAS f32x4*)(CW + 384 + j4), m_v = *(const LAS f32x4*)(CW + 448 + j4);
        const v2u rp = prv_[0], kp = prv_[1], vp = prv_[2];
        const f32x4 rcf = PU4(cur_[0]), kcf = PU4(cur_[1]), vcf = PU4(cur_[2]);
        const f32x4 rr = rcf + (PU4(rp) - rcf) * m_r, kv = kcf + (PU4(kp) - kcf) * m_k, vv = vcf + (PU4(vp) - vcf) * m_v;
        f32x4 nau, bbu, km, cum;
#pragma unroll
        for (int r = 0; r < 4; ++r) { const float av = sigmoid_fast(c_a0[r] + ca[r]), ku = kv[r] * c_kk[r]; km[r] = kv[r] * (1.0f + (av - 1.0f) * c_ka[r]);
            cum[r] = -0.6065306597126334f * sigmoid_fast(c_w0[r] + cw[r]);
            nau[r] = -ku; bbu[r] = ku * av; bn[mt] += rr[r] * km[r] * c_rk[r]; }
        f32x4 at4, rt4, bt4, kt4, ep4;
#pragma unroll
        for (int r = 0; r < 4; ++r) { float v = cum[r];
            v += __builtin_bit_cast(float, __builtin_amdgcn_update_dpp(0, __builtin_bit_cast(int, v), 0x111, 0xf, 0xf, true));
            v += __builtin_bit_cast(float, __builtin_amdgcn_update_dpp(0, __builtin_bit_cast(int, v), 0x112, 0xf, 0xf, true));
            v += __builtin_bit_cast(float, __builtin_amdgcn_update_dpp(0, __builtin_bit_cast(int, v), 0x114, 0xf, 0xf, true));
            v += __builtin_bit_cast(float, __builtin_amdgcn_update_dpp(0, __builtin_bit_cast(int, v), 0x118, 0xf, 0xf, true));
            if (mt == 0) tot0[nt][r] = __shfl(v, (lane & 48) | 15); else v += tot0[nt][r];
            const float ep = __expf(v), em = rcpf_(ep);
            float eprev = __builtin_bit_cast(float, __builtin_amdgcn_update_dpp(0, __builtin_bit_cast(int, ep), 0x111, 0xf, 0xf, true));
            if (fr == 0) eprev = mt ? __expf(tot0[nt][r]) : 1.0f;
            at4[r] = nau[r] * inv[mt] * eprev; rt4[r] = rr[r] * ep; bt4[r] = bbu[r] * inv[mt] * em; kt4[r] = km[r] * em; ep4[r] = ep; }
        { LAS bf16* sp = ST + fr * 64 + j4; v2u w;
          w.x = cvtpk(at4[0], at4[1]); w.y = cvtpk(at4[2], at4[3]); *(LAS v2u*)(sp) = w;
          w.x = cvtpk(rt4[0], rt4[1]); w.y = cvtpk(rt4[2], rt4[3]); *(LAS v2u*)(sp + 1024) = w;
          w.x = cvtpk(bt4[0], bt4[1]); w.y = cvtpk(bt4[2], bt4[3]); *(LAS v2u*)(sp + 2048) = w;
          w.x = cvtpk(kt4[0], kt4[1]); w.y = cvtpk(kt4[2], kt4[3]); *(LAS v2u*)(sp + 3072) = w;
          w.x = cvtpk(vv[0], vv[1]); w.y = cvtpk(vv[2], vv[3]); *(LAS v2u*)(sp + 4096) = w;
          w.x = cvtpk(cg[0], cg[1]); w.y = cvtpk(cg[2], cg[3]); *(LAS v2u*)(sp + 5120) = w; }
        if (nt == 3) {
            bf16* const dstp[6] = {TA, TR, TB, TK, TV, TG};
#pragma unroll
            for (int a6 = 0; a6 < 6; ++a6)
#pragma unroll
                for (int hrow = 0; hrow < 2; ++hrow) { const int row = hrow * 8 + (lane >> 3), c8 = (lane & 7) * 8;
                    const v4u pv = *(const LAS v4u*)(ST + a6 * 1024 + row * 64 + c8);
                    *(v4u*)(dstp[a6] + ((size_t)chunk * 32 + mt * 16 + row) * 1024 + (size_t)h * 64 + c8) = pv; } }
        if (mt == 1 && fr == 15) *(f32x4*)(PCG + (size_t)chunk * 1024 + col) = ep4;
    }
#undef PREP_LOAD_MT
#undef PREP_PREV
#undef DPPU
#undef PU4
#pragma unroll
    for (int mt = 0; mt < 2; ++mt) { float b2 = bn[mt];
        { auto x = __builtin_amdgcn_permlane16_swap(__float_as_uint(b2), __float_as_uint(b2), false, false); b2 = __uint_as_float(x[0]) + __uint_as_float(x[1]); }
        { auto x = __builtin_amdgcn_permlane32_swap(__float_as_uint(b2), __float_as_uint(b2), false, false); b2 = __uint_as_float(x[0]) + __uint_as_float(x[1]); }
        if (fq == 0) BONG[tokm[mt] * 16 + h] = b2; }
}
__device__ __forceinline__ void rwkv_prep_phase(const Frame& F) {
    LAS bf16* WL2 = (LAS bf16*)(F.lds + 0); LAS bf16* AL2 = (LAS bf16*)(F.lds + 9216); LAS bf16* GL2 = (LAS bf16*)(F.lds + 18432); LAS float* CW = (LAS float*)(F.lds + 39936);
    int hcur = -1;
    for (int u = F.bid; u < 1024; u += F.G) { const int h = u & 15, cg = u >> 4;
        if (h != hcur) { hcur = h; __syncthreads();
            int tid_ = F.tid; asm volatile("" : "+v"(tid_));
            const bf16* w2t = WSP(bf16, WS_W2T) + (size_t)h * 64 * 64; const bf16* a2t = WSP(bf16, WS_A2T) + (size_t)h * 64 * 64; const bf16* g2t = WSP(bf16, WS_G2T) + (size_t)h * 64 * 160;
            { const int r = tid_ >> 3, c = (tid_ & 7) * 8; *(LAS v4u*)(WL2 + r * 72 + c) = *(const v4u*)(w2t + r * 64 + c); *(LAS v4u*)(AL2 + r * 72 + c) = *(const v4u*)(a2t + r * 64 + c); }
            for (int i = tid_; i < 64 * 20; i += NTHR) { const int r = i / 20, c = (i - r * 20) * 8; *(LAS v4u*)(GL2 + r * 168 + c) = *(const v4u*)(g2t + r * 160 + c); }
            { const int q = tid_ >> 6, jj = tid_ & 63; const float* src = q == 0 ? F.in[I_W0] : (q == 1 ? F.in[I_A0] : (q == 2 ? F.in[I_KK] : (q == 3 ? F.in[I_KA] : (q == 4 ? F.in[I_RK] : F.in[I_MU] + (q - 5) * 1024)))); CW[q * 64 + jj] = src[h * 64 + jj]; }
            __syncthreads(); }
        rwkv_prep_unit(F, cg * 8 + F.wave, h, F.lane, WL2, AL2, GL2, CW, (LAS bf16*)(F.lds + 43008 + F.wave * 12288)); }
    __syncthreads();
}
typedef short v4i16_t __attribute__((ext_vector_type(4)));
__device__ __forceinline__ bf16x8 frag_tr16(const LAS bf16* p, int ld) {
    const v4i16_t a = __builtin_amdgcn_ds_read_tr16_b64_v4i16((LAS v4i16_t*)p), b = __builtin_amdgcn_ds_read_tr16_b64_v4i16((LAS v4i16_t*)(p + 4 * ld));
    return (bf16x8){a[0], a[1], a[2], a[3], b[0], b[1], b[2], b[3]};
}
#define RD_LOAD(src_, act_, row0_, j_) do { const float* tp_ = (src_) + ((act_) ? ((size_t)((row0_) + ((j_) >> 1)) * D + ((j_) & 1) * 1024) : (size_t)0) + lane * 16; \
        _Pragma("unroll") for (int q_ = 0; q_ < 4; ++q_) th[q_] = *(const f32x4*)(tp_ + q_ * 4); } while (0)
#define RD_PACK(dst_, v_, tq_) do { _Pragma("unroll") for (int q_ = 0; q_ < 4; ++q_) {   \
            const unsigned b0_ = __float_as_uint(__builtin_fmaf(v_[q_][0], tq_, 12582912.0f)), b1_ = __float_as_uint(__builtin_fmaf(v_[q_][1], tq_, 12582912.0f)); \
            const unsigned b2_ = __float_as_uint(__builtin_fmaf(v_[q_][2], tq_, 12582912.0f)), b3_ = __float_as_uint(__builtin_fmaf(v_[q_][3], tq_, 12582912.0f)); \
            dst_[q_] = __builtin_amdgcn_perm(b1_, b0_, 0x0c0c0400u) | __builtin_amdgcn_perm(b3_, b2_, 0x04000c0cu); } } while (0)
#define RD_CONSUME(dstb_, scb_, row0_, j_) do { float am_ = 0.f; \
        _Pragma("unroll") for (int q_ = 0; q_ < 4; ++q_) _Pragma("unroll") for (int e_ = 0; e_ < 4; ++e_) am_ = fmaxf(am_, fabsf(th[q_][e_])); \
        if (((j_) & 1) == 0) { _Pragma("unroll") for (int q_ = 0; q_ < 4; ++q_) tk[q_] = th[q_]; tkm = am_; } \
        else { am_ = fmaxf(am_, tkm); \
            am_ = fmaxf(am_, dppf<0xB1>(am_)); am_ = fmaxf(am_, dppf<0x4E>(am_)); am_ = fmaxf(am_, dppf<0x141>(am_)); am_ = fmaxf(am_, dppf<0x140>(am_)); \
            { auto s_ = __builtin_amdgcn_permlane16_swap(__float_as_uint(am_), __float_as_uint(am_), false, false); am_ = fmaxf(__uint_as_float(s_[0]), __uint_as_float(s_[1])); } \
            { auto s_ = __builtin_amdgcn_permlane32_swap(__float_as_uint(am_), __float_as_uint(am_), false, false); am_ = fmaxf(__uint_as_float(s_[0]), __uint_as_float(s_[1])); } \
            const float tq_ = am_ > 0.f ? 127.0f / am_ : 0.f; const size_t ro_ = (size_t)((row0_) + ((j_) >> 1)); \
            if (lane == 0) (scb_)[ro_] = am_ * (1.0f / 127.0f); \
            v4u o0_, o1_; RD_PACK(o0_, tk, tq_); RD_PACK(o1_, th, tq_); \
            *(v4u*)((dstb_) + ro_ * D + lane * 16) = o0_; *(v4u*)((dstb_) + ro_ * D + 1024 + lane * 16) = o1_; } } while (0)
__device__ __forceinline__ void rwkv_item(const Frame& F, int item) {
    const int b = item >> 4, h = item & 15, wave = F.wave; int tid = F.tid; asm volatile("" : "+v"(tid)); const int lane = tid & 63;
    LAS unsigned char* L = F.lds;
    constexpr int LD64 = 72, LD32 = 40, E0 = 73216;
    LAS bf16* AT = (LAS bf16*)(L + 0);  LAS bf16* BT_ = (LAS bf16*)(L + 4608); LAS bf16* KT_ = (LAS bf16*)(L + 9216); LAS bf16* RT = (LAS bf16*)(L + 13824);
    LAS bf16* VS2 = (LAS bf16*)(L + 18432);
    LAS bf16* GGB2 = (LAS bf16*)(L + 27648);
    LAS bf16* S0B = (LAS bf16*)(L + 36864);
    LAS float* YB2 = (LAS float*)(L + 55296);
    LAS float* BON2 = (LAS float*)(L + 72704);
    LAS float* PC = (LAS float*)(L + 72960);
    LAS bf16* AAK = (LAS bf16*)(L + E0); LAS bf16* ARB = (LAS bf16*)(L + E0 + 2560); LAS bf16* ARK = (LAS bf16*)(L + E0 + 5120);
    LAS bf16* MINV = (LAS bf16*)(L + E0 + 7680);
    LAS bf16* RHS = (LAS bf16*)(L + E0 + 23040);
    LAS bf16* SAB = (LAS bf16*)(L + E0 + 28160);
    static_assert(E0 + 33280 <= LDSCTL_OFF, "rwkv LDS map");
    bf16* Y = WSP(bf16, WS_Y);
#define FRAG(base, row0, ld, ks) (*(const LAS bf16x8*)((base) + ((row0) + fr) * (ld) + (ks) * 32 + 8 * fq))
#define FRAGT(base, col0, ld) frag_tr16((base) + (8 * fq + (fr >> 2)) * (ld) + (col0) + 4 * (fr & 3), (ld))
    const int tt = tid >> 4, j0 = (tid & 15) * 4, hc = h * 64 + j0;
    const f32x4 plw = *(const f32x4*)(F.in[I_LNW] + hc), plb = *(const f32x4*)(F.in[I_LNB] + hc);
    const int lr = (tid & 255) >> 3, lc8 = tid & 7; const bool hi2 = tid >= 256;
    const bf16* srcA[3] = { (hi2 ? WSP(bf16, WS_TR) : WSP(bf16, WS_TA)), (hi2 ? WSP(bf16, WS_TK) : WSP(bf16, WS_TB)), (hi2 ? (const bf16*)F.out + OUT_TG / 2 : (const bf16*)F.out + OUT_TV / 2) };
    const size_t poff = ((size_t)b * SEQ + lr) * 1024 + h * 64 + lc8 * 8;
    const float* PCG = F.out + OUT_PC / 4 + (size_t)(b * 64) * 1024 + h * 64; const float* BONG = F.out + OUT_BON / 4 + (size_t)b * SEQ * 16 + h;
    v4u pl_[3]; float ppc = 0.f, pbn = 0.f;
#define RWKV_PREFETCH(tl_) do { _Pragma("unroll") for (int q_ = 0; q_ < 3; ++q_) pl_[q_] = *(const v4u*)(srcA[q_] + poff + (size_t)(tl_) * 32 * 1024); \
        ppc = PCG[(size_t)(tl_) * 1024 + (tid & 63)]; pbn = BONG[((size_t)(tl_) * 32 + (tid & 31)) * 16]; } while (0)
    const int ib = wave >> 1, tb = wave & 1, i0 = ib * 16, t0m = tb * 16;
    f32x4 sacc[2], yacc;
    sacc[0] = (f32x4){0.f, 0.f, 0.f, 0.f}; sacc[1] = sacc[0]; yacc = sacc[0];
    for (int u = tid; u < 2 * 64 * LD64 / 2; u += NTHR) ((LAS unsigned*)S0B)[u] = 0u;
    RWKV_PREFETCH(0);
    __syncthreads();
    for (int tl = 0; tl <= SEQ / 32; ++tl) {
        const int cur = tl & 1;
        int lane_c = lane; asm volatile("" : "+v"(lane_c)); const int fr = lane_c & 15, fq = lane_c >> 4;
        LAS bf16* VS = VS2 + cur * 32 * LD64; LAS bf16* GGB = GGB2 + cur * 32 * LD64; LAS float* YB = YB2 + cur * 32 * 68; LAS float* BON = BON2 + cur * 32;
        const LAS bf16* VSp = VS2 + (cur ^ 1) * 32 * LD64; const LAS bf16* GGBp = GGB2 + (cur ^ 1) * 32 * LD64; const LAS float* YBp = YB2 + (cur ^ 1) * 32 * 68; const LAS float* BONp = BON2 + (cur ^ 1) * 32;
        if (tl > 0) { const size_t tokb = (size_t)b * SEQ + (tl - 1) * 32;
          const f32x4 y4 = *(const LAS f32x4*)(YBp + tt * 68 + j0); const v2u gw_ = *(const LAS v2u*)(GGBp + tt * LD64 + j0);
          const f32x4 g4 = (f32x4){bf_lo(gw_.x), bf_hi(gw_.x), bf_lo(gw_.y), bf_hi(gw_.y)};
          const v2u vw_ = *(const LAS v2u*)(VSp + tt * LD64 + j0); const f32x4 v4 = (f32x4){bf_lo(vw_.x), bf_hi(vw_.x), bf_lo(vw_.y), bf_hi(vw_.y)};
          float sm = (y4[0] + y4[1]) + (y4[2] + y4[3]); sm = red16(sm); const float mean = sm * (1.0f / 64.0f);
          const f32x4 d4 = y4 - mean; float sv = (d4[0] * d4[0] + d4[1] * d4[1]) + (d4[2] * d4[2] + d4[3] * d4[3]); sv = red16(sv);
          const float rstd = __builtin_amdgcn_rsqf(sv * (1.0f / 64.0f) + GN_EPS), bon = BONp[tt];
          f32x4 o;
#pragma unroll
          for (int e = 0; e < 4; ++e) o[e] = (d4[e] * rstd * plw[e] + plb[e] + bon * v4[e]) * g4[e];
          v2u w; w.x = cvtpk(o[0], o[1]); w.y = cvtpk(o[2], o[3]);
          *(v2u*)(Y + (tokb + tt) * D + 1024 + hc) = w; }
        if (tl == SEQ / 32) break;
        const LAS bf16* S0c = S0B + cur * 64 * LD64; LAS bf16* S0n = S0B + (cur ^ 1) * 64 * LD64;
        { const v4u p0 = pl_[0], p1 = pl_[1], p2 = pl_[2];
          *(LAS v4u*)((hi2 ? RT : AT) + lr * LD64 + lc8 * 8) = p0;
          *(LAS v4u*)((hi2 ? KT_ : BT_) + lr * LD64 + lc8 * 8) = p1;
          *(LAS v4u*)((hi2 ? GGB : VS) + lr * LD64 + lc8 * 8) = p2;
          if (tid < 64) PC[tid] = ppc;
          if (tid >= 64 && tid < 96) BON[tid - 64] = pbn; }
        { const int tn_ = tl + 1 < SEQ / 32 ? tl + 1 : SEQ / 32 - 1; RWKV_PREFETCH(tn_); }
        __syncthreads();
        f32x4 rhs4 = (f32x4){0.f, 0.f, 0.f, 0.f};
#define RWKV_FIRST do { rhs4 = (f32x4){0.f, 0.f, 0.f, 0.f}; yacc = (f32x4){0.f, 0.f, 0.f, 0.f}; \
            _Pragma("unroll") for (int ks = 0; ks < 2; ++ks) rhs4 = MFMA16(FRAG(AT, t0m, LD64, ks), FRAG(S0c, i0, LD64, ks), rhs4); \
            _Pragma("unroll") for (int ks = 0; ks < 2; ++ks) yacc = MFMA16(FRAG(S0c, i0, LD64, ks), FRAG(RT, t0m, LD64, ks), yacc); \
            _Pragma("unroll") for (int u = 0; u < 2; ++u) { const int tile = wave * 2 + u, si0 = (tile >> 2) * 16, sj0 = (tile & 3) * 16; sacc[u] = MFMA16(FRAGT(KT_, sj0, LD64), FRAGT(VS, si0, LD64), sacc[u]); } } while (0)
#define PK8(a_, s_) __builtin_bit_cast(bf16x8, (v4u){cvtpk(a_[8 * (s_) + 0], a_[8 * (s_) + 1]), cvtpk(a_[8 * (s_) + 2], a_[8 * (s_) + 3]), cvtpk(a_[8 * (s_) + 4], a_[8 * (s_) + 5]), cvtpk(a_[8 * (s_) + 6], a_[8 * (s_) + 7])})
        if (wave == 0) {
            const int c32 = lane_c & 31, h32 = lane_c >> 5;
            f32x16 U, V, PT;
#pragma unroll
            for (int e = 0; e < 16; ++e) { U[e] = 0.f; V[e] = 0.f; }
#pragma unroll
            for (int ks = 0; ks < 4; ++ks) { const bf16x8 fa = *(const LAS bf16x8*)(AT + c32 * LD64 + ks * 16 + h32 * 8), fb = *(const LAS bf16x8*)(BT_ + c32 * LD64 + ks * 16 + h32 * 8);
                U = MFMA32(fa, fb, U);
                V = MFMA32(fb, fa, V); }
#pragma unroll
            for (int e = 0; e < 16; ++e) { const int rr = (e & 3) + 8 * (e >> 2) + 4 * h32;
                U[e] = (c32 < rr) ? U[e] : 0.f;
                V[e] = (rr < c32) ? V[e] : 0.f;
                PT[e] = V[e] + ((rr == c32) ? 1.0f : 0.f); }
#pragma unroll
            for (int st = 1; st <= 5; ++st) {
                const bf16x8 fU0 = PK8(U, 0), fU1 = PK8(U, 1);
                f32x16 Un, Vn;
#pragma unroll
                for (int e = 0; e < 16; ++e) { Un[e] = 0.f; Vn[e] = 0.f; }
                if (st < 5) { const bf16x8 fV0 = PK8(V, 0), fV1 = PK8(V, 1);
                    Un = MFMA32(fV0, fU0, Un); Un = MFMA32(fV1, fU1, Un);
                    if (st < 4) { Vn = MFMA32(fU0, fV0, Vn); Vn = MFMA32(fU1, fV1, Vn); } }
                if (st > 1) { const bf16x8 fP0 = PK8(PT, 0), fP1 = PK8(PT, 1);
                    PT = MFMA32(fU0, fP0, PT); PT = MFMA32(fU1, fP1, PT); }
                U = Un; V = Vn; }
#pragma unroll
            for (int q = 0; q < 4; ++q) { v2u w; w.x = cvtpk(PT[4 * q], PT[4 * q + 1]); w.y = cvtpk(PT[4 * q + 2], PT[4 * q + 3]); *(LAS v2u*)(MINV + c32 * LD32 + 8 * q + 4 * h32) = w; }
        } else {
            if (wave < 7) { const int mtx = (wave - 1) >> 1;
                const LAS bf16* Xs = (mtx == 1) ? BT_ : KT_; const LAS bf16* Yt = (mtx == 0) ? AT : RT; LAS bf16* O = (mtx == 0) ? AAK : (mtx == 1 ? ARB : ARK);
#pragma unroll
                for (int qq = 0; qq < 2; ++qq) { const int q = ((wave - 1) & 1) * 2 + qq, tq = (q >> 1) * 16, sq = (q & 1) * 16;
                    f32x4 a4 = (f32x4){0.f, 0.f, 0.f, 0.f};
                    if (sq <= tq) {
#pragma unroll
                        for (int ks = 0; ks < 2; ++ks) a4 = MFMA16(FRAG(Xs, sq, LD64, ks), FRAG(Yt, tq, LD64, ks), a4); }
                    const int t = tq + fr, s = sq + fq * 4;
#pragma unroll
                    for (int r = 0; r < 4; ++r) { const bool keep = (mtx == 0) ? (s + r < t) : (s + r <= t); a4[r] = keep ? a4[r] : 0.f; }
                    v2u w; w.x = cvtpk(a4[0], a4[1]); w.y = cvtpk(a4[2], a4[3]); *(LAS v2u*)(O + t * LD32 + s) = w; } }
            RWKV_FIRST;
        }
        __syncthreads();
        if (wave == 0) RWKV_FIRST;
        { rhs4 = MFMA16(FRAG(AAK, t0m, LD32, 0), FRAGT(VS, i0, LD64), rhs4);
          v2u w; w.x = cvtpk(rhs4[0], rhs4[1]); w.y = cvtpk(rhs4[2], rhs4[3]); *(LAS v2u*)(RHS + (i0 + fr) * LD32 + t0m + fq * 4) = w;
          yacc = MFMA16(FRAGT(VS, i0, LD64), FRAG(ARK, t0m, LD32, 0), yacc); }
        __syncthreads();
#undef RWKV_FIRST
#undef PK8
        { f32x4 a4 = (f32x4){0.f, 0.f, 0.f, 0.f}; a4 = MFMA16(FRAG(MINV, t0m, LD32, 0), FRAG(RHS, i0, LD32, 0), a4);
          v2u w; w.x = cvtpk(a4[0], a4[1]); w.y = cvtpk(a4[2], a4[3]); *(LAS v2u*)(SAB + (i0 + fr) * LD32 + t0m + fq * 4) = w; }
        __syncthreads();
        { yacc = MFMA16(FRAG(SAB, i0, LD32, 0), FRAG(ARB, t0m, LD32, 0), yacc);
          *(LAS f32x4*)(YB + (t0m + fr) * 68 + i0 + fq * 4) = yacc;
#pragma unroll
          for (int u = 0; u < 2; ++u) { const int tile = wave * 2 + u, si0 = (tile >> 2) * 16, sj0 = (tile & 3) * 16;
              sacc[u] = MFMA16(FRAGT(BT_, sj0, LD64), FRAG(SAB, si0, LD32, 0), sacc[u]);
              const f32x4 pc = *(const LAS f32x4*)(PC + sj0 + fq * 4); sacc[u] = sacc[u] * pc;
              v2u w; w.x = cvtpk(sacc[u][0], sacc[u][1]); w.y = cvtpk(sacc[u][2], sacc[u][3]); *(LAS v2u*)(S0n + (si0 + fr) * LD64 + sj0 + fq * 4) = w; } }
        __syncthreads();
    }
    __syncthreads();
#undef FRAG
#undef FRAGT
#undef RWKV_PREFETCH
}
__device__ __forceinline__ void lora_prepass(const Frame& F) {
    const bf16* PROJ = WSP(bf16, WS_PROJ); bf16* LA = WSP(bf16, WS_LA); const float* mu = F.in[I_MU] + (PC_WD - RWKV_C0);
    const int gt = (F.bid * NWAVES + F.wave) * 64 + F.lane, NGT = F.G * NTHR;
    for (int i = gt; i < T * 36; i += NGT) { const int tok = i / 36, cc = i - tok * 36, m = cc * 8;
        const bf16* pr = PROJ + (size_t)tok * NINP + PC_WD + m;
        const v4u curv = *(const v4u*)pr; v4u prv = (v4u){0u, 0u, 0u, 0u}; if ((tok & (SEQ - 1)) != 0) prv = *(const v4u*)(pr - NINP);
        const f32x4 m0 = *(const f32x4*)(mu + m), m1 = *(const f32x4*)(mu + m + 4);
        float c[8], p[8], o[8]; unpack8(curv, c); unpack8(prv, p);
#pragma unroll
        for (int e = 0; e < 8; ++e) { const float ps = c[e] + (p[e] - c[e]) * (e < 4 ? m0[e] : m1[e - 4]); o[e] = (m < 64) ? tanh_fast(ps) : ((m < 128) ? ps : sigmoid_fast(ps)); }
        v4u w; w.x = cvtpk(o[0], o[1]); w.y = cvtpk(o[2], o[3]); w.z = cvtpk(o[4], o[5]); w.w = cvtpk(o[6], o[7]);
        *(v4u*)(LA + (size_t)tok * 288 + m) = w; }
}
__device__ __forceinline__ void lru_seq(const Frame& F, int item) {
    const int bh = item >> 1, hf = item & 1, b = bh >> 3, h = bh & 7, wave = F.wave; int tid = F.tid; asm volatile("" : "+v"(tid)); const int lane = tid & 63;
    constexpr int TT = 128, NTK = SEQ / TT;
    LAS unsigned char* L = F.lds;
    LAS bf16* XA = (LAS bf16*)(L + 0);
    LAS float* XC = (LAS float*)(L + 34816);
    LAS float* RI = (LAS float*)(L + 67584);
    LAS float* SEG = (LAS float*)(L + 133120);
    LAS float* CARRY = (LAS float*)(L + 137216);
    LAS float* CW = (LAS float*)(L + 137728);
    static_assert(137728 + 2560 <= LDSCTL_OFF, "lru LDS map");
    const bf16* PROJ = WSP(bf16, WS_PROJ); bf16* Y = WSP(bf16, WS_Y);
    const int fr0 = lane & 15, fq0 = lane >> 4;
    for (int i = tid; i < 640; i += NTHR) { const int w = i >> 7, cch = i & 127; CW[i] = (w < 4) ? F.in[I_CONVW][w * 1024 + h * 128 + cch] : F.in[I_CONVB][h * 128 + cch]; }
    if (tid < 128) CARRY[tid] = 0.f;
    const int gsel = wave & 1, ntl = wave >> 1, ntg = hf * 4 + ntl;
    bf16x8 wf[4];
    { const bf16* WTp = (gsel ? WSP(bf16, WS_WIT) : WSP(bf16, WS_WAT)) + (size_t)h * 128 * 128;
#pragma unroll
      for (int ks = 0; ks < 4; ++ks) wf[ks] = *(const bf16x8*)(WTp + (ntg * 16 + fr0) * 128 + ks * 32 + 8 * fq0); }
    const int c = tid & 63, sg = tid >> 6, chl = hf * 64 + c, chg = h * 128 + chl;
    const float ba_c = F.in[I_BA][chg], bi_c = F.in[I_BI][chg], sp8 = 8.0f * softplus_fast(-F.in[I_LAM][chg]);
    const int tq = tid >> 4, c8 = (tid & 15) * 8; const bool myhalf = ((tid & 15) >> 3) == hf;
    v4u pf[7];
#define LRU_PREFETCH(k_) do { _Pragma("unroll") for (int j_ = 0; j_ < 7; ++j_) { const int ts_ = (k_) * TT + 4 * tq - 3 + j_; const int tc_ = ts_ >= 0 ? ts_ : 0;   \
            const v4u x_ = *(const v4u*)(PROJ + ((size_t)b * SEQ + tc_) * NINP + h * 128 + c8); const unsigned m_ = ts_ >= 0 ? 0xffffffffu : 0u; \
            pf[j_] = (v4u){x_.x & m_, x_.y & m_, x_.z & m_, x_.w & m_}; } } while (0)
    unsigned short gtn[16];
#define LRU_GATES(k_) do { _Pragma("unroll") for (int e_ = 0; e_ < 16; ++e_) gtn[e_] = PROJ[((size_t)b * SEQ + (k_) * TT + sg * 16 + e_) * NINP + PC_GATE + chg]; } while (0)
    const int ttab = item >> 6, trow0 = ((item & 63) * 8 + wave) * 32;
    const float* tsrc = ttab ? F.in[I_V] : F.in[I_U]; unsigned char* tdst = ttab ? WSP(unsigned char, WS_VT) : WSP(unsigned char, WS_UT); float* tsc = ttab ? WSP(float, WS_VSC) : WSP(float, WS_USC);
    f32x4 th[4], tk[4]; float tkm = 0.f;
#pragma unroll
    for (int q = 0; q < 4; ++q) tk[q] = (f32x4){0.f, 0.f, 0.f, 0.f};
    LRU_PREFETCH(0); LRU_GATES(0);
    RD_LOAD(tsrc, true, trow0, 0);
    __syncthreads();
    for (int k = 0; k < NTK; ++k) {
        const size_t tokbase = (size_t)b * SEQ + k * TT;
        int lane_c = lane; asm volatile("" : "+v"(lane_c)); const int fr = lane_c & 15, fq = lane_c >> 4;
        { float xr[7][8];
#pragma unroll
          for (int j = 0; j < 7; ++j) unpack8(pf[j], xr[j]);
          const f32x4 b0 = *(const LAS f32x4*)(CW + 512 + c8), b1 = *(const LAS f32x4*)(CW + 512 + c8 + 4);
          f32x4 w0[4], w1[4];
#pragma unroll
          for (int w = 0; w < 4; ++w) { w0[w] = *(const LAS f32x4*)(CW + w * 128 + c8); w1[w] = *(const LAS f32x4*)(CW + w * 128 + c8 + 4); }
#pragma unroll
          for (int u = 0; u < 4; ++u) { const int t = 4 * tq + u; float acc[8];
#pragma unroll
              for (int e = 0; e < 4; ++e) { acc[e] = b0[e]; acc[e + 4] = b1[e]; }
#pragma unroll
              for (int w = 0; w < 4; ++w)
#pragma unroll
                  for (int e = 0; e < 4; ++e) { acc[e] += w0[w][e] * xr[u + w][e]; acc[e + 4] += w1[w][e] * xr[u + w][e + 4]; }
              v4u pk; pk.x = cvtpk(acc[0], acc[1]); pk.y = cvtpk(acc[2], acc[3]); pk.z = cvtpk(acc[4], acc[5]); pk.w = cvtpk(acc[6], acc[7]);
              *(LAS v4u*)(XA + t * 136 + c8) = pk;
              if (myhalf) { LAS float* d = XC + t * 64 + (c8 & 63); *(LAS f32x4*)d = (f32x4){acc[0], acc[1], acc[2], acc[3]}; *(LAS f32x4*)(d + 4) = (f32x4){acc[4], acc[5], acc[6], acc[7]}; } } }
        float gl[16];
#pragma unroll
        for (int e = 0; e < 16; ++e) gl[e] = gelu_fast(__uint_as_float((unsigned)gtn[e] << 16));
        { const int kn_ = k + 1 < NTK ? k + 1 : NTK - 1; LRU_PREFETCH(kn_); LRU_GATES(kn_); }
        RD_CONSUME(tdst, tsc, trow0, 4 * k);
        RD_LOAD(tsrc, true, trow0, 4 * k + 1);
        __syncthreads();
#pragma unroll
        for (int mt = 0; mt < TT / 16; ++mt) {
            bf16x8 af[4];
#pragma unroll
            for (int ks = 0; ks < 4; ++ks) af[ks] = *(const LAS bf16x8*)(XA + (mt * 16 + fr) * 136 + ks * 32 + 8 * fq);
            { f32x4 a4 = (f32x4){0.f, 0.f, 0.f, 0.f};
#pragma unroll
                for (int ks = 0; ks < 4; ++ks) a4 = MFMA16(wf[ks], af[ks], a4);
                *(LAS f32x4*)(RI + gsel * (TT * 64) + (mt * 16 + fr) * 64 + ntl * 16 + fq * 4) = a4; } }
        __syncthreads();
        RD_CONSUME(tdst, tsc, trow0, 4 * k + 1);
        RD_LOAD(tsrc, true, trow0, 4 * k + 2);
        float av[16], bx[16]; float A = 1.f, B = 0.f;
#pragma unroll
        for (int e = 0; e < 16; ++e) { const int t = sg * 16 + e; const float r = sigmoid_fast(RI[t * 64 + c] + ba_c), ig = sigmoid_fast(RI[TT * 64 + t * 64 + c] + bi_c), xc = XC[t * 64 + c];
            const float la = -sp8 * r; av[e] = __expf(la); bx[e] = sqrtf(fmaxf(1.0f - av[e] * av[e], 0.f)) * (ig * xc); A *= av[e]; B = av[e] * B + bx[e]; }
        SEG[(sg * 64 + c) * 2] = A; SEG[(sg * 64 + c) * 2 + 1] = B;
        RD_CONSUME(tdst, tsc, trow0, 4 * k + 2);
        RD_LOAD(tsrc, true, trow0, 4 * k + 3);
        __syncthreads();
        float hst = CARRY[(k & 1) * 64 + c];
        for (int s2 = 0; s2 < sg; ++s2) hst = SEG[(s2 * 64 + c) * 2] * hst + SEG[(s2 * 64 + c) * 2 + 1];
#pragma unroll
        for (int e = 0; e < 16; ++e) { hst = av[e] * hst + bx[e];
            Y[(tokbase + sg * 16 + e) * D + chg] = (bf16)(cvtpk(hst * gl[e], 0.f) & 0xffffu); }
        if (sg == 7) CARRY[((k + 1) & 1) * 64 + c] = hst;
        RD_CONSUME(tdst, tsc, trow0, 4 * k + 3);
        { const int kn_ = k + 1 < NTK ? k + 1 : NTK - 1; RD_LOAD(tsrc, true, trow0, 4 * kn_); }
    }
    __syncthreads();
#undef LRU_PREFETCH
#undef LRU_GATES
}
__device__ __forceinline__ void group_barrier(unsigned* cnt, unsigned n) {
    asm volatile("s_waitcnt vmcnt(0)" ::: "memory");
    __syncthreads();
    if (threadIdx.x == 0) {
        __builtin_amdgcn_fence(__ATOMIC_RELEASE, "agent");
        asm volatile("s_waitcnt vmcnt(0)" ::: "memory");
        xb_add(cnt, 1u);
        unsigned sp = 0; while (xb_ld(cnt) < n) { __builtin_amdgcn_s_sleep(2); if (++sp > (1u << 24)) break; }
        __builtin_amdgcn_fence(__ATOMIC_ACQUIRE, "agent");
        asm volatile("s_waitcnt vmcnt(0)" ::: "memory");
    }
    __syncthreads();
}

__device__ __forceinline__ unsigned f2ord(float f) { const unsigned u = __builtin_bit_cast(unsigned, f); return (u & 0x80000000u) ? ~u : (u | 0x80000000u); }
__device__ __forceinline__ float ord2f(unsigned o) { const unsigned u = (o & 0x80000000u) ? (o & 0x7fffffffu) : ~o; return __builtin_bit_cast(float, u); }
#define CMPX(hi_, lo_) do { const unsigned _a = (hi_), _b = (lo_); (hi_) = _a > _b ? _a : _b; (lo_) = _a > _b ? _b : _a; } while (0)
template <int N> __device__ __forceinline__ void sort_desc(unsigned (&a)[N]) {
#pragma unroll
    for (int k = 2; k <= N; k <<= 1)
#pragma unroll
        for (int j = k >> 1; j > 0; j >>= 1)
#pragma unroll
            for (int i = 0; i < N; ++i) { const int l = i ^ j; if (l > i) { if ((i & k) == 0) CMPX(a[i], a[l]); else CMPX(a[l], a[i]); } }
}
__device__ __forceinline__ void merge16(unsigned (&A)[16], const unsigned (&B)[16]) {
#pragma unroll
    for (int i = 0; i < 16; ++i) { const unsigned q = B[15 - i]; A[i] = A[i] > q ? A[i] : q; }
#pragma unroll
    for (int d = 8; d >= 1; d >>= 1)
#pragma unroll
        for (int i = 0; i < 16; ++i) if ((i & d) == 0) CMPX(A[i], A[i + d]);
}
__device__ __forceinline__ void merge_partner(unsigned (&Lk)[16]) {
    unsigned P[16];
#pragma unroll
    for (int i = 0; i < 16; ++i) P[i] = (unsigned)__shfl_xor((int)Lk[i], 32);
#pragma unroll
    for (int i = 0; i < 16; ++i) { const unsigned q = P[15 - i]; Lk[i] = Lk[i] > q ? Lk[i] : q; }
#pragma unroll
    for (int d = 8; d >= 1; d >>= 1)
#pragma unroll
        for (int i = 0; i < 16; ++i) if ((i & d) == 0) CMPX(Lk[i], Lk[i + d]);
}
__device__ __forceinline__ void route_item(const Frame& F, int item, int lane) {
    const int tok0 = (item >> 3) * 32, h = item & 7, c = lane & 31, hi = lane >> 5;
    const bf16* Q = WSP(bf16, WS_Q); const bf16* KB = WSP(bf16, WS_KEYS);
    LAS unsigned* WL = (LAS unsigned*)(F.lds + F.wave * 8192);
    unsigned LST[2][16];
    bf16x8 qf[8], qn[8], kf[8], kn[8];
#pragma unroll
    for (int ks = 0; ks < 8; ++ks) { qf[ks] = *(const bf16x8*)(Q + (size_t)(tok0 + c) * D + h * 256 + ks * 16 + 8 * hi); qn[ks] = *(const bf16x8*)(Q + (size_t)(tok0 + c) * D + h * 256 + 128 + ks * 16 + 8 * hi);
        kf[ks] = *(const bf16x8*)(KB + (size_t)((h * 2) * 128 + c) * 128 + 8 * hi + ks * 16); }
    unsigned Lk[16];
#pragma unroll
    for (int st = 0; st < 8; ++st) { const int p = st >> 2, m = st & 3;
        if (st < 7) { const int p2 = (st + 1) >> 2, m2 = (st + 1) & 3; const bf16* kp = KB + (size_t)((h * 2 + p2) * 128 + m2 * 32 + c) * 128 + 8 * hi;
#pragma unroll
            for (int ks = 0; ks < 8; ++ks) kn[ks] = *(const bf16x8*)(kp + ks * 16); }
        f32x16 acc;
#pragma unroll
        for (int r = 0; r < 16; ++r) acc[r] = 0.f;
#pragma unroll
        for (int ks = 0; ks < 8; ++ks) acc = MFMA32(kf[ks], p ? qn[ks] : qf[ks], acc);
        unsigned G16[16];
#pragma unroll
        for (int r = 0; r < 16; ++r) { const unsigned idx = (unsigned)(m * 32 + (r & 3) + 8 * (r >> 2)) | ((unsigned)hi << 2); G16[r] = (f2ord(acc[r]) & ~0x7Fu) | idx; }
        sort_desc<16>(G16);
        if (m == 0) {
#pragma unroll
            for (int i = 0; i < 16; ++i) Lk[i] = G16[i]; }
        else merge16(Lk, G16);
        if (m == 3) { merge_partner(Lk);
#pragma unroll
            for (int i = 0; i < 16; ++i) { LST[p][i] = Lk[i]; WL[(p * 16 + i) * 64 + lane] = Lk[i] & 0x7Fu; } }
#pragma unroll
        for (int ks = 0; ks < 8; ++ks) kf[ks] = kn[ks];
    }
    float va[4], vb[16];
#pragma unroll
    for (int i = 0; i < 4; ++i) va[i] = ord2f((hi ? LST[1][i] : LST[0][i]) & ~0x7Fu);
#pragma unroll
    for (int j = 0; j < 16; ++j) vb[j] = ord2f((hi ? LST[0][j] : LST[1][j]) & ~0x7Fu);
    unsigned C32[32];
#pragma unroll
    for (int i = 0; i < 32; ++i) C32[i] = 0u;
#pragma unroll
    for (int i = 0; i < 4; ++i) { const unsigned key = (f2ord(va[i] + vb[i]) & ~0xFFu) | (unsigned)(i * 17); C32[i] = hi ? 0u : key; }
    { int cn = 4;
#pragma unroll
      for (int i = 0; i < 3; ++i)
#pragma unroll
          for (int j = i + 1; j < 16; ++j) if ((i + 1) * (j + 1) <= 16) { const unsigned code = hi ? (unsigned)(j * 16 + i) : (unsigned)(i * 16 + j); C32[cn] = (f2ord(va[i] + vb[j]) & ~0xFFu) | code; ++cn; } }
    sort_desc<32>(C32);
    unsigned Ck[16];
#pragma unroll
    for (int i = 0; i < 16; ++i) Ck[i] = C32[i];
    merge_partner(Ck);
    const float mx = ord2f(Ck[0] & ~0xFFu); float den = 0.f;
#pragma unroll
    for (int k = 0; k < 16; ++k) den += __expf(ord2f(Ck[k] & ~0xFFu) - mx);
    const float rden = 1.0f / den;
    int eo[8]; float go[8];
#pragma unroll
    for (int k = 0; k < 8; ++k) { const unsigned fm = hi ? Ck[k + 8] : Ck[k]; const unsigned code = fm & 0xFFu;
        const unsigned k0 = WL[(code >> 4) * 64 + lane], k1 = WL[(16 + (code & 15u)) * 64 + lane];
        eo[k] = (int)(k0 * 128u + k1); go[k] = __expf(ord2f(fm & ~0xFFu) - mx) * rden; }
    unsigned short* ep = WSP(unsigned short, WS_EXP) + (size_t)(tok0 + c) * NSEL + h * 16 + hi * 8; float* gp = WSP(float, WS_GATE) + (size_t)(tok0 + c) * NSEL + h * 16 + hi * 8;
    *(v4u*)ep = (v4u){(unsigned)eo[0] | ((unsigned)eo[1] << 16), (unsigned)eo[2] | ((unsigned)eo[3] << 16), (unsigned)eo[4] | ((unsigned)eo[5] << 16), (unsigned)eo[6] | ((unsigned)eo[7] << 16)};
    *(f32x4*)gp = (f32x4){go[0], go[1], go[2], go[3]}; *(f32x4*)(gp + 4) = (f32x4){go[4], go[5], go[6], go[7]};
}

typedef float f32x2 __attribute__((ext_vector_type(2)));
__device__ __forceinline__ int dot4i(unsigned a, unsigned b, int c) { return __builtin_amdgcn_sdot4((int)a, (int)b, c, false); }
template <int CTRL> __device__ __forceinline__ int dppi(int x) { return __builtin_amdgcn_mov_dpp(x, CTRL, 0xf, 0xf, true); }
struct PeerGeom { int ngrp, g, rank, nrank; };
__device__ __forceinline__ PeerGeom peer_geom(const Frame& F) { PeerGeom p; p.ngrp = (F.G % 8 == 0) ? 8 : 1; p.g = F.bid % p.ngrp; p.rank = F.bid / p.ngrp; p.nrank = F.G / p.ngrp; return p; }
__device__ __forceinline__ void xquant_token(const Frame& F, int tok, int lane) {
    const bf16* xr = WSP(bf16, WS_XB) + (size_t)tok * D + lane * 16; float xf[32]; float am = 0.f, sq = 0.f;
#pragma unroll
    for (int hh = 0; hh < 2; ++hh)
#pragma unroll
        for (int q = 0; q < 2; ++q) { const v4u w = *(const v4u*)(xr + hh * 1024 + q * 8); float t8[8]; unpack8(w, t8);
            const f32x4 g0 = *(const f32x4*)(F.in[I_G2N] + hh * 1024 + lane * 16 + q * 8), g1 = *(const f32x4*)(F.in[I_G2N] + hh * 1024 + lane * 16 + q * 8 + 4);
#pragma unroll
            for (int e = 0; e < 8; ++e) { const float xg = t8[e] * (e < 4 ? g0[e & 3] : g1[e & 3]); xf[hh * 16 + q * 8 + e] = xg; am = fmaxf(am, fabsf(xg)); sq += t8[e] * t8[e]; } }
#pragma unroll
    for (int o = 1; o < 64; o <<= 1) am = fmaxf(am, __shfl_xor(am, o));
    sq = wave_sum(sq);
    const float qs = am > 0.f ? 127.0f / am : 0.f;
    if (lane == 0) { WSP(float, WS_SX)[tok] = am * (1.0f / 127.0f); WSP(float, WS_SSQ2)[tok] = sq; }
#pragma unroll
    for (int hh = 0; hh < 2; ++hh) { v4u o;
#pragma unroll
        for (int d = 0; d < 4; ++d) { unsigned w = 0u;
#pragma unroll
            for (int e = 0; e < 4; ++e) { const int qi = (int)rintf(xf[hh * 16 + d * 4 + e] * qs); w |= ((unsigned)qi & 0xFFu) << (8 * e); }
            o[d] = w; }
        *(v4u*)(WSP(unsigned char, WS_XQ) + (size_t)tok * D + hh * 1024 + lane * 16) = o; }
}
__device__ __forceinline__ void yquant_tokens(const Frame& F, int tokA, int tokB, int lane) {
    v4u ra[2][2], rb[2][2];
#pragma unroll
    for (int hh = 0; hh < 2; ++hh)
#pragma unroll
        for (int q = 0; q < 2; ++q) { ra[hh][q] = *(const v4u*)(WSP(bf16, WS_Y) + (size_t)tokA * D + hh * 1024 + lane * 16 + q * 8); rb[hh][q] = *(const v4u*)(WSP(bf16, WS_Y) + (size_t)tokB * D + hh * 1024 + lane * 16 + q * 8); }
#define YQ_ONE(R_, tok_) do { float xf_[32]; float am_ = 0.f; \
        _Pragma("unroll") for (int hh_ = 0; hh_ < 2; ++hh_) _Pragma("unroll") for (int q_ = 0; q_ < 2; ++q_) { float t8_[8]; unpack8(R_[hh_][q_], t8_); \
            _Pragma("unroll") for (int e_ = 0; e_ < 8; ++e_) { xf_[hh_ * 16 + q_ * 8 + e_] = t8_[e_]; am_ = fmaxf(am_, fabsf(t8_[e_])); } } \
        am_ = fmaxf(am_, dppf<0xB1>(am_)); am_ = fmaxf(am_, dppf<0x4E>(am_)); am_ = fmaxf(am_, dppf<0x141>(am_)); am_ = fmaxf(am_, dppf<0x140>(am_)); \
        { auto s_ = __builtin_amdgcn_permlane16_swap(__float_as_uint(am_), __float_as_uint(am_), false, false); am_ = fmaxf(__uint_as_float(s_[0]), __uint_as_float(s_[1])); } \
        { auto s_ = __builtin_amdgcn_permlane32_swap(__float_as_uint(am_), __float_as_uint(am_), false, false); am_ = fmaxf(__uint_as_float(s_[0]), __uint_as_float(s_[1])); } \
        const float qs_ = am_ > 0.f ? 127.0f / am_ : 0.f; \
        if (lane == 0) WSP(float, WS_SY)[tok_] = am_ * (1.0f / 127.0f); \
        _Pragma("unroll") for (int hh_ = 0; hh_ < 2; ++hh_) { v4u o_; \
            _Pragma("unroll") for (int d_ = 0; d_ < 4; ++d_) { \
                const unsigned b0_ = __float_as_uint(__builtin_fmaf(xf_[hh_ * 16 + d_ * 4 + 0], qs_, 12582912.0f)), b1_ = __float_as_uint(__builtin_fmaf(xf_[hh_ * 16 + d_ * 4 + 1], qs_, 12582912.0f)); \
                const unsigned b2_ = __float_as_uint(__builtin_fmaf(xf_[hh_ * 16 + d_ * 4 + 2], qs_, 12582912.0f)), b3_ = __float_as_uint(__builtin_fmaf(xf_[hh_ * 16 + d_ * 4 + 3], qs_, 12582912.0f)); \
                o_[d_] = __builtin_amdgcn_perm(b1_, b0_, 0x0c0c0400u) | __builtin_amdgcn_perm(b3_, b2_, 0x04000c0cu); } \
            *(v4u*)(WSP(unsigned char, WS_YQ) + (size_t)(tok_) * D + hh_ * 1024 + lane * 16) = o_; } } while (0)
    YQ_ONE(ra, tokA);
    if (tokB != tokA) YQ_ONE(rb, tokB);
#undef YQ_ONE
}
struct PeerIds { unsigned w; };
__device__ __forceinline__ PeerIds peer_ids_load(const Frame& F, int tok, int lane) { PeerIds r; r.w = WSP(unsigned, WS_EXP)[(size_t)tok * (NSEL / 2) + lane]; return r; }
struct PeerScoreBuf { v4u w[16]; v4u xs; };
__device__ __forceinline__ void peer_score_issue(const Frame& F, int tok, int slice, int lane, LAS int* wl, const PeerIds& id, PeerScoreBuf& B) {
    const int e8 = lane >> 3, c16 = lane & 7;
    *(LAS v2u*)(wl + 2 * lane) = (v2u){id.w & 0xffffu, id.w >> 16};
    B.xs = *(const v4u*)(WSP(unsigned char, WS_XQ) + (size_t)tok * D + slice * 128 + c16 * 16);
    const unsigned char* ub = WSP(unsigned char, WS_UT); const unsigned lo = (unsigned)(slice * 128 + c16 * 16);
#pragma unroll
    for (int ld = 0; ld < 16; ++ld) { const unsigned eid = (unsigned)wl[e8 * 16 + ld]; B.w[ld] = *(const v4u*)(ub + (eid * 2048u + lo)); }
}
__device__ __forceinline__ void peer_score_consume(const Frame& F, int tok, int slice, int lane, const PeerScoreBuf& B, bool valid) {
    int p[16];
#pragma unroll
    for (int ld = 0; ld < 16; ++ld) { const v4u w = B.w[ld]; int a = dot4i(w.x, B.xs.x, 0); a = dot4i(w.y, B.xs.y, a); a = dot4i(w.z, B.xs.z, a); p[ld] = dot4i(w.w, B.xs.w, a); }
    { const bool up = (lane & 4) != 0;
#pragma unroll
      for (int k = 0; k < 8; ++k) { const int keep = up ? p[k + 8] : p[k], send = up ? p[k] : p[k + 8]; p[k] = keep + dppi<0x141>(send); } }
    { const bool up = (lane & 2) != 0;
#pragma unroll
      for (int k = 0; k < 4; ++k) { const int keep = up ? p[k + 4] : p[k], send = up ? p[k] : p[k + 4]; p[k] = keep + dppi<0x4E>(send); } }
    { const bool up = (lane & 1) != 0;
#pragma unroll
      for (int k = 0; k < 2; ++k) { const int keep = up ? p[k + 2] : p[k], send = up ? p[k] : p[k + 2]; p[k] = keep + dppi<0xB1>(send); } }
    if (valid) { unsigned* dst = WSP(unsigned, WS_PART) + ((size_t)slice * T + tok) * (NSEL / 2) + lane;
        __builtin_nontemporal_store(((unsigned)((p[0] + 32) >> 6) & 0xffffu) | ((unsigned)((p[1] + 32) >> 6) << 16), dst); }
}
__device__ __forceinline__ void peer_score_phase(const Frame& F, const PeerGeom& pg, LAS int* wl2) {
    const int lane = F.lane, first = pg.rank * NWAVES + F.wave, step = pg.nrank * NWAVES, n = first < T ? (T - first + step - 1) / step : 0;
    LAS int* wlA = wl2; LAS int* wlB = wl2 + 256;
#define PEER_TOKC(k_) ((first + (k_) * step) < T ? (first + (k_) * step) : T - 1)
    for (int r = 0; r < 16 / pg.ngrp; ++r) { const int slice = r * pg.ngrp + pg.g;
        PeerScoreBuf A, B; PeerIds id = peer_ids_load(F, PEER_TOKC(0), lane);
        { const PeerIds cur = id; id = peer_ids_load(F, PEER_TOKC(1), lane); asm volatile("" ::: "memory"); peer_score_issue(F, PEER_TOKC(0), slice, lane, wlA, cur, A); }
        for (int i = 0; i < n; i += 2) {
            { const PeerIds cur = id; id = peer_ids_load(F, PEER_TOKC(i + 2), lane); asm volatile("" ::: "memory"); peer_score_issue(F, PEER_TOKC(i + 1), slice, lane, wlB, cur, B); }
            peer_score_consume(F, first + i * step, slice, lane, A, true);
            { const PeerIds cur = id; id = peer_ids_load(F, PEER_TOKC(i + 3), lane); asm volatile("" ::: "memory"); peer_score_issue(F, PEER_TOKC(i + 2), slice, lane, wlA, cur, A); }
            peer_score_consume(F, first + (i + 1) * step, slice, lane, B, i + 1 < n);
        }
    }
}
template <int NT> __device__ __forceinline__ void peer_coef_tokens(const Frame& F, const int (&tok)[NT], const bool (&valid)[NT], int lane) {
    unsigned pv[NT][16], exw[NT]; f32x2 ga[NT]; float sx[NT], sq[NT];
#pragma unroll
    for (int i = 0; i < NT; ++i) {
#pragma unroll
        for (int s = 0; s < 16; ++s) pv[i][s] = WSP(unsigned, WS_PART)[((size_t)s * T + tok[i]) * (NSEL / 2) + lane];
        exw[i] = WSP(unsigned, WS_EXP)[(size_t)tok[i] * (NSEL / 2) + lane]; ga[i] = *(const f32x2*)(WSP(float, WS_GATE) + (size_t)tok[i] * NSEL + lane * 2);
        sx[i] = WSP(float, WS_SX)[tok[i]]; sq[i] = WSP(float, WS_SSQ2)[tok[i]]; }
    float us0[NT], us1[NT], vs0[NT], vs1[NT];
#pragma unroll
    for (int i = 0; i < NT; ++i) { const unsigned e0 = exw[i] & 0xffffu, e1 = exw[i] >> 16;
        us0[i] = WSP(float, WS_USC)[e0]; us1[i] = WSP(float, WS_USC)[e1]; vs0[i] = WSP(float, WS_VSC)[e0]; vs1[i] = WSP(float, WS_VSC)[e1]; }
#pragma unroll
    for (int i = 0; i < NT; ++i) { int s0 = 0, s1 = 0;
#pragma unroll
        for (int s = 0; s < 16; ++s) { s0 += (int)(pv[i][s] << 16) >> 16; s1 += (int)pv[i][s] >> 16; }
        s0 <<= 6; s1 <<= 6;
        const float rs = sx[i] * (1.0f / sqrtf(sq[i] * (1.0f / D) + NORM_EPS));
        const float sc0 = (float)s0 * us0[i] * rs, sc1 = (float)s1 * us1[i] * rs;
        f32x2 c; c.x = ga[i].x * gelu_fast(sc0) * vs0[i]; c.y = ga[i].y * gelu_fast(sc1) * vs1[i];
        float cm = fmaxf(fabsf(c.x), fabsf(c.y));
        cm = fmaxf(cm, dppf<0xB1>(cm)); cm = fmaxf(cm, dppf<0x4E>(cm)); cm = fmaxf(cm, dppf<0x141>(cm)); cm = fmaxf(cm, dppf<0x140>(cm));
        { auto t = __builtin_amdgcn_permlane16_swap(__float_as_uint(cm), __float_as_uint(cm), false, false); cm = fmaxf(__uint_as_float(t[0]), __uint_as_float(t[1])); }
        { auto t = __builtin_amdgcn_permlane32_swap(__float_as_uint(cm), __float_as_uint(cm), false, false); cm = fmaxf(__uint_as_float(t[0]), __uint_as_float(t[1])); }
        const float qs = cm > 0.f ? 127.0f / cm : 0.f;
        const int q0 = (int)rintf(c.x * qs), q1 = (int)rintf(c.y * qs);
        if (valid[i]) { ((unsigned short*)(F.ws + WS_COEF))[(size_t)tok[i] * 64 + lane] = (unsigned short)(((unsigned)q0 & 0xFFu) | (((unsigned)q1 & 0xFFu) << 8));
            if (lane == 0) WSP(float, WS_CSC)[tok[i]] = cm * (1.0f / 127.0f); } }
}
struct PeerOutBuf { v4u w[16]; v4u cq; float cs; };
__device__ __forceinline__ void peer_out_issue(const Frame& F, int tok, int slice, int lane, LAS int* wl, const PeerIds& id, PeerOutBuf& B) {
    const int e8 = lane >> 3, c16 = lane & 7;
    *(LAS v2u*)(wl + 2 * lane) = (v2u){id.w & 0xffffu, id.w >> 16};
    B.cq = *(const v4u*)(F.ws + WS_COEF + (size_t)tok * 128 + e8 * 16);
    B.cs = WSP(float, WS_CSC)[tok];
    const unsigned char* vb = WSP(unsigned char, WS_VT); const unsigned lofs = (unsigned)(slice * 128 + c16 * 16);
#pragma unroll
    for (int ld = 0; ld < 16; ++ld) { const unsigned eid = (unsigned)wl[e8 * 16 + ld]; B.w[ld] = *(const v4u*)(vb + (eid * 2048u + lofs)); }
}
__device__ __forceinline__ void peer_out_consume(const Frame& F, int tok, int slice, int lane, const PeerOutBuf& B, bool valid) {
    const int e8 = lane >> 3, c16 = lane & 7;
    int o[16];
#pragma unroll
    for (int i = 0; i < 16; ++i) o[i] = 0;
#pragma unroll
    for (int g = 0; g < 4; ++g) { const unsigned cq = B.cq[g];
#pragma unroll
        for (int d = 0; d < 4; ++d) { const unsigned w0 = B.w[4 * g][d], w1 = B.w[4 * g + 1][d], w2 = B.w[4 * g + 2][d], w3 = B.w[4 * g + 3][d];
            const unsigned lo01 = __builtin_amdgcn_perm(w1, w0, 0x05010400u), hi01 = __builtin_amdgcn_perm(w1, w0, 0x07030602u);
            const unsigned lo23 = __builtin_amdgcn_perm(w3, w2, 0x05010400u), hi23 = __builtin_amdgcn_perm(w3, w2, 0x07030602u);
            const unsigned t0 = __builtin_amdgcn_perm(lo23, lo01, 0x05040100u), t1 = __builtin_amdgcn_perm(lo23, lo01, 0x07060302u);
            const unsigned t2 = __builtin_amdgcn_perm(hi23, hi01, 0x05040100u), t3 = __builtin_amdgcn_perm(hi23, hi01, 0x07060302u);
            o[d * 4 + 0] = dot4i(t0, cq, o[d * 4 + 0]); o[d * 4 + 1] = dot4i(t1, cq, o[d * 4 + 1]); o[d * 4 + 2] = dot4i(t2, cq, o[d * 4 + 2]); o[d * 4 + 3] = dot4i(t3, cq, o[d * 4 + 3]); } }
#pragma unroll
    for (int k = 0; k < 8; ++k) { auto s = __builtin_amdgcn_permlane32_swap((unsigned)o[k], (unsigned)o[k + 8], false, false); o[k] = (int)(s[0] + s[1]); }
#pragma unroll
    for (int k = 0; k < 4; ++k) { auto s = __builtin_amdgcn_permlane16_swap((unsigned)o[k], (unsigned)o[k + 4], false, false); o[k] = (int)(s[0] + s[1]); }
    { const bool up = (lane & 8) != 0;
#pragma unroll
      for (int k = 0; k < 2; ++k) { const int keep = up ? o[k + 2] : o[k], send = up ? o[k] : o[k + 2]; o[k] = keep + dppi<0x128>(send); } }
    const float x0 = (float)o[0] * B.cs, x1 = (float)o[1] * B.cs;
    if (valid) *(unsigned*)(WSP(bf16, WS_PEERB) + (size_t)tok * D + slice * 128 + c16 * 16 + e8 * 2) = cvtpk(x0, x1);
}
__device__ __forceinline__ void peer_out_phase(const Frame& F, const PeerGeom& pg, LAS int* wl2) {
    const int lane = F.lane, first = pg.rank * NWAVES + F.wave, step = pg.nrank * NWAVES, n = first < T ? (T - first + step - 1) / step : 0;
    LAS int* wlA = wl2; LAS int* wlB = wl2 + 256;
    for (int r = 0; r < 16 / pg.ngrp; ++r) { const int slice = r * pg.ngrp + pg.g;
        PeerOutBuf A, B; PeerIds id = peer_ids_load(F, PEER_TOKC(0), lane);
        { const PeerIds cur = id; id = peer_ids_load(F, PEER_TOKC(1), lane); asm volatile("" ::: "memory"); peer_out_issue(F, PEER_TOKC(0), slice, lane, wlA, cur, A); }
        for (int i = 0; i < n; i += 2) {
            { const PeerIds cur = id; id = peer_ids_load(F, PEER_TOKC(i + 2), lane); asm volatile("" ::: "memory"); peer_out_issue(F, PEER_TOKC(i + 1), slice, lane, wlB, cur, B); }
            peer_out_consume(F, first + i * step, slice, lane, A, true);
            { const PeerIds cur = id; id = peer_ids_load(F, PEER_TOKC(i + 3), lane); asm volatile("" ::: "memory"); peer_out_issue(F, PEER_TOKC(i + 2), slice, lane, wlA, cur, A); }
            peer_out_consume(F, first + (i + 1) * step, slice, lane, B, i + 1 < n);
        }
    }
}
#undef PEER_TOKC
__device__ __forceinline__ void final_norm_phase(const Frame& F) {
    const int lane = F.lane, gw = F.bid * NWAVES + F.wave, NGW = F.G * NWAVES;
    const f32x4* gf = (const f32x4*)F.in[I_GF] + lane;
    f32x4 g[8];
#pragma unroll
    for (int j = 0; j < 8; ++j) g[j] = gf[64 * j];
    if (gw >= T) return;
    v2u va[8], vb[8], vap[8], vbp[8]; float sa, sb;
#define FN_LOAD(v_, s_, tok_) do { const int tc_ = (tok_) < T ? (tok_) : T - 1; const v2u* xi_ = (const v2u*)(WSP(bf16, WS_XB) + (size_t)tc_ * D) + lane; const v2u* pi_ = (const v2u*)(WSP(bf16, WS_PEERB) + (size_t)tc_ * D) + lane; \
        _Pragma("unroll") for (int j_ = 0; j_ < 8; ++j_) { v_[j_] = xi_[64 * j_]; v_##p[j_] = pi_[64 * j_]; } } while (0)
#define FN_STORE(v_, s_, tok_) do { f32x4* xo_ = (f32x4*)(F.out + (size_t)(tok_) * D) + lane; s_ = 0.f; f32x4 f_[8]; \
        _Pragma("unroll") for (int j_ = 0; j_ < 8; ++j_) { f_[j_] = (f32x4){bf_lo(v_[j_].x) + bf_lo(v_##p[j_].x), bf_hi(v_[j_].x) + bf_hi(v_##p[j_].x), bf_lo(v_[j_].y) + bf_lo(v_##p[j_].y), bf_hi(v_[j_].y) + bf_hi(v_##p[j_].y)}; s_ += (f_[j_][0] * f_[j_][0] + f_[j_][1] * f_[j_][1]) + (f_[j_][2] * f_[j_][2] + f_[j_][3] * f_[j_][3]); } \
        s_ = wave_sum(s_); const float rs_ = 1.0f / sqrtf(s_ * (1.0f / D) + NORM_EPS); \
        _Pragma("unroll") for (int j_ = 0; j_ < 8; ++j_) xo_[64 * j_] = f_[j_] * rs_ * g[j_]; } while (0)
    FN_LOAD(va, sa, gw);
    for (int tok = gw; tok < T; tok += 2 * NGW) {
        FN_LOAD(vb, sb, tok + NGW);
        FN_STORE(va, sa, tok);
        FN_LOAD(va, sa, tok + 2 * NGW);
        if (tok + NGW < T) FN_STORE(vb, sb, tok + NGW);
    }
#undef FN_LOAD
#undef FN_STORE
}

struct Args { const float* in[28]; float* out; unsigned char* ws; int ph_lo, ph_hi, li, pad; };
__global__ void __launch_bounds__(NTHR, 2) hybrid_fwd(Args args) {
    extern __shared__ __attribute__((aligned(16))) unsigned char lds[];
    Frame F;
    F.lds = (LAS unsigned char*)lds;
    F.tid = threadIdx.x; F.lane = F.tid & 63; F.wave = __builtin_amdgcn_readfirstlane(F.tid >> 6);
    F.G = gridDim.x; F.bid = blockIdx.x;
#pragma unroll
    for (int i = 0; i < 28; ++i) F.in[i] = args.in[i];
    F.out = args.out; F.ws = args.ws;
    volatile LAS unsigned* MISC = (volatile LAS unsigned*)(F.lds + MISC_OFF);
    for (int u = F.tid; u < (LDS_BYTES - LDSCTL_OFF) / 4; u += NTHR) ((LAS unsigned*)(F.lds + LDSCTL_OFF))[u] = 0u;
    __syncthreads();
    unsigned* barw = (unsigned*)(F.ws + WS_CTL) + CW_BAR;
    XcdBarrier bar; bar.bar = barw; bar.x = 0; bar.st = nullptr;
    if (N_LAUNCHES == 1) bar = xcd_barrier_post(barw, MISC + 8);
    const int lo = args.ph_lo, hi = args.ph_hi;
#define IN(k) (lo <= (k) && (k) < hi)
#define SEAM(k) do { if (IN(k) && IN((k) + 1)) xcd_barrier(bar); } while (0)

#ifndef PROBE_DUP
#define PROBE_DUP -1
#endif
#define REPS(k) for (int rep_ = 0; rep_ < ((PROBE_DUP) == (k) ? 2 : 1); ++rep_)
    if (IN(0)) REPS(0) { p0_prologue<0>(F, F.bid, F.G); __syncthreads(); }
    SEAM(0);
    if (IN(1)) REPS(1) {
        pg8::Gemm g{(const bf16*)((const unsigned char*)F.out + OUT_X8), WSP(const bf16, WS_WIN), T, NINP, D / 2}; pg8::StaticOrder S; S.init(T, NINP, F.G, F.bid);
        pg8::EpiI8RowColBf16<0> E{WSP(bf16, WS_PROJ), NINP, WSP(const float, WS_RSTD1), WSP(const float, WS_CS1), nullptr, NORM_EPS};
        pg8::gemm_phase<pg8::EpiI8RowColBf16<0>, pg8::StaticOrder, true, true, true>(F.lds, g, S, E);
    }
    SEAM(1);
    if (IN(2)) REPS(2) {
        lora_prepass(F);
        group_barrier((unsigned*)(F.ws + WS_CTL) + CW_PREBAR, (unsigned)F.G);
        for (int r4 = 0; r4 < ((PROBE_DUP) == 70 ? 2 : 1); ++r4) rwkv_prep_phase(F);
        group_barrier((unsigned*)(F.ws + WS_CTL) + CW_PREPBAR, (unsigned)F.G);
        const int R1 = F.G >= 256 ? 128 : F.G, L0 = F.G >= 256 ? 128 : 0, NL = F.G - L0;
        if (F.bid < R1) for (int it = F.bid; it < 128; it += R1) rwkv_item(F, it);
        if (F.bid >= L0) for (int it = F.bid - L0; it < 128; it += NL) lru_seq(F, it);
        { volatile LAS int* qslot = (volatile LAS int*)(F.lds + LDSCTL_OFF + 1024);
          for (;;) { __syncthreads(); if (F.tid == 0) *qslot = (int)xb_add((unsigned*)(F.ws + WS_CTL) + CW_DEFQ, 1u); __syncthreads();
              const int vb = *qslot; if (vb >= DEF_SLICES) break; p0_prologue<1>(F, vb, DEF_SLICES); } }
    }
    SEAM(2);
    if (IN(3)) REPS(3) { const int gw = F.bid * NWAVES + F.wave, NGW = F.G * NWAVES;
        for (int tok = gw; tok < T; tok += 2 * NGW) yquant_tokens(F, tok, tok + NGW < T ? tok + NGW : tok, F.lane); }
    SEAM(3);
    if (IN(4)) REPS(4) {
        pg8::Gemm g{WSP(const bf16, WS_YQ), WSP(const bf16, WS_WOUT), T, D, D / 2}; pg8::StaticOrder S; S.init(T, D, F.G, F.bid);
        pg8::EpiI8Residual E{(const unsigned char*)F.out + OUT_X8, WSP(const float, WS_SX0), WSP(bf16, WS_XB), D, WSP(const float, WS_SY), WSP(const float, WS_CSO)};
        pg8::gemm_phase<pg8::EpiI8Residual, pg8::StaticOrder, true, true, true>(F.lds, g, S, E);
    }
    SEAM(4);
    if (IN(5)) { const int gw = F.bid * NWAVES + F.wave, NGW = F.G * NWAVES;
        for (int tok = gw; tok < T; tok += NGW) xquant_token(F, tok, F.lane); }
    SEAM(5);
    if (IN(6)) REPS(6) {
        pg8::Gemm g{WSP(const bf16, WS_XQ), WSP(const bf16, WS_WQ), T, D, D / 2}; pg8::StaticOrder S; S.init(T, D, F.G, F.bid);
        pg8::EpiI8RowColBf16<1> E{WSP(bf16, WS_Q), D, WSP(const float, WS_SX), WSP(const float, WS_CSQ), WSP(const float, WS_SSQ2), NORM_EPS};
        pg8::gemm_phase<pg8::EpiI8RowColBf16<1>, pg8::StaticOrder, true, true, true>(F.lds, g, S, E);
    }
    if (IN(6)) { __syncthreads();
        pg8::StaticOrder S; S.init(T, D, F.G, F.bid); pg8::Unit u;
        for (int i = 0; S.next(i, u); ++i) route_item(F, ((u.pm * 8 + F.wave) << 3) | u.pn, F.lane); }
    SEAM(6);
    { const PeerGeom pg = peer_geom(F); LAS int* wl = (LAS int*)(F.lds + F.wave * 1024);
      if (IN(7)) REPS(7) peer_score_phase(F, pg, (LAS int*)(F.lds + 16384 + F.wave * 2048));
      SEAM(7);
      if (IN(8)) REPS(8) { const int gw = F.bid * NWAVES + F.wave, NGW = F.G * NWAVES; for (int tok = gw; tok < T; tok += 4 * NGW) { int tk[4]; bool vl[4];
#pragma unroll
            for (int i = 0; i < 4; ++i) { const int t = tok + i * NGW; vl[i] = t < T; tk[i] = vl[i] ? t : tok; }
            peer_coef_tokens<4>(F, tk, vl, F.lane); } }
      SEAM(8);
      if (IN(9)) peer_out_phase(F, pg, (LAS int*)(F.lds + 16384 + F.wave * 2048));
      SEAM(9);
      if (IN(10)) final_norm_phase(F); }
#undef IN
#undef SEAM
}

extern "C" void kernel_launch(void* const* d_in, const int* in_sizes, int n_in, void* d_out, int out_size, void* d_ws, size_t ws_size, hipStream_t stream) {
    static int grid = 0;
    if (grid == 0) {
        if (n_in != 28 || in_sizes[0] != T * D || out_size != T * D || ws_size < WS_END) { fprintf(stderr, "kernel_launch: shape/workspace mismatch: n_in %d in0 %d out %d ws %zu (need %zu)\n", n_in, n_in > 0 ? in_sizes[0] : -1, out_size, ws_size, (size_t)WS_END); grid = -1; return; }
        int dev = 0, cus = 0, per_cu = 0;
        if (hipGetDevice(&dev) != hipSuccess || hipDeviceGetAttribute(&cus, hipDeviceAttributeMultiprocessorCount, dev) != hipSuccess) { fprintf(stderr, "kernel_launch: device query failed\n"); grid = -1; return; }
        if (hipFuncSetAttribute((const void*)hybrid_fwd, hipFuncAttributeMaxDynamicSharedMemorySize, LDS_BYTES) != hipSuccess) { fprintf(stderr, "kernel_launch: hipFuncSetAttribute failed\n"); grid = -1; return; }
        if (hipOccupancyMaxActiveBlocksPerMultiprocessor(&per_cu, (const void*)hybrid_fwd, NTHR, LDS_BYTES) != hipSuccess || per_cu < 1) { fprintf(stderr, "kernel_launch: occupancy query says %d blocks per CU\n", per_cu); per_cu = 1; }
        (void)hipGetLastError();
        grid = cus;
    }
    if (grid < 0) return;
    if (hipMemsetAsync((char*)d_ws + WS_CTL, 0, CTL_ZERO_BYTES, stream) != hipSuccess) { fprintf(stderr, "kernel_launch: hipMemsetAsync failed\n"); return; }
    Args a{};
    for (int i = 0; i < 28; ++i) a.in[i] = (const float*)d_in[i];
    a.out = (float*)d_out; a.ws = (unsigned char*)d_ws;
    for (int li = 0; li < N_LAUNCHES; ++li) {
        a.ph_lo = (N_LAUNCHES == 1) ? 0 : li; a.ph_hi = (N_LAUNCHES == 1) ? N_PHASES : li + 1; a.li = li;
        hipLaunchKernelGGL(hybrid_fwd, dim3(grid), dim3(NTHR), LDS_BYTES, stream, a);
        const hipError_t le = hipPeekAtLastError();
        if (le != hipSuccess) { fprintf(stderr, "kernel_launch: launch %d failed: %s\n", li, hipGetErrorName(le)); break; }
    }
}
```
